# Optimizing an MI355X kernel written in HIP

```python
import math
import jax, jax.numpy as jnp
from jax import lax
import numpy as np

D_MODEL = 1024
BATCH = 4
SEQ = 4096
DEPTH = 1

N_HEADS = 8
HEAD_DIM = 64
N_KV_HEADS = 2
GROUP = N_HEADS // N_KV_HEADS
ATTN_WIDTH = N_HEADS * HEAD_DIM
KV_W = N_KV_HEADS * HEAD_DIM
LRU_WIDTH = D_MODEL - ATTN_WIDTH
LRU_BLOCKS = 8
LRU_BLOCK_DIM = LRU_WIDTH // LRU_BLOCKS
CONV_WIDTH = 4
LRU_C = 8.0
CMP_LEN = 32
CMP_STRIDE = 16
CMP_HIDDEN = 256
SEL_LEN = 64
SEL_TOPK = 16
N_LOCAL_BLOCKS = 2
WINDOW = 512
Q_BLOCK = 128
N_BRANCH = 3
FORCE_LOCAL = 2.0e4
FORCE_INIT = 1.0e4
REL_BUCKETS = 32
REL_MAX_DIST = 128
PEER_HEADS = 8
PEER_N_KEYS = 128
PEER_EXPERTS = PEER_N_KEYS * PEER_N_KEYS
PEER_D_KEY = 256
PEER_TOPK = 16
PEER_CHUNK = 128
PLE_DIM = 256
EPS = 1e-6
NEG = -1e30
IN_SPLITS = [ATTN_WIDTH] + [KV_W] * 6 + [N_HEADS * N_BRANCH, LRU_WIDTH, LRU_WIDTH]
IN_COLS = sum(IN_SPLITS)

kernel_name = 'hymba_nsa_rglru_peer_layer'


def rmsnorm(x, g):
    xf = x.astype(jnp.float32)
    y = xf * lax.rsqrt(jnp.mean(xf * xf, axis=-1, keepdims=True) + EPS)
    return (y * g.astype(jnp.float32)).astype(x.dtype)


def masked_softmax(logits, mask):
    logits = jnp.where(mask, logits.astype(jnp.float32), NEG)
    p = jax.nn.softmax(logits, axis=-1)
    return jnp.where(mask, p, 0.0)


def rel_bucket(dist):
    n = jnp.maximum(dist, 0)
    max_exact = REL_BUCKETS // 2
    nf = jnp.maximum(n, max_exact).astype(jnp.float32)
    large = max_exact + (jnp.log(nf / max_exact) / math.log(REL_MAX_DIST / max_exact)
                         * (REL_BUCKETS - max_exact)).astype(jnp.int32)
    large = jnp.minimum(large, REL_BUCKETS - 1)
    return jnp.where(n < max_exact, n, large)


def nsa_mixer(q, kc, vc, ks, vs, kw, vw, gates, cmp_k_pe, cmp_k_w1, cmp_k_w2,
              cmp_v_pe, cmp_v_w1, cmp_v_w2, rel_table):
    B, T = q.shape[0], q.shape[1]
    dt = q.dtype
    f32 = jnp.float32
    table_kg = rel_table.T.reshape(N_KV_HEADS, GROUP, REL_BUCKETS)

    def heads(t, n):
        return t.reshape(B, T, n, HEAD_DIM).transpose(0, 2, 1, 3)

    qh = heads(q, N_HEADS).reshape(B, N_KV_HEADS, GROUP, T, HEAD_DIM) * (HEAD_DIM ** -0.5)
    kc, vc, ks, vs, kw, vw = [heads(t, N_KV_HEADS) for t in (kc, vc, ks, vs, kw, vw)]
    t_pos = jnp.arange(T, dtype=jnp.int32)

    n_cmp = (T - CMP_LEN) // CMP_STRIDE + 1
    cmp_start = jnp.arange(n_cmp, dtype=jnp.int32) * CMP_STRIDE
    tok_idx = cmp_start[:, None] + jnp.arange(CMP_LEN, dtype=jnp.int32)[None, :]

    def compress(kv, pe, w1, w2):
        blk = kv[:, :, tok_idx] + pe
        blk = blk.reshape(B, N_KV_HEADS, n_cmp, CMP_LEN * HEAD_DIM)
        return jax.nn.gelu(blk @ w1) @ w2

    k_cmp = compress(kc, cmp_k_pe, cmp_k_w1, cmp_k_w2)
    v_cmp = compress(vc, cmp_v_pe, cmp_v_w1, cmp_v_w2)
    dist_c = t_pos[:, None] - (cmp_start + CMP_LEN - 1)[None, :]
    bias_c = table_kg[:, :, rel_bucket(dist_c)]
    logit_c = jnp.einsum('bkgtd,bkcd->bkgtc', qh, k_cmp).astype(f32) + bias_c
    p_c = masked_softmax(logit_c, dist_c >= 0)
    o_c = jnp.einsum('bkgtc,bkcd->bkgtd', p_c.astype(dt), v_cmp)

    n_sel = T // SEL_LEN
    sel_start = jnp.arange(n_sel, dtype=jnp.int32) * SEL_LEN
    overlap = jnp.clip(jnp.minimum(cmp_start[:, None] + CMP_LEN, sel_start[None, :] + SEL_LEN)
                       - jnp.maximum(cmp_start[:, None], sel_start[None, :]), 0, None)
    overlap = overlap.astype(f32) / CMP_LEN
    imp = jnp.einsum('bkgtc,cs->bkts', p_c, overlap)
    d_blk = (t_pos // SEL_LEN)[:, None] - jnp.arange(n_sel, dtype=jnp.int32)[None, :]
    local = (d_blk >= 0) & (d_blk < N_LOCAL_BLOCKS)
    initial = (jnp.arange(n_sel) == 0)[None, :]
    imp = jnp.where(local, FORCE_LOCAL, jnp.where(initial, FORCE_INIT, jnp.where(d_blk >= 0, imp, -1.0)))
    k_top = min(SEL_TOPK, n_sel)
    _, sel_idx = lax.top_k(imp, k_top)

    ks_blk = ks.reshape(B, N_KV_HEADS, n_sel, SEL_LEN, HEAD_DIM)
    vs_blk = vs.reshape(B, N_KV_HEADS, n_sel, SEL_LEN, HEAD_DIM)
    kw_pad = jnp.pad(kw, ((0, 0), (0, 0), (WINDOW, 0), (0, 0)))
    vw_pad = jnp.pad(vw, ((0, 0), (0, 0), (WINDOW, 0), (0, 0)))
    span = WINDOW + Q_BLOCK
    dist_w = (jnp.arange(Q_BLOCK, dtype=jnp.int32)[:, None]
              - jnp.arange(span, dtype=jnp.int32)[None, :] + WINDOW)
    band = (dist_w >= 0) & (dist_w < WINDOW)
    bias_w = table_kg[:, :, rel_bucket(dist_w)]
    bi = jnp.arange(B)[:, None, None, None]
    hi = jnp.arange(N_KV_HEADS)[None, :, None, None]
    hk6 = jnp.arange(N_KV_HEADS)[None, :, None, None, None, None]
    gi6 = jnp.arange(GROUP)[None, None, :, None, None, None]
    n_keys_sel = k_top * SEL_LEN

    def chunk_fn(args):
        q_c, idx_c, q0 = args
        tq = q0 + jnp.arange(Q_BLOCK, dtype=jnp.int32)
        k_g = ks_blk[bi, hi, idx_c]
        v_g = vs_blk[bi, hi, idx_c]
        kpos = idx_c[..., None] * SEL_LEN + jnp.arange(SEL_LEN, dtype=jnp.int32)
        dist_s = tq[None, None, :, None, None] - kpos
        bias_s = table_kg[hk6, gi6, rel_bucket(dist_s)[:, :, None]]
        logit_s = jnp.einsum('bkgqd,bkqnsd->bkgqns', q_c, k_g).astype(f32) + bias_s
        logit_s = logit_s.reshape(B, N_KV_HEADS, GROUP, Q_BLOCK, n_keys_sel)
        mask_s = (dist_s >= 0).reshape(B, N_KV_HEADS, 1, Q_BLOCK, n_keys_sel)
        p_s = masked_softmax(logit_s, mask_s)
        o_s = jnp.einsum('bkgqn,bkqnd->bkgqd', p_s.astype(dt),
                         v_g.reshape(B, N_KV_HEADS, Q_BLOCK, n_keys_sel, HEAD_DIM))
        k_win = lax.dynamic_slice_in_dim(kw_pad, q0, span, axis=2)
        v_win = lax.dynamic_slice_in_dim(vw_pad, q0, span, axis=2)
        kpos_w = q0 - WINDOW + jnp.arange(span, dtype=jnp.int32)
        mask_w = band & (kpos_w >= 0)[None, :]
        logit_w = jnp.einsum('bkgqd,bksd->bkgqs', q_c, k_win).astype(f32) + bias_w
        p_w = masked_softmax(logit_w, mask_w)
        o_w = jnp.einsum('bkgqs,bksd->bkgqd', p_w.astype(dt), v_win)
        return o_s, o_w

    n_chunk = T // Q_BLOCK
    q_chunks = jnp.moveaxis(qh.reshape(B, N_KV_HEADS, GROUP, n_chunk, Q_BLOCK, HEAD_DIM), 3, 0)
    idx_chunks = jnp.moveaxis(sel_idx.reshape(B, N_KV_HEADS, n_chunk, Q_BLOCK, k_top), 2, 0)
    q0s = jnp.arange(n_chunk, dtype=jnp.int32) * Q_BLOCK
    o_s, o_w = lax.map(chunk_fn, (q_chunks, idx_chunks, q0s))
    o_s = jnp.moveaxis(o_s, 0, 3).reshape(B, N_HEADS, T, HEAD_DIM)
    o_w = jnp.moveaxis(o_w, 0, 3).reshape(B, N_HEADS, T, HEAD_DIM)
    o_c = o_c.reshape(B, N_HEADS, T, HEAD_DIM)

    g = jax.nn.sigmoid(gates.reshape(B, T, N_HEADS, N_BRANCH)).transpose(0, 2, 1, 3)
    o = g[..., 0:1] * o_c + g[..., 1:2] * o_s + g[..., 2:3] * o_w
    return o.transpose(0, 2, 1, 3).reshape(B, T, ATTN_WIDTH)


def rglru_mixer(xr, xg, conv_w, conv_b, wa, ba, wx, bx, lam):
    B, T, _ = xr.shape
    dt = xr.dtype
    xc = lax.conv_general_dilated(xr, conv_w, window_strides=(1,), padding=[(CONV_WIDTH - 1, 0)],
                                  dimension_numbers=('NWC', 'WIO', 'NWC'),
                                  feature_group_count=LRU_WIDTH) + conv_b
    xb = xc.reshape(B, T, LRU_BLOCKS, LRU_BLOCK_DIM)
    r = jax.nn.sigmoid(jnp.einsum('btnc,ncd->btnd', xb, wa).reshape(B, T, LRU_WIDTH) + ba)
    i = jax.nn.sigmoid(jnp.einsum('btnc,ncd->btnd', xb, wx).reshape(B, T, LRU_WIDTH) + bx)
    log_a = -LRU_C * r.astype(jnp.float32) * jax.nn.softplus(-lam.astype(jnp.float32))
    a = jnp.exp(log_a)
    b = jnp.sqrt(-jnp.expm1(2.0 * log_a)) * (i * xc).astype(jnp.float32)

    def combine(left, right):
        a1, b1 = left
        a2, b2 = right
        return a1 * a2, a2 * b1 + b2

    _, h = lax.associative_scan(combine, (a, b), axis=1)
    return h.astype(dt) * jax.nn.gelu(xg)


def peer_ffn(xn, wq, sub_keys, u_tab, v_tab):
    B, T, D = xn.shape
    dt = xn.dtype
    xt = xn.reshape(-1, PEER_CHUNK, D)

    def chunk(xc):
        q = (xc @ wq).reshape(PEER_CHUNK, PEER_HEADS, 2, PEER_D_KEY // 2)
        s = jnp.einsum('chpd,pkd->chpk', q, sub_keys).astype(jnp.float32)
        s1, i1 = lax.top_k(s[:, :, 0], PEER_TOPK)
        s2, i2 = lax.top_k(s[:, :, 1], PEER_TOPK)
        cand = (s1[..., :, None] + s2[..., None, :]).reshape(PEER_CHUNK, PEER_HEADS, PEER_TOPK * PEER_TOPK)
        sc, ci = lax.top_k(cand, PEER_TOPK)
        e = (jnp.take_along_axis(i1, ci // PEER_TOPK, axis=-1) * PEER_N_KEYS
             + jnp.take_along_axis(i2, ci % PEER_TOPK, axis=-1))
        g = jax.nn.softmax(sc, axis=-1).astype(dt)
        act = jax.nn.gelu(jnp.einsum('cd,chkd->chk', xc, u_tab[e]))
        return jnp.einsum('chk,chkd->cd', g * act, v_tab[e])

    return lax.map(chunk, xt).reshape(B, T, D)


def setup_inputs(seed: int = 0) -> dict:
    key = jax.random.key(seed)
    ks = jax.random.split(key, 32)
    f32 = jnp.float32

    def nrm(k, shape, scale):
        return jax.random.normal(k, shape, f32) * scale

    def gain(k, shape):
        return 1.0 + 0.02 * jax.random.normal(k, shape, f32)

    a8 = jax.random.uniform(ks[17], (DEPTH, LRU_WIDTH), f32, 0.9, 0.999)
    a = a8 ** (1.0 / LRU_C)
    lam = jnp.log(a) - jnp.log1p(-a)
    return {
        'x': nrm(ks[0], (BATCH, SEQ, D_MODEL), 1.0),
        'p': nrm(ks[1], (DEPTH, BATCH, SEQ, PLE_DIM), 1.0),
        'attn_norm': gain(ks[2], (DEPTH, D_MODEL)),
        'w_in': nrm(ks[3], (DEPTH, D_MODEL, IN_COLS), D_MODEL ** -0.5),
        'cmp_k_pe': nrm(ks[4], (DEPTH, CMP_LEN, HEAD_DIM), 0.3),
        'cmp_k_w1': nrm(ks[5], (DEPTH, CMP_LEN * HEAD_DIM, CMP_HIDDEN), (CMP_LEN * HEAD_DIM) ** -0.5),
        'cmp_k_w2': nrm(ks[6], (DEPTH, CMP_HIDDEN, HEAD_DIM), CMP_HIDDEN ** -0.5),
        'cmp_v_pe': nrm(ks[7], (DEPTH, CMP_LEN, HEAD_DIM), 0.3),
        'cmp_v_w1': nrm(ks[8], (DEPTH, CMP_LEN * HEAD_DIM, CMP_HIDDEN), (CMP_LEN * HEAD_DIM) ** -0.5),
        'cmp_v_w2': nrm(ks[9], (DEPTH, CMP_HIDDEN, HEAD_DIM), CMP_HIDDEN ** -0.5),
        'rel_table': nrm(ks[10], (REL_BUCKETS, N_HEADS), 0.5),
        'conv_w': nrm(ks[11], (DEPTH, CONV_WIDTH, 1, LRU_WIDTH), CONV_WIDTH ** -0.5),
        'conv_b': nrm(ks[12], (DEPTH, LRU_WIDTH), 0.01),
        'lru_wa': nrm(ks[13], (DEPTH, LRU_BLOCKS, LRU_BLOCK_DIM, LRU_BLOCK_DIM), LRU_BLOCK_DIM ** -0.5),
        'lru_ba': nrm(ks[14], (DEPTH, LRU_WIDTH), 0.01),
        'lru_wx': nrm(ks[15], (DEPTH, LRU_BLOCKS, LRU_BLOCK_DIM, LRU_BLOCK_DIM), LRU_BLOCK_DIM ** -0.5),
        'lru_bx': nrm(ks[16], (DEPTH, LRU_WIDTH), 0.01),
        'lru_lambda': lam,
        'grp_norm_attn': gain(ks[18], (DEPTH, ATTN_WIDTH)),
        'grp_norm_lru': gain(ks[19], (DEPTH, LRU_WIDTH)),
        'w_out': nrm(ks[20], (DEPTH, D_MODEL, D_MODEL), D_MODEL ** -0.5),
        'ffn_norm': gain(ks[21], (DEPTH, D_MODEL)),
        'peer_wq': nrm(ks[22], (DEPTH, D_MODEL, PEER_HEADS * PEER_D_KEY), D_MODEL ** -0.5),
        'peer_subkeys': nrm(ks[23], (DEPTH, 2, PEER_N_KEYS, PEER_D_KEY // 2), (PEER_D_KEY // 2) ** -0.5),
        'peer_u': nrm(ks[24], (DEPTH, PEER_EXPERTS, D_MODEL), D_MODEL ** -0.5),
        'peer_v': nrm(ks[25], (DEPTH, PEER_EXPERTS, D_MODEL), 0.3),
        'ple_norm': gain(ks[26], (DEPTH, D_MODEL)),
        'ple_wgate': nrm(ks[27], (DEPTH, D_MODEL, D_MODEL), D_MODEL ** -0.5),
        'ple_bgate': nrm(ks[28], (DEPTH, D_MODEL), 0.01),
        'ple_proj': nrm(ks[29], (DEPTH, PLE_DIM, D_MODEL), PLE_DIM ** -0.5),
        'final_norm': gain(ks[30], (D_MODEL,)),
    }


def reference(x, p, attn_norm, w_in, cmp_k_pe, cmp_k_w1, cmp_k_w2, cmp_v_pe, cmp_v_w1, cmp_v_w2,
              rel_table, conv_w, conv_b, lru_wa, lru_ba, lru_wx, lru_bx, lru_lambda,
              grp_norm_attn, grp_norm_lru, w_out, ffn_norm, peer_wq, peer_subkeys, peer_u, peer_v,
              ple_norm, ple_wgate, ple_bgate, ple_proj, final_norm):
    h = x
    split_at = [int(v) for v in np.cumsum(IN_SPLITS)[:-1]]
    for i in range(DEPTH):
        xn = rmsnorm(h, attn_norm[i])
        proj = xn @ w_in[i]
        q, kc, vc, ks, vs, kw, vw, gates, xr, xg = jnp.split(proj, split_at, axis=-1)
        a_out = nsa_mixer(q, kc, vc, ks, vs, kw, vw, gates, cmp_k_pe[i], cmp_k_w1[i], cmp_k_w2[i],
                          cmp_v_pe[i], cmp_v_w1[i], cmp_v_w2[i], rel_table)
        l_out = rglru_mixer(xr, xg, conv_w[i], conv_b[i], lru_wa[i], lru_ba[i], lru_wx[i], lru_bx[i],
                            lru_lambda[i])
        mixed = jnp.concatenate([rmsnorm(a_out, grp_norm_attn[i]), rmsnorm(l_out, grp_norm_lru[i])], axis=-1)
        h = h + mixed @ w_out[i]
        h = h + peer_ffn(rmsnorm(h, ffn_norm[i]), peer_wq[i], peer_subkeys[i], peer_u[i], peer_v[i])
        gate = jax.nn.sigmoid(rmsnorm(h, ple_norm[i]) @ ple_wgate[i] + ple_bgate[i])
        h = h + gate * (p[i] @ ple_proj[i])
    return rmsnorm(h, final_norm)
```

```cpp
#include <hip/hip_runtime.h>
#include <stdint.h>
#include <stdio.h>

typedef unsigned short bf16_t;
typedef float f32x4 __attribute__((ext_vector_type(4)));
typedef float f32x2 __attribute__((ext_vector_type(2)));
typedef unsigned u32x4 __attribute__((ext_vector_type(4)));
typedef unsigned u32x2 __attribute__((ext_vector_type(2)));
#define DI __device__ __forceinline__

constexpr int NB = 4, T_ = 4096, DM = 1024, NTOK = NB * T_;
constexpr int NH = 8, HD = 64, NKV = 2, GRP = 4, ATTW = 512, KVW = 128, LRUW = 512;
constexpr int INCOLS = 2328, NPROJ = 2560;
constexpr int NCMP = 255, NSEL = 64;
constexpr int PEER_H = 8, PEER_K = 16, PEER_NK = 128;
constexpr int PLE = 256;
constexpr float EPS = 1e-6f;

constexpr int PC_KV = 512, PC_XR = 1280, PC_XG = 1792, PC_GATE = 2304;

constexpr size_t MB = 1024 * 1024;
constexpr size_t WS_CTL   = 0;
constexpr size_t WS_WIN   = 64 * 1024;
constexpr size_t WS_WOUT  = WS_WIN  + (size_t)NPROJ * DM * 2;
constexpr size_t WS_WQS   = WS_WOUT + (size_t)DM * DM * 2;
constexpr size_t WS_WG    = WS_WQS  + (size_t)2048 * DM * 2;
constexpr size_t WS_WP    = WS_WG   + (size_t)DM * DM * 2;
constexpr size_t WS_CW1K  = WS_WP   + (size_t)DM * PLE * 2;
constexpr size_t WS_CW1V  = WS_CW1K + (size_t)256 * 2048 * 2;
constexpr size_t WS_CBK   = WS_CW1V + (size_t)256 * 2048 * 2;
constexpr size_t WS_CBV   = WS_CBK  + 1024;
constexpr size_t WS_RS0   = WS_CBV  + 1024;
constexpr size_t WS_RS2   = WS_RS0  + (size_t)NTOK * 4;
constexpr size_t WS_SSQ1  = WS_RS2  + (size_t)NTOK * 4;
constexpr size_t WS_SSQ3  = WS_SSQ1 + (size_t)16 * NTOK * 4;
constexpr size_t WS_KCMP  = WS_SSQ3 + (size_t)16 * NTOK * 4;
constexpr size_t WS_VCMP  = WS_KCMP + (size_t)8 * 256 * 64 * 4;
constexpr size_t WS_LRUP  = WS_VCMP + (size_t)8 * 256 * 64 * 4;
constexpr size_t WS_LRUH  = WS_LRUP + (size_t)256 * 512 * 4;
constexpr size_t WS_HID   = WS_LRUH + (size_t)256 * 512 * 4;
constexpr size_t WS_UB    = (WS_HID + (size_t)2 * 2048 * 256 * 4 + 4095) / 4096 * 4096;
constexpr size_t WS_VB    = WS_UB + (size_t)16384 * DM * 2;
constexpr size_t WS_PB    = WS_VB + (size_t)16384 * DM * 2;
constexpr size_t WS_XB    = WS_PB + (size_t)NTOK * PLE * 2;
constexpr size_t WS_R     = WS_XB + (size_t)NTOK * DM * 2;
constexpr size_t KVT = (size_t)NB * NKV * T_ * HD * 2 + 65536;
constexpr size_t R_QB    = WS_R;
constexpr size_t R_KC    = R_QB + (size_t)NTOK * 512 * 2;
constexpr size_t R_VC    = R_KC + KVT;
constexpr size_t R_KS    = R_VC + KVT;
constexpr size_t R_VS    = R_KS + KVT;
constexpr size_t R_KW    = R_VS + KVT;
constexpr size_t R_VW    = R_KW + KVT;
constexpr size_t R_GATE  = R_VW + KVT;
constexpr size_t R_XR    = R_GATE + (size_t)NTOK * 24 * 4;
constexpr size_t R_XG    = R_XR + (size_t)NTOK * 512 * 4;
constexpr size_t R_END13 = R_XG + (size_t)NTOK * 512 * 2;
constexpr size_t R_H1B   = WS_R;
constexpr size_t R_EXP   = R_H1B + (size_t)NTOK * DM * 2;
constexpr size_t R_GSM   = R_EXP + (size_t)NTOK * 128 * 4;
constexpr size_t R_BIG   = R_GSM + (size_t)NTOK * 128 * 4;
constexpr size_t WS_END  = (R_END13 > R_BIG + 64 * MB ? R_END13 : R_BIG + 64 * MB);
static_assert(WS_END <= 256 * MB, "workspace map exceeds 256 MiB");

DI float bf2f(bf16_t v) { return __uint_as_float((unsigned)v << 16); }
DI bf16_t f2bf(float x) { unsigned u = __float_as_uint(x); u += 0x7fffu + ((u >> 16) & 1u); return (bf16_t)(u >> 16); }
DI unsigned pack2bf(float lo, float hi) { return (unsigned)f2bf(lo) | ((unsigned)f2bf(hi) << 16); }
DI float gelu_tanh(float x) { const float u = 0.7978845608028654f * (x + 0.044715f * x * x * x); return 0.5f * x * (1.0f + tanhf(u)); }
DI float sigmoidf_(float x) { return 1.0f / (1.0f + __expf(-x)); }

__device__ const unsigned char REL_BUCKET_LUT[128] = {
0,1,2,3,4,5,6,7,8,9,10,11,12,13,14,15,16,16,16,17,17,18,18,18,19,19,19,20,20,20,20,21,21,21,21,22,22,22,22,22,23,23,23,23,23,23,24,24,24,24,24,24,25,25,25,25,25,25,25,26,26,26,26,26,26,26,26,27,27,27,27,27,27,27,27,27,27,28,28,28,28,28,28,28,28,28,28,29,29,29,29,29,29,29,29,29,29,29,29,30,30,30,30,30,30,30,30,30,30,30,30,30,30,31,31,31,31,31,31,31,31,31,31,31,31,31,31,31};
DI int rel_bucket(int dist) { dist = dist < 0 ? 0 : dist; return dist >= 128 ? 31 : (int)REL_BUCKET_LUT[dist]; }

struct Params {
    const float* in[31];
    float* out;
    unsigned char* ws;
};
enum { I_X = 0, I_P, I_ATTN_NORM, I_W_IN, I_CK_PE, I_CK_W1, I_CK_W2, I_CV_PE, I_CV_W1, I_CV_W2, I_REL, I_CONV_W, I_CONV_B, I_LRU_WA, I_LRU_BA, I_LRU_WX, I_LRU_BX,
       I_LRU_LAM, I_GN_ATTN, I_GN_LRU, I_W_OUT, I_FFN_NORM, I_PEER_WQ, I_PEER_SUB, I_PEER_U, I_PEER_V, I_PLE_NORM, I_PLE_WG, I_PLE_BG, I_PLE_PROJ, I_FINAL_NORM };

struct EpiProj {
    const float* rs0; bf16_t* qb; bf16_t* kv0; float* gates; float* xr; bf16_t* xg;
    DI void store4(int row, int col, f32x4 v) const {
        const float s = rs0[row];
        v *= s;
        if (col < PC_KV) { v *= 0.125f; u32x2 w; w.x = pack2bf(v[0], v[1]); w.y = pack2bf(v[2], v[3]); *(u32x2*)(qb + (size_t)row * 512 + col) = w; }
        else if (col < PC_XR) {
            const int c = col - PC_KV, tensor = c >> 7, within = c & 127, kvh = within >> 6, d = within & 63, b = row >> 12, t = row & 4095;
            bf16_t* dst = (bf16_t*)((unsigned char*)kv0 + (size_t)tensor * KVT) + ((size_t)(b * NKV + kvh) * T_ + t) * HD + d;
            u32x2 w; w.x = pack2bf(v[0], v[1]); w.y = pack2bf(v[2], v[3]); *(u32x2*)dst = w;
        }
        else if (col < PC_XG) { *(f32x4*)(xr + (size_t)row * 512 + (col - PC_XR)) = v; }
        else if (col < PC_GATE) { u32x2 w; w.x = pack2bf(v[0], v[1]); w.y = pack2bf(v[2], v[3]); *(u32x2*)(xg + (size_t)row * 512 + (col - PC_XG)) = w; }
        else if (col < PC_GATE + 24) { *(f32x4*)(gates + (size_t)row * 24 + (col - PC_GATE)) = v; }
    }
};
struct EpiOut {
    const float* x; float* h1; bf16_t* h1b;
    DI void store4(int row, int col, f32x4 v) const {
        const size_t o = (size_t)row * DM + col;
        v += *(const f32x4*)(x + o);
        *(f32x4*)(h1 + o) = v;
        u32x2 w; w.x = pack2bf(v[0], v[1]); w.y = pack2bf(v[2], v[3]); *(u32x2*)(h1b + o) = w;
    }
};
struct EpiF32Plain { float* C; int ldc; int coloff;
    DI void store4(int row, int col, f32x4 v) const { *(f32x4*)(C + (size_t)row * ldc + (col - coloff)) = v; } };
struct EpiGate {
    const float* rs2; const float* bias; const float* pp; float* h;
    DI void store4(int row, int col, f32x4 v) const {
        const size_t o = (size_t)row * DM + col;
        const float s = rs2[row];
        const f32x4 bb = *(const f32x4*)(bias + col), p4 = *(const f32x4*)(pp + o);
        f32x4 hv = *(f32x4*)(h + o);
#pragma unroll
        for (int j = 0; j < 4; ++j) hv[j] += sigmoidf_(v[j] * s + bb[j]) * p4[j];
        *(f32x4*)(h + o) = hv;
    }
};
DI float wave_sum(float v) {
#pragma unroll
    for (int o = 32; o > 0; o >>= 1) v += __shfl_xor(v, o);
    return v;
}
DI float wave_max(float v) {
#pragma unroll
    for (int o = 32; o > 0; o >>= 1) v = fmaxf(v, __shfl_xor(v, o));
    return v;
}
DI float block_sum256(float v, float* red) {
    v = wave_sum(v); __syncthreads();
    if ((threadIdx.x & 63) == 0) red[threadIdx.x >> 6] = v; __syncthreads();
    return (red[0] + red[1]) + (red[2] + red[3]);
}
DI float block_max256(float v, float* red) {
    v = wave_max(v); __syncthreads();
    if ((threadIdx.x & 63) == 0) red[threadIdx.x >> 6] = v; __syncthreads();
    return fmaxf(fmaxf(red[0], red[1]), fmaxf(red[2], red[3]));
}

__global__ __launch_bounds__(256) void k_prep_x(const float* __restrict__ x, bf16_t* __restrict__ xb, float* __restrict__ rs0) {
    __shared__ float red[8];
    const int row = blockIdx.x, t = threadIdx.x;
    const f32x4 v = *(const f32x4*)(x + (size_t)row * DM + t * 4);
    float s = v[0] * v[0] + v[1] * v[1] + v[2] * v[2] + v[3] * v[3];
    s = block_sum256(s, red);
    u32x2 w; w.x = pack2bf(v[0], v[1]); w.y = pack2bf(v[2], v[3]);
    *(u32x2*)(xb + (size_t)row * DM + t * 4) = w;
    if (t == 0) rs0[row] = rsqrtf(s * (1.0f / DM) + EPS);
}
__global__ void k_prep_win(const float* __restrict__ w_in, const float* __restrict__ gain, bf16_t* __restrict__ WinT) {
    const int idx = blockIdx.x * blockDim.x + threadIdx.x;
    if (idx >= NPROJ * DM) return;
    const int n = idx / DM, k = idx % DM;
    int src = -1;
    if (n < PC_XR) src = n; else if (n < PC_XG) src = 1304 + (n - PC_XR); else if (n < PC_GATE) src = 1816 + (n - PC_XG); else if (n < PC_GATE + 24) src = 1280 + (n - PC_GATE);
    WinT[idx] = src >= 0 ? f2bf(w_in[(size_t)k * INCOLS + src] * gain[k]) : (bf16_t)0;
}
__global__ void k_transpose_bf16(const float* __restrict__ src, const float* __restrict__ gain, bf16_t* __restrict__ dst, int K, int N) {
    const int idx = blockIdx.x * blockDim.x + threadIdx.x;
    if (idx >= K * N) return;
    const int n = idx / K, k = idx % K;
    dst[idx] = f2bf(src[(size_t)k * N + n] * (gain ? gain[k] : 1.0f));
}
__global__ __launch_bounds__(128) void k_prep_wqs(const float* __restrict__ wq, const float* __restrict__ sub, const float* __restrict__ gain, bf16_t* __restrict__ WqsT) {
    __shared__ float wrow[128];
    const int d = blockIdx.x % DM, hp = blockIdx.x / DM, p = hp & 1, kk = threadIdx.x;
    wrow[kk] = wq[(size_t)d * 2048 + hp * 128 + kk];
    __syncthreads();
    const float* sk = sub + ((size_t)p * 128 + kk) * 128;
    float acc = 0.f;
    for (int j = 0; j < 128; ++j) acc += wrow[j] * sk[j];
    WqsT[(size_t)(hp * 128 + kk) * DM + d] = f2bf(acc * gain[d]);
}
__global__ void k_cvt_bf16(const float* __restrict__ src, const float* __restrict__ gain, bf16_t* __restrict__ dst, size_t n4, int cols) {
    for (size_t i = (size_t)blockIdx.x * blockDim.x + threadIdx.x; i < n4; i += (size_t)gridDim.x * blockDim.x) {
        f32x4 v = *(const f32x4*)(src + i * 4);
        if (gain) { const f32x4 g = *(const f32x4*)(gain + (i * 4) % cols); v *= g; }
        u32x2 w; w.x = pack2bf(v[0], v[1]); w.y = pack2bf(v[2], v[3]);
        *(u32x2*)(dst + i * 4) = w;
    }
}
__global__ __launch_bounds__(256) void k_prep_cmpbias(const float* __restrict__ pe, const float* __restrict__ w1, float* __restrict__ cb) {
    const int j = threadIdx.x; float acc = 0.f;
    for (int k = 0; k < 2048; ++k) acc += pe[k] * w1[(size_t)k * 256 + j];
    cb[j] = acc;
}

template <class Epi>
__global__ __launch_bounds__(256) void k_gemm_naive(const bf16_t* __restrict__ A, int lda, const bf16_t* __restrict__ Bt, int ldb, int K, Epi E) {
    __shared__ float As[32][68], Bs[32][68];
    const int t = threadIdx.x, tx = t & 15, ty = t >> 4;
    const int row0 = blockIdx.y * 64, col0 = blockIdx.x * 64;
    float acc[4][4] = {};
    const int lr = t >> 2, lk = (t & 3) * 8;
    for (int k0 = 0; k0 < K; k0 += 32) {
        const u32x4 av = *(const u32x4*)(A + (size_t)(row0 + lr) * lda + k0 + lk);
        const u32x4 bv = *(const u32x4*)(Bt + (size_t)(col0 + lr) * ldb + k0 + lk);
        __syncthreads();
#pragma unroll
        for (int j = 0; j < 4; ++j) {
            As[lk + 2 * j][lr] = __uint_as_float(av[j] << 16); As[lk + 2 * j + 1][lr] = __uint_as_float(av[j] & 0xffff0000u);
            Bs[lk + 2 * j][lr] = __uint_as_float(bv[j] << 16); Bs[lk + 2 * j + 1][lr] = __uint_as_float(bv[j] & 0xffff0000u);
        }
        __syncthreads();
#pragma unroll
        for (int k = 0; k < 32; ++k) {
            const f32x4 a = *(const f32x4*)&As[k][ty * 4], b = *(const f32x4*)&Bs[k][tx * 4];
#pragma unroll
            for (int i = 0; i < 4; ++i)
#pragma unroll
                for (int j = 0; j < 4; ++j) acc[i][j] += a[i] * b[j];
        }
    }
#pragma unroll
    for (int i = 0; i < 4; ++i) E.store4(row0 + ty * 4 + i, col0 + tx * 4, (f32x4){acc[i][0], acc[i][1], acc[i][2], acc[i][3]});
}

__global__ __launch_bounds__(256) void k_cmp_hidden(const bf16_t* __restrict__ kvb, const bf16_t* __restrict__ W1T, const float* __restrict__ cb, float* __restrict__ hidden) {
    const int row = blockIdx.x, j = threadIdx.x, bh = row >> 8, c = row & 255;
    if (c >= NCMP) { hidden[(size_t)row * 256 + j] = 0.f; return; }
    const bf16_t* a = kvb + ((size_t)bh * T_ + 16 * c) * HD;
    const bf16_t* w = W1T + (size_t)j * 2048;
    float acc = 0.f;
    for (int k = 0; k < 2048; ++k) acc += bf2f(a[k]) * bf2f(w[k]);
    hidden[(size_t)row * 256 + j] = acc + cb[j];
}
__global__ __launch_bounds__(64) void k_cmp_out(const float* __restrict__ hidden, const float* __restrict__ w2, float* __restrict__ out) {
    const int row = blockIdx.x, d = threadIdx.x;
    float acc = 0.f;
    for (int j = 0; j < 256; ++j) acc += gelu_tanh(hidden[(size_t)row * 256 + j]) * w2[j * 64 + d];
    out[(size_t)row * 64 + d] = acc;
}

struct NsaArgs { const bf16_t* qb; const bf16_t* ks; const bf16_t* vs; const bf16_t* kw; const bf16_t* vw; const float* kcmp; const float* vcmp; const float* gates; const float* rel; float* raw; };
template <bool KF32> DI void nsa_logits(int nk, const void* Kbase, const int* kp, const int* dist, float (*lg)[1024], const float (*qs)[64], const float* rel, int kvh) {
    for (int idx = threadIdx.x; idx < nk; idx += 256) {
        float acc[4] = {0.f, 0.f, 0.f, 0.f};
        if (dist[idx] >= 0) {
            if (KF32) { const float* kr = (const float*)Kbase + (size_t)kp[idx] * HD;
                for (int d = 0; d < 64; ++d) { const float kv = kr[d]; for (int g = 0; g < 4; ++g) acc[g] += qs[g][d] * kv; } }
            else { const bf16_t* kr = (const bf16_t*)Kbase + (size_t)kp[idx] * HD;
                for (int d = 0; d < 64; ++d) { const float kv = bf2f(kr[d]); for (int g = 0; g < 4; ++g) acc[g] += qs[g][d] * kv; } }
            const int bk = rel_bucket(dist[idx]);
            for (int g = 0; g < 4; ++g) lg[g][idx] = acc[g] + rel[bk * NH + kvh * 4 + g];
        } else { for (int g = 0; g < 4; ++g) lg[g][idx] = -INFINITY; }
    }
}
DI void nsa_softmax(int nk, float (*lg)[1024], float* inv, float* red) {
    for (int g = 0; g < 4; ++g) {
        float m = -INFINITY;
        for (int idx = threadIdx.x; idx < nk; idx += 256) m = fmaxf(m, lg[g][idx]);
        m = block_max256(m, red);
        float s = 0.f;
        for (int idx = threadIdx.x; idx < nk; idx += 256) { const float l = lg[g][idx]; const float e = (l == -INFINITY) ? 0.f : __expf(l - m); lg[g][idx] = e; s += e; }
        s = block_sum256(s, red);
        if (threadIdx.x == 0) inv[g] = 1.0f / s;
    }
    __syncthreads();
}
template <bool VF32> DI float nsa_pv(int nk, const void* Vbase, const int* kp, const float (*lg)[1024], const float* inv) {
    const int g = threadIdx.x >> 6, d = threadIdx.x & 63;
    float acc = 0.f;
    for (int idx = 0; idx < nk; ++idx) {
        const float v = VF32 ? ((const float*)Vbase)[(size_t)kp[idx] * HD + d] : bf2f(((const bf16_t*)Vbase)[(size_t)kp[idx] * HD + d]);
        acc += lg[g][idx] * v;
    }
    return acc * inv[g];
}
__global__ __launch_bounds__(256) void k_nsa_naive(NsaArgs a) {
    __shared__ float qs[4][64]; __shared__ float lg[4][1024]; __shared__ int kp[1024]; __shared__ int dist[1024];
    __shared__ float red[8]; __shared__ float inv[4]; __shared__ float imp[64]; __shared__ float vals[64]; __shared__ int selblk[16]; __shared__ int nsel_s;
    const int tid = threadIdx.x, t = blockIdx.x % T_, kvh = (blockIdx.x / T_) % NKV, b = blockIdx.x / (T_ * NKV), bh = b * NKV + kvh;
    const int g = tid >> 6, d = tid & 63, h = kvh * 4 + g;
    const size_t tok = (size_t)b * T_ + t;
    qs[g][d] = bf2f(a.qb[tok * 512 + h * 64 + d]);
    if (tid == 0) nsel_s = 0;
    const int ncv = t >= 31 ? (t - 31) / 16 + 1 : 0;
    for (int idx = tid; idx < ncv; idx += 256) { kp[idx] = idx; dist[idx] = t - (16 * idx + 31); }
    __syncthreads();
    float o_c = 0.f;
    if (ncv > 0) {
        nsa_logits<true>(ncv, a.kcmp + (size_t)bh * 256 * HD, kp, dist, lg, qs, a.rel, kvh);
        __syncthreads();
        nsa_softmax(ncv, lg, inv, red);
        o_c = nsa_pv<true>(ncv, a.vcmp + (size_t)bh * 256 * HD, kp, lg, inv);
    }
    if (tid < 64) {
        float s = 0.f;
        for (int gg = 0; gg < 4; ++gg) {
            float sg = 0.f;
            for (int j = -1; j <= 3; ++j) { const int c = 4 * tid + j; if (c >= 0 && c < ncv) sg += lg[gg][c] * ((j == -1 || j == 3) ? 0.5f : 1.0f); }
            s += sg * inv[gg];
        }
        if (ncv == 0) s = 0.f;
        const int qblk = t >> 6, db = qblk - tid;
        vals[tid] = (db >= 0 && db < 2) ? 2.0e4f : (tid == 0 ? 1.0e4f : (db >= 0 ? s : -1.0f));
    }
    __syncthreads();
    if (tid < 64) {
        const float v = vals[tid]; int rank = 0;
        for (int s2 = 0; s2 < 64; ++s2) { const float w = vals[s2]; rank += (w > v || (w == v && s2 < tid)) ? 1 : 0; }
        if (rank < 16 && (t >> 6) - tid >= 0) { const int slot = atomicAdd(&nsel_s, 1); selblk[slot] = tid; }
    }
    __syncthreads();
    const int nsel = nsel_s, nks = nsel * 64;
    for (int idx = tid; idx < nks; idx += 256) { const int kpos = selblk[idx >> 6] * 64 + (idx & 63); kp[idx] = kpos; dist[idx] = t - kpos; }
    __syncthreads();
    nsa_logits<false>(nks, a.ks + (size_t)bh * T_ * HD, kp, dist, lg, qs, a.rel, kvh);
    __syncthreads();
    nsa_softmax(nks, lg, inv, red);
    const float o_s = nsa_pv<false>(nks, a.vs + (size_t)bh * T_ * HD, kp, lg, inv);
    __syncthreads();
    const int lo = t - 511 > 0 ? t - 511 : 0, nkw = t - lo + 1;
    for (int idx = tid; idx < nkw; idx += 256) { kp[idx] = lo + idx; dist[idx] = t - (lo + idx); }
    __syncthreads();
    nsa_logits<false>(nkw, a.kw + (size_t)bh * T_ * HD, kp, dist, lg, qs, a.rel, kvh);
    __syncthreads();
    nsa_softmax(nkw, lg, inv, red);
    const float o_w = nsa_pv<false>(nkw, a.vw + (size_t)bh * T_ * HD, kp, lg, inv);
    const float* gt = a.gates + tok * 24 + h * 3;
    a.raw[tok * DM + h * 64 + d] = sigmoidf_(gt[0]) * o_c + sigmoidf_(gt[1]) * o_s + sigmoidf_(gt[2]) * o_w;
}

struct LruArgs { const float* xr; const bf16_t* xg; const float* conv_w; const float* conv_b; const float* wa; const float* ba; const float* wx; const float* bx; const float* lam; float* raw; };
__global__ __launch_bounds__(64) void k_lru_naive(LruArgs a) {
    __shared__ float xs[64];
    const int tid = threadIdx.x, n = blockIdx.x & 7, b = blockIdx.x >> 3, ch = n * 64 + tid;
    float war[64], wxr[64];
#pragma unroll
    for (int c = 0; c < 64; ++c) { war[c] = a.wa[(size_t)(n * 64 + c) * 64 + tid]; wxr[c] = a.wx[(size_t)(n * 64 + c) * 64 + tid]; }
    const float cw0 = a.conv_w[0 * 512 + ch], cw1 = a.conv_w[1 * 512 + ch], cw2 = a.conv_w[2 * 512 + ch], cw3 = a.conv_w[3 * 512 + ch], cb = a.conv_b[ch];
    const float ba = a.ba[ch], bx = a.bx[ch], sp = log1pf(__expf(-a.lam[ch]));
    float x3 = 0.f, x2 = 0.f, x1 = 0.f, h = 0.f;
    for (int t = 0; t < T_; ++t) {
        const size_t tok = (size_t)b * T_ + t;
        const float x0 = a.xr[tok * 512 + ch];
        const float xc = cw0 * x3 + cw1 * x2 + cw2 * x1 + cw3 * x0 + cb;
        x3 = x2; x2 = x1; x1 = x0;
        __syncthreads();
        xs[tid] = xc;
        __syncthreads();
        float rp = 0.f, ip = 0.f;
#pragma unroll
        for (int c = 0; c < 64; ++c) { const float xv = xs[c]; rp += xv * war[c]; ip += xv * wxr[c]; }
        const float r = sigmoidf_(rp + ba), i = sigmoidf_(ip + bx);
        const float log_a = -8.0f * r * sp, aa = __expf(log_a), bb = sqrtf(-expm1f(2.0f * log_a)) * (i * xc);
        h = aa * h + bb;
        a.raw[tok * DM + 512 + ch] = h * gelu_tanh(bf2f(a.xg[tok * 512 + ch]));
    }
}
__global__ __launch_bounds__(256) void k_grpnorm(const float* __restrict__ raw, const float* __restrict__ ga, const float* __restrict__ gl, bf16_t* __restrict__ mixed) {
    __shared__ float red[8];
    const int row = blockIdx.x, t = threadIdx.x;
    const f32x4 v = *(const f32x4*)(raw + (size_t)row * DM + t * 4);
    const float s = v[0] * v[0] + v[1] * v[1] + v[2] * v[2] + v[3] * v[3];
    const float sa = block_sum256(t < 128 ? s : 0.f, red);
    const float sl = block_sum256(t < 128 ? 0.f : s, red);
    const float rs = rsqrtf((t < 128 ? sa : sl) * (1.0f / 512) + EPS);
    const f32x4 g = t < 128 ? *(const f32x4*)(ga + t * 4) : *(const f32x4*)(gl + (t - 128) * 4);
    u32x2 w; w.x = pack2bf(v[0] * rs * g[0], v[1] * rs * g[1]); w.y = pack2bf(v[2] * rs * g[2], v[3] * rs * g[3]);
    *(u32x2*)(mixed + (size_t)row * DM + t * 4) = w;
}
__global__ __launch_bounds__(256) void k_rowssq(const float* __restrict__ h, float* __restrict__ ssq) {
    __shared__ float red[8];
    const int row = blockIdx.x, t = threadIdx.x;
    const f32x4 v = *(const f32x4*)(h + (size_t)row * DM + t * 4);
    float s = v[0] * v[0] + v[1] * v[1] + v[2] * v[2] + v[3] * v[3];
    s = block_sum256(s, red);
    if (t < 16) ssq[(size_t)t * NTOK + row] = t == 0 ? s : 0.f;
}

DI float rs_from_ssq(const float* ssq, int row) { float s = 0.f; for (int j = 0; j < 16; ++j) s += ssq[(size_t)j * NTOK + row]; return rsqrtf(s * (1.0f / DM) + EPS); }
__global__ __launch_bounds__(256) void k_peer_route(const float* __restrict__ scores, const float* __restrict__ ssq1, int hh, int* __restrict__ eout, float* __restrict__ gout) {
    __shared__ float s[256]; __shared__ float tv[2][16]; __shared__ int ti[2][16]; __shared__ float cand[256]; __shared__ float scs[16]; __shared__ int es[16];
    const int tid = threadIdx.x, tok = blockIdx.x >> 2, hl = blockIdx.x & 3, h = hh * 4 + hl;
    const float rs1 = rs_from_ssq(ssq1, tok);
    s[tid] = scores[(size_t)tok * 1024 + hl * 256 + tid] * rs1;
    __syncthreads();
    { const int p = tid >> 7, k = tid & 127; const float v = s[tid]; int rank = 0;
      for (int j = 0; j < 128; ++j) { const float w = s[p * 128 + j]; rank += (w > v || (w == v && j < k)) ? 1 : 0; }
      if (rank < 16) { tv[p][rank] = v; ti[p][rank] = k; } }
    __syncthreads();
    cand[tid] = tv[0][tid >> 4] + tv[1][tid & 15];
    __syncthreads();
    { const float v = cand[tid]; int rank = 0;
      for (int j = 0; j < 256; ++j) { const float w = cand[j]; rank += (w > v || (w == v && j < tid)) ? 1 : 0; }
      if (rank < 16) { scs[rank] = v; es[rank] = ti[0][tid >> 4] * 128 + ti[1][tid & 15]; } }
    __syncthreads();
    if (tid < 16) {
        float m = -INFINITY; for (int j = 0; j < 16; ++j) m = fmaxf(m, scs[j]);
        float sum = 0.f; for (int j = 0; j < 16; ++j) sum += __expf(scs[j] - m);
        eout[(size_t)tok * 128 + h * 16 + tid] = es[tid];
        gout[(size_t)tok * 128 + h * 16 + tid] = __expf(scs[tid] - m) / sum;
    }
}
__global__ __launch_bounds__(256) void k_peer_apply(const bf16_t* __restrict__ ub, const bf16_t* __restrict__ vb, const int* __restrict__ e, const float* __restrict__ gsm,
                                                    const float* __restrict__ ssq1, float* __restrict__ h, bf16_t* __restrict__ hb, float* __restrict__ rs2) {
    __shared__ float xrow[DM]; __shared__ float coef[128]; __shared__ int eid[128]; __shared__ float red[8];
    const int tid = threadIdx.x, tok = blockIdx.x, lane = tid & 63, w = tid >> 6;
    const float rs1 = rs_from_ssq(ssq1, tok);
    for (int i = tid; i < DM; i += 256) xrow[i] = bf2f(hb[(size_t)tok * DM + i]);
    if (tid < 128) eid[tid] = e[(size_t)tok * 128 + tid];
    __syncthreads();
    for (int j = w; j < 128; j += 4) {
        const bf16_t* ur = ub + (size_t)eid[j] * DM;
        float acc = 0.f;
        for (int i = lane; i < DM; i += 64) acc += xrow[i] * bf2f(ur[i]);
        acc = wave_sum(acc);
        if (lane == 0) coef[j] = gsm[(size_t)tok * 128 + j] * gelu_tanh(acc * rs1);
    }
    __syncthreads();
    f32x4 acc = {0.f, 0.f, 0.f, 0.f};
    for (int j = 0; j < 128; ++j) {
        const u32x2 v = *(const u32x2*)(vb + (size_t)eid[j] * DM + tid * 4); const float c = coef[j];
        acc[0] += c * __uint_as_float(v.x << 16); acc[1] += c * __uint_as_float(v.x & 0xffff0000u); acc[2] += c * __uint_as_float(v.y << 16); acc[3] += c * __uint_as_float(v.y & 0xffff0000u);
    }
    f32x4 hv = *(f32x4*)(h + (size_t)tok * DM + tid * 4);
    hv += acc;
    *(f32x4*)(h + (size_t)tok * DM + tid * 4) = hv;
    u32x2 wv; wv.x = pack2bf(hv[0], hv[1]); wv.y = pack2bf(hv[2], hv[3]);
    *(u32x2*)(hb + (size_t)tok * DM + tid * 4) = wv;
    float s = hv[0] * hv[0] + hv[1] * hv[1] + hv[2] * hv[2] + hv[3] * hv[3];
    s = block_sum256(s, red);
    if (tid == 0) rs2[tok] = rsqrtf(s * (1.0f / DM) + EPS);
}
__global__ __launch_bounds__(256) void k_final_norm(float* __restrict__ h, const float* __restrict__ ssq3, const float* __restrict__ g) {
    const int row = blockIdx.x, t = threadIdx.x;
    const float rs = rs_from_ssq(ssq3, row);
    f32x4 v = *(f32x4*)(h + (size_t)row * DM + t * 4); const f32x4 gg = *(const f32x4*)(g + t * 4);
    v = v * rs * gg;
    *(f32x4*)(h + (size_t)row * DM + t * 4) = v;
}
template <class Epi> static void gemm_naive(hipStream_t st, const bf16_t* A, int lda, const bf16_t* Bt, int ldb, int M, int N, int K, const Epi& E) {
    hipLaunchKernelGGL((k_gemm_naive<Epi>), dim3(N / 64, M / 64), dim3(256), 0, st, A, lda, Bt, ldb, K, E);
}

static void run_prologue_naive(hipStream_t st, const Params& p) {
    unsigned char* ws = p.ws;
    hipLaunchKernelGGL(k_prep_x, dim3(NTOK), dim3(256), 0, st, p.in[I_X], (bf16_t*)(ws + WS_XB), (float*)(ws + WS_RS0));
    hipLaunchKernelGGL(k_prep_win, dim3((NPROJ * DM + 255) / 256), dim3(256), 0, st, p.in[I_W_IN], p.in[I_ATTN_NORM], (bf16_t*)(ws + WS_WIN));
    hipLaunchKernelGGL(k_transpose_bf16, dim3(DM * DM / 256), dim3(256), 0, st, p.in[I_W_OUT], (const float*)nullptr, (bf16_t*)(ws + WS_WOUT), DM, DM);
    hipLaunchKernelGGL(k_transpose_bf16, dim3(DM * DM / 256), dim3(256), 0, st, p.in[I_PLE_WG], p.in[I_PLE_NORM], (bf16_t*)(ws + WS_WG), DM, DM);
    hipLaunchKernelGGL(k_transpose_bf16, dim3(PLE * DM / 256), dim3(256), 0, st, p.in[I_PLE_PROJ], (const float*)nullptr, (bf16_t*)(ws + WS_WP), PLE, DM);
    hipLaunchKernelGGL(k_transpose_bf16, dim3(2048 * 256 / 256), dim3(256), 0, st, p.in[I_CK_W1], (const float*)nullptr, (bf16_t*)(ws + WS_CW1K), 2048, 256);
    hipLaunchKernelGGL(k_transpose_bf16, dim3(2048 * 256 / 256), dim3(256), 0, st, p.in[I_CV_W1], (const float*)nullptr, (bf16_t*)(ws + WS_CW1V), 2048, 256);
    hipLaunchKernelGGL(k_prep_wqs, dim3(DM * 16), dim3(128), 0, st, p.in[I_PEER_WQ], p.in[I_PEER_SUB], p.in[I_FFN_NORM], (bf16_t*)(ws + WS_WQS));
    hipLaunchKernelGGL(k_cvt_bf16, dim3(2048), dim3(256), 0, st, p.in[I_PEER_U], p.in[I_FFN_NORM], (bf16_t*)(ws + WS_UB), (size_t)16384 * DM / 4, DM);
    hipLaunchKernelGGL(k_cvt_bf16, dim3(2048), dim3(256), 0, st, p.in[I_PEER_V], (const float*)nullptr, (bf16_t*)(ws + WS_VB), (size_t)16384 * DM / 4, DM);
    hipLaunchKernelGGL(k_cvt_bf16, dim3(1024), dim3(256), 0, st, p.in[I_P], (const float*)nullptr, (bf16_t*)(ws + WS_PB), (size_t)NTOK * PLE / 4, PLE);
    hipLaunchKernelGGL(k_prep_cmpbias, dim3(1), dim3(256), 0, st, p.in[I_CK_PE], p.in[I_CK_W1], (float*)(ws + WS_CBK));
    hipLaunchKernelGGL(k_prep_cmpbias, dim3(1), dim3(256), 0, st, p.in[I_CV_PE], p.in[I_CV_W1], (float*)(ws + WS_CBV));
}
static void run_p1_naive(hipStream_t st, const Params& p) {
    unsigned char* ws = p.ws;
    EpiProj E{(const float*)(ws + WS_RS0), (bf16_t*)(ws + R_QB), (bf16_t*)(ws + R_KC), (float*)(ws + R_GATE), (float*)(ws + R_XR), (bf16_t*)(ws + R_XG)};
    gemm_naive(st, (const bf16_t*)(ws + WS_XB), DM, (const bf16_t*)(ws + WS_WIN), DM, NTOK, NPROJ, DM, E);
}
static void run_p2_naive(hipStream_t st, const Params& p) {
    unsigned char* ws = p.ws;
    float* hid = (float*)(ws + WS_HID);
    hipLaunchKernelGGL(k_cmp_hidden, dim3(2048), dim3(256), 0, st, (const bf16_t*)(ws + R_KC), (const bf16_t*)(ws + WS_CW1K), (const float*)(ws + WS_CBK), hid);
    hipLaunchKernelGGL(k_cmp_hidden, dim3(2048), dim3(256), 0, st, (const bf16_t*)(ws + R_VC), (const bf16_t*)(ws + WS_CW1V), (const float*)(ws + WS_CBV), hid + (size_t)2048 * 256);
    hipLaunchKernelGGL(k_cmp_out, dim3(2048), dim3(64), 0, st, (const float*)hid, p.in[I_CK_W2], (float*)(ws + WS_KCMP));
    hipLaunchKernelGGL(k_cmp_out, dim3(2048), dim3(64), 0, st, (const float*)(hid + (size_t)2048 * 256), p.in[I_CV_W2], (float*)(ws + WS_VCMP));
}
static void run_p3_naive(hipStream_t st, const Params& p) {
    unsigned char* ws = p.ws;
    NsaArgs na{(const bf16_t*)(ws + R_QB), (const bf16_t*)(ws + R_KS), (const bf16_t*)(ws + R_VS), (const bf16_t*)(ws + R_KW), (const bf16_t*)(ws + R_VW),
               (const float*)(ws + WS_KCMP), (const float*)(ws + WS_VCMP), (const float*)(ws + R_GATE), p.in[I_REL], p.out};
    hipLaunchKernelGGL(k_nsa_naive, dim3(NB * NKV * T_), dim3(256), 0, st, na);
    LruArgs la{(const float*)(ws + R_XR), (const bf16_t*)(ws + R_XG), p.in[I_CONV_W], p.in[I_CONV_B], p.in[I_LRU_WA], p.in[I_LRU_BA], p.in[I_LRU_WX], p.in[I_LRU_BX], p.in[I_LRU_LAM], p.out};
    hipLaunchKernelGGL(k_lru_naive, dim3(NB * 8), dim3(64), 0, st, la);
    hipLaunchKernelGGL(k_grpnorm, dim3(NTOK), dim3(256), 0, st, (const float*)p.out, p.in[I_GN_ATTN], p.in[I_GN_LRU], (bf16_t*)(ws + WS_XB));
}
static void run_p4_naive(hipStream_t st, const Params& p) {
    unsigned char* ws = p.ws;
    EpiOut E{p.in[I_X], p.out, (bf16_t*)(ws + R_H1B)};
    gemm_naive(st, (const bf16_t*)(ws + WS_XB), DM, (const bf16_t*)(ws + WS_WOUT), DM, NTOK, DM, DM, E);
    hipLaunchKernelGGL(k_rowssq, dim3(NTOK), dim3(256), 0, st, (const float*)p.out, (float*)(ws + WS_SSQ1));
}
static void run_p5_naive(hipStream_t st, const Params& p) {
    unsigned char* ws = p.ws;
    for (int hh = 0; hh < 2; ++hh) {
        EpiF32Plain E{(float*)(ws + R_BIG), 1024, 0};
        gemm_naive(st, (const bf16_t*)(ws + R_H1B), DM, (const bf16_t*)(ws + WS_WQS) + (size_t)hh * 1024 * DM, DM, NTOK, 1024, DM, E);
        hipLaunchKernelGGL(k_peer_route, dim3(NTOK * 4), dim3(256), 0, st, (const float*)(ws + R_BIG), (const float*)(ws + WS_SSQ1), hh, (int*)(ws + R_EXP), (float*)(ws + R_GSM));
    }
}
static void run_p6_naive(hipStream_t st, const Params& p) {
    unsigned char* ws = p.ws;
    hipLaunchKernelGGL(k_peer_apply, dim3(NTOK), dim3(256), 0, st, (const bf16_t*)(ws + WS_UB), (const bf16_t*)(ws + WS_VB), (const int*)(ws + R_EXP), (const float*)(ws + R_GSM),
                       (const float*)(ws + WS_SSQ1), p.out, (bf16_t*)(ws + R_H1B), (float*)(ws + WS_RS2));
}
static void run_p7_naive(hipStream_t st, const Params& p) {
    unsigned char* ws = p.ws;
    EpiF32Plain Ep{(float*)(ws + R_BIG), DM, 0};
    gemm_naive(st, (const bf16_t*)(ws + WS_PB), PLE, (const bf16_t*)(ws + WS_WP), PLE, NTOK, DM, PLE, Ep);
    EpiGate Eg{(const float*)(ws + WS_RS2), p.in[I_PLE_BG], (const float*)(ws + R_BIG), p.out};
    gemm_naive(st, (const bf16_t*)(ws + R_H1B), DM, (const bf16_t*)(ws + WS_WG), DM, NTOK, DM, DM, Eg);
    hipLaunchKernelGGL(k_rowssq, dim3(NTOK), dim3(256), 0, st, (const float*)p.out, (float*)(ws + WS_SSQ3));
}
static void run_p8_naive(hipStream_t st, const Params& p) {
    hipLaunchKernelGGL(k_final_norm, dim3(NTOK), dim3(256), 0, st, p.out, (const float*)(p.ws + WS_SSQ3), p.in[I_FINAL_NORM]);
}
extern "C" void kernel_launch(void* const* d_in, const int* in_sizes, int n_in, void* d_out, int out_size, void* d_ws, size_t ws_size, hipStream_t stream) {
    if (n_in != 31 || out_size != NTOK * DM || ws_size < WS_END) { fprintf(stderr, "kernel_launch: unexpected shapes (n_in %d out %d ws %zu)\n", n_in, out_size, ws_size); return; }
    Params p{};
    for (int i = 0; i < 31; ++i) p.in[i] = (const float*)d_in[i];
    p.out = (float*)d_out; p.ws = (unsigned char*)d_ws;
    run_prologue_naive(stream, p);
    run_p1_naive(stream, p);
    run_p2_naive(stream, p);
    run_p3_naive(stream, p);
    run_p4_naive(stream, p);
    run_p5_naive(stream, p);
    run_p6_naive(stream, p);
    run_p7_naive(stream, p);
    run_p8_naive(stream, p);
}
```

```cpp
#include <hip/hip_runtime.h>
#include <stdint.h>
#include <stdio.h>

typedef unsigned short bf16_t;
typedef float f32x4 __attribute__((ext_vector_type(4)));
typedef float f32x2 __attribute__((ext_vector_type(2)));
typedef unsigned u32x4 __attribute__((ext_vector_type(4)));
typedef unsigned u32x2 __attribute__((ext_vector_type(2)));
#define DI __device__ __forceinline__

constexpr int NB = 4, T_ = 4096, DM = 1024, NTOK = NB * T_;
constexpr int NH = 8, HD = 64, NKV = 2, GRP = 4, ATTW = 512, KVW = 128, LRUW = 512;
constexpr int INCOLS = 2328, NPROJ = 2560;
constexpr int NCMP = 255, NSEL = 64;
constexpr int PEER_H = 8, PEER_K = 16, PEER_NK = 128;
constexpr int PLE = 256;
constexpr float EPS = 1e-6f;

constexpr int PC_KV = 512, PC_XR = 1280, PC_XG = 1792, PC_GATE = 2304;

constexpr size_t MB = 1024 * 1024;
constexpr size_t WS_CTL   = 0;
constexpr size_t WS_WIN   = 64 * 1024;
constexpr size_t WS_WOUT  = WS_WIN  + (size_t)NPROJ * DM * 2;
constexpr size_t WS_WQS   = WS_WOUT + (size_t)DM * DM * 2;
constexpr size_t WS_WG    = WS_WQS  + (size_t)2048 * DM * 2;
constexpr size_t WS_WP    = WS_WG   + (size_t)DM * DM * 2;
constexpr size_t WS_CW1K  = WS_WP   + (size_t)DM * PLE * 2;
constexpr size_t WS_CW1V  = WS_CW1K + (size_t)256 * 2048 * 2;
constexpr size_t WS_CBK   = WS_CW1V + (size_t)256 * 2048 * 2;
constexpr size_t WS_CBV   = WS_CBK  + 1024;
constexpr size_t WS_RS0   = WS_CBV  + 1024;
constexpr size_t WS_RS2   = WS_RS0  + (size_t)NTOK * 4;
constexpr size_t WS_SSQ1  = WS_RS2  + (size_t)NTOK * 4;
constexpr size_t WS_SSQ3  = WS_SSQ1 + (size_t)16 * NTOK * 4;
constexpr size_t WS_KCMP  = WS_SSQ3 + (size_t)16 * NTOK * 4;
constexpr size_t WS_VCMP  = WS_KCMP + (size_t)8 * 256 * 64 * 4;
constexpr size_t WS_LRUP  = WS_VCMP + (size_t)8 * 256 * 64 * 4;
constexpr size_t WS_LRUH  = WS_LRUP + (size_t)256 * 512 * 4;
constexpr size_t WS_WAT   = WS_LRUH + (size_t)256 * 512 * 4;
constexpr size_t WS_WXT   = WS_WAT + 8 * 64 * 64 * 2;
constexpr size_t WS_CW2K  = WS_WXT + 8 * 64 * 64 * 2;
constexpr size_t WS_CW2V  = WS_CW2K + 64 * 256 * 2;
constexpr size_t WS_HID   = WS_CW2V + 64 * 256 * 2;
constexpr size_t WS_UB    = (WS_HID + (size_t)2 * 2048 * 256 * 4 + 4095) / 4096 * 4096;
constexpr size_t WS_VB    = WS_UB + (size_t)16384 * DM * 2;
constexpr size_t WS_PB    = WS_VB + (size_t)16384 * DM * 2;
constexpr size_t WS_XB    = WS_PB + (size_t)NTOK * PLE * 2;
constexpr size_t WS_R     = WS_XB + (size_t)NTOK * DM * 2;
constexpr size_t KVT = (size_t)NB * NKV * T_ * HD * 2 + 65536;
constexpr size_t R_QB    = WS_R;
constexpr size_t R_KC    = R_QB + (size_t)NTOK * 512 * 2;
constexpr size_t R_VC    = R_KC + KVT;
constexpr size_t R_KS    = R_VC + KVT;
constexpr size_t R_VS    = R_KS + KVT;
constexpr size_t R_KW    = R_VS + KVT;
constexpr size_t R_VW    = R_KW + KVT;
constexpr size_t R_GATE  = R_VW + KVT;
constexpr size_t R_XR    = R_GATE + (size_t)NTOK * 24 * 4;
constexpr size_t R_XG    = R_XR + (size_t)NTOK * 512 * 4;
constexpr size_t R_VST   = R_XG + (size_t)NTOK * 512 * 2;
constexpr size_t R_VWT   = R_VST + KVT;
constexpr size_t R_KCB   = R_VWT + KVT;
constexpr size_t R_VCT   = R_KCB + (size_t)8 * 256 * 64 * 2;
constexpr size_t R_END13 = R_VCT + (size_t)8 * 256 * 64 * 2;
constexpr size_t R_H1B   = WS_R;
constexpr size_t R_EXP   = R_H1B + (size_t)NTOK * DM * 2;
constexpr size_t R_GSM   = R_EXP + (size_t)NTOK * 128 * 4;
constexpr size_t R_BIG   = R_GSM + (size_t)NTOK * 128 * 4;
constexpr size_t WS_END  = (R_END13 > R_BIG + 64 * MB ? R_END13 : R_BIG + 64 * MB);
static_assert(WS_END <= 256 * MB, "workspace map exceeds 256 MiB");

DI float bf2f(bf16_t v) { return __uint_as_float((unsigned)v << 16); }
DI bf16_t f2bf(float x) { unsigned u = __float_as_uint(x); u += 0x7fffu + ((u >> 16) & 1u); return (bf16_t)(u >> 16); }
DI unsigned pack2bf(float lo, float hi) { return (unsigned)f2bf(lo) | ((unsigned)f2bf(hi) << 16); }
DI float gelu_tanh(float x) { const float u = 0.7978845608028654f * (x + 0.044715f * x * x * x); return 0.5f * x * (1.0f + tanhf(u)); }
DI float sigmoidf_(float x) { return 1.0f / (1.0f + __expf(-x)); }

__device__ const unsigned char REL_BUCKET_LUT[128] = {
0,1,2,3,4,5,6,7,8,9,10,11,12,13,14,15,16,16,16,17,17,18,18,18,19,19,19,20,20,20,20,21,21,21,21,22,22,22,22,22,23,23,23,23,23,23,24,24,24,24,24,24,25,25,25,25,25,25,25,26,26,26,26,26,26,26,26,27,27,27,27,27,27,27,27,27,27,28,28,28,28,28,28,28,28,28,28,29,29,29,29,29,29,29,29,29,29,29,29,30,30,30,30,30,30,30,30,30,30,30,30,30,30,31,31,31,31,31,31,31,31,31,31,31,31,31,31,31};
DI int rel_bucket(int dist) { dist = dist < 0 ? 0 : dist; return dist >= 128 ? 31 : (int)REL_BUCKET_LUT[dist]; }

struct Params {
    const float* in[31];
    float* out;
    unsigned char* ws;
};
enum { I_X = 0, I_P, I_ATTN_NORM, I_W_IN, I_CK_PE, I_CK_W1, I_CK_W2, I_CV_PE, I_CV_W1, I_CV_W2, I_REL, I_CONV_W, I_CONV_B, I_LRU_WA, I_LRU_BA, I_LRU_WX, I_LRU_BX,
       I_LRU_LAM, I_GN_ATTN, I_GN_LRU, I_W_OUT, I_FFN_NORM, I_PEER_WQ, I_PEER_SUB, I_PEER_U, I_PEER_V, I_PLE_NORM, I_PLE_WG, I_PLE_BG, I_PLE_PROJ, I_FINAL_NORM };

struct EpiProj {
    const float* rs0; bf16_t* qb; bf16_t* kv0; float* gates; float* xr; bf16_t* xg;
    DI void store4(int row, int col, f32x4 v) const {
        const float s = rs0[row];
        v *= s;
        if (col < PC_KV) { v *= 0.125f; u32x2 w; w.x = pack2bf(v[0], v[1]); w.y = pack2bf(v[2], v[3]); *(u32x2*)(qb + (size_t)row * 512 + col) = w; }
        else if (col < PC_XR) {
            const int c = col - PC_KV, tensor = c >> 7, within = c & 127, kvh = within >> 6, d = within & 63, b = row >> 12, t = row & 4095;
            bf16_t* dst = (bf16_t*)((unsigned char*)kv0 + (size_t)tensor * KVT) + ((size_t)(b * NKV + kvh) * T_ + t) * HD + d;
            u32x2 w; w.x = pack2bf(v[0], v[1]); w.y = pack2bf(v[2], v[3]); *(u32x2*)dst = w;
        }
        else if (col < PC_XG) { *(f32x4*)(xr + (size_t)row * 512 + (col - PC_XR)) = v; }
        else if (col < PC_GATE) { u32x2 w; w.x = pack2bf(v[0], v[1]); w.y = pack2bf(v[2], v[3]); *(u32x2*)(xg + (size_t)row * 512 + (col - PC_XG)) = w; }
        else if (col < PC_GATE + 24) { *(f32x4*)(gates + (size_t)row * 24 + (col - PC_GATE)) = v; }
    }
};
struct EpiOut {
    const float* x; float* h1; bf16_t* h1b;
    DI void store4(int row, int col, f32x4 v) const {
        const size_t o = (size_t)row * DM + col;
        v += *(const f32x4*)(x + o);
        *(f32x4*)(h1 + o) = v;
        u32x2 w; w.x = pack2bf(v[0], v[1]); w.y = pack2bf(v[2], v[3]); *(u32x2*)(h1b + o) = w;
    }
};
struct EpiF32Plain { float* C; int ldc; int coloff;
    DI void store4(int row, int col, f32x4 v) const { *(f32x4*)(C + (size_t)row * ldc + (col - coloff)) = v; } };
struct EpiGate {
    const float* rs2; const float* bias; const float* pp; float* h;
    DI void store4(int row, int col, f32x4 v) const {
        const size_t o = (size_t)row * DM + col;
        const float s = rs2[row];
        const f32x4 bb = *(const f32x4*)(bias + col), p4 = *(const f32x4*)(pp + o);
        f32x4 hv = *(f32x4*)(h + o);
#pragma unroll
        for (int j = 0; j < 4; ++j) hv[j] += sigmoidf_(v[j] * s + bb[j]) * p4[j];
        *(f32x4*)(h + o) = hv;
    }
};
#ifndef LRU_NAIVE
#define LRU_NAIVE 0
#endif
#ifndef CMP_NAIVE
#define CMP_NAIVE 0
#endif
#ifndef OPT_MASK
#define OPT_MASK 0x1FF
#endif
DI float wave_sum(float v) {
#pragma unroll
    for (int o = 32; o > 0; o >>= 1) v += __shfl_xor(v, o);
    return v;
}
DI float wave_max(float v) {
#pragma unroll
    for (int o = 32; o > 0; o >>= 1) v = fmaxf(v, __shfl_xor(v, o));
    return v;
}
DI float block_sum256(float v, float* red) {
    v = wave_sum(v); __syncthreads();
    if ((threadIdx.x & 63) == 0) red[threadIdx.x >> 6] = v; __syncthreads();
    return (red[0] + red[1]) + (red[2] + red[3]);
}
DI float block_max256(float v, float* red) {
    v = wave_max(v); __syncthreads();
    if ((threadIdx.x & 63) == 0) red[threadIdx.x >> 6] = v; __syncthreads();
    return fmaxf(fmaxf(red[0], red[1]), fmaxf(red[2], red[3]));
}

__global__ __launch_bounds__(256) void k_prep_x(const float* __restrict__ x, bf16_t* __restrict__ xb, float* __restrict__ rs0) {
    __shared__ float red[8];
    const int row = blockIdx.x, t = threadIdx.x;
    const f32x4 v = *(const f32x4*)(x + (size_t)row * DM + t * 4);
    float s = v[0] * v[0] + v[1] * v[1] + v[2] * v[2] + v[3] * v[3];
    s = block_sum256(s, red);
    u32x2 w; w.x = pack2bf(v[0], v[1]); w.y = pack2bf(v[2], v[3]);
    *(u32x2*)(xb + (size_t)row * DM + t * 4) = w;
    if (t == 0) rs0[row] = rsqrtf(s * (1.0f / DM) + EPS);
}
__global__ void k_prep_win(const float* __restrict__ w_in, const float* __restrict__ gain, bf16_t* __restrict__ WinT) {
    const int idx = blockIdx.x * blockDim.x + threadIdx.x;
    if (idx >= NPROJ * DM) return;
    const int n = idx / DM, k = idx % DM;
    int src = -1;
    if (n < PC_XR) src = n; else if (n < PC_XG) src = 1304 + (n - PC_XR); else if (n < PC_GATE) src = 1816 + (n - PC_XG); else if (n < PC_GATE + 24) src = 1280 + (n - PC_GATE);
    WinT[idx] = src >= 0 ? f2bf(w_in[(size_t)k * INCOLS + src] * gain[k]) : (bf16_t)0;
}
__global__ void k_transpose_bf16(const float* __restrict__ src, const float* __restrict__ gain, bf16_t* __restrict__ dst, int K, int N) {
    const int idx = blockIdx.x * blockDim.x + threadIdx.x;
    if (idx >= K * N) return;
    const int n = idx / K, k = idx % K;
    dst[idx] = f2bf(src[(size_t)k * N + n] * (gain ? gain[k] : 1.0f));
}
__global__ __launch_bounds__(128) void k_prep_wqs(const float* __restrict__ wq, const float* __restrict__ sub, const float* __restrict__ gain, bf16_t* __restrict__ WqsT) {
    __shared__ float wrow[128];
    const int d = blockIdx.x % DM, hp = blockIdx.x / DM, p = hp & 1, kk = threadIdx.x;
    wrow[kk] = wq[(size_t)d * 2048 + hp * 128 + kk];
    __syncthreads();
    const float* sk = sub + ((size_t)p * 128 + kk) * 128;
    float acc = 0.f;
    for (int j = 0; j < 128; ++j) acc += wrow[j] * sk[j];
    WqsT[(size_t)(hp * 128 + kk) * DM + d] = f2bf(acc * gain[d]);
}
__global__ void k_cvt_bf16(const float* __restrict__ src, const float* __restrict__ gain, bf16_t* __restrict__ dst, size_t n4, int cols) {
    for (size_t i = (size_t)blockIdx.x * blockDim.x + threadIdx.x; i < n4; i += (size_t)gridDim.x * blockDim.x) {
        f32x4 v = *(const f32x4*)(src + i * 4);
        if (gain) { const f32x4 g = *(const f32x4*)(gain + (i * 4) % cols); v *= g; }
        u32x2 w; w.x = pack2bf(v[0], v[1]); w.y = pack2bf(v[2], v[3]);
        *(u32x2*)(dst + i * 4) = w;
    }
}
__global__ __launch_bounds__(256) void k_prep_cmpbias(const float* __restrict__ pe, const float* __restrict__ w1, float* __restrict__ cb) {
    const int j = threadIdx.x; float acc = 0.f;
    for (int k = 0; k < 2048; ++k) acc += pe[k] * w1[(size_t)k * 256 + j];
    cb[j] = acc;
}

template <class Epi>
__global__ __launch_bounds__(256) void k_gemm_naive(const bf16_t* __restrict__ A, int lda, const bf16_t* __restrict__ Bt, int ldb, int K, Epi E) {
    __shared__ float As[32][68], Bs[32][68];
    const int t = threadIdx.x, tx = t & 15, ty = t >> 4;
    const int row0 = blockIdx.y * 64, col0 = blockIdx.x * 64;
    float acc[4][4] = {};
    const int lr = t >> 2, lk = (t & 3) * 8;
    for (int k0 = 0; k0 < K; k0 += 32) {
        const u32x4 av = *(const u32x4*)(A + (size_t)(row0 + lr) * lda + k0 + lk);
        const u32x4 bv = *(const u32x4*)(Bt + (size_t)(col0 + lr) * ldb + k0 + lk);
        __syncthreads();
#pragma unroll
        for (int j = 0; j < 4; ++j) {
            As[lk + 2 * j][lr] = __uint_as_float(av[j] << 16); As[lk + 2 * j + 1][lr] = __uint_as_float(av[j] & 0xffff0000u);
            Bs[lk + 2 * j][lr] = __uint_as_float(bv[j] << 16); Bs[lk + 2 * j + 1][lr] = __uint_as_float(bv[j] & 0xffff0000u);
        }
        __syncthreads();
#pragma unroll
        for (int k = 0; k < 32; ++k) {
            const f32x4 a = *(const f32x4*)&As[k][ty * 4], b = *(const f32x4*)&Bs[k][tx * 4];
#pragma unroll
            for (int i = 0; i < 4; ++i)
#pragma unroll
                for (int j = 0; j < 4; ++j) acc[i][j] += a[i] * b[j];
        }
    }
#pragma unroll
    for (int i = 0; i < 4; ++i) E.store4(row0 + ty * 4 + i, col0 + tx * 4, (f32x4){acc[i][0], acc[i][1], acc[i][2], acc[i][3]});
}

__global__ __launch_bounds__(256) void k_cmp_hidden(const bf16_t* __restrict__ kvb, const bf16_t* __restrict__ W1T, const float* __restrict__ cb, float* __restrict__ hidden) {
    const int row = blockIdx.x, j = threadIdx.x, bh = row >> 8, c = row & 255;
    if (c >= NCMP) { hidden[(size_t)row * 256 + j] = 0.f; return; }
    const bf16_t* a = kvb + ((size_t)bh * T_ + 16 * c) * HD;
    const bf16_t* w = W1T + (size_t)j * 2048;
    float acc = 0.f;
    for (int k = 0; k < 2048; ++k) acc += bf2f(a[k]) * bf2f(w[k]);
    hidden[(size_t)row * 256 + j] = acc + cb[j];
}
__global__ __launch_bounds__(64) void k_cmp_out(const float* __restrict__ hidden, const float* __restrict__ w2, float* __restrict__ out) {
    const int row = blockIdx.x, d = threadIdx.x;
    float acc = 0.f;
    for (int j = 0; j < 256; ++j) acc += gelu_tanh(hidden[(size_t)row * 256 + j]) * w2[j * 64 + d];
    out[(size_t)row * 64 + d] = acc;
}

struct NsaArgs { const bf16_t* qb; const bf16_t* ks; const bf16_t* vs; const bf16_t* kw; const bf16_t* vw; const float* kcmp; const float* vcmp; const float* gates; const float* rel; float* raw; };
template <bool KF32> DI void nsa_logits(int nk, const void* Kbase, const int* kp, const int* dist, float (*lg)[1024], const float (*qs)[64], const float* rel, int kvh) {
    for (int idx = threadIdx.x; idx < nk; idx += 256) {
        float acc[4] = {0.f, 0.f, 0.f, 0.f};
        if (dist[idx] >= 0) {
            if (KF32) { const float* kr = (const float*)Kbase + (size_t)kp[idx] * HD;
                for (int d = 0; d < 64; ++d) { const float kv = kr[d]; for (int g = 0; g < 4; ++g) acc[g] += qs[g][d] * kv; } }
            else { const bf16_t* kr = (const bf16_t*)Kbase + (size_t)kp[idx] * HD;
                for (int d = 0; d < 64; ++d) { const float kv = bf2f(kr[d]); for (int g = 0; g < 4; ++g) acc[g] += qs[g][d] * kv; } }
            const int bk = rel_bucket(dist[idx]);
            for (int g = 0; g < 4; ++g) lg[g][idx] = acc[g] + rel[bk * NH + kvh * 4 + g];
        } else { for (int g = 0; g < 4; ++g) lg[g][idx] = -INFINITY; }
    }
}
DI void nsa_softmax(int nk, float (*lg)[1024], float* inv, float* red) {
    for (int g = 0; g < 4; ++g) {
        float m = -INFINITY;
        for (int idx = threadIdx.x; idx < nk; idx += 256) m = fmaxf(m, lg[g][idx]);
        m = block_max256(m, red);
        float s = 0.f;
        for (int idx = threadIdx.x; idx < nk; idx += 256) { const float l = lg[g][idx]; const float e = (l == -INFINITY) ? 0.f : __expf(l - m); lg[g][idx] = e; s += e; }
        s = block_sum256(s, red);
        if (threadIdx.x == 0) inv[g] = 1.0f / s;
    }
    __syncthreads();
}
template <bool VF32> DI float nsa_pv(int nk, const void* Vbase, const int* kp, const float (*lg)[1024], const float* inv) {
    const int g = threadIdx.x >> 6, d = threadIdx.x & 63;
    float acc = 0.f;
    for (int idx = 0; idx < nk; ++idx) {
        const float v = VF32 ? ((const float*)Vbase)[(size_t)kp[idx] * HD + d] : bf2f(((const bf16_t*)Vbase)[(size_t)kp[idx] * HD + d]);
        acc += lg[g][idx] * v;
    }
    return acc * inv[g];
}
__global__ __launch_bounds__(256) void k_nsa_naive(NsaArgs a) {
    __shared__ float qs[4][64]; __shared__ float lg[4][1024]; __shared__ int kp[1024]; __shared__ int dist[1024];
    __shared__ float red[8]; __shared__ float inv[4]; __shared__ float imp[64]; __shared__ float vals[64]; __shared__ int selblk[16]; __shared__ int nsel_s;
    const int tid = threadIdx.x, t = blockIdx.x % T_, kvh = (blockIdx.x / T_) % NKV, b = blockIdx.x / (T_ * NKV), bh = b * NKV + kvh;
    const int g = tid >> 6, d = tid & 63, h = kvh * 4 + g;
    const size_t tok = (size_t)b * T_ + t;
    qs[g][d] = bf2f(a.qb[tok * 512 + h * 64 + d]);
    if (tid == 0) nsel_s = 0;
    const int ncv = t >= 31 ? (t - 31) / 16 + 1 : 0;
    for (int idx = tid; idx < ncv; idx += 256) { kp[idx] = idx; dist[idx] = t - (16 * idx + 31); }
    __syncthreads();
    float o_c = 0.f;
    if (ncv > 0) {
        nsa_logits<true>(ncv, a.kcmp + (size_t)bh * 256 * HD, kp, dist, lg, qs, a.rel, kvh);
        __syncthreads();
        nsa_softmax(ncv, lg, inv, red);
        o_c = nsa_pv<true>(ncv, a.vcmp + (size_t)bh * 256 * HD, kp, lg, inv);
    }
    if (tid < 64) {
        float s = 0.f;
        for (int gg = 0; gg < 4; ++gg) {
            float sg = 0.f;
            for (int j = -1; j <= 3; ++j) { const int c = 4 * tid + j; if (c >= 0 && c < ncv) sg += lg[gg][c] * ((j == -1 || j == 3) ? 0.5f : 1.0f); }
            s += sg * inv[gg];
        }
        if (ncv == 0) s = 0.f;
        const int qblk = t >> 6, db = qblk - tid;
        vals[tid] = (db >= 0 && db < 2) ? 2.0e4f : (tid == 0 ? 1.0e4f : (db >= 0 ? s : -1.0f));
    }
    __syncthreads();
    if (tid < 64) {
        const float v = vals[tid]; int rank = 0;
        for (int s2 = 0; s2 < 64; ++s2) { const float w = vals[s2]; rank += (w > v || (w == v && s2 < tid)) ? 1 : 0; }
        if (rank < 16 && (t >> 6) - tid >= 0) { const int slot = atomicAdd(&nsel_s, 1); selblk[slot] = tid; }
    }
    __syncthreads();
    const int nsel = nsel_s, nks = nsel * 64;
    for (int idx = tid; idx < nks; idx += 256) { const int kpos = selblk[idx >> 6] * 64 + (idx & 63); kp[idx] = kpos; dist[idx] = t - kpos; }
    __syncthreads();
    nsa_logits<false>(nks, a.ks + (size_t)bh * T_ * HD, kp, dist, lg, qs, a.rel, kvh);
    __syncthreads();
    nsa_softmax(nks, lg, inv, red);
    const float o_s = nsa_pv<false>(nks, a.vs + (size_t)bh * T_ * HD, kp, lg, inv);
    __syncthreads();
    const int lo = t - 511 > 0 ? t - 511 : 0, nkw = t - lo + 1;
    for (int idx = tid; idx < nkw; idx += 256) { kp[idx] = lo + idx; dist[idx] = t - (lo + idx); }
    __syncthreads();
    nsa_logits<false>(nkw, a.kw + (size_t)bh * T_ * HD, kp, dist, lg, qs, a.rel, kvh);
    __syncthreads();
    nsa_softmax(nkw, lg, inv, red);
    const float o_w = nsa_pv<false>(nkw, a.vw + (size_t)bh * T_ * HD, kp, lg, inv);
    const float* gt = a.gates + tok * 24 + h * 3;
    a.raw[tok * DM + h * 64 + d] = sigmoidf_(gt[0]) * o_c + sigmoidf_(gt[1]) * o_s + sigmoidf_(gt[2]) * o_w;
}

struct LruArgs { const float* xr; const bf16_t* xg; const float* conv_w; const float* conv_b; const float* wa; const float* ba; const float* wx; const float* bx; const float* lam; float* raw; };
__global__ __launch_bounds__(64) void k_lru_naive(LruArgs a) {
    __shared__ float xs[64];
    const int tid = threadIdx.x, n = blockIdx.x & 7, b = blockIdx.x >> 3, ch = n * 64 + tid;
    float war[64], wxr[64];
#pragma unroll
    for (int c = 0; c < 64; ++c) { war[c] = a.wa[(size_t)(n * 64 + c) * 64 + tid]; wxr[c] = a.wx[(size_t)(n * 64 + c) * 64 + tid]; }
    const float cw0 = a.conv_w[0 * 512 + ch], cw1 = a.conv_w[1 * 512 + ch], cw2 = a.conv_w[2 * 512 + ch], cw3 = a.conv_w[3 * 512 + ch], cb = a.conv_b[ch];
    const float ba = a.ba[ch], bx = a.bx[ch], sp = log1pf(__expf(-a.lam[ch]));
    float x3 = 0.f, x2 = 0.f, x1 = 0.f, h = 0.f;
    for (int t = 0; t < T_; ++t) {
        const size_t tok = (size_t)b * T_ + t;
        const float x0 = a.xr[tok * 512 + ch];
        const float xc = cw0 * x3 + cw1 * x2 + cw2 * x1 + cw3 * x0 + cb;
        x3 = x2; x2 = x1; x1 = x0;
        __syncthreads();
        xs[tid] = xc;
        __syncthreads();
        float rp = 0.f, ip = 0.f;
#pragma unroll
        for (int c = 0; c < 64; ++c) { const float xv = xs[c]; rp += xv * war[c]; ip += xv * wxr[c]; }
        const float r = sigmoidf_(rp + ba), i = sigmoidf_(ip + bx);
        const float log_a = -8.0f * r * sp, aa = __expf(log_a), bb = sqrtf(-expm1f(2.0f * log_a)) * (i * xc);
        h = aa * h + bb;
        a.raw[tok * DM + 512 + ch] = h * gelu_tanh(bf2f(a.xg[tok * 512 + ch]));
    }
}
__global__ __launch_bounds__(256) void k_grpnorm(const float* __restrict__ raw, const float* __restrict__ ga, const float* __restrict__ gl, bf16_t* __restrict__ mixed) {
    __shared__ float red[8];
    const int row = blockIdx.x, t = threadIdx.x;
    const f32x4 v = *(const f32x4*)(raw + (size_t)row * DM + t * 4);
    const float s = v[0] * v[0] + v[1] * v[1] + v[2] * v[2] + v[3] * v[3];
    const float sa = block_sum256(t < 128 ? s : 0.f, red);
    const float sl = block_sum256(t < 128 ? 0.f : s, red);
    const float rs = rsqrtf((t < 128 ? sa : sl) * (1.0f / 512) + EPS);
    const f32x4 g = t < 128 ? *(const f32x4*)(ga + t * 4) : *(const f32x4*)(gl + (t - 128) * 4);
    u32x2 w; w.x = pack2bf(v[0] * rs * g[0], v[1] * rs * g[1]); w.y = pack2bf(v[2] * rs * g[2], v[3] * rs * g[3]);
    *(u32x2*)(mixed + (size_t)row * DM + t * 4) = w;
}
__global__ __launch_bounds__(256) void k_rowssq(const float* __restrict__ h, float* __restrict__ ssq) {
    __shared__ float red[8];
    const int row = blockIdx.x, t = threadIdx.x;
    const f32x4 v = *(const f32x4*)(h + (size_t)row * DM + t * 4);
    float s = v[0] * v[0] + v[1] * v[1] + v[2] * v[2] + v[3] * v[3];
    s = block_sum256(s, red);
    if (t < 16) ssq[(size_t)t * NTOK + row] = t == 0 ? s : 0.f;
}

DI float rs_from_ssq(const float* ssq, int row) { float s = 0.f; for (int j = 0; j < 16; ++j) s += ssq[(size_t)j * NTOK + row]; return rsqrtf(s * (1.0f / DM) + EPS); }
__global__ __launch_bounds__(256) void k_peer_route(const float* __restrict__ scores, const float* __restrict__ ssq1, int hh, int* __restrict__ eout, float* __restrict__ gout) {
    __shared__ float s[256]; __shared__ float tv[2][16]; __shared__ int ti[2][16]; __shared__ float cand[256]; __shared__ float scs[16]; __shared__ int es[16];
    const int tid = threadIdx.x, tok = blockIdx.x >> 2, hl = blockIdx.x & 3, h = hh * 4 + hl;
    const float rs1 = rs_from_ssq(ssq1, tok);
    s[tid] = scores[(size_t)tok * 1024 + hl * 256 + tid] * rs1;
    __syncthreads();
    { const int p = tid >> 7, k = tid & 127; const float v = s[tid]; int rank = 0;
      for (int j = 0; j < 128; ++j) { const float w = s[p * 128 + j]; rank += (w > v || (w == v && j < k)) ? 1 : 0; }
      if (rank < 16) { tv[p][rank] = v; ti[p][rank] = k; } }
    __syncthreads();
    cand[tid] = tv[0][tid >> 4] + tv[1][tid & 15];
    __syncthreads();
    { const float v = cand[tid]; int rank = 0;
      for (int j = 0; j < 256; ++j) { const float w = cand[j]; rank += (w > v || (w == v && j < tid)) ? 1 : 0; }
      if (rank < 16) { scs[rank] = v; es[rank] = ti[0][tid >> 4] * 128 + ti[1][tid & 15]; } }
    __syncthreads();
    if (tid < 16) {
        float m = -INFINITY; for (int j = 0; j < 16; ++j) m = fmaxf(m, scs[j]);
        float sum = 0.f; for (int j = 0; j < 16; ++j) sum += __expf(scs[j] - m);
        eout[(size_t)tok * 128 + h * 16 + tid] = es[tid];
        gout[(size_t)tok * 128 + h * 16 + tid] = __expf(scs[tid] - m) / sum;
    }
}
__global__ __launch_bounds__(256) void k_peer_apply(const bf16_t* __restrict__ ub, const bf16_t* __restrict__ vb, const int* __restrict__ e, const float* __restrict__ gsm,
                                                    const float* __restrict__ ssq1, float* __restrict__ h, bf16_t* __restrict__ hb, float* __restrict__ rs2) {
    __shared__ float xrow[DM]; __shared__ float coef[128]; __shared__ int eid[128]; __shared__ float red[8];
    const int tid = threadIdx.x, tok = blockIdx.x, lane = tid & 63, w = tid >> 6;
    const float rs1 = rs_from_ssq(ssq1, tok);
    for (int i = tid; i < DM; i += 256) xrow[i] = bf2f(hb[(size_t)tok * DM + i]);
    if (tid < 128) eid[tid] = e[(size_t)tok * 128 + tid];
    __syncthreads();
    for (int j = w; j < 128; j += 4) {
        const bf16_t* ur = ub + (size_t)eid[j] * DM;
        float acc = 0.f;
        for (int i = lane; i < DM; i += 64) acc += xrow[i] * bf2f(ur[i]);
        acc = wave_sum(acc);
        if (lane == 0) coef[j] = gsm[(size_t)tok * 128 + j] * gelu_tanh(acc * rs1);
    }
    __syncthreads();
    f32x4 acc = {0.f, 0.f, 0.f, 0.f};
    for (int j = 0; j < 128; ++j) {
        const u32x2 v = *(const u32x2*)(vb + (size_t)eid[j] * DM + tid * 4); const float c = coef[j];
        acc[0] += c * __uint_as_float(v.x << 16); acc[1] += c * __uint_as_float(v.x & 0xffff0000u); acc[2] += c * __uint_as_float(v.y << 16); acc[3] += c * __uint_as_float(v.y & 0xffff0000u);
    }
    f32x4 hv = *(f32x4*)(h + (size_t)tok * DM + tid * 4);
    hv += acc;
    *(f32x4*)(h + (size_t)tok * DM + tid * 4) = hv;
    u32x2 wv; wv.x = pack2bf(hv[0], hv[1]); wv.y = pack2bf(hv[2], hv[3]);
    *(u32x2*)(hb + (size_t)tok * DM + tid * 4) = wv;
    float s = hv[0] * hv[0] + hv[1] * hv[1] + hv[2] * hv[2] + hv[3] * hv[3];
    s = block_sum256(s, red);
    if (tid == 0) rs2[tok] = rsqrtf(s * (1.0f / DM) + EPS);
}
__global__ __launch_bounds__(256) void k_final_norm(float* __restrict__ h, const float* __restrict__ ssq3, const float* __restrict__ g) {
    const int row = blockIdx.x, t = threadIdx.x;
    const float rs = rs_from_ssq(ssq3, row);
    f32x4 v = *(f32x4*)(h + (size_t)row * DM + t * 4); const f32x4 gg = *(const f32x4*)(g + t * 4);
    v = v * rs * gg;
    *(f32x4*)(h + (size_t)row * DM + t * 4) = v;
}

__global__ void k_p2_extras(const bf16_t* __restrict__ vs, const bf16_t* __restrict__ vw, const float* __restrict__ kcmp, const float* __restrict__ vcmp,
                            bf16_t* __restrict__ vsT, bf16_t* __restrict__ vwT, bf16_t* __restrict__ kcb, bf16_t* __restrict__ vcT) {
    const size_t n = (size_t)NB * NKV * T_ * HD;
    for (size_t i = (size_t)blockIdx.x * blockDim.x + threadIdx.x; i < n; i += (size_t)gridDim.x * blockDim.x) {
        const size_t bh = i / ((size_t)T_ * HD); const int t = (int)((i / HD) % T_), d = (int)(i % HD);
        vsT[(bh * HD + d) * T_ + t] = vs[i]; vwT[(bh * HD + d) * T_ + t] = vw[i];
    }
    for (size_t i = (size_t)blockIdx.x * blockDim.x + threadIdx.x; i < (size_t)8 * 256 * 64; i += (size_t)gridDim.x * blockDim.x) {
        const int bh = (int)(i / (256 * 64)), c = (int)((i / 64) % 256), d = (int)(i % 64);
        const bool ok = c < NCMP;
        kcb[i] = ok ? f2bf(kcmp[i]) : (bf16_t)0;
        vcT[((size_t)bh * 64 + d) * 256 + c] = ok ? f2bf(vcmp[i]) : (bf16_t)0;
    }
}
__global__ __launch_bounds__(256) void k_grpnorm_lru(const float* __restrict__ raw, const float* __restrict__ gl, bf16_t* __restrict__ mixed) {
    __shared__ float red[8];
    const int row = blockIdx.x, t = threadIdx.x;
    const f32x2 v = *(const f32x2*)(raw + (size_t)row * DM + 512 + t * 2);
    const float s = block_sum256(v[0] * v[0] + v[1] * v[1], red);
    const float rs = rsqrtf(s * (1.0f / 512) + EPS);
    *(unsigned*)(mixed + (size_t)row * DM + 512 + t * 2) = pack2bf(v[0] * rs * gl[t * 2], v[1] * rs * gl[t * 2 + 1]);
}
#define XB_TMO      128
#define XB_XCNT(j)  (256  + 64 * (j))
#define XB_XSUB(j)  (1280 + 64 * (j))
#define XB_XGEN(j)  (2304 + 64 * (j))
#define XB_TOP      3328
#define XB_TOPGEN   3392
#define XCD_BAR_WORDS 3456
#define XB_SPIN_CAP (1u << 18)
#define LAS __attribute__((address_space(3)))

__device__ __forceinline__ unsigned xb_ld(unsigned* p)              { return __hip_atomic_load(p, __ATOMIC_RELAXED, __HIP_MEMORY_SCOPE_AGENT); }
__device__ __forceinline__ unsigned xb_add(unsigned* p, unsigned v) { return __hip_atomic_fetch_add(p, v, __ATOMIC_RELAXED, __HIP_MEMORY_SCOPE_AGENT); }
__device__ __forceinline__ unsigned xb_xcc_id() { return (unsigned)__builtin_amdgcn_s_getreg((3 << 11) | 20) & 0xFu; }
#define XB_SPIN(cond, bar) do { unsigned _sp = 0; while (cond) { __builtin_amdgcn_s_sleep(1); \
    if ((++_sp & 255u) == 0u) { if (xb_ld(&(bar)[XB_TMO])) break; if (_sp > XB_SPIN_CAP) { atomicAdd(&(bar)[XB_TMO], 1u); break; } } } } while (0)

struct XcdBarrier {
    unsigned* bar; unsigned x;
    volatile LAS unsigned* st;
};

__device__ __forceinline__ XcdBarrier xcd_barrier_post(unsigned* bar, volatile LAS unsigned* st) {
    XcdBarrier b; b.bar = bar; b.x = xb_xcc_id(); b.st = st;
    if (threadIdx.x == 0) (void)xb_add(&bar[XB_XCNT(b.x)], 1u);
    return b;
}
__device__ __forceinline__ void xcd_barrier_complete(unsigned* bar, unsigned x, unsigned& nloc, unsigned& nx) {
    const unsigned G = gridDim.x * gridDim.y * gridDim.z;
    unsigned sum, cnt, mine, sp = 0u;
    for (;;) {
        sum = 0u; cnt = 0u; mine = 0u;
#pragma unroll
        for (unsigned j = 0; j < 16; ++j) { const unsigned c = xb_ld(&bar[XB_XCNT(j)]); sum += c; cnt += (c > 0u) ? 1u : 0u; mine = (j == x) ? c : mine; }
        if (sum == G) break;
        __builtin_amdgcn_s_sleep(1);
        if ((++sp & 255u) == 0u) { if (xb_ld(&bar[XB_TMO])) break; if (sp > XB_SPIN_CAP) { atomicAdd(&bar[XB_TMO], 1u); break; } }
    }
    nloc = mine > 0u ? mine : 1u; nx = cnt > 0u ? cnt : 1u;
}

__device__ __forceinline__ void xcd_barrier(const XcdBarrier& b) {
    asm volatile("s_waitcnt vmcnt(0)" ::: "memory");
    __syncthreads();
    if (threadIdx.x == 0) {
        unsigned* bar = b.bar;
        __builtin_amdgcn_s_waitcnt(0);
        unsigned nloc = b.st[0], nx = b.st[1];
        if (nloc == 0u) { xcd_barrier_complete(bar, b.x, nloc, nx); b.st[0] = nloc; b.st[1] = nx; }
        const unsigned old = xb_add(&bar[XB_XSUB(b.x)], 1u);
        const unsigned gen = old / nloc;
        if (old + 1u == (gen + 1u) * nloc) {
            __builtin_amdgcn_fence(__ATOMIC_RELEASE, "agent");
            asm volatile("s_waitcnt vmcnt(0)" ::: "memory");
            const unsigned og = xb_add(&bar[XB_TOP], 1u);
            const unsigned tg = og / nx;
            if (og + 1u == (tg + 1u) * nx) xb_add(&bar[XB_TOPGEN], 1u);
            else XB_SPIN(xb_ld(&bar[XB_TOPGEN]) == tg, bar);
            __builtin_amdgcn_fence(__ATOMIC_ACQUIRE, "agent");
            xb_add(&bar[XB_XGEN(b.x)], 1u);
            asm volatile("s_waitcnt vmcnt(0)" ::: "memory");
        } else {
            XB_SPIN(xb_ld(&bar[XB_XGEN(b.x)]) == gen, bar);
            __builtin_amdgcn_fence(__ATOMIC_ACQUIRE, "agent");
            asm volatile("s_waitcnt vmcnt(0)" ::: "memory");
        }
    }
    __syncthreads();
}


namespace pg8 {
#define PG8_LAS __attribute__((address_space(3)))
typedef short bf16x8 __attribute__((ext_vector_type(8)));
constexpr int BM = 256, BK = 64, HALF = 128, HTB = HALF * BK * 2  , STAGE_BYTES = 8 * HTB, NXCD = 8, WGM = 8;

__host__ __device__ __forceinline__ int lds_byte(int r, int c) { const int st = (r >> 4) * 2 + (c >> 5), rr = r & 15, cc = c & 31, ob = rr * 64 + cc * 2; return st * 1024 + (ob ^ (((ob >> 9) & 1) << 5)); }
__host__ __device__ __forceinline__ void stage_rc(int b, int& R, int& C) { const int st = b / 1024, sb = b % 1024, swz = sb ^ (((sb >> 9) & 1) << 5); R = (st >> 1) * 16 + swz / 64; C = (st & 1) * 32 + (swz % 64) / 2; }
__host__ __device__ __forceinline__ int perm32(int rho) { const int n = rho >> 4, i = rho & 15; return 8 * (i >> 2) + 4 * n + (i & 3); }

struct Unit { int pm, pn; };
struct Gemm { const bf16_t* A; const bf16_t* Bt; int M, N, K; };

struct StaticOrder {
    int nM, nN, nwg, G, c;
    __host__ __device__ void init(int M, int N, int G_, int c_) { nM = M / BM; nN = N / BM; nwg = nM * nN; G = G_; c = c_; }
    __host__ __device__ bool next(int i, Unit& u) const {
        const long L = (long)i * G + c; if (L >= nwg) return false;
        int wgid = (int)L; { const int q = nwg / NXCD, r = nwg % NXCD, xcd = wgid % NXCD, off = wgid / NXCD; wgid = (xcd < r ? xcd * (q + 1) : r * (q + 1) + (xcd - r) * q) + off; }
        const int nig = WGM * nN, gid = wgid / nig, fm = gid * WGM, gsz = (nM - fm) < WGM ? (nM - fm) : WGM;
        u.pm = fm + ((wgid % nig) % gsz); u.pn = (wgid % nig) / gsz; return true;
    }
    __device__ __forceinline__ void a_ready(const Unit&) const {}
    __device__ __forceinline__ void done(const Unit&) const {}
};
template <class Epi, class Sched, bool STAMP = false>
__device__ __forceinline__ void gemm_phase(PG8_LAS unsigned char* lds, const Gemm g, const Sched& S, const Epi& E, unsigned long long* stamps) {
    const int tid = threadIdx.x, wid = __builtin_amdgcn_readfirstlane(tid >> 6), lane = tid & 63, wr = wid >> 2, wc = wid & 3, fr = lane & 15, fq = lane >> 4;
    const int K = g.K, nt = K / BK;
    int ts_lo = 0, ts_hi = 0, nts = 0; const unsigned long long rt_entry = STAMP ? (unsigned long long)wall_clock64() : 0ull;
#define PG8_STAMP() do { if (STAMP && wid == 0 && nts < 64) { const unsigned long long _c = (unsigned long long)clock64(); \
        ts_lo = (lane == nts) ? (int)(unsigned)_c : ts_lo; ts_hi = (lane == nts) ? (int)(unsigned)(_c >> 32) : ts_hi; ++nts; } } while (0)
    PG8_STAMP();
    unsigned voffA[2], voffB[2];
#pragma unroll
    for (int i = 0; i < 2; ++i) { int R, C; stage_rc(tid * 16 + i * 8192, R, C); const int Rb = Epi::PERM ? ((R & ~31) + perm32(R & 31)) : R;
        voffA[i] = (unsigned)(R * K + C) * 2u; voffB[i] = (unsigned)(Rb * K + C) * 2u; }
    const size_t kstep = (size_t)(BK * 2);
    const size_t hstep = (size_t)HALF * K * 2;
    const size_t tstep = 2 * hstep;
    const unsigned ldsw = (unsigned)wid * 1024u;
    const int aoff = lds_byte(wr * 64 + fr, fq * 8), boff = lds_byte(wc * 32 + fr, fq * 8);
#define PG8_SA(b, h) (((b) * 2 + (h)) * HTB)
#define PG8_SB(b, h) ((4 + (b) * 2 + (h)) * HTB)
#define PG8_STAGE(bufoff, gbase, voff) do { _Pragma("unroll") for (int _i = 0; _i < 2; ++_i) \
        __builtin_amdgcn_global_load_lds((const unsigned*)((const char*)(gbase) + (voff)[_i]), (PG8_LAS unsigned*)(lds + (bufoff) + ldsw + _i * 8192), 16, 0, 0); } while (0)
#define PG8_LDA(dst, b, h) do { _Pragma("unroll") for (int m = 0; m < 4; ++m) _Pragma("unroll") for (int k = 0; k < 2; ++k) dst[m][k] = *(const PG8_LAS bf16x8*)(lds + PG8_SA(b, h) + aoff + m * 2048 + k * 1024); } while (0)
#define PG8_LDB(dst, b, h) do { _Pragma("unroll") for (int n = 0; n < 2; ++n) _Pragma("unroll") for (int k = 0; k < 2; ++k) dst[n][k] = *(const PG8_LAS bf16x8*)(lds + PG8_SB(b, h) + boff + n * 2048 + k * 1024); } while (0)
#define PG8_MMA(ai, bj, At, Bt) do { __builtin_amdgcn_s_setprio(1); _Pragma("unroll") for (int m = 0; m < 4; ++m) _Pragma("unroll") for (int n = 0; n < 2; ++n) _Pragma("unroll") for (int k = 0; k < 2; ++k) \
        acc[ai][bj][m][n] = __builtin_amdgcn_mfma_f32_16x16x32_bf16(Bt[n][k], At[m][k], acc[ai][bj][m][n], 0, 0, 0); __builtin_amdgcn_s_setprio(0); } while (0)
#define PG8_WAIT_V(n) asm volatile("s_waitcnt vmcnt(" #n ")" ::: "memory")
#define PG8_WAIT_L(n) asm volatile("s_waitcnt lgkmcnt(" #n ")" ::: "memory")
#define PG8_BAR __builtin_amdgcn_s_barrier()
#define PG8_SCHED __builtin_amdgcn_sched_barrier(0)
    Unit cur, nxt; int ui = 0;
    if (!S.next(0, cur)) return;
    f32x4 acc[2][2][4][2];
#pragma unroll
    for (int a = 0; a < 2; ++a)
#pragma unroll
        for (int b = 0; b < 2; ++b)
#pragma unroll
            for (int m = 0; m < 4; ++m)
#pragma unroll
                for (int n = 0; n < 2; ++n) acc[a][b][m][n] = (f32x4){0.f, 0.f, 0.f, 0.f};
    bf16x8 At[4][2], B0[2][2], B1[2][2];
    const char* cA = (const char*)g.A + (size_t)cur.pm * tstep; const char* cB = (const char*)g.Bt + (size_t)cur.pn * tstep;
    S.a_ready(cur);
    PG8_STAGE(PG8_SB(0, 0), cB, voffB); PG8_STAGE(PG8_SA(0, 0), cA, voffA); PG8_STAGE(PG8_SB(0, 1), cB + hstep, voffB); PG8_STAGE(PG8_SA(0, 1), cA + hstep, voffA);
    if (wr == 1) PG8_BAR;
    PG8_WAIT_V(4); PG8_BAR;
    PG8_STAGE(PG8_SB(1, 0), cB + kstep, voffB); PG8_STAGE(PG8_SA(1, 0), cA + kstep, voffA); PG8_STAGE(PG8_SB(1, 1), cB + hstep + kstep, voffB);
    PG8_WAIT_V(6); PG8_BAR;
    PG8_STAMP();
    for (;;) {
        const bool has_next = S.next(ui + 1, nxt);
        const char* nA = has_next ? (const char*)g.A + (size_t)nxt.pm * tstep : cA; const char* nB = has_next ? (const char*)g.Bt + (size_t)nxt.pn * tstep : cB;
        for (int t = 0; t < nt; t += 2) {
            const bool last = (t == nt - 2);
            const char* a1 = cA + (size_t)(t + 1) * kstep;
            const char* a2 = last ? nA : cA + (size_t)(t + 2) * kstep; const char* b2 = last ? nB : cB + (size_t)(t + 2) * kstep;
            const char* a3 = a2 + kstep; const char* b3 = b2 + kstep;
            if (last && has_next) S.a_ready(nxt);
            PG8_LDB(B0, 0, 0); PG8_SCHED; PG8_LDA(At, 0, 0); PG8_STAGE(PG8_SA(1, 1), a1 + hstep, voffA);
            PG8_WAIT_L(8); PG8_BAR; PG8_WAIT_L(0); PG8_MMA(0, 0, At, B0); PG8_BAR; PG8_SCHED;
            PG8_LDB(B1, 0, 1); PG8_STAGE(PG8_SB(0, 0), b2, voffB);
            PG8_BAR; PG8_WAIT_L(0); PG8_MMA(0, 1, At, B1); PG8_BAR;
            PG8_LDA(At, 0, 1); PG8_STAGE(PG8_SA(0, 0), a2, voffA);
            PG8_BAR; PG8_WAIT_L(0); PG8_MMA(1, 0, At, B0); PG8_BAR; PG8_SCHED;
            PG8_STAGE(PG8_SB(0, 1), b2 + hstep, voffB);
            PG8_WAIT_V(6); PG8_BAR; PG8_MMA(1, 1, At, B1); PG8_BAR;
            PG8_LDB(B0, 1, 0); PG8_SCHED; PG8_LDA(At, 1, 0); PG8_STAGE(PG8_SA(0, 1), a2 + hstep, voffA);
            PG8_WAIT_L(8); PG8_BAR; PG8_WAIT_L(0); PG8_MMA(0, 0, At, B0); PG8_BAR; PG8_SCHED;
            PG8_LDB(B1, 1, 1); PG8_STAGE(PG8_SB(1, 0), b3, voffB);
            PG8_BAR; PG8_WAIT_L(0); PG8_MMA(0, 1, At, B1); PG8_BAR;
            PG8_LDA(At, 1, 1); PG8_STAGE(PG8_SA(1, 0), a3, voffA);
            PG8_BAR; PG8_WAIT_L(0); PG8_MMA(1, 0, At, B0); PG8_BAR; PG8_SCHED;
            PG8_STAGE(PG8_SB(1, 1), b3 + hstep, voffB);
            PG8_WAIT_V(6); PG8_BAR; PG8_MMA(1, 1, At, B1); PG8_BAR;
        }
        PG8_STAMP();
        if constexpr (!Epi::AFTER_DRAIN) { E(acc, cur, wr, wc, fr, fq); S.done(cur); }
        PG8_STAMP();
        if (!has_next) break;
#pragma unroll
        for (int a = 0; a < 2; ++a)
#pragma unroll
            for (int b = 0; b < 2; ++b)
#pragma unroll
                for (int m = 0; m < 4; ++m)
#pragma unroll
                    for (int n = 0; n < 2; ++n) acc[a][b][m][n] = (f32x4){0.f, 0.f, 0.f, 0.f};
        cur = nxt; cA = nA; cB = nB; ++ui;
    }
    PG8_WAIT_V(0);
    if (wr == 0) PG8_BAR;
    PG8_BAR;
    if constexpr (Epi::AFTER_DRAIN) { E.fused(acc, cur, wr, wc, fr, fq, lds, wid, lane); S.done(cur); }
    PG8_STAMP();
    if (STAMP && wid == 0) { stamps[lane] = lane < nts ? (((unsigned long long)(unsigned)ts_hi << 32) | (unsigned)ts_lo) : 0ull;
        if (lane == 62) stamps[62] = rt_entry; if (lane == 63) stamps[63] = (unsigned long long)wall_clock64(); }
#undef PG8_STAMP
#undef PG8_SA
#undef PG8_SB
#undef PG8_STAGE
#undef PG8_LDA
#undef PG8_LDB
#undef PG8_MMA
#undef PG8_WAIT_V
#undef PG8_WAIT_L
#undef PG8_BAR
#undef PG8_SCHED
}
}
#define LAS3 __attribute__((address_space(3)))
constexpr int MK_THREADS = 512;
typedef __bf16 bf16x2_t __attribute__((ext_vector_type(2)));
DI float dot2bf(unsigned a, unsigned b, float c) { return __builtin_amdgcn_fdot2_f32_bf16(__builtin_bit_cast(bf16x2_t, a), __builtin_bit_cast(bf16x2_t, b), c, false); }
DI float bflo(unsigned v) { return __uint_as_float(v << 16); }
DI float bfhi(unsigned v) { return __uint_as_float(v & 0xffff0000u); }

template <class ColMap>
DI void transpose_tile(const float* __restrict__ src, int ldsrc, const float* __restrict__ gain, bf16_t* __restrict__ dst, int K, int k0, int n0, const ColMap& cm, LAS3 float* tl) {
    const int tid = threadIdx.x;
    __syncthreads();
    {
        const int n = tid & 63, sc = cm(n0 + n);
#pragma unroll
        for (int j = 0; j < 8; ++j) { const int k = (tid >> 6) + 8 * j; tl[k * 65 + n] = sc >= 0 ? src[(size_t)(k0 + k) * ldsrc + sc] * (gain ? gain[k0 + k] : 1.0f) : 0.f; }
    }
    __syncthreads();
    {
        const int n = tid >> 3, k8 = (tid & 7) * 8;
        u32x4 w;
        w.x = pack2bf(tl[(k8 + 0) * 65 + n], tl[(k8 + 1) * 65 + n]); w.y = pack2bf(tl[(k8 + 2) * 65 + n], tl[(k8 + 3) * 65 + n]);
        w.z = pack2bf(tl[(k8 + 4) * 65 + n], tl[(k8 + 5) * 65 + n]); w.w = pack2bf(tl[(k8 + 6) * 65 + n], tl[(k8 + 7) * 65 + n]);
        *(u32x4*)(dst + (size_t)(n0 + n) * K + k0 + k8) = w;
    }
}
struct ColId { DI int operator()(int n) const { return n; } };
struct ColWin { DI int operator()(int n) const { return n < PC_XR ? n : (n < PC_XG ? 1304 + (n - PC_XR) : (n < PC_GATE ? 1816 + (n - PC_XG) : (n < PC_GATE + 24 ? 1280 + (n - PC_GATE) : -1))); } };

DI void cvt_rows_bf16(const float* __restrict__ src, const float* __restrict__ gain, bf16_t* __restrict__ dst, size_t n8, int cols, size_t gtid, size_t nthr) {
    for (size_t i = gtid; i < n8; i += nthr) {
        f32x4 a = *(const f32x4*)(src + i * 8), b = *(const f32x4*)(src + i * 8 + 4);
        if (gain) { const int c = (int)((i * 8) % cols); a *= *(const f32x4*)(gain + c); b *= *(const f32x4*)(gain + c + 4); }
        u32x4 w; w.x = pack2bf(a[0], a[1]); w.y = pack2bf(a[2], a[3]); w.z = pack2bf(b[0], b[1]); w.w = pack2bf(b[2], b[3]);
        *(u32x4*)(dst + i * 8) = w;
    }
}

DI void p0_prologue(const Params& p, LAS3 unsigned char* lds, int G) {
    unsigned char* ws = p.ws;
    const int tid = threadIdx.x, lane = tid & 63, wid = tid >> 6, bid = blockIdx.x;
    const size_t gtid = (size_t)bid * MK_THREADS + tid, nthr = (size_t)G * MK_THREADS;
    const int gw = bid * 8 + wid, nw = G * 8;
    {
        const float* x = p.in[I_X]; bf16_t* xb = (bf16_t*)(ws + WS_XB); float* rs0 = (float*)(ws + WS_RS0);
        for (int row = gw; row < NTOK; row += nw) {
            f32x4 v[4]; float s = 0.f;
#pragma unroll
            for (int j = 0; j < 4; ++j) { v[j] = *(const f32x4*)(x + (size_t)row * DM + j * 256 + lane * 4); s += (v[j][0] * v[j][0] + v[j][1] * v[j][1]) + (v[j][2] * v[j][2] + v[j][3] * v[j][3]); }
            s = wave_sum(s);
#pragma unroll
            for (int j = 0; j < 4; ++j) { u32x2 w; w.x = pack2bf(v[j][0], v[j][1]); w.y = pack2bf(v[j][2], v[j][3]); *(u32x2*)(xb + (size_t)row * DM + j * 256 + lane * 4) = w; }
            if (lane == 0) rs0[row] = rsqrtf(s * (1.0f / DM) + EPS);
        }
    }
    cvt_rows_bf16(p.in[I_PEER_U], p.in[I_FFN_NORM], (bf16_t*)(ws + WS_UB), (size_t)16384 * DM / 8, DM, gtid, nthr);
    cvt_rows_bf16(p.in[I_PEER_V], nullptr, (bf16_t*)(ws + WS_VB), (size_t)16384 * DM / 8, DM, gtid, nthr);
    cvt_rows_bf16(p.in[I_P], nullptr, (bf16_t*)(ws + WS_PB), (size_t)NTOK * PLE / 8, PLE, gtid, nthr);
    LAS3 float* tl = (LAS3 float*)lds;
    {
        for (int u = bid; u < 1496; u += G) {
            if (u < 640) transpose_tile(p.in[I_W_IN], INCOLS, p.in[I_ATTN_NORM], (bf16_t*)(ws + WS_WIN), DM, (u % 16) * 64, (u / 16) * 64, ColWin{}, tl);
            else if (u < 896) { const int v = u - 640; transpose_tile(p.in[I_W_OUT], DM, nullptr, (bf16_t*)(ws + WS_WOUT), DM, (v % 16) * 64, (v / 16) * 64, ColId{}, tl); }
            else if (u < 1152) { const int v = u - 896; transpose_tile(p.in[I_PLE_WG], DM, p.in[I_PLE_NORM], (bf16_t*)(ws + WS_WG), DM, (v % 16) * 64, (v / 16) * 64, ColId{}, tl); }
            else if (u < 1216) { const int v = u - 1152; transpose_tile(p.in[I_PLE_PROJ], DM, nullptr, (bf16_t*)(ws + WS_WP), PLE, (v % 4) * 64, (v / 4) * 64, ColId{}, tl); }
            else if (u < 1344) { const int v = u - 1216; transpose_tile(p.in[I_CK_W1], 256, nullptr, (bf16_t*)(ws + WS_CW1K), 2048, (v % 32) * 64, (v / 32) * 64, ColId{}, tl); }
            else if (u < 1472) { const int v = u - 1344; transpose_tile(p.in[I_CV_W1], 256, nullptr, (bf16_t*)(ws + WS_CW1V), 2048, (v % 32) * 64, (v / 32) * 64, ColId{}, tl); }
            else if (u < 1480) { const int v = u - 1472; transpose_tile(p.in[I_LRU_WA] + v * 4096, 64, nullptr, (bf16_t*)(ws + WS_WAT) + v * 4096, 64, 0, 0, ColId{}, tl); }
            else if (u < 1488) { const int v = u - 1480; transpose_tile(p.in[I_LRU_WX] + v * 4096, 64, nullptr, (bf16_t*)(ws + WS_WXT) + v * 4096, 64, 0, 0, ColId{}, tl); }
            else if (u < 1492) { const int v = u - 1488; transpose_tile(p.in[I_CK_W2], 64, nullptr, (bf16_t*)(ws + WS_CW2K), 256, v * 64, 0, ColId{}, tl); }
            else { const int v = u - 1492; transpose_tile(p.in[I_CV_W2], 64, nullptr, (bf16_t*)(ws + WS_CW2V), 256, v * 64, 0, ColId{}, tl); }
        }
        __syncthreads();
    }
    {
        LAS3 float* wt = (LAS3 float*)lds;
        LAS3 float* st = (LAS3 float*)(lds + 32768);
        const float* wq = p.in[I_PEER_WQ]; const float* sub = p.in[I_PEER_SUB]; const float* gain = p.in[I_FFN_NORM]; bf16_t* WqsT = (bf16_t*)(ws + WS_WQS);
        for (int u = bid; u < 256; u += G) {
            const int hp = u >> 4, d0 = (u & 15) * 64, pp = hp & 1;
            __syncthreads();
            for (int i = tid; i < 64 * 128; i += MK_THREADS) { const int d = i >> 7, dk = i & 127; wt[dk * 64 + d] = wq[(size_t)(d0 + d) * 2048 + hp * 128 + dk]; }
            for (int i = tid; i < 128 * 128; i += MK_THREADS) { const int kk = i >> 7, dk = i & 127; st[kk * 129 + dk] = sub[((size_t)pp * 128 + kk) * 128 + dk]; }
            __syncthreads();
            const int kk = tid & 127, dg = (tid >> 7) * 16;
            float acc[16];
#pragma unroll
            for (int j = 0; j < 16; ++j) acc[j] = 0.f;
            for (int dk = 0; dk < 128; ++dk) {
                const float sv = st[kk * 129 + dk];
#pragma unroll
                for (int j4 = 0; j4 < 4; ++j4) { const f32x4 w4 = *(LAS3 f32x4*)(wt + dk * 64 + dg + j4 * 4);
#pragma unroll
                    for (int j = 0; j < 4; ++j) acc[j4 * 4 + j] += sv * w4[j]; }
            }
            u32x4 o0, o1;
#define GQ(j) (acc[j] * gain[d0 + dg + (j)])
            o0.x = pack2bf(GQ(0), GQ(1)); o0.y = pack2bf(GQ(2), GQ(3)); o0.z = pack2bf(GQ(4), GQ(5)); o0.w = pack2bf(GQ(6), GQ(7));
            o1.x = pack2bf(GQ(8), GQ(9)); o1.y = pack2bf(GQ(10), GQ(11)); o1.z = pack2bf(GQ(12), GQ(13)); o1.w = pack2bf(GQ(14), GQ(15));
#undef GQ
            bf16_t* dst = WqsT + (size_t)(hp * 128 + kk) * DM + d0 + dg;
            *(u32x4*)dst = o0; *(u32x4*)(dst + 8) = o1;
        }
        __syncthreads();
    }
    for (int o = gw; o < 512; o += nw) {
        const int kv = o >> 8, j = o & 255;
        const float* pe = p.in[kv ? I_CV_PE : I_CK_PE]; const float* w1 = p.in[kv ? I_CV_W1 : I_CK_W1];
        float acc = 0.f;
        for (int k = lane; k < 2048; k += 64) acc += pe[k] * w1[(size_t)k * 256 + j];
        acc = wave_sum(acc);
        if (lane == 0) ((float*)(ws + (kv ? WS_CBV : WS_CBK)))[j] = acc;
    }
}

DI void p6_peer_apply(const Params& p, int G) {
    unsigned char* ws = p.ws;
    const int tid = threadIdx.x, lane = tid & 63, wid = tid >> 6;
    const int gw = blockIdx.x * 8 + wid, nw = G * 8;
    const bf16_t* ub = (const bf16_t*)(ws + WS_UB); const bf16_t* vb = (const bf16_t*)(ws + WS_VB);
    const int* eidx = (const int*)(ws + R_EXP); const float* gsm = (const float*)(ws + R_GSM); const float* ssq1 = (const float*)(ws + WS_SSQ1);
    float* h = p.out; bf16_t* hb = (bf16_t*)(ws + R_H1B); float* rs2 = (float*)(ws + WS_RS2);
    for (int tok = gw; tok < NTOK; tok += nw) {
        float sq = lane < 16 ? ssq1[(size_t)lane * NTOK + tok] : 0.f;
        sq = wave_sum(sq);
        const float rs1 = rsqrtf(sq * (1.0f / DM) + EPS);
        const u32x4 xa = *(const u32x4*)(hb + (size_t)tok * DM + lane * 8), xc = *(const u32x4*)(hb + (size_t)tok * DM + 512 + lane * 8);
        const int e0 = eidx[(size_t)tok * 128 + lane], e1 = eidx[(size_t)tok * 128 + 64 + lane];
        const float g0 = gsm[(size_t)tok * 128 + lane], g1 = gsm[(size_t)tok * 128 + 64 + lane];
        float coef0 = 0.f, coef1 = 0.f;
#pragma unroll
        for (int half = 0; half < 2; ++half) {
            const int ev = half ? e1 : e0;
            float part[64];
#pragma unroll
            for (int j = 0; j < 64; ++j) {
                const int e = __builtin_amdgcn_readlane(ev, j);
                const bf16_t* ur = ub + (size_t)e * DM + lane * 8;
                const u32x4 ua = *(const u32x4*)ur, uc = *(const u32x4*)(ur + 512);
                float a = dot2bf(xa.x, ua.x, 0.f); a = dot2bf(xa.y, ua.y, a); a = dot2bf(xa.z, ua.z, a); a = dot2bf(xa.w, ua.w, a);
                a = dot2bf(xc.x, uc.x, a); a = dot2bf(xc.y, uc.y, a); a = dot2bf(xc.z, uc.z, a); a = dot2bf(xc.w, uc.w, a);
                part[j] = a;
            }
#pragma unroll
            for (int m = 32; m >= 1; m >>= 1) {
                const bool up = (lane & m) != 0;
#pragma unroll
                for (int i = 0; i < m; ++i) {
                    const float send = up ? part[i] : part[i + m];
                    const float keep = up ? part[i + m] : part[i];
                    part[i] = keep + __shfl_xor(send, m);
                }
            }
            const float act = gelu_tanh(part[0] * rs1);
            if (half) coef1 = g1 * act; else coef0 = g0 * act;
        }
        float acc[16];
#pragma unroll
        for (int i = 0; i < 16; ++i) acc[i] = 0.f;
#pragma unroll
        for (int half = 0; half < 2; ++half) {
            const int ev = half ? e1 : e0; const float cv = half ? coef1 : coef0;
#pragma unroll 16
            for (int j = 0; j < 64; ++j) {
                const int e = __builtin_amdgcn_readlane(ev, j);
                const float c = __uint_as_float(__builtin_amdgcn_readlane(__float_as_uint(cv), j));
                const bf16_t* vr = vb + (size_t)e * DM + lane * 8;
                const u32x4 va = *(const u32x4*)vr, vc = *(const u32x4*)(vr + 512);
                acc[0] += c * bflo(va.x); acc[1] += c * bfhi(va.x); acc[2] += c * bflo(va.y); acc[3] += c * bfhi(va.y);
                acc[4] += c * bflo(va.z); acc[5] += c * bfhi(va.z); acc[6] += c * bflo(va.w); acc[7] += c * bfhi(va.w);
                acc[8] += c * bflo(vc.x); acc[9] += c * bfhi(vc.x); acc[10] += c * bflo(vc.y); acc[11] += c * bfhi(vc.y);
                acc[12] += c * bflo(vc.z); acc[13] += c * bfhi(vc.z); acc[14] += c * bflo(vc.w); acc[15] += c * bfhi(vc.w);
            }
        }
        float* hr = h + (size_t)tok * DM + lane * 8;
        f32x4 h0 = *(f32x4*)hr, h1 = *(f32x4*)(hr + 4), h2 = *(f32x4*)(hr + 512), h3 = *(f32x4*)(hr + 516);
        h0 += (f32x4){acc[0], acc[1], acc[2], acc[3]}; h1 += (f32x4){acc[4], acc[5], acc[6], acc[7]};
        h2 += (f32x4){acc[8], acc[9], acc[10], acc[11]}; h3 += (f32x4){acc[12], acc[13], acc[14], acc[15]};
        *(f32x4*)hr = h0; *(f32x4*)(hr + 4) = h1; *(f32x4*)(hr + 512) = h2; *(f32x4*)(hr + 516) = h3;
        u32x4 w0, w1;
        w0.x = pack2bf(h0[0], h0[1]); w0.y = pack2bf(h0[2], h0[3]); w0.z = pack2bf(h1[0], h1[1]); w0.w = pack2bf(h1[2], h1[3]);
        w1.x = pack2bf(h2[0], h2[1]); w1.y = pack2bf(h2[2], h2[3]); w1.z = pack2bf(h3[0], h3[1]); w1.w = pack2bf(h3[2], h3[3]);
        *(u32x4*)(hb + (size_t)tok * DM + lane * 8) = w0; *(u32x4*)(hb + (size_t)tok * DM + 512 + lane * 8) = w1;
        float s = 0.f;
#pragma unroll
        for (int j = 0; j < 4; ++j) s += h0[j] * h0[j] + h1[j] * h1[j] + h2[j] * h2[j] + h3[j] * h3[j];
        s = wave_sum(s);
        if (lane == 0) rs2[tok] = rsqrtf(s * (1.0f / DM) + EPS);
    }
}

DI void p8_final_norm(const Params& p, int G) {
    const int lane = threadIdx.x & 63, gw = blockIdx.x * 8 + (threadIdx.x >> 6), nw = G * 8;
    const float* ssq3 = (const float*)(p.ws + WS_SSQ3); const float* g = p.in[I_FINAL_NORM]; float* h = p.out;
    f32x4 gg[4];
#pragma unroll
    for (int j = 0; j < 4; ++j) gg[j] = *(const f32x4*)(g + j * 256 + lane * 4);
    for (int row = gw; row < NTOK; row += nw) {
        float sq = lane < 16 ? ssq3[(size_t)lane * NTOK + row] : 0.f;
        sq = wave_sum(sq);
        const float rs = rsqrtf(sq * (1.0f / DM) + EPS);
#pragma unroll
        for (int j = 0; j < 4; ++j) { float* q = h + (size_t)row * DM + j * 256 + lane * 4; f32x4 v = *(f32x4*)q; v = v * rs * gg[j]; *(f32x4*)q = v; }
    }
}
typedef float f32x16 __attribute__((ext_vector_type(16)));
typedef short bf16x8v __attribute__((ext_vector_type(8)));
typedef __bf16 bf16x2v_ __attribute__((ext_vector_type(2)));
DI unsigned pk_bf16(float lo, float hi) { return __builtin_bit_cast(unsigned, __builtin_convertvector((f32x2){lo, hi}, bf16x2v_)); }
constexpr float LOG2E = 1.4426950408889634f;
constexpr int AT_KROW = 144, AT_VROW = 136;
constexpr int AT_KT = 64 * AT_KROW, AT_VT = 64 * AT_VROW, AT_BUF = 2 * AT_KT + 2 * AT_VT;
constexpr int AT_VAL = 0;
constexpr int AT_LUT = 2 * AT_BUF;
constexpr int AT_IMP = AT_LUT + 8 * 128 * 4;
constexpr int AT_SEL = AT_IMP + 8 * 32 * 65 * 4;
constexpr int AT_SSQ = AT_SEL + 512;
constexpr int AT_END = AT_SSQ + 1024;
static_assert(AT_END <= 160 * 1024 - 256, "attention LDS map");

struct AtSrc { const bf16_t* k0; const bf16_t* k1; const bf16_t* v0; const bf16_t* v1; int vld; };
DI void at_load(const AtSrc& s, int kpos, int tid, u32x4 (&r)[4]) {
    const int row = tid >> 3, seg = tid & 7;
    r[0] = *(const u32x4*)(s.k0 + (size_t)(kpos + row) * HD + seg * 8);
    r[1] = *(const u32x4*)(s.k1 + (size_t)(kpos + row) * HD + seg * 8);
    r[2] = *(const u32x4*)(s.v0 + (size_t)row * s.vld + kpos + seg * 8);
    r[3] = *(const u32x4*)(s.v1 + (size_t)row * s.vld + kpos + seg * 8);
}
DI void at_store(LAS3 unsigned char* buf, int tid, const u32x4 (&r)[4]) {
    const int row = tid >> 3, seg = tid & 7;
    *(LAS3 u32x4*)(buf + row * AT_KROW + seg * 16) = r[0];
    *(LAS3 u32x4*)(buf + AT_KT + row * AT_KROW + seg * 16) = r[1];
    LAS3 unsigned char* v = buf + 2 * AT_KT + row * AT_VROW + seg * 16;
    *(LAS3 u32x2*)(v) = (u32x2){r[2].x, r[2].y}; *(LAS3 u32x2*)(v + 8) = (u32x2){r[2].z, r[2].w};
    *(LAS3 u32x2*)(v + AT_VT) = (u32x2){r[3].x, r[3].y}; *(LAS3 u32x2*)(v + AT_VT + 8) = (u32x2){r[3].z, r[3].w};
}

template <int MODE, int PASS>
DI void at_step(LAS3 const unsigned char* Kb, LAS3 const unsigned char* Vb, const bf16x8v (&Q)[4], int k0, int tq, int lane, LAS3 const float* lut, bool blk_ok,
                float& m_run, float& l_run, f32x16 (&O)[2], float inv_l, LAS3 float* imp_row, float& bcarry) {
    const int r = lane & 31, hf = lane >> 5;
    f32x16 S[2];
#pragma unroll
    for (int sub = 0; sub < 2; ++sub) {
#pragma unroll
        for (int i = 0; i < 16; ++i) S[sub][i] = 0.f;
#pragma unroll
        for (int ks = 0; ks < 4; ++ks) {
            const bf16x8v a = *(LAS3 const bf16x8v*)(Kb + (32 * sub + r) * AT_KROW + 32 * ks + 16 * hf);
            S[sub] = __builtin_amdgcn_mfma_f32_32x32x16_bf16(a, Q[ks], S[sub], 0, 0, 0);
        }
    }
    float mx = -INFINITY;
#pragma unroll
    for (int sub = 0; sub < 2; ++sub)
#pragma unroll
        for (int i = 0; i < 16; ++i) {
            const int kp = k0 + 32 * sub + (i & 3) + 8 * (i >> 2) + 4 * hf;
            const int dist = MODE == 0 ? tq - (16 * kp + 31) : tq - kp;
            bool ok = dist >= 0 && blk_ok;
            if (MODE == 2) ok = ok && dist < 512;
            const int idx = dist < 0 ? 0 : (dist > 127 ? 127 : dist);
            float s = S[sub][i] * LOG2E + lut[idx];
            s = ok ? s : -INFINITY;
            S[sub][i] = s; mx = fmaxf(mx, s);
        }
    if (PASS != 2) {
        mx = fmaxf(mx, __shfl_xor(mx, 32));
        const float m_new = fmaxf(m_run, mx), m_safe = (m_new == -INFINITY) ? 0.f : m_new;
        const float alpha = __builtin_amdgcn_exp2f(m_run - m_safe);
        float sum = 0.f;
#pragma unroll
        for (int sub = 0; sub < 2; ++sub)
#pragma unroll
            for (int i = 0; i < 16; ++i) { const float pv = __builtin_amdgcn_exp2f(S[sub][i] - m_safe); S[sub][i] = pv; sum += pv; }
        l_run = l_run * alpha + sum; m_run = m_new;
        if (PASS == 0) {
#pragma unroll
            for (int db = 0; db < 2; ++db)
#pragma unroll
                for (int i = 0; i < 16; ++i) O[db][i] *= alpha;
        }
    } else {
#pragma unroll
        for (int sub = 0; sub < 2; ++sub) {
#pragma unroll
            for (int i = 0; i < 16; ++i) S[sub][i] = __builtin_amdgcn_exp2f(S[sub][i] - m_run) * inv_l;
            float bp[4], av[4];
#pragma unroll
            for (int a = 0; a < 4; ++a) {
                av[a] = S[sub][4 * a] + S[sub][4 * a + 1] + S[sub][4 * a + 2] + 0.5f * S[sub][4 * a + 3];
                bp[a] = __shfl_xor(0.5f * S[sub][4 * a + 3], 32);
            }
            const int sbase = (k0 >> 2) + 8 * sub + hf;
#pragma unroll
            for (int a = 0; a < 4; ++a) imp_row[sbase + 2 * a] = av[a] + (hf ? bp[a] : (a > 0 ? bp[a > 0 ? a - 1 : 0] : bcarry));
            bcarry = bp[3];
        }
    }
    if (PASS != 1) {
#pragma unroll
        for (int sub = 0; sub < 2; ++sub)
#pragma unroll
            for (int s2 = 0; s2 < 2; ++s2) {
                u32x4 pw;
                pw.x = pk_bf16(S[sub][8 * s2 + 0], S[sub][8 * s2 + 1]); pw.y = pk_bf16(S[sub][8 * s2 + 2], S[sub][8 * s2 + 3]);
                pw.z = pk_bf16(S[sub][8 * s2 + 4], S[sub][8 * s2 + 5]); pw.w = pk_bf16(S[sub][8 * s2 + 6], S[sub][8 * s2 + 7]);
                const bf16x8v pf = __builtin_bit_cast(bf16x8v, pw);
#pragma unroll
                for (int db = 0; db < 2; ++db) {
                    LAS3 const unsigned char* va = Vb + (32 * db + r) * AT_VROW + (32 * sub + 16 * s2 + 4 * hf) * 2;
                    const u32x2 v0 = *(LAS3 const u32x2*)va, v1 = *(LAS3 const u32x2*)(va + 16);
                    const bf16x8v vf = __builtin_bit_cast(bf16x8v, (u32x4){v0.x, v0.y, v1.x, v1.y});
                    O[db] = __builtin_amdgcn_mfma_f32_32x32x16_bf16(vf, pf, O[db], 0, 0, 0);
                }
            }
    }
}

template <int MODE, int PASS>
DI void at_branch(LAS3 unsigned char* lds, const AtSrc& src, int blk_lo, int blk_hi, const bf16x8v (&Q)[4], int tq, int tid, int kvh, LAS3 const float* lut,
                  unsigned mlo, unsigned mhi, float& m_run, float& l_run, f32x16 (&O)[2], float inv_l, LAS3 float* imp_row) {
    const int lane = tid & 63;
    u32x4 st[4];
    float bcarry = 0.f;
    at_load(src, blk_lo * 64, tid, st);
    for (int blk = blk_lo; blk <= blk_hi; ++blk) {
        LAS3 unsigned char* buf = lds + ((blk - blk_lo) & 1) * AT_BUF;
        at_store(buf, tid, st);
        __syncthreads();
        if (blk < blk_hi) at_load(src, (blk + 1) * 64, tid, st);
        bool blk_ok = true;
        if (MODE == 1) blk_ok = ((blk < 32 ? (mlo >> blk) : (mhi >> (blk - 32))) & 1u) != 0u;
        if (MODE != 1 || __any(blk_ok))
            at_step<MODE, PASS>(buf + kvh * AT_KT, buf + 2 * AT_KT + kvh * AT_VT, Q, blk * 64, tq, lane, lut, blk_ok, m_run, l_run, O, inv_l, imp_row, bcarry);
    }
    __syncthreads();
}

DI void p3_attention(const Params& p, LAS3 unsigned char* lds, int G) {
    unsigned char* ws = p.ws;
    const int tid = threadIdx.x, lane = tid & 63, h = __builtin_amdgcn_readfirstlane(tid >> 6), kvh = h >> 2, r = lane & 31, hf = lane >> 5;
    LAS3 float* lutall = (LAS3 float*)(lds + AT_LUT);
    {
        const float* rel = p.in[I_REL];
        for (int i = tid; i < 1024; i += MK_THREADS) lutall[i] = rel[rel_bucket(i & 127) * NH + (i >> 7)] * LOG2E;
    }
    __syncthreads();
    LAS3 const float* lut = lutall + h * 128;
    LAS3 float* impw = (LAS3 float*)(lds + AT_IMP);
    LAS3 float* vals = (LAS3 float*)(lds + AT_VAL);
    LAS3 unsigned char* selb = lds + AT_SEL;
    LAS3 float* ssq = (LAS3 float*)(lds + AT_SSQ);
    const bf16_t* qb = (const bf16_t*)(ws + R_QB);
    const float* gates = (const float*)(ws + R_GATE);
    const float* gn = p.in[I_GN_ATTN];
    bf16_t* mixed = (bf16_t*)(ws + WS_XB);
    for (int ui = blockIdx.x; ui < 512; ui += G) {
        const int q8 = ui & 255, rnd = ui >> 8, b = q8 >> 6, j6 = q8 & 63, tb = rnd == 0 ? 127 - j6 : j6;
        const int t0 = 32 * tb, qb64 = tb >> 1, tq = t0 + r;
        const size_t tok = (size_t)b * T_ + tq;
        bf16x8v Q[4];
#pragma unroll
        for (int ks = 0; ks < 4; ++ks) Q[ks] = *(const bf16x8v*)(qb + tok * 512 + h * 64 + 16 * ks + 8 * hf);
        f32x16 O[2];
#pragma unroll
        for (int db = 0; db < 2; ++db)
#pragma unroll
            for (int i = 0; i < 16; ++i) O[db][i] = 0.f;
        LAS3 float* oslot = (LAS3 float*)(lds + AT_IMP) + h * 2048 + lane;
        const size_t bh0 = (size_t)b * 2, bh1 = bh0 + 1;
        {
            const bf16_t* kcb = (const bf16_t*)(ws + R_KCB); const bf16_t* vct = (const bf16_t*)(ws + R_VCT);
            const AtSrc src{kcb + bh0 * 256 * 64, kcb + bh1 * 256 * 64, vct + bh0 * 64 * 256, vct + bh1 * 64 * 256, 256};
            const int nst = tb / 32 + 1;
            float m_run = -INFINITY, l_run = 0.f;
            at_branch<0, 1>(lds, src, 0, nst - 1, Q, tq, tid, kvh, lut, 0u, 0u, m_run, l_run, O, 0.f, nullptr);
            const float l_tot = l_run + __shfl_xor(l_run, 32);
            const float inv_l = l_tot > 0.f ? 1.0f / l_tot : 0.f;
            float m_fix = (m_run == -INFINITY) ? 0.f : m_run;
            at_branch<0, 2>(lds, src, 0, nst - 1, Q, tq, tid, kvh, lut, 0u, 0u, m_fix, l_run, O, inv_l, impw + (h * 32 + r) * 65);
        }
        {
            const int row = tid >> 3, j8 = tid & 7, kr = row >> 5, tr = row & 31;
#pragma unroll
            for (int jj = 0; jj < 8; ++jj) {
                const int s = j8 * 8 + jj, db = qb64 - s;
                float v = 0.f;
#pragma unroll
                for (int g = 0; g < 4; ++g) v += impw[((kr * 4 + g) * 32 + tr) * 65 + s];
                vals[row * 65 + s] = (db >= 0 && db < 2) ? 2.0e4f : (s == 0 ? 1.0e4f : (db >= 0 ? v : -1.0f));
            }
            __syncthreads();
            unsigned bits = 0u;
            {
                float vv[8]; int rk[8];
#pragma unroll
                for (int jj = 0; jj < 8; ++jj) { vv[jj] = vals[row * 65 + j8 * 8 + jj]; rk[jj] = 0; }
#pragma unroll 2
                for (int s2 = 0; s2 < 64; ++s2) {
                    const float w = vals[row * 65 + s2];
#pragma unroll
                    for (int jj = 0; jj < 8; ++jj) rk[jj] += (w > vv[jj] || (w == vv[jj] && s2 < j8 * 8 + jj)) ? 1 : 0;
                }
#pragma unroll
                for (int jj = 0; jj < 8; ++jj) if (rk[jj] < 16 && qb64 - (j8 * 8 + jj) >= 0) bits |= 1u << jj;
            }
            selb[row * 8 + j8] = (unsigned char)bits;
            __syncthreads();
        }
        const unsigned mlo = *(LAS3 const unsigned*)(selb + (kvh * 32 + r) * 8), mhi = *(LAS3 const unsigned*)(selb + (kvh * 32 + r) * 8 + 4);
        __syncthreads();
        {
            const float g0 = sigmoidf_(gates[tok * 24 + h * 3 + 0]);
#pragma unroll
            for (int db = 0; db < 2; ++db)
#pragma unroll
                for (int i = 0; i < 16; ++i) { oslot[(db * 16 + i) * 64] = g0 * O[db][i]; O[db][i] = 0.f; }
        }
        {
            const bf16_t* ksb = (const bf16_t*)(ws + R_KS); const bf16_t* vst = (const bf16_t*)(ws + R_VST);
            const AtSrc src{ksb + bh0 * T_ * HD, ksb + bh1 * T_ * HD, vst + bh0 * HD * T_, vst + bh1 * HD * T_, T_};
            float m_run = -INFINITY, l_run = 0.f;
            at_branch<1, 0>(lds, src, 0, qb64, Q, tq, tid, kvh, lut, mlo, mhi, m_run, l_run, O, 0.f, nullptr);
            const float l_tot = l_run + __shfl_xor(l_run, 32), sc = sigmoidf_(gates[tok * 24 + h * 3 + 1]) / l_tot;
#pragma unroll
            for (int db = 0; db < 2; ++db)
#pragma unroll
                for (int i = 0; i < 16; ++i) { oslot[(db * 16 + i) * 64] += sc * O[db][i]; O[db][i] = 0.f; }
        }
        {
            const bf16_t* kwb = (const bf16_t*)(ws + R_KW); const bf16_t* vwt = (const bf16_t*)(ws + R_VWT);
            const AtSrc src{kwb + bh0 * T_ * HD, kwb + bh1 * T_ * HD, vwt + bh0 * HD * T_, vwt + bh1 * HD * T_, T_};
            int wb0 = (t0 - 511) >> 6; wb0 = wb0 < 0 ? 0 : wb0;
            float m_run = -INFINITY, l_run = 0.f;
            at_branch<2, 0>(lds, src, wb0, qb64, Q, tq, tid, kvh, lut, 0u, 0u, m_run, l_run, O, 0.f, nullptr);
            const float l_tot = l_run + __shfl_xor(l_run, 32), sc = sigmoidf_(gates[tok * 24 + h * 3 + 2]) / l_tot;
#pragma unroll
            for (int db = 0; db < 2; ++db)
#pragma unroll
                for (int i = 0; i < 16; ++i) O[db][i] = oslot[(db * 16 + i) * 64] + sc * O[db][i];
        }
        {
            float ss = 0.f;
#pragma unroll
            for (int db = 0; db < 2; ++db)
#pragma unroll
                for (int i = 0; i < 16; ++i) ss += O[db][i] * O[db][i];
            ss += __shfl_xor(ss, 32);
            if (hf == 0) ssq[h * 32 + r] = ss;
            __syncthreads();
            float tot = 0.f;
#pragma unroll
            for (int hh = 0; hh < 8; ++hh) tot += ssq[hh * 32 + r];
            const float rs = rsqrtf(tot * (1.0f / 512) + EPS);
#pragma unroll
            for (int db = 0; db < 2; ++db)
#pragma unroll
                for (int a = 0; a < 4; ++a) {
                    const int d = 32 * db + 8 * a + 4 * hf;
                    const f32x4 g4 = *(const f32x4*)(gn + h * 64 + d);
                    u32x2 w; w.x = pk_bf16(O[db][4 * a] * rs * g4[0], O[db][4 * a + 1] * rs * g4[1]); w.y = pk_bf16(O[db][4 * a + 2] * rs * g4[2], O[db][4 * a + 3] * rs * g4[3]);
                    *(u32x2*)(mixed + tok * DM + h * 64 + d) = w;
                }
            __syncthreads();
        }
    }
}
constexpr int LR_STRIDE = 516;
constexpr int LR_XC = 0, LR_A = 32 * LR_STRIDE * 4, LR_RS = 2 * 32 * LR_STRIDE * 4, LR_END = LR_RS + 256;
static_assert(LR_END <= 160 * 1024 - 256, "LRU LDS map");

template <bool FINAL>
DI void lru_phase(const Params& p, LAS3 unsigned char* lds, int G) {
    unsigned char* ws = p.ws;
    const int tid = threadIdx.x, lane = tid & 63, n = __builtin_amdgcn_readfirstlane(tid >> 6), r = lane & 31, hf = lane >> 5, ch = tid;
    LAS3 float* XC = (LAS3 float*)(lds + LR_XC); LAS3 float* AA = (LAS3 float*)(lds + LR_A); LAS3 float* RS = (LAS3 float*)(lds + LR_RS);
    const float* xr = (const float*)(ws + R_XR); const bf16_t* xg = (const bf16_t*)(ws + R_XG);
    float* sumP = (float*)(ws + WS_LRUP); float* sumH = (float*)(ws + WS_LRUH);
    bf16_t* mixed = (bf16_t*)(ws + WS_XB);
    const float cw0 = p.in[I_CONV_W][0 * 512 + ch], cw1 = p.in[I_CONV_W][1 * 512 + ch], cw2 = p.in[I_CONV_W][2 * 512 + ch], cw3 = p.in[I_CONV_W][3 * 512 + ch], cb = p.in[I_CONV_B][ch];
    const float gl = FINAL ? p.in[I_GN_LRU][ch] : 0.f;
    float ba[2], bx[2], sp[2];
#pragma unroll
    for (int nb = 0; nb < 2; ++nb) { const int c2 = n * 64 + 32 * nb + r; ba[nb] = p.in[I_LRU_BA][c2]; bx[nb] = p.in[I_LRU_BX][c2]; sp[nb] = log1pf(__expf(-p.in[I_LRU_LAM][c2])); }
    bf16x8v Ba[2][4], Bx[2][4];
    {
        const bf16_t* waT = (const bf16_t*)(ws + WS_WAT); const bf16_t* wxT = (const bf16_t*)(ws + WS_WXT);
#pragma unroll
        for (int nb = 0; nb < 2; ++nb)
#pragma unroll
            for (int ks = 0; ks < 4; ++ks) {
                const size_t o = (size_t)(n * 64 + 32 * nb + r) * 64 + 16 * ks + 8 * hf;
                Ba[nb][ks] = *(const bf16x8v*)(waT + o); Bx[nb][ks] = *(const bf16x8v*)(wxT + o);
            }
    }
    for (int ci = blockIdx.x; ci < 256; ci += G) {
        const int b = ci >> 6, cib = ci & 63, t0 = cib * 64;
        const size_t tok0 = (size_t)b * T_ + t0;
        float x1 = 0.f, x2 = 0.f, x3 = 0.f;
        if (t0 > 0) { x1 = xr[(tok0 - 1) * 512 + ch]; x2 = xr[(tok0 - 2) * 512 + ch]; x3 = xr[(tok0 - 3) * 512 + ch]; }
        float hst = 0.f, pprod = 1.f;
        if (FINAL) {
            const float* Pp = sumP + (size_t)(b * 64) * 512 + ch; const float* Hp = sumH + (size_t)(b * 64) * 512 + ch;
            for (int k = 0; k < cib; ++k) hst = Pp[(size_t)k * 512] * hst + Hp[(size_t)k * 512];
        }
#pragma unroll 1
        for (int half = 0; half < 2; ++half) {
            const size_t tokh = tok0 + half * 32;
            __syncthreads();
#pragma unroll 8
            for (int t = 0; t < 32; ++t) {
                const float x0 = xr[(tokh + t) * 512 + ch];
                XC[t * LR_STRIDE + ch] = cw0 * x3 + cw1 * x2 + cw2 * x1 + cw3 * x0 + cb;
                x3 = x2; x2 = x1; x1 = x0;
            }
            __syncthreads();
            {
                f32x16 ar[2], ai[2];
#pragma unroll
                for (int nb = 0; nb < 2; ++nb)
#pragma unroll
                    for (int i = 0; i < 16; ++i) { ar[nb][i] = 0.f; ai[nb][i] = 0.f; }
#pragma unroll
                for (int ks = 0; ks < 4; ++ks) {
                    LAS3 const float* src = XC + r * LR_STRIDE + n * 64 + 16 * ks + 8 * hf;
                    const f32x4 f0 = *(LAS3 const f32x4*)src, f1 = *(LAS3 const f32x4*)(src + 4);
                    u32x4 pw; pw.x = pk_bf16(f0[0], f0[1]); pw.y = pk_bf16(f0[2], f0[3]); pw.z = pk_bf16(f1[0], f1[1]); pw.w = pk_bf16(f1[2], f1[3]);
                    const bf16x8v af = __builtin_bit_cast(bf16x8v, pw);
#pragma unroll
                    for (int nb = 0; nb < 2; ++nb) {
                        ar[nb] = __builtin_amdgcn_mfma_f32_32x32x16_bf16(af, Ba[nb][ks], ar[nb], 0, 0, 0);
                        ai[nb] = __builtin_amdgcn_mfma_f32_32x32x16_bf16(af, Bx[nb][ks], ai[nb], 0, 0, 0);
                    }
                }
                __syncthreads();
#pragma unroll
                for (int nb = 0; nb < 2; ++nb)
#pragma unroll
                    for (int i = 0; i < 16; ++i) {
                        const int t = (i & 3) + 8 * (i >> 2) + 4 * hf, o = t * LR_STRIDE + n * 64 + 32 * nb + r;
                        const float xcv = XC[o];
                        const float rg = sigmoidf_(ar[nb][i] + ba[nb]), ig = sigmoidf_(ai[nb][i] + bx[nb]);
                        const float log_a = -8.0f * rg * sp[nb];
                        AA[o] = __expf(log_a);
                        XC[o] = sqrtf(-expm1f(2.0f * log_a)) * (ig * xcv);
                    }
            }
            __syncthreads();
            if (!FINAL) {
#pragma unroll 8
                for (int t = 0; t < 32; ++t) { const float a = AA[t * LR_STRIDE + ch]; hst = a * hst + XC[t * LR_STRIDE + ch]; pprod *= a; }
            } else {
#pragma unroll 8
                for (int t = 0; t < 32; ++t) {
                    hst = AA[t * LR_STRIDE + ch] * hst + XC[t * LR_STRIDE + ch];
                    XC[t * LR_STRIDE + ch] = hst * gelu_tanh(bf2f(xg[(tokh + t) * 512 + ch]));
                }
                __syncthreads();
                {
                    const int t = tid >> 4, part = tid & 15;
                    float s = 0.f;
#pragma unroll 8
                    for (int j = 0; j < 32; ++j) { const float v = XC[t * LR_STRIDE + part + 16 * j]; s += v * v; }
                    s += __shfl_xor(s, 1); s += __shfl_xor(s, 2); s += __shfl_xor(s, 4); s += __shfl_xor(s, 8);
                    if (part == 0) RS[t] = rsqrtf(s * (1.0f / 512) + EPS);
                }
                __syncthreads();
#pragma unroll 8
                for (int t = 0; t < 32; ++t) mixed[(tokh + t) * DM + 512 + ch] = f2bf(XC[t * LR_STRIDE + ch] * RS[t] * gl);
            }
        }
        if (!FINAL) { sumP[(size_t)ci * 512 + ch] = pprod; sumH[(size_t)ci * 512 + ch] = hst; }
    }
    __syncthreads();
}
typedef float f32x4v __attribute__((ext_vector_type(4)));
constexpr int CM_IMG = 0;
constexpr int CM_HID = 36864;
constexpr int CM_END = CM_HID + 16 * 264 * 2;
DI void p2_compress(const Params& p, LAS3 unsigned char* lds, int G) {
    unsigned char* ws = p.ws;
    const int tid = threadIdx.x, lane = tid & 63, wid = __builtin_amdgcn_readfirstlane(tid >> 6), row = lane & 15, kg = lane >> 4;
    for (int u = blockIdx.x; u < 256; u += G) {
        const int kv = u >> 7, bh = (u >> 4) & 7, c0 = (u & 15) * 16;
        const bf16_t* src = (const bf16_t*)(ws + (kv ? R_VC : R_KC)) + ((size_t)bh * T_ + 16 * c0) * HD;
        const bf16_t* W1T = (const bf16_t*)(ws + (kv ? WS_CW1V : WS_CW1K));
        const float* cb = (const float*)(ws + (kv ? WS_CBV : WS_CBK));
        const bf16_t* W2T = (const bf16_t*)(ws + (kv ? WS_CW2V : WS_CW2K));
        __syncthreads();
        for (int i = tid; i < 272 * 8; i += MK_THREADS) { const int tau = i >> 3, cch = i & 7; *(LAS3 u32x4*)(lds + CM_IMG + tau * 128 + (tau >> 4) * 16 + cch * 16) = *(const u32x4*)(src + (size_t)tau * HD + cch * 8); }
        __syncthreads();
        f32x4v acc[2] = {{0.f, 0.f, 0.f, 0.f}, {0.f, 0.f, 0.f, 0.f}};
        const bf16_t* wb0 = W1T + (size_t)(wid * 32 + row) * 2048 + 8 * kg, * wb1 = wb0 + (size_t)16 * 2048;
#pragma unroll 8
        for (int ks = 0; ks < 64; ++ks) {
            const int tau = 16 * row + (ks >> 1);
            const bf16x8v a = *(LAS3 const bf16x8v*)(lds + CM_IMG + tau * 128 + (tau >> 4) * 16 + (32 * (ks & 1) + 8 * kg) * 2);
            const bf16x8v b0 = *(const bf16x8v*)(wb0 + 32 * ks), b1 = *(const bf16x8v*)(wb1 + 32 * ks);
            acc[0] = __builtin_amdgcn_mfma_f32_16x16x32_bf16(a, b0, acc[0], 0, 0, 0);
            acc[1] = __builtin_amdgcn_mfma_f32_16x16x32_bf16(a, b1, acc[1], 0, 0, 0);
        }
#pragma unroll
        for (int nb = 0; nb < 2; ++nb) {
            const int col = wid * 32 + 16 * nb + row; const float bias = cb[col];
#pragma unroll
            for (int i = 0; i < 4; ++i) *(LAS3 bf16_t*)(lds + CM_HID + ((4 * kg + i) * 264 + col) * 2) = f2bf(gelu_tanh(acc[nb][i] + bias));
        }
        __syncthreads();
        if (wid < 4) {
            f32x4v o = {0.f, 0.f, 0.f, 0.f};
#pragma unroll
            for (int ks = 0; ks < 8; ++ks) {
                const bf16x8v a = *(LAS3 const bf16x8v*)(lds + CM_HID + (row * 264 + 32 * ks + 8 * kg) * 2);
                const bf16x8v b = *(const bf16x8v*)(W2T + (size_t)(wid * 16 + row) * 256 + 32 * ks + 8 * kg);
                o = __builtin_amdgcn_mfma_f32_16x16x32_bf16(a, b, o, 0, 0, 0);
            }
            const int d = wid * 16 + row;
#pragma unroll
            for (int i = 0; i < 4; ++i) {
                const int c = c0 + 4 * kg + i; const float v = c < NCMP ? o[i] : 0.f;
                ((float*)(ws + (kv ? WS_VCMP : WS_KCMP)))[((size_t)bh * 256 + c) * 64 + d] = v;
                if (kv) ((bf16_t*)(ws + R_VCT))[((size_t)bh * 64 + d) * 256 + c] = f2bf(v);
                else    ((bf16_t*)(ws + R_KCB))[((size_t)bh * 256 + c) * 64 + d] = f2bf(v);
            }
        }
    }
    __syncthreads();
}
DI void p2_vtranspose(const Params& p, LAS3 unsigned char* lds, int G) {
    unsigned char* ws = p.ws;
    const int tid = threadIdx.x;
    LAS3 bf16_t* tl = (LAS3 bf16_t*)lds;
    for (int u = blockIdx.x; u < 1024; u += G) {
        const int which = u >> 9, bh = (u >> 6) & 7, tt = u & 63;
        const bf16_t* src = (const bf16_t*)(ws + (which ? R_VW : R_VS)) + ((size_t)bh * T_ + tt * 64) * HD;
        bf16_t* dst = (bf16_t*)(ws + (which ? R_VWT : R_VST)) + (size_t)bh * HD * T_ + tt * 64;
        __syncthreads();
        { const int tok = tid >> 3, seg = tid & 7; *(LAS3 u32x4*)(tl + tok * 72 + seg * 8) = *(const u32x4*)(src + (size_t)tok * HD + seg * 8); }
        __syncthreads();
        { const int d = tid >> 3, seg = tid & 7; u32x4 w;
          w.x = (unsigned)tl[(seg * 8 + 0) * 72 + d] | ((unsigned)tl[(seg * 8 + 1) * 72 + d] << 16); w.y = (unsigned)tl[(seg * 8 + 2) * 72 + d] | ((unsigned)tl[(seg * 8 + 3) * 72 + d] << 16);
          w.z = (unsigned)tl[(seg * 8 + 4) * 72 + d] | ((unsigned)tl[(seg * 8 + 5) * 72 + d] << 16); w.w = (unsigned)tl[(seg * 8 + 6) * 72 + d] | ((unsigned)tl[(seg * 8 + 7) * 72 + d] << 16);
          *(u32x4*)(dst + (size_t)d * T_ + seg * 8) = w; }
    }
    __syncthreads();
}
DI int ord_enc(float f) { const int u = __float_as_int(f); return u ^ ((u >> 31) & 0x7fffffff); }
DI float ord_dec(int o) { return __int_as_float(o ^ ((o >> 31) & 0x7fffffff)); }
#define PEER_CE_DESC(a, b) do { const int _hi = max((a), (b)), _lo = min((a), (b)); (a) = _hi; (b) = _lo; } while (0)
#define PEER_CE_ASC(a, b)  do { const int _hi = max((a), (b)), _lo = min((a), (b)); (a) = _lo; (b) = _hi; } while (0)
DI void sort16_desc(int (&x)[16]) {
#pragma unroll
    for (int k = 2; k <= 16; k <<= 1)
#pragma unroll
        for (int j = k >> 1; j > 0; j >>= 1)
#pragma unroll
            for (int i = 0; i < 16; ++i) { const int l = i ^ j; if (l > i) { if ((i & k) == 0) PEER_CE_DESC(x[i], x[l]); else PEER_CE_ASC(x[i], x[l]); } }
}
DI void merge16_desc(int (&a)[16], const int (&b)[16]) {
#pragma unroll
    for (int i = 0; i < 16; ++i) a[i] = max(a[i], b[15 - i]);
#pragma unroll
    for (int j = 8; j > 0; j >>= 1)
#pragma unroll
        for (int i = 0; i < 16; ++i) { const int l = i ^ j; if (l > i) PEER_CE_DESC(a[i], a[l]); }
}
constexpr int PR_KEYS = 0;
constexpr int PR_IDX = 512 * 68 * 4;
constexpr int PR_RS = PR_IDX + 128 * 32 * 4;
constexpr int PR_END = PR_RS + 1024;
static_assert(PR_END <= 160 * 1024 - 256, "PEER LDS map");

struct EpiPeerRoute {
    static constexpr bool PERM = true, AFTER_DRAIN = true;
    const float* ssq1; int* eout; float* gout;
    DI void fused(const f32x4 (&acc)[2][2][4][2], const pg8::Unit& u, int wr, int wc, int fr, int fq, PG8_LAS unsigned char* lds, int wid, int lane) const {
        const int tid = wid * 64 + lane, head = u.pn;
        LAS3 int* KEYS = (LAS3 int*)(lds + PR_KEYS); LAS3 int* IDX = (LAS3 int*)(lds + PR_IDX); LAS3 float* RS = (LAS3 float*)(lds + PR_RS);
        if (tid < 256) { float s = 0.f; for (int j = 0; j < 16; ++j) s += ssq1[(size_t)j * NTOK + u.pm * 256 + tid]; RS[tid] = rsqrtf(s * (1.0f / DM) + EPS); }
#pragma unroll 1
        for (int ai = 0; ai < 2; ++ai) {
            __syncthreads();
#pragma unroll
            for (int bj = 0; bj < 2; ++bj)
#pragma unroll
                for (int m = 0; m < 4; ++m)
#pragma unroll
                    for (int n = 0; n < 2; ++n) {
                        const int rl = 64 * wr + 16 * m + fr, kk0 = 32 * wc + 8 * fq + 4 * n, hl = ((rl * 2 + bj) * 2 + (kk0 >> 6));
                        const f32x4 v = ai == 0 ? acc[0][bj][m][n] : acc[1][bj][m][n];
                        u32x4 kq;
                        kq.x = (unsigned)((ord_enc(v[0]) & ~0x7f) | (127 - (kk0 + 0))); kq.y = (unsigned)((ord_enc(v[1]) & ~0x7f) | (127 - (kk0 + 1)));
                        kq.z = (unsigned)((ord_enc(v[2]) & ~0x7f) | (127 - (kk0 + 2))); kq.w = (unsigned)((ord_enc(v[3]) & ~0x7f) | (127 - (kk0 + 3)));
                        *(LAS3 u32x4*)(KEYS + hl * 68 + (kk0 & 63)) = kq;
                    }
            __syncthreads();
            int top[16];
            {
                LAS3 const int* src = KEYS + tid * 68;
                int t2[16];
#pragma unroll
                for (int q = 0; q < 4; ++q) { const u32x4 w = *(LAS3 const u32x4*)(src + 4 * q); top[4 * q] = (int)w.x; top[4 * q + 1] = (int)w.y; top[4 * q + 2] = (int)w.z; top[4 * q + 3] = (int)w.w; }
                sort16_desc(top);
#pragma unroll 1
                for (int g = 1; g < 4; ++g) {
#pragma unroll
                    for (int q = 0; q < 4; ++q) { const u32x4 w = *(LAS3 const u32x4*)(src + 16 * g + 4 * q); t2[4 * q] = (int)w.x; t2[4 * q + 1] = (int)w.y; t2[4 * q + 2] = (int)w.z; t2[4 * q + 3] = (int)w.w; }
                    sort16_desc(t2);
                    merge16_desc(top, t2);
                }
#pragma unroll
                for (int i = 0; i < 16; ++i) t2[i] = __shfl_xor(top[i], 1);
                merge16_desc(top, t2);
            }
            int s1[16], s2[16];
            {
                const bool isp1 = (lane & 2) != 0;
#pragma unroll
                for (int i = 0; i < 16; ++i) { const int o = __shfl_xor(top[i], 2); s1[i] = isp1 ? o : top[i]; s2[i] = isp1 ? top[i] : o; }
            }
            const int rl = tid >> 2, q4 = tid & 3;
#pragma unroll
            for (int kq = 0; kq < 4; ++kq) if (q4 == kq) {
#pragma unroll
                for (int j = 0; j < 4; ++j) { IDX[rl * 32 + 4 * kq + j] = 127 - (s1[4 * kq + j] & 0x7f); IDX[rl * 32 + 16 + 4 * kq + j] = 127 - (s2[4 * kq + j] & 0x7f); }
            }
            float v1[16], v2[16];
#pragma unroll
            for (int i = 0; i < 16; ++i) { v1[i] = ord_dec(s1[i] & ~0x7f); v2[i] = ord_dec(s2[i] & ~0x7f); }
            int best[16], grp[16];
            {
                int cnt = 0; bool first = true;
#pragma unroll
                for (int a = 0; a < 16; ++a)
#pragma unroll
                    for (int b = 0; b < 16; ++b) if ((a + 1) * (b + 1) <= 16) {
                        grp[cnt & 15] = (ord_enc(v1[a] + v2[b]) & ~0xff) | (255 - (16 * a + b));
                        ++cnt;
                        if ((cnt & 15) == 0) { sort16_desc(grp); if (first) {
#pragma unroll
                                for (int i = 0; i < 16; ++i) best[i] = grp[i];
                                first = false; } else merge16_desc(best, grp); }
                    }
#pragma unroll
                for (int i = 2; i < 16; ++i) grp[i] = (int)0x80000000;
                sort16_desc(grp); merge16_desc(best, grp);
            }
            __syncthreads();
            const float rs1 = RS[128 * ai + rl];
            float gsum = 0.f, gv[16]; int ev[16];
            const float mtop = ord_dec(best[0] & ~0xff) * rs1;
#pragma unroll
            for (int i = 0; i < 16; ++i) {
                const float sc = ord_dec(best[i] & ~0xff) * rs1; gv[i] = __expf(sc - mtop); gsum += gv[i];
                const int ab = 255 - (best[i] & 0xff);
                ev[i] = IDX[rl * 32 + (ab >> 4)] * 128 + IDX[rl * 32 + 16 + (ab & 15)];
            }
            const float ginv = 1.0f / gsum;
            const size_t tok = (size_t)u.pm * 256 + 128 * ai + rl;
#pragma unroll
            for (int kq = 0; kq < 4; ++kq) if (q4 == kq) {
                *(u32x4*)(eout + tok * 128 + head * 16 + 4 * kq) = (u32x4){(unsigned)ev[4 * kq], (unsigned)ev[4 * kq + 1], (unsigned)ev[4 * kq + 2], (unsigned)ev[4 * kq + 3]};
                *(f32x4*)(gout + tok * 128 + head * 16 + 4 * kq) = (f32x4){gv[4 * kq] * ginv, gv[4 * kq + 1] * ginv, gv[4 * kq + 2] * ginv, gv[4 * kq + 3] * ginv};
            }
        }
        __syncthreads();
    }
    DI void operator()(const f32x4 (&)[2][2][4][2], const pg8::Unit&, int, int, int, int) const {}
};
struct SliceOrder : pg8::StaticOrder {
    int slice;
    __device__ bool next(int i, pg8::Unit& u) const { if (i > 0) return false; return pg8::StaticOrder::next(slice, u); }
};
DI void p5_peer_route(const Params& p, LAS3 unsigned char* lds, int G) {
    unsigned char* ws = p.ws;
    pg8::Gemm g{(const bf16_t*)(ws + R_H1B), (const bf16_t*)(ws + WS_WQS), NTOK, 2048, DM};
    EpiPeerRoute E{(const float*)(ws + WS_SSQ1), (int*)(ws + R_EXP), (float*)(ws + R_GSM)};
    const int nslice = (512 + G - 1) / G;
#pragma unroll 1
    for (int s = 0; s < nslice; ++s) {
        SliceOrder S; S.init(NTOK, 2048, G, (int)blockIdx.x); S.slice = s;
        pg8::gemm_phase<EpiPeerRoute, SliceOrder>(lds, g, S, E, nullptr);
        __syncthreads();
    }
}
constexpr int LDS_MISC = 160 * 1024 - 256;
constexpr int LDS_BYTES = 160 * 1024;
constexpr size_t CTL_BAR = 0;
static_assert(XCD_BAR_WORDS * 4 <= 64 * 1024, "control region");

template <class F> struct EpiAdapt {
    static constexpr bool PERM = true, AFTER_DRAIN = false;
    F f;
    DI void operator()(const f32x4 (&acc)[2][2][4][2], const pg8::Unit& u, int wr, int wc, int fr, int fq) const {
        const int row0 = u.pm * 256 + wr * 64 + fr, col0 = u.pn * 256 + wc * 32 + 8 * fq;
#pragma unroll
        for (int ai = 0; ai < 2; ++ai)
#pragma unroll
            for (int m = 0; m < 4; ++m) {
                const int row = row0 + ai * 128 + m * 16;
#pragma unroll
                for (int bj = 0; bj < 2; ++bj)
#pragma unroll
                    for (int n = 0; n < 2; ++n) f.store4(row, col0 + bj * 128 + 4 * n, acc[ai][bj][m][n]);
            }
    }
};
template <class F> struct EpiAdaptSsq {
    static constexpr bool PERM = true, AFTER_DRAIN = false;
    F f; float* ssq;
    DI void operator()(const f32x4 (&acc)[2][2][4][2], const pg8::Unit& u, int wr, int wc, int fr, int fq) const {
        const int row0 = u.pm * 256 + wr * 64 + fr, col0 = u.pn * 256 + wc * 32 + 8 * fq;
#pragma unroll
        for (int ai = 0; ai < 2; ++ai)
#pragma unroll
            for (int m = 0; m < 4; ++m) {
                const int row = row0 + ai * 128 + m * 16;
                float s = 0.f;
#pragma unroll
                for (int bj = 0; bj < 2; ++bj)
#pragma unroll
                    for (int n = 0; n < 2; ++n) { const f32x4 v = f.store4r(row, col0 + bj * 128 + 4 * n, acc[ai][bj][m][n]); s += (v[0] * v[0] + v[1] * v[1]) + (v[2] * v[2] + v[3] * v[3]); }
                s += __shfl_xor(s, 16); s += __shfl_xor(s, 32);
                if (fq == 0) ssq[(size_t)(u.pn * 4 + wc) * NTOK + row] = s;
            }
    }
};
struct EpiOutR {
    const float* x; float* h1; bf16_t* h1b;
    DI f32x4 store4r(int row, int col, f32x4 v) const {
        const size_t o = (size_t)row * DM + col;
        v += *(const f32x4*)(x + o);
        *(f32x4*)(h1 + o) = v;
        u32x2 w; w.x = pack2bf(v[0], v[1]); w.y = pack2bf(v[2], v[3]); *(u32x2*)(h1b + o) = w;
        return v;
    }
};
struct EpiGateR {
    const float* rs2; const float* bias; const float* pp; float* h;
    DI f32x4 store4r(int row, int col, f32x4 v) const {
        const size_t o = (size_t)row * DM + col;
        const float s = rs2[row];
        const f32x4 bb = *(const f32x4*)(bias + col), p4 = *(const f32x4*)(pp + o);
        f32x4 hv = *(f32x4*)(h + o);
#pragma unroll
        for (int j = 0; j < 4; ++j) hv[j] += sigmoidf_(v[j] * s + bb[j]) * p4[j];
        *(f32x4*)(h + o) = hv;
        return hv;
    }
};

struct MegaArgs { Params p; int ph_lo, ph_hi; };

__global__ void __launch_bounds__(MK_THREADS, 2) mega_fwd(MegaArgs args) {
    extern __shared__ __attribute__((aligned(16))) unsigned char lds_raw[];
    LAS unsigned char* lds = (LAS unsigned char*)lds_raw;
    const Params& p = args.p;
    unsigned char* ws = p.ws;
    const int lo = args.ph_lo, hi = args.ph_hi;
    const int G = gridDim.x;
    volatile LAS unsigned* misc = (volatile LAS unsigned*)(lds + LDS_MISC);
    if (threadIdx.x < 64) misc[threadIdx.x] = 0u;
    __syncthreads();
    XcdBarrier bar; bar.bar = (unsigned*)(ws + WS_CTL); bar.x = 0; bar.st = nullptr;
    if (hi - lo > 1) bar = xcd_barrier_post((unsigned*)(ws + WS_CTL), misc);
#define IN(k) (lo <= (k) && (k) < hi)
#define SEAM(k) do { if (IN(k) && IN((k) + 1)) xcd_barrier(bar); } while (0)

    if (IN(0)) p0_prologue(p, lds, G);
    SEAM(0);
    if (IN(1)) {
        pg8::Gemm g{(const bf16_t*)(ws + WS_XB), (const bf16_t*)(ws + WS_WIN), NTOK, NPROJ, DM};
        pg8::StaticOrder S; S.init(NTOK, NPROJ, G, (int)blockIdx.x);
        EpiAdapt<EpiProj> E{{(const float*)(ws + WS_RS0), (bf16_t*)(ws + R_QB), (bf16_t*)(ws + R_KC), (float*)(ws + R_GATE), (float*)(ws + R_XR), (bf16_t*)(ws + R_XG)}};
        pg8::gemm_phase<EpiAdapt<EpiProj>, pg8::StaticOrder>(lds, g, S, E, nullptr);
    }
    SEAM(1);
    if (IN(2)) { if (!CMP_NAIVE) { p2_compress(p, lds, G); p2_vtranspose(p, lds, G); } lru_phase<false>(p, lds, G); }
    SEAM(2);
    if (IN(3)) { p3_attention(p, lds, G); if (!LRU_NAIVE) lru_phase<true>(p, lds, G); }
    SEAM(3);
    if (IN(4)) {
        pg8::Gemm g{(const bf16_t*)(ws + WS_XB), (const bf16_t*)(ws + WS_WOUT), NTOK, DM, DM};
        pg8::StaticOrder S; S.init(NTOK, DM, G, (int)blockIdx.x);
        EpiAdaptSsq<EpiOutR> E{{p.in[I_X], p.out, (bf16_t*)(ws + R_H1B)}, (float*)(ws + WS_SSQ1)};
        pg8::gemm_phase<EpiAdaptSsq<EpiOutR>, pg8::StaticOrder>(lds, g, S, E, nullptr);
    }
    SEAM(4);
    if (IN(5)) p5_peer_route(p, lds, G);
    SEAM(5);
    if (IN(6)) p6_peer_apply(p, G);
    SEAM(6);
    if (IN(7)) {
        {
            pg8::Gemm g{(const bf16_t*)(ws + WS_PB), (const bf16_t*)(ws + WS_WP), NTOK, DM, PLE};
            pg8::StaticOrder S; S.init(NTOK, DM, G, (int)blockIdx.x);
            EpiAdapt<EpiF32Plain> E{{(float*)(ws + R_BIG), DM, 0}};
            pg8::gemm_phase<EpiAdapt<EpiF32Plain>, pg8::StaticOrder>(lds, g, S, E, nullptr);
        }
        __syncthreads();
        {
            pg8::Gemm g{(const bf16_t*)(ws + R_H1B), (const bf16_t*)(ws + WS_WG), NTOK, DM, DM};
            pg8::StaticOrder S; S.init(NTOK, DM, G, (int)blockIdx.x);
            EpiAdaptSsq<EpiGateR> E{{(const float*)(ws + WS_RS2), p.in[I_PLE_BG], (const float*)(ws + R_BIG), p.out}, (float*)(ws + WS_SSQ3)};
            pg8::gemm_phase<EpiAdaptSsq<EpiGateR>, pg8::StaticOrder>(lds, g, S, E, nullptr);
        }
    }
    SEAM(7);
    if (IN(8)) p8_final_norm(p, G);
#undef IN
#undef SEAM
}

static int g_grid = 0;
static void launch_mega(hipStream_t st, const Params& p, int lo, int hi) {
    if (g_grid == 0) {
        int dev = 0, cus = 0, per_cu = 0;
        hipGetDevice(&dev); hipDeviceGetAttribute(&cus, hipDeviceAttributeMultiprocessorCount, dev);
        if (hipFuncSetAttribute((const void*)mega_fwd, hipFuncAttributeMaxDynamicSharedMemorySize, LDS_BYTES) != hipSuccess) { fprintf(stderr, "hipFuncSetAttribute failed\n"); g_grid = -1; return; }
        if (hipOccupancyMaxActiveBlocksPerMultiprocessor(&per_cu, (const void*)mega_fwd, MK_THREADS, LDS_BYTES) != hipSuccess || per_cu < 1) { fprintf(stderr, "occupancy query: %d per CU\n", per_cu); }
        (void)hipGetLastError();
        g_grid = cus;
    }
    if (g_grid < 0) return;
    MegaArgs a{}; a.p = p; a.ph_lo = lo; a.ph_hi = hi;
    hipLaunchKernelGGL(mega_fwd, dim3(g_grid), dim3(MK_THREADS), LDS_BYTES, st, a);
}
template <class Epi> static void gemm_naive(hipStream_t st, const bf16_t* A, int lda, const bf16_t* Bt, int ldb, int M, int N, int K, const Epi& E) {
    hipLaunchKernelGGL((k_gemm_naive<Epi>), dim3(N / 64, M / 64), dim3(256), 0, st, A, lda, Bt, ldb, K, E);
}

static void run_prologue_naive(hipStream_t st, const Params& p) {
    unsigned char* ws = p.ws;
    hipLaunchKernelGGL(k_prep_x, dim3(NTOK), dim3(256), 0, st, p.in[I_X], (bf16_t*)(ws + WS_XB), (float*)(ws + WS_RS0));
    hipLaunchKernelGGL(k_prep_win, dim3((NPROJ * DM + 255) / 256), dim3(256), 0, st, p.in[I_W_IN], p.in[I_ATTN_NORM], (bf16_t*)(ws + WS_WIN));
    hipLaunchKernelGGL(k_transpose_bf16, dim3(DM * DM / 256), dim3(256), 0, st, p.in[I_W_OUT], (const float*)nullptr, (bf16_t*)(ws + WS_WOUT), DM, DM);
    hipLaunchKernelGGL(k_transpose_bf16, dim3(DM * DM / 256), dim3(256), 0, st, p.in[I_PLE_WG], p.in[I_PLE_NORM], (bf16_t*)(ws + WS_WG), DM, DM);
    hipLaunchKernelGGL(k_transpose_bf16, dim3(PLE * DM / 256), dim3(256), 0, st, p.in[I_PLE_PROJ], (const float*)nullptr, (bf16_t*)(ws + WS_WP), PLE, DM);
    hipLaunchKernelGGL(k_transpose_bf16, dim3(2048 * 256 / 256), dim3(256), 0, st, p.in[I_CK_W1], (const float*)nullptr, (bf16_t*)(ws + WS_CW1K), 2048, 256);
    hipLaunchKernelGGL(k_transpose_bf16, dim3(2048 * 256 / 256), dim3(256), 0, st, p.in[I_CV_W1], (const float*)nullptr, (bf16_t*)(ws + WS_CW1V), 2048, 256);
    hipLaunchKernelGGL(k_prep_wqs, dim3(DM * 16), dim3(128), 0, st, p.in[I_PEER_WQ], p.in[I_PEER_SUB], p.in[I_FFN_NORM], (bf16_t*)(ws + WS_WQS));
    hipLaunchKernelGGL(k_cvt_bf16, dim3(2048), dim3(256), 0, st, p.in[I_PEER_U], p.in[I_FFN_NORM], (bf16_t*)(ws + WS_UB), (size_t)16384 * DM / 4, DM);
    hipLaunchKernelGGL(k_cvt_bf16, dim3(2048), dim3(256), 0, st, p.in[I_PEER_V], (const float*)nullptr, (bf16_t*)(ws + WS_VB), (size_t)16384 * DM / 4, DM);
    hipLaunchKernelGGL(k_cvt_bf16, dim3(1024), dim3(256), 0, st, p.in[I_P], (const float*)nullptr, (bf16_t*)(ws + WS_PB), (size_t)NTOK * PLE / 4, PLE);
    hipLaunchKernelGGL(k_prep_cmpbias, dim3(1), dim3(256), 0, st, p.in[I_CK_PE], p.in[I_CK_W1], (float*)(ws + WS_CBK));
    hipLaunchKernelGGL(k_prep_cmpbias, dim3(1), dim3(256), 0, st, p.in[I_CV_PE], p.in[I_CV_W1], (float*)(ws + WS_CBV));
}
static void run_p1_naive(hipStream_t st, const Params& p) {
    unsigned char* ws = p.ws;
    EpiProj E{(const float*)(ws + WS_RS0), (bf16_t*)(ws + R_QB), (bf16_t*)(ws + R_KC), (float*)(ws + R_GATE), (float*)(ws + R_XR), (bf16_t*)(ws + R_XG)};
    gemm_naive(st, (const bf16_t*)(ws + WS_XB), DM, (const bf16_t*)(ws + WS_WIN), DM, NTOK, NPROJ, DM, E);
}
static void run_p2_naive(hipStream_t st, const Params& p) {
    unsigned char* ws = p.ws;
    float* hid = (float*)(ws + WS_HID);
    hipLaunchKernelGGL(k_cmp_hidden, dim3(2048), dim3(256), 0, st, (const bf16_t*)(ws + R_KC), (const bf16_t*)(ws + WS_CW1K), (const float*)(ws + WS_CBK), hid);
    hipLaunchKernelGGL(k_cmp_hidden, dim3(2048), dim3(256), 0, st, (const bf16_t*)(ws + R_VC), (const bf16_t*)(ws + WS_CW1V), (const float*)(ws + WS_CBV), hid + (size_t)2048 * 256);
    hipLaunchKernelGGL(k_cmp_out, dim3(2048), dim3(64), 0, st, (const float*)hid, p.in[I_CK_W2], (float*)(ws + WS_KCMP));
    hipLaunchKernelGGL(k_cmp_out, dim3(2048), dim3(64), 0, st, (const float*)(hid + (size_t)2048 * 256), p.in[I_CV_W2], (float*)(ws + WS_VCMP));
}
static void run_p2_extras(hipStream_t st, const Params& p) {
    unsigned char* ws = p.ws;
    hipLaunchKernelGGL(k_p2_extras, dim3(2048), dim3(256), 0, st, (const bf16_t*)(ws + R_VS), (const bf16_t*)(ws + R_VW), (const float*)(ws + WS_KCMP), (const float*)(ws + WS_VCMP),
                       (bf16_t*)(ws + R_VST), (bf16_t*)(ws + R_VWT), (bf16_t*)(ws + R_KCB), (bf16_t*)(ws + R_VCT));
}
static void run_lru_naive(hipStream_t st, const Params& p) {
    unsigned char* ws = p.ws;
    LruArgs la{(const float*)(ws + R_XR), (const bf16_t*)(ws + R_XG), p.in[I_CONV_W], p.in[I_CONV_B], p.in[I_LRU_WA], p.in[I_LRU_BA], p.in[I_LRU_WX], p.in[I_LRU_BX], p.in[I_LRU_LAM], p.out};
    hipLaunchKernelGGL(k_lru_naive, dim3(NB * 8), dim3(64), 0, st, la);
    hipLaunchKernelGGL(k_grpnorm_lru, dim3(NTOK), dim3(256), 0, st, (const float*)p.out, p.in[I_GN_LRU], (bf16_t*)(ws + WS_XB));
}
static void run_p3_naive(hipStream_t st, const Params& p) {
    unsigned char* ws = p.ws;
    NsaArgs na{(const bf16_t*)(ws + R_QB), (const bf16_t*)(ws + R_KS), (const bf16_t*)(ws + R_VS), (const bf16_t*)(ws + R_KW), (const bf16_t*)(ws + R_VW),
               (const float*)(ws + WS_KCMP), (const float*)(ws + WS_VCMP), (const float*)(ws + R_GATE), p.in[I_REL], p.out};
    hipLaunchKernelGGL(k_nsa_naive, dim3(NB * NKV * T_), dim3(256), 0, st, na);
    LruArgs la{(const float*)(ws + R_XR), (const bf16_t*)(ws + R_XG), p.in[I_CONV_W], p.in[I_CONV_B], p.in[I_LRU_WA], p.in[I_LRU_BA], p.in[I_LRU_WX], p.in[I_LRU_BX], p.in[I_LRU_LAM], p.out};
    hipLaunchKernelGGL(k_lru_naive, dim3(NB * 8), dim3(64), 0, st, la);
    hipLaunchKernelGGL(k_grpnorm, dim3(NTOK), dim3(256), 0, st, (const float*)p.out, p.in[I_GN_ATTN], p.in[I_GN_LRU], (bf16_t*)(ws + WS_XB));
}
static void run_p4_naive(hipStream_t st, const Params& p) {
    unsigned char* ws = p.ws;
    EpiOut E{p.in[I_X], p.out, (bf16_t*)(ws + R_H1B)};
    gemm_naive(st, (const bf16_t*)(ws + WS_XB), DM, (const bf16_t*)(ws + WS_WOUT), DM, NTOK, DM, DM, E);
    hipLaunchKernelGGL(k_rowssq, dim3(NTOK), dim3(256), 0, st, (const float*)p.out, (float*)(ws + WS_SSQ1));
}
static void run_p5_naive(hipStream_t st, const Params& p) {
    unsigned char* ws = p.ws;
    for (int hh = 0; hh < 2; ++hh) {
        EpiF32Plain E{(float*)(ws + R_BIG), 1024, 0};
        gemm_naive(st, (const bf16_t*)(ws + R_H1B), DM, (const bf16_t*)(ws + WS_WQS) + (size_t)hh * 1024 * DM, DM, NTOK, 1024, DM, E);
        hipLaunchKernelGGL(k_peer_route, dim3(NTOK * 4), dim3(256), 0, st, (const float*)(ws + R_BIG), (const float*)(ws + WS_SSQ1), hh, (int*)(ws + R_EXP), (float*)(ws + R_GSM));
    }
}
static void run_p6_naive(hipStream_t st, const Params& p) {
    unsigned char* ws = p.ws;
    hipLaunchKernelGGL(k_peer_apply, dim3(NTOK), dim3(256), 0, st, (const bf16_t*)(ws + WS_UB), (const bf16_t*)(ws + WS_VB), (const int*)(ws + R_EXP), (const float*)(ws + R_GSM),
                       (const float*)(ws + WS_SSQ1), p.out, (bf16_t*)(ws + R_H1B), (float*)(ws + WS_RS2));
}
static void run_p7_naive(hipStream_t st, const Params& p) {
    unsigned char* ws = p.ws;
    EpiF32Plain Ep{(float*)(ws + R_BIG), DM, 0};
    gemm_naive(st, (const bf16_t*)(ws + WS_PB), PLE, (const bf16_t*)(ws + WS_WP), PLE, NTOK, DM, PLE, Ep);
    EpiGate Eg{(const float*)(ws + WS_RS2), p.in[I_PLE_BG], (const float*)(ws + R_BIG), p.out};
    gemm_naive(st, (const bf16_t*)(ws + R_H1B), DM, (const bf16_t*)(ws + WS_WG), DM, NTOK, DM, DM, Eg);
    hipLaunchKernelGGL(k_rowssq, dim3(NTOK), dim3(256), 0, st, (const float*)p.out, (float*)(ws + WS_SSQ3));
}
static void run_p8_naive(hipStream_t st, const Params& p) {
    hipLaunchKernelGGL(k_final_norm, dim3(NTOK), dim3(256), 0, st, p.out, (const float*)(p.ws + WS_SSQ3), p.in[I_FINAL_NORM]);
}
static void run_phase(hipStream_t st, const Params& p, int k) {
    switch (k) {
        case 0: run_prologue_naive(st, p); break;
        case 1: run_p1_naive(st, p); break;
        case 2: run_p2_naive(st, p); if ((OPT_MASK >> 3) & 1) run_p2_extras(st, p); break;
        case 3: run_p3_naive(st, p); break;
        case 4: run_p4_naive(st, p); break;
        case 5: run_p5_naive(st, p); break;
        case 6: run_p6_naive(st, p); break;
        case 7: run_p7_naive(st, p); break;
        case 8: run_p8_naive(st, p); break;
    }
}
extern "C" void kernel_launch(void* const* d_in, const int* in_sizes, int n_in, void* d_out, int out_size, void* d_ws, size_t ws_size, hipStream_t stream) {
    if (n_in != 31 || out_size != NTOK * DM || ws_size < WS_END) { fprintf(stderr, "kernel_launch: unexpected shapes (n_in %d out %d ws %zu)\n", n_in, out_size, ws_size); return; }
    Params p{};
    for (int i = 0; i < 31; ++i) p.in[i] = (const float*)d_in[i];
    p.out = (float*)d_out; p.ws = (unsigned char*)d_ws;
    int k = 0;
    while (k <= 8) {
        if ((OPT_MASK >> k) & 1) {
            int e = k; while (e <= 8 && ((OPT_MASK >> e) & 1)) ++e;
            if (LRU_NAIVE && k <= 3 && e > 4) e = 4;
            if (CMP_NAIVE && k <= 1 && e > 2) e = 2;
            if (CMP_NAIVE && k == 2) { run_p2_naive(stream, p); run_p2_extras(stream, p); }
            if (e - k > 1) hipMemsetAsync((char*)d_ws + WS_CTL, 0, XCD_BAR_WORDS * 4, stream);
            launch_mega(stream, p, k, e);
            if (LRU_NAIVE && k <= 3 && e == 4) run_lru_naive(stream, p);
            k = e;
        } else { run_phase(stream, p, k); ++k; }
    }
}
```

```cpp
#include <hip/hip_runtime.h>
#include <stdint.h>
#include <stdio.h>

typedef unsigned short bf16_t;
typedef float f32x4 __attribute__((ext_vector_type(4)));
typedef float f32x2 __attribute__((ext_vector_type(2)));
typedef unsigned u32x4 __attribute__((ext_vector_type(4)));
typedef unsigned u32x2 __attribute__((ext_vector_type(2)));
#define DI __device__ __forceinline__

constexpr int NB = 4, T_ = 4096, DM = 1024, NTOK = NB * T_;
constexpr int NH = 8, HD = 64, NKV = 2, GRP = 4, ATTW = 512, KVW = 128, LRUW = 512;
constexpr int INCOLS = 2328, NPROJ = 2560;
constexpr int NCMP = 255, NSEL = 64;
constexpr int PEER_H = 8, PEER_K = 16, PEER_NK = 128;
constexpr int PLE = 256;
constexpr float EPS = 1e-6f;

constexpr int PC_KV = 512, PC_XR = 1280, PC_XG = 1792, PC_GATE = 2304;

constexpr size_t MB = 1024 * 1024;
constexpr size_t WS_CTL   = 0;
constexpr size_t WS_WIN   = 64 * 1024;
constexpr size_t WS_WOUT  = WS_WIN  + (size_t)NPROJ * DM * 2;
constexpr size_t WS_WQS   = WS_WOUT + (size_t)DM * DM * 2;
constexpr size_t WS_WG    = WS_WQS  + (size_t)2048 * DM * 2;
constexpr size_t WS_WP    = WS_WG   + (size_t)DM * DM * 2;
constexpr size_t WS_CW1K  = WS_WP   + (size_t)DM * PLE * 2;
constexpr size_t WS_CW1V  = WS_CW1K + (size_t)256 * 2048 * 2;
constexpr size_t WS_CBK   = WS_CW1V + (size_t)256 * 2048 * 2;
constexpr size_t WS_CBV   = WS_CBK  + 1024;
constexpr size_t WS_RS0   = WS_CBV  + 1024;
constexpr size_t WS_RS2   = WS_RS0  + (size_t)NTOK * 4;
constexpr size_t WS_RS1   = WS_RS2  + (size_t)NTOK * 4;
constexpr size_t WS_SSQ2  = WS_RS1  + (size_t)NTOK * 4;
constexpr size_t WS_SSQ1  = WS_SSQ2 + (size_t)16 * NTOK * 4;
constexpr size_t WS_SSQ3  = WS_SSQ1 + (size_t)16 * NTOK * 4;
constexpr size_t WS_KCMP  = WS_SSQ3 + (size_t)16 * NTOK * 4;
constexpr size_t WS_VCMP  = WS_KCMP + (size_t)8 * 256 * 64 * 4;
constexpr size_t WS_LRUP  = WS_VCMP + (size_t)8 * 256 * 64 * 4;
constexpr size_t WS_LRUH  = WS_LRUP + (size_t)256 * 512 * 4;
constexpr size_t WS_WAT   = WS_LRUH + (size_t)256 * 512 * 4;
constexpr size_t WS_WXT   = WS_WAT + 8 * 64 * 64 * 2;
constexpr size_t WS_CW2K  = WS_WXT + 8 * 64 * 64 * 2;
constexpr size_t WS_CW2V  = WS_CW2K + 64 * 256 * 2;
constexpr size_t WS_HID   = WS_CW2V + 64 * 256 * 2;
constexpr size_t WS_UB    = (WS_HID + (size_t)2 * 2048 * 256 * 4 + 4095) / 4096 * 4096;
constexpr size_t WS_VB    = WS_UB + (size_t)16384 * DM * 2;
constexpr size_t WS_PB    = WS_VB + (size_t)16384 * DM * 2;
constexpr size_t WS_XB    = WS_PB + (size_t)NTOK * PLE * 2;
constexpr size_t WS_R     = WS_XB + (size_t)NTOK * DM * 2;
constexpr size_t KVT = (size_t)NB * NKV * T_ * HD * 2 + 65536;
constexpr size_t R_QB    = WS_R;
constexpr size_t R_KC    = R_QB + (size_t)NTOK * 512 * 2;
constexpr size_t R_VC    = R_KC + KVT;
constexpr size_t R_KS    = R_VC + KVT;
constexpr size_t R_VS    = R_KS + KVT;
constexpr size_t R_KW    = R_VS + KVT;
constexpr size_t R_VW    = R_KW + KVT;
constexpr size_t R_GATE  = R_VW + KVT;
constexpr size_t R_XR    = R_GATE + (size_t)NTOK * 24 * 4;
constexpr size_t R_XG    = R_XR + (size_t)NTOK * 512 * 4;
constexpr size_t R_VST   = R_XG + (size_t)NTOK * 512 * 2;
constexpr size_t R_VWT   = R_VST + KVT;
constexpr size_t R_KCB   = R_VWT + KVT;
constexpr size_t R_VCT   = R_KCB + (size_t)8 * 256 * 64 * 2;
constexpr size_t R_END13 = R_VCT + (size_t)8 * 256 * 64 * 2;
constexpr size_t R_H1B   = WS_R;
constexpr size_t R_EXP   = R_H1B + (size_t)NTOK * DM * 2;
constexpr size_t R_GSM   = R_EXP + (size_t)NTOK * 128 * 4;
constexpr size_t R_COEF  = R_GSM + (size_t)NTOK * 128 * 4;
constexpr size_t R_BIG   = R_COEF + (size_t)NTOK * 128 * 4;
constexpr size_t WS_END  = (R_END13 > R_BIG + 64 * MB ? R_END13 : R_BIG + 64 * MB);
static_assert(WS_END <= 256 * MB, "workspace map exceeds 256 MiB");

DI float bf2f(bf16_t v) { return __uint_as_float((unsigned)v << 16); }
DI bf16_t f2bf(float x) { unsigned u = __float_as_uint(x); u += 0x7fffu + ((u >> 16) & 1u); return (bf16_t)(u >> 16); }
DI unsigned pack2bf(float lo, float hi) { return (unsigned)f2bf(lo) | ((unsigned)f2bf(hi) << 16); }
DI float gelu_tanh(float x) { const float u = 0.7978845608028654f * (x + 0.044715f * x * x * x); return 0.5f * x * (1.0f + tanhf(u)); }
DI float sigmoidf_(float x) { return 1.0f / (1.0f + __expf(-x)); }

__device__ const unsigned char REL_BUCKET_LUT[128] = {
0,1,2,3,4,5,6,7,8,9,10,11,12,13,14,15,16,16,16,17,17,18,18,18,19,19,19,20,20,20,20,21,21,21,21,22,22,22,22,22,23,23,23,23,23,23,24,24,24,24,24,24,25,25,25,25,25,25,25,26,26,26,26,26,26,26,26,27,27,27,27,27,27,27,27,27,27,28,28,28,28,28,28,28,28,28,28,29,29,29,29,29,29,29,29,29,29,29,29,30,30,30,30,30,30,30,30,30,30,30,30,30,30,31,31,31,31,31,31,31,31,31,31,31,31,31,31,31};
DI int rel_bucket(int dist) { dist = dist < 0 ? 0 : dist; return dist >= 128 ? 31 : (int)REL_BUCKET_LUT[dist]; }

struct Params {
    const float* in[31];
    float* out;
    unsigned char* ws;
};
enum { I_X = 0, I_P, I_ATTN_NORM, I_W_IN, I_CK_PE, I_CK_W1, I_CK_W2, I_CV_PE, I_CV_W1, I_CV_W2, I_REL, I_CONV_W, I_CONV_B, I_LRU_WA, I_LRU_BA, I_LRU_WX, I_LRU_BX,
       I_LRU_LAM, I_GN_ATTN, I_GN_LRU, I_W_OUT, I_FFN_NORM, I_PEER_WQ, I_PEER_SUB, I_PEER_U, I_PEER_V, I_PLE_NORM, I_PLE_WG, I_PLE_BG, I_PLE_PROJ, I_FINAL_NORM };

struct EpiProj {
    const float* rs0; bf16_t* qb; bf16_t* kv0; float* gates; float* xr; bf16_t* xg;
    DI void store4(int row, int col, f32x4 v) const {
        const float s = rs0[row];
        v *= s;
        if (col < PC_KV) { v *= 0.125f; u32x2 w; w.x = pack2bf(v[0], v[1]); w.y = pack2bf(v[2], v[3]); *(u32x2*)(qb + (size_t)row * 512 + col) = w; }
        else if (col < PC_XR) {
            const int c = col - PC_KV, tensor = c >> 7, within = c & 127, kvh = within >> 6, d = within & 63, b = row >> 12, t = row & 4095;
            bf16_t* dst = (bf16_t*)((unsigned char*)kv0 + (size_t)tensor * KVT) + ((size_t)(b * NKV + kvh) * T_ + t) * HD + d;
            u32x2 w; w.x = pack2bf(v[0], v[1]); w.y = pack2bf(v[2], v[3]); *(u32x2*)dst = w;
        }
        else if (col < PC_XG) { *(f32x4*)(xr + (size_t)row * 512 + (col - PC_XR)) = v; }
        else if (col < PC_GATE) { u32x2 w; w.x = pack2bf(v[0], v[1]); w.y = pack2bf(v[2], v[3]); *(u32x2*)(xg + (size_t)row * 512 + (col - PC_XG)) = w; }
        else if (col < PC_GATE + 24) { *(f32x4*)(gates + (size_t)row * 24 + (col - PC_GATE)) = v; }
    }
};
struct EpiOut {
    const float* x; float* h1; bf16_t* h1b;
    DI void store4(int row, int col, f32x4 v) const {
        const size_t o = (size_t)row * DM + col;
        v += *(const f32x4*)(x + o);
        *(f32x4*)(h1 + o) = v;
        u32x2 w; w.x = pack2bf(v[0], v[1]); w.y = pack2bf(v[2], v[3]); *(u32x2*)(h1b + o) = w;
    }
};
struct EpiF32Plain { float* C; int ldc; int coloff;
    DI void store4(int row, int col, f32x4 v) const { *(f32x4*)(C + (size_t)row * ldc + (col - coloff)) = v; } };
struct EpiGate {
    const float* rs2; const float* bias; const float* pp; float* h;
    DI void store4(int row, int col, f32x4 v) const {
        const size_t o = (size_t)row * DM + col;
        const float s = rs2[row];
        const f32x4 bb = *(const f32x4*)(bias + col), p4 = *(const f32x4*)(pp + o);
        f32x4 hv = *(f32x4*)(h + o);
#pragma unroll
        for (int j = 0; j < 4; ++j) hv[j] += sigmoidf_(v[j] * s + bb[j]) * p4[j];
        *(f32x4*)(h + o) = hv;
    }
};
#ifndef LRU_NAIVE
#define LRU_NAIVE 0
#endif
#ifndef CMP_NAIVE
#define CMP_NAIVE 0
#endif
#ifndef OPT_MASK
#define OPT_MASK 0x1FF
#endif
#ifndef PEER_V6
#define PEER_V6 1
#endif
#ifndef PEER_V3
#define PEER_V3 1
#endif
#ifndef PEER_V2
#define PEER_V2 1
#endif
DI float wave_sum(float v) {
#pragma unroll
    for (int o = 32; o > 0; o >>= 1) v += __shfl_xor(v, o);
    return v;
}
DI float wave_max(float v) {
#pragma unroll
    for (int o = 32; o > 0; o >>= 1) v = fmaxf(v, __shfl_xor(v, o));
    return v;
}
DI float block_sum256(float v, float* red) {
    v = wave_sum(v); __syncthreads();
    if ((threadIdx.x & 63) == 0) red[threadIdx.x >> 6] = v; __syncthreads();
    return (red[0] + red[1]) + (red[2] + red[3]);
}
DI float block_max256(float v, float* red) {
    v = wave_max(v); __syncthreads();
    if ((threadIdx.x & 63) == 0) red[threadIdx.x >> 6] = v; __syncthreads();
    return fmaxf(fmaxf(red[0], red[1]), fmaxf(red[2], red[3]));
}

__global__ __launch_bounds__(256) void k_prep_x(const float* __restrict__ x, bf16_t* __restrict__ xb, float* __restrict__ rs0) {
    __shared__ float red[8];
    const int row = blockIdx.x, t = threadIdx.x;
    const f32x4 v = *(const f32x4*)(x + (size_t)row * DM + t * 4);
    float s = v[0] * v[0] + v[1] * v[1] + v[2] * v[2] + v[3] * v[3];
    s = block_sum256(s, red);
    u32x2 w; w.x = pack2bf(v[0], v[1]); w.y = pack2bf(v[2], v[3]);
    *(u32x2*)(xb + (size_t)row * DM + t * 4) = w;
    if (t == 0) rs0[row] = rsqrtf(s * (1.0f / DM) + EPS);
}
__global__ void k_prep_win(const float* __restrict__ w_in, const float* __restrict__ gain, bf16_t* __restrict__ WinT) {
    const int idx = blockIdx.x * blockDim.x + threadIdx.x;
    if (idx >= NPROJ * DM) return;
    const int n = idx / DM, k = idx % DM;
    int src = -1;
    if (n < PC_XR) src = n; else if (n < PC_XG) src = 1304 + (n - PC_XR); else if (n < PC_GATE) src = 1816 + (n - PC_XG); else if (n < PC_GATE + 24) src = 1280 + (n - PC_GATE);
    WinT[idx] = src >= 0 ? f2bf(w_in[(size_t)k * INCOLS + src] * gain[k]) : (bf16_t)0;
}
__global__ void k_transpose_bf16(const float* __restrict__ src, const float* __restrict__ gain, bf16_t* __restrict__ dst, int K, int N) {
    const int idx = blockIdx.x * blockDim.x + threadIdx.x;
    if (idx >= K * N) return;
    const int n = idx / K, k = idx % K;
    dst[idx] = f2bf(src[(size_t)k * N + n] * (gain ? gain[k] : 1.0f));
}
__global__ __launch_bounds__(128) void k_prep_wqs(const float* __restrict__ wq, const float* __restrict__ sub, const float* __restrict__ gain, bf16_t* __restrict__ WqsT) {
    __shared__ float wrow[128];
    const int d = blockIdx.x % DM, hp = blockIdx.x / DM, p = hp & 1, kk = threadIdx.x;
    wrow[kk] = wq[(size_t)d * 2048 + hp * 128 + kk];
    __syncthreads();
    const float* sk = sub + ((size_t)p * 128 + kk) * 128;
    float acc = 0.f;
    for (int j = 0; j < 128; ++j) acc += wrow[j] * sk[j];
    WqsT[(size_t)(hp * 128 + kk) * DM + d] = f2bf(acc * gain[d]);
}
__global__ void k_cvt_bf16(const float* __restrict__ src, const float* __restrict__ gain, bf16_t* __restrict__ dst, size_t n4, int cols) {
    for (size_t i = (size_t)blockIdx.x * blockDim.x + threadIdx.x; i < n4; i += (size_t)gridDim.x * blockDim.x) {
        f32x4 v = *(const f32x4*)(src + i * 4);
        if (gain) { const f32x4 g = *(const f32x4*)(gain + (i * 4) % cols); v *= g; }
        u32x2 w; w.x = pack2bf(v[0], v[1]); w.y = pack2bf(v[2], v[3]);
        *(u32x2*)(dst + i * 4) = w;
    }
}
__global__ __launch_bounds__(256) void k_prep_cmpbias(const float* __restrict__ pe, const float* __restrict__ w1, float* __restrict__ cb) {
    const int j = threadIdx.x; float acc = 0.f;
    for (int k = 0; k < 2048; ++k) acc += pe[k] * w1[(size_t)k * 256 + j];
    cb[j] = acc;
}

template <class Epi>
__global__ __launch_bounds__(256) void k_gemm_naive(const bf16_t* __restrict__ A, int lda, const bf16_t* __restrict__ Bt, int ldb, int K, Epi E) {
    __shared__ float As[32][68], Bs[32][68];
    const int t = threadIdx.x, tx = t & 15, ty = t >> 4;
    const int row0 = blockIdx.y * 64, col0 = blockIdx.x * 64;
    float acc[4][4] = {};
    const int lr = t >> 2, lk = (t & 3) * 8;
    for (int k0 = 0; k0 < K; k0 += 32) {
        const u32x4 av = *(const u32x4*)(A + (size_t)(row0 + lr) * lda + k0 + lk);
        const u32x4 bv = *(const u32x4*)(Bt + (size_t)(col0 + lr) * ldb + k0 + lk);
        __syncthreads();
#pragma unroll
        for (int j = 0; j < 4; ++j) {
            As[lk + 2 * j][lr] = __uint_as_float(av[j] << 16); As[lk + 2 * j + 1][lr] = __uint_as_float(av[j] & 0xffff0000u);
            Bs[lk + 2 * j][lr] = __uint_as_float(bv[j] << 16); Bs[lk + 2 * j + 1][lr] = __uint_as_float(bv[j] & 0xffff0000u);
        }
        __syncthreads();
#pragma unroll
        for (int k = 0; k < 32; ++k) {
            const f32x4 a = *(const f32x4*)&As[k][ty * 4], b = *(const f32x4*)&Bs[k][tx * 4];
#pragma unroll
            for (int i = 0; i < 4; ++i)
#pragma unroll
                for (int j = 0; j < 4; ++j) acc[i][j] += a[i] * b[j];
        }
    }
#pragma unroll
    for (int i = 0; i < 4; ++i) E.store4(row0 + ty * 4 + i, col0 + tx * 4, (f32x4){acc[i][0], acc[i][1], acc[i][2], acc[i][3]});
}

__global__ __launch_bounds__(256) void k_cmp_hidden(const bf16_t* __restrict__ kvb, const bf16_t* __restrict__ W1T, const float* __restrict__ cb, float* __restrict__ hidden) {
    const int row = blockIdx.x, j = threadIdx.x, bh = row >> 8, c = row & 255;
    if (c >= NCMP) { hidden[(size_t)row * 256 + j] = 0.f; return; }
    const bf16_t* a = kvb + ((size_t)bh * T_ + 16 * c) * HD;
    const bf16_t* w = W1T + (size_t)j * 2048;
    float acc = 0.f;
    for (int k = 0; k < 2048; ++k) acc += bf2f(a[k]) * bf2f(w[k]);
    hidden[(size_t)row * 256 + j] = acc + cb[j];
}
__global__ __launch_bounds__(64) void k_cmp_out(const float* __restrict__ hidden, const float* __restrict__ w2, float* __restrict__ out) {
    const int row = blockIdx.x, d = threadIdx.x;
    float acc = 0.f;
    for (int j = 0; j < 256; ++j) acc += gelu_tanh(hidden[(size_t)row * 256 + j]) * w2[j * 64 + d];
    out[(size_t)row * 64 + d] = acc;
}

struct NsaArgs { const bf16_t* qb; const bf16_t* ks; const bf16_t* vs; const bf16_t* kw; const bf16_t* vw; const float* kcmp; const float* vcmp; const float* gates; const float* rel; float* raw; };
template <bool KF32> DI void nsa_logits(int nk, const void* Kbase, const int* kp, const int* dist, float (*lg)[1024], const float (*qs)[64], const float* rel, int kvh) {
    for (int idx = threadIdx.x; idx < nk; idx += 256) {
        float acc[4] = {0.f, 0.f, 0.f, 0.f};
        if (dist[idx] >= 0) {
            if (KF32) { const float* kr = (const float*)Kbase + (size_t)kp[idx] * HD;
                for (int d = 0; d < 64; ++d) { const float kv = kr[d]; for (int g = 0; g < 4; ++g) acc[g] += qs[g][d] * kv; } }
            else { const bf16_t* kr = (const bf16_t*)Kbase + (size_t)kp[idx] * HD;
                for (int d = 0; d < 64; ++d) { const float kv = bf2f(kr[d]); for (int g = 0; g < 4; ++g) acc[g] += qs[g][d] * kv; } }
            const int bk = rel_bucket(dist[idx]);
            for (int g = 0; g < 4; ++g) lg[g][idx] = acc[g] + rel[bk * NH + kvh * 4 + g];
        } else { for (int g = 0; g < 4; ++g) lg[g][idx] = -INFINITY; }
    }
}
DI void nsa_softmax(int nk, float (*lg)[1024], float* inv, float* red) {
    for (int g = 0; g < 4; ++g) {
        float m = -INFINITY;
        for (int idx = threadIdx.x; idx < nk; idx += 256) m = fmaxf(m, lg[g][idx]);
        m = block_max256(m, red);
        float s = 0.f;
        for (int idx = threadIdx.x; idx < nk; idx += 256) { const float l = lg[g][idx]; const float e = (l == -INFINITY) ? 0.f : __expf(l - m); lg[g][idx] = e; s += e; }
        s = block_sum256(s, red);
        if (threadIdx.x == 0) inv[g] = 1.0f / s;
    }
    __syncthreads();
}
template <bool VF32> DI float nsa_pv(int nk, const void* Vbase, const int* kp, const float (*lg)[1024], const float* inv) {
    const int g = threadIdx.x >> 6, d = threadIdx.x & 63;
    float acc = 0.f;
    for (int idx = 0; idx < nk; ++idx) {
        const float v = VF32 ? ((const float*)Vbase)[(size_t)kp[idx] * HD + d] : bf2f(((const bf16_t*)Vbase)[(size_t)kp[idx] * HD + d]);
        acc += lg[g][idx] * v;
    }
    return acc * inv[g];
}
__global__ __launch_bounds__(256) void k_nsa_naive(NsaArgs a) {
    __shared__ float qs[4][64]; __shared__ float lg[4][1024]; __shared__ int kp[1024]; __shared__ int dist[1024];
    __shared__ float red[8]; __shared__ float inv[4]; __shared__ float imp[64]; __shared__ float vals[64]; __shared__ int selblk[16]; __shared__ int nsel_s;
    const int tid = threadIdx.x, t = blockIdx.x % T_, kvh = (blockIdx.x / T_) % NKV, b = blockIdx.x / (T_ * NKV), bh = b * NKV + kvh;
    const int g = tid >> 6, d = tid & 63, h = kvh * 4 + g;
    const size_t tok = (size_t)b * T_ + t;
    qs[g][d] = bf2f(a.qb[tok * 512 + h * 64 + d]);
    if (tid == 0) nsel_s = 0;
    const int ncv = t >= 31 ? (t - 31) / 16 + 1 : 0;
    for (int idx = tid; idx < ncv; idx += 256) { kp[idx] = idx; dist[idx] = t - (16 * idx + 31); }
    __syncthreads();
    float o_c = 0.f;
    if (ncv > 0) {
        nsa_logits<true>(ncv, a.kcmp + (size_t)bh * 256 * HD, kp, dist, lg, qs, a.rel, kvh);
        __syncthreads();
        nsa_softmax(ncv, lg, inv, red);
        o_c = nsa_pv<true>(ncv, a.vcmp + (size_t)bh * 256 * HD, kp, lg, inv);
    }
    if (tid < 64) {
        float s = 0.f;
        for (int gg = 0; gg < 4; ++gg) {
            float sg = 0.f;
            for (int j = -1; j <= 3; ++j) { const int c = 4 * tid + j; if (c >= 0 && c < ncv) sg += lg[gg][c] * ((j == -1 || j == 3) ? 0.5f : 1.0f); }
            s += sg * inv[gg];
        }
        if (ncv == 0) s = 0.f;
        const int qblk = t >> 6, db = qblk - tid;
        vals[tid] = (db >= 0 && db < 2) ? 2.0e4f : (tid == 0 ? 1.0e4f : (db >= 0 ? s : -1.0f));
    }
    __syncthreads();
    if (tid < 64) {
        const float v = vals[tid]; int rank = 0;
        for (int s2 = 0; s2 < 64; ++s2) { const float w = vals[s2]; rank += (w > v || (w == v && s2 < tid)) ? 1 : 0; }
        if (rank < 16 && (t >> 6) - tid >= 0) { const int slot = atomicAdd(&nsel_s, 1); selblk[slot] = tid; }
    }
    __syncthreads();
    const int nsel = nsel_s, nks = nsel * 64;
    for (int idx = tid; idx < nks; idx += 256) { const int kpos = selblk[idx >> 6] * 64 + (idx & 63); kp[idx] = kpos; dist[idx] = t - kpos; }
    __syncthreads();
    nsa_logits<false>(nks, a.ks + (size_t)bh * T_ * HD, kp, dist, lg, qs, a.rel, kvh);
    __syncthreads();
    nsa_softmax(nks, lg, inv, red);
    const float o_s = nsa_pv<false>(nks, a.vs + (size_t)bh * T_ * HD, kp, lg, inv);
    __syncthreads();
    const int lo = t - 511 > 0 ? t - 511 : 0, nkw = t - lo + 1;
    for (int idx = tid; idx < nkw; idx += 256) { kp[idx] = lo + idx; dist[idx] = t - (lo + idx); }
    __syncthreads();
    nsa_logits<false>(nkw, a.kw + (size_t)bh * T_ * HD, kp, dist, lg, qs, a.rel, kvh);
    __syncthreads();
    nsa_softmax(nkw, lg, inv, red);
    const float o_w = nsa_pv<false>(nkw, a.vw + (size_t)bh * T_ * HD, kp, lg, inv);
    const float* gt = a.gates + tok * 24 + h * 3;
    a.raw[tok * DM + h * 64 + d] = sigmoidf_(gt[0]) * o_c + sigmoidf_(gt[1]) * o_s + sigmoidf_(gt[2]) * o_w;
}

struct LruArgs { const float* xr; const bf16_t* xg; const float* conv_w; const float* conv_b; const float* wa; const float* ba; const float* wx; const float* bx; const float* lam; float* raw; };
__global__ __launch_bounds__(64) void k_lru_naive(LruArgs a) {
    __shared__ float xs[64];
    const int tid = threadIdx.x, n = blockIdx.x & 7, b = blockIdx.x >> 3, ch = n * 64 + tid;
    float war[64], wxr[64];
#pragma unroll
    for (int c = 0; c < 64; ++c) { war[c] = a.wa[(size_t)(n * 64 + c) * 64 + tid]; wxr[c] = a.wx[(size_t)(n * 64 + c) * 64 + tid]; }
    const float cw0 = a.conv_w[0 * 512 + ch], cw1 = a.conv_w[1 * 512 + ch], cw2 = a.conv_w[2 * 512 + ch], cw3 = a.conv_w[3 * 512 + ch], cb = a.conv_b[ch];
    const float ba = a.ba[ch], bx = a.bx[ch], sp = log1pf(__expf(-a.lam[ch]));
    float x3 = 0.f, x2 = 0.f, x1 = 0.f, h = 0.f;
    for (int t = 0; t < T_; ++t) {
        const size_t tok = (size_t)b * T_ + t;
        const float x0 = a.xr[tok * 512 + ch];
        const float xc = cw0 * x3 + cw1 * x2 + cw2 * x1 + cw3 * x0 + cb;
        x3 = x2; x2 = x1; x1 = x0;
        __syncthreads();
        xs[tid] = xc;
        __syncthreads();
        float rp = 0.f, ip = 0.f;
#pragma unroll
        for (int c = 0; c < 64; ++c) { const float xv = xs[c]; rp += xv * war[c]; ip += xv * wxr[c]; }
        const float r = sigmoidf_(rp + ba), i = sigmoidf_(ip + bx);
        const float log_a = -8.0f * r * sp, aa = __expf(log_a), bb = sqrtf(-expm1f(2.0f * log_a)) * (i * xc);
        h = aa * h + bb;
        a.raw[tok * DM + 512 + ch] = h * gelu_tanh(bf2f(a.xg[tok * 512 + ch]));
    }
}
__global__ __launch_bounds__(256) void k_grpnorm(const float* __restrict__ raw, const float* __restrict__ ga, const float* __restrict__ gl, bf16_t* __restrict__ mixed) {
    __shared__ float red[8];
    const int row = blockIdx.x, t = threadIdx.x;
    const f32x4 v = *(const f32x4*)(raw + (size_t)row * DM + t * 4);
    const float s = v[0] * v[0] + v[1] * v[1] + v[2] * v[2] + v[3] * v[3];
    const float sa = block_sum256(t < 128 ? s : 0.f, red);
    const float sl = block_sum256(t < 128 ? 0.f : s, red);
    const float rs = rsqrtf((t < 128 ? sa : sl) * (1.0f / 512) + EPS);
    const f32x4 g = t < 128 ? *(const f32x4*)(ga + t * 4) : *(const f32x4*)(gl + (t - 128) * 4);
    u32x2 w; w.x = pack2bf(v[0] * rs * g[0], v[1] * rs * g[1]); w.y = pack2bf(v[2] * rs * g[2], v[3] * rs * g[3]);
    *(u32x2*)(mixed + (size_t)row * DM + t * 4) = w;
}
__global__ __launch_bounds__(256) void k_rowssq(const float* __restrict__ h, float* __restrict__ ssq) {
    __shared__ float red[8];
    const int row = blockIdx.x, t = threadIdx.x;
    const f32x4 v = *(const f32x4*)(h + (size_t)row * DM + t * 4);
    float s = v[0] * v[0] + v[1] * v[1] + v[2] * v[2] + v[3] * v[3];
    s = block_sum256(s, red);
    if (t < 16) ssq[(size_t)t * NTOK + row] = t == 0 ? s : 0.f;
}

DI float rs_from_ssq(const float* ssq, int row) { float s = 0.f; for (int j = 0; j < 16; ++j) s += ssq[(size_t)j * NTOK + row]; return rsqrtf(s * (1.0f / DM) + EPS); }
__global__ __launch_bounds__(256) void k_peer_route(const float* __restrict__ scores, const float* __restrict__ ssq1, int hh, int* __restrict__ eout, float* __restrict__ gout) {
    __shared__ float s[256]; __shared__ float tv[2][16]; __shared__ int ti[2][16]; __shared__ float cand[256]; __shared__ float scs[16]; __shared__ int es[16];
    const int tid = threadIdx.x, tok = blockIdx.x >> 2, hl = blockIdx.x & 3, h = hh * 4 + hl;
    const float rs1 = rs_from_ssq(ssq1, tok);
    s[tid] = scores[(size_t)tok * 1024 + hl * 256 + tid] * rs1;
    __syncthreads();
    { const int p = tid >> 7, k = tid & 127; const float v = s[tid]; int rank = 0;
      for (int j = 0; j < 128; ++j) { const float w = s[p * 128 + j]; rank += (w > v || (w == v && j < k)) ? 1 : 0; }
      if (rank < 16) { tv[p][rank] = v; ti[p][rank] = k; } }
    __syncthreads();
    cand[tid] = tv[0][tid >> 4] + tv[1][tid & 15];
    __syncthreads();
    { const float v = cand[tid]; int rank = 0;
      for (int j = 0; j < 256; ++j) { const float w = cand[j]; rank += (w > v || (w == v && j < tid)) ? 1 : 0; }
      if (rank < 16) { scs[rank] = v; es[rank] = ti[0][tid >> 4] * 128 + ti[1][tid & 15]; } }
    __syncthreads();
    if (tid < 16) {
        float m = -INFINITY; for (int j = 0; j < 16; ++j) m = fmaxf(m, scs[j]);
        float sum = 0.f; for (int j = 0; j < 16; ++j) sum += __expf(scs[j] - m);
        eout[(size_t)tok * 128 + h * 16 + tid] = es[tid];
        gout[(size_t)tok * 128 + h * 16 + tid] = __expf(scs[tid] - m) / sum;
    }
}
__global__ __launch_bounds__(256) void k_peer_apply(const bf16_t* __restrict__ ub, const bf16_t* __restrict__ vb, const int* __restrict__ e, const float* __restrict__ gsm,
                                                    const float* __restrict__ ssq1, float* __restrict__ h, bf16_t* __restrict__ hb, float* __restrict__ rs2) {
    __shared__ float xrow[DM]; __shared__ float coef[128]; __shared__ int eid[128]; __shared__ float red[8];
    const int tid = threadIdx.x, tok = blockIdx.x, lane = tid & 63, w = tid >> 6;
    const float rs1 = rs_from_ssq(ssq1, tok);
    for (int i = tid; i < DM; i += 256) xrow[i] = bf2f(hb[(size_t)tok * DM + i]);
    if (tid < 128) eid[tid] = e[(size_t)tok * 128 + tid];
    __syncthreads();
    for (int j = w; j < 128; j += 4) {
        const bf16_t* ur = ub + (size_t)eid[j] * DM;
        float acc = 0.f;
        for (int i = lane; i < DM; i += 64) acc += xrow[i] * bf2f(ur[i]);
        acc = wave_sum(acc);
        if (lane == 0) coef[j] = gsm[(size_t)tok * 128 + j] * gelu_tanh(acc * rs1);
    }
    __syncthreads();
    f32x4 acc = {0.f, 0.f, 0.f, 0.f};
    for (int j = 0; j < 128; ++j) {
        const u32x2 v = *(const u32x2*)(vb + (size_t)eid[j] * DM + tid * 4); const float c = coef[j];
        acc[0] += c * __uint_as_float(v.x << 16); acc[1] += c * __uint_as_float(v.x & 0xffff0000u); acc[2] += c * __uint_as_float(v.y << 16); acc[3] += c * __uint_as_float(v.y & 0xffff0000u);
    }
    f32x4 hv = *(f32x4*)(h + (size_t)tok * DM + tid * 4);
    hv += acc;
    *(f32x4*)(h + (size_t)tok * DM + tid * 4) = hv;
    u32x2 wv; wv.x = pack2bf(hv[0], hv[1]); wv.y = pack2bf(hv[2], hv[3]);
    *(u32x2*)(hb + (size_t)tok * DM + tid * 4) = wv;
    float s = hv[0] * hv[0] + hv[1] * hv[1] + hv[2] * hv[2] + hv[3] * hv[3];
    s = block_sum256(s, red);
    if (tid == 0) rs2[tok] = rsqrtf(s * (1.0f / DM) + EPS);
}
__global__ __launch_bounds__(256) void k_final_norm(float* __restrict__ h, const float* __restrict__ ssq3, const float* __restrict__ g) {
    const int row = blockIdx.x, t = threadIdx.x;
    const float rs = rs_from_ssq(ssq3, row);
    f32x4 v = *(f32x4*)(h + (size_t)row * DM + t * 4); const f32x4 gg = *(const f32x4*)(g + t * 4);
    v = v * rs * gg;
    *(f32x4*)(h + (size_t)row * DM + t * 4) = v;
}

__global__ void k_p2_extras(const bf16_t* __restrict__ vs, const bf16_t* __restrict__ vw, const float* __restrict__ kcmp, const float* __restrict__ vcmp,
                            bf16_t* __restrict__ vsT, bf16_t* __restrict__ vwT, bf16_t* __restrict__ kcb, bf16_t* __restrict__ vcT) {
    const size_t n = (size_t)NB * NKV * T_ * HD;
    for (size_t i = (size_t)blockIdx.x * blockDim.x + threadIdx.x; i < n; i += (size_t)gridDim.x * blockDim.x) {
        const size_t bh = i / ((size_t)T_ * HD); const int t = (int)((i / HD) % T_), d = (int)(i % HD);
        vsT[(bh * HD + d) * T_ + t] = vs[i]; vwT[(bh * HD + d) * T_ + t] = vw[i];
    }
    for (size_t i = (size_t)blockIdx.x * blockDim.x + threadIdx.x; i < (size_t)8 * 256 * 64; i += (size_t)gridDim.x * blockDim.x) {
        const int bh = (int)(i / (256 * 64)), c = (int)((i / 64) % 256), d = (int)(i % 64);
        const bool ok = c < NCMP;
        kcb[i] = ok ? f2bf(kcmp[i]) : (bf16_t)0;
        vcT[((size_t)bh * 64 + d) * 256 + c] = ok ? f2bf(vcmp[i]) : (bf16_t)0;
    }
}
__global__ __launch_bounds__(256) void k_grpnorm_lru(const float* __restrict__ raw, const float* __restrict__ gl, bf16_t* __restrict__ mixed) {
    __shared__ float red[8];
    const int row = blockIdx.x, t = threadIdx.x;
    const f32x2 v = *(const f32x2*)(raw + (size_t)row * DM + 512 + t * 2);
    const float s = block_sum256(v[0] * v[0] + v[1] * v[1], red);
    const float rs = rsqrtf(s * (1.0f / 512) + EPS);
    *(unsigned*)(mixed + (size_t)row * DM + 512 + t * 2) = pack2bf(v[0] * rs * gl[t * 2], v[1] * rs * gl[t * 2 + 1]);
}
#define XB_TMO      128
#define XB_XCNT(j)  (256  + 64 * (j))
#define XB_XSUB(j)  (1280 + 64 * (j))
#define XB_XGEN(j)  (2304 + 64 * (j))
#define XB_TOP      3328
#define XB_TOPGEN   3392
#define XCD_BAR_WORDS 3456
#define XB_SPIN_CAP (1u << 18)
#define LAS __attribute__((address_space(3)))

__device__ __forceinline__ unsigned xb_ld(unsigned* p)              { return __hip_atomic_load(p, __ATOMIC_RELAXED, __HIP_MEMORY_SCOPE_AGENT); }
__device__ __forceinline__ unsigned xb_add(unsigned* p, unsigned v) { return __hip_atomic_fetch_add(p, v, __ATOMIC_RELAXED, __HIP_MEMORY_SCOPE_AGENT); }
__device__ __forceinline__ unsigned xb_xcc_id() { return (unsigned)__builtin_amdgcn_s_getreg((3 << 11) | 20) & 0xFu; }
#define XB_SPIN(cond, bar) do { unsigned _sp = 0; while (cond) { __builtin_amdgcn_s_sleep(1); \
    if ((++_sp & 255u) == 0u) { if (xb_ld(&(bar)[XB_TMO])) break; if (_sp > XB_SPIN_CAP) { atomicAdd(&(bar)[XB_TMO], 1u); break; } } } } while (0)

struct XcdBarrier {
    unsigned* bar; unsigned x;
    volatile LAS unsigned* st;
};

__device__ __forceinline__ XcdBarrier xcd_barrier_post(unsigned* bar, volatile LAS unsigned* st) {
    XcdBarrier b; b.bar = bar; b.x = xb_xcc_id(); b.st = st;
    if (threadIdx.x == 0) (void)xb_add(&bar[XB_XCNT(b.x)], 1u);
    return b;
}
__device__ __forceinline__ void xcd_barrier_complete(unsigned* bar, unsigned x, unsigned& nloc, unsigned& nx) {
    const unsigned G = gridDim.x * gridDim.y * gridDim.z;
    unsigned sum, cnt, mine, sp = 0u;
    for (;;) {
        sum = 0u; cnt = 0u; mine = 0u;
#pragma unroll
        for (unsigned j = 0; j < 16; ++j) { const unsigned c = xb_ld(&bar[XB_XCNT(j)]); sum += c; cnt += (c > 0u) ? 1u : 0u; mine = (j == x) ? c : mine; }
        if (sum == G) break;
        __builtin_amdgcn_s_sleep(1);
        if ((++sp & 255u) == 0u) { if (xb_ld(&bar[XB_TMO])) break; if (sp > XB_SPIN_CAP) { atomicAdd(&bar[XB_TMO], 1u); break; } }
    }
    nloc = mine > 0u ? mine : 1u; nx = cnt > 0u ? cnt : 1u;
}

__device__ __forceinline__ void xcd_barrier(const XcdBarrier& b) {
    asm volatile("s_waitcnt vmcnt(0)" ::: "memory");
    __syncthreads();
    if (threadIdx.x == 0) {
        unsigned* bar = b.bar;
        __builtin_amdgcn_s_waitcnt(0);
        unsigned nloc = b.st[0], nx = b.st[1];
        if (nloc == 0u) { xcd_barrier_complete(bar, b.x, nloc, nx); b.st[0] = nloc; b.st[1] = nx; }
        const unsigned old = xb_add(&bar[XB_XSUB(b.x)], 1u);
        const unsigned gen = old / nloc;
        if (old + 1u == (gen + 1u) * nloc) {
            __builtin_amdgcn_fence(__ATOMIC_RELEASE, "agent");
            asm volatile("s_waitcnt vmcnt(0)" ::: "memory");
            const unsigned og = xb_add(&bar[XB_TOP], 1u);
            const unsigned tg = og / nx;
            if (og + 1u == (tg + 1u) * nx) xb_add(&bar[XB_TOPGEN], 1u);
            else XB_SPIN(xb_ld(&bar[XB_TOPGEN]) == tg, bar);
            __builtin_amdgcn_fence(__ATOMIC_ACQUIRE, "agent");
            xb_add(&bar[XB_XGEN(b.x)], 1u);
            asm volatile("s_waitcnt vmcnt(0)" ::: "memory");
        } else {
            XB_SPIN(xb_ld(&bar[XB_XGEN(b.x)]) == gen, bar);
            __builtin_amdgcn_fence(__ATOMIC_ACQUIRE, "agent");
            asm volatile("s_waitcnt vmcnt(0)" ::: "memory");
        }
    }
    __syncthreads();
}


namespace pg8 {
#define PG8_LAS __attribute__((address_space(3)))
typedef short bf16x8 __attribute__((ext_vector_type(8)));
constexpr int BM = 256, BK = 64, HALF = 128, HTB = HALF * BK * 2  , STAGE_BYTES = 8 * HTB, NXCD = 8, WGM = 8;

__host__ __device__ __forceinline__ int lds_byte(int r, int c) { const int st = (r >> 4) * 2 + (c >> 5), rr = r & 15, cc = c & 31, ob = rr * 64 + cc * 2; return st * 1024 + (ob ^ (((ob >> 9) & 1) << 5)); }
__host__ __device__ __forceinline__ void stage_rc(int b, int& R, int& C) { const int st = b / 1024, sb = b % 1024, swz = sb ^ (((sb >> 9) & 1) << 5); R = (st >> 1) * 16 + swz / 64; C = (st & 1) * 32 + (swz % 64) / 2; }
__host__ __device__ __forceinline__ int perm32(int rho) { const int n = rho >> 4, i = rho & 15; return 8 * (i >> 2) + 4 * n + (i & 3); }

struct Unit { int pm, pn; };
struct Gemm { const bf16_t* A; const bf16_t* Bt; int M, N, K; };

struct StaticOrder {
    int nM, nN, nwg, G, c;
    __host__ __device__ void init(int M, int N, int G_, int c_) { nM = M / BM; nN = N / BM; nwg = nM * nN; G = G_; c = c_; }
    __host__ __device__ bool next(int i, Unit& u) const {
        const long L = (long)i * G + c; if (L >= nwg) return false;
        int wgid = (int)L; { const int q = nwg / NXCD, r = nwg % NXCD, xcd = wgid % NXCD, off = wgid / NXCD; wgid = (xcd < r ? xcd * (q + 1) : r * (q + 1) + (xcd - r) * q) + off; }
        const int nig = WGM * nN, gid = wgid / nig, fm = gid * WGM, gsz = (nM - fm) < WGM ? (nM - fm) : WGM;
        u.pm = fm + ((wgid % nig) % gsz); u.pn = (wgid % nig) / gsz; return true;
    }
    __device__ __forceinline__ void a_ready(const Unit&) const {}
    __device__ __forceinline__ void done(const Unit&) const {}
};
template <class Epi, class Sched, bool STAMP = false>
__device__ __forceinline__ void gemm_phase(PG8_LAS unsigned char* lds, const Gemm g, const Sched& S, const Epi& E, unsigned long long* stamps) {
    const int tid = threadIdx.x, wid = __builtin_amdgcn_readfirstlane(tid >> 6), lane = tid & 63, wr = wid >> 2, wc = wid & 3, fr = lane & 15, fq = lane >> 4;
    const int K = g.K, nt = K / BK;
    int ts_lo = 0, ts_hi = 0, nts = 0; const unsigned long long rt_entry = STAMP ? (unsigned long long)wall_clock64() : 0ull;
#define PG8_STAMP() do { if (STAMP && wid == 0 && nts < 64) { const unsigned long long _c = (unsigned long long)clock64(); \
        ts_lo = (lane == nts) ? (int)(unsigned)_c : ts_lo; ts_hi = (lane == nts) ? (int)(unsigned)(_c >> 32) : ts_hi; ++nts; } } while (0)
    PG8_STAMP();
    unsigned voffA[2], voffB[2];
#pragma unroll
    for (int i = 0; i < 2; ++i) { int R, C; stage_rc(tid * 16 + i * 8192, R, C); const int Rb = Epi::PERM ? ((R & ~31) + perm32(R & 31)) : R;
        voffA[i] = (unsigned)(R * K + C) * 2u; voffB[i] = (unsigned)(Rb * K + C) * 2u; }
    const size_t kstep = (size_t)(BK * 2);
    const size_t hstep = (size_t)HALF * K * 2;
    const size_t tstep = 2 * hstep;
    const unsigned ldsw = (unsigned)wid * 1024u;
    const int aoff = lds_byte(wr * 64 + fr, fq * 8), boff = lds_byte(wc * 32 + fr, fq * 8);
#define PG8_SA(b, h) (((b) * 2 + (h)) * HTB)
#define PG8_SB(b, h) ((4 + (b) * 2 + (h)) * HTB)
#define PG8_STAGE(bufoff, gbase, voff) do { _Pragma("unroll") for (int _i = 0; _i < 2; ++_i) \
        __builtin_amdgcn_global_load_lds((const unsigned*)((const char*)(gbase) + (voff)[_i]), (PG8_LAS unsigned*)(lds + (bufoff) + ldsw + _i * 8192), 16, 0, 0); } while (0)
#define PG8_LDA(dst, b, h) do { _Pragma("unroll") for (int m = 0; m < 4; ++m) _Pragma("unroll") for (int k = 0; k < 2; ++k) dst[m][k] = *(const PG8_LAS bf16x8*)(lds + PG8_SA(b, h) + aoff + m * 2048 + k * 1024); } while (0)
#define PG8_LDB(dst, b, h) do { _Pragma("unroll") for (int n = 0; n < 2; ++n) _Pragma("unroll") for (int k = 0; k < 2; ++k) dst[n][k] = *(const PG8_LAS bf16x8*)(lds + PG8_SB(b, h) + boff + n * 2048 + k * 1024); } while (0)
#define PG8_MMA(ai, bj, At, Bt) do { __builtin_amdgcn_s_setprio(1); _Pragma("unroll") for (int m = 0; m < 4; ++m) _Pragma("unroll") for (int n = 0; n < 2; ++n) _Pragma("unroll") for (int k = 0; k < 2; ++k) \
        acc[ai][bj][m][n] = __builtin_amdgcn_mfma_f32_16x16x32_bf16(Bt[n][k], At[m][k], acc[ai][bj][m][n], 0, 0, 0); __builtin_amdgcn_s_setprio(0); } while (0)
#define PG8_WAIT_V(n) asm volatile("s_waitcnt vmcnt(" #n ")" ::: "memory")
#define PG8_WAIT_L(n) asm volatile("s_waitcnt lgkmcnt(" #n ")" ::: "memory")
#define PG8_BAR __builtin_amdgcn_s_barrier()
#define PG8_SCHED __builtin_amdgcn_sched_barrier(0)
    Unit cur, nxt; int ui = 0;
    if (!S.next(0, cur)) return;
    f32x4 acc[2][2][4][2];
#pragma unroll
    for (int a = 0; a < 2; ++a)
#pragma unroll
        for (int b = 0; b < 2; ++b)
#pragma unroll
            for (int m = 0; m < 4; ++m)
#pragma unroll
                for (int n = 0; n < 2; ++n) acc[a][b][m][n] = (f32x4){0.f, 0.f, 0.f, 0.f};
    bf16x8 At[4][2], B0[2][2], B1[2][2];
    const char* cA = (const char*)g.A + (size_t)cur.pm * tstep; const char* cB = (const char*)g.Bt + (size_t)cur.pn * tstep;
    S.a_ready(cur);
    PG8_STAGE(PG8_SB(0, 0), cB, voffB); PG8_STAGE(PG8_SA(0, 0), cA, voffA); PG8_STAGE(PG8_SB(0, 1), cB + hstep, voffB); PG8_STAGE(PG8_SA(0, 1), cA + hstep, voffA);
    if (wr == 1) PG8_BAR;
    PG8_WAIT_V(4); PG8_BAR;
    PG8_STAGE(PG8_SB(1, 0), cB + kstep, voffB); PG8_STAGE(PG8_SA(1, 0), cA + kstep, voffA); PG8_STAGE(PG8_SB(1, 1), cB + hstep + kstep, voffB);
    PG8_WAIT_V(6); PG8_BAR;
    PG8_STAMP();
    for (;;) {
        const bool has_next = S.next(ui + 1, nxt);
        const char* nA = has_next ? (const char*)g.A + (size_t)nxt.pm * tstep : cA; const char* nB = has_next ? (const char*)g.Bt + (size_t)nxt.pn * tstep : cB;
        for (int t = 0; t < nt; t += 2) {
            const bool last = (t == nt - 2);
            const char* a1 = cA + (size_t)(t + 1) * kstep;
            const char* a2 = last ? nA : cA + (size_t)(t + 2) * kstep; const char* b2 = last ? nB : cB + (size_t)(t + 2) * kstep;
            const char* a3 = a2 + kstep; const char* b3 = b2 + kstep;
            if (last && has_next) S.a_ready(nxt);
            PG8_LDB(B0, 0, 0); PG8_SCHED; PG8_LDA(At, 0, 0); PG8_STAGE(PG8_SA(1, 1), a1 + hstep, voffA);
            PG8_WAIT_L(8); PG8_BAR; PG8_WAIT_L(0); PG8_MMA(0, 0, At, B0); PG8_BAR; PG8_SCHED;
            PG8_LDB(B1, 0, 1); PG8_STAGE(PG8_SB(0, 0), b2, voffB);
            PG8_BAR; PG8_WAIT_L(0); PG8_MMA(0, 1, At, B1); PG8_BAR;
            PG8_LDA(At, 0, 1); PG8_STAGE(PG8_SA(0, 0), a2, voffA);
            PG8_BAR; PG8_WAIT_L(0); PG8_MMA(1, 0, At, B0); PG8_BAR; PG8_SCHED;
            PG8_STAGE(PG8_SB(0, 1), b2 + hstep, voffB);
            PG8_WAIT_V(6); PG8_BAR; PG8_MMA(1, 1, At, B1); PG8_BAR;
            PG8_LDB(B0, 1, 0); PG8_SCHED; PG8_LDA(At, 1, 0); PG8_STAGE(PG8_SA(0, 1), a2 + hstep, voffA);
            PG8_WAIT_L(8); PG8_BAR; PG8_WAIT_L(0); PG8_MMA(0, 0, At, B0); PG8_BAR; PG8_SCHED;
            PG8_LDB(B1, 1, 1); PG8_STAGE(PG8_SB(1, 0), b3, voffB);
            PG8_BAR; PG8_WAIT_L(0); PG8_MMA(0, 1, At, B1); PG8_BAR;
            PG8_LDA(At, 1, 1); PG8_STAGE(PG8_SA(1, 0), a3, voffA);
            PG8_BAR; PG8_WAIT_L(0); PG8_MMA(1, 0, At, B0); PG8_BAR; PG8_SCHED;
            PG8_STAGE(PG8_SB(1, 1), b3 + hstep, voffB);
            PG8_WAIT_V(6); PG8_BAR; PG8_MMA(1, 1, At, B1); PG8_BAR;
        }
        PG8_STAMP();
        if constexpr (!Epi::AFTER_DRAIN) { E(acc, cur, wr, wc, fr, fq); S.done(cur); }
        PG8_STAMP();
        if (!has_next) break;
#pragma unroll
        for (int a = 0; a < 2; ++a)
#pragma unroll
            for (int b = 0; b < 2; ++b)
#pragma unroll
                for (int m = 0; m < 4; ++m)
#pragma unroll
                    for (int n = 0; n < 2; ++n) acc[a][b][m][n] = (f32x4){0.f, 0.f, 0.f, 0.f};
        cur = nxt; cA = nA; cB = nB; ++ui;
    }
    PG8_WAIT_V(0);
    if (wr == 0) PG8_BAR;
    PG8_BAR;
    if constexpr (Epi::AFTER_DRAIN) { E.fused(acc, cur, wr, wc, fr, fq, lds, wid, lane); S.done(cur); }
    PG8_STAMP();
    if (STAMP && wid == 0) { stamps[lane] = lane < nts ? (((unsigned long long)(unsigned)ts_hi << 32) | (unsigned)ts_lo) : 0ull;
        if (lane == 62) stamps[62] = rt_entry; if (lane == 63) stamps[63] = (unsigned long long)wall_clock64(); }
#undef PG8_STAMP
#undef PG8_SA
#undef PG8_SB
#undef PG8_STAGE
#undef PG8_LDA
#undef PG8_LDB
#undef PG8_MMA
#undef PG8_WAIT_V
#undef PG8_WAIT_L
#undef PG8_BAR
#undef PG8_SCHED
}
}
#define LAS3 __attribute__((address_space(3)))
constexpr int MK_THREADS = 512;
typedef __bf16 bf16x2_t __attribute__((ext_vector_type(2)));
DI float dot2bf(unsigned a, unsigned b, float c) { return __builtin_amdgcn_fdot2_f32_bf16(__builtin_bit_cast(bf16x2_t, a), __builtin_bit_cast(bf16x2_t, b), c, false); }
DI float bflo(unsigned v) { return __uint_as_float(v << 16); }
DI float bfhi(unsigned v) { return __uint_as_float(v & 0xffff0000u); }

template <class ColMap>
DI void transpose_tile(const float* __restrict__ src, int ldsrc, const float* __restrict__ gain, bf16_t* __restrict__ dst, int K, int k0, int n0, const ColMap& cm, LAS3 float* tl) {
    const int tid = threadIdx.x;
    __syncthreads();
    {
        const int n = tid & 63, sc = cm(n0 + n);
#pragma unroll
        for (int j = 0; j < 8; ++j) { const int k = (tid >> 6) + 8 * j; tl[k * 65 + n] = sc >= 0 ? src[(size_t)(k0 + k) * ldsrc + sc] * (gain ? gain[k0 + k] : 1.0f) : 0.f; }
    }
    __syncthreads();
    {
        const int n = tid >> 3, k8 = (tid & 7) * 8;
        u32x4 w;
        w.x = pack2bf(tl[(k8 + 0) * 65 + n], tl[(k8 + 1) * 65 + n]); w.y = pack2bf(tl[(k8 + 2) * 65 + n], tl[(k8 + 3) * 65 + n]);
        w.z = pack2bf(tl[(k8 + 4) * 65 + n], tl[(k8 + 5) * 65 + n]); w.w = pack2bf(tl[(k8 + 6) * 65 + n], tl[(k8 + 7) * 65 + n]);
        *(u32x4*)(dst + (size_t)(n0 + n) * K + k0 + k8) = w;
    }
}
struct ColId { DI int operator()(int n) const { return n; } };
struct ColWin { DI int operator()(int n) const { return n < PC_XR ? n : (n < PC_XG ? 1304 + (n - PC_XR) : (n < PC_GATE ? 1816 + (n - PC_XG) : (n < PC_GATE + 24 ? 1280 + (n - PC_GATE) : -1))); } };

DI void cvt_rows_bf16(const float* __restrict__ src, const float* __restrict__ gain, bf16_t* __restrict__ dst, size_t n8, int cols, size_t gtid, size_t nthr) {
    for (size_t i = gtid; i < n8; i += nthr) {
        f32x4 a = *(const f32x4*)(src + i * 8), b = *(const f32x4*)(src + i * 8 + 4);
        if (gain) { const int c = (int)((i * 8) % cols); a *= *(const f32x4*)(gain + c); b *= *(const f32x4*)(gain + c + 4); }
        u32x4 w; w.x = pack2bf(a[0], a[1]); w.y = pack2bf(a[2], a[3]); w.z = pack2bf(b[0], b[1]); w.w = pack2bf(b[2], b[3]);
        *(u32x4*)(dst + i * 8) = w;
    }
}

DI void cvt_rows_fp8(const float* __restrict__ src, const float* __restrict__ gain, float scale, unsigned char* __restrict__ dst, size_t n8, int cols, size_t gtid, size_t nthr) {
    for (size_t i = gtid; i < n8; i += nthr) {
        f32x4 a = *(const f32x4*)(src + i * 8), b = *(const f32x4*)(src + i * 8 + 4);
        if (gain) { const int c = (int)((i * 8) % cols); a *= *(const f32x4*)(gain + c); b *= *(const f32x4*)(gain + c + 4); }
        a *= scale; b *= scale;
        int w0 = 0, w1 = 0;
        w0 = __builtin_amdgcn_cvt_pk_fp8_f32(a[0], a[1], w0, false); w0 = __builtin_amdgcn_cvt_pk_fp8_f32(a[2], a[3], w0, true);
        w1 = __builtin_amdgcn_cvt_pk_fp8_f32(b[0], b[1], w1, false); w1 = __builtin_amdgcn_cvt_pk_fp8_f32(b[2], b[3], w1, true);
        *(u32x2*)(dst + i * 8) = (u32x2){(unsigned)w0, (unsigned)w1};
    }
}
DI void p0_prologue(const Params& p, LAS3 unsigned char* lds, int G) {
    unsigned char* ws = p.ws;
    const int tid = threadIdx.x, lane = tid & 63, wid = tid >> 6, bid = blockIdx.x;
    const size_t gtid = (size_t)bid * MK_THREADS + tid, nthr = (size_t)G * MK_THREADS;
    const int gw = bid * 8 + wid, nw = G * 8;
    {
        const float* x = p.in[I_X]; bf16_t* xb = (bf16_t*)(ws + WS_XB); float* rs0 = (float*)(ws + WS_RS0);
        for (int row = gw; row < NTOK; row += nw) {
            f32x4 v[4]; float s = 0.f;
#pragma unroll
            for (int j = 0; j < 4; ++j) { v[j] = *(const f32x4*)(x + (size_t)row * DM + j * 256 + lane * 4); s += (v[j][0] * v[j][0] + v[j][1] * v[j][1]) + (v[j][2] * v[j][2] + v[j][3] * v[j][3]); }
            s = wave_sum(s);
#pragma unroll
            for (int j = 0; j < 4; ++j) { u32x2 w; w.x = pack2bf(v[j][0], v[j][1]); w.y = pack2bf(v[j][2], v[j][3]); *(u32x2*)(xb + (size_t)row * DM + j * 256 + lane * 4) = w; }
            if (lane == 0) rs0[row] = rsqrtf(s * (1.0f / DM) + EPS);
        }
    }
#if PEER_V3
    cvt_rows_fp8(p.in[I_PEER_U], p.in[I_FFN_NORM], 32.0f, (unsigned char*)(ws + WS_UB), (size_t)16384 * DM / 8, DM, gtid, nthr);
    cvt_rows_fp8(p.in[I_PEER_V], nullptr, 8.0f, (unsigned char*)(ws + WS_VB), (size_t)16384 * DM / 8, DM, gtid, nthr);
#else
    cvt_rows_bf16(p.in[I_PEER_U], p.in[I_FFN_NORM], (bf16_t*)(ws + WS_UB), (size_t)16384 * DM / 8, DM, gtid, nthr);
    cvt_rows_bf16(p.in[I_PEER_V], nullptr, (bf16_t*)(ws + WS_VB), (size_t)16384 * DM / 8, DM, gtid, nthr);
#endif
    cvt_rows_bf16(p.in[I_P], nullptr, (bf16_t*)(ws + WS_PB), (size_t)NTOK * PLE / 8, PLE, gtid, nthr);
    LAS3 float* tl = (LAS3 float*)lds;
    {
        for (int u = bid; u < 1496; u += G) {
            if (u < 640) transpose_tile(p.in[I_W_IN], INCOLS, p.in[I_ATTN_NORM], (bf16_t*)(ws + WS_WIN), DM, (u % 16) * 64, (u / 16) * 64, ColWin{}, tl);
            else if (u < 896) { const int v = u - 640; transpose_tile(p.in[I_W_OUT], DM, nullptr, (bf16_t*)(ws + WS_WOUT), DM, (v % 16) * 64, (v / 16) * 64, ColId{}, tl); }
            else if (u < 1152) { const int v = u - 896; transpose_tile(p.in[I_PLE_WG], DM, p.in[I_PLE_NORM], (bf16_t*)(ws + WS_WG), DM, (v % 16) * 64, (v / 16) * 64, ColId{}, tl); }
            else if (u < 1216) { const int v = u - 1152; transpose_tile(p.in[I_PLE_PROJ], DM, nullptr, (bf16_t*)(ws + WS_WP), PLE, (v % 4) * 64, (v / 4) * 64, ColId{}, tl); }
            else if (u < 1344) { const int v = u - 1216; transpose_tile(p.in[I_CK_W1], 256, nullptr, (bf16_t*)(ws + WS_CW1K), 2048, (v % 32) * 64, (v / 32) * 64, ColId{}, tl); }
            else if (u < 1472) { const int v = u - 1344; transpose_tile(p.in[I_CV_W1], 256, nullptr, (bf16_t*)(ws + WS_CW1V), 2048, (v % 32) * 64, (v / 32) * 64, ColId{}, tl); }
            else if (u < 1480) { const int v = u - 1472; transpose_tile(p.in[I_LRU_WA] + v * 4096, 64, nullptr, (bf16_t*)(ws + WS_WAT) + v * 4096, 64, 0, 0, ColId{}, tl); }
            else if (u < 1488) { const int v = u - 1480; transpose_tile(p.in[I_LRU_WX] + v * 4096, 64, nullptr, (bf16_t*)(ws + WS_WXT) + v * 4096, 64, 0, 0, ColId{}, tl); }
            else if (u < 1492) { const int v = u - 1488; transpose_tile(p.in[I_CK_W2], 64, nullptr, (bf16_t*)(ws + WS_CW2K), 256, v * 64, 0, ColId{}, tl); }
            else { const int v = u - 1492; transpose_tile(p.in[I_CV_W2], 64, nullptr, (bf16_t*)(ws + WS_CW2V), 256, v * 64, 0, ColId{}, tl); }
        }
        __syncthreads();
    }
    {
        LAS3 float* wt = (LAS3 float*)lds;
        LAS3 float* st = (LAS3 float*)(lds + 32768);
        const float* wq = p.in[I_PEER_WQ]; const float* sub = p.in[I_PEER_SUB]; const float* gain = p.in[I_FFN_NORM]; bf16_t* WqsT = (bf16_t*)(ws + WS_WQS);
        for (int u = bid; u < 256; u += G) {
            const int hp = u >> 4, d0 = (u & 15) * 64, pp = hp & 1;
            __syncthreads();
            for (int i = tid; i < 64 * 128; i += MK_THREADS) { const int d = i >> 7, dk = i & 127; wt[dk * 64 + d] = wq[(size_t)(d0 + d) * 2048 + hp * 128 + dk]; }
            for (int i = tid; i < 128 * 128; i += MK_THREADS) { const int kk = i >> 7, dk = i & 127; st[kk * 129 + dk] = sub[((size_t)pp * 128 + kk) * 128 + dk]; }
            __syncthreads();
            const int kk = tid & 127, dg = (tid >> 7) * 16;
            float acc[16];
#pragma unroll
            for (int j = 0; j < 16; ++j) acc[j] = 0.f;
            for (int dk = 0; dk < 128; ++dk) {
                const float sv = st[kk * 129 + dk];
#pragma unroll
                for (int j4 = 0; j4 < 4; ++j4) { const f32x4 w4 = *(LAS3 f32x4*)(wt + dk * 64 + dg + j4 * 4);
#pragma unroll
                    for (int j = 0; j < 4; ++j) acc[j4 * 4 + j] += sv * w4[j]; }
            }
            u32x4 o0, o1;
#define GQ(j) (acc[j] * gain[d0 + dg + (j)])
            o0.x = pack2bf(GQ(0), GQ(1)); o0.y = pack2bf(GQ(2), GQ(3)); o0.z = pack2bf(GQ(4), GQ(5)); o0.w = pack2bf(GQ(6), GQ(7));
            o1.x = pack2bf(GQ(8), GQ(9)); o1.y = pack2bf(GQ(10), GQ(11)); o1.z = pack2bf(GQ(12), GQ(13)); o1.w = pack2bf(GQ(14), GQ(15));
#undef GQ
            bf16_t* dst = WqsT + (size_t)(hp * 128 + kk) * DM + d0 + dg;
            *(u32x4*)dst = o0; *(u32x4*)(dst + 8) = o1;
        }
        __syncthreads();
    }
    for (int o = gw; o < 512; o += nw) {
        const int kv = o >> 8, j = o & 255;
        const float* pe = p.in[kv ? I_CV_PE : I_CK_PE]; const float* w1 = p.in[kv ? I_CV_W1 : I_CK_W1];
        float acc = 0.f;
        for (int k = lane; k < 2048; k += 64) acc += pe[k] * w1[(size_t)k * 256 + j];
        acc = wave_sum(acc);
        if (lane == 0) ((float*)(ws + (kv ? WS_CBV : WS_CBK)))[j] = acc;
    }
}

DI void p6_peer_apply(const Params& p, int G) {
    unsigned char* ws = p.ws;
    const int tid = threadIdx.x, lane = tid & 63, wid = tid >> 6;
    const int gw = blockIdx.x * 8 + wid, nw = G * 8;
    const bf16_t* ub = (const bf16_t*)(ws + WS_UB); const bf16_t* vb = (const bf16_t*)(ws + WS_VB);
    const int* eidx = (const int*)(ws + R_EXP); const float* gsm = (const float*)(ws + R_GSM); const float* ssq1 = (const float*)(ws + WS_SSQ1);
    float* h = p.out; bf16_t* hb = (bf16_t*)(ws + R_H1B); float* rs2 = (float*)(ws + WS_RS2);
    for (int tok = gw; tok < NTOK; tok += nw) {
        float sq = lane < 16 ? ssq1[(size_t)lane * NTOK + tok] : 0.f;
        sq = wave_sum(sq);
        const float rs1 = rsqrtf(sq * (1.0f / DM) + EPS);
        const u32x4 xa = *(const u32x4*)(hb + (size_t)tok * DM + lane * 8), xc = *(const u32x4*)(hb + (size_t)tok * DM + 512 + lane * 8);
        const int e0 = eidx[(size_t)tok * 128 + lane], e1 = eidx[(size_t)tok * 128 + 64 + lane];
        const float g0 = gsm[(size_t)tok * 128 + lane], g1 = gsm[(size_t)tok * 128 + 64 + lane];
        float coef0 = 0.f, coef1 = 0.f;
#pragma unroll
        for (int half = 0; half < 2; ++half) {
            const int ev = half ? e1 : e0;
            float part[64];
#pragma unroll
            for (int j = 0; j < 64; ++j) {
                const int e = __builtin_amdgcn_readlane(ev, j);
                const bf16_t* ur = ub + (size_t)e * DM + lane * 8;
                const u32x4 ua = *(const u32x4*)ur, uc = *(const u32x4*)(ur + 512);
                float a = dot2bf(xa.x, ua.x, 0.f); a = dot2bf(xa.y, ua.y, a); a = dot2bf(xa.z, ua.z, a); a = dot2bf(xa.w, ua.w, a);
                a = dot2bf(xc.x, uc.x, a); a = dot2bf(xc.y, uc.y, a); a = dot2bf(xc.z, uc.z, a); a = dot2bf(xc.w, uc.w, a);
                part[j] = a;
            }
#pragma unroll
            for (int m = 32; m >= 1; m >>= 1) {
                const bool up = (lane & m) != 0;
#pragma unroll
                for (int i = 0; i < m; ++i) {
                    const float send = up ? part[i] : part[i + m];
                    const float keep = up ? part[i + m] : part[i];
                    part[i] = keep + __shfl_xor(send, m);
                }
            }
            const float act = gelu_tanh(part[0] * rs1);
            if (half) coef1 = g1 * act; else coef0 = g0 * act;
        }
        float acc[16];
#pragma unroll
        for (int i = 0; i < 16; ++i) acc[i] = 0.f;
#pragma unroll
        for (int half = 0; half < 2; ++half) {
            const int ev = half ? e1 : e0; const float cv = half ? coef1 : coef0;
#pragma unroll 16
            for (int j = 0; j < 64; ++j) {
                const int e = __builtin_amdgcn_readlane(ev, j);
                const float c = __uint_as_float(__builtin_amdgcn_readlane(__float_as_uint(cv), j));
                const bf16_t* vr = vb + (size_t)e * DM + lane * 8;
                const u32x4 va = *(const u32x4*)vr, vc = *(const u32x4*)(vr + 512);
                acc[0] += c * bflo(va.x); acc[1] += c * bfhi(va.x); acc[2] += c * bflo(va.y); acc[3] += c * bfhi(va.y);
                acc[4] += c * bflo(va.z); acc[5] += c * bfhi(va.z); acc[6] += c * bflo(va.w); acc[7] += c * bfhi(va.w);
                acc[8] += c * bflo(vc.x); acc[9] += c * bfhi(vc.x); acc[10] += c * bflo(vc.y); acc[11] += c * bfhi(vc.y);
                acc[12] += c * bflo(vc.z); acc[13] += c * bfhi(vc.z); acc[14] += c * bflo(vc.w); acc[15] += c * bfhi(vc.w);
            }
        }
        float* hr = h + (size_t)tok * DM + lane * 8;
        f32x4 h0 = *(f32x4*)hr, h1 = *(f32x4*)(hr + 4), h2 = *(f32x4*)(hr + 512), h3 = *(f32x4*)(hr + 516);
        h0 += (f32x4){acc[0], acc[1], acc[2], acc[3]}; h1 += (f32x4){acc[4], acc[5], acc[6], acc[7]};
        h2 += (f32x4){acc[8], acc[9], acc[10], acc[11]}; h3 += (f32x4){acc[12], acc[13], acc[14], acc[15]};
        *(f32x4*)hr = h0; *(f32x4*)(hr + 4) = h1; *(f32x4*)(hr + 512) = h2; *(f32x4*)(hr + 516) = h3;
        u32x4 w0, w1;
        w0.x = pack2bf(h0[0], h0[1]); w0.y = pack2bf(h0[2], h0[3]); w0.z = pack2bf(h1[0], h1[1]); w0.w = pack2bf(h1[2], h1[3]);
        w1.x = pack2bf(h2[0], h2[1]); w1.y = pack2bf(h2[2], h2[3]); w1.z = pack2bf(h3[0], h3[1]); w1.w = pack2bf(h3[2], h3[3]);
        *(u32x4*)(hb + (size_t)tok * DM + lane * 8) = w0; *(u32x4*)(hb + (size_t)tok * DM + 512 + lane * 8) = w1;
        float s = 0.f;
#pragma unroll
        for (int j = 0; j < 4; ++j) s += h0[j] * h0[j] + h1[j] * h1[j] + h2[j] * h2[j] + h3[j] * h3[j];
        s = wave_sum(s);
        if (lane == 0) rs2[tok] = rsqrtf(s * (1.0f / DM) + EPS);
    }
}

DI void p8_final_norm(const Params& p, int G) {
    const int lane = threadIdx.x & 63, gw = blockIdx.x * 8 + (threadIdx.x >> 6), nw = G * 8;
    const float* ssq3 = (const float*)(p.ws + WS_SSQ3); const float* g = p.in[I_FINAL_NORM]; float* h = p.out;
    f32x4 gg[4];
#pragma unroll
    for (int j = 0; j < 4; ++j) gg[j] = *(const f32x4*)(g + j * 256 + lane * 4);
    for (int row = gw; row < NTOK; row += nw) {
        float sq = lane < 16 ? ssq3[(size_t)lane * NTOK + row] : 0.f;
        sq = wave_sum(sq);
        const float rs = rsqrtf(sq * (1.0f / DM) + EPS);
#pragma unroll
        for (int j = 0; j < 4; ++j) { float* q = h + (size_t)row * DM + j * 256 + lane * 4; f32x4 v = *(f32x4*)q; v = v * rs * gg[j]; *(f32x4*)q = v; }
    }
}
typedef float f32x16 __attribute__((ext_vector_type(16)));
typedef short bf16x8v __attribute__((ext_vector_type(8)));
typedef __bf16 bf16x2v_ __attribute__((ext_vector_type(2)));
DI unsigned pk_bf16(float lo, float hi) { return __builtin_bit_cast(unsigned, __builtin_convertvector((f32x2){lo, hi}, bf16x2v_)); }
constexpr float LOG2E = 1.4426950408889634f;
constexpr int AT_KROW = 144, AT_VROW = 136;
constexpr int AT_KT = 64 * AT_KROW, AT_VT = 64 * AT_VROW, AT_BUF = 2 * AT_KT + 2 * AT_VT;
constexpr int AT_VAL = 0;
constexpr int AT_LUT = 2 * AT_BUF;
constexpr int AT_IMP = AT_LUT + 8 * 128 * 4;
constexpr int AT_SEL = AT_IMP + 8 * 32 * 65 * 4;
constexpr int AT_SSQ = AT_SEL + 512;
constexpr int AT_END = AT_SSQ + 1024;
static_assert(AT_END <= 160 * 1024 - 256, "attention LDS map");

struct AtSrc { const bf16_t* k0; const bf16_t* k1; const bf16_t* v0; const bf16_t* v1; int vld; };
DI void at_load(const AtSrc& s, int kpos, int tid, u32x4 (&r)[4]) {
    const int row = tid >> 3, seg = tid & 7;
    r[0] = *(const u32x4*)(s.k0 + (size_t)(kpos + row) * HD + seg * 8);
    r[1] = *(const u32x4*)(s.k1 + (size_t)(kpos + row) * HD + seg * 8);
    r[2] = *(const u32x4*)(s.v0 + (size_t)row * s.vld + kpos + seg * 8);
    r[3] = *(const u32x4*)(s.v1 + (size_t)row * s.vld + kpos + seg * 8);
}
DI void at_store(LAS3 unsigned char* buf, int tid, const u32x4 (&r)[4]) {
    const int row = tid >> 3, seg = tid & 7;
    *(LAS3 u32x4*)(buf + row * AT_KROW + seg * 16) = r[0];
    *(LAS3 u32x4*)(buf + AT_KT + row * AT_KROW + seg * 16) = r[1];
    LAS3 unsigned char* v = buf + 2 * AT_KT + row * AT_VROW + seg * 16;
    *(LAS3 u32x2*)(v) = (u32x2){r[2].x, r[2].y}; *(LAS3 u32x2*)(v + 8) = (u32x2){r[2].z, r[2].w};
    *(LAS3 u32x2*)(v + AT_VT) = (u32x2){r[3].x, r[3].y}; *(LAS3 u32x2*)(v + AT_VT + 8) = (u32x2){r[3].z, r[3].w};
}

template <int MODE, int PASS>
DI void at_step(LAS3 const unsigned char* Kb, LAS3 const unsigned char* Vb, const bf16x8v (&Q)[4], int k0, int tq, int lane, LAS3 const float* lut, bool blk_ok,
                float& m_run, float& l_run, f32x16 (&O)[2], float inv_l, LAS3 float* imp_row, float& bcarry) {
    const int r = lane & 31, hf = lane >> 5;
    f32x16 S[2];
#pragma unroll
    for (int sub = 0; sub < 2; ++sub) {
#pragma unroll
        for (int i = 0; i < 16; ++i) S[sub][i] = 0.f;
#pragma unroll
        for (int ks = 0; ks < 4; ++ks) {
            const bf16x8v a = *(LAS3 const bf16x8v*)(Kb + (32 * sub + r) * AT_KROW + 32 * ks + 16 * hf);
            S[sub] = __builtin_amdgcn_mfma_f32_32x32x16_bf16(a, Q[ks], S[sub], 0, 0, 0);
        }
    }
    float mx = -INFINITY;
#pragma unroll
    for (int sub = 0; sub < 2; ++sub)
#pragma unroll
        for (int i = 0; i < 16; ++i) {
            const int kp = k0 + 32 * sub + (i & 3) + 8 * (i >> 2) + 4 * hf;
            const int dist = MODE == 0 ? tq - (16 * kp + 31) : tq - kp;
            bool ok = dist >= 0 && blk_ok;
            if (MODE == 2) ok = ok && dist < 512;
            const int idx = dist < 0 ? 0 : (dist > 127 ? 127 : dist);
            float s = S[sub][i] * LOG2E + lut[idx];
            s = ok ? s : -INFINITY;
            S[sub][i] = s; mx = fmaxf(mx, s);
        }
    if (PASS != 2) {
        mx = fmaxf(mx, __shfl_xor(mx, 32));
        const float m_new = fmaxf(m_run, mx), m_safe = (m_new == -INFINITY) ? 0.f : m_new;
        const float alpha = __builtin_amdgcn_exp2f(m_run - m_safe);
        float sum = 0.f;
#pragma unroll
        for (int sub = 0; sub < 2; ++sub)
#pragma unroll
            for (int i = 0; i < 16; ++i) { const float pv = __builtin_amdgcn_exp2f(S[sub][i] - m_safe); S[sub][i] = pv; sum += pv; }
        l_run = l_run * alpha + sum; m_run = m_new;
        if (PASS == 0) {
#pragma unroll
            for (int db = 0; db < 2; ++db)
#pragma unroll
                for (int i = 0; i < 16; ++i) O[db][i] *= alpha;
        }
    } else {
#pragma unroll
        for (int sub = 0; sub < 2; ++sub) {
#pragma unroll
            for (int i = 0; i < 16; ++i) S[sub][i] = __builtin_amdgcn_exp2f(S[sub][i] - m_run) * inv_l;
            float bp[4], av[4];
#pragma unroll
            for (int a = 0; a < 4; ++a) {
                av[a] = S[sub][4 * a] + S[sub][4 * a + 1] + S[sub][4 * a + 2] + 0.5f * S[sub][4 * a + 3];
                bp[a] = __shfl_xor(0.5f * S[sub][4 * a + 3], 32);
            }
            const int sbase = (k0 >> 2) + 8 * sub + hf;
#pragma unroll
            for (int a = 0; a < 4; ++a) imp_row[sbase + 2 * a] = av[a] + (hf ? bp[a] : (a > 0 ? bp[a > 0 ? a - 1 : 0] : bcarry));
            bcarry = bp[3];
        }
    }
    if (PASS != 1) {
#pragma unroll
        for (int sub = 0; sub < 2; ++sub)
#pragma unroll
            for (int s2 = 0; s2 < 2; ++s2) {
                u32x4 pw;
                pw.x = pk_bf16(S[sub][8 * s2 + 0], S[sub][8 * s2 + 1]); pw.y = pk_bf16(S[sub][8 * s2 + 2], S[sub][8 * s2 + 3]);
                pw.z = pk_bf16(S[sub][8 * s2 + 4], S[sub][8 * s2 + 5]); pw.w = pk_bf16(S[sub][8 * s2 + 6], S[sub][8 * s2 + 7]);
                const bf16x8v pf = __builtin_bit_cast(bf16x8v, pw);
#pragma unroll
                for (int db = 0; db < 2; ++db) {
                    LAS3 const unsigned char* va = Vb + (32 * db + r) * AT_VROW + (32 * sub + 16 * s2 + 4 * hf) * 2;
                    const u32x2 v0 = *(LAS3 const u32x2*)va, v1 = *(LAS3 const u32x2*)(va + 16);
                    const bf16x8v vf = __builtin_bit_cast(bf16x8v, (u32x4){v0.x, v0.y, v1.x, v1.y});
                    O[db] = __builtin_amdgcn_mfma_f32_32x32x16_bf16(vf, pf, O[db], 0, 0, 0);
                }
            }
    }
}

template <int MODE, int PASS>
DI void at_branch(LAS3 unsigned char* lds, const AtSrc& src, int blk_lo, int blk_hi, const bf16x8v (&Q)[4], int tq, int tid, int kvh, LAS3 const float* lut,
                  unsigned mlo, unsigned mhi, float& m_run, float& l_run, f32x16 (&O)[2], float inv_l, LAS3 float* imp_row) {
    const int lane = tid & 63;
    u32x4 st[4];
    float bcarry = 0.f;
    at_load(src, blk_lo * 64, tid, st);
    for (int blk = blk_lo; blk <= blk_hi; ++blk) {
        LAS3 unsigned char* buf = lds + ((blk - blk_lo) & 1) * AT_BUF;
        at_store(buf, tid, st);
        __syncthreads();
        if (blk < blk_hi) at_load(src, (blk + 1) * 64, tid, st);
        bool blk_ok = true;
        if (MODE == 1) blk_ok = ((blk < 32 ? (mlo >> blk) : (mhi >> (blk - 32))) & 1u) != 0u;
        if (MODE != 1 || __any(blk_ok))
            at_step<MODE, PASS>(buf + kvh * AT_KT, buf + 2 * AT_KT + kvh * AT_VT, Q, blk * 64, tq, lane, lut, blk_ok, m_run, l_run, O, inv_l, imp_row, bcarry);
    }
    __syncthreads();
}

DI void p3_attention(const Params& p, LAS3 unsigned char* lds, int G) {
    unsigned char* ws = p.ws;
    const int tid = threadIdx.x, lane = tid & 63, h = __builtin_amdgcn_readfirstlane(tid >> 6), kvh = h >> 2, r = lane & 31, hf = lane >> 5;
    LAS3 float* lutall = (LAS3 float*)(lds + AT_LUT);
    {
        const float* rel = p.in[I_REL];
        for (int i = tid; i < 1024; i += MK_THREADS) lutall[i] = rel[rel_bucket(i & 127) * NH + (i >> 7)] * LOG2E;
    }
    __syncthreads();
    LAS3 const float* lut = lutall + h * 128;
    LAS3 float* impw = (LAS3 float*)(lds + AT_IMP);
    LAS3 float* vals = (LAS3 float*)(lds + AT_VAL);
    LAS3 unsigned char* selb = lds + AT_SEL;
    LAS3 float* ssq = (LAS3 float*)(lds + AT_SSQ);
    const bf16_t* qb = (const bf16_t*)(ws + R_QB);
    const float* gates = (const float*)(ws + R_GATE);
    const float* gn = p.in[I_GN_ATTN];
    bf16_t* mixed = (bf16_t*)(ws + WS_XB);
    for (int ui = blockIdx.x; ui < 512; ui += G) {
        const int q8 = ui & 255, rnd = ui >> 8, b = q8 >> 6, j6 = q8 & 63, tb = rnd == 0 ? 127 - j6 : j6;
        const int t0 = 32 * tb, qb64 = tb >> 1, tq = t0 + r;
        const size_t tok = (size_t)b * T_ + tq;
        bf16x8v Q[4];
#pragma unroll
        for (int ks = 0; ks < 4; ++ks) Q[ks] = *(const bf16x8v*)(qb + tok * 512 + h * 64 + 16 * ks + 8 * hf);
        f32x16 O[2];
#pragma unroll
        for (int db = 0; db < 2; ++db)
#pragma unroll
            for (int i = 0; i < 16; ++i) O[db][i] = 0.f;
        LAS3 float* oslot = (LAS3 float*)(lds + AT_IMP) + h * 2048 + lane;
        const size_t bh0 = (size_t)b * 2, bh1 = bh0 + 1;
        {
            const bf16_t* kcb = (const bf16_t*)(ws + R_KCB); const bf16_t* vct = (const bf16_t*)(ws + R_VCT);
            const AtSrc src{kcb + bh0 * 256 * 64, kcb + bh1 * 256 * 64, vct + bh0 * 64 * 256, vct + bh1 * 64 * 256, 256};
            const int nst = tb / 32 + 1;
            float m_run = -INFINITY, l_run = 0.f;
            at_branch<0, 1>(lds, src, 0, nst - 1, Q, tq, tid, kvh, lut, 0u, 0u, m_run, l_run, O, 0.f, nullptr);
            const float l_tot = l_run + __shfl_xor(l_run, 32);
            const float inv_l = l_tot > 0.f ? 1.0f / l_tot : 0.f;
            float m_fix = (m_run == -INFINITY) ? 0.f : m_run;
            at_branch<0, 2>(lds, src, 0, nst - 1, Q, tq, tid, kvh, lut, 0u, 0u, m_fix, l_run, O, inv_l, impw + (h * 32 + r) * 65);
        }
        {
            const int row = tid >> 3, j8 = tid & 7, kr = row >> 5, tr = row & 31;
#pragma unroll
            for (int jj = 0; jj < 8; ++jj) {
                const int s = j8 * 8 + jj, db = qb64 - s;
                float v = 0.f;
#pragma unroll
                for (int g = 0; g < 4; ++g) v += impw[((kr * 4 + g) * 32 + tr) * 65 + s];
                vals[row * 65 + s] = (db >= 0 && db < 2) ? 2.0e4f : (s == 0 ? 1.0e4f : (db >= 0 ? v : -1.0f));
            }
            __syncthreads();
            unsigned bits = 0u;
            {
                float vv[8]; int rk[8];
#pragma unroll
                for (int jj = 0; jj < 8; ++jj) { vv[jj] = vals[row * 65 + j8 * 8 + jj]; rk[jj] = 0; }
#pragma unroll 2
                for (int s2 = 0; s2 < 64; ++s2) {
                    const float w = vals[row * 65 + s2];
#pragma unroll
                    for (int jj = 0; jj < 8; ++jj) rk[jj] += (w > vv[jj] || (w == vv[jj] && s2 < j8 * 8 + jj)) ? 1 : 0;
                }
#pragma unroll
                for (int jj = 0; jj < 8; ++jj) if (rk[jj] < 16 && qb64 - (j8 * 8 + jj) >= 0) bits |= 1u << jj;
            }
            selb[row * 8 + j8] = (unsigned char)bits;
            __syncthreads();
        }
        const unsigned mlo = *(LAS3 const unsigned*)(selb + (kvh * 32 + r) * 8), mhi = *(LAS3 const unsigned*)(selb + (kvh * 32 + r) * 8 + 4);
        __syncthreads();
        {
            const float g0 = sigmoidf_(gates[tok * 24 + h * 3 + 0]);
#pragma unroll
            for (int db = 0; db < 2; ++db)
#pragma unroll
                for (int i = 0; i < 16; ++i) { oslot[(db * 16 + i) * 64] = g0 * O[db][i]; O[db][i] = 0.f; }
        }
        {
            const bf16_t* ksb = (const bf16_t*)(ws + R_KS); const bf16_t* vst = (const bf16_t*)(ws + R_VST);
            const AtSrc src{ksb + bh0 * T_ * HD, ksb + bh1 * T_ * HD, vst + bh0 * HD * T_, vst + bh1 * HD * T_, T_};
            float m_run = -INFINITY, l_run = 0.f;
            at_branch<1, 0>(lds, src, 0, qb64, Q, tq, tid, kvh, lut, mlo, mhi, m_run, l_run, O, 0.f, nullptr);
            const float l_tot = l_run + __shfl_xor(l_run, 32), sc = sigmoidf_(gates[tok * 24 + h * 3 + 1]) / l_tot;
#pragma unroll
            for (int db = 0; db < 2; ++db)
#pragma unroll
                for (int i = 0; i < 16; ++i) { oslot[(db * 16 + i) * 64] += sc * O[db][i]; O[db][i] = 0.f; }
        }
        {
            const bf16_t* kwb = (const bf16_t*)(ws + R_KW); const bf16_t* vwt = (const bf16_t*)(ws + R_VWT);
            const AtSrc src{kwb + bh0 * T_ * HD, kwb + bh1 * T_ * HD, vwt + bh0 * HD * T_, vwt + bh1 * HD * T_, T_};
            int wb0 = (t0 - 511) >> 6; wb0 = wb0 < 0 ? 0 : wb0;
            float m_run = -INFINITY, l_run = 0.f;
            at_branch<2, 0>(lds, src, wb0, qb64, Q, tq, tid, kvh, lut, 0u, 0u, m_run, l_run, O, 0.f, nullptr);
            const float l_tot = l_run + __shfl_xor(l_run, 32), sc = sigmoidf_(gates[tok * 24 + h * 3 + 2]) / l_tot;
#pragma unroll
            for (int db = 0; db < 2; ++db)
#pragma unroll
                for (int i = 0; i < 16; ++i) O[db][i] = oslot[(db * 16 + i) * 64] + sc * O[db][i];
        }
        {
            float ss = 0.f;
#pragma unroll
            for (int db = 0; db < 2; ++db)
#pragma unroll
                for (int i = 0; i < 16; ++i) ss += O[db][i] * O[db][i];
            ss += __shfl_xor(ss, 32);
            if (hf == 0) ssq[h * 32 + r] = ss;
            __syncthreads();
            float tot = 0.f;
#pragma unroll
            for (int hh = 0; hh < 8; ++hh) tot += ssq[hh * 32 + r];
            const float rs = rsqrtf(tot * (1.0f / 512) + EPS);
#pragma unroll
            for (int db = 0; db < 2; ++db)
#pragma unroll
                for (int a = 0; a < 4; ++a) {
                    const int d = 32 * db + 8 * a + 4 * hf;
                    const f32x4 g4 = *(const f32x4*)(gn + h * 64 + d);
                    u32x2 w; w.x = pk_bf16(O[db][4 * a] * rs * g4[0], O[db][4 * a + 1] * rs * g4[1]); w.y = pk_bf16(O[db][4 * a + 2] * rs * g4[2], O[db][4 * a + 3] * rs * g4[3]);
                    *(u32x2*)(mixed + tok * DM + h * 64 + d) = w;
                }
            __syncthreads();
        }
    }
}
constexpr int LR_STRIDE = 516;
constexpr int LR_XC = 0, LR_A = 32 * LR_STRIDE * 4, LR_RS = 2 * 32 * LR_STRIDE * 4, LR_END = LR_RS + 256;
static_assert(LR_END <= 160 * 1024 - 256, "LRU LDS map");

template <bool FINAL>
DI void lru_phase(const Params& p, LAS3 unsigned char* lds, int G) {
    unsigned char* ws = p.ws;
    const int tid = threadIdx.x, lane = tid & 63, n = __builtin_amdgcn_readfirstlane(tid >> 6), r = lane & 31, hf = lane >> 5, ch = tid;
    LAS3 float* XC = (LAS3 float*)(lds + LR_XC); LAS3 float* AA = (LAS3 float*)(lds + LR_A); LAS3 float* RS = (LAS3 float*)(lds + LR_RS);
    const float* xr = (const float*)(ws + R_XR); const bf16_t* xg = (const bf16_t*)(ws + R_XG);
    float* sumP = (float*)(ws + WS_LRUP); float* sumH = (float*)(ws + WS_LRUH);
    bf16_t* mixed = (bf16_t*)(ws + WS_XB);
    const float cw0 = p.in[I_CONV_W][0 * 512 + ch], cw1 = p.in[I_CONV_W][1 * 512 + ch], cw2 = p.in[I_CONV_W][2 * 512 + ch], cw3 = p.in[I_CONV_W][3 * 512 + ch], cb = p.in[I_CONV_B][ch];
    const float gl = FINAL ? p.in[I_GN_LRU][ch] : 0.f;
    float ba[2], bx[2], sp[2];
#pragma unroll
    for (int nb = 0; nb < 2; ++nb) { const int c2 = n * 64 + 32 * nb + r; ba[nb] = p.in[I_LRU_BA][c2]; bx[nb] = p.in[I_LRU_BX][c2]; sp[nb] = log1pf(__expf(-p.in[I_LRU_LAM][c2])); }
    bf16x8v Ba[2][4], Bx[2][4];
    {
        const bf16_t* waT = (const bf16_t*)(ws + WS_WAT); const bf16_t* wxT = (const bf16_t*)(ws + WS_WXT);
#pragma unroll
        for (int nb = 0; nb < 2; ++nb)
#pragma unroll
            for (int ks = 0; ks < 4; ++ks) {
                const size_t o = (size_t)(n * 64 + 32 * nb + r) * 64 + 16 * ks + 8 * hf;
                Ba[nb][ks] = *(const bf16x8v*)(waT + o); Bx[nb][ks] = *(const bf16x8v*)(wxT + o);
            }
    }
    for (int ci = blockIdx.x; ci < 256; ci += G) {
        const int b = ci >> 6, cib = ci & 63, t0 = cib * 64;
        const size_t tok0 = (size_t)b * T_ + t0;
        float x1 = 0.f, x2 = 0.f, x3 = 0.f;
        if (t0 > 0) { x1 = xr[(tok0 - 1) * 512 + ch]; x2 = xr[(tok0 - 2) * 512 + ch]; x3 = xr[(tok0 - 3) * 512 + ch]; }
        float hst = 0.f, pprod = 1.f;
        if (FINAL) {
            const float* Pp = sumP + (size_t)(b * 64) * 512 + ch; const float* Hp = sumH + (size_t)(b * 64) * 512 + ch;
            for (int k = 0; k < cib; ++k) hst = Pp[(size_t)k * 512] * hst + Hp[(size_t)k * 512];
        }
#pragma unroll 1
        for (int half = 0; half < 2; ++half) {
            const size_t tokh = tok0 + half * 32;
            __syncthreads();
#pragma unroll 8
            for (int t = 0; t < 32; ++t) {
                const float x0 = xr[(tokh + t) * 512 + ch];
                XC[t * LR_STRIDE + ch] = cw0 * x3 + cw1 * x2 + cw2 * x1 + cw3 * x0 + cb;
                x3 = x2; x2 = x1; x1 = x0;
            }
            __syncthreads();
            {
                f32x16 ar[2], ai[2];
#pragma unroll
                for (int nb = 0; nb < 2; ++nb)
#pragma unroll
                    for (int i = 0; i < 16; ++i) { ar[nb][i] = 0.f; ai[nb][i] = 0.f; }
#pragma unroll
                for (int ks = 0; ks < 4; ++ks) {
                    LAS3 const float* src = XC + r * LR_STRIDE + n * 64 + 16 * ks + 8 * hf;
                    const f32x4 f0 = *(LAS3 const f32x4*)src, f1 = *(LAS3 const f32x4*)(src + 4);
                    u32x4 pw; pw.x = pk_bf16(f0[0], f0[1]); pw.y = pk_bf16(f0[2], f0[3]); pw.z = pk_bf16(f1[0], f1[1]); pw.w = pk_bf16(f1[2], f1[3]);
                    const bf16x8v af = __builtin_bit_cast(bf16x8v, pw);
#pragma unroll
                    for (int nb = 0; nb < 2; ++nb) {
                        ar[nb] = __builtin_amdgcn_mfma_f32_32x32x16_bf16(af, Ba[nb][ks], ar[nb], 0, 0, 0);
                        ai[nb] = __builtin_amdgcn_mfma_f32_32x32x16_bf16(af, Bx[nb][ks], ai[nb], 0, 0, 0);
                    }
                }
                __syncthreads();
#pragma unroll
                for (int nb = 0; nb < 2; ++nb)
#pragma unroll
                    for (int i = 0; i < 16; ++i) {
                        const int t = (i & 3) + 8 * (i >> 2) + 4 * hf, o = t * LR_STRIDE + n * 64 + 32 * nb + r;
                        const float xcv = XC[o];
                        const float rg = sigmoidf_(ar[nb][i] + ba[nb]), ig = sigmoidf_(ai[nb][i] + bx[nb]);
                        const float log_a = -8.0f * rg * sp[nb];
                        AA[o] = __expf(log_a);
                        XC[o] = sqrtf(-expm1f(2.0f * log_a)) * (ig * xcv);
                    }
            }
            __syncthreads();
            if (!FINAL) {
#pragma unroll 8
                for (int t = 0; t < 32; ++t) { const float a = AA[t * LR_STRIDE + ch]; hst = a * hst + XC[t * LR_STRIDE + ch]; pprod *= a; }
            } else {
#pragma unroll 8
                for (int t = 0; t < 32; ++t) {
                    hst = AA[t * LR_STRIDE + ch] * hst + XC[t * LR_STRIDE + ch];
                    XC[t * LR_STRIDE + ch] = hst * gelu_tanh(bf2f(xg[(tokh + t) * 512 + ch]));
                }
                __syncthreads();
                {
                    const int t = tid >> 4, part = tid & 15;
                    float s = 0.f;
#pragma unroll 8
                    for (int j = 0; j < 32; ++j) { const float v = XC[t * LR_STRIDE + part + 16 * j]; s += v * v; }
                    s += __shfl_xor(s, 1); s += __shfl_xor(s, 2); s += __shfl_xor(s, 4); s += __shfl_xor(s, 8);
                    if (part == 0) RS[t] = rsqrtf(s * (1.0f / 512) + EPS);
                }
                __syncthreads();
#pragma unroll 8
                for (int t = 0; t < 32; ++t) mixed[(tokh + t) * DM + 512 + ch] = f2bf(XC[t * LR_STRIDE + ch] * RS[t] * gl);
            }
        }
        if (!FINAL) { sumP[(size_t)ci * 512 + ch] = pprod; sumH[(size_t)ci * 512 + ch] = hst; }
    }
    __syncthreads();
}
typedef float f32x4v __attribute__((ext_vector_type(4)));
constexpr int CM_IMG = 0;
constexpr int CM_HID = 36864;
constexpr int CM_END = CM_HID + 16 * 264 * 2;
DI void p2_compress(const Params& p, LAS3 unsigned char* lds, int G) {
    unsigned char* ws = p.ws;
    const int tid = threadIdx.x, lane = tid & 63, wid = __builtin_amdgcn_readfirstlane(tid >> 6), row = lane & 15, kg = lane >> 4;
    for (int u = blockIdx.x; u < 256; u += G) {
        const int kv = u >> 7, bh = (u >> 4) & 7, c0 = (u & 15) * 16;
        const bf16_t* src = (const bf16_t*)(ws + (kv ? R_VC : R_KC)) + ((size_t)bh * T_ + 16 * c0) * HD;
        const bf16_t* W1T = (const bf16_t*)(ws + (kv ? WS_CW1V : WS_CW1K));
        const float* cb = (const float*)(ws + (kv ? WS_CBV : WS_CBK));
        const bf16_t* W2T = (const bf16_t*)(ws + (kv ? WS_CW2V : WS_CW2K));
        __syncthreads();
        for (int i = tid; i < 272 * 8; i += MK_THREADS) { const int tau = i >> 3, cch = i & 7; *(LAS3 u32x4*)(lds + CM_IMG + tau * 128 + (tau >> 4) * 16 + cch * 16) = *(const u32x4*)(src + (size_t)tau * HD + cch * 8); }
        __syncthreads();
        f32x4v acc[2] = {{0.f, 0.f, 0.f, 0.f}, {0.f, 0.f, 0.f, 0.f}};
        const bf16_t* wb0 = W1T + (size_t)(wid * 32 + row) * 2048 + 8 * kg, * wb1 = wb0 + (size_t)16 * 2048;
#pragma unroll 8
        for (int ks = 0; ks < 64; ++ks) {
            const int tau = 16 * row + (ks >> 1);
            const bf16x8v a = *(LAS3 const bf16x8v*)(lds + CM_IMG + tau * 128 + (tau >> 4) * 16 + (32 * (ks & 1) + 8 * kg) * 2);
            const bf16x8v b0 = *(const bf16x8v*)(wb0 + 32 * ks), b1 = *(const bf16x8v*)(wb1 + 32 * ks);
            acc[0] = __builtin_amdgcn_mfma_f32_16x16x32_bf16(a, b0, acc[0], 0, 0, 0);
            acc[1] = __builtin_amdgcn_mfma_f32_16x16x32_bf16(a, b1, acc[1], 0, 0, 0);
        }
#pragma unroll
        for (int nb = 0; nb < 2; ++nb) {
            const int col = wid * 32 + 16 * nb + row; const float bias = cb[col];
#pragma unroll
            for (int i = 0; i < 4; ++i) *(LAS3 bf16_t*)(lds + CM_HID + ((4 * kg + i) * 264 + col) * 2) = f2bf(gelu_tanh(acc[nb][i] + bias));
        }
        __syncthreads();
        if (wid < 4) {
            f32x4v o = {0.f, 0.f, 0.f, 0.f};
#pragma unroll
            for (int ks = 0; ks < 8; ++ks) {
                const bf16x8v a = *(LAS3 const bf16x8v*)(lds + CM_HID + (row * 264 + 32 * ks + 8 * kg) * 2);
                const bf16x8v b = *(const bf16x8v*)(W2T + (size_t)(wid * 16 + row) * 256 + 32 * ks + 8 * kg);
                o = __builtin_amdgcn_mfma_f32_16x16x32_bf16(a, b, o, 0, 0, 0);
            }
            const int d = wid * 16 + row;
#pragma unroll
            for (int i = 0; i < 4; ++i) {
                const int c = c0 + 4 * kg + i; const float v = c < NCMP ? o[i] : 0.f;
                ((float*)(ws + (kv ? WS_VCMP : WS_KCMP)))[((size_t)bh * 256 + c) * 64 + d] = v;
                if (kv) ((bf16_t*)(ws + R_VCT))[((size_t)bh * 64 + d) * 256 + c] = f2bf(v);
                else    ((bf16_t*)(ws + R_KCB))[((size_t)bh * 256 + c) * 64 + d] = f2bf(v);
            }
        }
    }
    __syncthreads();
}
DI void p2_vtranspose(const Params& p, LAS3 unsigned char* lds, int G) {
    unsigned char* ws = p.ws;
    const int tid = threadIdx.x;
    LAS3 bf16_t* tl = (LAS3 bf16_t*)lds;
    for (int u = blockIdx.x; u < 1024; u += G) {
        const int which = u >> 9, bh = (u >> 6) & 7, tt = u & 63;
        const bf16_t* src = (const bf16_t*)(ws + (which ? R_VW : R_VS)) + ((size_t)bh * T_ + tt * 64) * HD;
        bf16_t* dst = (bf16_t*)(ws + (which ? R_VWT : R_VST)) + (size_t)bh * HD * T_ + tt * 64;
        __syncthreads();
        { const int tok = tid >> 3, seg = tid & 7; *(LAS3 u32x4*)(tl + tok * 72 + seg * 8) = *(const u32x4*)(src + (size_t)tok * HD + seg * 8); }
        __syncthreads();
        { const int d = tid >> 3, seg = tid & 7; u32x4 w;
          w.x = (unsigned)tl[(seg * 8 + 0) * 72 + d] | ((unsigned)tl[(seg * 8 + 1) * 72 + d] << 16); w.y = (unsigned)tl[(seg * 8 + 2) * 72 + d] | ((unsigned)tl[(seg * 8 + 3) * 72 + d] << 16);
          w.z = (unsigned)tl[(seg * 8 + 4) * 72 + d] | ((unsigned)tl[(seg * 8 + 5) * 72 + d] << 16); w.w = (unsigned)tl[(seg * 8 + 6) * 72 + d] | ((unsigned)tl[(seg * 8 + 7) * 72 + d] << 16);
          *(u32x4*)(dst + (size_t)d * T_ + seg * 8) = w; }
    }
    __syncthreads();
}
DI int ord_enc(float f) { const int u = __float_as_int(f); return u ^ ((u >> 31) & 0x7fffffff); }
DI float ord_dec(int o) { return __int_as_float(o ^ ((o >> 31) & 0x7fffffff)); }
#define PEER_CE_DESC(a, b) do { const int _hi = max((a), (b)), _lo = min((a), (b)); (a) = _hi; (b) = _lo; } while (0)
#define PEER_CE_ASC(a, b)  do { const int _hi = max((a), (b)), _lo = min((a), (b)); (a) = _lo; (b) = _hi; } while (0)
DI void sort16_desc(int (&x)[16]) {
#pragma unroll
    for (int k = 2; k <= 16; k <<= 1)
#pragma unroll
        for (int j = k >> 1; j > 0; j >>= 1)
#pragma unroll
            for (int i = 0; i < 16; ++i) { const int l = i ^ j; if (l > i) { if ((i & k) == 0) PEER_CE_DESC(x[i], x[l]); else PEER_CE_ASC(x[i], x[l]); } }
}
DI void merge16_desc(int (&a)[16], const int (&b)[16]) {
#pragma unroll
    for (int i = 0; i < 16; ++i) a[i] = max(a[i], b[15 - i]);
#pragma unroll
    for (int j = 8; j > 0; j >>= 1)
#pragma unroll
        for (int i = 0; i < 16; ++i) { const int l = i ^ j; if (l > i) PEER_CE_DESC(a[i], a[l]); }
}
constexpr int PR_KEYS = 0;
constexpr int PR_IDX = 512 * 68 * 4;
constexpr int PR_RS = PR_IDX + 128 * 32 * 4;
constexpr int PR_END = PR_RS + 1024;
static_assert(PR_END <= 160 * 1024 - 256, "PEER LDS map");

struct EpiPeerRoute {
    static constexpr bool PERM = true, AFTER_DRAIN = true;
    const float* ssq1; int* eout; float* gout; float* rs1out;
    DI void fused(const f32x4 (&acc)[2][2][4][2], const pg8::Unit& u, int wr, int wc, int fr, int fq, PG8_LAS unsigned char* lds, int wid, int lane) const {
        const int tid = wid * 64 + lane, head = u.pn;
        LAS3 int* KEYS = (LAS3 int*)(lds + PR_KEYS); LAS3 int* IDX = (LAS3 int*)(lds + PR_IDX); LAS3 float* RS = (LAS3 float*)(lds + PR_RS);
        if (tid < 256) { float s = 0.f; for (int j = 0; j < 16; ++j) s += ssq1[(size_t)j * NTOK + u.pm * 256 + tid]; RS[tid] = rsqrtf(s * (1.0f / DM) + EPS); if (u.pn == 0) rs1out[u.pm * 256 + tid] = RS[tid]; }
#pragma unroll 1
        for (int ai = 0; ai < 2; ++ai) {
            __syncthreads();
#pragma unroll
            for (int bj = 0; bj < 2; ++bj)
#pragma unroll
                for (int m = 0; m < 4; ++m)
#pragma unroll
                    for (int n = 0; n < 2; ++n) {
                        const int rl = 64 * wr + 16 * m + fr, kk0 = 32 * wc + 8 * fq + 4 * n, hl = ((rl * 2 + bj) * 2 + (kk0 >> 6));
                        const f32x4 v = ai == 0 ? acc[0][bj][m][n] : acc[1][bj][m][n];
                        u32x4 kq;
                        kq.x = (unsigned)((ord_enc(v[0]) & ~0x7f) | (127 - (kk0 + 0))); kq.y = (unsigned)((ord_enc(v[1]) & ~0x7f) | (127 - (kk0 + 1)));
                        kq.z = (unsigned)((ord_enc(v[2]) & ~0x7f) | (127 - (kk0 + 2))); kq.w = (unsigned)((ord_enc(v[3]) & ~0x7f) | (127 - (kk0 + 3)));
                        *(LAS3 u32x4*)(KEYS + hl * 68 + (kk0 & 63)) = kq;
                    }
            __syncthreads();
            int top[16];
            {
                LAS3 const int* src = KEYS + tid * 68;
                int t2[16];
#pragma unroll
                for (int q = 0; q < 4; ++q) { const u32x4 w = *(LAS3 const u32x4*)(src + 4 * q); top[4 * q] = (int)w.x; top[4 * q + 1] = (int)w.y; top[4 * q + 2] = (int)w.z; top[4 * q + 3] = (int)w.w; }
                sort16_desc(top);
#pragma unroll 1
                for (int g = 1; g < 4; ++g) {
#pragma unroll
                    for (int q = 0; q < 4; ++q) { const u32x4 w = *(LAS3 const u32x4*)(src + 16 * g + 4 * q); t2[4 * q] = (int)w.x; t2[4 * q + 1] = (int)w.y; t2[4 * q + 2] = (int)w.z; t2[4 * q + 3] = (int)w.w; }
                    sort16_desc(t2);
                    merge16_desc(top, t2);
                }
#pragma unroll
                for (int i = 0; i < 16; ++i) t2[i] = __shfl_xor(top[i], 1);
                merge16_desc(top, t2);
            }
            int s1[16], s2[16];
            {
                const bool isp1 = (lane & 2) != 0;
#pragma unroll
                for (int i = 0; i < 16; ++i) { const int o = __shfl_xor(top[i], 2); s1[i] = isp1 ? o : top[i]; s2[i] = isp1 ? top[i] : o; }
            }
            const int rl = tid >> 2, q4 = tid & 3;
#pragma unroll
            for (int kq = 0; kq < 4; ++kq) if (q4 == kq) {
#pragma unroll
                for (int j = 0; j < 4; ++j) { IDX[rl * 32 + 4 * kq + j] = 127 - (s1[4 * kq + j] & 0x7f); IDX[rl * 32 + 16 + 4 * kq + j] = 127 - (s2[4 * kq + j] & 0x7f); }
            }
            float v1[16], v2[16];
#pragma unroll
            for (int i = 0; i < 16; ++i) { v1[i] = ord_dec(s1[i] & ~0x7f); v2[i] = ord_dec(s2[i] & ~0x7f); }
            int best[16], grp[16];
            {
                int cnt = 0; bool first = true;
#pragma unroll
                for (int a = 0; a < 16; ++a)
#pragma unroll
                    for (int b = 0; b < 16; ++b) if ((a + 1) * (b + 1) <= 16) {
                        grp[cnt & 15] = (ord_enc(v1[a] + v2[b]) & ~0xff) | (255 - (16 * a + b));
                        ++cnt;
                        if ((cnt & 15) == 0) { sort16_desc(grp); if (first) {
#pragma unroll
                                for (int i = 0; i < 16; ++i) best[i] = grp[i];
                                first = false; } else merge16_desc(best, grp); }
                    }
#pragma unroll
                for (int i = 2; i < 16; ++i) grp[i] = (int)0x80000000;
                sort16_desc(grp); merge16_desc(best, grp);
            }
            __syncthreads();
            const float rs1 = RS[128 * ai + rl];
            float gsum = 0.f, gv[16]; int ev[16];
            const float mtop = ord_dec(best[0] & ~0xff) * rs1;
#pragma unroll
            for (int i = 0; i < 16; ++i) {
                const float sc = ord_dec(best[i] & ~0xff) * rs1; gv[i] = __expf(sc - mtop); gsum += gv[i];
                const int ab = 255 - (best[i] & 0xff);
                ev[i] = IDX[rl * 32 + (ab >> 4)] * 128 + IDX[rl * 32 + 16 + (ab & 15)];
            }
            const float ginv = 1.0f / gsum;
            const size_t tok = (size_t)u.pm * 256 + 128 * ai + rl;
#pragma unroll
            for (int kq = 0; kq < 4; ++kq) if (q4 == kq) {
                *(u32x4*)(eout + tok * 128 + head * 16 + 4 * kq) = (u32x4){(unsigned)ev[4 * kq], (unsigned)ev[4 * kq + 1], (unsigned)ev[4 * kq + 2], (unsigned)ev[4 * kq + 3]};
                *(f32x4*)(gout + tok * 128 + head * 16 + 4 * kq) = (f32x4){gv[4 * kq] * ginv, gv[4 * kq + 1] * ginv, gv[4 * kq + 2] * ginv, gv[4 * kq + 3] * ginv};
            }
        }
        __syncthreads();
    }
    DI void operator()(const f32x4 (&)[2][2][4][2], const pg8::Unit&, int, int, int, int) const {}
};
struct SliceOrder : pg8::StaticOrder {
    int slice;
    __device__ bool next(int i, pg8::Unit& u) const { if (i > 0) return false; return pg8::StaticOrder::next(slice, u); }
};
DI void p5_peer_route(const Params& p, LAS3 unsigned char* lds, int G) {
    unsigned char* ws = p.ws;
    pg8::Gemm g{(const bf16_t*)(ws + R_H1B), (const bf16_t*)(ws + WS_WQS), NTOK, 2048, DM};
    EpiPeerRoute E{(const float*)(ws + WS_SSQ1), (int*)(ws + R_EXP), (float*)(ws + R_GSM), (float*)(ws + WS_RS1)};
    const int nslice = (512 + G - 1) / G;
#pragma unroll 1
    for (int s = 0; s < nslice; ++s) {
        SliceOrder S; S.init(NTOK, 2048, G, (int)blockIdx.x); S.slice = s;
        pg8::gemm_phase<EpiPeerRoute, SliceOrder>(lds, g, S, E, nullptr);
        __syncthreads();
    }
}
DI void p6_peer_u(const Params& p, int G) {
    unsigned char* ws = p.ws;
    const int tid = threadIdx.x, lane = tid & 63, wid = tid >> 6, grp = blockIdx.x & 7, rank = blockIdx.x >> 3;
    const int nrank = (G - grp + 7) >> 3, wv = rank * 8 + wid, nwv = nrank * 8;
    const bf16_t* ub = (const bf16_t*)(ws + WS_UB); const bf16_t* hb = (const bf16_t*)(ws + R_H1B);
    const int* eidx = (const int*)(ws + R_EXP); const float* gsm = (const float*)(ws + R_GSM); const float* rs1v = (const float*)(ws + WS_RS1);
    float* coef = (float*)(ws + R_COEF);
#pragma unroll 1
    for (int sweep = 0; sweep < 2; ++sweep) {
        const int sel = grp + 8 * sweep;
#pragma unroll 1
        for (int tok = wv; tok < NTOK; tok += nwv) {
            const int ev0 = eidx[(size_t)tok * 128 + lane], ev1 = eidx[(size_t)tok * 128 + 64 + lane];
            unsigned long long m0 = __ballot((ev0 & 15) == sel), m1 = __ballot((ev1 & 15) == sel);
            if ((m0 | m1) == 0ull) continue;
            const float gv0 = gsm[(size_t)tok * 128 + lane], gv1 = gsm[(size_t)tok * 128 + 64 + lane];
            const u32x4 xa = *(const u32x4*)(hb + (size_t)tok * DM + lane * 8), xc = *(const u32x4*)(hb + (size_t)tok * DM + 512 + lane * 8);
            const float rs1 = rs1v[tok];
            while ((m0 | m1) != 0ull) {
                int jj[8]; int ee[8]; float gg[8]; int nv = 0;
#pragma unroll
                for (int k = 0; k < 8; ++k) {
                    int j = k > 0 ? jj[k - 1] : 0; int e = k > 0 ? ee[k - 1] : 0; float g = k > 0 ? gg[k - 1] : 0.f;
                    if (m0 != 0ull) { const int b = __builtin_ctzll(m0); m0 &= m0 - 1ull; j = b; e = __builtin_amdgcn_readlane(ev0, b); g = __uint_as_float(__builtin_amdgcn_readlane(__float_as_uint(gv0), b)); nv = k + 1; }
                    else if (m1 != 0ull) { const int b = __builtin_ctzll(m1); m1 &= m1 - 1ull; j = 64 + b; e = __builtin_amdgcn_readlane(ev1, b); g = __uint_as_float(__builtin_amdgcn_readlane(__float_as_uint(gv1), b)); nv = k + 1; }
                    jj[k] = j; ee[k] = e; gg[k] = g;
                }
                float part[8];
#pragma unroll
                for (int k = 0; k < 8; ++k) {
                    const bf16_t* ur = ub + (size_t)ee[k] * DM + lane * 8;
                    const u32x4 ua = *(const u32x4*)ur, uc = *(const u32x4*)(ur + 512);
                    float a = dot2bf(xa.x, ua.x, 0.f); a = dot2bf(xa.y, ua.y, a); a = dot2bf(xa.z, ua.z, a); a = dot2bf(xa.w, ua.w, a);
                    a = dot2bf(xc.x, uc.x, a); a = dot2bf(xc.y, uc.y, a); a = dot2bf(xc.z, uc.z, a); a = dot2bf(xc.w, uc.w, a);
                    part[k] = a;
                }
#pragma unroll
                for (int m = 4; m >= 1; m >>= 1) {
                    const bool up = (lane & (8 * m)) != 0;
#pragma unroll
                    for (int i = 0; i < m; ++i) { const float send = up ? part[i] : part[i + m], keep = up ? part[i + m] : part[i]; part[i] = keep + __shfl_xor(send, 8 * m); }
                }
                float tot = part[0];
                tot += __shfl_xor(tot, 4); tot += __shfl_xor(tot, 2); tot += __shfl_xor(tot, 1);
                const int kk = lane >> 3;
                int myj = jj[0]; float myg = gg[0];
#pragma unroll
                for (int k = 1; k < 8; ++k) { myj = kk == k ? jj[k] : myj; myg = kk == k ? gg[k] : myg; }
                if ((lane & 7) == 0 && kk < nv) coef[(size_t)tok * 128 + myj] = myg * gelu_tanh(tot * rs1);
            }
        }
    }
}
DI void p6_peer_v(const Params& p, int G) {
    unsigned char* ws = p.ws;
    const int tid = threadIdx.x, lane = tid & 63, wid = tid >> 6, grp = blockIdx.x & 7, rank = blockIdx.x >> 3;
    const int nrank = (G - grp + 7) >> 3, wv = rank * 8 + wid, nwv = nrank * 8;
    const bf16_t* vb = (const bf16_t*)(ws + WS_VB);
    const int* eidx = (const int*)(ws + R_EXP); const float* coef = (const float*)(ws + R_COEF);
    float* h = p.out; bf16_t* hb = (bf16_t*)(ws + R_H1B); float* ssq2 = (float*)(ws + WS_SSQ2);
    const int sub = lane >> 3, c8 = (lane & 7) * 8;
#pragma unroll 1
    for (int sweep = 0; sweep < 2; ++sweep) {
        const int slice = grp + 8 * sweep, col0 = slice * 64 + c8;
#pragma unroll 1
        for (int tok = wv; tok < NTOK; tok += nwv) {
            const int ev0 = eidx[(size_t)tok * 128 + lane], ev1 = eidx[(size_t)tok * 128 + 64 + lane];
            const float cv0 = coef[(size_t)tok * 128 + lane], cv1 = coef[(size_t)tok * 128 + 64 + lane];
            u32x4 vr[16]; float cf[16];
#pragma unroll
            for (int i = 0; i < 16; ++i) {
                const int j = 8 * i + sub;
                const int e = __shfl(i < 8 ? ev0 : ev1, j & 63); cf[i] = __shfl(i < 8 ? cv0 : cv1, j & 63);
                vr[i] = *(const u32x4*)(vb + (size_t)e * DM + col0);
            }
            float acc[8];
#pragma unroll
            for (int q = 0; q < 8; ++q) acc[q] = 0.f;
#pragma unroll
            for (int i = 0; i < 16; ++i) {
                const float c = cf[i];
                acc[0] += c * bflo(vr[i].x); acc[1] += c * bfhi(vr[i].x); acc[2] += c * bflo(vr[i].y); acc[3] += c * bfhi(vr[i].y);
                acc[4] += c * bflo(vr[i].z); acc[5] += c * bfhi(vr[i].z); acc[6] += c * bflo(vr[i].w); acc[7] += c * bfhi(vr[i].w);
            }
#pragma unroll
            for (int q = 0; q < 8; ++q) { acc[q] += __shfl_xor(acc[q], 8); acc[q] += __shfl_xor(acc[q], 16); acc[q] += __shfl_xor(acc[q], 32); }
            float ss = 0.f;
            if (lane < 8) {
                float* hr = h + (size_t)tok * DM + col0;
                f32x4 h0 = *(f32x4*)hr, h1 = *(f32x4*)(hr + 4);
                h0 += (f32x4){acc[0], acc[1], acc[2], acc[3]}; h1 += (f32x4){acc[4], acc[5], acc[6], acc[7]};
                *(f32x4*)hr = h0; *(f32x4*)(hr + 4) = h1;
                u32x4 w; w.x = pk_bf16(h0[0], h0[1]); w.y = pk_bf16(h0[2], h0[3]); w.z = pk_bf16(h1[0], h1[1]); w.w = pk_bf16(h1[2], h1[3]);
                *(u32x4*)(hb + (size_t)tok * DM + col0) = w;
                ss = (h0[0] * h0[0] + h0[1] * h0[1]) + (h0[2] * h0[2] + h0[3] * h0[3]) + (h1[0] * h1[0] + h1[1] * h1[1]) + (h1[2] * h1[2] + h1[3] * h1[3]);
            }
            ss += __shfl_xor(ss, 1); ss += __shfl_xor(ss, 2); ss += __shfl_xor(ss, 4);
            if (lane == 0) ssq2[(size_t)slice * NTOK + tok] = ss;
        }
    }
}
constexpr float U8_SCALE = 32.0f, V8_SCALE = 8.0f;
DI void fp8x16_to_f32(const u32x4 w, float (&f)[16]) {
#pragma unroll
    for (int q = 0; q < 4; ++q) {
        const f32x2 lo = __builtin_amdgcn_cvt_pk_f32_fp8((int)w[q], false), hi = __builtin_amdgcn_cvt_pk_f32_fp8((int)w[q], true);
        f[4 * q] = lo.x; f[4 * q + 1] = lo.y; f[4 * q + 2] = hi.x; f[4 * q + 3] = hi.y;
    }
}
struct Pu5Fixed { int ev0, ev1; float gv0, gv1; u32x4 xa, xb; float rs1; };
DI void pu5_load_fixed(Pu5Fixed& f, int tok, int lane, const int* eidx, const float* gsm, const bf16_t* hb, const float* rs1v) {
    f.ev0 = eidx[(size_t)tok * 128 + lane]; f.ev1 = eidx[(size_t)tok * 128 + 64 + lane];
    f.gv0 = gsm[(size_t)tok * 128 + lane]; f.gv1 = gsm[(size_t)tok * 128 + 64 + lane];
    f.xa = *(const u32x4*)(hb + (size_t)tok * DM + lane * 16); f.xb = *(const u32x4*)(hb + (size_t)tok * DM + lane * 16 + 8);
    f.rs1 = rs1v[tok];
}
DI int pu5_setup(const Pu5Fixed& f, int sel, int lane, LAS3 unsigned* ent) {
    const bool s0 = (f.ev0 & 15) == sel, s1 = (f.ev1 & 15) == sel;
    const unsigned long long b0 = __ballot(s0), b1 = __ballot(s1);
    const int c0 = __builtin_popcountll(b0), cnt = c0 + __builtin_popcountll(b1);
    const unsigned long long lt = (1ull << lane) - 1ull;
    const int r0 = __builtin_popcountll(b0 & lt), r1 = c0 + __builtin_popcountll(b1 & lt);
    if (s0) { ent[r0] = (unsigned)f.ev0 | ((unsigned)lane << 16); ent[128 + r0] = __float_as_uint(f.gv0); }
    if (s1) { ent[r1] = (unsigned)f.ev1 | ((unsigned)(64 + lane) << 16); ent[128 + r1] = __float_as_uint(f.gv1); }
    return cnt;
}
#define PU5_ISSUE(SET, ENT, CNT) do { \
        _Pragma("unroll") for (int q = 0; q < 4; ++q) { const u32x4 e4 = *(LAS3 const u32x4*)((ENT) + 4 * q); \
            _Pragma("unroll") for (int k2 = 0; k2 < 4; ++k2) { const int k = 4 * q + k2; \
                const unsigned off = k < (CNT) ? ((e4[k2] & 0x3fffu) * (unsigned)DM) + lane * 16 : 0x80000000u; \
                SET[k] = __builtin_amdgcn_raw_buffer_load_b128(urs, off, 0, 0); } } } while (0)
#define PU5_CONSUME(SET, ENT, CNT, TOK, RS) do { \
        float part[16]; \
        _Pragma("unroll") for (int k = 0; k < 16; ++k) { float a = 0.f; \
            if (k < (CNT)) { f32x2 a2 = {0.f, 0.f}; \
                _Pragma("unroll") for (int q = 0; q < 4; ++q) { \
                    a2 = __builtin_elementwise_fma(__builtin_amdgcn_cvt_pk_f32_fp8((int)SET[k][q], false), xp[2 * q], a2); \
                    a2 = __builtin_elementwise_fma(__builtin_amdgcn_cvt_pk_f32_fp8((int)SET[k][q], true), xp[2 * q + 1], a2); } \
                a = a2.x + a2.y; } \
            part[k] = a; } \
        _Pragma("unroll") for (int m = 8; m >= 1; m >>= 1) { const bool up = (lane & (4 * m)) != 0; \
            _Pragma("unroll") for (int i = 0; i < m; ++i) { const float send = up ? part[i] : part[i + m], keep = up ? part[i + m] : part[i]; part[i] = keep + __shfl_xor(send, 4 * m); } } \
        float tot = part[0]; tot += __shfl_xor(tot, 2); tot += __shfl_xor(tot, 1); \
        const int kk = lane >> 2; const unsigned ew = (ENT)[kk]; const float gw = __uint_as_float((ENT)[128 + kk]); \
        if ((lane & 3) == 0 && kk < (CNT)) coef[(size_t)(TOK) * 128 + (ew >> 16)] = gw * (1.0f / V8_SCALE) * gelu_tanh(tot * ((RS) * (1.0f / U8_SCALE))); \
        if ((CNT) > 16) {   \
            for (int base = 16; base < (CNT); base += 16) { u32x4 rx[16]; \
                _Pragma("unroll") for (int k = 0; k < 16; ++k) { const unsigned e1 = (ENT)[base + k]; \
                    rx[k] = __builtin_amdgcn_raw_buffer_load_b128(urs, base + k < (CNT) ? ((e1 & 0x3fffu) * (unsigned)DM) + lane * 16 : 0x80000000u, 0, 0); } \
                float pr[16]; \
                _Pragma("unroll") for (int k = 0; k < 16; ++k) { f32x2 a2 = {0.f, 0.f}; \
                    _Pragma("unroll") for (int q = 0; q < 4; ++q) { \
                        a2 = __builtin_elementwise_fma(__builtin_amdgcn_cvt_pk_f32_fp8((int)rx[k][q], false), xp[2 * q], a2); \
                        a2 = __builtin_elementwise_fma(__builtin_amdgcn_cvt_pk_f32_fp8((int)rx[k][q], true), xp[2 * q + 1], a2); } \
                    pr[k] = a2.x + a2.y; } \
                _Pragma("unroll") for (int m = 8; m >= 1; m >>= 1) { const bool up = (lane & (4 * m)) != 0; \
                    _Pragma("unroll") for (int i = 0; i < m; ++i) { const float send = up ? pr[i] : pr[i + m], keep = up ? pr[i + m] : pr[i]; pr[i] = keep + __shfl_xor(send, 4 * m); } } \
                float t2 = pr[0]; t2 += __shfl_xor(t2, 2); t2 += __shfl_xor(t2, 1); \
                const int k3 = base + (lane >> 2); const unsigned ew2 = (ENT)[k3 & 127]; const float gw2 = __uint_as_float((ENT)[128 + (k3 & 127)]); \
                if ((lane & 3) == 0 && k3 < (CNT)) coef[(size_t)(TOK) * 128 + (ew2 >> 16)] = gw2 * (1.0f / V8_SCALE) * gelu_tanh(t2 * ((RS) * (1.0f / U8_SCALE))); } } } while (0)
#define PU5_UNPACK(F) do { _Pragma("unroll") for (int q = 0; q < 4; ++q) { xp[q] = (f32x2){bflo((F).xa[q]), bfhi((F).xa[q])}; xp[4 + q] = (f32x2){bflo((F).xb[q]), bfhi((F).xb[q])}; } } while (0)
DI void p6v5_u(const Params& p, LAS3 unsigned char* lds, int G) {
    unsigned char* ws = p.ws;
    const int tid = threadIdx.x, lane = tid & 63, wid = tid >> 6, grp = blockIdx.x & 7, rank = blockIdx.x >> 3;
    const int nrank = (G - grp + 7) >> 3, wv = rank * 8 + wid, nwv = nrank * 8;
    const unsigned char* u8 = (const unsigned char*)(ws + WS_UB); const bf16_t* hb = (const bf16_t*)(ws + R_H1B);
    const int* eidx = (const int*)(ws + R_EXP); const float* gsm = (const float*)(ws + R_GSM); const float* rs1v = (const float*)(ws + WS_RS1);
    float* coef = (float*)(ws + R_COEF);
    LAS3 unsigned* entA = (LAS3 unsigned*)(lds + wid * 2048); LAS3 unsigned* entB = entA + 256;
    if (wv >= NTOK) return;
    const __amdgpu_buffer_rsrc_t urs = __builtin_amdgcn_make_buffer_rsrc((void*)u8, 0, 16384 * DM, 0x00020000);
    const int nvis = (NTOK - wv + nwv - 1) / nwv, NV = 2 * nvis;
#define PU5_TOK(V) (wv + (((V) < NV ? (V) : NV - 1) % nvis) * nwv)
#define PU5_SEL(V) (grp + 8 * (((V) < NV ? (V) : NV - 1) / nvis))
    Pu5Fixed f1, f2;
    pu5_load_fixed(f1, PU5_TOK(0), lane, eidx, gsm, hb, rs1v);
    u32x4 sa[16], sb[16];
    f32x2 xp[8];
    int cntA = pu5_setup(f1, PU5_SEL(0), lane, entA), cntB = 0;
    PU5_ISSUE(sa, entA, cntA);
    int tokA = PU5_TOK(0), tokB = 0; float rsA = f1.rs1, rsB = 0.f;
    PU5_UNPACK(f1);
    pu5_load_fixed(f1, PU5_TOK(1), lane, eidx, gsm, hb, rs1v);
#pragma unroll 1
    for (int v = 0; v < NV; v += 2) {
        pu5_load_fixed(f2, PU5_TOK(v + 2), lane, eidx, gsm, hb, rs1v);
        cntB = pu5_setup(f1, PU5_SEL(v + 1), lane, entB); if (v + 1 >= NV) cntB = 0;
        PU5_ISSUE(sb, entB, cntB);
        tokB = PU5_TOK(v + 1); rsB = f1.rs1;
        PU5_CONSUME(sa, entA, cntA, tokA, rsA);
        PU5_UNPACK(f1);
        f1 = f2;
        pu5_load_fixed(f2, PU5_TOK(v + 3), lane, eidx, gsm, hb, rs1v);
        cntA = pu5_setup(f1, PU5_SEL(v + 2), lane, entA); if (v + 2 >= NV) cntA = 0;
        PU5_ISSUE(sa, entA, cntA);
        tokA = PU5_TOK(v + 2); rsA = f1.rs1;
        PU5_CONSUME(sb, entB, cntB, tokB, rsB);
        PU5_UNPACK(f1);
        f1 = f2;
    }
#undef PU5_TOK
#undef PU5_SEL
}
#undef PU5_ISSUE
#undef PU5_CONSUME
#undef PU5_UNPACK
template <int PMODE> DI void p6v3_v(const Params& p, int G) {
    unsigned char* ws = p.ws;
    const int tid = threadIdx.x, lane = tid & 63, wid = tid >> 6, grp = blockIdx.x & 7, rank = blockIdx.x >> 3;
    const int nrank = (G - grp + 7) >> 3, wv = rank * 8 + wid, nwv = nrank * 8;
    const unsigned char* v8 = (const unsigned char*)(ws + WS_VB);
    const int* eidx = (const int*)(ws + R_EXP); const float* coef = (const float*)(ws + R_COEF);
    float* h = PMODE == 0 ? p.out : (float*)(ws + R_BIG); bf16_t* hb = PMODE == 0 ? (bf16_t*)(ws + R_H1B) : (bf16_t*)(ws + WS_XB); float* ssq2 = PMODE == 0 ? (float*)(ws + WS_SSQ2) : (float*)(ws + WS_SSQ3);
    const int sub = lane >> 3, col0 = grp * 128 + (lane & 7) * 16;
    if (wv >= NTOK) return;
    const int nvis = (NTOK - wv + nwv - 1) / nwv;
#define PV_LOADIDX(T, EV0, EV1, CV0, CV1) do { EV0 = eidx[(size_t)(T) * 128 + lane]; EV1 = eidx[(size_t)(T) * 128 + 64 + lane]; CV0 = coef[(size_t)(T) * 128 + lane]; CV1 = coef[(size_t)(T) * 128 + 64 + lane]; } while (0)
#define PV_ISSUE8(R, EV) do { _Pragma("unroll") for (int i = 0; i < 8; ++i) { const int e = __shfl((EV), 8 * i + sub); R[i] = *(const u32x4*)(v8 + (unsigned)(e * DM + col0)); } } while (0)
#define PV_CONS8(R, CV) do { _Pragma("unroll") for (int i = 0; i < 8; ++i) { float f[16]; fp8x16_to_f32(R[i], f); const float c = __shfl((CV), 8 * i + sub); \
            _Pragma("unroll") for (int q = 0; q < 16; ++q) acc[q] += c * f[q]; } } while (0)
    u32x4 ra[8], rb[8];
    int e0, e1, n0, n1, x0, x1; float c0, c1, d0, d1, y0, y1;
    PV_LOADIDX(wv, e0, e1, c0, c1);
    { const int t1 = nvis > 1 ? wv + nwv : wv; PV_LOADIDX(t1, n0, n1, d0, d1); }
    PV_ISSUE8(ra, e0); PV_ISSUE8(rb, e1);
#pragma unroll 1
    for (int it = 0; it < nvis; ++it) {
        const int tok = wv + it * nwv;
        const int t2 = wv + (it + 2 < nvis ? it + 2 : nvis - 1) * nwv;
        float* hr = h + (size_t)tok * DM + col0;
        const f32x4 hv0 = *(const f32x4*)hr, hv1 = *(const f32x4*)(hr + 4), hv2 = *(const f32x4*)(hr + 8), hv3 = *(const f32x4*)(hr + 12);
        PV_LOADIDX(t2, x0, x1, y0, y1);
        float acc[16];
#pragma unroll
        for (int q = 0; q < 16; ++q) acc[q] = 0.f;
        PV_CONS8(ra, c0);
        PV_ISSUE8(ra, n0);
        PV_CONS8(rb, c1);
        PV_ISSUE8(rb, n1);
#pragma unroll
        for (int q = 0; q < 16; ++q) { acc[q] += __shfl_xor(acc[q], 8); acc[q] += __shfl_xor(acc[q], 16); acc[q] += __shfl_xor(acc[q], 32); }
        float ss = 0.f;
        if (lane < 8) {
            const f32x4 o0 = hv0 + (f32x4){acc[0], acc[1], acc[2], acc[3]}, o1 = hv1 + (f32x4){acc[4], acc[5], acc[6], acc[7]};
            const f32x4 o2 = hv2 + (f32x4){acc[8], acc[9], acc[10], acc[11]}, o3 = hv3 + (f32x4){acc[12], acc[13], acc[14], acc[15]};
            *(f32x4*)hr = o0; *(f32x4*)(hr + 4) = o1; *(f32x4*)(hr + 8) = o2; *(f32x4*)(hr + 12) = o3;
            u32x4 w0, w1;
            w0.x = pk_bf16(o0[0], o0[1]); w0.y = pk_bf16(o0[2], o0[3]); w0.z = pk_bf16(o1[0], o1[1]); w0.w = pk_bf16(o1[2], o1[3]);
            w1.x = pk_bf16(o2[0], o2[1]); w1.y = pk_bf16(o2[2], o2[3]); w1.z = pk_bf16(o3[0], o3[1]); w1.w = pk_bf16(o3[2], o3[3]);
            *(u32x4*)(hb + (size_t)tok * DM + col0) = w0; *(u32x4*)(hb + (size_t)tok * DM + col0 + 8) = w1;
#pragma unroll
            for (int j = 0; j < 4; ++j) ss += o0[j] * o0[j] + o1[j] * o1[j] + o2[j] * o2[j] + o3[j] * o3[j];
        }
        ss += __shfl_xor(ss, 1); ss += __shfl_xor(ss, 2); ss += __shfl_xor(ss, 4);
        if (lane == 0) ssq2[(size_t)grp * NTOK + tok] = ss;
        e0 = n0; e1 = n1; c0 = d0; c1 = d1; n0 = x0; n1 = x1; d0 = y0; d1 = y1;
    }
#undef PV_LOADIDX
#undef PV_ISSUE8
#undef PV_CONS8
}
DI void p6v6_peer(const Params& p, int G) {
    unsigned char* ws = p.ws;
    const int tid = threadIdx.x, lane = tid & 63, wid = tid >> 6;
    const int gw = blockIdx.x * 8 + wid, nw = G * 8;
    const unsigned char* u8 = (const unsigned char*)(ws + WS_UB); const unsigned char* v8 = (const unsigned char*)(ws + WS_VB);
    const int* eidx = (const int*)(ws + R_EXP); const float* gsm = (const float*)(ws + R_GSM); const float* rs1v = (const float*)(ws + WS_RS1);
    float* h = p.out; bf16_t* hb = (bf16_t*)(ws + R_H1B); float* rs2 = (float*)(ws + WS_RS2);
#pragma unroll 1
    for (int tok = gw; tok < NTOK; tok += nw) {
        const float rs1 = rs1v[tok] * (1.0f / U8_SCALE);
        const u32x4 xa = *(const u32x4*)(hb + (size_t)tok * DM + lane * 16), xb = *(const u32x4*)(hb + (size_t)tok * DM + lane * 16 + 8);
        f32x2 xp[8];
#pragma unroll
        for (int q = 0; q < 4; ++q) { xp[q] = (f32x2){bflo(xa[q]), bfhi(xa[q])}; xp[4 + q] = (f32x2){bflo(xb[q]), bfhi(xb[q])}; }
        const int e0 = eidx[(size_t)tok * 128 + lane], e1 = eidx[(size_t)tok * 128 + 64 + lane];
        const float g0 = gsm[(size_t)tok * 128 + lane], g1 = gsm[(size_t)tok * 128 + 64 + lane];
        float coef0 = 0.f, coef1 = 0.f;
#pragma unroll
        for (int half = 0; half < 2; ++half) {
            const int ev = half ? e1 : e0;
            float part[64];
#pragma unroll
            for (int j = 0; j < 64; ++j) {
                const int e = __builtin_amdgcn_readlane(ev, j);
                const u32x4 w = *(const u32x4*)(u8 + (size_t)e * DM + lane * 16);
                f32x2 a2 = {0.f, 0.f};
#pragma unroll
                for (int q = 0; q < 4; ++q) {
                    a2 = __builtin_elementwise_fma(__builtin_amdgcn_cvt_pk_f32_fp8((int)w[q], false), xp[2 * q], a2);
                    a2 = __builtin_elementwise_fma(__builtin_amdgcn_cvt_pk_f32_fp8((int)w[q], true), xp[2 * q + 1], a2);
                }
                part[j] = a2.x + a2.y;
            }
#pragma unroll
            for (int m = 32; m >= 1; m >>= 1) {
                const bool up = (lane & m) != 0;
#pragma unroll
                for (int i = 0; i < m; ++i) { const float send = up ? part[i] : part[i + m], keep = up ? part[i + m] : part[i]; part[i] = keep + __shfl_xor(send, m); }
            }
            const float act = gelu_tanh(part[0] * rs1);
            if (half) coef1 = g1 * act * (1.0f / V8_SCALE); else coef0 = g0 * act * (1.0f / V8_SCALE);
        }
        f32x2 acc[8];
#pragma unroll
        for (int i = 0; i < 8; ++i) acc[i] = (f32x2){0.f, 0.f};
#pragma unroll
        for (int half = 0; half < 2; ++half) {
            const int ev = half ? e1 : e0; const float cv = half ? coef1 : coef0;
#pragma unroll 16
            for (int j = 0; j < 64; ++j) {
                const int e = __builtin_amdgcn_readlane(ev, j);
                const float c = __uint_as_float(__builtin_amdgcn_readlane(__float_as_uint(cv), j));
                const u32x4 w = *(const u32x4*)(v8 + (size_t)e * DM + lane * 16);
                const f32x2 c2 = {c, c};
#pragma unroll
                for (int q = 0; q < 4; ++q) {
                    acc[2 * q] = __builtin_elementwise_fma(__builtin_amdgcn_cvt_pk_f32_fp8((int)w[q], false), c2, acc[2 * q]);
                    acc[2 * q + 1] = __builtin_elementwise_fma(__builtin_amdgcn_cvt_pk_f32_fp8((int)w[q], true), c2, acc[2 * q + 1]);
                }
            }
        }
        float* hr = h + (size_t)tok * DM + lane * 16;
        u32x4 w0, w1; float ss = 0.f;
#pragma unroll
        for (int q4 = 0; q4 < 4; ++q4) {
            f32x4 hv = *(f32x4*)(hr + 4 * q4);
            hv += (f32x4){acc[2 * q4].x, acc[2 * q4].y, acc[2 * q4 + 1].x, acc[2 * q4 + 1].y};
            *(f32x4*)(hr + 4 * q4) = hv;
            ss += (hv[0] * hv[0] + hv[1] * hv[1]) + (hv[2] * hv[2] + hv[3] * hv[3]);
            const unsigned a_ = pk_bf16(hv[0], hv[1]), b_ = pk_bf16(hv[2], hv[3]);
            if (q4 == 0) { w0.x = a_; w0.y = b_; } else if (q4 == 1) { w0.z = a_; w0.w = b_; } else if (q4 == 2) { w1.x = a_; w1.y = b_; } else { w1.z = a_; w1.w = b_; }
        }
        *(u32x4*)(hb + (size_t)tok * DM + lane * 16) = w0; *(u32x4*)(hb + (size_t)tok * DM + lane * 16 + 8) = w1;
        ss = wave_sum(ss);
        if (lane == 0) rs2[tok] = rsqrtf(ss * (1.0f / DM) + EPS);
    }
}
constexpr int LDS_MISC = 160 * 1024 - 256;
constexpr int LDS_BYTES = 160 * 1024;
constexpr size_t CTL_BAR = 0;
static_assert(XCD_BAR_WORDS * 4 <= 64 * 1024, "control region");

template <class F> struct EpiAdapt {
    static constexpr bool PERM = true, AFTER_DRAIN = false;
    F f;
    DI void operator()(const f32x4 (&acc)[2][2][4][2], const pg8::Unit& u, int wr, int wc, int fr, int fq) const {
        const int row0 = u.pm * 256 + wr * 64 + fr, col0 = u.pn * 256 + wc * 32 + 8 * fq;
#pragma unroll
        for (int ai = 0; ai < 2; ++ai)
#pragma unroll
            for (int m = 0; m < 4; ++m) {
                const int row = row0 + ai * 128 + m * 16;
#pragma unroll
                for (int bj = 0; bj < 2; ++bj)
#pragma unroll
                    for (int n = 0; n < 2; ++n) f.store4(row, col0 + bj * 128 + 4 * n, acc[ai][bj][m][n]);
            }
    }
};
template <class F> struct EpiAdaptSsq {
    static constexpr bool PERM = true, AFTER_DRAIN = false;
    F f; float* ssq;
    DI void operator()(const f32x4 (&acc)[2][2][4][2], const pg8::Unit& u, int wr, int wc, int fr, int fq) const {
        const int row0 = u.pm * 256 + wr * 64 + fr, col0 = u.pn * 256 + wc * 32 + 8 * fq;
#pragma unroll
        for (int ai = 0; ai < 2; ++ai)
#pragma unroll
            for (int m = 0; m < 4; ++m) {
                const int row = row0 + ai * 128 + m * 16;
                float s = 0.f; const float rsc = f.rowscale(row);
#pragma unroll
                for (int bj = 0; bj < 2; ++bj)
#pragma unroll
                    for (int n = 0; n < 2; ++n) { const f32x4 v = f.store4r(row, col0 + bj * 128 + 4 * n, acc[ai][bj][m][n], rsc); s += (v[0] * v[0] + v[1] * v[1]) + (v[2] * v[2] + v[3] * v[3]); }
                s += __shfl_xor(s, 16); s += __shfl_xor(s, 32);
                if (fq == 0) ssq[(size_t)(u.pn * 4 + wc) * NTOK + row] = s;
            }
    }
};
struct EpiOutR {
    const float* x; float* h1; bf16_t* h1b;
    DI float rowscale(int) const { return 0.f; }
    DI f32x4 store4r(int row, int col, f32x4 v, float) const {
        const size_t o = (size_t)row * DM + col;
        v += *(const f32x4*)(x + o);
        *(f32x4*)(h1 + o) = v;
        u32x2 w; w.x = pack2bf(v[0], v[1]); w.y = pack2bf(v[2], v[3]); *(u32x2*)(h1b + o) = w;
        return v;
    }
};
struct EpiGateR {
    const float* rs2; const float* bias; const float* pp; float* h;
    DI float rowscale(int row) const {
#if PEER_V2 && !PEER_V6
        float s = 0.f;
#pragma unroll
        for (int j = 0; j < (PEER_V3 ? 8 : 16); ++j) s += rs2[(size_t)j * NTOK + row];
        return rsqrtf(s * (1.0f / DM) + EPS);
#else
        return rs2[row];
#endif
    }
    DI f32x4 store4r(int row, int col, f32x4 v, float s) const {
        const size_t o = (size_t)row * DM + col;
        const f32x4 bb = *(const f32x4*)(bias + col), p4 = *(const f32x4*)(pp + o);
        f32x4 hv = *(f32x4*)(h + o);
#pragma unroll
        for (int j = 0; j < 4; ++j) hv[j] += sigmoidf_(v[j] * s + bb[j]) * p4[j];
        *(f32x4*)(h + o) = hv;
        return hv;
    }
};

struct MegaArgs { Params p; int ph_lo, ph_hi; };

__global__ void __launch_bounds__(MK_THREADS, 2) mega_fwd(MegaArgs args) {
    extern __shared__ __attribute__((aligned(16))) unsigned char lds_raw[];
    LAS unsigned char* lds = (LAS unsigned char*)lds_raw;
    const Params& p = args.p;
    unsigned char* ws = p.ws;
    const int lo = args.ph_lo, hi = args.ph_hi;
    const int G = gridDim.x;
    volatile LAS unsigned* misc = (volatile LAS unsigned*)(lds + LDS_MISC);
    if (threadIdx.x < 64) misc[threadIdx.x] = 0u;
    __syncthreads();
    XcdBarrier bar; bar.bar = (unsigned*)(ws + WS_CTL); bar.x = 0; bar.st = nullptr;
    bar = xcd_barrier_post((unsigned*)(ws + WS_CTL), misc);
#define IN(k) (lo <= (k) && (k) < hi)
#define SEAM(k) do { if (IN(k) && IN((k) + 1)) xcd_barrier(bar); } while (0)

    if (IN(0)) p0_prologue(p, lds, G);
    SEAM(0);
    if (IN(1)) {
        pg8::Gemm g{(const bf16_t*)(ws + WS_XB), (const bf16_t*)(ws + WS_WIN), NTOK, NPROJ, DM};
        pg8::StaticOrder S; S.init(NTOK, NPROJ, G, (int)blockIdx.x);
        EpiAdapt<EpiProj> E{{(const float*)(ws + WS_RS0), (bf16_t*)(ws + R_QB), (bf16_t*)(ws + R_KC), (float*)(ws + R_GATE), (float*)(ws + R_XR), (bf16_t*)(ws + R_XG)}};
        pg8::gemm_phase<EpiAdapt<EpiProj>, pg8::StaticOrder>(lds, g, S, E, nullptr);
    }
    SEAM(1);
    if (IN(2)) { if (!CMP_NAIVE) { p2_compress(p, lds, G); p2_vtranspose(p, lds, G); } lru_phase<false>(p, lds, G); }
    SEAM(2);
    if (IN(3)) { p3_attention(p, lds, G); if (!LRU_NAIVE) lru_phase<true>(p, lds, G); }
    SEAM(3);
    if (IN(4)) {
        pg8::Gemm g{(const bf16_t*)(ws + WS_XB), (const bf16_t*)(ws + WS_WOUT), NTOK, DM, DM};
        pg8::StaticOrder S; S.init(NTOK, DM, G, (int)blockIdx.x);
        EpiAdaptSsq<EpiOutR> E{{p.in[I_X], p.out, (bf16_t*)(ws + R_H1B)}, (float*)(ws + WS_SSQ1)};
        pg8::gemm_phase<EpiAdaptSsq<EpiOutR>, pg8::StaticOrder>(lds, g, S, E, nullptr);
    }
    SEAM(4);
    if (IN(5)) p5_peer_route(p, lds, G);
    SEAM(5);
    if (IN(6)) {
#if PEER_V6
        p6v6_peer(p, G);
#elif PEER_V3
        p6v5_u(p, lds, G);
#ifdef PROBE_U2
        p6v5_u(p, lds, G);
#endif
        xcd_barrier(bar);
#ifdef PROBE_V2
        p6v3_v<1>(p, G);
#endif
        p6v3_v<0>(p, G);
#elif PEER_V2
        p6_peer_u(p, G);
#ifdef PROBE_U2
        p6_peer_u(p, G);
#endif
        xcd_barrier(bar); p6_peer_v(p, G);
#else
        p6_peer_apply(p, G);
#endif
    }
    SEAM(6);
    if (IN(7)) {
        {
            pg8::Gemm g{(const bf16_t*)(ws + WS_PB), (const bf16_t*)(ws + WS_WP), NTOK, DM, PLE};
            pg8::StaticOrder S; S.init(NTOK, DM, G, (int)blockIdx.x);
            EpiAdapt<EpiF32Plain> E{{(float*)(ws + R_BIG), DM, 0}};
            pg8::gemm_phase<EpiAdapt<EpiF32Plain>, pg8::StaticOrder>(lds, g, S, E, nullptr);
        }
        __syncthreads();
        {
            pg8::Gemm g{(const bf16_t*)(ws + R_H1B), (const bf16_t*)(ws + WS_WG), NTOK, DM, DM};
            pg8::StaticOrder S; S.init(NTOK, DM, G, (int)blockIdx.x);
            EpiAdaptSsq<EpiGateR> E{{(const float*)(ws + ((PEER_V2 && !PEER_V6) ? WS_SSQ2 : WS_RS2)), p.in[I_PLE_BG], (const float*)(ws + R_BIG), p.out}, (float*)(ws + WS_SSQ3)};
            pg8::gemm_phase<EpiAdaptSsq<EpiGateR>, pg8::StaticOrder>(lds, g, S, E, nullptr);
        }
    }
    SEAM(7);
    if (IN(8)) p8_final_norm(p, G);
#undef IN
#undef SEAM
}

static int g_grid = 0;
static void launch_mega(hipStream_t st, const Params& p, int lo, int hi) {
    if (g_grid == 0) {
        int dev = 0, cus = 0, per_cu = 0;
        hipGetDevice(&dev); hipDeviceGetAttribute(&cus, hipDeviceAttributeMultiprocessorCount, dev);
        if (hipFuncSetAttribute((const void*)mega_fwd, hipFuncAttributeMaxDynamicSharedMemorySize, LDS_BYTES) != hipSuccess) { fprintf(stderr, "hipFuncSetAttribute failed\n"); g_grid = -1; return; }
        if (hipOccupancyMaxActiveBlocksPerMultiprocessor(&per_cu, (const void*)mega_fwd, MK_THREADS, LDS_BYTES) != hipSuccess || per_cu < 1) { fprintf(stderr, "occupancy query: %d per CU\n", per_cu); }
        (void)hipGetLastError();
        g_grid = cus;
    }
    if (g_grid < 0) return;
    MegaArgs a{}; a.p = p; a.ph_lo = lo; a.ph_hi = hi;
    hipLaunchKernelGGL(mega_fwd, dim3(g_grid), dim3(MK_THREADS), LDS_BYTES, st, a);
}
template <class Epi> static void gemm_naive(hipStream_t st, const bf16_t* A, int lda, const bf16_t* Bt, int ldb, int M, int N, int K, const Epi& E) {
    hipLaunchKernelGGL((k_gemm_naive<Epi>), dim3(N / 64, M / 64), dim3(256), 0, st, A, lda, Bt, ldb, K, E);
}

static void run_prologue_naive(hipStream_t st, const Params& p) {
    unsigned char* ws = p.ws;
    hipLaunchKernelGGL(k_prep_x, dim3(NTOK), dim3(256), 0, st, p.in[I_X], (bf16_t*)(ws + WS_XB), (float*)(ws + WS_RS0));
    hipLaunchKernelGGL(k_prep_win, dim3((NPROJ * DM + 255) / 256), dim3(256), 0, st, p.in[I_W_IN], p.in[I_ATTN_NORM], (bf16_t*)(ws + WS_WIN));
    hipLaunchKernelGGL(k_transpose_bf16, dim3(DM * DM / 256), dim3(256), 0, st, p.in[I_W_OUT], (const float*)nullptr, (bf16_t*)(ws + WS_WOUT), DM, DM);
    hipLaunchKernelGGL(k_transpose_bf16, dim3(DM * DM / 256), dim3(256), 0, st, p.in[I_PLE_WG], p.in[I_PLE_NORM], (bf16_t*)(ws + WS_WG), DM, DM);
    hipLaunchKernelGGL(k_transpose_bf16, dim3(PLE * DM / 256), dim3(256), 0, st, p.in[I_PLE_PROJ], (const float*)nullptr, (bf16_t*)(ws + WS_WP), PLE, DM);
    hipLaunchKernelGGL(k_transpose_bf16, dim3(2048 * 256 / 256), dim3(256), 0, st, p.in[I_CK_W1], (const float*)nullptr, (bf16_t*)(ws + WS_CW1K), 2048, 256);
    hipLaunchKernelGGL(k_transpose_bf16, dim3(2048 * 256 / 256), dim3(256), 0, st, p.in[I_CV_W1], (const float*)nullptr, (bf16_t*)(ws + WS_CW1V), 2048, 256);
    hipLaunchKernelGGL(k_prep_wqs, dim3(DM * 16), dim3(128), 0, st, p.in[I_PEER_WQ], p.in[I_PEER_SUB], p.in[I_FFN_NORM], (bf16_t*)(ws + WS_WQS));
    hipLaunchKernelGGL(k_cvt_bf16, dim3(2048), dim3(256), 0, st, p.in[I_PEER_U], p.in[I_FFN_NORM], (bf16_t*)(ws + WS_UB), (size_t)16384 * DM / 4, DM);
    hipLaunchKernelGGL(k_cvt_bf16, dim3(2048), dim3(256), 0, st, p.in[I_PEER_V], (const float*)nullptr, (bf16_t*)(ws + WS_VB), (size_t)16384 * DM / 4, DM);
    hipLaunchKernelGGL(k_cvt_bf16, dim3(1024), dim3(256), 0, st, p.in[I_P], (const float*)nullptr, (bf16_t*)(ws + WS_PB), (size_t)NTOK * PLE / 4, PLE);
    hipLaunchKernelGGL(k_prep_cmpbias, dim3(1), dim3(256), 0, st, p.in[I_CK_PE], p.in[I_CK_W1], (float*)(ws + WS_CBK));
    hipLaunchKernelGGL(k_prep_cmpbias, dim3(1), dim3(256), 0, st, p.in[I_CV_PE], p.in[I_CV_W1], (float*)(ws + WS_CBV));
}
static void run_p1_naive(hipStream_t st, const Params& p) {
    unsigned char* ws = p.ws;
    EpiProj E{(const float*)(ws + WS_RS0), (bf16_t*)(ws + R_QB), (bf16_t*)(ws + R_KC), (float*)(ws + R_GATE), (float*)(ws + R_XR), (bf16_t*)(ws + R_XG)};
    gemm_naive(st, (const bf16_t*)(ws + WS_XB), DM, (const bf16_t*)(ws + WS_WIN), DM, NTOK, NPROJ, DM, E);
}
static void run_p2_naive(hipStream_t st, const Params& p) {
    unsigned char* ws = p.ws;
    float* hid = (float*)(ws + WS_HID);
    hipLaunchKernelGGL(k_cmp_hidden, dim3(2048), dim3(256), 0, st, (const bf16_t*)(ws + R_KC), (const bf16_t*)(ws + WS_CW1K), (const float*)(ws + WS_CBK), hid);
    hipLaunchKernelGGL(k_cmp_hidden, dim3(2048), dim3(256), 0, st, (const bf16_t*)(ws + R_VC), (const bf16_t*)(ws + WS_CW1V), (const float*)(ws + WS_CBV), hid + (size_t)2048 * 256);
    hipLaunchKernelGGL(k_cmp_out, dim3(2048), dim3(64), 0, st, (const float*)hid, p.in[I_CK_W2], (float*)(ws + WS_KCMP));
    hipLaunchKernelGGL(k_cmp_out, dim3(2048), dim3(64), 0, st, (const float*)(hid + (size_t)2048 * 256), p.in[I_CV_W2], (float*)(ws + WS_VCMP));
}
static void run_p2_extras(hipStream_t st, const Params& p) {
    unsigned char* ws = p.ws;
    hipLaunchKernelGGL(k_p2_extras, dim3(2048), dim3(256), 0, st, (const bf16_t*)(ws + R_VS), (const bf16_t*)(ws + R_VW), (const float*)(ws + WS_KCMP), (const float*)(ws + WS_VCMP),
                       (bf16_t*)(ws + R_VST), (bf16_t*)(ws + R_VWT), (bf16_t*)(ws + R_KCB), (bf16_t*)(ws + R_VCT));
}
static void run_lru_naive(hipStream_t st, const Params& p) {
    unsigned char* ws = p.ws;
    LruArgs la{(const float*)(ws + R_XR), (const bf16_t*)(ws + R_XG), p.in[I_CONV_W], p.in[I_CONV_B], p.in[I_LRU_WA], p.in[I_LRU_BA], p.in[I_LRU_WX], p.in[I_LRU_BX], p.in[I_LRU_LAM], p.out};
    hipLaunchKernelGGL(k_lru_naive, dim3(NB * 8), dim3(64), 0, st, la);
    hipLaunchKernelGGL(k_grpnorm_lru, dim3(NTOK), dim3(256), 0, st, (const float*)p.out, p.in[I_GN_LRU], (bf16_t*)(ws + WS_XB));
}
static void run_p3_naive(hipStream_t st, const Params& p) {
    unsigned char* ws = p.ws;
    NsaArgs na{(const bf16_t*)(ws + R_QB), (const bf16_t*)(ws + R_KS), (const bf16_t*)(ws + R_VS), (const bf16_t*)(ws + R_KW), (const bf16_t*)(ws + R_VW),
               (const float*)(ws + WS_KCMP), (const float*)(ws + WS_VCMP), (const float*)(ws + R_GATE), p.in[I_REL], p.out};
    hipLaunchKernelGGL(k_nsa_naive, dim3(NB * NKV * T_), dim3(256), 0, st, na);
    LruArgs la{(const float*)(ws + R_XR), (const bf16_t*)(ws + R_XG), p.in[I_CONV_W], p.in[I_CONV_B], p.in[I_LRU_WA], p.in[I_LRU_BA], p.in[I_LRU_WX], p.in[I_LRU_BX], p.in[I_LRU_LAM], p.out};
    hipLaunchKernelGGL(k_lru_naive, dim3(NB * 8), dim3(64), 0, st, la);
    hipLaunchKernelGGL(k_grpnorm, dim3(NTOK), dim3(256), 0, st, (const float*)p.out, p.in[I_GN_ATTN], p.in[I_GN_LRU], (bf16_t*)(ws + WS_XB));
}
static void run_p4_naive(hipStream_t st, const Params& p) {
    unsigned char* ws = p.ws;
    EpiOut E{p.in[I_X], p.out, (bf16_t*)(ws + R_H1B)};
    gemm_naive(st, (const bf16_t*)(ws + WS_XB), DM, (const bf16_t*)(ws + WS_WOUT), DM, NTOK, DM, DM, E);
    hipLaunchKernelGGL(k_rowssq, dim3(NTOK), dim3(256), 0, st, (const float*)p.out, (float*)(ws + WS_SSQ1));
}
static void run_p5_naive(hipStream_t st, const Params& p) {
    unsigned char* ws = p.ws;
    for (int hh = 0; hh < 2; ++hh) {
        EpiF32Plain E{(float*)(ws + R_BIG), 1024, 0};
        gemm_naive(st, (const bf16_t*)(ws + R_H1B), DM, (const bf16_t*)(ws + WS_WQS) + (size_t)hh * 1024 * DM, DM, NTOK, 1024, DM, E);
        hipLaunchKernelGGL(k_peer_route, dim3(NTOK * 4), dim3(256), 0, st, (const float*)(ws + R_BIG), (const float*)(ws + WS_SSQ1), hh, (int*)(ws + R_EXP), (float*)(ws + R_GSM));
    }
}
static void run_p6_naive(hipStream_t st, const Params& p) {
    unsigned char* ws = p.ws;
    hipLaunchKernelGGL(k_peer_apply, dim3(NTOK), dim3(256), 0, st, (const bf16_t*)(ws + WS_UB), (const bf16_t*)(ws + WS_VB), (const int*)(ws + R_EXP), (const float*)(ws + R_GSM),
                       (const float*)(ws + WS_SSQ1), p.out, (bf16_t*)(ws + R_H1B), (float*)(ws + WS_RS2));
}
static void run_p7_naive(hipStream_t st, const Params& p) {
    unsigned char* ws = p.ws;
    EpiF32Plain Ep{(float*)(ws + R_BIG), DM, 0};
    gemm_naive(st, (const bf16_t*)(ws + WS_PB), PLE, (const bf16_t*)(ws + WS_WP), PLE, NTOK, DM, PLE, Ep);
    EpiGate Eg{(const float*)(ws + WS_RS2), p.in[I_PLE_BG], (const float*)(ws + R_BIG), p.out};
    gemm_naive(st, (const bf16_t*)(ws + R_H1B), DM, (const bf16_t*)(ws + WS_WG), DM, NTOK, DM, DM, Eg);
    hipLaunchKernelGGL(k_rowssq, dim3(NTOK), dim3(256), 0, st, (const float*)p.out, (float*)(ws + WS_SSQ3));
}
static void run_p8_naive(hipStream_t st, const Params& p) {
    hipLaunchKernelGGL(k_final_norm, dim3(NTOK), dim3(256), 0, st, p.out, (const float*)(p.ws + WS_SSQ3), p.in[I_FINAL_NORM]);
}
static void run_phase(hipStream_t st, const Params& p, int k) {
    switch (k) {
        case 0: run_prologue_naive(st, p); break;
        case 1: run_p1_naive(st, p); break;
        case 2: run_p2_naive(st, p); if ((OPT_MASK >> 3) & 1) run_p2_extras(st, p); break;
        case 3: run_p3_naive(st, p); break;
        case 4: run_p4_naive(st, p); break;
        case 5: run_p5_naive(st, p); break;
        case 6: run_p6_naive(st, p); break;
        case 7: run_p7_naive(st, p); break;
        case 8: run_p8_naive(st, p); break;
    }
}
extern "C" void kernel_launch(void* const* d_in, const int* in_sizes, int n_in, void* d_out, int out_size, void* d_ws, size_t ws_size, hipStream_t stream) {
    if (n_in != 31 || out_size != NTOK * DM || ws_size < WS_END) { fprintf(stderr, "kernel_launch: unexpected shapes (n_in %d out %d ws %zu)\n", n_in, out_size, ws_size); return; }
    Params p{};
    for (int i = 0; i < 31; ++i) p.in[i] = (const float*)d_in[i];
    p.out = (float*)d_out; p.ws = (unsigned char*)d_ws;
    int k = 0;
    while (k <= 8) {
        if ((OPT_MASK >> k) & 1) {
            int e = k; while (e <= 8 && ((OPT_MASK >> e) & 1)) ++e;
            if (LRU_NAIVE && k <= 3 && e > 4) e = 4;
            if (CMP_NAIVE && k <= 1 && e > 2) e = 2;
            if (CMP_NAIVE && k == 2) { run_p2_naive(stream, p); run_p2_extras(stream, p); }
            hipMemsetAsync((char*)d_ws + WS_CTL, 0, XCD_BAR_WORDS * 4, stream);
            launch_mega(stream, p, k, e);
            if (LRU_NAIVE && k <= 3 && e == 4) run_lru_naive(stream, p);
            k = e;
        } else { run_phase(stream, p, k); ++k; }
    }
}
```

```cpp
#include <hip/hip_runtime.h>
#include <stdint.h>
#include <stdio.h>

typedef unsigned short bf16_t;
typedef float f32x4 __attribute__((ext_vector_type(4)));
typedef float f32x2 __attribute__((ext_vector_type(2)));
typedef unsigned u32x4 __attribute__((ext_vector_type(4)));
typedef unsigned u32x2 __attribute__((ext_vector_type(2)));
#define DI __device__ __forceinline__

constexpr int NB = 4, T_ = 4096, DM = 1024, NTOK = NB * T_;
constexpr int NH = 8, HD = 64, NKV = 2, GRP = 4, ATTW = 512, KVW = 128, LRUW = 512;
constexpr int INCOLS = 2328, NPROJ = 2560;
constexpr int NCMP = 255, NSEL = 64;
constexpr int PEER_H = 8, PEER_K = 16, PEER_NK = 128;
constexpr int PLE = 256;
constexpr float EPS = 1e-6f;

constexpr int PC_KV = 512, PC_XR = 1280, PC_XG = 1792, PC_GATE = 2304;

constexpr size_t MB = 1024 * 1024;
constexpr size_t WS_CTL   = 0;
constexpr size_t WS_WIN   = 64 * 1024;
constexpr size_t WS_WOUT  = WS_WIN  + (size_t)NPROJ * DM * 2;
constexpr size_t WS_WQS   = WS_WOUT + (size_t)DM * DM * 2;
constexpr size_t WS_WG    = WS_WQS  + (size_t)2048 * DM * 2;
constexpr size_t WS_WP    = WS_WG   + (size_t)DM * DM * 2;
constexpr size_t WS_CW1K  = WS_WP   + (size_t)DM * PLE * 2;
constexpr size_t WS_CW1V  = WS_CW1K + (size_t)256 * 2048 * 2;
constexpr size_t WS_CBK   = WS_CW1V + (size_t)256 * 2048 * 2;
constexpr size_t WS_CBV   = WS_CBK  + 1024;
constexpr size_t WS_RS0   = WS_CBV  + 1024;
constexpr size_t WS_RS2   = WS_RS0  + (size_t)NTOK * 4;
constexpr size_t WS_RS1   = WS_RS2  + (size_t)NTOK * 4;
constexpr size_t WS_SSQ2  = WS_RS1  + (size_t)NTOK * 4;
constexpr size_t WS_SSQ1  = WS_SSQ2 + (size_t)16 * NTOK * 4;
constexpr size_t WS_SSQ3  = WS_SSQ1 + (size_t)16 * NTOK * 4;
constexpr size_t WS_KCMP  = WS_SSQ3 + (size_t)16 * NTOK * 4;
constexpr size_t WS_VCMP  = WS_KCMP + (size_t)8 * 256 * 64 * 4;
constexpr size_t WS_LRUP  = WS_VCMP + (size_t)8 * 256 * 64 * 4;
constexpr size_t WS_LRUH  = WS_LRUP + (size_t)256 * 512 * 4;
constexpr size_t WS_WAT   = WS_LRUH + (size_t)256 * 512 * 4;
constexpr size_t WS_WXT   = WS_WAT + 8 * 64 * 64 * 2;
constexpr size_t WS_CW2K  = WS_WXT + 8 * 64 * 64 * 2;
constexpr size_t WS_CW2V  = WS_CW2K + 64 * 256 * 2;
constexpr size_t WS_HID   = WS_CW2V + 64 * 256 * 2;
constexpr size_t WS_UB    = (WS_HID + (size_t)2 * 2048 * 256 * 4 + 4095) / 4096 * 4096;
constexpr size_t WS_VB    = WS_UB + (size_t)16384 * DM * 2;
constexpr size_t WS_PB    = WS_VB + (size_t)16384 * DM * 2;
constexpr size_t WS_XB    = WS_PB + (size_t)NTOK * PLE * 2;
constexpr size_t WS_R     = WS_XB + (size_t)NTOK * DM * 2;
constexpr size_t KVT = (size_t)NB * NKV * T_ * HD * 2 + 65536;
constexpr size_t R_QB    = WS_R;
constexpr size_t R_KC    = R_QB + (size_t)NTOK * 512 * 2;
constexpr size_t R_VC    = R_KC + KVT;
constexpr size_t R_KS    = R_VC + KVT;
constexpr size_t R_VS    = R_KS + KVT;
constexpr size_t R_KW    = R_VS + KVT;
constexpr size_t R_VW    = R_KW + KVT;
constexpr size_t R_GATE  = R_VW + KVT;
constexpr size_t R_XR    = R_GATE + (size_t)NTOK * 24 * 4;
constexpr size_t R_XG    = R_XR + (size_t)NTOK * 512 * 4;
constexpr size_t R_VST   = R_XG + (size_t)NTOK * 512 * 2;
constexpr size_t R_VWT   = R_VST + KVT;
constexpr size_t R_KCB   = R_VWT + KVT;
constexpr size_t R_VCT   = R_KCB + (size_t)8 * 256 * 64 * 2;
constexpr size_t R_END13 = R_VCT + (size_t)8 * 256 * 64 * 2;
constexpr size_t R_H1B   = WS_R;
constexpr size_t R_EXP   = R_H1B + (size_t)NTOK * DM * 2;
constexpr size_t R_GSM   = R_EXP + (size_t)NTOK * 128 * 4;
constexpr size_t R_COEF  = R_GSM + (size_t)NTOK * 128 * 4;
constexpr size_t R_BIG   = R_COEF + (size_t)NTOK * 128 * 4;
constexpr size_t WS_END  = (R_END13 > R_BIG + 64 * MB ? R_END13 : R_BIG + 64 * MB);
static_assert(WS_END <= 256 * MB, "workspace map exceeds 256 MiB");

DI float bf2f(bf16_t v) { return __uint_as_float((unsigned)v << 16); }
DI bf16_t f2bf(float x) { unsigned u = __float_as_uint(x); u += 0x7fffu + ((u >> 16) & 1u); return (bf16_t)(u >> 16); }
DI unsigned pack2bf(float lo, float hi) { return (unsigned)f2bf(lo) | ((unsigned)f2bf(hi) << 16); }
DI float gelu_tanh(float x) { const float u = 0.7978845608028654f * (x + 0.044715f * x * x * x); return 0.5f * x * (1.0f + tanhf(u)); }
DI float sigmoidf_(float x) { return 1.0f / (1.0f + __expf(-x)); }

__device__ const unsigned char REL_BUCKET_LUT[128] = {
0,1,2,3,4,5,6,7,8,9,10,11,12,13,14,15,16,16,16,17,17,18,18,18,19,19,19,20,20,20,20,21,21,21,21,22,22,22,22,22,23,23,23,23,23,23,24,24,24,24,24,24,25,25,25,25,25,25,25,26,26,26,26,26,26,26,26,27,27,27,27,27,27,27,27,27,27,28,28,28,28,28,28,28,28,28,28,29,29,29,29,29,29,29,29,29,29,29,29,30,30,30,30,30,30,30,30,30,30,30,30,30,30,31,31,31,31,31,31,31,31,31,31,31,31,31,31,31};
DI int rel_bucket(int dist) { dist = dist < 0 ? 0 : dist; return dist >= 128 ? 31 : (int)REL_BUCKET_LUT[dist]; }

struct Params {
    const float* in[31];
    float* out;
    unsigned char* ws;
};
enum { I_X = 0, I_P, I_ATTN_NORM, I_W_IN, I_CK_PE, I_CK_W1, I_CK_W2, I_CV_PE, I_CV_W1, I_CV_W2, I_REL, I_CONV_W, I_CONV_B, I_LRU_WA, I_LRU_BA, I_LRU_WX, I_LRU_BX,
       I_LRU_LAM, I_GN_ATTN, I_GN_LRU, I_W_OUT, I_FFN_NORM, I_PEER_WQ, I_PEER_SUB, I_PEER_U, I_PEER_V, I_PLE_NORM, I_PLE_WG, I_PLE_BG, I_PLE_PROJ, I_FINAL_NORM };

struct EpiProj {
    const float* rs0; bf16_t* qb; bf16_t* kv0; float* gates; float* xr; bf16_t* xg;
    DI void store4(int row, int col, f32x4 v) const {
        const float s = rs0[row];
        v *= s;
        if (col < PC_KV) { v *= 0.125f; u32x2 w; w.x = pack2bf(v[0], v[1]); w.y = pack2bf(v[2], v[3]); *(u32x2*)(qb + (size_t)row * 512 + col) = w; }
        else if (col < PC_XR) {
            const int c = col - PC_KV, tensor = c >> 7, within = c & 127, kvh = within >> 6, d = within & 63, b = row >> 12, t = row & 4095;
            bf16_t* dst = (bf16_t*)((unsigned char*)kv0 + (size_t)tensor * KVT) + ((size_t)(b * NKV + kvh) * T_ + t) * HD + d;
            u32x2 w; w.x = pack2bf(v[0], v[1]); w.y = pack2bf(v[2], v[3]); *(u32x2*)dst = w;
        }
        else if (col < PC_XG) { *(f32x4*)(xr + (size_t)row * 512 + (col - PC_XR)) = v; }
        else if (col < PC_GATE) { u32x2 w; w.x = pack2bf(v[0], v[1]); w.y = pack2bf(v[2], v[3]); *(u32x2*)(xg + (size_t)row * 512 + (col - PC_XG)) = w; }
        else if (col < PC_GATE + 24) { *(f32x4*)(gates + (size_t)row * 24 + (col - PC_GATE)) = v; }
    }
};
struct EpiOut {
    const float* x; float* h1; bf16_t* h1b;
    DI void store4(int row, int col, f32x4 v) const {
        const size_t o = (size_t)row * DM + col;
        v += *(const f32x4*)(x + o);
        *(f32x4*)(h1 + o) = v;
        u32x2 w; w.x = pack2bf(v[0], v[1]); w.y = pack2bf(v[2], v[3]); *(u32x2*)(h1b + o) = w;
    }
};
struct EpiF32Plain { float* C; int ldc; int coloff;
    DI void store4(int row, int col, f32x4 v) const { *(f32x4*)(C + (size_t)row * ldc + (col - coloff)) = v; } };
struct EpiGate {
    const float* rs2; const float* bias; const float* pp; float* h;
    DI void store4(int row, int col, f32x4 v) const {
        const size_t o = (size_t)row * DM + col;
        const float s = rs2[row];
        const f32x4 bb = *(const f32x4*)(bias + col), p4 = *(const f32x4*)(pp + o);
        f32x4 hv = *(f32x4*)(h + o);
#pragma unroll
        for (int j = 0; j < 4; ++j) hv[j] += sigmoidf_(v[j] * s + bb[j]) * p4[j];
        *(f32x4*)(h + o) = hv;
    }
};
#ifndef LRU_NAIVE
#define LRU_NAIVE 0
#endif
#ifndef CMP_NAIVE
#define CMP_NAIVE 0
#endif
#ifndef OPT_MASK
#define OPT_MASK 0x1FF
#endif
#ifndef PEER_V6
#define PEER_V6 3
#endif
#ifndef PEER_V3
#define PEER_V3 1
#endif
#ifndef PEER_V2
#define PEER_V2 1
#endif
DI float wave_sum(float v) {
#pragma unroll
    for (int o = 32; o > 0; o >>= 1) v += __shfl_xor(v, o);
    return v;
}
DI float wave_max(float v) {
#pragma unroll
    for (int o = 32; o > 0; o >>= 1) v = fmaxf(v, __shfl_xor(v, o));
    return v;
}
DI float block_sum256(float v, float* red) {
    v = wave_sum(v); __syncthreads();
    if ((threadIdx.x & 63) == 0) red[threadIdx.x >> 6] = v; __syncthreads();
    return (red[0] + red[1]) + (red[2] + red[3]);
}
DI float block_max256(float v, float* red) {
    v = wave_max(v); __syncthreads();
    if ((threadIdx.x & 63) == 0) red[threadIdx.x >> 6] = v; __syncthreads();
    return fmaxf(fmaxf(red[0], red[1]), fmaxf(red[2], red[3]));
}

__global__ __launch_bounds__(256) void k_prep_x(const float* __restrict__ x, bf16_t* __restrict__ xb, float* __restrict__ rs0) {
    __shared__ float red[8];
    const int row = blockIdx.x, t = threadIdx.x;
    const f32x4 v = *(const f32x4*)(x + (size_t)row * DM + t * 4);
    float s = v[0] * v[0] + v[1] * v[1] + v[2] * v[2] + v[3] * v[3];
    s = block_sum256(s, red);
    u32x2 w; w.x = pack2bf(v[0], v[1]); w.y = pack2bf(v[2], v[3]);
    *(u32x2*)(xb + (size_t)row * DM + t * 4) = w;
    if (t == 0) rs0[row] = rsqrtf(s * (1.0f / DM) + EPS);
}
__global__ void k_prep_win(const float* __restrict__ w_in, const float* __restrict__ gain, bf16_t* __restrict__ WinT) {
    const int idx = blockIdx.x * blockDim.x + threadIdx.x;
    if (idx >= NPROJ * DM) return;
    const int n = idx / DM, k = idx % DM;
    int src = -1;
    if (n < PC_XR) src = n; else if (n < PC_XG) src = 1304 + (n - PC_XR); else if (n < PC_GATE) src = 1816 + (n - PC_XG); else if (n < PC_GATE + 24) src = 1280 + (n - PC_GATE);
    WinT[idx] = src >= 0 ? f2bf(w_in[(size_t)k * INCOLS + src] * gain[k]) : (bf16_t)0;
}
__global__ void k_transpose_bf16(const float* __restrict__ src, const float* __restrict__ gain, bf16_t* __restrict__ dst, int K, int N) {
    const int idx = blockIdx.x * blockDim.x + threadIdx.x;
    if (idx >= K * N) return;
    const int n = idx / K, k = idx % K;
    dst[idx] = f2bf(src[(size_t)k * N + n] * (gain ? gain[k] : 1.0f));
}
__global__ __launch_bounds__(128) void k_prep_wqs(const float* __restrict__ wq, const float* __restrict__ sub, const float* __restrict__ gain, bf16_t* __restrict__ WqsT) {
    __shared__ float wrow[128];
    const int d = blockIdx.x % DM, hp = blockIdx.x / DM, p = hp & 1, kk = threadIdx.x;
    wrow[kk] = wq[(size_t)d * 2048 + hp * 128 + kk];
    __syncthreads();
    const float* sk = sub + ((size_t)p * 128 + kk) * 128;
    float acc = 0.f;
    for (int j = 0; j < 128; ++j) acc += wrow[j] * sk[j];
    WqsT[(size_t)(hp * 128 + kk) * DM + d] = f2bf(acc * gain[d]);
}
__global__ void k_cvt_bf16(const float* __restrict__ src, const float* __restrict__ gain, bf16_t* __restrict__ dst, size_t n4, int cols) {
    for (size_t i = (size_t)blockIdx.x * blockDim.x + threadIdx.x; i < n4; i += (size_t)gridDim.x * blockDim.x) {
        f32x4 v = *(const f32x4*)(src + i * 4);
        if (gain) { const f32x4 g = *(const f32x4*)(gain + (i * 4) % cols); v *= g; }
        u32x2 w; w.x = pack2bf(v[0], v[1]); w.y = pack2bf(v[2], v[3]);
        *(u32x2*)(dst + i * 4) = w;
    }
}
__global__ __launch_bounds__(256) void k_prep_cmpbias(const float* __restrict__ pe, const float* __restrict__ w1, float* __restrict__ cb) {
    const int j = threadIdx.x; float acc = 0.f;
    for (int k = 0; k < 2048; ++k) acc += pe[k] * w1[(size_t)k * 256 + j];
    cb[j] = acc;
}

template <class Epi>
__global__ __launch_bounds__(256) void k_gemm_naive(const bf16_t* __restrict__ A, int lda, const bf16_t* __restrict__ Bt, int ldb, int K, Epi E) {
    __shared__ float As[32][68], Bs[32][68];
    const int t = threadIdx.x, tx = t & 15, ty = t >> 4;
    const int row0 = blockIdx.y * 64, col0 = blockIdx.x * 64;
    float acc[4][4] = {};
    const int lr = t >> 2, lk = (t & 3) * 8;
    for (int k0 = 0; k0 < K; k0 += 32) {
        const u32x4 av = *(const u32x4*)(A + (size_t)(row0 + lr) * lda + k0 + lk);
        const u32x4 bv = *(const u32x4*)(Bt + (size_t)(col0 + lr) * ldb + k0 + lk);
        __syncthreads();
#pragma unroll
        for (int j = 0; j < 4; ++j) {
            As[lk + 2 * j][lr] = __uint_as_float(av[j] << 16); As[lk + 2 * j + 1][lr] = __uint_as_float(av[j] & 0xffff0000u);
            Bs[lk + 2 * j][lr] = __uint_as_float(bv[j] << 16); Bs[lk + 2 * j + 1][lr] = __uint_as_float(bv[j] & 0xffff0000u);
        }
        __syncthreads();
#pragma unroll
        for (int k = 0; k < 32; ++k) {
            const f32x4 a = *(const f32x4*)&As[k][ty * 4], b = *(const f32x4*)&Bs[k][tx * 4];
#pragma unroll
            for (int i = 0; i < 4; ++i)
#pragma unroll
                for (int j = 0; j < 4; ++j) acc[i][j] += a[i] * b[j];
        }
    }
#pragma unroll
    for (int i = 0; i < 4; ++i) E.store4(row0 + ty * 4 + i, col0 + tx * 4, (f32x4){acc[i][0], acc[i][1], acc[i][2], acc[i][3]});
}

__global__ __launch_bounds__(256) void k_cmp_hidden(const bf16_t* __restrict__ kvb, const bf16_t* __restrict__ W1T, const float* __restrict__ cb, float* __restrict__ hidden) {
    const int row = blockIdx.x, j = threadIdx.x, bh = row >> 8, c = row & 255;
    if (c >= NCMP) { hidden[(size_t)row * 256 + j] = 0.f; return; }
    const bf16_t* a = kvb + ((size_t)bh * T_ + 16 * c) * HD;
    const bf16_t* w = W1T + (size_t)j * 2048;
    float acc = 0.f;
    for (int k = 0; k < 2048; ++k) acc += bf2f(a[k]) * bf2f(w[k]);
    hidden[(size_t)row * 256 + j] = acc + cb[j];
}
__global__ __launch_bounds__(64) void k_cmp_out(const float* __restrict__ hidden, const float* __restrict__ w2, float* __restrict__ out) {
    const int row = blockIdx.x, d = threadIdx.x;
    float acc = 0.f;
    for (int j = 0; j < 256; ++j) acc += gelu_tanh(hidden[(size_t)row * 256 + j]) * w2[j * 64 + d];
    out[(size_t)row * 64 + d] = acc;
}

struct NsaArgs { const bf16_t* qb; const bf16_t* ks; const bf16_t* vs; const bf16_t* kw; const bf16_t* vw; const float* kcmp; const float* vcmp; const float* gates; const float* rel; float* raw; };
template <bool KF32> DI void nsa_logits(int nk, const void* Kbase, const int* kp, const int* dist, float (*lg)[1024], const float (*qs)[64], const float* rel, int kvh) {
    for (int idx = threadIdx.x; idx < nk; idx += 256) {
        float acc[4] = {0.f, 0.f, 0.f, 0.f};
        if (dist[idx] >= 0) {
            if (KF32) { const float* kr = (const float*)Kbase + (size_t)kp[idx] * HD;
                for (int d = 0; d < 64; ++d) { const float kv = kr[d]; for (int g = 0; g < 4; ++g) acc[g] += qs[g][d] * kv; } }
            else { const bf16_t* kr = (const bf16_t*)Kbase + (size_t)kp[idx] * HD;
                for (int d = 0; d < 64; ++d) { const float kv = bf2f(kr[d]); for (int g = 0; g < 4; ++g) acc[g] += qs[g][d] * kv; } }
            const int bk = rel_bucket(dist[idx]);
            for (int g = 0; g < 4; ++g) lg[g][idx] = acc[g] + rel[bk * NH + kvh * 4 + g];
        } else { for (int g = 0; g < 4; ++g) lg[g][idx] = -INFINITY; }
    }
}
DI void nsa_softmax(int nk, float (*lg)[1024], float* inv, float* red) {
    for (int g = 0; g < 4; ++g) {
        float m = -INFINITY;
        for (int idx = threadIdx.x; idx < nk; idx += 256) m = fmaxf(m, lg[g][idx]);
        m = block_max256(m, red);
        float s = 0.f;
        for (int idx = threadIdx.x; idx < nk; idx += 256) { const float l = lg[g][idx]; const float e = (l == -INFINITY) ? 0.f : __expf(l - m); lg[g][idx] = e; s += e; }
        s = block_sum256(s, red);
        if (threadIdx.x == 0) inv[g] = 1.0f / s;
    }
    __syncthreads();
}
template <bool VF32> DI float nsa_pv(int nk, const void* Vbase, const int* kp, const float (*lg)[1024], const float* inv) {
    const int g = threadIdx.x >> 6, d = threadIdx.x & 63;
    float acc = 0.f;
    for (int idx = 0; idx < nk; ++idx) {
        const float v = VF32 ? ((const float*)Vbase)[(size_t)kp[idx] * HD + d] : bf2f(((const bf16_t*)Vbase)[(size_t)kp[idx] * HD + d]);
        acc += lg[g][idx] * v;
    }
    return acc * inv[g];
}
__global__ __launch_bounds__(256) void k_nsa_naive(NsaArgs a) {
    __shared__ float qs[4][64]; __shared__ float lg[4][1024]; __shared__ int kp[1024]; __shared__ int dist[1024];
    __shared__ float red[8]; __shared__ float inv[4]; __shared__ float imp[64]; __shared__ float vals[64]; __shared__ int selblk[16]; __shared__ int nsel_s;
    const int tid = threadIdx.x, t = blockIdx.x % T_, kvh = (blockIdx.x / T_) % NKV, b = blockIdx.x / (T_ * NKV), bh = b * NKV + kvh;
    const int g = tid >> 6, d = tid & 63, h = kvh * 4 + g;
    const size_t tok = (size_t)b * T_ + t;
    qs[g][d] = bf2f(a.qb[tok * 512 + h * 64 + d]);
    if (tid == 0) nsel_s = 0;
    const int ncv = t >= 31 ? (t - 31) / 16 + 1 : 0;
    for (int idx = tid; idx < ncv; idx += 256) { kp[idx] = idx; dist[idx] = t - (16 * idx + 31); }
    __syncthreads();
    float o_c = 0.f;
    if (ncv > 0) {
        nsa_logits<true>(ncv, a.kcmp + (size_t)bh * 256 * HD, kp, dist, lg, qs, a.rel, kvh);
        __syncthreads();
        nsa_softmax(ncv, lg, inv, red);
        o_c = nsa_pv<true>(ncv, a.vcmp + (size_t)bh * 256 * HD, kp, lg, inv);
    }
    if (tid < 64) {
        float s = 0.f;
        for (int gg = 0; gg < 4; ++gg) {
            float sg = 0.f;
            for (int j = -1; j <= 3; ++j) { const int c = 4 * tid + j; if (c >= 0 && c < ncv) sg += lg[gg][c] * ((j == -1 || j == 3) ? 0.5f : 1.0f); }
            s += sg * inv[gg];
        }
        if (ncv == 0) s = 0.f;
        const int qblk = t >> 6, db = qblk - tid;
        vals[tid] = (db >= 0 && db < 2) ? 2.0e4f : (tid == 0 ? 1.0e4f : (db >= 0 ? s : -1.0f));
    }
    __syncthreads();
    if (tid < 64) {
        const float v = vals[tid]; int rank = 0;
        for (int s2 = 0; s2 < 64; ++s2) { const float w = vals[s2]; rank += (w > v || (w == v && s2 < tid)) ? 1 : 0; }
        if (rank < 16 && (t >> 6) - tid >= 0) { const int slot = atomicAdd(&nsel_s, 1); selblk[slot] = tid; }
    }
    __syncthreads();
    const int nsel = nsel_s, nks = nsel * 64;
    for (int idx = tid; idx < nks; idx += 256) { const int kpos = selblk[idx >> 6] * 64 + (idx & 63); kp[idx] = kpos; dist[idx] = t - kpos; }
    __syncthreads();
    nsa_logits<false>(nks, a.ks + (size_t)bh * T_ * HD, kp, dist, lg, qs, a.rel, kvh);
    __syncthreads();
    nsa_softmax(nks, lg, inv, red);
    const float o_s = nsa_pv<false>(nks, a.vs + (size_t)bh * T_ * HD, kp, lg, inv);
    __syncthreads();
    const int lo = t - 511 > 0 ? t - 511 : 0, nkw = t - lo + 1;
    for (int idx = tid; idx < nkw; idx += 256) { kp[idx] = lo + idx; dist[idx] = t - (lo + idx); }
    __syncthreads();
    nsa_logits<false>(nkw, a.kw + (size_t)bh * T_ * HD, kp, dist, lg, qs, a.rel, kvh);
    __syncthreads();
    nsa_softmax(nkw, lg, inv, red);
    const float o_w = nsa_pv<false>(nkw, a.vw + (size_t)bh * T_ * HD, kp, lg, inv);
    const float* gt = a.gates + tok * 24 + h * 3;
    a.raw[tok * DM + h * 64 + d] = sigmoidf_(gt[0]) * o_c + sigmoidf_(gt[1]) * o_s + sigmoidf_(gt[2]) * o_w;
}

struct LruArgs { const float* xr; const bf16_t* xg; const float* conv_w; const float* conv_b; const float* wa; const float* ba; const float* wx; const float* bx; const float* lam; float* raw; };
__global__ __launch_bounds__(64) void k_lru_naive(LruArgs a) {
    __shared__ float xs[64];
    const int tid = threadIdx.x, n = blockIdx.x & 7, b = blockIdx.x >> 3, ch = n * 64 + tid;
    float war[64], wxr[64];
#pragma unroll
    for (int c = 0; c < 64; ++c) { war[c] = a.wa[(size_t)(n * 64 + c) * 64 + tid]; wxr[c] = a.wx[(size_t)(n * 64 + c) * 64 + tid]; }
    const float cw0 = a.conv_w[0 * 512 + ch], cw1 = a.conv_w[1 * 512 + ch], cw2 = a.conv_w[2 * 512 + ch], cw3 = a.conv_w[3 * 512 + ch], cb = a.conv_b[ch];
    const float ba = a.ba[ch], bx = a.bx[ch], sp = log1pf(__expf(-a.lam[ch]));
    float x3 = 0.f, x2 = 0.f, x1 = 0.f, h = 0.f;
    for (int t = 0; t < T_; ++t) {
        const size_t tok = (size_t)b * T_ + t;
        const float x0 = a.xr[tok * 512 + ch];
        const float xc = cw0 * x3 + cw1 * x2 + cw2 * x1 + cw3 * x0 + cb;
        x3 = x2; x2 = x1; x1 = x0;
        __syncthreads();
        xs[tid] = xc;
        __syncthreads();
        float rp = 0.f, ip = 0.f;
#pragma unroll
        for (int c = 0; c < 64; ++c) { const float xv = xs[c]; rp += xv * war[c]; ip += xv * wxr[c]; }
        const float r = sigmoidf_(rp + ba), i = sigmoidf_(ip + bx);
        const float log_a = -8.0f * r * sp, aa = __expf(log_a), bb = sqrtf(-expm1f(2.0f * log_a)) * (i * xc);
        h = aa * h + bb;
        a.raw[tok * DM + 512 + ch] = h * gelu_tanh(bf2f(a.xg[tok * 512 + ch]));
    }
}
__global__ __launch_bounds__(256) void k_grpnorm(const float* __restrict__ raw, const float* __restrict__ ga, const float* __restrict__ gl, bf16_t* __restrict__ mixed) {
    __shared__ float red[8];
    const int row = blockIdx.x, t = threadIdx.x;
    const f32x4 v = *(const f32x4*)(raw + (size_t)row * DM + t * 4);
    const float s = v[0] * v[0] + v[1] * v[1] + v[2] * v[2] + v[3] * v[3];
    const float sa = block_sum256(t < 128 ? s : 0.f, red);
    const float sl = block_sum256(t < 128 ? 0.f : s, red);
    const float rs = rsqrtf((t < 128 ? sa : sl) * (1.0f / 512) + EPS);
    const f32x4 g = t < 128 ? *(const f32x4*)(ga + t * 4) : *(const f32x4*)(gl + (t - 128) * 4);
    u32x2 w; w.x = pack2bf(v[0] * rs * g[0], v[1] * rs * g[1]); w.y = pack2bf(v[2] * rs * g[2], v[3] * rs * g[3]);
    *(u32x2*)(mixed + (size_t)row * DM + t * 4) = w;
}
__global__ __launch_bounds__(256) void k_rowssq(const float* __restrict__ h, float* __restrict__ ssq) {
    __shared__ float red[8];
    const int row = blockIdx.x, t = threadIdx.x;
    const f32x4 v = *(const f32x4*)(h + (size_t)row * DM + t * 4);
    float s = v[0] * v[0] + v[1] * v[1] + v[2] * v[2] + v[3] * v[3];
    s = block_sum256(s, red);
    if (t < 16) ssq[(size_t)t * NTOK + row] = t == 0 ? s : 0.f;
}

DI float rs_from_ssq(const float* ssq, int row) { float s = 0.f; for (int j = 0; j < 16; ++j) s += ssq[(size_t)j * NTOK + row]; return rsqrtf(s * (1.0f / DM) + EPS); }
__global__ __launch_bounds__(256) void k_peer_route(const float* __restrict__ scores, const float* __restrict__ ssq1, int hh, int* __restrict__ eout, float* __restrict__ gout) {
    __shared__ float s[256]; __shared__ float tv[2][16]; __shared__ int ti[2][16]; __shared__ float cand[256]; __shared__ float scs[16]; __shared__ int es[16];
    const int tid = threadIdx.x, tok = blockIdx.x >> 2, hl = blockIdx.x & 3, h = hh * 4 + hl;
    const float rs1 = rs_from_ssq(ssq1, tok);
    s[tid] = scores[(size_t)tok * 1024 + hl * 256 + tid] * rs1;
    __syncthreads();
    { const int p = tid >> 7, k = tid & 127; const float v = s[tid]; int rank = 0;
      for (int j = 0; j < 128; ++j) { const float w = s[p * 128 + j]; rank += (w > v || (w == v && j < k)) ? 1 : 0; }
      if (rank < 16) { tv[p][rank] = v; ti[p][rank] = k; } }
    __syncthreads();
    cand[tid] = tv[0][tid >> 4] + tv[1][tid & 15];
    __syncthreads();
    { const float v = cand[tid]; int rank = 0;
      for (int j = 0; j < 256; ++j) { const float w = cand[j]; rank += (w > v || (w == v && j < tid)) ? 1 : 0; }
      if (rank < 16) { scs[rank] = v; es[rank] = ti[0][tid >> 4] * 128 + ti[1][tid & 15]; } }
    __syncthreads();
    if (tid < 16) {
        float m = -INFINITY; for (int j = 0; j < 16; ++j) m = fmaxf(m, scs[j]);
        float sum = 0.f; for (int j = 0; j < 16; ++j) sum += __expf(scs[j] - m);
        eout[(size_t)tok * 128 + h * 16 + tid] = es[tid];
        gout[(size_t)tok * 128 + h * 16 + tid] = __expf(scs[tid] - m) / sum;
    }
}
__global__ __launch_bounds__(256) void k_peer_apply(const bf16_t* __restrict__ ub, const bf16_t* __restrict__ vb, const int* __restrict__ e, const float* __restrict__ gsm,
                                                    const float* __restrict__ ssq1, float* __restrict__ h, bf16_t* __restrict__ hb, float* __restrict__ rs2) {
    __shared__ float xrow[DM]; __shared__ float coef[128]; __shared__ int eid[128]; __shared__ float red[8];
    const int tid = threadIdx.x, tok = blockIdx.x, lane = tid & 63, w = tid >> 6;
    const float rs1 = rs_from_ssq(ssq1, tok);
    for (int i = tid; i < DM; i += 256) xrow[i] = bf2f(hb[(size_t)tok * DM + i]);
    if (tid < 128) eid[tid] = e[(size_t)tok * 128 + tid];
    __syncthreads();
    for (int j = w; j < 128; j += 4) {
        const bf16_t* ur = ub + (size_t)eid[j] * DM;
        float acc = 0.f;
        for (int i = lane; i < DM; i += 64) acc += xrow[i] * bf2f(ur[i]);
        acc = wave_sum(acc);
        if (lane == 0) coef[j] = gsm[(size_t)tok * 128 + j] * gelu_tanh(acc * rs1);
    }
    __syncthreads();
    f32x4 acc = {0.f, 0.f, 0.f, 0.f};
    for (int j = 0; j < 128; ++j) {
        const u32x2 v = *(const u32x2*)(vb + (size_t)eid[j] * DM + tid * 4); const float c = coef[j];
        acc[0] += c * __uint_as_float(v.x << 16); acc[1] += c * __uint_as_float(v.x & 0xffff0000u); acc[2] += c * __uint_as_float(v.y << 16); acc[3] += c * __uint_as_float(v.y & 0xffff0000u);
    }
    f32x4 hv = *(f32x4*)(h + (size_t)tok * DM + tid * 4);
    hv += acc;
    *(f32x4*)(h + (size_t)tok * DM + tid * 4) = hv;
    u32x2 wv; wv.x = pack2bf(hv[0], hv[1]); wv.y = pack2bf(hv[2], hv[3]);
    *(u32x2*)(hb + (size_t)tok * DM + tid * 4) = wv;
    float s = hv[0] * hv[0] + hv[1] * hv[1] + hv[2] * hv[2] + hv[3] * hv[3];
    s = block_sum256(s, red);
    if (tid == 0) rs2[tok] = rsqrtf(s * (1.0f / DM) + EPS);
}
__global__ __launch_bounds__(256) void k_final_norm(float* __restrict__ h, const float* __restrict__ ssq3, const float* __restrict__ g) {
    const int row = blockIdx.x, t = threadIdx.x;
    const float rs = rs_from_ssq(ssq3, row);
    f32x4 v = *(f32x4*)(h + (size_t)row * DM + t * 4); const f32x4 gg = *(const f32x4*)(g + t * 4);
    v = v * rs * gg;
    *(f32x4*)(h + (size_t)row * DM + t * 4) = v;
}

__global__ void k_p2_extras(const bf16_t* __restrict__ vs, const bf16_t* __restrict__ vw, const float* __restrict__ kcmp, const float* __restrict__ vcmp,
                            bf16_t* __restrict__ vsT, bf16_t* __restrict__ vwT, bf16_t* __restrict__ kcb, bf16_t* __restrict__ vcT) {
    const size_t n = (size_t)NB * NKV * T_ * HD;
    for (size_t i = (size_t)blockIdx.x * blockDim.x + threadIdx.x; i < n; i += (size_t)gridDim.x * blockDim.x) {
        const size_t bh = i / ((size_t)T_ * HD); const int t = (int)((i / HD) % T_), d = (int)(i % HD);
        vsT[(bh * HD + d) * T_ + t] = vs[i]; vwT[(bh * HD + d) * T_ + t] = vw[i];
    }
    for (size_t i = (size_t)blockIdx.x * blockDim.x + threadIdx.x; i < (size_t)8 * 256 * 64; i += (size_t)gridDim.x * blockDim.x) {
        const int bh = (int)(i / (256 * 64)), c = (int)((i / 64) % 256), d = (int)(i % 64);
        const bool ok = c < NCMP;
        kcb[i] = ok ? f2bf(kcmp[i]) : (bf16_t)0;
        vcT[((size_t)bh * 64 + d) * 256 + c] = ok ? f2bf(vcmp[i]) : (bf16_t)0;
    }
}
__global__ __launch_bounds__(256) void k_grpnorm_lru(const float* __restrict__ raw, const float* __restrict__ gl, bf16_t* __restrict__ mixed) {
    __shared__ float red[8];
    const int row = blockIdx.x, t = threadIdx.x;
    const f32x2 v = *(const f32x2*)(raw + (size_t)row * DM + 512 + t * 2);
    const float s = block_sum256(v[0] * v[0] + v[1] * v[1], red);
    const float rs = rsqrtf(s * (1.0f / 512) + EPS);
    *(unsigned*)(mixed + (size_t)row * DM + 512 + t * 2) = pack2bf(v[0] * rs * gl[t * 2], v[1] * rs * gl[t * 2 + 1]);
}
#define XB_TMO      128
#define XB_XCNT(j)  (256  + 64 * (j))
#define XB_XSUB(j)  (1280 + 64 * (j))
#define XB_XGEN(j)  (2304 + 64 * (j))
#define XB_TOP      3328
#define XB_TOPGEN   3392
#define XCD_BAR_WORDS 3456
#define XB_SPIN_CAP (1u << 18)
#define LAS __attribute__((address_space(3)))

__device__ __forceinline__ unsigned xb_ld(unsigned* p)              { return __hip_atomic_load(p, __ATOMIC_RELAXED, __HIP_MEMORY_SCOPE_AGENT); }
__device__ __forceinline__ unsigned xb_add(unsigned* p, unsigned v) { return __hip_atomic_fetch_add(p, v, __ATOMIC_RELAXED, __HIP_MEMORY_SCOPE_AGENT); }
__device__ __forceinline__ unsigned xb_xcc_id() { return (unsigned)__builtin_amdgcn_s_getreg((3 << 11) | 20) & 0xFu; }
#define XB_SPIN(cond, bar) do { unsigned _sp = 0; while (cond) { __builtin_amdgcn_s_sleep(1); \
    if ((++_sp & 255u) == 0u) { if (xb_ld(&(bar)[XB_TMO])) break; if (_sp > XB_SPIN_CAP) { atomicAdd(&(bar)[XB_TMO], 1u); break; } } } } while (0)

struct XcdBarrier {
    unsigned* bar; unsigned x;
    volatile LAS unsigned* st;
};

__device__ __forceinline__ XcdBarrier xcd_barrier_post(unsigned* bar, volatile LAS unsigned* st) {
    XcdBarrier b; b.bar = bar; b.x = xb_xcc_id(); b.st = st;
    if (threadIdx.x == 0) (void)xb_add(&bar[XB_XCNT(b.x)], 1u);
    return b;
}
__device__ __forceinline__ void xcd_barrier_complete(unsigned* bar, unsigned x, unsigned& nloc, unsigned& nx) {
    const unsigned G = gridDim.x * gridDim.y * gridDim.z;
    unsigned sum, cnt, mine, sp = 0u;
    for (;;) {
        sum = 0u; cnt = 0u; mine = 0u;
#pragma unroll
        for (unsigned j = 0; j < 16; ++j) { const unsigned c = xb_ld(&bar[XB_XCNT(j)]); sum += c; cnt += (c > 0u) ? 1u : 0u; mine = (j == x) ? c : mine; }
        if (sum == G) break;
        __builtin_amdgcn_s_sleep(1);
        if ((++sp & 255u) == 0u) { if (xb_ld(&bar[XB_TMO])) break; if (sp > XB_SPIN_CAP) { atomicAdd(&bar[XB_TMO], 1u); break; } }
    }
    nloc = mine > 0u ? mine : 1u; nx = cnt > 0u ? cnt : 1u;
}

__device__ __forceinline__ void xcd_barrier(const XcdBarrier& b) {
    asm volatile("s_waitcnt vmcnt(0)" ::: "memory");
    __syncthreads();
    if (threadIdx.x == 0) {
        unsigned* bar = b.bar;
        __builtin_amdgcn_s_waitcnt(0);
        unsigned nloc = b.st[0], nx = b.st[1];
        if (nloc == 0u) { xcd_barrier_complete(bar, b.x, nloc, nx); b.st[0] = nloc; b.st[1] = nx; }
        const unsigned old = xb_add(&bar[XB_XSUB(b.x)], 1u);
        const unsigned gen = old / nloc;
        if (old + 1u == (gen + 1u) * nloc) {
            __builtin_amdgcn_fence(__ATOMIC_RELEASE, "agent");
            asm volatile("s_waitcnt vmcnt(0)" ::: "memory");
            const unsigned og = xb_add(&bar[XB_TOP], 1u);
            const unsigned tg = og / nx;
            if (og + 1u == (tg + 1u) * nx) xb_add(&bar[XB_TOPGEN], 1u);
            else XB_SPIN(xb_ld(&bar[XB_TOPGEN]) == tg, bar);
            __builtin_amdgcn_fence(__ATOMIC_ACQUIRE, "agent");
            xb_add(&bar[XB_XGEN(b.x)], 1u);
            asm volatile("s_waitcnt vmcnt(0)" ::: "memory");
        } else {
            XB_SPIN(xb_ld(&bar[XB_XGEN(b.x)]) == gen, bar);
            __builtin_amdgcn_fence(__ATOMIC_ACQUIRE, "agent");
            asm volatile("s_waitcnt vmcnt(0)" ::: "memory");
        }
    }
    __syncthreads();
}


namespace pg8 {
#define PG8_LAS __attribute__((address_space(3)))
typedef short bf16x8 __attribute__((ext_vector_type(8)));
constexpr int BM = 256, BK = 64, HALF = 128, HTB = HALF * BK * 2  , STAGE_BYTES = 8 * HTB, NXCD = 8, WGM = 8;

__host__ __device__ __forceinline__ int lds_byte(int r, int c) { const int st = (r >> 4) * 2 + (c >> 5), rr = r & 15, cc = c & 31, ob = rr * 64 + cc * 2; return st * 1024 + (ob ^ (((ob >> 9) & 1) << 5)); }
__host__ __device__ __forceinline__ void stage_rc(int b, int& R, int& C) { const int st = b / 1024, sb = b % 1024, swz = sb ^ (((sb >> 9) & 1) << 5); R = (st >> 1) * 16 + swz / 64; C = (st & 1) * 32 + (swz % 64) / 2; }
__host__ __device__ __forceinline__ int perm32(int rho) { const int n = rho >> 4, i = rho & 15; return 8 * (i >> 2) + 4 * n + (i & 3); }

struct Unit { int pm, pn; };
struct Gemm { const bf16_t* A; const bf16_t* Bt; int M, N, K; };

struct StaticOrder {
    int nM, nN, nwg, G, c;
    __host__ __device__ void init(int M, int N, int G_, int c_) { nM = M / BM; nN = N / BM; nwg = nM * nN; G = G_; c = c_; }
    __host__ __device__ bool next(int i, Unit& u) const {
        const long L = (long)i * G + c; if (L >= nwg) return false;
        int wgid = (int)L; { const int q = nwg / NXCD, r = nwg % NXCD, xcd = wgid % NXCD, off = wgid / NXCD; wgid = (xcd < r ? xcd * (q + 1) : r * (q + 1) + (xcd - r) * q) + off; }
        const int nig = WGM * nN, gid = wgid / nig, fm = gid * WGM, gsz = (nM - fm) < WGM ? (nM - fm) : WGM;
        u.pm = fm + ((wgid % nig) % gsz); u.pn = (wgid % nig) / gsz; return true;
    }
    __device__ __forceinline__ void a_ready(const Unit&) const {}
    __device__ __forceinline__ void done(const Unit&) const {}
};
template <class Epi, class Sched, bool STAMP = false>
__device__ __forceinline__ void gemm_phase(PG8_LAS unsigned char* lds, const Gemm g, const Sched& S, const Epi& E, unsigned long long* stamps) {
    const int tid = threadIdx.x, wid = __builtin_amdgcn_readfirstlane(tid >> 6), lane = tid & 63, wr = wid >> 2, wc = wid & 3, fr = lane & 15, fq = lane >> 4;
    const int K = g.K, nt = K / BK;
    int ts_lo = 0, ts_hi = 0, nts = 0; const unsigned long long rt_entry = STAMP ? (unsigned long long)wall_clock64() : 0ull;
#define PG8_STAMP() do { if (STAMP && wid == 0 && nts < 64) { const unsigned long long _c = (unsigned long long)clock64(); \
        ts_lo = (lane == nts) ? (int)(unsigned)_c : ts_lo; ts_hi = (lane == nts) ? (int)(unsigned)(_c >> 32) : ts_hi; ++nts; } } while (0)
    PG8_STAMP();
    unsigned voffA[2], voffB[2];
#pragma unroll
    for (int i = 0; i < 2; ++i) { int R, C; stage_rc(tid * 16 + i * 8192, R, C); const int Rb = Epi::PERM ? ((R & ~31) + perm32(R & 31)) : R;
        voffA[i] = (unsigned)(R * K + C) * 2u; voffB[i] = (unsigned)(Rb * K + C) * 2u; }
    const size_t kstep = (size_t)(BK * 2);
    const size_t hstep = (size_t)HALF * K * 2;
    const size_t tstep = 2 * hstep;
    const unsigned ldsw = (unsigned)wid * 1024u;
    const int aoff = lds_byte(wr * 64 + fr, fq * 8), boff = lds_byte(wc * 32 + fr, fq * 8);
#define PG8_SA(b, h) (((b) * 2 + (h)) * HTB)
#define PG8_SB(b, h) ((4 + (b) * 2 + (h)) * HTB)
#define PG8_STAGE(bufoff, gbase, voff) do { _Pragma("unroll") for (int _i = 0; _i < 2; ++_i) \
        __builtin_amdgcn_global_load_lds((const unsigned*)((const char*)(gbase) + (voff)[_i]), (PG8_LAS unsigned*)(lds + (bufoff) + ldsw + _i * 8192), 16, 0, 0); } while (0)
#define PG8_LDA(dst, b, h) do { _Pragma("unroll") for (int m = 0; m < 4; ++m) _Pragma("unroll") for (int k = 0; k < 2; ++k) dst[m][k] = *(const PG8_LAS bf16x8*)(lds + PG8_SA(b, h) + aoff + m * 2048 + k * 1024); } while (0)
#define PG8_LDB(dst, b, h) do { _Pragma("unroll") for (int n = 0; n < 2; ++n) _Pragma("unroll") for (int k = 0; k < 2; ++k) dst[n][k] = *(const PG8_LAS bf16x8*)(lds + PG8_SB(b, h) + boff + n * 2048 + k * 1024); } while (0)
#define PG8_MMA(ai, bj, At, Bt) do { __builtin_amdgcn_s_setprio(1); _Pragma("unroll") for (int m = 0; m < 4; ++m) _Pragma("unroll") for (int n = 0; n < 2; ++n) _Pragma("unroll") for (int k = 0; k < 2; ++k) \
        acc[ai][bj][m][n] = __builtin_amdgcn_mfma_f32_16x16x32_bf16(Bt[n][k], At[m][k], acc[ai][bj][m][n], 0, 0, 0); __builtin_amdgcn_s_setprio(0); } while (0)
#define PG8_WAIT_V(n) asm volatile("s_waitcnt vmcnt(" #n ")" ::: "memory")
#define PG8_WAIT_L(n) asm volatile("s_waitcnt lgkmcnt(" #n ")" ::: "memory")
#define PG8_BAR __builtin_amdgcn_s_barrier()
#define PG8_SCHED __builtin_amdgcn_sched_barrier(0)
    Unit cur, nxt; int ui = 0;
    if (!S.next(0, cur)) return;
    f32x4 acc[2][2][4][2];
#pragma unroll
    for (int a = 0; a < 2; ++a)
#pragma unroll
        for (int b = 0; b < 2; ++b)
#pragma unroll
            for (int m = 0; m < 4; ++m)
#pragma unroll
                for (int n = 0; n < 2; ++n) acc[a][b][m][n] = (f32x4){0.f, 0.f, 0.f, 0.f};
    bf16x8 At[4][2], B0[2][2], B1[2][2];
    const char* cA = (const char*)g.A + (size_t)cur.pm * tstep; const char* cB = (const char*)g.Bt + (size_t)cur.pn * tstep;
    S.a_ready(cur);
    PG8_STAGE(PG8_SB(0, 0), cB, voffB); PG8_STAGE(PG8_SA(0, 0), cA, voffA); PG8_STAGE(PG8_SB(0, 1), cB + hstep, voffB); PG8_STAGE(PG8_SA(0, 1), cA + hstep, voffA);
    if (wr == 1) PG8_BAR;
    PG8_WAIT_V(4); PG8_BAR;
    PG8_STAGE(PG8_SB(1, 0), cB + kstep, voffB); PG8_STAGE(PG8_SA(1, 0), cA + kstep, voffA); PG8_STAGE(PG8_SB(1, 1), cB + hstep + kstep, voffB);
    PG8_WAIT_V(6); PG8_BAR;
    PG8_STAMP();
    for (;;) {
        const bool has_next = S.next(ui + 1, nxt);
        const char* nA = has_next ? (const char*)g.A + (size_t)nxt.pm * tstep : cA; const char* nB = has_next ? (const char*)g.Bt + (size_t)nxt.pn * tstep : cB;
        for (int t = 0; t < nt; t += 2) {
            const bool last = (t == nt - 2);
            const char* a1 = cA + (size_t)(t + 1) * kstep;
            const char* a2 = last ? nA : cA + (size_t)(t + 2) * kstep; const char* b2 = last ? nB : cB + (size_t)(t + 2) * kstep;
            const char* a3 = a2 + kstep; const char* b3 = b2 + kstep;
            if (last && has_next) S.a_ready(nxt);
            PG8_LDB(B0, 0, 0); PG8_SCHED; PG8_LDA(At, 0, 0); PG8_STAGE(PG8_SA(1, 1), a1 + hstep, voffA);
            PG8_WAIT_L(8); PG8_BAR; PG8_WAIT_L(0); PG8_MMA(0, 0, At, B0); PG8_BAR; PG8_SCHED;
            PG8_LDB(B1, 0, 1); PG8_STAGE(PG8_SB(0, 0), b2, voffB);
            PG8_BAR; PG8_WAIT_L(0); PG8_MMA(0, 1, At, B1); PG8_BAR;
            PG8_LDA(At, 0, 1); PG8_STAGE(PG8_SA(0, 0), a2, voffA);
            PG8_BAR; PG8_WAIT_L(0); PG8_MMA(1, 0, At, B0); PG8_BAR; PG8_SCHED;
            PG8_STAGE(PG8_SB(0, 1), b2 + hstep, voffB);
            PG8_WAIT_V(6); PG8_BAR; PG8_MMA(1, 1, At, B1); PG8_BAR;
            PG8_LDB(B0, 1, 0); PG8_SCHED; PG8_LDA(At, 1, 0); PG8_STAGE(PG8_SA(0, 1), a2 + hstep, voffA);
            PG8_WAIT_L(8); PG8_BAR; PG8_WAIT_L(0); PG8_MMA(0, 0, At, B0); PG8_BAR; PG8_SCHED;
            PG8_LDB(B1, 1, 1); PG8_STAGE(PG8_SB(1, 0), b3, voffB);
            PG8_BAR; PG8_WAIT_L(0); PG8_MMA(0, 1, At, B1); PG8_BAR;
            PG8_LDA(At, 1, 1); PG8_STAGE(PG8_SA(1, 0), a3, voffA);
            PG8_BAR; PG8_WAIT_L(0); PG8_MMA(1, 0, At, B0); PG8_BAR; PG8_SCHED;
            PG8_STAGE(PG8_SB(1, 1), b3 + hstep, voffB);
            PG8_WAIT_V(6); PG8_BAR; PG8_MMA(1, 1, At, B1); PG8_BAR;
        }
        PG8_STAMP();
        if constexpr (!Epi::AFTER_DRAIN) { E(acc, cur, wr, wc, fr, fq); S.done(cur); }
        PG8_STAMP();
        if (!has_next) break;
#pragma unroll
        for (int a = 0; a < 2; ++a)
#pragma unroll
            for (int b = 0; b < 2; ++b)
#pragma unroll
                for (int m = 0; m < 4; ++m)
#pragma unroll
                    for (int n = 0; n < 2; ++n) acc[a][b][m][n] = (f32x4){0.f, 0.f, 0.f, 0.f};
        cur = nxt; cA = nA; cB = nB; ++ui;
    }
    PG8_WAIT_V(0);
    if (wr == 0) PG8_BAR;
    PG8_BAR;
    if constexpr (Epi::AFTER_DRAIN) { E.fused(acc, cur, wr, wc, fr, fq, lds, wid, lane); S.done(cur); }
    PG8_STAMP();
    if (STAMP && wid == 0) { stamps[lane] = lane < nts ? (((unsigned long long)(unsigned)ts_hi << 32) | (unsigned)ts_lo) : 0ull;
        if (lane == 62) stamps[62] = rt_entry; if (lane == 63) stamps[63] = (unsigned long long)wall_clock64(); }
#undef PG8_STAMP
#undef PG8_SA
#undef PG8_SB
#undef PG8_STAGE
#undef PG8_LDA
#undef PG8_LDB
#undef PG8_MMA
#undef PG8_WAIT_V
#undef PG8_WAIT_L
#undef PG8_BAR
#undef PG8_SCHED
}
}
#define LAS3 __attribute__((address_space(3)))
constexpr int MK_THREADS = 512;
typedef __bf16 bf16x2_t __attribute__((ext_vector_type(2)));
DI float dot2bf(unsigned a, unsigned b, float c) { return __builtin_amdgcn_fdot2_f32_bf16(__builtin_bit_cast(bf16x2_t, a), __builtin_bit_cast(bf16x2_t, b), c, false); }
DI float bflo(unsigned v) { return __uint_as_float(v << 16); }
DI float bfhi(unsigned v) { return __uint_as_float(v & 0xffff0000u); }

template <class ColMap>
DI void transpose_tile(const float* __restrict__ src, int ldsrc, const float* __restrict__ gain, bf16_t* __restrict__ dst, int K, int k0, int n0, const ColMap& cm, LAS3 float* tl) {
    const int tid = threadIdx.x;
    __syncthreads();
    {
        const int n = tid & 63, sc = cm(n0 + n);
#pragma unroll
        for (int j = 0; j < 8; ++j) { const int k = (tid >> 6) + 8 * j; tl[k * 65 + n] = sc >= 0 ? src[(size_t)(k0 + k) * ldsrc + sc] * (gain ? gain[k0 + k] : 1.0f) : 0.f; }
    }
    __syncthreads();
    {
        const int n = tid >> 3, k8 = (tid & 7) * 8;
        u32x4 w;
        w.x = pack2bf(tl[(k8 + 0) * 65 + n], tl[(k8 + 1) * 65 + n]); w.y = pack2bf(tl[(k8 + 2) * 65 + n], tl[(k8 + 3) * 65 + n]);
        w.z = pack2bf(tl[(k8 + 4) * 65 + n], tl[(k8 + 5) * 65 + n]); w.w = pack2bf(tl[(k8 + 6) * 65 + n], tl[(k8 + 7) * 65 + n]);
        *(u32x4*)(dst + (size_t)(n0 + n) * K + k0 + k8) = w;
    }
}
struct ColId { DI int operator()(int n) const { return n; } };
struct ColWin { DI int operator()(int n) const { return n < PC_XR ? n : (n < PC_XG ? 1304 + (n - PC_XR) : (n < PC_GATE ? 1816 + (n - PC_XG) : (n < PC_GATE + 24 ? 1280 + (n - PC_GATE) : -1))); } };

DI void cvt_rows_bf16(const float* __restrict__ src, const float* __restrict__ gain, bf16_t* __restrict__ dst, size_t n8, int cols, size_t gtid, size_t nthr) {
    for (size_t i = gtid; i < n8; i += nthr) {
        f32x4 a = *(const f32x4*)(src + i * 8), b = *(const f32x4*)(src + i * 8 + 4);
        if (gain) { const int c = (int)((i * 8) % cols); a *= *(const f32x4*)(gain + c); b *= *(const f32x4*)(gain + c + 4); }
        u32x4 w; w.x = pack2bf(a[0], a[1]); w.y = pack2bf(a[2], a[3]); w.z = pack2bf(b[0], b[1]); w.w = pack2bf(b[2], b[3]);
        *(u32x4*)(dst + i * 8) = w;
    }
}

DI void cvt_rows_fp8(const float* __restrict__ src, const float* __restrict__ gain, float scale, unsigned char* __restrict__ dst, size_t n8, int cols, size_t gtid, size_t nthr) {
    for (size_t i = gtid; i < n8; i += nthr) {
        f32x4 a = *(const f32x4*)(src + i * 8), b = *(const f32x4*)(src + i * 8 + 4);
        if (gain) { const int c = (int)((i * 8) % cols); a *= *(const f32x4*)(gain + c); b *= *(const f32x4*)(gain + c + 4); }
        a *= scale; b *= scale;
        int w0 = 0, w1 = 0;
        w0 = __builtin_amdgcn_cvt_pk_fp8_f32(a[0], a[1], w0, false); w0 = __builtin_amdgcn_cvt_pk_fp8_f32(a[2], a[3], w0, true);
        w1 = __builtin_amdgcn_cvt_pk_fp8_f32(b[0], b[1], w1, false); w1 = __builtin_amdgcn_cvt_pk_fp8_f32(b[2], b[3], w1, true);
        *(u32x2*)(dst + i * 8) = (u32x2){(unsigned)w0, (unsigned)w1};
    }
}
DI void p0_prologue(const Params& p, LAS3 unsigned char* lds, int G) {
    unsigned char* ws = p.ws;
    const int tid = threadIdx.x, lane = tid & 63, wid = tid >> 6, bid = blockIdx.x;
    const size_t gtid = (size_t)bid * MK_THREADS + tid, nthr = (size_t)G * MK_THREADS;
    const int gw = bid * 8 + wid, nw = G * 8;
    {
        const float* x = p.in[I_X]; bf16_t* xb = (bf16_t*)(ws + WS_XB); float* rs0 = (float*)(ws + WS_RS0);
        for (int row = gw; row < NTOK; row += nw) {
            f32x4 v[4]; float s = 0.f;
#pragma unroll
            for (int j = 0; j < 4; ++j) { v[j] = *(const f32x4*)(x + (size_t)row * DM + j * 256 + lane * 4); s += (v[j][0] * v[j][0] + v[j][1] * v[j][1]) + (v[j][2] * v[j][2] + v[j][3] * v[j][3]); }
            s = wave_sum(s);
#pragma unroll
            for (int j = 0; j < 4; ++j) { u32x2 w; w.x = pack2bf(v[j][0], v[j][1]); w.y = pack2bf(v[j][2], v[j][3]); *(u32x2*)(xb + (size_t)row * DM + j * 256 + lane * 4) = w; }
            if (lane == 0) rs0[row] = rsqrtf(s * (1.0f / DM) + EPS);
        }
    }
#if PEER_V3
    cvt_rows_fp8(p.in[I_PEER_U], p.in[I_FFN_NORM], 32.0f, (unsigned char*)(ws + WS_UB), (size_t)16384 * DM / 8, DM, gtid, nthr);
    cvt_rows_fp8(p.in[I_PEER_V], nullptr, 8.0f, (unsigned char*)(ws + WS_VB), (size_t)16384 * DM / 8, DM, gtid, nthr);
#else
    cvt_rows_bf16(p.in[I_PEER_U], p.in[I_FFN_NORM], (bf16_t*)(ws + WS_UB), (size_t)16384 * DM / 8, DM, gtid, nthr);
    cvt_rows_bf16(p.in[I_PEER_V], nullptr, (bf16_t*)(ws + WS_VB), (size_t)16384 * DM / 8, DM, gtid, nthr);
#endif
    cvt_rows_bf16(p.in[I_P], nullptr, (bf16_t*)(ws + WS_PB), (size_t)NTOK * PLE / 8, PLE, gtid, nthr);
    LAS3 float* tl = (LAS3 float*)lds;
    {
        for (int u = bid; u < 1496; u += G) {
            if (u < 640) transpose_tile(p.in[I_W_IN], INCOLS, p.in[I_ATTN_NORM], (bf16_t*)(ws + WS_WIN), DM, (u % 16) * 64, (u / 16) * 64, ColWin{}, tl);
            else if (u < 896) { const int v = u - 640; transpose_tile(p.in[I_W_OUT], DM, nullptr, (bf16_t*)(ws + WS_WOUT), DM, (v % 16) * 64, (v / 16) * 64, ColId{}, tl); }
            else if (u < 1152) { const int v = u - 896; transpose_tile(p.in[I_PLE_WG], DM, p.in[I_PLE_NORM], (bf16_t*)(ws + WS_WG), DM, (v % 16) * 64, (v / 16) * 64, ColId{}, tl); }
            else if (u < 1216) { const int v = u - 1152; transpose_tile(p.in[I_PLE_PROJ], DM, nullptr, (bf16_t*)(ws + WS_WP), PLE, (v % 4) * 64, (v / 4) * 64, ColId{}, tl); }
            else if (u < 1344) { const int v = u - 1216; transpose_tile(p.in[I_CK_W1], 256, nullptr, (bf16_t*)(ws + WS_CW1K), 2048, (v % 32) * 64, (v / 32) * 64, ColId{}, tl); }
            else if (u < 1472) { const int v = u - 1344; transpose_tile(p.in[I_CV_W1], 256, nullptr, (bf16_t*)(ws + WS_CW1V), 2048, (v % 32) * 64, (v / 32) * 64, ColId{}, tl); }
            else if (u < 1480) { const int v = u - 1472; transpose_tile(p.in[I_LRU_WA] + v * 4096, 64, nullptr, (bf16_t*)(ws + WS_WAT) + v * 4096, 64, 0, 0, ColId{}, tl); }
            else if (u < 1488) { const int v = u - 1480; transpose_tile(p.in[I_LRU_WX] + v * 4096, 64, nullptr, (bf16_t*)(ws + WS_WXT) + v * 4096, 64, 0, 0, ColId{}, tl); }
            else if (u < 1492) { const int v = u - 1488; transpose_tile(p.in[I_CK_W2], 64, nullptr, (bf16_t*)(ws + WS_CW2K), 256, v * 64, 0, ColId{}, tl); }
            else { const int v = u - 1492; transpose_tile(p.in[I_CV_W2], 64, nullptr, (bf16_t*)(ws + WS_CW2V), 256, v * 64, 0, ColId{}, tl); }
        }
        __syncthreads();
    }
    {
        LAS3 float* wt = (LAS3 float*)lds;
        LAS3 float* st = (LAS3 float*)(lds + 32768);
        const float* wq = p.in[I_PEER_WQ]; const float* sub = p.in[I_PEER_SUB]; const float* gain = p.in[I_FFN_NORM]; bf16_t* WqsT = (bf16_t*)(ws + WS_WQS);
        for (int u = bid; u < 256; u += G) {
            const int hp = u >> 4, d0 = (u & 15) * 64, pp = hp & 1;
            __syncthreads();
            for (int i = tid; i < 64 * 128; i += MK_THREADS) { const int d = i >> 7, dk = i & 127; wt[dk * 64 + d] = wq[(size_t)(d0 + d) * 2048 + hp * 128 + dk]; }
            for (int i = tid; i < 128 * 128; i += MK_THREADS) { const int kk = i >> 7, dk = i & 127; st[kk * 129 + dk] = sub[((size_t)pp * 128 + kk) * 128 + dk]; }
            __syncthreads();
            const int kk = tid & 127, dg = (tid >> 7) * 16;
            float acc[16];
#pragma unroll
            for (int j = 0; j < 16; ++j) acc[j] = 0.f;
            for (int dk = 0; dk < 128; ++dk) {
                const float sv = st[kk * 129 + dk];
#pragma unroll
                for (int j4 = 0; j4 < 4; ++j4) { const f32x4 w4 = *(LAS3 f32x4*)(wt + dk * 64 + dg + j4 * 4);
#pragma unroll
                    for (int j = 0; j < 4; ++j) acc[j4 * 4 + j] += sv * w4[j]; }
            }
            u32x4 o0, o1;
#define GQ(j) (acc[j] * gain[d0 + dg + (j)])
            o0.x = pack2bf(GQ(0), GQ(1)); o0.y = pack2bf(GQ(2), GQ(3)); o0.z = pack2bf(GQ(4), GQ(5)); o0.w = pack2bf(GQ(6), GQ(7));
            o1.x = pack2bf(GQ(8), GQ(9)); o1.y = pack2bf(GQ(10), GQ(11)); o1.z = pack2bf(GQ(12), GQ(13)); o1.w = pack2bf(GQ(14), GQ(15));
#undef GQ
            bf16_t* dst = WqsT + (size_t)(hp * 128 + kk) * DM + d0 + dg;
            *(u32x4*)dst = o0; *(u32x4*)(dst + 8) = o1;
        }
        __syncthreads();
    }
    for (int o = gw; o < 512; o += nw) {
        const int kv = o >> 8, j = o & 255;
        const float* pe = p.in[kv ? I_CV_PE : I_CK_PE]; const float* w1 = p.in[kv ? I_CV_W1 : I_CK_W1];
        float acc = 0.f;
        for (int k = lane; k < 2048; k += 64) acc += pe[k] * w1[(size_t)k * 256 + j];
        acc = wave_sum(acc);
        if (lane == 0) ((float*)(ws + (kv ? WS_CBV : WS_CBK)))[j] = acc;
    }
}

DI void p6_peer_apply(const Params& p, int G) {
    unsigned char* ws = p.ws;
    const int tid = threadIdx.x, lane = tid & 63, wid = tid >> 6;
    const int gw = blockIdx.x * 8 + wid, nw = G * 8;
    const bf16_t* ub = (const bf16_t*)(ws + WS_UB); const bf16_t* vb = (const bf16_t*)(ws + WS_VB);
    const int* eidx = (const int*)(ws + R_EXP); const float* gsm = (const float*)(ws + R_GSM); const float* ssq1 = (const float*)(ws + WS_SSQ1);
    float* h = p.out; bf16_t* hb = (bf16_t*)(ws + R_H1B); float* rs2 = (float*)(ws + WS_RS2);
    for (int tok = gw; tok < NTOK; tok += nw) {
        float sq = lane < 16 ? ssq1[(size_t)lane * NTOK + tok] : 0.f;
        sq = wave_sum(sq);
        const float rs1 = rsqrtf(sq * (1.0f / DM) + EPS);
        const u32x4 xa = *(const u32x4*)(hb + (size_t)tok * DM + lane * 8), xc = *(const u32x4*)(hb + (size_t)tok * DM + 512 + lane * 8);
        const int e0 = eidx[(size_t)tok * 128 + lane], e1 = eidx[(size_t)tok * 128 + 64 + lane];
        const float g0 = gsm[(size_t)tok * 128 + lane], g1 = gsm[(size_t)tok * 128 + 64 + lane];
        float coef0 = 0.f, coef1 = 0.f;
#pragma unroll
        for (int half = 0; half < 2; ++half) {
            const int ev = half ? e1 : e0;
            float part[64];
#pragma unroll
            for (int j = 0; j < 64; ++j) {
                const int e = __builtin_amdgcn_readlane(ev, j);
                const bf16_t* ur = ub + (size_t)e * DM + lane * 8;
                const u32x4 ua = *(const u32x4*)ur, uc = *(const u32x4*)(ur + 512);
                float a = dot2bf(xa.x, ua.x, 0.f); a = dot2bf(xa.y, ua.y, a); a = dot2bf(xa.z, ua.z, a); a = dot2bf(xa.w, ua.w, a);
                a = dot2bf(xc.x, uc.x, a); a = dot2bf(xc.y, uc.y, a); a = dot2bf(xc.z, uc.z, a); a = dot2bf(xc.w, uc.w, a);
                part[j] = a;
            }
#pragma unroll
            for (int m = 32; m >= 1; m >>= 1) {
                const bool up = (lane & m) != 0;
#pragma unroll
                for (int i = 0; i < m; ++i) {
                    const float send = up ? part[i] : part[i + m];
                    const float keep = up ? part[i + m] : part[i];
                    part[i] = keep + __shfl_xor(send, m);
                }
            }
            const float act = gelu_tanh(part[0] * rs1);
            if (half) coef1 = g1 * act; else coef0 = g0 * act;
        }
        float acc[16];
#pragma unroll
        for (int i = 0; i < 16; ++i) acc[i] = 0.f;
#pragma unroll
        for (int half = 0; half < 2; ++half) {
            const int ev = half ? e1 : e0; const float cv = half ? coef1 : coef0;
#pragma unroll 16
            for (int j = 0; j < 64; ++j) {
                const int e = __builtin_amdgcn_readlane(ev, j);
                const float c = __uint_as_float(__builtin_amdgcn_readlane(__float_as_uint(cv), j));
                const bf16_t* vr = vb + (size_t)e * DM + lane * 8;
                const u32x4 va = *(const u32x4*)vr, vc = *(const u32x4*)(vr + 512);
                acc[0] += c * bflo(va.x); acc[1] += c * bfhi(va.x); acc[2] += c * bflo(va.y); acc[3] += c * bfhi(va.y);
                acc[4] += c * bflo(va.z); acc[5] += c * bfhi(va.z); acc[6] += c * bflo(va.w); acc[7] += c * bfhi(va.w);
                acc[8] += c * bflo(vc.x); acc[9] += c * bfhi(vc.x); acc[10] += c * bflo(vc.y); acc[11] += c * bfhi(vc.y);
                acc[12] += c * bflo(vc.z); acc[13] += c * bfhi(vc.z); acc[14] += c * bflo(vc.w); acc[15] += c * bfhi(vc.w);
            }
        }
        float* hr = h + (size_t)tok * DM + lane * 8;
        f32x4 h0 = *(f32x4*)hr, h1 = *(f32x4*)(hr + 4), h2 = *(f32x4*)(hr + 512), h3 = *(f32x4*)(hr + 516);
        h0 += (f32x4){acc[0], acc[1], acc[2], acc[3]}; h1 += (f32x4){acc[4], acc[5], acc[6], acc[7]};
        h2 += (f32x4){acc[8], acc[9], acc[10], acc[11]}; h3 += (f32x4){acc[12], acc[13], acc[14], acc[15]};
        *(f32x4*)hr = h0; *(f32x4*)(hr + 4) = h1; *(f32x4*)(hr + 512) = h2; *(f32x4*)(hr + 516) = h3;
        u32x4 w0, w1;
        w0.x = pack2bf(h0[0], h0[1]); w0.y = pack2bf(h0[2], h0[3]); w0.z = pack2bf(h1[0], h1[1]); w0.w = pack2bf(h1[2], h1[3]);
        w1.x = pack2bf(h2[0], h2[1]); w1.y = pack2bf(h2[2], h2[3]); w1.z = pack2bf(h3[0], h3[1]); w1.w = pack2bf(h3[2], h3[3]);
        *(u32x4*)(hb + (size_t)tok * DM + lane * 8) = w0; *(u32x4*)(hb + (size_t)tok * DM + 512 + lane * 8) = w1;
        float s = 0.f;
#pragma unroll
        for (int j = 0; j < 4; ++j) s += h0[j] * h0[j] + h1[j] * h1[j] + h2[j] * h2[j] + h3[j] * h3[j];
        s = wave_sum(s);
        if (lane == 0) rs2[tok] = rsqrtf(s * (1.0f / DM) + EPS);
    }
}

DI void p8_final_norm(const Params& p, int G) {
    const int lane = threadIdx.x & 63, gw = blockIdx.x * 8 + (threadIdx.x >> 6), nw = G * 8;
    const float* ssq3 = (const float*)(p.ws + WS_SSQ3); const float* g = p.in[I_FINAL_NORM]; float* h = p.out;
    f32x4 gg[4];
#pragma unroll
    for (int j = 0; j < 4; ++j) gg[j] = *(const f32x4*)(g + j * 256 + lane * 4);
    for (int row = gw; row < NTOK; row += nw) {
        float sq = lane < 16 ? ssq3[(size_t)lane * NTOK + row] : 0.f;
        sq = wave_sum(sq);
        const float rs = rsqrtf(sq * (1.0f / DM) + EPS);
#pragma unroll
        for (int j = 0; j < 4; ++j) { float* q = h + (size_t)row * DM + j * 256 + lane * 4; f32x4 v = *(f32x4*)q; v = v * rs * gg[j]; *(f32x4*)q = v; }
    }
}
typedef float f32x16 __attribute__((ext_vector_type(16)));
typedef short bf16x8v __attribute__((ext_vector_type(8)));
typedef __bf16 bf16x2v_ __attribute__((ext_vector_type(2)));
DI unsigned pk_bf16(float lo, float hi) { return __builtin_bit_cast(unsigned, __builtin_convertvector((f32x2){lo, hi}, bf16x2v_)); }
constexpr float LOG2E = 1.4426950408889634f;
constexpr int AT_KROW = 144, AT_VROW = 136;
constexpr int AT_KT = 64 * AT_KROW, AT_VT = 64 * AT_VROW, AT_BUF = 2 * AT_KT + 2 * AT_VT;
constexpr int AT_VAL = 0;
constexpr int AT_LUT = 2 * AT_BUF;
constexpr int AT_IMP = AT_LUT + 8 * 128 * 4;
constexpr int AT_SEL = AT_IMP + 8 * 32 * 65 * 4;
constexpr int AT_SSQ = AT_SEL + 512;
constexpr int AT_END = AT_SSQ + 1024;
static_assert(AT_END <= 160 * 1024 - 256, "attention LDS map");

struct AtSrc { const bf16_t* k0; const bf16_t* k1; const bf16_t* v0; const bf16_t* v1; int vld; };
DI void at_load(const AtSrc& s, int kpos, int tid, u32x4 (&r)[4]) {
    const int row = tid >> 3, seg = tid & 7;
    r[0] = *(const u32x4*)(s.k0 + (size_t)(kpos + row) * HD + seg * 8);
    r[1] = *(const u32x4*)(s.k1 + (size_t)(kpos + row) * HD + seg * 8);
    r[2] = *(const u32x4*)(s.v0 + (size_t)row * s.vld + kpos + seg * 8);
    r[3] = *(const u32x4*)(s.v1 + (size_t)row * s.vld + kpos + seg * 8);
}
DI void at_store(LAS3 unsigned char* buf, int tid, const u32x4 (&r)[4]) {
    const int row = tid >> 3, seg = tid & 7;
    *(LAS3 u32x4*)(buf + row * AT_KROW + seg * 16) = r[0];
    *(LAS3 u32x4*)(buf + AT_KT + row * AT_KROW + seg * 16) = r[1];
    LAS3 unsigned char* v = buf + 2 * AT_KT + row * AT_VROW + seg * 16;
    *(LAS3 u32x2*)(v) = (u32x2){r[2].x, r[2].y}; *(LAS3 u32x2*)(v + 8) = (u32x2){r[2].z, r[2].w};
    *(LAS3 u32x2*)(v + AT_VT) = (u32x2){r[3].x, r[3].y}; *(LAS3 u32x2*)(v + AT_VT + 8) = (u32x2){r[3].z, r[3].w};
}

template <int MODE, int PASS>
DI void at_step(LAS3 const unsigned char* Kb, LAS3 const unsigned char* Vb, const bf16x8v (&Q)[4], int k0, int tq, int lane, LAS3 const float* lut, bool blk_ok, bool farstep,
                float& m_run, float& l_run, f32x16 (&O)[2], float inv_l, LAS3 float* imp_row, float& bcarry) {
    const int r = lane & 31, hf = lane >> 5;
    f32x16 S[2];
#pragma unroll
    for (int sub = 0; sub < 2; ++sub) {
#pragma unroll
        for (int i = 0; i < 16; ++i) S[sub][i] = 0.f;
#pragma unroll
        for (int ks = 0; ks < 4; ++ks) {
            const bf16x8v a = *(LAS3 const bf16x8v*)(Kb + (32 * sub + r) * AT_KROW + 32 * ks + 16 * hf);
            S[sub] = __builtin_amdgcn_mfma_f32_32x32x16_bf16(a, Q[ks], S[sub], 0, 0, 0);
        }
    }
    __builtin_amdgcn_sched_barrier(0);
    float mx = -INFINITY;
    if (!farstep) {
#pragma unroll
        for (int sub = 0; sub < 2; ++sub)
#pragma unroll
            for (int i = 0; i < 16; ++i) {
                const int kp = k0 + 32 * sub + (i & 3) + 8 * (i >> 2) + 4 * hf;
                const int dist = MODE == 0 ? tq - (16 * kp + 31) : tq - kp;
                bool ok = dist >= 0 && blk_ok;
                if (MODE == 2) ok = ok && dist < 512;
                const int idx = dist < 0 ? 0 : (dist > 127 ? 127 : dist);
                float s = S[sub][i] * LOG2E + lut[idx];
                s = ok ? s : -INFINITY;
                S[sub][i] = s; mx = fmaxf(mx, s);
            }
    } else {
        const float bfar = lut[127];
#pragma unroll
        for (int sub = 0; sub < 2; ++sub)
#pragma unroll
            for (int i = 0; i < 16; ++i) {
                float s = S[sub][i] * LOG2E + bfar;
                if (MODE == 1) s = blk_ok ? s : -INFINITY;
                S[sub][i] = s; mx = fmaxf(mx, s);
            }
    }
    if (PASS != 2) {
        mx = fmaxf(mx, __shfl_xor(mx, 32));
        const float m_new = fmaxf(m_run, mx), m_safe = (m_new == -INFINITY) ? 0.f : m_new;
        const float alpha = __builtin_amdgcn_exp2f(m_run - m_safe);
        float sum = 0.f;
#pragma unroll
        for (int sub = 0; sub < 2; ++sub)
#pragma unroll
            for (int i = 0; i < 16; ++i) { const float pv = __builtin_amdgcn_exp2f(S[sub][i] - m_safe); S[sub][i] = pv; sum += pv; }
        l_run = l_run * alpha + sum; m_run = m_new;
        if (PASS == 0) {
#pragma unroll
            for (int db = 0; db < 2; ++db)
#pragma unroll
                for (int i = 0; i < 16; ++i) O[db][i] *= alpha;
        }
    } else {
#pragma unroll
        for (int sub = 0; sub < 2; ++sub) {
#pragma unroll
            for (int i = 0; i < 16; ++i) S[sub][i] = __builtin_amdgcn_exp2f(S[sub][i] - m_run) * inv_l;
            float bp[4], av[4];
#pragma unroll
            for (int a = 0; a < 4; ++a) {
                av[a] = S[sub][4 * a] + S[sub][4 * a + 1] + S[sub][4 * a + 2] + 0.5f * S[sub][4 * a + 3];
                bp[a] = __shfl_xor(0.5f * S[sub][4 * a + 3], 32);
            }
            const int sbase = (k0 >> 2) + 8 * sub + hf;
#pragma unroll
            for (int a = 0; a < 4; ++a) imp_row[sbase + 2 * a] = av[a] + (hf ? bp[a] : (a > 0 ? bp[a > 0 ? a - 1 : 0] : bcarry));
            bcarry = bp[3];
        }
    }
    __builtin_amdgcn_sched_barrier(0);
    if (PASS != 1) {
#pragma unroll
        for (int sub = 0; sub < 2; ++sub)
#pragma unroll
            for (int s2 = 0; s2 < 2; ++s2) {
                u32x4 pw;
                pw.x = pk_bf16(S[sub][8 * s2 + 0], S[sub][8 * s2 + 1]); pw.y = pk_bf16(S[sub][8 * s2 + 2], S[sub][8 * s2 + 3]);
                pw.z = pk_bf16(S[sub][8 * s2 + 4], S[sub][8 * s2 + 5]); pw.w = pk_bf16(S[sub][8 * s2 + 6], S[sub][8 * s2 + 7]);
                const bf16x8v pf = __builtin_bit_cast(bf16x8v, pw);
#pragma unroll
                for (int db = 0; db < 2; ++db) {
                    LAS3 const unsigned char* va = Vb + (32 * db + r) * AT_VROW + (32 * sub + 16 * s2 + 4 * hf) * 2;
                    const u32x2 v0 = *(LAS3 const u32x2*)va, v1 = *(LAS3 const u32x2*)(va + 16);
                    const bf16x8v vf = __builtin_bit_cast(bf16x8v, (u32x4){v0.x, v0.y, v1.x, v1.y});
                    O[db] = __builtin_amdgcn_mfma_f32_32x32x16_bf16(vf, pf, O[db], 0, 0, 0);
                }
            }
    }
}

template <int MODE, int PASS>
DI void at_branch(LAS3 unsigned char* lds, const AtSrc& src, int blk_lo, int blk_hi, const bf16x8v (&Q)[4], int tq, int tid, int kvh, LAS3 const float* lut,
                  unsigned mlo, unsigned mhi, float& m_run, float& l_run, f32x16 (&O)[2], float inv_l, LAS3 float* imp_row) {
    const int lane = tid & 63;
    u32x4 st[4];
    float bcarry = 0.f;
    at_load(src, blk_lo * 64, tid, st);
    for (int blk = blk_lo; blk <= blk_hi; ++blk) {
        LAS3 unsigned char* buf = lds + ((blk - blk_lo) & 1) * AT_BUF;
        at_store(buf, tid, st);
        __syncthreads();
        if (blk < blk_hi) at_load(src, (blk + 1) * 64, tid, st);
        bool blk_ok = true;
        if (MODE == 1) blk_ok = ((blk < 32 ? (mlo >> blk) : (mhi >> (blk - 32))) & 1u) != 0u;
        const int t0u = tq - (lane & 31);
        const bool farstep = MODE == 0 ? (t0u - 16 * (blk * 64 + 63) - 31 >= 128) : (MODE == 1 ? (t0u - blk * 64 - 63 >= 128) : (t0u - blk * 64 - 63 >= 128 && t0u + 31 - blk * 64 < 512));
        if (MODE != 1 || __any(blk_ok)) {
            at_step<MODE, PASS>(buf + kvh * AT_KT, buf + 2 * AT_KT + kvh * AT_VT, Q, blk * 64, tq, lane, lut, blk_ok, farstep, m_run, l_run, O, inv_l, imp_row, bcarry);
        }
    }
    __syncthreads();
}

DI void p3_attention(const Params& p, LAS3 unsigned char* lds, int G) {
    unsigned char* ws = p.ws;
    const int tid = threadIdx.x, lane = tid & 63, h = __builtin_amdgcn_readfirstlane(tid >> 6), kvh = h >> 2, r = lane & 31, hf = lane >> 5;
    LAS3 float* lutall = (LAS3 float*)(lds + AT_LUT);
    {
        const float* rel = p.in[I_REL];
        for (int i = tid; i < 1024; i += MK_THREADS) lutall[i] = rel[rel_bucket(i & 127) * NH + (i >> 7)] * LOG2E;
    }
    __syncthreads();
    LAS3 const float* lut = lutall + h * 128;
    LAS3 float* impw = (LAS3 float*)(lds + AT_IMP);
    LAS3 float* vals = (LAS3 float*)(lds + AT_VAL);
    LAS3 unsigned char* selb = lds + AT_SEL;
    LAS3 float* ssq = (LAS3 float*)(lds + AT_SSQ);
    const bf16_t* qb = (const bf16_t*)(ws + R_QB);
    const float* gates = (const float*)(ws + R_GATE);
    const float* gn = p.in[I_GN_ATTN];
    bf16_t* mixed = (bf16_t*)(ws + WS_XB);
    for (int ui = blockIdx.x; ui < 512; ui += G) {
        const int q8 = ui & 255, rnd = ui >> 8, b = q8 >> 6, j6 = q8 & 63, tb = rnd == 0 ? 127 - j6 : j6;
        const int t0 = 32 * tb, qb64 = tb >> 1, tq = t0 + r;
        const size_t tok = (size_t)b * T_ + tq;
        bf16x8v Q[4];
#pragma unroll
        for (int ks = 0; ks < 4; ++ks) Q[ks] = *(const bf16x8v*)(qb + tok * 512 + h * 64 + 16 * ks + 8 * hf);
        f32x16 O[2];
#pragma unroll
        for (int db = 0; db < 2; ++db)
#pragma unroll
            for (int i = 0; i < 16; ++i) O[db][i] = 0.f;
        LAS3 float* oslot = (LAS3 float*)(lds + AT_IMP) + h * 2048 + lane;
        const size_t bh0 = (size_t)b * 2, bh1 = bh0 + 1;
        {
            const bf16_t* kcb = (const bf16_t*)(ws + R_KCB); const bf16_t* vct = (const bf16_t*)(ws + R_VCT);
            const AtSrc src{kcb + bh0 * 256 * 64, kcb + bh1 * 256 * 64, vct + bh0 * 64 * 256, vct + bh1 * 64 * 256, 256};
            const int nst = tb / 32 + 1;
            float m_run = -INFINITY, l_run = 0.f;
            at_branch<0, 1>(lds, src, 0, nst - 1, Q, tq, tid, kvh, lut, 0u, 0u, m_run, l_run, O, 0.f, nullptr);
            const float l_tot = l_run + __shfl_xor(l_run, 32);
            const float inv_l = l_tot > 0.f ? 1.0f / l_tot : 0.f;
            float m_fix = (m_run == -INFINITY) ? 0.f : m_run;
            at_branch<0, 2>(lds, src, 0, nst - 1, Q, tq, tid, kvh, lut, 0u, 0u, m_fix, l_run, O, inv_l, impw + (h * 32 + r) * 65);
        }
        {
            const int row = tid >> 3, j8 = tid & 7, kr = row >> 5, tr = row & 31;
#pragma unroll
            for (int jj = 0; jj < 8; ++jj) {
                const int s = j8 * 8 + jj, db = qb64 - s;
                float v = 0.f;
#pragma unroll
                for (int g = 0; g < 4; ++g) v += impw[((kr * 4 + g) * 32 + tr) * 65 + s];
                vals[row * 65 + s] = (db >= 0 && db < 2) ? 2.0e4f : (s == 0 ? 1.0e4f : (db >= 0 ? v : -1.0f));
            }
            __syncthreads();
            unsigned bits = 0u;
            {
                float vv[8]; int rk[8];
#pragma unroll
                for (int jj = 0; jj < 8; ++jj) { vv[jj] = vals[row * 65 + j8 * 8 + jj]; rk[jj] = 0; }
#pragma unroll 2
                for (int s2 = 0; s2 < 64; ++s2) {
                    const float w = vals[row * 65 + s2];
#pragma unroll
                    for (int jj = 0; jj < 8; ++jj) rk[jj] += (w > vv[jj] || (w == vv[jj] && s2 < j8 * 8 + jj)) ? 1 : 0;
                }
#pragma unroll
                for (int jj = 0; jj < 8; ++jj) if (rk[jj] < 16 && qb64 - (j8 * 8 + jj) >= 0) bits |= 1u << jj;
            }
            selb[row * 8 + j8] = (unsigned char)bits;
            __syncthreads();
        }
        const unsigned mlo = *(LAS3 const unsigned*)(selb + (kvh * 32 + r) * 8), mhi = *(LAS3 const unsigned*)(selb + (kvh * 32 + r) * 8 + 4);
        __syncthreads();
        {
            const float g0 = sigmoidf_(gates[tok * 24 + h * 3 + 0]);
#pragma unroll
            for (int db = 0; db < 2; ++db)
#pragma unroll
                for (int i = 0; i < 16; ++i) { oslot[(db * 16 + i) * 64] = g0 * O[db][i]; O[db][i] = 0.f; }
        }
        {
            const bf16_t* ksb = (const bf16_t*)(ws + R_KS); const bf16_t* vst = (const bf16_t*)(ws + R_VST);
            const AtSrc src{ksb + bh0 * T_ * HD, ksb + bh1 * T_ * HD, vst + bh0 * HD * T_, vst + bh1 * HD * T_, T_};
            float m_run = -INFINITY, l_run = 0.f;
            at_branch<1, 0>(lds, src, 0, qb64, Q, tq, tid, kvh, lut, mlo, mhi, m_run, l_run, O, 0.f, nullptr);
            const float l_tot = l_run + __shfl_xor(l_run, 32), sc = sigmoidf_(gates[tok * 24 + h * 3 + 1]) / l_tot;
#pragma unroll
            for (int db = 0; db < 2; ++db)
#pragma unroll
                for (int i = 0; i < 16; ++i) { oslot[(db * 16 + i) * 64] += sc * O[db][i]; O[db][i] = 0.f; }
        }
        {
            const bf16_t* kwb = (const bf16_t*)(ws + R_KW); const bf16_t* vwt = (const bf16_t*)(ws + R_VWT);
            const AtSrc src{kwb + bh0 * T_ * HD, kwb + bh1 * T_ * HD, vwt + bh0 * HD * T_, vwt + bh1 * HD * T_, T_};
            int wb0 = (t0 - 511) >> 6; wb0 = wb0 < 0 ? 0 : wb0;
            float m_run = -INFINITY, l_run = 0.f;
            at_branch<2, 0>(lds, src, wb0, qb64, Q, tq, tid, kvh, lut, 0u, 0u, m_run, l_run, O, 0.f, nullptr);
            const float l_tot = l_run + __shfl_xor(l_run, 32), sc = sigmoidf_(gates[tok * 24 + h * 3 + 2]) / l_tot;
#pragma unroll
            for (int db = 0; db < 2; ++db)
#pragma unroll
                for (int i = 0; i < 16; ++i) O[db][i] = oslot[(db * 16 + i) * 64] + sc * O[db][i];
        }
        {
            float ss = 0.f;
#pragma unroll
            for (int db = 0; db < 2; ++db)
#pragma unroll
                for (int i = 0; i < 16; ++i) ss += O[db][i] * O[db][i];
            ss += __shfl_xor(ss, 32);
            if (hf == 0) ssq[h * 32 + r] = ss;
            __syncthreads();
            float tot = 0.f;
#pragma unroll
            for (int hh = 0; hh < 8; ++hh) tot += ssq[hh * 32 + r];
            const float rs = rsqrtf(tot * (1.0f / 512) + EPS);
#pragma unroll
            for (int db = 0; db < 2; ++db)
#pragma unroll
                for (int a = 0; a < 4; ++a) {
                    const int d = 32 * db + 8 * a + 4 * hf;
                    const f32x4 g4 = *(const f32x4*)(gn + h * 64 + d);
                    u32x2 w; w.x = pk_bf16(O[db][4 * a] * rs * g4[0], O[db][4 * a + 1] * rs * g4[1]); w.y = pk_bf16(O[db][4 * a + 2] * rs * g4[2], O[db][4 * a + 3] * rs * g4[3]);
                    *(u32x2*)(mixed + tok * DM + h * 64 + d) = w;
                }
            __syncthreads();
        }
    }
}
constexpr int LR_STRIDE = 516;
constexpr int LR_XC = 0, LR_A = 32 * LR_STRIDE * 4, LR_RS = 2 * 32 * LR_STRIDE * 4, LR_END = LR_RS + 256;
static_assert(LR_END <= 160 * 1024 - 256, "LRU LDS map");

template <bool FINAL>
DI void lru_phase(const Params& p, LAS3 unsigned char* lds, int G) {
    unsigned char* ws = p.ws;
    const int tid = threadIdx.x, lane = tid & 63, n = __builtin_amdgcn_readfirstlane(tid >> 6), r = lane & 31, hf = lane >> 5, ch = tid;
    LAS3 float* XC = (LAS3 float*)(lds + LR_XC); LAS3 float* AA = (LAS3 float*)(lds + LR_A); LAS3 float* RS = (LAS3 float*)(lds + LR_RS);
    const float* xr = (const float*)(ws + R_XR); const bf16_t* xg = (const bf16_t*)(ws + R_XG);
    float* sumP = (float*)(ws + WS_LRUP); float* sumH = (float*)(ws + WS_LRUH);
    bf16_t* mixed = (bf16_t*)(ws + WS_XB);
    const float cw0 = p.in[I_CONV_W][0 * 512 + ch], cw1 = p.in[I_CONV_W][1 * 512 + ch], cw2 = p.in[I_CONV_W][2 * 512 + ch], cw3 = p.in[I_CONV_W][3 * 512 + ch], cb = p.in[I_CONV_B][ch];
    const float gl = FINAL ? p.in[I_GN_LRU][ch] : 0.f;
    float ba[2], bx[2], sp[2];
#pragma unroll
    for (int nb = 0; nb < 2; ++nb) { const int c2 = n * 64 + 32 * nb + r; ba[nb] = p.in[I_LRU_BA][c2]; bx[nb] = p.in[I_LRU_BX][c2]; sp[nb] = log1pf(__expf(-p.in[I_LRU_LAM][c2])); }
    bf16x8v Ba[2][4], Bx[2][4];
    {
        const bf16_t* waT = (const bf16_t*)(ws + WS_WAT); const bf16_t* wxT = (const bf16_t*)(ws + WS_WXT);
#pragma unroll
        for (int nb = 0; nb < 2; ++nb)
#pragma unroll
            for (int ks = 0; ks < 4; ++ks) {
                const size_t o = (size_t)(n * 64 + 32 * nb + r) * 64 + 16 * ks + 8 * hf;
                Ba[nb][ks] = *(const bf16x8v*)(waT + o); Bx[nb][ks] = *(const bf16x8v*)(wxT + o);
            }
    }
    for (int ci = blockIdx.x; ci < 256; ci += G) {
        const int b = ci >> 6, cib = ci & 63, t0 = cib * 64;
        const size_t tok0 = (size_t)b * T_ + t0;
        float x1 = 0.f, x2 = 0.f, x3 = 0.f;
        if (t0 > 0) { x1 = xr[(tok0 - 1) * 512 + ch]; x2 = xr[(tok0 - 2) * 512 + ch]; x3 = xr[(tok0 - 3) * 512 + ch]; }
        float hst = 0.f, pprod = 1.f;
        if (FINAL) {
            const float* Pp = sumP + (size_t)(b * 64) * 512 + ch; const float* Hp = sumH + (size_t)(b * 64) * 512 + ch;
            for (int k = 0; k < cib; ++k) hst = Pp[(size_t)k * 512] * hst + Hp[(size_t)k * 512];
        }
#pragma unroll 1
        for (int half = 0; half < 2; ++half) {
            const size_t tokh = tok0 + half * 32;
            __syncthreads();
#pragma unroll 8
            for (int t = 0; t < 32; ++t) {
                const float x0 = xr[(tokh + t) * 512 + ch];
                XC[t * LR_STRIDE + ch] = cw0 * x3 + cw1 * x2 + cw2 * x1 + cw3 * x0 + cb;
                x3 = x2; x2 = x1; x1 = x0;
            }
            __syncthreads();
            {
                f32x16 ar[2], ai[2];
#pragma unroll
                for (int nb = 0; nb < 2; ++nb)
#pragma unroll
                    for (int i = 0; i < 16; ++i) { ar[nb][i] = 0.f; ai[nb][i] = 0.f; }
#pragma unroll
                for (int ks = 0; ks < 4; ++ks) {
                    LAS3 const float* src = XC + r * LR_STRIDE + n * 64 + 16 * ks + 8 * hf;
                    const f32x4 f0 = *(LAS3 const f32x4*)src, f1 = *(LAS3 const f32x4*)(src + 4);
                    u32x4 pw; pw.x = pk_bf16(f0[0], f0[1]); pw.y = pk_bf16(f0[2], f0[3]); pw.z = pk_bf16(f1[0], f1[1]); pw.w = pk_bf16(f1[2], f1[3]);
                    const bf16x8v af = __builtin_bit_cast(bf16x8v, pw);
#pragma unroll
                    for (int nb = 0; nb < 2; ++nb) {
                        ar[nb] = __builtin_amdgcn_mfma_f32_32x32x16_bf16(af, Ba[nb][ks], ar[nb], 0, 0, 0);
                        ai[nb] = __builtin_amdgcn_mfma_f32_32x32x16_bf16(af, Bx[nb][ks], ai[nb], 0, 0, 0);
                    }
                }
                __syncthreads();
#pragma unroll
                for (int nb = 0; nb < 2; ++nb)
#pragma unroll
                    for (int i = 0; i < 16; ++i) {
                        const int t = (i & 3) + 8 * (i >> 2) + 4 * hf, o = t * LR_STRIDE + n * 64 + 32 * nb + r;
                        const float xcv = XC[o];
                        const float rg = sigmoidf_(ar[nb][i] + ba[nb]), ig = sigmoidf_(ai[nb][i] + bx[nb]);
                        const float log_a = -8.0f * rg * sp[nb];
                        AA[o] = __expf(log_a);
                        XC[o] = sqrtf(-expm1f(2.0f * log_a)) * (ig * xcv);
                    }
            }
            __syncthreads();
            if (!FINAL) {
#pragma unroll 8
                for (int t = 0; t < 32; ++t) { const float a = AA[t * LR_STRIDE + ch]; hst = a * hst + XC[t * LR_STRIDE + ch]; pprod *= a; }
            } else {
#pragma unroll 8
                for (int t = 0; t < 32; ++t) {
                    hst = AA[t * LR_STRIDE + ch] * hst + XC[t * LR_STRIDE + ch];
                    XC[t * LR_STRIDE + ch] = hst * gelu_tanh(bf2f(xg[(tokh + t) * 512 + ch]));
                }
                __syncthreads();
                {
                    const int t = tid >> 4, part = tid & 15;
                    float s = 0.f;
#pragma unroll 8
                    for (int j = 0; j < 32; ++j) { const float v = XC[t * LR_STRIDE + part + 16 * j]; s += v * v; }
                    s += __shfl_xor(s, 1); s += __shfl_xor(s, 2); s += __shfl_xor(s, 4); s += __shfl_xor(s, 8);
                    if (part == 0) RS[t] = rsqrtf(s * (1.0f / 512) + EPS);
                }
                __syncthreads();
#pragma unroll 8
                for (int t = 0; t < 32; ++t) mixed[(tokh + t) * DM + 512 + ch] = f2bf(XC[t * LR_STRIDE + ch] * RS[t] * gl);
            }
        }
        if (!FINAL) { sumP[(size_t)ci * 512 + ch] = pprod; sumH[(size_t)ci * 512 + ch] = hst; }
    }
    __syncthreads();
}
typedef float f32x4v __attribute__((ext_vector_type(4)));
constexpr int CM_IMG = 0;
constexpr int CM_HID = 36864;
constexpr int CM_END = CM_HID + 16 * 264 * 2;
DI void p2_compress(const Params& p, LAS3 unsigned char* lds, int G) {
    unsigned char* ws = p.ws;
    const int tid = threadIdx.x, lane = tid & 63, wid = __builtin_amdgcn_readfirstlane(tid >> 6), row = lane & 15, kg = lane >> 4;
    for (int u = blockIdx.x; u < 256; u += G) {
        const int kv = u >> 7, bh = (u >> 4) & 7, c0 = (u & 15) * 16;
        const bf16_t* src = (const bf16_t*)(ws + (kv ? R_VC : R_KC)) + ((size_t)bh * T_ + 16 * c0) * HD;
        const bf16_t* W1T = (const bf16_t*)(ws + (kv ? WS_CW1V : WS_CW1K));
        const float* cb = (const float*)(ws + (kv ? WS_CBV : WS_CBK));
        const bf16_t* W2T = (const bf16_t*)(ws + (kv ? WS_CW2V : WS_CW2K));
        __syncthreads();
        for (int i = tid; i < 272 * 8; i += MK_THREADS) { const int tau = i >> 3, cch = i & 7; *(LAS3 u32x4*)(lds + CM_IMG + tau * 128 + (tau >> 4) * 16 + cch * 16) = *(const u32x4*)(src + (size_t)tau * HD + cch * 8); }
        __syncthreads();
        f32x4v acc[2] = {{0.f, 0.f, 0.f, 0.f}, {0.f, 0.f, 0.f, 0.f}};
        const bf16_t* wb0 = W1T + (size_t)(wid * 32 + row) * 2048 + 8 * kg, * wb1 = wb0 + (size_t)16 * 2048;
#pragma unroll 8
        for (int ks = 0; ks < 64; ++ks) {
            const int tau = 16 * row + (ks >> 1);
            const bf16x8v a = *(LAS3 const bf16x8v*)(lds + CM_IMG + tau * 128 + (tau >> 4) * 16 + (32 * (ks & 1) + 8 * kg) * 2);
            const bf16x8v b0 = *(const bf16x8v*)(wb0 + 32 * ks), b1 = *(const bf16x8v*)(wb1 + 32 * ks);
            acc[0] = __builtin_amdgcn_mfma_f32_16x16x32_bf16(a, b0, acc[0], 0, 0, 0);
            acc[1] = __builtin_amdgcn_mfma_f32_16x16x32_bf16(a, b1, acc[1], 0, 0, 0);
        }
#pragma unroll
        for (int nb = 0; nb < 2; ++nb) {
            const int col = wid * 32 + 16 * nb + row; const float bias = cb[col];
#pragma unroll
            for (int i = 0; i < 4; ++i) *(LAS3 bf16_t*)(lds + CM_HID + ((4 * kg + i) * 264 + col) * 2) = f2bf(gelu_tanh(acc[nb][i] + bias));
        }
        __syncthreads();
        if (wid < 4) {
            f32x4v o = {0.f, 0.f, 0.f, 0.f};
#pragma unroll
            for (int ks = 0; ks < 8; ++ks) {
                const bf16x8v a = *(LAS3 const bf16x8v*)(lds + CM_HID + (row * 264 + 32 * ks + 8 * kg) * 2);
                const bf16x8v b = *(const bf16x8v*)(W2T + (size_t)(wid * 16 + row) * 256 + 32 * ks + 8 * kg);
                o = __builtin_amdgcn_mfma_f32_16x16x32_bf16(a, b, o, 0, 0, 0);
            }
            const int d = wid * 16 + row;
#pragma unroll
            for (int i = 0; i < 4; ++i) {
                const int c = c0 + 4 * kg + i; const float v = c < NCMP ? o[i] : 0.f;
                ((float*)(ws + (kv ? WS_VCMP : WS_KCMP)))[((size_t)bh * 256 + c) * 64 + d] = v;
                if (kv) ((bf16_t*)(ws + R_VCT))[((size_t)bh * 64 + d) * 256 + c] = f2bf(v);
                else    ((bf16_t*)(ws + R_KCB))[((size_t)bh * 256 + c) * 64 + d] = f2bf(v);
            }
        }
    }
    __syncthreads();
}
DI void p2_vtranspose(const Params& p, LAS3 unsigned char* lds, int G) {
    unsigned char* ws = p.ws;
    const int tid = threadIdx.x;
    LAS3 bf16_t* tl = (LAS3 bf16_t*)lds;
    for (int u = blockIdx.x; u < 1024; u += G) {
        const int which = u >> 9, bh = (u >> 6) & 7, tt = u & 63;
        const bf16_t* src = (const bf16_t*)(ws + (which ? R_VW : R_VS)) + ((size_t)bh * T_ + tt * 64) * HD;
        bf16_t* dst = (bf16_t*)(ws + (which ? R_VWT : R_VST)) + (size_t)bh * HD * T_ + tt * 64;
        __syncthreads();
        { const int tok = tid >> 3, seg = tid & 7; *(LAS3 u32x4*)(tl + tok * 72 + seg * 8) = *(const u32x4*)(src + (size_t)tok * HD + seg * 8); }
        __syncthreads();
        { const int d = tid >> 3, seg = tid & 7; u32x4 w;
          w.x = (unsigned)tl[(seg * 8 + 0) * 72 + d] | ((unsigned)tl[(seg * 8 + 1) * 72 + d] << 16); w.y = (unsigned)tl[(seg * 8 + 2) * 72 + d] | ((unsigned)tl[(seg * 8 + 3) * 72 + d] << 16);
          w.z = (unsigned)tl[(seg * 8 + 4) * 72 + d] | ((unsigned)tl[(seg * 8 + 5) * 72 + d] << 16); w.w = (unsigned)tl[(seg * 8 + 6) * 72 + d] | ((unsigned)tl[(seg * 8 + 7) * 72 + d] << 16);
          *(u32x4*)(dst + (size_t)d * T_ + seg * 8) = w; }
    }
    __syncthreads();
}
DI int ord_enc(float f) { const int u = __float_as_int(f); return u ^ ((u >> 31) & 0x7fffffff); }
DI float ord_dec(int o) { return __int_as_float(o ^ ((o >> 31) & 0x7fffffff)); }
#define PEER_CE_DESC(a, b) do { const int _hi = max((a), (b)), _lo = min((a), (b)); (a) = _hi; (b) = _lo; } while (0)
#define PEER_CE_ASC(a, b)  do { const int _hi = max((a), (b)), _lo = min((a), (b)); (a) = _lo; (b) = _hi; } while (0)
DI void sort16_desc(int (&x)[16]) {
#pragma unroll
    for (int k = 2; k <= 16; k <<= 1)
#pragma unroll
        for (int j = k >> 1; j > 0; j >>= 1)
#pragma unroll
            for (int i = 0; i < 16; ++i) { const int l = i ^ j; if (l > i) { if ((i & k) == 0) PEER_CE_DESC(x[i], x[l]); else PEER_CE_ASC(x[i], x[l]); } }
}
DI void merge16_desc(int (&a)[16], const int (&b)[16]) {
#pragma unroll
    for (int i = 0; i < 16; ++i) a[i] = max(a[i], b[15 - i]);
#pragma unroll
    for (int j = 8; j > 0; j >>= 1)
#pragma unroll
        for (int i = 0; i < 16; ++i) { const int l = i ^ j; if (l > i) PEER_CE_DESC(a[i], a[l]); }
}
constexpr int PR_KEYS = 0;
constexpr int PR_IDX = 512 * 68 * 4;
constexpr int PR_RS = PR_IDX + 128 * 32 * 4;
constexpr int PR_END = PR_RS + 1024;
static_assert(PR_END <= 160 * 1024 - 256, "PEER LDS map");

struct EpiPeerRoute {
    static constexpr bool PERM = true, AFTER_DRAIN = true;
    const float* ssq1; int* eout; float* gout; float* rs1out;
    DI void fused(const f32x4 (&acc)[2][2][4][2], const pg8::Unit& u, int wr, int wc, int fr, int fq, PG8_LAS unsigned char* lds, int wid, int lane) const {
        const int tid = wid * 64 + lane, head = u.pn;
        LAS3 int* KEYS = (LAS3 int*)(lds + PR_KEYS); LAS3 int* IDX = (LAS3 int*)(lds + PR_IDX); LAS3 float* RS = (LAS3 float*)(lds + PR_RS);
        if (tid < 256) { float s = 0.f; for (int j = 0; j < 16; ++j) s += ssq1[(size_t)j * NTOK + u.pm * 256 + tid]; RS[tid] = rsqrtf(s * (1.0f / DM) + EPS); if (u.pn == 0) rs1out[u.pm * 256 + tid] = RS[tid]; }
#pragma unroll 1
        for (int ai = 0; ai < 2; ++ai) {
            __syncthreads();
#pragma unroll
            for (int bj = 0; bj < 2; ++bj)
#pragma unroll
                for (int m = 0; m < 4; ++m)
#pragma unroll
                    for (int n = 0; n < 2; ++n) {
                        const int rl = 64 * wr + 16 * m + fr, kk0 = 32 * wc + 8 * fq + 4 * n, hl = ((rl * 2 + bj) * 2 + (kk0 >> 6));
                        const f32x4 v = ai == 0 ? acc[0][bj][m][n] : acc[1][bj][m][n];
                        u32x4 kq;
                        kq.x = (unsigned)((ord_enc(v[0]) & ~0x7f) | (127 - (kk0 + 0))); kq.y = (unsigned)((ord_enc(v[1]) & ~0x7f) | (127 - (kk0 + 1)));
                        kq.z = (unsigned)((ord_enc(v[2]) & ~0x7f) | (127 - (kk0 + 2))); kq.w = (unsigned)((ord_enc(v[3]) & ~0x7f) | (127 - (kk0 + 3)));
                        *(LAS3 u32x4*)(KEYS + hl * 68 + (kk0 & 63)) = kq;
                    }
            __syncthreads();
            int top[16];
            {
                LAS3 const int* src = KEYS + tid * 68;
                int t2[16];
#pragma unroll
                for (int q = 0; q < 4; ++q) { const u32x4 w = *(LAS3 const u32x4*)(src + 4 * q); top[4 * q] = (int)w.x; top[4 * q + 1] = (int)w.y; top[4 * q + 2] = (int)w.z; top[4 * q + 3] = (int)w.w; }
                sort16_desc(top);
#pragma unroll 1
                for (int g = 1; g < 4; ++g) {
#pragma unroll
                    for (int q = 0; q < 4; ++q) { const u32x4 w = *(LAS3 const u32x4*)(src + 16 * g + 4 * q); t2[4 * q] = (int)w.x; t2[4 * q + 1] = (int)w.y; t2[4 * q + 2] = (int)w.z; t2[4 * q + 3] = (int)w.w; }
                    sort16_desc(t2);
                    merge16_desc(top, t2);
                }
#pragma unroll
                for (int i = 0; i < 16; ++i) t2[i] = __shfl_xor(top[i], 1);
                merge16_desc(top, t2);
            }
            int s1[16], s2[16];
            {
                const bool isp1 = (lane & 2) != 0;
#pragma unroll
                for (int i = 0; i < 16; ++i) { const int o = __shfl_xor(top[i], 2); s1[i] = isp1 ? o : top[i]; s2[i] = isp1 ? top[i] : o; }
            }
            const int rl = tid >> 2, q4 = tid & 3;
#pragma unroll
            for (int kq = 0; kq < 4; ++kq) if (q4 == kq) {
#pragma unroll
                for (int j = 0; j < 4; ++j) { IDX[rl * 32 + 4 * kq + j] = 127 - (s1[4 * kq + j] & 0x7f); IDX[rl * 32 + 16 + 4 * kq + j] = 127 - (s2[4 * kq + j] & 0x7f); }
            }
            float v1[16], v2[16];
#pragma unroll
            for (int i = 0; i < 16; ++i) { v1[i] = ord_dec(s1[i] & ~0x7f); v2[i] = ord_dec(s2[i] & ~0x7f); }
            int best[16], grp[16];
            {
                int cnt = 0; bool first = true;
#pragma unroll
                for (int a = 0; a < 16; ++a)
#pragma unroll
                    for (int b = 0; b < 16; ++b) if ((a + 1) * (b + 1) <= 16) {
                        grp[cnt & 15] = (ord_enc(v1[a] + v2[b]) & ~0xff) | (255 - (16 * a + b));
                        ++cnt;
                        if ((cnt & 15) == 0) { sort16_desc(grp); if (first) {
#pragma unroll
                                for (int i = 0; i < 16; ++i) best[i] = grp[i];
                                first = false; } else merge16_desc(best, grp); }
                    }
#pragma unroll
                for (int i = 2; i < 16; ++i) grp[i] = (int)0x80000000;
                sort16_desc(grp); merge16_desc(best, grp);
            }
            __syncthreads();
            const float rs1 = RS[128 * ai + rl];
            float gsum = 0.f, gv[16]; int ev[16];
            const float mtop = ord_dec(best[0] & ~0xff) * rs1;
#pragma unroll
            for (int i = 0; i < 16; ++i) {
                const float sc = ord_dec(best[i] & ~0xff) * rs1; gv[i] = __expf(sc - mtop); gsum += gv[i];
                const int ab = 255 - (best[i] & 0xff);
                ev[i] = IDX[rl * 32 + (ab >> 4)] * 128 + IDX[rl * 32 + 16 + (ab & 15)];
            }
            const float ginv = 1.0f / gsum;
            const size_t tok = (size_t)u.pm * 256 + 128 * ai + rl;
#pragma unroll
            for (int kq = 0; kq < 4; ++kq) if (q4 == kq) {
                *(u32x4*)(eout + tok * 128 + head * 16 + 4 * kq) = (u32x4){(unsigned)ev[4 * kq], (unsigned)ev[4 * kq + 1], (unsigned)ev[4 * kq + 2], (unsigned)ev[4 * kq + 3]};
                *(f32x4*)(gout + tok * 128 + head * 16 + 4 * kq) = (f32x4){gv[4 * kq] * ginv, gv[4 * kq + 1] * ginv, gv[4 * kq + 2] * ginv, gv[4 * kq + 3] * ginv};
            }
        }
        __syncthreads();
    }
    DI void operator()(const f32x4 (&)[2][2][4][2], const pg8::Unit&, int, int, int, int) const {}
};
struct SliceOrder : pg8::StaticOrder {
    int slice;
    __device__ bool next(int i, pg8::Unit& u) const { if (i > 0) return false; return pg8::StaticOrder::next(slice, u); }
};
DI void p5_peer_route(const Params& p, LAS3 unsigned char* lds, int G) {
    unsigned char* ws = p.ws;
    pg8::Gemm g{(const bf16_t*)(ws + R_H1B), (const bf16_t*)(ws + WS_WQS), NTOK, 2048, DM};
    EpiPeerRoute E{(const float*)(ws + WS_SSQ1), (int*)(ws + R_EXP), (float*)(ws + R_GSM), (float*)(ws + WS_RS1)};
    const int nslice = (512 + G - 1) / G;
#pragma unroll 1
    for (int s = 0; s < nslice; ++s) {
        SliceOrder S; S.init(NTOK, 2048, G, (int)blockIdx.x); S.slice = s;
        pg8::gemm_phase<EpiPeerRoute, SliceOrder>(lds, g, S, E, nullptr);
        __syncthreads();
    }
}
DI void p6_peer_u(const Params& p, int G) {
    unsigned char* ws = p.ws;
    const int tid = threadIdx.x, lane = tid & 63, wid = tid >> 6, grp = blockIdx.x & 7, rank = blockIdx.x >> 3;
    const int nrank = (G - grp + 7) >> 3, wv = rank * 8 + wid, nwv = nrank * 8;
    const bf16_t* ub = (const bf16_t*)(ws + WS_UB); const bf16_t* hb = (const bf16_t*)(ws + R_H1B);
    const int* eidx = (const int*)(ws + R_EXP); const float* gsm = (const float*)(ws + R_GSM); const float* rs1v = (const float*)(ws + WS_RS1);
    float* coef = (float*)(ws + R_COEF);
#pragma unroll 1
    for (int sweep = 0; sweep < 2; ++sweep) {
        const int sel = grp + 8 * sweep;
#pragma unroll 1
        for (int tok = wv; tok < NTOK; tok += nwv) {
            const int ev0 = eidx[(size_t)tok * 128 + lane], ev1 = eidx[(size_t)tok * 128 + 64 + lane];
            unsigned long long m0 = __ballot((ev0 & 15) == sel), m1 = __ballot((ev1 & 15) == sel);
            if ((m0 | m1) == 0ull) continue;
            const float gv0 = gsm[(size_t)tok * 128 + lane], gv1 = gsm[(size_t)tok * 128 + 64 + lane];
            const u32x4 xa = *(const u32x4*)(hb + (size_t)tok * DM + lane * 8), xc = *(const u32x4*)(hb + (size_t)tok * DM + 512 + lane * 8);
            const float rs1 = rs1v[tok];
            while ((m0 | m1) != 0ull) {
                int jj[8]; int ee[8]; float gg[8]; int nv = 0;
#pragma unroll
                for (int k = 0; k < 8; ++k) {
                    int j = k > 0 ? jj[k - 1] : 0; int e = k > 0 ? ee[k - 1] : 0; float g = k > 0 ? gg[k - 1] : 0.f;
                    if (m0 != 0ull) { const int b = __builtin_ctzll(m0); m0 &= m0 - 1ull; j = b; e = __builtin_amdgcn_readlane(ev0, b); g = __uint_as_float(__builtin_amdgcn_readlane(__float_as_uint(gv0), b)); nv = k + 1; }
                    else if (m1 != 0ull) { const int b = __builtin_ctzll(m1); m1 &= m1 - 1ull; j = 64 + b; e = __builtin_amdgcn_readlane(ev1, b); g = __uint_as_float(__builtin_amdgcn_readlane(__float_as_uint(gv1), b)); nv = k + 1; }
                    jj[k] = j; ee[k] = e; gg[k] = g;
                }
                float part[8];
#pragma unroll
                for (int k = 0; k < 8; ++k) {
                    const bf16_t* ur = ub + (size_t)ee[k] * DM + lane * 8;
                    const u32x4 ua = *(const u32x4*)ur, uc = *(const u32x4*)(ur + 512);
                    float a = dot2bf(xa.x, ua.x, 0.f); a = dot2bf(xa.y, ua.y, a); a = dot2bf(xa.z, ua.z, a); a = dot2bf(xa.w, ua.w, a);
                    a = dot2bf(xc.x, uc.x, a); a = dot2bf(xc.y, uc.y, a); a = dot2bf(xc.z, uc.z, a); a = dot2bf(xc.w, uc.w, a);
                    part[k] = a;
                }
#pragma unroll
                for (int m = 4; m >= 1; m >>= 1) {
                    const bool up = (lane & (8 * m)) != 0;
#pragma unroll
                    for (int i = 0; i < m; ++i) { const float send = up ? part[i] : part[i + m], keep = up ? part[i + m] : part[i]; part[i] = keep + __shfl_xor(send, 8 * m); }
                }
                float tot = part[0];
                tot += __shfl_xor(tot, 4); tot += __shfl_xor(tot, 2); tot += __shfl_xor(tot, 1);
                const int kk = lane >> 3;
                int myj = jj[0]; float myg = gg[0];
#pragma unroll
                for (int k = 1; k < 8; ++k) { myj = kk == k ? jj[k] : myj; myg = kk == k ? gg[k] : myg; }
                if ((lane & 7) == 0 && kk < nv) coef[(size_t)tok * 128 + myj] = myg * gelu_tanh(tot * rs1);
            }
        }
    }
}
DI void p6_peer_v(const Params& p, int G) {
    unsigned char* ws = p.ws;
    const int tid = threadIdx.x, lane = tid & 63, wid = tid >> 6, grp = blockIdx.x & 7, rank = blockIdx.x >> 3;
    const int nrank = (G - grp + 7) >> 3, wv = rank * 8 + wid, nwv = nrank * 8;
    const bf16_t* vb = (const bf16_t*)(ws + WS_VB);
    const int* eidx = (const int*)(ws + R_EXP); const float* coef = (const float*)(ws + R_COEF);
    float* h = p.out; bf16_t* hb = (bf16_t*)(ws + R_H1B); float* ssq2 = (float*)(ws + WS_SSQ2);
    const int sub = lane >> 3, c8 = (lane & 7) * 8;
#pragma unroll 1
    for (int sweep = 0; sweep < 2; ++sweep) {
        const int slice = grp + 8 * sweep, col0 = slice * 64 + c8;
#pragma unroll 1
        for (int tok = wv; tok < NTOK; tok += nwv) {
            const int ev0 = eidx[(size_t)tok * 128 + lane], ev1 = eidx[(size_t)tok * 128 + 64 + lane];
            const float cv0 = coef[(size_t)tok * 128 + lane], cv1 = coef[(size_t)tok * 128 + 64 + lane];
            u32x4 vr[16]; float cf[16];
#pragma unroll
            for (int i = 0; i < 16; ++i) {
                const int j = 8 * i + sub;
                const int e = __shfl(i < 8 ? ev0 : ev1, j & 63); cf[i] = __shfl(i < 8 ? cv0 : cv1, j & 63);
                vr[i] = *(const u32x4*)(vb + (size_t)e * DM + col0);
            }
            float acc[8];
#pragma unroll
            for (int q = 0; q < 8; ++q) acc[q] = 0.f;
#pragma unroll
            for (int i = 0; i < 16; ++i) {
                const float c = cf[i];
                acc[0] += c * bflo(vr[i].x); acc[1] += c * bfhi(vr[i].x); acc[2] += c * bflo(vr[i].y); acc[3] += c * bfhi(vr[i].y);
                acc[4] += c * bflo(vr[i].z); acc[5] += c * bfhi(vr[i].z); acc[6] += c * bflo(vr[i].w); acc[7] += c * bfhi(vr[i].w);
            }
#pragma unroll
            for (int q = 0; q < 8; ++q) { acc[q] += __shfl_xor(acc[q], 8); acc[q] += __shfl_xor(acc[q], 16); acc[q] += __shfl_xor(acc[q], 32); }
            float ss = 0.f;
            if (lane < 8) {
                float* hr = h + (size_t)tok * DM + col0;
                f32x4 h0 = *(f32x4*)hr, h1 = *(f32x4*)(hr + 4);
                h0 += (f32x4){acc[0], acc[1], acc[2], acc[3]}; h1 += (f32x4){acc[4], acc[5], acc[6], acc[7]};
                *(f32x4*)hr = h0; *(f32x4*)(hr + 4) = h1;
                u32x4 w; w.x = pk_bf16(h0[0], h0[1]); w.y = pk_bf16(h0[2], h0[3]); w.z = pk_bf16(h1[0], h1[1]); w.w = pk_bf16(h1[2], h1[3]);
                *(u32x4*)(hb + (size_t)tok * DM + col0) = w;
                ss = (h0[0] * h0[0] + h0[1] * h0[1]) + (h0[2] * h0[2] + h0[3] * h0[3]) + (h1[0] * h1[0] + h1[1] * h1[1]) + (h1[2] * h1[2] + h1[3] * h1[3]);
            }
            ss += __shfl_xor(ss, 1); ss += __shfl_xor(ss, 2); ss += __shfl_xor(ss, 4);
            if (lane == 0) ssq2[(size_t)slice * NTOK + tok] = ss;
        }
    }
}
constexpr float U8_SCALE = 32.0f, V8_SCALE = 8.0f;
DI void fp8x16_to_f32(const u32x4 w, float (&f)[16]) {
#pragma unroll
    for (int q = 0; q < 4; ++q) {
        const f32x2 lo = __builtin_amdgcn_cvt_pk_f32_fp8((int)w[q], false), hi = __builtin_amdgcn_cvt_pk_f32_fp8((int)w[q], true);
        f[4 * q] = lo.x; f[4 * q + 1] = lo.y; f[4 * q + 2] = hi.x; f[4 * q + 3] = hi.y;
    }
}
struct Pu5Fixed { int ev0, ev1; float gv0, gv1; u32x4 xa, xb; float rs1; };
DI void pu5_load_fixed(Pu5Fixed& f, int tok, int lane, const int* eidx, const float* gsm, const bf16_t* hb, const float* rs1v) {
    f.ev0 = eidx[(size_t)tok * 128 + lane]; f.ev1 = eidx[(size_t)tok * 128 + 64 + lane];
    f.gv0 = gsm[(size_t)tok * 128 + lane]; f.gv1 = gsm[(size_t)tok * 128 + 64 + lane];
    f.xa = *(const u32x4*)(hb + (size_t)tok * DM + lane * 16); f.xb = *(const u32x4*)(hb + (size_t)tok * DM + lane * 16 + 8);
    f.rs1 = rs1v[tok];
}
DI int pu5_setup(const Pu5Fixed& f, int sel, int lane, LAS3 unsigned* ent) {
    const bool s0 = (f.ev0 & 15) == sel, s1 = (f.ev1 & 15) == sel;
    const unsigned long long b0 = __ballot(s0), b1 = __ballot(s1);
    const int c0 = __builtin_popcountll(b0), cnt = c0 + __builtin_popcountll(b1);
    const unsigned long long lt = (1ull << lane) - 1ull;
    const int r0 = __builtin_popcountll(b0 & lt), r1 = c0 + __builtin_popcountll(b1 & lt);
    if (s0) { ent[r0] = (unsigned)f.ev0 | ((unsigned)lane << 16); ent[128 + r0] = __float_as_uint(f.gv0); }
    if (s1) { ent[r1] = (unsigned)f.ev1 | ((unsigned)(64 + lane) << 16); ent[128 + r1] = __float_as_uint(f.gv1); }
    return cnt;
}
#define PU5_ISSUE(SET, ENT, CNT) do { \
        _Pragma("unroll") for (int q = 0; q < 4; ++q) { const u32x4 e4 = *(LAS3 const u32x4*)((ENT) + 4 * q); \
            _Pragma("unroll") for (int k2 = 0; k2 < 4; ++k2) { const int k = 4 * q + k2; \
                const unsigned off = k < (CNT) ? ((e4[k2] & 0x3fffu) * (unsigned)DM) + lane * 16 : 0x80000000u; \
                SET[k] = __builtin_amdgcn_raw_buffer_load_b128(urs, off, 0, 0); } } } while (0)
#define PU5_CONSUME(SET, ENT, CNT, TOK, RS) do { \
        float part[16]; \
        _Pragma("unroll") for (int k = 0; k < 16; ++k) { float a = 0.f; \
            if (k < (CNT)) { f32x2 a2 = {0.f, 0.f}; \
                _Pragma("unroll") for (int q = 0; q < 4; ++q) { \
                    a2 = __builtin_elementwise_fma(__builtin_amdgcn_cvt_pk_f32_fp8((int)SET[k][q], false), xp[2 * q], a2); \
                    a2 = __builtin_elementwise_fma(__builtin_amdgcn_cvt_pk_f32_fp8((int)SET[k][q], true), xp[2 * q + 1], a2); } \
                a = a2.x + a2.y; } \
            part[k] = a; } \
        _Pragma("unroll") for (int m = 8; m >= 1; m >>= 1) { const bool up = (lane & (4 * m)) != 0; \
            _Pragma("unroll") for (int i = 0; i < m; ++i) { const float send = up ? part[i] : part[i + m], keep = up ? part[i + m] : part[i]; part[i] = keep + __shfl_xor(send, 4 * m); } } \
        float tot = part[0]; tot += __shfl_xor(tot, 2); tot += __shfl_xor(tot, 1); \
        const int kk = lane >> 2; const unsigned ew = (ENT)[kk]; const float gw = __uint_as_float((ENT)[128 + kk]); \
        if ((lane & 3) == 0 && kk < (CNT)) coef[(size_t)(TOK) * 128 + (ew >> 16)] = gw * (1.0f / V8_SCALE) * gelu_tanh(tot * ((RS) * (1.0f / U8_SCALE))); \
        if ((CNT) > 16) {   \
            for (int base = 16; base < (CNT); base += 16) { u32x4 rx[16]; \
                _Pragma("unroll") for (int k = 0; k < 16; ++k) { const unsigned e1 = (ENT)[base + k]; \
                    rx[k] = __builtin_amdgcn_raw_buffer_load_b128(urs, base + k < (CNT) ? ((e1 & 0x3fffu) * (unsigned)DM) + lane * 16 : 0x80000000u, 0, 0); } \
                float pr[16]; \
                _Pragma("unroll") for (int k = 0; k < 16; ++k) { f32x2 a2 = {0.f, 0.f}; \
                    _Pragma("unroll") for (int q = 0; q < 4; ++q) { \
                        a2 = __builtin_elementwise_fma(__builtin_amdgcn_cvt_pk_f32_fp8((int)rx[k][q], false), xp[2 * q], a2); \
                        a2 = __builtin_elementwise_fma(__builtin_amdgcn_cvt_pk_f32_fp8((int)rx[k][q], true), xp[2 * q + 1], a2); } \
                    pr[k] = a2.x + a2.y; } \
                _Pragma("unroll") for (int m = 8; m >= 1; m >>= 1) { const bool up = (lane & (4 * m)) != 0; \
                    _Pragma("unroll") for (int i = 0; i < m; ++i) { const float send = up ? pr[i] : pr[i + m], keep = up ? pr[i + m] : pr[i]; pr[i] = keep + __shfl_xor(send, 4 * m); } } \
                float t2 = pr[0]; t2 += __shfl_xor(t2, 2); t2 += __shfl_xor(t2, 1); \
                const int k3 = base + (lane >> 2); const unsigned ew2 = (ENT)[k3 & 127]; const float gw2 = __uint_as_float((ENT)[128 + (k3 & 127)]); \
                if ((lane & 3) == 0 && k3 < (CNT)) coef[(size_t)(TOK) * 128 + (ew2 >> 16)] = gw2 * (1.0f / V8_SCALE) * gelu_tanh(t2 * ((RS) * (1.0f / U8_SCALE))); } } } while (0)
#define PU5_UNPACK(F) do { _Pragma("unroll") for (int q = 0; q < 4; ++q) { xp[q] = (f32x2){bflo((F).xa[q]), bfhi((F).xa[q])}; xp[4 + q] = (f32x2){bflo((F).xb[q]), bfhi((F).xb[q])}; } } while (0)
DI void p6v5_u(const Params& p, LAS3 unsigned char* lds, int G) {
    unsigned char* ws = p.ws;
    const int tid = threadIdx.x, lane = tid & 63, wid = tid >> 6, grp = blockIdx.x & 7, rank = blockIdx.x >> 3;
    const int nrank = (G - grp + 7) >> 3, wv = rank * 8 + wid, nwv = nrank * 8;
    const unsigned char* u8 = (const unsigned char*)(ws + WS_UB); const bf16_t* hb = (const bf16_t*)(ws + R_H1B);
    const int* eidx = (const int*)(ws + R_EXP); const float* gsm = (const float*)(ws + R_GSM); const float* rs1v = (const float*)(ws + WS_RS1);
    float* coef = (float*)(ws + R_COEF);
    LAS3 unsigned* entA = (LAS3 unsigned*)(lds + wid * 2048); LAS3 unsigned* entB = entA + 256;
    if (wv >= NTOK) return;
    const __amdgpu_buffer_rsrc_t urs = __builtin_amdgcn_make_buffer_rsrc((void*)u8, 0, 16384 * DM, 0x00020000);
    const int nvis = (NTOK - wv + nwv - 1) / nwv, NV = 2 * nvis;
#define PU5_TOK(V) (wv + (((V) < NV ? (V) : NV - 1) % nvis) * nwv)
#define PU5_SEL(V) (grp + 8 * (((V) < NV ? (V) : NV - 1) / nvis))
    Pu5Fixed f1, f2;
    pu5_load_fixed(f1, PU5_TOK(0), lane, eidx, gsm, hb, rs1v);
    u32x4 sa[16], sb[16];
    f32x2 xp[8];
    int cntA = pu5_setup(f1, PU5_SEL(0), lane, entA), cntB = 0;
    PU5_ISSUE(sa, entA, cntA);
    int tokA = PU5_TOK(0), tokB = 0; float rsA = f1.rs1, rsB = 0.f;
    PU5_UNPACK(f1);
    pu5_load_fixed(f1, PU5_TOK(1), lane, eidx, gsm, hb, rs1v);
#pragma unroll 1
    for (int v = 0; v < NV; v += 2) {
        pu5_load_fixed(f2, PU5_TOK(v + 2), lane, eidx, gsm, hb, rs1v);
        cntB = pu5_setup(f1, PU5_SEL(v + 1), lane, entB); if (v + 1 >= NV) cntB = 0;
        PU5_ISSUE(sb, entB, cntB);
        tokB = PU5_TOK(v + 1); rsB = f1.rs1;
        PU5_CONSUME(sa, entA, cntA, tokA, rsA);
        PU5_UNPACK(f1);
        f1 = f2;
        pu5_load_fixed(f2, PU5_TOK(v + 3), lane, eidx, gsm, hb, rs1v);
        cntA = pu5_setup(f1, PU5_SEL(v + 2), lane, entA); if (v + 2 >= NV) cntA = 0;
        PU5_ISSUE(sa, entA, cntA);
        tokA = PU5_TOK(v + 2); rsA = f1.rs1;
        PU5_CONSUME(sb, entB, cntB, tokB, rsB);
        PU5_UNPACK(f1);
        f1 = f2;
    }
#undef PU5_TOK
#undef PU5_SEL
}
#undef PU5_ISSUE
#undef PU5_CONSUME
#undef PU5_UNPACK
template <int PMODE> DI void p6v3_v(const Params& p, int G) {
    unsigned char* ws = p.ws;
    const int tid = threadIdx.x, lane = tid & 63, wid = tid >> 6, grp = blockIdx.x & 7, rank = blockIdx.x >> 3;
    const int nrank = (G - grp + 7) >> 3, wv = rank * 8 + wid, nwv = nrank * 8;
    const unsigned char* v8 = (const unsigned char*)(ws + WS_VB);
    const int* eidx = (const int*)(ws + R_EXP); const float* coef = (const float*)(ws + R_COEF);
    float* h = PMODE == 0 ? p.out : (float*)(ws + R_BIG); bf16_t* hb = PMODE == 0 ? (bf16_t*)(ws + R_H1B) : (bf16_t*)(ws + WS_XB); float* ssq2 = PMODE == 0 ? (float*)(ws + WS_SSQ2) : (float*)(ws + WS_SSQ3);
    const int sub = lane >> 3, col0 = grp * 128 + (lane & 7) * 16;
    if (wv >= NTOK) return;
    const int nvis = (NTOK - wv + nwv - 1) / nwv;
#define PV_LOADIDX(T, EV0, EV1, CV0, CV1) do { EV0 = eidx[(size_t)(T) * 128 + lane]; EV1 = eidx[(size_t)(T) * 128 + 64 + lane]; CV0 = coef[(size_t)(T) * 128 + lane]; CV1 = coef[(size_t)(T) * 128 + 64 + lane]; } while (0)
#define PV_ISSUE8(R, EV) do { _Pragma("unroll") for (int i = 0; i < 8; ++i) { const int e = __shfl((EV), 8 * i + sub); R[i] = *(const u32x4*)(v8 + (unsigned)(e * DM + col0)); } } while (0)
#define PV_CONS8(R, CV) do { _Pragma("unroll") for (int i = 0; i < 8; ++i) { float f[16]; fp8x16_to_f32(R[i], f); const float c = __shfl((CV), 8 * i + sub); \
            _Pragma("unroll") for (int q = 0; q < 16; ++q) acc[q] += c * f[q]; } } while (0)
    u32x4 ra[8], rb[8];
    int e0, e1, n0, n1, x0, x1; float c0, c1, d0, d1, y0, y1;
    PV_LOADIDX(wv, e0, e1, c0, c1);
    { const int t1 = nvis > 1 ? wv + nwv : wv; PV_LOADIDX(t1, n0, n1, d0, d1); }
    PV_ISSUE8(ra, e0); PV_ISSUE8(rb, e1);
#pragma unroll 1
    for (int it = 0; it < nvis; ++it) {
        const int tok = wv + it * nwv;
        const int t2 = wv + (it + 2 < nvis ? it + 2 : nvis - 1) * nwv;
        float* hr = h + (size_t)tok * DM + col0;
        const f32x4 hv0 = *(const f32x4*)hr, hv1 = *(const f32x4*)(hr + 4), hv2 = *(const f32x4*)(hr + 8), hv3 = *(const f32x4*)(hr + 12);
        PV_LOADIDX(t2, x0, x1, y0, y1);
        float acc[16];
#pragma unroll
        for (int q = 0; q < 16; ++q) acc[q] = 0.f;
        PV_CONS8(ra, c0);
        PV_ISSUE8(ra, n0);
        PV_CONS8(rb, c1);
        PV_ISSUE8(rb, n1);
#pragma unroll
        for (int q = 0; q < 16; ++q) { acc[q] += __shfl_xor(acc[q], 8); acc[q] += __shfl_xor(acc[q], 16); acc[q] += __shfl_xor(acc[q], 32); }
        float ss = 0.f;
        if (lane < 8) {
            const f32x4 o0 = hv0 + (f32x4){acc[0], acc[1], acc[2], acc[3]}, o1 = hv1 + (f32x4){acc[4], acc[5], acc[6], acc[7]};
            const f32x4 o2 = hv2 + (f32x4){acc[8], acc[9], acc[10], acc[11]}, o3 = hv3 + (f32x4){acc[12], acc[13], acc[14], acc[15]};
            *(f32x4*)hr = o0; *(f32x4*)(hr + 4) = o1; *(f32x4*)(hr + 8) = o2; *(f32x4*)(hr + 12) = o3;
            u32x4 w0, w1;
            w0.x = pk_bf16(o0[0], o0[1]); w0.y = pk_bf16(o0[2], o0[3]); w0.z = pk_bf16(o1[0], o1[1]); w0.w = pk_bf16(o1[2], o1[3]);
            w1.x = pk_bf16(o2[0], o2[1]); w1.y = pk_bf16(o2[2], o2[3]); w1.z = pk_bf16(o3[0], o3[1]); w1.w = pk_bf16(o3[2], o3[3]);
            *(u32x4*)(hb + (size_t)tok * DM + col0) = w0; *(u32x4*)(hb + (size_t)tok * DM + col0 + 8) = w1;
#pragma unroll
            for (int j = 0; j < 4; ++j) ss += o0[j] * o0[j] + o1[j] * o1[j] + o2[j] * o2[j] + o3[j] * o3[j];
        }
        ss += __shfl_xor(ss, 1); ss += __shfl_xor(ss, 2); ss += __shfl_xor(ss, 4);
        if (lane == 0) ssq2[(size_t)grp * NTOK + tok] = ss;
        e0 = n0; e1 = n1; c0 = d0; c1 = d1; n0 = x0; n1 = x1; d0 = y0; d1 = y1;
    }
#undef PV_LOADIDX
#undef PV_ISSUE8
#undef PV_CONS8
}
DI void p6v6_peer(const Params& p, int G) {
    unsigned char* ws = p.ws;
    const int tid = threadIdx.x, lane = tid & 63, wid = tid >> 6;
    const int gw = blockIdx.x * 8 + wid, nw = G * 8;
    const unsigned char* u8 = (const unsigned char*)(ws + WS_UB); const unsigned char* v8 = (const unsigned char*)(ws + WS_VB);
    const int* eidx = (const int*)(ws + R_EXP); const float* gsm = (const float*)(ws + R_GSM); const float* rs1v = (const float*)(ws + WS_RS1);
    float* h = p.out; bf16_t* hb = (bf16_t*)(ws + R_H1B); float* rs2 = (float*)(ws + WS_RS2);
#pragma unroll 1
    for (int tok = gw; tok < NTOK; tok += nw) {
        const float rs1 = rs1v[tok] * (1.0f / U8_SCALE);
        const u32x4 xa = *(const u32x4*)(hb + (size_t)tok * DM + lane * 16), xb = *(const u32x4*)(hb + (size_t)tok * DM + lane * 16 + 8);
        f32x2 xp[8];
#pragma unroll
        for (int q = 0; q < 4; ++q) { xp[q] = (f32x2){bflo(xa[q]), bfhi(xa[q])}; xp[4 + q] = (f32x2){bflo(xb[q]), bfhi(xb[q])}; }
        const int e0 = eidx[(size_t)tok * 128 + lane], e1 = eidx[(size_t)tok * 128 + 64 + lane];
        const float g0 = gsm[(size_t)tok * 128 + lane], g1 = gsm[(size_t)tok * 128 + 64 + lane];
        float coef0 = 0.f, coef1 = 0.f;
#pragma unroll
        for (int half = 0; half < 2; ++half) {
            const int ev = half ? e1 : e0;
            float part[64];
#pragma unroll
            for (int j = 0; j < 64; ++j) {
                const int e = __builtin_amdgcn_readlane(ev, j);
                const u32x4 w = *(const u32x4*)(u8 + (size_t)e * DM + lane * 16);
                f32x2 a2 = {0.f, 0.f};
#pragma unroll
                for (int q = 0; q < 4; ++q) {
                    a2 = __builtin_elementwise_fma(__builtin_amdgcn_cvt_pk_f32_fp8((int)w[q], false), xp[2 * q], a2);
                    a2 = __builtin_elementwise_fma(__builtin_amdgcn_cvt_pk_f32_fp8((int)w[q], true), xp[2 * q + 1], a2);
                }
                part[j] = a2.x + a2.y;
            }
#pragma unroll
            for (int m = 32; m >= 1; m >>= 1) {
                const bool up = (lane & m) != 0;
#pragma unroll
                for (int i = 0; i < m; ++i) { const float send = up ? part[i] : part[i + m], keep = up ? part[i + m] : part[i]; part[i] = keep + __shfl_xor(send, m); }
            }
            const float act = gelu_tanh(part[0] * rs1);
            if (half) coef1 = g1 * act * (1.0f / V8_SCALE); else coef0 = g0 * act * (1.0f / V8_SCALE);
        }
        f32x2 acc[8];
#pragma unroll
        for (int i = 0; i < 8; ++i) acc[i] = (f32x2){0.f, 0.f};
#pragma unroll
        for (int half = 0; half < 2; ++half) {
            const int ev = half ? e1 : e0; const float cv = half ? coef1 : coef0;
#pragma unroll 16
            for (int j = 0; j < 64; ++j) {
                const int e = __builtin_amdgcn_readlane(ev, j);
                const float c = __uint_as_float(__builtin_amdgcn_readlane(__float_as_uint(cv), j));
                const u32x4 w = *(const u32x4*)(v8 + (size_t)e * DM + lane * 16);
                const f32x2 c2 = {c, c};
#pragma unroll
                for (int q = 0; q < 4; ++q) {
                    acc[2 * q] = __builtin_elementwise_fma(__builtin_amdgcn_cvt_pk_f32_fp8((int)w[q], false), c2, acc[2 * q]);
                    acc[2 * q + 1] = __builtin_elementwise_fma(__builtin_amdgcn_cvt_pk_f32_fp8((int)w[q], true), c2, acc[2 * q + 1]);
                }
            }
        }
        float* hr = h + (size_t)tok * DM + lane * 16;
        u32x4 w0, w1; float ss = 0.f;
#pragma unroll
        for (int q4 = 0; q4 < 4; ++q4) {
            f32x4 hv = *(f32x4*)(hr + 4 * q4);
            hv += (f32x4){acc[2 * q4].x, acc[2 * q4].y, acc[2 * q4 + 1].x, acc[2 * q4 + 1].y};
            *(f32x4*)(hr + 4 * q4) = hv;
            ss += (hv[0] * hv[0] + hv[1] * hv[1]) + (hv[2] * hv[2] + hv[3] * hv[3]);
            const unsigned a_ = pk_bf16(hv[0], hv[1]), b_ = pk_bf16(hv[2], hv[3]);
            if (q4 == 0) { w0.x = a_; w0.y = b_; } else if (q4 == 1) { w0.z = a_; w0.w = b_; } else if (q4 == 2) { w1.x = a_; w1.y = b_; } else { w1.z = a_; w1.w = b_; }
        }
        *(u32x4*)(hb + (size_t)tok * DM + lane * 16) = w0; *(u32x4*)(hb + (size_t)tok * DM + lane * 16 + 8) = w1;
        ss = wave_sum(ss);
        if (lane == 0) rs2[tok] = rsqrtf(ss * (1.0f / DM) + EPS);
    }
}
DI void p6v6_u(const Params& p, int G) {
    unsigned char* ws = p.ws;
    const int tid = threadIdx.x, lane = tid & 63, wid = tid >> 6;
    const int gw = blockIdx.x * 8 + wid, nw = G * 8;
    const unsigned char* u8 = (const unsigned char*)(ws + WS_UB); const unsigned char* v8 = (const unsigned char*)(ws + WS_VB);
    const int* eidx = (const int*)(ws + R_EXP); const float* gsm = (const float*)(ws + R_GSM); const float* rs1v = (const float*)(ws + WS_RS1);
    float* h = p.out; bf16_t* hb = (bf16_t*)(ws + R_H1B); float* rs2 = (float*)(ws + WS_RS2);
#pragma unroll 1
    for (int tok = gw; tok < NTOK; tok += nw) {
        const float rs1 = rs1v[tok] * (1.0f / U8_SCALE);
        const u32x4 xa = *(const u32x4*)(hb + (size_t)tok * DM + lane * 16), xb = *(const u32x4*)(hb + (size_t)tok * DM + lane * 16 + 8);
        f32x2 xp[8];
#pragma unroll
        for (int q = 0; q < 4; ++q) { xp[q] = (f32x2){bflo(xa[q]), bfhi(xa[q])}; xp[4 + q] = (f32x2){bflo(xb[q]), bfhi(xb[q])}; }
        const int e0 = eidx[(size_t)tok * 128 + lane], e1 = eidx[(size_t)tok * 128 + 64 + lane];
        const float g0 = gsm[(size_t)tok * 128 + lane], g1 = gsm[(size_t)tok * 128 + 64 + lane];
        float coef0 = 0.f, coef1 = 0.f;
#pragma unroll
        for (int half = 0; half < 2; ++half) {
            const int ev = half ? e1 : e0;
            float part[64];
#pragma unroll
            for (int j = 0; j < 64; ++j) {
                const int e = __builtin_amdgcn_readlane(ev, j);
                const u32x4 w = *(const u32x4*)(u8 + (size_t)e * DM + lane * 16);
                f32x2 a2 = {0.f, 0.f};
#pragma unroll
                for (int q = 0; q < 4; ++q) {
                    a2 = __builtin_elementwise_fma(__builtin_amdgcn_cvt_pk_f32_fp8((int)w[q], false), xp[2 * q], a2);
                    a2 = __builtin_elementwise_fma(__builtin_amdgcn_cvt_pk_f32_fp8((int)w[q], true), xp[2 * q + 1], a2);
                }
                part[j] = a2.x + a2.y;
            }
#pragma unroll
            for (int m = 32; m >= 1; m >>= 1) {
                const bool up = (lane & m) != 0;
#pragma unroll
                for (int i = 0; i < m; ++i) { const float send = up ? part[i] : part[i + m], keep = up ? part[i + m] : part[i]; part[i] = keep + __shfl_xor(send, m); }
            }
            const float act = gelu_tanh(part[0] * rs1);
            if (half) coef1 = g1 * act * (1.0f / V8_SCALE); else coef0 = g0 * act * (1.0f / V8_SCALE);
        }
        float* coef = (float*)(ws + R_COEF);
        coef[(size_t)tok * 128 + lane] = coef0; coef[(size_t)tok * 128 + 64 + lane] = coef1;
    }
}
DI void p6v6_v(const Params& p, int G) {
    unsigned char* ws = p.ws;
    const int tid = threadIdx.x, lane = tid & 63, wid = tid >> 6;
    const int gw = blockIdx.x * 8 + wid, nw = G * 8;
    const unsigned char* v8 = (const unsigned char*)(ws + WS_VB);
    const int* eidx = (const int*)(ws + R_EXP); const float* coef = (const float*)(ws + R_COEF);
    float* h = p.out; bf16_t* hb = (bf16_t*)(ws + R_H1B); float* rs2 = (float*)(ws + WS_RS2);
#pragma unroll 1
    for (int tok = gw; tok < NTOK; tok += nw) {
        const int e0 = eidx[(size_t)tok * 128 + lane], e1 = eidx[(size_t)tok * 128 + 64 + lane];
        const float coef0 = coef[(size_t)tok * 128 + lane], coef1 = coef[(size_t)tok * 128 + 64 + lane];
        f32x2 acc[8];
#pragma unroll
        for (int i = 0; i < 8; ++i) acc[i] = (f32x2){0.f, 0.f};
#pragma unroll
        for (int half = 0; half < 2; ++half) {
            const int ev = half ? e1 : e0; const float cv = half ? coef1 : coef0;
#pragma unroll 16
            for (int j = 0; j < 64; ++j) {
                const int e = __builtin_amdgcn_readlane(ev, j);
                const float c = __uint_as_float(__builtin_amdgcn_readlane(__float_as_uint(cv), j));
                const u32x4 w = *(const u32x4*)(v8 + (size_t)e * DM + lane * 16);
                const f32x2 c2 = {c, c};
#pragma unroll
                for (int q = 0; q < 4; ++q) {
                    acc[2 * q] = __builtin_elementwise_fma(__builtin_amdgcn_cvt_pk_f32_fp8((int)w[q], false), c2, acc[2 * q]);
                    acc[2 * q + 1] = __builtin_elementwise_fma(__builtin_amdgcn_cvt_pk_f32_fp8((int)w[q], true), c2, acc[2 * q + 1]);
                }
            }
        }
        float* hr = h + (size_t)tok * DM + lane * 16;
        u32x4 w0, w1; float ss = 0.f;
#pragma unroll
        for (int q4 = 0; q4 < 4; ++q4) {
            f32x4 hv = *(f32x4*)(hr + 4 * q4);
            hv += (f32x4){acc[2 * q4].x, acc[2 * q4].y, acc[2 * q4 + 1].x, acc[2 * q4 + 1].y};
            *(f32x4*)(hr + 4 * q4) = hv;
            ss += (hv[0] * hv[0] + hv[1] * hv[1]) + (hv[2] * hv[2] + hv[3] * hv[3]);
            const unsigned a_ = pk_bf16(hv[0], hv[1]), b_ = pk_bf16(hv[2], hv[3]);
            if (q4 == 0) { w0.x = a_; w0.y = b_; } else if (q4 == 1) { w0.z = a_; w0.w = b_; } else if (q4 == 2) { w1.x = a_; w1.y = b_; } else { w1.z = a_; w1.w = b_; }
        }
        *(u32x4*)(hb + (size_t)tok * DM + lane * 16) = w0; *(u32x4*)(hb + (size_t)tok * DM + lane * 16 + 8) = w1;
        ss = wave_sum(ss);
        if (lane == 0) rs2[tok] = rsqrtf(ss * (1.0f / DM) + EPS);
    }
}
constexpr int LDS_MISC = 160 * 1024 - 256;
constexpr int LDS_BYTES = 160 * 1024;
constexpr size_t CTL_BAR = 0;
static_assert(XCD_BAR_WORDS * 4 <= 64 * 1024, "control region");

template <class F> struct EpiAdapt {
    static constexpr bool PERM = true, AFTER_DRAIN = false;
    F f;
    DI void operator()(const f32x4 (&acc)[2][2][4][2], const pg8::Unit& u, int wr, int wc, int fr, int fq) const {
        const int row0 = u.pm * 256 + wr * 64 + fr, col0 = u.pn * 256 + wc * 32 + 8 * fq;
#pragma unroll
        for (int ai = 0; ai < 2; ++ai)
#pragma unroll
            for (int m = 0; m < 4; ++m) {
                const int row = row0 + ai * 128 + m * 16;
#pragma unroll
                for (int bj = 0; bj < 2; ++bj)
#pragma unroll
                    for (int n = 0; n < 2; ++n) f.store4(row, col0 + bj * 128 + 4 * n, acc[ai][bj][m][n]);
            }
    }
};
template <class F> struct EpiAdaptSsq {
    static constexpr bool PERM = true, AFTER_DRAIN = false;
    F f; float* ssq;
    DI void operator()(const f32x4 (&acc)[2][2][4][2], const pg8::Unit& u, int wr, int wc, int fr, int fq) const {
        const int row0 = u.pm * 256 + wr * 64 + fr, col0 = u.pn * 256 + wc * 32 + 8 * fq;
#pragma unroll
        for (int ai = 0; ai < 2; ++ai)
#pragma unroll
            for (int m = 0; m < 4; ++m) {
                const int row = row0 + ai * 128 + m * 16;
                float s = 0.f; const float rsc = f.rowscale(row);
#pragma unroll
                for (int bj = 0; bj < 2; ++bj)
#pragma unroll
                    for (int n = 0; n < 2; ++n) { const f32x4 v = f.store4r(row, col0 + bj * 128 + 4 * n, acc[ai][bj][m][n], rsc); s += (v[0] * v[0] + v[1] * v[1]) + (v[2] * v[2] + v[3] * v[3]); }
                s += __shfl_xor(s, 16); s += __shfl_xor(s, 32);
                if (fq == 0) ssq[(size_t)(u.pn * 4 + wc) * NTOK + row] = s;
            }
    }
};
struct EpiOutR {
    const float* x; float* h1; bf16_t* h1b;
    DI float rowscale(int) const { return 0.f; }
    DI f32x4 store4r(int row, int col, f32x4 v, float) const {
        const size_t o = (size_t)row * DM + col;
        v += *(const f32x4*)(x + o);
        *(f32x4*)(h1 + o) = v;
        u32x2 w; w.x = pack2bf(v[0], v[1]); w.y = pack2bf(v[2], v[3]); *(u32x2*)(h1b + o) = w;
        return v;
    }
};
struct EpiGateR {
    const float* rs2; const float* bias; const float* pp; float* h;
    DI float rowscale(int row) const {
#if PEER_V2 && (!PEER_V6 || PEER_V6 == 3)
        float s = 0.f;
#pragma unroll
        for (int j = 0; j < (PEER_V3 ? 8 : 16); ++j) s += rs2[(size_t)j * NTOK + row];
        return rsqrtf(s * (1.0f / DM) + EPS);
#else
        return rs2[row];
#endif
    }
    DI f32x4 store4r(int row, int col, f32x4 v, float s) const {
        const size_t o = (size_t)row * DM + col;
        const f32x4 bb = *(const f32x4*)(bias + col), p4 = *(const f32x4*)(pp + o);
        f32x4 hv = *(f32x4*)(h + o);
#pragma unroll
        for (int j = 0; j < 4; ++j) hv[j] += sigmoidf_(v[j] * s + bb[j]) * p4[j];
        *(f32x4*)(h + o) = hv;
        return hv;
    }
};

struct MegaArgs { Params p; int ph_lo, ph_hi; };

__global__ void __launch_bounds__(MK_THREADS, 2) mega_fwd(MegaArgs args) {
    extern __shared__ __attribute__((aligned(16))) unsigned char lds_raw[];
    LAS unsigned char* lds = (LAS unsigned char*)lds_raw;
    const Params& p = args.p;
    unsigned char* ws = p.ws;
    const int lo = args.ph_lo, hi = args.ph_hi;
    const int G = gridDim.x;
    volatile LAS unsigned* misc = (volatile LAS unsigned*)(lds + LDS_MISC);
    if (threadIdx.x < 64) misc[threadIdx.x] = 0u;
    __syncthreads();
    XcdBarrier bar; bar.bar = (unsigned*)(ws + WS_CTL); bar.x = 0; bar.st = nullptr;
    bar = xcd_barrier_post((unsigned*)(ws + WS_CTL), misc);
#define IN(k) (lo <= (k) && (k) < hi)
#define SEAM(k) do { if (IN(k) && IN((k) + 1)) xcd_barrier(bar); } while (0)

    if (IN(0)) p0_prologue(p, lds, G);
    SEAM(0);
    if (IN(1)) {
        pg8::Gemm g{(const bf16_t*)(ws + WS_XB), (const bf16_t*)(ws + WS_WIN), NTOK, NPROJ, DM};
        pg8::StaticOrder S; S.init(NTOK, NPROJ, G, (int)blockIdx.x);
        EpiAdapt<EpiProj> E{{(const float*)(ws + WS_RS0), (bf16_t*)(ws + R_QB), (bf16_t*)(ws + R_KC), (float*)(ws + R_GATE), (float*)(ws + R_XR), (bf16_t*)(ws + R_XG)}};
        pg8::gemm_phase<EpiAdapt<EpiProj>, pg8::StaticOrder>(lds, g, S, E, nullptr);
    }
    SEAM(1);
    if (IN(2)) { if (!CMP_NAIVE) { p2_compress(p, lds, G); p2_vtranspose(p, lds, G); } lru_phase<false>(p, lds, G); }
    SEAM(2);
    if (IN(3)) { p3_attention(p, lds, G); if (!LRU_NAIVE) lru_phase<true>(p, lds, G);
#ifdef PROBE_LRU2
        lru_phase<true>(p, lds, G);
#endif
#ifdef PROBE_ATT2
        p3_attention(p, lds, G);
#endif
    }
    SEAM(3);
    if (IN(4)) {
        pg8::Gemm g{(const bf16_t*)(ws + WS_XB), (const bf16_t*)(ws + WS_WOUT), NTOK, DM, DM};
        pg8::StaticOrder S; S.init(NTOK, DM, G, (int)blockIdx.x);
        EpiAdaptSsq<EpiOutR> E{{p.in[I_X], p.out, (bf16_t*)(ws + R_H1B)}, (float*)(ws + WS_SSQ1)};
        pg8::gemm_phase<EpiAdaptSsq<EpiOutR>, pg8::StaticOrder>(lds, g, S, E, nullptr);
    }
    SEAM(4);
    if (IN(5)) p5_peer_route(p, lds, G);
    SEAM(5);
    if (IN(6)) {
#if PEER_V6 == 2
        p6v6_u(p, G); xcd_barrier(bar); p6v6_v(p, G);
#elif PEER_V6 == 3
        p6v6_u(p, G); xcd_barrier(bar); p6v3_v<0>(p, G);
#elif PEER_V6
        p6v6_peer(p, G);
#elif PEER_V3
        p6v5_u(p, lds, G);
#ifdef PROBE_U2
        p6v5_u(p, lds, G);
#endif
        xcd_barrier(bar); p6v3_v<0>(p, G);
#elif PEER_V2
        p6_peer_u(p, G);
#ifdef PROBE_U2
        p6_peer_u(p, G);
#endif
        xcd_barrier(bar); p6_peer_v(p, G);
#else
        p6_peer_apply(p, G);
#endif
    }
    SEAM(6);
    if (IN(7)) {
        {
            pg8::Gemm g{(const bf16_t*)(ws + WS_PB), (const bf16_t*)(ws + WS_WP), NTOK, DM, PLE};
            pg8::StaticOrder S; S.init(NTOK, DM, G, (int)blockIdx.x);
            EpiAdapt<EpiF32Plain> E{{(float*)(ws + R_BIG), DM, 0}};
            pg8::gemm_phase<EpiAdapt<EpiF32Plain>, pg8::StaticOrder>(lds, g, S, E, nullptr);
        }
        __syncthreads();
        {
            pg8::Gemm g{(const bf16_t*)(ws + R_H1B), (const bf16_t*)(ws + WS_WG), NTOK, DM, DM};
            pg8::StaticOrder S; S.init(NTOK, DM, G, (int)blockIdx.x);
            EpiAdaptSsq<EpiGateR> E{{(const float*)(ws + ((PEER_V2 && (!PEER_V6 || PEER_V6 == 3)) ? WS_SSQ2 : WS_RS2)), p.in[I_PLE_BG], (const float*)(ws + R_BIG), p.out}, (float*)(ws + WS_SSQ3)};
            pg8::gemm_phase<EpiAdaptSsq<EpiGateR>, pg8::StaticOrder>(lds, g, S, E, nullptr);
        }
    }
    SEAM(7);
    if (IN(8)) p8_final_norm(p, G);
#undef IN
#undef SEAM
}

static int g_grid = 0;
static void launch_mega(hipStream_t st, const Params& p, int lo, int hi) {
    if (g_grid == 0) {
        int dev = 0, cus = 0, per_cu = 0;
        hipGetDevice(&dev); hipDeviceGetAttribute(&cus, hipDeviceAttributeMultiprocessorCount, dev);
        if (hipFuncSetAttribute((const void*)mega_fwd, hipFuncAttributeMaxDynamicSharedMemorySize, LDS_BYTES) != hipSuccess) { fprintf(stderr, "hipFuncSetAttribute failed\n"); g_grid = -1; return; }
        if (hipOccupancyMaxActiveBlocksPerMultiprocessor(&per_cu, (const void*)mega_fwd, MK_THREADS, LDS_BYTES) != hipSuccess || per_cu < 1) { fprintf(stderr, "occupancy query: %d per CU\n", per_cu); }
        (void)hipGetLastError();
        g_grid = cus;
    }
    if (g_grid < 0) return;
    MegaArgs a{}; a.p = p; a.ph_lo = lo; a.ph_hi = hi;
    hipLaunchKernelGGL(mega_fwd, dim3(g_grid), dim3(MK_THREADS), LDS_BYTES, st, a);
}
template <class Epi> static void gemm_naive(hipStream_t st, const bf16_t* A, int lda, const bf16_t* Bt, int ldb, int M, int N, int K, const Epi& E) {
    hipLaunchKernelGGL((k_gemm_naive<Epi>), dim3(N / 64, M / 64), dim3(256), 0, st, A, lda, Bt, ldb, K, E);
}

static void run_prologue_naive(hipStream_t st, const Params& p) {
    unsigned char* ws = p.ws;
    hipLaunchKernelGGL(k_prep_x, dim3(NTOK), dim3(256), 0, st, p.in[I_X], (bf16_t*)(ws + WS_XB), (float*)(ws + WS_RS0));
    hipLaunchKernelGGL(k_prep_win, dim3((NPROJ * DM + 255) / 256), dim3(256), 0, st, p.in[I_W_IN], p.in[I_ATTN_NORM], (bf16_t*)(ws + WS_WIN));
    hipLaunchKernelGGL(k_transpose_bf16, dim3(DM * DM / 256), dim3(256), 0, st, p.in[I_W_OUT], (const float*)nullptr, (bf16_t*)(ws + WS_WOUT), DM, DM);
    hipLaunchKernelGGL(k_transpose_bf16, dim3(DM * DM / 256), dim3(256), 0, st, p.in[I_PLE_WG], p.in[I_PLE_NORM], (bf16_t*)(ws + WS_WG), DM, DM);
    hipLaunchKernelGGL(k_transpose_bf16, dim3(PLE * DM / 256), dim3(256), 0, st, p.in[I_PLE_PROJ], (const float*)nullptr, (bf16_t*)(ws + WS_WP), PLE, DM);
    hipLaunchKernelGGL(k_transpose_bf16, dim3(2048 * 256 / 256), dim3(256), 0, st, p.in[I_CK_W1], (const float*)nullptr, (bf16_t*)(ws + WS_CW1K), 2048, 256);
    hipLaunchKernelGGL(k_transpose_bf16, dim3(2048 * 256 / 256), dim3(256), 0, st, p.in[I_CV_W1], (const float*)nullptr, (bf16_t*)(ws + WS_CW1V), 2048, 256);
    hipLaunchKernelGGL(k_prep_wqs, dim3(DM * 16), dim3(128), 0, st, p.in[I_PEER_WQ], p.in[I_PEER_SUB], p.in[I_FFN_NORM], (bf16_t*)(ws + WS_WQS));
    hipLaunchKernelGGL(k_cvt_bf16, dim3(2048), dim3(256), 0, st, p.in[I_PEER_U], p.in[I_FFN_NORM], (bf16_t*)(ws + WS_UB), (size_t)16384 * DM / 4, DM);
    hipLaunchKernelGGL(k_cvt_bf16, dim3(2048), dim3(256), 0, st, p.in[I_PEER_V], (const float*)nullptr, (bf16_t*)(ws + WS_VB), (size_t)16384 * DM / 4, DM);
    hipLaunchKernelGGL(k_cvt_bf16, dim3(1024), dim3(256), 0, st, p.in[I_P], (const float*)nullptr, (bf16_t*)(ws + WS_PB), (size_t)NTOK * PLE / 4, PLE);
    hipLaunchKernelGGL(k_prep_cmpbias, dim3(1), dim3(256), 0, st, p.in[I_CK_PE], p.in[I_CK_W1], (float*)(ws + WS_CBK));
    hipLaunchKernelGGL(k_prep_cmpbias, dim3(1), dim3(256), 0, st, p.in[I_CV_PE], p.in[I_CV_W1], (float*)(ws + WS_CBV));
}
static void run_p1_naive(hipStream_t st, const Params& p) {
    unsigned char* ws = p.ws;
    EpiProj E{(const float*)(ws + WS_RS0), (bf16_t*)(ws + R_QB), (bf16_t*)(ws + R_KC), (float*)(ws + R_GATE), (float*)(ws + R_XR), (bf16_t*)(ws + R_XG)};
    gemm_naive(st, (const bf16_t*)(ws + WS_XB), DM, (const bf16_t*)(ws + WS_WIN), DM, NTOK, NPROJ, DM, E);
}
static void run_p2_naive(hipStream_t st, const Params& p) {
    unsigned char* ws = p.ws;
    float* hid = (float*)(ws + WS_HID);
    hipLaunchKernelGGL(k_cmp_hidden, dim3(2048), dim3(256), 0, st, (const bf16_t*)(ws + R_KC), (const bf16_t*)(ws + WS_CW1K), (const float*)(ws + WS_CBK), hid);
    hipLaunchKernelGGL(k_cmp_hidden, dim3(2048), dim3(256), 0, st, (const bf16_t*)(ws + R_VC), (const bf16_t*)(ws + WS_CW1V), (const float*)(ws + WS_CBV), hid + (size_t)2048 * 256);
    hipLaunchKernelGGL(k_cmp_out, dim3(2048), dim3(64), 0, st, (const float*)hid, p.in[I_CK_W2], (float*)(ws + WS_KCMP));
    hipLaunchKernelGGL(k_cmp_out, dim3(2048), dim3(64), 0, st, (const float*)(hid + (size_t)2048 * 256), p.in[I_CV_W2], (float*)(ws + WS_VCMP));
}
static void run_p2_extras(hipStream_t st, const Params& p) {
    unsigned char* ws = p.ws;
    hipLaunchKernelGGL(k_p2_extras, dim3(2048), dim3(256), 0, st, (const bf16_t*)(ws + R_VS), (const bf16_t*)(ws + R_VW), (const float*)(ws + WS_KCMP), (const float*)(ws + WS_VCMP),
                       (bf16_t*)(ws + R_VST), (bf16_t*)(ws + R_VWT), (bf16_t*)(ws + R_KCB), (bf16_t*)(ws + R_VCT));
}
static void run_lru_naive(hipStream_t st, const Params& p) {
    unsigned char* ws = p.ws;
    LruArgs la{(const float*)(ws + R_XR), (const bf16_t*)(ws + R_XG), p.in[I_CONV_W], p.in[I_CONV_B], p.in[I_LRU_WA], p.in[I_LRU_BA], p.in[I_LRU_WX], p.in[I_LRU_BX], p.in[I_LRU_LAM], p.out};
    hipLaunchKernelGGL(k_lru_naive, dim3(NB * 8), dim3(64), 0, st, la);
    hipLaunchKernelGGL(k_grpnorm_lru, dim3(NTOK), dim3(256), 0, st, (const float*)p.out, p.in[I_GN_LRU], (bf16_t*)(ws + WS_XB));
}
static void run_p3_naive(hipStream_t st, const Params& p) {
    unsigned char* ws = p.ws;
    NsaArgs na{(const bf16_t*)(ws + R_QB), (const bf16_t*)(ws + R_KS), (const bf16_t*)(ws + R_VS), (const bf16_t*)(ws + R_KW), (const bf16_t*)(ws + R_VW),
               (const float*)(ws + WS_KCMP), (const float*)(ws + WS_VCMP), (const float*)(ws + R_GATE), p.in[I_REL], p.out};
    hipLaunchKernelGGL(k_nsa_naive, dim3(NB * NKV * T_), dim3(256), 0, st, na);
    LruArgs la{(const float*)(ws + R_XR), (const bf16_t*)(ws + R_XG), p.in[I_CONV_W], p.in[I_CONV_B], p.in[I_LRU_WA], p.in[I_LRU_BA], p.in[I_LRU_WX], p.in[I_LRU_BX], p.in[I_LRU_LAM], p.out};
    hipLaunchKernelGGL(k_lru_naive, dim3(NB * 8), dim3(64), 0, st, la);
    hipLaunchKernelGGL(k_grpnorm, dim3(NTOK), dim3(256), 0, st, (const float*)p.out, p.in[I_GN_ATTN], p.in[I_GN_LRU], (bf16_t*)(ws + WS_XB));
}
static void run_p4_naive(hipStream_t st, const Params& p) {
    unsigned char* ws = p.ws;
    EpiOut E{p.in[I_X], p.out, (bf16_t*)(ws + R_H1B)};
    gemm_naive(st, (const bf16_t*)(ws + WS_XB), DM, (const bf16_t*)(ws + WS_WOUT), DM, NTOK, DM, DM, E);
    hipLaunchKernelGGL(k_rowssq, dim3(NTOK), dim3(256), 0, st, (const float*)p.out, (float*)(ws + WS_SSQ1));
}
static void run_p5_naive(hipStream_t st, const Params& p) {
    unsigned char* ws = p.ws;
    for (int hh = 0; hh < 2; ++hh) {
        EpiF32Plain E{(float*)(ws + R_BIG), 1024, 0};
        gemm_naive(st, (const bf16_t*)(ws + R_H1B), DM, (const bf16_t*)(ws + WS_WQS) + (size_t)hh * 1024 * DM, DM, NTOK, 1024, DM, E);
        hipLaunchKernelGGL(k_peer_route, dim3(NTOK * 4), dim3(256), 0, st, (const float*)(ws + R_BIG), (const float*)(ws + WS_SSQ1), hh, (int*)(ws + R_EXP), (float*)(ws + R_GSM));
    }
}
static void run_p6_naive(hipStream_t st, const Params& p) {
    unsigned char* ws = p.ws;
    hipLaunchKernelGGL(k_peer_apply, dim3(NTOK), dim3(256), 0, st, (const bf16_t*)(ws + WS_UB), (const bf16_t*)(ws + WS_VB), (const int*)(ws + R_EXP), (const float*)(ws + R_GSM),
                       (const float*)(ws + WS_SSQ1), p.out, (bf16_t*)(ws + R_H1B), (float*)(ws + WS_RS2));
}
static void run_p7_naive(hipStream_t st, const Params& p) {
    unsigned char* ws = p.ws;
    EpiF32Plain Ep{(float*)(ws + R_BIG), DM, 0};
    gemm_naive(st, (const bf16_t*)(ws + WS_PB), PLE, (const bf16_t*)(ws + WS_WP), PLE, NTOK, DM, PLE, Ep);
    EpiGate Eg{(const float*)(ws + WS_RS2), p.in[I_PLE_BG], (const float*)(ws + R_BIG), p.out};
    gemm_naive(st, (const bf16_t*)(ws + R_H1B), DM, (const bf16_t*)(ws + WS_WG), DM, NTOK, DM, DM, Eg);
    hipLaunchKernelGGL(k_rowssq, dim3(NTOK), dim3(256), 0, st, (const float*)p.out, (float*)(ws + WS_SSQ3));
}
static void run_p8_naive(hipStream_t st, const Params& p) {
    hipLaunchKernelGGL(k_final_norm, dim3(NTOK), dim3(256), 0, st, p.out, (const float*)(p.ws + WS_SSQ3), p.in[I_FINAL_NORM]);
}
static void run_phase(hipStream_t st, const Params& p, int k) {
    switch (k) {
        case 0: run_prologue_naive(st, p); break;
        case 1: run_p1_naive(st, p); break;
        case 2: run_p2_naive(st, p); if ((OPT_MASK >> 3) & 1) run_p2_extras(st, p); break;
        case 3: run_p3_naive(st, p); break;
        case 4: run_p4_naive(st, p); break;
        case 5: run_p5_naive(st, p); break;
        case 6: run_p6_naive(st, p); break;
        case 7: run_p7_naive(st, p); break;
        case 8: run_p8_naive(st, p); break;
    }
}
extern "C" void kernel_launch(void* const* d_in, const int* in_sizes, int n_in, void* d_out, int out_size, void* d_ws, size_t ws_size, hipStream_t stream) {
    if (n_in != 31 || out_size != NTOK * DM || ws_size < WS_END) { fprintf(stderr, "kernel_launch: unexpected shapes (n_in %d out %d ws %zu)\n", n_in, out_size, ws_size); return; }
    Params p{};
    for (int i = 0; i < 31; ++i) p.in[i] = (const float*)d_in[i];
    p.out = (float*)d_out; p.ws = (unsigned char*)d_ws;
#ifdef PROBE_DOUBLE
    hipMemsetAsync((char*)d_ws + WS_CTL, 0, XCD_BAR_WORDS * 4, stream);
    launch_mega(stream, p, 0, PROBE_DOUBLE);
#endif
    int k = 0;
#ifdef PROBE_DOUBLE
    k = PROBE_START;
#endif
    while (k <= 8) {
        if ((OPT_MASK >> k) & 1) {
            int e = k; while (e <= 8 && ((OPT_MASK >> e) & 1)) ++e;
            if (LRU_NAIVE && k <= 3 && e > 4) e = 4;
            if (CMP_NAIVE && k <= 1 && e > 2) e = 2;
            if (CMP_NAIVE && k == 2) { run_p2_naive(stream, p); run_p2_extras(stream, p); }
            hipMemsetAsync((char*)d_ws + WS_CTL, 0, XCD_BAR_WORDS * 4, stream);
            launch_mega(stream, p, k, e);
            if (LRU_NAIVE && k <= 3 && e == 4) run_lru_naive(stream, p);
            k = e;
        } else { run_phase(stream, p, k); ++k; }
    }
}
```

```cpp
#include <hip/hip_runtime.h>
#include <stdint.h>
#include <stdio.h>

typedef unsigned short bf16_t;
typedef float f32x4 __attribute__((ext_vector_type(4)));
typedef float f32x2 __attribute__((ext_vector_type(2)));
typedef unsigned u32x4 __attribute__((ext_vector_type(4)));
typedef unsigned u32x2 __attribute__((ext_vector_type(2)));
#define DI __device__ __forceinline__

constexpr int NB = 4, T_ = 4096, DM = 1024, NTOK = NB * T_;
constexpr int NH = 8, HD = 64, NKV = 2, GRP = 4, ATTW = 512, KVW = 128, LRUW = 512;
constexpr int INCOLS = 2328, NPROJ = 2560;
constexpr int NCMP = 255, NSEL = 64;
constexpr int PEER_H = 8, PEER_K = 16, PEER_NK = 128;
constexpr int PLE = 256;
constexpr float EPS = 1e-6f;

constexpr int PC_KV = 512, PC_XR = 1280, PC_XG = 1792, PC_GATE = 2304;

constexpr size_t MB = 1024 * 1024;
constexpr size_t WS_CTL   = 0;
constexpr size_t WS_WIN   = 64 * 1024;
constexpr size_t WS_WOUT  = WS_WIN  + (size_t)NPROJ * DM * 2;
constexpr size_t WS_WQS   = WS_WOUT + (size_t)DM * DM * 2;
constexpr size_t WS_WG    = WS_WQS  + (size_t)2048 * DM * 2;
constexpr size_t WS_WP    = WS_WG   + (size_t)DM * DM * 2;
constexpr size_t WS_CW1K  = WS_WP   + (size_t)DM * PLE * 2;
constexpr size_t WS_CW1V  = WS_CW1K + (size_t)256 * 2048 * 2;
constexpr size_t WS_CBK   = WS_CW1V + (size_t)256 * 2048 * 2;
constexpr size_t WS_CBV   = WS_CBK  + 1024;
constexpr size_t WS_RS0   = WS_CBV  + 1024;
constexpr size_t WS_RS2   = WS_RS0  + (size_t)NTOK * 4;
constexpr size_t WS_RS1   = WS_RS2  + (size_t)NTOK * 4;
constexpr size_t WS_SSQ2  = WS_RS1  + (size_t)NTOK * 4;
constexpr size_t WS_SSQ1  = WS_SSQ2 + (size_t)16 * NTOK * 4;
constexpr size_t WS_SSQ3  = WS_SSQ1 + (size_t)16 * NTOK * 4;
constexpr size_t WS_KCMP  = WS_SSQ3 + (size_t)16 * NTOK * 4;
constexpr size_t WS_VCMP  = WS_KCMP + (size_t)8 * 256 * 64 * 4;
constexpr size_t WS_LRUP  = WS_VCMP + (size_t)8 * 256 * 64 * 4;
constexpr size_t WS_LRUH  = WS_LRUP + (size_t)256 * 512 * 4;
constexpr size_t WS_WAT   = WS_LRUH + (size_t)256 * 512 * 4;
constexpr size_t WS_WXT   = WS_WAT + 8 * 64 * 64 * 2;
constexpr size_t WS_CW2K  = WS_WXT + 8 * 64 * 64 * 2;
constexpr size_t WS_CW2V  = WS_CW2K + 64 * 256 * 2;
constexpr size_t WS_HID   = WS_CW2V + 64 * 256 * 2;
constexpr size_t WS_UB    = (WS_HID + (size_t)2 * 2048 * 256 * 4 + 4095) / 4096 * 4096;
constexpr size_t WS_VB    = WS_UB + (size_t)16384 * DM * 2;
constexpr size_t WS_PB    = WS_VB + (size_t)16384 * DM * 2;
constexpr size_t WS_XB    = WS_PB + (size_t)NTOK * PLE * 2;
constexpr size_t WS_R     = WS_XB + (size_t)NTOK * DM * 2;
constexpr size_t KVT = (size_t)NB * NKV * T_ * HD * 2 + 65536;
constexpr size_t R_QB    = WS_R;
constexpr size_t R_KC    = R_QB + (size_t)NTOK * 512 * 2;
constexpr size_t R_VC    = R_KC + KVT;
constexpr size_t R_KS    = R_VC + KVT;
constexpr size_t R_VS    = R_KS + KVT;
constexpr size_t R_KW    = R_VS + KVT;
constexpr size_t R_VW    = R_KW + KVT;
constexpr size_t R_GATE  = R_VW + KVT;
constexpr size_t R_XR    = R_GATE + (size_t)NTOK * 24 * 4;
constexpr size_t R_XG    = R_XR + (size_t)NTOK * 512 * 4;
constexpr size_t R_VST   = R_XG + (size_t)NTOK * 512 * 2;
constexpr size_t R_VWT   = R_VST + KVT;
constexpr size_t R_KCB   = R_VWT + KVT;
constexpr size_t R_VCT   = R_KCB + (size_t)8 * 256 * 64 * 2;
constexpr size_t R_END13 = R_VCT + (size_t)8 * 256 * 64 * 2;
constexpr size_t R_H1B   = WS_R;
constexpr size_t R_EXP   = R_H1B + (size_t)NTOK * DM * 2;
constexpr size_t R_GSM   = R_EXP + (size_t)NTOK * 128 * 4;
constexpr size_t R_COEF  = R_GSM + (size_t)NTOK * 128 * 4;
constexpr size_t R_BIG   = R_COEF + (size_t)NTOK * 128 * 4;
constexpr size_t WS_END  = (R_END13 > R_BIG + 64 * MB ? R_END13 : R_BIG + 64 * MB);
static_assert(WS_END <= 256 * MB, "workspace map exceeds 256 MiB");

DI float bf2f(bf16_t v) { return __uint_as_float((unsigned)v << 16); }
DI bf16_t f2bf(float x) { unsigned u = __float_as_uint(x); u += 0x7fffu + ((u >> 16) & 1u); return (bf16_t)(u >> 16); }
DI unsigned pack2bf(float lo, float hi) { return (unsigned)f2bf(lo) | ((unsigned)f2bf(hi) << 16); }
DI float gelu_tanh(float x) { const float u = 0.7978845608028654f * (x + 0.044715f * x * x * x); return 0.5f * x * (1.0f + tanhf(u)); }
DI float sigmoidf_(float x) { return 1.0f / (1.0f + __expf(-x)); }

__device__ const unsigned char REL_BUCKET_LUT[128] = {
0,1,2,3,4,5,6,7,8,9,10,11,12,13,14,15,16,16,16,17,17,18,18,18,19,19,19,20,20,20,20,21,21,21,21,22,22,22,22,22,23,23,23,23,23,23,24,24,24,24,24,24,25,25,25,25,25,25,25,26,26,26,26,26,26,26,26,27,27,27,27,27,27,27,27,27,27,28,28,28,28,28,28,28,28,28,28,29,29,29,29,29,29,29,29,29,29,29,29,30,30,30,30,30,30,30,30,30,30,30,30,30,30,31,31,31,31,31,31,31,31,31,31,31,31,31,31,31};
DI int rel_bucket(int dist) { dist = dist < 0 ? 0 : dist; return dist >= 128 ? 31 : (int)REL_BUCKET_LUT[dist]; }

struct Params {
    const float* in[31];
    float* out;
    unsigned char* ws;
};
enum { I_X = 0, I_P, I_ATTN_NORM, I_W_IN, I_CK_PE, I_CK_W1, I_CK_W2, I_CV_PE, I_CV_W1, I_CV_W2, I_REL, I_CONV_W, I_CONV_B, I_LRU_WA, I_LRU_BA, I_LRU_WX, I_LRU_BX,
       I_LRU_LAM, I_GN_ATTN, I_GN_LRU, I_W_OUT, I_FFN_NORM, I_PEER_WQ, I_PEER_SUB, I_PEER_U, I_PEER_V, I_PLE_NORM, I_PLE_WG, I_PLE_BG, I_PLE_PROJ, I_FINAL_NORM };

struct EpiProj {
    const float* rs0; bf16_t* qb; bf16_t* kv0; float* gates; float* xr; bf16_t* xg;
    DI void store4(int row, int col, f32x4 v) const {
        const float s = rs0[row];
        v *= s;
        if (col < PC_KV) { v *= 0.125f; u32x2 w; w.x = pack2bf(v[0], v[1]); w.y = pack2bf(v[2], v[3]); *(u32x2*)(qb + (size_t)row * 512 + col) = w; }
        else if (col < PC_XR) {
            const int c = col - PC_KV, tensor = c >> 7, within = c & 127, kvh = within >> 6, d = within & 63, b = row >> 12, t = row & 4095;
            bf16_t* dst = (bf16_t*)((unsigned char*)kv0 + (size_t)tensor * KVT) + ((size_t)(b * NKV + kvh) * T_ + t) * HD + d;
            u32x2 w; w.x = pack2bf(v[0], v[1]); w.y = pack2bf(v[2], v[3]); *(u32x2*)dst = w;
        }
        else if (col < PC_XG) { *(f32x4*)(xr + (size_t)row * 512 + (col - PC_XR)) = v; }
        else if (col < PC_GATE) { u32x2 w; w.x = pack2bf(v[0], v[1]); w.y = pack2bf(v[2], v[3]); *(u32x2*)(xg + (size_t)row * 512 + (col - PC_XG)) = w; }
        else if (col < PC_GATE + 24) { *(f32x4*)(gates + (size_t)row * 24 + (col - PC_GATE)) = v; }
    }
};
struct EpiOut {
    const float* x; float* h1; bf16_t* h1b;
    DI void store4(int row, int col, f32x4 v) const {
        const size_t o = (size_t)row * DM + col;
        v += *(const f32x4*)(x + o);
        *(f32x4*)(h1 + o) = v;
        u32x2 w; w.x = pack2bf(v[0], v[1]); w.y = pack2bf(v[2], v[3]); *(u32x2*)(h1b + o) = w;
    }
};
struct EpiF32Plain { float* C; int ldc; int coloff;
    DI void store4(int row, int col, f32x4 v) const { *(f32x4*)(C + (size_t)row * ldc + (col - coloff)) = v; } };
struct EpiGate {
    const float* rs2; const float* bias; const float* pp; float* h;
    DI void store4(int row, int col, f32x4 v) const {
        const size_t o = (size_t)row * DM + col;
        const float s = rs2[row];
        const f32x4 bb = *(const f32x4*)(bias + col), p4 = *(const f32x4*)(pp + o);
        f32x4 hv = *(f32x4*)(h + o);
#pragma unroll
        for (int j = 0; j < 4; ++j) hv[j] += sigmoidf_(v[j] * s + bb[j]) * p4[j];
        *(f32x4*)(h + o) = hv;
    }
};
#ifndef LRU_NAIVE
#define LRU_NAIVE 0
#endif
#ifndef CMP_NAIVE
#define CMP_NAIVE 0
#endif
#ifndef OPT_MASK
#define OPT_MASK 0x1FF
#endif
#ifndef PEER_V6
#define PEER_V6 5
#endif
#ifndef PEER_V3
#define PEER_V3 1
#endif
#ifndef PEER_V2
#define PEER_V2 1
#endif
#ifndef XCC_HW
#define XCC_HW 0
#endif
#ifndef PEER_FP4
#define PEER_FP4 0
#endif
#ifndef PEER_I8U
#define PEER_I8U 1
#endif
#ifndef PEER_V4EXP
#define PEER_V4EXP 1
#endif
DI float wave_sum(float v) {
#pragma unroll
    for (int o = 32; o > 0; o >>= 1) v += __shfl_xor(v, o);
    return v;
}
DI float wave_max(float v) {
#pragma unroll
    for (int o = 32; o > 0; o >>= 1) v = fmaxf(v, __shfl_xor(v, o));
    return v;
}
DI float block_sum256(float v, float* red) {
    v = wave_sum(v); __syncthreads();
    if ((threadIdx.x & 63) == 0) red[threadIdx.x >> 6] = v; __syncthreads();
    return (red[0] + red[1]) + (red[2] + red[3]);
}
DI float block_max256(float v, float* red) {
    v = wave_max(v); __syncthreads();
    if ((threadIdx.x & 63) == 0) red[threadIdx.x >> 6] = v; __syncthreads();
    return fmaxf(fmaxf(red[0], red[1]), fmaxf(red[2], red[3]));
}

__global__ __launch_bounds__(256) void k_prep_x(const float* __restrict__ x, bf16_t* __restrict__ xb, float* __restrict__ rs0) {
    __shared__ float red[8];
    const int row = blockIdx.x, t = threadIdx.x;
    const f32x4 v = *(const f32x4*)(x + (size_t)row * DM + t * 4);
    float s = v[0] * v[0] + v[1] * v[1] + v[2] * v[2] + v[3] * v[3];
    s = block_sum256(s, red);
    u32x2 w; w.x = pack2bf(v[0], v[1]); w.y = pack2bf(v[2], v[3]);
    *(u32x2*)(xb + (size_t)row * DM + t * 4) = w;
    if (t == 0) rs0[row] = rsqrtf(s * (1.0f / DM) + EPS);
}
__global__ void k_prep_win(const float* __restrict__ w_in, const float* __restrict__ gain, bf16_t* __restrict__ WinT) {
    const int idx = blockIdx.x * blockDim.x + threadIdx.x;
    if (idx >= NPROJ * DM) return;
    const int n = idx / DM, k = idx % DM;
    int src = -1;
    if (n < PC_XR) src = n; else if (n < PC_XG) src = 1304 + (n - PC_XR); else if (n < PC_GATE) src = 1816 + (n - PC_XG); else if (n < PC_GATE + 24) src = 1280 + (n - PC_GATE);
    WinT[idx] = src >= 0 ? f2bf(w_in[(size_t)k * INCOLS + src] * gain[k]) : (bf16_t)0;
}
__global__ void k_transpose_bf16(const float* __restrict__ src, const float* __restrict__ gain, bf16_t* __restrict__ dst, int K, int N) {
    const int idx = blockIdx.x * blockDim.x + threadIdx.x;
    if (idx >= K * N) return;
    const int n = idx / K, k = idx % K;
    dst[idx] = f2bf(src[(size_t)k * N + n] * (gain ? gain[k] : 1.0f));
}
__global__ __launch_bounds__(128) void k_prep_wqs(const float* __restrict__ wq, const float* __restrict__ sub, const float* __restrict__ gain, bf16_t* __restrict__ WqsT) {
    __shared__ float wrow[128];
    const int d = blockIdx.x % DM, hp = blockIdx.x / DM, p = hp & 1, kk = threadIdx.x;
    wrow[kk] = wq[(size_t)d * 2048 + hp * 128 + kk];
    __syncthreads();
    const float* sk = sub + ((size_t)p * 128 + kk) * 128;
    float acc = 0.f;
    for (int j = 0; j < 128; ++j) acc += wrow[j] * sk[j];
    WqsT[(size_t)(hp * 128 + kk) * DM + d] = f2bf(acc * gain[d]);
}
__global__ void k_cvt_bf16(const float* __restrict__ src, const float* __restrict__ gain, bf16_t* __restrict__ dst, size_t n4, int cols) {
    for (size_t i = (size_t)blockIdx.x * blockDim.x + threadIdx.x; i < n4; i += (size_t)gridDim.x * blockDim.x) {
        f32x4 v = *(const f32x4*)(src + i * 4);
        if (gain) { const f32x4 g = *(const f32x4*)(gain + (i * 4) % cols); v *= g; }
        u32x2 w; w.x = pack2bf(v[0], v[1]); w.y = pack2bf(v[2], v[3]);
        *(u32x2*)(dst + i * 4) = w;
    }
}
__global__ __launch_bounds__(256) void k_prep_cmpbias(const float* __restrict__ pe, const float* __restrict__ w1, float* __restrict__ cb) {
    const int j = threadIdx.x; float acc = 0.f;
    for (int k = 0; k < 2048; ++k) acc += pe[k] * w1[(size_t)k * 256 + j];
    cb[j] = acc;
}

template <class Epi>
__global__ __launch_bounds__(256) void k_gemm_naive(const bf16_t* __restrict__ A, int lda, const bf16_t* __restrict__ Bt, int ldb, int K, Epi E) {
    __shared__ float As[32][68], Bs[32][68];
    const int t = threadIdx.x, tx = t & 15, ty = t >> 4;
    const int row0 = blockIdx.y * 64, col0 = blockIdx.x * 64;
    float acc[4][4] = {};
    const int lr = t >> 2, lk = (t & 3) * 8;
    for (int k0 = 0; k0 < K; k0 += 32) {
        const u32x4 av = *(const u32x4*)(A + (size_t)(row0 + lr) * lda + k0 + lk);
        const u32x4 bv = *(const u32x4*)(Bt + (size_t)(col0 + lr) * ldb + k0 + lk);
        __syncthreads();
#pragma unroll
        for (int j = 0; j < 4; ++j) {
            As[lk + 2 * j][lr] = __uint_as_float(av[j] << 16); As[lk + 2 * j + 1][lr] = __uint_as_float(av[j] & 0xffff0000u);
            Bs[lk + 2 * j][lr] = __uint_as_float(bv[j] << 16); Bs[lk + 2 * j + 1][lr] = __uint_as_float(bv[j] & 0xffff0000u);
        }
        __syncthreads();
#pragma unroll
        for (int k = 0; k < 32; ++k) {
            const f32x4 a = *(const f32x4*)&As[k][ty * 4], b = *(const f32x4*)&Bs[k][tx * 4];
#pragma unroll
            for (int i = 0; i < 4; ++i)
#pragma unroll
                for (int j = 0; j < 4; ++j) acc[i][j] += a[i] * b[j];
        }
    }
#pragma unroll
    for (int i = 0; i < 4; ++i) E.store4(row0 + ty * 4 + i, col0 + tx * 4, (f32x4){acc[i][0], acc[i][1], acc[i][2], acc[i][3]});
}

__global__ __launch_bounds__(256) void k_cmp_hidden(const bf16_t* __restrict__ kvb, const bf16_t* __restrict__ W1T, const float* __restrict__ cb, float* __restrict__ hidden) {
    const int row = blockIdx.x, j = threadIdx.x, bh = row >> 8, c = row & 255;
    if (c >= NCMP) { hidden[(size_t)row * 256 + j] = 0.f; return; }
    const bf16_t* a = kvb + ((size_t)bh * T_ + 16 * c) * HD;
    const bf16_t* w = W1T + (size_t)j * 2048;
    float acc = 0.f;
    for (int k = 0; k < 2048; ++k) acc += bf2f(a[k]) * bf2f(w[k]);
    hidden[(size_t)row * 256 + j] = acc + cb[j];
}
__global__ __launch_bounds__(64) void k_cmp_out(const float* __restrict__ hidden, const float* __restrict__ w2, float* __restrict__ out) {
    const int row = blockIdx.x, d = threadIdx.x;
    float acc = 0.f;
    for (int j = 0; j < 256; ++j) acc += gelu_tanh(hidden[(size_t)row * 256 + j]) * w2[j * 64 + d];
    out[(size_t)row * 64 + d] = acc;
}

struct NsaArgs { const bf16_t* qb; const bf16_t* ks; const bf16_t* vs; const bf16_t* kw; const bf16_t* vw; const float* kcmp; const float* vcmp; const float* gates; const float* rel; float* raw; };
template <bool KF32> DI void nsa_logits(int nk, const void* Kbase, const int* kp, const int* dist, float (*lg)[1024], const float (*qs)[64], const float* rel, int kvh) {
    for (int idx = threadIdx.x; idx < nk; idx += 256) {
        float acc[4] = {0.f, 0.f, 0.f, 0.f};
        if (dist[idx] >= 0) {
            if (KF32) { const float* kr = (const float*)Kbase + (size_t)kp[idx] * HD;
                for (int d = 0; d < 64; ++d) { const float kv = kr[d]; for (int g = 0; g < 4; ++g) acc[g] += qs[g][d] * kv; } }
            else { const bf16_t* kr = (const bf16_t*)Kbase + (size_t)kp[idx] * HD;
                for (int d = 0; d < 64; ++d) { const float kv = bf2f(kr[d]); for (int g = 0; g < 4; ++g) acc[g] += qs[g][d] * kv; } }
            const int bk = rel_bucket(dist[idx]);
            for (int g = 0; g < 4; ++g) lg[g][idx] = acc[g] + rel[bk * NH + kvh * 4 + g];
        } else { for (int g = 0; g < 4; ++g) lg[g][idx] = -INFINITY; }
    }
}
DI void nsa_softmax(int nk, float (*lg)[1024], float* inv, float* red) {
    for (int g = 0; g < 4; ++g) {
        float m = -INFINITY;
        for (int idx = threadIdx.x; idx < nk; idx += 256) m = fmaxf(m, lg[g][idx]);
        m = block_max256(m, red);
        float s = 0.f;
        for (int idx = threadIdx.x; idx < nk; idx += 256) { const float l = lg[g][idx]; const float e = (l == -INFINITY) ? 0.f : __expf(l - m); lg[g][idx] = e; s += e; }
        s = block_sum256(s, red);
        if (threadIdx.x == 0) inv[g] = 1.0f / s;
    }
    __syncthreads();
}
template <bool VF32> DI float nsa_pv(int nk, const void* Vbase, const int* kp, const float (*lg)[1024], const float* inv) {
    const int g = threadIdx.x >> 6, d = threadIdx.x & 63;
    float acc = 0.f;
    for (int idx = 0; idx < nk; ++idx) {
        const float v = VF32 ? ((const float*)Vbase)[(size_t)kp[idx] * HD + d] : bf2f(((const bf16_t*)Vbase)[(size_t)kp[idx] * HD + d]);
        acc += lg[g][idx] * v;
    }
    return acc * inv[g];
}
__global__ __launch_bounds__(256) void k_nsa_naive(NsaArgs a) {
    __shared__ float qs[4][64]; __shared__ float lg[4][1024]; __shared__ int kp[1024]; __shared__ int dist[1024];
    __shared__ float red[8]; __shared__ float inv[4]; __shared__ float imp[64]; __shared__ float vals[64]; __shared__ int selblk[16]; __shared__ int nsel_s;
    const int tid = threadIdx.x, t = blockIdx.x % T_, kvh = (blockIdx.x / T_) % NKV, b = blockIdx.x / (T_ * NKV), bh = b * NKV + kvh;
    const int g = tid >> 6, d = tid & 63, h = kvh * 4 + g;
    const size_t tok = (size_t)b * T_ + t;
    qs[g][d] = bf2f(a.qb[tok * 512 + h * 64 + d]);
    if (tid == 0) nsel_s = 0;
    const int ncv = t >= 31 ? (t - 31) / 16 + 1 : 0;
    for (int idx = tid; idx < ncv; idx += 256) { kp[idx] = idx; dist[idx] = t - (16 * idx + 31); }
    __syncthreads();
    float o_c = 0.f;
    if (ncv > 0) {
        nsa_logits<true>(ncv, a.kcmp + (size_t)bh * 256 * HD, kp, dist, lg, qs, a.rel, kvh);
        __syncthreads();
        nsa_softmax(ncv, lg, inv, red);
        o_c = nsa_pv<true>(ncv, a.vcmp + (size_t)bh * 256 * HD, kp, lg, inv);
    }
    if (tid < 64) {
        float s = 0.f;
        for (int gg = 0; gg < 4; ++gg) {
            float sg = 0.f;
            for (int j = -1; j <= 3; ++j) { const int c = 4 * tid + j; if (c >= 0 && c < ncv) sg += lg[gg][c] * ((j == -1 || j == 3) ? 0.5f : 1.0f); }
            s += sg * inv[gg];
        }
        if (ncv == 0) s = 0.f;
        const int qblk = t >> 6, db = qblk - tid;
        vals[tid] = (db >= 0 && db < 2) ? 2.0e4f : (tid == 0 ? 1.0e4f : (db >= 0 ? s : -1.0f));
    }
    __syncthreads();
    if (tid < 64) {
        const float v = vals[tid]; int rank = 0;
        for (int s2 = 0; s2 < 64; ++s2) { const float w = vals[s2]; rank += (w > v || (w == v && s2 < tid)) ? 1 : 0; }
        if (rank < 16 && (t >> 6) - tid >= 0) { const int slot = atomicAdd(&nsel_s, 1); selblk[slot] = tid; }
    }
    __syncthreads();
    const int nsel = nsel_s, nks = nsel * 64;
    for (int idx = tid; idx < nks; idx += 256) { const int kpos = selblk[idx >> 6] * 64 + (idx & 63); kp[idx] = kpos; dist[idx] = t - kpos; }
    __syncthreads();
    nsa_logits<false>(nks, a.ks + (size_t)bh * T_ * HD, kp, dist, lg, qs, a.rel, kvh);
    __syncthreads();
    nsa_softmax(nks, lg, inv, red);
    const float o_s = nsa_pv<false>(nks, a.vs + (size_t)bh * T_ * HD, kp, lg, inv);
    __syncthreads();
    const int lo = t - 511 > 0 ? t - 511 : 0, nkw = t - lo + 1;
    for (int idx = tid; idx < nkw; idx += 256) { kp[idx] = lo + idx; dist[idx] = t - (lo + idx); }
    __syncthreads();
    nsa_logits<false>(nkw, a.kw + (size_t)bh * T_ * HD, kp, dist, lg, qs, a.rel, kvh);
    __syncthreads();
    nsa_softmax(nkw, lg, inv, red);
    const float o_w = nsa_pv<false>(nkw, a.vw + (size_t)bh * T_ * HD, kp, lg, inv);
    const float* gt = a.gates + tok * 24 + h * 3;
    a.raw[tok * DM + h * 64 + d] = sigmoidf_(gt[0]) * o_c + sigmoidf_(gt[1]) * o_s + sigmoidf_(gt[2]) * o_w;
}

struct LruArgs { const float* xr; const bf16_t* xg; const float* conv_w; const float* conv_b; const float* wa; const float* ba; const float* wx; const float* bx; const float* lam; float* raw; };
__global__ __launch_bounds__(64) void k_lru_naive(LruArgs a) {
    __shared__ float xs[64];
    const int tid = threadIdx.x, n = blockIdx.x & 7, b = blockIdx.x >> 3, ch = n * 64 + tid;
    float war[64], wxr[64];
#pragma unroll
    for (int c = 0; c < 64; ++c) { war[c] = a.wa[(size_t)(n * 64 + c) * 64 + tid]; wxr[c] = a.wx[(size_t)(n * 64 + c) * 64 + tid]; }
    const float cw0 = a.conv_w[0 * 512 + ch], cw1 = a.conv_w[1 * 512 + ch], cw2 = a.conv_w[2 * 512 + ch], cw3 = a.conv_w[3 * 512 + ch], cb = a.conv_b[ch];
    const float ba = a.ba[ch], bx = a.bx[ch], sp = log1pf(__expf(-a.lam[ch]));
    float x3 = 0.f, x2 = 0.f, x1 = 0.f, h = 0.f;
    for (int t = 0; t < T_; ++t) {
        const size_t tok = (size_t)b * T_ + t;
        const float x0 = a.xr[tok * 512 + ch];
        const float xc = cw0 * x3 + cw1 * x2 + cw2 * x1 + cw3 * x0 + cb;
        x3 = x2; x2 = x1; x1 = x0;
        __syncthreads();
        xs[tid] = xc;
        __syncthreads();
        float rp = 0.f, ip = 0.f;
#pragma unroll
        for (int c = 0; c < 64; ++c) { const float xv = xs[c]; rp += xv * war[c]; ip += xv * wxr[c]; }
        const float r = sigmoidf_(rp + ba), i = sigmoidf_(ip + bx);
        const float log_a = -8.0f * r * sp, aa = __expf(log_a), bb = sqrtf(-expm1f(2.0f * log_a)) * (i * xc);
        h = aa * h + bb;
        a.raw[tok * DM + 512 + ch] = h * gelu_tanh(bf2f(a.xg[tok * 512 + ch]));
    }
}
__global__ __launch_bounds__(256) void k_grpnorm(const float* __restrict__ raw, const float* __restrict__ ga, const float* __restrict__ gl, bf16_t* __restrict__ mixed) {
    __shared__ float red[8];
    const int row = blockIdx.x, t = threadIdx.x;
    const f32x4 v = *(const f32x4*)(raw + (size_t)row * DM + t * 4);
    const float s = v[0] * v[0] + v[1] * v[1] + v[2] * v[2] + v[3] * v[3];
    const float sa = block_sum256(t < 128 ? s : 0.f, red);
    const float sl = block_sum256(t < 128 ? 0.f : s, red);
    const float rs = rsqrtf((t < 128 ? sa : sl) * (1.0f / 512) + EPS);
    const f32x4 g = t < 128 ? *(const f32x4*)(ga + t * 4) : *(const f32x4*)(gl + (t - 128) * 4);
    u32x2 w; w.x = pack2bf(v[0] * rs * g[0], v[1] * rs * g[1]); w.y = pack2bf(v[2] * rs * g[2], v[3] * rs * g[3]);
    *(u32x2*)(mixed + (size_t)row * DM + t * 4) = w;
}
__global__ __launch_bounds__(256) void k_rowssq(const float* __restrict__ h, float* __restrict__ ssq) {
    __shared__ float red[8];
    const int row = blockIdx.x, t = threadIdx.x;
    const f32x4 v = *(const f32x4*)(h + (size_t)row * DM + t * 4);
    float s = v[0] * v[0] + v[1] * v[1] + v[2] * v[2] + v[3] * v[3];
    s = block_sum256(s, red);
    if (t < 16) ssq[(size_t)t * NTOK + row] = t == 0 ? s : 0.f;
}

DI float rs_from_ssq(const float* ssq, int row) { float s = 0.f; for (int j = 0; j < 16; ++j) s += ssq[(size_t)j * NTOK + row]; return rsqrtf(s * (1.0f / DM) + EPS); }
__global__ __launch_bounds__(256) void k_peer_route(const float* __restrict__ scores, const float* __restrict__ ssq1, int hh, int* __restrict__ eout, float* __restrict__ gout) {
    __shared__ float s[256]; __shared__ float tv[2][16]; __shared__ int ti[2][16]; __shared__ float cand[256]; __shared__ float scs[16]; __shared__ int es[16];
    const int tid = threadIdx.x, tok = blockIdx.x >> 2, hl = blockIdx.x & 3, h = hh * 4 + hl;
    const float rs1 = rs_from_ssq(ssq1, tok);
    s[tid] = scores[(size_t)tok * 1024 + hl * 256 + tid] * rs1;
    __syncthreads();
    { const int p = tid >> 7, k = tid & 127; const float v = s[tid]; int rank = 0;
      for (int j = 0; j < 128; ++j) { const float w = s[p * 128 + j]; rank += (w > v || (w == v && j < k)) ? 1 : 0; }
      if (rank < 16) { tv[p][rank] = v; ti[p][rank] = k; } }
    __syncthreads();
    cand[tid] = tv[0][tid >> 4] + tv[1][tid & 15];
    __syncthreads();
    { const float v = cand[tid]; int rank = 0;
      for (int j = 0; j < 256; ++j) { const float w = cand[j]; rank += (w > v || (w == v && j < tid)) ? 1 : 0; }
      if (rank < 16) { scs[rank] = v; es[rank] = ti[0][tid >> 4] * 128 + ti[1][tid & 15]; } }
    __syncthreads();
    if (tid < 16) {
        float m = -INFINITY; for (int j = 0; j < 16; ++j) m = fmaxf(m, scs[j]);
        float sum = 0.f; for (int j = 0; j < 16; ++j) sum += __expf(scs[j] - m);
        eout[(size_t)tok * 128 + h * 16 + tid] = es[tid];
        gout[(size_t)tok * 128 + h * 16 + tid] = __expf(scs[tid] - m) / sum;
    }
}
__global__ __launch_bounds__(256) void k_peer_apply(const bf16_t* __restrict__ ub, const bf16_t* __restrict__ vb, const int* __restrict__ e, const float* __restrict__ gsm,
                                                    const float* __restrict__ ssq1, float* __restrict__ h, bf16_t* __restrict__ hb, float* __restrict__ rs2) {
    __shared__ float xrow[DM]; __shared__ float coef[128]; __shared__ int eid[128]; __shared__ float red[8];
    const int tid = threadIdx.x, tok = blockIdx.x, lane = tid & 63, w = tid >> 6;
    const float rs1 = rs_from_ssq(ssq1, tok);
    for (int i = tid; i < DM; i += 256) xrow[i] = bf2f(hb[(size_t)tok * DM + i]);
    if (tid < 128) eid[tid] = e[(size_t)tok * 128 + tid];
    __syncthreads();
    for (int j = w; j < 128; j += 4) {
        const bf16_t* ur = ub + (size_t)eid[j] * DM;
        float acc = 0.f;
        for (int i = lane; i < DM; i += 64) acc += xrow[i] * bf2f(ur[i]);
        acc = wave_sum(acc);
        if (lane == 0) coef[j] = gsm[(size_t)tok * 128 + j] * gelu_tanh(acc * rs1);
    }
    __syncthreads();
    f32x4 acc = {0.f, 0.f, 0.f, 0.f};
    for (int j = 0; j < 128; ++j) {
        const u32x2 v = *(const u32x2*)(vb + (size_t)eid[j] * DM + tid * 4); const float c = coef[j];
        acc[0] += c * __uint_as_float(v.x << 16); acc[1] += c * __uint_as_float(v.x & 0xffff0000u); acc[2] += c * __uint_as_float(v.y << 16); acc[3] += c * __uint_as_float(v.y & 0xffff0000u);
    }
    f32x4 hv = *(f32x4*)(h + (size_t)tok * DM + tid * 4);
    hv += acc;
    *(f32x4*)(h + (size_t)tok * DM + tid * 4) = hv;
    u32x2 wv; wv.x = pack2bf(hv[0], hv[1]); wv.y = pack2bf(hv[2], hv[3]);
    *(u32x2*)(hb + (size_t)tok * DM + tid * 4) = wv;
    float s = hv[0] * hv[0] + hv[1] * hv[1] + hv[2] * hv[2] + hv[3] * hv[3];
    s = block_sum256(s, red);
    if (tid == 0) rs2[tok] = rsqrtf(s * (1.0f / DM) + EPS);
}
__global__ __launch_bounds__(256) void k_final_norm(float* __restrict__ h, const float* __restrict__ ssq3, const float* __restrict__ g) {
    const int row = blockIdx.x, t = threadIdx.x;
    const float rs = rs_from_ssq(ssq3, row);
    f32x4 v = *(f32x4*)(h + (size_t)row * DM + t * 4); const f32x4 gg = *(const f32x4*)(g + t * 4);
    v = v * rs * gg;
    *(f32x4*)(h + (size_t)row * DM + t * 4) = v;
}

__global__ void k_p2_extras(const bf16_t* __restrict__ vs, const bf16_t* __restrict__ vw, const float* __restrict__ kcmp, const float* __restrict__ vcmp,
                            bf16_t* __restrict__ vsT, bf16_t* __restrict__ vwT, bf16_t* __restrict__ kcb, bf16_t* __restrict__ vcT) {
    const size_t n = (size_t)NB * NKV * T_ * HD;
    for (size_t i = (size_t)blockIdx.x * blockDim.x + threadIdx.x; i < n; i += (size_t)gridDim.x * blockDim.x) {
        const size_t bh = i / ((size_t)T_ * HD); const int t = (int)((i / HD) % T_), d = (int)(i % HD);
        vsT[(bh * HD + d) * T_ + t] = vs[i]; vwT[(bh * HD + d) * T_ + t] = vw[i];
    }
    for (size_t i = (size_t)blockIdx.x * blockDim.x + threadIdx.x; i < (size_t)8 * 256 * 64; i += (size_t)gridDim.x * blockDim.x) {
        const int bh = (int)(i / (256 * 64)), c = (int)((i / 64) % 256), d = (int)(i % 64);
        const bool ok = c < NCMP;
        kcb[i] = ok ? f2bf(kcmp[i]) : (bf16_t)0;
        vcT[((size_t)bh * 64 + d) * 256 + c] = ok ? f2bf(vcmp[i]) : (bf16_t)0;
    }
}
__global__ __launch_bounds__(256) void k_grpnorm_lru(const float* __restrict__ raw, const float* __restrict__ gl, bf16_t* __restrict__ mixed) {
    __shared__ float red[8];
    const int row = blockIdx.x, t = threadIdx.x;
    const f32x2 v = *(const f32x2*)(raw + (size_t)row * DM + 512 + t * 2);
    const float s = block_sum256(v[0] * v[0] + v[1] * v[1], red);
    const float rs = rsqrtf(s * (1.0f / 512) + EPS);
    *(unsigned*)(mixed + (size_t)row * DM + 512 + t * 2) = pack2bf(v[0] * rs * gl[t * 2], v[1] * rs * gl[t * 2 + 1]);
}
#define XB_TMO      128
#define XB_XCNT(j)  (256  + 64 * (j))
#define XB_XSUB(j)  (1280 + 64 * (j))
#define XB_XGEN(j)  (2304 + 64 * (j))
#define XB_TOP      3328
#define XB_TOPGEN   3392
#define XCD_BAR_WORDS 3456
#define XB_SPIN_CAP (1u << 18)
#define LAS __attribute__((address_space(3)))

__device__ __forceinline__ unsigned xb_ld(unsigned* p)              { return __hip_atomic_load(p, __ATOMIC_RELAXED, __HIP_MEMORY_SCOPE_AGENT); }
__device__ __forceinline__ unsigned xb_add(unsigned* p, unsigned v) { return __hip_atomic_fetch_add(p, v, __ATOMIC_RELAXED, __HIP_MEMORY_SCOPE_AGENT); }
__device__ __forceinline__ unsigned xb_xcc_id() { return (unsigned)__builtin_amdgcn_s_getreg((3 << 11) | 20) & 0xFu; }
#define XB_SPIN(cond, bar) do { unsigned _sp = 0; while (cond) { __builtin_amdgcn_s_sleep(1); \
    if ((++_sp & 255u) == 0u) { if (xb_ld(&(bar)[XB_TMO])) break; if (_sp > XB_SPIN_CAP) { atomicAdd(&(bar)[XB_TMO], 1u); break; } } } } while (0)

struct XcdBarrier {
    unsigned* bar; unsigned x;
    volatile LAS unsigned* st;
};

__device__ __forceinline__ XcdBarrier xcd_barrier_post(unsigned* bar, volatile LAS unsigned* st) {
    XcdBarrier b; b.bar = bar; b.x = xb_xcc_id(); b.st = st;
    if (threadIdx.x == 0) (void)xb_add(&bar[XB_XCNT(b.x)], 1u);
    return b;
}
__device__ __forceinline__ void xcd_barrier_complete(unsigned* bar, unsigned x, unsigned& nloc, unsigned& nx) {
    const unsigned G = gridDim.x * gridDim.y * gridDim.z;
    unsigned sum, cnt, mine, sp = 0u;
    for (;;) {
        sum = 0u; cnt = 0u; mine = 0u;
#pragma unroll
        for (unsigned j = 0; j < 16; ++j) { const unsigned c = xb_ld(&bar[XB_XCNT(j)]); sum += c; cnt += (c > 0u) ? 1u : 0u; mine = (j == x) ? c : mine; }
        if (sum == G) break;
        __builtin_amdgcn_s_sleep(1);
        if ((++sp & 255u) == 0u) { if (xb_ld(&bar[XB_TMO])) break; if (sp > XB_SPIN_CAP) { atomicAdd(&bar[XB_TMO], 1u); break; } }
    }
    nloc = mine > 0u ? mine : 1u; nx = cnt > 0u ? cnt : 1u;
}

__device__ __forceinline__ void xcd_barrier(const XcdBarrier& b) {
    asm volatile("s_waitcnt vmcnt(0)" ::: "memory");
    __syncthreads();
    if (threadIdx.x == 0) {
        unsigned* bar = b.bar;
        __builtin_amdgcn_s_waitcnt(0);
        unsigned nloc = b.st[0], nx = b.st[1];
        if (nloc == 0u) { xcd_barrier_complete(bar, b.x, nloc, nx); b.st[0] = nloc; b.st[1] = nx; }
        const unsigned old = xb_add(&bar[XB_XSUB(b.x)], 1u);
        const unsigned gen = old / nloc;
        if (old + 1u == (gen + 1u) * nloc) {
            __builtin_amdgcn_fence(__ATOMIC_RELEASE, "agent");
            asm volatile("s_waitcnt vmcnt(0)" ::: "memory");
            const unsigned og = xb_add(&bar[XB_TOP], 1u);
            const unsigned tg = og / nx;
            if (og + 1u == (tg + 1u) * nx) xb_add(&bar[XB_TOPGEN], 1u);
            else XB_SPIN(xb_ld(&bar[XB_TOPGEN]) == tg, bar);
            __builtin_amdgcn_fence(__ATOMIC_ACQUIRE, "agent");
            xb_add(&bar[XB_XGEN(b.x)], 1u);
            asm volatile("s_waitcnt vmcnt(0)" ::: "memory");
        } else {
            XB_SPIN(xb_ld(&bar[XB_XGEN(b.x)]) == gen, bar);
            __builtin_amdgcn_fence(__ATOMIC_ACQUIRE, "agent");
            asm volatile("s_waitcnt vmcnt(0)" ::: "memory");
        }
    }
    __syncthreads();
}


namespace pg8 {
#define PG8_LAS __attribute__((address_space(3)))
typedef short bf16x8 __attribute__((ext_vector_type(8)));
constexpr int BM = 256, BK = 64, HALF = 128, HTB = HALF * BK * 2  , STAGE_BYTES = 8 * HTB, NXCD = 8, WGM = 8;

__host__ __device__ __forceinline__ int lds_byte(int r, int c) { const int st = (r >> 4) * 2 + (c >> 5), rr = r & 15, cc = c & 31, ob = rr * 64 + cc * 2; return st * 1024 + (ob ^ (((ob >> 9) & 1) << 5)); }
__host__ __device__ __forceinline__ void stage_rc(int b, int& R, int& C) { const int st = b / 1024, sb = b % 1024, swz = sb ^ (((sb >> 9) & 1) << 5); R = (st >> 1) * 16 + swz / 64; C = (st & 1) * 32 + (swz % 64) / 2; }
__host__ __device__ __forceinline__ int perm32(int rho) { const int n = rho >> 4, i = rho & 15; return 8 * (i >> 2) + 4 * n + (i & 3); }

struct Unit { int pm, pn; };
struct Gemm { const bf16_t* A; const bf16_t* Bt; int M, N, K; };

struct StaticOrder {
    int nM, nN, nwg, G, c;
    __host__ __device__ void init(int M, int N, int G_, int c_) { nM = M / BM; nN = N / BM; nwg = nM * nN; G = G_; c = c_; }
    __host__ __device__ bool next(int i, Unit& u) const {
        const long L = (long)i * G + c; if (L >= nwg) return false;
        int wgid = (int)L; { const int q = nwg / NXCD, r = nwg % NXCD, xcd = wgid % NXCD, off = wgid / NXCD; wgid = (xcd < r ? xcd * (q + 1) : r * (q + 1) + (xcd - r) * q) + off; }
        const int nig = WGM * nN, gid = wgid / nig, fm = gid * WGM, gsz = (nM - fm) < WGM ? (nM - fm) : WGM;
        u.pm = fm + ((wgid % nig) % gsz); u.pn = (wgid % nig) / gsz; return true;
    }
    __device__ __forceinline__ void a_ready(const Unit&) const {}
    __device__ __forceinline__ void done(const Unit&) const {}
};
template <class Epi, class Sched, bool STAMP = false>
__device__ __forceinline__ void gemm_phase(PG8_LAS unsigned char* lds, const Gemm g, const Sched& S, const Epi& E, unsigned long long* stamps) {
    const int tid = threadIdx.x, wid = __builtin_amdgcn_readfirstlane(tid >> 6), lane = tid & 63, wr = wid >> 2, wc = wid & 3, fr = lane & 15, fq = lane >> 4;
    const int K = g.K, nt = K / BK;
    int ts_lo = 0, ts_hi = 0, nts = 0; const unsigned long long rt_entry = STAMP ? (unsigned long long)wall_clock64() : 0ull;
#define PG8_STAMP() do { if (STAMP && wid == 0 && nts < 64) { const unsigned long long _c = (unsigned long long)clock64(); \
        ts_lo = (lane == nts) ? (int)(unsigned)_c : ts_lo; ts_hi = (lane == nts) ? (int)(unsigned)(_c >> 32) : ts_hi; ++nts; } } while (0)
    PG8_STAMP();
    unsigned voffA[2], voffB[2];
#pragma unroll
    for (int i = 0; i < 2; ++i) { int R, C; stage_rc(tid * 16 + i * 8192, R, C); const int Rb = Epi::PERM ? ((R & ~31) + perm32(R & 31)) : R;
        voffA[i] = (unsigned)(R * K + C) * 2u; voffB[i] = (unsigned)(Rb * K + C) * 2u; }
    const size_t kstep = (size_t)(BK * 2);
    const size_t hstep = (size_t)HALF * K * 2;
    const size_t tstep = 2 * hstep;
    const unsigned ldsw = (unsigned)wid * 1024u;
    const int aoff = lds_byte(wr * 64 + fr, fq * 8), boff = lds_byte(wc * 32 + fr, fq * 8);
#define PG8_SA(b, h) (((b) * 2 + (h)) * HTB)
#define PG8_SB(b, h) ((4 + (b) * 2 + (h)) * HTB)
#define PG8_STAGE(bufoff, gbase, voff) do { _Pragma("unroll") for (int _i = 0; _i < 2; ++_i) \
        __builtin_amdgcn_global_load_lds((const unsigned*)((const char*)(gbase) + (voff)[_i]), (PG8_LAS unsigned*)(lds + (bufoff) + ldsw + _i * 8192), 16, 0, 0); } while (0)
#define PG8_LDA(dst, b, h) do { _Pragma("unroll") for (int m = 0; m < 4; ++m) _Pragma("unroll") for (int k = 0; k < 2; ++k) dst[m][k] = *(const PG8_LAS bf16x8*)(lds + PG8_SA(b, h) + aoff + m * 2048 + k * 1024); } while (0)
#define PG8_LDB(dst, b, h) do { _Pragma("unroll") for (int n = 0; n < 2; ++n) _Pragma("unroll") for (int k = 0; k < 2; ++k) dst[n][k] = *(const PG8_LAS bf16x8*)(lds + PG8_SB(b, h) + boff + n * 2048 + k * 1024); } while (0)
#define PG8_MMA(ai, bj, At, Bt) do { __builtin_amdgcn_s_setprio(1); _Pragma("unroll") for (int m = 0; m < 4; ++m) _Pragma("unroll") for (int n = 0; n < 2; ++n) _Pragma("unroll") for (int k = 0; k < 2; ++k) \
        acc[ai][bj][m][n] = __builtin_amdgcn_mfma_f32_16x16x32_bf16(Bt[n][k], At[m][k], acc[ai][bj][m][n], 0, 0, 0); __builtin_amdgcn_s_setprio(0); } while (0)
#define PG8_WAIT_V(n) asm volatile("s_waitcnt vmcnt(" #n ")" ::: "memory")
#define PG8_WAIT_L(n) asm volatile("s_waitcnt lgkmcnt(" #n ")" ::: "memory")
#define PG8_BAR __builtin_amdgcn_s_barrier()
#define PG8_SCHED __builtin_amdgcn_sched_barrier(0)
    Unit cur, nxt; int ui = 0;
    if (!S.next(0, cur)) return;
    f32x4 acc[2][2][4][2];
#pragma unroll
    for (int a = 0; a < 2; ++a)
#pragma unroll
        for (int b = 0; b < 2; ++b)
#pragma unroll
            for (int m = 0; m < 4; ++m)
#pragma unroll
                for (int n = 0; n < 2; ++n) acc[a][b][m][n] = (f32x4){0.f, 0.f, 0.f, 0.f};
    bf16x8 At[4][2], B0[2][2], B1[2][2];
    const char* cA = (const char*)g.A + (size_t)cur.pm * tstep; const char* cB = (const char*)g.Bt + (size_t)cur.pn * tstep;
    S.a_ready(cur);
    PG8_STAGE(PG8_SB(0, 0), cB, voffB); PG8_STAGE(PG8_SA(0, 0), cA, voffA); PG8_STAGE(PG8_SB(0, 1), cB + hstep, voffB); PG8_STAGE(PG8_SA(0, 1), cA + hstep, voffA);
    if (wr == 1) PG8_BAR;
    PG8_WAIT_V(4); PG8_BAR;
    PG8_STAGE(PG8_SB(1, 0), cB + kstep, voffB); PG8_STAGE(PG8_SA(1, 0), cA + kstep, voffA); PG8_STAGE(PG8_SB(1, 1), cB + hstep + kstep, voffB);
    PG8_WAIT_V(6); PG8_BAR;
    PG8_STAMP();
    for (;;) {
        const bool has_next = S.next(ui + 1, nxt);
        const char* nA = has_next ? (const char*)g.A + (size_t)nxt.pm * tstep : cA; const char* nB = has_next ? (const char*)g.Bt + (size_t)nxt.pn * tstep : cB;
        for (int t = 0; t < nt; t += 2) {
            const bool last = (t == nt - 2);
            const char* a1 = cA + (size_t)(t + 1) * kstep;
            const char* a2 = last ? nA : cA + (size_t)(t + 2) * kstep; const char* b2 = last ? nB : cB + (size_t)(t + 2) * kstep;
            const char* a3 = a2 + kstep; const char* b3 = b2 + kstep;
            if (last && has_next) S.a_ready(nxt);
            PG8_LDB(B0, 0, 0); PG8_SCHED; PG8_LDA(At, 0, 0); PG8_STAGE(PG8_SA(1, 1), a1 + hstep, voffA);
            PG8_WAIT_L(8); PG8_BAR; PG8_WAIT_L(0); PG8_MMA(0, 0, At, B0); PG8_BAR; PG8_SCHED;
            PG8_LDB(B1, 0, 1); PG8_STAGE(PG8_SB(0, 0), b2, voffB);
            PG8_BAR; PG8_WAIT_L(0); PG8_MMA(0, 1, At, B1); PG8_BAR;
            PG8_LDA(At, 0, 1); PG8_STAGE(PG8_SA(0, 0), a2, voffA);
            PG8_BAR; PG8_WAIT_L(0); PG8_MMA(1, 0, At, B0); PG8_BAR; PG8_SCHED;
            PG8_STAGE(PG8_SB(0, 1), b2 + hstep, voffB);
            PG8_WAIT_V(6); PG8_BAR; PG8_MMA(1, 1, At, B1); PG8_BAR;
            PG8_LDB(B0, 1, 0); PG8_SCHED; PG8_LDA(At, 1, 0); PG8_STAGE(PG8_SA(0, 1), a2 + hstep, voffA);
            PG8_WAIT_L(8); PG8_BAR; PG8_WAIT_L(0); PG8_MMA(0, 0, At, B0); PG8_BAR; PG8_SCHED;
            PG8_LDB(B1, 1, 1); PG8_STAGE(PG8_SB(1, 0), b3, voffB);
            PG8_BAR; PG8_WAIT_L(0); PG8_MMA(0, 1, At, B1); PG8_BAR;
            PG8_LDA(At, 1, 1); PG8_STAGE(PG8_SA(1, 0), a3, voffA);
            PG8_BAR; PG8_WAIT_L(0); PG8_MMA(1, 0, At, B0); PG8_BAR; PG8_SCHED;
            PG8_STAGE(PG8_SB(1, 1), b3 + hstep, voffB);
            PG8_WAIT_V(6); PG8_BAR; PG8_MMA(1, 1, At, B1); PG8_BAR;
        }
        PG8_STAMP();
        if constexpr (!Epi::AFTER_DRAIN) { E(acc, cur, wr, wc, fr, fq); S.done(cur); }
        PG8_STAMP();
        if (!has_next) break;
#pragma unroll
        for (int a = 0; a < 2; ++a)
#pragma unroll
            for (int b = 0; b < 2; ++b)
#pragma unroll
                for (int m = 0; m < 4; ++m)
#pragma unroll
                    for (int n = 0; n < 2; ++n) acc[a][b][m][n] = (f32x4){0.f, 0.f, 0.f, 0.f};
        cur = nxt; cA = nA; cB = nB; ++ui;
    }
    PG8_WAIT_V(0);
    if (wr == 0) PG8_BAR;
    PG8_BAR;
    if constexpr (Epi::AFTER_DRAIN) { E.fused(acc, cur, wr, wc, fr, fq, lds, wid, lane); S.done(cur); }
    PG8_STAMP();
    if (STAMP && wid == 0) { stamps[lane] = lane < nts ? (((unsigned long long)(unsigned)ts_hi << 32) | (unsigned)ts_lo) : 0ull;
        if (lane == 62) stamps[62] = rt_entry; if (lane == 63) stamps[63] = (unsigned long long)wall_clock64(); }
#undef PG8_STAMP
#undef PG8_SA
#undef PG8_SB
#undef PG8_STAGE
#undef PG8_LDA
#undef PG8_LDB
#undef PG8_MMA
#undef PG8_WAIT_V
#undef PG8_WAIT_L
#undef PG8_BAR
#undef PG8_SCHED
}
}
#define LAS3 __attribute__((address_space(3)))
constexpr int MK_THREADS = 512;
typedef __bf16 bf16x2_t __attribute__((ext_vector_type(2)));
DI float dot2bf(unsigned a, unsigned b, float c) { return __builtin_amdgcn_fdot2_f32_bf16(__builtin_bit_cast(bf16x2_t, a), __builtin_bit_cast(bf16x2_t, b), c, false); }
DI float bflo(unsigned v) { return __uint_as_float(v << 16); }
DI float bfhi(unsigned v) { return __uint_as_float(v & 0xffff0000u); }

template <class ColMap>
DI void transpose_tile(const float* __restrict__ src, int ldsrc, const float* __restrict__ gain, bf16_t* __restrict__ dst, int K, int k0, int n0, const ColMap& cm, LAS3 float* tl) {
    const int tid = threadIdx.x;
    __syncthreads();
    {
        const int n = tid & 63, sc = cm(n0 + n);
#pragma unroll
        for (int j = 0; j < 8; ++j) { const int k = (tid >> 6) + 8 * j; tl[k * 65 + n] = sc >= 0 ? src[(size_t)(k0 + k) * ldsrc + sc] * (gain ? gain[k0 + k] : 1.0f) : 0.f; }
    }
    __syncthreads();
    {
        const int n = tid >> 3, k8 = (tid & 7) * 8;
        u32x4 w;
        w.x = pack2bf(tl[(k8 + 0) * 65 + n], tl[(k8 + 1) * 65 + n]); w.y = pack2bf(tl[(k8 + 2) * 65 + n], tl[(k8 + 3) * 65 + n]);
        w.z = pack2bf(tl[(k8 + 4) * 65 + n], tl[(k8 + 5) * 65 + n]); w.w = pack2bf(tl[(k8 + 6) * 65 + n], tl[(k8 + 7) * 65 + n]);
        *(u32x4*)(dst + (size_t)(n0 + n) * K + k0 + k8) = w;
    }
}
struct ColId { DI int operator()(int n) const { return n; } };
struct ColWin { DI int operator()(int n) const { return n < PC_XR ? n : (n < PC_XG ? 1304 + (n - PC_XR) : (n < PC_GATE ? 1816 + (n - PC_XG) : (n < PC_GATE + 24 ? 1280 + (n - PC_GATE) : -1))); } };

DI void cvt_rows_bf16(const float* __restrict__ src, const float* __restrict__ gain, bf16_t* __restrict__ dst, size_t n8, int cols, size_t gtid, size_t nthr) {
    for (size_t i0 = gtid; i0 < n8; i0 += 4 * nthr) {
        f32x4 a[4], b[4];
#pragma unroll
        for (int u = 0; u < 4; ++u) { const size_t i = i0 + u * nthr; if (i < n8) { a[u] = *(const f32x4*)(src + i * 8); b[u] = *(const f32x4*)(src + i * 8 + 4); } }
#pragma unroll
        for (int u = 0; u < 4; ++u) { const size_t i = i0 + u * nthr; if (i < n8) {
            f32x4 x = a[u], y = b[u];
            if (gain) { const int c = (int)((i * 8) % cols); x *= *(const f32x4*)(gain + c); y *= *(const f32x4*)(gain + c + 4); }
            u32x4 w; w.x = pack2bf(x[0], x[1]); w.y = pack2bf(x[2], x[3]); w.z = pack2bf(y[0], y[1]); w.w = pack2bf(y[2], y[3]);
            *(u32x4*)(dst + i * 8) = w; } }
    }
}
DI void cvt_rows_fp8(const float* __restrict__ src, const float* __restrict__ gain, float scale, unsigned char* __restrict__ dst, size_t n8, int cols, size_t gtid, size_t nthr) {
    for (size_t i0 = gtid; i0 < n8; i0 += 4 * nthr) {
        f32x4 a[4], b[4];
#pragma unroll
        for (int u = 0; u < 4; ++u) { const size_t i = i0 + u * nthr; if (i < n8) { a[u] = *(const f32x4*)(src + i * 8); b[u] = *(const f32x4*)(src + i * 8 + 4); } }
#pragma unroll
        for (int u = 0; u < 4; ++u) { const size_t i = i0 + u * nthr; if (i < n8) {
            f32x4 x = a[u], y = b[u];
            if (gain) { const int c = (int)((i * 8) % cols); x *= *(const f32x4*)(gain + c); y *= *(const f32x4*)(gain + c + 4); }
            x *= scale; y *= scale;
            int w0 = 0, w1 = 0;
            w0 = __builtin_amdgcn_cvt_pk_fp8_f32(x[0], x[1], w0, false); w0 = __builtin_amdgcn_cvt_pk_fp8_f32(x[2], x[3], w0, true);
            w1 = __builtin_amdgcn_cvt_pk_fp8_f32(y[0], y[1], w1, false); w1 = __builtin_amdgcn_cvt_pk_fp8_f32(y[2], y[3], w1, true);
            *(u32x2*)(dst + i * 8) = (u32x2){(unsigned)w0, (unsigned)w1}; } }
    }
}
DI void cvt_rows_i8(const float* __restrict__ src, const float* __restrict__ gain, float scale, unsigned char* __restrict__ dst, size_t n8, int cols, size_t gtid, size_t nthr) {
    for (size_t i0 = gtid; i0 < n8; i0 += 4 * nthr) {
        f32x4 a[4], b[4];
#pragma unroll
        for (int u = 0; u < 4; ++u) { const size_t i = i0 + u * nthr; if (i < n8) { a[u] = *(const f32x4*)(src + i * 8); b[u] = *(const f32x4*)(src + i * 8 + 4); } }
#pragma unroll
        for (int u = 0; u < 4; ++u) { const size_t i = i0 + u * nthr; if (i < n8) {
            f32x4 x = a[u], y = b[u];
            if (gain) { const int c = (int)((i * 8) % cols); x *= *(const f32x4*)(gain + c); y *= *(const f32x4*)(gain + c + 4); }
            unsigned w0 = 0u, w1 = 0u;
#pragma unroll
            for (int j = 0; j < 4; ++j) {
                const int qa = (int)rintf(fminf(fmaxf(x[j] * scale, -127.f), 127.f)), qb = (int)rintf(fminf(fmaxf(y[j] * scale, -127.f), 127.f));
                w0 |= ((unsigned)qa & 0xffu) << (8 * j); w1 |= ((unsigned)qb & 0xffu) << (8 * j);
            }
            *(u32x2*)(dst + i * 8) = (u32x2){w0, w1}; } }
    }
}
DI void cvt_rows_fp4(const float* __restrict__ src, const float* __restrict__ gain, float scale, unsigned char* __restrict__ dst, size_t n8, int cols, size_t gtid, size_t nthr) {
    for (size_t i = gtid; i < n8; i += nthr) {
        f32x4 a = *(const f32x4*)(src + i * 8), b = *(const f32x4*)(src + i * 8 + 4);
        if (gain) { const int c = (int)((i * 8) % cols); a *= *(const f32x4*)(gain + c); b *= *(const f32x4*)(gain + c + 4); }
        a *= scale; b *= scale;
        unsigned w = 0u;
        w = __builtin_amdgcn_cvt_scalef32_pk_fp4_f32(w, a[0], a[1], 1.0f, 0); w = __builtin_amdgcn_cvt_scalef32_pk_fp4_f32(w, a[2], a[3], 1.0f, 1);
        w = __builtin_amdgcn_cvt_scalef32_pk_fp4_f32(w, b[0], b[1], 1.0f, 2); w = __builtin_amdgcn_cvt_scalef32_pk_fp4_f32(w, b[2], b[3], 1.0f, 3);
        *(unsigned*)(dst + i * 4) = w;
    }
}
DI void p0_prologue(const Params& p, LAS3 unsigned char* lds, int G) {
    unsigned char* ws = p.ws;
    const int tid = threadIdx.x, lane = tid & 63, wid = tid >> 6, bid = blockIdx.x;
    const size_t gtid = (size_t)bid * MK_THREADS + tid, nthr = (size_t)G * MK_THREADS;
    const int gw = bid * 8 + wid, nw = G * 8;
    {
        const float* x = p.in[I_X]; bf16_t* xb = (bf16_t*)(ws + WS_XB); float* rs0 = (float*)(ws + WS_RS0);
        for (int row0 = gw; row0 < NTOK; row0 += 4 * nw) {
            f32x4 v[4][4];
#pragma unroll
            for (int u = 0; u < 4; ++u) { const int row = row0 + u * nw; if (row < NTOK) {
#pragma unroll
                for (int j = 0; j < 4; ++j) v[u][j] = *(const f32x4*)(x + (size_t)row * DM + j * 256 + lane * 4); } }
#pragma unroll
            for (int u = 0; u < 4; ++u) { const int row = row0 + u * nw; if (row < NTOK) {
                float s = 0.f;
#pragma unroll
                for (int j = 0; j < 4; ++j) s += (v[u][j][0] * v[u][j][0] + v[u][j][1] * v[u][j][1]) + (v[u][j][2] * v[u][j][2] + v[u][j][3] * v[u][j][3]);
                s = wave_sum(s);
#pragma unroll
                for (int j = 0; j < 4; ++j) { u32x2 w; w.x = pack2bf(v[u][j][0], v[u][j][1]); w.y = pack2bf(v[u][j][2], v[u][j][3]); *(u32x2*)(xb + (size_t)row * DM + j * 256 + lane * 4) = w; }
                if (lane == 0) rs0[row] = rsqrtf(s * (1.0f / DM) + EPS); } }
        }
    }
#if PEER_FP4
    cvt_rows_fp4(p.in[I_PEER_U], p.in[I_FFN_NORM], 64.0f, (unsigned char*)(ws + WS_UB), (size_t)16384 * DM / 8, DM, gtid, nthr);
    cvt_rows_fp4(p.in[I_PEER_V], nullptr, 6.0f, (unsigned char*)(ws + WS_VB), (size_t)16384 * DM / 8, DM, gtid, nthr);
#elif PEER_I8U
    cvt_rows_i8(p.in[I_PEER_U], p.in[I_FFN_NORM], 640.0f, (unsigned char*)(ws + WS_UB), (size_t)16384 * DM / 8, DM, gtid, nthr);
#if PEER_V4EXP
    cvt_rows_fp4(p.in[I_PEER_V], nullptr, 8.0f, (unsigned char*)(ws + WS_VB), (size_t)16384 * DM / 8, DM, gtid, nthr);
#else
    cvt_rows_fp8(p.in[I_PEER_V], nullptr, 8.0f, (unsigned char*)(ws + WS_VB), (size_t)16384 * DM / 8, DM, gtid, nthr);
#endif
#elif PEER_V3
    cvt_rows_fp8(p.in[I_PEER_U], p.in[I_FFN_NORM], 32.0f, (unsigned char*)(ws + WS_UB), (size_t)16384 * DM / 8, DM, gtid, nthr);
    cvt_rows_fp8(p.in[I_PEER_V], nullptr, 8.0f, (unsigned char*)(ws + WS_VB), (size_t)16384 * DM / 8, DM, gtid, nthr);
#else
    cvt_rows_bf16(p.in[I_PEER_U], p.in[I_FFN_NORM], (bf16_t*)(ws + WS_UB), (size_t)16384 * DM / 8, DM, gtid, nthr);
    cvt_rows_bf16(p.in[I_PEER_V], nullptr, (bf16_t*)(ws + WS_VB), (size_t)16384 * DM / 8, DM, gtid, nthr);
#endif
    cvt_rows_bf16(p.in[I_P], nullptr, (bf16_t*)(ws + WS_PB), (size_t)NTOK * PLE / 8, PLE, gtid, nthr);
    LAS3 float* tl = (LAS3 float*)lds;
    {
        for (int u = bid; u < 1496; u += G) {
            if (u < 640) transpose_tile(p.in[I_W_IN], INCOLS, p.in[I_ATTN_NORM], (bf16_t*)(ws + WS_WIN), DM, (u % 16) * 64, (u / 16) * 64, ColWin{}, tl);
            else if (u < 896) { const int v = u - 640; transpose_tile(p.in[I_W_OUT], DM, nullptr, (bf16_t*)(ws + WS_WOUT), DM, (v % 16) * 64, (v / 16) * 64, ColId{}, tl); }
            else if (u < 1152) { const int v = u - 896; transpose_tile(p.in[I_PLE_WG], DM, p.in[I_PLE_NORM], (bf16_t*)(ws + WS_WG), DM, (v % 16) * 64, (v / 16) * 64, ColId{}, tl); }
            else if (u < 1216) { const int v = u - 1152; transpose_tile(p.in[I_PLE_PROJ], DM, nullptr, (bf16_t*)(ws + WS_WP), PLE, (v % 4) * 64, (v / 4) * 64, ColId{}, tl); }
            else if (u < 1344) { const int v = u - 1216; transpose_tile(p.in[I_CK_W1], 256, nullptr, (bf16_t*)(ws + WS_CW1K), 2048, (v % 32) * 64, (v / 32) * 64, ColId{}, tl); }
            else if (u < 1472) { const int v = u - 1344; transpose_tile(p.in[I_CV_W1], 256, nullptr, (bf16_t*)(ws + WS_CW1V), 2048, (v % 32) * 64, (v / 32) * 64, ColId{}, tl); }
            else if (u < 1480) { const int v = u - 1472; transpose_tile(p.in[I_LRU_WA] + v * 4096, 64, nullptr, (bf16_t*)(ws + WS_WAT) + v * 4096, 64, 0, 0, ColId{}, tl); }
            else if (u < 1488) { const int v = u - 1480; transpose_tile(p.in[I_LRU_WX] + v * 4096, 64, nullptr, (bf16_t*)(ws + WS_WXT) + v * 4096, 64, 0, 0, ColId{}, tl); }
            else if (u < 1492) { const int v = u - 1488; transpose_tile(p.in[I_CK_W2], 64, nullptr, (bf16_t*)(ws + WS_CW2K), 256, v * 64, 0, ColId{}, tl); }
            else { const int v = u - 1492; transpose_tile(p.in[I_CV_W2], 64, nullptr, (bf16_t*)(ws + WS_CW2V), 256, v * 64, 0, ColId{}, tl); }
        }
        __syncthreads();
    }
    {
        LAS3 float* wt = (LAS3 float*)lds;
        LAS3 float* st = (LAS3 float*)(lds + 32768);
        const float* wq = p.in[I_PEER_WQ]; const float* sub = p.in[I_PEER_SUB]; const float* gain = p.in[I_FFN_NORM]; bf16_t* WqsT = (bf16_t*)(ws + WS_WQS);
        for (int u = bid; u < 256; u += G) {
            const int hp = u >> 4, d0 = (u & 15) * 64, pp = hp & 1;
            __syncthreads();
            for (int i = tid; i < 64 * 128; i += MK_THREADS) { const int d = i >> 7, dk = i & 127; wt[dk * 64 + d] = wq[(size_t)(d0 + d) * 2048 + hp * 128 + dk]; }
            for (int i = tid; i < 128 * 128; i += MK_THREADS) { const int kk = i >> 7, dk = i & 127; st[kk * 129 + dk] = sub[((size_t)pp * 128 + kk) * 128 + dk]; }
            __syncthreads();
            const int kk = tid & 127, dg = (tid >> 7) * 16;
            float acc[16];
#pragma unroll
            for (int j = 0; j < 16; ++j) acc[j] = 0.f;
            for (int dk = 0; dk < 128; ++dk) {
                const float sv = st[kk * 129 + dk];
#pragma unroll
                for (int j4 = 0; j4 < 4; ++j4) { const f32x4 w4 = *(LAS3 f32x4*)(wt + dk * 64 + dg + j4 * 4);
#pragma unroll
                    for (int j = 0; j < 4; ++j) acc[j4 * 4 + j] += sv * w4[j]; }
            }
            u32x4 o0, o1;
#define GQ(j) (acc[j] * gain[d0 + dg + (j)])
            o0.x = pack2bf(GQ(0), GQ(1)); o0.y = pack2bf(GQ(2), GQ(3)); o0.z = pack2bf(GQ(4), GQ(5)); o0.w = pack2bf(GQ(6), GQ(7));
            o1.x = pack2bf(GQ(8), GQ(9)); o1.y = pack2bf(GQ(10), GQ(11)); o1.z = pack2bf(GQ(12), GQ(13)); o1.w = pack2bf(GQ(14), GQ(15));
#undef GQ
            bf16_t* dst = WqsT + (size_t)(hp * 128 + kk) * DM + d0 + dg;
            *(u32x4*)dst = o0; *(u32x4*)(dst + 8) = o1;
        }
        __syncthreads();
    }
    for (int o = gw; o < 512; o += nw) {
        const int kv = o >> 8, j = o & 255;
        const float* pe = p.in[kv ? I_CV_PE : I_CK_PE]; const float* w1 = p.in[kv ? I_CV_W1 : I_CK_W1];
        float acc = 0.f;
        for (int k = lane; k < 2048; k += 64) acc += pe[k] * w1[(size_t)k * 256 + j];
        acc = wave_sum(acc);
        if (lane == 0) ((float*)(ws + (kv ? WS_CBV : WS_CBK)))[j] = acc;
    }
}

DI void p6_peer_apply(const Params& p, int G) {
    unsigned char* ws = p.ws;
    const int tid = threadIdx.x, lane = tid & 63, wid = tid >> 6;
    const int gw = blockIdx.x * 8 + wid, nw = G * 8;
    const bf16_t* ub = (const bf16_t*)(ws + WS_UB); const bf16_t* vb = (const bf16_t*)(ws + WS_VB);
    const int* eidx = (const int*)(ws + R_EXP); const float* gsm = (const float*)(ws + R_GSM); const float* ssq1 = (const float*)(ws + WS_SSQ1);
    float* h = p.out; bf16_t* hb = (bf16_t*)(ws + R_H1B); float* rs2 = (float*)(ws + WS_RS2);
    for (int tok = gw; tok < NTOK; tok += nw) {
        float sq = lane < 16 ? ssq1[(size_t)lane * NTOK + tok] : 0.f;
        sq = wave_sum(sq);
        const float rs1 = rsqrtf(sq * (1.0f / DM) + EPS);
        const u32x4 xa = *(const u32x4*)(hb + (size_t)tok * DM + lane * 8), xc = *(const u32x4*)(hb + (size_t)tok * DM + 512 + lane * 8);
        const int e0 = eidx[(size_t)tok * 128 + lane], e1 = eidx[(size_t)tok * 128 + 64 + lane];
        const float g0 = gsm[(size_t)tok * 128 + lane], g1 = gsm[(size_t)tok * 128 + 64 + lane];
        float coef0 = 0.f, coef1 = 0.f;
#pragma unroll
        for (int half = 0; half < 2; ++half) {
            const int ev = half ? e1 : e0;
            float part[64];
#pragma unroll
            for (int j = 0; j < 64; ++j) {
                const int e = __builtin_amdgcn_readlane(ev, j);
                const bf16_t* ur = ub + (size_t)e * DM + lane * 8;
                const u32x4 ua = *(const u32x4*)ur, uc = *(const u32x4*)(ur + 512);
                float a = dot2bf(xa.x, ua.x, 0.f); a = dot2bf(xa.y, ua.y, a); a = dot2bf(xa.z, ua.z, a); a = dot2bf(xa.w, ua.w, a);
                a = dot2bf(xc.x, uc.x, a); a = dot2bf(xc.y, uc.y, a); a = dot2bf(xc.z, uc.z, a); a = dot2bf(xc.w, uc.w, a);
                part[j] = a;
            }
#pragma unroll
            for (int m = 32; m >= 1; m >>= 1) {
                const bool up = (lane & m) != 0;
#pragma unroll
                for (int i = 0; i < m; ++i) {
                    const float send = up ? part[i] : part[i + m];
                    const float keep = up ? part[i + m] : part[i];
                    part[i] = keep + __shfl_xor(send, m);
                }
            }
            const float act = gelu_tanh(part[0] * rs1);
            if (half) coef1 = g1 * act; else coef0 = g0 * act;
        }
        float acc[16];
#pragma unroll
        for (int i = 0; i < 16; ++i) acc[i] = 0.f;
#pragma unroll
        for (int half = 0; half < 2; ++half) {
            const int ev = half ? e1 : e0; const float cv = half ? coef1 : coef0;
#pragma unroll 16
            for (int j = 0; j < 64; ++j) {
                const int e = __builtin_amdgcn_readlane(ev, j);
                const float c = __uint_as_float(__builtin_amdgcn_readlane(__float_as_uint(cv), j));
                const bf16_t* vr = vb + (size_t)e * DM + lane * 8;
                const u32x4 va = *(const u32x4*)vr, vc = *(const u32x4*)(vr + 512);
                acc[0] += c * bflo(va.x); acc[1] += c * bfhi(va.x); acc[2] += c * bflo(va.y); acc[3] += c * bfhi(va.y);
                acc[4] += c * bflo(va.z); acc[5] += c * bfhi(va.z); acc[6] += c * bflo(va.w); acc[7] += c * bfhi(va.w);
                acc[8] += c * bflo(vc.x); acc[9] += c * bfhi(vc.x); acc[10] += c * bflo(vc.y); acc[11] += c * bfhi(vc.y);
                acc[12] += c * bflo(vc.z); acc[13] += c * bfhi(vc.z); acc[14] += c * bflo(vc.w); acc[15] += c * bfhi(vc.w);
            }
        }
        float* hr = h + (size_t)tok * DM + lane * 8;
        f32x4 h0 = *(f32x4*)hr, h1 = *(f32x4*)(hr + 4), h2 = *(f32x4*)(hr + 512), h3 = *(f32x4*)(hr + 516);
        h0 += (f32x4){acc[0], acc[1], acc[2], acc[3]}; h1 += (f32x4){acc[4], acc[5], acc[6], acc[7]};
        h2 += (f32x4){acc[8], acc[9], acc[10], acc[11]}; h3 += (f32x4){acc[12], acc[13], acc[14], acc[15]};
        *(f32x4*)hr = h0; *(f32x4*)(hr + 4) = h1; *(f32x4*)(hr + 512) = h2; *(f32x4*)(hr + 516) = h3;
        u32x4 w0, w1;
        w0.x = pack2bf(h0[0], h0[1]); w0.y = pack2bf(h0[2], h0[3]); w0.z = pack2bf(h1[0], h1[1]); w0.w = pack2bf(h1[2], h1[3]);
        w1.x = pack2bf(h2[0], h2[1]); w1.y = pack2bf(h2[2], h2[3]); w1.z = pack2bf(h3[0], h3[1]); w1.w = pack2bf(h3[2], h3[3]);
        *(u32x4*)(hb + (size_t)tok * DM + lane * 8) = w0; *(u32x4*)(hb + (size_t)tok * DM + 512 + lane * 8) = w1;
        float s = 0.f;
#pragma unroll
        for (int j = 0; j < 4; ++j) s += h0[j] * h0[j] + h1[j] * h1[j] + h2[j] * h2[j] + h3[j] * h3[j];
        s = wave_sum(s);
        if (lane == 0) rs2[tok] = rsqrtf(s * (1.0f / DM) + EPS);
    }
}

DI void p8_final_norm(const Params& p, int G) {
    const int lane = threadIdx.x & 63, gw = blockIdx.x * 8 + (threadIdx.x >> 6), nw = G * 8;
    const float* ssq3 = (const float*)(p.ws + WS_SSQ3); const float* g = p.in[I_FINAL_NORM]; float* h = p.out;
    f32x4 gg[4];
#pragma unroll
    for (int j = 0; j < 4; ++j) gg[j] = *(const f32x4*)(g + j * 256 + lane * 4);
    for (int row0 = gw; row0 < NTOK; row0 += 4 * nw) {
        f32x4 v[4][4]; float sq[4];
#pragma unroll
        for (int u = 0; u < 4; ++u) { const int row = row0 + u * nw; if (row < NTOK) { sq[u] = lane < 16 ? ssq3[(size_t)lane * NTOK + row] : 0.f;
#pragma unroll
            for (int j = 0; j < 4; ++j) v[u][j] = *(const f32x4*)(h + (size_t)row * DM + j * 256 + lane * 4); } }
#pragma unroll
        for (int u = 0; u < 4; ++u) { const int row = row0 + u * nw; if (row < NTOK) {
            const float rs = rsqrtf(wave_sum(sq[u]) * (1.0f / DM) + EPS);
#pragma unroll
            for (int j = 0; j < 4; ++j) *(f32x4*)(h + (size_t)row * DM + j * 256 + lane * 4) = v[u][j] * rs * gg[j]; } }
    }
}
typedef float f32x16 __attribute__((ext_vector_type(16)));
typedef short bf16x8v __attribute__((ext_vector_type(8)));
typedef __bf16 bf16x2v_ __attribute__((ext_vector_type(2)));
DI unsigned pk_bf16(float lo, float hi) { return __builtin_bit_cast(unsigned, __builtin_convertvector((f32x2){lo, hi}, bf16x2v_)); }
constexpr float LOG2E = 1.4426950408889634f;
constexpr int AT_KROW = 144, AT_VROW = 136;
constexpr int AT_KT = 64 * AT_KROW, AT_VT = 64 * AT_VROW, AT_BUF = 2 * AT_KT + 2 * AT_VT;
constexpr int AT_VAL = 0;
constexpr int AT_LUT = 2 * AT_BUF;
constexpr int AT_IMP = AT_LUT + 8 * 128 * 4;
constexpr int AT_SEL = AT_IMP + 8 * 32 * 65 * 4;
constexpr int AT_SSQ = AT_SEL + 512;
constexpr int AT_END = AT_SSQ + 1024;
static_assert(AT_END <= 160 * 1024 - 256, "attention LDS map");

struct AtSrc { const bf16_t* k0; const bf16_t* k1; const bf16_t* v0; const bf16_t* v1; int vld; };
DI void at_load(const AtSrc& s, int kpos, int tid, u32x4 (&r)[4]) {
    const int row = tid >> 3, seg = tid & 7;
    r[0] = *(const u32x4*)(s.k0 + (size_t)(kpos + row) * HD + seg * 8);
    r[1] = *(const u32x4*)(s.k1 + (size_t)(kpos + row) * HD + seg * 8);
    r[2] = *(const u32x4*)(s.v0 + (size_t)row * s.vld + kpos + seg * 8);
    r[3] = *(const u32x4*)(s.v1 + (size_t)row * s.vld + kpos + seg * 8);
}
DI void at_store(LAS3 unsigned char* buf, int tid, const u32x4 (&r)[4]) {
    const int row = tid >> 3, seg = tid & 7;
    *(LAS3 u32x4*)(buf + row * AT_KROW + seg * 16) = r[0];
    *(LAS3 u32x4*)(buf + AT_KT + row * AT_KROW + seg * 16) = r[1];
    LAS3 unsigned char* v = buf + 2 * AT_KT + row * AT_VROW + seg * 16;
    *(LAS3 u32x2*)(v) = (u32x2){r[2].x, r[2].y}; *(LAS3 u32x2*)(v + 8) = (u32x2){r[2].z, r[2].w};
    *(LAS3 u32x2*)(v + AT_VT) = (u32x2){r[3].x, r[3].y}; *(LAS3 u32x2*)(v + AT_VT + 8) = (u32x2){r[3].z, r[3].w};
}

template <int MODE, int PASS>
DI void at_step(LAS3 const unsigned char* Kb, LAS3 const unsigned char* Vb, const bf16x8v (&Q)[4], int k0, int tq, int lane, LAS3 const float* lut, bool blk_ok, bool farstep,
                float& m_run, float& l_run, f32x16 (&O)[2], float inv_l, LAS3 float* imp_row, float& bcarry) {
    const int r = lane & 31, hf = lane >> 5;
    f32x16 S[2];
#pragma unroll
    for (int sub = 0; sub < 2; ++sub) {
#pragma unroll
        for (int i = 0; i < 16; ++i) S[sub][i] = 0.f;
#pragma unroll
        for (int ks = 0; ks < 4; ++ks) {
            const bf16x8v a = *(LAS3 const bf16x8v*)(Kb + (32 * sub + r) * AT_KROW + 32 * ks + 16 * hf);
            S[sub] = __builtin_amdgcn_mfma_f32_32x32x16_bf16(a, Q[ks], S[sub], 0, 0, 0);
        }
    }
    __builtin_amdgcn_sched_barrier(0);
    float mx = -INFINITY;
    if (!farstep) {
#pragma unroll
        for (int sub = 0; sub < 2; ++sub)
#pragma unroll
            for (int i = 0; i < 16; ++i) {
                const int kp = k0 + 32 * sub + (i & 3) + 8 * (i >> 2) + 4 * hf;
                const int dist = MODE == 0 ? tq - (16 * kp + 31) : tq - kp;
                bool ok = dist >= 0 && blk_ok;
                if (MODE == 2) ok = ok && dist < 512;
                const int idx = dist < 0 ? 0 : (dist > 127 ? 127 : dist);
                float s = S[sub][i] * LOG2E + lut[idx];
                s = ok ? s : -INFINITY;
                S[sub][i] = s; mx = fmaxf(mx, s);
            }
    } else {
        const float bfar = lut[127];
#pragma unroll
        for (int sub = 0; sub < 2; ++sub)
#pragma unroll
            for (int i = 0; i < 16; ++i) {
                float s = S[sub][i] * LOG2E + bfar;
                if (MODE == 1) s = blk_ok ? s : -INFINITY;
                S[sub][i] = s; mx = fmaxf(mx, s);
            }
    }
    if (PASS != 2) {
        mx = fmaxf(mx, __shfl_xor(mx, 32));
        const float m_new = fmaxf(m_run, mx), m_safe = (m_new == -INFINITY) ? 0.f : m_new;
        const float alpha = __builtin_amdgcn_exp2f(m_run - m_safe);
        float sum = 0.f;
#pragma unroll
        for (int sub = 0; sub < 2; ++sub)
#pragma unroll
            for (int i = 0; i < 16; ++i) { const float pv = __builtin_amdgcn_exp2f(S[sub][i] - m_safe); S[sub][i] = pv; sum += pv; }
        l_run = l_run * alpha + sum; m_run = m_new;
        if (PASS == 0) {
#pragma unroll
            for (int db = 0; db < 2; ++db)
#pragma unroll
                for (int i = 0; i < 16; ++i) O[db][i] *= alpha;
        }
    } else {
#pragma unroll
        for (int sub = 0; sub < 2; ++sub) {
#pragma unroll
            for (int i = 0; i < 16; ++i) S[sub][i] = __builtin_amdgcn_exp2f(S[sub][i] - m_run) * inv_l;
            float bp[4], av[4];
#pragma unroll
            for (int a = 0; a < 4; ++a) {
                av[a] = S[sub][4 * a] + S[sub][4 * a + 1] + S[sub][4 * a + 2] + 0.5f * S[sub][4 * a + 3];
                bp[a] = __shfl_xor(0.5f * S[sub][4 * a + 3], 32);
            }
            const int sbase = (k0 >> 2) + 8 * sub + hf;
#pragma unroll
            for (int a = 0; a < 4; ++a) imp_row[sbase + 2 * a] = av[a] + (hf ? bp[a] : (a > 0 ? bp[a > 0 ? a - 1 : 0] : bcarry));
            bcarry = bp[3];
        }
    }
    __builtin_amdgcn_sched_barrier(0);
    if (PASS != 1) {
#pragma unroll
        for (int sub = 0; sub < 2; ++sub)
#pragma unroll
            for (int s2 = 0; s2 < 2; ++s2) {
                u32x4 pw;
                pw.x = pk_bf16(S[sub][8 * s2 + 0], S[sub][8 * s2 + 1]); pw.y = pk_bf16(S[sub][8 * s2 + 2], S[sub][8 * s2 + 3]);
                pw.z = pk_bf16(S[sub][8 * s2 + 4], S[sub][8 * s2 + 5]); pw.w = pk_bf16(S[sub][8 * s2 + 6], S[sub][8 * s2 + 7]);
                const bf16x8v pf = __builtin_bit_cast(bf16x8v, pw);
#pragma unroll
                for (int db = 0; db < 2; ++db) {
                    LAS3 const unsigned char* va = Vb + (32 * db + r) * AT_VROW + (32 * sub + 16 * s2 + 4 * hf) * 2;
                    const u32x2 v0 = *(LAS3 const u32x2*)va, v1 = *(LAS3 const u32x2*)(va + 16);
                    const bf16x8v vf = __builtin_bit_cast(bf16x8v, (u32x4){v0.x, v0.y, v1.x, v1.y});
                    O[db] = __builtin_amdgcn_mfma_f32_32x32x16_bf16(vf, pf, O[db], 0, 0, 0);
                }
            }
    }
}

template <int MODE, int PASS>
DI void at_branch(LAS3 unsigned char* lds, const AtSrc& src, int blk_lo, int blk_hi, const bf16x8v (&Q)[4], int tq, int tid, int kvh, LAS3 const float* lut,
                  unsigned mlo, unsigned mhi, float& m_run, float& l_run, f32x16 (&O)[2], float inv_l, LAS3 float* imp_row) {
    const int lane = tid & 63;
    u32x4 st[4];
    float bcarry = 0.f;
    at_load(src, blk_lo * 64, tid, st);
    for (int blk = blk_lo; blk <= blk_hi; ++blk) {
        LAS3 unsigned char* buf = lds + ((blk - blk_lo) & 1) * AT_BUF;
        at_store(buf, tid, st);
        __syncthreads();
        if (blk < blk_hi) at_load(src, (blk + 1) * 64, tid, st);
        bool blk_ok = true;
        if (MODE == 1) blk_ok = ((blk < 32 ? (mlo >> blk) : (mhi >> (blk - 32))) & 1u) != 0u;
        const int t0u = tq - (lane & 31);
        const bool farstep = MODE == 0 ? (t0u - 16 * (blk * 64 + 63) - 31 >= 128) : (MODE == 1 ? (t0u - blk * 64 - 63 >= 128) : (t0u - blk * 64 - 63 >= 128 && t0u + 31 - blk * 64 < 512));
        if (MODE != 1 || __any(blk_ok)) {
            at_step<MODE, PASS>(buf + kvh * AT_KT, buf + 2 * AT_KT + kvh * AT_VT, Q, blk * 64, tq, lane, lut, blk_ok, farstep, m_run, l_run, O, inv_l, imp_row, bcarry);
        }
    }
    __syncthreads();
}

DI void p3_attention(const Params& p, LAS3 unsigned char* lds, int G) {
    unsigned char* ws = p.ws;
    const int tid = threadIdx.x, lane = tid & 63, h = __builtin_amdgcn_readfirstlane(tid >> 6), kvh = h >> 2, r = lane & 31, hf = lane >> 5;
    LAS3 float* lutall = (LAS3 float*)(lds + AT_LUT);
    {
        const float* rel = p.in[I_REL];
        for (int i = tid; i < 1024; i += MK_THREADS) lutall[i] = rel[rel_bucket(i & 127) * NH + (i >> 7)] * LOG2E;
    }
    __syncthreads();
    LAS3 const float* lut = lutall + h * 128;
    LAS3 float* impw = (LAS3 float*)(lds + AT_IMP);
    LAS3 float* vals = (LAS3 float*)(lds + AT_VAL);
    LAS3 unsigned char* selb = lds + AT_SEL;
    LAS3 float* ssq = (LAS3 float*)(lds + AT_SSQ);
    const bf16_t* qb = (const bf16_t*)(ws + R_QB);
    const float* gates = (const float*)(ws + R_GATE);
    const float* gn = p.in[I_GN_ATTN];
    bf16_t* mixed = (bf16_t*)(ws + WS_XB);
    for (int ui = blockIdx.x; ui < 512; ui += G) {
        const int q8 = ui & 255, rnd = ui >> 8, b = q8 >> 6, j6 = q8 & 63, tb = rnd == 0 ? 127 - j6 : j6;
        const int t0 = 32 * tb, qb64 = tb >> 1, tq = t0 + r;
        const size_t tok = (size_t)b * T_ + tq;
        bf16x8v Q[4];
#pragma unroll
        for (int ks = 0; ks < 4; ++ks) Q[ks] = *(const bf16x8v*)(qb + tok * 512 + h * 64 + 16 * ks + 8 * hf);
        f32x16 O[2];
#pragma unroll
        for (int db = 0; db < 2; ++db)
#pragma unroll
            for (int i = 0; i < 16; ++i) O[db][i] = 0.f;
        LAS3 float* oslot = (LAS3 float*)(lds + AT_IMP) + h * 2048 + lane;
        const size_t bh0 = (size_t)b * 2, bh1 = bh0 + 1;
        {
            const bf16_t* kcb = (const bf16_t*)(ws + R_KCB); const bf16_t* vct = (const bf16_t*)(ws + R_VCT);
            const AtSrc src{kcb + bh0 * 256 * 64, kcb + bh1 * 256 * 64, vct + bh0 * 64 * 256, vct + bh1 * 64 * 256, 256};
            const int nst = tb / 32 + 1;
            float m_run = -INFINITY, l_run = 0.f;
            at_branch<0, 1>(lds, src, 0, nst - 1, Q, tq, tid, kvh, lut, 0u, 0u, m_run, l_run, O, 0.f, nullptr);
            const float l_tot = l_run + __shfl_xor(l_run, 32);
            const float inv_l = l_tot > 0.f ? 1.0f / l_tot : 0.f;
            float m_fix = (m_run == -INFINITY) ? 0.f : m_run;
            at_branch<0, 2>(lds, src, 0, nst - 1, Q, tq, tid, kvh, lut, 0u, 0u, m_fix, l_run, O, inv_l, impw + (h * 32 + r) * 65);
        }
        {
            const int row = tid >> 3, j8 = tid & 7, kr = row >> 5, tr = row & 31;
#pragma unroll
            for (int jj = 0; jj < 8; ++jj) {
                const int s = j8 * 8 + jj, db = qb64 - s;
                float v = 0.f;
#pragma unroll
                for (int g = 0; g < 4; ++g) v += impw[((kr * 4 + g) * 32 + tr) * 65 + s];
                vals[row * 65 + s] = (db >= 0 && db < 2) ? 2.0e4f : (s == 0 ? 1.0e4f : (db >= 0 ? v : -1.0f));
            }
            __syncthreads();
            unsigned bits = 0u;
            {
                float vv[8]; int rk[8];
#pragma unroll
                for (int jj = 0; jj < 8; ++jj) { vv[jj] = vals[row * 65 + j8 * 8 + jj]; rk[jj] = 0; }
#pragma unroll 2
                for (int s2 = 0; s2 < 64; ++s2) {
                    const float w = vals[row * 65 + s2];
#pragma unroll
                    for (int jj = 0; jj < 8; ++jj) rk[jj] += (w > vv[jj] || (w == vv[jj] && s2 < j8 * 8 + jj)) ? 1 : 0;
                }
#pragma unroll
                for (int jj = 0; jj < 8; ++jj) if (rk[jj] < 16 && qb64 - (j8 * 8 + jj) >= 0) bits |= 1u << jj;
            }
            selb[row * 8 + j8] = (unsigned char)bits;
            __syncthreads();
        }
        const unsigned mlo = *(LAS3 const unsigned*)(selb + (kvh * 32 + r) * 8), mhi = *(LAS3 const unsigned*)(selb + (kvh * 32 + r) * 8 + 4);
        __syncthreads();
        {
            const float g0 = sigmoidf_(gates[tok * 24 + h * 3 + 0]);
#pragma unroll
            for (int db = 0; db < 2; ++db)
#pragma unroll
                for (int i = 0; i < 16; ++i) { oslot[(db * 16 + i) * 64] = g0 * O[db][i]; O[db][i] = 0.f; }
        }
        {
            const bf16_t* ksb = (const bf16_t*)(ws + R_KS); const bf16_t* vst = (const bf16_t*)(ws + R_VST);
            const AtSrc src{ksb + bh0 * T_ * HD, ksb + bh1 * T_ * HD, vst + bh0 * HD * T_, vst + bh1 * HD * T_, T_};
            float m_run = -INFINITY, l_run = 0.f;
            at_branch<1, 0>(lds, src, 0, qb64, Q, tq, tid, kvh, lut, mlo, mhi, m_run, l_run, O, 0.f, nullptr);
            const float l_tot = l_run + __shfl_xor(l_run, 32), sc = sigmoidf_(gates[tok * 24 + h * 3 + 1]) / l_tot;
#pragma unroll
            for (int db = 0; db < 2; ++db)
#pragma unroll
                for (int i = 0; i < 16; ++i) { oslot[(db * 16 + i) * 64] += sc * O[db][i]; O[db][i] = 0.f; }
        }
        {
            const bf16_t* kwb = (const bf16_t*)(ws + R_KW); const bf16_t* vwt = (const bf16_t*)(ws + R_VWT);
            const AtSrc src{kwb + bh0 * T_ * HD, kwb + bh1 * T_ * HD, vwt + bh0 * HD * T_, vwt + bh1 * HD * T_, T_};
            int wb0 = (t0 - 511) >> 6; wb0 = wb0 < 0 ? 0 : wb0;
            float m_run = -INFINITY, l_run = 0.f;
            at_branch<2, 0>(lds, src, wb0, qb64, Q, tq, tid, kvh, lut, 0u, 0u, m_run, l_run, O, 0.f, nullptr);
            const float l_tot = l_run + __shfl_xor(l_run, 32), sc = sigmoidf_(gates[tok * 24 + h * 3 + 2]) / l_tot;
#pragma unroll
            for (int db = 0; db < 2; ++db)
#pragma unroll
                for (int i = 0; i < 16; ++i) O[db][i] = oslot[(db * 16 + i) * 64] + sc * O[db][i];
        }
        {
            float ss = 0.f;
#pragma unroll
            for (int db = 0; db < 2; ++db)
#pragma unroll
                for (int i = 0; i < 16; ++i) ss += O[db][i] * O[db][i];
            ss += __shfl_xor(ss, 32);
            if (hf == 0) ssq[h * 32 + r] = ss;
            __syncthreads();
            float tot = 0.f;
#pragma unroll
            for (int hh = 0; hh < 8; ++hh) tot += ssq[hh * 32 + r];
            const float rs = rsqrtf(tot * (1.0f / 512) + EPS);
#pragma unroll
            for (int db = 0; db < 2; ++db)
#pragma unroll
                for (int a = 0; a < 4; ++a) {
                    const int d = 32 * db + 8 * a + 4 * hf;
                    const f32x4 g4 = *(const f32x4*)(gn + h * 64 + d);
                    u32x2 w; w.x = pk_bf16(O[db][4 * a] * rs * g4[0], O[db][4 * a + 1] * rs * g4[1]); w.y = pk_bf16(O[db][4 * a + 2] * rs * g4[2], O[db][4 * a + 3] * rs * g4[3]);
                    *(u32x2*)(mixed + tok * DM + h * 64 + d) = w;
                }
            __syncthreads();
        }
    }
}
constexpr int LR_STRIDE = 516;
constexpr int LR_XC = 0, LR_A = 32 * LR_STRIDE * 4, LR_RS = 2 * 32 * LR_STRIDE * 4, LR_END = LR_RS + 256;
static_assert(LR_END <= 160 * 1024 - 256, "LRU LDS map");

template <bool FINAL>
DI void lru_phase(const Params& p, LAS3 unsigned char* lds, int G) {
    unsigned char* ws = p.ws;
    const int tid = threadIdx.x, lane = tid & 63, n = __builtin_amdgcn_readfirstlane(tid >> 6), r = lane & 31, hf = lane >> 5, ch = tid;
    LAS3 float* XC = (LAS3 float*)(lds + LR_XC); LAS3 float* AA = (LAS3 float*)(lds + LR_A); LAS3 float* RS = (LAS3 float*)(lds + LR_RS);
    const float* xr = (const float*)(ws + R_XR); const bf16_t* xg = (const bf16_t*)(ws + R_XG);
    float* sumP = (float*)(ws + WS_LRUP); float* sumH = (float*)(ws + WS_LRUH);
    bf16_t* mixed = (bf16_t*)(ws + WS_XB);
    const float cw0 = p.in[I_CONV_W][0 * 512 + ch], cw1 = p.in[I_CONV_W][1 * 512 + ch], cw2 = p.in[I_CONV_W][2 * 512 + ch], cw3 = p.in[I_CONV_W][3 * 512 + ch], cb = p.in[I_CONV_B][ch];
    const float gl = FINAL ? p.in[I_GN_LRU][ch] : 0.f;
    float ba[2], bx[2], sp[2];
#pragma unroll
    for (int nb = 0; nb < 2; ++nb) { const int c2 = n * 64 + 32 * nb + r; ba[nb] = p.in[I_LRU_BA][c2]; bx[nb] = p.in[I_LRU_BX][c2]; sp[nb] = log1pf(__expf(-p.in[I_LRU_LAM][c2])); }
    const bf16_t* waT = (const bf16_t*)(ws + WS_WAT); const bf16_t* wxT = (const bf16_t*)(ws + WS_WXT);
    for (int ci = blockIdx.x; ci < 256; ci += G) {
        const int b = ci >> 6, cib = ci & 63, t0 = cib * 64;
        const size_t tok0 = (size_t)b * T_ + t0;
        float x1 = 0.f, x2 = 0.f, x3 = 0.f;
        if (t0 > 0) { x1 = xr[(tok0 - 1) * 512 + ch]; x2 = xr[(tok0 - 2) * 512 + ch]; x3 = xr[(tok0 - 3) * 512 + ch]; }
        float hst = 0.f, pprod = 1.f;
        if (FINAL) {
            const float* Pp = sumP + (size_t)(b * 64) * 512 + ch; const float* Hp = sumH + (size_t)(b * 64) * 512 + ch;
            for (int k = 0; k < cib; ++k) hst = Pp[(size_t)k * 512] * hst + Hp[(size_t)k * 512];
        }
#pragma unroll 1
        for (int half = 0; half < 2; ++half) {
            const size_t tokh = tok0 + half * 32;
            __syncthreads();
            {
                float xv[32];
#pragma unroll
                for (int t = 0; t < 32; ++t) xv[t] = xr[(tokh + t) * 512 + ch];
#pragma unroll
                for (int t = 0; t < 32; ++t) {
                    const float x0 = xv[t];
                    XC[t * LR_STRIDE + ch] = cw0 * x3 + cw1 * x2 + cw2 * x1 + cw3 * x0 + cb;
                    x3 = x2; x2 = x1; x1 = x0;
                }
            }
            __syncthreads();
            {
                f32x16 ar[2], ai[2];
#pragma unroll
                for (int nb = 0; nb < 2; ++nb)
#pragma unroll
                    for (int i = 0; i < 16; ++i) { ar[nb][i] = 0.f; ai[nb][i] = 0.f; }
                bf16x8v Ba[2][4], Bx[2][4];
#pragma unroll
                for (int nb = 0; nb < 2; ++nb)
#pragma unroll
                    for (int ks = 0; ks < 4; ++ks) {
                        const size_t o = (size_t)(n * 64 + 32 * nb + r) * 64 + 16 * ks + 8 * hf;
                        Ba[nb][ks] = *(const bf16x8v*)(waT + o); Bx[nb][ks] = *(const bf16x8v*)(wxT + o);
                    }
#pragma unroll
                for (int ks = 0; ks < 4; ++ks) {
                    LAS3 const float* src = XC + r * LR_STRIDE + n * 64 + 16 * ks + 8 * hf;
                    const f32x4 f0 = *(LAS3 const f32x4*)src, f1 = *(LAS3 const f32x4*)(src + 4);
                    u32x4 pw; pw.x = pk_bf16(f0[0], f0[1]); pw.y = pk_bf16(f0[2], f0[3]); pw.z = pk_bf16(f1[0], f1[1]); pw.w = pk_bf16(f1[2], f1[3]);
                    const bf16x8v af = __builtin_bit_cast(bf16x8v, pw);
#pragma unroll
                    for (int nb = 0; nb < 2; ++nb) {
                        ar[nb] = __builtin_amdgcn_mfma_f32_32x32x16_bf16(af, Ba[nb][ks], ar[nb], 0, 0, 0);
                        ai[nb] = __builtin_amdgcn_mfma_f32_32x32x16_bf16(af, Bx[nb][ks], ai[nb], 0, 0, 0);
                    }
                }
                __syncthreads();
#pragma unroll
                for (int nb = 0; nb < 2; ++nb)
#pragma unroll
                    for (int i = 0; i < 16; ++i) {
                        const int t = (i & 3) + 8 * (i >> 2) + 4 * hf, o = t * LR_STRIDE + n * 64 + 32 * nb + r;
                        const float xcv = XC[o];
                        const float rg = sigmoidf_(ar[nb][i] + ba[nb]), ig = sigmoidf_(ai[nb][i] + bx[nb]);
                        const float log_a = -8.0f * rg * sp[nb];
                        AA[o] = __expf(log_a);
                        XC[o] = sqrtf(-expm1f(2.0f * log_a)) * (ig * xcv);
                    }
            }
            __syncthreads();
            if (!FINAL) {
#pragma unroll 8
                for (int t = 0; t < 32; ++t) { const float a = AA[t * LR_STRIDE + ch]; hst = a * hst + XC[t * LR_STRIDE + ch]; pprod *= a; }
            } else {
                {
                    bf16_t gv[32];
#pragma unroll
                    for (int t = 0; t < 32; ++t) gv[t] = xg[(tokh + t) * 512 + ch];
#pragma unroll
                    for (int t = 0; t < 32; ++t) {
                        hst = AA[t * LR_STRIDE + ch] * hst + XC[t * LR_STRIDE + ch];
                        XC[t * LR_STRIDE + ch] = hst * gelu_tanh(bf2f(gv[t]));
                    }
                }
                __syncthreads();
                {
                    const int t = tid >> 4, part = tid & 15;
                    float s = 0.f;
#pragma unroll 8
                    for (int j = 0; j < 32; ++j) { const float v = XC[t * LR_STRIDE + part + 16 * j]; s += v * v; }
                    s += __shfl_xor(s, 1); s += __shfl_xor(s, 2); s += __shfl_xor(s, 4); s += __shfl_xor(s, 8);
                    if (part == 0) RS[t] = rsqrtf(s * (1.0f / 512) + EPS);
                }
                __syncthreads();
#pragma unroll 8
                for (int t = 0; t < 32; ++t) mixed[(tokh + t) * DM + 512 + ch] = f2bf(XC[t * LR_STRIDE + ch] * RS[t] * gl);
            }
        }
        if (!FINAL) { sumP[(size_t)ci * 512 + ch] = pprod; sumH[(size_t)ci * 512 + ch] = hst; }
    }
    __syncthreads();
}
typedef float f32x4v __attribute__((ext_vector_type(4)));
constexpr int CM_IMG = 0;
constexpr int CM_HID = 36864;
constexpr int CM_END = CM_HID + 16 * 264 * 2;
DI void p2_compress(const Params& p, LAS3 unsigned char* lds, int G) {
    unsigned char* ws = p.ws;
    const int tid = threadIdx.x, lane = tid & 63, wid = __builtin_amdgcn_readfirstlane(tid >> 6), row = lane & 15, kg = lane >> 4;
    for (int u = blockIdx.x; u < 256; u += G) {
        const int kv = u >> 7, bh = (u >> 4) & 7, c0 = (u & 15) * 16;
        const bf16_t* src = (const bf16_t*)(ws + (kv ? R_VC : R_KC)) + ((size_t)bh * T_ + 16 * c0) * HD;
        const bf16_t* W1T = (const bf16_t*)(ws + (kv ? WS_CW1V : WS_CW1K));
        const float* cb = (const float*)(ws + (kv ? WS_CBV : WS_CBK));
        const bf16_t* W2T = (const bf16_t*)(ws + (kv ? WS_CW2V : WS_CW2K));
        __syncthreads();
        for (int i = tid; i < 272 * 8; i += MK_THREADS) { const int tau = i >> 3, cch = i & 7; *(LAS3 u32x4*)(lds + CM_IMG + tau * 128 + (tau >> 4) * 16 + cch * 16) = *(const u32x4*)(src + (size_t)tau * HD + cch * 8); }
        __syncthreads();
        f32x4v acc[2] = {{0.f, 0.f, 0.f, 0.f}, {0.f, 0.f, 0.f, 0.f}};
        const bf16_t* wb0 = W1T + (size_t)(wid * 32 + row) * 2048 + 8 * kg, * wb1 = wb0 + (size_t)16 * 2048;
#pragma unroll 8
        for (int ks = 0; ks < 64; ++ks) {
            const int tau = 16 * row + (ks >> 1);
            const bf16x8v a = *(LAS3 const bf16x8v*)(lds + CM_IMG + tau * 128 + (tau >> 4) * 16 + (32 * (ks & 1) + 8 * kg) * 2);
            const bf16x8v b0 = *(const bf16x8v*)(wb0 + 32 * ks), b1 = *(const bf16x8v*)(wb1 + 32 * ks);
            acc[0] = __builtin_amdgcn_mfma_f32_16x16x32_bf16(a, b0, acc[0], 0, 0, 0);
            acc[1] = __builtin_amdgcn_mfma_f32_16x16x32_bf16(a, b1, acc[1], 0, 0, 0);
        }
#pragma unroll
        for (int nb = 0; nb < 2; ++nb) {
            const int col = wid * 32 + 16 * nb + row; const float bias = cb[col];
#pragma unroll
            for (int i = 0; i < 4; ++i) *(LAS3 bf16_t*)(lds + CM_HID + ((4 * kg + i) * 264 + col) * 2) = f2bf(gelu_tanh(acc[nb][i] + bias));
        }
        __syncthreads();
        if (wid < 4) {
            f32x4v o = {0.f, 0.f, 0.f, 0.f};
#pragma unroll
            for (int ks = 0; ks < 8; ++ks) {
                const bf16x8v a = *(LAS3 const bf16x8v*)(lds + CM_HID + (row * 264 + 32 * ks + 8 * kg) * 2);
                const bf16x8v b = *(const bf16x8v*)(W2T + (size_t)(wid * 16 + row) * 256 + 32 * ks + 8 * kg);
                o = __builtin_amdgcn_mfma_f32_16x16x32_bf16(a, b, o, 0, 0, 0);
            }
            const int d = wid * 16 + row;
#pragma unroll
            for (int i = 0; i < 4; ++i) {
                const int c = c0 + 4 * kg + i; const float v = c < NCMP ? o[i] : 0.f;
                ((float*)(ws + (kv ? WS_VCMP : WS_KCMP)))[((size_t)bh * 256 + c) * 64 + d] = v;
                if (kv) ((bf16_t*)(ws + R_VCT))[((size_t)bh * 64 + d) * 256 + c] = f2bf(v);
                else    ((bf16_t*)(ws + R_KCB))[((size_t)bh * 256 + c) * 64 + d] = f2bf(v);
            }
        }
    }
    __syncthreads();
}
DI void p2_vtranspose(const Params& p, LAS3 unsigned char* lds, int G) {
    unsigned char* ws = p.ws;
    const int tid = threadIdx.x;
    LAS3 bf16_t* tl = (LAS3 bf16_t*)lds;
    for (int u = blockIdx.x; u < 1024; u += G) {
        const int which = u >> 9, bh = (u >> 6) & 7, tt = u & 63;
        const bf16_t* src = (const bf16_t*)(ws + (which ? R_VW : R_VS)) + ((size_t)bh * T_ + tt * 64) * HD;
        bf16_t* dst = (bf16_t*)(ws + (which ? R_VWT : R_VST)) + (size_t)bh * HD * T_ + tt * 64;
        __syncthreads();
        { const int tok = tid >> 3, seg = tid & 7; *(LAS3 u32x4*)(tl + tok * 72 + seg * 8) = *(const u32x4*)(src + (size_t)tok * HD + seg * 8); }
        __syncthreads();
        { const int d = tid >> 3, seg = tid & 7; u32x4 w;
          w.x = (unsigned)tl[(seg * 8 + 0) * 72 + d] | ((unsigned)tl[(seg * 8 + 1) * 72 + d] << 16); w.y = (unsigned)tl[(seg * 8 + 2) * 72 + d] | ((unsigned)tl[(seg * 8 + 3) * 72 + d] << 16);
          w.z = (unsigned)tl[(seg * 8 + 4) * 72 + d] | ((unsigned)tl[(seg * 8 + 5) * 72 + d] << 16); w.w = (unsigned)tl[(seg * 8 + 6) * 72 + d] | ((unsigned)tl[(seg * 8 + 7) * 72 + d] << 16);
          *(u32x4*)(dst + (size_t)d * T_ + seg * 8) = w; }
    }
    __syncthreads();
}
DI int ord_enc(float f) { const int u = __float_as_int(f); return u ^ ((u >> 31) & 0x7fffffff); }
DI float ord_dec(int o) { return __int_as_float(o ^ ((o >> 31) & 0x7fffffff)); }
#define PEER_CE_DESC(a, b) do { const int _hi = max((a), (b)), _lo = min((a), (b)); (a) = _hi; (b) = _lo; } while (0)
#define PEER_CE_ASC(a, b)  do { const int _hi = max((a), (b)), _lo = min((a), (b)); (a) = _lo; (b) = _hi; } while (0)
DI void sort16_desc(int (&x)[16]) {
#pragma unroll
    for (int k = 2; k <= 16; k <<= 1)
#pragma unroll
        for (int j = k >> 1; j > 0; j >>= 1)
#pragma unroll
            for (int i = 0; i < 16; ++i) { const int l = i ^ j; if (l > i) { if ((i & k) == 0) PEER_CE_DESC(x[i], x[l]); else PEER_CE_ASC(x[i], x[l]); } }
}
DI void merge16_desc(int (&a)[16], const int (&b)[16]) {
#pragma unroll
    for (int i = 0; i < 16; ++i) a[i] = max(a[i], b[15 - i]);
#pragma unroll
    for (int j = 8; j > 0; j >>= 1)
#pragma unroll
        for (int i = 0; i < 16; ++i) { const int l = i ^ j; if (l > i) PEER_CE_DESC(a[i], a[l]); }
}
constexpr int PR_KEYS = 0;
constexpr int PR_IDX = 512 * 68 * 4;
constexpr int PR_RS = PR_IDX + 128 * 32 * 4;
constexpr int PR_END = PR_RS + 1024;
static_assert(PR_END <= 160 * 1024 - 256, "PEER LDS map");

struct EpiPeerRoute {
    static constexpr bool PERM = true, AFTER_DRAIN = true;
    const float* ssq1; int* eout; float* gout; float* rs1out;
    DI void fused(const f32x4 (&acc)[2][2][4][2], const pg8::Unit& u, int wr, int wc, int fr, int fq, PG8_LAS unsigned char* lds, int wid, int lane) const {
        const int tid = wid * 64 + lane, head = u.pn;
        LAS3 int* KEYS = (LAS3 int*)(lds + PR_KEYS); LAS3 int* IDX = (LAS3 int*)(lds + PR_IDX); LAS3 float* RS = (LAS3 float*)(lds + PR_RS);
        if (tid < 256) { float s = 0.f; for (int j = 0; j < 16; ++j) s += ssq1[(size_t)j * NTOK + u.pm * 256 + tid]; RS[tid] = rsqrtf(s * (1.0f / DM) + EPS); if (u.pn == 0) rs1out[u.pm * 256 + tid] = RS[tid]; }
#pragma unroll 1
        for (int ai = 0; ai < 2; ++ai) {
            __syncthreads();
#pragma unroll
            for (int bj = 0; bj < 2; ++bj)
#pragma unroll
                for (int m = 0; m < 4; ++m)
#pragma unroll
                    for (int n = 0; n < 2; ++n) {
                        const int rl = 64 * wr + 16 * m + fr, kk0 = 32 * wc + 8 * fq + 4 * n, hl = ((rl * 2 + bj) * 2 + (kk0 >> 6));
                        const f32x4 v = ai == 0 ? acc[0][bj][m][n] : acc[1][bj][m][n];
                        u32x4 kq;
                        kq.x = (unsigned)((ord_enc(v[0]) & ~0x7f) | (127 - (kk0 + 0))); kq.y = (unsigned)((ord_enc(v[1]) & ~0x7f) | (127 - (kk0 + 1)));
                        kq.z = (unsigned)((ord_enc(v[2]) & ~0x7f) | (127 - (kk0 + 2))); kq.w = (unsigned)((ord_enc(v[3]) & ~0x7f) | (127 - (kk0 + 3)));
                        *(LAS3 u32x4*)(KEYS + hl * 68 + (kk0 & 63)) = kq;
                    }
            __syncthreads();
            int top[16];
            {
                LAS3 const int* src = KEYS + tid * 68;
                int t2[16];
#pragma unroll
                for (int q = 0; q < 4; ++q) { const u32x4 w = *(LAS3 const u32x4*)(src + 4 * q); top[4 * q] = (int)w.x; top[4 * q + 1] = (int)w.y; top[4 * q + 2] = (int)w.z; top[4 * q + 3] = (int)w.w; }
                sort16_desc(top);
#pragma unroll 1
                for (int g = 1; g < 4; ++g) {
#pragma unroll
                    for (int q = 0; q < 4; ++q) { const u32x4 w = *(LAS3 const u32x4*)(src + 16 * g + 4 * q); t2[4 * q] = (int)w.x; t2[4 * q + 1] = (int)w.y; t2[4 * q + 2] = (int)w.z; t2[4 * q + 3] = (int)w.w; }
                    sort16_desc(t2);
                    merge16_desc(top, t2);
                }
#pragma unroll
                for (int i = 0; i < 16; ++i) t2[i] = __shfl_xor(top[i], 1);
                merge16_desc(top, t2);
            }
            int s1[16], s2[16];
            {
                const bool isp1 = (lane & 2) != 0;
#pragma unroll
                for (int i = 0; i < 16; ++i) { const int o = __shfl_xor(top[i], 2); s1[i] = isp1 ? o : top[i]; s2[i] = isp1 ? top[i] : o; }
            }
            const int rl = tid >> 2, q4 = tid & 3;
#pragma unroll
            for (int kq = 0; kq < 4; ++kq) if (q4 == kq) {
#pragma unroll
                for (int j = 0; j < 4; ++j) { IDX[rl * 32 + 4 * kq + j] = 127 - (s1[4 * kq + j] & 0x7f); IDX[rl * 32 + 16 + 4 * kq + j] = 127 - (s2[4 * kq + j] & 0x7f); }
            }
            float v1[16], v2[16];
#pragma unroll
            for (int i = 0; i < 16; ++i) { v1[i] = ord_dec(s1[i] & ~0x7f); v2[i] = ord_dec(s2[i] & ~0x7f); }
            int best[16], grp[16];
            {
                int cnt = 0; bool first = true;
#pragma unroll
                for (int a = 0; a < 16; ++a)
#pragma unroll
                    for (int b = 0; b < 16; ++b) if ((a + 1) * (b + 1) <= 16) {
                        grp[cnt & 15] = (ord_enc(v1[a] + v2[b]) & ~0xff) | (255 - (16 * a + b));
                        ++cnt;
                        if ((cnt & 15) == 0) { sort16_desc(grp); if (first) {
#pragma unroll
                                for (int i = 0; i < 16; ++i) best[i] = grp[i];
                                first = false; } else merge16_desc(best, grp); }
                    }
#pragma unroll
                for (int i = 2; i < 16; ++i) grp[i] = (int)0x80000000;
                sort16_desc(grp); merge16_desc(best, grp);
            }
            __syncthreads();
            const float rs1 = RS[128 * ai + rl];
            float gsum = 0.f, gv[16]; int ev[16];
            const float mtop = ord_dec(best[0] & ~0xff) * rs1;
#pragma unroll
            for (int i = 0; i < 16; ++i) {
                const float sc = ord_dec(best[i] & ~0xff) * rs1; gv[i] = __expf(sc - mtop); gsum += gv[i];
                const int ab = 255 - (best[i] & 0xff);
                ev[i] = IDX[rl * 32 + (ab >> 4)] * 128 + IDX[rl * 32 + 16 + (ab & 15)];
            }
            const float ginv = 1.0f / gsum;
            const size_t tok = (size_t)u.pm * 256 + 128 * ai + rl;
#pragma unroll
            for (int kq = 0; kq < 4; ++kq) if (q4 == kq) {
                *(u32x4*)(eout + tok * 128 + head * 16 + 4 * kq) = (u32x4){(unsigned)ev[4 * kq], (unsigned)ev[4 * kq + 1], (unsigned)ev[4 * kq + 2], (unsigned)ev[4 * kq + 3]};
                *(f32x4*)(gout + tok * 128 + head * 16 + 4 * kq) = (f32x4){gv[4 * kq] * ginv, gv[4 * kq + 1] * ginv, gv[4 * kq + 2] * ginv, gv[4 * kq + 3] * ginv};
            }
        }
        __syncthreads();
    }
    DI void operator()(const f32x4 (&)[2][2][4][2], const pg8::Unit&, int, int, int, int) const {}
};
struct SliceOrder : pg8::StaticOrder {
    int slice;
    __device__ bool next(int i, pg8::Unit& u) const { if (i > 0) return false; return pg8::StaticOrder::next(slice, u); }
};
DI void p5_peer_route(const Params& p, LAS3 unsigned char* lds, int G) {
    unsigned char* ws = p.ws;
    pg8::Gemm g{(const bf16_t*)(ws + R_H1B), (const bf16_t*)(ws + WS_WQS), NTOK, 2048, DM};
    EpiPeerRoute E{(const float*)(ws + WS_SSQ1), (int*)(ws + R_EXP), (float*)(ws + R_GSM), (float*)(ws + WS_RS1)};
    const int nslice = (512 + G - 1) / G;
#pragma unroll 1
    for (int s = 0; s < nslice; ++s) {
        SliceOrder S; S.init(NTOK, 2048, G, (int)blockIdx.x); S.slice = s;
        pg8::gemm_phase<EpiPeerRoute, SliceOrder>(lds, g, S, E, nullptr);
        __syncthreads();
    }
}
DI void p6_peer_u(const Params& p, int G) {
    unsigned char* ws = p.ws;
    const int tid = threadIdx.x, lane = tid & 63, wid = tid >> 6, grp = blockIdx.x & 7, rank = blockIdx.x >> 3;
    const int nrank = (G - grp + 7) >> 3, wv = rank * 8 + wid, nwv = nrank * 8;
    const bf16_t* ub = (const bf16_t*)(ws + WS_UB); const bf16_t* hb = (const bf16_t*)(ws + R_H1B);
    const int* eidx = (const int*)(ws + R_EXP); const float* gsm = (const float*)(ws + R_GSM); const float* rs1v = (const float*)(ws + WS_RS1);
    float* coef = (float*)(ws + R_COEF);
#pragma unroll 1
    for (int sweep = 0; sweep < 2; ++sweep) {
        const int sel = grp + 8 * sweep;
#pragma unroll 1
        for (int tok = wv; tok < NTOK; tok += nwv) {
            const int ev0 = eidx[(size_t)tok * 128 + lane], ev1 = eidx[(size_t)tok * 128 + 64 + lane];
            unsigned long long m0 = __ballot((ev0 & 15) == sel), m1 = __ballot((ev1 & 15) == sel);
            if ((m0 | m1) == 0ull) continue;
            const float gv0 = gsm[(size_t)tok * 128 + lane], gv1 = gsm[(size_t)tok * 128 + 64 + lane];
            const u32x4 xa = *(const u32x4*)(hb + (size_t)tok * DM + lane * 8), xc = *(const u32x4*)(hb + (size_t)tok * DM + 512 + lane * 8);
            const float rs1 = rs1v[tok];
            while ((m0 | m1) != 0ull) {
                int jj[8]; int ee[8]; float gg[8]; int nv = 0;
#pragma unroll
                for (int k = 0; k < 8; ++k) {
                    int j = k > 0 ? jj[k - 1] : 0; int e = k > 0 ? ee[k - 1] : 0; float g = k > 0 ? gg[k - 1] : 0.f;
                    if (m0 != 0ull) { const int b = __builtin_ctzll(m0); m0 &= m0 - 1ull; j = b; e = __builtin_amdgcn_readlane(ev0, b); g = __uint_as_float(__builtin_amdgcn_readlane(__float_as_uint(gv0), b)); nv = k + 1; }
                    else if (m1 != 0ull) { const int b = __builtin_ctzll(m1); m1 &= m1 - 1ull; j = 64 + b; e = __builtin_amdgcn_readlane(ev1, b); g = __uint_as_float(__builtin_amdgcn_readlane(__float_as_uint(gv1), b)); nv = k + 1; }
                    jj[k] = j; ee[k] = e; gg[k] = g;
                }
                float part[8];
#pragma unroll
                for (int k = 0; k < 8; ++k) {
                    const bf16_t* ur = ub + (size_t)ee[k] * DM + lane * 8;
                    const u32x4 ua = *(const u32x4*)ur, uc = *(const u32x4*)(ur + 512);
                    float a = dot2bf(xa.x, ua.x, 0.f); a = dot2bf(xa.y, ua.y, a); a = dot2bf(xa.z, ua.z, a); a = dot2bf(xa.w, ua.w, a);
                    a = dot2bf(xc.x, uc.x, a); a = dot2bf(xc.y, uc.y, a); a = dot2bf(xc.z, uc.z, a); a = dot2bf(xc.w, uc.w, a);
                    part[k] = a;
                }
#pragma unroll
                for (int m = 4; m >= 1; m >>= 1) {
                    const bool up = (lane & (8 * m)) != 0;
#pragma unroll
                    for (int i = 0; i < m; ++i) { const float send = up ? part[i] : part[i + m], keep = up ? part[i + m] : part[i]; part[i] = keep + __shfl_xor(send, 8 * m); }
                }
                float tot = part[0];
                tot += __shfl_xor(tot, 4); tot += __shfl_xor(tot, 2); tot += __shfl_xor(tot, 1);
                const int kk = lane >> 3;
                int myj = jj[0]; float myg = gg[0];
#pragma unroll
                for (int k = 1; k < 8; ++k) { myj = kk == k ? jj[k] : myj; myg = kk == k ? gg[k] : myg; }
                if ((lane & 7) == 0 && kk < nv) coef[(size_t)tok * 128 + myj] = myg * gelu_tanh(tot * rs1);
            }
        }
    }
}
DI void p6_peer_v(const Params& p, int G) {
    unsigned char* ws = p.ws;
    const int tid = threadIdx.x, lane = tid & 63, wid = tid >> 6, grp = blockIdx.x & 7, rank = blockIdx.x >> 3;
    const int nrank = (G - grp + 7) >> 3, wv = rank * 8 + wid, nwv = nrank * 8;
    const bf16_t* vb = (const bf16_t*)(ws + WS_VB);
    const int* eidx = (const int*)(ws + R_EXP); const float* coef = (const float*)(ws + R_COEF);
    float* h = p.out; bf16_t* hb = (bf16_t*)(ws + R_H1B); float* ssq2 = (float*)(ws + WS_SSQ2);
    const int sub = lane >> 3, c8 = (lane & 7) * 8;
#pragma unroll 1
    for (int sweep = 0; sweep < 2; ++sweep) {
        const int slice = grp + 8 * sweep, col0 = slice * 64 + c8;
#pragma unroll 1
        for (int tok = wv; tok < NTOK; tok += nwv) {
            const int ev0 = eidx[(size_t)tok * 128 + lane], ev1 = eidx[(size_t)tok * 128 + 64 + lane];
            const float cv0 = coef[(size_t)tok * 128 + lane], cv1 = coef[(size_t)tok * 128 + 64 + lane];
            u32x4 vr[16]; float cf[16];
#pragma unroll
            for (int i = 0; i < 16; ++i) {
                const int j = 8 * i + sub;
                const int e = __shfl(i < 8 ? ev0 : ev1, j & 63); cf[i] = __shfl(i < 8 ? cv0 : cv1, j & 63);
                vr[i] = *(const u32x4*)(vb + (size_t)e * DM + col0);
            }
            float acc[8];
#pragma unroll
            for (int q = 0; q < 8; ++q) acc[q] = 0.f;
#pragma unroll
            for (int i = 0; i < 16; ++i) {
                const float c = cf[i];
                acc[0] += c * bflo(vr[i].x); acc[1] += c * bfhi(vr[i].x); acc[2] += c * bflo(vr[i].y); acc[3] += c * bfhi(vr[i].y);
                acc[4] += c * bflo(vr[i].z); acc[5] += c * bfhi(vr[i].z); acc[6] += c * bflo(vr[i].w); acc[7] += c * bfhi(vr[i].w);
            }
#pragma unroll
            for (int q = 0; q < 8; ++q) { acc[q] += __shfl_xor(acc[q], 8); acc[q] += __shfl_xor(acc[q], 16); acc[q] += __shfl_xor(acc[q], 32); }
            float ss = 0.f;
            if (lane < 8) {
                float* hr = h + (size_t)tok * DM + col0;
                f32x4 h0 = *(f32x4*)hr, h1 = *(f32x4*)(hr + 4);
                h0 += (f32x4){acc[0], acc[1], acc[2], acc[3]}; h1 += (f32x4){acc[4], acc[5], acc[6], acc[7]};
                *(f32x4*)hr = h0; *(f32x4*)(hr + 4) = h1;
                u32x4 w; w.x = pk_bf16(h0[0], h0[1]); w.y = pk_bf16(h0[2], h0[3]); w.z = pk_bf16(h1[0], h1[1]); w.w = pk_bf16(h1[2], h1[3]);
                *(u32x4*)(hb + (size_t)tok * DM + col0) = w;
                ss = (h0[0] * h0[0] + h0[1] * h0[1]) + (h0[2] * h0[2] + h0[3] * h0[3]) + (h1[0] * h1[0] + h1[1] * h1[1]) + (h1[2] * h1[2] + h1[3] * h1[3]);
            }
            ss += __shfl_xor(ss, 1); ss += __shfl_xor(ss, 2); ss += __shfl_xor(ss, 4);
            if (lane == 0) ssq2[(size_t)slice * NTOK + tok] = ss;
        }
    }
}
#if PEER_FP4
constexpr float U8_SCALE = 64.0f, V8_SCALE = 6.0f;
#else
constexpr float U8_SCALE = 32.0f, V8_SCALE = 8.0f;
#endif
constexpr int LDS_MISC_OFF = 160 * 1024 - 256;
DI void fp8x16_to_f32(const u32x4 w, float (&f)[16]) {
#pragma unroll
    for (int q = 0; q < 4; ++q) {
        const f32x2 lo = __builtin_amdgcn_cvt_pk_f32_fp8((int)w[q], false), hi = __builtin_amdgcn_cvt_pk_f32_fp8((int)w[q], true);
        f[4 * q] = lo.x; f[4 * q + 1] = lo.y; f[4 * q + 2] = hi.x; f[4 * q + 3] = hi.y;
    }
}
struct Pu5Fixed { int ev0, ev1; float gv0, gv1; u32x4 xa, xb; float rs1; };
DI void pu5_load_fixed(Pu5Fixed& f, int tok, int lane, const int* eidx, const float* gsm, const bf16_t* hb, const float* rs1v) {
    f.ev0 = eidx[(size_t)tok * 128 + lane]; f.ev1 = eidx[(size_t)tok * 128 + 64 + lane];
    f.gv0 = gsm[(size_t)tok * 128 + lane]; f.gv1 = gsm[(size_t)tok * 128 + 64 + lane];
    f.xa = *(const u32x4*)(hb + (size_t)tok * DM + lane * 16); f.xb = *(const u32x4*)(hb + (size_t)tok * DM + lane * 16 + 8);
    f.rs1 = rs1v[tok];
}
DI int pu5_setup(const Pu5Fixed& f, int sel, int lane, LAS3 unsigned* ent) {
    const bool s0 = (f.ev0 & 15) == sel, s1 = (f.ev1 & 15) == sel;
    const unsigned long long b0 = __ballot(s0), b1 = __ballot(s1);
    const int c0 = __builtin_popcountll(b0), cnt = c0 + __builtin_popcountll(b1);
    const unsigned long long lt = (1ull << lane) - 1ull;
    const int r0 = __builtin_popcountll(b0 & lt), r1 = c0 + __builtin_popcountll(b1 & lt);
    if (s0) { ent[r0] = (unsigned)f.ev0 | ((unsigned)lane << 16); ent[128 + r0] = __float_as_uint(f.gv0); }
    if (s1) { ent[r1] = (unsigned)f.ev1 | ((unsigned)(64 + lane) << 16); ent[128 + r1] = __float_as_uint(f.gv1); }
    return cnt;
}
#define PU5_ISSUE(SET, ENT, CNT) do { \
        _Pragma("unroll") for (int q = 0; q < 4; ++q) { const u32x4 e4 = *(LAS3 const u32x4*)((ENT) + 4 * q); \
            _Pragma("unroll") for (int k2 = 0; k2 < 4; ++k2) { const int k = 4 * q + k2; \
                const unsigned off = k < (CNT) ? ((e4[k2] & 0x3fffu) * (unsigned)DM) + lane * 16 : 0x80000000u; \
                SET[k] = __builtin_amdgcn_raw_buffer_load_b128(urs, off, 0, 0); } } } while (0)
#define PU5_CONSUME(SET, ENT, CNT, TOK, RS) do { \
        float part[16]; \
        _Pragma("unroll") for (int k = 0; k < 16; ++k) { float a = 0.f; \
            if (k < (CNT)) { f32x2 a2 = {0.f, 0.f}; \
                _Pragma("unroll") for (int q = 0; q < 4; ++q) { \
                    a2 = __builtin_elementwise_fma(__builtin_amdgcn_cvt_pk_f32_fp8((int)SET[k][q], false), xp[2 * q], a2); \
                    a2 = __builtin_elementwise_fma(__builtin_amdgcn_cvt_pk_f32_fp8((int)SET[k][q], true), xp[2 * q + 1], a2); } \
                a = a2.x + a2.y; } \
            part[k] = a; } \
        _Pragma("unroll") for (int m = 8; m >= 1; m >>= 1) { const bool up = (lane & (4 * m)) != 0; \
            _Pragma("unroll") for (int i = 0; i < m; ++i) { const float send = up ? part[i] : part[i + m], keep = up ? part[i + m] : part[i]; part[i] = keep + __shfl_xor(send, 4 * m); } } \
        float tot = part[0]; tot += __shfl_xor(tot, 2); tot += __shfl_xor(tot, 1); \
        const int kk = lane >> 2; const unsigned ew = (ENT)[kk]; const float gw = __uint_as_float((ENT)[128 + kk]); \
        if ((lane & 3) == 0 && kk < (CNT)) coef[(size_t)(TOK) * 128 + (ew >> 16)] = gw * (1.0f / V8_SCALE) * gelu_tanh(tot * ((RS) * (1.0f / U8_SCALE))); \
        if ((CNT) > 16) {   \
            for (int base = 16; base < (CNT); base += 16) { u32x4 rx[16]; \
                _Pragma("unroll") for (int k = 0; k < 16; ++k) { const unsigned e1 = (ENT)[base + k]; \
                    rx[k] = __builtin_amdgcn_raw_buffer_load_b128(urs, base + k < (CNT) ? ((e1 & 0x3fffu) * (unsigned)DM) + lane * 16 : 0x80000000u, 0, 0); } \
                float pr[16]; \
                _Pragma("unroll") for (int k = 0; k < 16; ++k) { f32x2 a2 = {0.f, 0.f}; \
                    _Pragma("unroll") for (int q = 0; q < 4; ++q) { \
                        a2 = __builtin_elementwise_fma(__builtin_amdgcn_cvt_pk_f32_fp8((int)rx[k][q], false), xp[2 * q], a2); \
                        a2 = __builtin_elementwise_fma(__builtin_amdgcn_cvt_pk_f32_fp8((int)rx[k][q], true), xp[2 * q + 1], a2); } \
                    pr[k] = a2.x + a2.y; } \
                _Pragma("unroll") for (int m = 8; m >= 1; m >>= 1) { const bool up = (lane & (4 * m)) != 0; \
                    _Pragma("unroll") for (int i = 0; i < m; ++i) { const float send = up ? pr[i] : pr[i + m], keep = up ? pr[i + m] : pr[i]; pr[i] = keep + __shfl_xor(send, 4 * m); } } \
                float t2 = pr[0]; t2 += __shfl_xor(t2, 2); t2 += __shfl_xor(t2, 1); \
                const int k3 = base + (lane >> 2); const unsigned ew2 = (ENT)[k3 & 127]; const float gw2 = __uint_as_float((ENT)[128 + (k3 & 127)]); \
                if ((lane & 3) == 0 && k3 < (CNT)) coef[(size_t)(TOK) * 128 + (ew2 >> 16)] = gw2 * (1.0f / V8_SCALE) * gelu_tanh(t2 * ((RS) * (1.0f / U8_SCALE))); } } } while (0)
#define PU5_UNPACK(F) do { _Pragma("unroll") for (int q = 0; q < 4; ++q) { xp[q] = (f32x2){bflo((F).xa[q]), bfhi((F).xa[q])}; xp[4 + q] = (f32x2){bflo((F).xb[q]), bfhi((F).xb[q])}; } } while (0)
DI void p6v5_u(const Params& p, LAS3 unsigned char* lds, int G) {
    unsigned char* ws = p.ws;
    const int tid = threadIdx.x, lane = tid & 63, wid = tid >> 6, grp = blockIdx.x & 7, rank = blockIdx.x >> 3;
    const int nrank = (G - grp + 7) >> 3, wv = rank * 8 + wid, nwv = nrank * 8;
    const unsigned char* u8 = (const unsigned char*)(ws + WS_UB); const bf16_t* hb = (const bf16_t*)(ws + R_H1B);
    const int* eidx = (const int*)(ws + R_EXP); const float* gsm = (const float*)(ws + R_GSM); const float* rs1v = (const float*)(ws + WS_RS1);
    float* coef = (float*)(ws + R_COEF);
    LAS3 unsigned* entA = (LAS3 unsigned*)(lds + wid * 2048); LAS3 unsigned* entB = entA + 256;
    if (wv >= NTOK) return;
    const __amdgpu_buffer_rsrc_t urs = __builtin_amdgcn_make_buffer_rsrc((void*)u8, 0, 16384 * DM, 0x00020000);
    const int nvis = (NTOK - wv + nwv - 1) / nwv, NV = 2 * nvis;
#define PU5_TOK(V) (wv + (((V) < NV ? (V) : NV - 1) % nvis) * nwv)
#define PU5_SEL(V) (grp + 8 * (((V) < NV ? (V) : NV - 1) / nvis))
    Pu5Fixed f1, f2;
    pu5_load_fixed(f1, PU5_TOK(0), lane, eidx, gsm, hb, rs1v);
    u32x4 sa[16], sb[16];
    f32x2 xp[8];
    int cntA = pu5_setup(f1, PU5_SEL(0), lane, entA), cntB = 0;
    PU5_ISSUE(sa, entA, cntA);
    int tokA = PU5_TOK(0), tokB = 0; float rsA = f1.rs1, rsB = 0.f;
    PU5_UNPACK(f1);
    pu5_load_fixed(f1, PU5_TOK(1), lane, eidx, gsm, hb, rs1v);
#pragma unroll 1
    for (int v = 0; v < NV; v += 2) {
        pu5_load_fixed(f2, PU5_TOK(v + 2), lane, eidx, gsm, hb, rs1v);
        cntB = pu5_setup(f1, PU5_SEL(v + 1), lane, entB); if (v + 1 >= NV) cntB = 0;
        PU5_ISSUE(sb, entB, cntB);
        tokB = PU5_TOK(v + 1); rsB = f1.rs1;
        PU5_CONSUME(sa, entA, cntA, tokA, rsA);
        PU5_UNPACK(f1);
        f1 = f2;
        pu5_load_fixed(f2, PU5_TOK(v + 3), lane, eidx, gsm, hb, rs1v);
        cntA = pu5_setup(f1, PU5_SEL(v + 2), lane, entA); if (v + 2 >= NV) cntA = 0;
        PU5_ISSUE(sa, entA, cntA);
        tokA = PU5_TOK(v + 2); rsA = f1.rs1;
        PU5_CONSUME(sb, entB, cntB, tokB, rsB);
        PU5_UNPACK(f1);
        f1 = f2;
    }
#undef PU5_TOK
#undef PU5_SEL
}
#undef PU5_ISSUE
#undef PU5_CONSUME
#undef PU5_UNPACK
template <int PMODE> DI void p6v3_v(const Params& p, int G) {
    unsigned char* ws = p.ws;
    const int tid = threadIdx.x, lane = tid & 63, wid = tid >> 6;
#if XCC_HW
    volatile LAS3 unsigned* miscw = (volatile LAS3 unsigned*)((LAS3 unsigned char*)0 + LDS_MISC_OFF);
    const int grp = (int)miscw[16], rank = (int)miscw[17];
    const int nrank = (int)__hip_atomic_load((unsigned*)(ws + WS_CTL + 16384) + grp * 16, __ATOMIC_RELAXED, __HIP_MEMORY_SCOPE_AGENT);
#else
    const int grp = blockIdx.x & 7, rank = blockIdx.x >> 3;
    const int nrank = (G - grp + 7) >> 3;
#endif
    const int wv = rank * 8 + wid, nwv = nrank * 8;
    const unsigned char* v8 = (const unsigned char*)(ws + WS_VB);
    const int* eidx = (const int*)(ws + R_EXP); const float* coef = (const float*)(ws + R_COEF);
    float* h = PMODE == 0 ? p.out : (float*)(ws + R_BIG); bf16_t* hb = PMODE == 0 ? (bf16_t*)(ws + R_H1B) : (bf16_t*)(ws + WS_XB); float* ssq2 = PMODE == 0 ? (float*)(ws + WS_SSQ2) : (float*)(ws + WS_SSQ3);
    const int sub = lane >> 3, col0 = grp * 128 + (lane & 7) * 16;
    if (wv >= NTOK) return;
    const int nvis = (NTOK - wv + nwv - 1) / nwv;
#define PV_LOADIDX(T, EV0, EV1, CV0, CV1) do { EV0 = eidx[(size_t)(T) * 128 + lane]; EV1 = eidx[(size_t)(T) * 128 + 64 + lane]; CV0 = coef[(size_t)(T) * 128 + lane]; CV1 = coef[(size_t)(T) * 128 + 64 + lane]; } while (0)
#define PV_ISSUE8(R, EV) do { _Pragma("unroll") for (int i = 0; i < 8; ++i) { const int e = __shfl((EV), 8 * i + sub); R[i] = *(const u32x4*)(v8 + (unsigned)(e * DM + col0)); } } while (0)
#define PV_CONS8(R, CV) do { _Pragma("unroll") for (int i = 0; i < 8; ++i) { float f[16]; fp8x16_to_f32(R[i], f); const float c = __shfl((CV), 8 * i + sub); \
            _Pragma("unroll") for (int q = 0; q < 16; ++q) acc[q] += c * f[q]; } } while (0)
    u32x4 ra[8], rb[8];
    int e0, e1, n0, n1, x0, x1; float c0, c1, d0, d1, y0, y1;
    PV_LOADIDX(wv, e0, e1, c0, c1);
    { const int t1 = nvis > 1 ? wv + nwv : wv; PV_LOADIDX(t1, n0, n1, d0, d1); }
    PV_ISSUE8(ra, e0); PV_ISSUE8(rb, e1);
#pragma unroll 1
    for (int it = 0; it < nvis; ++it) {
        const int tok = wv + it * nwv;
        const int t2 = wv + (it + 2 < nvis ? it + 2 : nvis - 1) * nwv;
        float* hr = h + (size_t)tok * DM + col0;
        const f32x4 hv0 = *(const f32x4*)hr, hv1 = *(const f32x4*)(hr + 4), hv2 = *(const f32x4*)(hr + 8), hv3 = *(const f32x4*)(hr + 12);
        PV_LOADIDX(t2, x0, x1, y0, y1);
        float acc[16];
#pragma unroll
        for (int q = 0; q < 16; ++q) acc[q] = 0.f;
        PV_CONS8(ra, c0);
        PV_ISSUE8(ra, n0);
        PV_CONS8(rb, c1);
        PV_ISSUE8(rb, n1);
#pragma unroll
        for (int q = 0; q < 16; ++q) { acc[q] += __shfl_xor(acc[q], 8); acc[q] += __shfl_xor(acc[q], 16); acc[q] += __shfl_xor(acc[q], 32); }
        float ss = 0.f;
        if (lane < 8) {
            const f32x4 o0 = hv0 + (f32x4){acc[0], acc[1], acc[2], acc[3]}, o1 = hv1 + (f32x4){acc[4], acc[5], acc[6], acc[7]};
            const f32x4 o2 = hv2 + (f32x4){acc[8], acc[9], acc[10], acc[11]}, o3 = hv3 + (f32x4){acc[12], acc[13], acc[14], acc[15]};
            *(f32x4*)hr = o0; *(f32x4*)(hr + 4) = o1; *(f32x4*)(hr + 8) = o2; *(f32x4*)(hr + 12) = o3;
            u32x4 w0, w1;
            w0.x = pk_bf16(o0[0], o0[1]); w0.y = pk_bf16(o0[2], o0[3]); w0.z = pk_bf16(o1[0], o1[1]); w0.w = pk_bf16(o1[2], o1[3]);
            w1.x = pk_bf16(o2[0], o2[1]); w1.y = pk_bf16(o2[2], o2[3]); w1.z = pk_bf16(o3[0], o3[1]); w1.w = pk_bf16(o3[2], o3[3]);
            *(u32x4*)(hb + (size_t)tok * DM + col0) = w0; *(u32x4*)(hb + (size_t)tok * DM + col0 + 8) = w1;
#pragma unroll
            for (int j = 0; j < 4; ++j) ss += o0[j] * o0[j] + o1[j] * o1[j] + o2[j] * o2[j] + o3[j] * o3[j];
        }
        ss += __shfl_xor(ss, 1); ss += __shfl_xor(ss, 2); ss += __shfl_xor(ss, 4);
        if (lane == 0) ssq2[(size_t)grp * NTOK + tok] = ss;
        e0 = n0; e1 = n1; c0 = d0; c1 = d1; n0 = x0; n1 = x1; d0 = y0; d1 = y1;
    }
#undef PV_LOADIDX
#undef PV_ISSUE8
#undef PV_CONS8
}
DI void p6v6_peer(const Params& p, int G) {
    unsigned char* ws = p.ws;
    const int tid = threadIdx.x, lane = tid & 63, wid = tid >> 6;
    const int gw = blockIdx.x * 8 + wid, nw = G * 8;
    const unsigned char* u8 = (const unsigned char*)(ws + WS_UB); const unsigned char* v8 = (const unsigned char*)(ws + WS_VB);
    const int* eidx = (const int*)(ws + R_EXP); const float* gsm = (const float*)(ws + R_GSM); const float* rs1v = (const float*)(ws + WS_RS1);
    float* h = p.out; bf16_t* hb = (bf16_t*)(ws + R_H1B); float* rs2 = (float*)(ws + WS_RS2);
#pragma unroll 1
    for (int tok = gw; tok < NTOK; tok += nw) {
        const float rs1 = rs1v[tok] * (1.0f / U8_SCALE);
        const u32x4 xa = *(const u32x4*)(hb + (size_t)tok * DM + lane * 16), xb = *(const u32x4*)(hb + (size_t)tok * DM + lane * 16 + 8);
        f32x2 xp[8];
#pragma unroll
        for (int q = 0; q < 4; ++q) { xp[q] = (f32x2){bflo(xa[q]), bfhi(xa[q])}; xp[4 + q] = (f32x2){bflo(xb[q]), bfhi(xb[q])}; }
        const int e0 = eidx[(size_t)tok * 128 + lane], e1 = eidx[(size_t)tok * 128 + 64 + lane];
        const float g0 = gsm[(size_t)tok * 128 + lane], g1 = gsm[(size_t)tok * 128 + 64 + lane];
        float coef0 = 0.f, coef1 = 0.f;
#pragma unroll
        for (int half = 0; half < 2; ++half) {
            const int ev = half ? e1 : e0;
            float part[64];
#pragma unroll
            for (int j = 0; j < 64; ++j) {
                const int e = __builtin_amdgcn_readlane(ev, j);
                const u32x4 w = *(const u32x4*)(u8 + (size_t)e * DM + lane * 16);
                f32x2 a2 = {0.f, 0.f};
#pragma unroll
                for (int q = 0; q < 4; ++q) {
                    a2 = __builtin_elementwise_fma(__builtin_amdgcn_cvt_pk_f32_fp8((int)w[q], false), xp[2 * q], a2);
                    a2 = __builtin_elementwise_fma(__builtin_amdgcn_cvt_pk_f32_fp8((int)w[q], true), xp[2 * q + 1], a2);
                }
                part[j] = a2.x + a2.y;
            }
#pragma unroll
            for (int m = 32; m >= 1; m >>= 1) {
                const bool up = (lane & m) != 0;
#pragma unroll
                for (int i = 0; i < m; ++i) { const float send = up ? part[i] : part[i + m], keep = up ? part[i + m] : part[i]; part[i] = keep + __shfl_xor(send, m); }
            }
            const float act = gelu_tanh(part[0] * rs1);
            if (half) coef1 = g1 * act * (1.0f / V8_SCALE); else coef0 = g0 * act * (1.0f / V8_SCALE);
        }
        f32x2 acc[8];
#pragma unroll
        for (int i = 0; i < 8; ++i) acc[i] = (f32x2){0.f, 0.f};
#pragma unroll
        for (int half = 0; half < 2; ++half) {
            const int ev = half ? e1 : e0; const float cv = half ? coef1 : coef0;
#pragma unroll 16
            for (int j = 0; j < 64; ++j) {
                const int e = __builtin_amdgcn_readlane(ev, j);
                const float c = __uint_as_float(__builtin_amdgcn_readlane(__float_as_uint(cv), j));
                const u32x4 w = *(const u32x4*)(v8 + (size_t)e * DM + lane * 16);
                const f32x2 c2 = {c, c};
#pragma unroll
                for (int q = 0; q < 4; ++q) {
                    acc[2 * q] = __builtin_elementwise_fma(__builtin_amdgcn_cvt_pk_f32_fp8((int)w[q], false), c2, acc[2 * q]);
                    acc[2 * q + 1] = __builtin_elementwise_fma(__builtin_amdgcn_cvt_pk_f32_fp8((int)w[q], true), c2, acc[2 * q + 1]);
                }
            }
        }
        float* hr = h + (size_t)tok * DM + lane * 16;
        u32x4 w0, w1; float ss = 0.f;
#pragma unroll
        for (int q4 = 0; q4 < 4; ++q4) {
            f32x4 hv = *(f32x4*)(hr + 4 * q4);
            hv += (f32x4){acc[2 * q4].x, acc[2 * q4].y, acc[2 * q4 + 1].x, acc[2 * q4 + 1].y};
            *(f32x4*)(hr + 4 * q4) = hv;
            ss += (hv[0] * hv[0] + hv[1] * hv[1]) + (hv[2] * hv[2] + hv[3] * hv[3]);
            const unsigned a_ = pk_bf16(hv[0], hv[1]), b_ = pk_bf16(hv[2], hv[3]);
            if (q4 == 0) { w0.x = a_; w0.y = b_; } else if (q4 == 1) { w0.z = a_; w0.w = b_; } else if (q4 == 2) { w1.x = a_; w1.y = b_; } else { w1.z = a_; w1.w = b_; }
        }
        *(u32x4*)(hb + (size_t)tok * DM + lane * 16) = w0; *(u32x4*)(hb + (size_t)tok * DM + lane * 16 + 8) = w1;
        ss = wave_sum(ss);
        if (lane == 0) rs2[tok] = rsqrtf(ss * (1.0f / DM) + EPS);
    }
}
DI void p6v6_u(const Params& p, int G) {
    unsigned char* ws = p.ws;
    const int tid = threadIdx.x, lane = tid & 63, wid = tid >> 6;
    const int gw = blockIdx.x * 8 + wid, nw = G * 8;
    const unsigned char* u8 = (const unsigned char*)(ws + WS_UB); const unsigned char* v8 = (const unsigned char*)(ws + WS_VB);
    const int* eidx = (const int*)(ws + R_EXP); const float* gsm = (const float*)(ws + R_GSM); const float* rs1v = (const float*)(ws + WS_RS1);
    float* h = p.out; bf16_t* hb = (bf16_t*)(ws + R_H1B); float* rs2 = (float*)(ws + WS_RS2);
#pragma unroll 1
    for (int tok = gw; tok < NTOK; tok += nw) {
        const float rs1 = rs1v[tok] * (1.0f / U8_SCALE);
        const u32x4 xa = *(const u32x4*)(hb + (size_t)tok * DM + lane * 16), xb = *(const u32x4*)(hb + (size_t)tok * DM + lane * 16 + 8);
        f32x2 xp[8];
#pragma unroll
        for (int q = 0; q < 4; ++q) { xp[q] = (f32x2){bflo(xa[q]), bfhi(xa[q])}; xp[4 + q] = (f32x2){bflo(xb[q]), bfhi(xb[q])}; }
        const int e0 = eidx[(size_t)tok * 128 + lane], e1 = eidx[(size_t)tok * 128 + 64 + lane];
        const float g0 = gsm[(size_t)tok * 128 + lane], g1 = gsm[(size_t)tok * 128 + 64 + lane];
        float coef0 = 0.f, coef1 = 0.f;
#pragma unroll
        for (int half = 0; half < 2; ++half) {
            const int ev = half ? e1 : e0;
            float part[64];
#pragma unroll
            for (int j = 0; j < 64; ++j) {
                const int e = __builtin_amdgcn_readlane(ev, j);
                const u32x4 w = *(const u32x4*)(u8 + (size_t)e * DM + lane * 16);
                f32x2 a2 = {0.f, 0.f};
#pragma unroll
                for (int q = 0; q < 4; ++q) {
                    a2 = __builtin_elementwise_fma(__builtin_amdgcn_cvt_pk_f32_fp8((int)w[q], false), xp[2 * q], a2);
                    a2 = __builtin_elementwise_fma(__builtin_amdgcn_cvt_pk_f32_fp8((int)w[q], true), xp[2 * q + 1], a2);
                }
                part[j] = a2.x + a2.y;
            }
#pragma unroll
            for (int m = 32; m >= 1; m >>= 1) {
                const bool up = (lane & m) != 0;
#pragma unroll
                for (int i = 0; i < m; ++i) { const float send = up ? part[i] : part[i + m], keep = up ? part[i + m] : part[i]; part[i] = keep + __shfl_xor(send, m); }
            }
            const float act = gelu_tanh(part[0] * rs1);
            if (half) coef1 = g1 * act * (1.0f / V8_SCALE); else coef0 = g0 * act * (1.0f / V8_SCALE);
        }
        float* coef = (float*)(ws + R_COEF);
        coef[(size_t)tok * 128 + lane] = coef0; coef[(size_t)tok * 128 + 64 + lane] = coef1;
    }
}
DI void p6v6_v(const Params& p, int G) {
    unsigned char* ws = p.ws;
    const int tid = threadIdx.x, lane = tid & 63, wid = tid >> 6;
    const int gw = blockIdx.x * 8 + wid, nw = G * 8;
    const unsigned char* v8 = (const unsigned char*)(ws + WS_VB);
    const int* eidx = (const int*)(ws + R_EXP); const float* coef = (const float*)(ws + R_COEF);
    float* h = p.out; bf16_t* hb = (bf16_t*)(ws + R_H1B); float* rs2 = (float*)(ws + WS_RS2);
#pragma unroll 1
    for (int tok = gw; tok < NTOK; tok += nw) {
        const int e0 = eidx[(size_t)tok * 128 + lane], e1 = eidx[(size_t)tok * 128 + 64 + lane];
        const float coef0 = coef[(size_t)tok * 128 + lane], coef1 = coef[(size_t)tok * 128 + 64 + lane];
        f32x2 acc[8];
#pragma unroll
        for (int i = 0; i < 8; ++i) acc[i] = (f32x2){0.f, 0.f};
#pragma unroll
        for (int half = 0; half < 2; ++half) {
            const int ev = half ? e1 : e0; const float cv = half ? coef1 : coef0;
#pragma unroll 16
            for (int j = 0; j < 64; ++j) {
                const int e = __builtin_amdgcn_readlane(ev, j);
                const float c = __uint_as_float(__builtin_amdgcn_readlane(__float_as_uint(cv), j));
                const u32x4 w = *(const u32x4*)(v8 + (size_t)e * DM + lane * 16);
                const f32x2 c2 = {c, c};
#pragma unroll
                for (int q = 0; q < 4; ++q) {
                    acc[2 * q] = __builtin_elementwise_fma(__builtin_amdgcn_cvt_pk_f32_fp8((int)w[q], false), c2, acc[2 * q]);
                    acc[2 * q + 1] = __builtin_elementwise_fma(__builtin_amdgcn_cvt_pk_f32_fp8((int)w[q], true), c2, acc[2 * q + 1]);
                }
            }
        }
        float* hr = h + (size_t)tok * DM + lane * 16;
        u32x4 w0, w1; float ss = 0.f;
#pragma unroll
        for (int q4 = 0; q4 < 4; ++q4) {
            f32x4 hv = *(f32x4*)(hr + 4 * q4);
            hv += (f32x4){acc[2 * q4].x, acc[2 * q4].y, acc[2 * q4 + 1].x, acc[2 * q4 + 1].y};
            *(f32x4*)(hr + 4 * q4) = hv;
            ss += (hv[0] * hv[0] + hv[1] * hv[1]) + (hv[2] * hv[2] + hv[3] * hv[3]);
            const unsigned a_ = pk_bf16(hv[0], hv[1]), b_ = pk_bf16(hv[2], hv[3]);
            if (q4 == 0) { w0.x = a_; w0.y = b_; } else if (q4 == 1) { w0.z = a_; w0.w = b_; } else if (q4 == 2) { w1.x = a_; w1.y = b_; } else { w1.z = a_; w1.w = b_; }
        }
        *(u32x4*)(hb + (size_t)tok * DM + lane * 16) = w0; *(u32x4*)(hb + (size_t)tok * DM + lane * 16 + 8) = w1;
        ss = wave_sum(ss);
        if (lane == 0) rs2[tok] = rsqrtf(ss * (1.0f / DM) + EPS);
    }
}
DI void p6u_cols(const Params& p, int G) {
    unsigned char* ws = p.ws;
    const int tid = threadIdx.x, lane = tid & 63, wid = tid >> 6, grp = blockIdx.x & 7, rank = blockIdx.x >> 3;
    const int nrank = (G - grp + 7) >> 3, wv = rank * 8 + wid, nwv = nrank * 8;
    const unsigned char* u8 = (const unsigned char*)(ws + WS_UB); const bf16_t* hb = (const bf16_t*)(ws + R_H1B);
    const int* eidx = (const int*)(ws + R_EXP);
    float* part = (float*)(ws + R_BIG) + (size_t)grp * NTOK * 128;
    const int sub = lane >> 3, col0 = grp * 128 + (lane & 7) * 16;
    if (wv >= NTOK) return;
    const int nvis = (NTOK - wv + nwv - 1) / nwv;
#define PC_LOADIDX(T, EV0, EV1, XA, XB) do { EV0 = eidx[(size_t)(T) * 128 + lane]; EV1 = eidx[(size_t)(T) * 128 + 64 + lane]; \
        XA = *(const u32x4*)(hb + (size_t)(T) * DM + col0); XB = *(const u32x4*)(hb + (size_t)(T) * DM + col0 + 8); } while (0)
#define PC_ISSUE8(R, EV) do { _Pragma("unroll") for (int i = 0; i < 8; ++i) { const int e = __shfl((EV), 8 * i + sub); R[i] = *(const u32x4*)(u8 + (unsigned)(e * DM + col0)); } } while (0)
#define PC_CONS8(R, P0) do { _Pragma("unroll") for (int i = 0; i < 8; ++i) { f32x2 a2 = {0.f, 0.f}; \
            _Pragma("unroll") for (int q = 0; q < 4; ++q) { \
                a2 = __builtin_elementwise_fma(__builtin_amdgcn_cvt_pk_f32_fp8((int)R[i][q], false), xp[2 * q], a2); \
                a2 = __builtin_elementwise_fma(__builtin_amdgcn_cvt_pk_f32_fp8((int)R[i][q], true), xp[2 * q + 1], a2); } \
            pd[(P0) + i] = a2.x + a2.y; __builtin_amdgcn_sched_barrier(0); } } while (0)
    u32x4 ra[8], rb[8];
    int e0, e1, n0, n1, x0, x1; u32x4 xa0, xb0, xa1, xb1, xa2, xb2;
    PC_LOADIDX(wv, e0, e1, xa0, xb0);
    { const int t1 = nvis > 1 ? wv + nwv : wv; PC_LOADIDX(t1, n0, n1, xa1, xb1); }
    PC_ISSUE8(ra, e0); PC_ISSUE8(rb, e1);
#pragma unroll 1
    for (int it = 0; it < nvis; ++it) {
        const int tok = wv + it * nwv;
        const int t2 = wv + (it + 2 < nvis ? it + 2 : nvis - 1) * nwv;
        PC_LOADIDX(t2, x0, x1, xa2, xb2);
        f32x2 xp[8];
#pragma unroll
        for (int q = 0; q < 4; ++q) { xp[q] = (f32x2){bflo(xa0[q]), bfhi(xa0[q])}; xp[4 + q] = (f32x2){bflo(xb0[q]), bfhi(xb0[q])}; }
        float pd[16];
        PC_CONS8(ra, 0);
        PC_ISSUE8(ra, n0);
        PC_CONS8(rb, 8);
        PC_ISSUE8(rb, n1);
#define PC_RS(M, LB) do { const bool up = (lane & (LB)) != 0; _Pragma("unroll") for (int i = 0; i < (M); ++i) { \
            const float send = up ? pd[i] : pd[i + (M)], keep = up ? pd[i + (M)] : pd[i]; pd[i] = keep + __shfl_xor(send, (LB)); } } while (0)
        PC_RS(8, 4); PC_RS(4, 2); PC_RS(2, 1);
#undef PC_RS
        const int i0 = 8 * ((lane >> 2) & 1) + 4 * ((lane >> 1) & 1) + 2 * (lane & 1);
        *(f32x2*)(part + (size_t)tok * 128 + sub * 16 + i0) = (f32x2){pd[0], pd[1]};
        e0 = n0; e1 = n1; xa0 = xa1; xb0 = xb1; n0 = x0; n1 = x1; xa1 = xa2; xb1 = xb2;
    }
#undef PC_LOADIDX
#undef PC_ISSUE8
#undef PC_CONS8
}
DI void p6u_combine(const Params& p, int G) {
    unsigned char* ws = p.ws;
    const float* part = (const float*)(ws + R_BIG); const float* gsm = (const float*)(ws + R_GSM); const float* rs1v = (const float*)(ws + WS_RS1);
    float* coef = (float*)(ws + R_COEF);
    const size_t n = (size_t)NTOK * 128, nthr = (size_t)G * MK_THREADS;
    for (size_t idx = (size_t)blockIdx.x * MK_THREADS + threadIdx.x; idx < n; idx += nthr) {
        const size_t tok = idx >> 7; const int j = (int)(idx & 127), pos = (j & 7) * 16 + (j >> 3);
        float s = 0.f;
#pragma unroll
        for (int sl = 0; sl < 8; ++sl) s += part[(size_t)sl * NTOK * 128 + tok * 128 + pos];
        coef[idx] = gsm[idx] * (1.0f / V8_SCALE) * gelu_tanh(s * (rs1v[tok] * (1.0f / U8_SCALE)));
    }
}

#if PEER_FP4
DI void fp4x16_dot(const u32x2 w, const f32x2 (&xp)[8], f32x2& a2) {
#define F4D(Q, B) a2 = __builtin_elementwise_fma(__builtin_amdgcn_cvt_scalef32_pk_f32_fp4(w[Q], 1.0f, B), xp[4 * (Q) + (B)], a2)
    F4D(0, 0); F4D(0, 1); F4D(0, 2); F4D(0, 3); F4D(1, 0); F4D(1, 1); F4D(1, 2); F4D(1, 3);
#undef F4D
}
DI void p6f4_u(const Params& p, int G) {
    unsigned char* ws = p.ws;
    const int tid = threadIdx.x, lane = tid & 63, wid = tid >> 6;
    const int gw = blockIdx.x * 8 + wid, nw = G * 8;
    const unsigned char* u4 = (const unsigned char*)(ws + WS_UB);
    const int* eidx = (const int*)(ws + R_EXP); const float* gsm = (const float*)(ws + R_GSM); const float* rs1v = (const float*)(ws + WS_RS1);
    bf16_t* hb = (bf16_t*)(ws + R_H1B); float* coef = (float*)(ws + R_COEF);
#pragma unroll 1
    for (int tok = gw; tok < NTOK; tok += nw) {
        const float rs1 = rs1v[tok] * (1.0f / U8_SCALE);
        const u32x4 xa = *(const u32x4*)(hb + (size_t)tok * DM + lane * 16), xb = *(const u32x4*)(hb + (size_t)tok * DM + lane * 16 + 8);
        f32x2 xp[8];
#pragma unroll
        for (int q = 0; q < 4; ++q) { xp[q] = (f32x2){bflo(xa[q]), bfhi(xa[q])}; xp[4 + q] = (f32x2){bflo(xb[q]), bfhi(xb[q])}; }
        const int e0 = eidx[(size_t)tok * 128 + lane], e1 = eidx[(size_t)tok * 128 + 64 + lane];
        const float g0 = gsm[(size_t)tok * 128 + lane], g1 = gsm[(size_t)tok * 128 + 64 + lane];
#pragma unroll
        for (int half = 0; half < 2; ++half) {
            const int ev = half ? e1 : e0;
            float part[64];
#pragma unroll
            for (int j = 0; j < 64; ++j) {
                const int e = __builtin_amdgcn_readlane(ev, j);
                const u32x2 w = *(const u32x2*)(u4 + (size_t)e * (DM / 2) + lane * 8);
                f32x2 a2 = {0.f, 0.f};
                fp4x16_dot(w, xp, a2);
                part[j] = a2.x + a2.y;
            }
#define F4_RS(M) do { const bool up = (lane & (M)) != 0; _Pragma("unroll") for (int i = 0; i < (M); ++i) { \
                const float send = up ? part[i] : part[i + (M)], keep = up ? part[i + (M)] : part[i]; part[i] = keep + __shfl_xor(send, (M)); } } while (0)
            F4_RS(32); F4_RS(16); F4_RS(8); F4_RS(4); F4_RS(2); F4_RS(1);
#undef F4_RS
            const float act = gelu_tanh(part[0] * rs1);
            coef[(size_t)tok * 128 + half * 64 + lane] = (half ? g1 : g0) * act * (1.0f / V8_SCALE);
        }
    }
}
template <int PMODE> DI void p6f4_v(const Params& p, int G) {
    unsigned char* ws = p.ws;
    const int tid = threadIdx.x, lane = tid & 63, wid = tid >> 6;
    const int grp = blockIdx.x & 7, rank = blockIdx.x >> 3;
    const int nrank = (G - grp + 7) >> 3;
    const int wv = rank * 8 + wid, nwv = nrank * 8;
    const unsigned char* v4 = (const unsigned char*)(ws + WS_VB);
    const int* eidx = (const int*)(ws + R_EXP); const float* coef = (const float*)(ws + R_COEF);
    float* h = p.out; bf16_t* hb = (bf16_t*)(ws + R_H1B); float* ssq2 = (float*)(ws + WS_SSQ2);
    const int sub = lane >> 3, col0 = grp * 128 + (lane & 7) * 16;
    if (wv >= NTOK) return;
    const int nvis = (NTOK - wv + nwv - 1) / nwv;
#define PV_LOADIDX(T, EV0, EV1, CV0, CV1) do { EV0 = eidx[(size_t)(T) * 128 + lane]; EV1 = eidx[(size_t)(T) * 128 + 64 + lane]; CV0 = coef[(size_t)(T) * 128 + lane]; CV1 = coef[(size_t)(T) * 128 + 64 + lane]; } while (0)
#define PV_ISSUE8(R, EV) do { _Pragma("unroll") for (int i = 0; i < 8; ++i) { const int e = __shfl((EV), 8 * i + sub); R[i] = *(const u32x2*)(v4 + (unsigned)(e * (DM / 2) + (col0 >> 1))); } } while (0)
#define PV_CONS8(R, CV) do { _Pragma("unroll") for (int i = 0; i < 8; ++i) { const float c = __shfl((CV), 8 * i + sub); const f32x2 c2 = {c, c}; \
            F4A(R[i], 0, 0); F4A(R[i], 0, 1); F4A(R[i], 0, 2); F4A(R[i], 0, 3); F4A(R[i], 1, 0); F4A(R[i], 1, 1); F4A(R[i], 1, 2); F4A(R[i], 1, 3); } } while (0)
#define F4A(RR, Q, B) acc[4 * (Q) + (B)] = __builtin_elementwise_fma(__builtin_amdgcn_cvt_scalef32_pk_f32_fp4(RR[Q], 1.0f, B), c2, acc[4 * (Q) + (B)])
    u32x2 ra[8], rb[8];
    int e0, e1, n0, n1, x0, x1; float c0, c1, d0, d1, y0, y1;
    PV_LOADIDX(wv, e0, e1, c0, c1);
    { const int t1 = nvis > 1 ? wv + nwv : wv; PV_LOADIDX(t1, n0, n1, d0, d1); }
    PV_ISSUE8(ra, e0); PV_ISSUE8(rb, e1);
#pragma unroll 1
    for (int it = 0; it < nvis; ++it) {
        const int tok = wv + it * nwv;
        const int t2 = wv + (it + 2 < nvis ? it + 2 : nvis - 1) * nwv;
        float* hr = h + (size_t)tok * DM + col0;
        const f32x4 hv0 = *(const f32x4*)hr, hv1 = *(const f32x4*)(hr + 4), hv2 = *(const f32x4*)(hr + 8), hv3 = *(const f32x4*)(hr + 12);
        PV_LOADIDX(t2, x0, x1, y0, y1);
        f32x2 acc[8];
#pragma unroll
        for (int q = 0; q < 8; ++q) acc[q] = (f32x2){0.f, 0.f};
        PV_CONS8(ra, c0);
        PV_ISSUE8(ra, n0);
        PV_CONS8(rb, c1);
        PV_ISSUE8(rb, n1);
        float av[16];
#pragma unroll
        for (int q = 0; q < 8; ++q) { av[2 * q] = acc[q].x; av[2 * q + 1] = acc[q].y; }
#pragma unroll
        for (int q = 0; q < 16; ++q) { av[q] += __shfl_xor(av[q], 8); av[q] += __shfl_xor(av[q], 16); av[q] += __shfl_xor(av[q], 32); }
        float ss = 0.f;
        if (lane < 8) {
            const f32x4 o0 = hv0 + (f32x4){av[0], av[1], av[2], av[3]}, o1 = hv1 + (f32x4){av[4], av[5], av[6], av[7]};
            const f32x4 o2 = hv2 + (f32x4){av[8], av[9], av[10], av[11]}, o3 = hv3 + (f32x4){av[12], av[13], av[14], av[15]};
            *(f32x4*)hr = o0; *(f32x4*)(hr + 4) = o1; *(f32x4*)(hr + 8) = o2; *(f32x4*)(hr + 12) = o3;
            u32x4 w0, w1;
            w0.x = pk_bf16(o0[0], o0[1]); w0.y = pk_bf16(o0[2], o0[3]); w0.z = pk_bf16(o1[0], o1[1]); w0.w = pk_bf16(o1[2], o1[3]);
            w1.x = pk_bf16(o2[0], o2[1]); w1.y = pk_bf16(o2[2], o2[3]); w1.z = pk_bf16(o3[0], o3[1]); w1.w = pk_bf16(o3[2], o3[3]);
            *(u32x4*)(hb + (size_t)tok * DM + col0) = w0; *(u32x4*)(hb + (size_t)tok * DM + col0 + 8) = w1;
#pragma unroll
            for (int j = 0; j < 4; ++j) ss += o0[j] * o0[j] + o1[j] * o1[j] + o2[j] * o2[j] + o3[j] * o3[j];
        }
        ss += __shfl_xor(ss, 1); ss += __shfl_xor(ss, 2); ss += __shfl_xor(ss, 4);
        if (lane == 0) ssq2[(size_t)grp * NTOK + tok] = ss;
        e0 = n0; e1 = n1; c0 = d0; c1 = d1; n0 = x0; n1 = x1; d0 = y0; d1 = y1;
    }
#undef PV_LOADIDX
#undef PV_ISSUE8
#undef PV_CONS8
#undef F4A
}
#endif

#if PEER_I8U
constexpr float U_ISCALE = 640.0f;
#define I8_ISSUE(SET, EV, J0) do { int ev_ = (EV); asm volatile("" : "+v"(ev_)); _Pragma("unroll") for (int k = 0; k < 16; ++k) { const int e = __builtin_amdgcn_readlane(ev_, (J0) + k); \
        SET[k] = *(const u32x4*)(u8 + ((unsigned)e * (unsigned)DM + (unsigned)(lane * 16))); } __builtin_amdgcn_sched_barrier(0); } while (0)
#define I8_CONS(SET, P0) do { _Pragma("unroll") for (int k = 0; k < 16; ++k) { \
        int a = __builtin_amdgcn_sdot4((int)SET[k].x, (int)xq[0], 0, false); a = __builtin_amdgcn_sdot4((int)SET[k].y, (int)xq[1], a, false); \
        a = __builtin_amdgcn_sdot4((int)SET[k].z, (int)xq[2], a, false); a = __builtin_amdgcn_sdot4((int)SET[k].w, (int)xq[3], a, false); \
        part[(P0) + k] = (float)a; } __builtin_amdgcn_sched_barrier(0); } while (0)
#define I8_RS(M) do { const bool up = (lane & (M)) != 0; _Pragma("unroll") for (int i = 0; i < (M); ++i) { \
        const float send = up ? part[i] : part[i + (M)], keep = up ? part[i + (M)] : part[i]; part[i] = keep + __shfl_xor(send, (M)); } } while (0)
DI void p6i8_u(const Params& p, int G) {
    unsigned char* ws = p.ws;
    const int tid = threadIdx.x, lane = tid & 63, wid = tid >> 6;
    const int gw = blockIdx.x * 8 + wid, nw = G * 8;
    const unsigned char* u8 = (const unsigned char*)(ws + WS_UB);
    const int* eidx = (const int*)(ws + R_EXP); const float* gsm = (const float*)(ws + R_GSM); const float* rs1v = (const float*)(ws + WS_RS1);
    bf16_t* hb = (bf16_t*)(ws + R_H1B); float* coef = (float*)(ws + R_COEF);
#pragma unroll 1
    for (int tok = gw; tok < NTOK; tok += nw) {
        const int e0 = eidx[(size_t)tok * 128 + lane], e1 = eidx[(size_t)tok * 128 + 64 + lane];
        u32x4 sa[16], sb[16];
        I8_ISSUE(sa, e0, 0);
        I8_ISSUE(sb, e0, 16);
        const u32x4 xa = *(const u32x4*)(hb + (size_t)tok * DM + lane * 16), xb = *(const u32x4*)(hb + (size_t)tok * DM + lane * 16 + 8);
        const float g0 = gsm[(size_t)tok * 128 + lane], g1 = gsm[(size_t)tok * 128 + 64 + lane];
        const float rs1 = rs1v[tok];
        float xf[16];
#pragma unroll
        for (int q = 0; q < 4; ++q) { xf[2 * q] = bflo(xa[q]); xf[2 * q + 1] = bfhi(xa[q]); xf[8 + 2 * q] = bflo(xb[q]); xf[8 + 2 * q + 1] = bfhi(xb[q]); }
        float amax = 0.f;
#pragma unroll
        for (int i = 0; i < 16; ++i) amax = fmaxf(amax, fabsf(xf[i]));
        amax = wave_max(amax);
        const float sx = fmaxf(amax, 1e-20f) * (1.0f / 127.0f), isx = 1.0f / sx;
        unsigned xq[4];
#pragma unroll
        for (int q = 0; q < 4; ++q) {
            unsigned w = 0u;
#pragma unroll
            for (int b = 0; b < 4; ++b) w |= ((unsigned)(int)rintf(xf[4 * q + b] * isx) & 0xffu) << (8 * b);
            xq[q] = w;
        }
        const float scl = rs1 * sx * (1.0f / U_ISCALE);
        float part[64];
        I8_CONS(sa, 0);  I8_ISSUE(sa, e0, 32);
        I8_CONS(sb, 16); I8_ISSUE(sb, e0, 48);
        I8_CONS(sa, 32); I8_ISSUE(sa, e1, 0);
        I8_CONS(sb, 48); I8_ISSUE(sb, e1, 16);
        I8_RS(32); I8_RS(16); I8_RS(8); I8_RS(4); I8_RS(2); I8_RS(1);
        coef[(size_t)tok * 128 + lane] = g0 * gelu_tanh(part[0] * scl) * (1.0f / V8_SCALE);
        I8_CONS(sa, 0);  I8_ISSUE(sa, e1, 32);
        I8_CONS(sb, 16); I8_ISSUE(sb, e1, 48);
        I8_CONS(sa, 32);
        I8_CONS(sb, 48);
        I8_RS(32); I8_RS(16); I8_RS(8); I8_RS(4); I8_RS(2); I8_RS(1);
        coef[(size_t)tok * 128 + 64 + lane] = g1 * gelu_tanh(part[0] * scl) * (1.0f / V8_SCALE);
    }
}
#undef I8_ISSUE
#undef I8_CONS
#undef I8_RS
#endif
#define V8_ISSUE(SET, EV, J0) do { int ev_ = (EV); asm volatile("" : "+v"(ev_)); _Pragma("unroll") for (int k = 0; k < 16; ++k) { const int e = __builtin_amdgcn_readlane(ev_, (J0) + k); \
        SET[k] = *(const u32x4*)(v8 + ((unsigned)e * (unsigned)DM + (unsigned)(lane * 16))); } __builtin_amdgcn_sched_barrier(0); } while (0)
#define V8_FMA(W, I) do { t_[2 * (I)] = __builtin_elementwise_fma(__builtin_amdgcn_cvt_pk_f32_fp8((int)(W), false), c2, t_[2 * (I)]); \
        t_[2 * (I) + 1] = __builtin_elementwise_fma(__builtin_amdgcn_cvt_pk_f32_fp8((int)(W), true), c2, t_[2 * (I) + 1]); } while (0)
#define V8_ROW(SET, CV, J0, K) do { const float c = (CV)[(J0) + (K)]; const f32x2 c2 = {c, c}; const u32x4 w_ = SET[K]; \
        V8_FMA(w_.x, 0); V8_FMA(w_.y, 1); V8_FMA(w_.z, 2); V8_FMA(w_.w, 3); } while (0)
#define V8_CONS(SET, CV, J0) do { f32x2 t_[8]; _Pragma("unroll") for (int i_ = 0; i_ < 8; ++i_) t_[i_] = (f32x2){0.f, 0.f}; V8_ROW(SET, CV, J0, 0); V8_ROW(SET, CV, J0, 1); V8_ROW(SET, CV, J0, 2); V8_ROW(SET, CV, J0, 3); V8_ROW(SET, CV, J0, 4); V8_ROW(SET, CV, J0, 5); \
        V8_ROW(SET, CV, J0, 6); V8_ROW(SET, CV, J0, 7); V8_ROW(SET, CV, J0, 8); V8_ROW(SET, CV, J0, 9); V8_ROW(SET, CV, J0, 10); V8_ROW(SET, CV, J0, 11); \
        V8_ROW(SET, CV, J0, 12); V8_ROW(SET, CV, J0, 13); V8_ROW(SET, CV, J0, 14); V8_ROW(SET, CV, J0, 15); \
        _Pragma("unroll") for (int i_ = 0; i_ < 8; ++i_) acc[i_] += t_[i_]; __builtin_amdgcn_sched_barrier(0); } while (0)
DI void p6v8_v(const Params& p, LAS3 unsigned char* lds, int G) {
    unsigned char* ws = p.ws;
    const int tid = threadIdx.x, lane = tid & 63, wid = tid >> 6;
    const int gw = blockIdx.x * 8 + wid, nw = G * 8;
    const unsigned char* v8 = (const unsigned char*)(ws + WS_VB);
    const int* eidx = (const int*)(ws + R_EXP); const float* coef = (const float*)(ws + R_COEF);
    float* h = p.out; bf16_t* hb = (bf16_t*)(ws + R_H1B); float* rs2 = (float*)(ws + WS_RS2);
#pragma unroll 1
    for (int tok = gw; tok < NTOK; tok += nw) {
        const int e0 = eidx[(size_t)tok * 128 + lane], e1 = eidx[(size_t)tok * 128 + 64 + lane];
        u32x4 sa[16], sb[16];
        V8_ISSUE(sa, e0, 0);
        V8_ISSUE(sb, e0, 16);
        LAS3 float* cl = (LAS3 float*)(lds + wid * 512);
        cl[lane] = coef[(size_t)tok * 128 + lane]; cl[64 + lane] = coef[(size_t)tok * 128 + 64 + lane];
        LAS3 const float* c0 = cl; LAS3 const float* c1 = cl + 64;
        float* hr = h + (size_t)tok * DM + lane * 16;
        const f32x4 hv0 = *(const f32x4*)hr, hv1 = *(const f32x4*)(hr + 4), hv2 = *(const f32x4*)(hr + 8), hv3 = *(const f32x4*)(hr + 12);
        f32x2 acc[8];
#pragma unroll
        for (int i = 0; i < 8; ++i) acc[i] = (f32x2){0.f, 0.f};
        V8_CONS(sa, c0, 0);  V8_ISSUE(sa, e0, 32);
        V8_CONS(sb, c0, 16); V8_ISSUE(sb, e0, 48);
        V8_CONS(sa, c0, 32); V8_ISSUE(sa, e1, 0);
        V8_CONS(sb, c0, 48); V8_ISSUE(sb, e1, 16);
        V8_CONS(sa, c1, 0);  V8_ISSUE(sa, e1, 32);
        V8_CONS(sb, c1, 16); V8_ISSUE(sb, e1, 48);
        V8_CONS(sa, c1, 32);
        V8_CONS(sb, c1, 48);
        const f32x4 o0 = hv0 + (f32x4){acc[0].x, acc[0].y, acc[1].x, acc[1].y}, o1 = hv1 + (f32x4){acc[2].x, acc[2].y, acc[3].x, acc[3].y};
        const f32x4 o2 = hv2 + (f32x4){acc[4].x, acc[4].y, acc[5].x, acc[5].y}, o3 = hv3 + (f32x4){acc[6].x, acc[6].y, acc[7].x, acc[7].y};
        *(f32x4*)hr = o0; *(f32x4*)(hr + 4) = o1; *(f32x4*)(hr + 8) = o2; *(f32x4*)(hr + 12) = o3;
        u32x4 w0, w1;
        w0.x = pk_bf16(o0[0], o0[1]); w0.y = pk_bf16(o0[2], o0[3]); w0.z = pk_bf16(o1[0], o1[1]); w0.w = pk_bf16(o1[2], o1[3]);
        w1.x = pk_bf16(o2[0], o2[1]); w1.y = pk_bf16(o2[2], o2[3]); w1.z = pk_bf16(o3[0], o3[1]); w1.w = pk_bf16(o3[2], o3[3]);
        *(u32x4*)(hb + (size_t)tok * DM + lane * 16) = w0; *(u32x4*)(hb + (size_t)tok * DM + lane * 16 + 8) = w1;
        float ss = 0.f;
#pragma unroll
        for (int j = 0; j < 4; ++j) ss += o0[j] * o0[j] + o1[j] * o1[j] + o2[j] * o2[j] + o3[j] * o3[j];
        ss = wave_sum(ss);
        if (lane == 0) rs2[tok] = rsqrtf(ss * (1.0f / DM) + EPS);
    }
}
#undef V8_ISSUE
#undef V8_CONS
#undef V8_FMA
#undef V8_ROW

#if PEER_V4EXP
#define V4_ISSUE(SET, EV, J0) do { int ev_ = (EV); asm volatile("" : "+v"(ev_)); _Pragma("unroll") for (int k = 0; k < 16; ++k) { const int e = __builtin_amdgcn_readlane(ev_, (J0) + k); \
        SET[k] = *(const u32x2*)(v8 + ((unsigned)e * (unsigned)(DM / 2) + (unsigned)(lane * 8))); } __builtin_amdgcn_sched_barrier(0); } while (0)
#define V4_FMA(W, I) do { t_[4 * (I)] = __builtin_elementwise_fma(__builtin_amdgcn_cvt_scalef32_pk_f32_fp4((W), 1.0f, 0), c2, t_[4 * (I)]); \
        t_[4 * (I) + 1] = __builtin_elementwise_fma(__builtin_amdgcn_cvt_scalef32_pk_f32_fp4((W), 1.0f, 1), c2, t_[4 * (I) + 1]); \
        t_[4 * (I) + 2] = __builtin_elementwise_fma(__builtin_amdgcn_cvt_scalef32_pk_f32_fp4((W), 1.0f, 2), c2, t_[4 * (I) + 2]); \
        t_[4 * (I) + 3] = __builtin_elementwise_fma(__builtin_amdgcn_cvt_scalef32_pk_f32_fp4((W), 1.0f, 3), c2, t_[4 * (I) + 3]); } while (0)
#define V4_ROW(SET, CV, J0, K) do { const float c = (CV)[(J0) + (K)]; const f32x2 c2 = {c, c}; const u32x2 w_ = SET[K]; \
        V4_FMA(w_.x, 0); V4_FMA(w_.y, 1); } while (0)
#define V4_CONS(SET, CV, J0) do { f32x2 t_[8]; _Pragma("unroll") for (int i_ = 0; i_ < 8; ++i_) t_[i_] = (f32x2){0.f, 0.f}; V4_ROW(SET, CV, J0, 0); V4_ROW(SET, CV, J0, 1); V4_ROW(SET, CV, J0, 2); V4_ROW(SET, CV, J0, 3); V4_ROW(SET, CV, J0, 4); V4_ROW(SET, CV, J0, 5); \
        V4_ROW(SET, CV, J0, 6); V4_ROW(SET, CV, J0, 7); V4_ROW(SET, CV, J0, 8); V4_ROW(SET, CV, J0, 9); V4_ROW(SET, CV, J0, 10); V4_ROW(SET, CV, J0, 11); \
        V4_ROW(SET, CV, J0, 12); V4_ROW(SET, CV, J0, 13); V4_ROW(SET, CV, J0, 14); V4_ROW(SET, CV, J0, 15); \
        _Pragma("unroll") for (int i_ = 0; i_ < 8; ++i_) acc[i_] += t_[i_]; __builtin_amdgcn_sched_barrier(0); } while (0)
DI void p6v4_v(const Params& p, LAS3 unsigned char* lds, int G) {
    unsigned char* ws = p.ws;
    const int tid = threadIdx.x, lane = tid & 63, wid = tid >> 6;
    const int gw = blockIdx.x * 8 + wid, nw = G * 8;
    const unsigned char* v8 = (const unsigned char*)(ws + WS_VB);
    const int* eidx = (const int*)(ws + R_EXP); const float* coef = (const float*)(ws + R_COEF);
    float* h = p.out; bf16_t* hb = (bf16_t*)(ws + R_H1B); float* rs2 = (float*)(ws + WS_RS2);
#pragma unroll 1
    for (int tok = gw; tok < NTOK; tok += nw) {
        const int e0 = eidx[(size_t)tok * 128 + lane], e1 = eidx[(size_t)tok * 128 + 64 + lane];
        u32x2 sa[16], sb[16];
        V4_ISSUE(sa, e0, 0);
        V4_ISSUE(sb, e0, 16);
        LAS3 float* cl = (LAS3 float*)(lds + wid * 512);
        cl[lane] = coef[(size_t)tok * 128 + lane]; cl[64 + lane] = coef[(size_t)tok * 128 + 64 + lane];
        LAS3 const float* c0 = cl; LAS3 const float* c1 = cl + 64;
        float* hr = h + (size_t)tok * DM + lane * 16;
        const f32x4 hv0 = *(const f32x4*)hr, hv1 = *(const f32x4*)(hr + 4), hv2 = *(const f32x4*)(hr + 8), hv3 = *(const f32x4*)(hr + 12);
        f32x2 acc[8];
#pragma unroll
        for (int i = 0; i < 8; ++i) acc[i] = (f32x2){0.f, 0.f};
        V4_CONS(sa, c0, 0);  V4_ISSUE(sa, e0, 32);
        V4_CONS(sb, c0, 16); V4_ISSUE(sb, e0, 48);
        V4_CONS(sa, c0, 32); V4_ISSUE(sa, e1, 0);
        V4_CONS(sb, c0, 48); V4_ISSUE(sb, e1, 16);
        V4_CONS(sa, c1, 0);  V4_ISSUE(sa, e1, 32);
        V4_CONS(sb, c1, 16); V4_ISSUE(sb, e1, 48);
        V4_CONS(sa, c1, 32);
        V4_CONS(sb, c1, 48);
        const f32x4 o0 = hv0 + (f32x4){acc[0].x, acc[0].y, acc[1].x, acc[1].y}, o1 = hv1 + (f32x4){acc[2].x, acc[2].y, acc[3].x, acc[3].y};
        const f32x4 o2 = hv2 + (f32x4){acc[4].x, acc[4].y, acc[5].x, acc[5].y}, o3 = hv3 + (f32x4){acc[6].x, acc[6].y, acc[7].x, acc[7].y};
        *(f32x4*)hr = o0; *(f32x4*)(hr + 4) = o1; *(f32x4*)(hr + 8) = o2; *(f32x4*)(hr + 12) = o3;
        u32x4 w0, w1;
        w0.x = pk_bf16(o0[0], o0[1]); w0.y = pk_bf16(o0[2], o0[3]); w0.z = pk_bf16(o1[0], o1[1]); w0.w = pk_bf16(o1[2], o1[3]);
        w1.x = pk_bf16(o2[0], o2[1]); w1.y = pk_bf16(o2[2], o2[3]); w1.z = pk_bf16(o3[0], o3[1]); w1.w = pk_bf16(o3[2], o3[3]);
        *(u32x4*)(hb + (size_t)tok * DM + lane * 16) = w0; *(u32x4*)(hb + (size_t)tok * DM + lane * 16 + 8) = w1;
        float ss = 0.f;
#pragma unroll
        for (int j = 0; j < 4; ++j) ss += o0[j] * o0[j] + o1[j] * o1[j] + o2[j] * o2[j] + o3[j] * o3[j];
        ss = wave_sum(ss);
        if (lane == 0) rs2[tok] = rsqrtf(ss * (1.0f / DM) + EPS);
    }
}
#undef V4_ISSUE
#undef V4_CONS
#undef V4_FMA
#undef V4_ROW
#endif
#define VS_SETUP(BUF, E0, E1, C0, C1, EP, CP) do { LAS3 unsigned* eb = (LAS3 unsigned*)(wl + (BUF) * 1024); LAS3 float* cb = (LAS3 float*)(wl + (BUF) * 1024 + 512); \
        eb[(lane & 7) * 16 + (lane >> 3)] = (unsigned)(E0); eb[(lane & 7) * 16 + 8 + (lane >> 3)] = (unsigned)(E1); \
        cb[(lane & 7) * 16 + (lane >> 3)] = (C0); cb[(lane & 7) * 16 + 8 + (lane >> 3)] = (C1); \
        _Pragma("unroll") for (int q = 0; q < 4; ++q) { const u32x4 ev4 = *(LAS3 const u32x4*)(eb + sub * 16 + 4 * q); const f32x4 cv4 = *(LAS3 const f32x4*)(cb + sub * 16 + 4 * q); \
            EP[4 * q] = ev4.x; EP[4 * q + 1] = ev4.y; EP[4 * q + 2] = ev4.z; EP[4 * q + 3] = ev4.w; CP[4 * q] = cv4[0]; CP[4 * q + 1] = cv4[1]; CP[4 * q + 2] = cv4[2]; CP[4 * q + 3] = cv4[3]; } } while (0)
#define VS_ISSUE(SET, EP) do { _Pragma("unroll") for (int i = 0; i < 16; ++i) SET[i] = *(const u32x4*)(v8 + (EP[i] * (unsigned)DM + (unsigned)col0)); __builtin_amdgcn_sched_barrier(0); } while (0)
#define VS_FMA(W, I) do { t_[2 * (I)] = __builtin_elementwise_fma(__builtin_amdgcn_cvt_pk_f32_fp8((int)(W), false), c2, t_[2 * (I)]); \
        t_[2 * (I) + 1] = __builtin_elementwise_fma(__builtin_amdgcn_cvt_pk_f32_fp8((int)(W), true), c2, t_[2 * (I) + 1]); } while (0)
#define VS_ROW(SET, CP, K) do { const f32x2 c2 = {CP[K], CP[K]}; const u32x4 w_ = SET[K]; VS_FMA(w_.x, 0); VS_FMA(w_.y, 1); VS_FMA(w_.z, 2); VS_FMA(w_.w, 3); } while (0)
#define VS_RS(M, LB) do { const bool up = (lane & (LB)) != 0; _Pragma("unroll") for (int i = 0; i < (M); ++i) { \
        const float send = up ? av[i] : av[i + (M)], keep = up ? av[i + (M)] : av[i]; av[i] = keep + __shfl_xor(send, (LB)); } } while (0)
#define VS_CONSUME(SET, CP, TOK, HV) do { f32x2 t_[8]; _Pragma("unroll") for (int i_ = 0; i_ < 8; ++i_) t_[i_] = (f32x2){0.f, 0.f}; \
        VS_ROW(SET, CP, 0); VS_ROW(SET, CP, 1); VS_ROW(SET, CP, 2); VS_ROW(SET, CP, 3); VS_ROW(SET, CP, 4); VS_ROW(SET, CP, 5); VS_ROW(SET, CP, 6); VS_ROW(SET, CP, 7); \
        f32x2 t2_[8]; _Pragma("unroll") for (int i_ = 0; i_ < 8; ++i_) { t2_[i_] = t_[i_]; t_[i_] = (f32x2){0.f, 0.f}; } \
        VS_ROW(SET, CP, 8); VS_ROW(SET, CP, 9); VS_ROW(SET, CP, 10); VS_ROW(SET, CP, 11); VS_ROW(SET, CP, 12); VS_ROW(SET, CP, 13); VS_ROW(SET, CP, 14); VS_ROW(SET, CP, 15); \
        float av[16]; _Pragma("unroll") for (int i_ = 0; i_ < 8; ++i_) { av[2 * i_] = t_[i_].x + t2_[i_].x; av[2 * i_ + 1] = t_[i_].y + t2_[i_].y; } \
        VS_RS(8, 32); VS_RS(4, 16); VS_RS(2, 8); \
        const f32x2 o_ = (HV) + (f32x2){av[0], av[1]}; \
        *(f32x2*)(h + (size_t)(TOK) * DM + colL) = o_; *(unsigned*)(hb + (size_t)(TOK) * DM + colL) = pk_bf16(o_.x, o_.y); \
        const float ss_ = wave_sum(o_.x * o_.x + o_.y * o_.y); if (lane == 0) ssq2[(size_t)grp * NTOK + (TOK)] = ss_; \
        __builtin_amdgcn_sched_barrier(0); } while (0)
DI void p6vs_v(const Params& p, LAS3 unsigned char* lds, int G) {
    unsigned char* ws = p.ws;
    const int tid = threadIdx.x, lane = tid & 63, wid = tid >> 6, grp = blockIdx.x & 7, rank = blockIdx.x >> 3;
    const int nrank = (G - grp + 7) >> 3, wv = rank * 8 + wid, nwv = nrank * 8;
    const unsigned char* v8 = (const unsigned char*)(ws + WS_VB);
    const int* eidx = (const int*)(ws + R_EXP); const float* coef = (const float*)(ws + R_COEF);
    float* h = p.out; bf16_t* hb = (bf16_t*)(ws + R_H1B); float* ssq2 = (float*)(ws + WS_SSQ2);
    LAS3 unsigned char* wl = lds + wid * 2048;
    const int sub = lane >> 3, col0 = grp * 128 + (lane & 7) * 16;
    const int colL = col0 + 8 * ((lane >> 5) & 1) + 4 * ((lane >> 4) & 1) + 2 * ((lane >> 3) & 1);
    if (wv >= NTOK) return;
    const int nvis = (NTOK - wv + nwv - 1) / nwv;
#define VS_TOK(V) (wv + ((V) < nvis ? (V) : nvis - 1) * nwv)
#define VS_LOADIDX(V, E0, E1, C0, C1) do { const size_t t_ = (size_t)VS_TOK(V) * 128; E0 = eidx[t_ + lane]; E1 = eidx[t_ + 64 + lane]; C0 = coef[t_ + lane]; C1 = coef[t_ + 64 + lane]; } while (0)
    u32x4 sa[16], sb[16];
    unsigned ep[16]; float cpa[16], cpb[16];
    int ea0, ea1, eb0, eb1; float ca0, ca1, cb0, cb1;
    f32x2 hva, hvb;
    VS_LOADIDX(0, ea0, ea1, ca0, ca1); VS_LOADIDX(1, eb0, eb1, cb0, cb1);
    VS_SETUP(0, ea0, ea1, ca0, ca1, ep, cpa); VS_ISSUE(sa, ep); hva = *(const f32x2*)(h + (size_t)VS_TOK(0) * DM + colL);
    VS_SETUP(1, eb0, eb1, cb0, cb1, ep, cpb); VS_ISSUE(sb, ep); hvb = *(const f32x2*)(h + (size_t)VS_TOK(1) * DM + colL);
    VS_LOADIDX(2, ea0, ea1, ca0, ca1); VS_LOADIDX(3, eb0, eb1, cb0, cb1);
#pragma unroll 1
    for (int v = 0; v < nvis; v += 2) {
        { const int tok = VS_TOK(v); VS_CONSUME(sa, cpa, tok, hva); }
        VS_SETUP(0, ea0, ea1, ca0, ca1, ep, cpa); VS_ISSUE(sa, ep); hva = *(const f32x2*)(h + (size_t)VS_TOK(v + 2) * DM + colL);
        VS_LOADIDX(v + 4, ea0, ea1, ca0, ca1);
        if (v + 1 < nvis) { const int tok = VS_TOK(v + 1); VS_CONSUME(sb, cpb, tok, hvb); }
        VS_SETUP(1, eb0, eb1, cb0, cb1, ep, cpb); VS_ISSUE(sb, ep); hvb = *(const f32x2*)(h + (size_t)VS_TOK(v + 3) * DM + colL);
        VS_LOADIDX(v + 5, eb0, eb1, cb0, cb1);
    }
#undef VS_TOK
#undef VS_LOADIDX
}
#undef VS_SETUP
#undef VS_ISSUE
#undef VS_FMA
#undef VS_ROW
#undef VS_RS
#undef VS_CONSUME
constexpr int LDS_MISC = 160 * 1024 - 256;
constexpr int LDS_BYTES = 160 * 1024;
constexpr size_t CTL_BAR = 0;
static_assert(XCD_BAR_WORDS * 4 <= 64 * 1024, "control region");

template <class F> struct EpiAdapt {
    static constexpr bool PERM = true, AFTER_DRAIN = false;
    F f;
    DI void operator()(const f32x4 (&acc)[2][2][4][2], const pg8::Unit& u, int wr, int wc, int fr, int fq) const {
        const int row0 = u.pm * 256 + wr * 64 + fr, col0 = u.pn * 256 + wc * 32 + 8 * fq;
#pragma unroll
        for (int ai = 0; ai < 2; ++ai)
#pragma unroll
            for (int m = 0; m < 4; ++m) {
                const int row = row0 + ai * 128 + m * 16;
#pragma unroll
                for (int bj = 0; bj < 2; ++bj)
#pragma unroll
                    for (int n = 0; n < 2; ++n) f.store4(row, col0 + bj * 128 + 4 * n, acc[ai][bj][m][n]);
            }
    }
};
template <class F> struct EpiAdaptSsq {
    static constexpr bool PERM = true, AFTER_DRAIN = false;
    F f; float* ssq;
    DI void operator()(const f32x4 (&acc)[2][2][4][2], const pg8::Unit& u, int wr, int wc, int fr, int fq) const {
        const int row0 = u.pm * 256 + wr * 64 + fr, col0 = u.pn * 256 + wc * 32 + 8 * fq;
#pragma unroll
        for (int ai = 0; ai < 2; ++ai)
#pragma unroll
            for (int m = 0; m < 4; ++m) {
                const int row = row0 + ai * 128 + m * 16;
                float s = 0.f; const float rsc = f.rowscale(row);
#pragma unroll
                for (int bj = 0; bj < 2; ++bj)
#pragma unroll
                    for (int n = 0; n < 2; ++n) { const f32x4 v = f.store4r(row, col0 + bj * 128 + 4 * n, acc[ai][bj][m][n], rsc); s += (v[0] * v[0] + v[1] * v[1]) + (v[2] * v[2] + v[3] * v[3]); }
                s += __shfl_xor(s, 16); s += __shfl_xor(s, 32);
                if (fq == 0) ssq[(size_t)(u.pn * 4 + wc) * NTOK + row] = s;
            }
    }
};
struct EpiOutR {
    const float* x; float* h1; bf16_t* h1b;
    DI float rowscale(int) const { return 0.f; }
    DI f32x4 store4r(int row, int col, f32x4 v, float) const {
        const size_t o = (size_t)row * DM + col;
        v += *(const f32x4*)(x + o);
        *(f32x4*)(h1 + o) = v;
        u32x2 w; w.x = pack2bf(v[0], v[1]); w.y = pack2bf(v[2], v[3]); *(u32x2*)(h1b + o) = w;
        return v;
    }
};
struct EpiGateR {
    const float* rs2; const float* bias; const float* pp; float* h;
    DI float rowscale(int row) const {
#if PEER_V2 && (!PEER_V6 || PEER_V6 == 3 || PEER_V6 == 4 || PEER_V6 == 6)
        float s = 0.f;
#pragma unroll
        for (int j = 0; j < (PEER_V3 ? 8 : 16); ++j) s += rs2[(size_t)j * NTOK + row];
        return rsqrtf(s * (1.0f / DM) + EPS);
#else
        return rs2[row];
#endif
    }
    DI f32x4 store4r(int row, int col, f32x4 v, float s) const {
        const size_t o = (size_t)row * DM + col;
        const f32x4 bb = *(const f32x4*)(bias + col), p4 = *(const f32x4*)(pp + o);
        f32x4 hv = *(f32x4*)(h + o);
#pragma unroll
        for (int j = 0; j < 4; ++j) hv[j] += sigmoidf_(v[j] * s + bb[j]) * p4[j];
        *(f32x4*)(h + o) = hv;
        return hv;
    }
};

struct MegaArgs { Params p; int ph_lo, ph_hi; };

__global__ void __launch_bounds__(MK_THREADS, 2) mega_fwd(MegaArgs args) {
    extern __shared__ __attribute__((aligned(16))) unsigned char lds_raw[];
    LAS unsigned char* lds = (LAS unsigned char*)lds_raw;
    const Params& p = args.p;
    unsigned char* ws = p.ws;
    const int lo = args.ph_lo, hi = args.ph_hi;
    const int G = gridDim.x;
    volatile LAS unsigned* misc = (volatile LAS unsigned*)(lds + LDS_MISC);
    if (threadIdx.x < 64) misc[threadIdx.x] = 0u;
    __syncthreads();
    XcdBarrier bar; bar.bar = (unsigned*)(ws + WS_CTL); bar.x = 0; bar.st = nullptr;
    bar = xcd_barrier_post((unsigned*)(ws + WS_CTL), misc);
    if (threadIdx.x == 0) { const unsigned xc = xb_xcc_id() & 7u; misc[16] = xc; misc[17] = atomicAdd((unsigned*)(ws + WS_CTL + 16384) + xc * 16, 1u); }
    __syncthreads();
#define IN(k) (lo <= (k) && (k) < hi)
#define SEAM(k) do { if (IN(k) && IN((k) + 1)) xcd_barrier(bar); } while (0)

    if (IN(0)) p0_prologue(p, lds, G);
    SEAM(0);
    if (IN(1)) {
        pg8::Gemm g{(const bf16_t*)(ws + WS_XB), (const bf16_t*)(ws + WS_WIN), NTOK, NPROJ, DM};
        pg8::StaticOrder S; S.init(NTOK, NPROJ, G, (int)blockIdx.x);
        EpiAdapt<EpiProj> E{{(const float*)(ws + WS_RS0), (bf16_t*)(ws + R_QB), (bf16_t*)(ws + R_KC), (float*)(ws + R_GATE), (float*)(ws + R_XR), (bf16_t*)(ws + R_XG)}};
        pg8::gemm_phase<EpiAdapt<EpiProj>, pg8::StaticOrder>(lds, g, S, E, nullptr);
    }
    SEAM(1);
    if (IN(2)) { if (!CMP_NAIVE) { p2_compress(p, lds, G); p2_vtranspose(p, lds, G); } lru_phase<false>(p, lds, G); }
    SEAM(2);
    if (IN(3)) { p3_attention(p, lds, G); if (!LRU_NAIVE) lru_phase<true>(p, lds, G);
#ifdef PROBE_LRU2
        lru_phase<true>(p, lds, G);
#endif
#ifdef PROBE_ATT2
        p3_attention(p, lds, G);
#endif
    }
    SEAM(3);
    if (IN(4)) {
        pg8::Gemm g{(const bf16_t*)(ws + WS_XB), (const bf16_t*)(ws + WS_WOUT), NTOK, DM, DM};
        pg8::StaticOrder S; S.init(NTOK, DM, G, (int)blockIdx.x);
        EpiAdaptSsq<EpiOutR> E{{p.in[I_X], p.out, (bf16_t*)(ws + R_H1B)}, (float*)(ws + WS_SSQ1)};
        pg8::gemm_phase<EpiAdaptSsq<EpiOutR>, pg8::StaticOrder>(lds, g, S, E, nullptr);
    }
    SEAM(4);
    if (IN(5)) p5_peer_route(p, lds, G);
    SEAM(5);
    if (IN(6)) {
#if PEER_V6 == 2
        p6v6_u(p, G); xcd_barrier(bar); p6v6_v(p, G);
#elif PEER_V6 == 4
        p6u_cols(p, G); xcd_barrier(bar); p6u_combine(p, G); xcd_barrier(bar); p6v3_v<0>(p, G);
#elif PEER_V6 == 3 && PEER_FP4
        p6f4_u(p, G); xcd_barrier(bar); p6f4_v<0>(p, G);
#elif PEER_V6 == 6 && PEER_I8U
        p6i8_u(p, G); xcd_barrier(bar); p6vs_v(p, lds, G);
#elif PEER_V6 == 5 && PEER_I8U
#if PEER_V4EXP
        p6i8_u(p, G); xcd_barrier(bar); p6v4_v(p, lds, G);
#else
        p6i8_u(p, G); xcd_barrier(bar); p6v8_v(p, lds, G);
#endif
#elif PEER_V6 == 3 && PEER_I8U
        p6i8_u(p, G);
#ifdef PROBE_U2
        p6i8_u(p, G);
#endif
        xcd_barrier(bar);
#ifdef PROBE_V2
        p6v3_v<1>(p, G);
#endif
        p6v3_v<0>(p, G);
#elif PEER_V6 == 3
        p6v6_u(p, G); xcd_barrier(bar); p6v3_v<0>(p, G);
#elif PEER_V6
        p6v6_peer(p, G);
#elif PEER_V3
        p6v5_u(p, lds, G);
#ifdef PROBE_U2
        p6v5_u(p, lds, G);
#endif
        xcd_barrier(bar); p6v3_v<0>(p, G);
#elif PEER_V2
        p6_peer_u(p, G);
#ifdef PROBE_U2
        p6_peer_u(p, G);
#endif
        xcd_barrier(bar); p6_peer_v(p, G);
#else
        p6_peer_apply(p, G);
#endif
    }
    SEAM(6);
    if (IN(7)) {
        {
            pg8::Gemm g{(const bf16_t*)(ws + WS_PB), (const bf16_t*)(ws + WS_WP), NTOK, DM, PLE};
            pg8::StaticOrder S; S.init(NTOK, DM, G, (int)blockIdx.x);
            EpiAdapt<EpiF32Plain> E{{(float*)(ws + R_BIG), DM, 0}};
            pg8::gemm_phase<EpiAdapt<EpiF32Plain>, pg8::StaticOrder>(lds, g, S, E, nullptr);
        }
        __syncthreads();
        {
            pg8::Gemm g{(const bf16_t*)(ws + R_H1B), (const bf16_t*)(ws + WS_WG), NTOK, DM, DM};
            pg8::StaticOrder S; S.init(NTOK, DM, G, (int)blockIdx.x);
            EpiAdaptSsq<EpiGateR> E{{(const float*)(ws + ((PEER_V2 && (!PEER_V6 || PEER_V6 == 3 || PEER_V6 == 4 || PEER_V6 == 6)) ? WS_SSQ2 : WS_RS2)), p.in[I_PLE_BG], (const float*)(ws + R_BIG), p.out}, (float*)(ws + WS_SSQ3)};
            pg8::gemm_phase<EpiAdaptSsq<EpiGateR>, pg8::StaticOrder>(lds, g, S, E, nullptr);
        }
    }
    SEAM(7);
    if (IN(8)) p8_final_norm(p, G);
#undef IN
#undef SEAM
}

static int g_grid = 0;
static void launch_mega(hipStream_t st, const Params& p, int lo, int hi) {
    if (g_grid == 0) {
        int dev = 0, cus = 0, per_cu = 0;
        hipGetDevice(&dev); hipDeviceGetAttribute(&cus, hipDeviceAttributeMultiprocessorCount, dev);
        if (hipFuncSetAttribute((const void*)mega_fwd, hipFuncAttributeMaxDynamicSharedMemorySize, LDS_BYTES) != hipSuccess) { fprintf(stderr, "hipFuncSetAttribute failed\n"); g_grid = -1; return; }
        if (hipOccupancyMaxActiveBlocksPerMultiprocessor(&per_cu, (const void*)mega_fwd, MK_THREADS, LDS_BYTES) != hipSuccess || per_cu < 1) { fprintf(stderr, "occupancy query: %d per CU\n", per_cu); }
        (void)hipGetLastError();
        g_grid = cus;
    }
    if (g_grid < 0) return;
    MegaArgs a{}; a.p = p; a.ph_lo = lo; a.ph_hi = hi;
    hipLaunchKernelGGL(mega_fwd, dim3(g_grid), dim3(MK_THREADS), LDS_BYTES, st, a);
}
template <class Epi> static void gemm_naive(hipStream_t st, const bf16_t* A, int lda, const bf16_t* Bt, int ldb, int M, int N, int K, const Epi& E) {
    hipLaunchKernelGGL((k_gemm_naive<Epi>), dim3(N / 64, M / 64), dim3(256), 0, st, A, lda, Bt, ldb, K, E);
}

static void run_prologue_naive(hipStream_t st, const Params& p) {
    unsigned char* ws = p.ws;
    hipLaunchKernelGGL(k_prep_x, dim3(NTOK), dim3(256), 0, st, p.in[I_X], (bf16_t*)(ws + WS_XB), (float*)(ws + WS_RS0));
    hipLaunchKernelGGL(k_prep_win, dim3((NPROJ * DM + 255) / 256), dim3(256), 0, st, p.in[I_W_IN], p.in[I_ATTN_NORM], (bf16_t*)(ws + WS_WIN));
    hipLaunchKernelGGL(k_transpose_bf16, dim3(DM * DM / 256), dim3(256), 0, st, p.in[I_W_OUT], (const float*)nullptr, (bf16_t*)(ws + WS_WOUT), DM, DM);
    hipLaunchKernelGGL(k_transpose_bf16, dim3(DM * DM / 256), dim3(256), 0, st, p.in[I_PLE_WG], p.in[I_PLE_NORM], (bf16_t*)(ws + WS_WG), DM, DM);
    hipLaunchKernelGGL(k_transpose_bf16, dim3(PLE * DM / 256), dim3(256), 0, st, p.in[I_PLE_PROJ], (const float*)nullptr, (bf16_t*)(ws + WS_WP), PLE, DM);
    hipLaunchKernelGGL(k_transpose_bf16, dim3(2048 * 256 / 256), dim3(256), 0, st, p.in[I_CK_W1], (const float*)nullptr, (bf16_t*)(ws + WS_CW1K), 2048, 256);
    hipLaunchKernelGGL(k_transpose_bf16, dim3(2048 * 256 / 256), dim3(256), 0, st, p.in[I_CV_W1], (const float*)nullptr, (bf16_t*)(ws + WS_CW1V), 2048, 256);
    hipLaunchKernelGGL(k_prep_wqs, dim3(DM * 16), dim3(128), 0, st, p.in[I_PEER_WQ], p.in[I_PEER_SUB], p.in[I_FFN_NORM], (bf16_t*)(ws + WS_WQS));
    hipLaunchKernelGGL(k_cvt_bf16, dim3(2048), dim3(256), 0, st, p.in[I_PEER_U], p.in[I_FFN_NORM], (bf16_t*)(ws + WS_UB), (size_t)16384 * DM / 4, DM);
    hipLaunchKernelGGL(k_cvt_bf16, dim3(2048), dim3(256), 0, st, p.in[I_PEER_V], (const float*)nullptr, (bf16_t*)(ws + WS_VB), (size_t)16384 * DM / 4, DM);
    hipLaunchKernelGGL(k_cvt_bf16, dim3(1024), dim3(256), 0, st, p.in[I_P], (const float*)nullptr, (bf16_t*)(ws + WS_PB), (size_t)NTOK * PLE / 4, PLE);
    hipLaunchKernelGGL(k_prep_cmpbias, dim3(1), dim3(256), 0, st, p.in[I_CK_PE], p.in[I_CK_W1], (float*)(ws + WS_CBK));
    hipLaunchKernelGGL(k_prep_cmpbias, dim3(1), dim3(256), 0, st, p.in[I_CV_PE], p.in[I_CV_W1], (float*)(ws + WS_CBV));
}
static void run_p1_naive(hipStream_t st, const Params& p) {
    unsigned char* ws = p.ws;
    EpiProj E{(const float*)(ws + WS_RS0), (bf16_t*)(ws + R_QB), (bf16_t*)(ws + R_KC), (float*)(ws + R_GATE), (float*)(ws + R_XR), (bf16_t*)(ws + R_XG)};
    gemm_naive(st, (const bf16_t*)(ws + WS_XB), DM, (const bf16_t*)(ws + WS_WIN), DM, NTOK, NPROJ, DM, E);
}
static void run_p2_naive(hipStream_t st, const Params& p) {
    unsigned char* ws = p.ws;
    float* hid = (float*)(ws + WS_HID);
    hipLaunchKernelGGL(k_cmp_hidden, dim3(2048), dim3(256), 0, st, (const bf16_t*)(ws + R_KC), (const bf16_t*)(ws + WS_CW1K), (const float*)(ws + WS_CBK), hid);
    hipLaunchKernelGGL(k_cmp_hidden, dim3(2048), dim3(256), 0, st, (const bf16_t*)(ws + R_VC), (const bf16_t*)(ws + WS_CW1V), (const float*)(ws + WS_CBV), hid + (size_t)2048 * 256);
    hipLaunchKernelGGL(k_cmp_out, dim3(2048), dim3(64), 0, st, (const float*)hid, p.in[I_CK_W2], (float*)(ws + WS_KCMP));
    hipLaunchKernelGGL(k_cmp_out, dim3(2048), dim3(64), 0, st, (const float*)(hid + (size_t)2048 * 256), p.in[I_CV_W2], (float*)(ws + WS_VCMP));
}
static void run_p2_extras(hipStream_t st, const Params& p) {
    unsigned char* ws = p.ws;
    hipLaunchKernelGGL(k_p2_extras, dim3(2048), dim3(256), 0, st, (const bf16_t*)(ws + R_VS), (const bf16_t*)(ws + R_VW), (const float*)(ws + WS_KCMP), (const float*)(ws + WS_VCMP),
                       (bf16_t*)(ws + R_VST), (bf16_t*)(ws + R_VWT), (bf16_t*)(ws + R_KCB), (bf16_t*)(ws + R_VCT));
}
static void run_lru_naive(hipStream_t st, const Params& p) {
    unsigned char* ws = p.ws;
    LruArgs la{(const float*)(ws + R_XR), (const bf16_t*)(ws + R_XG), p.in[I_CONV_W], p.in[I_CONV_B], p.in[I_LRU_WA], p.in[I_LRU_BA], p.in[I_LRU_WX], p.in[I_LRU_BX], p.in[I_LRU_LAM], p.out};
    hipLaunchKernelGGL(k_lru_naive, dim3(NB * 8), dim3(64), 0, st, la);
    hipLaunchKernelGGL(k_grpnorm_lru, dim3(NTOK), dim3(256), 0, st, (const float*)p.out, p.in[I_GN_LRU], (bf16_t*)(ws + WS_XB));
}
static void run_p3_naive(hipStream_t st, const Params& p) {
    unsigned char* ws = p.ws;
    NsaArgs na{(const bf16_t*)(ws + R_QB), (const bf16_t*)(ws + R_KS), (const bf16_t*)(ws + R_VS), (const bf16_t*)(ws + R_KW), (const bf16_t*)(ws + R_VW),
               (const float*)(ws + WS_KCMP), (const float*)(ws + WS_VCMP), (const float*)(ws + R_GATE), p.in[I_REL], p.out};
    hipLaunchKernelGGL(k_nsa_naive, dim3(NB * NKV * T_), dim3(256), 0, st, na);
    LruArgs la{(const float*)(ws + R_XR), (const bf16_t*)(ws + R_XG), p.in[I_CONV_W], p.in[I_CONV_B], p.in[I_LRU_WA], p.in[I_LRU_BA], p.in[I_LRU_WX], p.in[I_LRU_BX], p.in[I_LRU_LAM], p.out};
    hipLaunchKernelGGL(k_lru_naive, dim3(NB * 8), dim3(64), 0, st, la);
    hipLaunchKernelGGL(k_grpnorm, dim3(NTOK), dim3(256), 0, st, (const float*)p.out, p.in[I_GN_ATTN], p.in[I_GN_LRU], (bf16_t*)(ws + WS_XB));
}
static void run_p4_naive(hipStream_t st, const Params& p) {
    unsigned char* ws = p.ws;
    EpiOut E{p.in[I_X], p.out, (bf16_t*)(ws + R_H1B)};
    gemm_naive(st, (const bf16_t*)(ws + WS_XB), DM, (const bf16_t*)(ws + WS_WOUT), DM, NTOK, DM, DM, E);
    hipLaunchKernelGGL(k_rowssq, dim3(NTOK), dim3(256), 0, st, (const float*)p.out, (float*)(ws + WS_SSQ1));
}
static void run_p5_naive(hipStream_t st, const Params& p) {
    unsigned char* ws = p.ws;
    for (int hh = 0; hh < 2; ++hh) {
        EpiF32Plain E{(float*)(ws + R_BIG), 1024, 0};
        gemm_naive(st, (const bf16_t*)(ws + R_H1B), DM, (const bf16_t*)(ws + WS_WQS) + (size_t)hh * 1024 * DM, DM, NTOK, 1024, DM, E);
        hipLaunchKernelGGL(k_peer_route, dim3(NTOK * 4), dim3(256), 0, st, (const float*)(ws + R_BIG), (const float*)(ws + WS_SSQ1), hh, (int*)(ws + R_EXP), (float*)(ws + R_GSM));
    }
}
static void run_p6_naive(hipStream_t st, const Params& p) {
    unsigned char* ws = p.ws;
    hipLaunchKernelGGL(k_peer_apply, dim3(NTOK), dim3(256), 0, st, (const bf16_t*)(ws + WS_UB), (const bf16_t*)(ws + WS_VB), (const int*)(ws + R_EXP), (const float*)(ws + R_GSM),
                       (const float*)(ws + WS_SSQ1), p.out, (bf16_t*)(ws + R_H1B), (float*)(ws + WS_RS2));
}
static void run_p7_naive(hipStream_t st, const Params& p) {
    unsigned char* ws = p.ws;
    EpiF32Plain Ep{(float*)(ws + R_BIG), DM, 0};
    gemm_naive(st, (const bf16_t*)(ws + WS_PB), PLE, (const bf16_t*)(ws + WS_WP), PLE, NTOK, DM, PLE, Ep);
    EpiGate Eg{(const float*)(ws + WS_RS2), p.in[I_PLE_BG], (const float*)(ws + R_BIG), p.out};
    gemm_naive(st, (const bf16_t*)(ws + R_H1B), DM, (const bf16_t*)(ws + WS_WG), DM, NTOK, DM, DM, Eg);
    hipLaunchKernelGGL(k_rowssq, dim3(NTOK), dim3(256), 0, st, (const float*)p.out, (float*)(ws + WS_SSQ3));
}
static void run_p8_naive(hipStream_t st, const Params& p) {
    hipLaunchKernelGGL(k_final_norm, dim3(NTOK), dim3(256), 0, st, p.out, (const float*)(p.ws + WS_SSQ3), p.in[I_FINAL_NORM]);
}
static void run_phase(hipStream_t st, const Params& p, int k) {
    switch (k) {
        case 0: run_prologue_naive(st, p); break;
        case 1: run_p1_naive(st, p); break;
        case 2: run_p2_naive(st, p); if ((OPT_MASK >> 3) & 1) run_p2_extras(st, p); break;
        case 3: run_p3_naive(st, p); break;
        case 4: run_p4_naive(st, p); break;
        case 5: run_p5_naive(st, p); break;
        case 6: run_p6_naive(st, p); break;
        case 7: run_p7_naive(st, p); break;
        case 8: run_p8_naive(st, p); break;
    }
}
extern "C" void kernel_launch(void* const* d_in, const int* in_sizes, int n_in, void* d_out, int out_size, void* d_ws, size_t ws_size, hipStream_t stream) {
    if (n_in != 31 || out_size != NTOK * DM || ws_size < WS_END) { fprintf(stderr, "kernel_launch: unexpected shapes (n_in %d out %d ws %zu)\n", n_in, out_size, ws_size); return; }
    Params p{};
    for (int i = 0; i < 31; ++i) p.in[i] = (const float*)d_in[i];
    p.out = (float*)d_out; p.ws = (unsigned char*)d_ws;
#ifdef PROBE_DOUBLE
    hipMemsetAsync((char*)d_ws + WS_CTL, 0, 16384 + 1024, stream);
    launch_mega(stream, p, 0, PROBE_DOUBLE);
#endif
    int k = 0;
#ifdef PROBE_DOUBLE
    k = PROBE_START;
#endif
    while (k <= 8) {
        if ((OPT_MASK >> k) & 1) {
            int e = k; while (e <= 8 && ((OPT_MASK >> e) & 1)) ++e;
            if (LRU_NAIVE && k <= 3 && e > 4) e = 4;
            if (CMP_NAIVE && k <= 1 && e > 2) e = 2;
            if (CMP_NAIVE && k == 2) { run_p2_naive(stream, p); run_p2_extras(stream, p); }
            hipMemsetAsync((char*)d_ws + WS_CTL, 0, 16384 + 1024, stream);
            launch_mega(stream, p, k, e);
            if (LRU_NAIVE && k <= 3 && e == 4) run_lru_naive(stream, p);
            k = e;
        } else { run_phase(stream, p, k); ++k; }
    }
}
```

```cpp
#include <hip/hip_runtime.h>
#include <stdint.h>
#include <stdio.h>

typedef unsigned short bf16_t;
typedef float f32x4 __attribute__((ext_vector_type(4)));
typedef float f32x2 __attribute__((ext_vector_type(2)));
typedef unsigned u32x4 __attribute__((ext_vector_type(4)));
typedef unsigned u32x2 __attribute__((ext_vector_type(2)));
#define DI __device__ __forceinline__

constexpr int NB = 4, T_ = 4096, DM = 1024, NTOK = NB * T_;
constexpr int NH = 8, HD = 64, NKV = 2, GRP = 4, ATTW = 512, KVW = 128, LRUW = 512;
constexpr int INCOLS = 2328, NPROJ = 2560;
constexpr int NCMP = 255, NSEL = 64;
constexpr int PEER_H = 8, PEER_K = 16, PEER_NK = 128;
constexpr int PLE = 256;
constexpr float EPS = 1e-6f;

constexpr int PC_KV = 512, PC_XR = 1280, PC_XG = 1792, PC_GATE = 2304;

constexpr size_t MB = 1024 * 1024;
constexpr size_t WS_CTL   = 0;
constexpr size_t WS_WIN   = 64 * 1024;
constexpr size_t WS_WOUT  = WS_WIN  + (size_t)NPROJ * DM * 2;
constexpr size_t WS_WQS   = WS_WOUT + (size_t)DM * DM * 2;
constexpr size_t WS_WG    = WS_WQS  + (size_t)2048 * DM * 2;
constexpr size_t WS_WP    = WS_WG   + (size_t)DM * DM * 2;
constexpr size_t WS_CW1K  = WS_WP   + (size_t)DM * PLE * 2;
constexpr size_t WS_CW1V  = WS_CW1K + (size_t)256 * 2048 * 2;
constexpr size_t WS_CBK   = WS_CW1V + (size_t)256 * 2048 * 2;
constexpr size_t WS_CBV   = WS_CBK  + 1024;
constexpr size_t WS_RS0   = WS_CBV  + 1024;
constexpr size_t WS_RS2   = WS_RS0  + (size_t)NTOK * 4;
constexpr size_t WS_RS1   = WS_RS2  + (size_t)NTOK * 4;
constexpr size_t WS_SSQ2  = WS_RS1  + (size_t)NTOK * 4;
constexpr size_t WS_SSQ1  = WS_SSQ2 + (size_t)16 * NTOK * 4;
constexpr size_t WS_SSQ3  = WS_SSQ1 + (size_t)16 * NTOK * 4;
constexpr size_t WS_KCMP  = WS_SSQ3 + (size_t)16 * NTOK * 4;
constexpr size_t WS_VCMP  = WS_KCMP + (size_t)8 * 256 * 64 * 4;
constexpr size_t WS_LRUP  = WS_VCMP + (size_t)8 * 256 * 64 * 4;
constexpr size_t WS_LRUH  = WS_LRUP + (size_t)256 * 512 * 4;
constexpr size_t WS_WAT   = WS_LRUH + (size_t)256 * 512 * 4;
constexpr size_t WS_WXT   = WS_WAT + 8 * 64 * 64 * 2;
constexpr size_t WS_CW2K  = WS_WXT + 8 * 64 * 64 * 2;
constexpr size_t WS_CW2V  = WS_CW2K + 64 * 256 * 2;
constexpr size_t WS_HID   = WS_CW2V + 64 * 256 * 2;
constexpr size_t WS_UB    = (WS_HID + (size_t)2 * 2048 * 256 * 4 + 4095) / 4096 * 4096;
constexpr size_t WS_VB    = WS_UB + (size_t)16384 * DM * 2;
constexpr size_t WS_PB    = WS_VB + (size_t)16384 * DM * 2;
constexpr size_t WS_XB    = WS_PB + (size_t)NTOK * PLE * 2;
constexpr size_t WS_R     = WS_XB + (size_t)NTOK * DM * 2;
constexpr size_t KVT = (size_t)NB * NKV * T_ * HD * 2 + 65536;
constexpr size_t R_QB    = WS_R;
constexpr size_t R_KC    = R_QB + (size_t)NTOK * 512 * 2;
constexpr size_t R_VC    = R_KC + KVT;
constexpr size_t R_KS    = R_VC + KVT;
constexpr size_t R_VS    = R_KS + KVT;
constexpr size_t R_KW    = R_VS + KVT;
constexpr size_t R_VW    = R_KW + KVT;
constexpr size_t R_GATE  = R_VW + KVT;
constexpr size_t R_XR    = R_GATE + (size_t)NTOK * 24 * 4;
constexpr size_t R_XG    = R_XR + (size_t)NTOK * 512 * 4;
constexpr size_t R_VST   = R_XG + (size_t)NTOK * 512 * 2;
constexpr size_t R_VWT   = R_VST + KVT;
constexpr size_t R_KCB   = R_VWT + KVT;
constexpr size_t R_VCT   = R_KCB + (size_t)8 * 256 * 64 * 2;
constexpr size_t R_END13 = R_VCT + (size_t)8 * 256 * 64 * 2;
constexpr size_t R_H1B   = WS_R;
constexpr size_t R_EXP   = R_H1B + (size_t)NTOK * DM * 2;
constexpr size_t R_GSM   = R_EXP + (size_t)NTOK * 128 * 4;
constexpr size_t R_COEF  = R_GSM + (size_t)NTOK * 128 * 4;
constexpr size_t R_BIG   = R_COEF + (size_t)NTOK * 128 * 4;
constexpr size_t WS_END  = (R_END13 > R_BIG + 64 * MB ? R_END13 : R_BIG + 64 * MB);
static_assert(WS_END <= 256 * MB, "workspace map exceeds 256 MiB");

DI float bf2f(bf16_t v) { return __uint_as_float((unsigned)v << 16); }
DI bf16_t f2bf(float x) { unsigned u = __float_as_uint(x); u += 0x7fffu + ((u >> 16) & 1u); return (bf16_t)(u >> 16); }
DI unsigned pack2bf(float lo, float hi) { return (unsigned)f2bf(lo) | ((unsigned)f2bf(hi) << 16); }
DI float gelu_tanh(float x) { const float u = 0.7978845608028654f * (x + 0.044715f * x * x * x); return 0.5f * x * (1.0f + tanhf(u)); }
DI float sigmoidf_(float x) { return 1.0f / (1.0f + __expf(-x)); }

__device__ const unsigned char REL_BUCKET_LUT[128] = {
0,1,2,3,4,5,6,7,8,9,10,11,12,13,14,15,16,16,16,17,17,18,18,18,19,19,19,20,20,20,20,21,21,21,21,22,22,22,22,22,23,23,23,23,23,23,24,24,24,24,24,24,25,25,25,25,25,25,25,26,26,26,26,26,26,26,26,27,27,27,27,27,27,27,27,27,27,28,28,28,28,28,28,28,28,28,28,29,29,29,29,29,29,29,29,29,29,29,29,30,30,30,30,30,30,30,30,30,30,30,30,30,30,31,31,31,31,31,31,31,31,31,31,31,31,31,31,31};
DI int rel_bucket(int dist) { dist = dist < 0 ? 0 : dist; return dist >= 128 ? 31 : (int)REL_BUCKET_LUT[dist]; }

struct Params {
    const float* in[31];
    float* out;
    unsigned char* ws;
};
enum { I_X = 0, I_P, I_ATTN_NORM, I_W_IN, I_CK_PE, I_CK_W1, I_CK_W2, I_CV_PE, I_CV_W1, I_CV_W2, I_REL, I_CONV_W, I_CONV_B, I_LRU_WA, I_LRU_BA, I_LRU_WX, I_LRU_BX,
       I_LRU_LAM, I_GN_ATTN, I_GN_LRU, I_W_OUT, I_FFN_NORM, I_PEER_WQ, I_PEER_SUB, I_PEER_U, I_PEER_V, I_PLE_NORM, I_PLE_WG, I_PLE_BG, I_PLE_PROJ, I_FINAL_NORM };

struct EpiProj {
    const float* rs0; bf16_t* qb; bf16_t* kv0; float* gates; float* xr; bf16_t* xg;
    DI void store4(int row, int col, f32x4 v) const {
        const float s = rs0[row];
        v *= s;
        if (col < PC_KV) { v *= 0.125f * 1.4426950408889634f;     u32x2 w; w.x = pack2bf(v[0], v[1]); w.y = pack2bf(v[2], v[3]); *(u32x2*)(qb + (size_t)row * 512 + col) = w; }
        else if (col < PC_XR) {
            const int c = col - PC_KV, tensor = c >> 7, within = c & 127, kvh = within >> 6, d = within & 63, b = row >> 12, t = row & 4095;
            bf16_t* dst = (bf16_t*)((unsigned char*)kv0 + (size_t)tensor * KVT) + ((size_t)(b * NKV + kvh) * T_ + t) * HD + d;
            u32x2 w; w.x = pack2bf(v[0], v[1]); w.y = pack2bf(v[2], v[3]); *(u32x2*)dst = w;
        }
        else if (col < PC_XG) { *(f32x4*)(xr + (size_t)row * 512 + (col - PC_XR)) = v; }
        else if (col < PC_GATE) { u32x2 w; w.x = pack2bf(v[0], v[1]); w.y = pack2bf(v[2], v[3]); *(u32x2*)(xg + (size_t)row * 512 + (col - PC_XG)) = w; }
        else if (col < PC_GATE + 24) { *(f32x4*)(gates + (size_t)row * 24 + (col - PC_GATE)) = v; }
    }
};
struct EpiOut {
    const float* x; float* h1; bf16_t* h1b;
    DI void store4(int row, int col, f32x4 v) const {
        const size_t o = (size_t)row * DM + col;
        v += *(const f32x4*)(x + o);
        *(f32x4*)(h1 + o) = v;
        u32x2 w; w.x = pack2bf(v[0], v[1]); w.y = pack2bf(v[2], v[3]); *(u32x2*)(h1b + o) = w;
    }
};
struct EpiF32Plain { float* C; int ldc; int coloff;
    DI void store4(int row, int col, f32x4 v) const { *(f32x4*)(C + (size_t)row * ldc + (col - coloff)) = v; } };
struct EpiGate {
    const float* rs2; const float* bias; const float* pp; float* h;
    DI void store4(int row, int col, f32x4 v) const {
        const size_t o = (size_t)row * DM + col;
        const float s = rs2[row];
        const f32x4 bb = *(const f32x4*)(bias + col), p4 = *(const f32x4*)(pp + o);
        f32x4 hv = *(f32x4*)(h + o);
#pragma unroll
        for (int j = 0; j < 4; ++j) hv[j] += sigmoidf_(v[j] * s + bb[j]) * p4[j];
        *(f32x4*)(h + o) = hv;
    }
};
#ifndef LRU_NAIVE
#define LRU_NAIVE 0
#endif
#ifndef CMP_NAIVE
#define CMP_NAIVE 0
#endif
#ifndef OPT_MASK
#define OPT_MASK 0x1FF
#endif
#ifndef PEER_V6
#define PEER_V6 5
#endif
#ifndef PEER_V3
#define PEER_V3 1
#endif
#ifndef PEER_V2
#define PEER_V2 1
#endif
#ifndef XCC_HW
#define XCC_HW 0
#endif
#ifndef PEER_FP4
#define PEER_FP4 0
#endif
#ifndef PEER_I8U
#define PEER_I8U 1
#endif
#ifndef PEER_V4EXP
#define PEER_V4EXP 1
#endif
#ifndef PEER_FUSED
#define PEER_FUSED 1
#endif
DI float wave_sum(float v) {
#pragma unroll
    for (int o = 32; o > 0; o >>= 1) v += __shfl_xor(v, o);
    return v;
}
DI float wave_max(float v) {
#pragma unroll
    for (int o = 32; o > 0; o >>= 1) v = fmaxf(v, __shfl_xor(v, o));
    return v;
}
DI float block_sum256(float v, float* red) {
    v = wave_sum(v); __syncthreads();
    if ((threadIdx.x & 63) == 0) red[threadIdx.x >> 6] = v; __syncthreads();
    return (red[0] + red[1]) + (red[2] + red[3]);
}
DI float block_max256(float v, float* red) {
    v = wave_max(v); __syncthreads();
    if ((threadIdx.x & 63) == 0) red[threadIdx.x >> 6] = v; __syncthreads();
    return fmaxf(fmaxf(red[0], red[1]), fmaxf(red[2], red[3]));
}

__global__ __launch_bounds__(256) void k_prep_x(const float* __restrict__ x, bf16_t* __restrict__ xb, float* __restrict__ rs0) {
    __shared__ float red[8];
    const int row = blockIdx.x, t = threadIdx.x;
    const f32x4 v = *(const f32x4*)(x + (size_t)row * DM + t * 4);
    float s = v[0] * v[0] + v[1] * v[1] + v[2] * v[2] + v[3] * v[3];
    s = block_sum256(s, red);
    u32x2 w; w.x = pack2bf(v[0], v[1]); w.y = pack2bf(v[2], v[3]);
    *(u32x2*)(xb + (size_t)row * DM + t * 4) = w;
    if (t == 0) rs0[row] = rsqrtf(s * (1.0f / DM) + EPS);
}
__global__ void k_prep_win(const float* __restrict__ w_in, const float* __restrict__ gain, bf16_t* __restrict__ WinT) {
    const int idx = blockIdx.x * blockDim.x + threadIdx.x;
    if (idx >= NPROJ * DM) return;
    const int n = idx / DM, k = idx % DM;
    int src = -1;
    if (n < PC_XR) src = n; else if (n < PC_XG) src = 1304 + (n - PC_XR); else if (n < PC_GATE) src = 1816 + (n - PC_XG); else if (n < PC_GATE + 24) src = 1280 + (n - PC_GATE);
    WinT[idx] = src >= 0 ? f2bf(w_in[(size_t)k * INCOLS + src] * gain[k]) : (bf16_t)0;
}
__global__ void k_transpose_bf16(const float* __restrict__ src, const float* __restrict__ gain, bf16_t* __restrict__ dst, int K, int N) {
    const int idx = blockIdx.x * blockDim.x + threadIdx.x;
    if (idx >= K * N) return;
    const int n = idx / K, k = idx % K;
    dst[idx] = f2bf(src[(size_t)k * N + n] * (gain ? gain[k] : 1.0f));
}
__global__ __launch_bounds__(128) void k_prep_wqs(const float* __restrict__ wq, const float* __restrict__ sub, const float* __restrict__ gain, bf16_t* __restrict__ WqsT) {
    __shared__ float wrow[128];
    const int d = blockIdx.x % DM, hp = blockIdx.x / DM, p = hp & 1, kk = threadIdx.x;
    wrow[kk] = wq[(size_t)d * 2048 + hp * 128 + kk];
    __syncthreads();
    const float* sk = sub + ((size_t)p * 128 + kk) * 128;
    float acc = 0.f;
    for (int j = 0; j < 128; ++j) acc += wrow[j] * sk[j];
    WqsT[(size_t)(hp * 128 + kk) * DM + d] = f2bf(acc * gain[d]);
}
__global__ void k_cvt_bf16(const float* __restrict__ src, const float* __restrict__ gain, bf16_t* __restrict__ dst, size_t n4, int cols) {
    for (size_t i = (size_t)blockIdx.x * blockDim.x + threadIdx.x; i < n4; i += (size_t)gridDim.x * blockDim.x) {
        f32x4 v = *(const f32x4*)(src + i * 4);
        if (gain) { const f32x4 g = *(const f32x4*)(gain + (i * 4) % cols); v *= g; }
        u32x2 w; w.x = pack2bf(v[0], v[1]); w.y = pack2bf(v[2], v[3]);
        *(u32x2*)(dst + i * 4) = w;
    }
}
__global__ __launch_bounds__(256) void k_prep_cmpbias(const float* __restrict__ pe, const float* __restrict__ w1, float* __restrict__ cb) {
    const int j = threadIdx.x; float acc = 0.f;
    for (int k = 0; k < 2048; ++k) acc += pe[k] * w1[(size_t)k * 256 + j];
    cb[j] = acc;
}

template <class Epi>
__global__ __launch_bounds__(256) void k_gemm_naive(const bf16_t* __restrict__ A, int lda, const bf16_t* __restrict__ Bt, int ldb, int K, Epi E) {
    __shared__ float As[32][68], Bs[32][68];
    const int t = threadIdx.x, tx = t & 15, ty = t >> 4;
    const int row0 = blockIdx.y * 64, col0 = blockIdx.x * 64;
    float acc[4][4] = {};
    const int lr = t >> 2, lk = (t & 3) * 8;
    for (int k0 = 0; k0 < K; k0 += 32) {
        const u32x4 av = *(const u32x4*)(A + (size_t)(row0 + lr) * lda + k0 + lk);
        const u32x4 bv = *(const u32x4*)(Bt + (size_t)(col0 + lr) * ldb + k0 + lk);
        __syncthreads();
#pragma unroll
        for (int j = 0; j < 4; ++j) {
            As[lk + 2 * j][lr] = __uint_as_float(av[j] << 16); As[lk + 2 * j + 1][lr] = __uint_as_float(av[j] & 0xffff0000u);
            Bs[lk + 2 * j][lr] = __uint_as_float(bv[j] << 16); Bs[lk + 2 * j + 1][lr] = __uint_as_float(bv[j] & 0xffff0000u);
        }
        __syncthreads();
#pragma unroll
        for (int k = 0; k < 32; ++k) {
            const f32x4 a = *(const f32x4*)&As[k][ty * 4], b = *(const f32x4*)&Bs[k][tx * 4];
#pragma unroll
            for (int i = 0; i < 4; ++i)
#pragma unroll
                for (int j = 0; j < 4; ++j) acc[i][j] += a[i] * b[j];
        }
    }
#pragma unroll
    for (int i = 0; i < 4; ++i) E.store4(row0 + ty * 4 + i, col0 + tx * 4, (f32x4){acc[i][0], acc[i][1], acc[i][2], acc[i][3]});
}

__global__ __launch_bounds__(256) void k_cmp_hidden(const bf16_t* __restrict__ kvb, const bf16_t* __restrict__ W1T, const float* __restrict__ cb, float* __restrict__ hidden) {
    const int row = blockIdx.x, j = threadIdx.x, bh = row >> 8, c = row & 255;
    if (c >= NCMP) { hidden[(size_t)row * 256 + j] = 0.f; return; }
    const bf16_t* a = kvb + ((size_t)bh * T_ + 16 * c) * HD;
    const bf16_t* w = W1T + (size_t)j * 2048;
    float acc = 0.f;
    for (int k = 0; k < 2048; ++k) acc += bf2f(a[k]) * bf2f(w[k]);
    hidden[(size_t)row * 256 + j] = acc + cb[j];
}
__global__ __launch_bounds__(64) void k_cmp_out(const float* __restrict__ hidden, const float* __restrict__ w2, float* __restrict__ out) {
    const int row = blockIdx.x, d = threadIdx.x;
    float acc = 0.f;
    for (int j = 0; j < 256; ++j) acc += gelu_tanh(hidden[(size_t)row * 256 + j]) * w2[j * 64 + d];
    out[(size_t)row * 64 + d] = acc;
}

struct NsaArgs { const bf16_t* qb; const bf16_t* ks; const bf16_t* vs; const bf16_t* kw; const bf16_t* vw; const float* kcmp; const float* vcmp; const float* gates; const float* rel; float* raw; };
template <bool KF32> DI void nsa_logits(int nk, const void* Kbase, const int* kp, const int* dist, float (*lg)[1024], const float (*qs)[64], const float* rel, int kvh) {
    for (int idx = threadIdx.x; idx < nk; idx += 256) {
        float acc[4] = {0.f, 0.f, 0.f, 0.f};
        if (dist[idx] >= 0) {
            if (KF32) { const float* kr = (const float*)Kbase + (size_t)kp[idx] * HD;
                for (int d = 0; d < 64; ++d) { const float kv = kr[d]; for (int g = 0; g < 4; ++g) acc[g] += qs[g][d] * kv; } }
            else { const bf16_t* kr = (const bf16_t*)Kbase + (size_t)kp[idx] * HD;
                for (int d = 0; d < 64; ++d) { const float kv = bf2f(kr[d]); for (int g = 0; g < 4; ++g) acc[g] += qs[g][d] * kv; } }
            const int bk = rel_bucket(dist[idx]);
            for (int g = 0; g < 4; ++g) lg[g][idx] = acc[g] + rel[bk * NH + kvh * 4 + g];
        } else { for (int g = 0; g < 4; ++g) lg[g][idx] = -INFINITY; }
    }
}
DI void nsa_softmax(int nk, float (*lg)[1024], float* inv, float* red) {
    for (int g = 0; g < 4; ++g) {
        float m = -INFINITY;
        for (int idx = threadIdx.x; idx < nk; idx += 256) m = fmaxf(m, lg[g][idx]);
        m = block_max256(m, red);
        float s = 0.f;
        for (int idx = threadIdx.x; idx < nk; idx += 256) { const float l = lg[g][idx]; const float e = (l == -INFINITY) ? 0.f : __expf(l - m); lg[g][idx] = e; s += e; }
        s = block_sum256(s, red);
        if (threadIdx.x == 0) inv[g] = 1.0f / s;
    }
    __syncthreads();
}
template <bool VF32> DI float nsa_pv(int nk, const void* Vbase, const int* kp, const float (*lg)[1024], const float* inv) {
    const int g = threadIdx.x >> 6, d = threadIdx.x & 63;
    float acc = 0.f;
    for (int idx = 0; idx < nk; ++idx) {
        const float v = VF32 ? ((const float*)Vbase)[(size_t)kp[idx] * HD + d] : bf2f(((const bf16_t*)Vbase)[(size_t)kp[idx] * HD + d]);
        acc += lg[g][idx] * v;
    }
    return acc * inv[g];
}
__global__ __launch_bounds__(256) void k_nsa_naive(NsaArgs a) {
    __shared__ float qs[4][64]; __shared__ float lg[4][1024]; __shared__ int kp[1024]; __shared__ int dist[1024];
    __shared__ float red[8]; __shared__ float inv[4]; __shared__ float imp[64]; __shared__ float vals[64]; __shared__ int selblk[16]; __shared__ int nsel_s;
    const int tid = threadIdx.x, t = blockIdx.x % T_, kvh = (blockIdx.x / T_) % NKV, b = blockIdx.x / (T_ * NKV), bh = b * NKV + kvh;
    const int g = tid >> 6, d = tid & 63, h = kvh * 4 + g;
    const size_t tok = (size_t)b * T_ + t;
    qs[g][d] = bf2f(a.qb[tok * 512 + h * 64 + d]);
    if (tid == 0) nsel_s = 0;
    const int ncv = t >= 31 ? (t - 31) / 16 + 1 : 0;
    for (int idx = tid; idx < ncv; idx += 256) { kp[idx] = idx; dist[idx] = t - (16 * idx + 31); }
    __syncthreads();
    float o_c = 0.f;
    if (ncv > 0) {
        nsa_logits<true>(ncv, a.kcmp + (size_t)bh * 256 * HD, kp, dist, lg, qs, a.rel, kvh);
        __syncthreads();
        nsa_softmax(ncv, lg, inv, red);
        o_c = nsa_pv<true>(ncv, a.vcmp + (size_t)bh * 256 * HD, kp, lg, inv);
    }
    if (tid < 64) {
        float s = 0.f;
        for (int gg = 0; gg < 4; ++gg) {
            float sg = 0.f;
            for (int j = -1; j <= 3; ++j) { const int c = 4 * tid + j; if (c >= 0 && c < ncv) sg += lg[gg][c] * ((j == -1 || j == 3) ? 0.5f : 1.0f); }
            s += sg * inv[gg];
        }
        if (ncv == 0) s = 0.f;
        const int qblk = t >> 6, db = qblk - tid;
        vals[tid] = (db >= 0 && db < 2) ? 2.0e4f : (tid == 0 ? 1.0e4f : (db >= 0 ? s : -1.0f));
    }
    __syncthreads();
    if (tid < 64) {
        const float v = vals[tid]; int rank = 0;
        for (int s2 = 0; s2 < 64; ++s2) { const float w = vals[s2]; rank += (w > v || (w == v && s2 < tid)) ? 1 : 0; }
        if (rank < 16 && (t >> 6) - tid >= 0) { const int slot = atomicAdd(&nsel_s, 1); selblk[slot] = tid; }
    }
    __syncthreads();
    const int nsel = nsel_s, nks = nsel * 64;
    for (int idx = tid; idx < nks; idx += 256) { const int kpos = selblk[idx >> 6] * 64 + (idx & 63); kp[idx] = kpos; dist[idx] = t - kpos; }
    __syncthreads();
    nsa_logits<false>(nks, a.ks + (size_t)bh * T_ * HD, kp, dist, lg, qs, a.rel, kvh);
    __syncthreads();
    nsa_softmax(nks, lg, inv, red);
    const float o_s = nsa_pv<false>(nks, a.vs + (size_t)bh * T_ * HD, kp, lg, inv);
    __syncthreads();
    const int lo = t - 511 > 0 ? t - 511 : 0, nkw = t - lo + 1;
    for (int idx = tid; idx < nkw; idx += 256) { kp[idx] = lo + idx; dist[idx] = t - (lo + idx); }
    __syncthreads();
    nsa_logits<false>(nkw, a.kw + (size_t)bh * T_ * HD, kp, dist, lg, qs, a.rel, kvh);
    __syncthreads();
    nsa_softmax(nkw, lg, inv, red);
    const float o_w = nsa_pv<false>(nkw, a.vw + (size_t)bh * T_ * HD, kp, lg, inv);
    const float* gt = a.gates + tok * 24 + h * 3;
    a.raw[tok * DM + h * 64 + d] = sigmoidf_(gt[0]) * o_c + sigmoidf_(gt[1]) * o_s + sigmoidf_(gt[2]) * o_w;
}

struct LruArgs { const float* xr; const bf16_t* xg; const float* conv_w; const float* conv_b; const float* wa; const float* ba; const float* wx; const float* bx; const float* lam; float* raw; };
__global__ __launch_bounds__(64) void k_lru_naive(LruArgs a) {
    __shared__ float xs[64];
    const int tid = threadIdx.x, n = blockIdx.x & 7, b = blockIdx.x >> 3, ch = n * 64 + tid;
    float war[64], wxr[64];
#pragma unroll
    for (int c = 0; c < 64; ++c) { war[c] = a.wa[(size_t)(n * 64 + c) * 64 + tid]; wxr[c] = a.wx[(size_t)(n * 64 + c) * 64 + tid]; }
    const float cw0 = a.conv_w[0 * 512 + ch], cw1 = a.conv_w[1 * 512 + ch], cw2 = a.conv_w[2 * 512 + ch], cw3 = a.conv_w[3 * 512 + ch], cb = a.conv_b[ch];
    const float ba = a.ba[ch], bx = a.bx[ch], sp = log1pf(__expf(-a.lam[ch]));
    float x3 = 0.f, x2 = 0.f, x1 = 0.f, h = 0.f;
    for (int t = 0; t < T_; ++t) {
        const size_t tok = (size_t)b * T_ + t;
        const float x0 = a.xr[tok * 512 + ch];
        const float xc = cw0 * x3 + cw1 * x2 + cw2 * x1 + cw3 * x0 + cb;
        x3 = x2; x2 = x1; x1 = x0;
        __syncthreads();
        xs[tid] = xc;
        __syncthreads();
        float rp = 0.f, ip = 0.f;
#pragma unroll
        for (int c = 0; c < 64; ++c) { const float xv = xs[c]; rp += xv * war[c]; ip += xv * wxr[c]; }
        const float r = sigmoidf_(rp + ba), i = sigmoidf_(ip + bx);
        const float log_a = -8.0f * r * sp, aa = __expf(log_a), bb = sqrtf(-expm1f(2.0f * log_a)) * (i * xc);
        h = aa * h + bb;
        a.raw[tok * DM + 512 + ch] = h * gelu_tanh(bf2f(a.xg[tok * 512 + ch]));
    }
}
__global__ __launch_bounds__(256) void k_grpnorm(const float* __restrict__ raw, const float* __restrict__ ga, const float* __restrict__ gl, bf16_t* __restrict__ mixed) {
    __shared__ float red[8];
    const int row = blockIdx.x, t = threadIdx.x;
    const f32x4 v = *(const f32x4*)(raw + (size_t)row * DM + t * 4);
    const float s = v[0] * v[0] + v[1] * v[1] + v[2] * v[2] + v[3] * v[3];
    const float sa = block_sum256(t < 128 ? s : 0.f, red);
    const float sl = block_sum256(t < 128 ? 0.f : s, red);
    const float rs = rsqrtf((t < 128 ? sa : sl) * (1.0f / 512) + EPS);
    const f32x4 g = t < 128 ? *(const f32x4*)(ga + t * 4) : *(const f32x4*)(gl + (t - 128) * 4);
    u32x2 w; w.x = pack2bf(v[0] * rs * g[0], v[1] * rs * g[1]); w.y = pack2bf(v[2] * rs * g[2], v[3] * rs * g[3]);
    *(u32x2*)(mixed + (size_t)row * DM + t * 4) = w;
}
__global__ __launch_bounds__(256) void k_rowssq(const float* __restrict__ h, float* __restrict__ ssq) {
    __shared__ float red[8];
    const int row = blockIdx.x, t = threadIdx.x;
    const f32x4 v = *(const f32x4*)(h + (size_t)row * DM + t * 4);
    float s = v[0] * v[0] + v[1] * v[1] + v[2] * v[2] + v[3] * v[3];
    s = block_sum256(s, red);
    if (t < 16) ssq[(size_t)t * NTOK + row] = t == 0 ? s : 0.f;
}

DI float rs_from_ssq(const float* ssq, int row) { float s = 0.f; for (int j = 0; j < 16; ++j) s += ssq[(size_t)j * NTOK + row]; return rsqrtf(s * (1.0f / DM) + EPS); }
__global__ __launch_bounds__(256) void k_peer_route(const float* __restrict__ scores, const float* __restrict__ ssq1, int hh, int* __restrict__ eout, float* __restrict__ gout) {
    __shared__ float s[256]; __shared__ float tv[2][16]; __shared__ int ti[2][16]; __shared__ float cand[256]; __shared__ float scs[16]; __shared__ int es[16];
    const int tid = threadIdx.x, tok = blockIdx.x >> 2, hl = blockIdx.x & 3, h = hh * 4 + hl;
    const float rs1 = rs_from_ssq(ssq1, tok);
    s[tid] = scores[(size_t)tok * 1024 + hl * 256 + tid] * rs1;
    __syncthreads();
    { const int p = tid >> 7, k = tid & 127; const float v = s[tid]; int rank = 0;
      for (int j = 0; j < 128; ++j) { const float w = s[p * 128 + j]; rank += (w > v || (w == v && j < k)) ? 1 : 0; }
      if (rank < 16) { tv[p][rank] = v; ti[p][rank] = k; } }
    __syncthreads();
    cand[tid] = tv[0][tid >> 4] + tv[1][tid & 15];
    __syncthreads();
    { const float v = cand[tid]; int rank = 0;
      for (int j = 0; j < 256; ++j) { const float w = cand[j]; rank += (w > v || (w == v && j < tid)) ? 1 : 0; }
      if (rank < 16) { scs[rank] = v; es[rank] = ti[0][tid >> 4] * 128 + ti[1][tid & 15]; } }
    __syncthreads();
    if (tid < 16) {
        float m = -INFINITY; for (int j = 0; j < 16; ++j) m = fmaxf(m, scs[j]);
        float sum = 0.f; for (int j = 0; j < 16; ++j) sum += __expf(scs[j] - m);
        eout[(size_t)tok * 128 + h * 16 + tid] = es[tid];
        gout[(size_t)tok * 128 + h * 16 + tid] = __expf(scs[tid] - m) / sum;
    }
}
__global__ __launch_bounds__(256) void k_peer_apply(const bf16_t* __restrict__ ub, const bf16_t* __restrict__ vb, const int* __restrict__ e, const float* __restrict__ gsm,
                                                    const float* __restrict__ ssq1, float* __restrict__ h, bf16_t* __restrict__ hb, float* __restrict__ rs2) {
    __shared__ float xrow[DM]; __shared__ float coef[128]; __shared__ int eid[128]; __shared__ float red[8];
    const int tid = threadIdx.x, tok = blockIdx.x, lane = tid & 63, w = tid >> 6;
    const float rs1 = rs_from_ssq(ssq1, tok);
    for (int i = tid; i < DM; i += 256) xrow[i] = bf2f(hb[(size_t)tok * DM + i]);
    if (tid < 128) eid[tid] = e[(size_t)tok * 128 + tid];
    __syncthreads();
    for (int j = w; j < 128; j += 4) {
        const bf16_t* ur = ub + (size_t)eid[j] * DM;
        float acc = 0.f;
        for (int i = lane; i < DM; i += 64) acc += xrow[i] * bf2f(ur[i]);
        acc = wave_sum(acc);
        if (lane == 0) coef[j] = gsm[(size_t)tok * 128 + j] * gelu_tanh(acc * rs1);
    }
    __syncthreads();
    f32x4 acc = {0.f, 0.f, 0.f, 0.f};
    for (int j = 0; j < 128; ++j) {
        const u32x2 v = *(const u32x2*)(vb + (size_t)eid[j] * DM + tid * 4); const float c = coef[j];
        acc[0] += c * __uint_as_float(v.x << 16); acc[1] += c * __uint_as_float(v.x & 0xffff0000u); acc[2] += c * __uint_as_float(v.y << 16); acc[3] += c * __uint_as_float(v.y & 0xffff0000u);
    }
    f32x4 hv = *(f32x4*)(h + (size_t)tok * DM + tid * 4);
    hv += acc;
    *(f32x4*)(h + (size_t)tok * DM + tid * 4) = hv;
    u32x2 wv; wv.x = pack2bf(hv[0], hv[1]); wv.y = pack2bf(hv[2], hv[3]);
    *(u32x2*)(hb + (size_t)tok * DM + tid * 4) = wv;
    float s = hv[0] * hv[0] + hv[1] * hv[1] + hv[2] * hv[2] + hv[3] * hv[3];
    s = block_sum256(s, red);
    if (tid == 0) rs2[tok] = rsqrtf(s * (1.0f / DM) + EPS);
}
__global__ __launch_bounds__(256) void k_final_norm(float* __restrict__ h, const float* __restrict__ ssq3, const float* __restrict__ g) {
    const int row = blockIdx.x, t = threadIdx.x;
    const float rs = rs_from_ssq(ssq3, row);
    f32x4 v = *(f32x4*)(h + (size_t)row * DM + t * 4); const f32x4 gg = *(const f32x4*)(g + t * 4);
    v = v * rs * gg;
    *(f32x4*)(h + (size_t)row * DM + t * 4) = v;
}

__global__ void k_p2_extras(const bf16_t* __restrict__ vs, const bf16_t* __restrict__ vw, const float* __restrict__ kcmp, const float* __restrict__ vcmp,
                            bf16_t* __restrict__ vsT, bf16_t* __restrict__ vwT, bf16_t* __restrict__ kcb, bf16_t* __restrict__ vcT) {
    const size_t n = (size_t)NB * NKV * T_ * HD;
    for (size_t i = (size_t)blockIdx.x * blockDim.x + threadIdx.x; i < n; i += (size_t)gridDim.x * blockDim.x) {
        const size_t bh = i / ((size_t)T_ * HD); const int t = (int)((i / HD) % T_), d = (int)(i % HD);
        vsT[(bh * HD + d) * T_ + t] = vs[i]; vwT[(bh * HD + d) * T_ + t] = vw[i];
    }
    for (size_t i = (size_t)blockIdx.x * blockDim.x + threadIdx.x; i < (size_t)8 * 256 * 64; i += (size_t)gridDim.x * blockDim.x) {
        const int bh = (int)(i / (256 * 64)), c = (int)((i / 64) % 256), d = (int)(i % 64);
        const bool ok = c < NCMP;
        kcb[i] = ok ? f2bf(kcmp[i]) : (bf16_t)0;
        vcT[((size_t)bh * 64 + d) * 256 + c] = ok ? f2bf(vcmp[i]) : (bf16_t)0;
    }
}
__global__ __launch_bounds__(256) void k_grpnorm_lru(const float* __restrict__ raw, const float* __restrict__ gl, bf16_t* __restrict__ mixed) {
    __shared__ float red[8];
    const int row = blockIdx.x, t = threadIdx.x;
    const f32x2 v = *(const f32x2*)(raw + (size_t)row * DM + 512 + t * 2);
    const float s = block_sum256(v[0] * v[0] + v[1] * v[1], red);
    const float rs = rsqrtf(s * (1.0f / 512) + EPS);
    *(unsigned*)(mixed + (size_t)row * DM + 512 + t * 2) = pack2bf(v[0] * rs * gl[t * 2], v[1] * rs * gl[t * 2 + 1]);
}
#define XB_TMO      128
#define XB_XCNT(j)  (256  + 64 * (j))
#define XB_XSUB(j)  (1280 + 64 * (j))
#define XB_XGEN(j)  (2304 + 64 * (j))
#define XB_TOP      3328
#define XB_TOPGEN   3392
#define XCD_BAR_WORDS 3456
#define XB_SPIN_CAP (1u << 18)
#define LAS __attribute__((address_space(3)))

__device__ __forceinline__ unsigned xb_ld(unsigned* p)              { return __hip_atomic_load(p, __ATOMIC_RELAXED, __HIP_MEMORY_SCOPE_AGENT); }
__device__ __forceinline__ unsigned xb_add(unsigned* p, unsigned v) { return __hip_atomic_fetch_add(p, v, __ATOMIC_RELAXED, __HIP_MEMORY_SCOPE_AGENT); }
__device__ __forceinline__ unsigned xb_xcc_id() { return (unsigned)__builtin_amdgcn_s_getreg((3 << 11) | 20) & 0xFu; }
#define XB_SPIN(cond, bar) do { unsigned _sp = 0; while (cond) { __builtin_amdgcn_s_sleep(1); \
    if ((++_sp & 255u) == 0u) { if (xb_ld(&(bar)[XB_TMO])) break; if (_sp > XB_SPIN_CAP) { atomicAdd(&(bar)[XB_TMO], 1u); break; } } } } while (0)

struct XcdBarrier {
    unsigned* bar; unsigned x;
    volatile LAS unsigned* st;
};

__device__ __forceinline__ XcdBarrier xcd_barrier_post(unsigned* bar, volatile LAS unsigned* st) {
    XcdBarrier b; b.bar = bar; b.x = xb_xcc_id(); b.st = st;
    if (threadIdx.x == 0) (void)xb_add(&bar[XB_XCNT(b.x)], 1u);
    return b;
}
__device__ __forceinline__ void xcd_barrier_complete(unsigned* bar, unsigned x, unsigned& nloc, unsigned& nx) {
    const unsigned G = gridDim.x * gridDim.y * gridDim.z;
    unsigned sum, cnt, mine, sp = 0u;
    for (;;) {
        sum = 0u; cnt = 0u; mine = 0u;
#pragma unroll
        for (unsigned j = 0; j < 16; ++j) { const unsigned c = xb_ld(&bar[XB_XCNT(j)]); sum += c; cnt += (c > 0u) ? 1u : 0u; mine = (j == x) ? c : mine; }
        if (sum == G) break;
        __builtin_amdgcn_s_sleep(1);
        if ((++sp & 255u) == 0u) { if (xb_ld(&bar[XB_TMO])) break; if (sp > XB_SPIN_CAP) { atomicAdd(&bar[XB_TMO], 1u); break; } }
    }
    nloc = mine > 0u ? mine : 1u; nx = cnt > 0u ? cnt : 1u;
}

__device__ __forceinline__ void xcd_barrier(const XcdBarrier& b) {
    asm volatile("s_waitcnt vmcnt(0)" ::: "memory");
    __syncthreads();
    if (threadIdx.x == 0) {
        unsigned* bar = b.bar;
        __builtin_amdgcn_s_waitcnt(0);
        unsigned nloc = b.st[0], nx = b.st[1];
        if (nloc == 0u) { xcd_barrier_complete(bar, b.x, nloc, nx); b.st[0] = nloc; b.st[1] = nx; }
        const unsigned old = xb_add(&bar[XB_XSUB(b.x)], 1u);
        const unsigned gen = old / nloc;
        if (old + 1u == (gen + 1u) * nloc) {
            __builtin_amdgcn_fence(__ATOMIC_RELEASE, "agent");
            asm volatile("s_waitcnt vmcnt(0)" ::: "memory");
            const unsigned og = xb_add(&bar[XB_TOP], 1u);
            const unsigned tg = og / nx;
            if (og + 1u == (tg + 1u) * nx) xb_add(&bar[XB_TOPGEN], 1u);
            else XB_SPIN(xb_ld(&bar[XB_TOPGEN]) == tg, bar);
            __builtin_amdgcn_fence(__ATOMIC_ACQUIRE, "agent");
            xb_add(&bar[XB_XGEN(b.x)], 1u);
            asm volatile("s_waitcnt vmcnt(0)" ::: "memory");
        } else {
            XB_SPIN(xb_ld(&bar[XB_XGEN(b.x)]) == gen, bar);
            __builtin_amdgcn_fence(__ATOMIC_ACQUIRE, "agent");
            asm volatile("s_waitcnt vmcnt(0)" ::: "memory");
        }
    }
    __syncthreads();
}


namespace pg8 {
#define PG8_LAS __attribute__((address_space(3)))
typedef short bf16x8 __attribute__((ext_vector_type(8)));
constexpr int BM = 256, BK = 64, HALF = 128, HTB = HALF * BK * 2  , STAGE_BYTES = 8 * HTB, NXCD = 8, WGM = 8;

__host__ __device__ __forceinline__ int lds_byte(int r, int c) { const int st = (r >> 4) * 2 + (c >> 5), rr = r & 15, cc = c & 31, ob = rr * 64 + cc * 2; return st * 1024 + (ob ^ (((ob >> 9) & 1) << 5)); }
__host__ __device__ __forceinline__ void stage_rc(int b, int& R, int& C) { const int st = b / 1024, sb = b % 1024, swz = sb ^ (((sb >> 9) & 1) << 5); R = (st >> 1) * 16 + swz / 64; C = (st & 1) * 32 + (swz % 64) / 2; }
__host__ __device__ __forceinline__ int perm32(int rho) { const int n = rho >> 4, i = rho & 15; return 8 * (i >> 2) + 4 * n + (i & 3); }

struct Unit { int pm, pn; };
struct Gemm { const bf16_t* A; const bf16_t* Bt; int M, N, K; };

struct StaticOrder {
    int nM, nN, nwg, G, c;
    __host__ __device__ void init(int M, int N, int G_, int c_) { nM = M / BM; nN = N / BM; nwg = nM * nN; G = G_; c = c_; }
    __host__ __device__ bool next(int i, Unit& u) const {
        const long L = (long)i * G + c; if (L >= nwg) return false;
        int wgid = (int)L; { const int q = nwg / NXCD, r = nwg % NXCD, xcd = wgid % NXCD, off = wgid / NXCD; wgid = (xcd < r ? xcd * (q + 1) : r * (q + 1) + (xcd - r) * q) + off; }
        const int nig = WGM * nN, gid = wgid / nig, fm = gid * WGM, gsz = (nM - fm) < WGM ? (nM - fm) : WGM;
        u.pm = fm + ((wgid % nig) % gsz); u.pn = (wgid % nig) / gsz; return true;
    }
    __device__ __forceinline__ void a_ready(const Unit&) const {}
    __device__ __forceinline__ void done(const Unit&) const {}
};
template <class Epi, class Sched, bool STAMP = false>
__device__ __forceinline__ void gemm_phase(PG8_LAS unsigned char* lds, const Gemm g, const Sched& S, const Epi& E, unsigned long long* stamps) {
    const int tid = threadIdx.x, wid = __builtin_amdgcn_readfirstlane(tid >> 6), lane = tid & 63, wr = wid >> 2, wc = wid & 3, fr = lane & 15, fq = lane >> 4;
    const int K = g.K, nt = K / BK;
    int ts_lo = 0, ts_hi = 0, nts = 0; const unsigned long long rt_entry = STAMP ? (unsigned long long)wall_clock64() : 0ull;
#define PG8_STAMP() do { if (STAMP && wid == 0 && nts < 64) { const unsigned long long _c = (unsigned long long)clock64(); \
        ts_lo = (lane == nts) ? (int)(unsigned)_c : ts_lo; ts_hi = (lane == nts) ? (int)(unsigned)(_c >> 32) : ts_hi; ++nts; } } while (0)
    PG8_STAMP();
    unsigned voffA[2], voffB[2];
#pragma unroll
    for (int i = 0; i < 2; ++i) { int R, C; stage_rc(tid * 16 + i * 8192, R, C); const int Rb = Epi::PERM ? ((R & ~31) + perm32(R & 31)) : R;
        voffA[i] = (unsigned)(R * K + C) * 2u; voffB[i] = (unsigned)(Rb * K + C) * 2u; }
    const size_t kstep = (size_t)(BK * 2);
    const size_t hstep = (size_t)HALF * K * 2;
    const size_t tstep = 2 * hstep;
    const unsigned ldsw = (unsigned)wid * 1024u;
    const int aoff = lds_byte(wr * 64 + fr, fq * 8), boff = lds_byte(wc * 32 + fr, fq * 8);
#define PG8_SA(b, h) (((b) * 2 + (h)) * HTB)
#define PG8_SB(b, h) ((4 + (b) * 2 + (h)) * HTB)
#define PG8_STAGE(bufoff, gbase, voff) do { _Pragma("unroll") for (int _i = 0; _i < 2; ++_i) \
        __builtin_amdgcn_global_load_lds((const unsigned*)((const char*)(gbase) + (voff)[_i]), (PG8_LAS unsigned*)(lds + (bufoff) + ldsw + _i * 8192), 16, 0, 0); } while (0)
#define PG8_LDA(dst, b, h) do { _Pragma("unroll") for (int m = 0; m < 4; ++m) _Pragma("unroll") for (int k = 0; k < 2; ++k) dst[m][k] = *(const PG8_LAS bf16x8*)(lds + PG8_SA(b, h) + aoff + m * 2048 + k * 1024); } while (0)
#define PG8_LDB(dst, b, h) do { _Pragma("unroll") for (int n = 0; n < 2; ++n) _Pragma("unroll") for (int k = 0; k < 2; ++k) dst[n][k] = *(const PG8_LAS bf16x8*)(lds + PG8_SB(b, h) + boff + n * 2048 + k * 1024); } while (0)
#define PG8_MMA(ai, bj, At, Bt) do { __builtin_amdgcn_s_setprio(1); _Pragma("unroll") for (int m = 0; m < 4; ++m) _Pragma("unroll") for (int n = 0; n < 2; ++n) _Pragma("unroll") for (int k = 0; k < 2; ++k) \
        acc[ai][bj][m][n] = __builtin_amdgcn_mfma_f32_16x16x32_bf16(Bt[n][k], At[m][k], acc[ai][bj][m][n], 0, 0, 0); __builtin_amdgcn_s_setprio(0); } while (0)
#define PG8_WAIT_V(n) asm volatile("s_waitcnt vmcnt(" #n ")" ::: "memory")
#define PG8_WAIT_L(n) asm volatile("s_waitcnt lgkmcnt(" #n ")" ::: "memory")
#define PG8_BAR __builtin_amdgcn_s_barrier()
#define PG8_SCHED __builtin_amdgcn_sched_barrier(0)
    Unit cur, nxt; int ui = 0;
    if (!S.next(0, cur)) return;
    f32x4 acc[2][2][4][2];
#pragma unroll
    for (int a = 0; a < 2; ++a)
#pragma unroll
        for (int b = 0; b < 2; ++b)
#pragma unroll
            for (int m = 0; m < 4; ++m)
#pragma unroll
                for (int n = 0; n < 2; ++n) acc[a][b][m][n] = (f32x4){0.f, 0.f, 0.f, 0.f};
    bf16x8 At[4][2], B0[2][2], B1[2][2];
    const char* cA = (const char*)g.A + (size_t)cur.pm * tstep; const char* cB = (const char*)g.Bt + (size_t)cur.pn * tstep;
    S.a_ready(cur);
    PG8_STAGE(PG8_SB(0, 0), cB, voffB); PG8_STAGE(PG8_SA(0, 0), cA, voffA); PG8_STAGE(PG8_SB(0, 1), cB + hstep, voffB); PG8_STAGE(PG8_SA(0, 1), cA + hstep, voffA);
    if (wr == 1) PG8_BAR;
    PG8_WAIT_V(4); PG8_BAR;
    PG8_STAGE(PG8_SB(1, 0), cB + kstep, voffB); PG8_STAGE(PG8_SA(1, 0), cA + kstep, voffA); PG8_STAGE(PG8_SB(1, 1), cB + hstep + kstep, voffB);
    PG8_WAIT_V(6); PG8_BAR;
    PG8_STAMP();
    for (;;) {
        const bool has_next = S.next(ui + 1, nxt);
        const char* nA = has_next ? (const char*)g.A + (size_t)nxt.pm * tstep : cA; const char* nB = has_next ? (const char*)g.Bt + (size_t)nxt.pn * tstep : cB;
        for (int t = 0; t < nt; t += 2) {
            const bool last = (t == nt - 2);
            const char* a1 = cA + (size_t)(t + 1) * kstep;
            const char* a2 = last ? nA : cA + (size_t)(t + 2) * kstep; const char* b2 = last ? nB : cB + (size_t)(t + 2) * kstep;
            const char* a3 = a2 + kstep; const char* b3 = b2 + kstep;
            if (last && has_next) S.a_ready(nxt);
            PG8_LDB(B0, 0, 0); PG8_SCHED; PG8_LDA(At, 0, 0); PG8_STAGE(PG8_SA(1, 1), a1 + hstep, voffA);
            PG8_WAIT_L(8); PG8_BAR; PG8_WAIT_L(0); PG8_MMA(0, 0, At, B0); PG8_BAR; PG8_SCHED;
            PG8_LDB(B1, 0, 1); PG8_STAGE(PG8_SB(0, 0), b2, voffB);
            PG8_BAR; PG8_WAIT_L(0); PG8_MMA(0, 1, At, B1); PG8_BAR;
            PG8_LDA(At, 0, 1); PG8_STAGE(PG8_SA(0, 0), a2, voffA);
            PG8_BAR; PG8_WAIT_L(0); PG8_MMA(1, 0, At, B0); PG8_BAR; PG8_SCHED;
            PG8_STAGE(PG8_SB(0, 1), b2 + hstep, voffB);
            PG8_WAIT_V(6); PG8_BAR; PG8_MMA(1, 1, At, B1); PG8_BAR;
            PG8_LDB(B0, 1, 0); PG8_SCHED; PG8_LDA(At, 1, 0); PG8_STAGE(PG8_SA(0, 1), a2 + hstep, voffA);
            PG8_WAIT_L(8); PG8_BAR; PG8_WAIT_L(0); PG8_MMA(0, 0, At, B0); PG8_BAR; PG8_SCHED;
            PG8_LDB(B1, 1, 1); PG8_STAGE(PG8_SB(1, 0), b3, voffB);
            PG8_BAR; PG8_WAIT_L(0); PG8_MMA(0, 1, At, B1); PG8_BAR;
            PG8_LDA(At, 1, 1); PG8_STAGE(PG8_SA(1, 0), a3, voffA);
            PG8_BAR; PG8_WAIT_L(0); PG8_MMA(1, 0, At, B0); PG8_BAR; PG8_SCHED;
            PG8_STAGE(PG8_SB(1, 1), b3 + hstep, voffB);
            PG8_WAIT_V(6); PG8_BAR; PG8_MMA(1, 1, At, B1); PG8_BAR;
        }
        PG8_STAMP();
        if constexpr (!Epi::AFTER_DRAIN) { E(acc, cur, wr, wc, fr, fq); S.done(cur); }
        PG8_STAMP();
        if (!has_next) break;
#pragma unroll
        for (int a = 0; a < 2; ++a)
#pragma unroll
            for (int b = 0; b < 2; ++b)
#pragma unroll
                for (int m = 0; m < 4; ++m)
#pragma unroll
                    for (int n = 0; n < 2; ++n) acc[a][b][m][n] = (f32x4){0.f, 0.f, 0.f, 0.f};
        cur = nxt; cA = nA; cB = nB; ++ui;
    }
    PG8_WAIT_V(0);
    if (wr == 0) PG8_BAR;
    PG8_BAR;
    if constexpr (Epi::AFTER_DRAIN) { E.fused(acc, cur, wr, wc, fr, fq, lds, wid, lane); S.done(cur); }
    PG8_STAMP();
    if (STAMP && wid == 0) { stamps[lane] = lane < nts ? (((unsigned long long)(unsigned)ts_hi << 32) | (unsigned)ts_lo) : 0ull;
        if (lane == 62) stamps[62] = rt_entry; if (lane == 63) stamps[63] = (unsigned long long)wall_clock64(); }
#undef PG8_STAMP
#undef PG8_SA
#undef PG8_SB
#undef PG8_STAGE
#undef PG8_LDA
#undef PG8_LDB
#undef PG8_MMA
#undef PG8_WAIT_V
#undef PG8_WAIT_L
#undef PG8_BAR
#undef PG8_SCHED
}
}
#define LAS3 __attribute__((address_space(3)))
constexpr int MK_THREADS = 512;
typedef __bf16 bf16x2_t __attribute__((ext_vector_type(2)));
DI float dot2bf(unsigned a, unsigned b, float c) { return __builtin_amdgcn_fdot2_f32_bf16(__builtin_bit_cast(bf16x2_t, a), __builtin_bit_cast(bf16x2_t, b), c, false); }
DI float bflo(unsigned v) { return __uint_as_float(v << 16); }
DI float bfhi(unsigned v) { return __uint_as_float(v & 0xffff0000u); }

template <class ColMap>
DI void transpose_tile(const float* __restrict__ src, int ldsrc, const float* __restrict__ gain, bf16_t* __restrict__ dst, int K, int k0, int n0, const ColMap& cm, LAS3 float* tl) {
    const int tid = threadIdx.x;
    __syncthreads();
    {
        const int n = tid & 63, sc = cm(n0 + n);
#pragma unroll
        for (int j = 0; j < 8; ++j) { const int k = (tid >> 6) + 8 * j; tl[k * 65 + n] = sc >= 0 ? src[(size_t)(k0 + k) * ldsrc + sc] * (gain ? gain[k0 + k] : 1.0f) : 0.f; }
    }
    __syncthreads();
    {
        const int n = tid >> 3, k8 = (tid & 7) * 8;
        u32x4 w;
        w.x = pack2bf(tl[(k8 + 0) * 65 + n], tl[(k8 + 1) * 65 + n]); w.y = pack2bf(tl[(k8 + 2) * 65 + n], tl[(k8 + 3) * 65 + n]);
        w.z = pack2bf(tl[(k8 + 4) * 65 + n], tl[(k8 + 5) * 65 + n]); w.w = pack2bf(tl[(k8 + 6) * 65 + n], tl[(k8 + 7) * 65 + n]);
        *(u32x4*)(dst + (size_t)(n0 + n) * K + k0 + k8) = w;
    }
}
struct ColId { DI int operator()(int n) const { return n; } };
struct ColWin { DI int operator()(int n) const { return n < PC_XR ? n : (n < PC_XG ? 1304 + (n - PC_XR) : (n < PC_GATE ? 1816 + (n - PC_XG) : (n < PC_GATE + 24 ? 1280 + (n - PC_GATE) : -1))); } };

DI void cvt_rows_bf16(const float* __restrict__ src, const float* __restrict__ gain, bf16_t* __restrict__ dst, size_t n8, int cols, size_t gtid, size_t nthr) {
    for (size_t i0 = gtid; i0 < n8; i0 += 4 * nthr) {
        f32x4 a[4], b[4];
#pragma unroll
        for (int u = 0; u < 4; ++u) { const size_t i = i0 + u * nthr; if (i < n8) { a[u] = *(const f32x4*)(src + i * 8); b[u] = *(const f32x4*)(src + i * 8 + 4); } }
#pragma unroll
        for (int u = 0; u < 4; ++u) { const size_t i = i0 + u * nthr; if (i < n8) {
            f32x4 x = a[u], y = b[u];
            if (gain) { const int c = (int)((i * 8) % cols); x *= *(const f32x4*)(gain + c); y *= *(const f32x4*)(gain + c + 4); }
            u32x4 w; w.x = pack2bf(x[0], x[1]); w.y = pack2bf(x[2], x[3]); w.z = pack2bf(y[0], y[1]); w.w = pack2bf(y[2], y[3]);
            *(u32x4*)(dst + i * 8) = w; } }
    }
}
DI void cvt_rows_fp8(const float* __restrict__ src, const float* __restrict__ gain, float scale, unsigned char* __restrict__ dst, size_t n8, int cols, size_t gtid, size_t nthr) {
    for (size_t i0 = gtid; i0 < n8; i0 += 4 * nthr) {
        f32x4 a[4], b[4];
#pragma unroll
        for (int u = 0; u < 4; ++u) { const size_t i = i0 + u * nthr; if (i < n8) { a[u] = *(const f32x4*)(src + i * 8); b[u] = *(const f32x4*)(src + i * 8 + 4); } }
#pragma unroll
        for (int u = 0; u < 4; ++u) { const size_t i = i0 + u * nthr; if (i < n8) {
            f32x4 x = a[u], y = b[u];
            if (gain) { const int c = (int)((i * 8) % cols); x *= *(const f32x4*)(gain + c); y *= *(const f32x4*)(gain + c + 4); }
            x *= scale; y *= scale;
            int w0 = 0, w1 = 0;
            w0 = __builtin_amdgcn_cvt_pk_fp8_f32(x[0], x[1], w0, false); w0 = __builtin_amdgcn_cvt_pk_fp8_f32(x[2], x[3], w0, true);
            w1 = __builtin_amdgcn_cvt_pk_fp8_f32(y[0], y[1], w1, false); w1 = __builtin_amdgcn_cvt_pk_fp8_f32(y[2], y[3], w1, true);
            *(u32x2*)(dst + i * 8) = (u32x2){(unsigned)w0, (unsigned)w1}; } }
    }
}
DI void cvt_rows_i8(const float* __restrict__ src, const float* __restrict__ gain, float scale, unsigned char* __restrict__ dst, size_t n8, int cols, size_t gtid, size_t nthr) {
    for (size_t i0 = gtid; i0 < n8; i0 += 4 * nthr) {
        f32x4 a[4], b[4];
#pragma unroll
        for (int u = 0; u < 4; ++u) { const size_t i = i0 + u * nthr; if (i < n8) { a[u] = *(const f32x4*)(src + i * 8); b[u] = *(const f32x4*)(src + i * 8 + 4); } }
#pragma unroll
        for (int u = 0; u < 4; ++u) { const size_t i = i0 + u * nthr; if (i < n8) {
            f32x4 x = a[u], y = b[u];
            if (gain) { const int c = (int)((i * 8) % cols); x *= *(const f32x4*)(gain + c); y *= *(const f32x4*)(gain + c + 4); }
            unsigned w0 = 0u, w1 = 0u;
#pragma unroll
            for (int j = 0; j < 4; ++j) {
                const int qa = (int)rintf(fminf(fmaxf(x[j] * scale, -127.f), 127.f)), qb = (int)rintf(fminf(fmaxf(y[j] * scale, -127.f), 127.f));
                w0 |= ((unsigned)qa & 0xffu) << (8 * j); w1 |= ((unsigned)qb & 0xffu) << (8 * j);
            }
            *(u32x2*)(dst + i * 8) = (u32x2){w0, w1}; } }
    }
}
DI void cvt_rows_fp4(const float* __restrict__ src, const float* __restrict__ gain, float scale, unsigned char* __restrict__ dst, size_t n8, int cols, size_t gtid, size_t nthr) {
    for (size_t i = gtid; i < n8; i += nthr) {
        f32x4 a = *(const f32x4*)(src + i * 8), b = *(const f32x4*)(src + i * 8 + 4);
        if (gain) { const int c = (int)((i * 8) % cols); a *= *(const f32x4*)(gain + c); b *= *(const f32x4*)(gain + c + 4); }
        a *= scale; b *= scale;
        unsigned w = 0u;
        w = __builtin_amdgcn_cvt_scalef32_pk_fp4_f32(w, a[0], a[1], 1.0f, 0); w = __builtin_amdgcn_cvt_scalef32_pk_fp4_f32(w, a[2], a[3], 1.0f, 1);
        w = __builtin_amdgcn_cvt_scalef32_pk_fp4_f32(w, b[0], b[1], 1.0f, 2); w = __builtin_amdgcn_cvt_scalef32_pk_fp4_f32(w, b[2], b[3], 1.0f, 3);
        *(unsigned*)(dst + i * 4) = w;
    }
}
DI void p0_prologue(const Params& p, LAS3 unsigned char* lds, int G) {
    unsigned char* ws = p.ws;
    const int tid = threadIdx.x, lane = tid & 63, wid = tid >> 6, bid = blockIdx.x;
    const size_t gtid = (size_t)bid * MK_THREADS + tid, nthr = (size_t)G * MK_THREADS;
    const int gw = bid * 8 + wid, nw = G * 8;
    {
        const float* x = p.in[I_X]; bf16_t* xb = (bf16_t*)(ws + WS_XB); float* rs0 = (float*)(ws + WS_RS0);
        for (int row0 = gw; row0 < NTOK; row0 += 4 * nw) {
            f32x4 v[4][4];
#pragma unroll
            for (int u = 0; u < 4; ++u) { const int row = row0 + u * nw; if (row < NTOK) {
#pragma unroll
                for (int j = 0; j < 4; ++j) v[u][j] = *(const f32x4*)(x + (size_t)row * DM + j * 256 + lane * 4); } }
#pragma unroll
            for (int u = 0; u < 4; ++u) { const int row = row0 + u * nw; if (row < NTOK) {
                float s = 0.f;
#pragma unroll
                for (int j = 0; j < 4; ++j) s += (v[u][j][0] * v[u][j][0] + v[u][j][1] * v[u][j][1]) + (v[u][j][2] * v[u][j][2] + v[u][j][3] * v[u][j][3]);
                s = wave_sum(s);
#pragma unroll
                for (int j = 0; j < 4; ++j) { u32x2 w; w.x = pack2bf(v[u][j][0], v[u][j][1]); w.y = pack2bf(v[u][j][2], v[u][j][3]); *(u32x2*)(xb + (size_t)row * DM + j * 256 + lane * 4) = w; }
                if (lane == 0) rs0[row] = rsqrtf(s * (1.0f / DM) + EPS); } }
        }
    }
#if PEER_FP4
    cvt_rows_fp4(p.in[I_PEER_U], p.in[I_FFN_NORM], 64.0f, (unsigned char*)(ws + WS_UB), (size_t)16384 * DM / 8, DM, gtid, nthr);
    cvt_rows_fp4(p.in[I_PEER_V], nullptr, 6.0f, (unsigned char*)(ws + WS_VB), (size_t)16384 * DM / 8, DM, gtid, nthr);
#elif PEER_I8U
    cvt_rows_i8(p.in[I_PEER_U], p.in[I_FFN_NORM], 640.0f, (unsigned char*)(ws + WS_UB), (size_t)16384 * DM / 8, DM, gtid, nthr);
#if PEER_V4EXP
    cvt_rows_fp4(p.in[I_PEER_V], nullptr, 8.0f, (unsigned char*)(ws + WS_VB), (size_t)16384 * DM / 8, DM, gtid, nthr);
#else
    cvt_rows_fp8(p.in[I_PEER_V], nullptr, 8.0f, (unsigned char*)(ws + WS_VB), (size_t)16384 * DM / 8, DM, gtid, nthr);
#endif
#elif PEER_V3
    cvt_rows_fp8(p.in[I_PEER_U], p.in[I_FFN_NORM], 32.0f, (unsigned char*)(ws + WS_UB), (size_t)16384 * DM / 8, DM, gtid, nthr);
    cvt_rows_fp8(p.in[I_PEER_V], nullptr, 8.0f, (unsigned char*)(ws + WS_VB), (size_t)16384 * DM / 8, DM, gtid, nthr);
#else
    cvt_rows_bf16(p.in[I_PEER_U], p.in[I_FFN_NORM], (bf16_t*)(ws + WS_UB), (size_t)16384 * DM / 8, DM, gtid, nthr);
    cvt_rows_bf16(p.in[I_PEER_V], nullptr, (bf16_t*)(ws + WS_VB), (size_t)16384 * DM / 8, DM, gtid, nthr);
#endif
    cvt_rows_bf16(p.in[I_P], nullptr, (bf16_t*)(ws + WS_PB), (size_t)NTOK * PLE / 8, PLE, gtid, nthr);
    LAS3 float* tl = (LAS3 float*)lds;
    {
        for (int u = bid; u < 1496; u += G) {
            if (u < 640) transpose_tile(p.in[I_W_IN], INCOLS, p.in[I_ATTN_NORM], (bf16_t*)(ws + WS_WIN), DM, (u % 16) * 64, (u / 16) * 64, ColWin{}, tl);
            else if (u < 896) { const int v = u - 640; transpose_tile(p.in[I_W_OUT], DM, nullptr, (bf16_t*)(ws + WS_WOUT), DM, (v % 16) * 64, (v / 16) * 64, ColId{}, tl); }
            else if (u < 1152) { const int v = u - 896; transpose_tile(p.in[I_PLE_WG], DM, p.in[I_PLE_NORM], (bf16_t*)(ws + WS_WG), DM, (v % 16) * 64, (v / 16) * 64, ColId{}, tl); }
            else if (u < 1216) { const int v = u - 1152; transpose_tile(p.in[I_PLE_PROJ], DM, nullptr, (bf16_t*)(ws + WS_WP), PLE, (v % 4) * 64, (v / 4) * 64, ColId{}, tl); }
            else if (u < 1344) { const int v = u - 1216; transpose_tile(p.in[I_CK_W1], 256, nullptr, (bf16_t*)(ws + WS_CW1K), 2048, (v % 32) * 64, (v / 32) * 64, ColId{}, tl); }
            else if (u < 1472) { const int v = u - 1344; transpose_tile(p.in[I_CV_W1], 256, nullptr, (bf16_t*)(ws + WS_CW1V), 2048, (v % 32) * 64, (v / 32) * 64, ColId{}, tl); }
            else if (u < 1480) { const int v = u - 1472; transpose_tile(p.in[I_LRU_WA] + v * 4096, 64, nullptr, (bf16_t*)(ws + WS_WAT) + v * 4096, 64, 0, 0, ColId{}, tl); }
            else if (u < 1488) { const int v = u - 1480; transpose_tile(p.in[I_LRU_WX] + v * 4096, 64, nullptr, (bf16_t*)(ws + WS_WXT) + v * 4096, 64, 0, 0, ColId{}, tl); }
            else if (u < 1492) { const int v = u - 1488; transpose_tile(p.in[I_CK_W2], 64, nullptr, (bf16_t*)(ws + WS_CW2K), 256, v * 64, 0, ColId{}, tl); }
            else { const int v = u - 1492; transpose_tile(p.in[I_CV_W2], 64, nullptr, (bf16_t*)(ws + WS_CW2V), 256, v * 64, 0, ColId{}, tl); }
        }
        __syncthreads();
    }
    {
        LAS3 float* wt = (LAS3 float*)lds;
        LAS3 float* st = (LAS3 float*)(lds + 32768);
        const float* wq = p.in[I_PEER_WQ]; const float* sub = p.in[I_PEER_SUB]; const float* gain = p.in[I_FFN_NORM]; bf16_t* WqsT = (bf16_t*)(ws + WS_WQS);
        for (int u = bid; u < 256; u += G) {
            const int hp = u >> 4, d0 = (u & 15) * 64, pp = hp & 1;
            __syncthreads();
            for (int i = tid; i < 64 * 128; i += MK_THREADS) { const int d = i >> 7, dk = i & 127; wt[dk * 64 + d] = wq[(size_t)(d0 + d) * 2048 + hp * 128 + dk]; }
            for (int i = tid; i < 128 * 128; i += MK_THREADS) { const int kk = i >> 7, dk = i & 127; st[kk * 129 + dk] = sub[((size_t)pp * 128 + kk) * 128 + dk]; }
            __syncthreads();
            const int kk = tid & 127, dg = (tid >> 7) * 16;
            float acc[16];
#pragma unroll
            for (int j = 0; j < 16; ++j) acc[j] = 0.f;
            for (int dk = 0; dk < 128; ++dk) {
                const float sv = st[kk * 129 + dk];
#pragma unroll
                for (int j4 = 0; j4 < 4; ++j4) { const f32x4 w4 = *(LAS3 f32x4*)(wt + dk * 64 + dg + j4 * 4);
#pragma unroll
                    for (int j = 0; j < 4; ++j) acc[j4 * 4 + j] += sv * w4[j]; }
            }
            u32x4 o0, o1;
#define GQ(j) (acc[j] * gain[d0 + dg + (j)])
            o0.x = pack2bf(GQ(0), GQ(1)); o0.y = pack2bf(GQ(2), GQ(3)); o0.z = pack2bf(GQ(4), GQ(5)); o0.w = pack2bf(GQ(6), GQ(7));
            o1.x = pack2bf(GQ(8), GQ(9)); o1.y = pack2bf(GQ(10), GQ(11)); o1.z = pack2bf(GQ(12), GQ(13)); o1.w = pack2bf(GQ(14), GQ(15));
#undef GQ
            bf16_t* dst = WqsT + (size_t)(hp * 128 + kk) * DM + d0 + dg;
            *(u32x4*)dst = o0; *(u32x4*)(dst + 8) = o1;
        }
        __syncthreads();
    }
    for (int o = gw; o < 512; o += nw) {
        const int kv = o >> 8, j = o & 255;
        const float* pe = p.in[kv ? I_CV_PE : I_CK_PE]; const float* w1 = p.in[kv ? I_CV_W1 : I_CK_W1];
        float acc = 0.f;
        for (int k = lane; k < 2048; k += 64) acc += pe[k] * w1[(size_t)k * 256 + j];
        acc = wave_sum(acc);
        if (lane == 0) ((float*)(ws + (kv ? WS_CBV : WS_CBK)))[j] = acc;
    }
}

DI void p6_peer_apply(const Params& p, int G) {
    unsigned char* ws = p.ws;
    const int tid = threadIdx.x, lane = tid & 63, wid = tid >> 6;
    const int gw = blockIdx.x * 8 + wid, nw = G * 8;
    const bf16_t* ub = (const bf16_t*)(ws + WS_UB); const bf16_t* vb = (const bf16_t*)(ws + WS_VB);
    const int* eidx = (const int*)(ws + R_EXP); const float* gsm = (const float*)(ws + R_GSM); const float* ssq1 = (const float*)(ws + WS_SSQ1);
    float* h = p.out; bf16_t* hb = (bf16_t*)(ws + R_H1B); float* rs2 = (float*)(ws + WS_RS2);
    for (int tok = gw; tok < NTOK; tok += nw) {
        float sq = lane < 16 ? ssq1[(size_t)lane * NTOK + tok] : 0.f;
        sq = wave_sum(sq);
        const float rs1 = rsqrtf(sq * (1.0f / DM) + EPS);
        const u32x4 xa = *(const u32x4*)(hb + (size_t)tok * DM + lane * 8), xc = *(const u32x4*)(hb + (size_t)tok * DM + 512 + lane * 8);
        const int e0 = eidx[(size_t)tok * 128 + lane], e1 = eidx[(size_t)tok * 128 + 64 + lane];
        const float g0 = gsm[(size_t)tok * 128 + lane], g1 = gsm[(size_t)tok * 128 + 64 + lane];
        float coef0 = 0.f, coef1 = 0.f;
#pragma unroll
        for (int half = 0; half < 2; ++half) {
            const int ev = half ? e1 : e0;
            float part[64];
#pragma unroll
            for (int j = 0; j < 64; ++j) {
                const int e = __builtin_amdgcn_readlane(ev, j);
                const bf16_t* ur = ub + (size_t)e * DM + lane * 8;
                const u32x4 ua = *(const u32x4*)ur, uc = *(const u32x4*)(ur + 512);
                float a = dot2bf(xa.x, ua.x, 0.f); a = dot2bf(xa.y, ua.y, a); a = dot2bf(xa.z, ua.z, a); a = dot2bf(xa.w, ua.w, a);
                a = dot2bf(xc.x, uc.x, a); a = dot2bf(xc.y, uc.y, a); a = dot2bf(xc.z, uc.z, a); a = dot2bf(xc.w, uc.w, a);
                part[j] = a;
            }
#pragma unroll
            for (int m = 32; m >= 1; m >>= 1) {
                const bool up = (lane & m) != 0;
#pragma unroll
                for (int i = 0; i < m; ++i) {
                    const float send = up ? part[i] : part[i + m];
                    const float keep = up ? part[i + m] : part[i];
                    part[i] = keep + __shfl_xor(send, m);
                }
            }
            const float act = gelu_tanh(part[0] * rs1);
            if (half) coef1 = g1 * act; else coef0 = g0 * act;
        }
        float acc[16];
#pragma unroll
        for (int i = 0; i < 16; ++i) acc[i] = 0.f;
#pragma unroll
        for (int half = 0; half < 2; ++half) {
            const int ev = half ? e1 : e0; const float cv = half ? coef1 : coef0;
#pragma unroll 16
            for (int j = 0; j < 64; ++j) {
                const int e = __builtin_amdgcn_readlane(ev, j);
                const float c = __uint_as_float(__builtin_amdgcn_readlane(__float_as_uint(cv), j));
                const bf16_t* vr = vb + (size_t)e * DM + lane * 8;
                const u32x4 va = *(const u32x4*)vr, vc = *(const u32x4*)(vr + 512);
                acc[0] += c * bflo(va.x); acc[1] += c * bfhi(va.x); acc[2] += c * bflo(va.y); acc[3] += c * bfhi(va.y);
                acc[4] += c * bflo(va.z); acc[5] += c * bfhi(va.z); acc[6] += c * bflo(va.w); acc[7] += c * bfhi(va.w);
                acc[8] += c * bflo(vc.x); acc[9] += c * bfhi(vc.x); acc[10] += c * bflo(vc.y); acc[11] += c * bfhi(vc.y);
                acc[12] += c * bflo(vc.z); acc[13] += c * bfhi(vc.z); acc[14] += c * bflo(vc.w); acc[15] += c * bfhi(vc.w);
            }
        }
        float* hr = h + (size_t)tok * DM + lane * 8;
        f32x4 h0 = *(f32x4*)hr, h1 = *(f32x4*)(hr + 4), h2 = *(f32x4*)(hr + 512), h3 = *(f32x4*)(hr + 516);
        h0 += (f32x4){acc[0], acc[1], acc[2], acc[3]}; h1 += (f32x4){acc[4], acc[5], acc[6], acc[7]};
        h2 += (f32x4){acc[8], acc[9], acc[10], acc[11]}; h3 += (f32x4){acc[12], acc[13], acc[14], acc[15]};
        *(f32x4*)hr = h0; *(f32x4*)(hr + 4) = h1; *(f32x4*)(hr + 512) = h2; *(f32x4*)(hr + 516) = h3;
        u32x4 w0, w1;
        w0.x = pack2bf(h0[0], h0[1]); w0.y = pack2bf(h0[2], h0[3]); w0.z = pack2bf(h1[0], h1[1]); w0.w = pack2bf(h1[2], h1[3]);
        w1.x = pack2bf(h2[0], h2[1]); w1.y = pack2bf(h2[2], h2[3]); w1.z = pack2bf(h3[0], h3[1]); w1.w = pack2bf(h3[2], h3[3]);
        *(u32x4*)(hb + (size_t)tok * DM + lane * 8) = w0; *(u32x4*)(hb + (size_t)tok * DM + 512 + lane * 8) = w1;
        float s = 0.f;
#pragma unroll
        for (int j = 0; j < 4; ++j) s += h0[j] * h0[j] + h1[j] * h1[j] + h2[j] * h2[j] + h3[j] * h3[j];
        s = wave_sum(s);
        if (lane == 0) rs2[tok] = rsqrtf(s * (1.0f / DM) + EPS);
    }
}

DI void p8_final_norm(const Params& p, int G) {
    const int lane = threadIdx.x & 63, gw = blockIdx.x * 8 + (threadIdx.x >> 6), nw = G * 8;
    const float* ssq3 = (const float*)(p.ws + WS_SSQ3); const float* g = p.in[I_FINAL_NORM]; float* h = p.out;
    f32x4 gg[4];
#pragma unroll
    for (int j = 0; j < 4; ++j) gg[j] = *(const f32x4*)(g + j * 256 + lane * 4);
    for (int row0 = gw; row0 < NTOK; row0 += 4 * nw) {
        f32x4 v[4][4]; float sq[4];
#pragma unroll
        for (int u = 0; u < 4; ++u) { const int row = row0 + u * nw; if (row < NTOK) { sq[u] = lane < 16 ? ssq3[(size_t)lane * NTOK + row] : 0.f;
#pragma unroll
            for (int j = 0; j < 4; ++j) v[u][j] = *(const f32x4*)(h + (size_t)row * DM + j * 256 + lane * 4); } }
#pragma unroll
        for (int u = 0; u < 4; ++u) { const int row = row0 + u * nw; if (row < NTOK) {
            const float rs = rsqrtf(wave_sum(sq[u]) * (1.0f / DM) + EPS);
#pragma unroll
            for (int j = 0; j < 4; ++j) *(f32x4*)(h + (size_t)row * DM + j * 256 + lane * 4) = v[u][j] * rs * gg[j]; } }
    }
}
typedef float f32x16 __attribute__((ext_vector_type(16)));
typedef short bf16x8v __attribute__((ext_vector_type(8)));
typedef __bf16 bf16x2v_ __attribute__((ext_vector_type(2)));
DI unsigned pk_bf16(float lo, float hi) { return __builtin_bit_cast(unsigned, __builtin_convertvector((f32x2){lo, hi}, bf16x2v_)); }
constexpr float LOG2E = 1.4426950408889634f;
constexpr int AT_KROW = 144, AT_VROW = 136;
constexpr int AT_KT = 64 * AT_KROW, AT_VT = 64 * AT_VROW, AT_BUF = 2 * AT_KT + 2 * AT_VT;
constexpr int AT_VAL = 0;
constexpr int AT_LUT = 2 * AT_BUF;
constexpr int AT_IMP = AT_LUT + 8 * 128 * 4;
constexpr int AT_SEL = AT_IMP + 8 * 32 * 65 * 4;
constexpr int AT_SSQ = AT_SEL + 512;
constexpr int AT_END = AT_SSQ + 1024;
static_assert(AT_END <= 160 * 1024 - 256, "attention LDS map");

struct AtSrc { const bf16_t* k0; const bf16_t* k1; const bf16_t* v0; const bf16_t* v1; int vld; };
DI void at_load(const AtSrc& s, int kpos, int tid, u32x4 (&r)[4]) {
    const int row = tid >> 3, seg = tid & 7;
    r[0] = *(const u32x4*)(s.k0 + (size_t)(kpos + row) * HD + seg * 8);
    r[1] = *(const u32x4*)(s.k1 + (size_t)(kpos + row) * HD + seg * 8);
    r[2] = *(const u32x4*)(s.v0 + (size_t)row * s.vld + kpos + seg * 8);
    r[3] = *(const u32x4*)(s.v1 + (size_t)row * s.vld + kpos + seg * 8);
}
DI void at_store(LAS3 unsigned char* buf, int tid, const u32x4 (&r)[4]) {
    const int row = tid >> 3, seg = tid & 7;
    *(LAS3 u32x4*)(buf + row * AT_KROW + seg * 16) = r[0];
    *(LAS3 u32x4*)(buf + AT_KT + row * AT_KROW + seg * 16) = r[1];
    LAS3 unsigned char* v = buf + 2 * AT_KT + row * AT_VROW + seg * 16;
    *(LAS3 u32x2*)(v) = (u32x2){r[2].x, r[2].y}; *(LAS3 u32x2*)(v + 8) = (u32x2){r[2].z, r[2].w};
    *(LAS3 u32x2*)(v + AT_VT) = (u32x2){r[3].x, r[3].y}; *(LAS3 u32x2*)(v + AT_VT + 8) = (u32x2){r[3].z, r[3].w};
}

template <int MODE, int PASS, int APROBE>
DI void at_step(LAS3 const unsigned char* Kb, LAS3 const unsigned char* Vb, const bf16x8v (&Q)[4], int k0, int tq, int lane, LAS3 const float* lut, bool blk_ok, bool farstep,
                float& m_run, float& l_run, f32x16 (&O)[2], float inv_l, LAS3 float* imp_row, float& bcarry) {
    const int r = lane & 31, hf = lane >> 5;
    f32x16 S[2];
#pragma unroll
    for (int sub = 0; sub < 2; ++sub) {
#pragma unroll
        for (int i = 0; i < 16; ++i) S[sub][i] = 0.f;
#pragma unroll
        for (int ks = 0; ks < 4; ++ks) {
            const bf16x8v a = *(LAS3 const bf16x8v*)(Kb + (32 * sub + r) * AT_KROW + 32 * ks + 16 * hf);
            if (APROBE < 3) S[sub] = __builtin_amdgcn_mfma_f32_32x32x16_bf16(a, Q[ks], S[sub], 0, 0, 0);
            else S[sub][ks] += __builtin_bit_cast(float, (int)a[0] | ((int)a[1] << 16));
        }
    }
    __builtin_amdgcn_sched_barrier(0);
    float mx = -INFINITY;
    const float bfar = lut[127];
    if (APROBE >= 2) { mx = S[0][0]; } else
    if (!farstep) {
#pragma unroll
        for (int sub = 0; sub < 2; ++sub)
#pragma unroll
            for (int i = 0; i < 16; ++i) {
                const int kp = k0 + 32 * sub + (i & 3) + 8 * (i >> 2) + 4 * hf;
                const int dist = MODE == 0 ? tq - (16 * kp + 31) : tq - kp;
                bool ok = dist >= 0 && blk_ok;
                if (MODE == 2) ok = ok && dist < 512;
                const int idx = dist < 0 ? 0 : (dist > 127 ? 127 : dist);
                float s = S[sub][i] + lut[idx];
                s = ok ? s : -INFINITY;
                S[sub][i] = s; mx = fmaxf(mx, s);
            }
    } else {
#pragma unroll
        for (int sub = 0; sub < 2; ++sub)
#pragma unroll
            for (int i = 0; i < 16; ++i) mx = fmaxf(mx, S[sub][i]);
        mx += bfar;
        if (MODE == 1) mx = blk_ok ? mx : -INFINITY;
    }
    if (APROBE >= 2) { l_run += mx; } else
    if (PASS != 2) {
        mx = fmaxf(mx, __shfl_xor(mx, 32));
        const float m_new = fmaxf(m_run, mx), m_safe = (m_new == -INFINITY) ? 0.f : m_new;
        const float alpha = __builtin_amdgcn_exp2f(m_run - m_safe);
        float m_use = farstep ? m_safe - bfar : m_safe;
        if (MODE == 1 && farstep) m_use = blk_ok ? m_use : INFINITY;
        float sum = 0.f;
#pragma unroll
        for (int sub = 0; sub < 2; ++sub)
#pragma unroll
            for (int i = 0; i < 16; ++i) { const float pv = __builtin_amdgcn_exp2f(S[sub][i] - m_use); S[sub][i] = pv; sum += pv; }
        l_run = l_run * alpha + sum; m_run = m_new;
        if (PASS == 0) {
            if (__any(alpha != 1.0f)) {
#pragma unroll
                for (int db = 0; db < 2; ++db)
#pragma unroll
                    for (int i = 0; i < 16; ++i) O[db][i] *= alpha;
            }
        }
    } else {
        const float mu = farstep ? m_run - bfar : m_run;
#pragma unroll
        for (int sub = 0; sub < 2; ++sub) {
#pragma unroll
            for (int i = 0; i < 16; ++i) S[sub][i] = __builtin_amdgcn_exp2f(S[sub][i] - mu) * inv_l;
            float bp[4], av[4];
#pragma unroll
            for (int a = 0; a < 4; ++a) {
                av[a] = S[sub][4 * a] + S[sub][4 * a + 1] + S[sub][4 * a + 2] + 0.5f * S[sub][4 * a + 3];
                bp[a] = __shfl_xor(0.5f * S[sub][4 * a + 3], 32);
            }
            const int sbase = (k0 >> 2) + 8 * sub + hf;
#pragma unroll
            for (int a = 0; a < 4; ++a) imp_row[sbase + 2 * a] = av[a] + (hf ? bp[a] : (a > 0 ? bp[a > 0 ? a - 1 : 0] : bcarry));
            bcarry = bp[3];
        }
    }
    __builtin_amdgcn_sched_barrier(0);
    if (PASS != 1) {
#pragma unroll
        for (int sub = 0; sub < 2; ++sub)
#pragma unroll
            for (int s2 = 0; s2 < 2; ++s2) {
                u32x4 pw;
                pw.x = pk_bf16(S[sub][8 * s2 + 0], S[sub][8 * s2 + 1]); pw.y = pk_bf16(S[sub][8 * s2 + 2], S[sub][8 * s2 + 3]);
                pw.z = pk_bf16(S[sub][8 * s2 + 4], S[sub][8 * s2 + 5]); pw.w = pk_bf16(S[sub][8 * s2 + 6], S[sub][8 * s2 + 7]);
                const bf16x8v pf = __builtin_bit_cast(bf16x8v, pw);
#pragma unroll
                for (int db = 0; db < 2; ++db) {
                    LAS3 const unsigned char* va = Vb + (32 * db + r) * AT_VROW + (32 * sub + 16 * s2 + 4 * hf) * 2;
                    const u32x2 v0 = *(LAS3 const u32x2*)va, v1 = *(LAS3 const u32x2*)(va + 16);
                    const bf16x8v vf = __builtin_bit_cast(bf16x8v, (u32x4){v0.x, v0.y, v1.x, v1.y});
                    if (APROBE < 3) O[db] = __builtin_amdgcn_mfma_f32_32x32x16_bf16(vf, pf, O[db], 0, 0, 0); else O[db][s2] += __builtin_bit_cast(float, (int)vf[0] | ((int)pf[1] << 16));
                }
            }
    }
}

template <int MODE, int PASS, int APROBE>
DI void at_branch(LAS3 unsigned char* lds, const AtSrc& src, int blk_lo, int blk_hi, const bf16x8v (&Q)[4], int tq, int tid, int kvh, LAS3 const float* lut,
                  unsigned mlo, unsigned mhi, float& m_run, float& l_run, f32x16 (&O)[2], float inv_l, LAS3 float* imp_row) {
    const int lane = tid & 63;
    u32x4 st[4];
    float bcarry = 0.f;
    at_load(src, blk_lo * 64, tid, st);
    for (int blk = blk_lo; blk <= blk_hi; ++blk) {
        LAS3 unsigned char* buf = lds + ((blk - blk_lo) & 1) * AT_BUF;
        at_store(buf, tid, st);
        __syncthreads();
        if (blk < blk_hi) at_load(src, (blk + 1) * 64, tid, st);
        bool blk_ok = true;
        if (MODE == 1) blk_ok = ((blk < 32 ? (mlo >> blk) : (mhi >> (blk - 32))) & 1u) != 0u;
        const int t0u = tq - (lane & 31);
        const bool farstep = MODE == 0 ? (t0u - 16 * (blk * 64 + 63) - 31 >= 128) : (MODE == 1 ? (t0u - blk * 64 - 63 >= 128) : (t0u - blk * 64 - 63 >= 128 && t0u + 31 - blk * 64 < 512));
        if (MODE != 1 || __any(blk_ok)) {
            at_step<MODE, PASS, APROBE>(buf + kvh * AT_KT, buf + 2 * AT_KT + kvh * AT_VT, Q, blk * 64, tq, lane, lut, blk_ok, farstep, m_run, l_run, O, inv_l, imp_row, bcarry);
        }
    }
    __syncthreads();
}

template <int APROBE> DI void p3_attention(const Params& p, LAS3 unsigned char* lds, int G) {
    unsigned char* ws = p.ws;
    const int tid = threadIdx.x, lane = tid & 63, h = __builtin_amdgcn_readfirstlane(tid >> 6), kvh = h >> 2, r = lane & 31, hf = lane >> 5;
    LAS3 float* lutall = (LAS3 float*)(lds + AT_LUT);
    {
        const float* rel = p.in[I_REL];
        for (int i = tid; i < 1024; i += MK_THREADS) lutall[i] = rel[rel_bucket(i & 127) * NH + (i >> 7)] * LOG2E;
    }
    __syncthreads();
    LAS3 const float* lut = lutall + h * 128;
    LAS3 float* impw = (LAS3 float*)(lds + AT_IMP);
    LAS3 float* vals = (LAS3 float*)(lds + AT_VAL);
    LAS3 unsigned char* selb = lds + AT_SEL;
    LAS3 float* ssq = (LAS3 float*)(lds + AT_SSQ);
    const bf16_t* qb = (const bf16_t*)(ws + R_QB);
    const float* gates = (const float*)(ws + R_GATE);
    const float* gn = p.in[I_GN_ATTN];
    bf16_t* mixed = APROBE ? (bf16_t*)(ws + R_BIG) : (bf16_t*)(ws + WS_XB);
    for (int ui = blockIdx.x; ui < 512; ui += G) {
        const int q8 = ui & 255, rnd = ui >> 8, b = q8 >> 6, j6 = q8 & 63, tb = rnd == 0 ? 127 - j6 : j6;
        const int t0 = 32 * tb, qb64 = tb >> 1, tq = t0 + r;
        const size_t tok = (size_t)b * T_ + tq;
        bf16x8v Q[4];
#pragma unroll
        for (int ks = 0; ks < 4; ++ks) Q[ks] = *(const bf16x8v*)(qb + tok * 512 + h * 64 + 16 * ks + 8 * hf);
        f32x16 O[2];
#pragma unroll
        for (int db = 0; db < 2; ++db)
#pragma unroll
            for (int i = 0; i < 16; ++i) O[db][i] = 0.f;
        LAS3 float* oslot = (LAS3 float*)(lds + AT_IMP) + h * 2048 + lane;
        const size_t bh0 = (size_t)b * 2, bh1 = bh0 + 1;
        {
            const bf16_t* kcb = (const bf16_t*)(ws + R_KCB); const bf16_t* vct = (const bf16_t*)(ws + R_VCT);
            const AtSrc src{kcb + bh0 * 256 * 64, kcb + bh1 * 256 * 64, vct + bh0 * 64 * 256, vct + bh1 * 64 * 256, 256};
            const int nst = tb / 32 + 1;
            float m_run = -INFINITY, l_run = 0.f;
            at_branch<0, 1, APROBE>(lds, src, 0, nst - 1, Q, tq, tid, kvh, lut, 0u, 0u, m_run, l_run, O, 0.f, nullptr);
            const float l_tot = l_run + __shfl_xor(l_run, 32);
            const float inv_l = l_tot > 0.f ? 1.0f / l_tot : 0.f;
            float m_fix = (m_run == -INFINITY) ? 0.f : m_run;
            at_branch<0, 2, APROBE>(lds, src, 0, nst - 1, Q, tq, tid, kvh, lut, 0u, 0u, m_fix, l_run, O, inv_l, impw + (h * 32 + r) * 65);
        }
        {
            const int row = tid >> 3, j8 = tid & 7, kr = row >> 5, tr = row & 31;
#pragma unroll
            for (int jj = 0; jj < 8; ++jj) {
                const int s = j8 * 8 + jj, db = qb64 - s;
                float v = 0.f;
#pragma unroll
                for (int g = 0; g < 4; ++g) v += impw[((kr * 4 + g) * 32 + tr) * 65 + s];
                vals[row * 65 + s] = (db >= 0 && db < 2) ? 2.0e4f : (s == 0 ? 1.0e4f : (db >= 0 ? v : -1.0f));
            }
            __syncthreads();
            unsigned bits = 0u;
            {
                float vv[8]; int rk[8];
#pragma unroll
                for (int jj = 0; jj < 8; ++jj) { vv[jj] = vals[row * 65 + j8 * 8 + jj]; rk[jj] = 0; }
#pragma unroll 2
                for (int s2 = 0; s2 < 64; ++s2) {
                    const float w = vals[row * 65 + s2];
#pragma unroll
                    for (int jj = 0; jj < 8; ++jj) rk[jj] += (w > vv[jj] || (w == vv[jj] && s2 < j8 * 8 + jj)) ? 1 : 0;
                }
#pragma unroll
                for (int jj = 0; jj < 8; ++jj) if (rk[jj] < 16 && qb64 - (j8 * 8 + jj) >= 0) bits |= 1u << jj;
            }
            selb[row * 8 + j8] = (unsigned char)bits;
            __syncthreads();
        }
        const unsigned mlo = *(LAS3 const unsigned*)(selb + (kvh * 32 + r) * 8), mhi = *(LAS3 const unsigned*)(selb + (kvh * 32 + r) * 8 + 4);
        __syncthreads();
        {
            const float g0 = sigmoidf_(gates[tok * 24 + h * 3 + 0]);
#pragma unroll
            for (int db = 0; db < 2; ++db)
#pragma unroll
                for (int i = 0; i < 16; ++i) { oslot[(db * 16 + i) * 64] = g0 * O[db][i]; O[db][i] = 0.f; }
        }
        {
            const bf16_t* ksb = (const bf16_t*)(ws + R_KS); const bf16_t* vst = (const bf16_t*)(ws + R_VST);
            const AtSrc src{ksb + bh0 * T_ * HD, ksb + bh1 * T_ * HD, vst + bh0 * HD * T_, vst + bh1 * HD * T_, T_};
            float m_run = -INFINITY, l_run = 0.f;
            at_branch<1, 0, APROBE>(lds, src, 0, qb64, Q, tq, tid, kvh, lut, mlo, mhi, m_run, l_run, O, 0.f, nullptr);
            const float l_tot = l_run + __shfl_xor(l_run, 32), sc = sigmoidf_(gates[tok * 24 + h * 3 + 1]) / l_tot;
#pragma unroll
            for (int db = 0; db < 2; ++db)
#pragma unroll
                for (int i = 0; i < 16; ++i) { oslot[(db * 16 + i) * 64] += sc * O[db][i]; O[db][i] = 0.f; }
        }
        {
            const bf16_t* kwb = (const bf16_t*)(ws + R_KW); const bf16_t* vwt = (const bf16_t*)(ws + R_VWT);
            const AtSrc src{kwb + bh0 * T_ * HD, kwb + bh1 * T_ * HD, vwt + bh0 * HD * T_, vwt + bh1 * HD * T_, T_};
            int wb0 = (t0 - 511) >> 6; wb0 = wb0 < 0 ? 0 : wb0;
            float m_run = -INFINITY, l_run = 0.f;
            at_branch<2, 0, APROBE>(lds, src, wb0, qb64, Q, tq, tid, kvh, lut, 0u, 0u, m_run, l_run, O, 0.f, nullptr);
            const float l_tot = l_run + __shfl_xor(l_run, 32), sc = sigmoidf_(gates[tok * 24 + h * 3 + 2]) / l_tot;
#pragma unroll
            for (int db = 0; db < 2; ++db)
#pragma unroll
                for (int i = 0; i < 16; ++i) O[db][i] = oslot[(db * 16 + i) * 64] + sc * O[db][i];
        }
        {
            float ss = 0.f;
#pragma unroll
            for (int db = 0; db < 2; ++db)
#pragma unroll
                for (int i = 0; i < 16; ++i) ss += O[db][i] * O[db][i];
            ss += __shfl_xor(ss, 32);
            if (hf == 0) ssq[h * 32 + r] = ss;
            __syncthreads();
            float tot = 0.f;
#pragma unroll
            for (int hh = 0; hh < 8; ++hh) tot += ssq[hh * 32 + r];
            const float rs = rsqrtf(tot * (1.0f / 512) + EPS);
#pragma unroll
            for (int db = 0; db < 2; ++db)
#pragma unroll
                for (int a = 0; a < 4; ++a) {
                    const int d = 32 * db + 8 * a + 4 * hf;
                    const f32x4 g4 = *(const f32x4*)(gn + h * 64 + d);
                    u32x2 w; w.x = pk_bf16(O[db][4 * a] * rs * g4[0], O[db][4 * a + 1] * rs * g4[1]); w.y = pk_bf16(O[db][4 * a + 2] * rs * g4[2], O[db][4 * a + 3] * rs * g4[3]);
                    *(u32x2*)(mixed + tok * DM + h * 64 + d) = w;
                }
            __syncthreads();
        }
    }
}
constexpr int LR_STRIDE = 516;
constexpr int LR_XC = 0, LR_A = 32 * LR_STRIDE * 4, LR_RS = 2 * 32 * LR_STRIDE * 4, LR_END = LR_RS + 256;
static_assert(LR_END <= 160 * 1024 - 256, "LRU LDS map");

template <bool FINAL>
DI void lru_phase(const Params& p, LAS3 unsigned char* lds, int G) {
    unsigned char* ws = p.ws;
    const int tid = threadIdx.x, lane = tid & 63, n = __builtin_amdgcn_readfirstlane(tid >> 6), r = lane & 31, hf = lane >> 5, ch = tid;
    LAS3 float* XC = (LAS3 float*)(lds + LR_XC); LAS3 float* AA = (LAS3 float*)(lds + LR_A); LAS3 float* RS = (LAS3 float*)(lds + LR_RS);
    const float* xr = (const float*)(ws + R_XR); const bf16_t* xg = (const bf16_t*)(ws + R_XG);
    float* sumP = (float*)(ws + WS_LRUP); float* sumH = (float*)(ws + WS_LRUH);
    bf16_t* mixed = (bf16_t*)(ws + WS_XB);
    const float cw0 = p.in[I_CONV_W][0 * 512 + ch], cw1 = p.in[I_CONV_W][1 * 512 + ch], cw2 = p.in[I_CONV_W][2 * 512 + ch], cw3 = p.in[I_CONV_W][3 * 512 + ch], cb = p.in[I_CONV_B][ch];
    const float gl = FINAL ? p.in[I_GN_LRU][ch] : 0.f;
    float ba[2], bx[2], sp[2];
#pragma unroll
    for (int nb = 0; nb < 2; ++nb) { const int c2 = n * 64 + 32 * nb + r; ba[nb] = p.in[I_LRU_BA][c2]; bx[nb] = p.in[I_LRU_BX][c2]; sp[nb] = log1pf(__expf(-p.in[I_LRU_LAM][c2])); }
    const bf16_t* waT = (const bf16_t*)(ws + WS_WAT); const bf16_t* wxT = (const bf16_t*)(ws + WS_WXT);
    for (int ci = blockIdx.x; ci < 256; ci += G) {
        const int b = ci >> 6, cib = ci & 63, t0 = cib * 64;
        const size_t tok0 = (size_t)b * T_ + t0;
        float x1 = 0.f, x2 = 0.f, x3 = 0.f;
        if (t0 > 0) { x1 = xr[(tok0 - 1) * 512 + ch]; x2 = xr[(tok0 - 2) * 512 + ch]; x3 = xr[(tok0 - 3) * 512 + ch]; }
        float hst = 0.f, pprod = 1.f;
        if (FINAL) {
            const float* Pp = sumP + (size_t)(b * 64) * 512 + ch; const float* Hp = sumH + (size_t)(b * 64) * 512 + ch;
            for (int k = 0; k < cib; ++k) hst = Pp[(size_t)k * 512] * hst + Hp[(size_t)k * 512];
        }
#pragma unroll 1
        for (int half = 0; half < 2; ++half) {
            const size_t tokh = tok0 + half * 32;
            __syncthreads();
            {
                float xv[32];
#pragma unroll
                for (int t = 0; t < 32; ++t) xv[t] = xr[(tokh + t) * 512 + ch];
#pragma unroll
                for (int t = 0; t < 32; ++t) {
                    const float x0 = xv[t];
                    XC[t * LR_STRIDE + ch] = cw0 * x3 + cw1 * x2 + cw2 * x1 + cw3 * x0 + cb;
                    x3 = x2; x2 = x1; x1 = x0;
                }
            }
            __syncthreads();
            {
                f32x16 ar[2], ai[2];
#pragma unroll
                for (int nb = 0; nb < 2; ++nb)
#pragma unroll
                    for (int i = 0; i < 16; ++i) { ar[nb][i] = 0.f; ai[nb][i] = 0.f; }
                bf16x8v Ba[2][4], Bx[2][4];
#pragma unroll
                for (int nb = 0; nb < 2; ++nb)
#pragma unroll
                    for (int ks = 0; ks < 4; ++ks) {
                        const size_t o = (size_t)(n * 64 + 32 * nb + r) * 64 + 16 * ks + 8 * hf;
                        Ba[nb][ks] = *(const bf16x8v*)(waT + o); Bx[nb][ks] = *(const bf16x8v*)(wxT + o);
                    }
#pragma unroll
                for (int ks = 0; ks < 4; ++ks) {
                    LAS3 const float* src = XC + r * LR_STRIDE + n * 64 + 16 * ks + 8 * hf;
                    const f32x4 f0 = *(LAS3 const f32x4*)src, f1 = *(LAS3 const f32x4*)(src + 4);
                    u32x4 pw; pw.x = pk_bf16(f0[0], f0[1]); pw.y = pk_bf16(f0[2], f0[3]); pw.z = pk_bf16(f1[0], f1[1]); pw.w = pk_bf16(f1[2], f1[3]);
                    const bf16x8v af = __builtin_bit_cast(bf16x8v, pw);
#pragma unroll
                    for (int nb = 0; nb < 2; ++nb) {
                        ar[nb] = __builtin_amdgcn_mfma_f32_32x32x16_bf16(af, Ba[nb][ks], ar[nb], 0, 0, 0);
                        ai[nb] = __builtin_amdgcn_mfma_f32_32x32x16_bf16(af, Bx[nb][ks], ai[nb], 0, 0, 0);
                    }
                }
                __syncthreads();
#pragma unroll
                for (int nb = 0; nb < 2; ++nb)
#pragma unroll
                    for (int i = 0; i < 16; ++i) {
                        const int t = (i & 3) + 8 * (i >> 2) + 4 * hf, o = t * LR_STRIDE + n * 64 + 32 * nb + r;
                        const float xcv = XC[o];
                        const float rg = sigmoidf_(ar[nb][i] + ba[nb]), ig = sigmoidf_(ai[nb][i] + bx[nb]);
                        const float log_a = -8.0f * rg * sp[nb];
                        AA[o] = __expf(log_a);
                        XC[o] = sqrtf(-expm1f(2.0f * log_a)) * (ig * xcv);
                    }
            }
            __syncthreads();
            if (!FINAL) {
#pragma unroll 8
                for (int t = 0; t < 32; ++t) { const float a = AA[t * LR_STRIDE + ch]; hst = a * hst + XC[t * LR_STRIDE + ch]; pprod *= a; }
            } else {
                {
                    bf16_t gv[32];
#pragma unroll
                    for (int t = 0; t < 32; ++t) gv[t] = xg[(tokh + t) * 512 + ch];
#pragma unroll
                    for (int t = 0; t < 32; ++t) {
                        hst = AA[t * LR_STRIDE + ch] * hst + XC[t * LR_STRIDE + ch];
                        XC[t * LR_STRIDE + ch] = hst * gelu_tanh(bf2f(gv[t]));
                    }
                }
                __syncthreads();
                {
                    const int t = tid >> 4, part = tid & 15;
                    float s = 0.f;
#pragma unroll 8
                    for (int j = 0; j < 32; ++j) { const float v = XC[t * LR_STRIDE + part + 16 * j]; s += v * v; }
                    s += __shfl_xor(s, 1); s += __shfl_xor(s, 2); s += __shfl_xor(s, 4); s += __shfl_xor(s, 8);
                    if (part == 0) RS[t] = rsqrtf(s * (1.0f / 512) + EPS);
                }
                __syncthreads();
#pragma unroll 8
                for (int t = 0; t < 32; ++t) mixed[(tokh + t) * DM + 512 + ch] = f2bf(XC[t * LR_STRIDE + ch] * RS[t] * gl);
            }
        }
        if (!FINAL) { sumP[(size_t)ci * 512 + ch] = pprod; sumH[(size_t)ci * 512 + ch] = hst; }
    }
    __syncthreads();
}
typedef float f32x4v __attribute__((ext_vector_type(4)));
constexpr int CM_IMG = 0;
constexpr int CM_HID = 36864;
constexpr int CM_END = CM_HID + 16 * 264 * 2;
DI void p2_compress(const Params& p, LAS3 unsigned char* lds, int G) {
    unsigned char* ws = p.ws;
    const int tid = threadIdx.x, lane = tid & 63, wid = __builtin_amdgcn_readfirstlane(tid >> 6), row = lane & 15, kg = lane >> 4;
    for (int u = blockIdx.x; u < 256; u += G) {
        const int kv = u >> 7, bh = (u >> 4) & 7, c0 = (u & 15) * 16;
        const bf16_t* src = (const bf16_t*)(ws + (kv ? R_VC : R_KC)) + ((size_t)bh * T_ + 16 * c0) * HD;
        const bf16_t* W1T = (const bf16_t*)(ws + (kv ? WS_CW1V : WS_CW1K));
        const float* cb = (const float*)(ws + (kv ? WS_CBV : WS_CBK));
        const bf16_t* W2T = (const bf16_t*)(ws + (kv ? WS_CW2V : WS_CW2K));
        __syncthreads();
        for (int i = tid; i < 272 * 8; i += MK_THREADS) { const int tau = i >> 3, cch = i & 7; *(LAS3 u32x4*)(lds + CM_IMG + tau * 128 + (tau >> 4) * 16 + cch * 16) = *(const u32x4*)(src + (size_t)tau * HD + cch * 8); }
        __syncthreads();
        f32x4v acc[2] = {{0.f, 0.f, 0.f, 0.f}, {0.f, 0.f, 0.f, 0.f}};
        const bf16_t* wb0 = W1T + (size_t)(wid * 32 + row) * 2048 + 8 * kg, * wb1 = wb0 + (size_t)16 * 2048;
#pragma unroll 8
        for (int ks = 0; ks < 64; ++ks) {
            const int tau = 16 * row + (ks >> 1);
            const bf16x8v a = *(LAS3 const bf16x8v*)(lds + CM_IMG + tau * 128 + (tau >> 4) * 16 + (32 * (ks & 1) + 8 * kg) * 2);
            const bf16x8v b0 = *(const bf16x8v*)(wb0 + 32 * ks), b1 = *(const bf16x8v*)(wb1 + 32 * ks);
            acc[0] = __builtin_amdgcn_mfma_f32_16x16x32_bf16(a, b0, acc[0], 0, 0, 0);
            acc[1] = __builtin_amdgcn_mfma_f32_16x16x32_bf16(a, b1, acc[1], 0, 0, 0);
        }
#pragma unroll
        for (int nb = 0; nb < 2; ++nb) {
            const int col = wid * 32 + 16 * nb + row; const float bias = cb[col];
#pragma unroll
            for (int i = 0; i < 4; ++i) *(LAS3 bf16_t*)(lds + CM_HID + ((4 * kg + i) * 264 + col) * 2) = f2bf(gelu_tanh(acc[nb][i] + bias));
        }
        __syncthreads();
        if (wid < 4) {
            f32x4v o = {0.f, 0.f, 0.f, 0.f};
#pragma unroll
            for (int ks = 0; ks < 8; ++ks) {
                const bf16x8v a = *(LAS3 const bf16x8v*)(lds + CM_HID + (row * 264 + 32 * ks + 8 * kg) * 2);
                const bf16x8v b = *(const bf16x8v*)(W2T + (size_t)(wid * 16 + row) * 256 + 32 * ks + 8 * kg);
                o = __builtin_amdgcn_mfma_f32_16x16x32_bf16(a, b, o, 0, 0, 0);
            }
            const int d = wid * 16 + row;
#pragma unroll
            for (int i = 0; i < 4; ++i) {
                const int c = c0 + 4 * kg + i; const float v = c < NCMP ? o[i] : 0.f;
                ((float*)(ws + (kv ? WS_VCMP : WS_KCMP)))[((size_t)bh * 256 + c) * 64 + d] = v;
                if (kv) ((bf16_t*)(ws + R_VCT))[((size_t)bh * 64 + d) * 256 + c] = f2bf(v);
                else    ((bf16_t*)(ws + R_KCB))[((size_t)bh * 256 + c) * 64 + d] = f2bf(v);
            }
        }
    }
    __syncthreads();
}
DI void p2_vtranspose(const Params& p, LAS3 unsigned char* lds, int G) {
    unsigned char* ws = p.ws;
    const int tid = threadIdx.x;
    LAS3 bf16_t* tl = (LAS3 bf16_t*)lds;
    for (int u = blockIdx.x; u < 1024; u += G) {
        const int which = u >> 9, bh = (u >> 6) & 7, tt = u & 63;
        const bf16_t* src = (const bf16_t*)(ws + (which ? R_VW : R_VS)) + ((size_t)bh * T_ + tt * 64) * HD;
        bf16_t* dst = (bf16_t*)(ws + (which ? R_VWT : R_VST)) + (size_t)bh * HD * T_ + tt * 64;
        __syncthreads();
        { const int tok = tid >> 3, seg = tid & 7; *(LAS3 u32x4*)(tl + tok * 72 + seg * 8) = *(const u32x4*)(src + (size_t)tok * HD + seg * 8); }
        __syncthreads();
        { const int d = tid >> 3, seg = tid & 7; u32x4 w;
          w.x = (unsigned)tl[(seg * 8 + 0) * 72 + d] | ((unsigned)tl[(seg * 8 + 1) * 72 + d] << 16); w.y = (unsigned)tl[(seg * 8 + 2) * 72 + d] | ((unsigned)tl[(seg * 8 + 3) * 72 + d] << 16);
          w.z = (unsigned)tl[(seg * 8 + 4) * 72 + d] | ((unsigned)tl[(seg * 8 + 5) * 72 + d] << 16); w.w = (unsigned)tl[(seg * 8 + 6) * 72 + d] | ((unsigned)tl[(seg * 8 + 7) * 72 + d] << 16);
          *(u32x4*)(dst + (size_t)d * T_ + seg * 8) = w; }
    }
    __syncthreads();
}
DI int ord_enc(float f) { const int u = __float_as_int(f); return u ^ ((u >> 31) & 0x7fffffff); }
DI float ord_dec(int o) { return __int_as_float(o ^ ((o >> 31) & 0x7fffffff)); }
#define PEER_CE_DESC(a, b) do { const int _hi = max((a), (b)), _lo = min((a), (b)); (a) = _hi; (b) = _lo; } while (0)
#define PEER_CE_ASC(a, b)  do { const int _hi = max((a), (b)), _lo = min((a), (b)); (a) = _lo; (b) = _hi; } while (0)
DI void sort16_desc(int (&x)[16]) {
#pragma unroll
    for (int k = 2; k <= 16; k <<= 1)
#pragma unroll
        for (int j = k >> 1; j > 0; j >>= 1)
#pragma unroll
            for (int i = 0; i < 16; ++i) { const int l = i ^ j; if (l > i) { if ((i & k) == 0) PEER_CE_DESC(x[i], x[l]); else PEER_CE_ASC(x[i], x[l]); } }
}
DI void merge16_desc(int (&a)[16], const int (&b)[16]) {
#pragma unroll
    for (int i = 0; i < 16; ++i) a[i] = max(a[i], b[15 - i]);
#pragma unroll
    for (int j = 8; j > 0; j >>= 1)
#pragma unroll
        for (int i = 0; i < 16; ++i) { const int l = i ^ j; if (l > i) PEER_CE_DESC(a[i], a[l]); }
}
constexpr int PR_KEYS = 0;
constexpr int PR_IDX = 512 * 68 * 4;
constexpr int PR_RS = PR_IDX + 128 * 32 * 4;
constexpr int PR_END = PR_RS + 1024;
static_assert(PR_END <= 160 * 1024 - 256, "PEER LDS map");

struct EpiPeerRoute {
    static constexpr bool PERM = true, AFTER_DRAIN = true;
    const float* ssq1; int* eout; float* gout; float* rs1out;
    DI void fused(const f32x4 (&acc)[2][2][4][2], const pg8::Unit& u, int wr, int wc, int fr, int fq, PG8_LAS unsigned char* lds, int wid, int lane) const {
        const int tid = wid * 64 + lane, head = u.pn;
        LAS3 int* KEYS = (LAS3 int*)(lds + PR_KEYS); LAS3 int* IDX = (LAS3 int*)(lds + PR_IDX); LAS3 float* RS = (LAS3 float*)(lds + PR_RS);
        if (tid < 256) { float s = 0.f; for (int j = 0; j < 16; ++j) s += ssq1[(size_t)j * NTOK + u.pm * 256 + tid]; RS[tid] = rsqrtf(s * (1.0f / DM) + EPS); if (u.pn == 0) rs1out[u.pm * 256 + tid] = RS[tid]; }
#pragma unroll 1
        for (int ai = 0; ai < 2; ++ai) {
            __syncthreads();
#pragma unroll
            for (int bj = 0; bj < 2; ++bj)
#pragma unroll
                for (int m = 0; m < 4; ++m)
#pragma unroll
                    for (int n = 0; n < 2; ++n) {
                        const int rl = 64 * wr + 16 * m + fr, kk0 = 32 * wc + 8 * fq + 4 * n, hl = ((rl * 2 + bj) * 2 + (kk0 >> 6));
                        const f32x4 v = ai == 0 ? acc[0][bj][m][n] : acc[1][bj][m][n];
                        u32x4 kq;
                        kq.x = (unsigned)((ord_enc(v[0]) & ~0x7f) | (127 - (kk0 + 0))); kq.y = (unsigned)((ord_enc(v[1]) & ~0x7f) | (127 - (kk0 + 1)));
                        kq.z = (unsigned)((ord_enc(v[2]) & ~0x7f) | (127 - (kk0 + 2))); kq.w = (unsigned)((ord_enc(v[3]) & ~0x7f) | (127 - (kk0 + 3)));
                        *(LAS3 u32x4*)(KEYS + hl * 68 + (kk0 & 63)) = kq;
                    }
            __syncthreads();
            int top[16];
            {
                LAS3 const int* src = KEYS + tid * 68;
                int t2[16];
#pragma unroll
                for (int q = 0; q < 4; ++q) { const u32x4 w = *(LAS3 const u32x4*)(src + 4 * q); top[4 * q] = (int)w.x; top[4 * q + 1] = (int)w.y; top[4 * q + 2] = (int)w.z; top[4 * q + 3] = (int)w.w; }
                sort16_desc(top);
#pragma unroll 1
                for (int g = 1; g < 4; ++g) {
#pragma unroll
                    for (int q = 0; q < 4; ++q) { const u32x4 w = *(LAS3 const u32x4*)(src + 16 * g + 4 * q); t2[4 * q] = (int)w.x; t2[4 * q + 1] = (int)w.y; t2[4 * q + 2] = (int)w.z; t2[4 * q + 3] = (int)w.w; }
                    sort16_desc(t2);
                    merge16_desc(top, t2);
                }
#pragma unroll
                for (int i = 0; i < 16; ++i) t2[i] = __shfl_xor(top[i], 1);
                merge16_desc(top, t2);
            }
            int s1[16], s2[16];
            {
                const bool isp1 = (lane & 2) != 0;
#pragma unroll
                for (int i = 0; i < 16; ++i) { const int o = __shfl_xor(top[i], 2); s1[i] = isp1 ? o : top[i]; s2[i] = isp1 ? top[i] : o; }
            }
            const int rl = tid >> 2, q4 = tid & 3;
#pragma unroll
            for (int kq = 0; kq < 4; ++kq) if (q4 == kq) {
#pragma unroll
                for (int j = 0; j < 4; ++j) { IDX[rl * 32 + 4 * kq + j] = 127 - (s1[4 * kq + j] & 0x7f); IDX[rl * 32 + 16 + 4 * kq + j] = 127 - (s2[4 * kq + j] & 0x7f); }
            }
            float v1[16], v2[16];
#pragma unroll
            for (int i = 0; i < 16; ++i) { v1[i] = ord_dec(s1[i] & ~0x7f); v2[i] = ord_dec(s2[i] & ~0x7f); }
            int best[16], grp[16];
            {
                int cnt = 0; bool first = true;
#pragma unroll
                for (int a = 0; a < 16; ++a)
#pragma unroll
                    for (int b = 0; b < 16; ++b) if ((a + 1) * (b + 1) <= 16) {
                        grp[cnt & 15] = (ord_enc(v1[a] + v2[b]) & ~0xff) | (255 - (16 * a + b));
                        ++cnt;
                        if ((cnt & 15) == 0) { sort16_desc(grp); if (first) {
#pragma unroll
                                for (int i = 0; i < 16; ++i) best[i] = grp[i];
                                first = false; } else merge16_desc(best, grp); }
                    }
#pragma unroll
                for (int i = 2; i < 16; ++i) grp[i] = (int)0x80000000;
                sort16_desc(grp); merge16_desc(best, grp);
            }
            __syncthreads();
            const float rs1 = RS[128 * ai + rl];
            float gsum = 0.f, gv[16]; int ev[16];
            const float mtop = ord_dec(best[0] & ~0xff) * rs1;
#pragma unroll
            for (int i = 0; i < 16; ++i) {
                const float sc = ord_dec(best[i] & ~0xff) * rs1; gv[i] = __expf(sc - mtop); gsum += gv[i];
                const int ab = 255 - (best[i] & 0xff);
                ev[i] = IDX[rl * 32 + (ab >> 4)] * 128 + IDX[rl * 32 + 16 + (ab & 15)];
            }
            const float ginv = 1.0f / gsum;
            const size_t tok = (size_t)u.pm * 256 + 128 * ai + rl;
#pragma unroll
            for (int kq = 0; kq < 4; ++kq) if (q4 == kq) {
                *(u32x4*)(eout + tok * 128 + head * 16 + 4 * kq) = (u32x4){(unsigned)ev[4 * kq], (unsigned)ev[4 * kq + 1], (unsigned)ev[4 * kq + 2], (unsigned)ev[4 * kq + 3]};
                *(f32x4*)(gout + tok * 128 + head * 16 + 4 * kq) = (f32x4){gv[4 * kq] * ginv, gv[4 * kq + 1] * ginv, gv[4 * kq + 2] * ginv, gv[4 * kq + 3] * ginv};
            }
        }
        __syncthreads();
    }
    DI void operator()(const f32x4 (&)[2][2][4][2], const pg8::Unit&, int, int, int, int) const {}
};
struct SliceOrder : pg8::StaticOrder {
    int slice;
    __device__ bool next(int i, pg8::Unit& u) const { if (i > 0) return false; return pg8::StaticOrder::next(slice, u); }
};
DI void p5_peer_route(const Params& p, LAS3 unsigned char* lds, int G) {
    unsigned char* ws = p.ws;
    pg8::Gemm g{(const bf16_t*)(ws + R_H1B), (const bf16_t*)(ws + WS_WQS), NTOK, 2048, DM};
    EpiPeerRoute E{(const float*)(ws + WS_SSQ1), (int*)(ws + R_EXP), (float*)(ws + R_GSM), (float*)(ws + WS_RS1)};
    const int nslice = (512 + G - 1) / G;
#pragma unroll 1
    for (int s = 0; s < nslice; ++s) {
        SliceOrder S; S.init(NTOK, 2048, G, (int)blockIdx.x); S.slice = s;
        pg8::gemm_phase<EpiPeerRoute, SliceOrder>(lds, g, S, E, nullptr);
        __syncthreads();
    }
}
DI void p6_peer_u(const Params& p, int G) {
    unsigned char* ws = p.ws;
    const int tid = threadIdx.x, lane = tid & 63, wid = tid >> 6, grp = blockIdx.x & 7, rank = blockIdx.x >> 3;
    const int nrank = (G - grp + 7) >> 3, wv = rank * 8 + wid, nwv = nrank * 8;
    const bf16_t* ub = (const bf16_t*)(ws + WS_UB); const bf16_t* hb = (const bf16_t*)(ws + R_H1B);
    const int* eidx = (const int*)(ws + R_EXP); const float* gsm = (const float*)(ws + R_GSM); const float* rs1v = (const float*)(ws + WS_RS1);
    float* coef = (float*)(ws + R_COEF);
#pragma unroll 1
    for (int sweep = 0; sweep < 2; ++sweep) {
        const int sel = grp + 8 * sweep;
#pragma unroll 1
        for (int tok = wv; tok < NTOK; tok += nwv) {
            const int ev0 = eidx[(size_t)tok * 128 + lane], ev1 = eidx[(size_t)tok * 128 + 64 + lane];
            unsigned long long m0 = __ballot((ev0 & 15) == sel), m1 = __ballot((ev1 & 15) == sel);
            if ((m0 | m1) == 0ull) continue;
            const float gv0 = gsm[(size_t)tok * 128 + lane], gv1 = gsm[(size_t)tok * 128 + 64 + lane];
            const u32x4 xa = *(const u32x4*)(hb + (size_t)tok * DM + lane * 8), xc = *(const u32x4*)(hb + (size_t)tok * DM + 512 + lane * 8);
            const float rs1 = rs1v[tok];
            while ((m0 | m1) != 0ull) {
                int jj[8]; int ee[8]; float gg[8]; int nv = 0;
#pragma unroll
                for (int k = 0; k < 8; ++k) {
                    int j = k > 0 ? jj[k - 1] : 0; int e = k > 0 ? ee[k - 1] : 0; float g = k > 0 ? gg[k - 1] : 0.f;
                    if (m0 != 0ull) { const int b = __builtin_ctzll(m0); m0 &= m0 - 1ull; j = b; e = __builtin_amdgcn_readlane(ev0, b); g = __uint_as_float(__builtin_amdgcn_readlane(__float_as_uint(gv0), b)); nv = k + 1; }
                    else if (m1 != 0ull) { const int b = __builtin_ctzll(m1); m1 &= m1 - 1ull; j = 64 + b; e = __builtin_amdgcn_readlane(ev1, b); g = __uint_as_float(__builtin_amdgcn_readlane(__float_as_uint(gv1), b)); nv = k + 1; }
                    jj[k] = j; ee[k] = e; gg[k] = g;
                }
                float part[8];
#pragma unroll
                for (int k = 0; k < 8; ++k) {
                    const bf16_t* ur = ub + (size_t)ee[k] * DM + lane * 8;
                    const u32x4 ua = *(const u32x4*)ur, uc = *(const u32x4*)(ur + 512);
                    float a = dot2bf(xa.x, ua.x, 0.f); a = dot2bf(xa.y, ua.y, a); a = dot2bf(xa.z, ua.z, a); a = dot2bf(xa.w, ua.w, a);
                    a = dot2bf(xc.x, uc.x, a); a = dot2bf(xc.y, uc.y, a); a = dot2bf(xc.z, uc.z, a); a = dot2bf(xc.w, uc.w, a);
                    part[k] = a;
                }
#pragma unroll
                for (int m = 4; m >= 1; m >>= 1) {
                    const bool up = (lane & (8 * m)) != 0;
#pragma unroll
                    for (int i = 0; i < m; ++i) { const float send = up ? part[i] : part[i + m], keep = up ? part[i + m] : part[i]; part[i] = keep + __shfl_xor(send, 8 * m); }
                }
                float tot = part[0];
                tot += __shfl_xor(tot, 4); tot += __shfl_xor(tot, 2); tot += __shfl_xor(tot, 1);
                const int kk = lane >> 3;
                int myj = jj[0]; float myg = gg[0];
#pragma unroll
                for (int k = 1; k < 8; ++k) { myj = kk == k ? jj[k] : myj; myg = kk == k ? gg[k] : myg; }
                if ((lane & 7) == 0 && kk < nv) coef[(size_t)tok * 128 + myj] = myg * gelu_tanh(tot * rs1);
            }
        }
    }
}
DI void p6_peer_v(const Params& p, int G) {
    unsigned char* ws = p.ws;
    const int tid = threadIdx.x, lane = tid & 63, wid = tid >> 6, grp = blockIdx.x & 7, rank = blockIdx.x >> 3;
    const int nrank = (G - grp + 7) >> 3, wv = rank * 8 + wid, nwv = nrank * 8;
    const bf16_t* vb = (const bf16_t*)(ws + WS_VB);
    const int* eidx = (const int*)(ws + R_EXP); const float* coef = (const float*)(ws + R_COEF);
    float* h = p.out; bf16_t* hb = (bf16_t*)(ws + R_H1B); float* ssq2 = (float*)(ws + WS_SSQ2);
    const int sub = lane >> 3, c8 = (lane & 7) * 8;
#pragma unroll 1
    for (int sweep = 0; sweep < 2; ++sweep) {
        const int slice = grp + 8 * sweep, col0 = slice * 64 + c8;
#pragma unroll 1
        for (int tok = wv; tok < NTOK; tok += nwv) {
            const int ev0 = eidx[(size_t)tok * 128 + lane], ev1 = eidx[(size_t)tok * 128 + 64 + lane];
            const float cv0 = coef[(size_t)tok * 128 + lane], cv1 = coef[(size_t)tok * 128 + 64 + lane];
            u32x4 vr[16]; float cf[16];
#pragma unroll
            for (int i = 0; i < 16; ++i) {
                const int j = 8 * i + sub;
                const int e = __shfl(i < 8 ? ev0 : ev1, j & 63); cf[i] = __shfl(i < 8 ? cv0 : cv1, j & 63);
                vr[i] = *(const u32x4*)(vb + (size_t)e * DM + col0);
            }
            float acc[8];
#pragma unroll
            for (int q = 0; q < 8; ++q) acc[q] = 0.f;
#pragma unroll
            for (int i = 0; i < 16; ++i) {
                const float c = cf[i];
                acc[0] += c * bflo(vr[i].x); acc[1] += c * bfhi(vr[i].x); acc[2] += c * bflo(vr[i].y); acc[3] += c * bfhi(vr[i].y);
                acc[4] += c * bflo(vr[i].z); acc[5] += c * bfhi(vr[i].z); acc[6] += c * bflo(vr[i].w); acc[7] += c * bfhi(vr[i].w);
            }
#pragma unroll
            for (int q = 0; q < 8; ++q) { acc[q] += __shfl_xor(acc[q], 8); acc[q] += __shfl_xor(acc[q], 16); acc[q] += __shfl_xor(acc[q], 32); }
            float ss = 0.f;
            if (lane < 8) {
                float* hr = h + (size_t)tok * DM + col0;
                f32x4 h0 = *(f32x4*)hr, h1 = *(f32x4*)(hr + 4);
                h0 += (f32x4){acc[0], acc[1], acc[2], acc[3]}; h1 += (f32x4){acc[4], acc[5], acc[6], acc[7]};
                *(f32x4*)hr = h0; *(f32x4*)(hr + 4) = h1;
                u32x4 w; w.x = pk_bf16(h0[0], h0[1]); w.y = pk_bf16(h0[2], h0[3]); w.z = pk_bf16(h1[0], h1[1]); w.w = pk_bf16(h1[2], h1[3]);
                *(u32x4*)(hb + (size_t)tok * DM + col0) = w;
                ss = (h0[0] * h0[0] + h0[1] * h0[1]) + (h0[2] * h0[2] + h0[3] * h0[3]) + (h1[0] * h1[0] + h1[1] * h1[1]) + (h1[2] * h1[2] + h1[3] * h1[3]);
            }
            ss += __shfl_xor(ss, 1); ss += __shfl_xor(ss, 2); ss += __shfl_xor(ss, 4);
            if (lane == 0) ssq2[(size_t)slice * NTOK + tok] = ss;
        }
    }
}
#if PEER_FP4
constexpr float U8_SCALE = 64.0f, V8_SCALE = 6.0f;
#else
constexpr float U8_SCALE = 32.0f, V8_SCALE = 8.0f;
#endif
constexpr int LDS_MISC_OFF = 160 * 1024 - 256;
DI void fp8x16_to_f32(const u32x4 w, float (&f)[16]) {
#pragma unroll
    for (int q = 0; q < 4; ++q) {
        const f32x2 lo = __builtin_amdgcn_cvt_pk_f32_fp8((int)w[q], false), hi = __builtin_amdgcn_cvt_pk_f32_fp8((int)w[q], true);
        f[4 * q] = lo.x; f[4 * q + 1] = lo.y; f[4 * q + 2] = hi.x; f[4 * q + 3] = hi.y;
    }
}
struct Pu5Fixed { int ev0, ev1; float gv0, gv1; u32x4 xa, xb; float rs1; };
DI void pu5_load_fixed(Pu5Fixed& f, int tok, int lane, const int* eidx, const float* gsm, const bf16_t* hb, const float* rs1v) {
    f.ev0 = eidx[(size_t)tok * 128 + lane]; f.ev1 = eidx[(size_t)tok * 128 + 64 + lane];
    f.gv0 = gsm[(size_t)tok * 128 + lane]; f.gv1 = gsm[(size_t)tok * 128 + 64 + lane];
    f.xa = *(const u32x4*)(hb + (size_t)tok * DM + lane * 16); f.xb = *(const u32x4*)(hb + (size_t)tok * DM + lane * 16 + 8);
    f.rs1 = rs1v[tok];
}
DI int pu5_setup(const Pu5Fixed& f, int sel, int lane, LAS3 unsigned* ent) {
    const bool s0 = (f.ev0 & 15) == sel, s1 = (f.ev1 & 15) == sel;
    const unsigned long long b0 = __ballot(s0), b1 = __ballot(s1);
    const int c0 = __builtin_popcountll(b0), cnt = c0 + __builtin_popcountll(b1);
    const unsigned long long lt = (1ull << lane) - 1ull;
    const int r0 = __builtin_popcountll(b0 & lt), r1 = c0 + __builtin_popcountll(b1 & lt);
    if (s0) { ent[r0] = (unsigned)f.ev0 | ((unsigned)lane << 16); ent[128 + r0] = __float_as_uint(f.gv0); }
    if (s1) { ent[r1] = (unsigned)f.ev1 | ((unsigned)(64 + lane) << 16); ent[128 + r1] = __float_as_uint(f.gv1); }
    return cnt;
}
#define PU5_ISSUE(SET, ENT, CNT) do { \
        _Pragma("unroll") for (int q = 0; q < 4; ++q) { const u32x4 e4 = *(LAS3 const u32x4*)((ENT) + 4 * q); \
            _Pragma("unroll") for (int k2 = 0; k2 < 4; ++k2) { const int k = 4 * q + k2; \
                const unsigned off = k < (CNT) ? ((e4[k2] & 0x3fffu) * (unsigned)DM) + lane * 16 : 0x80000000u; \
                SET[k] = __builtin_amdgcn_raw_buffer_load_b128(urs, off, 0, 0); } } } while (0)
#define PU5_CONSUME(SET, ENT, CNT, TOK, RS) do { \
        float part[16]; \
        _Pragma("unroll") for (int k = 0; k < 16; ++k) { float a = 0.f; \
            if (k < (CNT)) { f32x2 a2 = {0.f, 0.f}; \
                _Pragma("unroll") for (int q = 0; q < 4; ++q) { \
                    a2 = __builtin_elementwise_fma(__builtin_amdgcn_cvt_pk_f32_fp8((int)SET[k][q], false), xp[2 * q], a2); \
                    a2 = __builtin_elementwise_fma(__builtin_amdgcn_cvt_pk_f32_fp8((int)SET[k][q], true), xp[2 * q + 1], a2); } \
                a = a2.x + a2.y; } \
            part[k] = a; } \
        _Pragma("unroll") for (int m = 8; m >= 1; m >>= 1) { const bool up = (lane & (4 * m)) != 0; \
            _Pragma("unroll") for (int i = 0; i < m; ++i) { const float send = up ? part[i] : part[i + m], keep = up ? part[i + m] : part[i]; part[i] = keep + __shfl_xor(send, 4 * m); } } \
        float tot = part[0]; tot += __shfl_xor(tot, 2); tot += __shfl_xor(tot, 1); \
        const int kk = lane >> 2; const unsigned ew = (ENT)[kk]; const float gw = __uint_as_float((ENT)[128 + kk]); \
        if ((lane & 3) == 0 && kk < (CNT)) coef[(size_t)(TOK) * 128 + (ew >> 16)] = gw * (1.0f / V8_SCALE) * gelu_tanh(tot * ((RS) * (1.0f / U8_SCALE))); \
        if ((CNT) > 16) {   \
            for (int base = 16; base < (CNT); base += 16) { u32x4 rx[16]; \
                _Pragma("unroll") for (int k = 0; k < 16; ++k) { const unsigned e1 = (ENT)[base + k]; \
                    rx[k] = __builtin_amdgcn_raw_buffer_load_b128(urs, base + k < (CNT) ? ((e1 & 0x3fffu) * (unsigned)DM) + lane * 16 : 0x80000000u, 0, 0); } \
                float pr[16]; \
                _Pragma("unroll") for (int k = 0; k < 16; ++k) { f32x2 a2 = {0.f, 0.f}; \
                    _Pragma("unroll") for (int q = 0; q < 4; ++q) { \
                        a2 = __builtin_elementwise_fma(__builtin_amdgcn_cvt_pk_f32_fp8((int)rx[k][q], false), xp[2 * q], a2); \
                        a2 = __builtin_elementwise_fma(__builtin_amdgcn_cvt_pk_f32_fp8((int)rx[k][q], true), xp[2 * q + 1], a2); } \
                    pr[k] = a2.x + a2.y; } \
                _Pragma("unroll") for (int m = 8; m >= 1; m >>= 1) { const bool up = (lane & (4 * m)) != 0; \
                    _Pragma("unroll") for (int i = 0; i < m; ++i) { const float send = up ? pr[i] : pr[i + m], keep = up ? pr[i + m] : pr[i]; pr[i] = keep + __shfl_xor(send, 4 * m); } } \
                float t2 = pr[0]; t2 += __shfl_xor(t2, 2); t2 += __shfl_xor(t2, 1); \
                const int k3 = base + (lane >> 2); const unsigned ew2 = (ENT)[k3 & 127]; const float gw2 = __uint_as_float((ENT)[128 + (k3 & 127)]); \
                if ((lane & 3) == 0 && k3 < (CNT)) coef[(size_t)(TOK) * 128 + (ew2 >> 16)] = gw2 * (1.0f / V8_SCALE) * gelu_tanh(t2 * ((RS) * (1.0f / U8_SCALE))); } } } while (0)
#define PU5_UNPACK(F) do { _Pragma("unroll") for (int q = 0; q < 4; ++q) { xp[q] = (f32x2){bflo((F).xa[q]), bfhi((F).xa[q])}; xp[4 + q] = (f32x2){bflo((F).xb[q]), bfhi((F).xb[q])}; } } while (0)
DI void p6v5_u(const Params& p, LAS3 unsigned char* lds, int G) {
    unsigned char* ws = p.ws;
    const int tid = threadIdx.x, lane = tid & 63, wid = tid >> 6, grp = blockIdx.x & 7, rank = blockIdx.x >> 3;
    const int nrank = (G - grp + 7) >> 3, wv = rank * 8 + wid, nwv = nrank * 8;
    const unsigned char* u8 = (const unsigned char*)(ws + WS_UB); const bf16_t* hb = (const bf16_t*)(ws + R_H1B);
    const int* eidx = (const int*)(ws + R_EXP); const float* gsm = (const float*)(ws + R_GSM); const float* rs1v = (const float*)(ws + WS_RS1);
    float* coef = (float*)(ws + R_COEF);
    LAS3 unsigned* entA = (LAS3 unsigned*)(lds + wid * 2048); LAS3 unsigned* entB = entA + 256;
    if (wv >= NTOK) return;
    const __amdgpu_buffer_rsrc_t urs = __builtin_amdgcn_make_buffer_rsrc((void*)u8, 0, 16384 * DM, 0x00020000);
    const int nvis = (NTOK - wv + nwv - 1) / nwv, NV = 2 * nvis;
#define PU5_TOK(V) (wv + (((V) < NV ? (V) : NV - 1) % nvis) * nwv)
#define PU5_SEL(V) (grp + 8 * (((V) < NV ? (V) : NV - 1) / nvis))
    Pu5Fixed f1, f2;
    pu5_load_fixed(f1, PU5_TOK(0), lane, eidx, gsm, hb, rs1v);
    u32x4 sa[16], sb[16];
    f32x2 xp[8];
    int cntA = pu5_setup(f1, PU5_SEL(0), lane, entA), cntB = 0;
    PU5_ISSUE(sa, entA, cntA);
    int tokA = PU5_TOK(0), tokB = 0; float rsA = f1.rs1, rsB = 0.f;
    PU5_UNPACK(f1);
    pu5_load_fixed(f1, PU5_TOK(1), lane, eidx, gsm, hb, rs1v);
#pragma unroll 1
    for (int v = 0; v < NV; v += 2) {
        pu5_load_fixed(f2, PU5_TOK(v + 2), lane, eidx, gsm, hb, rs1v);
        cntB = pu5_setup(f1, PU5_SEL(v + 1), lane, entB); if (v + 1 >= NV) cntB = 0;
        PU5_ISSUE(sb, entB, cntB);
        tokB = PU5_TOK(v + 1); rsB = f1.rs1;
        PU5_CONSUME(sa, entA, cntA, tokA, rsA);
        PU5_UNPACK(f1);
        f1 = f2;
        pu5_load_fixed(f2, PU5_TOK(v + 3), lane, eidx, gsm, hb, rs1v);
        cntA = pu5_setup(f1, PU5_SEL(v + 2), lane, entA); if (v + 2 >= NV) cntA = 0;
        PU5_ISSUE(sa, entA, cntA);
        tokA = PU5_TOK(v + 2); rsA = f1.rs1;
        PU5_CONSUME(sb, entB, cntB, tokB, rsB);
        PU5_UNPACK(f1);
        f1 = f2;
    }
#undef PU5_TOK
#undef PU5_SEL
}
#undef PU5_ISSUE
#undef PU5_CONSUME
#undef PU5_UNPACK
template <int PMODE> DI void p6v3_v(const Params& p, int G) {
    unsigned char* ws = p.ws;
    const int tid = threadIdx.x, lane = tid & 63, wid = tid >> 6;
#if XCC_HW
    volatile LAS3 unsigned* miscw = (volatile LAS3 unsigned*)((LAS3 unsigned char*)0 + LDS_MISC_OFF);
    const int grp = (int)miscw[16], rank = (int)miscw[17];
    const int nrank = (int)__hip_atomic_load((unsigned*)(ws + WS_CTL + 16384) + grp * 16, __ATOMIC_RELAXED, __HIP_MEMORY_SCOPE_AGENT);
#else
    const int grp = blockIdx.x & 7, rank = blockIdx.x >> 3;
    const int nrank = (G - grp + 7) >> 3;
#endif
    const int wv = rank * 8 + wid, nwv = nrank * 8;
    const unsigned char* v8 = (const unsigned char*)(ws + WS_VB);
    const int* eidx = (const int*)(ws + R_EXP); const float* coef = (const float*)(ws + R_COEF);
    float* h = PMODE == 0 ? p.out : (float*)(ws + R_BIG); bf16_t* hb = PMODE == 0 ? (bf16_t*)(ws + R_H1B) : (bf16_t*)(ws + WS_XB); float* ssq2 = PMODE == 0 ? (float*)(ws + WS_SSQ2) : (float*)(ws + WS_SSQ3);
    const int sub = lane >> 3, col0 = grp * 128 + (lane & 7) * 16;
    if (wv >= NTOK) return;
    const int nvis = (NTOK - wv + nwv - 1) / nwv;
#define PV_LOADIDX(T, EV0, EV1, CV0, CV1) do { EV0 = eidx[(size_t)(T) * 128 + lane]; EV1 = eidx[(size_t)(T) * 128 + 64 + lane]; CV0 = coef[(size_t)(T) * 128 + lane]; CV1 = coef[(size_t)(T) * 128 + 64 + lane]; } while (0)
#define PV_ISSUE8(R, EV) do { _Pragma("unroll") for (int i = 0; i < 8; ++i) { const int e = __shfl((EV), 8 * i + sub); R[i] = *(const u32x4*)(v8 + (unsigned)(e * DM + col0)); } } while (0)
#define PV_CONS8(R, CV) do { _Pragma("unroll") for (int i = 0; i < 8; ++i) { float f[16]; fp8x16_to_f32(R[i], f); const float c = __shfl((CV), 8 * i + sub); \
            _Pragma("unroll") for (int q = 0; q < 16; ++q) acc[q] += c * f[q]; } } while (0)
    u32x4 ra[8], rb[8];
    int e0, e1, n0, n1, x0, x1; float c0, c1, d0, d1, y0, y1;
    PV_LOADIDX(wv, e0, e1, c0, c1);
    { const int t1 = nvis > 1 ? wv + nwv : wv; PV_LOADIDX(t1, n0, n1, d0, d1); }
    PV_ISSUE8(ra, e0); PV_ISSUE8(rb, e1);
#pragma unroll 1
    for (int it = 0; it < nvis; ++it) {
        const int tok = wv + it * nwv;
        const int t2 = wv + (it + 2 < nvis ? it + 2 : nvis - 1) * nwv;
        float* hr = h + (size_t)tok * DM + col0;
        const f32x4 hv0 = *(const f32x4*)hr, hv1 = *(const f32x4*)(hr + 4), hv2 = *(const f32x4*)(hr + 8), hv3 = *(const f32x4*)(hr + 12);
        PV_LOADIDX(t2, x0, x1, y0, y1);
        float acc[16];
#pragma unroll
        for (int q = 0; q < 16; ++q) acc[q] = 0.f;
        PV_CONS8(ra, c0);
        PV_ISSUE8(ra, n0);
        PV_CONS8(rb, c1);
        PV_ISSUE8(rb, n1);
#pragma unroll
        for (int q = 0; q < 16; ++q) { acc[q] += __shfl_xor(acc[q], 8); acc[q] += __shfl_xor(acc[q], 16); acc[q] += __shfl_xor(acc[q], 32); }
        float ss = 0.f;
        if (lane < 8) {
            const f32x4 o0 = hv0 + (f32x4){acc[0], acc[1], acc[2], acc[3]}, o1 = hv1 + (f32x4){acc[4], acc[5], acc[6], acc[7]};
            const f32x4 o2 = hv2 + (f32x4){acc[8], acc[9], acc[10], acc[11]}, o3 = hv3 + (f32x4){acc[12], acc[13], acc[14], acc[15]};
            *(f32x4*)hr = o0; *(f32x4*)(hr + 4) = o1; *(f32x4*)(hr + 8) = o2; *(f32x4*)(hr + 12) = o3;
            u32x4 w0, w1;
            w0.x = pk_bf16(o0[0], o0[1]); w0.y = pk_bf16(o0[2], o0[3]); w0.z = pk_bf16(o1[0], o1[1]); w0.w = pk_bf16(o1[2], o1[3]);
            w1.x = pk_bf16(o2[0], o2[1]); w1.y = pk_bf16(o2[2], o2[3]); w1.z = pk_bf16(o3[0], o3[1]); w1.w = pk_bf16(o3[2], o3[3]);
            *(u32x4*)(hb + (size_t)tok * DM + col0) = w0; *(u32x4*)(hb + (size_t)tok * DM + col0 + 8) = w1;
#pragma unroll
            for (int j = 0; j < 4; ++j) ss += o0[j] * o0[j] + o1[j] * o1[j] + o2[j] * o2[j] + o3[j] * o3[j];
        }
        ss += __shfl_xor(ss, 1); ss += __shfl_xor(ss, 2); ss += __shfl_xor(ss, 4);
        if (lane == 0) ssq2[(size_t)grp * NTOK + tok] = ss;
        e0 = n0; e1 = n1; c0 = d0; c1 = d1; n0 = x0; n1 = x1; d0 = y0; d1 = y1;
    }
#undef PV_LOADIDX
#undef PV_ISSUE8
#undef PV_CONS8
}
DI void p6v6_peer(const Params& p, int G) {
    unsigned char* ws = p.ws;
    const int tid = threadIdx.x, lane = tid & 63, wid = tid >> 6;
    const int gw = blockIdx.x * 8 + wid, nw = G * 8;
    const unsigned char* u8 = (const unsigned char*)(ws + WS_UB); const unsigned char* v8 = (const unsigned char*)(ws + WS_VB);
    const int* eidx = (const int*)(ws + R_EXP); const float* gsm = (const float*)(ws + R_GSM); const float* rs1v = (const float*)(ws + WS_RS1);
    float* h = p.out; bf16_t* hb = (bf16_t*)(ws + R_H1B); float* rs2 = (float*)(ws + WS_RS2);
#pragma unroll 1
    for (int tok = gw; tok < NTOK; tok += nw) {
        const float rs1 = rs1v[tok] * (1.0f / U8_SCALE);
        const u32x4 xa = *(const u32x4*)(hb + (size_t)tok * DM + lane * 16), xb = *(const u32x4*)(hb + (size_t)tok * DM + lane * 16 + 8);
        f32x2 xp[8];
#pragma unroll
        for (int q = 0; q < 4; ++q) { xp[q] = (f32x2){bflo(xa[q]), bfhi(xa[q])}; xp[4 + q] = (f32x2){bflo(xb[q]), bfhi(xb[q])}; }
        const int e0 = eidx[(size_t)tok * 128 + lane], e1 = eidx[(size_t)tok * 128 + 64 + lane];
        const float g0 = gsm[(size_t)tok * 128 + lane], g1 = gsm[(size_t)tok * 128 + 64 + lane];
        float coef0 = 0.f, coef1 = 0.f;
#pragma unroll
        for (int half = 0; half < 2; ++half) {
            const int ev = half ? e1 : e0;
            float part[64];
#pragma unroll
            for (int j = 0; j < 64; ++j) {
                const int e = __builtin_amdgcn_readlane(ev, j);
                const u32x4 w = *(const u32x4*)(u8 + (size_t)e * DM + lane * 16);
                f32x2 a2 = {0.f, 0.f};
#pragma unroll
                for (int q = 0; q < 4; ++q) {
                    a2 = __builtin_elementwise_fma(__builtin_amdgcn_cvt_pk_f32_fp8((int)w[q], false), xp[2 * q], a2);
                    a2 = __builtin_elementwise_fma(__builtin_amdgcn_cvt_pk_f32_fp8((int)w[q], true), xp[2 * q + 1], a2);
                }
                part[j] = a2.x + a2.y;
            }
#pragma unroll
            for (int m = 32; m >= 1; m >>= 1) {
                const bool up = (lane & m) != 0;
#pragma unroll
                for (int i = 0; i < m; ++i) { const float send = up ? part[i] : part[i + m], keep = up ? part[i + m] : part[i]; part[i] = keep + __shfl_xor(send, m); }
            }
            const float act = gelu_tanh(part[0] * rs1);
            if (half) coef1 = g1 * act * (1.0f / V8_SCALE); else coef0 = g0 * act * (1.0f / V8_SCALE);
        }
        f32x2 acc[8];
#pragma unroll
        for (int i = 0; i < 8; ++i) acc[i] = (f32x2){0.f, 0.f};
#pragma unroll
        for (int half = 0; half < 2; ++half) {
            const int ev = half ? e1 : e0; const float cv = half ? coef1 : coef0;
#pragma unroll 16
            for (int j = 0; j < 64; ++j) {
                const int e = __builtin_amdgcn_readlane(ev, j);
                const float c = __uint_as_float(__builtin_amdgcn_readlane(__float_as_uint(cv), j));
                const u32x4 w = *(const u32x4*)(v8 + (size_t)e * DM + lane * 16);
                const f32x2 c2 = {c, c};
#pragma unroll
                for (int q = 0; q < 4; ++q) {
                    acc[2 * q] = __builtin_elementwise_fma(__builtin_amdgcn_cvt_pk_f32_fp8((int)w[q], false), c2, acc[2 * q]);
                    acc[2 * q + 1] = __builtin_elementwise_fma(__builtin_amdgcn_cvt_pk_f32_fp8((int)w[q], true), c2, acc[2 * q + 1]);
                }
            }
        }
        float* hr = h + (size_t)tok * DM + lane * 16;
        u32x4 w0, w1; float ss = 0.f;
#pragma unroll
        for (int q4 = 0; q4 < 4; ++q4) {
            f32x4 hv = *(f32x4*)(hr + 4 * q4);
            hv += (f32x4){acc[2 * q4].x, acc[2 * q4].y, acc[2 * q4 + 1].x, acc[2 * q4 + 1].y};
            *(f32x4*)(hr + 4 * q4) = hv;
            ss += (hv[0] * hv[0] + hv[1] * hv[1]) + (hv[2] * hv[2] + hv[3] * hv[3]);
            const unsigned a_ = pk_bf16(hv[0], hv[1]), b_ = pk_bf16(hv[2], hv[3]);
            if (q4 == 0) { w0.x = a_; w0.y = b_; } else if (q4 == 1) { w0.z = a_; w0.w = b_; } else if (q4 == 2) { w1.x = a_; w1.y = b_; } else { w1.z = a_; w1.w = b_; }
        }
        *(u32x4*)(hb + (size_t)tok * DM + lane * 16) = w0; *(u32x4*)(hb + (size_t)tok * DM + lane * 16 + 8) = w1;
        ss = wave_sum(ss);
        if (lane == 0) rs2[tok] = rsqrtf(ss * (1.0f / DM) + EPS);
    }
}
DI void p6v6_u(const Params& p, int G) {
    unsigned char* ws = p.ws;
    const int tid = threadIdx.x, lane = tid & 63, wid = tid >> 6;
    const int gw = blockIdx.x * 8 + wid, nw = G * 8;
    const unsigned char* u8 = (const unsigned char*)(ws + WS_UB); const unsigned char* v8 = (const unsigned char*)(ws + WS_VB);
    const int* eidx = (const int*)(ws + R_EXP); const float* gsm = (const float*)(ws + R_GSM); const float* rs1v = (const float*)(ws + WS_RS1);
    float* h = p.out; bf16_t* hb = (bf16_t*)(ws + R_H1B); float* rs2 = (float*)(ws + WS_RS2);
#pragma unroll 1
    for (int tok = gw; tok < NTOK; tok += nw) {
        const float rs1 = rs1v[tok] * (1.0f / U8_SCALE);
        const u32x4 xa = *(const u32x4*)(hb + (size_t)tok * DM + lane * 16), xb = *(const u32x4*)(hb + (size_t)tok * DM + lane * 16 + 8);
        f32x2 xp[8];
#pragma unroll
        for (int q = 0; q < 4; ++q) { xp[q] = (f32x2){bflo(xa[q]), bfhi(xa[q])}; xp[4 + q] = (f32x2){bflo(xb[q]), bfhi(xb[q])}; }
        const int e0 = eidx[(size_t)tok * 128 + lane], e1 = eidx[(size_t)tok * 128 + 64 + lane];
        const float g0 = gsm[(size_t)tok * 128 + lane], g1 = gsm[(size_t)tok * 128 + 64 + lane];
        float coef0 = 0.f, coef1 = 0.f;
#pragma unroll
        for (int half = 0; half < 2; ++half) {
            const int ev = half ? e1 : e0;
            float part[64];
#pragma unroll
            for (int j = 0; j < 64; ++j) {
                const int e = __builtin_amdgcn_readlane(ev, j);
                const u32x4 w = *(const u32x4*)(u8 + (size_t)e * DM + lane * 16);
                f32x2 a2 = {0.f, 0.f};
#pragma unroll
                for (int q = 0; q < 4; ++q) {
                    a2 = __builtin_elementwise_fma(__builtin_amdgcn_cvt_pk_f32_fp8((int)w[q], false), xp[2 * q], a2);
                    a2 = __builtin_elementwise_fma(__builtin_amdgcn_cvt_pk_f32_fp8((int)w[q], true), xp[2 * q + 1], a2);
                }
                part[j] = a2.x + a2.y;
            }
#pragma unroll
            for (int m = 32; m >= 1; m >>= 1) {
                const bool up = (lane & m) != 0;
#pragma unroll
                for (int i = 0; i < m; ++i) { const float send = up ? part[i] : part[i + m], keep = up ? part[i + m] : part[i]; part[i] = keep + __shfl_xor(send, m); }
            }
            const float act = gelu_tanh(part[0] * rs1);
            if (half) coef1 = g1 * act * (1.0f / V8_SCALE); else coef0 = g0 * act * (1.0f / V8_SCALE);
        }
        float* coef = (float*)(ws + R_COEF);
        coef[(size_t)tok * 128 + lane] = coef0; coef[(size_t)tok * 128 + 64 + lane] = coef1;
    }
}
DI void p6v6_v(const Params& p, int G) {
    unsigned char* ws = p.ws;
    const int tid = threadIdx.x, lane = tid & 63, wid = tid >> 6;
    const int gw = blockIdx.x * 8 + wid, nw = G * 8;
    const unsigned char* v8 = (const unsigned char*)(ws + WS_VB);
    const int* eidx = (const int*)(ws + R_EXP); const float* coef = (const float*)(ws + R_COEF);
    float* h = p.out; bf16_t* hb = (bf16_t*)(ws + R_H1B); float* rs2 = (float*)(ws + WS_RS2);
#pragma unroll 1
    for (int tok = gw; tok < NTOK; tok += nw) {
        const int e0 = eidx[(size_t)tok * 128 + lane], e1 = eidx[(size_t)tok * 128 + 64 + lane];
        const float coef0 = coef[(size_t)tok * 128 + lane], coef1 = coef[(size_t)tok * 128 + 64 + lane];
        f32x2 acc[8];
#pragma unroll
        for (int i = 0; i < 8; ++i) acc[i] = (f32x2){0.f, 0.f};
#pragma unroll
        for (int half = 0; half < 2; ++half) {
            const int ev = half ? e1 : e0; const float cv = half ? coef1 : coef0;
#pragma unroll 16
            for (int j = 0; j < 64; ++j) {
                const int e = __builtin_amdgcn_readlane(ev, j);
                const float c = __uint_as_float(__builtin_amdgcn_readlane(__float_as_uint(cv), j));
                const u32x4 w = *(const u32x4*)(v8 + (size_t)e * DM + lane * 16);
                const f32x2 c2 = {c, c};
#pragma unroll
                for (int q = 0; q < 4; ++q) {
                    acc[2 * q] = __builtin_elementwise_fma(__builtin_amdgcn_cvt_pk_f32_fp8((int)w[q], false), c2, acc[2 * q]);
                    acc[2 * q + 1] = __builtin_elementwise_fma(__builtin_amdgcn_cvt_pk_f32_fp8((int)w[q], true), c2, acc[2 * q + 1]);
                }
            }
        }
        float* hr = h + (size_t)tok * DM + lane * 16;
        u32x4 w0, w1; float ss = 0.f;
#pragma unroll
        for (int q4 = 0; q4 < 4; ++q4) {
            f32x4 hv = *(f32x4*)(hr + 4 * q4);
            hv += (f32x4){acc[2 * q4].x, acc[2 * q4].y, acc[2 * q4 + 1].x, acc[2 * q4 + 1].y};
            *(f32x4*)(hr + 4 * q4) = hv;
            ss += (hv[0] * hv[0] + hv[1] * hv[1]) + (hv[2] * hv[2] + hv[3] * hv[3]);
            const unsigned a_ = pk_bf16(hv[0], hv[1]), b_ = pk_bf16(hv[2], hv[3]);
            if (q4 == 0) { w0.x = a_; w0.y = b_; } else if (q4 == 1) { w0.z = a_; w0.w = b_; } else if (q4 == 2) { w1.x = a_; w1.y = b_; } else { w1.z = a_; w1.w = b_; }
        }
        *(u32x4*)(hb + (size_t)tok * DM + lane * 16) = w0; *(u32x4*)(hb + (size_t)tok * DM + lane * 16 + 8) = w1;
        ss = wave_sum(ss);
        if (lane == 0) rs2[tok] = rsqrtf(ss * (1.0f / DM) + EPS);
    }
}
DI void p6u_cols(const Params& p, int G) {
    unsigned char* ws = p.ws;
    const int tid = threadIdx.x, lane = tid & 63, wid = tid >> 6, grp = blockIdx.x & 7, rank = blockIdx.x >> 3;
    const int nrank = (G - grp + 7) >> 3, wv = rank * 8 + wid, nwv = nrank * 8;
    const unsigned char* u8 = (const unsigned char*)(ws + WS_UB); const bf16_t* hb = (const bf16_t*)(ws + R_H1B);
    const int* eidx = (const int*)(ws + R_EXP);
    float* part = (float*)(ws + R_BIG) + (size_t)grp * NTOK * 128;
    const int sub = lane >> 3, col0 = grp * 128 + (lane & 7) * 16;
    if (wv >= NTOK) return;
    const int nvis = (NTOK - wv + nwv - 1) / nwv;
#define PC_LOADIDX(T, EV0, EV1, XA, XB) do { EV0 = eidx[(size_t)(T) * 128 + lane]; EV1 = eidx[(size_t)(T) * 128 + 64 + lane]; \
        XA = *(const u32x4*)(hb + (size_t)(T) * DM + col0); XB = *(const u32x4*)(hb + (size_t)(T) * DM + col0 + 8); } while (0)
#define PC_ISSUE8(R, EV) do { _Pragma("unroll") for (int i = 0; i < 8; ++i) { const int e = __shfl((EV), 8 * i + sub); R[i] = *(const u32x4*)(u8 + (unsigned)(e * DM + col0)); } } while (0)
#define PC_CONS8(R, P0) do { _Pragma("unroll") for (int i = 0; i < 8; ++i) { f32x2 a2 = {0.f, 0.f}; \
            _Pragma("unroll") for (int q = 0; q < 4; ++q) { \
                a2 = __builtin_elementwise_fma(__builtin_amdgcn_cvt_pk_f32_fp8((int)R[i][q], false), xp[2 * q], a2); \
                a2 = __builtin_elementwise_fma(__builtin_amdgcn_cvt_pk_f32_fp8((int)R[i][q], true), xp[2 * q + 1], a2); } \
            pd[(P0) + i] = a2.x + a2.y; __builtin_amdgcn_sched_barrier(0); } } while (0)
    u32x4 ra[8], rb[8];
    int e0, e1, n0, n1, x0, x1; u32x4 xa0, xb0, xa1, xb1, xa2, xb2;
    PC_LOADIDX(wv, e0, e1, xa0, xb0);
    { const int t1 = nvis > 1 ? wv + nwv : wv; PC_LOADIDX(t1, n0, n1, xa1, xb1); }
    PC_ISSUE8(ra, e0); PC_ISSUE8(rb, e1);
#pragma unroll 1
    for (int it = 0; it < nvis; ++it) {
        const int tok = wv + it * nwv;
        const int t2 = wv + (it + 2 < nvis ? it + 2 : nvis - 1) * nwv;
        PC_LOADIDX(t2, x0, x1, xa2, xb2);
        f32x2 xp[8];
#pragma unroll
        for (int q = 0; q < 4; ++q) { xp[q] = (f32x2){bflo(xa0[q]), bfhi(xa0[q])}; xp[4 + q] = (f32x2){bflo(xb0[q]), bfhi(xb0[q])}; }
        float pd[16];
        PC_CONS8(ra, 0);
        PC_ISSUE8(ra, n0);
        PC_CONS8(rb, 8);
        PC_ISSUE8(rb, n1);
#define PC_RS(M, LB) do { const bool up = (lane & (LB)) != 0; _Pragma("unroll") for (int i = 0; i < (M); ++i) { \
            const float send = up ? pd[i] : pd[i + (M)], keep = up ? pd[i + (M)] : pd[i]; pd[i] = keep + __shfl_xor(send, (LB)); } } while (0)
        PC_RS(8, 4); PC_RS(4, 2); PC_RS(2, 1);
#undef PC_RS
        const int i0 = 8 * ((lane >> 2) & 1) + 4 * ((lane >> 1) & 1) + 2 * (lane & 1);
        *(f32x2*)(part + (size_t)tok * 128 + sub * 16 + i0) = (f32x2){pd[0], pd[1]};
        e0 = n0; e1 = n1; xa0 = xa1; xb0 = xb1; n0 = x0; n1 = x1; xa1 = xa2; xb1 = xb2;
    }
#undef PC_LOADIDX
#undef PC_ISSUE8
#undef PC_CONS8
}
DI void p6u_combine(const Params& p, int G) {
    unsigned char* ws = p.ws;
    const float* part = (const float*)(ws + R_BIG); const float* gsm = (const float*)(ws + R_GSM); const float* rs1v = (const float*)(ws + WS_RS1);
    float* coef = (float*)(ws + R_COEF);
    const size_t n = (size_t)NTOK * 128, nthr = (size_t)G * MK_THREADS;
    for (size_t idx = (size_t)blockIdx.x * MK_THREADS + threadIdx.x; idx < n; idx += nthr) {
        const size_t tok = idx >> 7; const int j = (int)(idx & 127), pos = (j & 7) * 16 + (j >> 3);
        float s = 0.f;
#pragma unroll
        for (int sl = 0; sl < 8; ++sl) s += part[(size_t)sl * NTOK * 128 + tok * 128 + pos];
        coef[idx] = gsm[idx] * (1.0f / V8_SCALE) * gelu_tanh(s * (rs1v[tok] * (1.0f / U8_SCALE)));
    }
}

#if PEER_FP4
DI void fp4x16_dot(const u32x2 w, const f32x2 (&xp)[8], f32x2& a2) {
#define F4D(Q, B) a2 = __builtin_elementwise_fma(__builtin_amdgcn_cvt_scalef32_pk_f32_fp4(w[Q], 1.0f, B), xp[4 * (Q) + (B)], a2)
    F4D(0, 0); F4D(0, 1); F4D(0, 2); F4D(0, 3); F4D(1, 0); F4D(1, 1); F4D(1, 2); F4D(1, 3);
#undef F4D
}
DI void p6f4_u(const Params& p, int G) {
    unsigned char* ws = p.ws;
    const int tid = threadIdx.x, lane = tid & 63, wid = tid >> 6;
    const int gw = blockIdx.x * 8 + wid, nw = G * 8;
    const unsigned char* u4 = (const unsigned char*)(ws + WS_UB);
    const int* eidx = (const int*)(ws + R_EXP); const float* gsm = (const float*)(ws + R_GSM); const float* rs1v = (const float*)(ws + WS_RS1);
    bf16_t* hb = (bf16_t*)(ws + R_H1B); float* coef = (float*)(ws + R_COEF);
#pragma unroll 1
    for (int tok = gw; tok < NTOK; tok += nw) {
        const float rs1 = rs1v[tok] * (1.0f / U8_SCALE);
        const u32x4 xa = *(const u32x4*)(hb + (size_t)tok * DM + lane * 16), xb = *(const u32x4*)(hb + (size_t)tok * DM + lane * 16 + 8);
        f32x2 xp[8];
#pragma unroll
        for (int q = 0; q < 4; ++q) { xp[q] = (f32x2){bflo(xa[q]), bfhi(xa[q])}; xp[4 + q] = (f32x2){bflo(xb[q]), bfhi(xb[q])}; }
        const int e0 = eidx[(size_t)tok * 128 + lane], e1 = eidx[(size_t)tok * 128 + 64 + lane];
        const float g0 = gsm[(size_t)tok * 128 + lane], g1 = gsm[(size_t)tok * 128 + 64 + lane];
#pragma unroll
        for (int half = 0; half < 2; ++half) {
            const int ev = half ? e1 : e0;
            float part[64];
#pragma unroll
            for (int j = 0; j < 64; ++j) {
                const int e = __builtin_amdgcn_readlane(ev, j);
                const u32x2 w = *(const u32x2*)(u4 + (size_t)e * (DM / 2) + lane * 8);
                f32x2 a2 = {0.f, 0.f};
                fp4x16_dot(w, xp, a2);
                part[j] = a2.x + a2.y;
            }
#define F4_RS(M) do { const bool up = (lane & (M)) != 0; _Pragma("unroll") for (int i = 0; i < (M); ++i) { \
                const float send = up ? part[i] : part[i + (M)], keep = up ? part[i + (M)] : part[i]; part[i] = keep + __shfl_xor(send, (M)); } } while (0)
            F4_RS(32); F4_RS(16); F4_RS(8); F4_RS(4); F4_RS(2); F4_RS(1);
#undef F4_RS
            const float act = gelu_tanh(part[0] * rs1);
            coef[(size_t)tok * 128 + half * 64 + lane] = (half ? g1 : g0) * act * (1.0f / V8_SCALE);
        }
    }
}
template <int PMODE> DI void p6f4_v(const Params& p, int G) {
    unsigned char* ws = p.ws;
    const int tid = threadIdx.x, lane = tid & 63, wid = tid >> 6;
    const int grp = blockIdx.x & 7, rank = blockIdx.x >> 3;
    const int nrank = (G - grp + 7) >> 3;
    const int wv = rank * 8 + wid, nwv = nrank * 8;
    const unsigned char* v4 = (const unsigned char*)(ws + WS_VB);
    const int* eidx = (const int*)(ws + R_EXP); const float* coef = (const float*)(ws + R_COEF);
    float* h = p.out; bf16_t* hb = (bf16_t*)(ws + R_H1B); float* ssq2 = (float*)(ws + WS_SSQ2);
    const int sub = lane >> 3, col0 = grp * 128 + (lane & 7) * 16;
    if (wv >= NTOK) return;
    const int nvis = (NTOK - wv + nwv - 1) / nwv;
#define PV_LOADIDX(T, EV0, EV1, CV0, CV1) do { EV0 = eidx[(size_t)(T) * 128 + lane]; EV1 = eidx[(size_t)(T) * 128 + 64 + lane]; CV0 = coef[(size_t)(T) * 128 + lane]; CV1 = coef[(size_t)(T) * 128 + 64 + lane]; } while (0)
#define PV_ISSUE8(R, EV) do { _Pragma("unroll") for (int i = 0; i < 8; ++i) { const int e = __shfl((EV), 8 * i + sub); R[i] = *(const u32x2*)(v4 + (unsigned)(e * (DM / 2) + (col0 >> 1))); } } while (0)
#define PV_CONS8(R, CV) do { _Pragma("unroll") for (int i = 0; i < 8; ++i) { const float c = __shfl((CV), 8 * i + sub); const f32x2 c2 = {c, c}; \
            F4A(R[i], 0, 0); F4A(R[i], 0, 1); F4A(R[i], 0, 2); F4A(R[i], 0, 3); F4A(R[i], 1, 0); F4A(R[i], 1, 1); F4A(R[i], 1, 2); F4A(R[i], 1, 3); } } while (0)
#define F4A(RR, Q, B) acc[4 * (Q) + (B)] = __builtin_elementwise_fma(__builtin_amdgcn_cvt_scalef32_pk_f32_fp4(RR[Q], 1.0f, B), c2, acc[4 * (Q) + (B)])
    u32x2 ra[8], rb[8];
    int e0, e1, n0, n1, x0, x1; float c0, c1, d0, d1, y0, y1;
    PV_LOADIDX(wv, e0, e1, c0, c1);
    { const int t1 = nvis > 1 ? wv + nwv : wv; PV_LOADIDX(t1, n0, n1, d0, d1); }
    PV_ISSUE8(ra, e0); PV_ISSUE8(rb, e1);
#pragma unroll 1
    for (int it = 0; it < nvis; ++it) {
        const int tok = wv + it * nwv;
        const int t2 = wv + (it + 2 < nvis ? it + 2 : nvis - 1) * nwv;
        float* hr = h + (size_t)tok * DM + col0;
        const f32x4 hv0 = *(const f32x4*)hr, hv1 = *(const f32x4*)(hr + 4), hv2 = *(const f32x4*)(hr + 8), hv3 = *(const f32x4*)(hr + 12);
        PV_LOADIDX(t2, x0, x1, y0, y1);
        f32x2 acc[8];
#pragma unroll
        for (int q = 0; q < 8; ++q) acc[q] = (f32x2){0.f, 0.f};
        PV_CONS8(ra, c0);
        PV_ISSUE8(ra, n0);
        PV_CONS8(rb, c1);
        PV_ISSUE8(rb, n1);
        float av[16];
#pragma unroll
        for (int q = 0; q < 8; ++q) { av[2 * q] = acc[q].x; av[2 * q + 1] = acc[q].y; }
#pragma unroll
        for (int q = 0; q < 16; ++q) { av[q] += __shfl_xor(av[q], 8); av[q] += __shfl_xor(av[q], 16); av[q] += __shfl_xor(av[q], 32); }
        float ss = 0.f;
        if (lane < 8) {
            const f32x4 o0 = hv0 + (f32x4){av[0], av[1], av[2], av[3]}, o1 = hv1 + (f32x4){av[4], av[5], av[6], av[7]};
            const f32x4 o2 = hv2 + (f32x4){av[8], av[9], av[10], av[11]}, o3 = hv3 + (f32x4){av[12], av[13], av[14], av[15]};
            *(f32x4*)hr = o0; *(f32x4*)(hr + 4) = o1; *(f32x4*)(hr + 8) = o2; *(f32x4*)(hr + 12) = o3;
            u32x4 w0, w1;
            w0.x = pk_bf16(o0[0], o0[1]); w0.y = pk_bf16(o0[2], o0[3]); w0.z = pk_bf16(o1[0], o1[1]); w0.w = pk_bf16(o1[2], o1[3]);
            w1.x = pk_bf16(o2[0], o2[1]); w1.y = pk_bf16(o2[2], o2[3]); w1.z = pk_bf16(o3[0], o3[1]); w1.w = pk_bf16(o3[2], o3[3]);
            *(u32x4*)(hb + (size_t)tok * DM + col0) = w0; *(u32x4*)(hb + (size_t)tok * DM + col0 + 8) = w1;
#pragma unroll
            for (int j = 0; j < 4; ++j) ss += o0[j] * o0[j] + o1[j] * o1[j] + o2[j] * o2[j] + o3[j] * o3[j];
        }
        ss += __shfl_xor(ss, 1); ss += __shfl_xor(ss, 2); ss += __shfl_xor(ss, 4);
        if (lane == 0) ssq2[(size_t)grp * NTOK + tok] = ss;
        e0 = n0; e1 = n1; c0 = d0; c1 = d1; n0 = x0; n1 = x1; d0 = y0; d1 = y1;
    }
#undef PV_LOADIDX
#undef PV_ISSUE8
#undef PV_CONS8
#undef F4A
}
#endif

#if PEER_I8U
constexpr float U_ISCALE = 640.0f;
#define I8_ISSUE(SET, EV, J0) do { int ev_ = (EV); asm volatile("" : "+v"(ev_)); _Pragma("unroll") for (int k = 0; k < 16; ++k) { const int e = __builtin_amdgcn_readlane(ev_, (J0) + k); \
        SET[k] = *(const u32x4*)(u8 + ((unsigned)e * (unsigned)DM + (unsigned)(lane * 16))); } __builtin_amdgcn_sched_barrier(0); } while (0)
#define I8_CONS(SET, P0) do { _Pragma("unroll") for (int k = 0; k < 16; ++k) { \
        int a = __builtin_amdgcn_sdot4((int)SET[k].x, (int)xq[0], 0, false); a = __builtin_amdgcn_sdot4((int)SET[k].y, (int)xq[1], a, false); \
        a = __builtin_amdgcn_sdot4((int)SET[k].z, (int)xq[2], a, false); a = __builtin_amdgcn_sdot4((int)SET[k].w, (int)xq[3], a, false); \
        part[(P0) + k] = (float)a; } __builtin_amdgcn_sched_barrier(0); } while (0)
#define I8_RS(M) do { const bool up = (lane & (M)) != 0; _Pragma("unroll") for (int i = 0; i < (M); ++i) { \
        const float send = up ? part[i] : part[i + (M)], keep = up ? part[i + (M)] : part[i]; part[i] = keep + __shfl_xor(send, (M)); } } while (0)
DI void p6i8_u(const Params& p, int G) {
    unsigned char* ws = p.ws;
    const int tid = threadIdx.x, lane = tid & 63, wid = tid >> 6;
    const int gw = blockIdx.x * 8 + wid, nw = G * 8;
    const unsigned char* u8 = (const unsigned char*)(ws + WS_UB);
    const int* eidx = (const int*)(ws + R_EXP); const float* gsm = (const float*)(ws + R_GSM); const float* rs1v = (const float*)(ws + WS_RS1);
    bf16_t* hb = (bf16_t*)(ws + R_H1B); float* coef = (float*)(ws + R_COEF);
#pragma unroll 1
    for (int tok = gw; tok < NTOK; tok += nw) {
        const int e0 = eidx[(size_t)tok * 128 + lane], e1 = eidx[(size_t)tok * 128 + 64 + lane];
        u32x4 sa[16], sb[16];
        I8_ISSUE(sa, e0, 0);
        I8_ISSUE(sb, e0, 16);
        const u32x4 xa = *(const u32x4*)(hb + (size_t)tok * DM + lane * 16), xb = *(const u32x4*)(hb + (size_t)tok * DM + lane * 16 + 8);
        const float g0 = gsm[(size_t)tok * 128 + lane], g1 = gsm[(size_t)tok * 128 + 64 + lane];
        const float rs1 = rs1v[tok];
        float xf[16];
#pragma unroll
        for (int q = 0; q < 4; ++q) { xf[2 * q] = bflo(xa[q]); xf[2 * q + 1] = bfhi(xa[q]); xf[8 + 2 * q] = bflo(xb[q]); xf[8 + 2 * q + 1] = bfhi(xb[q]); }
        float amax = 0.f;
#pragma unroll
        for (int i = 0; i < 16; ++i) amax = fmaxf(amax, fabsf(xf[i]));
        amax = wave_max(amax);
        const float sx = fmaxf(amax, 1e-20f) * (1.0f / 127.0f), isx = 1.0f / sx;
        unsigned xq[4];
#pragma unroll
        for (int q = 0; q < 4; ++q) {
            unsigned w = 0u;
#pragma unroll
            for (int b = 0; b < 4; ++b) w |= ((unsigned)(int)rintf(xf[4 * q + b] * isx) & 0xffu) << (8 * b);
            xq[q] = w;
        }
        const float scl = rs1 * sx * (1.0f / U_ISCALE);
        float part[64];
        I8_CONS(sa, 0);  I8_ISSUE(sa, e0, 32);
        I8_CONS(sb, 16); I8_ISSUE(sb, e0, 48);
        I8_CONS(sa, 32); I8_ISSUE(sa, e1, 0);
        I8_CONS(sb, 48); I8_ISSUE(sb, e1, 16);
        I8_RS(32); I8_RS(16); I8_RS(8); I8_RS(4); I8_RS(2); I8_RS(1);
        coef[(size_t)tok * 128 + lane] = g0 * gelu_tanh(part[0] * scl) * (1.0f / V8_SCALE);
        I8_CONS(sa, 0);  I8_ISSUE(sa, e1, 32);
        I8_CONS(sb, 16); I8_ISSUE(sb, e1, 48);
        I8_CONS(sa, 32);
        I8_CONS(sb, 48);
        I8_RS(32); I8_RS(16); I8_RS(8); I8_RS(4); I8_RS(2); I8_RS(1);
        coef[(size_t)tok * 128 + 64 + lane] = g1 * gelu_tanh(part[0] * scl) * (1.0f / V8_SCALE);
    }
}
#undef I8_ISSUE
#undef I8_CONS
#undef I8_RS
#endif
#define V8_ISSUE(SET, EV, J0) do { int ev_ = (EV); asm volatile("" : "+v"(ev_)); _Pragma("unroll") for (int k = 0; k < 16; ++k) { const int e = __builtin_amdgcn_readlane(ev_, (J0) + k); \
        SET[k] = *(const u32x4*)(v8 + ((unsigned)e * (unsigned)DM + (unsigned)(lane * 16))); } __builtin_amdgcn_sched_barrier(0); } while (0)
#define V8_FMA(W, I) do { t_[2 * (I)] = __builtin_elementwise_fma(__builtin_amdgcn_cvt_pk_f32_fp8((int)(W), false), c2, t_[2 * (I)]); \
        t_[2 * (I) + 1] = __builtin_elementwise_fma(__builtin_amdgcn_cvt_pk_f32_fp8((int)(W), true), c2, t_[2 * (I) + 1]); } while (0)
#define V8_ROW(SET, CV, J0, K) do { const float c = (CV)[(J0) + (K)]; const f32x2 c2 = {c, c}; const u32x4 w_ = SET[K]; \
        V8_FMA(w_.x, 0); V8_FMA(w_.y, 1); V8_FMA(w_.z, 2); V8_FMA(w_.w, 3); } while (0)
#define V8_CONS(SET, CV, J0) do { f32x2 t_[8]; _Pragma("unroll") for (int i_ = 0; i_ < 8; ++i_) t_[i_] = (f32x2){0.f, 0.f}; V8_ROW(SET, CV, J0, 0); V8_ROW(SET, CV, J0, 1); V8_ROW(SET, CV, J0, 2); V8_ROW(SET, CV, J0, 3); V8_ROW(SET, CV, J0, 4); V8_ROW(SET, CV, J0, 5); \
        V8_ROW(SET, CV, J0, 6); V8_ROW(SET, CV, J0, 7); V8_ROW(SET, CV, J0, 8); V8_ROW(SET, CV, J0, 9); V8_ROW(SET, CV, J0, 10); V8_ROW(SET, CV, J0, 11); \
        V8_ROW(SET, CV, J0, 12); V8_ROW(SET, CV, J0, 13); V8_ROW(SET, CV, J0, 14); V8_ROW(SET, CV, J0, 15); \
        _Pragma("unroll") for (int i_ = 0; i_ < 8; ++i_) acc[i_] += t_[i_]; __builtin_amdgcn_sched_barrier(0); } while (0)
DI void p6v8_v(const Params& p, LAS3 unsigned char* lds, int G) {
    unsigned char* ws = p.ws;
    const int tid = threadIdx.x, lane = tid & 63, wid = tid >> 6;
    const int gw = blockIdx.x * 8 + wid, nw = G * 8;
    const unsigned char* v8 = (const unsigned char*)(ws + WS_VB);
    const int* eidx = (const int*)(ws + R_EXP); const float* coef = (const float*)(ws + R_COEF);
    float* h = p.out; bf16_t* hb = (bf16_t*)(ws + R_H1B); float* rs2 = (float*)(ws + WS_RS2);
#pragma unroll 1
    for (int tok = gw; tok < NTOK; tok += nw) {
        const int e0 = eidx[(size_t)tok * 128 + lane], e1 = eidx[(size_t)tok * 128 + 64 + lane];
        u32x4 sa[16], sb[16];
        V8_ISSUE(sa, e0, 0);
        V8_ISSUE(sb, e0, 16);
        LAS3 float* cl = (LAS3 float*)(lds + wid * 512);
        cl[lane] = coef[(size_t)tok * 128 + lane]; cl[64 + lane] = coef[(size_t)tok * 128 + 64 + lane];
        LAS3 const float* c0 = cl; LAS3 const float* c1 = cl + 64;
        float* hr = h + (size_t)tok * DM + lane * 16;
        const f32x4 hv0 = *(const f32x4*)hr, hv1 = *(const f32x4*)(hr + 4), hv2 = *(const f32x4*)(hr + 8), hv3 = *(const f32x4*)(hr + 12);
        f32x2 acc[8];
#pragma unroll
        for (int i = 0; i < 8; ++i) acc[i] = (f32x2){0.f, 0.f};
        V8_CONS(sa, c0, 0);  V8_ISSUE(sa, e0, 32);
        V8_CONS(sb, c0, 16); V8_ISSUE(sb, e0, 48);
        V8_CONS(sa, c0, 32); V8_ISSUE(sa, e1, 0);
        V8_CONS(sb, c0, 48); V8_ISSUE(sb, e1, 16);
        V8_CONS(sa, c1, 0);  V8_ISSUE(sa, e1, 32);
        V8_CONS(sb, c1, 16); V8_ISSUE(sb, e1, 48);
        V8_CONS(sa, c1, 32);
        V8_CONS(sb, c1, 48);
        const f32x4 o0 = hv0 + (f32x4){acc[0].x, acc[0].y, acc[1].x, acc[1].y}, o1 = hv1 + (f32x4){acc[2].x, acc[2].y, acc[3].x, acc[3].y};
        const f32x4 o2 = hv2 + (f32x4){acc[4].x, acc[4].y, acc[5].x, acc[5].y}, o3 = hv3 + (f32x4){acc[6].x, acc[6].y, acc[7].x, acc[7].y};
        *(f32x4*)hr = o0; *(f32x4*)(hr + 4) = o1; *(f32x4*)(hr + 8) = o2; *(f32x4*)(hr + 12) = o3;
        u32x4 w0, w1;
        w0.x = pk_bf16(o0[0], o0[1]); w0.y = pk_bf16(o0[2], o0[3]); w0.z = pk_bf16(o1[0], o1[1]); w0.w = pk_bf16(o1[2], o1[3]);
        w1.x = pk_bf16(o2[0], o2[1]); w1.y = pk_bf16(o2[2], o2[3]); w1.z = pk_bf16(o3[0], o3[1]); w1.w = pk_bf16(o3[2], o3[3]);
        *(u32x4*)(hb + (size_t)tok * DM + lane * 16) = w0; *(u32x4*)(hb + (size_t)tok * DM + lane * 16 + 8) = w1;
        float ss = 0.f;
#pragma unroll
        for (int j = 0; j < 4; ++j) ss += o0[j] * o0[j] + o1[j] * o1[j] + o2[j] * o2[j] + o3[j] * o3[j];
        ss = wave_sum(ss);
        if (lane == 0) rs2[tok] = rsqrtf(ss * (1.0f / DM) + EPS);
    }
}
#undef V8_ISSUE
#undef V8_CONS
#undef V8_FMA
#undef V8_ROW

#if PEER_V4EXP
#define V4_ISSUE(SET, EV, J0) do { int ev_ = (EV); asm volatile("" : "+v"(ev_)); _Pragma("unroll") for (int k = 0; k < 16; ++k) { const int e = __builtin_amdgcn_readlane(ev_, (J0) + k); \
        SET[k] = *(const u32x2*)(v8 + ((unsigned)e * (unsigned)(DM / 2) + (unsigned)(lane * 8))); } __builtin_amdgcn_sched_barrier(0); } while (0)
#define V4_FMA(W, I) do { t_[4 * (I)] = __builtin_elementwise_fma(__builtin_amdgcn_cvt_scalef32_pk_f32_fp4((W), 1.0f, 0), c2, t_[4 * (I)]); \
        t_[4 * (I) + 1] = __builtin_elementwise_fma(__builtin_amdgcn_cvt_scalef32_pk_f32_fp4((W), 1.0f, 1), c2, t_[4 * (I) + 1]); \
        t_[4 * (I) + 2] = __builtin_elementwise_fma(__builtin_amdgcn_cvt_scalef32_pk_f32_fp4((W), 1.0f, 2), c2, t_[4 * (I) + 2]); \
        t_[4 * (I) + 3] = __builtin_elementwise_fma(__builtin_amdgcn_cvt_scalef32_pk_f32_fp4((W), 1.0f, 3), c2, t_[4 * (I) + 3]); } while (0)
#define V4_ROW(SET, CV, J0, K) do { const float c = (CV)[(J0) + (K)]; const f32x2 c2 = {c, c}; const u32x2 w_ = SET[K]; \
        V4_FMA(w_.x, 0); V4_FMA(w_.y, 1); } while (0)
#define V4_CONS(SET, CV, J0) do { f32x2 t_[8]; _Pragma("unroll") for (int i_ = 0; i_ < 8; ++i_) t_[i_] = (f32x2){0.f, 0.f}; V4_ROW(SET, CV, J0, 0); V4_ROW(SET, CV, J0, 1); V4_ROW(SET, CV, J0, 2); V4_ROW(SET, CV, J0, 3); V4_ROW(SET, CV, J0, 4); V4_ROW(SET, CV, J0, 5); \
        V4_ROW(SET, CV, J0, 6); V4_ROW(SET, CV, J0, 7); V4_ROW(SET, CV, J0, 8); V4_ROW(SET, CV, J0, 9); V4_ROW(SET, CV, J0, 10); V4_ROW(SET, CV, J0, 11); \
        V4_ROW(SET, CV, J0, 12); V4_ROW(SET, CV, J0, 13); V4_ROW(SET, CV, J0, 14); V4_ROW(SET, CV, J0, 15); \
        _Pragma("unroll") for (int i_ = 0; i_ < 8; ++i_) acc[i_] += t_[i_]; __builtin_amdgcn_sched_barrier(0); } while (0)
DI void p6v4_v(const Params& p, LAS3 unsigned char* lds, int G) {
    unsigned char* ws = p.ws;
    const int tid = threadIdx.x, lane = tid & 63, wid = tid >> 6;
    const int gw = blockIdx.x * 8 + wid, nw = G * 8;
    const unsigned char* v8 = (const unsigned char*)(ws + WS_VB);
    const int* eidx = (const int*)(ws + R_EXP); const float* coef = (const float*)(ws + R_COEF);
    float* h = p.out; bf16_t* hb = (bf16_t*)(ws + R_H1B); float* rs2 = (float*)(ws + WS_RS2);
#pragma unroll 1
    for (int tok = gw; tok < NTOK; tok += nw) {
        const int e0 = eidx[(size_t)tok * 128 + lane], e1 = eidx[(size_t)tok * 128 + 64 + lane];
        u32x2 sa[16], sb[16];
        V4_ISSUE(sa, e0, 0);
        V4_ISSUE(sb, e0, 16);
        LAS3 float* cl = (LAS3 float*)(lds + wid * 512);
        cl[lane] = coef[(size_t)tok * 128 + lane]; cl[64 + lane] = coef[(size_t)tok * 128 + 64 + lane];
        LAS3 const float* c0 = cl; LAS3 const float* c1 = cl + 64;
        float* hr = h + (size_t)tok * DM + lane * 16;
        const f32x4 hv0 = *(const f32x4*)hr, hv1 = *(const f32x4*)(hr + 4), hv2 = *(const f32x4*)(hr + 8), hv3 = *(const f32x4*)(hr + 12);
        f32x2 acc[8];
#pragma unroll
        for (int i = 0; i < 8; ++i) acc[i] = (f32x2){0.f, 0.f};
        V4_CONS(sa, c0, 0);  V4_ISSUE(sa, e0, 32);
        V4_CONS(sb, c0, 16); V4_ISSUE(sb, e0, 48);
        V4_CONS(sa, c0, 32); V4_ISSUE(sa, e1, 0);
        V4_CONS(sb, c0, 48); V4_ISSUE(sb, e1, 16);
        V4_CONS(sa, c1, 0);  V4_ISSUE(sa, e1, 32);
        V4_CONS(sb, c1, 16); V4_ISSUE(sb, e1, 48);
        V4_CONS(sa, c1, 32);
        V4_CONS(sb, c1, 48);
        const f32x4 o0 = hv0 + (f32x4){acc[0].x, acc[0].y, acc[1].x, acc[1].y}, o1 = hv1 + (f32x4){acc[2].x, acc[2].y, acc[3].x, acc[3].y};
        const f32x4 o2 = hv2 + (f32x4){acc[4].x, acc[4].y, acc[5].x, acc[5].y}, o3 = hv3 + (f32x4){acc[6].x, acc[6].y, acc[7].x, acc[7].y};
        *(f32x4*)hr = o0; *(f32x4*)(hr + 4) = o1; *(f32x4*)(hr + 8) = o2; *(f32x4*)(hr + 12) = o3;
        u32x4 w0, w1;
        w0.x = pk_bf16(o0[0], o0[1]); w0.y = pk_bf16(o0[2], o0[3]); w0.z = pk_bf16(o1[0], o1[1]); w0.w = pk_bf16(o1[2], o1[3]);
        w1.x = pk_bf16(o2[0], o2[1]); w1.y = pk_bf16(o2[2], o2[3]); w1.z = pk_bf16(o3[0], o3[1]); w1.w = pk_bf16(o3[2], o3[3]);
        *(u32x4*)(hb + (size_t)tok * DM + lane * 16) = w0; *(u32x4*)(hb + (size_t)tok * DM + lane * 16 + 8) = w1;
        float ss = 0.f;
#pragma unroll
        for (int j = 0; j < 4; ++j) ss += o0[j] * o0[j] + o1[j] * o1[j] + o2[j] * o2[j] + o3[j] * o3[j];
        ss = wave_sum(ss);
        if (lane == 0) rs2[tok] = rsqrtf(ss * (1.0f / DM) + EPS);
    }
}
#undef V4_ISSUE
#undef V4_CONS
#undef V4_FMA
#undef V4_ROW
#endif
#define VS_SETUP(BUF, E0, E1, C0, C1, EP, CP) do { LAS3 unsigned* eb = (LAS3 unsigned*)(wl + (BUF) * 1024); LAS3 float* cb = (LAS3 float*)(wl + (BUF) * 1024 + 512); \
        eb[(lane & 7) * 16 + (lane >> 3)] = (unsigned)(E0); eb[(lane & 7) * 16 + 8 + (lane >> 3)] = (unsigned)(E1); \
        cb[(lane & 7) * 16 + (lane >> 3)] = (C0); cb[(lane & 7) * 16 + 8 + (lane >> 3)] = (C1); \
        _Pragma("unroll") for (int q = 0; q < 4; ++q) { const u32x4 ev4 = *(LAS3 const u32x4*)(eb + sub * 16 + 4 * q); const f32x4 cv4 = *(LAS3 const f32x4*)(cb + sub * 16 + 4 * q); \
            EP[4 * q] = ev4.x; EP[4 * q + 1] = ev4.y; EP[4 * q + 2] = ev4.z; EP[4 * q + 3] = ev4.w; CP[4 * q] = cv4[0]; CP[4 * q + 1] = cv4[1]; CP[4 * q + 2] = cv4[2]; CP[4 * q + 3] = cv4[3]; } } while (0)
#define VS_ISSUE(SET, EP) do { _Pragma("unroll") for (int i = 0; i < 16; ++i) SET[i] = *(const u32x4*)(v8 + (EP[i] * (unsigned)DM + (unsigned)col0)); __builtin_amdgcn_sched_barrier(0); } while (0)
#define VS_FMA(W, I) do { t_[2 * (I)] = __builtin_elementwise_fma(__builtin_amdgcn_cvt_pk_f32_fp8((int)(W), false), c2, t_[2 * (I)]); \
        t_[2 * (I) + 1] = __builtin_elementwise_fma(__builtin_amdgcn_cvt_pk_f32_fp8((int)(W), true), c2, t_[2 * (I) + 1]); } while (0)
#define VS_ROW(SET, CP, K) do { const f32x2 c2 = {CP[K], CP[K]}; const u32x4 w_ = SET[K]; VS_FMA(w_.x, 0); VS_FMA(w_.y, 1); VS_FMA(w_.z, 2); VS_FMA(w_.w, 3); } while (0)
#define VS_RS(M, LB) do { const bool up = (lane & (LB)) != 0; _Pragma("unroll") for (int i = 0; i < (M); ++i) { \
        const float send = up ? av[i] : av[i + (M)], keep = up ? av[i + (M)] : av[i]; av[i] = keep + __shfl_xor(send, (LB)); } } while (0)
#define VS_CONSUME(SET, CP, TOK, HV) do { f32x2 t_[8]; _Pragma("unroll") for (int i_ = 0; i_ < 8; ++i_) t_[i_] = (f32x2){0.f, 0.f}; \
        VS_ROW(SET, CP, 0); VS_ROW(SET, CP, 1); VS_ROW(SET, CP, 2); VS_ROW(SET, CP, 3); VS_ROW(SET, CP, 4); VS_ROW(SET, CP, 5); VS_ROW(SET, CP, 6); VS_ROW(SET, CP, 7); \
        f32x2 t2_[8]; _Pragma("unroll") for (int i_ = 0; i_ < 8; ++i_) { t2_[i_] = t_[i_]; t_[i_] = (f32x2){0.f, 0.f}; } \
        VS_ROW(SET, CP, 8); VS_ROW(SET, CP, 9); VS_ROW(SET, CP, 10); VS_ROW(SET, CP, 11); VS_ROW(SET, CP, 12); VS_ROW(SET, CP, 13); VS_ROW(SET, CP, 14); VS_ROW(SET, CP, 15); \
        float av[16]; _Pragma("unroll") for (int i_ = 0; i_ < 8; ++i_) { av[2 * i_] = t_[i_].x + t2_[i_].x; av[2 * i_ + 1] = t_[i_].y + t2_[i_].y; } \
        VS_RS(8, 32); VS_RS(4, 16); VS_RS(2, 8); \
        const f32x2 o_ = (HV) + (f32x2){av[0], av[1]}; \
        *(f32x2*)(h + (size_t)(TOK) * DM + colL) = o_; *(unsigned*)(hb + (size_t)(TOK) * DM + colL) = pk_bf16(o_.x, o_.y); \
        const float ss_ = wave_sum(o_.x * o_.x + o_.y * o_.y); if (lane == 0) ssq2[(size_t)grp * NTOK + (TOK)] = ss_; \
        __builtin_amdgcn_sched_barrier(0); } while (0)
DI void p6vs_v(const Params& p, LAS3 unsigned char* lds, int G) {
    unsigned char* ws = p.ws;
    const int tid = threadIdx.x, lane = tid & 63, wid = tid >> 6, grp = blockIdx.x & 7, rank = blockIdx.x >> 3;
    const int nrank = (G - grp + 7) >> 3, wv = rank * 8 + wid, nwv = nrank * 8;
    const unsigned char* v8 = (const unsigned char*)(ws + WS_VB);
    const int* eidx = (const int*)(ws + R_EXP); const float* coef = (const float*)(ws + R_COEF);
    float* h = p.out; bf16_t* hb = (bf16_t*)(ws + R_H1B); float* ssq2 = (float*)(ws + WS_SSQ2);
    LAS3 unsigned char* wl = lds + wid * 2048;
    const int sub = lane >> 3, col0 = grp * 128 + (lane & 7) * 16;
    const int colL = col0 + 8 * ((lane >> 5) & 1) + 4 * ((lane >> 4) & 1) + 2 * ((lane >> 3) & 1);
    if (wv >= NTOK) return;
    const int nvis = (NTOK - wv + nwv - 1) / nwv;
#define VS_TOK(V) (wv + ((V) < nvis ? (V) : nvis - 1) * nwv)
#define VS_LOADIDX(V, E0, E1, C0, C1) do { const size_t t_ = (size_t)VS_TOK(V) * 128; E0 = eidx[t_ + lane]; E1 = eidx[t_ + 64 + lane]; C0 = coef[t_ + lane]; C1 = coef[t_ + 64 + lane]; } while (0)
    u32x4 sa[16], sb[16];
    unsigned ep[16]; float cpa[16], cpb[16];
    int ea0, ea1, eb0, eb1; float ca0, ca1, cb0, cb1;
    f32x2 hva, hvb;
    VS_LOADIDX(0, ea0, ea1, ca0, ca1); VS_LOADIDX(1, eb0, eb1, cb0, cb1);
    VS_SETUP(0, ea0, ea1, ca0, ca1, ep, cpa); VS_ISSUE(sa, ep); hva = *(const f32x2*)(h + (size_t)VS_TOK(0) * DM + colL);
    VS_SETUP(1, eb0, eb1, cb0, cb1, ep, cpb); VS_ISSUE(sb, ep); hvb = *(const f32x2*)(h + (size_t)VS_TOK(1) * DM + colL);
    VS_LOADIDX(2, ea0, ea1, ca0, ca1); VS_LOADIDX(3, eb0, eb1, cb0, cb1);
#pragma unroll 1
    for (int v = 0; v < nvis; v += 2) {
        { const int tok = VS_TOK(v); VS_CONSUME(sa, cpa, tok, hva); }
        VS_SETUP(0, ea0, ea1, ca0, ca1, ep, cpa); VS_ISSUE(sa, ep); hva = *(const f32x2*)(h + (size_t)VS_TOK(v + 2) * DM + colL);
        VS_LOADIDX(v + 4, ea0, ea1, ca0, ca1);
        if (v + 1 < nvis) { const int tok = VS_TOK(v + 1); VS_CONSUME(sb, cpb, tok, hvb); }
        VS_SETUP(1, eb0, eb1, cb0, cb1, ep, cpb); VS_ISSUE(sb, ep); hvb = *(const f32x2*)(h + (size_t)VS_TOK(v + 3) * DM + colL);
        VS_LOADIDX(v + 5, eb0, eb1, cb0, cb1);
    }
#undef VS_TOK
#undef VS_LOADIDX
}
#undef VS_SETUP
#undef VS_ISSUE
#undef VS_FMA
#undef VS_ROW
#undef VS_RS
#undef VS_CONSUME

#if PEER_V4EXP && PEER_I8U
#define I8_ISSUE(SET, EV, J0) do { int ev_ = (EV); asm volatile("" : "+v"(ev_)); _Pragma("unroll") for (int k = 0; k < 16; ++k) { const int e = __builtin_amdgcn_readlane(ev_, (J0) + k); \
        SET[k] = *(const u32x4*)(u8 + ((unsigned)e * (unsigned)DM + (unsigned)(lane * 16))); } __builtin_amdgcn_sched_barrier(0); } while (0)
#define I8_CONS(SET, P0) do { _Pragma("unroll") for (int k = 0; k < 16; ++k) { \
        int a = __builtin_amdgcn_sdot4((int)SET[k].x, (int)xq[0], 0, false); a = __builtin_amdgcn_sdot4((int)SET[k].y, (int)xq[1], a, false); \
        a = __builtin_amdgcn_sdot4((int)SET[k].z, (int)xq[2], a, false); a = __builtin_amdgcn_sdot4((int)SET[k].w, (int)xq[3], a, false); \
        part[(P0) + k] = (float)a; } __builtin_amdgcn_sched_barrier(0); } while (0)
#define I8_RS(M) do { const bool up = (lane & (M)) != 0; _Pragma("unroll") for (int i = 0; i < (M); ++i) { \
        const float send = up ? part[i] : part[i + (M)], keep = up ? part[i + (M)] : part[i]; part[i] = keep + __shfl_xor(send, (M)); } } while (0)
#define V4_ISSUE(SET, EV, J0) do { int ev_ = (EV); asm volatile("" : "+v"(ev_)); _Pragma("unroll") for (int k = 0; k < 16; ++k) { const int e = __builtin_amdgcn_readlane(ev_, (J0) + k); \
        SET[k] = *(const u32x2*)(v8 + ((unsigned)e * (unsigned)(DM / 2) + (unsigned)(lane * 8))); } __builtin_amdgcn_sched_barrier(0); } while (0)
#define V4_FMA(W, I) do { t_[4 * (I)] = __builtin_elementwise_fma(__builtin_amdgcn_cvt_scalef32_pk_f32_fp4((W), 1.0f, 0), c2, t_[4 * (I)]); \
        t_[4 * (I) + 1] = __builtin_elementwise_fma(__builtin_amdgcn_cvt_scalef32_pk_f32_fp4((W), 1.0f, 1), c2, t_[4 * (I) + 1]); \
        t_[4 * (I) + 2] = __builtin_elementwise_fma(__builtin_amdgcn_cvt_scalef32_pk_f32_fp4((W), 1.0f, 2), c2, t_[4 * (I) + 2]); \
        t_[4 * (I) + 3] = __builtin_elementwise_fma(__builtin_amdgcn_cvt_scalef32_pk_f32_fp4((W), 1.0f, 3), c2, t_[4 * (I) + 3]); } while (0)
#define V4_ROW(SET, CV, J0, K) do { const float c = (CV)[(J0) + (K)]; const f32x2 c2 = {c, c}; const u32x2 w_ = SET[K]; \
        V4_FMA(w_.x, 0); V4_FMA(w_.y, 1); } while (0)
#define V4_CONS(SET, CV, J0) do { f32x2 t_[8]; _Pragma("unroll") for (int i_ = 0; i_ < 8; ++i_) t_[i_] = (f32x2){0.f, 0.f}; V4_ROW(SET, CV, J0, 0); V4_ROW(SET, CV, J0, 1); V4_ROW(SET, CV, J0, 2); V4_ROW(SET, CV, J0, 3); V4_ROW(SET, CV, J0, 4); V4_ROW(SET, CV, J0, 5); \
        V4_ROW(SET, CV, J0, 6); V4_ROW(SET, CV, J0, 7); V4_ROW(SET, CV, J0, 8); V4_ROW(SET, CV, J0, 9); V4_ROW(SET, CV, J0, 10); V4_ROW(SET, CV, J0, 11); \
        V4_ROW(SET, CV, J0, 12); V4_ROW(SET, CV, J0, 13); V4_ROW(SET, CV, J0, 14); V4_ROW(SET, CV, J0, 15); \
        _Pragma("unroll") for (int i_ = 0; i_ < 8; ++i_) acc[i_] += t_[i_]; __builtin_amdgcn_sched_barrier(0); } while (0)
DI void p6fused(const Params& p, LAS3 unsigned char* lds, int G) {
    unsigned char* ws = p.ws;
    const int tid = threadIdx.x, lane = tid & 63, wid = tid >> 6;
    const int gw = blockIdx.x * 8 + wid, nw = G * 8;
    const unsigned char* u8 = (const unsigned char*)(ws + WS_UB); const unsigned char* v8 = (const unsigned char*)(ws + WS_VB);
    const int* eidx = (const int*)(ws + R_EXP); const float* gsm = (const float*)(ws + R_GSM); const float* rs1v = (const float*)(ws + WS_RS1);
    float* h = p.out; bf16_t* hb = (bf16_t*)(ws + R_H1B); float* rs2 = (float*)(ws + WS_RS2);
    LAS3 float* cl = (LAS3 float*)(lds + wid * 512);
#pragma unroll 1
    for (int tok = gw; tok < NTOK; tok += nw) {
        const int e0 = eidx[(size_t)tok * 128 + lane], e1 = eidx[(size_t)tok * 128 + 64 + lane];
        {
            u32x4 sa[16], sb[16];
            I8_ISSUE(sa, e0, 0);
            I8_ISSUE(sb, e0, 16);
            const u32x4 xa = *(const u32x4*)(hb + (size_t)tok * DM + lane * 16), xb = *(const u32x4*)(hb + (size_t)tok * DM + lane * 16 + 8);
            const float g0 = gsm[(size_t)tok * 128 + lane], g1 = gsm[(size_t)tok * 128 + 64 + lane];
            const float rs1 = rs1v[tok];
            float xf[16];
#pragma unroll
            for (int q = 0; q < 4; ++q) { xf[2 * q] = bflo(xa[q]); xf[2 * q + 1] = bfhi(xa[q]); xf[8 + 2 * q] = bflo(xb[q]); xf[8 + 2 * q + 1] = bfhi(xb[q]); }
            float amax = 0.f;
#pragma unroll
            for (int i = 0; i < 16; ++i) amax = fmaxf(amax, fabsf(xf[i]));
            amax = wave_max(amax);
            const float sx = fmaxf(amax, 1e-20f) * (1.0f / 127.0f), isx = 1.0f / sx;
            unsigned xq[4];
#pragma unroll
            for (int q = 0; q < 4; ++q) {
                unsigned w = 0u;
#pragma unroll
                for (int b = 0; b < 4; ++b) w |= ((unsigned)(int)rintf(xf[4 * q + b] * isx) & 0xffu) << (8 * b);
                xq[q] = w;
            }
            const float scl = rs1 * sx * (1.0f / U_ISCALE);
            float part[64];
            I8_CONS(sa, 0);  I8_ISSUE(sa, e0, 32);
            I8_CONS(sb, 16); I8_ISSUE(sb, e0, 48);
            I8_CONS(sa, 32); I8_ISSUE(sa, e1, 0);
            I8_CONS(sb, 48); I8_ISSUE(sb, e1, 16);
            I8_RS(32); I8_RS(16); I8_RS(8); I8_RS(4); I8_RS(2); I8_RS(1);
            cl[lane] = g0 * gelu_tanh(part[0] * scl) * (1.0f / V8_SCALE);
            I8_CONS(sa, 0);  I8_ISSUE(sa, e1, 32);
            I8_CONS(sb, 16); I8_ISSUE(sb, e1, 48);
            I8_CONS(sa, 32);
            I8_CONS(sb, 48);
            I8_RS(32); I8_RS(16); I8_RS(8); I8_RS(4); I8_RS(2); I8_RS(1);
            cl[64 + lane] = g1 * gelu_tanh(part[0] * scl) * (1.0f / V8_SCALE);
        }
        {
            u32x2 sa[16], sb[16];
            V4_ISSUE(sa, e0, 0);
            V4_ISSUE(sb, e0, 16);
            LAS3 const float* c0 = cl; LAS3 const float* c1 = cl + 64;
            float* hr = h + (size_t)tok * DM + lane * 16;
            const f32x4 hv0 = *(const f32x4*)hr, hv1 = *(const f32x4*)(hr + 4), hv2 = *(const f32x4*)(hr + 8), hv3 = *(const f32x4*)(hr + 12);
            f32x2 acc[8];
#pragma unroll
            for (int i = 0; i < 8; ++i) acc[i] = (f32x2){0.f, 0.f};
            V4_CONS(sa, c0, 0);  V4_ISSUE(sa, e0, 32);
            V4_CONS(sb, c0, 16); V4_ISSUE(sb, e0, 48);
            V4_CONS(sa, c0, 32); V4_ISSUE(sa, e1, 0);
            V4_CONS(sb, c0, 48); V4_ISSUE(sb, e1, 16);
            V4_CONS(sa, c1, 0);  V4_ISSUE(sa, e1, 32);
            V4_CONS(sb, c1, 16); V4_ISSUE(sb, e1, 48);
            V4_CONS(sa, c1, 32);
            V4_CONS(sb, c1, 48);
            const f32x4 o0 = hv0 + (f32x4){acc[0].x, acc[0].y, acc[1].x, acc[1].y}, o1 = hv1 + (f32x4){acc[2].x, acc[2].y, acc[3].x, acc[3].y};
            const f32x4 o2 = hv2 + (f32x4){acc[4].x, acc[4].y, acc[5].x, acc[5].y}, o3 = hv3 + (f32x4){acc[6].x, acc[6].y, acc[7].x, acc[7].y};
            *(f32x4*)hr = o0; *(f32x4*)(hr + 4) = o1; *(f32x4*)(hr + 8) = o2; *(f32x4*)(hr + 12) = o3;
            u32x4 w0, w1;
            w0.x = pk_bf16(o0[0], o0[1]); w0.y = pk_bf16(o0[2], o0[3]); w0.z = pk_bf16(o1[0], o1[1]); w0.w = pk_bf16(o1[2], o1[3]);
            w1.x = pk_bf16(o2[0], o2[1]); w1.y = pk_bf16(o2[2], o2[3]); w1.z = pk_bf16(o3[0], o3[1]); w1.w = pk_bf16(o3[2], o3[3]);
            *(u32x4*)(hb + (size_t)tok * DM + lane * 16) = w0; *(u32x4*)(hb + (size_t)tok * DM + lane * 16 + 8) = w1;
            float ss = 0.f;
#pragma unroll
            for (int j = 0; j < 4; ++j) ss += o0[j] * o0[j] + o1[j] * o1[j] + o2[j] * o2[j] + o3[j] * o3[j];
            ss = wave_sum(ss);
            if (lane == 0) rs2[tok] = rsqrtf(ss * (1.0f / DM) + EPS);
        }
    }
}
#undef I8_ISSUE
#undef I8_CONS
#undef I8_RS
#undef V4_ISSUE
#undef V4_CONS
#undef V4_FMA
#undef V4_ROW
#endif
constexpr int LDS_MISC = 160 * 1024 - 256;
constexpr int LDS_BYTES = 160 * 1024;
constexpr size_t CTL_BAR = 0;
static_assert(XCD_BAR_WORDS * 4 <= 64 * 1024, "control region");

template <class F> struct EpiAdapt {
    static constexpr bool PERM = true, AFTER_DRAIN = false;
    F f;
    DI void operator()(const f32x4 (&acc)[2][2][4][2], const pg8::Unit& u, int wr, int wc, int fr, int fq) const {
        const int row0 = u.pm * 256 + wr * 64 + fr, col0 = u.pn * 256 + wc * 32 + 8 * fq;
#pragma unroll
        for (int ai = 0; ai < 2; ++ai)
#pragma unroll
            for (int m = 0; m < 4; ++m) {
                const int row = row0 + ai * 128 + m * 16;
#pragma unroll
                for (int bj = 0; bj < 2; ++bj)
#pragma unroll
                    for (int n = 0; n < 2; ++n) f.store4(row, col0 + bj * 128 + 4 * n, acc[ai][bj][m][n]);
            }
    }
};
template <class F> struct EpiAdaptSsq {
    static constexpr bool PERM = true, AFTER_DRAIN = false;
    F f; float* ssq;
    DI void operator()(const f32x4 (&acc)[2][2][4][2], const pg8::Unit& u, int wr, int wc, int fr, int fq) const {
        const int row0 = u.pm * 256 + wr * 64 + fr, col0 = u.pn * 256 + wc * 32 + 8 * fq;
#pragma unroll
        for (int ai = 0; ai < 2; ++ai)
#pragma unroll
            for (int m = 0; m < 4; ++m) {
                const int row = row0 + ai * 128 + m * 16;
                float s = 0.f; const float rsc = f.rowscale(row);
#pragma unroll
                for (int bj = 0; bj < 2; ++bj)
#pragma unroll
                    for (int n = 0; n < 2; ++n) { const f32x4 v = f.store4r(row, col0 + bj * 128 + 4 * n, acc[ai][bj][m][n], rsc); s += (v[0] * v[0] + v[1] * v[1]) + (v[2] * v[2] + v[3] * v[3]); }
                s += __shfl_xor(s, 16); s += __shfl_xor(s, 32);
                if (fq == 0) ssq[(size_t)(u.pn * 4 + wc) * NTOK + row] = s;
            }
    }
};
struct EpiOutR {
    const float* x; float* h1; bf16_t* h1b;
    DI float rowscale(int) const { return 0.f; }
    DI f32x4 store4r(int row, int col, f32x4 v, float) const {
        const size_t o = (size_t)row * DM + col;
        v += *(const f32x4*)(x + o);
        *(f32x4*)(h1 + o) = v;
        u32x2 w; w.x = pack2bf(v[0], v[1]); w.y = pack2bf(v[2], v[3]); *(u32x2*)(h1b + o) = w;
        return v;
    }
};
struct EpiBf16Plain { bf16_t* C; int ldc;
    DI void store4(int row, int col, f32x4 v) const { u32x2 w; w.x = pack2bf(v[0], v[1]); w.y = pack2bf(v[2], v[3]); *(u32x2*)(C + (size_t)row * ldc + col) = w; } };
struct EpiGateR {
    const float* rs2; const float* bias; const float* pp; float* h;
    DI float rowscale(int row) const {
#if PEER_V2 && (!PEER_V6 || PEER_V6 == 3 || PEER_V6 == 4 || PEER_V6 == 6)
        float s = 0.f;
#pragma unroll
        for (int j = 0; j < (PEER_V3 ? 8 : 16); ++j) s += rs2[(size_t)j * NTOK + row];
        return rsqrtf(s * (1.0f / DM) + EPS);
#else
        return rs2[row];
#endif
    }
    DI f32x4 store4r(int row, int col, f32x4 v, float s) const {
        const size_t o = (size_t)row * DM + col;
        const f32x4 bb = *(const f32x4*)(bias + col), p4 = *(const f32x4*)(pp + o);
        f32x4 hv = *(f32x4*)(h + o);
#pragma unroll
        for (int j = 0; j < 4; ++j) hv[j] += sigmoidf_(v[j] * s + bb[j]) * p4[j];
        *(f32x4*)(h + o) = hv;
        return hv;
    }
};

struct MegaArgs { Params p; int ph_lo, ph_hi; };

__global__ void __launch_bounds__(MK_THREADS, 2) mega_fwd(MegaArgs args) {
    extern __shared__ __attribute__((aligned(16))) unsigned char lds_raw[];
    LAS unsigned char* lds = (LAS unsigned char*)lds_raw;
    const Params& p = args.p;
    unsigned char* ws = p.ws;
    const int lo = args.ph_lo, hi = args.ph_hi;
    const int G = gridDim.x;
    volatile LAS unsigned* misc = (volatile LAS unsigned*)(lds + LDS_MISC);
    if (threadIdx.x < 64) misc[threadIdx.x] = 0u;
    __syncthreads();
    XcdBarrier bar; bar.bar = (unsigned*)(ws + WS_CTL); bar.x = 0; bar.st = nullptr;
    bar = xcd_barrier_post((unsigned*)(ws + WS_CTL), misc);
    if (threadIdx.x == 0) { const unsigned xc = xb_xcc_id() & 7u; misc[16] = xc; misc[17] = atomicAdd((unsigned*)(ws + WS_CTL + 16384) + xc * 16, 1u); }
    __syncthreads();
#define IN(k) (lo <= (k) && (k) < hi)
#define SEAM(k) do { if (IN(k) && IN((k) + 1)) xcd_barrier(bar); } while (0)

    if (IN(0)) p0_prologue(p, lds, G);
    SEAM(0);
    if (IN(1)) {
        pg8::Gemm g{(const bf16_t*)(ws + WS_XB), (const bf16_t*)(ws + WS_WIN), NTOK, NPROJ, DM};
        pg8::StaticOrder S; S.init(NTOK, NPROJ, G, (int)blockIdx.x);
        EpiAdapt<EpiProj> E{{(const float*)(ws + WS_RS0), (bf16_t*)(ws + R_QB), (bf16_t*)(ws + R_KC), (float*)(ws + R_GATE), (float*)(ws + R_XR), (bf16_t*)(ws + R_XG)}};
        pg8::gemm_phase<EpiAdapt<EpiProj>, pg8::StaticOrder>(lds, g, S, E, nullptr);
    }
    SEAM(1);
    if (IN(2)) { if (!CMP_NAIVE) { p2_compress(p, lds, G); p2_vtranspose(p, lds, G); } lru_phase<false>(p, lds, G); }
    SEAM(2);
    if (IN(3)) { p3_attention<0>(p, lds, G); if (!LRU_NAIVE) lru_phase<true>(p, lds, G);
#ifdef PROBE_LRU2
        lru_phase<true>(p, lds, G);
#endif
#ifdef PROBE_ATT2
        p3_attention<PROBE_ATT2>(p, lds, G);
#endif
    }
    SEAM(3);
    if (IN(4)) {
        pg8::Gemm g{(const bf16_t*)(ws + WS_XB), (const bf16_t*)(ws + WS_WOUT), NTOK, DM, DM};
        pg8::StaticOrder S; S.init(NTOK, DM, G, (int)blockIdx.x);
        EpiAdaptSsq<EpiOutR> E{{p.in[I_X], p.out, (bf16_t*)(ws + R_H1B)}, (float*)(ws + WS_SSQ1)};
        pg8::gemm_phase<EpiAdaptSsq<EpiOutR>, pg8::StaticOrder>(lds, g, S, E, nullptr);
    }
    SEAM(4);
    if (IN(5)) p5_peer_route(p, lds, G);
    SEAM(5);
    if (IN(6)) {
#if PEER_V6 == 2
        p6v6_u(p, G); xcd_barrier(bar); p6v6_v(p, G);
#elif PEER_V6 == 4
        p6u_cols(p, G); xcd_barrier(bar); p6u_combine(p, G); xcd_barrier(bar); p6v3_v<0>(p, G);
#elif PEER_V6 == 3 && PEER_FP4
        p6f4_u(p, G); xcd_barrier(bar); p6f4_v<0>(p, G);
#elif PEER_V6 == 6 && PEER_I8U
        p6i8_u(p, G); xcd_barrier(bar); p6vs_v(p, lds, G);
#elif PEER_V6 == 5 && PEER_I8U
#if PEER_V4EXP && PEER_FUSED
        p6fused(p, lds, G);
#elif PEER_V4EXP
        p6i8_u(p, G); xcd_barrier(bar); p6v4_v(p, lds, G);
#else
        p6i8_u(p, G); xcd_barrier(bar); p6v8_v(p, lds, G);
#endif
#elif PEER_V6 == 3 && PEER_I8U
        p6i8_u(p, G);
#ifdef PROBE_U2
        p6i8_u(p, G);
#endif
        xcd_barrier(bar);
#ifdef PROBE_V2
        p6v3_v<1>(p, G);
#endif
        p6v3_v<0>(p, G);
#elif PEER_V6 == 3
        p6v6_u(p, G); xcd_barrier(bar); p6v3_v<0>(p, G);
#elif PEER_V6
        p6v6_peer(p, G);
#elif PEER_V3
        p6v5_u(p, lds, G);
#ifdef PROBE_U2
        p6v5_u(p, lds, G);
#endif
        xcd_barrier(bar); p6v3_v<0>(p, G);
#elif PEER_V2
        p6_peer_u(p, G);
#ifdef PROBE_U2
        p6_peer_u(p, G);
#endif
        xcd_barrier(bar); p6_peer_v(p, G);
#else
        p6_peer_apply(p, G);
#endif
    }
    SEAM(6);
    if (IN(7)) {
        {
            pg8::Gemm g{(const bf16_t*)(ws + WS_PB), (const bf16_t*)(ws + WS_WP), NTOK, DM, PLE};
            pg8::StaticOrder S; S.init(NTOK, DM, G, (int)blockIdx.x);
            EpiAdapt<EpiF32Plain> E{{(float*)(ws + R_BIG), DM, 0}};
            pg8::gemm_phase<EpiAdapt<EpiF32Plain>, pg8::StaticOrder>(lds, g, S, E, nullptr);
        }
        __syncthreads();
        {
            pg8::Gemm g{(const bf16_t*)(ws + R_H1B), (const bf16_t*)(ws + WS_WG), NTOK, DM, DM};
            pg8::StaticOrder S; S.init(NTOK, DM, G, (int)blockIdx.x);
            EpiAdaptSsq<EpiGateR> E{{(const float*)(ws + ((PEER_V2 && (!PEER_V6 || PEER_V6 == 3 || PEER_V6 == 4 || PEER_V6 == 6)) ? WS_SSQ2 : WS_RS2)), p.in[I_PLE_BG], (const float*)(ws + R_BIG), p.out}, (float*)(ws + WS_SSQ3)};
            pg8::gemm_phase<EpiAdaptSsq<EpiGateR>, pg8::StaticOrder>(lds, g, S, E, nullptr);
        }
    }
    SEAM(7);
#ifdef PROBE_BARS
    for (int i = 0; i < PROBE_BARS; ++i) xcd_barrier(bar);
#endif
    if (IN(8)) p8_final_norm(p, G);
#undef IN
#undef SEAM
}

static int g_grid = 0;
static void launch_mega(hipStream_t st, const Params& p, int lo, int hi) {
    if (g_grid == 0) {
        int dev = 0, cus = 0, per_cu = 0;
        hipGetDevice(&dev); hipDeviceGetAttribute(&cus, hipDeviceAttributeMultiprocessorCount, dev);
        if (hipFuncSetAttribute((const void*)mega_fwd, hipFuncAttributeMaxDynamicSharedMemorySize, LDS_BYTES) != hipSuccess) { fprintf(stderr, "hipFuncSetAttribute failed\n"); g_grid = -1; return; }
        if (hipOccupancyMaxActiveBlocksPerMultiprocessor(&per_cu, (const void*)mega_fwd, MK_THREADS, LDS_BYTES) != hipSuccess || per_cu < 1) { fprintf(stderr, "occupancy query: %d per CU\n", per_cu); }
        (void)hipGetLastError();
        g_grid = cus;
    }
    if (g_grid < 0) return;
    MegaArgs a{}; a.p = p; a.ph_lo = lo; a.ph_hi = hi;
    hipLaunchKernelGGL(mega_fwd, dim3(g_grid), dim3(MK_THREADS), LDS_BYTES, st, a);
}
template <class Epi> static void gemm_naive(hipStream_t st, const bf16_t* A, int lda, const bf16_t* Bt, int ldb, int M, int N, int K, const Epi& E) {
    hipLaunchKernelGGL((k_gemm_naive<Epi>), dim3(N / 64, M / 64), dim3(256), 0, st, A, lda, Bt, ldb, K, E);
}

static void run_prologue_naive(hipStream_t st, const Params& p) {
    unsigned char* ws = p.ws;
    hipLaunchKernelGGL(k_prep_x, dim3(NTOK), dim3(256), 0, st, p.in[I_X], (bf16_t*)(ws + WS_XB), (float*)(ws + WS_RS0));
    hipLaunchKernelGGL(k_prep_win, dim3((NPROJ * DM + 255) / 256), dim3(256), 0, st, p.in[I_W_IN], p.in[I_ATTN_NORM], (bf16_t*)(ws + WS_WIN));
    hipLaunchKernelGGL(k_transpose_bf16, dim3(DM * DM / 256), dim3(256), 0, st, p.in[I_W_OUT], (const float*)nullptr, (bf16_t*)(ws + WS_WOUT), DM, DM);
    hipLaunchKernelGGL(k_transpose_bf16, dim3(DM * DM / 256), dim3(256), 0, st, p.in[I_PLE_WG], p.in[I_PLE_NORM], (bf16_t*)(ws + WS_WG), DM, DM);
    hipLaunchKernelGGL(k_transpose_bf16, dim3(PLE * DM / 256), dim3(256), 0, st, p.in[I_PLE_PROJ], (const float*)nullptr, (bf16_t*)(ws + WS_WP), PLE, DM);
    hipLaunchKernelGGL(k_transpose_bf16, dim3(2048 * 256 / 256), dim3(256), 0, st, p.in[I_CK_W1], (const float*)nullptr, (bf16_t*)(ws + WS_CW1K), 2048, 256);
    hipLaunchKernelGGL(k_transpose_bf16, dim3(2048 * 256 / 256), dim3(256), 0, st, p.in[I_CV_W1], (const float*)nullptr, (bf16_t*)(ws + WS_CW1V), 2048, 256);
    hipLaunchKernelGGL(k_prep_wqs, dim3(DM * 16), dim3(128), 0, st, p.in[I_PEER_WQ], p.in[I_PEER_SUB], p.in[I_FFN_NORM], (bf16_t*)(ws + WS_WQS));
    hipLaunchKernelGGL(k_cvt_bf16, dim3(2048), dim3(256), 0, st, p.in[I_PEER_U], p.in[I_FFN_NORM], (bf16_t*)(ws + WS_UB), (size_t)16384 * DM / 4, DM);
    hipLaunchKernelGGL(k_cvt_bf16, dim3(2048), dim3(256), 0, st, p.in[I_PEER_V], (const float*)nullptr, (bf16_t*)(ws + WS_VB), (size_t)16384 * DM / 4, DM);
    hipLaunchKernelGGL(k_cvt_bf16, dim3(1024), dim3(256), 0, st, p.in[I_P], (const float*)nullptr, (bf16_t*)(ws + WS_PB), (size_t)NTOK * PLE / 4, PLE);
    hipLaunchKernelGGL(k_prep_cmpbias, dim3(1), dim3(256), 0, st, p.in[I_CK_PE], p.in[I_CK_W1], (float*)(ws + WS_CBK));
    hipLaunchKernelGGL(k_prep_cmpbias, dim3(1), dim3(256), 0, st, p.in[I_CV_PE], p.in[I_CV_W1], (float*)(ws + WS_CBV));
}
static void run_p1_naive(hipStream_t st, const Params& p) {
    unsigned char* ws = p.ws;
    EpiProj E{(const float*)(ws + WS_RS0), (bf16_t*)(ws + R_QB), (bf16_t*)(ws + R_KC), (float*)(ws + R_GATE), (float*)(ws + R_XR), (bf16_t*)(ws + R_XG)};
    gemm_naive(st, (const bf16_t*)(ws + WS_XB), DM, (const bf16_t*)(ws + WS_WIN), DM, NTOK, NPROJ, DM, E);
}
static void run_p2_naive(hipStream_t st, const Params& p) {
    unsigned char* ws = p.ws;
    float* hid = (float*)(ws + WS_HID);
    hipLaunchKernelGGL(k_cmp_hidden, dim3(2048), dim3(256), 0, st, (const bf16_t*)(ws + R_KC), (const bf16_t*)(ws + WS_CW1K), (const float*)(ws + WS_CBK), hid);
    hipLaunchKernelGGL(k_cmp_hidden, dim3(2048), dim3(256), 0, st, (const bf16_t*)(ws + R_VC), (const bf16_t*)(ws + WS_CW1V), (const float*)(ws + WS_CBV), hid + (size_t)2048 * 256);
    hipLaunchKernelGGL(k_cmp_out, dim3(2048), dim3(64), 0, st, (const float*)hid, p.in[I_CK_W2], (float*)(ws + WS_KCMP));
    hipLaunchKernelGGL(k_cmp_out, dim3(2048), dim3(64), 0, st, (const float*)(hid + (size_t)2048 * 256), p.in[I_CV_W2], (float*)(ws + WS_VCMP));
}
static void run_p2_extras(hipStream_t st, const Params& p) {
    unsigned char* ws = p.ws;
    hipLaunchKernelGGL(k_p2_extras, dim3(2048), dim3(256), 0, st, (const bf16_t*)(ws + R_VS), (const bf16_t*)(ws + R_VW), (const float*)(ws + WS_KCMP), (const float*)(ws + WS_VCMP),
                       (bf16_t*)(ws + R_VST), (bf16_t*)(ws + R_VWT), (bf16_t*)(ws + R_KCB), (bf16_t*)(ws + R_VCT));
}
static void run_lru_naive(hipStream_t st, const Params& p) {
    unsigned char* ws = p.ws;
    LruArgs la{(const float*)(ws + R_XR), (const bf16_t*)(ws + R_XG), p.in[I_CONV_W], p.in[I_CONV_B], p.in[I_LRU_WA], p.in[I_LRU_BA], p.in[I_LRU_WX], p.in[I_LRU_BX], p.in[I_LRU_LAM], p.out};
    hipLaunchKernelGGL(k_lru_naive, dim3(NB * 8), dim3(64), 0, st, la);
    hipLaunchKernelGGL(k_grpnorm_lru, dim3(NTOK), dim3(256), 0, st, (const float*)p.out, p.in[I_GN_LRU], (bf16_t*)(ws + WS_XB));
}
static void run_p3_naive(hipStream_t st, const Params& p) {
    unsigned char* ws = p.ws;
    NsaArgs na{(const bf16_t*)(ws + R_QB), (const bf16_t*)(ws + R_KS), (const bf16_t*)(ws + R_VS), (const bf16_t*)(ws + R_KW), (const bf16_t*)(ws + R_VW),
               (const float*)(ws + WS_KCMP), (const float*)(ws + WS_VCMP), (const float*)(ws + R_GATE), p.in[I_REL], p.out};
    hipLaunchKernelGGL(k_nsa_naive, dim3(NB * NKV * T_), dim3(256), 0, st, na);
    LruArgs la{(const float*)(ws + R_XR), (const bf16_t*)(ws + R_XG), p.in[I_CONV_W], p.in[I_CONV_B], p.in[I_LRU_WA], p.in[I_LRU_BA], p.in[I_LRU_WX], p.in[I_LRU_BX], p.in[I_LRU_LAM], p.out};
    hipLaunchKernelGGL(k_lru_naive, dim3(NB * 8), dim3(64), 0, st, la);
    hipLaunchKernelGGL(k_grpnorm, dim3(NTOK), dim3(256), 0, st, (const float*)p.out, p.in[I_GN_ATTN], p.in[I_GN_LRU], (bf16_t*)(ws + WS_XB));
}
static void run_p4_naive(hipStream_t st, const Params& p) {
    unsigned char* ws = p.ws;
    EpiOut E{p.in[I_X], p.out, (bf16_t*)(ws + R_H1B)};
    gemm_naive(st, (const bf16_t*)(ws + WS_XB), DM, (const bf16_t*)(ws + WS_WOUT), DM, NTOK, DM, DM, E);
    hipLaunchKernelGGL(k_rowssq, dim3(NTOK), dim3(256), 0, st, (const float*)p.out, (float*)(ws + WS_SSQ1));
}
static void run_p5_naive(hipStream_t st, const Params& p) {
    unsigned char* ws = p.ws;
    for (int hh = 0; hh < 2; ++hh) {
        EpiF32Plain E{(float*)(ws + R_BIG), 1024, 0};
        gemm_naive(st, (const bf16_t*)(ws + R_H1B), DM, (const bf16_t*)(ws + WS_WQS) + (size_t)hh * 1024 * DM, DM, NTOK, 1024, DM, E);
        hipLaunchKernelGGL(k_peer_route, dim3(NTOK * 4), dim3(256), 0, st, (const float*)(ws + R_BIG), (const float*)(ws + WS_SSQ1), hh, (int*)(ws + R_EXP), (float*)(ws + R_GSM));
    }
}
static void run_p6_naive(hipStream_t st, const Params& p) {
    unsigned char* ws = p.ws;
    hipLaunchKernelGGL(k_peer_apply, dim3(NTOK), dim3(256), 0, st, (const bf16_t*)(ws + WS_UB), (const bf16_t*)(ws + WS_VB), (const int*)(ws + R_EXP), (const float*)(ws + R_GSM),
                       (const float*)(ws + WS_SSQ1), p.out, (bf16_t*)(ws + R_H1B), (float*)(ws + WS_RS2));
}
static void run_p7_naive(hipStream_t st, const Params& p) {
    unsigned char* ws = p.ws;
    EpiF32Plain Ep{(float*)(ws + R_BIG), DM, 0};
    gemm_naive(st, (const bf16_t*)(ws + WS_PB), PLE, (const bf16_t*)(ws + WS_WP), PLE, NTOK, DM, PLE, Ep);
    EpiGate Eg{(const float*)(ws + WS_RS2), p.in[I_PLE_BG], (const float*)(ws + R_BIG), p.out};
    gemm_naive(st, (const bf16_t*)(ws + R_H1B), DM, (const bf16_t*)(ws + WS_WG), DM, NTOK, DM, DM, Eg);
    hipLaunchKernelGGL(k_rowssq, dim3(NTOK), dim3(256), 0, st, (const float*)p.out, (float*)(ws + WS_SSQ3));
}
static void run_p8_naive(hipStream_t st, const Params& p) {
    hipLaunchKernelGGL(k_final_norm, dim3(NTOK), dim3(256), 0, st, p.out, (const float*)(p.ws + WS_SSQ3), p.in[I_FINAL_NORM]);
}
static void run_phase(hipStream_t st, const Params& p, int k) {
    switch (k) {
        case 0: run_prologue_naive(st, p); break;
        case 1: run_p1_naive(st, p); break;
        case 2: run_p2_naive(st, p); if ((OPT_MASK >> 3) & 1) run_p2_extras(st, p); break;
        case 3: run_p3_naive(st, p); break;
        case 4: run_p4_naive(st, p); break;
        case 5: run_p5_naive(st, p); break;
        case 6: run_p6_naive(st, p); break;
        case 7: run_p7_naive(st, p); break;
        case 8: run_p8_naive(st, p); break;
    }
}
extern "C" void kernel_launch(void* const* d_in, const int* in_sizes, int n_in, void* d_out, int out_size, void* d_ws, size_t ws_size, hipStream_t stream) {
    if (n_in != 31 || out_size != NTOK * DM || ws_size < WS_END) { fprintf(stderr, "kernel_launch: unexpected shapes (n_in %d out %d ws %zu)\n", n_in, out_size, ws_size); return; }
    Params p{};
    for (int i = 0; i < 31; ++i) p.in[i] = (const float*)d_in[i];
    p.out = (float*)d_out; p.ws = (unsigned char*)d_ws;
#ifdef PROBE_DOUBLE
    hipMemsetAsync((char*)d_ws + WS_CTL, 0, 16384 + 1024, stream);
    launch_mega(stream, p, 0, PROBE_DOUBLE);
#endif
    int k = 0;
#ifdef PROBE_DOUBLE
    k = PROBE_START;
#endif
    while (k <= 8) {
        if ((OPT_MASK >> k) & 1) {
            int e = k; while (e <= 8 && ((OPT_MASK >> e) & 1)) ++e;
            if (LRU_NAIVE && k <= 3 && e > 4) e = 4;
            if (CMP_NAIVE && k <= 1 && e > 2) e = 2;
            if (CMP_NAIVE && k == 2) { run_p2_naive(stream, p); run_p2_extras(stream, p); }
            hipMemsetAsync((char*)d_ws + WS_CTL, 0, 16384 + 1024, stream);
            launch_mega(stream, p, k, e);
            if (LRU_NAIVE && k <= 3 && e == 4) run_lru_naive(stream, p);
            k = e;
        } else { run_phase(stream, p, k); ++k; }
    }
}
```

```cpp
#include <hip/hip_runtime.h>
#include <stdint.h>
#include <stdio.h>

typedef unsigned short bf16_t;
typedef float f32x4 __attribute__((ext_vector_type(4)));
typedef float f32x2 __attribute__((ext_vector_type(2)));
typedef unsigned u32x4 __attribute__((ext_vector_type(4)));
typedef unsigned u32x2 __attribute__((ext_vector_type(2)));
#define DI __device__ __forceinline__

constexpr int NB = 4, T_ = 4096, DM = 1024, NTOK = NB * T_;
constexpr int NH = 8, HD = 64, NKV = 2, GRP = 4, ATTW = 512, KVW = 128, LRUW = 512;
constexpr int INCOLS = 2328, NPROJ = 2560;
constexpr int NCMP = 255, NSEL = 64;
constexpr int PEER_H = 8, PEER_K = 16, PEER_NK = 128;
constexpr int PLE = 256;
constexpr float EPS = 1e-6f;

constexpr int PC_KV = 512, PC_XR = 1280, PC_XG = 1792, PC_GATE = 2304;

constexpr size_t MB = 1024 * 1024;
constexpr size_t WS_CTL   = 0;
constexpr size_t WS_WIN   = 64 * 1024;
constexpr size_t WS_WOUT  = WS_WIN  + (size_t)NPROJ * DM * 2;
constexpr size_t WS_WQS   = WS_WOUT + (size_t)DM * DM * 2;
constexpr size_t WS_WG    = WS_WQS  + (size_t)2048 * DM * 2;
constexpr size_t WS_WP    = WS_WG   + (size_t)DM * DM * 2;
constexpr size_t WS_CW1K  = WS_WP   + (size_t)DM * PLE * 2;
constexpr size_t WS_CW1V  = WS_CW1K + (size_t)256 * 2048 * 2;
constexpr size_t WS_CBK   = WS_CW1V + (size_t)256 * 2048 * 2;
constexpr size_t WS_CBV   = WS_CBK  + 1024;
constexpr size_t WS_RS0   = WS_CBV  + 1024;
constexpr size_t WS_RS2   = WS_RS0  + (size_t)NTOK * 4;
constexpr size_t WS_RS1   = WS_RS2  + (size_t)NTOK * 4;
constexpr size_t WS_SSQ2  = WS_RS1  + (size_t)NTOK * 4;
constexpr size_t WS_SSQ1  = WS_SSQ2 + (size_t)16 * NTOK * 4;
constexpr size_t WS_SSQ3  = WS_SSQ1 + (size_t)16 * NTOK * 4;
constexpr size_t WS_KCMP  = WS_SSQ3 + (size_t)16 * NTOK * 4;
constexpr size_t WS_VCMP  = WS_KCMP + (size_t)8 * 256 * 64 * 4;
constexpr size_t WS_LRUP  = WS_VCMP + (size_t)8 * 256 * 64 * 4;
constexpr size_t WS_LRUH  = WS_LRUP + (size_t)256 * 512 * 4;
constexpr size_t WS_WAT   = WS_LRUH + (size_t)256 * 512 * 4;
constexpr size_t WS_WXT   = WS_WAT + 8 * 64 * 64 * 2;
constexpr size_t WS_CW2K  = WS_WXT + 8 * 64 * 64 * 2;
constexpr size_t WS_CW2V  = WS_CW2K + 64 * 256 * 2;
constexpr size_t WS_HID   = WS_CW2V + 64 * 256 * 2;
constexpr size_t WS_UB    = (WS_HID + (size_t)2 * 2048 * 256 * 4 + 4095) / 4096 * 4096;
constexpr size_t WS_VB    = WS_UB + (size_t)16384 * DM * 2;
constexpr size_t WS_PB    = WS_VB + (size_t)16384 * DM * 2;
constexpr size_t WS_XB    = WS_PB + (size_t)NTOK * PLE * 2;
constexpr size_t WS_R     = WS_XB + (size_t)NTOK * DM * 2;
constexpr size_t KVT = (size_t)NB * NKV * T_ * HD * 2 + 65536;
constexpr size_t R_QB    = WS_R;
constexpr size_t R_KC    = R_QB + (size_t)NTOK * 512 * 2;
constexpr size_t R_VC    = R_KC + KVT;
constexpr size_t R_KS    = R_VC + KVT;
constexpr size_t R_VS    = R_KS + KVT;
constexpr size_t R_KW    = R_VS + KVT;
constexpr size_t R_VW    = R_KW + KVT;
constexpr size_t R_GATE  = R_VW + KVT;
constexpr size_t R_XR    = R_GATE + (size_t)NTOK * 24 * 4;
constexpr size_t R_XG    = R_XR + (size_t)NTOK * 512 * 2;
constexpr size_t R_VST   = R_XG + (size_t)NTOK * 512 * 2;
constexpr size_t R_VWT   = R_VST + KVT;
constexpr size_t R_KCB   = R_VWT + KVT;
constexpr size_t R_VCT   = R_KCB + (size_t)8 * 256 * 64 * 2;
constexpr size_t R_END13 = R_VCT + (size_t)8 * 256 * 64 * 2;
constexpr size_t R_H1B   = WS_R;
constexpr size_t R_EXP   = R_H1B + (size_t)NTOK * DM * 2;
constexpr size_t R_GSM   = R_EXP + (size_t)NTOK * 128 * 4;
constexpr size_t R_COEF  = R_GSM + (size_t)NTOK * 128 * 4;
constexpr size_t R_BIG   = R_COEF + (size_t)NTOK * 128 * 4;
constexpr size_t WS_END  = (R_END13 > R_BIG + 64 * MB ? R_END13 : R_BIG + 64 * MB);
static_assert(WS_END <= 256 * MB, "workspace map exceeds 256 MiB");

DI float bf2f(bf16_t v) { return __uint_as_float((unsigned)v << 16); }
DI bf16_t f2bf(float x) { unsigned u = __float_as_uint(x); u += 0x7fffu + ((u >> 16) & 1u); return (bf16_t)(u >> 16); }
DI unsigned pack2bf(float lo, float hi) { return (unsigned)f2bf(lo) | ((unsigned)f2bf(hi) << 16); }
DI float gelu_tanh(float x) { const float u = 0.7978845608028654f * (x + 0.044715f * x * x * x); return 0.5f * x * (1.0f + tanhf(u)); }
DI float sigmoidf_(float x) { return 1.0f / (1.0f + __expf(-x)); }

__device__ const unsigned char REL_BUCKET_LUT[128] = {
0,1,2,3,4,5,6,7,8,9,10,11,12,13,14,15,16,16,16,17,17,18,18,18,19,19,19,20,20,20,20,21,21,21,21,22,22,22,22,22,23,23,23,23,23,23,24,24,24,24,24,24,25,25,25,25,25,25,25,26,26,26,26,26,26,26,26,27,27,27,27,27,27,27,27,27,27,28,28,28,28,28,28,28,28,28,28,29,29,29,29,29,29,29,29,29,29,29,29,30,30,30,30,30,30,30,30,30,30,30,30,30,30,31,31,31,31,31,31,31,31,31,31,31,31,31,31,31};
DI int rel_bucket(int dist) { dist = dist < 0 ? 0 : dist; return dist >= 128 ? 31 : (int)REL_BUCKET_LUT[dist]; }

struct Params {
    const float* in[31];
    float* out;
    unsigned char* ws;
};
enum { I_X = 0, I_P, I_ATTN_NORM, I_W_IN, I_CK_PE, I_CK_W1, I_CK_W2, I_CV_PE, I_CV_W1, I_CV_W2, I_REL, I_CONV_W, I_CONV_B, I_LRU_WA, I_LRU_BA, I_LRU_WX, I_LRU_BX,
       I_LRU_LAM, I_GN_ATTN, I_GN_LRU, I_W_OUT, I_FFN_NORM, I_PEER_WQ, I_PEER_SUB, I_PEER_U, I_PEER_V, I_PLE_NORM, I_PLE_WG, I_PLE_BG, I_PLE_PROJ, I_FINAL_NORM };

struct EpiProj {
    static constexpr bool HAS8 = true;
    const float* rs0; bf16_t* qb; bf16_t* kv0; float* gates; bf16_t* xr; bf16_t* xg;
    DI void store8(int row, int col, f32x4 v0, f32x4 v1) const {
        const float s = rs0[row];
        v0 *= s; v1 *= s;
        if (col < PC_KV) { const float qs = 0.125f * 1.4426950408889634f;
            v0 *= qs; v1 *= qs;
            u32x4 w; w.x = pack2bf(v0[0], v0[1]); w.y = pack2bf(v0[2], v0[3]); w.z = pack2bf(v1[0], v1[1]); w.w = pack2bf(v1[2], v1[3]); *(u32x4*)(qb + (size_t)row * 512 + col) = w; }
        else if (col < PC_XR) {
            const int c = col - PC_KV, tensor = c >> 7, within = c & 127, kvh = within >> 6, d = within & 63, b = row >> 12, t = row & 4095;
            bf16_t* dst = (bf16_t*)((unsigned char*)kv0 + (size_t)tensor * KVT) + ((size_t)(b * NKV + kvh) * T_ + t) * HD + d;
            u32x4 w; w.x = pack2bf(v0[0], v0[1]); w.y = pack2bf(v0[2], v0[3]); w.z = pack2bf(v1[0], v1[1]); w.w = pack2bf(v1[2], v1[3]); *(u32x4*)dst = w;
        }
        else if (col < PC_XG) { u32x4 w; w.x = pack2bf(v0[0], v0[1]); w.y = pack2bf(v0[2], v0[3]); w.z = pack2bf(v1[0], v1[1]); w.w = pack2bf(v1[2], v1[3]); *(u32x4*)(xr + (size_t)row * 512 + (col - PC_XR)) = w; }
        else if (col < PC_GATE) { u32x4 w; w.x = pack2bf(v0[0], v0[1]); w.y = pack2bf(v0[2], v0[3]); w.z = pack2bf(v1[0], v1[1]); w.w = pack2bf(v1[2], v1[3]); *(u32x4*)(xg + (size_t)row * 512 + (col - PC_XG)) = w; }
        else if (col < PC_GATE + 24) { float* g = gates + (size_t)row * 24 + (col - PC_GATE); *(f32x4*)g = v0; *(f32x4*)(g + 4) = v1; }
    }
};
struct EpiOut {
    const float* x; float* h1; bf16_t* h1b;
    DI void store4(int row, int col, f32x4 v) const {
        const size_t o = (size_t)row * DM + col;
        v += *(const f32x4*)(x + o);
        *(f32x4*)(h1 + o) = v;
        u32x2 w; w.x = pack2bf(v[0], v[1]); w.y = pack2bf(v[2], v[3]); *(u32x2*)(h1b + o) = w;
    }
};
struct EpiF32Plain { float* C; int ldc; int coloff;
    DI void store4(int row, int col, f32x4 v) const { *(f32x4*)(C + (size_t)row * ldc + (col - coloff)) = v; } };
struct EpiGate {
    const float* rs2; const float* bias; const float* pp; float* h;
    DI void store4(int row, int col, f32x4 v) const {
        const size_t o = (size_t)row * DM + col;
        const float s = rs2[row];
        const f32x4 bb = *(const f32x4*)(bias + col), p4 = *(const f32x4*)(pp + o);
        f32x4 hv = *(f32x4*)(h + o);
#pragma unroll
        for (int j = 0; j < 4; ++j) hv[j] += sigmoidf_(v[j] * s + bb[j]) * p4[j];
        *(f32x4*)(h + o) = hv;
    }
};
#ifndef LRU_NAIVE
#define LRU_NAIVE 0
#endif
#ifndef CMP_NAIVE
#define CMP_NAIVE 0
#endif
#ifndef OPT_MASK
#define OPT_MASK 0x1FF
#endif
#ifndef PEER_V6
#define PEER_V6 5
#endif
#ifndef PEER_V3
#define PEER_V3 1
#endif
#ifndef PEER_V2
#define PEER_V2 1
#endif
#ifndef XCC_HW
#define XCC_HW 0
#endif
#ifndef PEER_FP4
#define PEER_FP4 0
#endif
#ifndef PEER_I8U
#define PEER_I8U 1
#endif
#ifndef PEER_V4EXP
#define PEER_V4EXP 1
#endif
#ifndef PEER_FUSED
#define PEER_FUSED 1
#endif
DI float wave_sum(float v) {
#pragma unroll
    for (int o = 32; o > 0; o >>= 1) v += __shfl_xor(v, o);
    return v;
}
DI float wave_max(float v) {
#pragma unroll
    for (int o = 32; o > 0; o >>= 1) v = fmaxf(v, __shfl_xor(v, o));
    return v;
}
DI float block_sum256(float v, float* red) {
    v = wave_sum(v); __syncthreads();
    if ((threadIdx.x & 63) == 0) red[threadIdx.x >> 6] = v; __syncthreads();
    return (red[0] + red[1]) + (red[2] + red[3]);
}
DI float block_max256(float v, float* red) {
    v = wave_max(v); __syncthreads();
    if ((threadIdx.x & 63) == 0) red[threadIdx.x >> 6] = v; __syncthreads();
    return fmaxf(fmaxf(red[0], red[1]), fmaxf(red[2], red[3]));
}

#define XB_TMO      128
#define XB_XCNT(j)  (256  + 64 * (j))
#define XB_XSUB(j)  (1280 + 64 * (j))
#define XB_XGEN(j)  (2304 + 64 * (j))
#define XB_TOP      3328
#define XB_TOPGEN   3392
#define XCD_BAR_WORDS 3456
#define XB_SPIN_CAP (1u << 18)
#define LAS __attribute__((address_space(3)))

__device__ __forceinline__ unsigned xb_ld(unsigned* p)              { return __hip_atomic_load(p, __ATOMIC_RELAXED, __HIP_MEMORY_SCOPE_AGENT); }
__device__ __forceinline__ unsigned xb_add(unsigned* p, unsigned v) { return __hip_atomic_fetch_add(p, v, __ATOMIC_RELAXED, __HIP_MEMORY_SCOPE_AGENT); }
__device__ __forceinline__ unsigned xb_xcc_id() { return (unsigned)__builtin_amdgcn_s_getreg((3 << 11) | 20) & 0xFu; }
#define XB_SPIN(cond, bar) do { unsigned _sp = 0; while (cond) { __builtin_amdgcn_s_sleep(1); \
    if ((++_sp & 255u) == 0u) { if (xb_ld(&(bar)[XB_TMO])) break; if (_sp > XB_SPIN_CAP) { atomicAdd(&(bar)[XB_TMO], 1u); break; } } } } while (0)

struct XcdBarrier {
    unsigned* bar; unsigned x;
    volatile LAS unsigned* st;
};

__device__ __forceinline__ XcdBarrier xcd_barrier_post(unsigned* bar, volatile LAS unsigned* st) {
    XcdBarrier b; b.bar = bar; b.x = xb_xcc_id(); b.st = st;
    if (threadIdx.x == 0) (void)xb_add(&bar[XB_XCNT(b.x)], 1u);
    return b;
}
__device__ __forceinline__ void xcd_barrier_complete(unsigned* bar, unsigned x, unsigned& nloc, unsigned& nx) {
    const unsigned G = gridDim.x * gridDim.y * gridDim.z;
    unsigned sum, cnt, mine, sp = 0u;
    for (;;) {
        sum = 0u; cnt = 0u; mine = 0u;
#pragma unroll
        for (unsigned j = 0; j < 16; ++j) { const unsigned c = xb_ld(&bar[XB_XCNT(j)]); sum += c; cnt += (c > 0u) ? 1u : 0u; mine = (j == x) ? c : mine; }
        if (sum == G) break;
        __builtin_amdgcn_s_sleep(1);
        if ((++sp & 255u) == 0u) { if (xb_ld(&bar[XB_TMO])) break; if (sp > XB_SPIN_CAP) { atomicAdd(&bar[XB_TMO], 1u); break; } }
    }
    nloc = mine > 0u ? mine : 1u; nx = cnt > 0u ? cnt : 1u;
}

__device__ __forceinline__ void xcd_barrier(const XcdBarrier& b) {
    asm volatile("s_waitcnt vmcnt(0)" ::: "memory");
    __syncthreads();
    if (threadIdx.x == 0) {
        unsigned* bar = b.bar;
        __builtin_amdgcn_s_waitcnt(0);
        unsigned nloc = b.st[0], nx = b.st[1];
        if (nloc == 0u) { xcd_barrier_complete(bar, b.x, nloc, nx); b.st[0] = nloc; b.st[1] = nx; }
        const unsigned old = xb_add(&bar[XB_XSUB(b.x)], 1u);
        const unsigned gen = old / nloc;
        if (old + 1u == (gen + 1u) * nloc) {
            __builtin_amdgcn_fence(__ATOMIC_RELEASE, "agent");
            asm volatile("s_waitcnt vmcnt(0)" ::: "memory");
            const unsigned og = xb_add(&bar[XB_TOP], 1u);
            const unsigned tg = og / nx;
            if (og + 1u == (tg + 1u) * nx) xb_add(&bar[XB_TOPGEN], 1u);
            else XB_SPIN(xb_ld(&bar[XB_TOPGEN]) == tg, bar);
            __builtin_amdgcn_fence(__ATOMIC_ACQUIRE, "agent");
            xb_add(&bar[XB_XGEN(b.x)], 1u);
            asm volatile("s_waitcnt vmcnt(0)" ::: "memory");
        } else {
            XB_SPIN(xb_ld(&bar[XB_XGEN(b.x)]) == gen, bar);
            __builtin_amdgcn_fence(__ATOMIC_ACQUIRE, "agent");
            asm volatile("s_waitcnt vmcnt(0)" ::: "memory");
        }
    }
    __syncthreads();
}


namespace pg8 {
#define PG8_LAS __attribute__((address_space(3)))
typedef short bf16x8 __attribute__((ext_vector_type(8)));
constexpr int BM = 256, BK = 64, HALF = 128, HTB = HALF * BK * 2  , STAGE_BYTES = 8 * HTB, NXCD = 8, WGM = 8;

__host__ __device__ __forceinline__ int lds_byte(int r, int c) { const int st = (r >> 4) * 2 + (c >> 5), rr = r & 15, cc = c & 31, ob = rr * 64 + cc * 2; return st * 1024 + (ob ^ (((ob >> 9) & 1) << 5)); }
__host__ __device__ __forceinline__ void stage_rc(int b, int& R, int& C) { const int st = b / 1024, sb = b % 1024, swz = sb ^ (((sb >> 9) & 1) << 5); R = (st >> 1) * 16 + swz / 64; C = (st & 1) * 32 + (swz % 64) / 2; }
__host__ __device__ __forceinline__ int perm32(int rho) { const int n = rho >> 4, i = rho & 15; return 8 * (i >> 2) + 4 * n + (i & 3); }

struct Unit { int pm, pn; };
struct Gemm { const bf16_t* A; const bf16_t* Bt; int M, N, K; };

struct StaticOrder {
    int nM, nN, nwg, G, c;
    __host__ __device__ void init(int M, int N, int G_, int c_) { nM = M / BM; nN = N / BM; nwg = nM * nN; G = G_; c = c_; }
    __host__ __device__ bool next(int i, Unit& u) const {
        const long L = (long)i * G + c; if (L >= nwg) return false;
        int wgid = (int)L; { const int q = nwg / NXCD, r = nwg % NXCD, xcd = wgid % NXCD, off = wgid / NXCD; wgid = (xcd < r ? xcd * (q + 1) : r * (q + 1) + (xcd - r) * q) + off; }
        const int nig = WGM * nN, gid = wgid / nig, fm = gid * WGM, gsz = (nM - fm) < WGM ? (nM - fm) : WGM;
        u.pm = fm + ((wgid % nig) % gsz); u.pn = (wgid % nig) / gsz; return true;
    }
    __device__ __forceinline__ void a_ready(const Unit&) const {}
    __device__ __forceinline__ void done(const Unit&) const {}
};
template <class Epi, class Sched, bool STAMP = false>
__device__ __forceinline__ void gemm_phase(PG8_LAS unsigned char* lds, const Gemm g, const Sched& S, const Epi& E, unsigned long long* stamps) {
    int tid_ = threadIdx.x; asm volatile("" : "+v"(tid_));
    const int tid = tid_, wid = __builtin_amdgcn_readfirstlane(tid >> 6), lane = tid & 63, wr = wid >> 2, wc = wid & 3, fr = lane & 15, fq = lane >> 4;
    const int K = g.K, nt = K / BK;
    int ts_lo = 0, ts_hi = 0, nts = 0; const unsigned long long rt_entry = STAMP ? (unsigned long long)wall_clock64() : 0ull;
#define PG8_STAMP() do { if (STAMP && wid == 0 && nts < 64) { const unsigned long long _c = (unsigned long long)clock64(); \
        ts_lo = (lane == nts) ? (int)(unsigned)_c : ts_lo; ts_hi = (lane == nts) ? (int)(unsigned)(_c >> 32) : ts_hi; ++nts; } } while (0)
    PG8_STAMP();
    unsigned voffA[2], voffB[2];
#pragma unroll
    for (int i = 0; i < 2; ++i) { int R, C; stage_rc(tid * 16 + i * 8192, R, C); const int Rb = Epi::PERM ? ((R & ~31) + perm32(R & 31)) : R;
        voffA[i] = (unsigned)(R * K + C) * 2u; voffB[i] = (unsigned)(Rb * K + C) * 2u; }
    const size_t kstep = (size_t)(BK * 2);
    const size_t hstep = (size_t)HALF * K * 2;
    const size_t tstep = 2 * hstep;
    const unsigned ldsw = (unsigned)wid * 1024u;
    const int aoff = lds_byte(wr * 64 + fr, fq * 8), boff = lds_byte(wc * 32 + fr, fq * 8);
#define PG8_SA(b, h) (((b) * 2 + (h)) * HTB)
#define PG8_SB(b, h) ((4 + (b) * 2 + (h)) * HTB)
#define PG8_STAGE(bufoff, gbase, voff) do { _Pragma("unroll") for (int _i = 0; _i < 2; ++_i) \
        __builtin_amdgcn_global_load_lds((const unsigned*)((const char*)(gbase) + (voff)[_i]), (PG8_LAS unsigned*)(lds + (bufoff) + ldsw + _i * 8192), 16, 0, 0); } while (0)
#define PG8_LDA(dst, b, h) do { _Pragma("unroll") for (int m = 0; m < 4; ++m) _Pragma("unroll") for (int k = 0; k < 2; ++k) dst[m][k] = *(const PG8_LAS bf16x8*)(lds + PG8_SA(b, h) + aoff + m * 2048 + k * 1024); } while (0)
#define PG8_LDB(dst, b, h) do { _Pragma("unroll") for (int n = 0; n < 2; ++n) _Pragma("unroll") for (int k = 0; k < 2; ++k) dst[n][k] = *(const PG8_LAS bf16x8*)(lds + PG8_SB(b, h) + boff + n * 2048 + k * 1024); } while (0)
#define PG8_MMA(ai, bj, At, Bt) do { __builtin_amdgcn_s_setprio(1); _Pragma("unroll") for (int m = 0; m < 4; ++m) _Pragma("unroll") for (int n = 0; n < 2; ++n) _Pragma("unroll") for (int k = 0; k < 2; ++k) \
        acc[ai][bj][m][n] = __builtin_amdgcn_mfma_f32_16x16x32_bf16(Bt[n][k], At[m][k], acc[ai][bj][m][n], 0, 0, 0); __builtin_amdgcn_s_setprio(0); } while (0)
#define PG8_WAIT_V(n) asm volatile("s_waitcnt vmcnt(" #n ")" ::: "memory")
#define PG8_WAIT_L(n) asm volatile("s_waitcnt lgkmcnt(" #n ")" ::: "memory")
#define PG8_BAR __builtin_amdgcn_s_barrier()
#define PG8_SCHED __builtin_amdgcn_sched_barrier(0)
    Unit cur, nxt; int ui = 0;
    if (!S.next(0, cur)) return;
    f32x4 acc[2][2][4][2];
#pragma unroll
    for (int a = 0; a < 2; ++a)
#pragma unroll
        for (int b = 0; b < 2; ++b)
#pragma unroll
            for (int m = 0; m < 4; ++m)
#pragma unroll
                for (int n = 0; n < 2; ++n) acc[a][b][m][n] = (f32x4){0.f, 0.f, 0.f, 0.f};
    bf16x8 At[4][2], B0[2][2], B1[2][2];
    const char* cA = (const char*)g.A + (size_t)cur.pm * tstep; const char* cB = (const char*)g.Bt + (size_t)cur.pn * tstep;
    S.a_ready(cur);
    PG8_STAGE(PG8_SB(0, 0), cB, voffB); PG8_STAGE(PG8_SA(0, 0), cA, voffA); PG8_STAGE(PG8_SB(0, 1), cB + hstep, voffB); PG8_STAGE(PG8_SA(0, 1), cA + hstep, voffA);
    if (wr == 1) PG8_BAR;
    PG8_WAIT_V(4); PG8_BAR;
    PG8_STAGE(PG8_SB(1, 0), cB + kstep, voffB); PG8_STAGE(PG8_SA(1, 0), cA + kstep, voffA); PG8_STAGE(PG8_SB(1, 1), cB + hstep + kstep, voffB);
    PG8_WAIT_V(6); PG8_BAR;
    PG8_STAMP();
    for (;;) {
        const bool has_next = S.next(ui + 1, nxt);
        const char* nA = has_next ? (const char*)g.A + (size_t)nxt.pm * tstep : cA; const char* nB = has_next ? (const char*)g.Bt + (size_t)nxt.pn * tstep : cB;
        for (int t = 0; t < nt; t += 2) {
            const bool last = (t == nt - 2);
            const char* a1 = cA + (size_t)(t + 1) * kstep;
            const char* a2 = last ? nA : cA + (size_t)(t + 2) * kstep; const char* b2 = last ? nB : cB + (size_t)(t + 2) * kstep;
            const char* a3 = a2 + kstep; const char* b3 = b2 + kstep;
            if (last && has_next) S.a_ready(nxt);
            PG8_LDB(B0, 0, 0); PG8_SCHED; PG8_LDA(At, 0, 0); PG8_STAGE(PG8_SA(1, 1), a1 + hstep, voffA);
            PG8_WAIT_L(8); PG8_BAR; PG8_WAIT_L(0); PG8_MMA(0, 0, At, B0); PG8_BAR; PG8_SCHED;
            PG8_LDB(B1, 0, 1); PG8_STAGE(PG8_SB(0, 0), b2, voffB);
            PG8_BAR; PG8_WAIT_L(0); PG8_MMA(0, 1, At, B1); PG8_BAR;
            PG8_LDA(At, 0, 1); PG8_STAGE(PG8_SA(0, 0), a2, voffA);
            PG8_BAR; PG8_WAIT_L(0); PG8_MMA(1, 0, At, B0); PG8_BAR; PG8_SCHED;
            PG8_STAGE(PG8_SB(0, 1), b2 + hstep, voffB);
            PG8_WAIT_V(6); PG8_BAR; PG8_MMA(1, 1, At, B1); PG8_BAR;
            PG8_LDB(B0, 1, 0); PG8_SCHED; PG8_LDA(At, 1, 0); PG8_STAGE(PG8_SA(0, 1), a2 + hstep, voffA);
            PG8_WAIT_L(8); PG8_BAR; PG8_WAIT_L(0); PG8_MMA(0, 0, At, B0); PG8_BAR; PG8_SCHED;
            PG8_LDB(B1, 1, 1); PG8_STAGE(PG8_SB(1, 0), b3, voffB);
            PG8_BAR; PG8_WAIT_L(0); PG8_MMA(0, 1, At, B1); PG8_BAR;
            PG8_LDA(At, 1, 1); PG8_STAGE(PG8_SA(1, 0), a3, voffA);
            PG8_BAR; PG8_WAIT_L(0); PG8_MMA(1, 0, At, B0); PG8_BAR; PG8_SCHED;
            PG8_STAGE(PG8_SB(1, 1), b3 + hstep, voffB);
            PG8_WAIT_V(6); PG8_BAR; PG8_MMA(1, 1, At, B1); PG8_BAR;
        }
        PG8_STAMP();
        if constexpr (!Epi::AFTER_DRAIN) { E(acc, cur, wr, wc, fr, fq); S.done(cur); }
        PG8_STAMP();
        if (!has_next) break;
#pragma unroll
        for (int a = 0; a < 2; ++a)
#pragma unroll
            for (int b = 0; b < 2; ++b)
#pragma unroll
                for (int m = 0; m < 4; ++m)
#pragma unroll
                    for (int n = 0; n < 2; ++n) acc[a][b][m][n] = (f32x4){0.f, 0.f, 0.f, 0.f};
        cur = nxt; cA = nA; cB = nB; ++ui;
    }
    PG8_WAIT_V(0);
    if (wr == 0) PG8_BAR;
    PG8_BAR;
    if constexpr (Epi::AFTER_DRAIN) { E.fused(acc, cur, wr, wc, fr, fq, lds, wid, lane); S.done(cur); }
    PG8_STAMP();
    if (STAMP && wid == 0) { stamps[lane] = lane < nts ? (((unsigned long long)(unsigned)ts_hi << 32) | (unsigned)ts_lo) : 0ull;
        if (lane == 62) stamps[62] = rt_entry; if (lane == 63) stamps[63] = (unsigned long long)wall_clock64(); }
#undef PG8_STAMP
#undef PG8_SA
#undef PG8_SB
#undef PG8_STAGE
#undef PG8_LDA
#undef PG8_LDB
#undef PG8_MMA
#undef PG8_WAIT_V
#undef PG8_WAIT_L
#undef PG8_BAR
#undef PG8_SCHED
}
}
#define LAS3 __attribute__((address_space(3)))
constexpr int MK_THREADS = 512;
typedef __bf16 bf16x2_t __attribute__((ext_vector_type(2)));
DI float dot2bf(unsigned a, unsigned b, float c) { return __builtin_amdgcn_fdot2_f32_bf16(__builtin_bit_cast(bf16x2_t, a), __builtin_bit_cast(bf16x2_t, b), c, false); }
DI float bflo(unsigned v) { return __uint_as_float(v << 16); }
DI float bfhi(unsigned v) { return __uint_as_float(v & 0xffff0000u); }

template <class ColMap>
DI void transpose_tile(const float* __restrict__ src, int ldsrc, const float* __restrict__ gain, bf16_t* __restrict__ dst, int K, int k0, int n0, const ColMap& cm, LAS3 float* tl) {
    const int tid = threadIdx.x;
    __syncthreads();
    {
        const int n = tid & 63, sc = cm(n0 + n);
#pragma unroll
        for (int j = 0; j < 8; ++j) { const int k = (tid >> 6) + 8 * j; tl[k * 65 + n] = sc >= 0 ? src[(size_t)(k0 + k) * ldsrc + sc] * (gain ? gain[k0 + k] : 1.0f) : 0.f; }
    }
    __syncthreads();
    {
        const int n = tid >> 3, k8 = (tid & 7) * 8;
        u32x4 w;
        w.x = pack2bf(tl[(k8 + 0) * 65 + n], tl[(k8 + 1) * 65 + n]); w.y = pack2bf(tl[(k8 + 2) * 65 + n], tl[(k8 + 3) * 65 + n]);
        w.z = pack2bf(tl[(k8 + 4) * 65 + n], tl[(k8 + 5) * 65 + n]); w.w = pack2bf(tl[(k8 + 6) * 65 + n], tl[(k8 + 7) * 65 + n]);
        *(u32x4*)(dst + (size_t)(n0 + n) * K + k0 + k8) = w;
    }
}
struct ColId { DI int operator()(int n) const { return n; } };
struct ColWin { DI int operator()(int n) const { return n < PC_XR ? n : (n < PC_XG ? 1304 + (n - PC_XR) : (n < PC_GATE ? 1816 + (n - PC_XG) : (n < PC_GATE + 24 ? 1280 + (n - PC_GATE) : -1))); } };

DI void cvt_rows_bf16(const float* __restrict__ src, const float* __restrict__ gain, bf16_t* __restrict__ dst, size_t n8, int cols, size_t gtid, size_t nthr) {
    for (size_t i0 = gtid; i0 < n8; i0 += 8 * nthr) {
        f32x4 a[8], b[8];
#pragma unroll
        for (int u = 0; u < 8; ++u) { const size_t i = i0 + u * nthr; if (i < n8) { a[u] = *(const f32x4*)(src + i * 8); b[u] = *(const f32x4*)(src + i * 8 + 4); } }
#pragma unroll
        for (int u = 0; u < 8; ++u) { const size_t i = i0 + u * nthr; if (i < n8) {
            f32x4 x = a[u], y = b[u];
            if (gain) { const int c = (int)((i * 8) % cols); x *= *(const f32x4*)(gain + c); y *= *(const f32x4*)(gain + c + 4); }
            u32x4 w; w.x = pack2bf(x[0], x[1]); w.y = pack2bf(x[2], x[3]); w.z = pack2bf(y[0], y[1]); w.w = pack2bf(y[2], y[3]);
            *(u32x4*)(dst + i * 8) = w; } }
    }
}
DI void cvt_rows_fp8(const float* __restrict__ src, const float* __restrict__ gain, float scale, unsigned char* __restrict__ dst, size_t n8, int cols, size_t gtid, size_t nthr) {
    for (size_t i0 = gtid; i0 < n8; i0 += 8 * nthr) {
        f32x4 a[8], b[8];
#pragma unroll
        for (int u = 0; u < 8; ++u) { const size_t i = i0 + u * nthr; if (i < n8) { a[u] = *(const f32x4*)(src + i * 8); b[u] = *(const f32x4*)(src + i * 8 + 4); } }
#pragma unroll
        for (int u = 0; u < 8; ++u) { const size_t i = i0 + u * nthr; if (i < n8) {
            f32x4 x = a[u], y = b[u];
            if (gain) { const int c = (int)((i * 8) % cols); x *= *(const f32x4*)(gain + c); y *= *(const f32x4*)(gain + c + 4); }
            x *= scale; y *= scale;
            int w0 = 0, w1 = 0;
            w0 = __builtin_amdgcn_cvt_pk_fp8_f32(x[0], x[1], w0, false); w0 = __builtin_amdgcn_cvt_pk_fp8_f32(x[2], x[3], w0, true);
            w1 = __builtin_amdgcn_cvt_pk_fp8_f32(y[0], y[1], w1, false); w1 = __builtin_amdgcn_cvt_pk_fp8_f32(y[2], y[3], w1, true);
            *(u32x2*)(dst + i * 8) = (u32x2){(unsigned)w0, (unsigned)w1}; } }
    }
}
DI void cvt_rows_i8(const float* __restrict__ src, const float* __restrict__ gain, float scale, unsigned char* __restrict__ dst, size_t n8, int cols, size_t gtid, size_t nthr) {
    for (size_t i0 = gtid; i0 < n8; i0 += 8 * nthr) {
        f32x4 a[8], b[8];
#pragma unroll
        for (int u = 0; u < 8; ++u) { const size_t i = i0 + u * nthr; if (i < n8) { a[u] = *(const f32x4*)(src + i * 8); b[u] = *(const f32x4*)(src + i * 8 + 4); } }
#pragma unroll
        for (int u = 0; u < 8; ++u) { const size_t i = i0 + u * nthr; if (i < n8) {
            f32x4 x = a[u], y = b[u];
            if (gain) { const int c = (int)((i * 8) % cols); x *= *(const f32x4*)(gain + c); y *= *(const f32x4*)(gain + c + 4); }
            unsigned w0 = 0u, w1 = 0u;
#pragma unroll
            for (int j = 0; j < 4; ++j) {
                const int qa = (int)rintf(fminf(fmaxf(x[j] * scale, -127.f), 127.f)), qb = (int)rintf(fminf(fmaxf(y[j] * scale, -127.f), 127.f));
                w0 |= ((unsigned)qa & 0xffu) << (8 * j); w1 |= ((unsigned)qb & 0xffu) << (8 * j);
            }
            *(u32x2*)(dst + i * 8) = (u32x2){w0, w1}; } }
    }
}
DI void cvt_rows_fp4(const float* __restrict__ src, const float* __restrict__ gain, float scale, unsigned char* __restrict__ dst, size_t n8, int cols, size_t gtid, size_t nthr) {
    for (size_t i0 = gtid; i0 < n8; i0 += 8 * nthr) {
        f32x4 a[8], b[8];
#pragma unroll
        for (int u = 0; u < 8; ++u) { const size_t i = i0 + u * nthr; if (i < n8) { a[u] = *(const f32x4*)(src + i * 8); b[u] = *(const f32x4*)(src + i * 8 + 4); } }
#pragma unroll
        for (int u = 0; u < 8; ++u) { const size_t i = i0 + u * nthr; if (i < n8) {
            f32x4 x = a[u], y = b[u];
            if (gain) { const int c = (int)((i * 8) % cols); x *= *(const f32x4*)(gain + c); y *= *(const f32x4*)(gain + c + 4); }
            x *= scale; y *= scale;
            unsigned w = 0u;
            w = __builtin_amdgcn_cvt_scalef32_pk_fp4_f32(w, x[0], x[1], 1.0f, 0); w = __builtin_amdgcn_cvt_scalef32_pk_fp4_f32(w, x[2], x[3], 1.0f, 1);
            w = __builtin_amdgcn_cvt_scalef32_pk_fp4_f32(w, y[0], y[1], 1.0f, 2); w = __builtin_amdgcn_cvt_scalef32_pk_fp4_f32(w, y[2], y[3], 1.0f, 3);
            *(unsigned*)(dst + i * 4) = w; } }
    }
}
DI void p0_prologue(const Params& p, LAS3 unsigned char* lds, int G) {
    unsigned char* ws = p.ws;
    const int tid = threadIdx.x, lane = tid & 63, wid = tid >> 6, bid = blockIdx.x;
    const size_t gtid = (size_t)bid * MK_THREADS + tid, nthr = (size_t)G * MK_THREADS;
    const int gw = bid * 8 + wid, nw = G * 8;
    {
        const float* x = p.in[I_X]; bf16_t* xb = (bf16_t*)(ws + WS_XB); float* rs0 = (float*)(ws + WS_RS0);
        for (int row0 = gw; row0 < NTOK; row0 += 4 * nw) {
            f32x4 v[4][4];
#pragma unroll
            for (int u = 0; u < 4; ++u) { const int row = row0 + u * nw; if (row < NTOK) {
#pragma unroll
                for (int j = 0; j < 4; ++j) v[u][j] = *(const f32x4*)(x + (size_t)row * DM + j * 256 + lane * 4); } }
#pragma unroll
            for (int u = 0; u < 4; ++u) { const int row = row0 + u * nw; if (row < NTOK) {
                float s = 0.f;
#pragma unroll
                for (int j = 0; j < 4; ++j) s += (v[u][j][0] * v[u][j][0] + v[u][j][1] * v[u][j][1]) + (v[u][j][2] * v[u][j][2] + v[u][j][3] * v[u][j][3]);
                s = wave_sum(s);
#pragma unroll
                for (int j = 0; j < 4; ++j) { u32x2 w; w.x = pack2bf(v[u][j][0], v[u][j][1]); w.y = pack2bf(v[u][j][2], v[u][j][3]); *(u32x2*)(xb + (size_t)row * DM + j * 256 + lane * 4) = w; }
                if (lane == 0) rs0[row] = rsqrtf(s * (1.0f / DM) + EPS); } }
        }
    }
#if PEER_FP4
    cvt_rows_fp4(p.in[I_PEER_U], p.in[I_FFN_NORM], 64.0f, (unsigned char*)(ws + WS_UB), (size_t)16384 * DM / 8, DM, gtid, nthr);
    cvt_rows_fp4(p.in[I_PEER_V], nullptr, 6.0f, (unsigned char*)(ws + WS_VB), (size_t)16384 * DM / 8, DM, gtid, nthr);
#elif PEER_I8U
    cvt_rows_i8(p.in[I_PEER_U], p.in[I_FFN_NORM], 640.0f, (unsigned char*)(ws + WS_UB), (size_t)16384 * DM / 8, DM, gtid, nthr);
#if PEER_V4EXP
    cvt_rows_fp4(p.in[I_PEER_V], nullptr, 8.0f, (unsigned char*)(ws + WS_VB), (size_t)16384 * DM / 8, DM, gtid, nthr);
#else
    cvt_rows_fp8(p.in[I_PEER_V], nullptr, 8.0f, (unsigned char*)(ws + WS_VB), (size_t)16384 * DM / 8, DM, gtid, nthr);
#endif
#elif PEER_V3
    cvt_rows_fp8(p.in[I_PEER_U], p.in[I_FFN_NORM], 32.0f, (unsigned char*)(ws + WS_UB), (size_t)16384 * DM / 8, DM, gtid, nthr);
    cvt_rows_fp8(p.in[I_PEER_V], nullptr, 8.0f, (unsigned char*)(ws + WS_VB), (size_t)16384 * DM / 8, DM, gtid, nthr);
#else
    cvt_rows_bf16(p.in[I_PEER_U], p.in[I_FFN_NORM], (bf16_t*)(ws + WS_UB), (size_t)16384 * DM / 8, DM, gtid, nthr);
    cvt_rows_bf16(p.in[I_PEER_V], nullptr, (bf16_t*)(ws + WS_VB), (size_t)16384 * DM / 8, DM, gtid, nthr);
#endif
    cvt_rows_bf16(p.in[I_P], nullptr, (bf16_t*)(ws + WS_PB), (size_t)NTOK * PLE / 8, PLE, gtid, nthr);
    LAS3 float* tl = (LAS3 float*)lds;
    {
        for (int u = bid; u < 1496; u += G) {
            if (u < 640) transpose_tile(p.in[I_W_IN], INCOLS, p.in[I_ATTN_NORM], (bf16_t*)(ws + WS_WIN), DM, (u % 16) * 64, (u / 16) * 64, ColWin{}, tl);
            else if (u < 896) { const int v = u - 640; transpose_tile(p.in[I_W_OUT], DM, nullptr, (bf16_t*)(ws + WS_WOUT), DM, (v % 16) * 64, (v / 16) * 64, ColId{}, tl); }
            else if (u < 1152) { const int v = u - 896; transpose_tile(p.in[I_PLE_WG], DM, p.in[I_PLE_NORM], (bf16_t*)(ws + WS_WG), DM, (v % 16) * 64, (v / 16) * 64, ColId{}, tl); }
            else if (u < 1216) { const int v = u - 1152; transpose_tile(p.in[I_PLE_PROJ], DM, nullptr, (bf16_t*)(ws + WS_WP), PLE, (v % 4) * 64, (v / 4) * 64, ColId{}, tl); }
            else if (u < 1344) { const int v = u - 1216; transpose_tile(p.in[I_CK_W1], 256, nullptr, (bf16_t*)(ws + WS_CW1K), 2048, (v % 32) * 64, (v / 32) * 64, ColId{}, tl); }
            else if (u < 1472) { const int v = u - 1344; transpose_tile(p.in[I_CV_W1], 256, nullptr, (bf16_t*)(ws + WS_CW1V), 2048, (v % 32) * 64, (v / 32) * 64, ColId{}, tl); }
            else if (u < 1480) { const int v = u - 1472; transpose_tile(p.in[I_LRU_WA] + v * 4096, 64, nullptr, (bf16_t*)(ws + WS_WAT) + v * 4096, 64, 0, 0, ColId{}, tl); }
            else if (u < 1488) { const int v = u - 1480; transpose_tile(p.in[I_LRU_WX] + v * 4096, 64, nullptr, (bf16_t*)(ws + WS_WXT) + v * 4096, 64, 0, 0, ColId{}, tl); }
            else if (u < 1492) { const int v = u - 1488; transpose_tile(p.in[I_CK_W2], 64, nullptr, (bf16_t*)(ws + WS_CW2K), 256, v * 64, 0, ColId{}, tl); }
            else { const int v = u - 1492; transpose_tile(p.in[I_CV_W2], 64, nullptr, (bf16_t*)(ws + WS_CW2V), 256, v * 64, 0, ColId{}, tl); }
        }
        __syncthreads();
    }
    {
        LAS3 float* wt = (LAS3 float*)lds;
        LAS3 float* st = (LAS3 float*)(lds + 32768);
        const float* wq = p.in[I_PEER_WQ]; const float* sub = p.in[I_PEER_SUB]; const float* gain = p.in[I_FFN_NORM]; bf16_t* WqsT = (bf16_t*)(ws + WS_WQS);
        for (int u = bid; u < 256; u += G) {
            const int hp = u >> 4, d0 = (u & 15) * 64, pp = hp & 1;
            __syncthreads();
            {
                f32x4 wv[4], sv[8];
#pragma unroll
                for (int u = 0; u < 4; ++u) { const int i = tid + u * MK_THREADS, d = i >> 5, dk4 = (i & 31) * 4; wv[u] = *(const f32x4*)(wq + (size_t)(d0 + d) * 2048 + hp * 128 + dk4); }
#pragma unroll
                for (int u = 0; u < 8; ++u) { const int i = tid + u * MK_THREADS, kk = i >> 5, dk4 = (i & 31) * 4; sv[u] = *(const f32x4*)(sub + ((size_t)pp * 128 + kk) * 128 + dk4); }
#pragma unroll
                for (int u = 0; u < 4; ++u) { const int i = tid + u * MK_THREADS, d = i >> 5, dk4 = (i & 31) * 4;
#pragma unroll
                    for (int j = 0; j < 4; ++j) wt[(dk4 + j) * 64 + d] = wv[u][j]; }
#pragma unroll
                for (int u = 0; u < 8; ++u) { const int i = tid + u * MK_THREADS, kk = i >> 5, dk4 = (i & 31) * 4;
#pragma unroll
                    for (int j = 0; j < 4; ++j) st[kk * 129 + dk4 + j] = sv[u][j]; }
            }
            __syncthreads();
            const int kk = tid & 127, dg = (tid >> 7) * 16;
            float acc[16];
#pragma unroll
            for (int j = 0; j < 16; ++j) acc[j] = 0.f;
            for (int dk = 0; dk < 128; ++dk) {
                const float sv = st[kk * 129 + dk];
#pragma unroll
                for (int j4 = 0; j4 < 4; ++j4) { const f32x4 w4 = *(LAS3 f32x4*)(wt + dk * 64 + dg + j4 * 4);
#pragma unroll
                    for (int j = 0; j < 4; ++j) acc[j4 * 4 + j] += sv * w4[j]; }
            }
            u32x4 o0, o1;
#define GQ(j) (acc[j] * gain[d0 + dg + (j)])
            o0.x = pack2bf(GQ(0), GQ(1)); o0.y = pack2bf(GQ(2), GQ(3)); o0.z = pack2bf(GQ(4), GQ(5)); o0.w = pack2bf(GQ(6), GQ(7));
            o1.x = pack2bf(GQ(8), GQ(9)); o1.y = pack2bf(GQ(10), GQ(11)); o1.z = pack2bf(GQ(12), GQ(13)); o1.w = pack2bf(GQ(14), GQ(15));
#undef GQ
            bf16_t* dst = WqsT + (size_t)(hp * 128 + kk) * DM + d0 + dg;
            *(u32x4*)dst = o0; *(u32x4*)(dst + 8) = o1;
        }
        __syncthreads();
    }
    for (int o = gw; o < 512; o += nw) {
        const int kv = o >> 8, j = o & 255;
        const float* pe = p.in[kv ? I_CV_PE : I_CK_PE]; const float* w1 = p.in[kv ? I_CV_W1 : I_CK_W1];
        float acc = 0.f;
        for (int k = lane; k < 2048; k += 64) acc += pe[k] * w1[(size_t)k * 256 + j];
        acc = wave_sum(acc);
        if (lane == 0) ((float*)(ws + (kv ? WS_CBV : WS_CBK)))[j] = acc;
    }
}

DI void p6_peer_apply(const Params& p, int G) {
    unsigned char* ws = p.ws;
    const int tid = threadIdx.x, lane = tid & 63, wid = tid >> 6;
    const int gw = blockIdx.x * 8 + wid, nw = G * 8;
    const bf16_t* ub = (const bf16_t*)(ws + WS_UB); const bf16_t* vb = (const bf16_t*)(ws + WS_VB);
    const int* eidx = (const int*)(ws + R_EXP); const float* gsm = (const float*)(ws + R_GSM); const float* ssq1 = (const float*)(ws + WS_SSQ1);
    float* h = p.out; bf16_t* hb = (bf16_t*)(ws + R_H1B); float* rs2 = (float*)(ws + WS_RS2);
    for (int tok = gw; tok < NTOK; tok += nw) {
        float sq = lane < 16 ? ssq1[(size_t)lane * NTOK + tok] : 0.f;
        sq = wave_sum(sq);
        const float rs1 = rsqrtf(sq * (1.0f / DM) + EPS);
        const u32x4 xa = *(const u32x4*)(hb + (size_t)tok * DM + lane * 8), xc = *(const u32x4*)(hb + (size_t)tok * DM + 512 + lane * 8);
        const int e0 = eidx[(size_t)tok * 128 + lane], e1 = eidx[(size_t)tok * 128 + 64 + lane];
        const float g0 = gsm[(size_t)tok * 128 + lane], g1 = gsm[(size_t)tok * 128 + 64 + lane];
        float coef0 = 0.f, coef1 = 0.f;
#pragma unroll
        for (int half = 0; half < 2; ++half) {
            const int ev = half ? e1 : e0;
            float part[64];
#pragma unroll
            for (int j = 0; j < 64; ++j) {
                const int e = __builtin_amdgcn_readlane(ev, j);
                const bf16_t* ur = ub + (size_t)e * DM + lane * 8;
                const u32x4 ua = *(const u32x4*)ur, uc = *(const u32x4*)(ur + 512);
                float a = dot2bf(xa.x, ua.x, 0.f); a = dot2bf(xa.y, ua.y, a); a = dot2bf(xa.z, ua.z, a); a = dot2bf(xa.w, ua.w, a);
                a = dot2bf(xc.x, uc.x, a); a = dot2bf(xc.y, uc.y, a); a = dot2bf(xc.z, uc.z, a); a = dot2bf(xc.w, uc.w, a);
                part[j] = a;
            }
#pragma unroll
            for (int m = 32; m >= 1; m >>= 1) {
                const bool up = (lane & m) != 0;
#pragma unroll
                for (int i = 0; i < m; ++i) {
                    const float send = up ? part[i] : part[i + m];
                    const float keep = up ? part[i + m] : part[i];
                    part[i] = keep + __shfl_xor(send, m);
                }
            }
            const float act = gelu_tanh(part[0] * rs1);
            if (half) coef1 = g1 * act; else coef0 = g0 * act;
        }
        float acc[16];
#pragma unroll
        for (int i = 0; i < 16; ++i) acc[i] = 0.f;
#pragma unroll
        for (int half = 0; half < 2; ++half) {
            const int ev = half ? e1 : e0; const float cv = half ? coef1 : coef0;
#pragma unroll 16
            for (int j = 0; j < 64; ++j) {
                const int e = __builtin_amdgcn_readlane(ev, j);
                const float c = __uint_as_float(__builtin_amdgcn_readlane(__float_as_uint(cv), j));
                const bf16_t* vr = vb + (size_t)e * DM + lane * 8;
                const u32x4 va = *(const u32x4*)vr, vc = *(const u32x4*)(vr + 512);
                acc[0] += c * bflo(va.x); acc[1] += c * bfhi(va.x); acc[2] += c * bflo(va.y); acc[3] += c * bfhi(va.y);
                acc[4] += c * bflo(va.z); acc[5] += c * bfhi(va.z); acc[6] += c * bflo(va.w); acc[7] += c * bfhi(va.w);
                acc[8] += c * bflo(vc.x); acc[9] += c * bfhi(vc.x); acc[10] += c * bflo(vc.y); acc[11] += c * bfhi(vc.y);
                acc[12] += c * bflo(vc.z); acc[13] += c * bfhi(vc.z); acc[14] += c * bflo(vc.w); acc[15] += c * bfhi(vc.w);
            }
        }
        float* hr = h + (size_t)tok * DM + lane * 8;
        f32x4 h0 = *(f32x4*)hr, h1 = *(f32x4*)(hr + 4), h2 = *(f32x4*)(hr + 512), h3 = *(f32x4*)(hr + 516);
        h0 += (f32x4){acc[0], acc[1], acc[2], acc[3]}; h1 += (f32x4){acc[4], acc[5], acc[6], acc[7]};
        h2 += (f32x4){acc[8], acc[9], acc[10], acc[11]}; h3 += (f32x4){acc[12], acc[13], acc[14], acc[15]};
        *(f32x4*)hr = h0; *(f32x4*)(hr + 4) = h1; *(f32x4*)(hr + 512) = h2; *(f32x4*)(hr + 516) = h3;
        u32x4 w0, w1;
        w0.x = pack2bf(h0[0], h0[1]); w0.y = pack2bf(h0[2], h0[3]); w0.z = pack2bf(h1[0], h1[1]); w0.w = pack2bf(h1[2], h1[3]);
        w1.x = pack2bf(h2[0], h2[1]); w1.y = pack2bf(h2[2], h2[3]); w1.z = pack2bf(h3[0], h3[1]); w1.w = pack2bf(h3[2], h3[3]);
        *(u32x4*)(hb + (size_t)tok * DM + lane * 8) = w0; *(u32x4*)(hb + (size_t)tok * DM + 512 + lane * 8) = w1;
        float s = 0.f;
#pragma unroll
        for (int j = 0; j < 4; ++j) s += h0[j] * h0[j] + h1[j] * h1[j] + h2[j] * h2[j] + h3[j] * h3[j];
        s = wave_sum(s);
        if (lane == 0) rs2[tok] = rsqrtf(s * (1.0f / DM) + EPS);
    }
}

DI void p8_final_norm(const Params& p, int G) {
    const int lane = threadIdx.x & 63, gw = blockIdx.x * 8 + (threadIdx.x >> 6), nw = G * 8;
    const float* ssq3 = (const float*)(p.ws + WS_SSQ3); const float* g = p.in[I_FINAL_NORM]; const bf16_t* h3 = (const bf16_t*)(p.ws + WS_XB); float* out = p.out;
    f32x4 gg[4];
    gg[0] = *(const f32x4*)(g + lane * 8); gg[1] = *(const f32x4*)(g + lane * 8 + 4); gg[2] = *(const f32x4*)(g + 512 + lane * 8); gg[3] = *(const f32x4*)(g + 512 + lane * 8 + 4);
    for (int row0 = gw; row0 < NTOK; row0 += 4 * nw) {
        u32x4 va[4], vb[4]; float sq[4];
#pragma unroll
        for (int u = 0; u < 4; ++u) { const int row = row0 + u * nw; if (row < NTOK) { sq[u] = lane < 16 ? ssq3[(size_t)lane * NTOK + row] : 0.f;
            va[u] = *(const u32x4*)(h3 + (size_t)row * DM + lane * 8); vb[u] = *(const u32x4*)(h3 + (size_t)row * DM + 512 + lane * 8); } }
#pragma unroll
        for (int u = 0; u < 4; ++u) { const int row = row0 + u * nw; if (row < NTOK) {
            const float rs = rsqrtf(wave_sum(sq[u]) * (1.0f / DM) + EPS);
            float* o = out + (size_t)row * DM + lane * 8;
            *(f32x4*)o = (f32x4){bflo(va[u].x), bfhi(va[u].x), bflo(va[u].y), bfhi(va[u].y)} * rs * gg[0];
            *(f32x4*)(o + 4) = (f32x4){bflo(va[u].z), bfhi(va[u].z), bflo(va[u].w), bfhi(va[u].w)} * rs * gg[1];
            *(f32x4*)(o + 512) = (f32x4){bflo(vb[u].x), bfhi(vb[u].x), bflo(vb[u].y), bfhi(vb[u].y)} * rs * gg[2];
            *(f32x4*)(o + 516) = (f32x4){bflo(vb[u].z), bfhi(vb[u].z), bflo(vb[u].w), bfhi(vb[u].w)} * rs * gg[3]; } }
    }
}
typedef float f32x16 __attribute__((ext_vector_type(16)));
typedef short bf16x8v __attribute__((ext_vector_type(8)));
typedef __bf16 bf16x2v_ __attribute__((ext_vector_type(2)));
DI unsigned pk_bf16(float lo, float hi) { return __builtin_bit_cast(unsigned, __builtin_convertvector((f32x2){lo, hi}, bf16x2v_)); }
constexpr float LOG2E = 1.4426950408889634f;
constexpr int AT_KROW = 144, AT_VROW = 136;
constexpr int AT_KT = 64 * AT_KROW, AT_VT = 64 * AT_VROW, AT_BUF = 2 * AT_KT + 2 * AT_VT;
constexpr int AT_VAL = 0;
constexpr int AT_LUT = 2 * AT_BUF;
constexpr int AT_IMP = AT_LUT + 8 * 128 * 4;
constexpr int AT_SEL = AT_IMP + 8 * 32 * 65 * 4;
constexpr int AT_SSQ = AT_SEL + 512;
constexpr int AT_END = AT_SSQ + 1024;
static_assert(AT_END <= 160 * 1024 - 256, "attention LDS map");

struct AtSrc { const bf16_t* k0; const bf16_t* k1; const bf16_t* v0; const bf16_t* v1; int vld; };
DI void at_load(const AtSrc& s, int kpos, int tid, u32x4 (&r)[4]) {
    const int row = tid >> 3, seg = tid & 7;
    r[0] = *(const u32x4*)(s.k0 + (size_t)(kpos + row) * HD + seg * 8);
    r[1] = *(const u32x4*)(s.k1 + (size_t)(kpos + row) * HD + seg * 8);
    r[2] = *(const u32x4*)(s.v0 + (size_t)row * s.vld + kpos + seg * 8);
    r[3] = *(const u32x4*)(s.v1 + (size_t)row * s.vld + kpos + seg * 8);
}
DI void at_store(LAS3 unsigned char* buf, int tid, const u32x4 (&r)[4]) {
    const int row = tid >> 3, seg = tid & 7;
    *(LAS3 u32x4*)(buf + row * AT_KROW + seg * 16) = r[0];
    *(LAS3 u32x4*)(buf + AT_KT + row * AT_KROW + seg * 16) = r[1];
    LAS3 unsigned char* v = buf + 2 * AT_KT + row * AT_VROW + seg * 16;
    *(LAS3 u32x2*)(v) = (u32x2){r[2].x, r[2].y}; *(LAS3 u32x2*)(v + 8) = (u32x2){r[2].z, r[2].w};
    *(LAS3 u32x2*)(v + AT_VT) = (u32x2){r[3].x, r[3].y}; *(LAS3 u32x2*)(v + AT_VT + 8) = (u32x2){r[3].z, r[3].w};
}

template <int MODE, int PASS, int APROBE>
DI void at_step(LAS3 const unsigned char* Kb, LAS3 const unsigned char* Vb, const bf16x8v (&Q)[4], int k0, int tq, int lane, LAS3 const float* lut, bool blk_ok, bool farstep,
                float& m_run, float& l_run, f32x16 (&O)[2], float inv_l, LAS3 float* imp_row, float& bcarry) {
    const int r = lane & 31, hf = lane >> 5;
    f32x16 S[2];
#pragma unroll
    for (int sub = 0; sub < 2; ++sub) {
#pragma unroll
        for (int i = 0; i < 16; ++i) S[sub][i] = 0.f;
#pragma unroll
        for (int ks = 0; ks < 4; ++ks) {
            const bf16x8v a = *(LAS3 const bf16x8v*)(Kb + (32 * sub + r) * AT_KROW + 32 * ks + 16 * hf);
            if (APROBE < 3) S[sub] = __builtin_amdgcn_mfma_f32_32x32x16_bf16(a, Q[ks], S[sub], 0, 0, 0);
            else S[sub][ks] += __builtin_bit_cast(float, (int)a[0] | ((int)a[1] << 16));
        }
    }
    __builtin_amdgcn_sched_barrier(0);
    float mx = -INFINITY;
    const float bfar = lut[127];
    if (APROBE >= 2) { mx = S[0][0]; } else
    if (!farstep) {
#pragma unroll
        for (int sub = 0; sub < 2; ++sub)
#pragma unroll
            for (int i = 0; i < 16; ++i) {
                const int kp = k0 + 32 * sub + (i & 3) + 8 * (i >> 2) + 4 * hf;
                const int dist = MODE == 0 ? tq - (16 * kp + 31) : tq - kp;
                bool ok = dist >= 0 && blk_ok;
                if (MODE == 2) ok = ok && dist < 512;
                const int idx = dist < 0 ? 0 : (dist > 127 ? 127 : dist);
                float s = S[sub][i] + lut[idx];
                s = ok ? s : -INFINITY;
                S[sub][i] = s; mx = fmaxf(mx, s);
            }
    } else {
#pragma unroll
        for (int sub = 0; sub < 2; ++sub)
#pragma unroll
            for (int i = 0; i < 16; ++i) mx = fmaxf(mx, S[sub][i]);
        mx += bfar;
        if (MODE == 1) mx = blk_ok ? mx : -INFINITY;
    }
    if (APROBE >= 2) { l_run += mx; } else
    if (PASS != 2) {
        mx = fmaxf(mx, __shfl_xor(mx, 32));
        const float m_new = fmaxf(m_run, mx), m_safe = (m_new == -INFINITY) ? 0.f : m_new;
        const float alpha = __builtin_amdgcn_exp2f(m_run - m_safe);
        float m_use = farstep ? m_safe - bfar : m_safe;
        if (MODE == 1 && farstep) m_use = blk_ok ? m_use : INFINITY;
        float sum = 0.f;
#pragma unroll
        for (int sub = 0; sub < 2; ++sub)
#pragma unroll
            for (int i = 0; i < 16; ++i) { const float pv = __builtin_amdgcn_exp2f(S[sub][i] - m_use); S[sub][i] = pv; sum += pv; }
        l_run = l_run * alpha + sum; m_run = m_new;
        if (PASS == 0) {
            if (__any(alpha != 1.0f)) {
#pragma unroll
                for (int db = 0; db < 2; ++db)
#pragma unroll
                    for (int i = 0; i < 16; ++i) O[db][i] *= alpha;
            }
        }
    } else {
        const float mu = farstep ? m_run - bfar : m_run;
#pragma unroll
        for (int sub = 0; sub < 2; ++sub) {
#pragma unroll
            for (int i = 0; i < 16; ++i) S[sub][i] = __builtin_amdgcn_exp2f(S[sub][i] - mu) * inv_l;
            float bp[4], av[4];
#pragma unroll
            for (int a = 0; a < 4; ++a) {
                av[a] = S[sub][4 * a] + S[sub][4 * a + 1] + S[sub][4 * a + 2] + 0.5f * S[sub][4 * a + 3];
                bp[a] = __shfl_xor(0.5f * S[sub][4 * a + 3], 32);
            }
            const int sbase = (k0 >> 2) + 8 * sub + hf;
#pragma unroll
            for (int a = 0; a < 4; ++a) imp_row[sbase + 2 * a] = av[a] + (hf ? bp[a] : (a > 0 ? bp[a > 0 ? a - 1 : 0] : bcarry));
            bcarry = bp[3];
        }
    }
    __builtin_amdgcn_sched_barrier(0);
    if (PASS != 1) {
#pragma unroll
        for (int sub = 0; sub < 2; ++sub)
#pragma unroll
            for (int s2 = 0; s2 < 2; ++s2) {
                u32x4 pw;
                pw.x = pk_bf16(S[sub][8 * s2 + 0], S[sub][8 * s2 + 1]); pw.y = pk_bf16(S[sub][8 * s2 + 2], S[sub][8 * s2 + 3]);
                pw.z = pk_bf16(S[sub][8 * s2 + 4], S[sub][8 * s2 + 5]); pw.w = pk_bf16(S[sub][8 * s2 + 6], S[sub][8 * s2 + 7]);
                const bf16x8v pf = __builtin_bit_cast(bf16x8v, pw);
#pragma unroll
                for (int db = 0; db < 2; ++db) {
                    LAS3 const unsigned char* va = Vb + (32 * db + r) * AT_VROW + (32 * sub + 16 * s2 + 4 * hf) * 2;
                    const u32x2 v0 = *(LAS3 const u32x2*)va, v1 = *(LAS3 const u32x2*)(va + 16);
                    const bf16x8v vf = __builtin_bit_cast(bf16x8v, (u32x4){v0.x, v0.y, v1.x, v1.y});
                    if (APROBE < 3) O[db] = __builtin_amdgcn_mfma_f32_32x32x16_bf16(vf, pf, O[db], 0, 0, 0); else O[db][s2] += __builtin_bit_cast(float, (int)vf[0] | ((int)pf[1] << 16));
                }
            }
    }
}

template <int MODE, int PASS, int APROBE>
DI void at_branch(LAS3 unsigned char* lds, const AtSrc& src, int blk_lo, int blk_hi, const bf16x8v (&Q)[4], int tq, int tid, int kvh, LAS3 const float* lut,
                  unsigned mlo, unsigned mhi, float& m_run, float& l_run, f32x16 (&O)[2], float inv_l, LAS3 float* imp_row) {
    const int lane = tid & 63;
    u32x4 st[4];
    float bcarry = 0.f;
    at_load(src, blk_lo * 64, tid, st);
    for (int blk = blk_lo; blk <= blk_hi; ++blk) {
        LAS3 unsigned char* buf = lds + ((blk - blk_lo) & 1) * AT_BUF;
        at_store(buf, tid, st);
        __syncthreads();
        if (blk < blk_hi) at_load(src, (blk + 1) * 64, tid, st);
        bool blk_ok = true;
        if (MODE == 1) blk_ok = ((blk < 32 ? (mlo >> blk) : (mhi >> (blk - 32))) & 1u) != 0u;
        const int t0u = tq - (lane & 31);
        const bool farstep = MODE == 0 ? (t0u - 16 * (blk * 64 + 63) - 31 >= 128) : (MODE == 1 ? (t0u - blk * 64 - 63 >= 128) : (t0u - blk * 64 - 63 >= 128 && t0u + 31 - blk * 64 < 512));
        if (MODE != 1 || __any(blk_ok)) {
            at_step<MODE, PASS, APROBE>(buf + kvh * AT_KT, buf + 2 * AT_KT + kvh * AT_VT, Q, blk * 64, tq, lane, lut, blk_ok, farstep, m_run, l_run, O, inv_l, imp_row, bcarry);
        }
    }
    __syncthreads();
}

template <int APROBE> DI void p3_attention(const Params& p, LAS3 unsigned char* lds, int G) {
    unsigned char* ws = p.ws;
    const int tid = threadIdx.x, lane = tid & 63, h = __builtin_amdgcn_readfirstlane(tid >> 6), kvh = h >> 2, r = lane & 31, hf = lane >> 5;
    LAS3 float* lutall = (LAS3 float*)(lds + AT_LUT);
    {
        const float* rel = p.in[I_REL];
        for (int i = tid; i < 1024; i += MK_THREADS) lutall[i] = rel[rel_bucket(i & 127) * NH + (i >> 7)] * LOG2E;
    }
    __syncthreads();
    LAS3 const float* lut = lutall + h * 128;
    LAS3 float* impw = (LAS3 float*)(lds + AT_IMP);
    LAS3 float* vals = (LAS3 float*)(lds + AT_VAL);
    LAS3 unsigned char* selb = lds + AT_SEL;
    LAS3 float* ssq = (LAS3 float*)(lds + AT_SSQ);
    const bf16_t* qb = (const bf16_t*)(ws + R_QB);
    const float* gates = (const float*)(ws + R_GATE);
    const float* gn = p.in[I_GN_ATTN];
    bf16_t* mixed = APROBE ? (bf16_t*)(ws + R_BIG) : (bf16_t*)(ws + WS_XB);
    for (int ui = blockIdx.x; ui < 512; ui += G) {
        const int q8 = ui & 255, rnd = ui >> 8, b = q8 >> 6, j6 = q8 & 63, tb = rnd == 0 ? 127 - j6 : j6;
        const int t0 = 32 * tb, qb64 = tb >> 1, tq = t0 + r;
        const size_t tok = (size_t)b * T_ + tq;
        bf16x8v Q[4];
#pragma unroll
        for (int ks = 0; ks < 4; ++ks) Q[ks] = *(const bf16x8v*)(qb + tok * 512 + h * 64 + 16 * ks + 8 * hf);
        f32x16 O[2];
#pragma unroll
        for (int db = 0; db < 2; ++db)
#pragma unroll
            for (int i = 0; i < 16; ++i) O[db][i] = 0.f;
        LAS3 float* oslot = (LAS3 float*)(lds + AT_IMP) + h * 2048 + lane;
        const size_t bh0 = (size_t)b * 2, bh1 = bh0 + 1;
        {
            const bf16_t* kcb = (const bf16_t*)(ws + R_KCB); const bf16_t* vct = (const bf16_t*)(ws + R_VCT);
            const AtSrc src{kcb + bh0 * 256 * 64, kcb + bh1 * 256 * 64, vct + bh0 * 64 * 256, vct + bh1 * 64 * 256, 256};
            const int nst = tb / 32 + 1;
            float m_run = -INFINITY, l_run = 0.f;
            at_branch<0, 1, APROBE>(lds, src, 0, nst - 1, Q, tq, tid, kvh, lut, 0u, 0u, m_run, l_run, O, 0.f, nullptr);
            const float l_tot = l_run + __shfl_xor(l_run, 32);
            const float inv_l = l_tot > 0.f ? 1.0f / l_tot : 0.f;
            float m_fix = (m_run == -INFINITY) ? 0.f : m_run;
            at_branch<0, 2, APROBE>(lds, src, 0, nst - 1, Q, tq, tid, kvh, lut, 0u, 0u, m_fix, l_run, O, inv_l, impw + (h * 32 + r) * 65);
        }
        {
            const int row = tid >> 3, j8 = tid & 7, kr = row >> 5, tr = row & 31;
#pragma unroll
            for (int jj = 0; jj < 8; ++jj) {
                const int s = j8 * 8 + jj, db = qb64 - s;
                float v = 0.f;
#pragma unroll
                for (int g = 0; g < 4; ++g) v += impw[((kr * 4 + g) * 32 + tr) * 65 + s];
                vals[row * 65 + s] = (db >= 0 && db < 2) ? 2.0e4f : (s == 0 ? 1.0e4f : (db >= 0 ? v : -1.0f));
            }
            __syncthreads();
            unsigned bits = 0u;
            {
                float vv[8]; int rk[8];
#pragma unroll
                for (int jj = 0; jj < 8; ++jj) { vv[jj] = vals[row * 65 + j8 * 8 + jj]; rk[jj] = 0; }
#pragma unroll 2
                for (int s2 = 0; s2 < 64; ++s2) {
                    const float w = vals[row * 65 + s2];
#pragma unroll
                    for (int jj = 0; jj < 8; ++jj) rk[jj] += (w > vv[jj] || (w == vv[jj] && s2 < j8 * 8 + jj)) ? 1 : 0;
                }
#pragma unroll
                for (int jj = 0; jj < 8; ++jj) if (rk[jj] < 16 && qb64 - (j8 * 8 + jj) >= 0) bits |= 1u << jj;
            }
            selb[row * 8 + j8] = (unsigned char)bits;
            __syncthreads();
        }
        const unsigned mlo = *(LAS3 const unsigned*)(selb + (kvh * 32 + r) * 8), mhi = *(LAS3 const unsigned*)(selb + (kvh * 32 + r) * 8 + 4);
        __syncthreads();
        {
            const float g0 = sigmoidf_(gates[tok * 24 + h * 3 + 0]);
#pragma unroll
            for (int db = 0; db < 2; ++db)
#pragma unroll
                for (int i = 0; i < 16; ++i) { oslot[(db * 16 + i) * 64] = g0 * O[db][i]; O[db][i] = 0.f; }
        }
        {
            const bf16_t* ksb = (const bf16_t*)(ws + R_KS); const bf16_t* vst = (const bf16_t*)(ws + R_VST);
            const AtSrc src{ksb + bh0 * T_ * HD, ksb + bh1 * T_ * HD, vst + bh0 * HD * T_, vst + bh1 * HD * T_, T_};
            float m_run = -INFINITY, l_run = 0.f;
            at_branch<1, 0, APROBE>(lds, src, 0, qb64, Q, tq, tid, kvh, lut, mlo, mhi, m_run, l_run, O, 0.f, nullptr);
            const float l_tot = l_run + __shfl_xor(l_run, 32), sc = sigmoidf_(gates[tok * 24 + h * 3 + 1]) / l_tot;
#pragma unroll
            for (int db = 0; db < 2; ++db)
#pragma unroll
                for (int i = 0; i < 16; ++i) { oslot[(db * 16 + i) * 64] += sc * O[db][i]; O[db][i] = 0.f; }
        }
        {
            const bf16_t* kwb = (const bf16_t*)(ws + R_KW); const bf16_t* vwt = (const bf16_t*)(ws + R_VWT);
            const AtSrc src{kwb + bh0 * T_ * HD, kwb + bh1 * T_ * HD, vwt + bh0 * HD * T_, vwt + bh1 * HD * T_, T_};
            int wb0 = (t0 - 511) >> 6; wb0 = wb0 < 0 ? 0 : wb0;
            float m_run = -INFINITY, l_run = 0.f;
            at_branch<2, 0, APROBE>(lds, src, wb0, qb64, Q, tq, tid, kvh, lut, 0u, 0u, m_run, l_run, O, 0.f, nullptr);
            const float l_tot = l_run + __shfl_xor(l_run, 32), sc = sigmoidf_(gates[tok * 24 + h * 3 + 2]) / l_tot;
#pragma unroll
            for (int db = 0; db < 2; ++db)
#pragma unroll
                for (int i = 0; i < 16; ++i) O[db][i] = oslot[(db * 16 + i) * 64] + sc * O[db][i];
        }
        {
            float ss = 0.f;
#pragma unroll
            for (int db = 0; db < 2; ++db)
#pragma unroll
                for (int i = 0; i < 16; ++i) ss += O[db][i] * O[db][i];
            ss += __shfl_xor(ss, 32);
            if (hf == 0) ssq[h * 32 + r] = ss;
            __syncthreads();
            float tot = 0.f;
#pragma unroll
            for (int hh = 0; hh < 8; ++hh) tot += ssq[hh * 32 + r];
            const float rs = rsqrtf(tot * (1.0f / 512) + EPS);
#pragma unroll
            for (int db = 0; db < 2; ++db)
#pragma unroll
                for (int a = 0; a < 4; ++a) {
                    const int d = 32 * db + 8 * a + 4 * hf;
                    const f32x4 g4 = *(const f32x4*)(gn + h * 64 + d);
                    u32x2 w; w.x = pk_bf16(O[db][4 * a] * rs * g4[0], O[db][4 * a + 1] * rs * g4[1]); w.y = pk_bf16(O[db][4 * a + 2] * rs * g4[2], O[db][4 * a + 3] * rs * g4[3]);
                    *(u32x2*)(mixed + tok * DM + h * 64 + d) = w;
                }
            __syncthreads();
        }
    }
}
constexpr int LR_STRIDE = 516;
constexpr int LR_XC = 0, LR_A = 32 * LR_STRIDE * 4, LR_RS = 2 * 32 * LR_STRIDE * 4, LR_END = LR_RS + 256;
static_assert(LR_END <= 160 * 1024 - 256, "LRU LDS map");

template <bool FINAL>
DI void lru_phase(const Params& p, LAS3 unsigned char* lds, int G) {
    unsigned char* ws = p.ws;
    const int tid = threadIdx.x, lane = tid & 63, n = __builtin_amdgcn_readfirstlane(tid >> 6), r = lane & 31, hf = lane >> 5, ch = tid;
    LAS3 float* XC = (LAS3 float*)(lds + LR_XC); LAS3 float* AA = (LAS3 float*)(lds + LR_A); LAS3 float* RS = (LAS3 float*)(lds + LR_RS);
    const bf16_t* xr = (const bf16_t*)(ws + R_XR); const bf16_t* xg = (const bf16_t*)(ws + R_XG);
    float* sumP = (float*)(ws + WS_LRUP); float* sumH = (float*)(ws + WS_LRUH);
    bf16_t* mixed = (bf16_t*)(ws + WS_XB);
    const float cw0 = p.in[I_CONV_W][0 * 512 + ch], cw1 = p.in[I_CONV_W][1 * 512 + ch], cw2 = p.in[I_CONV_W][2 * 512 + ch], cw3 = p.in[I_CONV_W][3 * 512 + ch], cb = p.in[I_CONV_B][ch];
    const float gl = FINAL ? p.in[I_GN_LRU][ch] : 0.f;
    float ba[2], bx[2], sp[2];
#pragma unroll
    for (int nb = 0; nb < 2; ++nb) { const int c2 = n * 64 + 32 * nb + r; ba[nb] = p.in[I_LRU_BA][c2]; bx[nb] = p.in[I_LRU_BX][c2]; sp[nb] = log1pf(__expf(-p.in[I_LRU_LAM][c2])); }
    const bf16_t* waT = (const bf16_t*)(ws + WS_WAT); const bf16_t* wxT = (const bf16_t*)(ws + WS_WXT);
    for (int ci = blockIdx.x; ci < 256; ci += G) {
        const int b = ci >> 6, cib = ci & 63, t0 = cib * 64;
        const size_t tok0 = (size_t)b * T_ + t0;
        float x1 = 0.f, x2 = 0.f, x3 = 0.f;
        if (t0 > 0) { x1 = bf2f(xr[(tok0 - 1) * 512 + ch]); x2 = bf2f(xr[(tok0 - 2) * 512 + ch]); x3 = bf2f(xr[(tok0 - 3) * 512 + ch]); }
        float hst = 0.f, pprod = 1.f;
        if (FINAL) {
            const float* Pp = sumP + (size_t)(b * 64) * 512 + ch; const float* Hp = sumH + (size_t)(b * 64) * 512 + ch;
            for (int k = 0; k < cib; ++k) hst = Pp[(size_t)k * 512] * hst + Hp[(size_t)k * 512];
        }
#pragma unroll 1
        for (int half = 0; half < 2; ++half) {
            const size_t tokh = tok0 + half * 32;
            __syncthreads();
            {
                bf16_t xw[32]; float xv[32];
#pragma unroll
                for (int t = 0; t < 32; ++t) xw[t] = xr[(tokh + t) * 512 + ch];
#pragma unroll
                for (int t = 0; t < 32; ++t) xv[t] = bf2f(xw[t]);
#pragma unroll
                for (int t = 0; t < 32; ++t) {
                    const float x0 = xv[t];
                    XC[t * LR_STRIDE + ch] = cw0 * x3 + cw1 * x2 + cw2 * x1 + cw3 * x0 + cb;
                    x3 = x2; x2 = x1; x1 = x0;
                }
            }
            __syncthreads();
            {
                f32x16 ar[2], ai[2];
#pragma unroll
                for (int nb = 0; nb < 2; ++nb)
#pragma unroll
                    for (int i = 0; i < 16; ++i) { ar[nb][i] = 0.f; ai[nb][i] = 0.f; }
                bf16x8v Ba[2][4], Bx[2][4];
#pragma unroll
                for (int nb = 0; nb < 2; ++nb)
#pragma unroll
                    for (int ks = 0; ks < 4; ++ks) {
                        const size_t o = (size_t)(n * 64 + 32 * nb + r) * 64 + 16 * ks + 8 * hf;
                        Ba[nb][ks] = *(const bf16x8v*)(waT + o); Bx[nb][ks] = *(const bf16x8v*)(wxT + o);
                    }
#pragma unroll
                for (int ks = 0; ks < 4; ++ks) {
                    LAS3 const float* src = XC + r * LR_STRIDE + n * 64 + 16 * ks + 8 * hf;
                    const f32x4 f0 = *(LAS3 const f32x4*)src, f1 = *(LAS3 const f32x4*)(src + 4);
                    u32x4 pw; pw.x = pk_bf16(f0[0], f0[1]); pw.y = pk_bf16(f0[2], f0[3]); pw.z = pk_bf16(f1[0], f1[1]); pw.w = pk_bf16(f1[2], f1[3]);
                    const bf16x8v af = __builtin_bit_cast(bf16x8v, pw);
#pragma unroll
                    for (int nb = 0; nb < 2; ++nb) {
                        ar[nb] = __builtin_amdgcn_mfma_f32_32x32x16_bf16(af, Ba[nb][ks], ar[nb], 0, 0, 0);
                        ai[nb] = __builtin_amdgcn_mfma_f32_32x32x16_bf16(af, Bx[nb][ks], ai[nb], 0, 0, 0);
                    }
                }
                __syncthreads();
#pragma unroll
                for (int nb = 0; nb < 2; ++nb)
#pragma unroll
                    for (int i = 0; i < 16; ++i) {
                        const int t = (i & 3) + 8 * (i >> 2) + 4 * hf, o = t * LR_STRIDE + n * 64 + 32 * nb + r;
                        const float xcv = XC[o];
                        const float rg = sigmoidf_(ar[nb][i] + ba[nb]), ig = sigmoidf_(ai[nb][i] + bx[nb]);
                        const float log_a = -8.0f * rg * sp[nb];
                        AA[o] = __expf(log_a);
                        XC[o] = sqrtf(-expm1f(2.0f * log_a)) * (ig * xcv);
                    }
            }
            __syncthreads();
            if (!FINAL) {
#pragma unroll 8
                for (int t = 0; t < 32; ++t) { const float a = AA[t * LR_STRIDE + ch]; hst = a * hst + XC[t * LR_STRIDE + ch]; pprod *= a; }
            } else {
                {
                    bf16_t gv[32];
#pragma unroll
                    for (int t = 0; t < 32; ++t) gv[t] = xg[(tokh + t) * 512 + ch];
#pragma unroll
                    for (int t = 0; t < 32; ++t) {
                        hst = AA[t * LR_STRIDE + ch] * hst + XC[t * LR_STRIDE + ch];
                        XC[t * LR_STRIDE + ch] = hst * gelu_tanh(bf2f(gv[t]));
                    }
                }
                __syncthreads();
                {
                    const int t = tid >> 4, part = tid & 15;
                    float s = 0.f;
#pragma unroll 8
                    for (int j = 0; j < 32; ++j) { const float v = XC[t * LR_STRIDE + part + 16 * j]; s += v * v; }
                    s += __shfl_xor(s, 1); s += __shfl_xor(s, 2); s += __shfl_xor(s, 4); s += __shfl_xor(s, 8);
                    if (part == 0) RS[t] = rsqrtf(s * (1.0f / 512) + EPS);
                }
                __syncthreads();
#pragma unroll 8
                for (int t = 0; t < 32; ++t) mixed[(tokh + t) * DM + 512 + ch] = f2bf(XC[t * LR_STRIDE + ch] * RS[t] * gl);
            }
        }
        if (!FINAL) { sumP[(size_t)ci * 512 + ch] = pprod; sumH[(size_t)ci * 512 + ch] = hst; }
    }
    __syncthreads();
}
typedef float f32x4v __attribute__((ext_vector_type(4)));
constexpr int CM_IMG = 0;
constexpr int CM_HID = 36864;
constexpr int CM_END = CM_HID + 16 * 264 * 2;
DI void p2_compress(const Params& p, LAS3 unsigned char* lds, int G) {
    unsigned char* ws = p.ws;
    const int tid = threadIdx.x, lane = tid & 63, wid = __builtin_amdgcn_readfirstlane(tid >> 6), row = lane & 15, kg = lane >> 4;
    for (int u = blockIdx.x; u < 256; u += G) {
        const int kv = u >> 7, bh = (u >> 4) & 7, c0 = (u & 15) * 16;
        const bf16_t* src = (const bf16_t*)(ws + (kv ? R_VC : R_KC)) + ((size_t)bh * T_ + 16 * c0) * HD;
        const bf16_t* W1T = (const bf16_t*)(ws + (kv ? WS_CW1V : WS_CW1K));
        const float* cb = (const float*)(ws + (kv ? WS_CBV : WS_CBK));
        const bf16_t* W2T = (const bf16_t*)(ws + (kv ? WS_CW2V : WS_CW2K));
        __syncthreads();
        for (int i = tid; i < 272 * 8; i += MK_THREADS) { const int tau = i >> 3, cch = i & 7; *(LAS3 u32x4*)(lds + CM_IMG + tau * 128 + (tau >> 4) * 16 + cch * 16) = *(const u32x4*)(src + (size_t)tau * HD + cch * 8); }
        __syncthreads();
        f32x4v acc[2] = {{0.f, 0.f, 0.f, 0.f}, {0.f, 0.f, 0.f, 0.f}};
        const bf16_t* wb0 = W1T + (size_t)(wid * 32 + row) * 2048 + 8 * kg, * wb1 = wb0 + (size_t)16 * 2048;
#pragma unroll 8
        for (int ks = 0; ks < 64; ++ks) {
            const int tau = 16 * row + (ks >> 1);
            const bf16x8v a = *(LAS3 const bf16x8v*)(lds + CM_IMG + tau * 128 + (tau >> 4) * 16 + (32 * (ks & 1) + 8 * kg) * 2);
            const bf16x8v b0 = *(const bf16x8v*)(wb0 + 32 * ks), b1 = *(const bf16x8v*)(wb1 + 32 * ks);
            acc[0] = __builtin_amdgcn_mfma_f32_16x16x32_bf16(a, b0, acc[0], 0, 0, 0);
            acc[1] = __builtin_amdgcn_mfma_f32_16x16x32_bf16(a, b1, acc[1], 0, 0, 0);
        }
#pragma unroll
        for (int nb = 0; nb < 2; ++nb) {
            const int col = wid * 32 + 16 * nb + row; const float bias = cb[col];
#pragma unroll
            for (int i = 0; i < 4; ++i) *(LAS3 bf16_t*)(lds + CM_HID + ((4 * kg + i) * 264 + col) * 2) = f2bf(gelu_tanh(acc[nb][i] + bias));
        }
        __syncthreads();
        if (wid < 4) {
            f32x4v o = {0.f, 0.f, 0.f, 0.f};
#pragma unroll
            for (int ks = 0; ks < 8; ++ks) {
                const bf16x8v a = *(LAS3 const bf16x8v*)(lds + CM_HID + (row * 264 + 32 * ks + 8 * kg) * 2);
                const bf16x8v b = *(const bf16x8v*)(W2T + (size_t)(wid * 16 + row) * 256 + 32 * ks + 8 * kg);
                o = __builtin_amdgcn_mfma_f32_16x16x32_bf16(a, b, o, 0, 0, 0);
            }
            const int d = wid * 16 + row;
#pragma unroll
            for (int i = 0; i < 4; ++i) {
                const int c = c0 + 4 * kg + i; const float v = c < NCMP ? o[i] : 0.f;
                ((float*)(ws + (kv ? WS_VCMP : WS_KCMP)))[((size_t)bh * 256 + c) * 64 + d] = v;
                if (kv) ((bf16_t*)(ws + R_VCT))[((size_t)bh * 64 + d) * 256 + c] = f2bf(v);
                else    ((bf16_t*)(ws + R_KCB))[((size_t)bh * 256 + c) * 64 + d] = f2bf(v);
            }
        }
    }
    __syncthreads();
}
DI void p2_vtranspose(const Params& p, LAS3 unsigned char* lds, int G) {
    unsigned char* ws = p.ws;
    const int tid = threadIdx.x;
    LAS3 bf16_t* tl = (LAS3 bf16_t*)lds;
    for (int u = blockIdx.x; u < 1024; u += G) {
        const int which = u >> 9, bh = (u >> 6) & 7, tt = u & 63;
        const bf16_t* src = (const bf16_t*)(ws + (which ? R_VW : R_VS)) + ((size_t)bh * T_ + tt * 64) * HD;
        bf16_t* dst = (bf16_t*)(ws + (which ? R_VWT : R_VST)) + (size_t)bh * HD * T_ + tt * 64;
        __syncthreads();
        { const int tok = tid >> 3, seg = tid & 7; *(LAS3 u32x4*)(tl + tok * 72 + seg * 8) = *(const u32x4*)(src + (size_t)tok * HD + seg * 8); }
        __syncthreads();
        { const int d = tid >> 3, seg = tid & 7; u32x4 w;
          w.x = (unsigned)tl[(seg * 8 + 0) * 72 + d] | ((unsigned)tl[(seg * 8 + 1) * 72 + d] << 16); w.y = (unsigned)tl[(seg * 8 + 2) * 72 + d] | ((unsigned)tl[(seg * 8 + 3) * 72 + d] << 16);
          w.z = (unsigned)tl[(seg * 8 + 4) * 72 + d] | ((unsigned)tl[(seg * 8 + 5) * 72 + d] << 16); w.w = (unsigned)tl[(seg * 8 + 6) * 72 + d] | ((unsigned)tl[(seg * 8 + 7) * 72 + d] << 16);
          *(u32x4*)(dst + (size_t)d * T_ + seg * 8) = w; }
    }
    __syncthreads();
}
DI int ord_enc(float f) { const int u = __float_as_int(f); return u ^ ((u >> 31) & 0x7fffffff); }
DI float ord_dec(int o) { return __int_as_float(o ^ ((o >> 31) & 0x7fffffff)); }
#define PEER_CE_DESC(a, b) do { const int _hi = max((a), (b)), _lo = min((a), (b)); (a) = _hi; (b) = _lo; } while (0)
#define PEER_CE_ASC(a, b)  do { const int _hi = max((a), (b)), _lo = min((a), (b)); (a) = _lo; (b) = _hi; } while (0)
DI void sort16_desc(int (&x)[16]) {
#pragma unroll
    for (int k = 2; k <= 16; k <<= 1)
#pragma unroll
        for (int j = k >> 1; j > 0; j >>= 1)
#pragma unroll
            for (int i = 0; i < 16; ++i) { const int l = i ^ j; if (l > i) { if ((i & k) == 0) PEER_CE_DESC(x[i], x[l]); else PEER_CE_ASC(x[i], x[l]); } }
}
DI void merge16_desc(int (&a)[16], const int (&b)[16]) {
#pragma unroll
    for (int i = 0; i < 16; ++i) a[i] = max(a[i], b[15 - i]);
#pragma unroll
    for (int j = 8; j > 0; j >>= 1)
#pragma unroll
        for (int i = 0; i < 16; ++i) { const int l = i ^ j; if (l > i) PEER_CE_DESC(a[i], a[l]); }
}
constexpr int PR_KEYS = 0;
constexpr int PR_IDX = 512 * 68 * 4;
constexpr int PR_RS = PR_IDX + 128 * 32 * 4;
constexpr int PR_END = PR_RS + 1024;
static_assert(PR_END <= 160 * 1024 - 256, "PEER LDS map");

struct EpiPeerRoute {
    static constexpr bool PERM = true, AFTER_DRAIN = true;
    const float* ssq1; int* eout; float* gout; float* rs1out;
    DI void fused(const f32x4 (&acc)[2][2][4][2], const pg8::Unit& u, int wr, int wc, int fr, int fq, PG8_LAS unsigned char* lds, int wid, int lane) const {
        const int tid = wid * 64 + lane, head = u.pn;
        LAS3 int* KEYS = (LAS3 int*)(lds + PR_KEYS); LAS3 int* IDX = (LAS3 int*)(lds + PR_IDX); LAS3 float* RS = (LAS3 float*)(lds + PR_RS);
        if (tid < 256) { float s = 0.f; for (int j = 0; j < 16; ++j) s += ssq1[(size_t)j * NTOK + u.pm * 256 + tid]; RS[tid] = rsqrtf(s * (1.0f / DM) + EPS); if (u.pn == 0) rs1out[u.pm * 256 + tid] = RS[tid]; }
#pragma unroll 1
        for (int ai = 0; ai < 2; ++ai) {
            __syncthreads();
#pragma unroll
            for (int bj = 0; bj < 2; ++bj)
#pragma unroll
                for (int m = 0; m < 4; ++m)
#pragma unroll
                    for (int n = 0; n < 2; ++n) {
                        const int rl = 64 * wr + 16 * m + fr, kk0 = 32 * wc + 8 * fq + 4 * n, hl = ((rl * 2 + bj) * 2 + (kk0 >> 6));
                        const f32x4 v = ai == 0 ? acc[0][bj][m][n] : acc[1][bj][m][n];
                        u32x4 kq;
                        kq.x = (unsigned)((ord_enc(v[0]) & ~0x7f) | (127 - (kk0 + 0))); kq.y = (unsigned)((ord_enc(v[1]) & ~0x7f) | (127 - (kk0 + 1)));
                        kq.z = (unsigned)((ord_enc(v[2]) & ~0x7f) | (127 - (kk0 + 2))); kq.w = (unsigned)((ord_enc(v[3]) & ~0x7f) | (127 - (kk0 + 3)));
                        *(LAS3 u32x4*)(KEYS + hl * 68 + (kk0 & 63)) = kq;
                    }
            __syncthreads();
            int top[16];
            {
                LAS3 const int* src = KEYS + tid * 68;
                int t2[16];
#pragma unroll
                for (int q = 0; q < 4; ++q) { const u32x4 w = *(LAS3 const u32x4*)(src + 4 * q); top[4 * q] = (int)w.x; top[4 * q + 1] = (int)w.y; top[4 * q + 2] = (int)w.z; top[4 * q + 3] = (int)w.w; }
                sort16_desc(top);
#pragma unroll 1
                for (int g = 1; g < 4; ++g) {
#pragma unroll
                    for (int q = 0; q < 4; ++q) { const u32x4 w = *(LAS3 const u32x4*)(src + 16 * g + 4 * q); t2[4 * q] = (int)w.x; t2[4 * q + 1] = (int)w.y; t2[4 * q + 2] = (int)w.z; t2[4 * q + 3] = (int)w.w; }
                    sort16_desc(t2);
                    merge16_desc(top, t2);
                }
#pragma unroll
                for (int i = 0; i < 16; ++i) t2[i] = __shfl_xor(top[i], 1);
                merge16_desc(top, t2);
            }
            int s1[16], s2[16];
            {
                const bool isp1 = (lane & 2) != 0;
#pragma unroll
                for (int i = 0; i < 16; ++i) { const int o = __shfl_xor(top[i], 2); s1[i] = isp1 ? o : top[i]; s2[i] = isp1 ? top[i] : o; }
            }
            const int rl = tid >> 2, q4 = tid & 3;
#pragma unroll
            for (int kq = 0; kq < 4; ++kq) if (q4 == kq) {
#pragma unroll
                for (int j = 0; j < 4; ++j) { IDX[rl * 32 + 4 * kq + j] = 127 - (s1[4 * kq + j] & 0x7f); IDX[rl * 32 + 16 + 4 * kq + j] = 127 - (s2[4 * kq + j] & 0x7f); }
            }
            float v1[16], v2[16];
#pragma unroll
            for (int i = 0; i < 16; ++i) { v1[i] = ord_dec(s1[i] & ~0x7f); v2[i] = ord_dec(s2[i] & ~0x7f); }
            int best[16], grp[16];
            {
                int cnt = 0; bool first = true;
#pragma unroll
                for (int a = 0; a < 16; ++a)
#pragma unroll
                    for (int b = 0; b < 16; ++b) if ((a + 1) * (b + 1) <= 16) {
                        grp[cnt & 15] = (ord_enc(v1[a] + v2[b]) & ~0xff) | (255 - (16 * a + b));
                        ++cnt;
                        if ((cnt & 15) == 0) { sort16_desc(grp); if (first) {
#pragma unroll
                                for (int i = 0; i < 16; ++i) best[i] = grp[i];
                                first = false; } else merge16_desc(best, grp); }
                    }
#pragma unroll
                for (int i = 2; i < 16; ++i) grp[i] = (int)0x80000000;
                sort16_desc(grp); merge16_desc(best, grp);
            }
            __syncthreads();
            const float rs1 = RS[128 * ai + rl];
            float gsum = 0.f, gv[16]; int ev[16];
            const float mtop = ord_dec(best[0] & ~0xff) * rs1;
#pragma unroll
            for (int i = 0; i < 16; ++i) {
                const float sc = ord_dec(best[i] & ~0xff) * rs1; gv[i] = __expf(sc - mtop); gsum += gv[i];
                const int ab = 255 - (best[i] & 0xff);
                ev[i] = IDX[rl * 32 + (ab >> 4)] * 128 + IDX[rl * 32 + 16 + (ab & 15)];
            }
            const float ginv = 1.0f / gsum;
            const size_t tok = (size_t)u.pm * 256 + 128 * ai + rl;
#pragma unroll
            for (int kq = 0; kq < 4; ++kq) if (q4 == kq) {
                *(u32x4*)(eout + tok * 128 + head * 16 + 4 * kq) = (u32x4){(unsigned)ev[4 * kq], (unsigned)ev[4 * kq + 1], (unsigned)ev[4 * kq + 2], (unsigned)ev[4 * kq + 3]};
                *(f32x4*)(gout + tok * 128 + head * 16 + 4 * kq) = (f32x4){gv[4 * kq] * ginv, gv[4 * kq + 1] * ginv, gv[4 * kq + 2] * ginv, gv[4 * kq + 3] * ginv};
            }
        }
        __syncthreads();
    }
    DI void operator()(const f32x4 (&)[2][2][4][2], const pg8::Unit&, int, int, int, int) const {}
};
struct SliceOrder : pg8::StaticOrder {
    int slice;
    __device__ bool next(int i, pg8::Unit& u) const { if (i > 0) return false; return pg8::StaticOrder::next(slice, u); }
};
DI void p5_peer_route(const Params& p, LAS3 unsigned char* lds, int G) {
    unsigned char* ws = p.ws;
    pg8::Gemm g{(const bf16_t*)(ws + R_H1B), (const bf16_t*)(ws + WS_WQS), NTOK, 2048, DM};
    EpiPeerRoute E{(const float*)(ws + WS_SSQ1), (int*)(ws + R_EXP), (float*)(ws + R_GSM), (float*)(ws + WS_RS1)};
    const int nslice = (512 + G - 1) / G;
#pragma unroll 1
    for (int s = 0; s < nslice; ++s) {
        SliceOrder S; S.init(NTOK, 2048, G, (int)blockIdx.x); S.slice = s;
        pg8::gemm_phase<EpiPeerRoute, SliceOrder>(lds, g, S, E, nullptr);
        __syncthreads();
    }
}
#if PEER_FP4
constexpr float U8_SCALE = 64.0f, V8_SCALE = 6.0f;
#else
constexpr float U8_SCALE = 32.0f, V8_SCALE = 8.0f;
#endif
constexpr int LDS_MISC_OFF = 160 * 1024 - 256;
DI void fp8x16_to_f32(const u32x4 w, float (&f)[16]) {
#pragma unroll
    for (int q = 0; q < 4; ++q) {
        const f32x2 lo = __builtin_amdgcn_cvt_pk_f32_fp8((int)w[q], false), hi = __builtin_amdgcn_cvt_pk_f32_fp8((int)w[q], true);
        f[4 * q] = lo.x; f[4 * q + 1] = lo.y; f[4 * q + 2] = hi.x; f[4 * q + 3] = hi.y;
    }
}
struct Pu5Fixed { int ev0, ev1; float gv0, gv1; u32x4 xa, xb; float rs1; };
DI void pu5_load_fixed(Pu5Fixed& f, int tok, int lane, const int* eidx, const float* gsm, const bf16_t* hb, const float* rs1v) {
    f.ev0 = eidx[(size_t)tok * 128 + lane]; f.ev1 = eidx[(size_t)tok * 128 + 64 + lane];
    f.gv0 = gsm[(size_t)tok * 128 + lane]; f.gv1 = gsm[(size_t)tok * 128 + 64 + lane];
    f.xa = *(const u32x4*)(hb + (size_t)tok * DM + lane * 16); f.xb = *(const u32x4*)(hb + (size_t)tok * DM + lane * 16 + 8);
    f.rs1 = rs1v[tok];
}
DI int pu5_setup(const Pu5Fixed& f, int sel, int lane, LAS3 unsigned* ent) {
    const bool s0 = (f.ev0 & 15) == sel, s1 = (f.ev1 & 15) == sel;
    const unsigned long long b0 = __ballot(s0), b1 = __ballot(s1);
    const int c0 = __builtin_popcountll(b0), cnt = c0 + __builtin_popcountll(b1);
    const unsigned long long lt = (1ull << lane) - 1ull;
    const int r0 = __builtin_popcountll(b0 & lt), r1 = c0 + __builtin_popcountll(b1 & lt);
    if (s0) { ent[r0] = (unsigned)f.ev0 | ((unsigned)lane << 16); ent[128 + r0] = __float_as_uint(f.gv0); }
    if (s1) { ent[r1] = (unsigned)f.ev1 | ((unsigned)(64 + lane) << 16); ent[128 + r1] = __float_as_uint(f.gv1); }
    return cnt;
}
#define PU5_ISSUE(SET, ENT, CNT) do { \
        _Pragma("unroll") for (int q = 0; q < 4; ++q) { const u32x4 e4 = *(LAS3 const u32x4*)((ENT) + 4 * q); \
            _Pragma("unroll") for (int k2 = 0; k2 < 4; ++k2) { const int k = 4 * q + k2; \
                const unsigned off = k < (CNT) ? ((e4[k2] & 0x3fffu) * (unsigned)DM) + lane * 16 : 0x80000000u; \
                SET[k] = __builtin_amdgcn_raw_buffer_load_b128(urs, off, 0, 0); } } } while (0)
#define PU5_CONSUME(SET, ENT, CNT, TOK, RS) do { \
        float part[16]; \
        _Pragma("unroll") for (int k = 0; k < 16; ++k) { float a = 0.f; \
            if (k < (CNT)) { f32x2 a2 = {0.f, 0.f}; \
                _Pragma("unroll") for (int q = 0; q < 4; ++q) { \
                    a2 = __builtin_elementwise_fma(__builtin_amdgcn_cvt_pk_f32_fp8((int)SET[k][q], false), xp[2 * q], a2); \
                    a2 = __builtin_elementwise_fma(__builtin_amdgcn_cvt_pk_f32_fp8((int)SET[k][q], true), xp[2 * q + 1], a2); } \
                a = a2.x + a2.y; } \
            part[k] = a; } \
        _Pragma("unroll") for (int m = 8; m >= 1; m >>= 1) { const bool up = (lane & (4 * m)) != 0; \
            _Pragma("unroll") for (int i = 0; i < m; ++i) { const float send = up ? part[i] : part[i + m], keep = up ? part[i + m] : part[i]; part[i] = keep + __shfl_xor(send, 4 * m); } } \
        float tot = part[0]; tot += __shfl_xor(tot, 2); tot += __shfl_xor(tot, 1); \
        const int kk = lane >> 2; const unsigned ew = (ENT)[kk]; const float gw = __uint_as_float((ENT)[128 + kk]); \
        if ((lane & 3) == 0 && kk < (CNT)) coef[(size_t)(TOK) * 128 + (ew >> 16)] = gw * (1.0f / V8_SCALE) * gelu_tanh(tot * ((RS) * (1.0f / U8_SCALE))); \
        if ((CNT) > 16) {   \
            for (int base = 16; base < (CNT); base += 16) { u32x4 rx[16]; \
                _Pragma("unroll") for (int k = 0; k < 16; ++k) { const unsigned e1 = (ENT)[base + k]; \
                    rx[k] = __builtin_amdgcn_raw_buffer_load_b128(urs, base + k < (CNT) ? ((e1 & 0x3fffu) * (unsigned)DM) + lane * 16 : 0x80000000u, 0, 0); } \
                float pr[16]; \
                _Pragma("unroll") for (int k = 0; k < 16; ++k) { f32x2 a2 = {0.f, 0.f}; \
                    _Pragma("unroll") for (int q = 0; q < 4; ++q) { \
                        a2 = __builtin_elementwise_fma(__builtin_amdgcn_cvt_pk_f32_fp8((int)rx[k][q], false), xp[2 * q], a2); \
                        a2 = __builtin_elementwise_fma(__builtin_amdgcn_cvt_pk_f32_fp8((int)rx[k][q], true), xp[2 * q + 1], a2); } \
                    pr[k] = a2.x + a2.y; } \
                _Pragma("unroll") for (int m = 8; m >= 1; m >>= 1) { const bool up = (lane & (4 * m)) != 0; \
                    _Pragma("unroll") for (int i = 0; i < m; ++i) { const float send = up ? pr[i] : pr[i + m], keep = up ? pr[i + m] : pr[i]; pr[i] = keep + __shfl_xor(send, 4 * m); } } \
                float t2 = pr[0]; t2 += __shfl_xor(t2, 2); t2 += __shfl_xor(t2, 1); \
                const int k3 = base + (lane >> 2); const unsigned ew2 = (ENT)[k3 & 127]; const float gw2 = __uint_as_float((ENT)[128 + (k3 & 127)]); \
                if ((lane & 3) == 0 && k3 < (CNT)) coef[(size_t)(TOK) * 128 + (ew2 >> 16)] = gw2 * (1.0f / V8_SCALE) * gelu_tanh(t2 * ((RS) * (1.0f / U8_SCALE))); } } } while (0)
#define PU5_UNPACK(F) do { _Pragma("unroll") for (int q = 0; q < 4; ++q) { xp[q] = (f32x2){bflo((F).xa[q]), bfhi((F).xa[q])}; xp[4 + q] = (f32x2){bflo((F).xb[q]), bfhi((F).xb[q])}; } } while (0)
DI void p6v5_u(const Params& p, LAS3 unsigned char* lds, int G) {
    unsigned char* ws = p.ws;
    const int tid = threadIdx.x, lane = tid & 63, wid = tid >> 6, grp = blockIdx.x & 7, rank = blockIdx.x >> 3;
    const int nrank = (G - grp + 7) >> 3, wv = rank * 8 + wid, nwv = nrank * 8;
    const unsigned char* u8 = (const unsigned char*)(ws + WS_UB); const bf16_t* hb = (const bf16_t*)(ws + R_H1B);
    const int* eidx = (const int*)(ws + R_EXP); const float* gsm = (const float*)(ws + R_GSM); const float* rs1v = (const float*)(ws + WS_RS1);
    float* coef = (float*)(ws + R_COEF);
    LAS3 unsigned* entA = (LAS3 unsigned*)(lds + wid * 2048); LAS3 unsigned* entB = entA + 256;
    if (wv >= NTOK) return;
    const __amdgpu_buffer_rsrc_t urs = __builtin_amdgcn_make_buffer_rsrc((void*)u8, 0, 16384 * DM, 0x00020000);
    const int nvis = (NTOK - wv + nwv - 1) / nwv, NV = 2 * nvis;
#define PU5_TOK(V) (wv + (((V) < NV ? (V) : NV - 1) % nvis) * nwv)
#define PU5_SEL(V) (grp + 8 * (((V) < NV ? (V) : NV - 1) / nvis))
    Pu5Fixed f1, f2;
    pu5_load_fixed(f1, PU5_TOK(0), lane, eidx, gsm, hb, rs1v);
    u32x4 sa[16], sb[16];
    f32x2 xp[8];
    int cntA = pu5_setup(f1, PU5_SEL(0), lane, entA), cntB = 0;
    PU5_ISSUE(sa, entA, cntA);
    int tokA = PU5_TOK(0), tokB = 0; float rsA = f1.rs1, rsB = 0.f;
    PU5_UNPACK(f1);
    pu5_load_fixed(f1, PU5_TOK(1), lane, eidx, gsm, hb, rs1v);
#pragma unroll 1
    for (int v = 0; v < NV; v += 2) {
        pu5_load_fixed(f2, PU5_TOK(v + 2), lane, eidx, gsm, hb, rs1v);
        cntB = pu5_setup(f1, PU5_SEL(v + 1), lane, entB); if (v + 1 >= NV) cntB = 0;
        PU5_ISSUE(sb, entB, cntB);
        tokB = PU5_TOK(v + 1); rsB = f1.rs1;
        PU5_CONSUME(sa, entA, cntA, tokA, rsA);
        PU5_UNPACK(f1);
        f1 = f2;
        pu5_load_fixed(f2, PU5_TOK(v + 3), lane, eidx, gsm, hb, rs1v);
        cntA = pu5_setup(f1, PU5_SEL(v + 2), lane, entA); if (v + 2 >= NV) cntA = 0;
        PU5_ISSUE(sa, entA, cntA);
        tokA = PU5_TOK(v + 2); rsA = f1.rs1;
        PU5_CONSUME(sb, entB, cntB, tokB, rsB);
        PU5_UNPACK(f1);
        f1 = f2;
    }
#undef PU5_TOK
#undef PU5_SEL
}
#undef PU5_ISSUE
#undef PU5_CONSUME
#undef PU5_UNPACK
template <int PMODE> DI void p6v3_v(const Params& p, int G) {
    unsigned char* ws = p.ws;
    const int tid = threadIdx.x, lane = tid & 63, wid = tid >> 6;
#if XCC_HW
    volatile LAS3 unsigned* miscw = (volatile LAS3 unsigned*)((LAS3 unsigned char*)0 + LDS_MISC_OFF);
    const int grp = (int)miscw[16], rank = (int)miscw[17];
    const int nrank = (int)__hip_atomic_load((unsigned*)(ws + WS_CTL + 16384) + grp * 16, __ATOMIC_RELAXED, __HIP_MEMORY_SCOPE_AGENT);
#else
    const int grp = blockIdx.x & 7, rank = blockIdx.x >> 3;
    const int nrank = (G - grp + 7) >> 3;
#endif
    const int wv = rank * 8 + wid, nwv = nrank * 8;
    const unsigned char* v8 = (const unsigned char*)(ws + WS_VB);
    const int* eidx = (const int*)(ws + R_EXP); const float* coef = (const float*)(ws + R_COEF);
    float* h = PMODE == 0 ? p.out : (float*)(ws + R_BIG); bf16_t* hb = PMODE == 0 ? (bf16_t*)(ws + R_H1B) : (bf16_t*)(ws + WS_XB); float* ssq2 = PMODE == 0 ? (float*)(ws + WS_SSQ2) : (float*)(ws + WS_SSQ3);
    const int sub = lane >> 3, col0 = grp * 128 + (lane & 7) * 16;
    if (wv >= NTOK) return;
    const int nvis = (NTOK - wv + nwv - 1) / nwv;
#define PV_LOADIDX(T, EV0, EV1, CV0, CV1) do { EV0 = eidx[(size_t)(T) * 128 + lane]; EV1 = eidx[(size_t)(T) * 128 + 64 + lane]; CV0 = coef[(size_t)(T) * 128 + lane]; CV1 = coef[(size_t)(T) * 128 + 64 + lane]; } while (0)
#define PV_ISSUE8(R, EV) do { _Pragma("unroll") for (int i = 0; i < 8; ++i) { const int e = __shfl((EV), 8 * i + sub); R[i] = *(const u32x4*)(v8 + (unsigned)(e * DM + col0)); } } while (0)
#define PV_CONS8(R, CV) do { _Pragma("unroll") for (int i = 0; i < 8; ++i) { float f[16]; fp8x16_to_f32(R[i], f); const float c = __shfl((CV), 8 * i + sub); \
            _Pragma("unroll") for (int q = 0; q < 16; ++q) acc[q] += c * f[q]; } } while (0)
    u32x4 ra[8], rb[8];
    int e0, e1, n0, n1, x0, x1; float c0, c1, d0, d1, y0, y1;
    PV_LOADIDX(wv, e0, e1, c0, c1);
    { const int t1 = nvis > 1 ? wv + nwv : wv; PV_LOADIDX(t1, n0, n1, d0, d1); }
    PV_ISSUE8(ra, e0); PV_ISSUE8(rb, e1);
#pragma unroll 1
    for (int it = 0; it < nvis; ++it) {
        const int tok = wv + it * nwv;
        const int t2 = wv + (it + 2 < nvis ? it + 2 : nvis - 1) * nwv;
        float* hr = h + (size_t)tok * DM + col0;
        const f32x4 hv0 = *(const f32x4*)hr, hv1 = *(const f32x4*)(hr + 4), hv2 = *(const f32x4*)(hr + 8), hv3 = *(const f32x4*)(hr + 12);
        PV_LOADIDX(t2, x0, x1, y0, y1);
        float acc[16];
#pragma unroll
        for (int q = 0; q < 16; ++q) acc[q] = 0.f;
        PV_CONS8(ra, c0);
        PV_ISSUE8(ra, n0);
        PV_CONS8(rb, c1);
        PV_ISSUE8(rb, n1);
#pragma unroll
        for (int q = 0; q < 16; ++q) { acc[q] += __shfl_xor(acc[q], 8); acc[q] += __shfl_xor(acc[q], 16); acc[q] += __shfl_xor(acc[q], 32); }
        float ss = 0.f;
        if (lane < 8) {
            const f32x4 o0 = hv0 + (f32x4){acc[0], acc[1], acc[2], acc[3]}, o1 = hv1 + (f32x4){acc[4], acc[5], acc[6], acc[7]};
            const f32x4 o2 = hv2 + (f32x4){acc[8], acc[9], acc[10], acc[11]}, o3 = hv3 + (f32x4){acc[12], acc[13], acc[14], acc[15]};
            *(f32x4*)hr = o0; *(f32x4*)(hr + 4) = o1; *(f32x4*)(hr + 8) = o2; *(f32x4*)(hr + 12) = o3;
            u32x4 w0, w1;
            w0.x = pk_bf16(o0[0], o0[1]); w0.y = pk_bf16(o0[2], o0[3]); w0.z = pk_bf16(o1[0], o1[1]); w0.w = pk_bf16(o1[2], o1[3]);
            w1.x = pk_bf16(o2[0], o2[1]); w1.y = pk_bf16(o2[2], o2[3]); w1.z = pk_bf16(o3[0], o3[1]); w1.w = pk_bf16(o3[2], o3[3]);
            *(u32x4*)(hb + (size_t)tok * DM + col0) = w0; *(u32x4*)(hb + (size_t)tok * DM + col0 + 8) = w1;
#pragma unroll
            for (int j = 0; j < 4; ++j) ss += o0[j] * o0[j] + o1[j] * o1[j] + o2[j] * o2[j] + o3[j] * o3[j];
        }
        ss += __shfl_xor(ss, 1); ss += __shfl_xor(ss, 2); ss += __shfl_xor(ss, 4);
        if (lane == 0) ssq2[(size_t)grp * NTOK + tok] = ss;
        e0 = n0; e1 = n1; c0 = d0; c1 = d1; n0 = x0; n1 = x1; d0 = y0; d1 = y1;
    }
#undef PV_LOADIDX
#undef PV_ISSUE8
#undef PV_CONS8
}
DI void p6v6_peer(const Params& p, int G) {
    unsigned char* ws = p.ws;
    const int tid = threadIdx.x, lane = tid & 63, wid = tid >> 6;
    const int gw = blockIdx.x * 8 + wid, nw = G * 8;
    const unsigned char* u8 = (const unsigned char*)(ws + WS_UB); const unsigned char* v8 = (const unsigned char*)(ws + WS_VB);
    const int* eidx = (const int*)(ws + R_EXP); const float* gsm = (const float*)(ws + R_GSM); const float* rs1v = (const float*)(ws + WS_RS1);
    float* h = p.out; bf16_t* hb = (bf16_t*)(ws + R_H1B); float* rs2 = (float*)(ws + WS_RS2);
#pragma unroll 1
    for (int tok = gw; tok < NTOK; tok += nw) {
        const float rs1 = rs1v[tok] * (1.0f / U8_SCALE);
        const u32x4 xa = *(const u32x4*)(hb + (size_t)tok * DM + lane * 16), xb = *(const u32x4*)(hb + (size_t)tok * DM + lane * 16 + 8);
        f32x2 xp[8];
#pragma unroll
        for (int q = 0; q < 4; ++q) { xp[q] = (f32x2){bflo(xa[q]), bfhi(xa[q])}; xp[4 + q] = (f32x2){bflo(xb[q]), bfhi(xb[q])}; }
        const int e0 = eidx[(size_t)tok * 128 + lane], e1 = eidx[(size_t)tok * 128 + 64 + lane];
        const float g0 = gsm[(size_t)tok * 128 + lane], g1 = gsm[(size_t)tok * 128 + 64 + lane];
        float coef0 = 0.f, coef1 = 0.f;
#pragma unroll
        for (int half = 0; half < 2; ++half) {
            const int ev = half ? e1 : e0;
            float part[64];
#pragma unroll
            for (int j = 0; j < 64; ++j) {
                const int e = __builtin_amdgcn_readlane(ev, j);
                const u32x4 w = *(const u32x4*)(u8 + (size_t)e * DM + lane * 16);
                f32x2 a2 = {0.f, 0.f};
#pragma unroll
                for (int q = 0; q < 4; ++q) {
                    a2 = __builtin_elementwise_fma(__builtin_amdgcn_cvt_pk_f32_fp8((int)w[q], false), xp[2 * q], a2);
                    a2 = __builtin_elementwise_fma(__builtin_amdgcn_cvt_pk_f32_fp8((int)w[q], true), xp[2 * q + 1], a2);
                }
                part[j] = a2.x + a2.y;
            }
#pragma unroll
            for (int m = 32; m >= 1; m >>= 1) {
                const bool up = (lane & m) != 0;
#pragma unroll
                for (int i = 0; i < m; ++i) { const float send = up ? part[i] : part[i + m], keep = up ? part[i + m] : part[i]; part[i] = keep + __shfl_xor(send, m); }
            }
            const float act = gelu_tanh(part[0] * rs1);
            if (half) coef1 = g1 * act * (1.0f / V8_SCALE); else coef0 = g0 * act * (1.0f / V8_SCALE);
        }
        f32x2 acc[8];
#pragma unroll
        for (int i = 0; i < 8; ++i) acc[i] = (f32x2){0.f, 0.f};
#pragma unroll
        for (int half = 0; half < 2; ++half) {
            const int ev = half ? e1 : e0; const float cv = half ? coef1 : coef0;
#pragma unroll 16
            for (int j = 0; j < 64; ++j) {
                const int e = __builtin_amdgcn_readlane(ev, j);
                const float c = __uint_as_float(__builtin_amdgcn_readlane(__float_as_uint(cv), j));
                const u32x4 w = *(const u32x4*)(v8 + (size_t)e * DM + lane * 16);
                const f32x2 c2 = {c, c};
#pragma unroll
                for (int q = 0; q < 4; ++q) {
                    acc[2 * q] = __builtin_elementwise_fma(__builtin_amdgcn_cvt_pk_f32_fp8((int)w[q], false), c2, acc[2 * q]);
                    acc[2 * q + 1] = __builtin_elementwise_fma(__builtin_amdgcn_cvt_pk_f32_fp8((int)w[q], true), c2, acc[2 * q + 1]);
                }
            }
        }
        float* hr = h + (size_t)tok * DM + lane * 16;
        u32x4 w0, w1; float ss = 0.f;
#pragma unroll
        for (int q4 = 0; q4 < 4; ++q4) {
            f32x4 hv = *(f32x4*)(hr + 4 * q4);
            hv += (f32x4){acc[2 * q4].x, acc[2 * q4].y, acc[2 * q4 + 1].x, acc[2 * q4 + 1].y};
            *(f32x4*)(hr + 4 * q4) = hv;
            ss += (hv[0] * hv[0] + hv[1] * hv[1]) + (hv[2] * hv[2] + hv[3] * hv[3]);
            const unsigned a_ = pk_bf16(hv[0], hv[1]), b_ = pk_bf16(hv[2], hv[3]);
            if (q4 == 0) { w0.x = a_; w0.y = b_; } else if (q4 == 1) { w0.z = a_; w0.w = b_; } else if (q4 == 2) { w1.x = a_; w1.y = b_; } else { w1.z = a_; w1.w = b_; }
        }
        *(u32x4*)(hb + (size_t)tok * DM + lane * 16) = w0; *(u32x4*)(hb + (size_t)tok * DM + lane * 16 + 8) = w1;
        ss = wave_sum(ss);
        if (lane == 0) rs2[tok] = rsqrtf(ss * (1.0f / DM) + EPS);
    }
}
DI void p6v6_u(const Params& p, int G) {
    unsigned char* ws = p.ws;
    const int tid = threadIdx.x, lane = tid & 63, wid = tid >> 6;
    const int gw = blockIdx.x * 8 + wid, nw = G * 8;
    const unsigned char* u8 = (const unsigned char*)(ws + WS_UB); const unsigned char* v8 = (const unsigned char*)(ws + WS_VB);
    const int* eidx = (const int*)(ws + R_EXP); const float* gsm = (const float*)(ws + R_GSM); const float* rs1v = (const float*)(ws + WS_RS1);
    float* h = p.out; bf16_t* hb = (bf16_t*)(ws + R_H1B); float* rs2 = (float*)(ws + WS_RS2);
#pragma unroll 1
    for (int tok = gw; tok < NTOK; tok += nw) {
        const float rs1 = rs1v[tok] * (1.0f / U8_SCALE);
        const u32x4 xa = *(const u32x4*)(hb + (size_t)tok * DM + lane * 16), xb = *(const u32x4*)(hb + (size_t)tok * DM + lane * 16 + 8);
        f32x2 xp[8];
#pragma unroll
        for (int q = 0; q < 4; ++q) { xp[q] = (f32x2){bflo(xa[q]), bfhi(xa[q])}; xp[4 + q] = (f32x2){bflo(xb[q]), bfhi(xb[q])}; }
        const int e0 = eidx[(size_t)tok * 128 + lane], e1 = eidx[(size_t)tok * 128 + 64 + lane];
        const float g0 = gsm[(size_t)tok * 128 + lane], g1 = gsm[(size_t)tok * 128 + 64 + lane];
        float coef0 = 0.f, coef1 = 0.f;
#pragma unroll
        for (int half = 0; half < 2; ++half) {
            const int ev = half ? e1 : e0;
            float part[64];
#pragma unroll
            for (int j = 0; j < 64; ++j) {
                const int e = __builtin_amdgcn_readlane(ev, j);
                const u32x4 w = *(const u32x4*)(u8 + (size_t)e * DM + lane * 16);
                f32x2 a2 = {0.f, 0.f};
#pragma unroll
                for (int q = 0; q < 4; ++q) {
                    a2 = __builtin_elementwise_fma(__builtin_amdgcn_cvt_pk_f32_fp8((int)w[q], false), xp[2 * q], a2);
                    a2 = __builtin_elementwise_fma(__builtin_amdgcn_cvt_pk_f32_fp8((int)w[q], true), xp[2 * q + 1], a2);
                }
                part[j] = a2.x + a2.y;
            }
#pragma unroll
            for (int m = 32; m >= 1; m >>= 1) {
                const bool up = (lane & m) != 0;
#pragma unroll
                for (int i = 0; i < m; ++i) { const float send = up ? part[i] : part[i + m], keep = up ? part[i + m] : part[i]; part[i] = keep + __shfl_xor(send, m); }
            }
            const float act = gelu_tanh(part[0] * rs1);
            if (half) coef1 = g1 * act * (1.0f / V8_SCALE); else coef0 = g0 * act * (1.0f / V8_SCALE);
        }
        float* coef = (float*)(ws + R_COEF);
        coef[(size_t)tok * 128 + lane] = coef0; coef[(size_t)tok * 128 + 64 + lane] = coef1;
    }
}
DI void p6v6_v(const Params& p, int G) {
    unsigned char* ws = p.ws;
    const int tid = threadIdx.x, lane = tid & 63, wid = tid >> 6;
    const int gw = blockIdx.x * 8 + wid, nw = G * 8;
    const unsigned char* v8 = (const unsigned char*)(ws + WS_VB);
    const int* eidx = (const int*)(ws + R_EXP); const float* coef = (const float*)(ws + R_COEF);
    float* h = p.out; bf16_t* hb = (bf16_t*)(ws + R_H1B); float* rs2 = (float*)(ws + WS_RS2);
#pragma unroll 1
    for (int tok = gw; tok < NTOK; tok += nw) {
        const int e0 = eidx[(size_t)tok * 128 + lane], e1 = eidx[(size_t)tok * 128 + 64 + lane];
        const float coef0 = coef[(size_t)tok * 128 + lane], coef1 = coef[(size_t)tok * 128 + 64 + lane];
        f32x2 acc[8];
#pragma unroll
        for (int i = 0; i < 8; ++i) acc[i] = (f32x2){0.f, 0.f};
#pragma unroll
        for (int half = 0; half < 2; ++half) {
            const int ev = half ? e1 : e0; const float cv = half ? coef1 : coef0;
#pragma unroll 16
            for (int j = 0; j < 64; ++j) {
                const int e = __builtin_amdgcn_readlane(ev, j);
                const float c = __uint_as_float(__builtin_amdgcn_readlane(__float_as_uint(cv), j));
                const u32x4 w = *(const u32x4*)(v8 + (size_t)e * DM + lane * 16);
                const f32x2 c2 = {c, c};
#pragma unroll
                for (int q = 0; q < 4; ++q) {
                    acc[2 * q] = __builtin_elementwise_fma(__builtin_amdgcn_cvt_pk_f32_fp8((int)w[q], false), c2, acc[2 * q]);
                    acc[2 * q + 1] = __builtin_elementwise_fma(__builtin_amdgcn_cvt_pk_f32_fp8((int)w[q], true), c2, acc[2 * q + 1]);
                }
            }
        }
        float* hr = h + (size_t)tok * DM + lane * 16;
        u32x4 w0, w1; float ss = 0.f;
#pragma unroll
        for (int q4 = 0; q4 < 4; ++q4) {
            f32x4 hv = *(f32x4*)(hr + 4 * q4);
            hv += (f32x4){acc[2 * q4].x, acc[2 * q4].y, acc[2 * q4 + 1].x, acc[2 * q4 + 1].y};
            *(f32x4*)(hr + 4 * q4) = hv;
            ss += (hv[0] * hv[0] + hv[1] * hv[1]) + (hv[2] * hv[2] + hv[3] * hv[3]);
            const unsigned a_ = pk_bf16(hv[0], hv[1]), b_ = pk_bf16(hv[2], hv[3]);
            if (q4 == 0) { w0.x = a_; w0.y = b_; } else if (q4 == 1) { w0.z = a_; w0.w = b_; } else if (q4 == 2) { w1.x = a_; w1.y = b_; } else { w1.z = a_; w1.w = b_; }
        }
        *(u32x4*)(hb + (size_t)tok * DM + lane * 16) = w0; *(u32x4*)(hb + (size_t)tok * DM + lane * 16 + 8) = w1;
        ss = wave_sum(ss);
        if (lane == 0) rs2[tok] = rsqrtf(ss * (1.0f / DM) + EPS);
    }
}
DI void p6u_cols(const Params& p, int G) {
    unsigned char* ws = p.ws;
    const int tid = threadIdx.x, lane = tid & 63, wid = tid >> 6, grp = blockIdx.x & 7, rank = blockIdx.x >> 3;
    const int nrank = (G - grp + 7) >> 3, wv = rank * 8 + wid, nwv = nrank * 8;
    const unsigned char* u8 = (const unsigned char*)(ws + WS_UB); const bf16_t* hb = (const bf16_t*)(ws + R_H1B);
    const int* eidx = (const int*)(ws + R_EXP);
    float* part = (float*)(ws + R_BIG) + (size_t)grp * NTOK * 128;
    const int sub = lane >> 3, col0 = grp * 128 + (lane & 7) * 16;
    if (wv >= NTOK) return;
    const int nvis = (NTOK - wv + nwv - 1) / nwv;
#define PC_LOADIDX(T, EV0, EV1, XA, XB) do { EV0 = eidx[(size_t)(T) * 128 + lane]; EV1 = eidx[(size_t)(T) * 128 + 64 + lane]; \
        XA = *(const u32x4*)(hb + (size_t)(T) * DM + col0); XB = *(const u32x4*)(hb + (size_t)(T) * DM + col0 + 8); } while (0)
#define PC_ISSUE8(R, EV) do { _Pragma("unroll") for (int i = 0; i < 8; ++i) { const int e = __shfl((EV), 8 * i + sub); R[i] = *(const u32x4*)(u8 + (unsigned)(e * DM + col0)); } } while (0)
#define PC_CONS8(R, P0) do { _Pragma("unroll") for (int i = 0; i < 8; ++i) { f32x2 a2 = {0.f, 0.f}; \
            _Pragma("unroll") for (int q = 0; q < 4; ++q) { \
                a2 = __builtin_elementwise_fma(__builtin_amdgcn_cvt_pk_f32_fp8((int)R[i][q], false), xp[2 * q], a2); \
                a2 = __builtin_elementwise_fma(__builtin_amdgcn_cvt_pk_f32_fp8((int)R[i][q], true), xp[2 * q + 1], a2); } \
            pd[(P0) + i] = a2.x + a2.y; __builtin_amdgcn_sched_barrier(0); } } while (0)
    u32x4 ra[8], rb[8];
    int e0, e1, n0, n1, x0, x1; u32x4 xa0, xb0, xa1, xb1, xa2, xb2;
    PC_LOADIDX(wv, e0, e1, xa0, xb0);
    { const int t1 = nvis > 1 ? wv + nwv : wv; PC_LOADIDX(t1, n0, n1, xa1, xb1); }
    PC_ISSUE8(ra, e0); PC_ISSUE8(rb, e1);
#pragma unroll 1
    for (int it = 0; it < nvis; ++it) {
        const int tok = wv + it * nwv;
        const int t2 = wv + (it + 2 < nvis ? it + 2 : nvis - 1) * nwv;
        PC_LOADIDX(t2, x0, x1, xa2, xb2);
        f32x2 xp[8];
#pragma unroll
        for (int q = 0; q < 4; ++q) { xp[q] = (f32x2){bflo(xa0[q]), bfhi(xa0[q])}; xp[4 + q] = (f32x2){bflo(xb0[q]), bfhi(xb0[q])}; }
        float pd[16];
        PC_CONS8(ra, 0);
        PC_ISSUE8(ra, n0);
        PC_CONS8(rb, 8);
        PC_ISSUE8(rb, n1);
#define PC_RS(M, LB) do { const bool up = (lane & (LB)) != 0; _Pragma("unroll") for (int i = 0; i < (M); ++i) { \
            const float send = up ? pd[i] : pd[i + (M)], keep = up ? pd[i + (M)] : pd[i]; pd[i] = keep + __shfl_xor(send, (LB)); } } while (0)
        PC_RS(8, 4); PC_RS(4, 2); PC_RS(2, 1);
#undef PC_RS
        const int i0 = 8 * ((lane >> 2) & 1) + 4 * ((lane >> 1) & 1) + 2 * (lane & 1);
        *(f32x2*)(part + (size_t)tok * 128 + sub * 16 + i0) = (f32x2){pd[0], pd[1]};
        e0 = n0; e1 = n1; xa0 = xa1; xb0 = xb1; n0 = x0; n1 = x1; xa1 = xa2; xb1 = xb2;
    }
#undef PC_LOADIDX
#undef PC_ISSUE8
#undef PC_CONS8
}
DI void p6u_combine(const Params& p, int G) {
    unsigned char* ws = p.ws;
    const float* part = (const float*)(ws + R_BIG); const float* gsm = (const float*)(ws + R_GSM); const float* rs1v = (const float*)(ws + WS_RS1);
    float* coef = (float*)(ws + R_COEF);
    const size_t n = (size_t)NTOK * 128, nthr = (size_t)G * MK_THREADS;
    for (size_t idx = (size_t)blockIdx.x * MK_THREADS + threadIdx.x; idx < n; idx += nthr) {
        const size_t tok = idx >> 7; const int j = (int)(idx & 127), pos = (j & 7) * 16 + (j >> 3);
        float s = 0.f;
#pragma unroll
        for (int sl = 0; sl < 8; ++sl) s += part[(size_t)sl * NTOK * 128 + tok * 128 + pos];
        coef[idx] = gsm[idx] * (1.0f / V8_SCALE) * gelu_tanh(s * (rs1v[tok] * (1.0f / U8_SCALE)));
    }
}

#if PEER_FP4
DI void fp4x16_dot(const u32x2 w, const f32x2 (&xp)[8], f32x2& a2) {
#define F4D(Q, B) a2 = __builtin_elementwise_fma(__builtin_amdgcn_cvt_scalef32_pk_f32_fp4(w[Q], 1.0f, B), xp[4 * (Q) + (B)], a2)
    F4D(0, 0); F4D(0, 1); F4D(0, 2); F4D(0, 3); F4D(1, 0); F4D(1, 1); F4D(1, 2); F4D(1, 3);
#undef F4D
}
DI void p6f4_u(const Params& p, int G) {
    unsigned char* ws = p.ws;
    const int tid = threadIdx.x, lane = tid & 63, wid = tid >> 6;
    const int gw = blockIdx.x * 8 + wid, nw = G * 8;
    const unsigned char* u4 = (const unsigned char*)(ws + WS_UB);
    const int* eidx = (const int*)(ws + R_EXP); const float* gsm = (const float*)(ws + R_GSM); const float* rs1v = (const float*)(ws + WS_RS1);
    bf16_t* hb = (bf16_t*)(ws + R_H1B); float* coef = (float*)(ws + R_COEF);
#pragma unroll 1
    for (int tok = gw; tok < NTOK; tok += nw) {
        const float rs1 = rs1v[tok] * (1.0f / U8_SCALE);
        const u32x4 xa = *(const u32x4*)(hb + (size_t)tok * DM + lane * 16), xb = *(const u32x4*)(hb + (size_t)tok * DM + lane * 16 + 8);
        f32x2 xp[8];
#pragma unroll
        for (int q = 0; q < 4; ++q) { xp[q] = (f32x2){bflo(xa[q]), bfhi(xa[q])}; xp[4 + q] = (f32x2){bflo(xb[q]), bfhi(xb[q])}; }
        const int e0 = eidx[(size_t)tok * 128 + lane], e1 = eidx[(size_t)tok * 128 + 64 + lane];
        const float g0 = gsm[(size_t)tok * 128 + lane], g1 = gsm[(size_t)tok * 128 + 64 + lane];
#pragma unroll
        for (int half = 0; half < 2; ++half) {
            const int ev = half ? e1 : e0;
            float part[64];
#pragma unroll
            for (int j = 0; j < 64; ++j) {
                const int e = __builtin_amdgcn_readlane(ev, j);
                const u32x2 w = *(const u32x2*)(u4 + (size_t)e * (DM / 2) + lane * 8);
                f32x2 a2 = {0.f, 0.f};
                fp4x16_dot(w, xp, a2);
                part[j] = a2.x + a2.y;
            }
#define F4_RS(M) do { const bool up = (lane & (M)) != 0; _Pragma("unroll") for (int i = 0; i < (M); ++i) { \
                const float send = up ? part[i] : part[i + (M)], keep = up ? part[i + (M)] : part[i]; part[i] = keep + __shfl_xor(send, (M)); } } while (0)
            F4_RS(32); F4_RS(16); F4_RS(8); F4_RS(4); F4_RS(2); F4_RS(1);
#undef F4_RS
            const float act = gelu_tanh(part[0] * rs1);
            coef[(size_t)tok * 128 + half * 64 + lane] = (half ? g1 : g0) * act * (1.0f / V8_SCALE);
        }
    }
}
template <int PMODE> DI void p6f4_v(const Params& p, int G) {
    unsigned char* ws = p.ws;
    const int tid = threadIdx.x, lane = tid & 63, wid = tid >> 6;
    const int grp = blockIdx.x & 7, rank = blockIdx.x >> 3;
    const int nrank = (G - grp + 7) >> 3;
    const int wv = rank * 8 + wid, nwv = nrank * 8;
    const unsigned char* v4 = (const unsigned char*)(ws + WS_VB);
    const int* eidx = (const int*)(ws + R_EXP); const float* coef = (const float*)(ws + R_COEF);
    float* h = p.out; bf16_t* hb = (bf16_t*)(ws + R_H1B); float* ssq2 = (float*)(ws + WS_SSQ2);
    const int sub = lane >> 3, col0 = grp * 128 + (lane & 7) * 16;
    if (wv >= NTOK) return;
    const int nvis = (NTOK - wv + nwv - 1) / nwv;
#define PV_LOADIDX(T, EV0, EV1, CV0, CV1) do { EV0 = eidx[(size_t)(T) * 128 + lane]; EV1 = eidx[(size_t)(T) * 128 + 64 + lane]; CV0 = coef[(size_t)(T) * 128 + lane]; CV1 = coef[(size_t)(T) * 128 + 64 + lane]; } while (0)
#define PV_ISSUE8(R, EV) do { _Pragma("unroll") for (int i = 0; i < 8; ++i) { const int e = __shfl((EV), 8 * i + sub); R[i] = *(const u32x2*)(v4 + (unsigned)(e * (DM / 2) + (col0 >> 1))); } } while (0)
#define PV_CONS8(R, CV) do { _Pragma("unroll") for (int i = 0; i < 8; ++i) { const float c = __shfl((CV), 8 * i + sub); const f32x2 c2 = {c, c}; \
            F4A(R[i], 0, 0); F4A(R[i], 0, 1); F4A(R[i], 0, 2); F4A(R[i], 0, 3); F4A(R[i], 1, 0); F4A(R[i], 1, 1); F4A(R[i], 1, 2); F4A(R[i], 1, 3); } } while (0)
#define F4A(RR, Q, B) acc[4 * (Q) + (B)] = __builtin_elementwise_fma(__builtin_amdgcn_cvt_scalef32_pk_f32_fp4(RR[Q], 1.0f, B), c2, acc[4 * (Q) + (B)])
    u32x2 ra[8], rb[8];
    int e0, e1, n0, n1, x0, x1; float c0, c1, d0, d1, y0, y1;
    PV_LOADIDX(wv, e0, e1, c0, c1);
    { const int t1 = nvis > 1 ? wv + nwv : wv; PV_LOADIDX(t1, n0, n1, d0, d1); }
    PV_ISSUE8(ra, e0); PV_ISSUE8(rb, e1);
#pragma unroll 1
    for (int it = 0; it < nvis; ++it) {
        const int tok = wv + it * nwv;
        const int t2 = wv + (it + 2 < nvis ? it + 2 : nvis - 1) * nwv;
        float* hr = h + (size_t)tok * DM + col0;
        const f32x4 hv0 = *(const f32x4*)hr, hv1 = *(const f32x4*)(hr + 4), hv2 = *(const f32x4*)(hr + 8), hv3 = *(const f32x4*)(hr + 12);
        PV_LOADIDX(t2, x0, x1, y0, y1);
        f32x2 acc[8];
#pragma unroll
        for (int q = 0; q < 8; ++q) acc[q] = (f32x2){0.f, 0.f};
        PV_CONS8(ra, c0);
        PV_ISSUE8(ra, n0);
        PV_CONS8(rb, c1);
        PV_ISSUE8(rb, n1);
        float av[16];
#pragma unroll
        for (int q = 0; q < 8; ++q) { av[2 * q] = acc[q].x; av[2 * q + 1] = acc[q].y; }
#pragma unroll
        for (int q = 0; q < 16; ++q) { av[q] += __shfl_xor(av[q], 8); av[q] += __shfl_xor(av[q], 16); av[q] += __shfl_xor(av[q], 32); }
        float ss = 0.f;
        if (lane < 8) {
            const f32x4 o0 = hv0 + (f32x4){av[0], av[1], av[2], av[3]}, o1 = hv1 + (f32x4){av[4], av[5], av[6], av[7]};
            const f32x4 o2 = hv2 + (f32x4){av[8], av[9], av[10], av[11]}, o3 = hv3 + (f32x4){av[12], av[13], av[14], av[15]};
            *(f32x4*)hr = o0; *(f32x4*)(hr + 4) = o1; *(f32x4*)(hr + 8) = o2; *(f32x4*)(hr + 12) = o3;
            u32x4 w0, w1;
            w0.x = pk_bf16(o0[0], o0[1]); w0.y = pk_bf16(o0[2], o0[3]); w0.z = pk_bf16(o1[0], o1[1]); w0.w = pk_bf16(o1[2], o1[3]);
            w1.x = pk_bf16(o2[0], o2[1]); w1.y = pk_bf16(o2[2], o2[3]); w1.z = pk_bf16(o3[0], o3[1]); w1.w = pk_bf16(o3[2], o3[3]);
            *(u32x4*)(hb + (size_t)tok * DM + col0) = w0; *(u32x4*)(hb + (size_t)tok * DM + col0 + 8) = w1;
#pragma unroll
            for (int j = 0; j < 4; ++j) ss += o0[j] * o0[j] + o1[j] * o1[j] + o2[j] * o2[j] + o3[j] * o3[j];
        }
        ss += __shfl_xor(ss, 1); ss += __shfl_xor(ss, 2); ss += __shfl_xor(ss, 4);
        if (lane == 0) ssq2[(size_t)grp * NTOK + tok] = ss;
        e0 = n0; e1 = n1; c0 = d0; c1 = d1; n0 = x0; n1 = x1; d0 = y0; d1 = y1;
    }
#undef PV_LOADIDX
#undef PV_ISSUE8
#undef PV_CONS8
#undef F4A
}
#endif

#if PEER_I8U
constexpr float U_ISCALE = 640.0f;
#define I8_ISSUE(SET, EV, J0) do { int ev_ = (EV); asm volatile("" : "+v"(ev_)); _Pragma("unroll") for (int k = 0; k < 16; ++k) { const int e = __builtin_amdgcn_readlane(ev_, (J0) + k); \
        SET[k] = *(const u32x4*)(u8 + ((unsigned)e * (unsigned)DM + (unsigned)(lane * 16))); } __builtin_amdgcn_sched_barrier(0); } while (0)
#define I8_CONS(SET, P0) do { _Pragma("unroll") for (int k = 0; k < 16; ++k) { \
        int a = __builtin_amdgcn_sdot4((int)SET[k].x, (int)xq[0], 0, false); a = __builtin_amdgcn_sdot4((int)SET[k].y, (int)xq[1], a, false); \
        a = __builtin_amdgcn_sdot4((int)SET[k].z, (int)xq[2], a, false); a = __builtin_amdgcn_sdot4((int)SET[k].w, (int)xq[3], a, false); \
        part[(P0) + k] = (float)a; } __builtin_amdgcn_sched_barrier(0); } while (0)
#define I8_RS(M) do { const bool up = (lane & (M)) != 0; _Pragma("unroll") for (int i = 0; i < (M); ++i) { \
        const float send = up ? part[i] : part[i + (M)], keep = up ? part[i + (M)] : part[i]; part[i] = keep + __shfl_xor(send, (M)); } } while (0)
DI void p6i8_u(const Params& p, int G) {
    unsigned char* ws = p.ws;
    const int tid = threadIdx.x, lane = tid & 63, wid = tid >> 6;
    const int gw = blockIdx.x * 8 + wid, nw = G * 8;
    const unsigned char* u8 = (const unsigned char*)(ws + WS_UB);
    const int* eidx = (const int*)(ws + R_EXP); const float* gsm = (const float*)(ws + R_GSM); const float* rs1v = (const float*)(ws + WS_RS1);
    bf16_t* hb = (bf16_t*)(ws + R_H1B); float* coef = (float*)(ws + R_COEF);
#pragma unroll 1
    for (int tok = gw; tok < NTOK; tok += nw) {
        const int e0 = eidx[(size_t)tok * 128 + lane], e1 = eidx[(size_t)tok * 128 + 64 + lane];
        u32x4 sa[16], sb[16];
        I8_ISSUE(sa, e0, 0);
        I8_ISSUE(sb, e0, 16);
        const u32x4 xa = *(const u32x4*)(hb + (size_t)tok * DM + lane * 16), xb = *(const u32x4*)(hb + (size_t)tok * DM + lane * 16 + 8);
        const float g0 = gsm[(size_t)tok * 128 + lane], g1 = gsm[(size_t)tok * 128 + 64 + lane];
        const float rs1 = rs1v[tok];
        float xf[16];
#pragma unroll
        for (int q = 0; q < 4; ++q) { xf[2 * q] = bflo(xa[q]); xf[2 * q + 1] = bfhi(xa[q]); xf[8 + 2 * q] = bflo(xb[q]); xf[8 + 2 * q + 1] = bfhi(xb[q]); }
        float amax = 0.f;
#pragma unroll
        for (int i = 0; i < 16; ++i) amax = fmaxf(amax, fabsf(xf[i]));
        amax = wave_max(amax);
        const float sx = fmaxf(amax, 1e-20f) * (1.0f / 127.0f), isx = 1.0f / sx;
        unsigned xq[4];
#pragma unroll
        for (int q = 0; q < 4; ++q) {
            unsigned w = 0u;
#pragma unroll
            for (int b = 0; b < 4; ++b) w |= ((unsigned)(int)rintf(xf[4 * q + b] * isx) & 0xffu) << (8 * b);
            xq[q] = w;
        }
        const float scl = rs1 * sx * (1.0f / U_ISCALE);
        float part[64];
        I8_CONS(sa, 0);  I8_ISSUE(sa, e0, 32);
        I8_CONS(sb, 16); I8_ISSUE(sb, e0, 48);
        I8_CONS(sa, 32); I8_ISSUE(sa, e1, 0);
        I8_CONS(sb, 48); I8_ISSUE(sb, e1, 16);
        I8_RS(32); I8_RS(16); I8_RS(8); I8_RS(4); I8_RS(2); I8_RS(1);
        coef[(size_t)tok * 128 + lane] = g0 * gelu_tanh(part[0] * scl) * (1.0f / V8_SCALE);
        I8_CONS(sa, 0);  I8_ISSUE(sa, e1, 32);
        I8_CONS(sb, 16); I8_ISSUE(sb, e1, 48);
        I8_CONS(sa, 32);
        I8_CONS(sb, 48);
        I8_RS(32); I8_RS(16); I8_RS(8); I8_RS(4); I8_RS(2); I8_RS(1);
        coef[(size_t)tok * 128 + 64 + lane] = g1 * gelu_tanh(part[0] * scl) * (1.0f / V8_SCALE);
    }
}
#undef I8_ISSUE
#undef I8_CONS
#undef I8_RS
#endif
#define V8_ISSUE(SET, EV, J0) do { int ev_ = (EV); asm volatile("" : "+v"(ev_)); _Pragma("unroll") for (int k = 0; k < 16; ++k) { const int e = __builtin_amdgcn_readlane(ev_, (J0) + k); \
        SET[k] = *(const u32x4*)(v8 + ((unsigned)e * (unsigned)DM + (unsigned)(lane * 16))); } __builtin_amdgcn_sched_barrier(0); } while (0)
#define V8_FMA(W, I) do { t_[2 * (I)] = __builtin_elementwise_fma(__builtin_amdgcn_cvt_pk_f32_fp8((int)(W), false), c2, t_[2 * (I)]); \
        t_[2 * (I) + 1] = __builtin_elementwise_fma(__builtin_amdgcn_cvt_pk_f32_fp8((int)(W), true), c2, t_[2 * (I) + 1]); } while (0)
#define V8_ROW(SET, CV, J0, K) do { const float c = (CV)[(J0) + (K)]; const f32x2 c2 = {c, c}; const u32x4 w_ = SET[K]; \
        V8_FMA(w_.x, 0); V8_FMA(w_.y, 1); V8_FMA(w_.z, 2); V8_FMA(w_.w, 3); } while (0)
#define V8_CONS(SET, CV, J0) do { f32x2 t_[8]; _Pragma("unroll") for (int i_ = 0; i_ < 8; ++i_) t_[i_] = (f32x2){0.f, 0.f}; V8_ROW(SET, CV, J0, 0); V8_ROW(SET, CV, J0, 1); V8_ROW(SET, CV, J0, 2); V8_ROW(SET, CV, J0, 3); V8_ROW(SET, CV, J0, 4); V8_ROW(SET, CV, J0, 5); \
        V8_ROW(SET, CV, J0, 6); V8_ROW(SET, CV, J0, 7); V8_ROW(SET, CV, J0, 8); V8_ROW(SET, CV, J0, 9); V8_ROW(SET, CV, J0, 10); V8_ROW(SET, CV, J0, 11); \
        V8_ROW(SET, CV, J0, 12); V8_ROW(SET, CV, J0, 13); V8_ROW(SET, CV, J0, 14); V8_ROW(SET, CV, J0, 15); \
        _Pragma("unroll") for (int i_ = 0; i_ < 8; ++i_) acc[i_] += t_[i_]; __builtin_amdgcn_sched_barrier(0); } while (0)
DI void p6v8_v(const Params& p, LAS3 unsigned char* lds, int G) {
    unsigned char* ws = p.ws;
    const int tid = threadIdx.x, lane = tid & 63, wid = tid >> 6;
    const int gw = blockIdx.x * 8 + wid, nw = G * 8;
    const unsigned char* v8 = (const unsigned char*)(ws + WS_VB);
    const int* eidx = (const int*)(ws + R_EXP); const float* coef = (const float*)(ws + R_COEF);
    float* h = p.out; bf16_t* hb = (bf16_t*)(ws + R_H1B); float* rs2 = (float*)(ws + WS_RS2);
#pragma unroll 1
    for (int tok = gw; tok < NTOK; tok += nw) {
        const int e0 = eidx[(size_t)tok * 128 + lane], e1 = eidx[(size_t)tok * 128 + 64 + lane];
        u32x4 sa[16], sb[16];
        V8_ISSUE(sa, e0, 0);
        V8_ISSUE(sb, e0, 16);
        LAS3 float* cl = (LAS3 float*)(lds + wid * 512);
        cl[lane] = coef[(size_t)tok * 128 + lane]; cl[64 + lane] = coef[(size_t)tok * 128 + 64 + lane];
        LAS3 const float* c0 = cl; LAS3 const float* c1 = cl + 64;
        float* hr = h + (size_t)tok * DM + lane * 16;
        const f32x4 hv0 = *(const f32x4*)hr, hv1 = *(const f32x4*)(hr + 4), hv2 = *(const f32x4*)(hr + 8), hv3 = *(const f32x4*)(hr + 12);
        f32x2 acc[8];
#pragma unroll
        for (int i = 0; i < 8; ++i) acc[i] = (f32x2){0.f, 0.f};
        V8_CONS(sa, c0, 0);  V8_ISSUE(sa, e0, 32);
        V8_CONS(sb, c0, 16); V8_ISSUE(sb, e0, 48);
        V8_CONS(sa, c0, 32); V8_ISSUE(sa, e1, 0);
        V8_CONS(sb, c0, 48); V8_ISSUE(sb, e1, 16);
        V8_CONS(sa, c1, 0);  V8_ISSUE(sa, e1, 32);
        V8_CONS(sb, c1, 16); V8_ISSUE(sb, e1, 48);
        V8_CONS(sa, c1, 32);
        V8_CONS(sb, c1, 48);
        const f32x4 o0 = hv0 + (f32x4){acc[0].x, acc[0].y, acc[1].x, acc[1].y}, o1 = hv1 + (f32x4){acc[2].x, acc[2].y, acc[3].x, acc[3].y};
        const f32x4 o2 = hv2 + (f32x4){acc[4].x, acc[4].y, acc[5].x, acc[5].y}, o3 = hv3 + (f32x4){acc[6].x, acc[6].y, acc[7].x, acc[7].y};
        *(f32x4*)hr = o0; *(f32x4*)(hr + 4) = o1; *(f32x4*)(hr + 8) = o2; *(f32x4*)(hr + 12) = o3;
        u32x4 w0, w1;
        w0.x = pk_bf16(o0[0], o0[1]); w0.y = pk_bf16(o0[2], o0[3]); w0.z = pk_bf16(o1[0], o1[1]); w0.w = pk_bf16(o1[2], o1[3]);
        w1.x = pk_bf16(o2[0], o2[1]); w1.y = pk_bf16(o2[2], o2[3]); w1.z = pk_bf16(o3[0], o3[1]); w1.w = pk_bf16(o3[2], o3[3]);
        *(u32x4*)(hb + (size_t)tok * DM + lane * 16) = w0; *(u32x4*)(hb + (size_t)tok * DM + lane * 16 + 8) = w1;
        float ss = 0.f;
#pragma unroll
        for (int j = 0; j < 4; ++j) ss += o0[j] * o0[j] + o1[j] * o1[j] + o2[j] * o2[j] + o3[j] * o3[j];
        ss = wave_sum(ss);
        if (lane == 0) rs2[tok] = rsqrtf(ss * (1.0f / DM) + EPS);
    }
}
#undef V8_ISSUE
#undef V8_CONS
#undef V8_FMA
#undef V8_ROW

#if PEER_V4EXP
#define V4_ISSUE(SET, EV, J0) do { int ev_ = (EV); asm volatile("" : "+v"(ev_)); _Pragma("unroll") for (int k = 0; k < 16; ++k) { const int e = __builtin_amdgcn_readlane(ev_, (J0) + k); \
        SET[k] = *(const u32x2*)(v8 + ((unsigned)e * (unsigned)(DM / 2) + (unsigned)(lane * 8))); } __builtin_amdgcn_sched_barrier(0); } while (0)
#define V4_FMA(W, I) do { t_[4 * (I)] = __builtin_elementwise_fma(__builtin_amdgcn_cvt_scalef32_pk_f32_fp4((W), 1.0f, 0), c2, t_[4 * (I)]); \
        t_[4 * (I) + 1] = __builtin_elementwise_fma(__builtin_amdgcn_cvt_scalef32_pk_f32_fp4((W), 1.0f, 1), c2, t_[4 * (I) + 1]); \
        t_[4 * (I) + 2] = __builtin_elementwise_fma(__builtin_amdgcn_cvt_scalef32_pk_f32_fp4((W), 1.0f, 2), c2, t_[4 * (I) + 2]); \
        t_[4 * (I) + 3] = __builtin_elementwise_fma(__builtin_amdgcn_cvt_scalef32_pk_f32_fp4((W), 1.0f, 3), c2, t_[4 * (I) + 3]); } while (0)
#define V4_ROW(SET, CV, J0, K) do { const float c = (CV)[(J0) + (K)]; const f32x2 c2 = {c, c}; const u32x2 w_ = SET[K]; \
        V4_FMA(w_.x, 0); V4_FMA(w_.y, 1); } while (0)
#define V4_CONS(SET, CV, J0) do { f32x2 t_[8]; _Pragma("unroll") for (int i_ = 0; i_ < 8; ++i_) t_[i_] = (f32x2){0.f, 0.f}; V4_ROW(SET, CV, J0, 0); V4_ROW(SET, CV, J0, 1); V4_ROW(SET, CV, J0, 2); V4_ROW(SET, CV, J0, 3); V4_ROW(SET, CV, J0, 4); V4_ROW(SET, CV, J0, 5); \
        V4_ROW(SET, CV, J0, 6); V4_ROW(SET, CV, J0, 7); V4_ROW(SET, CV, J0, 8); V4_ROW(SET, CV, J0, 9); V4_ROW(SET, CV, J0, 10); V4_ROW(SET, CV, J0, 11); \
        V4_ROW(SET, CV, J0, 12); V4_ROW(SET, CV, J0, 13); V4_ROW(SET, CV, J0, 14); V4_ROW(SET, CV, J0, 15); \
        _Pragma("unroll") for (int i_ = 0; i_ < 8; ++i_) acc[i_] += t_[i_]; __builtin_amdgcn_sched_barrier(0); } while (0)
DI void p6v4_v(const Params& p, LAS3 unsigned char* lds, int G) {
    unsigned char* ws = p.ws;
    const int tid = threadIdx.x, lane = tid & 63, wid = tid >> 6;
    const int gw = blockIdx.x * 8 + wid, nw = G * 8;
    const unsigned char* v8 = (const unsigned char*)(ws + WS_VB);
    const int* eidx = (const int*)(ws + R_EXP); const float* coef = (const float*)(ws + R_COEF);
    float* h = p.out; bf16_t* hb = (bf16_t*)(ws + R_H1B); float* rs2 = (float*)(ws + WS_RS2);
#pragma unroll 1
    for (int tok = gw; tok < NTOK; tok += nw) {
        const int e0 = eidx[(size_t)tok * 128 + lane], e1 = eidx[(size_t)tok * 128 + 64 + lane];
        u32x2 sa[16], sb[16];
        V4_ISSUE(sa, e0, 0);
        V4_ISSUE(sb, e0, 16);
        LAS3 float* cl = (LAS3 float*)(lds + wid * 512);
        cl[lane] = coef[(size_t)tok * 128 + lane]; cl[64 + lane] = coef[(size_t)tok * 128 + 64 + lane];
        LAS3 const float* c0 = cl; LAS3 const float* c1 = cl + 64;
        float* hr = h + (size_t)tok * DM + lane * 16;
        const f32x4 hv0 = *(const f32x4*)hr, hv1 = *(const f32x4*)(hr + 4), hv2 = *(const f32x4*)(hr + 8), hv3 = *(const f32x4*)(hr + 12);
        f32x2 acc[8];
#pragma unroll
        for (int i = 0; i < 8; ++i) acc[i] = (f32x2){0.f, 0.f};
        V4_CONS(sa, c0, 0);  V4_ISSUE(sa, e0, 32);
        V4_CONS(sb, c0, 16); V4_ISSUE(sb, e0, 48);
        V4_CONS(sa, c0, 32); V4_ISSUE(sa, e1, 0);
        V4_CONS(sb, c0, 48); V4_ISSUE(sb, e1, 16);
        V4_CONS(sa, c1, 0);  V4_ISSUE(sa, e1, 32);
        V4_CONS(sb, c1, 16); V4_ISSUE(sb, e1, 48);
        V4_CONS(sa, c1, 32);
        V4_CONS(sb, c1, 48);
        const f32x4 o0 = hv0 + (f32x4){acc[0].x, acc[0].y, acc[1].x, acc[1].y}, o1 = hv1 + (f32x4){acc[2].x, acc[2].y, acc[3].x, acc[3].y};
        const f32x4 o2 = hv2 + (f32x4){acc[4].x, acc[4].y, acc[5].x, acc[5].y}, o3 = hv3 + (f32x4){acc[6].x, acc[6].y, acc[7].x, acc[7].y};
        *(f32x4*)hr = o0; *(f32x4*)(hr + 4) = o1; *(f32x4*)(hr + 8) = o2; *(f32x4*)(hr + 12) = o3;
        u32x4 w0, w1;
        w0.x = pk_bf16(o0[0], o0[1]); w0.y = pk_bf16(o0[2], o0[3]); w0.z = pk_bf16(o1[0], o1[1]); w0.w = pk_bf16(o1[2], o1[3]);
        w1.x = pk_bf16(o2[0], o2[1]); w1.y = pk_bf16(o2[2], o2[3]); w1.z = pk_bf16(o3[0], o3[1]); w1.w = pk_bf16(o3[2], o3[3]);
        *(u32x4*)(hb + (size_t)tok * DM + lane * 16) = w0; *(u32x4*)(hb + (size_t)tok * DM + lane * 16 + 8) = w1;
        float ss = 0.f;
#pragma unroll
        for (int j = 0; j < 4; ++j) ss += o0[j] * o0[j] + o1[j] * o1[j] + o2[j] * o2[j] + o3[j] * o3[j];
        ss = wave_sum(ss);
        if (lane == 0) rs2[tok] = rsqrtf(ss * (1.0f / DM) + EPS);
    }
}
#undef V4_ISSUE
#undef V4_CONS
#undef V4_FMA
#undef V4_ROW
#endif
#define VS_SETUP(BUF, E0, E1, C0, C1, EP, CP) do { LAS3 unsigned* eb = (LAS3 unsigned*)(wl + (BUF) * 1024); LAS3 float* cb = (LAS3 float*)(wl + (BUF) * 1024 + 512); \
        eb[(lane & 7) * 16 + (lane >> 3)] = (unsigned)(E0); eb[(lane & 7) * 16 + 8 + (lane >> 3)] = (unsigned)(E1); \
        cb[(lane & 7) * 16 + (lane >> 3)] = (C0); cb[(lane & 7) * 16 + 8 + (lane >> 3)] = (C1); \
        _Pragma("unroll") for (int q = 0; q < 4; ++q) { const u32x4 ev4 = *(LAS3 const u32x4*)(eb + sub * 16 + 4 * q); const f32x4 cv4 = *(LAS3 const f32x4*)(cb + sub * 16 + 4 * q); \
            EP[4 * q] = ev4.x; EP[4 * q + 1] = ev4.y; EP[4 * q + 2] = ev4.z; EP[4 * q + 3] = ev4.w; CP[4 * q] = cv4[0]; CP[4 * q + 1] = cv4[1]; CP[4 * q + 2] = cv4[2]; CP[4 * q + 3] = cv4[3]; } } while (0)
#define VS_ISSUE(SET, EP) do { _Pragma("unroll") for (int i = 0; i < 16; ++i) SET[i] = *(const u32x4*)(v8 + (EP[i] * (unsigned)DM + (unsigned)col0)); __builtin_amdgcn_sched_barrier(0); } while (0)
#define VS_FMA(W, I) do { t_[2 * (I)] = __builtin_elementwise_fma(__builtin_amdgcn_cvt_pk_f32_fp8((int)(W), false), c2, t_[2 * (I)]); \
        t_[2 * (I) + 1] = __builtin_elementwise_fma(__builtin_amdgcn_cvt_pk_f32_fp8((int)(W), true), c2, t_[2 * (I) + 1]); } while (0)
#define VS_ROW(SET, CP, K) do { const f32x2 c2 = {CP[K], CP[K]}; const u32x4 w_ = SET[K]; VS_FMA(w_.x, 0); VS_FMA(w_.y, 1); VS_FMA(w_.z, 2); VS_FMA(w_.w, 3); } while (0)
#define VS_RS(M, LB) do { const bool up = (lane & (LB)) != 0; _Pragma("unroll") for (int i = 0; i < (M); ++i) { \
        const float send = up ? av[i] : av[i + (M)], keep = up ? av[i + (M)] : av[i]; av[i] = keep + __shfl_xor(send, (LB)); } } while (0)
#define VS_CONSUME(SET, CP, TOK, HV) do { f32x2 t_[8]; _Pragma("unroll") for (int i_ = 0; i_ < 8; ++i_) t_[i_] = (f32x2){0.f, 0.f}; \
        VS_ROW(SET, CP, 0); VS_ROW(SET, CP, 1); VS_ROW(SET, CP, 2); VS_ROW(SET, CP, 3); VS_ROW(SET, CP, 4); VS_ROW(SET, CP, 5); VS_ROW(SET, CP, 6); VS_ROW(SET, CP, 7); \
        f32x2 t2_[8]; _Pragma("unroll") for (int i_ = 0; i_ < 8; ++i_) { t2_[i_] = t_[i_]; t_[i_] = (f32x2){0.f, 0.f}; } \
        VS_ROW(SET, CP, 8); VS_ROW(SET, CP, 9); VS_ROW(SET, CP, 10); VS_ROW(SET, CP, 11); VS_ROW(SET, CP, 12); VS_ROW(SET, CP, 13); VS_ROW(SET, CP, 14); VS_ROW(SET, CP, 15); \
        float av[16]; _Pragma("unroll") for (int i_ = 0; i_ < 8; ++i_) { av[2 * i_] = t_[i_].x + t2_[i_].x; av[2 * i_ + 1] = t_[i_].y + t2_[i_].y; } \
        VS_RS(8, 32); VS_RS(4, 16); VS_RS(2, 8); \
        const f32x2 o_ = (HV) + (f32x2){av[0], av[1]}; \
        *(f32x2*)(h + (size_t)(TOK) * DM + colL) = o_; *(unsigned*)(hb + (size_t)(TOK) * DM + colL) = pk_bf16(o_.x, o_.y); \
        const float ss_ = wave_sum(o_.x * o_.x + o_.y * o_.y); if (lane == 0) ssq2[(size_t)grp * NTOK + (TOK)] = ss_; \
        __builtin_amdgcn_sched_barrier(0); } while (0)
DI void p6vs_v(const Params& p, LAS3 unsigned char* lds, int G) {
    unsigned char* ws = p.ws;
    const int tid = threadIdx.x, lane = tid & 63, wid = tid >> 6, grp = blockIdx.x & 7, rank = blockIdx.x >> 3;
    const int nrank = (G - grp + 7) >> 3, wv = rank * 8 + wid, nwv = nrank * 8;
    const unsigned char* v8 = (const unsigned char*)(ws + WS_VB);
    const int* eidx = (const int*)(ws + R_EXP); const float* coef = (const float*)(ws + R_COEF);
    float* h = p.out; bf16_t* hb = (bf16_t*)(ws + R_H1B); float* ssq2 = (float*)(ws + WS_SSQ2);
    LAS3 unsigned char* wl = lds + wid * 2048;
    const int sub = lane >> 3, col0 = grp * 128 + (lane & 7) * 16;
    const int colL = col0 + 8 * ((lane >> 5) & 1) + 4 * ((lane >> 4) & 1) + 2 * ((lane >> 3) & 1);
    if (wv >= NTOK) return;
    const int nvis = (NTOK - wv + nwv - 1) / nwv;
#define VS_TOK(V) (wv + ((V) < nvis ? (V) : nvis - 1) * nwv)
#define VS_LOADIDX(V, E0, E1, C0, C1) do { const size_t t_ = (size_t)VS_TOK(V) * 128; E0 = eidx[t_ + lane]; E1 = eidx[t_ + 64 + lane]; C0 = coef[t_ + lane]; C1 = coef[t_ + 64 + lane]; } while (0)
    u32x4 sa[16], sb[16];
    unsigned ep[16]; float cpa[16], cpb[16];
    int ea0, ea1, eb0, eb1; float ca0, ca1, cb0, cb1;
    f32x2 hva, hvb;
    VS_LOADIDX(0, ea0, ea1, ca0, ca1); VS_LOADIDX(1, eb0, eb1, cb0, cb1);
    VS_SETUP(0, ea0, ea1, ca0, ca1, ep, cpa); VS_ISSUE(sa, ep); hva = *(const f32x2*)(h + (size_t)VS_TOK(0) * DM + colL);
    VS_SETUP(1, eb0, eb1, cb0, cb1, ep, cpb); VS_ISSUE(sb, ep); hvb = *(const f32x2*)(h + (size_t)VS_TOK(1) * DM + colL);
    VS_LOADIDX(2, ea0, ea1, ca0, ca1); VS_LOADIDX(3, eb0, eb1, cb0, cb1);
#pragma unroll 1
    for (int v = 0; v < nvis; v += 2) {
        { const int tok = VS_TOK(v); VS_CONSUME(sa, cpa, tok, hva); }
        VS_SETUP(0, ea0, ea1, ca0, ca1, ep, cpa); VS_ISSUE(sa, ep); hva = *(const f32x2*)(h + (size_t)VS_TOK(v + 2) * DM + colL);
        VS_LOADIDX(v + 4, ea0, ea1, ca0, ca1);
        if (v + 1 < nvis) { const int tok = VS_TOK(v + 1); VS_CONSUME(sb, cpb, tok, hvb); }
        VS_SETUP(1, eb0, eb1, cb0, cb1, ep, cpb); VS_ISSUE(sb, ep); hvb = *(const f32x2*)(h + (size_t)VS_TOK(v + 3) * DM + colL);
        VS_LOADIDX(v + 5, eb0, eb1, cb0, cb1);
    }
#undef VS_TOK
#undef VS_LOADIDX
}
#undef VS_SETUP
#undef VS_ISSUE
#undef VS_FMA
#undef VS_ROW
#undef VS_RS
#undef VS_CONSUME

#if PEER_V4EXP && PEER_I8U
#define I8_ISSUE(SET, EV, J0) do { int ev_ = (EV); asm volatile("" : "+v"(ev_)); _Pragma("unroll") for (int k = 0; k < 16; ++k) { const int e = __builtin_amdgcn_readlane(ev_, (J0) + k); \
        SET[k] = *(const u32x4*)(u8 + ((unsigned)e * (unsigned)DM + (unsigned)(lane * 16))); } __builtin_amdgcn_sched_barrier(0); } while (0)
#define I8_CONS(SET, P0) do { _Pragma("unroll") for (int k = 0; k < 16; ++k) { \
        int a = __builtin_amdgcn_sdot4((int)SET[k].x, (int)xq[0], 0, false); a = __builtin_amdgcn_sdot4((int)SET[k].y, (int)xq[1], a, false); \
        a = __builtin_amdgcn_sdot4((int)SET[k].z, (int)xq[2], a, false); a = __builtin_amdgcn_sdot4((int)SET[k].w, (int)xq[3], a, false); \
        part[(P0) + k] = (float)a; } __builtin_amdgcn_sched_barrier(0); } while (0)
#define I8_RS(M) do { const bool up = (lane & (M)) != 0; _Pragma("unroll") for (int i = 0; i < (M); ++i) { \
        const float send = up ? part[i] : part[i + (M)], keep = up ? part[i + (M)] : part[i]; part[i] = keep + __shfl_xor(send, (M)); } } while (0)
#define V4_ISSUE(SET, EV, J0) do { int ev_ = (EV); asm volatile("" : "+v"(ev_)); _Pragma("unroll") for (int k = 0; k < 16; ++k) { const int e = __builtin_amdgcn_readlane(ev_, (J0) + k); \
        SET[k] = *(const u32x2*)(v8 + ((unsigned)e * (unsigned)(DM / 2) + (unsigned)(lane * 8))); } __builtin_amdgcn_sched_barrier(0); } while (0)
#define V4_FMA(W, I) do { t_[4 * (I)] = __builtin_elementwise_fma(__builtin_amdgcn_cvt_scalef32_pk_f32_fp4((W), 1.0f, 0), c2, t_[4 * (I)]); \
        t_[4 * (I) + 1] = __builtin_elementwise_fma(__builtin_amdgcn_cvt_scalef32_pk_f32_fp4((W), 1.0f, 1), c2, t_[4 * (I) + 1]); \
        t_[4 * (I) + 2] = __builtin_elementwise_fma(__builtin_amdgcn_cvt_scalef32_pk_f32_fp4((W), 1.0f, 2), c2, t_[4 * (I) + 2]); \
        t_[4 * (I) + 3] = __builtin_elementwise_fma(__builtin_amdgcn_cvt_scalef32_pk_f32_fp4((W), 1.0f, 3), c2, t_[4 * (I) + 3]); } while (0)
#define V4_ROW(SET, CV, J0, K) do { const float c = (CV)[(J0) + (K)]; const f32x2 c2 = {c, c}; const u32x2 w_ = SET[K]; \
        V4_FMA(w_.x, 0); V4_FMA(w_.y, 1); } while (0)
#define V4_CONS(SET, CV, J0) do { f32x2 t_[8]; _Pragma("unroll") for (int i_ = 0; i_ < 8; ++i_) t_[i_] = (f32x2){0.f, 0.f}; V4_ROW(SET, CV, J0, 0); V4_ROW(SET, CV, J0, 1); V4_ROW(SET, CV, J0, 2); V4_ROW(SET, CV, J0, 3); V4_ROW(SET, CV, J0, 4); V4_ROW(SET, CV, J0, 5); \
        V4_ROW(SET, CV, J0, 6); V4_ROW(SET, CV, J0, 7); V4_ROW(SET, CV, J0, 8); V4_ROW(SET, CV, J0, 9); V4_ROW(SET, CV, J0, 10); V4_ROW(SET, CV, J0, 11); \
        V4_ROW(SET, CV, J0, 12); V4_ROW(SET, CV, J0, 13); V4_ROW(SET, CV, J0, 14); V4_ROW(SET, CV, J0, 15); \
        _Pragma("unroll") for (int i_ = 0; i_ < 8; ++i_) acc[i_] += t_[i_]; __builtin_amdgcn_sched_barrier(0); } while (0)
DI void p6fused(const Params& p, LAS3 unsigned char* lds, int G) {
    unsigned char* ws = p.ws;
    const int tid = threadIdx.x, lane = tid & 63, wid = tid >> 6;
    const int gw = blockIdx.x * 8 + wid, nw = G * 8;
    const unsigned char* u8 = (const unsigned char*)(ws + WS_UB); const unsigned char* v8 = (const unsigned char*)(ws + WS_VB);
    const int* eidx = (const int*)(ws + R_EXP); const float* gsm = (const float*)(ws + R_GSM); const float* rs1v = (const float*)(ws + WS_RS1);
    bf16_t* hb = (bf16_t*)(ws + R_H1B); float* rs2 = (float*)(ws + WS_RS2);
    LAS3 float* cl = (LAS3 float*)(lds + wid * 512);
#pragma unroll 1
    for (int tok = gw; tok < NTOK; tok += nw) {
        const int e0 = eidx[(size_t)tok * 128 + lane], e1 = eidx[(size_t)tok * 128 + 64 + lane];
        {
            u32x4 sa[16], sb[16];
            I8_ISSUE(sa, e0, 0);
            I8_ISSUE(sb, e0, 16);
            const u32x4 xa = *(const u32x4*)(hb + (size_t)tok * DM + lane * 16), xb = *(const u32x4*)(hb + (size_t)tok * DM + lane * 16 + 8);
            const float g0 = gsm[(size_t)tok * 128 + lane], g1 = gsm[(size_t)tok * 128 + 64 + lane];
            const float rs1 = rs1v[tok];
            float xf[16];
#pragma unroll
            for (int q = 0; q < 4; ++q) { xf[2 * q] = bflo(xa[q]); xf[2 * q + 1] = bfhi(xa[q]); xf[8 + 2 * q] = bflo(xb[q]); xf[8 + 2 * q + 1] = bfhi(xb[q]); }
            float amax = 0.f;
#pragma unroll
            for (int i = 0; i < 16; ++i) amax = fmaxf(amax, fabsf(xf[i]));
            amax = wave_max(amax);
            const float sx = fmaxf(amax, 1e-20f) * (1.0f / 127.0f), isx = 1.0f / sx;
            unsigned xq[4];
#pragma unroll
            for (int q = 0; q < 4; ++q) {
                unsigned w = 0u;
#pragma unroll
                for (int b = 0; b < 4; ++b) w |= ((unsigned)(int)rintf(xf[4 * q + b] * isx) & 0xffu) << (8 * b);
                xq[q] = w;
            }
            const float scl = rs1 * sx * (1.0f / U_ISCALE);
            float part[64];
            I8_CONS(sa, 0);  I8_ISSUE(sa, e0, 32);
            I8_CONS(sb, 16); I8_ISSUE(sb, e0, 48);
            I8_CONS(sa, 32); I8_ISSUE(sa, e1, 0);
            I8_CONS(sb, 48); I8_ISSUE(sb, e1, 16);
            I8_RS(32); I8_RS(16); I8_RS(8); I8_RS(4); I8_RS(2); I8_RS(1);
            cl[lane] = g0 * gelu_tanh(part[0] * scl) * (1.0f / V8_SCALE);
            I8_CONS(sa, 0);  I8_ISSUE(sa, e1, 32);
            I8_CONS(sb, 16); I8_ISSUE(sb, e1, 48);
            I8_CONS(sa, 32);
            I8_CONS(sb, 48);
            I8_RS(32); I8_RS(16); I8_RS(8); I8_RS(4); I8_RS(2); I8_RS(1);
            cl[64 + lane] = g1 * gelu_tanh(part[0] * scl) * (1.0f / V8_SCALE);
        }
        {
            u32x2 sa[16], sb[16];
            V4_ISSUE(sa, e0, 0);
            V4_ISSUE(sb, e0, 16);
            LAS3 const float* c0 = cl; LAS3 const float* c1 = cl + 64;
            const u32x4 ha = *(const u32x4*)(hb + (size_t)tok * DM + lane * 16), hc = *(const u32x4*)(hb + (size_t)tok * DM + lane * 16 + 8);
            const f32x4 hv0 = {bflo(ha.x), bfhi(ha.x), bflo(ha.y), bfhi(ha.y)}, hv1 = {bflo(ha.z), bfhi(ha.z), bflo(ha.w), bfhi(ha.w)};
            const f32x4 hv2 = {bflo(hc.x), bfhi(hc.x), bflo(hc.y), bfhi(hc.y)}, hv3 = {bflo(hc.z), bfhi(hc.z), bflo(hc.w), bfhi(hc.w)};
            f32x2 acc[8];
#pragma unroll
            for (int i = 0; i < 8; ++i) acc[i] = (f32x2){0.f, 0.f};
            V4_CONS(sa, c0, 0);  V4_ISSUE(sa, e0, 32);
            V4_CONS(sb, c0, 16); V4_ISSUE(sb, e0, 48);
            V4_CONS(sa, c0, 32); V4_ISSUE(sa, e1, 0);
            V4_CONS(sb, c0, 48); V4_ISSUE(sb, e1, 16);
            V4_CONS(sa, c1, 0);  V4_ISSUE(sa, e1, 32);
            V4_CONS(sb, c1, 16); V4_ISSUE(sb, e1, 48);
            V4_CONS(sa, c1, 32);
            V4_CONS(sb, c1, 48);
            const f32x4 o0 = hv0 + (f32x4){acc[0].x, acc[0].y, acc[1].x, acc[1].y}, o1 = hv1 + (f32x4){acc[2].x, acc[2].y, acc[3].x, acc[3].y};
            const f32x4 o2 = hv2 + (f32x4){acc[4].x, acc[4].y, acc[5].x, acc[5].y}, o3 = hv3 + (f32x4){acc[6].x, acc[6].y, acc[7].x, acc[7].y};
            u32x4 w0, w1;
            w0.x = pk_bf16(o0[0], o0[1]); w0.y = pk_bf16(o0[2], o0[3]); w0.z = pk_bf16(o1[0], o1[1]); w0.w = pk_bf16(o1[2], o1[3]);
            w1.x = pk_bf16(o2[0], o2[1]); w1.y = pk_bf16(o2[2], o2[3]); w1.z = pk_bf16(o3[0], o3[1]); w1.w = pk_bf16(o3[2], o3[3]);
            *(u32x4*)(hb + (size_t)tok * DM + lane * 16) = w0; *(u32x4*)(hb + (size_t)tok * DM + lane * 16 + 8) = w1;
            float ss = 0.f;
#pragma unroll
            for (int j = 0; j < 4; ++j) ss += o0[j] * o0[j] + o1[j] * o1[j] + o2[j] * o2[j] + o3[j] * o3[j];
            ss = wave_sum(ss);
            if (lane == 0) rs2[tok] = rsqrtf(ss * (1.0f / DM) + EPS);
        }
    }
}
#undef I8_ISSUE
#undef I8_CONS
#undef I8_RS
#undef V4_ISSUE
#undef V4_CONS
#undef V4_FMA
#undef V4_ROW
#endif
constexpr int LDS_MISC = 160 * 1024 - 256;
constexpr int LDS_BYTES = 160 * 1024;
constexpr size_t CTL_BAR = 0;
static_assert(XCD_BAR_WORDS * 4 <= 64 * 1024, "control region");

template <class F> struct EpiAdapt {
    static constexpr bool PERM = true, AFTER_DRAIN = false;
    F f;
    DI void operator()(const f32x4 (&acc)[2][2][4][2], const pg8::Unit& u, int wr, int wc, int fr, int fq) const {
        int fr_ = fr, fq_ = fq; asm volatile("" : "+v"(fr_), "+v"(fq_));
        const int row0 = u.pm * 256 + wr * 64 + fr_, col0 = u.pn * 256 + wc * 32 + 8 * fq_;
#pragma unroll
        for (int ai = 0; ai < 2; ++ai)
#pragma unroll
            for (int m = 0; m < 4; ++m) {
                const int row = row0 + ai * 128 + m * 16;
#pragma unroll
                for (int bj = 0; bj < 2; ++bj)
                    f.store8(row, col0 + bj * 128, acc[ai][bj][m][0], acc[ai][bj][m][1]);
            }
    }
};
template <class F> struct EpiAdaptSsq {
    static constexpr bool PERM = true, AFTER_DRAIN = false;
    F f; float* ssq;
    DI void operator()(const f32x4 (&acc)[2][2][4][2], const pg8::Unit& u, int wr, int wc, int fr, int fq) const {
        int fr_ = fr, fq_ = fq; asm volatile("" : "+v"(fr_), "+v"(fq_));
        const int row0 = u.pm * 256 + wr * 64 + fr_, col0 = u.pn * 256 + wc * 32 + 8 * fq_;
#pragma unroll
        for (int ai = 0; ai < 2; ++ai)
#pragma unroll
            for (int m = 0; m < 4; ++m) {
                const int row = row0 + ai * 128 + m * 16;
                float s = 0.f; const float rsc = f.rowscale(row);
#pragma unroll
                for (int bj = 0; bj < 2; ++bj)
                    s += f.store8r(row, col0 + bj * 128, acc[ai][bj][m][0], acc[ai][bj][m][1], rsc);
                s += __shfl_xor(s, 16); s += __shfl_xor(s, 32);
                if (fq_ == 0) ssq[(size_t)(u.pn * 4 + wc) * NTOK + row] = s;
            }
    }
};
struct EpiOutR {
    const float* x; bf16_t* h1b;
    DI float rowscale(int) const { return 0.f; }
    DI float store8r(int row, int col, f32x4 v0, f32x4 v1, float) const {
        const size_t o = (size_t)row * DM + col;
        v0 += *(const f32x4*)(x + o); v1 += *(const f32x4*)(x + o + 4);
        u32x4 w; w.x = pack2bf(v0[0], v0[1]); w.y = pack2bf(v0[2], v0[3]); w.z = pack2bf(v1[0], v1[1]); w.w = pack2bf(v1[2], v1[3]); *(u32x4*)(h1b + o) = w;
        return ((v0[0] * v0[0] + v0[1] * v0[1]) + (v0[2] * v0[2] + v0[3] * v0[3])) + ((v1[0] * v1[0] + v1[1] * v1[1]) + (v1[2] * v1[2] + v1[3] * v1[3]));
    }
};
struct EpiBf16Plain { bf16_t* C; int ldc;
    DI void store8(int row, int col, f32x4 v0, f32x4 v1) const { u32x4 w; w.x = pack2bf(v0[0], v0[1]); w.y = pack2bf(v0[2], v0[3]); w.z = pack2bf(v1[0], v1[1]); w.w = pack2bf(v1[2], v1[3]); *(u32x4*)(C + (size_t)row * ldc + col) = w; } };
struct EpiGateR {
    const float* rs2; const float* bias; const bf16_t* pp; const bf16_t* h2; bf16_t* h3;
    DI float rowscale(int row) const { return rs2[row]; }
    DI float store8r(int row, int col, f32x4 v0, f32x4 v1, float s) const {
        const size_t o = (size_t)row * DM + col;
        const f32x4 b0 = *(const f32x4*)(bias + col), b1 = *(const f32x4*)(bias + col + 4); const u32x4 pw = *(const u32x4*)(pp + o), hw = *(const u32x4*)(h2 + o);
        float hv[8] = {bflo(hw.x), bfhi(hw.x), bflo(hw.y), bfhi(hw.y), bflo(hw.z), bfhi(hw.z), bflo(hw.w), bfhi(hw.w)};
        const float pv[8] = {bflo(pw.x), bfhi(pw.x), bflo(pw.y), bfhi(pw.y), bflo(pw.z), bfhi(pw.z), bflo(pw.w), bfhi(pw.w)};
        float ss = 0.f;
#pragma unroll
        for (int j = 0; j < 4; ++j) { hv[j] += sigmoidf_(v0[j] * s + b0[j]) * pv[j]; hv[4 + j] += sigmoidf_(v1[j] * s + b1[j]) * pv[4 + j]; }
#pragma unroll
        for (int j = 0; j < 8; ++j) ss += hv[j] * hv[j];
        u32x4 w; w.x = pack2bf(hv[0], hv[1]); w.y = pack2bf(hv[2], hv[3]); w.z = pack2bf(hv[4], hv[5]); w.w = pack2bf(hv[6], hv[7]); *(u32x4*)(h3 + o) = w;
        return ss;
    }
};

struct MegaArgs { Params p; int ph_lo, ph_hi; };

__global__ void __launch_bounds__(MK_THREADS, 2) mega_fwd(MegaArgs args) {
    extern __shared__ __attribute__((aligned(16))) unsigned char lds_raw[];
    LAS unsigned char* lds = (LAS unsigned char*)lds_raw;
    const Params& p = args.p;
    unsigned char* ws = p.ws;
    const int lo = args.ph_lo, hi = args.ph_hi;
    const int G = gridDim.x;
    volatile LAS unsigned* misc = (volatile LAS unsigned*)(lds + LDS_MISC);
    if (threadIdx.x < 64) misc[threadIdx.x] = 0u;
    __syncthreads();
    XcdBarrier bar; bar.bar = (unsigned*)(ws + WS_CTL); bar.x = 0; bar.st = nullptr;
    bar = xcd_barrier_post((unsigned*)(ws + WS_CTL), misc);
    if (threadIdx.x == 0) { const unsigned xc = xb_xcc_id() & 7u; misc[16] = xc; misc[17] = atomicAdd((unsigned*)(ws + WS_CTL + 16384) + xc * 16, 1u); }
    __syncthreads();
#define IN(k) (lo <= (k) && (k) < hi)
#define SEAM(k) do { if (IN(k) && IN((k) + 1)) xcd_barrier(bar); } while (0)

    if (IN(0)) p0_prologue(p, lds, G);
#if defined(PROBE_PH) && PROBE_PH == 0
    if (IN(0)) p0_prologue(p, lds, G);
#endif
    SEAM(0);
    if (IN(1)) {
        pg8::Gemm g{(const bf16_t*)(ws + WS_XB), (const bf16_t*)(ws + WS_WIN), NTOK, NPROJ, DM};
        pg8::StaticOrder S; S.init(NTOK, NPROJ, G, (int)blockIdx.x);
        EpiAdapt<EpiProj> E{{(const float*)(ws + WS_RS0), (bf16_t*)(ws + R_QB), (bf16_t*)(ws + R_KC), (float*)(ws + R_GATE), (bf16_t*)(ws + R_XR), (bf16_t*)(ws + R_XG)}};
        pg8::gemm_phase<EpiAdapt<EpiProj>, pg8::StaticOrder>(lds, g, S, E, nullptr);
#if defined(PROBE_PH) && PROBE_PH == 1
        __syncthreads();
        pg8::gemm_phase<EpiAdapt<EpiProj>, pg8::StaticOrder>(lds, g, S, E, nullptr);
#endif
    }
    SEAM(1);
    if (IN(2)) { if (!CMP_NAIVE) { p2_compress(p, lds, G); p2_vtranspose(p, lds, G); } lru_phase<false>(p, lds, G); }
#ifdef PROBE_P2
    if (IN(2)) { p2_compress(p, lds, G); p2_vtranspose(p, lds, G); lru_phase<false>(p, lds, G); }
#endif
    SEAM(2);
    if (IN(3)) { p3_attention<0>(p, lds, G); if (!LRU_NAIVE) lru_phase<true>(p, lds, G);
#ifdef PROBE_LRU2
        lru_phase<true>(p, lds, G);
#endif
#ifdef PROBE_ATT2
        p3_attention<PROBE_ATT2>(p, lds, G);
#endif
    }
    SEAM(3);
    if (IN(4)) {
        pg8::Gemm g{(const bf16_t*)(ws + WS_XB), (const bf16_t*)(ws + WS_WOUT), NTOK, DM, DM};
        pg8::StaticOrder S; S.init(NTOK, DM, G, (int)blockIdx.x);
        EpiAdaptSsq<EpiOutR> E{{p.in[I_X], (bf16_t*)(ws + R_H1B)}, (float*)(ws + WS_SSQ1)};
        pg8::gemm_phase<EpiAdaptSsq<EpiOutR>, pg8::StaticOrder>(lds, g, S, E, nullptr);
#if defined(PROBE_PH) && PROBE_PH == 4
        __syncthreads();
        pg8::gemm_phase<EpiAdaptSsq<EpiOutR>, pg8::StaticOrder>(lds, g, S, E, nullptr);
#endif
    }
    SEAM(4);
    if (IN(5)) p5_peer_route(p, lds, G);
#ifdef PROBE_P5
    if (IN(5)) p5_peer_route(p, lds, G);
#endif
    SEAM(5);
    if (IN(6)) {
#if PEER_V6 == 2
        p6v6_u(p, G); xcd_barrier(bar); p6v6_v(p, G);
#elif PEER_V6 == 4
        p6u_cols(p, G); xcd_barrier(bar); p6u_combine(p, G); xcd_barrier(bar); p6v3_v<0>(p, G);
#elif PEER_V6 == 3 && PEER_FP4
        p6f4_u(p, G); xcd_barrier(bar); p6f4_v<0>(p, G);
#elif PEER_V6 == 6 && PEER_I8U
        p6i8_u(p, G); xcd_barrier(bar); p6vs_v(p, lds, G);
#elif PEER_V6 == 5 && PEER_I8U
#if PEER_V4EXP && PEER_FUSED
        p6fused(p, lds, G);
#elif PEER_V4EXP
        p6i8_u(p, G); xcd_barrier(bar); p6v4_v(p, lds, G);
#else
        p6i8_u(p, G); xcd_barrier(bar); p6v8_v(p, lds, G);
#endif
#elif PEER_V6 == 3 && PEER_I8U
        p6i8_u(p, G);
#ifdef PROBE_U2
        p6i8_u(p, G);
#endif
        xcd_barrier(bar);
#ifdef PROBE_V2
        p6v3_v<1>(p, G);
#endif
        p6v3_v<0>(p, G);
#elif PEER_V6 == 3
        p6v6_u(p, G); xcd_barrier(bar); p6v3_v<0>(p, G);
#elif PEER_V6
        p6v6_peer(p, G);
#elif PEER_V3
        p6v5_u(p, lds, G);
#ifdef PROBE_U2
        p6v5_u(p, lds, G);
#endif
        xcd_barrier(bar); p6v3_v<0>(p, G);
#elif PEER_V2
        p6_peer_u(p, G);
#ifdef PROBE_U2
        p6_peer_u(p, G);
#endif
        xcd_barrier(bar); p6_peer_v(p, G);
#else
        p6_peer_apply(p, G);
#endif
    }
    SEAM(6);
    if (IN(7)) {
        {
            pg8::Gemm g{(const bf16_t*)(ws + WS_PB), (const bf16_t*)(ws + WS_WP), NTOK, DM, PLE};
            pg8::StaticOrder S; S.init(NTOK, DM, G, (int)blockIdx.x);
            EpiAdapt<EpiBf16Plain> E{{(bf16_t*)(ws + R_BIG), DM}};
            pg8::gemm_phase<EpiAdapt<EpiBf16Plain>, pg8::StaticOrder>(lds, g, S, E, nullptr);
        }
        __syncthreads();
        {
            pg8::Gemm g{(const bf16_t*)(ws + R_H1B), (const bf16_t*)(ws + WS_WG), NTOK, DM, DM};
            pg8::StaticOrder S; S.init(NTOK, DM, G, (int)blockIdx.x);
            EpiAdaptSsq<EpiGateR> E{{(const float*)(ws + WS_RS2), p.in[I_PLE_BG], (const bf16_t*)(ws + R_BIG), (const bf16_t*)(ws + R_H1B), (bf16_t*)(ws + WS_XB)}, (float*)(ws + WS_SSQ3)};
            pg8::gemm_phase<EpiAdaptSsq<EpiGateR>, pg8::StaticOrder>(lds, g, S, E, nullptr);
        }
    }
    SEAM(7);
#ifdef PROBE_BARS
    for (int i = 0; i < PROBE_BARS; ++i) xcd_barrier(bar);
#endif
    if (IN(8)) p8_final_norm(p, G);
#undef IN
#undef SEAM
}

static int g_grid = 0;
static void launch_mega(hipStream_t st, const Params& p, int lo, int hi) {
    if (g_grid == 0) {
        int dev = 0, cus = 0, per_cu = 0;
        hipGetDevice(&dev); hipDeviceGetAttribute(&cus, hipDeviceAttributeMultiprocessorCount, dev);
        if (hipFuncSetAttribute((const void*)mega_fwd, hipFuncAttributeMaxDynamicSharedMemorySize, LDS_BYTES) != hipSuccess) { fprintf(stderr, "hipFuncSetAttribute failed\n"); g_grid = -1; return; }
        if (hipOccupancyMaxActiveBlocksPerMultiprocessor(&per_cu, (const void*)mega_fwd, MK_THREADS, LDS_BYTES) != hipSuccess || per_cu < 1) { fprintf(stderr, "occupancy query: %d per CU\n", per_cu); }
        (void)hipGetLastError();
        g_grid = cus;
    }
    if (g_grid < 0) return;
    MegaArgs a{}; a.p = p; a.ph_lo = lo; a.ph_hi = hi;
    hipLaunchKernelGGL(mega_fwd, dim3(g_grid), dim3(MK_THREADS), LDS_BYTES, st, a);
}
extern "C" void kernel_launch(void* const* d_in, const int* in_sizes, int n_in, void* d_out, int out_size, void* d_ws, size_t ws_size, hipStream_t stream) {
    if (n_in != 31 || out_size != NTOK * DM || ws_size < WS_END) { fprintf(stderr, "kernel_launch: unexpected shapes (n_in %d out %d ws %zu)\n", n_in, out_size, ws_size); return; }
    Params p{};
    for (int i = 0; i < 31; ++i) p.in[i] = (const float*)d_in[i];
    p.out = (float*)d_out; p.ws = (unsigned char*)d_ws;
    (void)hipMemsetAsync((char*)d_ws + WS_CTL, 0, 16384 + 1024, stream);
    launch_mega(stream, p, 0, 9);
}
```

```cpp
#include <hip/hip_runtime.h>
#include <stdint.h>
#include <stdio.h>

typedef unsigned short bf16_t;
typedef float f32x4 __attribute__((ext_vector_type(4)));
typedef float f32x2 __attribute__((ext_vector_type(2)));
typedef unsigned u32x4 __attribute__((ext_vector_type(4)));
typedef unsigned u32x2 __attribute__((ext_vector_type(2)));
#define DI __device__ __forceinline__

constexpr int NB = 4, T_ = 4096, DM = 1024, NTOK = NB * T_;
constexpr int NH = 8, HD = 64, NKV = 2, GRP = 4, ATTW = 512, KVW = 128, LRUW = 512;
constexpr int INCOLS = 2328, NPROJ = 2560;
constexpr int NCMP = 255, NSEL = 64;
constexpr int PEER_H = 8, PEER_K = 16, PEER_NK = 128;
constexpr int PLE = 256;
constexpr float EPS = 1e-6f;

constexpr int PC_KV = 512, PC_XR = 1280, PC_XG = 1792, PC_GATE = 2304;

constexpr size_t MB = 1024 * 1024;
constexpr size_t WS_CTL   = 0;
constexpr size_t WS_WIN   = 64 * 1024;
constexpr size_t WS_WOUT  = WS_WIN  + (size_t)NPROJ * DM * 2;
constexpr size_t WS_WQS   = WS_WOUT + (size_t)DM * DM * 2;
constexpr size_t WS_WG    = WS_WQS  + (size_t)2048 * DM * 2;
constexpr size_t WS_WP    = WS_WG   + (size_t)DM * DM * 2;
constexpr size_t WS_CW1K  = WS_WP   + (size_t)DM * PLE * 2;
constexpr size_t WS_CW1V  = WS_CW1K + (size_t)256 * 2048 * 2;
constexpr size_t WS_CBK   = WS_CW1V + (size_t)256 * 2048 * 2;
constexpr size_t WS_CBV   = WS_CBK  + 1024;
constexpr size_t WS_RS0   = WS_CBV  + 1024;
constexpr size_t WS_RS2   = WS_RS0  + (size_t)NTOK * 4;
constexpr size_t WS_RS1   = WS_RS2  + (size_t)NTOK * 4;
constexpr size_t WS_SSQ2  = WS_RS1  + (size_t)NTOK * 4;
constexpr size_t WS_SSQ1  = WS_SSQ2 + (size_t)16 * NTOK * 4;
constexpr size_t WS_SSQ3  = WS_SSQ1 + (size_t)16 * NTOK * 4;
constexpr size_t WS_KCMP  = WS_SSQ3 + (size_t)16 * NTOK * 4;
constexpr size_t WS_VCMP  = WS_KCMP + (size_t)8 * 256 * 64 * 4;
constexpr size_t WS_LRUP  = WS_VCMP + (size_t)8 * 256 * 64 * 4;
constexpr size_t WS_LRUH  = WS_LRUP + (size_t)256 * 512 * 4;
constexpr size_t WS_WAT   = WS_LRUH + (size_t)256 * 512 * 4;
constexpr size_t WS_WXT   = WS_WAT + 8 * 64 * 64 * 2;
constexpr size_t WS_CW2K  = WS_WXT + 8 * 64 * 64 * 2;
constexpr size_t WS_CW2V  = WS_CW2K + 64 * 256 * 2;
constexpr size_t WS_HID   = WS_CW2V + 64 * 256 * 2;
constexpr size_t WS_UB    = (WS_HID + (size_t)2 * 2048 * 256 * 4 + 4095) / 4096 * 4096;
constexpr size_t WS_VB    = WS_UB + (size_t)16384 * DM * 2;
constexpr size_t WS_PB    = WS_VB + (size_t)16384 * DM * 2;
constexpr size_t WS_XB    = WS_PB + (size_t)NTOK * PLE * 2;
constexpr size_t WS_R     = WS_XB + (size_t)NTOK * DM * 2;
constexpr size_t KVT = (size_t)NB * NKV * T_ * HD * 2 + 65536;
constexpr size_t R_QB    = WS_R;
constexpr size_t R_KC    = R_QB + (size_t)NTOK * 512 * 2;
constexpr size_t R_VC    = R_KC + KVT;
constexpr size_t R_KS    = R_VC + KVT;
constexpr size_t R_VS    = R_KS + KVT;
constexpr size_t R_KW    = R_VS + KVT;
constexpr size_t R_VW    = R_KW + KVT;
constexpr size_t R_GATE  = R_VW + KVT;
constexpr size_t R_XR    = R_GATE + (size_t)NTOK * 24 * 4;
constexpr size_t R_XG    = R_XR + (size_t)NTOK * 512 * 2;
constexpr size_t R_VST   = R_XG + (size_t)NTOK * 512 * 2;
constexpr size_t R_VWT   = R_VST + KVT;
constexpr size_t R_KCB   = R_VWT + KVT;
constexpr size_t R_VCT   = R_KCB + (size_t)8 * 256 * 64 * 2;
constexpr size_t R_END13 = R_VCT + (size_t)8 * 256 * 64 * 2;
constexpr size_t R_H1B   = WS_R;
constexpr size_t R_EXP   = R_H1B + (size_t)NTOK * DM * 2;
constexpr size_t R_GSM   = R_EXP + (size_t)NTOK * 128 * 4;
constexpr size_t R_COEF  = R_GSM + (size_t)NTOK * 128 * 4;
constexpr size_t R_BIG   = R_COEF + (size_t)NTOK * 128 * 4;
constexpr size_t WS_MIXED = (R_END13 + 4095) / 4096 * 4096;
static_assert(WS_MIXED + (size_t)NTOK * DM * 2 <= R_BIG + 64 * MB, "mixed must fit below the end of region R");
constexpr size_t WS_END  = (R_END13 > R_BIG + 64 * MB ? R_END13 : R_BIG + 64 * MB);
static_assert(WS_END <= 256 * MB, "workspace map exceeds 256 MiB");

DI float bf2f(bf16_t v) { return __uint_as_float((unsigned)v << 16); }
DI bf16_t f2bf(float x) { unsigned u = __float_as_uint(x); u += 0x7fffu + ((u >> 16) & 1u); return (bf16_t)(u >> 16); }
DI unsigned pack2bf(float lo, float hi) { return (unsigned)f2bf(lo) | ((unsigned)f2bf(hi) << 16); }
DI float gelu_tanh(float x) { const float u = 0.7978845608028654f * (x + 0.044715f * x * x * x); return 0.5f * x * (1.0f + tanhf(u)); }
DI float sigmoidf_(float x) { return 1.0f / (1.0f + __expf(-x)); }

__device__ const unsigned char REL_BUCKET_LUT[128] = {
0,1,2,3,4,5,6,7,8,9,10,11,12,13,14,15,16,16,16,17,17,18,18,18,19,19,19,20,20,20,20,21,21,21,21,22,22,22,22,22,23,23,23,23,23,23,24,24,24,24,24,24,25,25,25,25,25,25,25,26,26,26,26,26,26,26,26,27,27,27,27,27,27,27,27,27,27,28,28,28,28,28,28,28,28,28,28,29,29,29,29,29,29,29,29,29,29,29,29,30,30,30,30,30,30,30,30,30,30,30,30,30,30,31,31,31,31,31,31,31,31,31,31,31,31,31,31,31};
DI int rel_bucket(int dist) { dist = dist < 0 ? 0 : dist; return dist >= 128 ? 31 : (int)REL_BUCKET_LUT[dist]; }

struct Params {
    const float* in[31];
    float* out;
    unsigned char* ws;
};
enum { I_X = 0, I_P, I_ATTN_NORM, I_W_IN, I_CK_PE, I_CK_W1, I_CK_W2, I_CV_PE, I_CV_W1, I_CV_W2, I_REL, I_CONV_W, I_CONV_B, I_LRU_WA, I_LRU_BA, I_LRU_WX, I_LRU_BX,
       I_LRU_LAM, I_GN_ATTN, I_GN_LRU, I_W_OUT, I_FFN_NORM, I_PEER_WQ, I_PEER_SUB, I_PEER_U, I_PEER_V, I_PLE_NORM, I_PLE_WG, I_PLE_BG, I_PLE_PROJ, I_FINAL_NORM };

struct EpiProj {
    static constexpr bool HAS8 = true;
    const float* rs0; bf16_t* qb; bf16_t* kv0; float* gates; bf16_t* xr; bf16_t* xg;
    DI void store8(int row, int col, f32x4 v0, f32x4 v1) const {
        const float s = rs0[row];
        v0 *= s; v1 *= s;
        const int tl = __builtin_amdgcn_readfirstlane(col >> 8);
        if (tl < 2) { const float qs = 0.125f * 1.4426950408889634f;
            v0 *= qs; v1 *= qs;
            u32x4 w; w.x = pack2bf(v0[0], v0[1]); w.y = pack2bf(v0[2], v0[3]); w.z = pack2bf(v1[0], v1[1]); w.w = pack2bf(v1[2], v1[3]); *(u32x4*)(qb + (size_t)row * 512 + col) = w; }
        else if (tl < 5) {
            const int c = col - PC_KV, tensor = c >> 7, within = c & 127, kvh = within >> 6, d = within & 63, b = row >> 12, t = row & 4095;
            bf16_t* dst = (bf16_t*)((unsigned char*)kv0 + (size_t)tensor * KVT) + ((size_t)(b * NKV + kvh) * T_ + t) * HD + d;
            u32x4 w; w.x = pack2bf(v0[0], v0[1]); w.y = pack2bf(v0[2], v0[3]); w.z = pack2bf(v1[0], v1[1]); w.w = pack2bf(v1[2], v1[3]); *(u32x4*)dst = w;
        }
        else if (tl < 7) { u32x4 w; w.x = pack2bf(v0[0], v0[1]); w.y = pack2bf(v0[2], v0[3]); w.z = pack2bf(v1[0], v1[1]); w.w = pack2bf(v1[2], v1[3]); *(u32x4*)(xr + (size_t)row * 512 + (col - PC_XR)) = w; }
        else if (tl < 9) { u32x4 w; w.x = pack2bf(v0[0], v0[1]); w.y = pack2bf(v0[2], v0[3]); w.z = pack2bf(v1[0], v1[1]); w.w = pack2bf(v1[2], v1[3]); *(u32x4*)(xg + (size_t)row * 512 + (col - PC_XG)) = w; }
        else if (col < PC_GATE + 24) { float* g = gates + (size_t)row * 24 + (col - PC_GATE); *(f32x4*)g = v0; *(f32x4*)(g + 4) = v1; }
    }
};
struct EpiOut {
    const float* x; float* h1; bf16_t* h1b;
    DI void store4(int row, int col, f32x4 v) const {
        const size_t o = (size_t)row * DM + col;
        v += *(const f32x4*)(x + o);
        *(f32x4*)(h1 + o) = v;
        u32x2 w; w.x = pack2bf(v[0], v[1]); w.y = pack2bf(v[2], v[3]); *(u32x2*)(h1b + o) = w;
    }
};
struct EpiF32Plain { float* C; int ldc; int coloff;
    DI void store4(int row, int col, f32x4 v) const { *(f32x4*)(C + (size_t)row * ldc + (col - coloff)) = v; } };
struct EpiGate {
    const float* rs2; const float* bias; const float* pp; float* h;
    DI void store4(int row, int col, f32x4 v) const {
        const size_t o = (size_t)row * DM + col;
        const float s = rs2[row];
        const f32x4 bb = *(const f32x4*)(bias + col), p4 = *(const f32x4*)(pp + o);
        f32x4 hv = *(f32x4*)(h + o);
#pragma unroll
        for (int j = 0; j < 4; ++j) hv[j] += sigmoidf_(v[j] * s + bb[j]) * p4[j];
        *(f32x4*)(h + o) = hv;
    }
};
#ifndef LRU_NAIVE
#define LRU_NAIVE 0
#endif
#ifndef CMP_NAIVE
#define CMP_NAIVE 0
#endif
#ifndef OPT_MASK
#define OPT_MASK 0x1FF
#endif
#ifndef PEER_V6
#define PEER_V6 5
#endif
#ifndef PEER_V3
#define PEER_V3 1
#endif
#ifndef PEER_V2
#define PEER_V2 1
#endif
#ifndef XCC_HW
#define XCC_HW 0
#endif
#ifndef PEER_FP4
#define PEER_FP4 0
#endif
#ifndef PEER_I8U
#define PEER_I8U 1
#endif
#ifndef PEER_V4EXP
#define PEER_V4EXP 1
#endif
#ifndef PEER_FUSED
#define PEER_FUSED 1
#endif
#ifndef PEER_I4U
#define PEER_I4U 1
#endif
DI float wave_sum(float v) {
#pragma unroll
    for (int o = 32; o > 0; o >>= 1) v += __shfl_xor(v, o);
    return v;
}
DI float wave_max(float v) {
#pragma unroll
    for (int o = 32; o > 0; o >>= 1) v = fmaxf(v, __shfl_xor(v, o));
    return v;
}
DI float block_sum256(float v, float* red) {
    v = wave_sum(v); __syncthreads();
    if ((threadIdx.x & 63) == 0) red[threadIdx.x >> 6] = v; __syncthreads();
    return (red[0] + red[1]) + (red[2] + red[3]);
}
DI float block_max256(float v, float* red) {
    v = wave_max(v); __syncthreads();
    if ((threadIdx.x & 63) == 0) red[threadIdx.x >> 6] = v; __syncthreads();
    return fmaxf(fmaxf(red[0], red[1]), fmaxf(red[2], red[3]));
}

#define XB_TMO      128
#define XB_XCNT(j)  (256  + 64 * (j))
#define XB_XSUB(j)  (1280 + 64 * (j))
#define XB_XGEN(j)  (2304 + 64 * (j))
#define XB_TOP      3328
#define XB_TOPGEN   3392
#define XCD_BAR_WORDS 3456
#define XB_SPIN_CAP (1u << 18)
#define LAS __attribute__((address_space(3)))

__device__ __forceinline__ unsigned xb_ld(unsigned* p)              { return __hip_atomic_load(p, __ATOMIC_RELAXED, __HIP_MEMORY_SCOPE_AGENT); }
__device__ __forceinline__ unsigned xb_add(unsigned* p, unsigned v) { return __hip_atomic_fetch_add(p, v, __ATOMIC_RELAXED, __HIP_MEMORY_SCOPE_AGENT); }
__device__ __forceinline__ unsigned xb_xcc_id() { return (unsigned)__builtin_amdgcn_s_getreg((3 << 11) | 20) & 0xFu; }
#define XB_SPIN(cond, bar) do { unsigned _sp = 0; while (cond) { __builtin_amdgcn_s_sleep(1); \
    if ((++_sp & 255u) == 0u) { if (xb_ld(&(bar)[XB_TMO])) break; if (_sp > XB_SPIN_CAP) { atomicAdd(&(bar)[XB_TMO], 1u); break; } } } } while (0)

struct XcdBarrier {
    unsigned* bar; unsigned x;
    volatile LAS unsigned* st;
};

__device__ __forceinline__ XcdBarrier xcd_barrier_post(unsigned* bar, volatile LAS unsigned* st) {
    XcdBarrier b; b.bar = bar; b.x = xb_xcc_id(); b.st = st;
    if (threadIdx.x == 0) (void)xb_add(&bar[XB_XCNT(b.x)], 1u);
    return b;
}
__device__ __forceinline__ void xcd_barrier_complete(unsigned* bar, unsigned x, unsigned& nloc, unsigned& nx) {
    const unsigned G = gridDim.x * gridDim.y * gridDim.z;
    unsigned sum, cnt, mine, sp = 0u;
    for (;;) {
        sum = 0u; cnt = 0u; mine = 0u;
#pragma unroll
        for (unsigned j = 0; j < 16; ++j) { const unsigned c = xb_ld(&bar[XB_XCNT(j)]); sum += c; cnt += (c > 0u) ? 1u : 0u; mine = (j == x) ? c : mine; }
        if (sum == G) break;
        __builtin_amdgcn_s_sleep(1);
        if ((++sp & 255u) == 0u) { if (xb_ld(&bar[XB_TMO])) break; if (sp > XB_SPIN_CAP) { atomicAdd(&bar[XB_TMO], 1u); break; } }
    }
    nloc = mine > 0u ? mine : 1u; nx = cnt > 0u ? cnt : 1u;
}

__device__ __forceinline__ void xcd_barrier(const XcdBarrier& b) {
    asm volatile("s_waitcnt vmcnt(0)" ::: "memory");
    __syncthreads();
    if (threadIdx.x == 0) {
        unsigned* bar = b.bar;
        __builtin_amdgcn_s_waitcnt(0);
        unsigned nloc = b.st[0], nx = b.st[1];
        if (nloc == 0u) { xcd_barrier_complete(bar, b.x, nloc, nx); b.st[0] = nloc; b.st[1] = nx; }
        const unsigned old = xb_add(&bar[XB_XSUB(b.x)], 1u);
        const unsigned gen = old / nloc;
        if (old + 1u == (gen + 1u) * nloc) {
            __builtin_amdgcn_fence(__ATOMIC_RELEASE, "agent");
            asm volatile("s_waitcnt vmcnt(0)" ::: "memory");
            const unsigned og = xb_add(&bar[XB_TOP], 1u);
            const unsigned tg = og / nx;
            if (og + 1u == (tg + 1u) * nx) xb_add(&bar[XB_TOPGEN], 1u);
            else XB_SPIN(xb_ld(&bar[XB_TOPGEN]) == tg, bar);
            __builtin_amdgcn_fence(__ATOMIC_ACQUIRE, "agent");
            xb_add(&bar[XB_XGEN(b.x)], 1u);
            asm volatile("s_waitcnt vmcnt(0)" ::: "memory");
        } else {
            XB_SPIN(xb_ld(&bar[XB_XGEN(b.x)]) == gen, bar);
            __builtin_amdgcn_fence(__ATOMIC_ACQUIRE, "agent");
            asm volatile("s_waitcnt vmcnt(0)" ::: "memory");
        }
    }
    __syncthreads();
}


namespace pg8 {
#define PG8_LAS __attribute__((address_space(3)))
typedef short bf16x8 __attribute__((ext_vector_type(8)));
constexpr int BM = 256, BK = 64, HALF = 128, HTB = HALF * BK * 2  , STAGE_BYTES = 8 * HTB, NXCD = 8, WGM = 8;

__host__ __device__ __forceinline__ int lds_byte(int r, int c) { const int st = (r >> 4) * 2 + (c >> 5), rr = r & 15, cc = c & 31, ob = rr * 64 + cc * 2; return st * 1024 + (ob ^ (((ob >> 9) & 1) << 5)); }
__host__ __device__ __forceinline__ void stage_rc(int b, int& R, int& C) { const int st = b / 1024, sb = b % 1024, swz = sb ^ (((sb >> 9) & 1) << 5); R = (st >> 1) * 16 + swz / 64; C = (st & 1) * 32 + (swz % 64) / 2; }
__host__ __device__ __forceinline__ int perm32(int rho) { const int n = rho >> 4, i = rho & 15; return 8 * (i >> 2) + 4 * n + (i & 3); }

struct Unit { int pm, pn; };
struct Gemm { const bf16_t* A; const bf16_t* Bt; int M, N, K; };

struct StaticOrder {
    int nM, nN, nwg, G, c;
    __host__ __device__ void init(int M, int N, int G_, int c_) { nM = M / BM; nN = N / BM; nwg = nM * nN; G = G_; c = c_; }
    __host__ __device__ bool next(int i, Unit& u) const {
        const long L = (long)i * G + c; if (L >= nwg) return false;
        int wgid = (int)L; { const int q = nwg / NXCD, r = nwg % NXCD, xcd = wgid % NXCD, off = wgid / NXCD; wgid = (xcd < r ? xcd * (q + 1) : r * (q + 1) + (xcd - r) * q) + off; }
        const int nig = WGM * nN, gid = wgid / nig, fm = gid * WGM, gsz = (nM - fm) < WGM ? (nM - fm) : WGM;
        u.pm = fm + ((wgid % nig) % gsz); u.pn = (wgid % nig) / gsz; return true;
    }
    __device__ __forceinline__ void a_ready(const Unit&) const {}
    __device__ __forceinline__ void done(const Unit&) const {}
};
template <class Epi, class Sched, bool STAMP = false>
__device__ __forceinline__ void gemm_phase(PG8_LAS unsigned char* lds, const Gemm g, const Sched& S, const Epi& E, unsigned long long* stamps) {
    int tid_ = threadIdx.x; asm volatile("" : "+v"(tid_));
    const int tid = tid_, wid = __builtin_amdgcn_readfirstlane(tid >> 6), lane = tid & 63, wr = wid >> 2, wc = wid & 3, fr = lane & 15, fq = lane >> 4;
    const int K = g.K, nt = K / BK;
    int ts_lo = 0, ts_hi = 0, nts = 0; const unsigned long long rt_entry = STAMP ? (unsigned long long)wall_clock64() : 0ull;
#define PG8_STAMP() do { if (STAMP && wid == 0 && nts < 64) { const unsigned long long _c = (unsigned long long)clock64(); \
        ts_lo = (lane == nts) ? (int)(unsigned)_c : ts_lo; ts_hi = (lane == nts) ? (int)(unsigned)(_c >> 32) : ts_hi; ++nts; } } while (0)
    PG8_STAMP();
    unsigned voffA[2], voffB[2];
#pragma unroll
    for (int i = 0; i < 2; ++i) { int R, C; stage_rc(tid * 16 + i * 8192, R, C); const int Rb = Epi::PERM ? ((R & ~31) + perm32(R & 31)) : R;
        voffA[i] = (unsigned)(R * K + C) * 2u; voffB[i] = (unsigned)(Rb * K + C) * 2u; }
    const size_t kstep = (size_t)(BK * 2);
    const size_t hstep = (size_t)HALF * K * 2;
    const size_t tstep = 2 * hstep;
    const unsigned ldsw = (unsigned)wid * 1024u;
    const int aoff = lds_byte(wr * 64 + fr, fq * 8), boff = lds_byte(wc * 32 + fr, fq * 8);
#define PG8_SA(b, h) (((b) * 2 + (h)) * HTB)
#define PG8_SB(b, h) ((4 + (b) * 2 + (h)) * HTB)
#define PG8_STAGE(bufoff, gbase, voff) do { _Pragma("unroll") for (int _i = 0; _i < 2; ++_i) \
        __builtin_amdgcn_global_load_lds((const unsigned*)((const char*)(gbase) + (voff)[_i]), (PG8_LAS unsigned*)(lds + (bufoff) + ldsw + _i * 8192), 16, 0, 0); } while (0)
#define PG8_LDA(dst, b, h) do { _Pragma("unroll") for (int m = 0; m < 4; ++m) _Pragma("unroll") for (int k = 0; k < 2; ++k) dst[m][k] = *(const PG8_LAS bf16x8*)(lds + PG8_SA(b, h) + aoff + m * 2048 + k * 1024); } while (0)
#define PG8_LDB(dst, b, h) do { _Pragma("unroll") for (int n = 0; n < 2; ++n) _Pragma("unroll") for (int k = 0; k < 2; ++k) dst[n][k] = *(const PG8_LAS bf16x8*)(lds + PG8_SB(b, h) + boff + n * 2048 + k * 1024); } while (0)
#define PG8_MMA(ai, bj, At, Bt) do { __builtin_amdgcn_s_setprio(1); _Pragma("unroll") for (int m = 0; m < 4; ++m) _Pragma("unroll") for (int n = 0; n < 2; ++n) _Pragma("unroll") for (int k = 0; k < 2; ++k) \
        acc[ai][bj][m][n] = __builtin_amdgcn_mfma_f32_16x16x32_bf16(Bt[n][k], At[m][k], acc[ai][bj][m][n], 0, 0, 0); __builtin_amdgcn_s_setprio(0); } while (0)
#define PG8_WAIT_V(n) asm volatile("s_waitcnt vmcnt(" #n ")" ::: "memory")
#define PG8_WAIT_L(n) asm volatile("s_waitcnt lgkmcnt(" #n ")" ::: "memory")
#define PG8_BAR __builtin_amdgcn_s_barrier()
#define PG8_SCHED __builtin_amdgcn_sched_barrier(0)
    Unit cur, nxt; int ui = 0;
    if (!S.next(0, cur)) return;
    f32x4 acc[2][2][4][2];
#pragma unroll
    for (int a = 0; a < 2; ++a)
#pragma unroll
        for (int b = 0; b < 2; ++b)
#pragma unroll
            for (int m = 0; m < 4; ++m)
#pragma unroll
                for (int n = 0; n < 2; ++n) acc[a][b][m][n] = (f32x4){0.f, 0.f, 0.f, 0.f};
    bf16x8 At[4][2], B0[2][2], B1[2][2];
    const char* cA = (const char*)g.A + (size_t)cur.pm * tstep; const char* cB = (const char*)g.Bt + (size_t)cur.pn * tstep;
    S.a_ready(cur);
    PG8_STAGE(PG8_SB(0, 0), cB, voffB); PG8_STAGE(PG8_SA(0, 0), cA, voffA); PG8_STAGE(PG8_SB(0, 1), cB + hstep, voffB); PG8_STAGE(PG8_SA(0, 1), cA + hstep, voffA);
    if (wr == 1) PG8_BAR;
    PG8_WAIT_V(4); PG8_BAR;
    PG8_STAGE(PG8_SB(1, 0), cB + kstep, voffB); PG8_STAGE(PG8_SA(1, 0), cA + kstep, voffA); PG8_STAGE(PG8_SB(1, 1), cB + hstep + kstep, voffB);
    PG8_WAIT_V(6); PG8_BAR;
    PG8_STAMP();
    for (;;) {
        const bool has_next = S.next(ui + 1, nxt);
        const char* nA = has_next ? (const char*)g.A + (size_t)nxt.pm * tstep : cA; const char* nB = has_next ? (const char*)g.Bt + (size_t)nxt.pn * tstep : cB;
        for (int t = 0; t < nt; t += 2) {
            const bool last = (t == nt - 2);
            const char* a1 = cA + (size_t)(t + 1) * kstep;
            const char* a2 = last ? nA : cA + (size_t)(t + 2) * kstep; const char* b2 = last ? nB : cB + (size_t)(t + 2) * kstep;
            const char* a3 = a2 + kstep; const char* b3 = b2 + kstep;
            if (last && has_next) S.a_ready(nxt);
            PG8_LDB(B0, 0, 0); PG8_SCHED; PG8_LDA(At, 0, 0); PG8_STAGE(PG8_SA(1, 1), a1 + hstep, voffA);
            PG8_WAIT_L(8); PG8_BAR; PG8_WAIT_L(0); PG8_MMA(0, 0, At, B0); PG8_BAR; PG8_SCHED;
            PG8_LDB(B1, 0, 1); PG8_STAGE(PG8_SB(0, 0), b2, voffB);
            PG8_BAR; PG8_WAIT_L(0); PG8_MMA(0, 1, At, B1); PG8_BAR;
            PG8_LDA(At, 0, 1); PG8_STAGE(PG8_SA(0, 0), a2, voffA);
            PG8_BAR; PG8_WAIT_L(0); PG8_MMA(1, 0, At, B0); PG8_BAR; PG8_SCHED;
            PG8_STAGE(PG8_SB(0, 1), b2 + hstep, voffB);
            PG8_WAIT_V(6); PG8_BAR; PG8_MMA(1, 1, At, B1); PG8_BAR;
            PG8_LDB(B0, 1, 0); PG8_SCHED; PG8_LDA(At, 1, 0); PG8_STAGE(PG8_SA(0, 1), a2 + hstep, voffA);
            PG8_WAIT_L(8); PG8_BAR; PG8_WAIT_L(0); PG8_MMA(0, 0, At, B0); PG8_BAR; PG8_SCHED;
            PG8_LDB(B1, 1, 1); PG8_STAGE(PG8_SB(1, 0), b3, voffB);
            PG8_BAR; PG8_WAIT_L(0); PG8_MMA(0, 1, At, B1); PG8_BAR;
            PG8_LDA(At, 1, 1); PG8_STAGE(PG8_SA(1, 0), a3, voffA);
            PG8_BAR; PG8_WAIT_L(0); PG8_MMA(1, 0, At, B0); PG8_BAR; PG8_SCHED;
            PG8_STAGE(PG8_SB(1, 1), b3 + hstep, voffB);
            PG8_WAIT_V(6); PG8_BAR; PG8_MMA(1, 1, At, B1); PG8_BAR;
        }
        PG8_STAMP();
        if constexpr (!Epi::AFTER_DRAIN) { E(acc, cur, wr, wc, fr, fq); S.done(cur); }
        PG8_STAMP();
        if (!has_next) break;
#pragma unroll
        for (int a = 0; a < 2; ++a)
#pragma unroll
            for (int b = 0; b < 2; ++b)
#pragma unroll
                for (int m = 0; m < 4; ++m)
#pragma unroll
                    for (int n = 0; n < 2; ++n) acc[a][b][m][n] = (f32x4){0.f, 0.f, 0.f, 0.f};
        cur = nxt; cA = nA; cB = nB; ++ui;
    }
    PG8_WAIT_V(0);
    if (wr == 0) PG8_BAR;
    PG8_BAR;
    if constexpr (Epi::AFTER_DRAIN) { E.fused(acc, cur, wr, wc, fr, fq, lds, wid, lane); S.done(cur); }
    PG8_STAMP();
    if (STAMP && wid == 0) { stamps[lane] = lane < nts ? (((unsigned long long)(unsigned)ts_hi << 32) | (unsigned)ts_lo) : 0ull;
        if (lane == 62) stamps[62] = rt_entry; if (lane == 63) stamps[63] = (unsigned long long)wall_clock64(); }
#undef PG8_STAMP
#undef PG8_SA
#undef PG8_SB
#undef PG8_STAGE
#undef PG8_LDA
#undef PG8_LDB
#undef PG8_MMA
#undef PG8_WAIT_V
#undef PG8_WAIT_L
#undef PG8_BAR
#undef PG8_SCHED
}
}
#define LAS3 __attribute__((address_space(3)))
constexpr int MK_THREADS = 512;
constexpr float U4_ISCALE = 83.0f;
typedef __bf16 bf16x2_t __attribute__((ext_vector_type(2)));
DI float dot2bf(unsigned a, unsigned b, float c) { return __builtin_amdgcn_fdot2_f32_bf16(__builtin_bit_cast(bf16x2_t, a), __builtin_bit_cast(bf16x2_t, b), c, false); }
DI float bflo(unsigned v) { return __uint_as_float(v << 16); }
DI float bfhi(unsigned v) { return __uint_as_float(v & 0xffff0000u); }

template <class ColMap>
DI void transpose_tile(const float* __restrict__ src, int ldsrc, const float* __restrict__ gain, bf16_t* __restrict__ dst, int K, int k0, int n0, const ColMap& cm, LAS3 float* tl) {
    const int tid = threadIdx.x;
    __syncthreads();
    {
        const int n = tid & 63, sc = cm(n0 + n);
#pragma unroll
        for (int j = 0; j < 8; ++j) { const int k = (tid >> 6) + 8 * j; tl[k * 65 + n] = sc >= 0 ? src[(size_t)(k0 + k) * ldsrc + sc] * (gain ? gain[k0 + k] : 1.0f) : 0.f; }
    }
    __syncthreads();
    {
        const int n = tid >> 3, k8 = (tid & 7) * 8;
        u32x4 w;
        w.x = pack2bf(tl[(k8 + 0) * 65 + n], tl[(k8 + 1) * 65 + n]); w.y = pack2bf(tl[(k8 + 2) * 65 + n], tl[(k8 + 3) * 65 + n]);
        w.z = pack2bf(tl[(k8 + 4) * 65 + n], tl[(k8 + 5) * 65 + n]); w.w = pack2bf(tl[(k8 + 6) * 65 + n], tl[(k8 + 7) * 65 + n]);
        *(u32x4*)(dst + (size_t)(n0 + n) * K + k0 + k8) = w;
    }
}
struct ColId { DI int operator()(int n) const { return n; } };
struct ColWin { DI int operator()(int n) const { return n < PC_XR ? n : (n < PC_XG ? 1304 + (n - PC_XR) : (n < PC_GATE ? 1816 + (n - PC_XG) : (n < PC_GATE + 24 ? 1280 + (n - PC_GATE) : -1))); } };

DI void cvt_rows_bf16(const float* __restrict__ src, const float* __restrict__ gain, bf16_t* __restrict__ dst, size_t n8, int cols, size_t gtid, size_t nthr) {
    for (size_t i0 = gtid; i0 < n8; i0 += 8 * nthr) {
        f32x4 a[8], b[8];
#pragma unroll
        for (int u = 0; u < 8; ++u) { const size_t i = i0 + u * nthr; if (i < n8) { a[u] = *(const f32x4*)(src + i * 8); b[u] = *(const f32x4*)(src + i * 8 + 4); } }
#pragma unroll
        for (int u = 0; u < 8; ++u) { const size_t i = i0 + u * nthr; if (i < n8) {
            f32x4 x = a[u], y = b[u];
            if (gain) { const int c = (int)((i * 8) % cols); x *= *(const f32x4*)(gain + c); y *= *(const f32x4*)(gain + c + 4); }
            u32x4 w; w.x = pack2bf(x[0], x[1]); w.y = pack2bf(x[2], x[3]); w.z = pack2bf(y[0], y[1]); w.w = pack2bf(y[2], y[3]);
            *(u32x4*)(dst + i * 8) = w; } }
    }
}
DI void cvt_rows_fp8(const float* __restrict__ src, const float* __restrict__ gain, float scale, unsigned char* __restrict__ dst, size_t n8, int cols, size_t gtid, size_t nthr) {
    for (size_t i0 = gtid; i0 < n8; i0 += 8 * nthr) {
        f32x4 a[8], b[8];
#pragma unroll
        for (int u = 0; u < 8; ++u) { const size_t i = i0 + u * nthr; if (i < n8) { a[u] = *(const f32x4*)(src + i * 8); b[u] = *(const f32x4*)(src + i * 8 + 4); } }
#pragma unroll
        for (int u = 0; u < 8; ++u) { const size_t i = i0 + u * nthr; if (i < n8) {
            f32x4 x = a[u], y = b[u];
            if (gain) { const int c = (int)((i * 8) % cols); x *= *(const f32x4*)(gain + c); y *= *(const f32x4*)(gain + c + 4); }
            x *= scale; y *= scale;
            int w0 = 0, w1 = 0;
            w0 = __builtin_amdgcn_cvt_pk_fp8_f32(x[0], x[1], w0, false); w0 = __builtin_amdgcn_cvt_pk_fp8_f32(x[2], x[3], w0, true);
            w1 = __builtin_amdgcn_cvt_pk_fp8_f32(y[0], y[1], w1, false); w1 = __builtin_amdgcn_cvt_pk_fp8_f32(y[2], y[3], w1, true);
            *(u32x2*)(dst + i * 8) = (u32x2){(unsigned)w0, (unsigned)w1}; } }
    }
}
DI void cvt_rows_i8(const float* __restrict__ src, const float* __restrict__ gain, float scale, unsigned char* __restrict__ dst, size_t n8, int cols, size_t gtid, size_t nthr) {
    for (size_t i0 = gtid; i0 < n8; i0 += 8 * nthr) {
        f32x4 a[8], b[8];
#pragma unroll
        for (int u = 0; u < 8; ++u) { const size_t i = i0 + u * nthr; if (i < n8) { a[u] = *(const f32x4*)(src + i * 8); b[u] = *(const f32x4*)(src + i * 8 + 4); } }
#pragma unroll
        for (int u = 0; u < 8; ++u) { const size_t i = i0 + u * nthr; if (i < n8) {
            f32x4 x = a[u], y = b[u];
            if (gain) { const int c = (int)((i * 8) % cols); x *= *(const f32x4*)(gain + c); y *= *(const f32x4*)(gain + c + 4); }
            unsigned w0 = 0u, w1 = 0u;
#pragma unroll
            for (int j = 0; j < 4; ++j) {
                const int qa = (int)rintf(fminf(fmaxf(x[j] * scale, -127.f), 127.f)), qb = (int)rintf(fminf(fmaxf(y[j] * scale, -127.f), 127.f));
                w0 |= ((unsigned)qa & 0xffu) << (8 * j); w1 |= ((unsigned)qb & 0xffu) << (8 * j);
            }
            { const unsigned n0 = __shfl_down(w0, 1), n1 = __shfl_down(w1, 1); if ((threadIdx.x & 1) == 0) *(u32x4*)(dst + i * 8) = (u32x4){w0, w1, n0, n1}; } } }
    }
}
DI void cvt_rows_i4(const float* __restrict__ src, const float* __restrict__ gain, float scale, unsigned char* __restrict__ dst, size_t n8, int cols, size_t gtid, size_t nthr) {
    for (size_t i0 = gtid; i0 < n8; i0 += 8 * nthr) {
        f32x4 a[8], b[8];
#pragma unroll
        for (int u = 0; u < 8; ++u) { const size_t i = i0 + u * nthr; if (i < n8) { a[u] = *(const f32x4*)(src + i * 8); b[u] = *(const f32x4*)(src + i * 8 + 4); } }
#pragma unroll
        for (int u = 0; u < 8; ++u) { const size_t i = i0 + u * nthr; if (i < n8) {
            f32x4 x = a[u], y = b[u];
            if (gain) { const int c = (int)((i * 8) % cols); x *= *(const f32x4*)(gain + c); y *= *(const f32x4*)(gain + c + 4); }
            unsigned w = 0u;
#pragma unroll
            for (int j = 0; j < 4; ++j) {
                const int qa = (int)rintf(fminf(fmaxf(x[j] * scale, -7.f), 7.f)), qb = (int)rintf(fminf(fmaxf(y[j] * scale, -7.f), 7.f));
                w |= ((unsigned)qa & 0xfu) << (4 * j); w |= ((unsigned)qb & 0xfu) << (16 + 4 * j);
            }
            { const unsigned n1 = __shfl_down(w, 1), n2 = __shfl_down(w, 2), n3 = __shfl_down(w, 3); if ((threadIdx.x & 3) == 0) *(u32x4*)(dst + i * 4) = (u32x4){w, n1, n2, n3}; } } }
    }
}
DI void cvt_rows_fp4(const float* __restrict__ src, const float* __restrict__ gain, float scale, unsigned char* __restrict__ dst, size_t n8, int cols, size_t gtid, size_t nthr) {
    for (size_t i0 = gtid; i0 < n8; i0 += 8 * nthr) {
        f32x4 a[8], b[8];
#pragma unroll
        for (int u = 0; u < 8; ++u) { const size_t i = i0 + u * nthr; if (i < n8) { a[u] = *(const f32x4*)(src + i * 8); b[u] = *(const f32x4*)(src + i * 8 + 4); } }
#pragma unroll
        for (int u = 0; u < 8; ++u) { const size_t i = i0 + u * nthr; if (i < n8) {
            f32x4 x = a[u], y = b[u];
            if (gain) { const int c = (int)((i * 8) % cols); x *= *(const f32x4*)(gain + c); y *= *(const f32x4*)(gain + c + 4); }
            x *= scale; y *= scale;
            unsigned w = 0u;
            w = __builtin_amdgcn_cvt_scalef32_pk_fp4_f32(w, x[0], x[1], 1.0f, 0); w = __builtin_amdgcn_cvt_scalef32_pk_fp4_f32(w, x[2], x[3], 1.0f, 1);
            w = __builtin_amdgcn_cvt_scalef32_pk_fp4_f32(w, y[0], y[1], 1.0f, 2); w = __builtin_amdgcn_cvt_scalef32_pk_fp4_f32(w, y[2], y[3], 1.0f, 3);
            { const unsigned n1 = __shfl_down(w, 1), n2 = __shfl_down(w, 2), n3 = __shfl_down(w, 3); if ((threadIdx.x & 3) == 0) *(u32x4*)(dst + i * 4) = (u32x4){w, n1, n2, n3}; } } }
    }
}
DI void p0_prologue(const Params& p, LAS3 unsigned char* lds, int G) {
    unsigned char* ws = p.ws;
    const int tid = threadIdx.x, lane = tid & 63, wid = tid >> 6, bid = blockIdx.x;
    const size_t gtid = (size_t)bid * MK_THREADS + tid, nthr = (size_t)G * MK_THREADS;
    const int gw = bid * 8 + wid, nw = G * 8;
    {
        const float* x = p.in[I_X]; bf16_t* xb = (bf16_t*)(ws + WS_XB); float* rs0 = (float*)(ws + WS_RS0);
        for (int row0 = gw; row0 < NTOK; row0 += 4 * nw) {
            f32x4 v[4][4];
#pragma unroll
            for (int u = 0; u < 4; ++u) { const int row = row0 + u * nw; if (row < NTOK) { const float* xr_ = x + (size_t)row * DM + lane * 8;
                v[u][0] = *(const f32x4*)xr_; v[u][1] = *(const f32x4*)(xr_ + 4); v[u][2] = *(const f32x4*)(xr_ + 512); v[u][3] = *(const f32x4*)(xr_ + 516); } }
#pragma unroll
            for (int u = 0; u < 4; ++u) { const int row = row0 + u * nw; if (row < NTOK) {
                float s = 0.f;
#pragma unroll
                for (int j = 0; j < 4; ++j) s += (v[u][j][0] * v[u][j][0] + v[u][j][1] * v[u][j][1]) + (v[u][j][2] * v[u][j][2] + v[u][j][3] * v[u][j][3]);
                s = wave_sum(s);
                u32x4 w0, w1;
                w0.x = pack2bf(v[u][0][0], v[u][0][1]); w0.y = pack2bf(v[u][0][2], v[u][0][3]); w0.z = pack2bf(v[u][1][0], v[u][1][1]); w0.w = pack2bf(v[u][1][2], v[u][1][3]);
                w1.x = pack2bf(v[u][2][0], v[u][2][1]); w1.y = pack2bf(v[u][2][2], v[u][2][3]); w1.z = pack2bf(v[u][3][0], v[u][3][1]); w1.w = pack2bf(v[u][3][2], v[u][3][3]);
                *(u32x4*)(xb + (size_t)row * DM + lane * 8) = w0; *(u32x4*)(xb + (size_t)row * DM + 512 + lane * 8) = w1;
                if (lane == 0) rs0[row] = rsqrtf(s * (1.0f / DM) + EPS); } }
        }
    }
#if PEER_FP4
    cvt_rows_fp4(p.in[I_PEER_U], p.in[I_FFN_NORM], 64.0f, (unsigned char*)(ws + WS_UB), (size_t)16384 * DM / 8, DM, gtid, nthr);
    cvt_rows_fp4(p.in[I_PEER_V], nullptr, 6.0f, (unsigned char*)(ws + WS_VB), (size_t)16384 * DM / 8, DM, gtid, nthr);
#elif PEER_I8U
#if PEER_I4U
    cvt_rows_i4(p.in[I_PEER_U], p.in[I_FFN_NORM], U4_ISCALE, (unsigned char*)(ws + WS_UB), (size_t)16384 * DM / 8, DM, gtid, nthr);
#else
    cvt_rows_i8(p.in[I_PEER_U], p.in[I_FFN_NORM], 640.0f, (unsigned char*)(ws + WS_UB), (size_t)16384 * DM / 8, DM, gtid, nthr);
#endif
#if PEER_V4EXP
    cvt_rows_fp4(p.in[I_PEER_V], nullptr, 8.0f, (unsigned char*)(ws + WS_VB), (size_t)16384 * DM / 8, DM, gtid, nthr);
#else
    cvt_rows_fp8(p.in[I_PEER_V], nullptr, 8.0f, (unsigned char*)(ws + WS_VB), (size_t)16384 * DM / 8, DM, gtid, nthr);
#endif
#elif PEER_V3
    cvt_rows_fp8(p.in[I_PEER_U], p.in[I_FFN_NORM], 32.0f, (unsigned char*)(ws + WS_UB), (size_t)16384 * DM / 8, DM, gtid, nthr);
    cvt_rows_fp8(p.in[I_PEER_V], nullptr, 8.0f, (unsigned char*)(ws + WS_VB), (size_t)16384 * DM / 8, DM, gtid, nthr);
#else
    cvt_rows_bf16(p.in[I_PEER_U], p.in[I_FFN_NORM], (bf16_t*)(ws + WS_UB), (size_t)16384 * DM / 8, DM, gtid, nthr);
    cvt_rows_bf16(p.in[I_PEER_V], nullptr, (bf16_t*)(ws + WS_VB), (size_t)16384 * DM / 8, DM, gtid, nthr);
#endif
    cvt_rows_bf16(p.in[I_P], nullptr, (bf16_t*)(ws + WS_PB), (size_t)NTOK * PLE / 8, PLE, gtid, nthr);
    LAS3 float* tl = (LAS3 float*)lds;
    {
        for (int u = bid; u < 1496; u += G) {
            if (u < 640) transpose_tile(p.in[I_W_IN], INCOLS, p.in[I_ATTN_NORM], (bf16_t*)(ws + WS_WIN), DM, (u % 16) * 64, (u / 16) * 64, ColWin{}, tl);
            else if (u < 896) { const int v = u - 640; transpose_tile(p.in[I_W_OUT], DM, nullptr, (bf16_t*)(ws + WS_WOUT), DM, (v % 16) * 64, (v / 16) * 64, ColId{}, tl); }
            else if (u < 1152) { const int v = u - 896; transpose_tile(p.in[I_PLE_WG], DM, p.in[I_PLE_NORM], (bf16_t*)(ws + WS_WG), DM, (v % 16) * 64, (v / 16) * 64, ColId{}, tl); }
            else if (u < 1216) { const int v = u - 1152; transpose_tile(p.in[I_PLE_PROJ], DM, nullptr, (bf16_t*)(ws + WS_WP), PLE, (v % 4) * 64, (v / 4) * 64, ColId{}, tl); }
            else if (u < 1344) { const int v = u - 1216; transpose_tile(p.in[I_CK_W1], 256, nullptr, (bf16_t*)(ws + WS_CW1K), 2048, (v % 32) * 64, (v / 32) * 64, ColId{}, tl); }
            else if (u < 1472) { const int v = u - 1344; transpose_tile(p.in[I_CV_W1], 256, nullptr, (bf16_t*)(ws + WS_CW1V), 2048, (v % 32) * 64, (v / 32) * 64, ColId{}, tl); }
            else if (u < 1480) { const int v = u - 1472; transpose_tile(p.in[I_LRU_WA] + v * 4096, 64, nullptr, (bf16_t*)(ws + WS_WAT) + v * 4096, 64, 0, 0, ColId{}, tl); }
            else if (u < 1488) { const int v = u - 1480; transpose_tile(p.in[I_LRU_WX] + v * 4096, 64, nullptr, (bf16_t*)(ws + WS_WXT) + v * 4096, 64, 0, 0, ColId{}, tl); }
            else if (u < 1492) { const int v = u - 1488; transpose_tile(p.in[I_CK_W2], 64, nullptr, (bf16_t*)(ws + WS_CW2K), 256, v * 64, 0, ColId{}, tl); }
            else { const int v = u - 1492; transpose_tile(p.in[I_CV_W2], 64, nullptr, (bf16_t*)(ws + WS_CW2V), 256, v * 64, 0, ColId{}, tl); }
        }
        __syncthreads();
    }
    {
        LAS3 float* wt = (LAS3 float*)lds;
        LAS3 float* st = (LAS3 float*)(lds + 32768);
        const float* wq = p.in[I_PEER_WQ]; const float* sub = p.in[I_PEER_SUB]; const float* gain = p.in[I_FFN_NORM]; bf16_t* WqsT = (bf16_t*)(ws + WS_WQS);
        for (int u = bid; u < 256; u += G) {
            const int hp = u >> 4, d0 = (u & 15) * 64, pp = hp & 1;
            __syncthreads();
            {
                f32x4 wv[4], sv[8];
#pragma unroll
                for (int u = 0; u < 4; ++u) { const int i = tid + u * MK_THREADS, d = i >> 5, dk4 = (i & 31) * 4; wv[u] = *(const f32x4*)(wq + (size_t)(d0 + d) * 2048 + hp * 128 + dk4); }
#pragma unroll
                for (int u = 0; u < 8; ++u) { const int i = tid + u * MK_THREADS, kk = i >> 5, dk4 = (i & 31) * 4; sv[u] = *(const f32x4*)(sub + ((size_t)pp * 128 + kk) * 128 + dk4); }
#pragma unroll
                for (int u = 0; u < 4; ++u) { const int i = tid + u * MK_THREADS, d = i >> 5, dk4 = (i & 31) * 4;
#pragma unroll
                    for (int j = 0; j < 4; ++j) wt[(dk4 + j) * 64 + d] = wv[u][j]; }
#pragma unroll
                for (int u = 0; u < 8; ++u) { const int i = tid + u * MK_THREADS, kk = i >> 5, dk4 = (i & 31) * 4;
#pragma unroll
                    for (int j = 0; j < 4; ++j) st[kk * 129 + dk4 + j] = sv[u][j]; }
            }
            __syncthreads();
            const int kk = tid & 127, dg = (tid >> 7) * 16;
            float acc[16];
#pragma unroll
            for (int j = 0; j < 16; ++j) acc[j] = 0.f;
            for (int dk = 0; dk < 128; ++dk) {
                const float sv = st[kk * 129 + dk];
#pragma unroll
                for (int j4 = 0; j4 < 4; ++j4) { const f32x4 w4 = *(LAS3 f32x4*)(wt + dk * 64 + dg + j4 * 4);
#pragma unroll
                    for (int j = 0; j < 4; ++j) acc[j4 * 4 + j] += sv * w4[j]; }
            }
            u32x4 o0, o1;
#define GQ(j) (acc[j] * gain[d0 + dg + (j)])
            o0.x = pack2bf(GQ(0), GQ(1)); o0.y = pack2bf(GQ(2), GQ(3)); o0.z = pack2bf(GQ(4), GQ(5)); o0.w = pack2bf(GQ(6), GQ(7));
            o1.x = pack2bf(GQ(8), GQ(9)); o1.y = pack2bf(GQ(10), GQ(11)); o1.z = pack2bf(GQ(12), GQ(13)); o1.w = pack2bf(GQ(14), GQ(15));
#undef GQ
            bf16_t* dst = WqsT + (size_t)(hp * 128 + kk) * DM + d0 + dg;
            *(u32x4*)dst = o0; *(u32x4*)(dst + 8) = o1;
        }
        __syncthreads();
    }
    for (int o = gw; o < 512; o += nw) {
        const int kv = o >> 8, j = o & 255;
        const float* pe = p.in[kv ? I_CV_PE : I_CK_PE]; const float* w1 = p.in[kv ? I_CV_W1 : I_CK_W1];
        float acc = 0.f;
        for (int k = lane; k < 2048; k += 64) acc += pe[k] * w1[(size_t)k * 256 + j];
        acc = wave_sum(acc);
        if (lane == 0) ((float*)(ws + (kv ? WS_CBV : WS_CBK)))[j] = acc;
    }
}

DI void p6_peer_apply(const Params& p, int G) {
    unsigned char* ws = p.ws;
    const int tid = threadIdx.x, lane = tid & 63, wid = tid >> 6;
    const int gw = blockIdx.x * 8 + wid, nw = G * 8;
    const bf16_t* ub = (const bf16_t*)(ws + WS_UB); const bf16_t* vb = (const bf16_t*)(ws + WS_VB);
    const int* eidx = (const int*)(ws + R_EXP); const float* gsm = (const float*)(ws + R_GSM); const float* ssq1 = (const float*)(ws + WS_SSQ1);
    float* h = p.out; bf16_t* hb = (bf16_t*)(ws + R_H1B); float* rs2 = (float*)(ws + WS_RS2);
    for (int tok = gw; tok < NTOK; tok += nw) {
        float sq = lane < 16 ? ssq1[(size_t)lane * NTOK + tok] : 0.f;
        sq = wave_sum(sq);
        const float rs1 = rsqrtf(sq * (1.0f / DM) + EPS);
        const u32x4 xa = *(const u32x4*)(hb + (size_t)tok * DM + lane * 8), xc = *(const u32x4*)(hb + (size_t)tok * DM + 512 + lane * 8);
        const int e0 = eidx[(size_t)tok * 128 + lane], e1 = eidx[(size_t)tok * 128 + 64 + lane];
        const float g0 = gsm[(size_t)tok * 128 + lane], g1 = gsm[(size_t)tok * 128 + 64 + lane];
        float coef0 = 0.f, coef1 = 0.f;
#pragma unroll
        for (int half = 0; half < 2; ++half) {
            const int ev = half ? e1 : e0;
            float part[64];
#pragma unroll
            for (int j = 0; j < 64; ++j) {
                const int e = __builtin_amdgcn_readlane(ev, j);
                const bf16_t* ur = ub + (size_t)e * DM + lane * 8;
                const u32x4 ua = *(const u32x4*)ur, uc = *(const u32x4*)(ur + 512);
                float a = dot2bf(xa.x, ua.x, 0.f); a = dot2bf(xa.y, ua.y, a); a = dot2bf(xa.z, ua.z, a); a = dot2bf(xa.w, ua.w, a);
                a = dot2bf(xc.x, uc.x, a); a = dot2bf(xc.y, uc.y, a); a = dot2bf(xc.z, uc.z, a); a = dot2bf(xc.w, uc.w, a);
                part[j] = a;
            }
#pragma unroll
            for (int m = 32; m >= 1; m >>= 1) {
                const bool up = (lane & m) != 0;
#pragma unroll
                for (int i = 0; i < m; ++i) {
                    const float send = up ? part[i] : part[i + m];
                    const float keep = up ? part[i + m] : part[i];
                    part[i] = keep + __shfl_xor(send, m);
                }
            }
            const float act = gelu_tanh(part[0] * rs1);
            if (half) coef1 = g1 * act; else coef0 = g0 * act;
        }
        float acc[16];
#pragma unroll
        for (int i = 0; i < 16; ++i) acc[i] = 0.f;
#pragma unroll
        for (int half = 0; half < 2; ++half) {
            const int ev = half ? e1 : e0; const float cv = half ? coef1 : coef0;
#pragma unroll 16
            for (int j = 0; j < 64; ++j) {
                const int e = __builtin_amdgcn_readlane(ev, j);
                const float c = __uint_as_float(__builtin_amdgcn_readlane(__float_as_uint(cv), j));
                const bf16_t* vr = vb + (size_t)e * DM + lane * 8;
                const u32x4 va = *(const u32x4*)vr, vc = *(const u32x4*)(vr + 512);
                acc[0] += c * bflo(va.x); acc[1] += c * bfhi(va.x); acc[2] += c * bflo(va.y); acc[3] += c * bfhi(va.y);
                acc[4] += c * bflo(va.z); acc[5] += c * bfhi(va.z); acc[6] += c * bflo(va.w); acc[7] += c * bfhi(va.w);
                acc[8] += c * bflo(vc.x); acc[9] += c * bfhi(vc.x); acc[10] += c * bflo(vc.y); acc[11] += c * bfhi(vc.y);
                acc[12] += c * bflo(vc.z); acc[13] += c * bfhi(vc.z); acc[14] += c * bflo(vc.w); acc[15] += c * bfhi(vc.w);
            }
        }
        float* hr = h + (size_t)tok * DM + lane * 8;
        f32x4 h0 = *(f32x4*)hr, h1 = *(f32x4*)(hr + 4), h2 = *(f32x4*)(hr + 512), h3 = *(f32x4*)(hr + 516);
        h0 += (f32x4){acc[0], acc[1], acc[2], acc[3]}; h1 += (f32x4){acc[4], acc[5], acc[6], acc[7]};
        h2 += (f32x4){acc[8], acc[9], acc[10], acc[11]}; h3 += (f32x4){acc[12], acc[13], acc[14], acc[15]};
        *(f32x4*)hr = h0; *(f32x4*)(hr + 4) = h1; *(f32x4*)(hr + 512) = h2; *(f32x4*)(hr + 516) = h3;
        u32x4 w0, w1;
        w0.x = pack2bf(h0[0], h0[1]); w0.y = pack2bf(h0[2], h0[3]); w0.z = pack2bf(h1[0], h1[1]); w0.w = pack2bf(h1[2], h1[3]);
        w1.x = pack2bf(h2[0], h2[1]); w1.y = pack2bf(h2[2], h2[3]); w1.z = pack2bf(h3[0], h3[1]); w1.w = pack2bf(h3[2], h3[3]);
        *(u32x4*)(hb + (size_t)tok * DM + lane * 8) = w0; *(u32x4*)(hb + (size_t)tok * DM + 512 + lane * 8) = w1;
        float s = 0.f;
#pragma unroll
        for (int j = 0; j < 4; ++j) s += h0[j] * h0[j] + h1[j] * h1[j] + h2[j] * h2[j] + h3[j] * h3[j];
        s = wave_sum(s);
        if (lane == 0) rs2[tok] = rsqrtf(s * (1.0f / DM) + EPS);
    }
}

DI void p8_final_norm(const Params& p, int G) {
    const int lane = threadIdx.x & 63, gw = blockIdx.x * 8 + (threadIdx.x >> 6), nw = G * 8;
    const float* ssq3 = (const float*)(p.ws + WS_SSQ3); const float* g = p.in[I_FINAL_NORM]; const bf16_t* h3 = (const bf16_t*)(p.ws + WS_XB); float* out = p.out;
    f32x4 gg[4];
    gg[0] = *(const f32x4*)(g + lane * 8); gg[1] = *(const f32x4*)(g + lane * 8 + 4); gg[2] = *(const f32x4*)(g + 512 + lane * 8); gg[3] = *(const f32x4*)(g + 512 + lane * 8 + 4);
    for (int row0 = gw; row0 < NTOK; row0 += 4 * nw) {
        u32x4 va[4], vb[4]; float sq[4];
#pragma unroll
        for (int u = 0; u < 4; ++u) { const int row = row0 + u * nw; if (row < NTOK) { sq[u] = lane < 16 ? ssq3[(size_t)lane * NTOK + row] : 0.f;
            va[u] = *(const u32x4*)(h3 + (size_t)row * DM + lane * 8); vb[u] = *(const u32x4*)(h3 + (size_t)row * DM + 512 + lane * 8); } }
#pragma unroll
        for (int u = 0; u < 4; ++u) { const int row = row0 + u * nw; if (row < NTOK) {
            const float rs = rsqrtf(wave_sum(sq[u]) * (1.0f / DM) + EPS);
            float* o = out + (size_t)row * DM + lane * 8;
            *(f32x4*)o = (f32x4){bflo(va[u].x), bfhi(va[u].x), bflo(va[u].y), bfhi(va[u].y)} * rs * gg[0];
            *(f32x4*)(o + 4) = (f32x4){bflo(va[u].z), bfhi(va[u].z), bflo(va[u].w), bfhi(va[u].w)} * rs * gg[1];
            *(f32x4*)(o + 512) = (f32x4){bflo(vb[u].x), bfhi(vb[u].x), bflo(vb[u].y), bfhi(vb[u].y)} * rs * gg[2];
            *(f32x4*)(o + 516) = (f32x4){bflo(vb[u].z), bfhi(vb[u].z), bflo(vb[u].w), bfhi(vb[u].w)} * rs * gg[3]; } }
    }
}
typedef float f32x16 __attribute__((ext_vector_type(16)));
typedef short bf16x8v __attribute__((ext_vector_type(8)));
typedef __bf16 bf16x2v_ __attribute__((ext_vector_type(2)));
DI unsigned pk_bf16(float lo, float hi) { return __builtin_bit_cast(unsigned, __builtin_convertvector((f32x2){lo, hi}, bf16x2v_)); }
constexpr float LOG2E = 1.4426950408889634f;
constexpr int AT_KROW = 144, AT_VROW = 136;
constexpr int AT_KT = 64 * AT_KROW, AT_VT = 64 * AT_VROW, AT_BUF = 2 * AT_KT + 2 * AT_VT;
constexpr int AT_VAL = 0;
constexpr int AT_LUT = 2 * AT_BUF;
constexpr int AT_IMP = AT_LUT + 8 * 128 * 4;
constexpr int AT_SEL = AT_IMP + 8 * 32 * 65 * 4;
constexpr int AT_SSQ = AT_SEL + 512;
constexpr int AT_END = AT_SSQ + 1024;
static_assert(AT_END <= 160 * 1024 - 256, "attention LDS map");

struct AtSrc { const bf16_t* k0; const bf16_t* k1; const bf16_t* v0; const bf16_t* v1; int vld; };
DI void at_load(const AtSrc& s, int kpos, int tid, u32x4 (&r)[4]) {
    const int row = tid >> 3, seg = tid & 7;
    r[0] = *(const u32x4*)(s.k0 + (size_t)(kpos + row) * HD + seg * 8);
    r[1] = *(const u32x4*)(s.k1 + (size_t)(kpos + row) * HD + seg * 8);
    r[2] = *(const u32x4*)(s.v0 + (size_t)row * s.vld + kpos + seg * 8);
    r[3] = *(const u32x4*)(s.v1 + (size_t)row * s.vld + kpos + seg * 8);
}
DI void at_store(LAS3 unsigned char* buf, int tid, const u32x4 (&r)[4]) {
    const int row = tid >> 3, seg = tid & 7;
    *(LAS3 u32x4*)(buf + row * AT_KROW + seg * 16) = r[0];
    *(LAS3 u32x4*)(buf + AT_KT + row * AT_KROW + seg * 16) = r[1];
    LAS3 unsigned char* v = buf + 2 * AT_KT + row * AT_VROW + seg * 16;
    *(LAS3 u32x2*)(v) = (u32x2){r[2].x, r[2].y}; *(LAS3 u32x2*)(v + 8) = (u32x2){r[2].z, r[2].w};
    *(LAS3 u32x2*)(v + AT_VT) = (u32x2){r[3].x, r[3].y}; *(LAS3 u32x2*)(v + AT_VT + 8) = (u32x2){r[3].z, r[3].w};
}

template <int MODE, int PASS, int APROBE>
DI void at_step(LAS3 const unsigned char* Kb, LAS3 const unsigned char* Vb, const bf16x8v (&Q)[4], int k0, int tq, int lane, LAS3 const float* lut, bool blk_ok, bool farstep,
                float& m_run, float& l_run, f32x16 (&O)[2], float inv_l, LAS3 float* imp_row, float& bcarry) {
    const int r = lane & 31, hf = lane >> 5;
    f32x16 S[2];
#pragma unroll
    for (int sub = 0; sub < 2; ++sub) {
#pragma unroll
        for (int i = 0; i < 16; ++i) S[sub][i] = 0.f;
#pragma unroll
        for (int ks = 0; ks < 4; ++ks) {
            const bf16x8v a = *(LAS3 const bf16x8v*)(Kb + (32 * sub + r) * AT_KROW + 32 * ks + 16 * hf);
            if (APROBE < 3) S[sub] = __builtin_amdgcn_mfma_f32_32x32x16_bf16(a, Q[ks], S[sub], 0, 0, 0);
            else S[sub][ks] += __builtin_bit_cast(float, (int)a[0] | ((int)a[1] << 16));
        }
    }
    __builtin_amdgcn_sched_barrier(0);
    float mx = -INFINITY;
    const float bfar = lut[127];
    if (APROBE >= 2) { mx = S[0][0]; } else
    if (!farstep) {
#pragma unroll
        for (int sub = 0; sub < 2; ++sub)
#pragma unroll
            for (int i = 0; i < 16; ++i) {
                const int kp = k0 + 32 * sub + (i & 3) + 8 * (i >> 2) + 4 * hf;
                const int dist = MODE == 0 ? tq - (16 * kp + 31) : tq - kp;
                bool ok = dist >= 0 && blk_ok;
                if (MODE == 2) ok = ok && dist < 512;
                const int idx = dist < 0 ? 0 : (dist > 127 ? 127 : dist);
                float s = S[sub][i] + lut[idx];
                s = ok ? s : -INFINITY;
                S[sub][i] = s; mx = fmaxf(mx, s);
            }
    } else {
#pragma unroll
        for (int sub = 0; sub < 2; ++sub)
#pragma unroll
            for (int i = 0; i < 16; ++i) mx = fmaxf(mx, S[sub][i]);
        mx += bfar;
        if (MODE == 1) mx = blk_ok ? mx : -INFINITY;
    }
    if (APROBE >= 2) { l_run += mx; } else
    if (PASS != 2) {
        mx = fmaxf(mx, __shfl_xor(mx, 32));
        const float m_new = fmaxf(m_run, mx), m_safe = (m_new == -INFINITY) ? 0.f : m_new;
        const float alpha = __builtin_amdgcn_exp2f(m_run - m_safe);
        float m_use = farstep ? m_safe - bfar : m_safe;
        if (MODE == 1 && farstep) m_use = blk_ok ? m_use : INFINITY;
        float sum = 0.f;
#pragma unroll
        for (int sub = 0; sub < 2; ++sub)
#pragma unroll
            for (int i = 0; i < 16; ++i) { const float pv = __builtin_amdgcn_exp2f(S[sub][i] - m_use); S[sub][i] = pv; sum += pv; }
        l_run = l_run * alpha + sum; m_run = m_new;
        if (PASS == 0) {
            if (__any(alpha != 1.0f)) {
#pragma unroll
                for (int db = 0; db < 2; ++db)
#pragma unroll
                    for (int i = 0; i < 16; ++i) O[db][i] *= alpha;
            }
        }
    } else {
        const float mu = farstep ? m_run - bfar : m_run;
#pragma unroll
        for (int sub = 0; sub < 2; ++sub) {
#pragma unroll
            for (int i = 0; i < 16; ++i) S[sub][i] = __builtin_amdgcn_exp2f(S[sub][i] - mu) * inv_l;
            float bp[4], av[4];
#pragma unroll
            for (int a = 0; a < 4; ++a) {
                av[a] = S[sub][4 * a] + S[sub][4 * a + 1] + S[sub][4 * a + 2] + 0.5f * S[sub][4 * a + 3];
                bp[a] = __shfl_xor(0.5f * S[sub][4 * a + 3], 32);
            }
            const int sbase = (k0 >> 2) + 8 * sub + hf;
#pragma unroll
            for (int a = 0; a < 4; ++a) imp_row[sbase + 2 * a] = av[a] + (hf ? bp[a] : (a > 0 ? bp[a > 0 ? a - 1 : 0] : bcarry));
            bcarry = bp[3];
        }
    }
    __builtin_amdgcn_sched_barrier(0);
    if (PASS != 1) {
#pragma unroll
        for (int sub = 0; sub < 2; ++sub)
#pragma unroll
            for (int s2 = 0; s2 < 2; ++s2) {
                u32x4 pw;
                pw.x = pk_bf16(S[sub][8 * s2 + 0], S[sub][8 * s2 + 1]); pw.y = pk_bf16(S[sub][8 * s2 + 2], S[sub][8 * s2 + 3]);
                pw.z = pk_bf16(S[sub][8 * s2 + 4], S[sub][8 * s2 + 5]); pw.w = pk_bf16(S[sub][8 * s2 + 6], S[sub][8 * s2 + 7]);
                const bf16x8v pf = __builtin_bit_cast(bf16x8v, pw);
#pragma unroll
                for (int db = 0; db < 2; ++db) {
                    LAS3 const unsigned char* va = Vb + (32 * db + r) * AT_VROW + (32 * sub + 16 * s2 + 4 * hf) * 2;
                    const u32x2 v0 = *(LAS3 const u32x2*)va, v1 = *(LAS3 const u32x2*)(va + 16);
                    const bf16x8v vf = __builtin_bit_cast(bf16x8v, (u32x4){v0.x, v0.y, v1.x, v1.y});
                    if (APROBE < 3) O[db] = __builtin_amdgcn_mfma_f32_32x32x16_bf16(vf, pf, O[db], 0, 0, 0); else O[db][s2] += __builtin_bit_cast(float, (int)vf[0] | ((int)pf[1] << 16));
                }
            }
    }
}

template <int MODE, int PASS, int APROBE>
DI void at_branch(LAS3 unsigned char* lds, const AtSrc& src, int blk_lo, int blk_hi, const bf16x8v (&Q)[4], int tq, int tid, int kvh, LAS3 const float* lut,
                  unsigned mlo, unsigned mhi, float& m_run, float& l_run, f32x16 (&O)[2], float inv_l, LAS3 float* imp_row) {
    const int lane = tid & 63;
    u32x4 st[4];
    float bcarry = 0.f;
    at_load(src, blk_lo * 64, tid, st);
    for (int blk = blk_lo; blk <= blk_hi; ++blk) {
        LAS3 unsigned char* buf = lds + ((blk - blk_lo) & 1) * AT_BUF;
        at_store(buf, tid, st);
        __syncthreads();
        if (blk < blk_hi) at_load(src, (blk + 1) * 64, tid, st);
        bool blk_ok = true;
        if (MODE == 1) blk_ok = ((blk < 32 ? (mlo >> blk) : (mhi >> (blk - 32))) & 1u) != 0u;
        const int t0u = tq - (lane & 31);
        const bool farstep = MODE == 0 ? (t0u - 16 * (blk * 64 + 63) - 31 >= 128) : (MODE == 1 ? (t0u - blk * 64 - 63 >= 128) : (t0u - blk * 64 - 63 >= 128 && t0u + 31 - blk * 64 < 512));
        if (MODE != 1 || __any(blk_ok)) {
            at_step<MODE, PASS, APROBE>(buf + kvh * AT_KT, buf + 2 * AT_KT + kvh * AT_VT, Q, blk * 64, tq, lane, lut, blk_ok, farstep, m_run, l_run, O, inv_l, imp_row, bcarry);
        }
    }
    __syncthreads();
}

template <int APROBE> DI void p3_attention(const Params& p, LAS3 unsigned char* lds, int G) {
    unsigned char* ws = p.ws;
    const int tid = threadIdx.x, lane = tid & 63, h = __builtin_amdgcn_readfirstlane(tid >> 6), kvh = h >> 2, r = lane & 31, hf = lane >> 5;
    LAS3 float* lutall = (LAS3 float*)(lds + AT_LUT);
    {
        const float* rel = p.in[I_REL];
        for (int i = tid; i < 1024; i += MK_THREADS) lutall[i] = rel[rel_bucket(i & 127) * NH + (i >> 7)] * LOG2E;
    }
    __syncthreads();
    LAS3 const float* lut = lutall + h * 128;
    LAS3 float* impw = (LAS3 float*)(lds + AT_IMP);
    LAS3 float* vals = (LAS3 float*)(lds + AT_VAL);
    LAS3 unsigned char* selb = lds + AT_SEL;
    LAS3 float* ssq = (LAS3 float*)(lds + AT_SSQ);
    const bf16_t* qb = (const bf16_t*)(ws + R_QB);
    const float* gates = (const float*)(ws + R_GATE);
    const float* gn = p.in[I_GN_ATTN];
    bf16_t* mixed = APROBE ? (bf16_t*)(ws + R_BIG + 32 * MB) : (bf16_t*)(ws + WS_MIXED);
    for (int ui = blockIdx.x; ui < 512; ui += G) {
        const int q8 = ui & 255, rnd = ui >> 8, b = q8 >> 6, j6 = q8 & 63, tb = rnd == 0 ? 127 - j6 : j6;
        const int t0 = 32 * tb, qb64 = tb >> 1, tq = t0 + r;
        const size_t tok = (size_t)b * T_ + tq;
        bf16x8v Q[4];
#pragma unroll
        for (int ks = 0; ks < 4; ++ks) Q[ks] = *(const bf16x8v*)(qb + tok * 512 + h * 64 + 16 * ks + 8 * hf);
        f32x16 O[2];
#pragma unroll
        for (int db = 0; db < 2; ++db)
#pragma unroll
            for (int i = 0; i < 16; ++i) O[db][i] = 0.f;
        LAS3 float* oslot = (LAS3 float*)(lds + AT_IMP) + h * 2048 + lane;
        const size_t bh0 = (size_t)b * 2, bh1 = bh0 + 1;
        {
            const bf16_t* kcb = (const bf16_t*)(ws + R_KCB); const bf16_t* vct = (const bf16_t*)(ws + R_VCT);
            const AtSrc src{kcb + bh0 * 256 * 64, kcb + bh1 * 256 * 64, vct + bh0 * 64 * 256, vct + bh1 * 64 * 256, 256};
            const int nst = tb / 32 + 1;
            float m_run = -INFINITY, l_run = 0.f;
            at_branch<0, 1, APROBE>(lds, src, 0, nst - 1, Q, tq, tid, kvh, lut, 0u, 0u, m_run, l_run, O, 0.f, nullptr);
            const float l_tot = l_run + __shfl_xor(l_run, 32);
            const float inv_l = l_tot > 0.f ? 1.0f / l_tot : 0.f;
            float m_fix = (m_run == -INFINITY) ? 0.f : m_run;
            at_branch<0, 2, APROBE>(lds, src, 0, nst - 1, Q, tq, tid, kvh, lut, 0u, 0u, m_fix, l_run, O, inv_l, impw + (h * 32 + r) * 65);
        }
        {
            const int row = tid >> 3, j8 = tid & 7, kr = row >> 5, tr = row & 31;
#pragma unroll
            for (int jj = 0; jj < 8; ++jj) {
                const int s = j8 * 8 + jj, db = qb64 - s;
                float v = 0.f;
#pragma unroll
                for (int g = 0; g < 4; ++g) v += impw[((kr * 4 + g) * 32 + tr) * 65 + s];
                vals[row * 65 + s] = (db >= 0 && db < 2) ? 2.0e4f : (s == 0 ? 1.0e4f : (db >= 0 ? v : -1.0f));
            }
            __syncthreads();
            unsigned bits = 0u;
            {
                float vv[8]; int rk[8];
#pragma unroll
                for (int jj = 0; jj < 8; ++jj) { vv[jj] = vals[row * 65 + j8 * 8 + jj]; rk[jj] = 0; }
#pragma unroll 2
                for (int s2 = 0; s2 < 64; ++s2) {
                    const float w = vals[row * 65 + s2];
#pragma unroll
                    for (int jj = 0; jj < 8; ++jj) rk[jj] += (w > vv[jj] || (w == vv[jj] && s2 < j8 * 8 + jj)) ? 1 : 0;
                }
#pragma unroll
                for (int jj = 0; jj < 8; ++jj) if (rk[jj] < 16 && qb64 - (j8 * 8 + jj) >= 0) bits |= 1u << jj;
            }
            selb[row * 8 + j8] = (unsigned char)bits;
            __syncthreads();
        }
        const unsigned mlo = *(LAS3 const unsigned*)(selb + (kvh * 32 + r) * 8), mhi = *(LAS3 const unsigned*)(selb + (kvh * 32 + r) * 8 + 4);
        __syncthreads();
        {
            const float g0 = sigmoidf_(gates[tok * 24 + h * 3 + 0]);
#pragma unroll
            for (int db = 0; db < 2; ++db)
#pragma unroll
                for (int i = 0; i < 16; ++i) { oslot[(db * 16 + i) * 64] = g0 * O[db][i]; O[db][i] = 0.f; }
        }
        {
            const bf16_t* ksb = (const bf16_t*)(ws + R_KS); const bf16_t* vst = (const bf16_t*)(ws + R_VST);
            const AtSrc src{ksb + bh0 * T_ * HD, ksb + bh1 * T_ * HD, vst + bh0 * HD * T_, vst + bh1 * HD * T_, T_};
            float m_run = -INFINITY, l_run = 0.f;
            at_branch<1, 0, APROBE>(lds, src, 0, qb64, Q, tq, tid, kvh, lut, mlo, mhi, m_run, l_run, O, 0.f, nullptr);
            const float l_tot = l_run + __shfl_xor(l_run, 32), sc = sigmoidf_(gates[tok * 24 + h * 3 + 1]) / l_tot;
#pragma unroll
            for (int db = 0; db < 2; ++db)
#pragma unroll
                for (int i = 0; i < 16; ++i) { oslot[(db * 16 + i) * 64] += sc * O[db][i]; O[db][i] = 0.f; }
        }
        {
            const bf16_t* kwb = (const bf16_t*)(ws + R_KW); const bf16_t* vwt = (const bf16_t*)(ws + R_VWT);
            const AtSrc src{kwb + bh0 * T_ * HD, kwb + bh1 * T_ * HD, vwt + bh0 * HD * T_, vwt + bh1 * HD * T_, T_};
            int wb0 = (t0 - 511) >> 6; wb0 = wb0 < 0 ? 0 : wb0;
            float m_run = -INFINITY, l_run = 0.f;
            at_branch<2, 0, APROBE>(lds, src, wb0, qb64, Q, tq, tid, kvh, lut, 0u, 0u, m_run, l_run, O, 0.f, nullptr);
            const float l_tot = l_run + __shfl_xor(l_run, 32), sc = sigmoidf_(gates[tok * 24 + h * 3 + 2]) / l_tot;
#pragma unroll
            for (int db = 0; db < 2; ++db)
#pragma unroll
                for (int i = 0; i < 16; ++i) O[db][i] = oslot[(db * 16 + i) * 64] + sc * O[db][i];
        }
        {
            float ss = 0.f;
#pragma unroll
            for (int db = 0; db < 2; ++db)
#pragma unroll
                for (int i = 0; i < 16; ++i) ss += O[db][i] * O[db][i];
            ss += __shfl_xor(ss, 32);
            if (hf == 0) ssq[h * 32 + r] = ss;
            __syncthreads();
            float tot = 0.f;
#pragma unroll
            for (int hh = 0; hh < 8; ++hh) tot += ssq[hh * 32 + r];
            const float rs = rsqrtf(tot * (1.0f / 512) + EPS);
#pragma unroll
            for (int db = 0; db < 2; ++db)
#pragma unroll
                for (int a = 0; a < 4; ++a) {
                    const int d = 32 * db + 8 * a + 4 * hf;
                    const f32x4 g4 = *(const f32x4*)(gn + h * 64 + d);
                    u32x2 w; w.x = pk_bf16(O[db][4 * a] * rs * g4[0], O[db][4 * a + 1] * rs * g4[1]); w.y = pk_bf16(O[db][4 * a + 2] * rs * g4[2], O[db][4 * a + 3] * rs * g4[3]);
                    *(u32x2*)(mixed + tok * DM + h * 64 + d) = w;
                }
            __syncthreads();
        }
    }
}
constexpr int LR_STRIDE = 516;
constexpr int LR_XC = 0, LR_A = 32 * LR_STRIDE * 4, LR_RS = 2 * 32 * LR_STRIDE * 4, LR_END = LR_RS + 256;
static_assert(LR_END <= 160 * 1024 - 256, "LRU LDS map");

template <bool FINAL>
DI void lru_phase(const Params& p, LAS3 unsigned char* lds, int G) {
    unsigned char* ws = p.ws;
    const int tid = threadIdx.x, lane = tid & 63, n = __builtin_amdgcn_readfirstlane(tid >> 6), r = lane & 31, hf = lane >> 5, ch = tid;
    LAS3 float* XC = (LAS3 float*)(lds + LR_XC); LAS3 float* AA = (LAS3 float*)(lds + LR_A); LAS3 float* RS = (LAS3 float*)(lds + LR_RS);
    const bf16_t* xr = (const bf16_t*)(ws + R_XR); const bf16_t* xg = (const bf16_t*)(ws + R_XG);
    float* sumP = (float*)(ws + WS_LRUP); float* sumH = (float*)(ws + WS_LRUH);
    bf16_t* mixed = (bf16_t*)(ws + WS_MIXED);
    const float cw0 = p.in[I_CONV_W][0 * 512 + ch], cw1 = p.in[I_CONV_W][1 * 512 + ch], cw2 = p.in[I_CONV_W][2 * 512 + ch], cw3 = p.in[I_CONV_W][3 * 512 + ch], cb = p.in[I_CONV_B][ch];
    const float gl = FINAL ? p.in[I_GN_LRU][ch] : 0.f;
    float ba[2], bx[2], sp[2];
#pragma unroll
    for (int nb = 0; nb < 2; ++nb) { const int c2 = n * 64 + 32 * nb + r; ba[nb] = p.in[I_LRU_BA][c2]; bx[nb] = p.in[I_LRU_BX][c2]; sp[nb] = log1pf(__expf(-p.in[I_LRU_LAM][c2])); }
    const bf16_t* waT = (const bf16_t*)(ws + WS_WAT); const bf16_t* wxT = (const bf16_t*)(ws + WS_WXT);
    for (int ci = blockIdx.x; ci < 256; ci += G) {
        const int b = ci >> 6, cib = ci & 63, t0 = cib * 64;
        const size_t tok0 = (size_t)b * T_ + t0;
        float x1 = 0.f, x2 = 0.f, x3 = 0.f;
        if (t0 > 0) { x1 = bf2f(xr[(tok0 - 1) * 512 + ch]); x2 = bf2f(xr[(tok0 - 2) * 512 + ch]); x3 = bf2f(xr[(tok0 - 3) * 512 + ch]); }
        float hst = 0.f, pprod = 1.f;
        if (FINAL) {
            const float* Pp = sumP + (size_t)(b * 64) * 512 + ch; const float* Hp = sumH + (size_t)(b * 64) * 512 + ch;
            for (int k = 0; k < cib; ++k) hst = Pp[(size_t)k * 512] * hst + Hp[(size_t)k * 512];
        }
#pragma unroll 1
        for (int half = 0; half < 2; ++half) {
            const size_t tokh = tok0 + half * 32;
            __syncthreads();
            {
                bf16_t xw[32]; float xv[32];
#pragma unroll
                for (int t = 0; t < 32; ++t) xw[t] = xr[(tokh + t) * 512 + ch];
#pragma unroll
                for (int t = 0; t < 32; ++t) xv[t] = bf2f(xw[t]);
#pragma unroll
                for (int t = 0; t < 32; ++t) {
                    const float x0 = xv[t];
                    XC[t * LR_STRIDE + ch] = cw0 * x3 + cw1 * x2 + cw2 * x1 + cw3 * x0 + cb;
                    x3 = x2; x2 = x1; x1 = x0;
                }
            }
            __syncthreads();
            {
                f32x16 ar[2], ai[2];
#pragma unroll
                for (int nb = 0; nb < 2; ++nb)
#pragma unroll
                    for (int i = 0; i < 16; ++i) { ar[nb][i] = 0.f; ai[nb][i] = 0.f; }
                bf16x8v Ba[2][4], Bx[2][4];
#pragma unroll
                for (int nb = 0; nb < 2; ++nb)
#pragma unroll
                    for (int ks = 0; ks < 4; ++ks) {
                        const size_t o = (size_t)(n * 64 + 32 * nb + r) * 64 + 16 * ks + 8 * hf;
                        Ba[nb][ks] = *(const bf16x8v*)(waT + o); Bx[nb][ks] = *(const bf16x8v*)(wxT + o);
                    }
#pragma unroll
                for (int ks = 0; ks < 4; ++ks) {
                    LAS3 const float* src = XC + r * LR_STRIDE + n * 64 + 16 * ks + 8 * hf;
                    const f32x4 f0 = *(LAS3 const f32x4*)src, f1 = *(LAS3 const f32x4*)(src + 4);
                    u32x4 pw; pw.x = pk_bf16(f0[0], f0[1]); pw.y = pk_bf16(f0[2], f0[3]); pw.z = pk_bf16(f1[0], f1[1]); pw.w = pk_bf16(f1[2], f1[3]);
                    const bf16x8v af = __builtin_bit_cast(bf16x8v, pw);
#pragma unroll
                    for (int nb = 0; nb < 2; ++nb) {
                        ar[nb] = __builtin_amdgcn_mfma_f32_32x32x16_bf16(af, Ba[nb][ks], ar[nb], 0, 0, 0);
                        ai[nb] = __builtin_amdgcn_mfma_f32_32x32x16_bf16(af, Bx[nb][ks], ai[nb], 0, 0, 0);
                    }
                }
                __syncthreads();
#pragma unroll
                for (int nb = 0; nb < 2; ++nb)
#pragma unroll
                    for (int i = 0; i < 16; ++i) {
                        const int t = (i & 3) + 8 * (i >> 2) + 4 * hf, o = t * LR_STRIDE + n * 64 + 32 * nb + r;
                        const float xcv = XC[o];
                        const float rg = sigmoidf_(ar[nb][i] + ba[nb]), ig = sigmoidf_(ai[nb][i] + bx[nb]);
                        const float log_a = -8.0f * rg * sp[nb];
                        AA[o] = __expf(log_a);
                        XC[o] = sqrtf(-expm1f(2.0f * log_a)) * (ig * xcv);
                    }
            }
            __syncthreads();
            if (!FINAL) {
#pragma unroll 8
                for (int t = 0; t < 32; ++t) { const float a = AA[t * LR_STRIDE + ch]; hst = a * hst + XC[t * LR_STRIDE + ch]; pprod *= a; }
            } else {
                {
                    bf16_t gv[32];
#pragma unroll
                    for (int t = 0; t < 32; ++t) gv[t] = xg[(tokh + t) * 512 + ch];
#pragma unroll
                    for (int t = 0; t < 32; ++t) {
                        hst = AA[t * LR_STRIDE + ch] * hst + XC[t * LR_STRIDE + ch];
                        XC[t * LR_STRIDE + ch] = hst * gelu_tanh(bf2f(gv[t]));
                    }
                }
                __syncthreads();
                {
                    const int t = tid >> 4, part = tid & 15;
                    float s = 0.f;
#pragma unroll 8
                    for (int j = 0; j < 32; ++j) { const float v = XC[t * LR_STRIDE + part + 16 * j]; s += v * v; }
                    s += __shfl_xor(s, 1); s += __shfl_xor(s, 2); s += __shfl_xor(s, 4); s += __shfl_xor(s, 8);
                    if (part == 0) RS[t] = rsqrtf(s * (1.0f / 512) + EPS);
                }
                __syncthreads();
                {
                    const int t = tid >> 4, part = tid & 15; const float rs = RS[t];
                    const float* gp = p.in[I_GN_LRU] + part * 32; LAS3 const float* xp = XC + t * LR_STRIDE + part * 32;
                    bf16_t* dst = mixed + (tokh + t) * DM + 512 + part * 32;
#pragma unroll
                    for (int q = 0; q < 4; ++q) {
                        const f32x4 a = *(LAS3 const f32x4*)(xp + 8 * q), b = *(LAS3 const f32x4*)(xp + 8 * q + 4), ga = *(const f32x4*)(gp + 8 * q), gb = *(const f32x4*)(gp + 8 * q + 4);
                        u32x4 w; w.x = pack2bf(a[0] * rs * ga[0], a[1] * rs * ga[1]); w.y = pack2bf(a[2] * rs * ga[2], a[3] * rs * ga[3]);
                        w.z = pack2bf(b[0] * rs * gb[0], b[1] * rs * gb[1]); w.w = pack2bf(b[2] * rs * gb[2], b[3] * rs * gb[3]);
                        *(u32x4*)(dst + 8 * q) = w;
                    }
                }
            }
        }
        if (!FINAL) { sumP[(size_t)ci * 512 + ch] = pprod; sumH[(size_t)ci * 512 + ch] = hst; }
    }
    __syncthreads();
}
typedef float f32x4v __attribute__((ext_vector_type(4)));
constexpr int CM_IMG = 0;
constexpr int CM_HID = 36864;
constexpr int CM_END = CM_HID + 16 * 264 * 2;
DI void p2_compress(const Params& p, LAS3 unsigned char* lds, int G) {
    unsigned char* ws = p.ws;
    const int tid = threadIdx.x, lane = tid & 63, wid = __builtin_amdgcn_readfirstlane(tid >> 6), row = lane & 15, kg = lane >> 4;
    for (int u = blockIdx.x; u < 256; u += G) {
        const int kv = u >> 7, bh = (u >> 4) & 7, c0 = (u & 15) * 16;
        const bf16_t* src = (const bf16_t*)(ws + (kv ? R_VC : R_KC)) + ((size_t)bh * T_ + 16 * c0) * HD;
        const bf16_t* W1T = (const bf16_t*)(ws + (kv ? WS_CW1V : WS_CW1K));
        const float* cb = (const float*)(ws + (kv ? WS_CBV : WS_CBK));
        const bf16_t* W2T = (const bf16_t*)(ws + (kv ? WS_CW2V : WS_CW2K));
        __syncthreads();
        for (int i = tid; i < 272 * 8; i += MK_THREADS) { const int tau = i >> 3, cch = i & 7; *(LAS3 u32x4*)(lds + CM_IMG + tau * 128 + (tau >> 4) * 16 + cch * 16) = *(const u32x4*)(src + (size_t)tau * HD + cch * 8); }
        __syncthreads();
        f32x4v acc[2] = {{0.f, 0.f, 0.f, 0.f}, {0.f, 0.f, 0.f, 0.f}};
        const bf16_t* wb0 = W1T + (size_t)(wid * 32 + row) * 2048 + 8 * kg, * wb1 = wb0 + (size_t)16 * 2048;
#pragma unroll 8
        for (int ks = 0; ks < 64; ++ks) {
            const int tau = 16 * row + (ks >> 1);
            const bf16x8v a = *(LAS3 const bf16x8v*)(lds + CM_IMG + tau * 128 + (tau >> 4) * 16 + (32 * (ks & 1) + 8 * kg) * 2);
            const bf16x8v b0 = *(const bf16x8v*)(wb0 + 32 * ks), b1 = *(const bf16x8v*)(wb1 + 32 * ks);
            acc[0] = __builtin_amdgcn_mfma_f32_16x16x32_bf16(a, b0, acc[0], 0, 0, 0);
            acc[1] = __builtin_amdgcn_mfma_f32_16x16x32_bf16(a, b1, acc[1], 0, 0, 0);
        }
#pragma unroll
        for (int nb = 0; nb < 2; ++nb) {
            const int col = wid * 32 + 16 * nb + row; const float bias = cb[col];
#pragma unroll
            for (int i = 0; i < 4; ++i) *(LAS3 bf16_t*)(lds + CM_HID + ((4 * kg + i) * 264 + col) * 2) = f2bf(gelu_tanh(acc[nb][i] + bias));
        }
        __syncthreads();
        if (wid < 4) {
            f32x4v o = {0.f, 0.f, 0.f, 0.f};
#pragma unroll
            for (int ks = 0; ks < 8; ++ks) {
                const bf16x8v a = *(LAS3 const bf16x8v*)(lds + CM_HID + (row * 264 + 32 * ks + 8 * kg) * 2);
                const bf16x8v b = *(const bf16x8v*)(W2T + (size_t)(wid * 16 + row) * 256 + 32 * ks + 8 * kg);
                o = __builtin_amdgcn_mfma_f32_16x16x32_bf16(a, b, o, 0, 0, 0);
            }
            const int d = wid * 16 + row;
#pragma unroll
            for (int i = 0; i < 4; ++i) {
                const int c = c0 + 4 * kg + i; const float v = c < NCMP ? o[i] : 0.f;
                ((float*)(ws + (kv ? WS_VCMP : WS_KCMP)))[((size_t)bh * 256 + c) * 64 + d] = v;
                if (kv) ((bf16_t*)(ws + R_VCT))[((size_t)bh * 64 + d) * 256 + c] = f2bf(v);
                else    ((bf16_t*)(ws + R_KCB))[((size_t)bh * 256 + c) * 64 + d] = f2bf(v);
            }
        }
    }
    __syncthreads();
}
DI void p2_vtranspose(const Params& p, LAS3 unsigned char* lds, int G) {
    unsigned char* ws = p.ws;
    const int tid = threadIdx.x;
    LAS3 bf16_t* tl = (LAS3 bf16_t*)lds;
    for (int u = blockIdx.x; u < 1024; u += G) {
        const int which = u >> 9, bh = (u >> 6) & 7, tt = u & 63;
        const bf16_t* src = (const bf16_t*)(ws + (which ? R_VW : R_VS)) + ((size_t)bh * T_ + tt * 64) * HD;
        bf16_t* dst = (bf16_t*)(ws + (which ? R_VWT : R_VST)) + (size_t)bh * HD * T_ + tt * 64;
        __syncthreads();
        { const int tok = tid >> 3, seg = tid & 7; *(LAS3 u32x4*)(tl + tok * 72 + seg * 8) = *(const u32x4*)(src + (size_t)tok * HD + seg * 8); }
        __syncthreads();
        { const int d = tid >> 3, seg = tid & 7; u32x4 w;
          w.x = (unsigned)tl[(seg * 8 + 0) * 72 + d] | ((unsigned)tl[(seg * 8 + 1) * 72 + d] << 16); w.y = (unsigned)tl[(seg * 8 + 2) * 72 + d] | ((unsigned)tl[(seg * 8 + 3) * 72 + d] << 16);
          w.z = (unsigned)tl[(seg * 8 + 4) * 72 + d] | ((unsigned)tl[(seg * 8 + 5) * 72 + d] << 16); w.w = (unsigned)tl[(seg * 8 + 6) * 72 + d] | ((unsigned)tl[(seg * 8 + 7) * 72 + d] << 16);
          *(u32x4*)(dst + (size_t)d * T_ + seg * 8) = w; }
    }
    __syncthreads();
}
DI int ord_enc(float f) { const int u = __float_as_int(f); return u ^ ((u >> 31) & 0x7fffffff); }
DI float ord_dec(int o) { return __int_as_float(o ^ ((o >> 31) & 0x7fffffff)); }
#define PEER_CE_DESC(a, b) do { const int _hi = max((a), (b)), _lo = min((a), (b)); (a) = _hi; (b) = _lo; } while (0)
#define PEER_CE_ASC(a, b)  do { const int _hi = max((a), (b)), _lo = min((a), (b)); (a) = _lo; (b) = _hi; } while (0)
DI void sort16_desc(int (&x)[16]) {
#pragma unroll
    for (int k = 2; k <= 16; k <<= 1)
#pragma unroll
        for (int j = k >> 1; j > 0; j >>= 1)
#pragma unroll
            for (int i = 0; i < 16; ++i) { const int l = i ^ j; if (l > i) { if ((i & k) == 0) PEER_CE_DESC(x[i], x[l]); else PEER_CE_ASC(x[i], x[l]); } }
}
DI void merge16_desc(int (&a)[16], const int (&b)[16]) {
#pragma unroll
    for (int i = 0; i < 16; ++i) a[i] = max(a[i], b[15 - i]);
#pragma unroll
    for (int j = 8; j > 0; j >>= 1)
#pragma unroll
        for (int i = 0; i < 16; ++i) { const int l = i ^ j; if (l > i) PEER_CE_DESC(a[i], a[l]); }
}
constexpr int PR_KEYS = 0;
constexpr int PR_IDX = 512 * 68 * 4;
constexpr int PR_RS = PR_IDX + 128 * 32 * 4;
constexpr int PR_END = PR_RS + 1024;
static_assert(PR_END <= 160 * 1024 - 256, "PEER LDS map");

struct EpiPeerRoute {
    static constexpr bool PERM = true, AFTER_DRAIN = true;
    const float* ssq1; int* eout; float* gout; float* rs1out;
    DI void fused(const f32x4 (&acc)[2][2][4][2], const pg8::Unit& u, int wr, int wc, int fr, int fq, PG8_LAS unsigned char* lds, int wid, int lane) const {
        const int tid = wid * 64 + lane, head = u.pn;
        LAS3 int* KEYS = (LAS3 int*)(lds + PR_KEYS); LAS3 int* IDX = (LAS3 int*)(lds + PR_IDX); LAS3 float* RS = (LAS3 float*)(lds + PR_RS);
        if (tid < 256) { float s = 0.f; for (int j = 0; j < 16; ++j) s += ssq1[(size_t)j * NTOK + u.pm * 256 + tid]; RS[tid] = rsqrtf(s * (1.0f / DM) + EPS); if (u.pn == 0) rs1out[u.pm * 256 + tid] = RS[tid]; }
#pragma unroll 1
        for (int ai = 0; ai < 2; ++ai) {
            __syncthreads();
#pragma unroll
            for (int bj = 0; bj < 2; ++bj)
#pragma unroll
                for (int m = 0; m < 4; ++m)
#pragma unroll
                    for (int n = 0; n < 2; ++n) {
                        const int rl = 64 * wr + 16 * m + fr, kk0 = 32 * wc + 8 * fq + 4 * n, hl = ((rl * 2 + bj) * 2 + (kk0 >> 6));
                        const f32x4 v = ai == 0 ? acc[0][bj][m][n] : acc[1][bj][m][n];
                        u32x4 kq;
                        kq.x = (unsigned)((ord_enc(v[0]) & ~0x7f) | (127 - (kk0 + 0))); kq.y = (unsigned)((ord_enc(v[1]) & ~0x7f) | (127 - (kk0 + 1)));
                        kq.z = (unsigned)((ord_enc(v[2]) & ~0x7f) | (127 - (kk0 + 2))); kq.w = (unsigned)((ord_enc(v[3]) & ~0x7f) | (127 - (kk0 + 3)));
                        *(LAS3 u32x4*)(KEYS + hl * 68 + (kk0 & 63)) = kq;
                    }
            __syncthreads();
            int top[16];
            {
                LAS3 const int* src = KEYS + tid * 68;
                int t2[16];
#pragma unroll
                for (int q = 0; q < 4; ++q) { const u32x4 w = *(LAS3 const u32x4*)(src + 4 * q); top[4 * q] = (int)w.x; top[4 * q + 1] = (int)w.y; top[4 * q + 2] = (int)w.z; top[4 * q + 3] = (int)w.w; }
                sort16_desc(top);
#pragma unroll 1
                for (int g = 1; g < 4; ++g) {
#pragma unroll
                    for (int q = 0; q < 4; ++q) { const u32x4 w = *(LAS3 const u32x4*)(src + 16 * g + 4 * q); t2[4 * q] = (int)w.x; t2[4 * q + 1] = (int)w.y; t2[4 * q + 2] = (int)w.z; t2[4 * q + 3] = (int)w.w; }
                    sort16_desc(t2);
                    merge16_desc(top, t2);
                }
#pragma unroll
                for (int i = 0; i < 16; ++i) t2[i] = __shfl_xor(top[i], 1);
                merge16_desc(top, t2);
            }
            int s1[16], s2[16];
            {
                const bool isp1 = (lane & 2) != 0;
#pragma unroll
                for (int i = 0; i < 16; ++i) { const int o = __shfl_xor(top[i], 2); s1[i] = isp1 ? o : top[i]; s2[i] = isp1 ? top[i] : o; }
            }
            const int rl = tid >> 2, q4 = tid & 3;
#pragma unroll
            for (int kq = 0; kq < 4; ++kq) if (q4 == kq) {
#pragma unroll
                for (int j = 0; j < 4; ++j) { IDX[rl * 32 + 4 * kq + j] = 127 - (s1[4 * kq + j] & 0x7f); IDX[rl * 32 + 16 + 4 * kq + j] = 127 - (s2[4 * kq + j] & 0x7f); }
            }
            float v1[16], v2[16];
#pragma unroll
            for (int i = 0; i < 16; ++i) { v1[i] = ord_dec(s1[i] & ~0x7f); v2[i] = ord_dec(s2[i] & ~0x7f); }
            int best[16], grp[16];
            {
                int cnt = 0; bool first = true;
#pragma unroll
                for (int a = 0; a < 16; ++a)
#pragma unroll
                    for (int b = 0; b < 16; ++b) if ((a + 1) * (b + 1) <= 16) {
                        grp[cnt & 15] = (ord_enc(v1[a] + v2[b]) & ~0xff) | (255 - (16 * a + b));
                        ++cnt;
                        if ((cnt & 15) == 0) { sort16_desc(grp); if (first) {
#pragma unroll
                                for (int i = 0; i < 16; ++i) best[i] = grp[i];
                                first = false; } else merge16_desc(best, grp); }
                    }
#pragma unroll
                for (int i = 2; i < 16; ++i) grp[i] = (int)0x80000000;
                sort16_desc(grp); merge16_desc(best, grp);
            }
            __syncthreads();
            const float rs1 = RS[128 * ai + rl];
            float gsum = 0.f, gv[16]; int ev[16];
            const float mtop = ord_dec(best[0] & ~0xff) * rs1;
#pragma unroll
            for (int i = 0; i < 16; ++i) {
                const float sc = ord_dec(best[i] & ~0xff) * rs1; gv[i] = __expf(sc - mtop); gsum += gv[i];
                const int ab = 255 - (best[i] & 0xff);
                ev[i] = IDX[rl * 32 + (ab >> 4)] * 128 + IDX[rl * 32 + 16 + (ab & 15)];
            }
            const float ginv = 1.0f / gsum;
            const size_t tok = (size_t)u.pm * 256 + 128 * ai + rl;
#pragma unroll
            for (int kq = 0; kq < 4; ++kq) if (q4 == kq) {
                *(u32x4*)(eout + tok * 128 + head * 16 + 4 * kq) = (u32x4){(unsigned)ev[4 * kq], (unsigned)ev[4 * kq + 1], (unsigned)ev[4 * kq + 2], (unsigned)ev[4 * kq + 3]};
                *(f32x4*)(gout + tok * 128 + head * 16 + 4 * kq) = (f32x4){gv[4 * kq] * ginv, gv[4 * kq + 1] * ginv, gv[4 * kq + 2] * ginv, gv[4 * kq + 3] * ginv};
            }
        }
        __syncthreads();
    }
    DI void operator()(const f32x4 (&)[2][2][4][2], const pg8::Unit&, int, int, int, int) const {}
};
struct SliceOrder : pg8::StaticOrder {
    int slice;
    __device__ bool next(int i, pg8::Unit& u) const { if (i > 0) return false; return pg8::StaticOrder::next(slice, u); }
};
DI void p5_peer_route(const Params& p, LAS3 unsigned char* lds, int G) {
    unsigned char* ws = p.ws;
    pg8::Gemm g{(const bf16_t*)(ws + R_H1B), (const bf16_t*)(ws + WS_WQS), NTOK, 2048, DM};
    EpiPeerRoute E{(const float*)(ws + WS_SSQ1), (int*)(ws + R_EXP), (float*)(ws + R_GSM), (float*)(ws + WS_RS1)};
    const int nslice = (512 + G - 1) / G;
#pragma unroll 1
    for (int s = 0; s < nslice; ++s) {
        SliceOrder S; S.init(NTOK, 2048, G, (int)blockIdx.x); S.slice = s;
        pg8::gemm_phase<EpiPeerRoute, SliceOrder>(lds, g, S, E, nullptr);
        __syncthreads();
    }
}
#if PEER_FP4
constexpr float U8_SCALE = 64.0f, V8_SCALE = 6.0f;
#else
constexpr float U8_SCALE = 32.0f, V8_SCALE = 8.0f;
#endif
constexpr int LDS_MISC_OFF = 160 * 1024 - 256;
DI void fp8x16_to_f32(const u32x4 w, float (&f)[16]) {
#pragma unroll
    for (int q = 0; q < 4; ++q) {
        const f32x2 lo = __builtin_amdgcn_cvt_pk_f32_fp8((int)w[q], false), hi = __builtin_amdgcn_cvt_pk_f32_fp8((int)w[q], true);
        f[4 * q] = lo.x; f[4 * q + 1] = lo.y; f[4 * q + 2] = hi.x; f[4 * q + 3] = hi.y;
    }
}
struct Pu5Fixed { int ev0, ev1; float gv0, gv1; u32x4 xa, xb; float rs1; };
DI void pu5_load_fixed(Pu5Fixed& f, int tok, int lane, const int* eidx, const float* gsm, const bf16_t* hb, const float* rs1v) {
    f.ev0 = eidx[(size_t)tok * 128 + lane]; f.ev1 = eidx[(size_t)tok * 128 + 64 + lane];
    f.gv0 = gsm[(size_t)tok * 128 + lane]; f.gv1 = gsm[(size_t)tok * 128 + 64 + lane];
    f.xa = *(const u32x4*)(hb + (size_t)tok * DM + lane * 16); f.xb = *(const u32x4*)(hb + (size_t)tok * DM + lane * 16 + 8);
    f.rs1 = rs1v[tok];
}
DI int pu5_setup(const Pu5Fixed& f, int sel, int lane, LAS3 unsigned* ent) {
    const bool s0 = (f.ev0 & 15) == sel, s1 = (f.ev1 & 15) == sel;
    const unsigned long long b0 = __ballot(s0), b1 = __ballot(s1);
    const int c0 = __builtin_popcountll(b0), cnt = c0 + __builtin_popcountll(b1);
    const unsigned long long lt = (1ull << lane) - 1ull;
    const int r0 = __builtin_popcountll(b0 & lt), r1 = c0 + __builtin_popcountll(b1 & lt);
    if (s0) { ent[r0] = (unsigned)f.ev0 | ((unsigned)lane << 16); ent[128 + r0] = __float_as_uint(f.gv0); }
    if (s1) { ent[r1] = (unsigned)f.ev1 | ((unsigned)(64 + lane) << 16); ent[128 + r1] = __float_as_uint(f.gv1); }
    return cnt;
}
#define PU5_ISSUE(SET, ENT, CNT) do { \
        _Pragma("unroll") for (int q = 0; q < 4; ++q) { const u32x4 e4 = *(LAS3 const u32x4*)((ENT) + 4 * q); \
            _Pragma("unroll") for (int k2 = 0; k2 < 4; ++k2) { const int k = 4 * q + k2; \
                const unsigned off = k < (CNT) ? ((e4[k2] & 0x3fffu) * (unsigned)DM) + lane * 16 : 0x80000000u; \
                SET[k] = __builtin_amdgcn_raw_buffer_load_b128(urs, off, 0, 0); } } } while (0)
#define PU5_CONSUME(SET, ENT, CNT, TOK, RS) do { \
        float part[16]; \
        _Pragma("unroll") for (int k = 0; k < 16; ++k) { float a = 0.f; \
            if (k < (CNT)) { f32x2 a2 = {0.f, 0.f}; \
                _Pragma("unroll") for (int q = 0; q < 4; ++q) { \
                    a2 = __builtin_elementwise_fma(__builtin_amdgcn_cvt_pk_f32_fp8((int)SET[k][q], false), xp[2 * q], a2); \
                    a2 = __builtin_elementwise_fma(__builtin_amdgcn_cvt_pk_f32_fp8((int)SET[k][q], true), xp[2 * q + 1], a2); } \
                a = a2.x + a2.y; } \
            part[k] = a; } \
        _Pragma("unroll") for (int m = 8; m >= 1; m >>= 1) { const bool up = (lane & (4 * m)) != 0; \
            _Pragma("unroll") for (int i = 0; i < m; ++i) { const float send = up ? part[i] : part[i + m], keep = up ? part[i + m] : part[i]; part[i] = keep + __shfl_xor(send, 4 * m); } } \
        float tot = part[0]; tot += __shfl_xor(tot, 2); tot += __shfl_xor(tot, 1); \
        const int kk = lane >> 2; const unsigned ew = (ENT)[kk]; const float gw = __uint_as_float((ENT)[128 + kk]); \
        if ((lane & 3) == 0 && kk < (CNT)) coef[(size_t)(TOK) * 128 + (ew >> 16)] = gw * (1.0f / V8_SCALE) * gelu_tanh(tot * ((RS) * (1.0f / U8_SCALE))); \
        if ((CNT) > 16) {   \
            for (int base = 16; base < (CNT); base += 16) { u32x4 rx[16]; \
                _Pragma("unroll") for (int k = 0; k < 16; ++k) { const unsigned e1 = (ENT)[base + k]; \
                    rx[k] = __builtin_amdgcn_raw_buffer_load_b128(urs, base + k < (CNT) ? ((e1 & 0x3fffu) * (unsigned)DM) + lane * 16 : 0x80000000u, 0, 0); } \
                float pr[16]; \
                _Pragma("unroll") for (int k = 0; k < 16; ++k) { f32x2 a2 = {0.f, 0.f}; \
                    _Pragma("unroll") for (int q = 0; q < 4; ++q) { \
                        a2 = __builtin_elementwise_fma(__builtin_amdgcn_cvt_pk_f32_fp8((int)rx[k][q], false), xp[2 * q], a2); \
                        a2 = __builtin_elementwise_fma(__builtin_amdgcn_cvt_pk_f32_fp8((int)rx[k][q], true), xp[2 * q + 1], a2); } \
                    pr[k] = a2.x + a2.y; } \
                _Pragma("unroll") for (int m = 8; m >= 1; m >>= 1) { const bool up = (lane & (4 * m)) != 0; \
                    _Pragma("unroll") for (int i = 0; i < m; ++i) { const float send = up ? pr[i] : pr[i + m], keep = up ? pr[i + m] : pr[i]; pr[i] = keep + __shfl_xor(send, 4 * m); } } \
                float t2 = pr[0]; t2 += __shfl_xor(t2, 2); t2 += __shfl_xor(t2, 1); \
                const int k3 = base + (lane >> 2); const unsigned ew2 = (ENT)[k3 & 127]; const float gw2 = __uint_as_float((ENT)[128 + (k3 & 127)]); \
                if ((lane & 3) == 0 && k3 < (CNT)) coef[(size_t)(TOK) * 128 + (ew2 >> 16)] = gw2 * (1.0f / V8_SCALE) * gelu_tanh(t2 * ((RS) * (1.0f / U8_SCALE))); } } } while (0)
#define PU5_UNPACK(F) do { _Pragma("unroll") for (int q = 0; q < 4; ++q) { xp[q] = (f32x2){bflo((F).xa[q]), bfhi((F).xa[q])}; xp[4 + q] = (f32x2){bflo((F).xb[q]), bfhi((F).xb[q])}; } } while (0)
DI void p6v5_u(const Params& p, LAS3 unsigned char* lds, int G) {
    unsigned char* ws = p.ws;
    const int tid = threadIdx.x, lane = tid & 63, wid = tid >> 6, grp = blockIdx.x & 7, rank = blockIdx.x >> 3;
    const int nrank = (G - grp + 7) >> 3, wv = rank * 8 + wid, nwv = nrank * 8;
    const unsigned char* u8 = (const unsigned char*)(ws + WS_UB); const bf16_t* hb = (const bf16_t*)(ws + R_H1B);
    const int* eidx = (const int*)(ws + R_EXP); const float* gsm = (const float*)(ws + R_GSM); const float* rs1v = (const float*)(ws + WS_RS1);
    float* coef = (float*)(ws + R_COEF);
    LAS3 unsigned* entA = (LAS3 unsigned*)(lds + wid * 2048); LAS3 unsigned* entB = entA + 256;
    if (wv >= NTOK) return;
    const __amdgpu_buffer_rsrc_t urs = __builtin_amdgcn_make_buffer_rsrc((void*)u8, 0, 16384 * DM, 0x00020000);
    const int nvis = (NTOK - wv + nwv - 1) / nwv, NV = 2 * nvis;
#define PU5_TOK(V) (wv + (((V) < NV ? (V) : NV - 1) % nvis) * nwv)
#define PU5_SEL(V) (grp + 8 * (((V) < NV ? (V) : NV - 1) / nvis))
    Pu5Fixed f1, f2;
    pu5_load_fixed(f1, PU5_TOK(0), lane, eidx, gsm, hb, rs1v);
    u32x4 sa[16], sb[16];
    f32x2 xp[8];
    int cntA = pu5_setup(f1, PU5_SEL(0), lane, entA), cntB = 0;
    PU5_ISSUE(sa, entA, cntA);
    int tokA = PU5_TOK(0), tokB = 0; float rsA = f1.rs1, rsB = 0.f;
    PU5_UNPACK(f1);
    pu5_load_fixed(f1, PU5_TOK(1), lane, eidx, gsm, hb, rs1v);
#pragma unroll 1
    for (int v = 0; v < NV; v += 2) {
        pu5_load_fixed(f2, PU5_TOK(v + 2), lane, eidx, gsm, hb, rs1v);
        cntB = pu5_setup(f1, PU5_SEL(v + 1), lane, entB); if (v + 1 >= NV) cntB = 0;
        PU5_ISSUE(sb, entB, cntB);
        tokB = PU5_TOK(v + 1); rsB = f1.rs1;
        PU5_CONSUME(sa, entA, cntA, tokA, rsA);
        PU5_UNPACK(f1);
        f1 = f2;
        pu5_load_fixed(f2, PU5_TOK(v + 3), lane, eidx, gsm, hb, rs1v);
        cntA = pu5_setup(f1, PU5_SEL(v + 2), lane, entA); if (v + 2 >= NV) cntA = 0;
        PU5_ISSUE(sa, entA, cntA);
        tokA = PU5_TOK(v + 2); rsA = f1.rs1;
        PU5_CONSUME(sb, entB, cntB, tokB, rsB);
        PU5_UNPACK(f1);
        f1 = f2;
    }
#undef PU5_TOK
#undef PU5_SEL
}
#undef PU5_ISSUE
#undef PU5_CONSUME
#undef PU5_UNPACK
template <int PMODE> DI void p6v3_v(const Params& p, int G) {
    unsigned char* ws = p.ws;
    const int tid = threadIdx.x, lane = tid & 63, wid = tid >> 6;
#if XCC_HW
    volatile LAS3 unsigned* miscw = (volatile LAS3 unsigned*)((LAS3 unsigned char*)0 + LDS_MISC_OFF);
    const int grp = (int)miscw[16], rank = (int)miscw[17];
    const int nrank = (int)__hip_atomic_load((unsigned*)(ws + WS_CTL + 16384) + grp * 16, __ATOMIC_RELAXED, __HIP_MEMORY_SCOPE_AGENT);
#else
    const int grp = blockIdx.x & 7, rank = blockIdx.x >> 3;
    const int nrank = (G - grp + 7) >> 3;
#endif
    const int wv = rank * 8 + wid, nwv = nrank * 8;
    const unsigned char* v8 = (const unsigned char*)(ws + WS_VB);
    const int* eidx = (const int*)(ws + R_EXP); const float* coef = (const float*)(ws + R_COEF);
    float* h = PMODE == 0 ? p.out : (float*)(ws + R_BIG); bf16_t* hb = PMODE == 0 ? (bf16_t*)(ws + R_H1B) : (bf16_t*)(ws + WS_XB); float* ssq2 = PMODE == 0 ? (float*)(ws + WS_SSQ2) : (float*)(ws + WS_SSQ3);
    const int sub = lane >> 3, col0 = grp * 128 + (lane & 7) * 16;
    if (wv >= NTOK) return;
    const int nvis = (NTOK - wv + nwv - 1) / nwv;
#define PV_LOADIDX(T, EV0, EV1, CV0, CV1) do { EV0 = eidx[(size_t)(T) * 128 + lane]; EV1 = eidx[(size_t)(T) * 128 + 64 + lane]; CV0 = coef[(size_t)(T) * 128 + lane]; CV1 = coef[(size_t)(T) * 128 + 64 + lane]; } while (0)
#define PV_ISSUE8(R, EV) do { _Pragma("unroll") for (int i = 0; i < 8; ++i) { const int e = __shfl((EV), 8 * i + sub); R[i] = *(const u32x4*)(v8 + (unsigned)(e * DM + col0)); } } while (0)
#define PV_CONS8(R, CV) do { _Pragma("unroll") for (int i = 0; i < 8; ++i) { float f[16]; fp8x16_to_f32(R[i], f); const float c = __shfl((CV), 8 * i + sub); \
            _Pragma("unroll") for (int q = 0; q < 16; ++q) acc[q] += c * f[q]; } } while (0)
    u32x4 ra[8], rb[8];
    int e0, e1, n0, n1, x0, x1; float c0, c1, d0, d1, y0, y1;
    PV_LOADIDX(wv, e0, e1, c0, c1);
    { const int t1 = nvis > 1 ? wv + nwv : wv; PV_LOADIDX(t1, n0, n1, d0, d1); }
    PV_ISSUE8(ra, e0); PV_ISSUE8(rb, e1);
#pragma unroll 1
    for (int it = 0; it < nvis; ++it) {
        const int tok = wv + it * nwv;
        const int t2 = wv + (it + 2 < nvis ? it + 2 : nvis - 1) * nwv;
        float* hr = h + (size_t)tok * DM + col0;
        const f32x4 hv0 = *(const f32x4*)hr, hv1 = *(const f32x4*)(hr + 4), hv2 = *(const f32x4*)(hr + 8), hv3 = *(const f32x4*)(hr + 12);
        PV_LOADIDX(t2, x0, x1, y0, y1);
        float acc[16];
#pragma unroll
        for (int q = 0; q < 16; ++q) acc[q] = 0.f;
        PV_CONS8(ra, c0);
        PV_ISSUE8(ra, n0);
        PV_CONS8(rb, c1);
        PV_ISSUE8(rb, n1);
#pragma unroll
        for (int q = 0; q < 16; ++q) { acc[q] += __shfl_xor(acc[q], 8); acc[q] += __shfl_xor(acc[q], 16); acc[q] += __shfl_xor(acc[q], 32); }
        float ss = 0.f;
        if (lane < 8) {
            const f32x4 o0 = hv0 + (f32x4){acc[0], acc[1], acc[2], acc[3]}, o1 = hv1 + (f32x4){acc[4], acc[5], acc[6], acc[7]};
            const f32x4 o2 = hv2 + (f32x4){acc[8], acc[9], acc[10], acc[11]}, o3 = hv3 + (f32x4){acc[12], acc[13], acc[14], acc[15]};
            *(f32x4*)hr = o0; *(f32x4*)(hr + 4) = o1; *(f32x4*)(hr + 8) = o2; *(f32x4*)(hr + 12) = o3;
            u32x4 w0, w1;
            w0.x = pk_bf16(o0[0], o0[1]); w0.y = pk_bf16(o0[2], o0[3]); w0.z = pk_bf16(o1[0], o1[1]); w0.w = pk_bf16(o1[2], o1[3]);
            w1.x = pk_bf16(o2[0], o2[1]); w1.y = pk_bf16(o2[2], o2[3]); w1.z = pk_bf16(o3[0], o3[1]); w1.w = pk_bf16(o3[2], o3[3]);
            *(u32x4*)(hb + (size_t)tok * DM + col0) = w0; *(u32x4*)(hb + (size_t)tok * DM + col0 + 8) = w1;
#pragma unroll
            for (int j = 0; j < 4; ++j) ss += o0[j] * o0[j] + o1[j] * o1[j] + o2[j] * o2[j] + o3[j] * o3[j];
        }
        ss += __shfl_xor(ss, 1); ss += __shfl_xor(ss, 2); ss += __shfl_xor(ss, 4);
        if (lane == 0) ssq2[(size_t)grp * NTOK + tok] = ss;
        e0 = n0; e1 = n1; c0 = d0; c1 = d1; n0 = x0; n1 = x1; d0 = y0; d1 = y1;
    }
#undef PV_LOADIDX
#undef PV_ISSUE8
#undef PV_CONS8
}
DI void p6v6_peer(const Params& p, int G) {
    unsigned char* ws = p.ws;
    const int tid = threadIdx.x, lane = tid & 63, wid = tid >> 6;
    const int gw = blockIdx.x * 8 + wid, nw = G * 8;
    const unsigned char* u8 = (const unsigned char*)(ws + WS_UB); const unsigned char* v8 = (const unsigned char*)(ws + WS_VB);
    const int* eidx = (const int*)(ws + R_EXP); const float* gsm = (const float*)(ws + R_GSM); const float* rs1v = (const float*)(ws + WS_RS1);
    float* h = p.out; bf16_t* hb = (bf16_t*)(ws + R_H1B); float* rs2 = (float*)(ws + WS_RS2);
#pragma unroll 1
    for (int tok = gw; tok < NTOK; tok += nw) {
        const float rs1 = rs1v[tok] * (1.0f / U8_SCALE);
        const u32x4 xa = *(const u32x4*)(hb + (size_t)tok * DM + lane * 16), xb = *(const u32x4*)(hb + (size_t)tok * DM + lane * 16 + 8);
        f32x2 xp[8];
#pragma unroll
        for (int q = 0; q < 4; ++q) { xp[q] = (f32x2){bflo(xa[q]), bfhi(xa[q])}; xp[4 + q] = (f32x2){bflo(xb[q]), bfhi(xb[q])}; }
        const int e0 = eidx[(size_t)tok * 128 + lane], e1 = eidx[(size_t)tok * 128 + 64 + lane];
        const float g0 = gsm[(size_t)tok * 128 + lane], g1 = gsm[(size_t)tok * 128 + 64 + lane];
        float coef0 = 0.f, coef1 = 0.f;
#pragma unroll
        for (int half = 0; half < 2; ++half) {
            const int ev = half ? e1 : e0;
            float part[64];
#pragma unroll
            for (int j = 0; j < 64; ++j) {
                const int e = __builtin_amdgcn_readlane(ev, j);
                const u32x4 w = *(const u32x4*)(u8 + (size_t)e * DM + lane * 16);
                f32x2 a2 = {0.f, 0.f};
#pragma unroll
                for (int q = 0; q < 4; ++q) {
                    a2 = __builtin_elementwise_fma(__builtin_amdgcn_cvt_pk_f32_fp8((int)w[q], false), xp[2 * q], a2);
                    a2 = __builtin_elementwise_fma(__builtin_amdgcn_cvt_pk_f32_fp8((int)w[q], true), xp[2 * q + 1], a2);
                }
                part[j] = a2.x + a2.y;
            }
#pragma unroll
            for (int m = 32; m >= 1; m >>= 1) {
                const bool up = (lane & m) != 0;
#pragma unroll
                for (int i = 0; i < m; ++i) { const float send = up ? part[i] : part[i + m], keep = up ? part[i + m] : part[i]; part[i] = keep + __shfl_xor(send, m); }
            }
            const float act = gelu_tanh(part[0] * rs1);
            if (half) coef1 = g1 * act * (1.0f / V8_SCALE); else coef0 = g0 * act * (1.0f / V8_SCALE);
        }
        f32x2 acc[8];
#pragma unroll
        for (int i = 0; i < 8; ++i) acc[i] = (f32x2){0.f, 0.f};
#pragma unroll
        for (int half = 0; half < 2; ++half) {
            const int ev = half ? e1 : e0; const float cv = half ? coef1 : coef0;
#pragma unroll 16
            for (int j = 0; j < 64; ++j) {
                const int e = __builtin_amdgcn_readlane(ev, j);
                const float c = __uint_as_float(__builtin_amdgcn_readlane(__float_as_uint(cv), j));
                const u32x4 w = *(const u32x4*)(v8 + (size_t)e * DM + lane * 16);
                const f32x2 c2 = {c, c};
#pragma unroll
                for (int q = 0; q < 4; ++q) {
                    acc[2 * q] = __builtin_elementwise_fma(__builtin_amdgcn_cvt_pk_f32_fp8((int)w[q], false), c2, acc[2 * q]);
                    acc[2 * q + 1] = __builtin_elementwise_fma(__builtin_amdgcn_cvt_pk_f32_fp8((int)w[q], true), c2, acc[2 * q + 1]);
                }
            }
        }
        float* hr = h + (size_t)tok * DM + lane * 16;
        u32x4 w0, w1; float ss = 0.f;
#pragma unroll
        for (int q4 = 0; q4 < 4; ++q4) {
            f32x4 hv = *(f32x4*)(hr + 4 * q4);
            hv += (f32x4){acc[2 * q4].x, acc[2 * q4].y, acc[2 * q4 + 1].x, acc[2 * q4 + 1].y};
            *(f32x4*)(hr + 4 * q4) = hv;
            ss += (hv[0] * hv[0] + hv[1] * hv[1]) + (hv[2] * hv[2] + hv[3] * hv[3]);
            const unsigned a_ = pk_bf16(hv[0], hv[1]), b_ = pk_bf16(hv[2], hv[3]);
            if (q4 == 0) { w0.x = a_; w0.y = b_; } else if (q4 == 1) { w0.z = a_; w0.w = b_; } else if (q4 == 2) { w1.x = a_; w1.y = b_; } else { w1.z = a_; w1.w = b_; }
        }
        *(u32x4*)(hb + (size_t)tok * DM + lane * 16) = w0; *(u32x4*)(hb + (size_t)tok * DM + lane * 16 + 8) = w1;
        ss = wave_sum(ss);
        if (lane == 0) rs2[tok] = rsqrtf(ss * (1.0f / DM) + EPS);
    }
}
DI void p6v6_u(const Params& p, int G) {
    unsigned char* ws = p.ws;
    const int tid = threadIdx.x, lane = tid & 63, wid = tid >> 6;
    const int gw = blockIdx.x * 8 + wid, nw = G * 8;
    const unsigned char* u8 = (const unsigned char*)(ws + WS_UB); const unsigned char* v8 = (const unsigned char*)(ws + WS_VB);
    const int* eidx = (const int*)(ws + R_EXP); const float* gsm = (const float*)(ws + R_GSM); const float* rs1v = (const float*)(ws + WS_RS1);
    float* h = p.out; bf16_t* hb = (bf16_t*)(ws + R_H1B); float* rs2 = (float*)(ws + WS_RS2);
#pragma unroll 1
    for (int tok = gw; tok < NTOK; tok += nw) {
        const float rs1 = rs1v[tok] * (1.0f / U8_SCALE);
        const u32x4 xa = *(const u32x4*)(hb + (size_t)tok * DM + lane * 16), xb = *(const u32x4*)(hb + (size_t)tok * DM + lane * 16 + 8);
        f32x2 xp[8];
#pragma unroll
        for (int q = 0; q < 4; ++q) { xp[q] = (f32x2){bflo(xa[q]), bfhi(xa[q])}; xp[4 + q] = (f32x2){bflo(xb[q]), bfhi(xb[q])}; }
        const int e0 = eidx[(size_t)tok * 128 + lane], e1 = eidx[(size_t)tok * 128 + 64 + lane];
        const float g0 = gsm[(size_t)tok * 128 + lane], g1 = gsm[(size_t)tok * 128 + 64 + lane];
        float coef0 = 0.f, coef1 = 0.f;
#pragma unroll
        for (int half = 0; half < 2; ++half) {
            const int ev = half ? e1 : e0;
            float part[64];
#pragma unroll
            for (int j = 0; j < 64; ++j) {
                const int e = __builtin_amdgcn_readlane(ev, j);
                const u32x4 w = *(const u32x4*)(u8 + (size_t)e * DM + lane * 16);
                f32x2 a2 = {0.f, 0.f};
#pragma unroll
                for (int q = 0; q < 4; ++q) {
                    a2 = __builtin_elementwise_fma(__builtin_amdgcn_cvt_pk_f32_fp8((int)w[q], false), xp[2 * q], a2);
                    a2 = __builtin_elementwise_fma(__builtin_amdgcn_cvt_pk_f32_fp8((int)w[q], true), xp[2 * q + 1], a2);
                }
                part[j] = a2.x + a2.y;
            }
#pragma unroll
            for (int m = 32; m >= 1; m >>= 1) {
                const bool up = (lane & m) != 0;
#pragma unroll
                for (int i = 0; i < m; ++i) { const float send = up ? part[i] : part[i + m], keep = up ? part[i + m] : part[i]; part[i] = keep + __shfl_xor(send, m); }
            }
            const float act = gelu_tanh(part[0] * rs1);
            if (half) coef1 = g1 * act * (1.0f / V8_SCALE); else coef0 = g0 * act * (1.0f / V8_SCALE);
        }
        float* coef = (float*)(ws + R_COEF);
        coef[(size_t)tok * 128 + lane] = coef0; coef[(size_t)tok * 128 + 64 + lane] = coef1;
    }
}
DI void p6v6_v(const Params& p, int G) {
    unsigned char* ws = p.ws;
    const int tid = threadIdx.x, lane = tid & 63, wid = tid >> 6;
    const int gw = blockIdx.x * 8 + wid, nw = G * 8;
    const unsigned char* v8 = (const unsigned char*)(ws + WS_VB);
    const int* eidx = (const int*)(ws + R_EXP); const float* coef = (const float*)(ws + R_COEF);
    float* h = p.out; bf16_t* hb = (bf16_t*)(ws + R_H1B); float* rs2 = (float*)(ws + WS_RS2);
#pragma unroll 1
    for (int tok = gw; tok < NTOK; tok += nw) {
        const int e0 = eidx[(size_t)tok * 128 + lane], e1 = eidx[(size_t)tok * 128 + 64 + lane];
        const float coef0 = coef[(size_t)tok * 128 + lane], coef1 = coef[(size_t)tok * 128 + 64 + lane];
        f32x2 acc[8];
#pragma unroll
        for (int i = 0; i < 8; ++i) acc[i] = (f32x2){0.f, 0.f};
#pragma unroll
        for (int half = 0; half < 2; ++half) {
            const int ev = half ? e1 : e0; const float cv = half ? coef1 : coef0;
#pragma unroll 16
            for (int j = 0; j < 64; ++j) {
                const int e = __builtin_amdgcn_readlane(ev, j);
                const float c = __uint_as_float(__builtin_amdgcn_readlane(__float_as_uint(cv), j));
                const u32x4 w = *(const u32x4*)(v8 + (size_t)e * DM + lane * 16);
                const f32x2 c2 = {c, c};
#pragma unroll
                for (int q = 0; q < 4; ++q) {
                    acc[2 * q] = __builtin_elementwise_fma(__builtin_amdgcn_cvt_pk_f32_fp8((int)w[q], false), c2, acc[2 * q]);
                    acc[2 * q + 1] = __builtin_elementwise_fma(__builtin_amdgcn_cvt_pk_f32_fp8((int)w[q], true), c2, acc[2 * q + 1]);
                }
            }
        }
        float* hr = h + (size_t)tok * DM + lane * 16;
        u32x4 w0, w1; float ss = 0.f;
#pragma unroll
        for (int q4 = 0; q4 < 4; ++q4) {
            f32x4 hv = *(f32x4*)(hr + 4 * q4);
            hv += (f32x4){acc[2 * q4].x, acc[2 * q4].y, acc[2 * q4 + 1].x, acc[2 * q4 + 1].y};
            *(f32x4*)(hr + 4 * q4) = hv;
            ss += (hv[0] * hv[0] + hv[1] * hv[1]) + (hv[2] * hv[2] + hv[3] * hv[3]);
            const unsigned a_ = pk_bf16(hv[0], hv[1]), b_ = pk_bf16(hv[2], hv[3]);
            if (q4 == 0) { w0.x = a_; w0.y = b_; } else if (q4 == 1) { w0.z = a_; w0.w = b_; } else if (q4 == 2) { w1.x = a_; w1.y = b_; } else { w1.z = a_; w1.w = b_; }
        }
        *(u32x4*)(hb + (size_t)tok * DM + lane * 16) = w0; *(u32x4*)(hb + (size_t)tok * DM + lane * 16 + 8) = w1;
        ss = wave_sum(ss);
        if (lane == 0) rs2[tok] = rsqrtf(ss * (1.0f / DM) + EPS);
    }
}
DI void p6u_cols(const Params& p, int G) {
    unsigned char* ws = p.ws;
    const int tid = threadIdx.x, lane = tid & 63, wid = tid >> 6, grp = blockIdx.x & 7, rank = blockIdx.x >> 3;
    const int nrank = (G - grp + 7) >> 3, wv = rank * 8 + wid, nwv = nrank * 8;
    const unsigned char* u8 = (const unsigned char*)(ws + WS_UB); const bf16_t* hb = (const bf16_t*)(ws + R_H1B);
    const int* eidx = (const int*)(ws + R_EXP);
    float* part = (float*)(ws + R_BIG) + (size_t)grp * NTOK * 128;
    const int sub = lane >> 3, col0 = grp * 128 + (lane & 7) * 16;
    if (wv >= NTOK) return;
    const int nvis = (NTOK - wv + nwv - 1) / nwv;
#define PC_LOADIDX(T, EV0, EV1, XA, XB) do { EV0 = eidx[(size_t)(T) * 128 + lane]; EV1 = eidx[(size_t)(T) * 128 + 64 + lane]; \
        XA = *(const u32x4*)(hb + (size_t)(T) * DM + col0); XB = *(const u32x4*)(hb + (size_t)(T) * DM + col0 + 8); } while (0)
#define PC_ISSUE8(R, EV) do { _Pragma("unroll") for (int i = 0; i < 8; ++i) { const int e = __shfl((EV), 8 * i + sub); R[i] = *(const u32x4*)(u8 + (unsigned)(e * DM + col0)); } } while (0)
#define PC_CONS8(R, P0) do { _Pragma("unroll") for (int i = 0; i < 8; ++i) { f32x2 a2 = {0.f, 0.f}; \
            _Pragma("unroll") for (int q = 0; q < 4; ++q) { \
                a2 = __builtin_elementwise_fma(__builtin_amdgcn_cvt_pk_f32_fp8((int)R[i][q], false), xp[2 * q], a2); \
                a2 = __builtin_elementwise_fma(__builtin_amdgcn_cvt_pk_f32_fp8((int)R[i][q], true), xp[2 * q + 1], a2); } \
            pd[(P0) + i] = a2.x + a2.y; __builtin_amdgcn_sched_barrier(0); } } while (0)
    u32x4 ra[8], rb[8];
    int e0, e1, n0, n1, x0, x1; u32x4 xa0, xb0, xa1, xb1, xa2, xb2;
    PC_LOADIDX(wv, e0, e1, xa0, xb0);
    { const int t1 = nvis > 1 ? wv + nwv : wv; PC_LOADIDX(t1, n0, n1, xa1, xb1); }
    PC_ISSUE8(ra, e0); PC_ISSUE8(rb, e1);
#pragma unroll 1
    for (int it = 0; it < nvis; ++it) {
        const int tok = wv + it * nwv;
        const int t2 = wv + (it + 2 < nvis ? it + 2 : nvis - 1) * nwv;
        PC_LOADIDX(t2, x0, x1, xa2, xb2);
        f32x2 xp[8];
#pragma unroll
        for (int q = 0; q < 4; ++q) { xp[q] = (f32x2){bflo(xa0[q]), bfhi(xa0[q])}; xp[4 + q] = (f32x2){bflo(xb0[q]), bfhi(xb0[q])}; }
        float pd[16];
        PC_CONS8(ra, 0);
        PC_ISSUE8(ra, n0);
        PC_CONS8(rb, 8);
        PC_ISSUE8(rb, n1);
#define PC_RS(M, LB) do { const bool up = (lane & (LB)) != 0; _Pragma("unroll") for (int i = 0; i < (M); ++i) { \
            const float send = up ? pd[i] : pd[i + (M)], keep = up ? pd[i + (M)] : pd[i]; pd[i] = keep + __shfl_xor(send, (LB)); } } while (0)
        PC_RS(8, 4); PC_RS(4, 2); PC_RS(2, 1);
#undef PC_RS
        const int i0 = 8 * ((lane >> 2) & 1) + 4 * ((lane >> 1) & 1) + 2 * (lane & 1);
        *(f32x2*)(part + (size_t)tok * 128 + sub * 16 + i0) = (f32x2){pd[0], pd[1]};
        e0 = n0; e1 = n1; xa0 = xa1; xb0 = xb1; n0 = x0; n1 = x1; xa1 = xa2; xb1 = xb2;
    }
#undef PC_LOADIDX
#undef PC_ISSUE8
#undef PC_CONS8
}
DI void p6u_combine(const Params& p, int G) {
    unsigned char* ws = p.ws;
    const float* part = (const float*)(ws + R_BIG); const float* gsm = (const float*)(ws + R_GSM); const float* rs1v = (const float*)(ws + WS_RS1);
    float* coef = (float*)(ws + R_COEF);
    const size_t n = (size_t)NTOK * 128, nthr = (size_t)G * MK_THREADS;
    for (size_t idx = (size_t)blockIdx.x * MK_THREADS + threadIdx.x; idx < n; idx += nthr) {
        const size_t tok = idx >> 7; const int j = (int)(idx & 127), pos = (j & 7) * 16 + (j >> 3);
        float s = 0.f;
#pragma unroll
        for (int sl = 0; sl < 8; ++sl) s += part[(size_t)sl * NTOK * 128 + tok * 128 + pos];
        coef[idx] = gsm[idx] * (1.0f / V8_SCALE) * gelu_tanh(s * (rs1v[tok] * (1.0f / U8_SCALE)));
    }
}

#if PEER_FP4
DI void fp4x16_dot(const u32x2 w, const f32x2 (&xp)[8], f32x2& a2) {
#define F4D(Q, B) a2 = __builtin_elementwise_fma(__builtin_amdgcn_cvt_scalef32_pk_f32_fp4(w[Q], 1.0f, B), xp[4 * (Q) + (B)], a2)
    F4D(0, 0); F4D(0, 1); F4D(0, 2); F4D(0, 3); F4D(1, 0); F4D(1, 1); F4D(1, 2); F4D(1, 3);
#undef F4D
}
DI void p6f4_u(const Params& p, int G) {
    unsigned char* ws = p.ws;
    const int tid = threadIdx.x, lane = tid & 63, wid = tid >> 6;
    const int gw = blockIdx.x * 8 + wid, nw = G * 8;
    const unsigned char* u4 = (const unsigned char*)(ws + WS_UB);
    const int* eidx = (const int*)(ws + R_EXP); const float* gsm = (const float*)(ws + R_GSM); const float* rs1v = (const float*)(ws + WS_RS1);
    bf16_t* hb = (bf16_t*)(ws + R_H1B); float* coef = (float*)(ws + R_COEF);
#pragma unroll 1
    for (int tok = gw; tok < NTOK; tok += nw) {
        const float rs1 = rs1v[tok] * (1.0f / U8_SCALE);
        const u32x4 xa = *(const u32x4*)(hb + (size_t)tok * DM + lane * 16), xb = *(const u32x4*)(hb + (size_t)tok * DM + lane * 16 + 8);
        f32x2 xp[8];
#pragma unroll
        for (int q = 0; q < 4; ++q) { xp[q] = (f32x2){bflo(xa[q]), bfhi(xa[q])}; xp[4 + q] = (f32x2){bflo(xb[q]), bfhi(xb[q])}; }
        const int e0 = eidx[(size_t)tok * 128 + lane], e1 = eidx[(size_t)tok * 128 + 64 + lane];
        const float g0 = gsm[(size_t)tok * 128 + lane], g1 = gsm[(size_t)tok * 128 + 64 + lane];
#pragma unroll
        for (int half = 0; half < 2; ++half) {
            const int ev = half ? e1 : e0;
            float part[64];
#pragma unroll
            for (int j = 0; j < 64; ++j) {
                const int e = __builtin_amdgcn_readlane(ev, j);
                const u32x2 w = *(const u32x2*)(u4 + (size_t)e * (DM / 2) + lane * 8);
                f32x2 a2 = {0.f, 0.f};
                fp4x16_dot(w, xp, a2);
                part[j] = a2.x + a2.y;
            }
#define F4_RS(M) do { const bool up = (lane & (M)) != 0; _Pragma("unroll") for (int i = 0; i < (M); ++i) { \
                const float send = up ? part[i] : part[i + (M)], keep = up ? part[i + (M)] : part[i]; part[i] = keep + __shfl_xor(send, (M)); } } while (0)
            F4_RS(32); F4_RS(16); F4_RS(8); F4_RS(4); F4_RS(2); F4_RS(1);
#undef F4_RS
            const float act = gelu_tanh(part[0] * rs1);
            coef[(size_t)tok * 128 + half * 64 + lane] = (half ? g1 : g0) * act * (1.0f / V8_SCALE);
        }
    }
}
template <int PMODE> DI void p6f4_v(const Params& p, int G) {
    unsigned char* ws = p.ws;
    const int tid = threadIdx.x, lane = tid & 63, wid = tid >> 6;
    const int grp = blockIdx.x & 7, rank = blockIdx.x >> 3;
    const int nrank = (G - grp + 7) >> 3;
    const int wv = rank * 8 + wid, nwv = nrank * 8;
    const unsigned char* v4 = (const unsigned char*)(ws + WS_VB);
    const int* eidx = (const int*)(ws + R_EXP); const float* coef = (const float*)(ws + R_COEF);
    float* h = p.out; bf16_t* hb = (bf16_t*)(ws + R_H1B); float* ssq2 = (float*)(ws + WS_SSQ2);
    const int sub = lane >> 3, col0 = grp * 128 + (lane & 7) * 16;
    if (wv >= NTOK) return;
    const int nvis = (NTOK - wv + nwv - 1) / nwv;
#define PV_LOADIDX(T, EV0, EV1, CV0, CV1) do { EV0 = eidx[(size_t)(T) * 128 + lane]; EV1 = eidx[(size_t)(T) * 128 + 64 + lane]; CV0 = coef[(size_t)(T) * 128 + lane]; CV1 = coef[(size_t)(T) * 128 + 64 + lane]; } while (0)
#define PV_ISSUE8(R, EV) do { _Pragma("unroll") for (int i = 0; i < 8; ++i) { const int e = __shfl((EV), 8 * i + sub); R[i] = *(const u32x2*)(v4 + (unsigned)(e * (DM / 2) + (col0 >> 1))); } } while (0)
#define PV_CONS8(R, CV) do { _Pragma("unroll") for (int i = 0; i < 8; ++i) { const float c = __shfl((CV), 8 * i + sub); const f32x2 c2 = {c, c}; \
            F4A(R[i], 0, 0); F4A(R[i], 0, 1); F4A(R[i], 0, 2); F4A(R[i], 0, 3); F4A(R[i], 1, 0); F4A(R[i], 1, 1); F4A(R[i], 1, 2); F4A(R[i], 1, 3); } } while (0)
#define F4A(RR, Q, B) acc[4 * (Q) + (B)] = __builtin_elementwise_fma(__builtin_amdgcn_cvt_scalef32_pk_f32_fp4(RR[Q], 1.0f, B), c2, acc[4 * (Q) + (B)])
    u32x2 ra[8], rb[8];
    int e0, e1, n0, n1, x0, x1; float c0, c1, d0, d1, y0, y1;
    PV_LOADIDX(wv, e0, e1, c0, c1);
    { const int t1 = nvis > 1 ? wv + nwv : wv; PV_LOADIDX(t1, n0, n1, d0, d1); }
    PV_ISSUE8(ra, e0); PV_ISSUE8(rb, e1);
#pragma unroll 1
    for (int it = 0; it < nvis; ++it) {
        const int tok = wv + it * nwv;
        const int t2 = wv + (it + 2 < nvis ? it + 2 : nvis - 1) * nwv;
        float* hr = h + (size_t)tok * DM + col0;
        const f32x4 hv0 = *(const f32x4*)hr, hv1 = *(const f32x4*)(hr + 4), hv2 = *(const f32x4*)(hr + 8), hv3 = *(const f32x4*)(hr + 12);
        PV_LOADIDX(t2, x0, x1, y0, y1);
        f32x2 acc[8];
#pragma unroll
        for (int q = 0; q < 8; ++q) acc[q] = (f32x2){0.f, 0.f};
        PV_CONS8(ra, c0);
        PV_ISSUE8(ra, n0);
        PV_CONS8(rb, c1);
        PV_ISSUE8(rb, n1);
        float av[16];
#pragma unroll
        for (int q = 0; q < 8; ++q) { av[2 * q] = acc[q].x; av[2 * q + 1] = acc[q].y; }
#pragma unroll
        for (int q = 0; q < 16; ++q) { av[q] += __shfl_xor(av[q], 8); av[q] += __shfl_xor(av[q], 16); av[q] += __shfl_xor(av[q], 32); }
        float ss = 0.f;
        if (lane < 8) {
            const f32x4 o0 = hv0 + (f32x4){av[0], av[1], av[2], av[3]}, o1 = hv1 + (f32x4){av[4], av[5], av[6], av[7]};
            const f32x4 o2 = hv2 + (f32x4){av[8], av[9], av[10], av[11]}, o3 = hv3 + (f32x4){av[12], av[13], av[14], av[15]};
            *(f32x4*)hr = o0; *(f32x4*)(hr + 4) = o1; *(f32x4*)(hr + 8) = o2; *(f32x4*)(hr + 12) = o3;
            u32x4 w0, w1;
            w0.x = pk_bf16(o0[0], o0[1]); w0.y = pk_bf16(o0[2], o0[3]); w0.z = pk_bf16(o1[0], o1[1]); w0.w = pk_bf16(o1[2], o1[3]);
            w1.x = pk_bf16(o2[0], o2[1]); w1.y = pk_bf16(o2[2], o2[3]); w1.z = pk_bf16(o3[0], o3[1]); w1.w = pk_bf16(o3[2], o3[3]);
            *(u32x4*)(hb + (size_t)tok * DM + col0) = w0; *(u32x4*)(hb + (size_t)tok * DM + col0 + 8) = w1;
#pragma unroll
            for (int j = 0; j < 4; ++j) ss += o0[j] * o0[j] + o1[j] * o1[j] + o2[j] * o2[j] + o3[j] * o3[j];
        }
        ss += __shfl_xor(ss, 1); ss += __shfl_xor(ss, 2); ss += __shfl_xor(ss, 4);
        if (lane == 0) ssq2[(size_t)grp * NTOK + tok] = ss;
        e0 = n0; e1 = n1; c0 = d0; c1 = d1; n0 = x0; n1 = x1; d0 = y0; d1 = y1;
    }
#undef PV_LOADIDX
#undef PV_ISSUE8
#undef PV_CONS8
#undef F4A
}
#endif

#if PEER_I8U
constexpr float U_ISCALE = 640.0f;
#define I8_ISSUE(SET, EV, J0) do { int ev_ = (EV); asm volatile("" : "+v"(ev_)); _Pragma("unroll") for (int k = 0; k < 16; ++k) { const int e = __builtin_amdgcn_readlane(ev_, (J0) + k); \
        SET[k] = *(const u32x4*)(u8 + ((unsigned)e * (unsigned)DM + (unsigned)(lane * 16))); } __builtin_amdgcn_sched_barrier(0); } while (0)
#define I8_CONS(SET, P0) do { _Pragma("unroll") for (int k = 0; k < 16; ++k) { \
        int a = __builtin_amdgcn_sdot4((int)SET[k].x, (int)xq[0], 0, false); a = __builtin_amdgcn_sdot4((int)SET[k].y, (int)xq[1], a, false); \
        a = __builtin_amdgcn_sdot4((int)SET[k].z, (int)xq[2], a, false); a = __builtin_amdgcn_sdot4((int)SET[k].w, (int)xq[3], a, false); \
        part[(P0) + k] = (float)a; } __builtin_amdgcn_sched_barrier(0); } while (0)
#define I8_RS(M) do { const bool up = (lane & (M)) != 0; _Pragma("unroll") for (int i = 0; i < (M); ++i) { \
        const float send = up ? part[i] : part[i + (M)], keep = up ? part[i + (M)] : part[i]; part[i] = keep + __shfl_xor(send, (M)); } } while (0)
DI void p6i8_u(const Params& p, int G) {
    unsigned char* ws = p.ws;
    const int tid = threadIdx.x, lane = tid & 63, wid = tid >> 6;
    const int gw = blockIdx.x * 8 + wid, nw = G * 8;
    const unsigned char* u8 = (const unsigned char*)(ws + WS_UB);
    const int* eidx = (const int*)(ws + R_EXP); const float* gsm = (const float*)(ws + R_GSM); const float* rs1v = (const float*)(ws + WS_RS1);
    bf16_t* hb = (bf16_t*)(ws + R_H1B); float* coef = (float*)(ws + R_COEF);
#pragma unroll 1
    for (int tok = gw; tok < NTOK; tok += nw) {
        const int e0 = eidx[(size_t)tok * 128 + lane], e1 = eidx[(size_t)tok * 128 + 64 + lane];
        u32x4 sa[16], sb[16];
        I8_ISSUE(sa, e0, 0);
        I8_ISSUE(sb, e0, 16);
        const u32x4 xa = *(const u32x4*)(hb + (size_t)tok * DM + lane * 16), xb = *(const u32x4*)(hb + (size_t)tok * DM + lane * 16 + 8);
        const float g0 = gsm[(size_t)tok * 128 + lane], g1 = gsm[(size_t)tok * 128 + 64 + lane];
        const float rs1 = rs1v[tok];
        float xf[16];
#pragma unroll
        for (int q = 0; q < 4; ++q) { xf[2 * q] = bflo(xa[q]); xf[2 * q + 1] = bfhi(xa[q]); xf[8 + 2 * q] = bflo(xb[q]); xf[8 + 2 * q + 1] = bfhi(xb[q]); }
        float amax = 0.f;
#pragma unroll
        for (int i = 0; i < 16; ++i) amax = fmaxf(amax, fabsf(xf[i]));
        amax = wave_max(amax);
        const float sx = fmaxf(amax, 1e-20f) * (1.0f / 127.0f), isx = 1.0f / sx;
        unsigned xq[4];
#pragma unroll
        for (int q = 0; q < 4; ++q) {
            unsigned w = 0u;
#pragma unroll
            for (int b = 0; b < 4; ++b) w |= ((unsigned)(int)rintf(xf[4 * q + b] * isx) & 0xffu) << (8 * b);
            xq[q] = w;
        }
        const float scl = rs1 * sx * (1.0f / U_ISCALE);
        float part[64];
        I8_CONS(sa, 0);  I8_ISSUE(sa, e0, 32);
        I8_CONS(sb, 16); I8_ISSUE(sb, e0, 48);
        I8_CONS(sa, 32); I8_ISSUE(sa, e1, 0);
        I8_CONS(sb, 48); I8_ISSUE(sb, e1, 16);
        I8_RS(32); I8_RS(16); I8_RS(8); I8_RS(4); I8_RS(2); I8_RS(1);
        coef[(size_t)tok * 128 + lane] = g0 * gelu_tanh(part[0] * scl) * (1.0f / V8_SCALE);
        I8_CONS(sa, 0);  I8_ISSUE(sa, e1, 32);
        I8_CONS(sb, 16); I8_ISSUE(sb, e1, 48);
        I8_CONS(sa, 32);
        I8_CONS(sb, 48);
        I8_RS(32); I8_RS(16); I8_RS(8); I8_RS(4); I8_RS(2); I8_RS(1);
        coef[(size_t)tok * 128 + 64 + lane] = g1 * gelu_tanh(part[0] * scl) * (1.0f / V8_SCALE);
    }
}
#undef I8_ISSUE
#undef I8_CONS
#undef I8_RS
#endif
#define V8_ISSUE(SET, EV, J0) do { int ev_ = (EV); asm volatile("" : "+v"(ev_)); _Pragma("unroll") for (int k = 0; k < 16; ++k) { const int e = __builtin_amdgcn_readlane(ev_, (J0) + k); \
        SET[k] = *(const u32x4*)(v8 + ((unsigned)e * (unsigned)DM + (unsigned)(lane * 16))); } __builtin_amdgcn_sched_barrier(0); } while (0)
#define V8_FMA(W, I) do { t_[2 * (I)] = __builtin_elementwise_fma(__builtin_amdgcn_cvt_pk_f32_fp8((int)(W), false), c2, t_[2 * (I)]); \
        t_[2 * (I) + 1] = __builtin_elementwise_fma(__builtin_amdgcn_cvt_pk_f32_fp8((int)(W), true), c2, t_[2 * (I) + 1]); } while (0)
#define V8_ROW(SET, CV, J0, K) do { const float c = (CV)[(J0) + (K)]; const f32x2 c2 = {c, c}; const u32x4 w_ = SET[K]; \
        V8_FMA(w_.x, 0); V8_FMA(w_.y, 1); V8_FMA(w_.z, 2); V8_FMA(w_.w, 3); } while (0)
#define V8_CONS(SET, CV, J0) do { f32x2 t_[8]; _Pragma("unroll") for (int i_ = 0; i_ < 8; ++i_) t_[i_] = (f32x2){0.f, 0.f}; V8_ROW(SET, CV, J0, 0); V8_ROW(SET, CV, J0, 1); V8_ROW(SET, CV, J0, 2); V8_ROW(SET, CV, J0, 3); V8_ROW(SET, CV, J0, 4); V8_ROW(SET, CV, J0, 5); \
        V8_ROW(SET, CV, J0, 6); V8_ROW(SET, CV, J0, 7); V8_ROW(SET, CV, J0, 8); V8_ROW(SET, CV, J0, 9); V8_ROW(SET, CV, J0, 10); V8_ROW(SET, CV, J0, 11); \
        V8_ROW(SET, CV, J0, 12); V8_ROW(SET, CV, J0, 13); V8_ROW(SET, CV, J0, 14); V8_ROW(SET, CV, J0, 15); \
        _Pragma("unroll") for (int i_ = 0; i_ < 8; ++i_) acc[i_] += t_[i_]; __builtin_amdgcn_sched_barrier(0); } while (0)
DI void p6v8_v(const Params& p, LAS3 unsigned char* lds, int G) {
    unsigned char* ws = p.ws;
    const int tid = threadIdx.x, lane = tid & 63, wid = tid >> 6;
    const int gw = blockIdx.x * 8 + wid, nw = G * 8;
    const unsigned char* v8 = (const unsigned char*)(ws + WS_VB);
    const int* eidx = (const int*)(ws + R_EXP); const float* coef = (const float*)(ws + R_COEF);
    float* h = p.out; bf16_t* hb = (bf16_t*)(ws + R_H1B); float* rs2 = (float*)(ws + WS_RS2);
#pragma unroll 1
    for (int tok = gw; tok < NTOK; tok += nw) {
        const int e0 = eidx[(size_t)tok * 128 + lane], e1 = eidx[(size_t)tok * 128 + 64 + lane];
        u32x4 sa[16], sb[16];
        V8_ISSUE(sa, e0, 0);
        V8_ISSUE(sb, e0, 16);
        LAS3 float* cl = (LAS3 float*)(lds + wid * 512);
        cl[lane] = coef[(size_t)tok * 128 + lane]; cl[64 + lane] = coef[(size_t)tok * 128 + 64 + lane];
        LAS3 const float* c0 = cl; LAS3 const float* c1 = cl + 64;
        float* hr = h + (size_t)tok * DM + lane * 16;
        const f32x4 hv0 = *(const f32x4*)hr, hv1 = *(const f32x4*)(hr + 4), hv2 = *(const f32x4*)(hr + 8), hv3 = *(const f32x4*)(hr + 12);
        f32x2 acc[8];
#pragma unroll
        for (int i = 0; i < 8; ++i) acc[i] = (f32x2){0.f, 0.f};
        V8_CONS(sa, c0, 0);  V8_ISSUE(sa, e0, 32);
        V8_CONS(sb, c0, 16); V8_ISSUE(sb, e0, 48);
        V8_CONS(sa, c0, 32); V8_ISSUE(sa, e1, 0);
        V8_CONS(sb, c0, 48); V8_ISSUE(sb, e1, 16);
        V8_CONS(sa, c1, 0);  V8_ISSUE(sa, e1, 32);
        V8_CONS(sb, c1, 16); V8_ISSUE(sb, e1, 48);
        V8_CONS(sa, c1, 32);
        V8_CONS(sb, c1, 48);
        const f32x4 o0 = hv0 + (f32x4){acc[0].x, acc[0].y, acc[1].x, acc[1].y}, o1 = hv1 + (f32x4){acc[2].x, acc[2].y, acc[3].x, acc[3].y};
        const f32x4 o2 = hv2 + (f32x4){acc[4].x, acc[4].y, acc[5].x, acc[5].y}, o3 = hv3 + (f32x4){acc[6].x, acc[6].y, acc[7].x, acc[7].y};
        *(f32x4*)hr = o0; *(f32x4*)(hr + 4) = o1; *(f32x4*)(hr + 8) = o2; *(f32x4*)(hr + 12) = o3;
        u32x4 w0, w1;
        w0.x = pk_bf16(o0[0], o0[1]); w0.y = pk_bf16(o0[2], o0[3]); w0.z = pk_bf16(o1[0], o1[1]); w0.w = pk_bf16(o1[2], o1[3]);
        w1.x = pk_bf16(o2[0], o2[1]); w1.y = pk_bf16(o2[2], o2[3]); w1.z = pk_bf16(o3[0], o3[1]); w1.w = pk_bf16(o3[2], o3[3]);
        *(u32x4*)(hb + (size_t)tok * DM + lane * 16) = w0; *(u32x4*)(hb + (size_t)tok * DM + lane * 16 + 8) = w1;
        float ss = 0.f;
#pragma unroll
        for (int j = 0; j < 4; ++j) ss += o0[j] * o0[j] + o1[j] * o1[j] + o2[j] * o2[j] + o3[j] * o3[j];
        ss = wave_sum(ss);
        if (lane == 0) rs2[tok] = rsqrtf(ss * (1.0f / DM) + EPS);
    }
}
#undef V8_ISSUE
#undef V8_CONS
#undef V8_FMA
#undef V8_ROW

#if PEER_V4EXP
#define V4_ISSUE(SET, EV, J0) do { int ev_ = (EV); asm volatile("" : "+v"(ev_)); _Pragma("unroll") for (int k = 0; k < 16; ++k) { const int e = __builtin_amdgcn_readlane(ev_, (J0) + k); \
        SET[k] = *(const u32x2*)(v8 + ((unsigned)e * (unsigned)(DM / 2) + (unsigned)(lane * 8))); } __builtin_amdgcn_sched_barrier(0); } while (0)
#define V4_FMA(W, I) do { t_[4 * (I)] = __builtin_elementwise_fma(__builtin_amdgcn_cvt_scalef32_pk_f32_fp4((W), 1.0f, 0), c2, t_[4 * (I)]); \
        t_[4 * (I) + 1] = __builtin_elementwise_fma(__builtin_amdgcn_cvt_scalef32_pk_f32_fp4((W), 1.0f, 1), c2, t_[4 * (I) + 1]); \
        t_[4 * (I) + 2] = __builtin_elementwise_fma(__builtin_amdgcn_cvt_scalef32_pk_f32_fp4((W), 1.0f, 2), c2, t_[4 * (I) + 2]); \
        t_[4 * (I) + 3] = __builtin_elementwise_fma(__builtin_amdgcn_cvt_scalef32_pk_f32_fp4((W), 1.0f, 3), c2, t_[4 * (I) + 3]); } while (0)
#define V4_ROW(SET, CV, J0, K) do { const float c = (CV)[(J0) + (K)]; const f32x2 c2 = {c, c}; const u32x2 w_ = SET[K]; \
        V4_FMA(w_.x, 0); V4_FMA(w_.y, 1); } while (0)
#define V4_CONS(SET, CV, J0) do { f32x2 t_[8]; _Pragma("unroll") for (int i_ = 0; i_ < 8; ++i_) t_[i_] = (f32x2){0.f, 0.f}; V4_ROW(SET, CV, J0, 0); V4_ROW(SET, CV, J0, 1); V4_ROW(SET, CV, J0, 2); V4_ROW(SET, CV, J0, 3); V4_ROW(SET, CV, J0, 4); V4_ROW(SET, CV, J0, 5); \
        V4_ROW(SET, CV, J0, 6); V4_ROW(SET, CV, J0, 7); V4_ROW(SET, CV, J0, 8); V4_ROW(SET, CV, J0, 9); V4_ROW(SET, CV, J0, 10); V4_ROW(SET, CV, J0, 11); \
        V4_ROW(SET, CV, J0, 12); V4_ROW(SET, CV, J0, 13); V4_ROW(SET, CV, J0, 14); V4_ROW(SET, CV, J0, 15); \
        _Pragma("unroll") for (int i_ = 0; i_ < 8; ++i_) acc[i_] += t_[i_]; __builtin_amdgcn_sched_barrier(0); } while (0)
DI void p6v4_v(const Params& p, LAS3 unsigned char* lds, int G) {
    unsigned char* ws = p.ws;
    const int tid = threadIdx.x, lane = tid & 63, wid = tid >> 6;
    const int gw = blockIdx.x * 8 + wid, nw = G * 8;
    const unsigned char* v8 = (const unsigned char*)(ws + WS_VB);
    const int* eidx = (const int*)(ws + R_EXP); const float* coef = (const float*)(ws + R_COEF);
    float* h = p.out; bf16_t* hb = (bf16_t*)(ws + R_H1B); float* rs2 = (float*)(ws + WS_RS2);
#pragma unroll 1
    for (int tok = gw; tok < NTOK; tok += nw) {
        const int e0 = eidx[(size_t)tok * 128 + lane], e1 = eidx[(size_t)tok * 128 + 64 + lane];
        u32x2 sa[16], sb[16];
        V4_ISSUE(sa, e0, 0);
        V4_ISSUE(sb, e0, 16);
        LAS3 float* cl = (LAS3 float*)(lds + wid * 512);
        cl[lane] = coef[(size_t)tok * 128 + lane]; cl[64 + lane] = coef[(size_t)tok * 128 + 64 + lane];
        LAS3 const float* c0 = cl; LAS3 const float* c1 = cl + 64;
        float* hr = h + (size_t)tok * DM + lane * 16;
        const f32x4 hv0 = *(const f32x4*)hr, hv1 = *(const f32x4*)(hr + 4), hv2 = *(const f32x4*)(hr + 8), hv3 = *(const f32x4*)(hr + 12);
        f32x2 acc[8];
#pragma unroll
        for (int i = 0; i < 8; ++i) acc[i] = (f32x2){0.f, 0.f};
        V4_CONS(sa, c0, 0);  V4_ISSUE(sa, e0, 32);
        V4_CONS(sb, c0, 16); V4_ISSUE(sb, e0, 48);
        V4_CONS(sa, c0, 32); V4_ISSUE(sa, e1, 0);
        V4_CONS(sb, c0, 48); V4_ISSUE(sb, e1, 16);
        V4_CONS(sa, c1, 0);  V4_ISSUE(sa, e1, 32);
        V4_CONS(sb, c1, 16); V4_ISSUE(sb, e1, 48);
        V4_CONS(sa, c1, 32);
        V4_CONS(sb, c1, 48);
        const f32x4 o0 = hv0 + (f32x4){acc[0].x, acc[0].y, acc[1].x, acc[1].y}, o1 = hv1 + (f32x4){acc[2].x, acc[2].y, acc[3].x, acc[3].y};
        const f32x4 o2 = hv2 + (f32x4){acc[4].x, acc[4].y, acc[5].x, acc[5].y}, o3 = hv3 + (f32x4){acc[6].x, acc[6].y, acc[7].x, acc[7].y};
        *(f32x4*)hr = o0; *(f32x4*)(hr + 4) = o1; *(f32x4*)(hr + 8) = o2; *(f32x4*)(hr + 12) = o3;
        u32x4 w0, w1;
        w0.x = pk_bf16(o0[0], o0[1]); w0.y = pk_bf16(o0[2], o0[3]); w0.z = pk_bf16(o1[0], o1[1]); w0.w = pk_bf16(o1[2], o1[3]);
        w1.x = pk_bf16(o2[0], o2[1]); w1.y = pk_bf16(o2[2], o2[3]); w1.z = pk_bf16(o3[0], o3[1]); w1.w = pk_bf16(o3[2], o3[3]);
        *(u32x4*)(hb + (size_t)tok * DM + lane * 16) = w0; *(u32x4*)(hb + (size_t)tok * DM + lane * 16 + 8) = w1;
        float ss = 0.f;
#pragma unroll
        for (int j = 0; j < 4; ++j) ss += o0[j] * o0[j] + o1[j] * o1[j] + o2[j] * o2[j] + o3[j] * o3[j];
        ss = wave_sum(ss);
        if (lane == 0) rs2[tok] = rsqrtf(ss * (1.0f / DM) + EPS);
    }
}
#undef V4_ISSUE
#undef V4_CONS
#undef V4_FMA
#undef V4_ROW
#endif
#define VS_SETUP(BUF, E0, E1, C0, C1, EP, CP) do { LAS3 unsigned* eb = (LAS3 unsigned*)(wl + (BUF) * 1024); LAS3 float* cb = (LAS3 float*)(wl + (BUF) * 1024 + 512); \
        eb[(lane & 7) * 16 + (lane >> 3)] = (unsigned)(E0); eb[(lane & 7) * 16 + 8 + (lane >> 3)] = (unsigned)(E1); \
        cb[(lane & 7) * 16 + (lane >> 3)] = (C0); cb[(lane & 7) * 16 + 8 + (lane >> 3)] = (C1); \
        _Pragma("unroll") for (int q = 0; q < 4; ++q) { const u32x4 ev4 = *(LAS3 const u32x4*)(eb + sub * 16 + 4 * q); const f32x4 cv4 = *(LAS3 const f32x4*)(cb + sub * 16 + 4 * q); \
            EP[4 * q] = ev4.x; EP[4 * q + 1] = ev4.y; EP[4 * q + 2] = ev4.z; EP[4 * q + 3] = ev4.w; CP[4 * q] = cv4[0]; CP[4 * q + 1] = cv4[1]; CP[4 * q + 2] = cv4[2]; CP[4 * q + 3] = cv4[3]; } } while (0)
#define VS_ISSUE(SET, EP) do { _Pragma("unroll") for (int i = 0; i < 16; ++i) SET[i] = *(const u32x4*)(v8 + (EP[i] * (unsigned)DM + (unsigned)col0)); __builtin_amdgcn_sched_barrier(0); } while (0)
#define VS_FMA(W, I) do { t_[2 * (I)] = __builtin_elementwise_fma(__builtin_amdgcn_cvt_pk_f32_fp8((int)(W), false), c2, t_[2 * (I)]); \
        t_[2 * (I) + 1] = __builtin_elementwise_fma(__builtin_amdgcn_cvt_pk_f32_fp8((int)(W), true), c2, t_[2 * (I) + 1]); } while (0)
#define VS_ROW(SET, CP, K) do { const f32x2 c2 = {CP[K], CP[K]}; const u32x4 w_ = SET[K]; VS_FMA(w_.x, 0); VS_FMA(w_.y, 1); VS_FMA(w_.z, 2); VS_FMA(w_.w, 3); } while (0)
#define VS_RS(M, LB) do { const bool up = (lane & (LB)) != 0; _Pragma("unroll") for (int i = 0; i < (M); ++i) { \
        const float send = up ? av[i] : av[i + (M)], keep = up ? av[i + (M)] : av[i]; av[i] = keep + __shfl_xor(send, (LB)); } } while (0)
#define VS_CONSUME(SET, CP, TOK, HV) do { f32x2 t_[8]; _Pragma("unroll") for (int i_ = 0; i_ < 8; ++i_) t_[i_] = (f32x2){0.f, 0.f}; \
        VS_ROW(SET, CP, 0); VS_ROW(SET, CP, 1); VS_ROW(SET, CP, 2); VS_ROW(SET, CP, 3); VS_ROW(SET, CP, 4); VS_ROW(SET, CP, 5); VS_ROW(SET, CP, 6); VS_ROW(SET, CP, 7); \
        f32x2 t2_[8]; _Pragma("unroll") for (int i_ = 0; i_ < 8; ++i_) { t2_[i_] = t_[i_]; t_[i_] = (f32x2){0.f, 0.f}; } \
        VS_ROW(SET, CP, 8); VS_ROW(SET, CP, 9); VS_ROW(SET, CP, 10); VS_ROW(SET, CP, 11); VS_ROW(SET, CP, 12); VS_ROW(SET, CP, 13); VS_ROW(SET, CP, 14); VS_ROW(SET, CP, 15); \
        float av[16]; _Pragma("unroll") for (int i_ = 0; i_ < 8; ++i_) { av[2 * i_] = t_[i_].x + t2_[i_].x; av[2 * i_ + 1] = t_[i_].y + t2_[i_].y; } \
        VS_RS(8, 32); VS_RS(4, 16); VS_RS(2, 8); \
        const f32x2 o_ = (HV) + (f32x2){av[0], av[1]}; \
        *(f32x2*)(h + (size_t)(TOK) * DM + colL) = o_; *(unsigned*)(hb + (size_t)(TOK) * DM + colL) = pk_bf16(o_.x, o_.y); \
        const float ss_ = wave_sum(o_.x * o_.x + o_.y * o_.y); if (lane == 0) ssq2[(size_t)grp * NTOK + (TOK)] = ss_; \
        __builtin_amdgcn_sched_barrier(0); } while (0)
DI void p6vs_v(const Params& p, LAS3 unsigned char* lds, int G) {
    unsigned char* ws = p.ws;
    const int tid = threadIdx.x, lane = tid & 63, wid = tid >> 6, grp = blockIdx.x & 7, rank = blockIdx.x >> 3;
    const int nrank = (G - grp + 7) >> 3, wv = rank * 8 + wid, nwv = nrank * 8;
    const unsigned char* v8 = (const unsigned char*)(ws + WS_VB);
    const int* eidx = (const int*)(ws + R_EXP); const float* coef = (const float*)(ws + R_COEF);
    float* h = p.out; bf16_t* hb = (bf16_t*)(ws + R_H1B); float* ssq2 = (float*)(ws + WS_SSQ2);
    LAS3 unsigned char* wl = lds + wid * 2048;
    const int sub = lane >> 3, col0 = grp * 128 + (lane & 7) * 16;
    const int colL = col0 + 8 * ((lane >> 5) & 1) + 4 * ((lane >> 4) & 1) + 2 * ((lane >> 3) & 1);
    if (wv >= NTOK) return;
    const int nvis = (NTOK - wv + nwv - 1) / nwv;
#define VS_TOK(V) (wv + ((V) < nvis ? (V) : nvis - 1) * nwv)
#define VS_LOADIDX(V, E0, E1, C0, C1) do { const size_t t_ = (size_t)VS_TOK(V) * 128; E0 = eidx[t_ + lane]; E1 = eidx[t_ + 64 + lane]; C0 = coef[t_ + lane]; C1 = coef[t_ + 64 + lane]; } while (0)
    u32x4 sa[16], sb[16];
    unsigned ep[16]; float cpa[16], cpb[16];
    int ea0, ea1, eb0, eb1; float ca0, ca1, cb0, cb1;
    f32x2 hva, hvb;
    VS_LOADIDX(0, ea0, ea1, ca0, ca1); VS_LOADIDX(1, eb0, eb1, cb0, cb1);
    VS_SETUP(0, ea0, ea1, ca0, ca1, ep, cpa); VS_ISSUE(sa, ep); hva = *(const f32x2*)(h + (size_t)VS_TOK(0) * DM + colL);
    VS_SETUP(1, eb0, eb1, cb0, cb1, ep, cpb); VS_ISSUE(sb, ep); hvb = *(const f32x2*)(h + (size_t)VS_TOK(1) * DM + colL);
    VS_LOADIDX(2, ea0, ea1, ca0, ca1); VS_LOADIDX(3, eb0, eb1, cb0, cb1);
#pragma unroll 1
    for (int v = 0; v < nvis; v += 2) {
        { const int tok = VS_TOK(v); VS_CONSUME(sa, cpa, tok, hva); }
        VS_SETUP(0, ea0, ea1, ca0, ca1, ep, cpa); VS_ISSUE(sa, ep); hva = *(const f32x2*)(h + (size_t)VS_TOK(v + 2) * DM + colL);
        VS_LOADIDX(v + 4, ea0, ea1, ca0, ca1);
        if (v + 1 < nvis) { const int tok = VS_TOK(v + 1); VS_CONSUME(sb, cpb, tok, hvb); }
        VS_SETUP(1, eb0, eb1, cb0, cb1, ep, cpb); VS_ISSUE(sb, ep); hvb = *(const f32x2*)(h + (size_t)VS_TOK(v + 3) * DM + colL);
        VS_LOADIDX(v + 5, eb0, eb1, cb0, cb1);
    }
#undef VS_TOK
#undef VS_LOADIDX
}
#undef VS_SETUP
#undef VS_ISSUE
#undef VS_FMA
#undef VS_ROW
#undef VS_RS
#undef VS_CONSUME

#if PEER_V4EXP && PEER_I8U
#if PEER_I4U
#define I8_LOADROW(E) (*(const u32x2*)(u8 + ((unsigned)(E) * (unsigned)(DM / 2) + (unsigned)(lane * 8))))
DI int i4_dotrow(const u32x2 w, const unsigned (&xq)[4]) {
    int a = __builtin_amdgcn_sdot4((int)((w.x << 4) & 0xF0F0F0F0u), (int)xq[0], 0, false); a = __builtin_amdgcn_sdot4((int)(w.x & 0xF0F0F0F0u), (int)xq[1], a, false);
    a = __builtin_amdgcn_sdot4((int)((w.y << 4) & 0xF0F0F0F0u), (int)xq[2], a, false); a = __builtin_amdgcn_sdot4((int)(w.y & 0xF0F0F0F0u), (int)xq[3], a, false);
    return a;
}
#define I8_DOTROW(W) i4_dotrow((W), xq)
#else
#define I8_LOADROW(E) (*(const u32x4*)(u8 + ((unsigned)(E) * (unsigned)DM + (unsigned)(lane * 16))))
DI int i8_dotrow(const u32x4 w, const unsigned (&xq)[4]) {
    int a = __builtin_amdgcn_sdot4((int)w.x, (int)xq[0], 0, false); a = __builtin_amdgcn_sdot4((int)w.y, (int)xq[1], a, false);
    a = __builtin_amdgcn_sdot4((int)w.z, (int)xq[2], a, false); a = __builtin_amdgcn_sdot4((int)w.w, (int)xq[3], a, false);
    return a;
}
#define I8_DOTROW(W) i8_dotrow((W), xq)
#endif
#define I8_ISSUE(SET, EV, J0) do { int ev_ = (EV); asm volatile("" : "+v"(ev_)); _Pragma("unroll") for (int k = 0; k < 16; ++k) { const int e = __builtin_amdgcn_readlane(ev_, (J0) + k); \
        SET[k] = I8_LOADROW(e); } __builtin_amdgcn_sched_barrier(0); } while (0)
#define I8_CONS(SET, P0) do { _Pragma("unroll") for (int k = 0; k < 16; ++k) { \
        part[(P0) + k] = (float)I8_DOTROW(SET[k]); } __builtin_amdgcn_sched_barrier(0); } while (0)
#define I8_RS(M) do { const bool up = (lane & (M)) != 0; _Pragma("unroll") for (int i = 0; i < (M); ++i) { \
        const float send = up ? part[i] : part[i + (M)], keep = up ? part[i + (M)] : part[i]; part[i] = keep + __shfl_xor(send, (M)); } } while (0)
#define V4_ISSUE(SET, EV, J0) do { int ev_ = (EV); asm volatile("" : "+v"(ev_)); _Pragma("unroll") for (int k = 0; k < 16; ++k) { const int e = __builtin_amdgcn_readlane(ev_, (J0) + k); \
        SET[k] = *(const u32x2*)(v8 + ((unsigned)e * (unsigned)(DM / 2) + (unsigned)(lane * 8))); } __builtin_amdgcn_sched_barrier(0); } while (0)
#define V4_FMA(W, I) do { t_[4 * (I)] = __builtin_elementwise_fma(__builtin_amdgcn_cvt_scalef32_pk_f32_fp4((W), 1.0f, 0), c2, t_[4 * (I)]); \
        t_[4 * (I) + 1] = __builtin_elementwise_fma(__builtin_amdgcn_cvt_scalef32_pk_f32_fp4((W), 1.0f, 1), c2, t_[4 * (I) + 1]); \
        t_[4 * (I) + 2] = __builtin_elementwise_fma(__builtin_amdgcn_cvt_scalef32_pk_f32_fp4((W), 1.0f, 2), c2, t_[4 * (I) + 2]); \
        t_[4 * (I) + 3] = __builtin_elementwise_fma(__builtin_amdgcn_cvt_scalef32_pk_f32_fp4((W), 1.0f, 3), c2, t_[4 * (I) + 3]); } while (0)
#define V4_ROW(SET, CV, J0, K) do { const float c = (CV)[(J0) + (K)]; const f32x2 c2 = {c, c}; const u32x2 w_ = SET[K]; \
        V4_FMA(w_.x, 0); V4_FMA(w_.y, 1); } while (0)
#define V4_CONS(SET, CV, J0) do { f32x2 t_[8]; _Pragma("unroll") for (int i_ = 0; i_ < 8; ++i_) t_[i_] = (f32x2){0.f, 0.f}; V4_ROW(SET, CV, J0, 0); V4_ROW(SET, CV, J0, 1); V4_ROW(SET, CV, J0, 2); V4_ROW(SET, CV, J0, 3); V4_ROW(SET, CV, J0, 4); V4_ROW(SET, CV, J0, 5); \
        V4_ROW(SET, CV, J0, 6); V4_ROW(SET, CV, J0, 7); V4_ROW(SET, CV, J0, 8); V4_ROW(SET, CV, J0, 9); V4_ROW(SET, CV, J0, 10); V4_ROW(SET, CV, J0, 11); \
        V4_ROW(SET, CV, J0, 12); V4_ROW(SET, CV, J0, 13); V4_ROW(SET, CV, J0, 14); V4_ROW(SET, CV, J0, 15); \
        _Pragma("unroll") for (int i_ = 0; i_ < 8; ++i_) acc[i_] += t_[i_]; __builtin_amdgcn_sched_barrier(0); } while (0)
DI void p6fused(const Params& p, LAS3 unsigned char* lds, int G) {
    unsigned char* ws = p.ws;
    const int tid = threadIdx.x, lane = tid & 63, wid = tid >> 6;
    const int gw = blockIdx.x * 8 + wid, nw = G * 8;
    const unsigned char* u8 = (const unsigned char*)(ws + WS_UB); const unsigned char* v8 = (const unsigned char*)(ws + WS_VB);
    const int* eidx = (const int*)(ws + R_EXP); const float* gsm = (const float*)(ws + R_GSM); const float* rs1v = (const float*)(ws + WS_RS1);
    bf16_t* hb = (bf16_t*)(ws + R_H1B); float* rs2 = (float*)(ws + WS_RS2);
    LAS3 float* cl = (LAS3 float*)(lds + wid * 512);
#pragma unroll 1
    for (int tok = gw; tok < NTOK; tok += nw) {
        const int e0 = eidx[(size_t)tok * 128 + lane], e1 = eidx[(size_t)tok * 128 + 64 + lane];
        {
#if PEER_I4U
            u32x2 sa[16], sb[16];
#else
            u32x4 sa[16], sb[16];
#endif
            I8_ISSUE(sa, e0, 0);
            I8_ISSUE(sb, e0, 16);
            const u32x4 xa = *(const u32x4*)(hb + (size_t)tok * DM + lane * 16), xb = *(const u32x4*)(hb + (size_t)tok * DM + lane * 16 + 8);
            const float g0 = gsm[(size_t)tok * 128 + lane], g1 = gsm[(size_t)tok * 128 + 64 + lane];
            const float rs1 = rs1v[tok];
            float xf[16];
#pragma unroll
            for (int q = 0; q < 4; ++q) { xf[2 * q] = bflo(xa[q]); xf[2 * q + 1] = bfhi(xa[q]); xf[8 + 2 * q] = bflo(xb[q]); xf[8 + 2 * q + 1] = bfhi(xb[q]); }
            float amax = 0.f;
#pragma unroll
            for (int i = 0; i < 16; ++i) amax = fmaxf(amax, fabsf(xf[i]));
            amax = wave_max(amax);
            const float sx = fmaxf(amax, 1e-20f) * (1.0f / 127.0f), isx = 1.0f / sx;
            unsigned xq[4];
#if PEER_I4U
#pragma unroll
            for (int q = 0; q < 2; ++q) {
                unsigned we = 0u, wo = 0u;
#pragma unroll
                for (int b = 0; b < 4; ++b) { we |= ((unsigned)(int)rintf(xf[8 * q + 2 * b] * isx) & 0xffu) << (8 * b); wo |= ((unsigned)(int)rintf(xf[8 * q + 2 * b + 1] * isx) & 0xffu) << (8 * b); }
                xq[2 * q] = we; xq[2 * q + 1] = wo;
            }
            const float scl = rs1 * sx * (1.0f / (16.0f * U4_ISCALE));
#else
#pragma unroll
            for (int q = 0; q < 4; ++q) {
                unsigned w = 0u;
#pragma unroll
                for (int b = 0; b < 4; ++b) w |= ((unsigned)(int)rintf(xf[4 * q + b] * isx) & 0xffu) << (8 * b);
                xq[q] = w;
            }
            const float scl = rs1 * sx * (1.0f / U_ISCALE);
#endif
            float part[64];
            I8_CONS(sa, 0);  I8_ISSUE(sa, e0, 32);
            I8_CONS(sb, 16); I8_ISSUE(sb, e0, 48);
            I8_CONS(sa, 32); I8_ISSUE(sa, e1, 0);
            I8_CONS(sb, 48); I8_ISSUE(sb, e1, 16);
            I8_RS(32); I8_RS(16); I8_RS(8); I8_RS(4); I8_RS(2); I8_RS(1);
            cl[lane] = g0 * gelu_tanh(part[0] * scl) * (1.0f / V8_SCALE);
            I8_CONS(sa, 0);  I8_ISSUE(sa, e1, 32);
            I8_CONS(sb, 16); I8_ISSUE(sb, e1, 48);
            I8_CONS(sa, 32);
            I8_CONS(sb, 48);
            I8_RS(32); I8_RS(16); I8_RS(8); I8_RS(4); I8_RS(2); I8_RS(1);
            cl[64 + lane] = g1 * gelu_tanh(part[0] * scl) * (1.0f / V8_SCALE);
        }
        {
            u32x2 sa[16], sb[16];
            V4_ISSUE(sa, e0, 0);
            V4_ISSUE(sb, e0, 16);
            LAS3 const float* c0 = cl; LAS3 const float* c1 = cl + 64;
            const u32x4 ha = *(const u32x4*)(hb + (size_t)tok * DM + lane * 16), hc = *(const u32x4*)(hb + (size_t)tok * DM + lane * 16 + 8);
            const f32x4 hv0 = {bflo(ha.x), bfhi(ha.x), bflo(ha.y), bfhi(ha.y)}, hv1 = {bflo(ha.z), bfhi(ha.z), bflo(ha.w), bfhi(ha.w)};
            const f32x4 hv2 = {bflo(hc.x), bfhi(hc.x), bflo(hc.y), bfhi(hc.y)}, hv3 = {bflo(hc.z), bfhi(hc.z), bflo(hc.w), bfhi(hc.w)};
            f32x2 acc[8];
#pragma unroll
            for (int i = 0; i < 8; ++i) acc[i] = (f32x2){0.f, 0.f};
            V4_CONS(sa, c0, 0);  V4_ISSUE(sa, e0, 32);
            V4_CONS(sb, c0, 16); V4_ISSUE(sb, e0, 48);
            V4_CONS(sa, c0, 32); V4_ISSUE(sa, e1, 0);
            V4_CONS(sb, c0, 48); V4_ISSUE(sb, e1, 16);
            V4_CONS(sa, c1, 0);  V4_ISSUE(sa, e1, 32);
            V4_CONS(sb, c1, 16); V4_ISSUE(sb, e1, 48);
            V4_CONS(sa, c1, 32);
            V4_CONS(sb, c1, 48);
            const f32x4 o0 = hv0 + (f32x4){acc[0].x, acc[0].y, acc[1].x, acc[1].y}, o1 = hv1 + (f32x4){acc[2].x, acc[2].y, acc[3].x, acc[3].y};
            const f32x4 o2 = hv2 + (f32x4){acc[4].x, acc[4].y, acc[5].x, acc[5].y}, o3 = hv3 + (f32x4){acc[6].x, acc[6].y, acc[7].x, acc[7].y};
            u32x4 w0, w1;
            w0.x = pk_bf16(o0[0], o0[1]); w0.y = pk_bf16(o0[2], o0[3]); w0.z = pk_bf16(o1[0], o1[1]); w0.w = pk_bf16(o1[2], o1[3]);
            w1.x = pk_bf16(o2[0], o2[1]); w1.y = pk_bf16(o2[2], o2[3]); w1.z = pk_bf16(o3[0], o3[1]); w1.w = pk_bf16(o3[2], o3[3]);
            *(u32x4*)(hb + (size_t)tok * DM + lane * 16) = w0; *(u32x4*)(hb + (size_t)tok * DM + lane * 16 + 8) = w1;
            float ss = 0.f;
#pragma unroll
            for (int j = 0; j < 4; ++j) ss += o0[j] * o0[j] + o1[j] * o1[j] + o2[j] * o2[j] + o3[j] * o3[j];
            ss = wave_sum(ss);
            if (lane == 0) rs2[tok] = rsqrtf(ss * (1.0f / DM) + EPS);
        }
    }
}
#undef I8_ISSUE
#undef I8_CONS
#undef I8_RS
#undef V4_ISSUE
#undef V4_CONS
#undef V4_FMA
#undef V4_ROW
#endif
constexpr int LDS_MISC = 160 * 1024 - 256;
constexpr int LDS_BYTES = 160 * 1024;
constexpr size_t CTL_BAR = 0;
static_assert(XCD_BAR_WORDS * 4 <= 64 * 1024, "control region");

template <class F> struct EpiAdapt {
    static constexpr bool PERM = true, AFTER_DRAIN = false;
    F f;
    DI void operator()(const f32x4 (&acc)[2][2][4][2], const pg8::Unit& u, int wr, int wc, int fr, int fq) const {
        int fr_ = fr, fq_ = fq; asm volatile("" : "+v"(fr_), "+v"(fq_));
        const int row0 = u.pm * 256 + wr * 64 + fr_, col0 = u.pn * 256 + wc * 32 + 8 * fq_;
#pragma unroll
        for (int ai = 0; ai < 2; ++ai)
#pragma unroll
            for (int m = 0; m < 4; ++m) {
                const int row = row0 + ai * 128 + m * 16;
#pragma unroll
                for (int bj = 0; bj < 2; ++bj)
                    f.store8(row, col0 + bj * 128, acc[ai][bj][m][0], acc[ai][bj][m][1]);
            }
    }
};
template <class F> struct EpiAdaptSsq {
    static constexpr bool PERM = true, AFTER_DRAIN = false;
    F f; float* ssq;
    DI void operator()(const f32x4 (&acc)[2][2][4][2], const pg8::Unit& u, int wr, int wc, int fr, int fq) const {
        int fr_ = fr, fq_ = fq; asm volatile("" : "+v"(fr_), "+v"(fq_));
        const int row0 = u.pm * 256 + wr * 64 + fr_, col0 = u.pn * 256 + wc * 32 + 8 * fq_;
#pragma unroll
        for (int ai = 0; ai < 2; ++ai)
#pragma unroll
            for (int m = 0; m < 4; ++m) {
                const int row = row0 + ai * 128 + m * 16;
                float s = 0.f; const float rsc = f.rowscale(row);
#pragma unroll
                for (int bj = 0; bj < 2; ++bj)
                    s += f.store8r(row, col0 + bj * 128, acc[ai][bj][m][0], acc[ai][bj][m][1], rsc);
                s += __shfl_xor(s, 16); s += __shfl_xor(s, 32);
                if (fq_ == 0) ssq[(size_t)(u.pn * 4 + wc) * NTOK + row] = s;
            }
    }
};
struct EpiOutR {
    const bf16_t* xb; bf16_t* h1b;
    DI float rowscale(int) const { return 0.f; }
    DI float store8r(int row, int col, f32x4 v0, f32x4 v1, float) const {
        const size_t o = (size_t)row * DM + col;
        const u32x4 xw = *(const u32x4*)(xb + o);
        v0 += (f32x4){bflo(xw.x), bfhi(xw.x), bflo(xw.y), bfhi(xw.y)}; v1 += (f32x4){bflo(xw.z), bfhi(xw.z), bflo(xw.w), bfhi(xw.w)};
        u32x4 w; w.x = pack2bf(v0[0], v0[1]); w.y = pack2bf(v0[2], v0[3]); w.z = pack2bf(v1[0], v1[1]); w.w = pack2bf(v1[2], v1[3]); *(u32x4*)(h1b + o) = w;
        return ((v0[0] * v0[0] + v0[1] * v0[1]) + (v0[2] * v0[2] + v0[3] * v0[3])) + ((v1[0] * v1[0] + v1[1] * v1[1]) + (v1[2] * v1[2] + v1[3] * v1[3]));
    }
};
struct EpiBf16Plain { bf16_t* C; int ldc;
    DI void store8(int row, int col, f32x4 v0, f32x4 v1) const { u32x4 w; w.x = pack2bf(v0[0], v0[1]); w.y = pack2bf(v0[2], v0[3]); w.z = pack2bf(v1[0], v1[1]); w.w = pack2bf(v1[2], v1[3]); *(u32x4*)(C + (size_t)row * ldc + col) = w; } };
struct EpiGateR {
    const float* rs2; const float* bias; const bf16_t* pp; const bf16_t* h2; bf16_t* h3;
    DI float rowscale(int row) const { return rs2[row]; }
    DI float store8r(int row, int col, f32x4 v0, f32x4 v1, float s) const {
        const size_t o = (size_t)row * DM + col;
        const f32x4 b0 = *(const f32x4*)(bias + col), b1 = *(const f32x4*)(bias + col + 4); const u32x4 pw = *(const u32x4*)(pp + o), hw = *(const u32x4*)(h2 + o);
        float hv[8] = {bflo(hw.x), bfhi(hw.x), bflo(hw.y), bfhi(hw.y), bflo(hw.z), bfhi(hw.z), bflo(hw.w), bfhi(hw.w)};
        const float pv[8] = {bflo(pw.x), bfhi(pw.x), bflo(pw.y), bfhi(pw.y), bflo(pw.z), bfhi(pw.z), bflo(pw.w), bfhi(pw.w)};
        float ss = 0.f;
#pragma unroll
        for (int j = 0; j < 4; ++j) { hv[j] += sigmoidf_(v0[j] * s + b0[j]) * pv[j]; hv[4 + j] += sigmoidf_(v1[j] * s + b1[j]) * pv[4 + j]; }
#pragma unroll
        for (int j = 0; j < 8; ++j) ss += hv[j] * hv[j];
        u32x4 w; w.x = pack2bf(hv[0], hv[1]); w.y = pack2bf(hv[2], hv[3]); w.z = pack2bf(hv[4], hv[5]); w.w = pack2bf(hv[6], hv[7]); *(u32x4*)(h3 + o) = w;
        return ss;
    }
};

struct MegaArgs { Params p; int ph_lo, ph_hi; };

__global__ void __launch_bounds__(MK_THREADS, 2) mega_fwd(MegaArgs args) {
    extern __shared__ __attribute__((aligned(16))) unsigned char lds_raw[];
    LAS unsigned char* lds = (LAS unsigned char*)lds_raw;
    const Params& p = args.p;
    unsigned char* ws = p.ws;
    const int lo = args.ph_lo, hi = args.ph_hi;
    const int G = gridDim.x;
    volatile LAS unsigned* misc = (volatile LAS unsigned*)(lds + LDS_MISC);
    if (threadIdx.x < 64) misc[threadIdx.x] = 0u;
    __syncthreads();
    XcdBarrier bar; bar.bar = (unsigned*)(ws + WS_CTL); bar.x = 0; bar.st = nullptr;
    bar = xcd_barrier_post((unsigned*)(ws + WS_CTL), misc);
    if (threadIdx.x == 0) { const unsigned xc = xb_xcc_id() & 7u; misc[16] = xc; misc[17] = atomicAdd((unsigned*)(ws + WS_CTL + 16384) + xc * 16, 1u); }
    __syncthreads();
#define IN(k) (lo <= (k) && (k) < hi)
#define SEAM(k) do { if (IN(k) && IN((k) + 1)) xcd_barrier(bar); } while (0)

    if (IN(0)) p0_prologue(p, lds, G);
#if defined(PROBE_PH) && PROBE_PH == 0
    if (IN(0)) p0_prologue(p, lds, G);
#endif
    SEAM(0);
    if (IN(1)) {
        pg8::Gemm g{(const bf16_t*)(ws + WS_XB), (const bf16_t*)(ws + WS_WIN), NTOK, NPROJ, DM};
        pg8::StaticOrder S; S.init(NTOK, NPROJ, G, (int)blockIdx.x);
        EpiAdapt<EpiProj> E{{(const float*)(ws + WS_RS0), (bf16_t*)(ws + R_QB), (bf16_t*)(ws + R_KC), (float*)(ws + R_GATE), (bf16_t*)(ws + R_XR), (bf16_t*)(ws + R_XG)}};
        pg8::gemm_phase<EpiAdapt<EpiProj>, pg8::StaticOrder>(lds, g, S, E, nullptr);
#if defined(PROBE_PH) && PROBE_PH == 1
        __syncthreads();
        pg8::gemm_phase<EpiAdapt<EpiProj>, pg8::StaticOrder>(lds, g, S, E, nullptr);
#endif
    }
    SEAM(1);
    if (IN(2)) { if (!CMP_NAIVE) { p2_compress(p, lds, G); p2_vtranspose(p, lds, G); } lru_phase<false>(p, lds, G); }
#ifdef PROBE_P2
    if (IN(2)) { p2_compress(p, lds, G); p2_vtranspose(p, lds, G); lru_phase<false>(p, lds, G); }
#endif
    SEAM(2);
    if (IN(3)) { p3_attention<0>(p, lds, G); if (!LRU_NAIVE) lru_phase<true>(p, lds, G);
#ifdef PROBE_LRU2
        lru_phase<true>(p, lds, G);
#endif
#ifdef PROBE_ATT2
        p3_attention<PROBE_ATT2>(p, lds, G);
#endif
    }
    SEAM(3);
    if (IN(4)) {
        pg8::Gemm g{(const bf16_t*)(ws + WS_MIXED), (const bf16_t*)(ws + WS_WOUT), NTOK, DM, DM};
        pg8::StaticOrder S; S.init(NTOK, DM, G, (int)blockIdx.x);
        EpiAdaptSsq<EpiOutR> E{{(const bf16_t*)(ws + WS_XB), (bf16_t*)(ws + R_H1B)}, (float*)(ws + WS_SSQ1)};
        pg8::gemm_phase<EpiAdaptSsq<EpiOutR>, pg8::StaticOrder>(lds, g, S, E, nullptr);
#if defined(PROBE_PH) && PROBE_PH == 4
        __syncthreads();
        pg8::gemm_phase<EpiAdaptSsq<EpiOutR>, pg8::StaticOrder>(lds, g, S, E, nullptr);
#endif
    }
    SEAM(4);
    if (IN(5)) p5_peer_route(p, lds, G);
#ifdef PROBE_P5
    if (IN(5)) p5_peer_route(p, lds, G);
#endif
    SEAM(5);
    if (IN(6)) {
#if PEER_V6 == 2
        p6v6_u(p, G); xcd_barrier(bar); p6v6_v(p, G);
#elif PEER_V6 == 4
        p6u_cols(p, G); xcd_barrier(bar); p6u_combine(p, G); xcd_barrier(bar); p6v3_v<0>(p, G);
#elif PEER_V6 == 3 && PEER_FP4
        p6f4_u(p, G); xcd_barrier(bar); p6f4_v<0>(p, G);
#elif PEER_V6 == 6 && PEER_I8U
        p6i8_u(p, G); xcd_barrier(bar); p6vs_v(p, lds, G);
#elif PEER_V6 == 5 && PEER_I8U
#if PEER_V4EXP && PEER_FUSED
        p6fused(p, lds, G);
#elif PEER_V4EXP
        p6i8_u(p, G); xcd_barrier(bar); p6v4_v(p, lds, G);
#else
        p6i8_u(p, G); xcd_barrier(bar); p6v8_v(p, lds, G);
#endif
#elif PEER_V6 == 3 && PEER_I8U
        p6i8_u(p, G);
#ifdef PROBE_U2
        p6i8_u(p, G);
#endif
        xcd_barrier(bar);
#ifdef PROBE_V2
        p6v3_v<1>(p, G);
#endif
        p6v3_v<0>(p, G);
#elif PEER_V6 == 3
        p6v6_u(p, G); xcd_barrier(bar); p6v3_v<0>(p, G);
#elif PEER_V6
        p6v6_peer(p, G);
#elif PEER_V3
        p6v5_u(p, lds, G);
#ifdef PROBE_U2
        p6v5_u(p, lds, G);
#endif
        xcd_barrier(bar); p6v3_v<0>(p, G);
#elif PEER_V2
        p6_peer_u(p, G);
#ifdef PROBE_U2
        p6_peer_u(p, G);
#endif
        xcd_barrier(bar); p6_peer_v(p, G);
#else
        p6_peer_apply(p, G);
#endif
    }
    SEAM(6);
    if (IN(7)) {
        {
            pg8::Gemm g{(const bf16_t*)(ws + WS_PB), (const bf16_t*)(ws + WS_WP), NTOK, DM, PLE};
            pg8::StaticOrder S; S.init(NTOK, DM, G, (int)blockIdx.x);
            EpiAdapt<EpiBf16Plain> E{{(bf16_t*)(ws + R_BIG), DM}};
            pg8::gemm_phase<EpiAdapt<EpiBf16Plain>, pg8::StaticOrder>(lds, g, S, E, nullptr);
        }
        __syncthreads();
        {
            pg8::Gemm g{(const bf16_t*)(ws + R_H1B), (const bf16_t*)(ws + WS_WG), NTOK, DM, DM};
            pg8::StaticOrder S; S.init(NTOK, DM, G, (int)blockIdx.x);
            EpiAdaptSsq<EpiGateR> E{{(const float*)(ws + WS_RS2), p.in[I_PLE_BG], (const bf16_t*)(ws + R_BIG), (const bf16_t*)(ws + R_H1B), (bf16_t*)(ws + WS_XB)}, (float*)(ws + WS_SSQ3)};
            pg8::gemm_phase<EpiAdaptSsq<EpiGateR>, pg8::StaticOrder>(lds, g, S, E, nullptr);
        }
    }
    SEAM(7);
#ifdef PROBE_BARS
    for (int i = 0; i < PROBE_BARS; ++i) xcd_barrier(bar);
#endif
    if (IN(8)) p8_final_norm(p, G);
#undef IN
#undef SEAM
}

static int g_grid = 0;
static void launch_mega(hipStream_t st, const Params& p, int lo, int hi) {
    if (g_grid == 0) {
        int dev = 0, cus = 0, per_cu = 0;
        hipGetDevice(&dev); hipDeviceGetAttribute(&cus, hipDeviceAttributeMultiprocessorCount, dev);
        if (hipFuncSetAttribute((const void*)mega_fwd, hipFuncAttributeMaxDynamicSharedMemorySize, LDS_BYTES) != hipSuccess) { fprintf(stderr, "hipFuncSetAttribute failed\n"); g_grid = -1; return; }
        if (hipOccupancyMaxActiveBlocksPerMultiprocessor(&per_cu, (const void*)mega_fwd, MK_THREADS, LDS_BYTES) != hipSuccess || per_cu < 1) { fprintf(stderr, "occupancy query: %d per CU\n", per_cu); }
        (void)hipGetLastError();
        g_grid = cus;
    }
    if (g_grid < 0) return;
    MegaArgs a{}; a.p = p; a.ph_lo = lo; a.ph_hi = hi;
    hipLaunchKernelGGL(mega_fwd, dim3(g_grid), dim3(MK_THREADS), LDS_BYTES, st, a);
}
extern "C" void kernel_launch(void* const* d_in, const int* in_sizes, int n_in, void* d_out, int out_size, void* d_ws, size_t ws_size, hipStream_t stream) {
    if (n_in != 31 || out_size != NTOK * DM || ws_size < WS_END) { fprintf(stderr, "kernel_launch: unexpected shapes (n_in %d out %d ws %zu)\n", n_in, out_size, ws_size); return; }
    Params p{};
    for (int i = 0; i < 31; ++i) p.in[i] = (const float*)d_in[i];
    p.out = (float*)d_out; p.ws = (unsigned char*)d_ws;
    (void)hipMemsetAsync((char*)d_ws + WS_CTL, 0, 16384 + 1024, stream);
    launch_mega(stream, p, 0, 9);
}
```

```cpp
#include <hip/hip_runtime.h>
#include <stdint.h>
#include <stdio.h>

typedef unsigned short bf16_t;
typedef float f32x4 __attribute__((ext_vector_type(4)));
typedef float f32x2 __attribute__((ext_vector_type(2)));
typedef unsigned u32x4 __attribute__((ext_vector_type(4)));
typedef unsigned u32x2 __attribute__((ext_vector_type(2)));
#define DI __device__ __forceinline__

constexpr int NB = 4, T_ = 4096, DM = 1024, NTOK = NB * T_;
constexpr int NH = 8, HD = 64, NKV = 2, GRP = 4, ATTW = 512, KVW = 128, LRUW = 512;
constexpr int INCOLS = 2328, NPROJ = 2560;
constexpr int NCMP = 255, NSEL = 64;
constexpr int PEER_H = 8, PEER_K = 16, PEER_NK = 128;
constexpr int PLE = 256;
constexpr float EPS = 1e-6f;

constexpr int PC_KV = 512, PC_XR = 1280, PC_XG = 1792, PC_GATE = 2304;

constexpr size_t MB = 1024 * 1024;
constexpr size_t WS_CTL   = 0;
constexpr size_t WS_WIN   = 64 * 1024;
constexpr size_t WS_WOUT  = WS_WIN  + (size_t)NPROJ * DM * 2;
constexpr size_t WS_WQS   = WS_WOUT + (size_t)DM * DM * 2;
constexpr size_t WS_WG    = WS_WQS  + (size_t)2048 * DM * 2;
constexpr size_t WS_WP    = WS_WG   + (size_t)DM * DM * 2;
constexpr size_t WS_CW1K  = WS_WP   + (size_t)DM * PLE * 2;
constexpr size_t WS_CW1V  = WS_CW1K + (size_t)256 * 2048 * 2;
constexpr size_t WS_CBK   = WS_CW1V + (size_t)256 * 2048 * 2;
constexpr size_t WS_CBV   = WS_CBK  + 1024;
constexpr size_t WS_RS0   = WS_CBV  + 1024;
constexpr size_t WS_RS2   = WS_RS0  + (size_t)NTOK * 4;
constexpr size_t WS_RS1   = WS_RS2  + (size_t)NTOK * 4;
constexpr size_t WS_SSQ2  = WS_RS1  + (size_t)NTOK * 4;
constexpr size_t WS_SSQ1  = WS_SSQ2 + (size_t)16 * NTOK * 4;
constexpr size_t WS_SSQ3  = WS_SSQ1 + (size_t)16 * NTOK * 4;
constexpr size_t WS_KCMP  = WS_SSQ3 + (size_t)16 * NTOK * 4;
constexpr size_t WS_VCMP  = WS_KCMP + (size_t)8 * 256 * 64 * 4;
constexpr size_t WS_LRUP  = WS_VCMP + (size_t)8 * 256 * 64 * 4;
constexpr size_t WS_LRUH  = WS_LRUP + (size_t)256 * 512 * 4;
constexpr size_t WS_WAT   = WS_LRUH + (size_t)256 * 512 * 4;
constexpr size_t WS_WXT   = WS_WAT + 8 * 64 * 64 * 2;
constexpr size_t WS_CW2K  = WS_WXT + 8 * 64 * 64 * 2;
constexpr size_t WS_CW2V  = WS_CW2K + 64 * 256 * 2;
constexpr size_t WS_HID   = WS_CW2V + 64 * 256 * 2;
constexpr size_t WS_UB    = (WS_HID + (size_t)2 * 2048 * 256 * 4 + 4095) / 4096 * 4096;
constexpr size_t WS_VB    = WS_UB + (size_t)16384 * DM * 2;
constexpr size_t WS_PB    = WS_VB + (size_t)16384 * DM * 2;
constexpr size_t WS_XB    = WS_PB + (size_t)NTOK * PLE * 2;
constexpr size_t WS_R     = WS_XB + (size_t)NTOK * DM * 2;
constexpr size_t KVT = (size_t)NB * NKV * T_ * HD * 2 + 65536;
constexpr size_t R_QB    = WS_R;
constexpr size_t R_KC    = R_QB + (size_t)NTOK * 512 * 2;
constexpr size_t R_VC    = R_KC + KVT;
constexpr size_t R_KS    = R_VC + KVT;
constexpr size_t R_VS    = R_KS + KVT;
constexpr size_t R_KW    = R_VS + KVT;
constexpr size_t R_VW    = R_KW + KVT;
constexpr size_t R_GATE  = R_VW + KVT;
constexpr size_t R_XR    = R_GATE + (size_t)NTOK * 24 * 4;
constexpr size_t R_XG    = R_XR + (size_t)NTOK * 512 * 2;
constexpr size_t R_VST   = R_XG + (size_t)NTOK * 512 * 2;
constexpr size_t R_VWT   = R_VST + KVT;
constexpr size_t R_KCB   = R_VWT + KVT;
constexpr size_t R_VCT   = R_KCB + (size_t)8 * 256 * 64 * 2;
constexpr size_t R_END13 = R_VCT + (size_t)8 * 256 * 64 * 2;
constexpr size_t R_H1B   = WS_R;
constexpr size_t R_EXP   = R_H1B + (size_t)NTOK * DM * 2;
constexpr size_t R_GSM   = R_EXP + (size_t)NTOK * 128 * 4;
constexpr size_t R_COEF  = R_GSM + (size_t)NTOK * 128 * 4;
constexpr size_t R_BIG   = R_COEF + (size_t)NTOK * 128 * 4;
constexpr size_t WS_MIXED = (R_END13 + 4095) / 4096 * 4096;
static_assert(WS_MIXED + (size_t)NTOK * DM * 2 <= R_BIG + 64 * MB, "mixed must fit below the end of region R");
constexpr size_t WS_END  = (R_END13 > R_BIG + 64 * MB ? R_END13 : R_BIG + 64 * MB);
static_assert(WS_END <= 256 * MB, "workspace map exceeds 256 MiB");

DI float bf2f(bf16_t v) { return __uint_as_float((unsigned)v << 16); }
DI bf16_t f2bf(float x) { unsigned u = __float_as_uint(x); u += 0x7fffu + ((u >> 16) & 1u); return (bf16_t)(u >> 16); }
DI unsigned pack2bf(float lo, float hi) { return (unsigned)f2bf(lo) | ((unsigned)f2bf(hi) << 16); }
DI float gelu_tanh(float x) { const float u = 0.7978845608028654f * (x + 0.044715f * x * x * x); return 0.5f * x * (1.0f + tanhf(u)); }
DI float sigmoidf_(float x) { return 1.0f / (1.0f + __expf(-x)); }

__device__ const unsigned char REL_BUCKET_LUT[128] = {
0,1,2,3,4,5,6,7,8,9,10,11,12,13,14,15,16,16,16,17,17,18,18,18,19,19,19,20,20,20,20,21,21,21,21,22,22,22,22,22,23,23,23,23,23,23,24,24,24,24,24,24,25,25,25,25,25,25,25,26,26,26,26,26,26,26,26,27,27,27,27,27,27,27,27,27,27,28,28,28,28,28,28,28,28,28,28,29,29,29,29,29,29,29,29,29,29,29,29,30,30,30,30,30,30,30,30,30,30,30,30,30,30,31,31,31,31,31,31,31,31,31,31,31,31,31,31,31};
DI int rel_bucket(int dist) { dist = dist < 0 ? 0 : dist; return dist >= 128 ? 31 : (int)REL_BUCKET_LUT[dist]; }

struct Params {
    const float* in[31];
    float* out;
    unsigned char* ws;
};
enum { I_X = 0, I_P, I_ATTN_NORM, I_W_IN, I_CK_PE, I_CK_W1, I_CK_W2, I_CV_PE, I_CV_W1, I_CV_W2, I_REL, I_CONV_W, I_CONV_B, I_LRU_WA, I_LRU_BA, I_LRU_WX, I_LRU_BX,
       I_LRU_LAM, I_GN_ATTN, I_GN_LRU, I_W_OUT, I_FFN_NORM, I_PEER_WQ, I_PEER_SUB, I_PEER_U, I_PEER_V, I_PLE_NORM, I_PLE_WG, I_PLE_BG, I_PLE_PROJ, I_FINAL_NORM };

struct EpiProj {
    static constexpr bool HAS8 = true;
    const float* rs0; bf16_t* qb; bf16_t* kv0; float* gates; bf16_t* xr; bf16_t* xg;
    DI void store8(int row, int col, f32x4 v0, f32x4 v1) const {
        const float s = rs0[row];
        v0 *= s; v1 *= s;
        const int tl = __builtin_amdgcn_readfirstlane(col >> 8);
        if (tl < 2) { const float qs = 0.125f * 1.4426950408889634f;
            v0 *= qs; v1 *= qs;
            u32x4 w; w.x = pack2bf(v0[0], v0[1]); w.y = pack2bf(v0[2], v0[3]); w.z = pack2bf(v1[0], v1[1]); w.w = pack2bf(v1[2], v1[3]); *(u32x4*)(qb + (size_t)row * 512 + col) = w; }
        else if (tl < 5) {
            const int c = col - PC_KV, tensor = c >> 7, within = c & 127, kvh = within >> 6, d = within & 63, b = row >> 12, t = row & 4095;
            bf16_t* dst = (bf16_t*)((unsigned char*)kv0 + (size_t)tensor * KVT) + ((size_t)(b * NKV + kvh) * T_ + t) * HD + d;
            u32x4 w; w.x = pack2bf(v0[0], v0[1]); w.y = pack2bf(v0[2], v0[3]); w.z = pack2bf(v1[0], v1[1]); w.w = pack2bf(v1[2], v1[3]); *(u32x4*)dst = w;
        }
        else if (tl < 7) { u32x4 w; w.x = pack2bf(v0[0], v0[1]); w.y = pack2bf(v0[2], v0[3]); w.z = pack2bf(v1[0], v1[1]); w.w = pack2bf(v1[2], v1[3]); *(u32x4*)(xr + (size_t)row * 512 + (col - PC_XR)) = w; }
        else if (tl < 9) { u32x4 w; w.x = pack2bf(v0[0], v0[1]); w.y = pack2bf(v0[2], v0[3]); w.z = pack2bf(v1[0], v1[1]); w.w = pack2bf(v1[2], v1[3]); *(u32x4*)(xg + (size_t)row * 512 + (col - PC_XG)) = w; }
        else if (col < PC_GATE + 24) { float* g = gates + (size_t)row * 24 + (col - PC_GATE); *(f32x4*)g = v0; *(f32x4*)(g + 4) = v1; }
    }
};
struct EpiOut {
    const float* x; float* h1; bf16_t* h1b;
    DI void store4(int row, int col, f32x4 v) const {
        const size_t o = (size_t)row * DM + col;
        v += *(const f32x4*)(x + o);
        *(f32x4*)(h1 + o) = v;
        u32x2 w; w.x = pack2bf(v[0], v[1]); w.y = pack2bf(v[2], v[3]); *(u32x2*)(h1b + o) = w;
    }
};
struct EpiF32Plain { float* C; int ldc; int coloff;
    DI void store4(int row, int col, f32x4 v) const { *(f32x4*)(C + (size_t)row * ldc + (col - coloff)) = v; } };
struct EpiGate {
    const float* rs2; const float* bias; const float* pp; float* h;
    DI void store4(int row, int col, f32x4 v) const {
        const size_t o = (size_t)row * DM + col;
        const float s = rs2[row];
        const f32x4 bb = *(const f32x4*)(bias + col), p4 = *(const f32x4*)(pp + o);
        f32x4 hv = *(f32x4*)(h + o);
#pragma unroll
        for (int j = 0; j < 4; ++j) hv[j] += sigmoidf_(v[j] * s + bb[j]) * p4[j];
        *(f32x4*)(h + o) = hv;
    }
};
DI float wave_sum(float v) {
#pragma unroll
    for (int o = 32; o > 0; o >>= 1) v += __shfl_xor(v, o);
    return v;
}
DI float wave_max(float v) {
#pragma unroll
    for (int o = 32; o > 0; o >>= 1) v = fmaxf(v, __shfl_xor(v, o));
    return v;
}
DI float block_sum256(float v, float* red) {
    v = wave_sum(v); __syncthreads();
    if ((threadIdx.x & 63) == 0) red[threadIdx.x >> 6] = v; __syncthreads();
    return (red[0] + red[1]) + (red[2] + red[3]);
}
DI float block_max256(float v, float* red) {
    v = wave_max(v); __syncthreads();
    if ((threadIdx.x & 63) == 0) red[threadIdx.x >> 6] = v; __syncthreads();
    return fmaxf(fmaxf(red[0], red[1]), fmaxf(red[2], red[3]));
}

#define XB_TMO      128
#define XB_XCNT(j)  (256  + 64 * (j))
#define XB_XSUB(j)  (1280 + 64 * (j))
#define XB_XGEN(j)  (2304 + 64 * (j))
#define XB_TOP      3328
#define XB_TOPGEN   3392
#define XCD_BAR_WORDS 3456
#define XB_SPIN_CAP (1u << 18)
#define LAS __attribute__((address_space(3)))

__device__ __forceinline__ unsigned xb_ld(unsigned* p)              { return __hip_atomic_load(p, __ATOMIC_RELAXED, __HIP_MEMORY_SCOPE_AGENT); }
__device__ __forceinline__ unsigned xb_add(unsigned* p, unsigned v) { return __hip_atomic_fetch_add(p, v, __ATOMIC_RELAXED, __HIP_MEMORY_SCOPE_AGENT); }
__device__ __forceinline__ unsigned xb_xcc_id() { return (unsigned)__builtin_amdgcn_s_getreg((3 << 11) | 20) & 0xFu; }
#define XB_SPIN(cond, bar) do { unsigned _sp = 0; while (cond) { __builtin_amdgcn_s_sleep(1); \
    if ((++_sp & 255u) == 0u) { if (xb_ld(&(bar)[XB_TMO])) break; if (_sp > XB_SPIN_CAP) { atomicAdd(&(bar)[XB_TMO], 1u); break; } } } } while (0)

struct XcdBarrier {
    unsigned* bar; unsigned x;
    volatile LAS unsigned* st;
};

__device__ __forceinline__ XcdBarrier xcd_barrier_post(unsigned* bar, volatile LAS unsigned* st) {
    XcdBarrier b; b.bar = bar; b.x = xb_xcc_id(); b.st = st;
    if (threadIdx.x == 0) (void)xb_add(&bar[XB_XCNT(b.x)], 1u);
    return b;
}
__device__ __forceinline__ void xcd_barrier_complete(unsigned* bar, unsigned x, unsigned& nloc, unsigned& nx) {
    const unsigned G = gridDim.x * gridDim.y * gridDim.z;
    unsigned sum, cnt, mine, sp = 0u;
    for (;;) {
        sum = 0u; cnt = 0u; mine = 0u;
#pragma unroll
        for (unsigned j = 0; j < 16; ++j) { const unsigned c = xb_ld(&bar[XB_XCNT(j)]); sum += c; cnt += (c > 0u) ? 1u : 0u; mine = (j == x) ? c : mine; }
        if (sum == G) break;
        __builtin_amdgcn_s_sleep(1);
        if ((++sp & 255u) == 0u) { if (xb_ld(&bar[XB_TMO])) break; if (sp > XB_SPIN_CAP) { atomicAdd(&bar[XB_TMO], 1u); break; } }
    }
    nloc = mine > 0u ? mine : 1u; nx = cnt > 0u ? cnt : 1u;
}

__device__ __forceinline__ void xcd_barrier(const XcdBarrier& b) {
    asm volatile("s_waitcnt vmcnt(0)" ::: "memory");
    __syncthreads();
    if (threadIdx.x == 0) {
        unsigned* bar = b.bar;
        __builtin_amdgcn_s_waitcnt(0);
        unsigned nloc = b.st[0], nx = b.st[1];
        if (nloc == 0u) { xcd_barrier_complete(bar, b.x, nloc, nx); b.st[0] = nloc; b.st[1] = nx; }
        const unsigned old = xb_add(&bar[XB_XSUB(b.x)], 1u);
        const unsigned gen = old / nloc;
        if (old + 1u == (gen + 1u) * nloc) {
            __builtin_amdgcn_fence(__ATOMIC_RELEASE, "agent");
            asm volatile("s_waitcnt vmcnt(0)" ::: "memory");
            const unsigned og = xb_add(&bar[XB_TOP], 1u);
            const unsigned tg = og / nx;
            if (og + 1u == (tg + 1u) * nx) xb_add(&bar[XB_TOPGEN], 1u);
            else XB_SPIN(xb_ld(&bar[XB_TOPGEN]) == tg, bar);
            __builtin_amdgcn_fence(__ATOMIC_ACQUIRE, "agent");
            xb_add(&bar[XB_XGEN(b.x)], 1u);
            asm volatile("s_waitcnt vmcnt(0)" ::: "memory");
        } else {
            XB_SPIN(xb_ld(&bar[XB_XGEN(b.x)]) == gen, bar);
            __builtin_amdgcn_fence(__ATOMIC_ACQUIRE, "agent");
            asm volatile("s_waitcnt vmcnt(0)" ::: "memory");
        }
    }
    __syncthreads();
}


namespace pg8 {
#define PG8_LAS __attribute__((address_space(3)))
typedef short bf16x8 __attribute__((ext_vector_type(8)));
constexpr int BM = 256, BK = 64, HALF = 128, HTB = HALF * BK * 2  , STAGE_BYTES = 8 * HTB, NXCD = 8, WGM = 8;

__host__ __device__ __forceinline__ int lds_byte(int r, int c) { const int st = (r >> 4) * 2 + (c >> 5), rr = r & 15, cc = c & 31, ob = rr * 64 + cc * 2; return st * 1024 + (ob ^ (((ob >> 9) & 1) << 5)); }
__host__ __device__ __forceinline__ void stage_rc(int b, int& R, int& C) { const int st = b / 1024, sb = b % 1024, swz = sb ^ (((sb >> 9) & 1) << 5); R = (st >> 1) * 16 + swz / 64; C = (st & 1) * 32 + (swz % 64) / 2; }
__host__ __device__ __forceinline__ int perm32(int rho) { const int n = rho >> 4, i = rho & 15; return 8 * (i >> 2) + 4 * n + (i & 3); }

struct Unit { int pm, pn; };
struct Gemm { const bf16_t* A; const bf16_t* Bt; int M, N, K; };

struct StaticOrder {
    int nM, nN, nwg, G, c;
    __host__ __device__ void init(int M, int N, int G_, int c_) { nM = M / BM; nN = N / BM; nwg = nM * nN; G = G_; c = c_; }
    __host__ __device__ bool next(int i, Unit& u) const {
        const long L = (long)i * G + c; if (L >= nwg) return false;
        int wgid = (int)L; { const int q = nwg / NXCD, r = nwg % NXCD, xcd = wgid % NXCD, off = wgid / NXCD; wgid = (xcd < r ? xcd * (q + 1) : r * (q + 1) + (xcd - r) * q) + off; }
        const int nig = WGM * nN, gid = wgid / nig, fm = gid * WGM, gsz = (nM - fm) < WGM ? (nM - fm) : WGM;
        u.pm = fm + ((wgid % nig) % gsz); u.pn = (wgid % nig) / gsz; return true;
    }
    __device__ __forceinline__ void a_ready(const Unit&) const {}
    __device__ __forceinline__ void done(const Unit&) const {}
};
template <class Epi, class Sched, bool STAMP = false>
__device__ __forceinline__ void gemm_phase(PG8_LAS unsigned char* lds, const Gemm g, const Sched& S, const Epi& E, unsigned long long* stamps) {
    int tid_ = threadIdx.x; asm volatile("" : "+v"(tid_));
    const int tid = tid_, wid = __builtin_amdgcn_readfirstlane(tid >> 6), lane = tid & 63, wr = wid >> 2, wc = wid & 3, fr = lane & 15, fq = lane >> 4;
    const int K = g.K, nt = K / BK;
    int ts_lo = 0, ts_hi = 0, nts = 0; const unsigned long long rt_entry = STAMP ? (unsigned long long)wall_clock64() : 0ull;
#define PG8_STAMP() do { if (STAMP && wid == 0 && nts < 64) { const unsigned long long _c = (unsigned long long)clock64(); \
        ts_lo = (lane == nts) ? (int)(unsigned)_c : ts_lo; ts_hi = (lane == nts) ? (int)(unsigned)(_c >> 32) : ts_hi; ++nts; } } while (0)
    PG8_STAMP();
    unsigned voffA[2], voffB[2];
#pragma unroll
    for (int i = 0; i < 2; ++i) { int R, C; stage_rc(tid * 16 + i * 8192, R, C); const int Rb = Epi::PERM ? ((R & ~31) + perm32(R & 31)) : R;
        voffA[i] = (unsigned)(R * K + C) * 2u; voffB[i] = (unsigned)(Rb * K + C) * 2u; }
    const size_t kstep = (size_t)(BK * 2);
    const size_t hstep = (size_t)HALF * K * 2;
    const size_t tstep = 2 * hstep;
    const unsigned ldsw = (unsigned)wid * 1024u;
    const int aoff = lds_byte(wr * 64 + fr, fq * 8), boff = lds_byte(wc * 32 + fr, fq * 8);
#define PG8_SA(b, h) (((b) * 2 + (h)) * HTB)
#define PG8_SB(b, h) ((4 + (b) * 2 + (h)) * HTB)
#define PG8_STAGE(bufoff, gbase, voff) do { _Pragma("unroll") for (int _i = 0; _i < 2; ++_i) \
        __builtin_amdgcn_global_load_lds((const unsigned*)((const char*)(gbase) + (voff)[_i]), (PG8_LAS unsigned*)(lds + (bufoff) + ldsw + _i * 8192), 16, 0, 0); } while (0)
#define PG8_LDA(dst, b, h) do { _Pragma("unroll") for (int m = 0; m < 4; ++m) _Pragma("unroll") for (int k = 0; k < 2; ++k) dst[m][k] = *(const PG8_LAS bf16x8*)(lds + PG8_SA(b, h) + aoff + m * 2048 + k * 1024); } while (0)
#define PG8_LDB(dst, b, h) do { _Pragma("unroll") for (int n = 0; n < 2; ++n) _Pragma("unroll") for (int k = 0; k < 2; ++k) dst[n][k] = *(const PG8_LAS bf16x8*)(lds + PG8_SB(b, h) + boff + n * 2048 + k * 1024); } while (0)
#define PG8_MMA(ai, bj, At, Bt) do { __builtin_amdgcn_s_setprio(1); _Pragma("unroll") for (int m = 0; m < 4; ++m) _Pragma("unroll") for (int n = 0; n < 2; ++n) _Pragma("unroll") for (int k = 0; k < 2; ++k) \
        acc[ai][bj][m][n] = __builtin_amdgcn_mfma_f32_16x16x32_bf16(Bt[n][k], At[m][k], acc[ai][bj][m][n], 0, 0, 0); __builtin_amdgcn_s_setprio(0); } while (0)
#define PG8_WAIT_V(n) asm volatile("s_waitcnt vmcnt(" #n ")" ::: "memory")
#define PG8_WAIT_L(n) asm volatile("s_waitcnt lgkmcnt(" #n ")" ::: "memory")
#define PG8_BAR __builtin_amdgcn_s_barrier()
#define PG8_SCHED __builtin_amdgcn_sched_barrier(0)
    Unit cur, nxt; int ui = 0;
    if (!S.next(0, cur)) return;
    f32x4 acc[2][2][4][2];
#pragma unroll
    for (int a = 0; a < 2; ++a)
#pragma unroll
        for (int b = 0; b < 2; ++b)
#pragma unroll
            for (int m = 0; m < 4; ++m)
#pragma unroll
                for (int n = 0; n < 2; ++n) acc[a][b][m][n] = (f32x4){0.f, 0.f, 0.f, 0.f};
    bf16x8 At[4][2], B0[2][2], B1[2][2];
    const char* cA = (const char*)g.A + (size_t)cur.pm * tstep; const char* cB = (const char*)g.Bt + (size_t)cur.pn * tstep;
    S.a_ready(cur);
    PG8_STAGE(PG8_SB(0, 0), cB, voffB); PG8_STAGE(PG8_SA(0, 0), cA, voffA); PG8_STAGE(PG8_SB(0, 1), cB + hstep, voffB); PG8_STAGE(PG8_SA(0, 1), cA + hstep, voffA);
    if (wr == 1) PG8_BAR;
    PG8_WAIT_V(4); PG8_BAR;
    PG8_STAGE(PG8_SB(1, 0), cB + kstep, voffB); PG8_STAGE(PG8_SA(1, 0), cA + kstep, voffA); PG8_STAGE(PG8_SB(1, 1), cB + hstep + kstep, voffB);
    PG8_WAIT_V(6); PG8_BAR;
    PG8_STAMP();
    for (;;) {
        const bool has_next = S.next(ui + 1, nxt);
        const char* nA = has_next ? (const char*)g.A + (size_t)nxt.pm * tstep : cA; const char* nB = has_next ? (const char*)g.Bt + (size_t)nxt.pn * tstep : cB;
        for (int t = 0; t < nt; t += 2) {
            const bool last = (t == nt - 2);
            const char* a1 = cA + (size_t)(t + 1) * kstep;
            const char* a2 = last ? nA : cA + (size_t)(t + 2) * kstep; const char* b2 = last ? nB : cB + (size_t)(t + 2) * kstep;
            const char* a3 = a2 + kstep; const char* b3 = b2 + kstep;
            if (last && has_next) S.a_ready(nxt);
            PG8_LDB(B0, 0, 0); PG8_SCHED; PG8_LDA(At, 0, 0); PG8_STAGE(PG8_SA(1, 1), a1 + hstep, voffA);
            PG8_WAIT_L(8); PG8_BAR; PG8_WAIT_L(0); PG8_MMA(0, 0, At, B0); PG8_BAR; PG8_SCHED;
            PG8_LDB(B1, 0, 1); PG8_STAGE(PG8_SB(0, 0), b2, voffB);
            PG8_BAR; PG8_WAIT_L(0); PG8_MMA(0, 1, At, B1); PG8_BAR;
            PG8_LDA(At, 0, 1); PG8_STAGE(PG8_SA(0, 0), a2, voffA);
            PG8_BAR; PG8_WAIT_L(0); PG8_MMA(1, 0, At, B0); PG8_BAR; PG8_SCHED;
            PG8_STAGE(PG8_SB(0, 1), b2 + hstep, voffB);
            PG8_WAIT_V(6); PG8_BAR; PG8_MMA(1, 1, At, B1); PG8_BAR;
            PG8_LDB(B0, 1, 0); PG8_SCHED; PG8_LDA(At, 1, 0); PG8_STAGE(PG8_SA(0, 1), a2 + hstep, voffA);
            PG8_WAIT_L(8); PG8_BAR; PG8_WAIT_L(0); PG8_MMA(0, 0, At, B0); PG8_BAR; PG8_SCHED;
            PG8_LDB(B1, 1, 1); PG8_STAGE(PG8_SB(1, 0), b3, voffB);
            PG8_BAR; PG8_WAIT_L(0); PG8_MMA(0, 1, At, B1); PG8_BAR;
            PG8_LDA(At, 1, 1); PG8_STAGE(PG8_SA(1, 0), a3, voffA);
            PG8_BAR; PG8_WAIT_L(0); PG8_MMA(1, 0, At, B0); PG8_BAR; PG8_SCHED;
            PG8_STAGE(PG8_SB(1, 1), b3 + hstep, voffB);
            PG8_WAIT_V(6); PG8_BAR; PG8_MMA(1, 1, At, B1); PG8_BAR;
        }
        PG8_STAMP();
        if constexpr (!Epi::AFTER_DRAIN) { E(acc, cur, wr, wc, fr, fq); S.done(cur); }
        PG8_STAMP();
        if (!has_next) break;
#pragma unroll
        for (int a = 0; a < 2; ++a)
#pragma unroll
            for (int b = 0; b < 2; ++b)
#pragma unroll
                for (int m = 0; m < 4; ++m)
#pragma unroll
                    for (int n = 0; n < 2; ++n) acc[a][b][m][n] = (f32x4){0.f, 0.f, 0.f, 0.f};
        cur = nxt; cA = nA; cB = nB; ++ui;
    }
    PG8_WAIT_V(0);
    if (wr == 0) PG8_BAR;
    PG8_BAR;
    if constexpr (Epi::AFTER_DRAIN) { E.fused(acc, cur, wr, wc, fr, fq, lds, wid, lane); S.done(cur); }
    PG8_STAMP();
    if (STAMP && wid == 0) { stamps[lane] = lane < nts ? (((unsigned long long)(unsigned)ts_hi << 32) | (unsigned)ts_lo) : 0ull;
        if (lane == 62) stamps[62] = rt_entry; if (lane == 63) stamps[63] = (unsigned long long)wall_clock64(); }
#undef PG8_STAMP
#undef PG8_SA
#undef PG8_SB
#undef PG8_STAGE
#undef PG8_LDA
#undef PG8_LDB
#undef PG8_MMA
#undef PG8_WAIT_V
#undef PG8_WAIT_L
#undef PG8_BAR
#undef PG8_SCHED
}
}
#define LAS3 __attribute__((address_space(3)))
constexpr int MK_THREADS = 512;
constexpr float U4_ISCALE = 83.0f;
typedef __bf16 bf16x2_t __attribute__((ext_vector_type(2)));
DI float dot2bf(unsigned a, unsigned b, float c) { return __builtin_amdgcn_fdot2_f32_bf16(__builtin_bit_cast(bf16x2_t, a), __builtin_bit_cast(bf16x2_t, b), c, false); }
DI float bflo(unsigned v) { return __uint_as_float(v << 16); }
DI float bfhi(unsigned v) { return __uint_as_float(v & 0xffff0000u); }

template <class ColMap>
DI void transpose_tile(const float* __restrict__ src, int ldsrc, const float* __restrict__ gain, bf16_t* __restrict__ dst, int K, int k0, int n0, const ColMap& cm, LAS3 float* tl) {
    const int tid = threadIdx.x;
    __syncthreads();
    {
        const int n = tid & 63, sc = cm(n0 + n);
#pragma unroll
        for (int j = 0; j < 8; ++j) { const int k = (tid >> 6) + 8 * j; tl[k * 65 + n] = sc >= 0 ? src[(size_t)(k0 + k) * ldsrc + sc] * (gain ? gain[k0 + k] : 1.0f) : 0.f; }
    }
    __syncthreads();
    {
        const int n = tid >> 3, k8 = (tid & 7) * 8;
        u32x4 w;
        w.x = pack2bf(tl[(k8 + 0) * 65 + n], tl[(k8 + 1) * 65 + n]); w.y = pack2bf(tl[(k8 + 2) * 65 + n], tl[(k8 + 3) * 65 + n]);
        w.z = pack2bf(tl[(k8 + 4) * 65 + n], tl[(k8 + 5) * 65 + n]); w.w = pack2bf(tl[(k8 + 6) * 65 + n], tl[(k8 + 7) * 65 + n]);
        *(u32x4*)(dst + (size_t)(n0 + n) * K + k0 + k8) = w;
    }
}
struct ColId { DI int operator()(int n) const { return n; } };
struct ColWin { DI int operator()(int n) const { return n < PC_XR ? n : (n < PC_XG ? 1304 + (n - PC_XR) : (n < PC_GATE ? 1816 + (n - PC_XG) : (n < PC_GATE + 24 ? 1280 + (n - PC_GATE) : -1))); } };

DI void cvt_rows_bf16(const float* __restrict__ src, const float* __restrict__ gain, bf16_t* __restrict__ dst, size_t n8, int cols, size_t gtid, size_t nthr) {
    for (size_t i0 = gtid; i0 < n8; i0 += 8 * nthr) {
        f32x4 a[8], b[8];
#pragma unroll
        for (int u = 0; u < 8; ++u) { const size_t i = i0 + u * nthr; if (i < n8) { a[u] = *(const f32x4*)(src + i * 8); b[u] = *(const f32x4*)(src + i * 8 + 4); } }
#pragma unroll
        for (int u = 0; u < 8; ++u) { const size_t i = i0 + u * nthr; if (i < n8) {
            f32x4 x = a[u], y = b[u];
            if (gain) { const int c = (int)((i * 8) % cols); x *= *(const f32x4*)(gain + c); y *= *(const f32x4*)(gain + c + 4); }
            u32x4 w; w.x = pack2bf(x[0], x[1]); w.y = pack2bf(x[2], x[3]); w.z = pack2bf(y[0], y[1]); w.w = pack2bf(y[2], y[3]);
            *(u32x4*)(dst + i * 8) = w; } }
    }
}
DI void cvt_rows_i4(const float* __restrict__ src, const float* __restrict__ gain, float scale, unsigned char* __restrict__ dst, size_t n8, int cols, size_t gtid, size_t nthr) {
    for (size_t i0 = gtid; i0 < n8; i0 += 8 * nthr) {
        f32x4 a[8], b[8];
#pragma unroll
        for (int u = 0; u < 8; ++u) { const size_t i = i0 + u * nthr; if (i < n8) { a[u] = *(const f32x4*)(src + i * 8); b[u] = *(const f32x4*)(src + i * 8 + 4); } }
#pragma unroll
        for (int u = 0; u < 8; ++u) { const size_t i = i0 + u * nthr; if (i < n8) {
            f32x4 x = a[u], y = b[u];
            if (gain) { const int c = (int)((i * 8) % cols); x *= *(const f32x4*)(gain + c); y *= *(const f32x4*)(gain + c + 4); }
            unsigned w = 0u;
#pragma unroll
            for (int j = 0; j < 4; ++j) {
                const int qa = (int)rintf(fminf(fmaxf(x[j] * scale, -7.f), 7.f)), qb = (int)rintf(fminf(fmaxf(y[j] * scale, -7.f), 7.f));
                w |= ((unsigned)qa & 0xfu) << (4 * j); w |= ((unsigned)qb & 0xfu) << (16 + 4 * j);
            }
            { const unsigned n1 = __shfl_down(w, 1), n2 = __shfl_down(w, 2), n3 = __shfl_down(w, 3); if ((threadIdx.x & 3) == 0) *(u32x4*)(dst + i * 4) = (u32x4){w, n1, n2, n3}; } } }
    }
}
DI void cvt_rows_fp4(const float* __restrict__ src, const float* __restrict__ gain, float scale, unsigned char* __restrict__ dst, size_t n8, int cols, size_t gtid, size_t nthr) {
    for (size_t i0 = gtid; i0 < n8; i0 += 8 * nthr) {
        f32x4 a[8], b[8];
#pragma unroll
        for (int u = 0; u < 8; ++u) { const size_t i = i0 + u * nthr; if (i < n8) { a[u] = *(const f32x4*)(src + i * 8); b[u] = *(const f32x4*)(src + i * 8 + 4); } }
#pragma unroll
        for (int u = 0; u < 8; ++u) { const size_t i = i0 + u * nthr; if (i < n8) {
            f32x4 x = a[u], y = b[u];
            if (gain) { const int c = (int)((i * 8) % cols); x *= *(const f32x4*)(gain + c); y *= *(const f32x4*)(gain + c + 4); }
            x *= scale; y *= scale;
            unsigned w = 0u;
            w = __builtin_amdgcn_cvt_scalef32_pk_fp4_f32(w, x[0], x[1], 1.0f, 0); w = __builtin_amdgcn_cvt_scalef32_pk_fp4_f32(w, x[2], x[3], 1.0f, 1);
            w = __builtin_amdgcn_cvt_scalef32_pk_fp4_f32(w, y[0], y[1], 1.0f, 2); w = __builtin_amdgcn_cvt_scalef32_pk_fp4_f32(w, y[2], y[3], 1.0f, 3);
            { const unsigned n1 = __shfl_down(w, 1), n2 = __shfl_down(w, 2), n3 = __shfl_down(w, 3); if ((threadIdx.x & 3) == 0) *(u32x4*)(dst + i * 4) = (u32x4){w, n1, n2, n3}; } } }
    }
}
DI void p1_deferred(const Params& p, int G) {
    const int nunits = (NTOK / 256) * (NPROJ / 256), nfull = nunits % G;
    const int first = nfull == 0 ? 0 : nfull, nwg = G - first;
    if ((int)blockIdx.x < first) return;
    const size_t gtid = (size_t)(blockIdx.x - first) * MK_THREADS + threadIdx.x, nthr = (size_t)nwg * MK_THREADS;
    cvt_rows_i4(p.in[I_PEER_U], p.in[I_FFN_NORM], U4_ISCALE, (unsigned char*)(p.ws + WS_UB), (size_t)16384 * DM / 8, DM, gtid, nthr);
    cvt_rows_bf16(p.in[I_P], nullptr, (bf16_t*)(p.ws + WS_PB), (size_t)NTOK * PLE / 8, PLE, gtid, nthr);
}
DI void p0_prologue(const Params& p, LAS3 unsigned char* lds, int G) {
    unsigned char* ws = p.ws;
    const int tid = threadIdx.x, lane = tid & 63, wid = tid >> 6, bid = blockIdx.x;
    const size_t gtid = (size_t)bid * MK_THREADS + tid, nthr = (size_t)G * MK_THREADS;
    const int gw = bid * 8 + wid, nw = G * 8;
    {
        const float* x = p.in[I_X]; bf16_t* xb = (bf16_t*)(ws + WS_XB); float* rs0 = (float*)(ws + WS_RS0);
        for (int row0 = gw; row0 < NTOK; row0 += 4 * nw) {
            f32x4 v[4][4];
#pragma unroll
            for (int u = 0; u < 4; ++u) { const int row = row0 + u * nw; if (row < NTOK) { const float* xr_ = x + (size_t)row * DM + lane * 8;
                v[u][0] = *(const f32x4*)xr_; v[u][1] = *(const f32x4*)(xr_ + 4); v[u][2] = *(const f32x4*)(xr_ + 512); v[u][3] = *(const f32x4*)(xr_ + 516); } }
#pragma unroll
            for (int u = 0; u < 4; ++u) { const int row = row0 + u * nw; if (row < NTOK) {
                float s = 0.f;
#pragma unroll
                for (int j = 0; j < 4; ++j) s += (v[u][j][0] * v[u][j][0] + v[u][j][1] * v[u][j][1]) + (v[u][j][2] * v[u][j][2] + v[u][j][3] * v[u][j][3]);
                s = wave_sum(s);
                u32x4 w0, w1;
                w0.x = pack2bf(v[u][0][0], v[u][0][1]); w0.y = pack2bf(v[u][0][2], v[u][0][3]); w0.z = pack2bf(v[u][1][0], v[u][1][1]); w0.w = pack2bf(v[u][1][2], v[u][1][3]);
                w1.x = pack2bf(v[u][2][0], v[u][2][1]); w1.y = pack2bf(v[u][2][2], v[u][2][3]); w1.z = pack2bf(v[u][3][0], v[u][3][1]); w1.w = pack2bf(v[u][3][2], v[u][3][3]);
                *(u32x4*)(xb + (size_t)row * DM + lane * 8) = w0; *(u32x4*)(xb + (size_t)row * DM + 512 + lane * 8) = w1;
                if (lane == 0) rs0[row] = rsqrtf(s * (1.0f / DM) + EPS); } }
        }
    }
    cvt_rows_fp4(p.in[I_PEER_V], nullptr, 8.0f, (unsigned char*)(ws + WS_VB), (size_t)16384 * DM / 8, DM, gtid, nthr);
    LAS3 float* tl = (LAS3 float*)lds;
    {
        for (int u = bid; u < 1496; u += G) {
            if (u < 640) transpose_tile(p.in[I_W_IN], INCOLS, p.in[I_ATTN_NORM], (bf16_t*)(ws + WS_WIN), DM, (u % 16) * 64, (u / 16) * 64, ColWin{}, tl);
            else if (u < 896) { const int v = u - 640; transpose_tile(p.in[I_W_OUT], DM, nullptr, (bf16_t*)(ws + WS_WOUT), DM, (v % 16) * 64, (v / 16) * 64, ColId{}, tl); }
            else if (u < 1152) { const int v = u - 896; transpose_tile(p.in[I_PLE_WG], DM, p.in[I_PLE_NORM], (bf16_t*)(ws + WS_WG), DM, (v % 16) * 64, (v / 16) * 64, ColId{}, tl); }
            else if (u < 1216) { const int v = u - 1152; transpose_tile(p.in[I_PLE_PROJ], DM, nullptr, (bf16_t*)(ws + WS_WP), PLE, (v % 4) * 64, (v / 4) * 64, ColId{}, tl); }
            else if (u < 1344) { const int v = u - 1216; transpose_tile(p.in[I_CK_W1], 256, nullptr, (bf16_t*)(ws + WS_CW1K), 2048, (v % 32) * 64, (v / 32) * 64, ColId{}, tl); }
            else if (u < 1472) { const int v = u - 1344; transpose_tile(p.in[I_CV_W1], 256, nullptr, (bf16_t*)(ws + WS_CW1V), 2048, (v % 32) * 64, (v / 32) * 64, ColId{}, tl); }
            else if (u < 1480) { const int v = u - 1472; transpose_tile(p.in[I_LRU_WA] + v * 4096, 64, nullptr, (bf16_t*)(ws + WS_WAT) + v * 4096, 64, 0, 0, ColId{}, tl); }
            else if (u < 1488) { const int v = u - 1480; transpose_tile(p.in[I_LRU_WX] + v * 4096, 64, nullptr, (bf16_t*)(ws + WS_WXT) + v * 4096, 64, 0, 0, ColId{}, tl); }
            else if (u < 1492) { const int v = u - 1488; transpose_tile(p.in[I_CK_W2], 64, nullptr, (bf16_t*)(ws + WS_CW2K), 256, v * 64, 0, ColId{}, tl); }
            else { const int v = u - 1492; transpose_tile(p.in[I_CV_W2], 64, nullptr, (bf16_t*)(ws + WS_CW2V), 256, v * 64, 0, ColId{}, tl); }
        }
        __syncthreads();
    }
    {
        LAS3 float* wt = (LAS3 float*)lds;
        LAS3 float* st = (LAS3 float*)(lds + 32768);
        const float* wq = p.in[I_PEER_WQ]; const float* sub = p.in[I_PEER_SUB]; const float* gain = p.in[I_FFN_NORM]; bf16_t* WqsT = (bf16_t*)(ws + WS_WQS);
        for (int u = bid; u < 256; u += G) {
            const int hp = u >> 4, d0 = (u & 15) * 64, pp = hp & 1;
            __syncthreads();
            {
                f32x4 wv[4], sv[8];
#pragma unroll
                for (int u = 0; u < 4; ++u) { const int i = tid + u * MK_THREADS, d = i >> 5, dk4 = (i & 31) * 4; wv[u] = *(const f32x4*)(wq + (size_t)(d0 + d) * 2048 + hp * 128 + dk4); }
#pragma unroll
                for (int u = 0; u < 8; ++u) { const int i = tid + u * MK_THREADS, kk = i >> 5, dk4 = (i & 31) * 4; sv[u] = *(const f32x4*)(sub + ((size_t)pp * 128 + kk) * 128 + dk4); }
#pragma unroll
                for (int u = 0; u < 4; ++u) { const int i = tid + u * MK_THREADS, d = i >> 5, dk4 = (i & 31) * 4;
#pragma unroll
                    for (int j = 0; j < 4; ++j) wt[(dk4 + j) * 64 + d] = wv[u][j]; }
#pragma unroll
                for (int u = 0; u < 8; ++u) { const int i = tid + u * MK_THREADS, kk = i >> 5, dk4 = (i & 31) * 4;
#pragma unroll
                    for (int j = 0; j < 4; ++j) st[kk * 129 + dk4 + j] = sv[u][j]; }
            }
            __syncthreads();
            const int kk = tid & 127, dg = (tid >> 7) * 16;
            float acc[16];
#pragma unroll
            for (int j = 0; j < 16; ++j) acc[j] = 0.f;
            for (int dk = 0; dk < 128; ++dk) {
                const float sv = st[kk * 129 + dk];
#pragma unroll
                for (int j4 = 0; j4 < 4; ++j4) { const f32x4 w4 = *(LAS3 f32x4*)(wt + dk * 64 + dg + j4 * 4);
#pragma unroll
                    for (int j = 0; j < 4; ++j) acc[j4 * 4 + j] += sv * w4[j]; }
            }
            u32x4 o0, o1;
#define GQ(j) (acc[j] * gain[d0 + dg + (j)])
            o0.x = pack2bf(GQ(0), GQ(1)); o0.y = pack2bf(GQ(2), GQ(3)); o0.z = pack2bf(GQ(4), GQ(5)); o0.w = pack2bf(GQ(6), GQ(7));
            o1.x = pack2bf(GQ(8), GQ(9)); o1.y = pack2bf(GQ(10), GQ(11)); o1.z = pack2bf(GQ(12), GQ(13)); o1.w = pack2bf(GQ(14), GQ(15));
#undef GQ
            bf16_t* dst = WqsT + (size_t)(hp * 128 + kk) * DM + d0 + dg;
            *(u32x4*)dst = o0; *(u32x4*)(dst + 8) = o1;
        }
        __syncthreads();
    }
    for (int o = gw; o < 512; o += nw) {
        const int kv = o >> 8, j = o & 255;
        const float* pe = p.in[kv ? I_CV_PE : I_CK_PE]; const float* w1 = p.in[kv ? I_CV_W1 : I_CK_W1];
        float acc = 0.f;
        for (int k = lane; k < 2048; k += 64) acc += pe[k] * w1[(size_t)k * 256 + j];
        acc = wave_sum(acc);
        if (lane == 0) ((float*)(ws + (kv ? WS_CBV : WS_CBK)))[j] = acc;
    }
}

DI void p6_peer_apply(const Params& p, int G) {
    unsigned char* ws = p.ws;
    const int tid = threadIdx.x, lane = tid & 63, wid = tid >> 6;
    const int gw = blockIdx.x * 8 + wid, nw = G * 8;
    const bf16_t* ub = (const bf16_t*)(ws + WS_UB); const bf16_t* vb = (const bf16_t*)(ws + WS_VB);
    const int* eidx = (const int*)(ws + R_EXP); const float* gsm = (const float*)(ws + R_GSM); const float* ssq1 = (const float*)(ws + WS_SSQ1);
    float* h = p.out; bf16_t* hb = (bf16_t*)(ws + R_H1B); float* rs2 = (float*)(ws + WS_RS2);
    for (int tok = gw; tok < NTOK; tok += nw) {
        float sq = lane < 16 ? ssq1[(size_t)lane * NTOK + tok] : 0.f;
        sq = wave_sum(sq);
        const float rs1 = rsqrtf(sq * (1.0f / DM) + EPS);
        const u32x4 xa = *(const u32x4*)(hb + (size_t)tok * DM + lane * 8), xc = *(const u32x4*)(hb + (size_t)tok * DM + 512 + lane * 8);
        const int e0 = eidx[(size_t)tok * 128 + lane], e1 = eidx[(size_t)tok * 128 + 64 + lane];
        const float g0 = gsm[(size_t)tok * 128 + lane], g1 = gsm[(size_t)tok * 128 + 64 + lane];
        float coef0 = 0.f, coef1 = 0.f;
#pragma unroll
        for (int half = 0; half < 2; ++half) {
            const int ev = half ? e1 : e0;
            float part[64];
#pragma unroll
            for (int j = 0; j < 64; ++j) {
                const int e = __builtin_amdgcn_readlane(ev, j);
                const bf16_t* ur = ub + (size_t)e * DM + lane * 8;
                const u32x4 ua = *(const u32x4*)ur, uc = *(const u32x4*)(ur + 512);
                float a = dot2bf(xa.x, ua.x, 0.f); a = dot2bf(xa.y, ua.y, a); a = dot2bf(xa.z, ua.z, a); a = dot2bf(xa.w, ua.w, a);
                a = dot2bf(xc.x, uc.x, a); a = dot2bf(xc.y, uc.y, a); a = dot2bf(xc.z, uc.z, a); a = dot2bf(xc.w, uc.w, a);
                part[j] = a;
            }
#pragma unroll
            for (int m = 32; m >= 1; m >>= 1) {
                const bool up = (lane & m) != 0;
#pragma unroll
                for (int i = 0; i < m; ++i) {
                    const float send = up ? part[i] : part[i + m];
                    const float keep = up ? part[i + m] : part[i];
                    part[i] = keep + __shfl_xor(send, m);
                }
            }
            const float act = gelu_tanh(part[0] * rs1);
            if (half) coef1 = g1 * act; else coef0 = g0 * act;
        }
        float acc[16];
#pragma unroll
        for (int i = 0; i < 16; ++i) acc[i] = 0.f;
#pragma unroll
        for (int half = 0; half < 2; ++half) {
            const int ev = half ? e1 : e0; const float cv = half ? coef1 : coef0;
#pragma unroll 16
            for (int j = 0; j < 64; ++j) {
                const int e = __builtin_amdgcn_readlane(ev, j);
                const float c = __uint_as_float(__builtin_amdgcn_readlane(__float_as_uint(cv), j));
                const bf16_t* vr = vb + (size_t)e * DM + lane * 8;
                const u32x4 va = *(const u32x4*)vr, vc = *(const u32x4*)(vr + 512);
                acc[0] += c * bflo(va.x); acc[1] += c * bfhi(va.x); acc[2] += c * bflo(va.y); acc[3] += c * bfhi(va.y);
                acc[4] += c * bflo(va.z); acc[5] += c * bfhi(va.z); acc[6] += c * bflo(va.w); acc[7] += c * bfhi(va.w);
                acc[8] += c * bflo(vc.x); acc[9] += c * bfhi(vc.x); acc[10] += c * bflo(vc.y); acc[11] += c * bfhi(vc.y);
                acc[12] += c * bflo(vc.z); acc[13] += c * bfhi(vc.z); acc[14] += c * bflo(vc.w); acc[15] += c * bfhi(vc.w);
            }
        }
        float* hr = h + (size_t)tok * DM + lane * 8;
        f32x4 h0 = *(f32x4*)hr, h1 = *(f32x4*)(hr + 4), h2 = *(f32x4*)(hr + 512), h3 = *(f32x4*)(hr + 516);
        h0 += (f32x4){acc[0], acc[1], acc[2], acc[3]}; h1 += (f32x4){acc[4], acc[5], acc[6], acc[7]};
        h2 += (f32x4){acc[8], acc[9], acc[10], acc[11]}; h3 += (f32x4){acc[12], acc[13], acc[14], acc[15]};
        *(f32x4*)hr = h0; *(f32x4*)(hr + 4) = h1; *(f32x4*)(hr + 512) = h2; *(f32x4*)(hr + 516) = h3;
        u32x4 w0, w1;
        w0.x = pack2bf(h0[0], h0[1]); w0.y = pack2bf(h0[2], h0[3]); w0.z = pack2bf(h1[0], h1[1]); w0.w = pack2bf(h1[2], h1[3]);
        w1.x = pack2bf(h2[0], h2[1]); w1.y = pack2bf(h2[2], h2[3]); w1.z = pack2bf(h3[0], h3[1]); w1.w = pack2bf(h3[2], h3[3]);
        *(u32x4*)(hb + (size_t)tok * DM + lane * 8) = w0; *(u32x4*)(hb + (size_t)tok * DM + 512 + lane * 8) = w1;
        float s = 0.f;
#pragma unroll
        for (int j = 0; j < 4; ++j) s += h0[j] * h0[j] + h1[j] * h1[j] + h2[j] * h2[j] + h3[j] * h3[j];
        s = wave_sum(s);
        if (lane == 0) rs2[tok] = rsqrtf(s * (1.0f / DM) + EPS);
    }
}

DI void p8_final_norm(const Params& p, int G) {
    const int lane = threadIdx.x & 63, gw = blockIdx.x * 8 + (threadIdx.x >> 6), nw = G * 8;
    const float* ssq3 = (const float*)(p.ws + WS_SSQ3); const float* g = p.in[I_FINAL_NORM]; const bf16_t* h3 = (const bf16_t*)(p.ws + WS_XB); float* out = p.out;
    f32x4 gg[4];
    gg[0] = *(const f32x4*)(g + lane * 8); gg[1] = *(const f32x4*)(g + lane * 8 + 4); gg[2] = *(const f32x4*)(g + 512 + lane * 8); gg[3] = *(const f32x4*)(g + 512 + lane * 8 + 4);
    for (int row0 = gw; row0 < NTOK; row0 += 4 * nw) {
        u32x4 va[4], vb[4]; float sq[4];
#pragma unroll
        for (int u = 0; u < 4; ++u) { const int row = row0 + u * nw; if (row < NTOK) { sq[u] = lane < 16 ? ssq3[(size_t)lane * NTOK + row] : 0.f;
            va[u] = *(const u32x4*)(h3 + (size_t)row * DM + lane * 8); vb[u] = *(const u32x4*)(h3 + (size_t)row * DM + 512 + lane * 8); } }
#pragma unroll
        for (int u = 0; u < 4; ++u) { const int row = row0 + u * nw; if (row < NTOK) {
            const float rs = rsqrtf(wave_sum(sq[u]) * (1.0f / DM) + EPS);
            float* o = out + (size_t)row * DM + lane * 8;
            *(f32x4*)o = (f32x4){bflo(va[u].x), bfhi(va[u].x), bflo(va[u].y), bfhi(va[u].y)} * rs * gg[0];
            *(f32x4*)(o + 4) = (f32x4){bflo(va[u].z), bfhi(va[u].z), bflo(va[u].w), bfhi(va[u].w)} * rs * gg[1];
            *(f32x4*)(o + 512) = (f32x4){bflo(vb[u].x), bfhi(vb[u].x), bflo(vb[u].y), bfhi(vb[u].y)} * rs * gg[2];
            *(f32x4*)(o + 516) = (f32x4){bflo(vb[u].z), bfhi(vb[u].z), bflo(vb[u].w), bfhi(vb[u].w)} * rs * gg[3]; } }
    }
}
typedef float f32x16 __attribute__((ext_vector_type(16)));
typedef short bf16x8v __attribute__((ext_vector_type(8)));
typedef __bf16 bf16x2v_ __attribute__((ext_vector_type(2)));
DI unsigned pk_bf16(float lo, float hi) { return __builtin_bit_cast(unsigned, __builtin_convertvector((f32x2){lo, hi}, bf16x2v_)); }
constexpr float LOG2E = 1.4426950408889634f;
constexpr int AT_KROW = 144, AT_VROW = 136;
constexpr int AT_KT = 64 * AT_KROW, AT_VT = 64 * AT_VROW, AT_BUF = 2 * AT_KT + 2 * AT_VT;
constexpr int AT_VAL = 0;
constexpr int AT_LUT = 2 * AT_BUF;
constexpr int AT_IMP = AT_LUT + 8 * 128 * 4;
constexpr int AT_SEL = AT_IMP + 8 * 32 * 65 * 4;
constexpr int AT_SSQ = AT_SEL + 512;
constexpr int AT_END = AT_SSQ + 1024;
static_assert(AT_END <= 160 * 1024 - 256, "attention LDS map");

struct AtSrc { const bf16_t* k0; const bf16_t* k1; const bf16_t* v0; const bf16_t* v1; int vld; };
DI void at_load(const AtSrc& s, int kpos, int tid, u32x4 (&r)[4]) {
    const int row = tid >> 3, seg = tid & 7;
    r[0] = *(const u32x4*)(s.k0 + (size_t)(kpos + row) * HD + seg * 8);
    r[1] = *(const u32x4*)(s.k1 + (size_t)(kpos + row) * HD + seg * 8);
    r[2] = *(const u32x4*)(s.v0 + (size_t)row * s.vld + kpos + seg * 8);
    r[3] = *(const u32x4*)(s.v1 + (size_t)row * s.vld + kpos + seg * 8);
}
DI void at_store(LAS3 unsigned char* buf, int tid, const u32x4 (&r)[4]) {
    const int row = tid >> 3, seg = tid & 7;
    *(LAS3 u32x4*)(buf + row * AT_KROW + seg * 16) = r[0];
    *(LAS3 u32x4*)(buf + AT_KT + row * AT_KROW + seg * 16) = r[1];
    LAS3 unsigned char* v = buf + 2 * AT_KT + row * AT_VROW + seg * 16;
    *(LAS3 u32x2*)(v) = (u32x2){r[2].x, r[2].y}; *(LAS3 u32x2*)(v + 8) = (u32x2){r[2].z, r[2].w};
    *(LAS3 u32x2*)(v + AT_VT) = (u32x2){r[3].x, r[3].y}; *(LAS3 u32x2*)(v + AT_VT + 8) = (u32x2){r[3].z, r[3].w};
}

template <int MODE, int PASS, int APROBE>
DI void at_step(LAS3 const unsigned char* Kb, LAS3 const unsigned char* Vb, const bf16x8v (&Q)[4], int k0, int tq, int lane, LAS3 const float* lut, bool blk_ok, bool farstep,
                float& m_run, float& l_run, f32x16 (&O)[2], float inv_l, LAS3 float* imp_row, float& bcarry) {
    const int r = lane & 31, hf = lane >> 5;
    f32x16 S[2];
#pragma unroll
    for (int sub = 0; sub < 2; ++sub) {
#pragma unroll
        for (int i = 0; i < 16; ++i) S[sub][i] = 0.f;
#pragma unroll
        for (int ks = 0; ks < 4; ++ks) {
            const bf16x8v a = *(LAS3 const bf16x8v*)(Kb + (32 * sub + r) * AT_KROW + 32 * ks + 16 * hf);
            if (APROBE < 3) S[sub] = __builtin_amdgcn_mfma_f32_32x32x16_bf16(a, Q[ks], S[sub], 0, 0, 0);
            else S[sub][ks] += __builtin_bit_cast(float, (int)a[0] | ((int)a[1] << 16));
        }
    }
    __builtin_amdgcn_sched_barrier(0);
    float mx = -INFINITY;
    const float bfar = lut[127];
    if (APROBE >= 2) { mx = S[0][0]; } else
    if (!farstep) {
#pragma unroll
        for (int sub = 0; sub < 2; ++sub)
#pragma unroll
            for (int i = 0; i < 16; ++i) {
                const int kp = k0 + 32 * sub + (i & 3) + 8 * (i >> 2) + 4 * hf;
                const int dist = MODE == 0 ? tq - (16 * kp + 31) : tq - kp;
                bool ok = dist >= 0 && blk_ok;
                if (MODE == 2) ok = ok && dist < 512;
                const int idx = dist < 0 ? 0 : (dist > 127 ? 127 : dist);
                float s = S[sub][i] + lut[idx];
                s = ok ? s : -INFINITY;
                S[sub][i] = s; mx = fmaxf(mx, s);
            }
    } else {
#pragma unroll
        for (int sub = 0; sub < 2; ++sub)
#pragma unroll
            for (int i = 0; i < 16; ++i) mx = fmaxf(mx, S[sub][i]);
        mx += bfar;
        if (MODE == 1) mx = blk_ok ? mx : -INFINITY;
    }
    if (APROBE >= 2) { l_run += mx; } else
    if (PASS != 2) {
        mx = fmaxf(mx, __shfl_xor(mx, 32));
        const float m_new = fmaxf(m_run, mx), m_safe = (m_new == -INFINITY) ? 0.f : m_new;
        const float alpha = __builtin_amdgcn_exp2f(m_run - m_safe);
        float m_use = farstep ? m_safe - bfar : m_safe;
        if (MODE == 1 && farstep) m_use = blk_ok ? m_use : INFINITY;
        float sum = 0.f;
#pragma unroll
        for (int sub = 0; sub < 2; ++sub)
#pragma unroll
            for (int i = 0; i < 16; ++i) { const float pv = __builtin_amdgcn_exp2f(S[sub][i] - m_use); S[sub][i] = pv; sum += pv; }
        l_run = l_run * alpha + sum; m_run = m_new;
        if (PASS == 0) {
            if (__any(alpha != 1.0f)) {
#pragma unroll
                for (int db = 0; db < 2; ++db)
#pragma unroll
                    for (int i = 0; i < 16; ++i) O[db][i] *= alpha;
            }
        }
    } else {
        const float mu = farstep ? m_run - bfar : m_run;
#pragma unroll
        for (int sub = 0; sub < 2; ++sub) {
#pragma unroll
            for (int i = 0; i < 16; ++i) S[sub][i] = __builtin_amdgcn_exp2f(S[sub][i] - mu) * inv_l;
            float bp[4], av[4];
#pragma unroll
            for (int a = 0; a < 4; ++a) {
                av[a] = S[sub][4 * a] + S[sub][4 * a + 1] + S[sub][4 * a + 2] + 0.5f * S[sub][4 * a + 3];
                bp[a] = __shfl_xor(0.5f * S[sub][4 * a + 3], 32);
            }
            const int sbase = (k0 >> 2) + 8 * sub + hf;
#pragma unroll
            for (int a = 0; a < 4; ++a) imp_row[sbase + 2 * a] = av[a] + (hf ? bp[a] : (a > 0 ? bp[a > 0 ? a - 1 : 0] : bcarry));
            bcarry = bp[3];
        }
    }
    __builtin_amdgcn_sched_barrier(0);
    if (PASS != 1) {
#pragma unroll
        for (int sub = 0; sub < 2; ++sub)
#pragma unroll
            for (int s2 = 0; s2 < 2; ++s2) {
                u32x4 pw;
                pw.x = pk_bf16(S[sub][8 * s2 + 0], S[sub][8 * s2 + 1]); pw.y = pk_bf16(S[sub][8 * s2 + 2], S[sub][8 * s2 + 3]);
                pw.z = pk_bf16(S[sub][8 * s2 + 4], S[sub][8 * s2 + 5]); pw.w = pk_bf16(S[sub][8 * s2 + 6], S[sub][8 * s2 + 7]);
                const bf16x8v pf = __builtin_bit_cast(bf16x8v, pw);
#pragma unroll
                for (int db = 0; db < 2; ++db) {
                    LAS3 const unsigned char* va = Vb + (32 * db + r) * AT_VROW + (32 * sub + 16 * s2 + 4 * hf) * 2;
                    const u32x2 v0 = *(LAS3 const u32x2*)va, v1 = *(LAS3 const u32x2*)(va + 16);
                    const bf16x8v vf = __builtin_bit_cast(bf16x8v, (u32x4){v0.x, v0.y, v1.x, v1.y});
                    if (APROBE < 3) O[db] = __builtin_amdgcn_mfma_f32_32x32x16_bf16(vf, pf, O[db], 0, 0, 0); else O[db][s2] += __builtin_bit_cast(float, (int)vf[0] | ((int)pf[1] << 16));
                }
            }
    }
}

template <int MODE, int PASS, int APROBE>
DI void at_branch(LAS3 unsigned char* lds, const AtSrc& src, int blk_lo, int blk_hi, const bf16x8v (&Q)[4], int tq, int tid, int kvh, LAS3 const float* lut,
                  unsigned mlo, unsigned mhi, float& m_run, float& l_run, f32x16 (&O)[2], float inv_l, LAS3 float* imp_row) {
    const int lane = tid & 63;
    u32x4 st[4];
    float bcarry = 0.f;
    at_load(src, blk_lo * 64, tid, st);
    for (int blk = blk_lo; blk <= blk_hi; ++blk) {
        LAS3 unsigned char* buf = lds + ((blk - blk_lo) & 1) * AT_BUF;
        at_store(buf, tid, st);
        __syncthreads();
        if (blk < blk_hi) at_load(src, (blk + 1) * 64, tid, st);
        bool blk_ok = true;
        if (MODE == 1) blk_ok = ((blk < 32 ? (mlo >> blk) : (mhi >> (blk - 32))) & 1u) != 0u;
        const int t0u = tq - (lane & 31);
        const bool farstep = MODE == 0 ? (t0u - 16 * (blk * 64 + 63) - 31 >= 128) : (MODE == 1 ? (t0u - blk * 64 - 63 >= 128) : (t0u - blk * 64 - 63 >= 128 && t0u + 31 - blk * 64 < 512));
        if (MODE != 1 || __any(blk_ok)) {
            at_step<MODE, PASS, APROBE>(buf + kvh * AT_KT, buf + 2 * AT_KT + kvh * AT_VT, Q, blk * 64, tq, lane, lut, blk_ok, farstep, m_run, l_run, O, inv_l, imp_row, bcarry);
        }
    }
    __syncthreads();
}

template <int APROBE> DI void p3_attention(const Params& p, LAS3 unsigned char* lds, int G) {
    unsigned char* ws = p.ws;
    const int tid = threadIdx.x, lane = tid & 63, h = __builtin_amdgcn_readfirstlane(tid >> 6), kvh = h >> 2, r = lane & 31, hf = lane >> 5;
    LAS3 float* lutall = (LAS3 float*)(lds + AT_LUT);
    {
        const float* rel = p.in[I_REL];
        for (int i = tid; i < 1024; i += MK_THREADS) lutall[i] = rel[rel_bucket(i & 127) * NH + (i >> 7)] * LOG2E;
    }
    __syncthreads();
    LAS3 const float* lut = lutall + h * 128;
    LAS3 float* impw = (LAS3 float*)(lds + AT_IMP);
    LAS3 float* vals = (LAS3 float*)(lds + AT_VAL);
    LAS3 unsigned char* selb = lds + AT_SEL;
    LAS3 float* ssq = (LAS3 float*)(lds + AT_SSQ);
    const bf16_t* qb = (const bf16_t*)(ws + R_QB);
    const float* gates = (const float*)(ws + R_GATE);
    const float* gn = p.in[I_GN_ATTN];
    bf16_t* mixed = APROBE ? (bf16_t*)(ws + R_BIG + 32 * MB) : (bf16_t*)(ws + WS_MIXED);
    for (int ui = blockIdx.x; ui < 512; ui += G) {
        const int q8 = ui & 255, rnd = ui >> 8, b = q8 >> 6, j6 = q8 & 63, tb = rnd == 0 ? 127 - j6 : j6;
        const int t0 = 32 * tb, qb64 = tb >> 1, tq = t0 + r;
        const size_t tok = (size_t)b * T_ + tq;
        bf16x8v Q[4];
#pragma unroll
        for (int ks = 0; ks < 4; ++ks) Q[ks] = *(const bf16x8v*)(qb + tok * 512 + h * 64 + 16 * ks + 8 * hf);
        f32x16 O[2];
#pragma unroll
        for (int db = 0; db < 2; ++db)
#pragma unroll
            for (int i = 0; i < 16; ++i) O[db][i] = 0.f;
        LAS3 float* oslot = (LAS3 float*)(lds + AT_IMP) + h * 2048 + lane;
        const size_t bh0 = (size_t)b * 2, bh1 = bh0 + 1;
        {
            const bf16_t* kcb = (const bf16_t*)(ws + R_KCB); const bf16_t* vct = (const bf16_t*)(ws + R_VCT);
            const AtSrc src{kcb + bh0 * 256 * 64, kcb + bh1 * 256 * 64, vct + bh0 * 64 * 256, vct + bh1 * 64 * 256, 256};
            const int nst = tb / 32 + 1;
            float m_run = -INFINITY, l_run = 0.f;
            at_branch<0, 1, APROBE>(lds, src, 0, nst - 1, Q, tq, tid, kvh, lut, 0u, 0u, m_run, l_run, O, 0.f, nullptr);
            const float l_tot = l_run + __shfl_xor(l_run, 32);
            const float inv_l = l_tot > 0.f ? 1.0f / l_tot : 0.f;
            float m_fix = (m_run == -INFINITY) ? 0.f : m_run;
            at_branch<0, 2, APROBE>(lds, src, 0, nst - 1, Q, tq, tid, kvh, lut, 0u, 0u, m_fix, l_run, O, inv_l, impw + (h * 32 + r) * 65);
        }
        {
            const int row = tid >> 3, j8 = tid & 7, kr = row >> 5, tr = row & 31;
#pragma unroll
            for (int jj = 0; jj < 8; ++jj) {
                const int s = j8 * 8 + jj, db = qb64 - s;
                float v = 0.f;
#pragma unroll
                for (int g = 0; g < 4; ++g) v += impw[((kr * 4 + g) * 32 + tr) * 65 + s];
                vals[row * 65 + s] = (db >= 0 && db < 2) ? 2.0e4f : (s == 0 ? 1.0e4f : (db >= 0 ? v : -1.0f));
            }
            __syncthreads();
            unsigned bits = 0u;
            {
                float vv[8]; int rk[8];
#pragma unroll
                for (int jj = 0; jj < 8; ++jj) { vv[jj] = vals[row * 65 + j8 * 8 + jj]; rk[jj] = 0; }
#pragma unroll 2
                for (int s2 = 0; s2 < 64; ++s2) {
                    const float w = vals[row * 65 + s2];
#pragma unroll
                    for (int jj = 0; jj < 8; ++jj) rk[jj] += (w > vv[jj] || (w == vv[jj] && s2 < j8 * 8 + jj)) ? 1 : 0;
                }
#pragma unroll
                for (int jj = 0; jj < 8; ++jj) if (rk[jj] < 16 && qb64 - (j8 * 8 + jj) >= 0) bits |= 1u << jj;
            }
            selb[row * 8 + j8] = (unsigned char)bits;
            __syncthreads();
        }
        const unsigned mlo = *(LAS3 const unsigned*)(selb + (kvh * 32 + r) * 8), mhi = *(LAS3 const unsigned*)(selb + (kvh * 32 + r) * 8 + 4);
        __syncthreads();
        {
            const float g0 = sigmoidf_(gates[tok * 24 + h * 3 + 0]);
#pragma unroll
            for (int db = 0; db < 2; ++db)
#pragma unroll
                for (int i = 0; i < 16; ++i) { oslot[(db * 16 + i) * 64] = g0 * O[db][i]; O[db][i] = 0.f; }
        }
        {
            const bf16_t* ksb = (const bf16_t*)(ws + R_KS); const bf16_t* vst = (const bf16_t*)(ws + R_VST);
            const AtSrc src{ksb + bh0 * T_ * HD, ksb + bh1 * T_ * HD, vst + bh0 * HD * T_, vst + bh1 * HD * T_, T_};
            float m_run = -INFINITY, l_run = 0.f;
            at_branch<1, 0, APROBE>(lds, src, 0, qb64, Q, tq, tid, kvh, lut, mlo, mhi, m_run, l_run, O, 0.f, nullptr);
            const float l_tot = l_run + __shfl_xor(l_run, 32), sc = sigmoidf_(gates[tok * 24 + h * 3 + 1]) / l_tot;
#pragma unroll
            for (int db = 0; db < 2; ++db)
#pragma unroll
                for (int i = 0; i < 16; ++i) { oslot[(db * 16 + i) * 64] += sc * O[db][i]; O[db][i] = 0.f; }
        }
        {
            const bf16_t* kwb = (const bf16_t*)(ws + R_KW); const bf16_t* vwt = (const bf16_t*)(ws + R_VWT);
            const AtSrc src{kwb + bh0 * T_ * HD, kwb + bh1 * T_ * HD, vwt + bh0 * HD * T_, vwt + bh1 * HD * T_, T_};
            int wb0 = (t0 - 511) >> 6; wb0 = wb0 < 0 ? 0 : wb0;
            float m_run = -INFINITY, l_run = 0.f;
            at_branch<2, 0, APROBE>(lds, src, wb0, qb64, Q, tq, tid, kvh, lut, 0u, 0u, m_run, l_run, O, 0.f, nullptr);
            const float l_tot = l_run + __shfl_xor(l_run, 32), sc = sigmoidf_(gates[tok * 24 + h * 3 + 2]) / l_tot;
#pragma unroll
            for (int db = 0; db < 2; ++db)
#pragma unroll
                for (int i = 0; i < 16; ++i) O[db][i] = oslot[(db * 16 + i) * 64] + sc * O[db][i];
        }
        {
            float ss = 0.f;
#pragma unroll
            for (int db = 0; db < 2; ++db)
#pragma unroll
                for (int i = 0; i < 16; ++i) ss += O[db][i] * O[db][i];
            ss += __shfl_xor(ss, 32);
            if (hf == 0) ssq[h * 32 + r] = ss;
            __syncthreads();
            float tot = 0.f;
#pragma unroll
            for (int hh = 0; hh < 8; ++hh) tot += ssq[hh * 32 + r];
            const float rs = rsqrtf(tot * (1.0f / 512) + EPS);
#pragma unroll
            for (int db = 0; db < 2; ++db)
#pragma unroll
                for (int a = 0; a < 4; ++a) {
                    const int d = 32 * db + 8 * a + 4 * hf;
                    const f32x4 g4 = *(const f32x4*)(gn + h * 64 + d);
                    u32x2 w; w.x = pk_bf16(O[db][4 * a] * rs * g4[0], O[db][4 * a + 1] * rs * g4[1]); w.y = pk_bf16(O[db][4 * a + 2] * rs * g4[2], O[db][4 * a + 3] * rs * g4[3]);
                    *(u32x2*)(mixed + tok * DM + h * 64 + d) = w;
                }
            __syncthreads();
        }
    }
}
constexpr int LR_STRIDE = 516;
constexpr int LR_XC = 0, LR_A = 32 * LR_STRIDE * 4, LR_RS = 2 * 32 * LR_STRIDE * 4, LR_END = LR_RS + 256;
static_assert(LR_END <= 160 * 1024 - 256, "LRU LDS map");

template <bool FINAL>
DI void lru_phase(const Params& p, LAS3 unsigned char* lds, int G) {
    unsigned char* ws = p.ws;
    const int tid = threadIdx.x, lane = tid & 63, n = __builtin_amdgcn_readfirstlane(tid >> 6), r = lane & 31, hf = lane >> 5, ch = tid;
    LAS3 float* XC = (LAS3 float*)(lds + LR_XC); LAS3 float* AA = (LAS3 float*)(lds + LR_A); LAS3 float* RS = (LAS3 float*)(lds + LR_RS);
    const bf16_t* xr = (const bf16_t*)(ws + R_XR); const bf16_t* xg = (const bf16_t*)(ws + R_XG);
    float* sumP = (float*)(ws + WS_LRUP); float* sumH = (float*)(ws + WS_LRUH);
    bf16_t* mixed = (bf16_t*)(ws + WS_MIXED);
    const float cw0 = p.in[I_CONV_W][0 * 512 + ch], cw1 = p.in[I_CONV_W][1 * 512 + ch], cw2 = p.in[I_CONV_W][2 * 512 + ch], cw3 = p.in[I_CONV_W][3 * 512 + ch], cb = p.in[I_CONV_B][ch];
    const float gl = FINAL ? p.in[I_GN_LRU][ch] : 0.f;
    float ba[2], bx[2], sp[2];
#pragma unroll
    for (int nb = 0; nb < 2; ++nb) { const int c2 = n * 64 + 32 * nb + r; ba[nb] = p.in[I_LRU_BA][c2]; bx[nb] = p.in[I_LRU_BX][c2]; sp[nb] = log1pf(__expf(-p.in[I_LRU_LAM][c2])); }
    const bf16_t* waT = (const bf16_t*)(ws + WS_WAT); const bf16_t* wxT = (const bf16_t*)(ws + WS_WXT);
    for (int ci = blockIdx.x; ci < 256; ci += G) {
        const int b = ci >> 6, cib = ci & 63, t0 = cib * 64;
        const size_t tok0 = (size_t)b * T_ + t0;
        float x1 = 0.f, x2 = 0.f, x3 = 0.f;
        if (t0 > 0) { x1 = bf2f(xr[(tok0 - 1) * 512 + ch]); x2 = bf2f(xr[(tok0 - 2) * 512 + ch]); x3 = bf2f(xr[(tok0 - 3) * 512 + ch]); }
        float hst = 0.f, pprod = 1.f;
        if (FINAL) {
            const float* Pp = sumP + (size_t)(b * 64) * 512 + ch; const float* Hp = sumH + (size_t)(b * 64) * 512 + ch;
            for (int k = 0; k < cib; ++k) hst = Pp[(size_t)k * 512] * hst + Hp[(size_t)k * 512];
        }
#pragma unroll 1
        for (int half = 0; half < 2; ++half) {
            const size_t tokh = tok0 + half * 32;
            __syncthreads();
            {
                bf16_t xw[32]; float xv[32];
#pragma unroll
                for (int t = 0; t < 32; ++t) xw[t] = xr[(tokh + t) * 512 + ch];
#pragma unroll
                for (int t = 0; t < 32; ++t) xv[t] = bf2f(xw[t]);
#pragma unroll
                for (int t = 0; t < 32; ++t) {
                    const float x0 = xv[t];
                    XC[t * LR_STRIDE + ch] = cw0 * x3 + cw1 * x2 + cw2 * x1 + cw3 * x0 + cb;
                    x3 = x2; x2 = x1; x1 = x0;
                }
            }
            __syncthreads();
            {
                f32x16 ar[2], ai[2];
#pragma unroll
                for (int nb = 0; nb < 2; ++nb)
#pragma unroll
                    for (int i = 0; i < 16; ++i) { ar[nb][i] = 0.f; ai[nb][i] = 0.f; }
                bf16x8v Ba[2][4], Bx[2][4];
#pragma unroll
                for (int nb = 0; nb < 2; ++nb)
#pragma unroll
                    for (int ks = 0; ks < 4; ++ks) {
                        const size_t o = (size_t)(n * 64 + 32 * nb + r) * 64 + 16 * ks + 8 * hf;
                        Ba[nb][ks] = *(const bf16x8v*)(waT + o); Bx[nb][ks] = *(const bf16x8v*)(wxT + o);
                    }
#pragma unroll
                for (int ks = 0; ks < 4; ++ks) {
                    LAS3 const float* src = XC + r * LR_STRIDE + n * 64 + 16 * ks + 8 * hf;
                    const f32x4 f0 = *(LAS3 const f32x4*)src, f1 = *(LAS3 const f32x4*)(src + 4);
                    u32x4 pw; pw.x = pk_bf16(f0[0], f0[1]); pw.y = pk_bf16(f0[2], f0[3]); pw.z = pk_bf16(f1[0], f1[1]); pw.w = pk_bf16(f1[2], f1[3]);
                    const bf16x8v af = __builtin_bit_cast(bf16x8v, pw);
#pragma unroll
                    for (int nb = 0; nb < 2; ++nb) {
                        ar[nb] = __builtin_amdgcn_mfma_f32_32x32x16_bf16(af, Ba[nb][ks], ar[nb], 0, 0, 0);
                        ai[nb] = __builtin_amdgcn_mfma_f32_32x32x16_bf16(af, Bx[nb][ks], ai[nb], 0, 0, 0);
                    }
                }
                __syncthreads();
#pragma unroll
                for (int nb = 0; nb < 2; ++nb)
#pragma unroll
                    for (int i = 0; i < 16; ++i) {
                        const int t = (i & 3) + 8 * (i >> 2) + 4 * hf, o = t * LR_STRIDE + n * 64 + 32 * nb + r;
                        const float xcv = XC[o];
                        const float rg = sigmoidf_(ar[nb][i] + ba[nb]), ig = sigmoidf_(ai[nb][i] + bx[nb]);
                        const float log_a = -8.0f * rg * sp[nb];
                        AA[o] = __expf(log_a);
                        XC[o] = sqrtf(-expm1f(2.0f * log_a)) * (ig * xcv);
                    }
            }
            __syncthreads();
            if (!FINAL) {
#pragma unroll 8
                for (int t = 0; t < 32; ++t) { const float a = AA[t * LR_STRIDE + ch]; hst = a * hst + XC[t * LR_STRIDE + ch]; pprod *= a; }
            } else {
                {
                    bf16_t gv[32];
#pragma unroll
                    for (int t = 0; t < 32; ++t) gv[t] = xg[(tokh + t) * 512 + ch];
#pragma unroll
                    for (int t = 0; t < 32; ++t) {
                        hst = AA[t * LR_STRIDE + ch] * hst + XC[t * LR_STRIDE + ch];
                        XC[t * LR_STRIDE + ch] = hst * gelu_tanh(bf2f(gv[t]));
                    }
                }
                __syncthreads();
                {
                    const int t = tid >> 4, part = tid & 15;
                    float s = 0.f;
#pragma unroll 8
                    for (int j = 0; j < 32; ++j) { const float v = XC[t * LR_STRIDE + part + 16 * j]; s += v * v; }
                    s += __shfl_xor(s, 1); s += __shfl_xor(s, 2); s += __shfl_xor(s, 4); s += __shfl_xor(s, 8);
                    if (part == 0) RS[t] = rsqrtf(s * (1.0f / 512) + EPS);
                }
                __syncthreads();
                {
                    const int t = tid >> 4, part = tid & 15; const float rs = RS[t];
                    const float* gp = p.in[I_GN_LRU] + part * 32; LAS3 const float* xp = XC + t * LR_STRIDE + part * 32;
                    bf16_t* dst = mixed + (tokh + t) * DM + 512 + part * 32;
#pragma unroll
                    for (int q = 0; q < 4; ++q) {
                        const f32x4 a = *(LAS3 const f32x4*)(xp + 8 * q), b = *(LAS3 const f32x4*)(xp + 8 * q + 4), ga = *(const f32x4*)(gp + 8 * q), gb = *(const f32x4*)(gp + 8 * q + 4);
                        u32x4 w; w.x = pack2bf(a[0] * rs * ga[0], a[1] * rs * ga[1]); w.y = pack2bf(a[2] * rs * ga[2], a[3] * rs * ga[3]);
                        w.z = pack2bf(b[0] * rs * gb[0], b[1] * rs * gb[1]); w.w = pack2bf(b[2] * rs * gb[2], b[3] * rs * gb[3]);
                        *(u32x4*)(dst + 8 * q) = w;
                    }
                }
            }
        }
        if (!FINAL) { sumP[(size_t)ci * 512 + ch] = pprod; sumH[(size_t)ci * 512 + ch] = hst; }
    }
    __syncthreads();
}
typedef float f32x4v __attribute__((ext_vector_type(4)));
constexpr int CM_IMG = 0;
constexpr int CM_HID = 36864;
constexpr int CM_END = CM_HID + 16 * 264 * 2;
DI void p2_compress(const Params& p, LAS3 unsigned char* lds, int G) {
    unsigned char* ws = p.ws;
    const int tid = threadIdx.x, lane = tid & 63, wid = __builtin_amdgcn_readfirstlane(tid >> 6), row = lane & 15, kg = lane >> 4;
    for (int u = blockIdx.x; u < 256; u += G) {
        const int kv = u >> 7, bh = (u >> 4) & 7, c0 = (u & 15) * 16;
        const bf16_t* src = (const bf16_t*)(ws + (kv ? R_VC : R_KC)) + ((size_t)bh * T_ + 16 * c0) * HD;
        const bf16_t* W1T = (const bf16_t*)(ws + (kv ? WS_CW1V : WS_CW1K));
        const float* cb = (const float*)(ws + (kv ? WS_CBV : WS_CBK));
        const bf16_t* W2T = (const bf16_t*)(ws + (kv ? WS_CW2V : WS_CW2K));
        __syncthreads();
        for (int i = tid; i < 272 * 8; i += MK_THREADS) { const int tau = i >> 3, cch = i & 7; *(LAS3 u32x4*)(lds + CM_IMG + tau * 128 + (tau >> 4) * 16 + cch * 16) = *(const u32x4*)(src + (size_t)tau * HD + cch * 8); }
        __syncthreads();
        f32x4v acc[2] = {{0.f, 0.f, 0.f, 0.f}, {0.f, 0.f, 0.f, 0.f}};
        const bf16_t* wb0 = W1T + (size_t)(wid * 32 + row) * 2048 + 8 * kg, * wb1 = wb0 + (size_t)16 * 2048;
#pragma unroll 8
        for (int ks = 0; ks < 64; ++ks) {
            const int tau = 16 * row + (ks >> 1);
            const bf16x8v a = *(LAS3 const bf16x8v*)(lds + CM_IMG + tau * 128 + (tau >> 4) * 16 + (32 * (ks & 1) + 8 * kg) * 2);
            const bf16x8v b0 = *(const bf16x8v*)(wb0 + 32 * ks), b1 = *(const bf16x8v*)(wb1 + 32 * ks);
            acc[0] = __builtin_amdgcn_mfma_f32_16x16x32_bf16(a, b0, acc[0], 0, 0, 0);
            acc[1] = __builtin_amdgcn_mfma_f32_16x16x32_bf16(a, b1, acc[1], 0, 0, 0);
        }
#pragma unroll
        for (int nb = 0; nb < 2; ++nb) {
            const int col = wid * 32 + 16 * nb + row; const float bias = cb[col];
#pragma unroll
            for (int i = 0; i < 4; ++i) *(LAS3 bf16_t*)(lds + CM_HID + ((4 * kg + i) * 264 + col) * 2) = f2bf(gelu_tanh(acc[nb][i] + bias));
        }
        __syncthreads();
        if (wid < 4) {
            f32x4v o = {0.f, 0.f, 0.f, 0.f};
#pragma unroll
            for (int ks = 0; ks < 8; ++ks) {
                const bf16x8v a = *(LAS3 const bf16x8v*)(lds + CM_HID + (row * 264 + 32 * ks + 8 * kg) * 2);
                const bf16x8v b = *(const bf16x8v*)(W2T + (size_t)(wid * 16 + row) * 256 + 32 * ks + 8 * kg);
                o = __builtin_amdgcn_mfma_f32_16x16x32_bf16(a, b, o, 0, 0, 0);
            }
            const int d = wid * 16 + row;
#pragma unroll
            for (int i = 0; i < 4; ++i) {
                const int c = c0 + 4 * kg + i; const float v = c < NCMP ? o[i] : 0.f;
                ((float*)(ws + (kv ? WS_VCMP : WS_KCMP)))[((size_t)bh * 256 + c) * 64 + d] = v;
                if (kv) ((bf16_t*)(ws + R_VCT))[((size_t)bh * 64 + d) * 256 + c] = f2bf(v);
                else    ((bf16_t*)(ws + R_KCB))[((size_t)bh * 256 + c) * 64 + d] = f2bf(v);
            }
        }
    }
    __syncthreads();
}
DI void p2_vtranspose(const Params& p, LAS3 unsigned char* lds, int G) {
    unsigned char* ws = p.ws;
    const int tid = threadIdx.x;
    LAS3 bf16_t* tl = (LAS3 bf16_t*)lds;
    for (int u = blockIdx.x; u < 1024; u += G) {
        const int which = u >> 9, bh = (u >> 6) & 7, tt = u & 63;
        const bf16_t* src = (const bf16_t*)(ws + (which ? R_VW : R_VS)) + ((size_t)bh * T_ + tt * 64) * HD;
        bf16_t* dst = (bf16_t*)(ws + (which ? R_VWT : R_VST)) + (size_t)bh * HD * T_ + tt * 64;
        __syncthreads();
        { const int tok = tid >> 3, seg = tid & 7; *(LAS3 u32x4*)(tl + tok * 72 + seg * 8) = *(const u32x4*)(src + (size_t)tok * HD + seg * 8); }
        __syncthreads();
        { const int d = tid >> 3, seg = tid & 7; u32x4 w;
          w.x = (unsigned)tl[(seg * 8 + 0) * 72 + d] | ((unsigned)tl[(seg * 8 + 1) * 72 + d] << 16); w.y = (unsigned)tl[(seg * 8 + 2) * 72 + d] | ((unsigned)tl[(seg * 8 + 3) * 72 + d] << 16);
          w.z = (unsigned)tl[(seg * 8 + 4) * 72 + d] | ((unsigned)tl[(seg * 8 + 5) * 72 + d] << 16); w.w = (unsigned)tl[(seg * 8 + 6) * 72 + d] | ((unsigned)tl[(seg * 8 + 7) * 72 + d] << 16);
          *(u32x4*)(dst + (size_t)d * T_ + seg * 8) = w; }
    }
    __syncthreads();
}
DI int ord_enc(float f) { const int u = __float_as_int(f); return u ^ ((u >> 31) & 0x7fffffff); }
DI float ord_dec(int o) { return __int_as_float(o ^ ((o >> 31) & 0x7fffffff)); }
#define PEER_CE_DESC(a, b) do { const int _hi = max((a), (b)), _lo = min((a), (b)); (a) = _hi; (b) = _lo; } while (0)
#define PEER_CE_ASC(a, b)  do { const int _hi = max((a), (b)), _lo = min((a), (b)); (a) = _lo; (b) = _hi; } while (0)
DI void sort16_desc(int (&x)[16]) {
#pragma unroll
    for (int k = 2; k <= 16; k <<= 1)
#pragma unroll
        for (int j = k >> 1; j > 0; j >>= 1)
#pragma unroll
            for (int i = 0; i < 16; ++i) { const int l = i ^ j; if (l > i) { if ((i & k) == 0) PEER_CE_DESC(x[i], x[l]); else PEER_CE_ASC(x[i], x[l]); } }
}
DI void merge16_desc(int (&a)[16], const int (&b)[16]) {
#pragma unroll
    for (int i = 0; i < 16; ++i) a[i] = max(a[i], b[15 - i]);
#pragma unroll
    for (int j = 8; j > 0; j >>= 1)
#pragma unroll
        for (int i = 0; i < 16; ++i) { const int l = i ^ j; if (l > i) PEER_CE_DESC(a[i], a[l]); }
}
constexpr int PR_KEYS = 0;
constexpr int PR_IDX = 512 * 68 * 4;
constexpr int PR_RS = PR_IDX + 128 * 32 * 4;
constexpr int PR_END = PR_RS + 1024;
static_assert(PR_END <= 160 * 1024 - 256, "PEER LDS map");

struct EpiPeerRoute {
    static constexpr bool PERM = true, AFTER_DRAIN = true;
    const float* ssq1; int* eout; float* gout; float* rs1out;
    DI void fused(const f32x4 (&acc)[2][2][4][2], const pg8::Unit& u, int wr, int wc, int fr, int fq, PG8_LAS unsigned char* lds, int wid, int lane) const {
        const int tid = wid * 64 + lane, head = u.pn;
        LAS3 int* KEYS = (LAS3 int*)(lds + PR_KEYS); LAS3 int* IDX = (LAS3 int*)(lds + PR_IDX); LAS3 float* RS = (LAS3 float*)(lds + PR_RS);
        if (tid < 256) { float s = 0.f; for (int j = 0; j < 16; ++j) s += ssq1[(size_t)j * NTOK + u.pm * 256 + tid]; RS[tid] = rsqrtf(s * (1.0f / DM) + EPS); if (u.pn == 0) rs1out[u.pm * 256 + tid] = RS[tid]; }
#pragma unroll 1
        for (int ai = 0; ai < 2; ++ai) {
            __syncthreads();
#pragma unroll
            for (int bj = 0; bj < 2; ++bj)
#pragma unroll
                for (int m = 0; m < 4; ++m)
#pragma unroll
                    for (int n = 0; n < 2; ++n) {
                        const int rl = 64 * wr + 16 * m + fr, kk0 = 32 * wc + 8 * fq + 4 * n, hl = ((rl * 2 + bj) * 2 + (kk0 >> 6));
                        const f32x4 v = ai == 0 ? acc[0][bj][m][n] : acc[1][bj][m][n];
                        u32x4 kq;
                        kq.x = (unsigned)((ord_enc(v[0]) & ~0x7f) | (127 - (kk0 + 0))); kq.y = (unsigned)((ord_enc(v[1]) & ~0x7f) | (127 - (kk0 + 1)));
                        kq.z = (unsigned)((ord_enc(v[2]) & ~0x7f) | (127 - (kk0 + 2))); kq.w = (unsigned)((ord_enc(v[3]) & ~0x7f) | (127 - (kk0 + 3)));
                        *(LAS3 u32x4*)(KEYS + hl * 68 + (kk0 & 63)) = kq;
                    }
            __syncthreads();
            int top[16];
            {
                LAS3 const int* src = KEYS + tid * 68;
                int t2[16];
#pragma unroll
                for (int q = 0; q < 4; ++q) { const u32x4 w = *(LAS3 const u32x4*)(src + 4 * q); top[4 * q] = (int)w.x; top[4 * q + 1] = (int)w.y; top[4 * q + 2] = (int)w.z; top[4 * q + 3] = (int)w.w; }
                sort16_desc(top);
#pragma unroll 1
                for (int g = 1; g < 4; ++g) {
#pragma unroll
                    for (int q = 0; q < 4; ++q) { const u32x4 w = *(LAS3 const u32x4*)(src + 16 * g + 4 * q); t2[4 * q] = (int)w.x; t2[4 * q + 1] = (int)w.y; t2[4 * q + 2] = (int)w.z; t2[4 * q + 3] = (int)w.w; }
                    sort16_desc(t2);
                    merge16_desc(top, t2);
                }
#pragma unroll
                for (int i = 0; i < 16; ++i) t2[i] = __shfl_xor(top[i], 1);
                merge16_desc(top, t2);
            }
            int s1[16], s2[16];
            {
                const bool isp1 = (lane & 2) != 0;
#pragma unroll
                for (int i = 0; i < 16; ++i) { const int o = __shfl_xor(top[i], 2); s1[i] = isp1 ? o : top[i]; s2[i] = isp1 ? top[i] : o; }
            }
            const int rl = tid >> 2, q4 = tid & 3;
#pragma unroll
            for (int kq = 0; kq < 4; ++kq) if (q4 == kq) {
#pragma unroll
                for (int j = 0; j < 4; ++j) { IDX[rl * 32 + 4 * kq + j] = 127 - (s1[4 * kq + j] & 0x7f); IDX[rl * 32 + 16 + 4 * kq + j] = 127 - (s2[4 * kq + j] & 0x7f); }
            }
            float v1[16], v2[16];
#pragma unroll
            for (int i = 0; i < 16; ++i) { v1[i] = ord_dec(s1[i] & ~0x7f); v2[i] = ord_dec(s2[i] & ~0x7f); }
            int best[16], grp[16];
            {
                int cnt = 0; bool first = true;
#pragma unroll
                for (int a = 0; a < 16; ++a)
#pragma unroll
                    for (int b = 0; b < 16; ++b) if ((a + 1) * (b + 1) <= 16) {
                        grp[cnt & 15] = (ord_enc(v1[a] + v2[b]) & ~0xff) | (255 - (16 * a + b));
                        ++cnt;
                        if ((cnt & 15) == 0) { sort16_desc(grp); if (first) {
#pragma unroll
                                for (int i = 0; i < 16; ++i) best[i] = grp[i];
                                first = false; } else merge16_desc(best, grp); }
                    }
#pragma unroll
                for (int i = 2; i < 16; ++i) grp[i] = (int)0x80000000;
                sort16_desc(grp); merge16_desc(best, grp);
            }
            __syncthreads();
            const float rs1 = RS[128 * ai + rl];
            float gsum = 0.f, gv[16]; int ev[16];
            const float mtop = ord_dec(best[0] & ~0xff) * rs1;
#pragma unroll
            for (int i = 0; i < 16; ++i) {
                const float sc = ord_dec(best[i] & ~0xff) * rs1; gv[i] = __expf(sc - mtop); gsum += gv[i];
                const int ab = 255 - (best[i] & 0xff);
                ev[i] = IDX[rl * 32 + (ab >> 4)] * 128 + IDX[rl * 32 + 16 + (ab & 15)];
            }
            const float ginv = 1.0f / gsum;
            const size_t tok = (size_t)u.pm * 256 + 128 * ai + rl;
#pragma unroll
            for (int kq = 0; kq < 4; ++kq) if (q4 == kq) {
                *(u32x4*)(eout + tok * 128 + head * 16 + 4 * kq) = (u32x4){(unsigned)ev[4 * kq], (unsigned)ev[4 * kq + 1], (unsigned)ev[4 * kq + 2], (unsigned)ev[4 * kq + 3]};
                *(f32x4*)(gout + tok * 128 + head * 16 + 4 * kq) = (f32x4){gv[4 * kq] * ginv, gv[4 * kq + 1] * ginv, gv[4 * kq + 2] * ginv, gv[4 * kq + 3] * ginv};
            }
        }
        __syncthreads();
    }
    DI void operator()(const f32x4 (&)[2][2][4][2], const pg8::Unit&, int, int, int, int) const {}
};
struct SliceOrder : pg8::StaticOrder {
    int slice;
    __device__ bool next(int i, pg8::Unit& u) const { if (i > 0) return false; return pg8::StaticOrder::next(slice, u); }
};
DI void p5_peer_route(const Params& p, LAS3 unsigned char* lds, int G) {
    unsigned char* ws = p.ws;
    pg8::Gemm g{(const bf16_t*)(ws + R_H1B), (const bf16_t*)(ws + WS_WQS), NTOK, 2048, DM};
    EpiPeerRoute E{(const float*)(ws + WS_SSQ1), (int*)(ws + R_EXP), (float*)(ws + R_GSM), (float*)(ws + WS_RS1)};
    const int nslice = (512 + G - 1) / G;
#pragma unroll 1
    for (int s = 0; s < nslice; ++s) {
        SliceOrder S; S.init(NTOK, 2048, G, (int)blockIdx.x); S.slice = s;
        pg8::gemm_phase<EpiPeerRoute, SliceOrder>(lds, g, S, E, nullptr);
        __syncthreads();
    }
}
constexpr float V8_SCALE = 8.0f;
#define I8_LOADROW(E) (*(const u32x2*)(u8 + ((unsigned)(E) * (unsigned)(DM / 2) + (unsigned)(lane * 8))))
DI int i4_dotrow(const u32x2 w, const unsigned (&xq)[4]) {
    int a = __builtin_amdgcn_sdot4((int)((w.x << 4) & 0xF0F0F0F0u), (int)xq[0], 0, false); a = __builtin_amdgcn_sdot4((int)(w.x & 0xF0F0F0F0u), (int)xq[1], a, false);
    a = __builtin_amdgcn_sdot4((int)((w.y << 4) & 0xF0F0F0F0u), (int)xq[2], a, false); a = __builtin_amdgcn_sdot4((int)(w.y & 0xF0F0F0F0u), (int)xq[3], a, false);
    return a;
}
#define I8_DOTROW(W) i4_dotrow((W), xq)
#define I8_ISSUE(SET, EV, J0) do { int ev_ = (EV); asm volatile("" : "+v"(ev_)); _Pragma("unroll") for (int k = 0; k < 16; ++k) { const int e = __builtin_amdgcn_readlane(ev_, (J0) + k); \
        SET[k] = I8_LOADROW(e); } __builtin_amdgcn_sched_barrier(0); } while (0)
#define I8_CONS(SET, P0) do { _Pragma("unroll") for (int k = 0; k < 16; ++k) { \
        part[(P0) + k] = (float)I8_DOTROW(SET[k]); } __builtin_amdgcn_sched_barrier(0); } while (0)
#define I8_RS(M) do { const bool up = (lane & (M)) != 0; _Pragma("unroll") for (int i = 0; i < (M); ++i) { \
        const float send = up ? part[i] : part[i + (M)], keep = up ? part[i + (M)] : part[i]; part[i] = keep + __shfl_xor(send, (M)); } } while (0)
#define V4_ISSUE(SET, EV, J0) do { int ev_ = (EV); asm volatile("" : "+v"(ev_)); _Pragma("unroll") for (int k = 0; k < 16; ++k) { const int e = __builtin_amdgcn_readlane(ev_, (J0) + k); \
        SET[k] = *(const u32x2*)(v8 + ((unsigned)e * (unsigned)(DM / 2) + (unsigned)(lane * 8))); } __builtin_amdgcn_sched_barrier(0); } while (0)
#define V4_CVT(W, B) __builtin_amdgcn_cvt_scalef32_pk_f32_fp4((W), 1.0f, B)
#define V4_FMA(W, I) do { t_[4 * (I)] = __builtin_elementwise_fma(V4_CVT(W, 0), c2, t_[4 * (I)]); \
        t_[4 * (I) + 1] = __builtin_elementwise_fma(V4_CVT(W, 1), c2, t_[4 * (I) + 1]); \
        t_[4 * (I) + 2] = __builtin_elementwise_fma(V4_CVT(W, 2), c2, t_[4 * (I) + 2]); \
        t_[4 * (I) + 3] = __builtin_elementwise_fma(V4_CVT(W, 3), c2, t_[4 * (I) + 3]); } while (0)
#define V4_ROW(SET, CV, J0, K) do { const float c = (CV)[(J0) + (K)]; const f32x2 c2 = {c, c}; const u32x2 w_ = SET[K]; \
        V4_FMA(w_.x, 0); V4_FMA(w_.y, 1); } while (0)
#define V4_CONS(SET, CV, J0) do { f32x2 t_[8]; _Pragma("unroll") for (int i_ = 0; i_ < 8; ++i_) t_[i_] = (f32x2){0.f, 0.f}; V4_ROW(SET, CV, J0, 0); V4_ROW(SET, CV, J0, 1); V4_ROW(SET, CV, J0, 2); V4_ROW(SET, CV, J0, 3); V4_ROW(SET, CV, J0, 4); V4_ROW(SET, CV, J0, 5); \
        V4_ROW(SET, CV, J0, 6); V4_ROW(SET, CV, J0, 7); V4_ROW(SET, CV, J0, 8); V4_ROW(SET, CV, J0, 9); V4_ROW(SET, CV, J0, 10); V4_ROW(SET, CV, J0, 11); \
        V4_ROW(SET, CV, J0, 12); V4_ROW(SET, CV, J0, 13); V4_ROW(SET, CV, J0, 14); V4_ROW(SET, CV, J0, 15); \
        _Pragma("unroll") for (int i_ = 0; i_ < 8; ++i_) acc[i_] += t_[i_]; __builtin_amdgcn_sched_barrier(0); } while (0)
DI void p6fused(const Params& p, LAS3 unsigned char* lds, int G) {
    unsigned char* ws = p.ws;
    const int tid = threadIdx.x, lane = tid & 63, wid = tid >> 6;
    const int gw = blockIdx.x * 8 + wid, nw = G * 8;
    const unsigned char* u8 = (const unsigned char*)(ws + WS_UB); const unsigned char* v8 = (const unsigned char*)(ws + WS_VB);
    const int* eidx = (const int*)(ws + R_EXP); const float* gsm = (const float*)(ws + R_GSM); const float* rs1v = (const float*)(ws + WS_RS1);
    bf16_t* hb = (bf16_t*)(ws + R_H1B); float* rs2 = (float*)(ws + WS_RS2);
    LAS3 float* cl = (LAS3 float*)(lds + wid * 512);
#pragma unroll 1
    for (int tok = gw; tok < NTOK; tok += nw) {
        const int e0 = eidx[(size_t)tok * 128 + lane], e1 = eidx[(size_t)tok * 128 + 64 + lane];
        {
            u32x2 sa[16], sb[16];
            I8_ISSUE(sa, e0, 0);
            I8_ISSUE(sb, e0, 16);
            const u32x4 xa = *(const u32x4*)(hb + (size_t)tok * DM + lane * 16), xb = *(const u32x4*)(hb + (size_t)tok * DM + lane * 16 + 8);
            const float g0 = gsm[(size_t)tok * 128 + lane], g1 = gsm[(size_t)tok * 128 + 64 + lane];
            const float rs1 = rs1v[tok];
            float xf[16];
#pragma unroll
            for (int q = 0; q < 4; ++q) { xf[2 * q] = bflo(xa[q]); xf[2 * q + 1] = bfhi(xa[q]); xf[8 + 2 * q] = bflo(xb[q]); xf[8 + 2 * q + 1] = bfhi(xb[q]); }
            float amax = 0.f;
#pragma unroll
            for (int i = 0; i < 16; ++i) amax = fmaxf(amax, fabsf(xf[i]));
            amax = wave_max(amax);
            const float sx = fmaxf(amax, 1e-20f) * (1.0f / 127.0f), isx = 1.0f / sx;
            unsigned xq[4];
#pragma unroll
            for (int q = 0; q < 2; ++q) {
                unsigned we = 0u, wo = 0u;
#pragma unroll
                for (int b = 0; b < 4; ++b) { we |= ((unsigned)(int)rintf(xf[8 * q + 2 * b] * isx) & 0xffu) << (8 * b); wo |= ((unsigned)(int)rintf(xf[8 * q + 2 * b + 1] * isx) & 0xffu) << (8 * b); }
                xq[2 * q] = we; xq[2 * q + 1] = wo;
            }
            const float scl = rs1 * sx * (1.0f / (16.0f * U4_ISCALE));
            float part[64];
            I8_CONS(sa, 0);  I8_ISSUE(sa, e0, 32);
            I8_CONS(sb, 16); I8_ISSUE(sb, e0, 48);
            I8_CONS(sa, 32); I8_ISSUE(sa, e1, 0);
            I8_CONS(sb, 48); I8_ISSUE(sb, e1, 16);
            I8_RS(32); I8_RS(16); I8_RS(8); I8_RS(4); I8_RS(2); I8_RS(1);
            cl[lane] = g0 * gelu_tanh(part[0] * scl) * (1.0f / V8_SCALE);
            I8_CONS(sa, 0);  I8_ISSUE(sa, e1, 32);
            I8_CONS(sb, 16); I8_ISSUE(sb, e1, 48);
            I8_CONS(sa, 32);
            I8_CONS(sb, 48);
            I8_RS(32); I8_RS(16); I8_RS(8); I8_RS(4); I8_RS(2); I8_RS(1);
            cl[64 + lane] = g1 * gelu_tanh(part[0] * scl) * (1.0f / V8_SCALE);
        }
        {
            u32x2 sa[16], sb[16];
            V4_ISSUE(sa, e0, 0);
            V4_ISSUE(sb, e0, 16);
            LAS3 const float* c0 = cl; LAS3 const float* c1 = cl + 64;
            const u32x4 ha = *(const u32x4*)(hb + (size_t)tok * DM + lane * 16), hc = *(const u32x4*)(hb + (size_t)tok * DM + lane * 16 + 8);
            const f32x4 hv0 = {bflo(ha.x), bfhi(ha.x), bflo(ha.y), bfhi(ha.y)}, hv1 = {bflo(ha.z), bfhi(ha.z), bflo(ha.w), bfhi(ha.w)};
            const f32x4 hv2 = {bflo(hc.x), bfhi(hc.x), bflo(hc.y), bfhi(hc.y)}, hv3 = {bflo(hc.z), bfhi(hc.z), bflo(hc.w), bfhi(hc.w)};
            f32x2 acc[8];
#pragma unroll
            for (int i = 0; i < 8; ++i) acc[i] = (f32x2){0.f, 0.f};
            V4_CONS(sa, c0, 0);  V4_ISSUE(sa, e0, 32);
            V4_CONS(sb, c0, 16); V4_ISSUE(sb, e0, 48);
            V4_CONS(sa, c0, 32); V4_ISSUE(sa, e1, 0);
            V4_CONS(sb, c0, 48); V4_ISSUE(sb, e1, 16);
            V4_CONS(sa, c1, 0);  V4_ISSUE(sa, e1, 32);
            V4_CONS(sb, c1, 16); V4_ISSUE(sb, e1, 48);
            V4_CONS(sa, c1, 32);
            V4_CONS(sb, c1, 48);
            const f32x4 o0 = hv0 + (f32x4){acc[0].x, acc[0].y, acc[1].x, acc[1].y}, o1 = hv1 + (f32x4){acc[2].x, acc[2].y, acc[3].x, acc[3].y};
            const f32x4 o2 = hv2 + (f32x4){acc[4].x, acc[4].y, acc[5].x, acc[5].y}, o3 = hv3 + (f32x4){acc[6].x, acc[6].y, acc[7].x, acc[7].y};
            u32x4 w0, w1;
            w0.x = pk_bf16(o0[0], o0[1]); w0.y = pk_bf16(o0[2], o0[3]); w0.z = pk_bf16(o1[0], o1[1]); w0.w = pk_bf16(o1[2], o1[3]);
            w1.x = pk_bf16(o2[0], o2[1]); w1.y = pk_bf16(o2[2], o2[3]); w1.z = pk_bf16(o3[0], o3[1]); w1.w = pk_bf16(o3[2], o3[3]);
            *(u32x4*)(hb + (size_t)tok * DM + lane * 16) = w0; *(u32x4*)(hb + (size_t)tok * DM + lane * 16 + 8) = w1;
            float ss = 0.f;
#pragma unroll
            for (int j = 0; j < 4; ++j) ss += o0[j] * o0[j] + o1[j] * o1[j] + o2[j] * o2[j] + o3[j] * o3[j];
            ss = wave_sum(ss);
            if (lane == 0) rs2[tok] = rsqrtf(ss * (1.0f / DM) + EPS);
        }
    }
}
#undef I8_ISSUE
#undef I8_CONS
#undef I8_RS
#undef V4_ISSUE
#undef V4_CONS
#undef V4_FMA
#undef V4_ROW
#undef V4_CVT
#undef I8_LOADROW
#undef I8_DOTROW

constexpr int LDS_MISC = 160 * 1024 - 256;
constexpr int LDS_BYTES = 160 * 1024;
constexpr size_t CTL_BAR = 0;
static_assert(XCD_BAR_WORDS * 4 <= 64 * 1024, "control region");

template <class F> struct EpiAdapt {
    static constexpr bool PERM = true, AFTER_DRAIN = false;
    F f;
    DI void operator()(const f32x4 (&acc)[2][2][4][2], const pg8::Unit& u, int wr, int wc, int fr, int fq) const {
        int fr_ = fr, fq_ = fq; asm volatile("" : "+v"(fr_), "+v"(fq_));
        const int row0 = u.pm * 256 + wr * 64 + fr_, col0 = u.pn * 256 + wc * 32 + 8 * fq_;
#pragma unroll
        for (int ai = 0; ai < 2; ++ai)
#pragma unroll
            for (int m = 0; m < 4; ++m) {
                const int row = row0 + ai * 128 + m * 16;
#pragma unroll
                for (int bj = 0; bj < 2; ++bj)
                    f.store8(row, col0 + bj * 128, acc[ai][bj][m][0], acc[ai][bj][m][1]);
            }
    }
};
template <class F> struct EpiAdaptSsq {
    static constexpr bool PERM = true, AFTER_DRAIN = false;
    F f; float* ssq;
    DI void operator()(const f32x4 (&acc)[2][2][4][2], const pg8::Unit& u, int wr, int wc, int fr, int fq) const {
        int fr_ = fr, fq_ = fq; asm volatile("" : "+v"(fr_), "+v"(fq_));
        const int row0 = u.pm * 256 + wr * 64 + fr_, col0 = u.pn * 256 + wc * 32 + 8 * fq_;
#pragma unroll
        for (int ai = 0; ai < 2; ++ai)
#pragma unroll
            for (int m = 0; m < 4; ++m) {
                const int row = row0 + ai * 128 + m * 16;
                float s = 0.f; const float rsc = f.rowscale(row);
#pragma unroll
                for (int bj = 0; bj < 2; ++bj)
                    s += f.store8r(row, col0 + bj * 128, acc[ai][bj][m][0], acc[ai][bj][m][1], rsc);
                s += __shfl_xor(s, 16); s += __shfl_xor(s, 32);
                if (fq_ == 0) ssq[(size_t)(u.pn * 4 + wc) * NTOK + row] = s;
            }
    }
};
struct EpiOutR {
    const bf16_t* xb; bf16_t* h1b;
    DI float rowscale(int) const { return 0.f; }
    DI float store8r(int row, int col, f32x4 v0, f32x4 v1, float) const {
        const size_t o = (size_t)row * DM + col;
        const u32x4 xw = *(const u32x4*)(xb + o);
        v0 += (f32x4){bflo(xw.x), bfhi(xw.x), bflo(xw.y), bfhi(xw.y)}; v1 += (f32x4){bflo(xw.z), bfhi(xw.z), bflo(xw.w), bfhi(xw.w)};
        u32x4 w; w.x = pack2bf(v0[0], v0[1]); w.y = pack2bf(v0[2], v0[3]); w.z = pack2bf(v1[0], v1[1]); w.w = pack2bf(v1[2], v1[3]); *(u32x4*)(h1b + o) = w;
        return ((v0[0] * v0[0] + v0[1] * v0[1]) + (v0[2] * v0[2] + v0[3] * v0[3])) + ((v1[0] * v1[0] + v1[1] * v1[1]) + (v1[2] * v1[2] + v1[3] * v1[3]));
    }
};
struct EpiBf16Plain { bf16_t* C; int ldc;
    DI void store8(int row, int col, f32x4 v0, f32x4 v1) const { u32x4 w; w.x = pack2bf(v0[0], v0[1]); w.y = pack2bf(v0[2], v0[3]); w.z = pack2bf(v1[0], v1[1]); w.w = pack2bf(v1[2], v1[3]); *(u32x4*)(C + (size_t)row * ldc + col) = w; } };
struct EpiGateR {
    const float* rs2; const float* bias; const bf16_t* pp; const bf16_t* h2; bf16_t* h3;
    DI float rowscale(int row) const { return rs2[row]; }
    DI float store8r(int row, int col, f32x4 v0, f32x4 v1, float s) const {
        const size_t o = (size_t)row * DM + col;
        const f32x4 b0 = *(const f32x4*)(bias + col), b1 = *(const f32x4*)(bias + col + 4); const u32x4 pw = *(const u32x4*)(pp + o), hw = *(const u32x4*)(h2 + o);
        float hv[8] = {bflo(hw.x), bfhi(hw.x), bflo(hw.y), bfhi(hw.y), bflo(hw.z), bfhi(hw.z), bflo(hw.w), bfhi(hw.w)};
        const float pv[8] = {bflo(pw.x), bfhi(pw.x), bflo(pw.y), bfhi(pw.y), bflo(pw.z), bfhi(pw.z), bflo(pw.w), bfhi(pw.w)};
        float ss = 0.f;
#pragma unroll
        for (int j = 0; j < 4; ++j) { hv[j] += sigmoidf_(v0[j] * s + b0[j]) * pv[j]; hv[4 + j] += sigmoidf_(v1[j] * s + b1[j]) * pv[4 + j]; }
#pragma unroll
        for (int j = 0; j < 8; ++j) ss += hv[j] * hv[j];
        u32x4 w; w.x = pack2bf(hv[0], hv[1]); w.y = pack2bf(hv[2], hv[3]); w.z = pack2bf(hv[4], hv[5]); w.w = pack2bf(hv[6], hv[7]); *(u32x4*)(h3 + o) = w;
        return ss;
    }
};

struct MegaArgs { Params p; int ph_lo, ph_hi; };

__global__ void __launch_bounds__(MK_THREADS, 2) mega_fwd(MegaArgs args) {
    extern __shared__ __attribute__((aligned(16))) unsigned char lds_raw[];
    LAS unsigned char* lds = (LAS unsigned char*)lds_raw;
    const Params& p = args.p;
    unsigned char* ws = p.ws;
    const int lo = args.ph_lo, hi = args.ph_hi;
    const int G = gridDim.x;
    volatile LAS unsigned* misc = (volatile LAS unsigned*)(lds + LDS_MISC);
    if (threadIdx.x < 64) misc[threadIdx.x] = 0u;
    __syncthreads();
    const XcdBarrier bar = xcd_barrier_post((unsigned*)(ws + WS_CTL), misc);
#define IN(k) (lo <= (k) && (k) < hi)
#define SEAM(k) do { if (IN(k) && IN((k) + 1)) xcd_barrier(bar); } while (0)

    if (IN(0)) p0_prologue(p, lds, G);
    SEAM(0);
    if (IN(1)) {
        pg8::Gemm g{(const bf16_t*)(ws + WS_XB), (const bf16_t*)(ws + WS_WIN), NTOK, NPROJ, DM};
        pg8::StaticOrder S; S.init(NTOK, NPROJ, G, (int)blockIdx.x);
        EpiAdapt<EpiProj> E{{(const float*)(ws + WS_RS0), (bf16_t*)(ws + R_QB), (bf16_t*)(ws + R_KC), (float*)(ws + R_GATE), (bf16_t*)(ws + R_XR), (bf16_t*)(ws + R_XG)}};
        pg8::gemm_phase<EpiAdapt<EpiProj>, pg8::StaticOrder>(lds, g, S, E, nullptr);
        p1_deferred(p, G);
    }
    SEAM(1);
    if (IN(2)) { p2_compress(p, lds, G); p2_vtranspose(p, lds, G); lru_phase<false>(p, lds, G); }
    SEAM(2);
    if (IN(3)) { p3_attention<0>(p, lds, G); lru_phase<true>(p, lds, G); }
    SEAM(3);
    if (IN(4)) {
        pg8::Gemm g{(const bf16_t*)(ws + WS_MIXED), (const bf16_t*)(ws + WS_WOUT), NTOK, DM, DM};
        pg8::StaticOrder S; S.init(NTOK, DM, G, (int)blockIdx.x);
        EpiAdaptSsq<EpiOutR> E{{(const bf16_t*)(ws + WS_XB), (bf16_t*)(ws + R_H1B)}, (float*)(ws + WS_SSQ1)};
        pg8::gemm_phase<EpiAdaptSsq<EpiOutR>, pg8::StaticOrder>(lds, g, S, E, nullptr);
    }
    SEAM(4);
    if (IN(5)) p5_peer_route(p, lds, G);
    SEAM(5);
    if (IN(6)) p6fused(p, lds, G);
    SEAM(6);
    if (IN(7)) {
        {
            pg8::Gemm g{(const bf16_t*)(ws + WS_PB), (const bf16_t*)(ws + WS_WP), NTOK, DM, PLE};
            pg8::StaticOrder S; S.init(NTOK, DM, G, (int)blockIdx.x);
            EpiAdapt<EpiBf16Plain> E{{(bf16_t*)(ws + R_BIG), DM}};
            pg8::gemm_phase<EpiAdapt<EpiBf16Plain>, pg8::StaticOrder>(lds, g, S, E, nullptr);
        }
        __syncthreads();
        {
            pg8::Gemm g{(const bf16_t*)(ws + R_H1B), (const bf16_t*)(ws + WS_WG), NTOK, DM, DM};
            pg8::StaticOrder S; S.init(NTOK, DM, G, (int)blockIdx.x);
            EpiAdaptSsq<EpiGateR> E{{(const float*)(ws + WS_RS2), p.in[I_PLE_BG], (const bf16_t*)(ws + R_BIG), (const bf16_t*)(ws + R_H1B), (bf16_t*)(ws + WS_XB)}, (float*)(ws + WS_SSQ3)};
            pg8::gemm_phase<EpiAdaptSsq<EpiGateR>, pg8::StaticOrder>(lds, g, S, E, nullptr);
        }
    }
    SEAM(7);
    if (IN(8)) p8_final_norm(p, G);
#undef IN
#undef SEAM
}

static int g_grid = 0;
static void launch_mega(hipStream_t st, const Params& p, int lo, int hi) {
    if (g_grid == 0) {
        int dev = 0, cus = 0, per_cu = 0;
        hipGetDevice(&dev); hipDeviceGetAttribute(&cus, hipDeviceAttributeMultiprocessorCount, dev);
        if (hipFuncSetAttribute((const void*)mega_fwd, hipFuncAttributeMaxDynamicSharedMemorySize, LDS_BYTES) != hipSuccess) { fprintf(stderr, "hipFuncSetAttribute failed\n"); g_grid = -1; return; }
        if (hipOccupancyMaxActiveBlocksPerMultiprocessor(&per_cu, (const void*)mega_fwd, MK_THREADS, LDS_BYTES) != hipSuccess || per_cu < 1) { fprintf(stderr, "occupancy query: %d per CU\n", per_cu); }
        (void)hipGetLastError();
        g_grid = cus;
    }
    if (g_grid < 0) return;
    MegaArgs a{}; a.p = p; a.ph_lo = lo; a.ph_hi = hi;
    hipLaunchKernelGGL(mega_fwd, dim3(g_grid), dim3(MK_THREADS), LDS_BYTES, st, a);
}
extern "C" void kernel_launch(void* const* d_in, const int* in_sizes, int n_in, void* d_out, int out_size, void* d_ws, size_t ws_size, hipStream_t stream) {
    if (n_in != 31 || out_size != NTOK * DM || ws_size < WS_END) { fprintf(stderr, "kernel_launch: unexpected shapes (n_in %d out %d ws %zu)\n", n_in, out_size, ws_size); return; }
    Params p{};
    for (int i = 0; i < 31; ++i) p.in[i] = (const float*)d_in[i];
    p.out = (float*)d_out; p.ws = (unsigned char*)d_ws;
    (void)hipMemsetAsync((char*)d_ws + WS_CTL, 0, 16384 + 1024, stream);
    launch_mega(stream, p, 0, 9);
}
```

```cpp
#include <hip/hip_runtime.h>
#include <stdint.h>
#include <stdio.h>

typedef unsigned short bf16_t;
typedef float f32x4 __attribute__((ext_vector_type(4)));
typedef float f32x2 __attribute__((ext_vector_type(2)));
typedef unsigned u32x4 __attribute__((ext_vector_type(4)));
typedef unsigned u32x2 __attribute__((ext_vector_type(2)));
#define DI __device__ __forceinline__

constexpr int NB = 4, T_ = 4096, DM = 1024, NTOK = NB * T_;
constexpr int NH = 8, HD = 64, NKV = 2, GRP = 4, ATTW = 512, KVW = 128, LRUW = 512;
constexpr int INCOLS = 2328, NPROJ = 2560;
constexpr int NCMP = 255, NSEL = 64;
constexpr int PEER_H = 8, PEER_K = 16, PEER_NK = 128;
constexpr int PLE = 256;
constexpr float EPS = 1e-6f;

constexpr int PC_KV = 512, PC_XR = 1280, PC_XG = 1792, PC_GATE = 2304;

constexpr size_t MB = 1024 * 1024;
constexpr size_t WS_CTL   = 0;
constexpr size_t WS_WIN   = 64 * 1024;
constexpr size_t WS_WOUT  = WS_WIN  + (size_t)NPROJ * DM * 2;
constexpr size_t WS_WQS   = WS_WOUT + (size_t)DM * DM * 2;
constexpr size_t WS_WG    = WS_WQS  + (size_t)2048 * DM * 2;
constexpr size_t WS_WP    = WS_WG   + (size_t)DM * DM * 2;
constexpr size_t WS_CW1K  = WS_WP   + (size_t)DM * PLE * 2;
constexpr size_t WS_CW1V  = WS_CW1K + (size_t)256 * 2048 * 2;
constexpr size_t WS_CBK   = WS_CW1V + (size_t)256 * 2048 * 2;
constexpr size_t WS_CBV   = WS_CBK  + 1024;
constexpr size_t WS_RS0   = WS_CBV  + 1024;
constexpr size_t WS_RS2   = WS_RS0  + (size_t)NTOK * 4;
constexpr size_t WS_RS1   = WS_RS2  + (size_t)NTOK * 4;
constexpr size_t WS_SSQ2  = WS_RS1  + (size_t)NTOK * 4;
constexpr size_t WS_SSQ1  = WS_SSQ2 + (size_t)16 * NTOK * 4;
constexpr size_t WS_SSQ3  = WS_SSQ1 + (size_t)16 * NTOK * 4;
constexpr size_t WS_KCMP  = WS_SSQ3 + (size_t)16 * NTOK * 4;
constexpr size_t WS_VCMP  = WS_KCMP + (size_t)8 * 256 * 64 * 4;
constexpr size_t WS_LRUP  = WS_VCMP + (size_t)8 * 256 * 64 * 4;
constexpr size_t WS_LRUH  = WS_LRUP + (size_t)256 * 512 * 4;
constexpr size_t WS_WAT   = WS_LRUH + (size_t)256 * 512 * 4;
constexpr size_t WS_WXT   = WS_WAT + 8 * 64 * 64 * 2;
constexpr size_t WS_CW2K  = WS_WXT + 8 * 64 * 64 * 2;
constexpr size_t WS_CW2V  = WS_CW2K + 64 * 256 * 2;
constexpr size_t WS_HID   = WS_CW2V + 64 * 256 * 2;
constexpr size_t WS_UB    = (WS_HID + (size_t)2 * 2048 * 256 * 4 + 4095) / 4096 * 4096;
constexpr size_t WS_VB    = WS_UB + (size_t)16384 * DM * 2;
constexpr size_t WS_PB    = WS_VB + (size_t)16384 * DM * 2;
constexpr size_t WS_XB    = WS_PB + (size_t)NTOK * PLE * 2;
constexpr size_t WS_R     = WS_XB + (size_t)NTOK * DM * 2;
constexpr size_t KVT = (size_t)NB * NKV * T_ * HD * 2 + 65536;
constexpr size_t R_QB    = WS_R;
constexpr size_t R_KC    = R_QB + (size_t)NTOK * 512 * 2;
constexpr size_t R_VC    = R_KC + KVT;
constexpr size_t R_KS    = R_VC + KVT;
constexpr size_t R_VS    = R_KS + KVT;
constexpr size_t R_KW    = R_VS + KVT;
constexpr size_t R_VW    = R_KW + KVT;
constexpr size_t R_GATE  = R_VW + KVT;
constexpr size_t R_XR    = R_GATE + (size_t)NTOK * 24 * 4;
constexpr size_t R_XG    = R_XR + (size_t)NTOK * 512 * 2;
constexpr size_t R_VST   = R_XG + (size_t)NTOK * 512 * 2;
constexpr size_t R_VWT   = R_VST + KVT;
constexpr size_t R_KCB   = R_VWT + KVT;
constexpr size_t R_VCT   = R_KCB + (size_t)8 * 256 * 64 * 2;
constexpr size_t R_END13 = R_VCT + (size_t)8 * 256 * 64 * 2;
constexpr size_t R_H1B   = WS_R;
constexpr size_t R_EXP   = R_H1B + (size_t)NTOK * DM * 2;
constexpr size_t R_GSM   = R_EXP + (size_t)NTOK * 128 * 4;
constexpr size_t R_COEF  = R_GSM + (size_t)NTOK * 128 * 4;
constexpr size_t R_BIG   = R_COEF + (size_t)NTOK * 128 * 4;
constexpr size_t WS_MIXED = (R_END13 + 4095) / 4096 * 4096;
static_assert(WS_MIXED + (size_t)NTOK * DM * 2 <= R_BIG + 64 * MB, "mixed must fit below the end of region R");
constexpr size_t WS_END  = (R_END13 > R_BIG + 64 * MB ? R_END13 : R_BIG + 64 * MB);
static_assert(WS_END <= 256 * MB, "workspace map exceeds 256 MiB");

DI float bf2f(bf16_t v) { return __uint_as_float((unsigned)v << 16); }
DI bf16_t f2bf(float x) { unsigned u = __float_as_uint(x); u += 0x7fffu + ((u >> 16) & 1u); return (bf16_t)(u >> 16); }
DI unsigned pack2bf(float lo, float hi) { return (unsigned)f2bf(lo) | ((unsigned)f2bf(hi) << 16); }
DI float gelu_tanh(float x) { const float u = 0.7978845608028654f * (x + 0.044715f * x * x * x); return 0.5f * x * (1.0f + tanhf(u)); }
DI float sigmoidf_(float x) { return 1.0f / (1.0f + __expf(-x)); }

__device__ const unsigned char REL_BUCKET_LUT[128] = {
0,1,2,3,4,5,6,7,8,9,10,11,12,13,14,15,16,16,16,17,17,18,18,18,19,19,19,20,20,20,20,21,21,21,21,22,22,22,22,22,23,23,23,23,23,23,24,24,24,24,24,24,25,25,25,25,25,25,25,26,26,26,26,26,26,26,26,27,27,27,27,27,27,27,27,27,27,28,28,28,28,28,28,28,28,28,28,29,29,29,29,29,29,29,29,29,29,29,29,30,30,30,30,30,30,30,30,30,30,30,30,30,30,31,31,31,31,31,31,31,31,31,31,31,31,31,31,31};
DI int rel_bucket(int dist) { dist = dist < 0 ? 0 : dist; return dist >= 128 ? 31 : (int)REL_BUCKET_LUT[dist]; }

struct Params {
    const float* in[31];
    float* out;
    unsigned char* ws;
};
enum { I_X = 0, I_P, I_ATTN_NORM, I_W_IN, I_CK_PE, I_CK_W1, I_CK_W2, I_CV_PE, I_CV_W1, I_CV_W2, I_REL, I_CONV_W, I_CONV_B, I_LRU_WA, I_LRU_BA, I_LRU_WX, I_LRU_BX,
       I_LRU_LAM, I_GN_ATTN, I_GN_LRU, I_W_OUT, I_FFN_NORM, I_PEER_WQ, I_PEER_SUB, I_PEER_U, I_PEER_V, I_PLE_NORM, I_PLE_WG, I_PLE_BG, I_PLE_PROJ, I_FINAL_NORM };

struct EpiProj {
    static constexpr bool HAS8 = true;
    const float* rs0; bf16_t* qb; bf16_t* kv0; float* gates; bf16_t* xr; bf16_t* xg;
    DI void store8(int row, int col, f32x4 v0, f32x4 v1) const {
        const float s = rs0[row];
        v0 *= s; v1 *= s;
        const int tl = __builtin_amdgcn_readfirstlane(col >> 8);
        if (tl < 2) { const float qs = 0.125f * 1.4426950408889634f;
            v0 *= qs; v1 *= qs;
            u32x4 w; w.x = pack2bf(v0[0], v0[1]); w.y = pack2bf(v0[2], v0[3]); w.z = pack2bf(v1[0], v1[1]); w.w = pack2bf(v1[2], v1[3]); *(u32x4*)(qb + (size_t)row * 512 + col) = w; }
        else if (tl < 5) {
            const int c = col - PC_KV, tensor = c >> 7, within = c & 127, kvh = within >> 6, d = within & 63, b = row >> 12, t = row & 4095;
            bf16_t* dst = (bf16_t*)((unsigned char*)kv0 + (size_t)tensor * KVT) + ((size_t)(b * NKV + kvh) * T_ + t) * HD + d;
            u32x4 w; w.x = pack2bf(v0[0], v0[1]); w.y = pack2bf(v0[2], v0[3]); w.z = pack2bf(v1[0], v1[1]); w.w = pack2bf(v1[2], v1[3]); *(u32x4*)dst = w;
        }
        else if (tl < 7) { u32x4 w; w.x = pack2bf(v0[0], v0[1]); w.y = pack2bf(v0[2], v0[3]); w.z = pack2bf(v1[0], v1[1]); w.w = pack2bf(v1[2], v1[3]); *(u32x4*)(xr + (size_t)row * 512 + (col - PC_XR)) = w; }
        else if (tl < 9) { u32x4 w; w.x = pack2bf(v0[0], v0[1]); w.y = pack2bf(v0[2], v0[3]); w.z = pack2bf(v1[0], v1[1]); w.w = pack2bf(v1[2], v1[3]); *(u32x4*)(xg + (size_t)row * 512 + (col - PC_XG)) = w; }
        else if (col < PC_GATE + 24) { float* g = gates + (size_t)row * 24 + (col - PC_GATE); *(f32x4*)g = v0; *(f32x4*)(g + 4) = v1; }
    }
};
struct EpiOut {
    const float* x; float* h1; bf16_t* h1b;
    DI void store4(int row, int col, f32x4 v) const {
        const size_t o = (size_t)row * DM + col;
        v += *(const f32x4*)(x + o);
        *(f32x4*)(h1 + o) = v;
        u32x2 w; w.x = pack2bf(v[0], v[1]); w.y = pack2bf(v[2], v[3]); *(u32x2*)(h1b + o) = w;
    }
};
struct EpiF32Plain { float* C; int ldc; int coloff;
    DI void store4(int row, int col, f32x4 v) const { *(f32x4*)(C + (size_t)row * ldc + (col - coloff)) = v; } };
struct EpiGate {
    const float* rs2; const float* bias; const float* pp; float* h;
    DI void store4(int row, int col, f32x4 v) const {
        const size_t o = (size_t)row * DM + col;
        const float s = rs2[row];
        const f32x4 bb = *(const f32x4*)(bias + col), p4 = *(const f32x4*)(pp + o);
        f32x4 hv = *(f32x4*)(h + o);
#pragma unroll
        for (int j = 0; j < 4; ++j) hv[j] += sigmoidf_(v[j] * s + bb[j]) * p4[j];
        *(f32x4*)(h + o) = hv;
    }
};
DI float wave_sum(float v) {
#pragma unroll
    for (int o = 32; o > 0; o >>= 1) v += __shfl_xor(v, o);
    return v;
}
DI float wave_max(float v) {
#pragma unroll
    for (int o = 32; o > 0; o >>= 1) v = fmaxf(v, __shfl_xor(v, o));
    return v;
}
DI float block_sum256(float v, float* red) {
    v = wave_sum(v); __syncthreads();
    if ((threadIdx.x & 63) == 0) red[threadIdx.x >> 6] = v; __syncthreads();
    return (red[0] + red[1]) + (red[2] + red[3]);
}
DI float block_max256(float v, float* red) {
    v = wave_max(v); __syncthreads();
    if ((threadIdx.x & 63) == 0) red[threadIdx.x >> 6] = v; __syncthreads();
    return fmaxf(fmaxf(red[0], red[1]), fmaxf(red[2], red[3]));
}

#define XB_TMO      128
#define XB_XCNT(j)  (256  + 64 * (j))
#define XB_XSUB(j)  (1280 + 64 * (j))
#define XB_XGEN(j)  (2304 + 64 * (j))
#define XB_TOP      3328
#define XB_TOPGEN   3392
#define XCD_BAR_WORDS 3456
#define XB_SPIN_CAP (1u << 18)
#define LAS __attribute__((address_space(3)))

__device__ __forceinline__ unsigned xb_ld(unsigned* p)              { return __hip_atomic_load(p, __ATOMIC_RELAXED, __HIP_MEMORY_SCOPE_AGENT); }
__device__ __forceinline__ unsigned xb_add(unsigned* p, unsigned v) { return __hip_atomic_fetch_add(p, v, __ATOMIC_RELAXED, __HIP_MEMORY_SCOPE_AGENT); }
__device__ __forceinline__ unsigned xb_xcc_id() { return (unsigned)__builtin_amdgcn_s_getreg((3 << 11) | 20) & 0xFu; }
#define XB_SPIN(cond, bar) do { unsigned _sp = 0; while (cond) { __builtin_amdgcn_s_sleep(1); \
    if ((++_sp & 255u) == 0u) { if (xb_ld(&(bar)[XB_TMO])) break; if (_sp > XB_SPIN_CAP) { atomicAdd(&(bar)[XB_TMO], 1u); break; } } } } while (0)

struct XcdBarrier {
    unsigned* bar; unsigned x;
    volatile LAS unsigned* st;
};

__device__ __forceinline__ XcdBarrier xcd_barrier_post(unsigned* bar, volatile LAS unsigned* st) {
    XcdBarrier b; b.bar = bar; b.x = xb_xcc_id(); b.st = st;
    if (threadIdx.x == 0) (void)xb_add(&bar[XB_XCNT(b.x)], 1u);
    return b;
}
__device__ __forceinline__ void xcd_barrier_complete(unsigned* bar, unsigned x, unsigned& nloc, unsigned& nx) {
    const unsigned G = gridDim.x * gridDim.y * gridDim.z;
    unsigned sum, cnt, mine, sp = 0u;
    for (;;) {
        sum = 0u; cnt = 0u; mine = 0u;
#pragma unroll
        for (unsigned j = 0; j < 16; ++j) { const unsigned c = xb_ld(&bar[XB_XCNT(j)]); sum += c; cnt += (c > 0u) ? 1u : 0u; mine = (j == x) ? c : mine; }
        if (sum == G) break;
        __builtin_amdgcn_s_sleep(1);
        if ((++sp & 255u) == 0u) { if (xb_ld(&bar[XB_TMO])) break; if (sp > XB_SPIN_CAP) { atomicAdd(&bar[XB_TMO], 1u); break; } }
    }
    nloc = mine > 0u ? mine : 1u; nx = cnt > 0u ? cnt : 1u;
}

__device__ __forceinline__ void xcd_barrier(const XcdBarrier& b) {
    asm volatile("s_waitcnt vmcnt(0)" ::: "memory");
    __syncthreads();
    if (threadIdx.x == 0) {
        unsigned* bar = b.bar;
        __builtin_amdgcn_s_waitcnt(0);
        unsigned nloc = b.st[0], nx = b.st[1];
        if (nloc == 0u) { xcd_barrier_complete(bar, b.x, nloc, nx); b.st[0] = nloc; b.st[1] = nx; }
        const unsigned old = xb_add(&bar[XB_XSUB(b.x)], 1u);
        const unsigned gen = old / nloc;
        if (old + 1u == (gen + 1u) * nloc) {
            __builtin_amdgcn_fence(__ATOMIC_RELEASE, "agent");
            asm volatile("s_waitcnt vmcnt(0)" ::: "memory");
            const unsigned og = xb_add(&bar[XB_TOP], 1u);
            const unsigned tg = og / nx;
            if (og + 1u == (tg + 1u) * nx) xb_add(&bar[XB_TOPGEN], 1u);
            else XB_SPIN(xb_ld(&bar[XB_TOPGEN]) == tg, bar);
            __builtin_amdgcn_fence(__ATOMIC_ACQUIRE, "agent");
            xb_add(&bar[XB_XGEN(b.x)], 1u);
            asm volatile("s_waitcnt vmcnt(0)" ::: "memory");
        } else {
            XB_SPIN(xb_ld(&bar[XB_XGEN(b.x)]) == gen, bar);
            __builtin_amdgcn_fence(__ATOMIC_ACQUIRE, "agent");
            asm volatile("s_waitcnt vmcnt(0)" ::: "memory");
        }
    }
    __syncthreads();
}


namespace pg8 {
#define PG8_LAS __attribute__((address_space(3)))
typedef short bf16x8 __attribute__((ext_vector_type(8)));
constexpr int BM = 256, BK = 64, HALF = 128, HTB = HALF * BK * 2  , STAGE_BYTES = 8 * HTB, NXCD = 8, WGM = 8;

__host__ __device__ __forceinline__ int lds_byte(int r, int c) { const int st = (r >> 4) * 2 + (c >> 5), rr = r & 15, cc = c & 31, ob = rr * 64 + cc * 2; return st * 1024 + (ob ^ (((ob >> 9) & 1) << 5)); }
__host__ __device__ __forceinline__ void stage_rc(int b, int& R, int& C) { const int st = b / 1024, sb = b % 1024, swz = sb ^ (((sb >> 9) & 1) << 5); R = (st >> 1) * 16 + swz / 64; C = (st & 1) * 32 + (swz % 64) / 2; }
__host__ __device__ __forceinline__ int perm32(int rho) { const int n = rho >> 4, i = rho & 15; return 8 * (i >> 2) + 4 * n + (i & 3); }

struct Unit { int pm, pn; };
struct Gemm { const bf16_t* A; const bf16_t* Bt; int M, N, K; };

struct StaticOrder {
    int nM, nN, nwg, G, c;
    __host__ __device__ void init(int M, int N, int G_, int c_) { nM = M / BM; nN = N / BM; nwg = nM * nN; G = G_; c = c_; }
    __host__ __device__ bool next(int i, Unit& u) const {
        const long L = (long)i * G + c; if (L >= nwg) return false;
        int wgid = (int)L; { const int q = nwg / NXCD, r = nwg % NXCD, xcd = wgid % NXCD, off = wgid / NXCD; wgid = (xcd < r ? xcd * (q + 1) : r * (q + 1) + (xcd - r) * q) + off; }
        const int nig = WGM * nN, gid = wgid / nig, fm = gid * WGM, gsz = (nM - fm) < WGM ? (nM - fm) : WGM;
        u.pm = fm + ((wgid % nig) % gsz); u.pn = (wgid % nig) / gsz; return true;
    }
    __device__ __forceinline__ void a_ready(const Unit&) const {}
    __device__ __forceinline__ void done(const Unit&) const {}
};
template <class Epi, class Sched, bool STAMP = false>
__device__ __forceinline__ void gemm_phase(PG8_LAS unsigned char* lds, const Gemm g, const Sched& S, const Epi& E, unsigned long long* stamps) {
    int tid_ = threadIdx.x; asm volatile("" : "+v"(tid_));
    const int tid = tid_, wid = __builtin_amdgcn_readfirstlane(tid >> 6), lane = tid & 63, wr = wid >> 2, wc = wid & 3, fr = lane & 15, fq = lane >> 4;
    const int K = g.K, nt = K / BK;
    int ts_lo = 0, ts_hi = 0, nts = 0; const unsigned long long rt_entry = STAMP ? (unsigned long long)wall_clock64() : 0ull;
#define PG8_STAMP() do { if (STAMP && wid == 0 && nts < 64) { const unsigned long long _c = (unsigned long long)clock64(); \
        ts_lo = (lane == nts) ? (int)(unsigned)_c : ts_lo; ts_hi = (lane == nts) ? (int)(unsigned)(_c >> 32) : ts_hi; ++nts; } } while (0)
    PG8_STAMP();
    unsigned voffA[2], voffB[2];
#pragma unroll
    for (int i = 0; i < 2; ++i) { int R, C; stage_rc(tid * 16 + i * 8192, R, C); const int Rb = Epi::PERM ? ((R & ~31) + perm32(R & 31)) : R;
        voffA[i] = (unsigned)(R * K + C) * 2u; voffB[i] = (unsigned)(Rb * K + C) * 2u; }
    const size_t kstep = (size_t)(BK * 2);
    const size_t hstep = (size_t)HALF * K * 2;
    const size_t tstep = 2 * hstep;
    const unsigned ldsw = (unsigned)wid * 1024u;
    const int aoff = lds_byte(wr * 64 + fr, fq * 8), boff = lds_byte(wc * 32 + fr, fq * 8);
#define PG8_SA(b, h) (((b) * 2 + (h)) * HTB)
#define PG8_SB(b, h) ((4 + (b) * 2 + (h)) * HTB)
#define PG8_STAGE(bufoff, gbase, voff) do { _Pragma("unroll") for (int _i = 0; _i < 2; ++_i) \
        __builtin_amdgcn_global_load_lds((const unsigned*)((const char*)(gbase) + (voff)[_i]), (PG8_LAS unsigned*)(lds + (bufoff) + ldsw + _i * 8192), 16, 0, 0); } while (0)
#define PG8_LDA(dst, b, h) do { _Pragma("unroll") for (int m = 0; m < 4; ++m) _Pragma("unroll") for (int k = 0; k < 2; ++k) dst[m][k] = *(const PG8_LAS bf16x8*)(lds + PG8_SA(b, h) + aoff + m * 2048 + k * 1024); } while (0)
#define PG8_LDB(dst, b, h) do { _Pragma("unroll") for (int n = 0; n < 2; ++n) _Pragma("unroll") for (int k = 0; k < 2; ++k) dst[n][k] = *(const PG8_LAS bf16x8*)(lds + PG8_SB(b, h) + boff + n * 2048 + k * 1024); } while (0)
#define PG8_MMA(ai, bj, At, Bt) do { __builtin_amdgcn_s_setprio(1); _Pragma("unroll") for (int m = 0; m < 4; ++m) _Pragma("unroll") for (int n = 0; n < 2; ++n) _Pragma("unroll") for (int k = 0; k < 2; ++k) \
        acc[ai][bj][m][n] = __builtin_amdgcn_mfma_f32_16x16x32_bf16(Bt[n][k], At[m][k], acc[ai][bj][m][n], 0, 0, 0); __builtin_amdgcn_s_setprio(0); } while (0)
#define PG8_WAIT_V(n) asm volatile("s_waitcnt vmcnt(" #n ")" ::: "memory")
#define PG8_WAIT_L(n) asm volatile("s_waitcnt lgkmcnt(" #n ")" ::: "memory")
#define PG8_BAR __builtin_amdgcn_s_barrier()
#define PG8_SCHED __builtin_amdgcn_sched_barrier(0)
    Unit cur, nxt; int ui = 0;
    if (!S.next(0, cur)) return;
    f32x4 acc[2][2][4][2];
#pragma unroll
    for (int a = 0; a < 2; ++a)
#pragma unroll
        for (int b = 0; b < 2; ++b)
#pragma unroll
            for (int m = 0; m < 4; ++m)
#pragma unroll
                for (int n = 0; n < 2; ++n) acc[a][b][m][n] = (f32x4){0.f, 0.f, 0.f, 0.f};
    bf16x8 At[4][2], B0[2][2], B1[2][2];
    const char* cA = (const char*)g.A + (size_t)cur.pm * tstep; const char* cB = (const char*)g.Bt + (size_t)cur.pn * tstep;
    S.a_ready(cur);
    PG8_STAGE(PG8_SB(0, 0), cB, voffB); PG8_STAGE(PG8_SA(0, 0), cA, voffA); PG8_STAGE(PG8_SB(0, 1), cB + hstep, voffB); PG8_STAGE(PG8_SA(0, 1), cA + hstep, voffA);
    if (wr == 1) PG8_BAR;
    PG8_WAIT_V(4); PG8_BAR;
    PG8_STAGE(PG8_SB(1, 0), cB + kstep, voffB); PG8_STAGE(PG8_SA(1, 0), cA + kstep, voffA); PG8_STAGE(PG8_SB(1, 1), cB + hstep + kstep, voffB);
    PG8_WAIT_V(6); PG8_BAR;
    PG8_STAMP();
    for (;;) {
        const bool has_next = S.next(ui + 1, nxt);
        const char* nA = has_next ? (const char*)g.A + (size_t)nxt.pm * tstep : cA; const char* nB = has_next ? (const char*)g.Bt + (size_t)nxt.pn * tstep : cB;
        for (int t = 0; t < nt; t += 2) {
            const bool last = (t == nt - 2);
            const char* a1 = cA + (size_t)(t + 1) * kstep;
            const char* a2 = last ? nA : cA + (size_t)(t + 2) * kstep; const char* b2 = last ? nB : cB + (size_t)(t + 2) * kstep;
            const char* a3 = a2 + kstep; const char* b3 = b2 + kstep;
            if (last && has_next) S.a_ready(nxt);
            PG8_LDB(B0, 0, 0); PG8_SCHED; PG8_LDA(At, 0, 0); PG8_STAGE(PG8_SA(1, 1), a1 + hstep, voffA);
            PG8_WAIT_L(8); PG8_BAR; PG8_WAIT_L(0); PG8_MMA(0, 0, At, B0); PG8_BAR; PG8_SCHED;
            PG8_LDB(B1, 0, 1); PG8_STAGE(PG8_SB(0, 0), b2, voffB);
            PG8_BAR; PG8_WAIT_L(0); PG8_MMA(0, 1, At, B1); PG8_BAR;
            PG8_LDA(At, 0, 1); PG8_STAGE(PG8_SA(0, 0), a2, voffA);
            PG8_BAR; PG8_WAIT_L(0); PG8_MMA(1, 0, At, B0); PG8_BAR; PG8_SCHED;
            PG8_STAGE(PG8_SB(0, 1), b2 + hstep, voffB);
            PG8_WAIT_V(6); PG8_BAR; PG8_MMA(1, 1, At, B1); PG8_BAR;
            PG8_LDB(B0, 1, 0); PG8_SCHED; PG8_LDA(At, 1, 0); PG8_STAGE(PG8_SA(0, 1), a2 + hstep, voffA);
            PG8_WAIT_L(8); PG8_BAR; PG8_WAIT_L(0); PG8_MMA(0, 0, At, B0); PG8_BAR; PG8_SCHED;
            PG8_LDB(B1, 1, 1); PG8_STAGE(PG8_SB(1, 0), b3, voffB);
            PG8_BAR; PG8_WAIT_L(0); PG8_MMA(0, 1, At, B1); PG8_BAR;
            PG8_LDA(At, 1, 1); PG8_STAGE(PG8_SA(1, 0), a3, voffA);
            PG8_BAR; PG8_WAIT_L(0); PG8_MMA(1, 0, At, B0); PG8_BAR; PG8_SCHED;
            PG8_STAGE(PG8_SB(1, 1), b3 + hstep, voffB);
            PG8_WAIT_V(6); PG8_BAR; PG8_MMA(1, 1, At, B1); PG8_BAR;
        }
        PG8_STAMP();
        if constexpr (!Epi::AFTER_DRAIN) { E(acc, cur, wr, wc, fr, fq); S.done(cur); }
        PG8_STAMP();
        if (!has_next) break;
#pragma unroll
        for (int a = 0; a < 2; ++a)
#pragma unroll
            for (int b = 0; b < 2; ++b)
#pragma unroll
                for (int m = 0; m < 4; ++m)
#pragma unroll
                    for (int n = 0; n < 2; ++n) acc[a][b][m][n] = (f32x4){0.f, 0.f, 0.f, 0.f};
        cur = nxt; cA = nA; cB = nB; ++ui;
    }
    PG8_WAIT_V(0);
    if (wr == 0) PG8_BAR;
    PG8_BAR;
    if constexpr (Epi::AFTER_DRAIN) { E.fused(acc, cur, wr, wc, fr, fq, lds, wid, lane); S.done(cur); }
    PG8_STAMP();
    if (STAMP && wid == 0) { stamps[lane] = lane < nts ? (((unsigned long long)(unsigned)ts_hi << 32) | (unsigned)ts_lo) : 0ull;
        if (lane == 62) stamps[62] = rt_entry; if (lane == 63) stamps[63] = (unsigned long long)wall_clock64(); }
#undef PG8_STAMP
#undef PG8_SA
#undef PG8_SB
#undef PG8_STAGE
#undef PG8_LDA
#undef PG8_LDB
#undef PG8_MMA
#undef PG8_WAIT_V
#undef PG8_WAIT_L
#undef PG8_BAR
#undef PG8_SCHED
}
}
#define LAS3 __attribute__((address_space(3)))
constexpr int MK_THREADS = 512;
constexpr float U4_ISCALE = 83.0f;
typedef __bf16 bf16x2_t __attribute__((ext_vector_type(2)));
DI float dot2bf(unsigned a, unsigned b, float c) { return __builtin_amdgcn_fdot2_f32_bf16(__builtin_bit_cast(bf16x2_t, a), __builtin_bit_cast(bf16x2_t, b), c, false); }
DI float bflo(unsigned v) { return __uint_as_float(v << 16); }
DI float bfhi(unsigned v) { return __uint_as_float(v & 0xffff0000u); }

template <class ColMap>
DI void transpose_tile(const float* __restrict__ src, int ldsrc, const float* __restrict__ gain, bf16_t* __restrict__ dst, int K, int k0, int n0, const ColMap& cm, LAS3 float* tl) {
    const int tid = threadIdx.x;
    __syncthreads();
    {
        const int n = tid & 63, sc = cm(n0 + n);
#pragma unroll
        for (int j = 0; j < 8; ++j) { const int k = (tid >> 6) + 8 * j; tl[k * 65 + n] = sc >= 0 ? src[(size_t)(k0 + k) * ldsrc + sc] * (gain ? gain[k0 + k] : 1.0f) : 0.f; }
    }
    __syncthreads();
    {
        const int n = tid >> 3, k8 = (tid & 7) * 8;
        u32x4 w;
        w.x = pack2bf(tl[(k8 + 0) * 65 + n], tl[(k8 + 1) * 65 + n]); w.y = pack2bf(tl[(k8 + 2) * 65 + n], tl[(k8 + 3) * 65 + n]);
        w.z = pack2bf(tl[(k8 + 4) * 65 + n], tl[(k8 + 5) * 65 + n]); w.w = pack2bf(tl[(k8 + 6) * 65 + n], tl[(k8 + 7) * 65 + n]);
        *(u32x4*)(dst + (size_t)(n0 + n) * K + k0 + k8) = w;
    }
}
struct ColId { DI int operator()(int n) const { return n; } };
struct ColWin { DI int operator()(int n) const { return n < PC_XR ? n : (n < PC_XG ? 1304 + (n - PC_XR) : (n < PC_GATE ? 1816 + (n - PC_XG) : (n < PC_GATE + 24 ? 1280 + (n - PC_GATE) : -1))); } };

DI void cvt_rows_bf16(const float* __restrict__ src, const float* __restrict__ gain, bf16_t* __restrict__ dst, size_t n8, int cols, size_t gtid, size_t nthr) {
    for (size_t i0 = gtid; i0 < n8; i0 += 8 * nthr) {
        f32x4 a[8], b[8];
#pragma unroll
        for (int u = 0; u < 8; ++u) { const size_t i = i0 + u * nthr; if (i < n8) { a[u] = *(const f32x4*)(src + i * 8); b[u] = *(const f32x4*)(src + i * 8 + 4); } }
#pragma unroll
        for (int u = 0; u < 8; ++u) { const size_t i = i0 + u * nthr; if (i < n8) {
            f32x4 x = a[u], y = b[u];
            if (gain) { const int c = (int)((i * 8) % cols); x *= *(const f32x4*)(gain + c); y *= *(const f32x4*)(gain + c + 4); }
            u32x4 w; w.x = pack2bf(x[0], x[1]); w.y = pack2bf(x[2], x[3]); w.z = pack2bf(y[0], y[1]); w.w = pack2bf(y[2], y[3]);
            *(u32x4*)(dst + i * 8) = w; } }
    }
}
DI void cvt_rows_i4(const float* __restrict__ src, const float* __restrict__ gain, float scale, unsigned char* __restrict__ dst, size_t n8, int cols, size_t gtid, size_t nthr) {
    for (size_t i0 = gtid; i0 < n8; i0 += 8 * nthr) {
        f32x4 a[8], b[8];
#pragma unroll
        for (int u = 0; u < 8; ++u) { const size_t i = i0 + u * nthr; if (i < n8) { a[u] = *(const f32x4*)(src + i * 8); b[u] = *(const f32x4*)(src + i * 8 + 4); } }
#pragma unroll
        for (int u = 0; u < 8; ++u) { const size_t i = i0 + u * nthr; if (i < n8) {
            f32x4 x = a[u], y = b[u];
            if (gain) { const int c = (int)((i * 8) % cols); x *= *(const f32x4*)(gain + c); y *= *(const f32x4*)(gain + c + 4); }
            unsigned w = 0u;
#pragma unroll
            for (int j = 0; j < 4; ++j) {
                const int qa = (int)rintf(fminf(fmaxf(x[j] * scale, -7.f), 7.f)), qb = (int)rintf(fminf(fmaxf(y[j] * scale, -7.f), 7.f));
                w |= ((unsigned)qa & 0xfu) << (4 * j); w |= ((unsigned)qb & 0xfu) << (16 + 4 * j);
            }
            { const unsigned n1 = __shfl_down(w, 1), n2 = __shfl_down(w, 2), n3 = __shfl_down(w, 3); if ((threadIdx.x & 3) == 0) *(u32x4*)(dst + i * 4) = (u32x4){w, n1, n2, n3}; } } }
    }
}
DI void cvt_rows_fp4(const float* __restrict__ src, const float* __restrict__ gain, float scale, unsigned char* __restrict__ dst, size_t n8, int cols, size_t gtid, size_t nthr) {
    for (size_t i0 = gtid; i0 < n8; i0 += 8 * nthr) {
        f32x4 a[8], b[8];
#pragma unroll
        for (int u = 0; u < 8; ++u) { const size_t i = i0 + u * nthr; if (i < n8) { a[u] = *(const f32x4*)(src + i * 8); b[u] = *(const f32x4*)(src + i * 8 + 4); } }
#pragma unroll
        for (int u = 0; u < 8; ++u) { const size_t i = i0 + u * nthr; if (i < n8) {
            f32x4 x = a[u], y = b[u];
            if (gain) { const int c = (int)((i * 8) % cols); x *= *(const f32x4*)(gain + c); y *= *(const f32x4*)(gain + c + 4); }
            x *= scale; y *= scale;
            unsigned w = 0u;
            w = __builtin_amdgcn_cvt_scalef32_pk_fp4_f32(w, x[0], x[1], 1.0f, 0); w = __builtin_amdgcn_cvt_scalef32_pk_fp4_f32(w, x[2], x[3], 1.0f, 1);
            w = __builtin_amdgcn_cvt_scalef32_pk_fp4_f32(w, y[0], y[1], 1.0f, 2); w = __builtin_amdgcn_cvt_scalef32_pk_fp4_f32(w, y[2], y[3], 1.0f, 3);
            { const unsigned n1 = __shfl_down(w, 1), n2 = __shfl_down(w, 2), n3 = __shfl_down(w, 3); if ((threadIdx.x & 3) == 0) *(u32x4*)(dst + i * 4) = (u32x4){w, n1, n2, n3}; } } }
    }
}
DI void p1_deferred(const Params& p, int G) {
    const int nunits = (NTOK / 256) * (NPROJ / 256), nfull = nunits % G;
    const int first = nfull == 0 ? 0 : nfull, nwg = G - first;
    if ((int)blockIdx.x < first) return;
    const size_t gtid = (size_t)(blockIdx.x - first) * MK_THREADS + threadIdx.x, nthr = (size_t)nwg * MK_THREADS;
    cvt_rows_i4(p.in[I_PEER_U], p.in[I_FFN_NORM], U4_ISCALE, (unsigned char*)(p.ws + WS_UB), (size_t)16384 * DM / 8, DM, gtid, nthr);
    cvt_rows_bf16(p.in[I_P], nullptr, (bf16_t*)(p.ws + WS_PB), (size_t)NTOK * PLE / 8, PLE, gtid, nthr);
}
DI void p0_prologue(const Params& p, LAS3 unsigned char* lds, int G) {
    unsigned char* ws = p.ws;
    const int tid = threadIdx.x, lane = tid & 63, wid = tid >> 6, bid = blockIdx.x;
    const size_t gtid = (size_t)bid * MK_THREADS + tid, nthr = (size_t)G * MK_THREADS;
    const int gw = bid * 8 + wid, nw = G * 8;
    {
        const float* x = p.in[I_X]; bf16_t* xb = (bf16_t*)(ws + WS_XB); float* rs0 = (float*)(ws + WS_RS0);
        for (int row0 = gw; row0 < NTOK; row0 += 4 * nw) {
            f32x4 v[4][4];
#pragma unroll
            for (int u = 0; u < 4; ++u) { const int row = row0 + u * nw; if (row < NTOK) { const float* xr_ = x + (size_t)row * DM + lane * 8;
                v[u][0] = *(const f32x4*)xr_; v[u][1] = *(const f32x4*)(xr_ + 4); v[u][2] = *(const f32x4*)(xr_ + 512); v[u][3] = *(const f32x4*)(xr_ + 516); } }
#pragma unroll
            for (int u = 0; u < 4; ++u) { const int row = row0 + u * nw; if (row < NTOK) {
                float s = 0.f;
#pragma unroll
                for (int j = 0; j < 4; ++j) s += (v[u][j][0] * v[u][j][0] + v[u][j][1] * v[u][j][1]) + (v[u][j][2] * v[u][j][2] + v[u][j][3] * v[u][j][3]);
                s = wave_sum(s);
                u32x4 w0, w1;
                w0.x = pack2bf(v[u][0][0], v[u][0][1]); w0.y = pack2bf(v[u][0][2], v[u][0][3]); w0.z = pack2bf(v[u][1][0], v[u][1][1]); w0.w = pack2bf(v[u][1][2], v[u][1][3]);
                w1.x = pack2bf(v[u][2][0], v[u][2][1]); w1.y = pack2bf(v[u][2][2], v[u][2][3]); w1.z = pack2bf(v[u][3][0], v[u][3][1]); w1.w = pack2bf(v[u][3][2], v[u][3][3]);
                *(u32x4*)(xb + (size_t)row * DM + lane * 8) = w0; *(u32x4*)(xb + (size_t)row * DM + 512 + lane * 8) = w1;
                if (lane == 0) rs0[row] = rsqrtf(s * (1.0f / DM) + EPS); } }
        }
    }
    cvt_rows_fp4(p.in[I_PEER_V], nullptr, 8.0f, (unsigned char*)(ws + WS_VB), (size_t)16384 * DM / 8, DM, gtid, nthr);
    LAS3 float* tl = (LAS3 float*)lds;
    {
        for (int u = bid; u < 1496; u += G) {
            if (u < 640) transpose_tile(p.in[I_W_IN], INCOLS, p.in[I_ATTN_NORM], (bf16_t*)(ws + WS_WIN), DM, (u % 16) * 64, (u / 16) * 64, ColWin{}, tl);
            else if (u < 896) { const int v = u - 640; transpose_tile(p.in[I_W_OUT], DM, nullptr, (bf16_t*)(ws + WS_WOUT), DM, (v % 16) * 64, (v / 16) * 64, ColId{}, tl); }
            else if (u < 1152) { const int v = u - 896; transpose_tile(p.in[I_PLE_WG], DM, p.in[I_PLE_NORM], (bf16_t*)(ws + WS_WG), DM, (v % 16) * 64, (v / 16) * 64, ColId{}, tl); }
            else if (u < 1216) { const int v = u - 1152; transpose_tile(p.in[I_PLE_PROJ], DM, nullptr, (bf16_t*)(ws + WS_WP), PLE, (v % 4) * 64, (v / 4) * 64, ColId{}, tl); }
            else if (u < 1344) { const int v = u - 1216; transpose_tile(p.in[I_CK_W1], 256, nullptr, (bf16_t*)(ws + WS_CW1K), 2048, (v % 32) * 64, (v / 32) * 64, ColId{}, tl); }
            else if (u < 1472) { const int v = u - 1344; transpose_tile(p.in[I_CV_W1], 256, nullptr, (bf16_t*)(ws + WS_CW1V), 2048, (v % 32) * 64, (v / 32) * 64, ColId{}, tl); }
            else if (u < 1480) { const int v = u - 1472; transpose_tile(p.in[I_LRU_WA] + v * 4096, 64, nullptr, (bf16_t*)(ws + WS_WAT) + v * 4096, 64, 0, 0, ColId{}, tl); }
            else if (u < 1488) { const int v = u - 1480; transpose_tile(p.in[I_LRU_WX] + v * 4096, 64, nullptr, (bf16_t*)(ws + WS_WXT) + v * 4096, 64, 0, 0, ColId{}, tl); }
            else if (u < 1492) { const int v = u - 1488; transpose_tile(p.in[I_CK_W2], 64, nullptr, (bf16_t*)(ws + WS_CW2K), 256, v * 64, 0, ColId{}, tl); }
            else { const int v = u - 1492; transpose_tile(p.in[I_CV_W2], 64, nullptr, (bf16_t*)(ws + WS_CW2V), 256, v * 64, 0, ColId{}, tl); }
        }
        __syncthreads();
    }
    {
        LAS3 float* wt = (LAS3 float*)lds;
        LAS3 float* st = (LAS3 float*)(lds + 32768);
        const float* wq = p.in[I_PEER_WQ]; const float* sub = p.in[I_PEER_SUB]; const float* gain = p.in[I_FFN_NORM]; bf16_t* WqsT = (bf16_t*)(ws + WS_WQS);
        for (int u = bid; u < 256; u += G) {
            const int hp = u >> 4, d0 = (u & 15) * 64, pp = hp & 1;
            __syncthreads();
            {
                f32x4 wv[4], sv[8];
#pragma unroll
                for (int u = 0; u < 4; ++u) { const int i = tid + u * MK_THREADS, d = i >> 5, dk4 = (i & 31) * 4; wv[u] = *(const f32x4*)(wq + (size_t)(d0 + d) * 2048 + hp * 128 + dk4); }
#pragma unroll
                for (int u = 0; u < 8; ++u) { const int i = tid + u * MK_THREADS, kk = i >> 5, dk4 = (i & 31) * 4; sv[u] = *(const f32x4*)(sub + ((size_t)pp * 128 + kk) * 128 + dk4); }
#pragma unroll
                for (int u = 0; u < 4; ++u) { const int i = tid + u * MK_THREADS, d = i >> 5, dk4 = (i & 31) * 4;
#pragma unroll
                    for (int j = 0; j < 4; ++j) wt[(dk4 + j) * 64 + d] = wv[u][j]; }
#pragma unroll
                for (int u = 0; u < 8; ++u) { const int i = tid + u * MK_THREADS, kk = i >> 5, dk4 = (i & 31) * 4;
#pragma unroll
                    for (int j = 0; j < 4; ++j) st[kk * 129 + dk4 + j] = sv[u][j]; }
            }
            __syncthreads();
            const int kk = tid & 127, dg = (tid >> 7) * 16;
            float acc[16];
#pragma unroll
            for (int j = 0; j < 16; ++j) acc[j] = 0.f;
            for (int dk = 0; dk < 128; ++dk) {
                const float sv = st[kk * 129 + dk];
#pragma unroll
                for (int j4 = 0; j4 < 4; ++j4) { const f32x4 w4 = *(LAS3 f32x4*)(wt + dk * 64 + dg + j4 * 4);
#pragma unroll
                    for (int j = 0; j < 4; ++j) acc[j4 * 4 + j] += sv * w4[j]; }
            }
            u32x4 o0, o1;
#define GQ(j) (acc[j] * gain[d0 + dg + (j)])
            o0.x = pack2bf(GQ(0), GQ(1)); o0.y = pack2bf(GQ(2), GQ(3)); o0.z = pack2bf(GQ(4), GQ(5)); o0.w = pack2bf(GQ(6), GQ(7));
            o1.x = pack2bf(GQ(8), GQ(9)); o1.y = pack2bf(GQ(10), GQ(11)); o1.z = pack2bf(GQ(12), GQ(13)); o1.w = pack2bf(GQ(14), GQ(15));
#undef GQ
            bf16_t* dst = WqsT + (size_t)(hp * 128 + kk) * DM + d0 + dg;
            *(u32x4*)dst = o0; *(u32x4*)(dst + 8) = o1;
        }
        __syncthreads();
    }
    for (int o = gw; o < 512; o += nw) {
        const int kv = o >> 8, j = o & 255;
        const float* pe = p.in[kv ? I_CV_PE : I_CK_PE]; const float* w1 = p.in[kv ? I_CV_W1 : I_CK_W1];
        float acc = 0.f;
        for (int k = lane; k < 2048; k += 64) acc += pe[k] * w1[(size_t)k * 256 + j];
        acc = wave_sum(acc);
        if (lane == 0) ((float*)(ws + (kv ? WS_CBV : WS_CBK)))[j] = acc;
    }
}

DI void p6_peer_apply(const Params& p, int G) {
    unsigned char* ws = p.ws;
    const int tid = threadIdx.x, lane = tid & 63, wid = tid >> 6;
    const int gw = blockIdx.x * 8 + wid, nw = G * 8;
    const bf16_t* ub = (const bf16_t*)(ws + WS_UB); const bf16_t* vb = (const bf16_t*)(ws + WS_VB);
    const int* eidx = (const int*)(ws + R_EXP); const float* gsm = (const float*)(ws + R_GSM); const float* ssq1 = (const float*)(ws + WS_SSQ1);
    float* h = p.out; bf16_t* hb = (bf16_t*)(ws + R_H1B); float* rs2 = (float*)(ws + WS_RS2);
    for (int tok = gw; tok < NTOK; tok += nw) {
        float sq = lane < 16 ? ssq1[(size_t)lane * NTOK + tok] : 0.f;
        sq = wave_sum(sq);
        const float rs1 = rsqrtf(sq * (1.0f / DM) + EPS);
        const u32x4 xa = *(const u32x4*)(hb + (size_t)tok * DM + lane * 8), xc = *(const u32x4*)(hb + (size_t)tok * DM + 512 + lane * 8);
        const int e0 = eidx[(size_t)tok * 128 + lane], e1 = eidx[(size_t)tok * 128 + 64 + lane];
        const float g0 = gsm[(size_t)tok * 128 + lane], g1 = gsm[(size_t)tok * 128 + 64 + lane];
        float coef0 = 0.f, coef1 = 0.f;
#pragma unroll
        for (int half = 0; half < 2; ++half) {
            const int ev = half ? e1 : e0;
            float part[64];
#pragma unroll
            for (int j = 0; j < 64; ++j) {
                const int e = __builtin_amdgcn_readlane(ev, j);
                const bf16_t* ur = ub + (size_t)e * DM + lane * 8;
                const u32x4 ua = *(const u32x4*)ur, uc = *(const u32x4*)(ur + 512);
                float a = dot2bf(xa.x, ua.x, 0.f); a = dot2bf(xa.y, ua.y, a); a = dot2bf(xa.z, ua.z, a); a = dot2bf(xa.w, ua.w, a);
                a = dot2bf(xc.x, uc.x, a); a = dot2bf(xc.y, uc.y, a); a = dot2bf(xc.z, uc.z, a); a = dot2bf(xc.w, uc.w, a);
                part[j] = a;
            }
#pragma unroll
            for (int m = 32; m >= 1; m >>= 1) {
                const bool up = (lane & m) != 0;
#pragma unroll
                for (int i = 0; i < m; ++i) {
                    const float send = up ? part[i] : part[i + m];
                    const float keep = up ? part[i + m] : part[i];
                    part[i] = keep + __shfl_xor(send, m);
                }
            }
            const float act = gelu_tanh(part[0] * rs1);
            if (half) coef1 = g1 * act; else coef0 = g0 * act;
        }
        float acc[16];
#pragma unroll
        for (int i = 0; i < 16; ++i) acc[i] = 0.f;
#pragma unroll
        for (int half = 0; half < 2; ++half) {
            const int ev = half ? e1 : e0; const float cv = half ? coef1 : coef0;
#pragma unroll 16
            for (int j = 0; j < 64; ++j) {
                const int e = __builtin_amdgcn_readlane(ev, j);
                const float c = __uint_as_float(__builtin_amdgcn_readlane(__float_as_uint(cv), j));
                const bf16_t* vr = vb + (size_t)e * DM + lane * 8;
                const u32x4 va = *(const u32x4*)vr, vc = *(const u32x4*)(vr + 512);
                acc[0] += c * bflo(va.x); acc[1] += c * bfhi(va.x); acc[2] += c * bflo(va.y); acc[3] += c * bfhi(va.y);
                acc[4] += c * bflo(va.z); acc[5] += c * bfhi(va.z); acc[6] += c * bflo(va.w); acc[7] += c * bfhi(va.w);
                acc[8] += c * bflo(vc.x); acc[9] += c * bfhi(vc.x); acc[10] += c * bflo(vc.y); acc[11] += c * bfhi(vc.y);
                acc[12] += c * bflo(vc.z); acc[13] += c * bfhi(vc.z); acc[14] += c * bflo(vc.w); acc[15] += c * bfhi(vc.w);
            }
        }
        float* hr = h + (size_t)tok * DM + lane * 8;
        f32x4 h0 = *(f32x4*)hr, h1 = *(f32x4*)(hr + 4), h2 = *(f32x4*)(hr + 512), h3 = *(f32x4*)(hr + 516);
        h0 += (f32x4){acc[0], acc[1], acc[2], acc[3]}; h1 += (f32x4){acc[4], acc[5], acc[6], acc[7]};
        h2 += (f32x4){acc[8], acc[9], acc[10], acc[11]}; h3 += (f32x4){acc[12], acc[13], acc[14], acc[15]};
        *(f32x4*)hr = h0; *(f32x4*)(hr + 4) = h1; *(f32x4*)(hr + 512) = h2; *(f32x4*)(hr + 516) = h3;
        u32x4 w0, w1;
        w0.x = pack2bf(h0[0], h0[1]); w0.y = pack2bf(h0[2], h0[3]); w0.z = pack2bf(h1[0], h1[1]); w0.w = pack2bf(h1[2], h1[3]);
        w1.x = pack2bf(h2[0], h2[1]); w1.y = pack2bf(h2[2], h2[3]); w1.z = pack2bf(h3[0], h3[1]); w1.w = pack2bf(h3[2], h3[3]);
        *(u32x4*)(hb + (size_t)tok * DM + lane * 8) = w0; *(u32x4*)(hb + (size_t)tok * DM + 512 + lane * 8) = w1;
        float s = 0.f;
#pragma unroll
        for (int j = 0; j < 4; ++j) s += h0[j] * h0[j] + h1[j] * h1[j] + h2[j] * h2[j] + h3[j] * h3[j];
        s = wave_sum(s);
        if (lane == 0) rs2[tok] = rsqrtf(s * (1.0f / DM) + EPS);
    }
}

DI void p8_final_norm(const Params& p, int G) {
    const int lane = threadIdx.x & 63, gw = blockIdx.x * 8 + (threadIdx.x >> 6), nw = G * 8;
    const float* ssq3 = (const float*)(p.ws + WS_SSQ3); const float* g = p.in[I_FINAL_NORM]; const bf16_t* h3 = (const bf16_t*)(p.ws + WS_XB); float* out = p.out;
    f32x4 gg[4];
    gg[0] = *(const f32x4*)(g + lane * 8); gg[1] = *(const f32x4*)(g + lane * 8 + 4); gg[2] = *(const f32x4*)(g + 512 + lane * 8); gg[3] = *(const f32x4*)(g + 512 + lane * 8 + 4);
    for (int row0 = gw; row0 < NTOK; row0 += 4 * nw) {
        u32x4 va[4], vb[4]; float sq[4];
#pragma unroll
        for (int u = 0; u < 4; ++u) { const int row = row0 + u * nw; if (row < NTOK) { sq[u] = lane < 16 ? ssq3[(size_t)lane * NTOK + row] : 0.f;
            va[u] = *(const u32x4*)(h3 + (size_t)row * DM + lane * 8); vb[u] = *(const u32x4*)(h3 + (size_t)row * DM + 512 + lane * 8); } }
#pragma unroll
        for (int u = 0; u < 4; ++u) { const int row = row0 + u * nw; if (row < NTOK) {
            const float rs = rsqrtf(wave_sum(sq[u]) * (1.0f / DM) + EPS);
            float* o = out + (size_t)row * DM + lane * 8;
            *(f32x4*)o = (f32x4){bflo(va[u].x), bfhi(va[u].x), bflo(va[u].y), bfhi(va[u].y)} * rs * gg[0];
            *(f32x4*)(o + 4) = (f32x4){bflo(va[u].z), bfhi(va[u].z), bflo(va[u].w), bfhi(va[u].w)} * rs * gg[1];
            *(f32x4*)(o + 512) = (f32x4){bflo(vb[u].x), bfhi(vb[u].x), bflo(vb[u].y), bfhi(vb[u].y)} * rs * gg[2];
            *(f32x4*)(o + 516) = (f32x4){bflo(vb[u].z), bfhi(vb[u].z), bflo(vb[u].w), bfhi(vb[u].w)} * rs * gg[3]; } }
    }
}
typedef float f32x16 __attribute__((ext_vector_type(16)));
typedef short bf16x8v __attribute__((ext_vector_type(8)));
typedef __bf16 bf16x2v_ __attribute__((ext_vector_type(2)));
DI unsigned pk_bf16(float lo, float hi) { return __builtin_bit_cast(unsigned, __builtin_convertvector((f32x2){lo, hi}, bf16x2v_)); }
constexpr float LOG2E = 1.4426950408889634f;
constexpr int AT_KROW = 144, AT_VROW = 136;
constexpr int AT_KT = 64 * AT_KROW, AT_VT = 64 * AT_VROW, AT_BUF = 2 * AT_KT + 2 * AT_VT;
constexpr int AT_VAL = 0;
constexpr int AT_LUT = 2 * AT_BUF;
constexpr int AT_IMP = AT_LUT + 8 * 128 * 4;
constexpr int AT_SEL = AT_IMP + 8 * 32 * 65 * 4;
constexpr int AT_SSQ = AT_SEL + 512;
constexpr int AT_END = AT_SSQ + 1024;
static_assert(AT_END <= 160 * 1024 - 256, "attention LDS map");

struct AtSrc { const bf16_t* k0; const bf16_t* k1; const bf16_t* v0; const bf16_t* v1; int vld; };
DI void at_load(const AtSrc& s, int kpos, int tid, u32x4 (&r)[4]) {
    const int row = tid >> 3, seg = tid & 7;
    r[0] = *(const u32x4*)(s.k0 + (size_t)(kpos + row) * HD + seg * 8);
    r[1] = *(const u32x4*)(s.k1 + (size_t)(kpos + row) * HD + seg * 8);
    r[2] = *(const u32x4*)(s.v0 + (size_t)row * s.vld + kpos + seg * 8);
    r[3] = *(const u32x4*)(s.v1 + (size_t)row * s.vld + kpos + seg * 8);
}
DI void at_store(LAS3 unsigned char* buf, int tid, const u32x4 (&r)[4]) {
    const int row = tid >> 3, seg = tid & 7;
    *(LAS3 u32x4*)(buf + row * AT_KROW + seg * 16) = r[0];
    *(LAS3 u32x4*)(buf + AT_KT + row * AT_KROW + seg * 16) = r[1];
    LAS3 unsigned char* v = buf + 2 * AT_KT + row * AT_VROW + seg * 16;
    *(LAS3 u32x2*)(v) = (u32x2){r[2].x, r[2].y}; *(LAS3 u32x2*)(v + 8) = (u32x2){r[2].z, r[2].w};
    *(LAS3 u32x2*)(v + AT_VT) = (u32x2){r[3].x, r[3].y}; *(LAS3 u32x2*)(v + AT_VT + 8) = (u32x2){r[3].z, r[3].w};
}

template <int MODE, int PASS, int APROBE>
DI void at_step(LAS3 const unsigned char* Kb, LAS3 const unsigned char* Vb, const bf16x8v (&Q)[4], int k0, int tq, int lane, LAS3 const float* lut, bool blk_ok, bool farstep,
                float& m_run, float& l_run, f32x16 (&O)[2], float inv_l, LAS3 float* imp_row, float& bcarry) {
    const int r = lane & 31, hf = lane >> 5;
    f32x16 S[2];
#pragma unroll
    for (int sub = 0; sub < 2; ++sub) {
#pragma unroll
        for (int i = 0; i < 16; ++i) S[sub][i] = 0.f;
#pragma unroll
        for (int ks = 0; ks < 4; ++ks) {
            const bf16x8v a = *(LAS3 const bf16x8v*)(Kb + (32 * sub + r) * AT_KROW + 32 * ks + 16 * hf);
            if (APROBE < 3) S[sub] = __builtin_amdgcn_mfma_f32_32x32x16_bf16(a, Q[ks], S[sub], 0, 0, 0);
            else S[sub][ks] += __builtin_bit_cast(float, (int)a[0] | ((int)a[1] << 16));
        }
    }
    __builtin_amdgcn_sched_barrier(0);
    float mx = -INFINITY;
    const float bfar = lut[127];
    if (APROBE >= 2) { mx = S[0][0]; } else
    if (!farstep) {
#pragma unroll
        for (int sub = 0; sub < 2; ++sub)
#pragma unroll
            for (int i = 0; i < 16; ++i) {
                const int kp = k0 + 32 * sub + (i & 3) + 8 * (i >> 2) + 4 * hf;
                const int dist = MODE == 0 ? tq - (16 * kp + 31) : tq - kp;
                bool ok = dist >= 0 && blk_ok;
                if (MODE == 2) ok = ok && dist < 512;
                const int idx = dist < 0 ? 0 : (dist > 127 ? 127 : dist);
                float s = S[sub][i] + lut[idx];
                s = ok ? s : -INFINITY;
                S[sub][i] = s; mx = fmaxf(mx, s);
            }
    } else {
#pragma unroll
        for (int sub = 0; sub < 2; ++sub)
#pragma unroll
            for (int i = 0; i < 16; ++i) mx = fmaxf(mx, S[sub][i]);
        mx += bfar;
        if (MODE == 1) mx = blk_ok ? mx : -INFINITY;
    }
    if (APROBE >= 2) { l_run += mx; } else
    if (PASS != 2) {
        mx = fmaxf(mx, __shfl_xor(mx, 32));
        const float m_new = fmaxf(m_run, mx), m_safe = (m_new == -INFINITY) ? 0.f : m_new;
        const float alpha = __builtin_amdgcn_exp2f(m_run - m_safe);
        float m_use = farstep ? m_safe - bfar : m_safe;
        if (MODE == 1 && farstep) m_use = blk_ok ? m_use : INFINITY;
        float sum = 0.f;
#pragma unroll
        for (int sub = 0; sub < 2; ++sub)
#pragma unroll
            for (int i = 0; i < 16; ++i) { const float pv = __builtin_amdgcn_exp2f(S[sub][i] - m_use); S[sub][i] = pv; sum += pv; }
        l_run = l_run * alpha + sum; m_run = m_new;
        if (PASS == 0) {
            if (__any(alpha != 1.0f)) {
#pragma unroll
                for (int db = 0; db < 2; ++db)
#pragma unroll
                    for (int i = 0; i < 16; ++i) O[db][i] *= alpha;
            }
        }
    } else {
        const float mu = farstep ? m_run - bfar : m_run;
#pragma unroll
        for (int sub = 0; sub < 2; ++sub) {
#pragma unroll
            for (int i = 0; i < 16; ++i) S[sub][i] = __builtin_amdgcn_exp2f(S[sub][i] - mu) * inv_l;
            float bp[4], av[4];
#pragma unroll
            for (int a = 0; a < 4; ++a) {
                av[a] = S[sub][4 * a] + S[sub][4 * a + 1] + S[sub][4 * a + 2] + 0.5f * S[sub][4 * a + 3];
                bp[a] = __shfl_xor(0.5f * S[sub][4 * a + 3], 32);
            }
            const int sbase = (k0 >> 2) + 8 * sub + hf;
#pragma unroll
            for (int a = 0; a < 4; ++a) imp_row[sbase + 2 * a] = av[a] + (hf ? bp[a] : (a > 0 ? bp[a > 0 ? a - 1 : 0] : bcarry));
            bcarry = bp[3];
        }
    }
    __builtin_amdgcn_sched_barrier(0);
    if (PASS != 1) {
#pragma unroll
        for (int sub = 0; sub < 2; ++sub)
#pragma unroll
            for (int s2 = 0; s2 < 2; ++s2) {
                u32x4 pw;
                pw.x = pk_bf16(S[sub][8 * s2 + 0], S[sub][8 * s2 + 1]); pw.y = pk_bf16(S[sub][8 * s2 + 2], S[sub][8 * s2 + 3]);
                pw.z = pk_bf16(S[sub][8 * s2 + 4], S[sub][8 * s2 + 5]); pw.w = pk_bf16(S[sub][8 * s2 + 6], S[sub][8 * s2 + 7]);
                const bf16x8v pf = __builtin_bit_cast(bf16x8v, pw);
#pragma unroll
                for (int db = 0; db < 2; ++db) {
                    LAS3 const unsigned char* va = Vb + (32 * db + r) * AT_VROW + (32 * sub + 16 * s2 + 4 * hf) * 2;
                    const u32x2 v0 = *(LAS3 const u32x2*)va, v1 = *(LAS3 const u32x2*)(va + 16);
                    const bf16x8v vf = __builtin_bit_cast(bf16x8v, (u32x4){v0.x, v0.y, v1.x, v1.y});
                    if (APROBE < 3) O[db] = __builtin_amdgcn_mfma_f32_32x32x16_bf16(vf, pf, O[db], 0, 0, 0); else O[db][s2] += __builtin_bit_cast(float, (int)vf[0] | ((int)pf[1] << 16));
                }
            }
    }
}

template <int MODE, int PASS, int APROBE>
DI void at_branch(LAS3 unsigned char* lds, const AtSrc& src, int blk_lo, int blk_hi, const bf16x8v (&Q)[4], int tq, int tid, int kvh, LAS3 const float* lut,
                  unsigned mlo, unsigned mhi, float& m_run, float& l_run, f32x16 (&O)[2], float inv_l, LAS3 float* imp_row) {
    const int lane = tid & 63;
    u32x4 st[4];
    float bcarry = 0.f;
    at_load(src, blk_lo * 64, tid, st);
    for (int blk = blk_lo; blk <= blk_hi; ++blk) {
        LAS3 unsigned char* buf = lds + ((blk - blk_lo) & 1) * AT_BUF;
        at_store(buf, tid, st);
        __syncthreads();
        if (blk < blk_hi) at_load(src, (blk + 1) * 64, tid, st);
        bool blk_ok = true;
        if (MODE == 1) blk_ok = ((blk < 32 ? (mlo >> blk) : (mhi >> (blk - 32))) & 1u) != 0u;
        const int t0u = tq - (lane & 31);
        const bool farstep = MODE == 0 ? (t0u - 16 * (blk * 64 + 63) - 31 >= 128) : (MODE == 1 ? (t0u - blk * 64 - 63 >= 128) : (t0u - blk * 64 - 63 >= 128 && t0u + 31 - blk * 64 < 512));
        if (MODE != 1 || __any(blk_ok)) {
            at_step<MODE, PASS, APROBE>(buf + kvh * AT_KT, buf + 2 * AT_KT + kvh * AT_VT, Q, blk * 64, tq, lane, lut, blk_ok, farstep, m_run, l_run, O, inv_l, imp_row, bcarry);
        }
    }
    __syncthreads();
}

template <int APROBE> DI void p3_attention(const Params& p, LAS3 unsigned char* lds, int G) {
    unsigned char* ws = p.ws;
    const int tid = threadIdx.x, lane = tid & 63, h = __builtin_amdgcn_readfirstlane(tid >> 6), kvh = h >> 2, r = lane & 31, hf = lane >> 5;
    LAS3 float* lutall = (LAS3 float*)(lds + AT_LUT);
    {
        const float* rel = p.in[I_REL];
        for (int i = tid; i < 1024; i += MK_THREADS) lutall[i] = rel[rel_bucket(i & 127) * NH + (i >> 7)] * LOG2E;
    }
    __syncthreads();
    LAS3 const float* lut = lutall + h * 128;
    LAS3 float* impw = (LAS3 float*)(lds + AT_IMP);
    LAS3 float* vals = (LAS3 float*)(lds + AT_VAL);
    LAS3 unsigned char* selb = lds + AT_SEL;
    LAS3 float* ssq = (LAS3 float*)(lds + AT_SSQ);
    const bf16_t* qb = (const bf16_t*)(ws + R_QB);
    const float* gates = (const float*)(ws + R_GATE);
    const float* gn = p.in[I_GN_ATTN];
    bf16_t* mixed = APROBE ? (bf16_t*)(ws + R_BIG + 32 * MB) : (bf16_t*)(ws + WS_MIXED);
    for (int ui = blockIdx.x; ui < 512; ui += G) {
        const int q8 = ui & 255, rnd = ui >> 8, b = q8 >> 6, j6 = q8 & 63, tb = rnd == 0 ? 127 - j6 : j6;
        const int t0 = 32 * tb, qb64 = tb >> 1, tq = t0 + r;
        const size_t tok = (size_t)b * T_ + tq;
        bf16x8v Q[4];
#pragma unroll
        for (int ks = 0; ks < 4; ++ks) Q[ks] = *(const bf16x8v*)(qb + tok * 512 + h * 64 + 16 * ks + 8 * hf);
        f32x16 O[2];
#pragma unroll
        for (int db = 0; db < 2; ++db)
#pragma unroll
            for (int i = 0; i < 16; ++i) O[db][i] = 0.f;
        LAS3 float* oslot = (LAS3 float*)(lds + AT_IMP) + h * 2048 + lane;
        const size_t bh0 = (size_t)b * 2, bh1 = bh0 + 1;
        {
            const bf16_t* kcb = (const bf16_t*)(ws + R_KCB); const bf16_t* vct = (const bf16_t*)(ws + R_VCT);
            const AtSrc src{kcb + bh0 * 256 * 64, kcb + bh1 * 256 * 64, vct + bh0 * 64 * 256, vct + bh1 * 64 * 256, 256};
            const int nst = tb / 32 + 1;
            float m_run = -INFINITY, l_run = 0.f;
            at_branch<0, 1, APROBE>(lds, src, 0, nst - 1, Q, tq, tid, kvh, lut, 0u, 0u, m_run, l_run, O, 0.f, nullptr);
            const float l_tot = l_run + __shfl_xor(l_run, 32);
            const float inv_l = l_tot > 0.f ? 1.0f / l_tot : 0.f;
            float m_fix = (m_run == -INFINITY) ? 0.f : m_run;
            at_branch<0, 2, APROBE>(lds, src, 0, nst - 1, Q, tq, tid, kvh, lut, 0u, 0u, m_fix, l_run, O, inv_l, impw + (h * 32 + r) * 65);
        }
        {
            const int row = tid >> 3, j8 = tid & 7, kr = row >> 5, tr = row & 31;
#pragma unroll
            for (int jj = 0; jj < 8; ++jj) {
                const int s = j8 * 8 + jj, db = qb64 - s;
                float v = 0.f;
#pragma unroll
                for (int g = 0; g < 4; ++g) v += impw[((kr * 4 + g) * 32 + tr) * 65 + s];
                vals[row * 65 + s] = (db >= 0 && db < 2) ? 2.0e4f : (s == 0 ? 1.0e4f : (db >= 0 ? v : -1.0f));
            }
            __syncthreads();
            unsigned bits = 0u;
            {
                float vv[8]; int rk[8];
#pragma unroll
                for (int jj = 0; jj < 8; ++jj) { vv[jj] = vals[row * 65 + j8 * 8 + jj]; rk[jj] = 0; }
#pragma unroll 2
                for (int s2 = 0; s2 < 64; ++s2) {
                    const float w = vals[row * 65 + s2];
#pragma unroll
                    for (int jj = 0; jj < 8; ++jj) rk[jj] += (w > vv[jj] || (w == vv[jj] && s2 < j8 * 8 + jj)) ? 1 : 0;
                }
#pragma unroll
                for (int jj = 0; jj < 8; ++jj) if (rk[jj] < 16 && qb64 - (j8 * 8 + jj) >= 0) bits |= 1u << jj;
            }
            selb[row * 8 + j8] = (unsigned char)bits;
            __syncthreads();
        }
        const unsigned mlo = *(LAS3 const unsigned*)(selb + (kvh * 32 + r) * 8), mhi = *(LAS3 const unsigned*)(selb + (kvh * 32 + r) * 8 + 4);
        __syncthreads();
        {
            const float g0 = sigmoidf_(gates[tok * 24 + h * 3 + 0]);
#pragma unroll
            for (int db = 0; db < 2; ++db)
#pragma unroll
                for (int i = 0; i < 16; ++i) { oslot[(db * 16 + i) * 64] = g0 * O[db][i]; O[db][i] = 0.f; }
        }
        {
            const bf16_t* ksb = (const bf16_t*)(ws + R_KS); const bf16_t* vst = (const bf16_t*)(ws + R_VST);
            const AtSrc src{ksb + bh0 * T_ * HD, ksb + bh1 * T_ * HD, vst + bh0 * HD * T_, vst + bh1 * HD * T_, T_};
            float m_run = -INFINITY, l_run = 0.f;
            at_branch<1, 0, APROBE>(lds, src, 0, qb64, Q, tq, tid, kvh, lut, mlo, mhi, m_run, l_run, O, 0.f, nullptr);
            const float l_tot = l_run + __shfl_xor(l_run, 32), sc = sigmoidf_(gates[tok * 24 + h * 3 + 1]) / l_tot;
#pragma unroll
            for (int db = 0; db < 2; ++db)
#pragma unroll
                for (int i = 0; i < 16; ++i) { oslot[(db * 16 + i) * 64] += sc * O[db][i]; O[db][i] = 0.f; }
        }
        {
            const bf16_t* kwb = (const bf16_t*)(ws + R_KW); const bf16_t* vwt = (const bf16_t*)(ws + R_VWT);
            const AtSrc src{kwb + bh0 * T_ * HD, kwb + bh1 * T_ * HD, vwt + bh0 * HD * T_, vwt + bh1 * HD * T_, T_};
            int wb0 = (t0 - 511) >> 6; wb0 = wb0 < 0 ? 0 : wb0;
            float m_run = -INFINITY, l_run = 0.f;
            at_branch<2, 0, APROBE>(lds, src, wb0, qb64, Q, tq, tid, kvh, lut, 0u, 0u, m_run, l_run, O, 0.f, nullptr);
            const float l_tot = l_run + __shfl_xor(l_run, 32), sc = sigmoidf_(gates[tok * 24 + h * 3 + 2]) / l_tot;
#pragma unroll
            for (int db = 0; db < 2; ++db)
#pragma unroll
                for (int i = 0; i < 16; ++i) O[db][i] = oslot[(db * 16 + i) * 64] + sc * O[db][i];
        }
        {
            float ss = 0.f;
#pragma unroll
            for (int db = 0; db < 2; ++db)
#pragma unroll
                for (int i = 0; i < 16; ++i) ss += O[db][i] * O[db][i];
            ss += __shfl_xor(ss, 32);
            if (hf == 0) ssq[h * 32 + r] = ss;
            __syncthreads();
            float tot = 0.f;
#pragma unroll
            for (int hh = 0; hh < 8; ++hh) tot += ssq[hh * 32 + r];
            const float rs = rsqrtf(tot * (1.0f / 512) + EPS);
#pragma unroll
            for (int db = 0; db < 2; ++db)
#pragma unroll
                for (int a = 0; a < 4; ++a) {
                    const int d = 32 * db + 8 * a + 4 * hf;
                    const f32x4 g4 = *(const f32x4*)(gn + h * 64 + d);
                    u32x2 w; w.x = pk_bf16(O[db][4 * a] * rs * g4[0], O[db][4 * a + 1] * rs * g4[1]); w.y = pk_bf16(O[db][4 * a + 2] * rs * g4[2], O[db][4 * a + 3] * rs * g4[3]);
                    *(u32x2*)(mixed + tok * DM + h * 64 + d) = w;
                }
            __syncthreads();
        }
    }
}
constexpr int LR_STRIDE = 516;
constexpr int LR_XC = 0, LR_A = 32 * LR_STRIDE * 4, LR_RS = 2 * 32 * LR_STRIDE * 4, LR_END = LR_RS + 256;
static_assert(LR_END <= 160 * 1024 - 256, "LRU LDS map");

template <bool FINAL>
DI void lru_phase(const Params& p, LAS3 unsigned char* lds, int G) {
    unsigned char* ws = p.ws;
    const int tid = threadIdx.x, lane = tid & 63, n = __builtin_amdgcn_readfirstlane(tid >> 6), r = lane & 31, hf = lane >> 5, ch = tid;
    LAS3 float* XC = (LAS3 float*)(lds + LR_XC); LAS3 float* AA = (LAS3 float*)(lds + LR_A); LAS3 float* RS = (LAS3 float*)(lds + LR_RS);
    const bf16_t* xr = (const bf16_t*)(ws + R_XR); const bf16_t* xg = (const bf16_t*)(ws + R_XG);
    float* sumP = (float*)(ws + WS_LRUP); float* sumH = (float*)(ws + WS_LRUH);
    bf16_t* mixed = (bf16_t*)(ws + WS_MIXED);
    const float cw0 = p.in[I_CONV_W][0 * 512 + ch], cw1 = p.in[I_CONV_W][1 * 512 + ch], cw2 = p.in[I_CONV_W][2 * 512 + ch], cw3 = p.in[I_CONV_W][3 * 512 + ch], cb = p.in[I_CONV_B][ch];
    const float gl = FINAL ? p.in[I_GN_LRU][ch] : 0.f;
    float ba[2], bx[2], sp[2];
#pragma unroll
    for (int nb = 0; nb < 2; ++nb) { const int c2 = n * 64 + 32 * nb + r; ba[nb] = p.in[I_LRU_BA][c2]; bx[nb] = p.in[I_LRU_BX][c2]; sp[nb] = log1pf(__expf(-p.in[I_LRU_LAM][c2])); }
    const bf16_t* waT = (const bf16_t*)(ws + WS_WAT); const bf16_t* wxT = (const bf16_t*)(ws + WS_WXT);
    for (int ci = blockIdx.x; ci < 256; ci += G) {
        const int b = ci >> 6, cib = ci & 63, t0 = cib * 64;
        const size_t tok0 = (size_t)b * T_ + t0;
        float x1 = 0.f, x2 = 0.f, x3 = 0.f;
        if (t0 > 0) { x1 = bf2f(xr[(tok0 - 1) * 512 + ch]); x2 = bf2f(xr[(tok0 - 2) * 512 + ch]); x3 = bf2f(xr[(tok0 - 3) * 512 + ch]); }
        float hst = 0.f, pprod = 1.f;
        if (FINAL) {
            const float* Pp = sumP + (size_t)(b * 64) * 512 + ch; const float* Hp = sumH + (size_t)(b * 64) * 512 + ch;
            for (int k0 = 0; k0 < cib; k0 += 16) {
                float pv[16], hv[16];
#pragma unroll
                for (int j = 0; j < 16; ++j) { const int k = k0 + j < cib ? k0 + j : cib - 1; pv[j] = Pp[(size_t)k * 512]; hv[j] = Hp[(size_t)k * 512]; }
#pragma unroll
                for (int j = 0; j < 16; ++j) if (k0 + j < cib) hst = pv[j] * hst + hv[j];
            }
        }
#pragma unroll 1
        for (int half = 0; half < 2; ++half) {
            const size_t tokh = tok0 + half * 32;
            __syncthreads();
            {
                bf16_t xw[32]; float xv[32];
#pragma unroll
                for (int t = 0; t < 32; ++t) xw[t] = xr[(tokh + t) * 512 + ch];
#pragma unroll
                for (int t = 0; t < 32; ++t) xv[t] = bf2f(xw[t]);
#pragma unroll
                for (int t = 0; t < 32; ++t) {
                    const float x0 = xv[t];
                    XC[t * LR_STRIDE + ch] = cw0 * x3 + cw1 * x2 + cw2 * x1 + cw3 * x0 + cb;
                    x3 = x2; x2 = x1; x1 = x0;
                }
            }
            __syncthreads();
            {
                f32x16 ar[2], ai[2];
#pragma unroll
                for (int nb = 0; nb < 2; ++nb)
#pragma unroll
                    for (int i = 0; i < 16; ++i) { ar[nb][i] = 0.f; ai[nb][i] = 0.f; }
                bf16x8v Ba[2][4], Bx[2][4];
#pragma unroll
                for (int nb = 0; nb < 2; ++nb)
#pragma unroll
                    for (int ks = 0; ks < 4; ++ks) {
                        const size_t o = (size_t)(n * 64 + 32 * nb + r) * 64 + 16 * ks + 8 * hf;
                        Ba[nb][ks] = *(const bf16x8v*)(waT + o); Bx[nb][ks] = *(const bf16x8v*)(wxT + o);
                    }
#pragma unroll
                for (int ks = 0; ks < 4; ++ks) {
                    LAS3 const float* src = XC + r * LR_STRIDE + n * 64 + 16 * ks + 8 * hf;
                    const f32x4 f0 = *(LAS3 const f32x4*)src, f1 = *(LAS3 const f32x4*)(src + 4);
                    u32x4 pw; pw.x = pk_bf16(f0[0], f0[1]); pw.y = pk_bf16(f0[2], f0[3]); pw.z = pk_bf16(f1[0], f1[1]); pw.w = pk_bf16(f1[2], f1[3]);
                    const bf16x8v af = __builtin_bit_cast(bf16x8v, pw);
#pragma unroll
                    for (int nb = 0; nb < 2; ++nb) {
                        ar[nb] = __builtin_amdgcn_mfma_f32_32x32x16_bf16(af, Ba[nb][ks], ar[nb], 0, 0, 0);
                        ai[nb] = __builtin_amdgcn_mfma_f32_32x32x16_bf16(af, Bx[nb][ks], ai[nb], 0, 0, 0);
                    }
                }
                __syncthreads();
#pragma unroll
                for (int nb = 0; nb < 2; ++nb)
#pragma unroll
                    for (int i = 0; i < 16; ++i) {
                        const int t = (i & 3) + 8 * (i >> 2) + 4 * hf, o = t * LR_STRIDE + n * 64 + 32 * nb + r;
                        const float xcv = XC[o];
                        const float rg = sigmoidf_(ar[nb][i] + ba[nb]), ig = sigmoidf_(ai[nb][i] + bx[nb]);
                        const float log_a = -8.0f * rg * sp[nb];
                        AA[o] = __expf(log_a);
                        XC[o] = sqrtf(-expm1f(2.0f * log_a)) * (ig * xcv);
                    }
            }
            __syncthreads();
            if (!FINAL) {
#pragma unroll 8
                for (int t = 0; t < 32; ++t) { const float a = AA[t * LR_STRIDE + ch]; hst = a * hst + XC[t * LR_STRIDE + ch]; pprod *= a; }
            } else {
                {
                    bf16_t gv[32];
#pragma unroll
                    for (int t = 0; t < 32; ++t) gv[t] = xg[(tokh + t) * 512 + ch];
#pragma unroll
                    for (int t = 0; t < 32; ++t) {
                        hst = AA[t * LR_STRIDE + ch] * hst + XC[t * LR_STRIDE + ch];
                        XC[t * LR_STRIDE + ch] = hst * gelu_tanh(bf2f(gv[t]));
                    }
                }
                __syncthreads();
                {
                    const int t = tid >> 4, part = tid & 15;
                    float s = 0.f;
#pragma unroll 8
                    for (int j = 0; j < 32; ++j) { const float v = XC[t * LR_STRIDE + part + 16 * j]; s += v * v; }
                    s += __shfl_xor(s, 1); s += __shfl_xor(s, 2); s += __shfl_xor(s, 4); s += __shfl_xor(s, 8);
                    if (part == 0) RS[t] = rsqrtf(s * (1.0f / 512) + EPS);
                }
                __syncthreads();
                {
                    const int t = tid >> 4, part = tid & 15; const float rs = RS[t];
                    const float* gp = p.in[I_GN_LRU] + part * 32; LAS3 const float* xp = XC + t * LR_STRIDE + part * 32;
                    bf16_t* dst = mixed + (tokh + t) * DM + 512 + part * 32;
#pragma unroll
                    for (int q = 0; q < 4; ++q) {
                        const f32x4 a = *(LAS3 const f32x4*)(xp + 8 * q), b = *(LAS3 const f32x4*)(xp + 8 * q + 4), ga = *(const f32x4*)(gp + 8 * q), gb = *(const f32x4*)(gp + 8 * q + 4);
                        u32x4 w; w.x = pack2bf(a[0] * rs * ga[0], a[1] * rs * ga[1]); w.y = pack2bf(a[2] * rs * ga[2], a[3] * rs * ga[3]);
                        w.z = pack2bf(b[0] * rs * gb[0], b[1] * rs * gb[1]); w.w = pack2bf(b[2] * rs * gb[2], b[3] * rs * gb[3]);
                        *(u32x4*)(dst + 8 * q) = w;
                    }
                }
            }
        }
        if (!FINAL) { sumP[(size_t)ci * 512 + ch] = pprod; sumH[(size_t)ci * 512 + ch] = hst; }
    }
    __syncthreads();
}
typedef float f32x4v __attribute__((ext_vector_type(4)));
constexpr int CM_IMG = 0;
constexpr int CM_HID = 36864;
constexpr int CM_END = CM_HID + 16 * 264 * 2;
DI void p2_compress(const Params& p, LAS3 unsigned char* lds, int G) {
    unsigned char* ws = p.ws;
    const int tid = threadIdx.x, lane = tid & 63, wid = __builtin_amdgcn_readfirstlane(tid >> 6), row = lane & 15, kg = lane >> 4;
    for (int u = blockIdx.x; u < 256; u += G) {
        const int kv = u >> 7, bh = (u >> 4) & 7, c0 = (u & 15) * 16;
        const bf16_t* src = (const bf16_t*)(ws + (kv ? R_VC : R_KC)) + ((size_t)bh * T_ + 16 * c0) * HD;
        const bf16_t* W1T = (const bf16_t*)(ws + (kv ? WS_CW1V : WS_CW1K));
        const float* cb = (const float*)(ws + (kv ? WS_CBV : WS_CBK));
        const bf16_t* W2T = (const bf16_t*)(ws + (kv ? WS_CW2V : WS_CW2K));
        __syncthreads();
        {
            u32x4 cv[5];
#pragma unroll
            for (int k = 0; k < 5; ++k) { const int i = tid + k * MK_THREADS; if (i < 272 * 8) cv[k] = *(const u32x4*)(src + (size_t)(i >> 3) * HD + (i & 7) * 8); }
#pragma unroll
            for (int k = 0; k < 5; ++k) { const int i = tid + k * MK_THREADS; if (i < 272 * 8) { const int tau = i >> 3, cch = i & 7; *(LAS3 u32x4*)(lds + CM_IMG + tau * 128 + (tau >> 4) * 16 + cch * 16) = cv[k]; } }
        }
        __syncthreads();
        f32x4v acc[2] = {{0.f, 0.f, 0.f, 0.f}, {0.f, 0.f, 0.f, 0.f}};
        const bf16_t* wb0 = W1T + (size_t)(wid * 32 + row) * 2048 + 8 * kg, * wb1 = wb0 + (size_t)16 * 2048;
#pragma unroll 16
        for (int ks = 0; ks < 64; ++ks) {
            const int tau = 16 * row + (ks >> 1);
            const bf16x8v a = *(LAS3 const bf16x8v*)(lds + CM_IMG + tau * 128 + (tau >> 4) * 16 + (32 * (ks & 1) + 8 * kg) * 2);
            const bf16x8v b0 = *(const bf16x8v*)(wb0 + 32 * ks), b1 = *(const bf16x8v*)(wb1 + 32 * ks);
            acc[0] = __builtin_amdgcn_mfma_f32_16x16x32_bf16(a, b0, acc[0], 0, 0, 0);
            acc[1] = __builtin_amdgcn_mfma_f32_16x16x32_bf16(a, b1, acc[1], 0, 0, 0);
        }
#pragma unroll
        for (int nb = 0; nb < 2; ++nb) {
            const int col = wid * 32 + 16 * nb + row; const float bias = cb[col];
#pragma unroll
            for (int i = 0; i < 4; ++i) *(LAS3 bf16_t*)(lds + CM_HID + ((4 * kg + i) * 264 + col) * 2) = f2bf(gelu_tanh(acc[nb][i] + bias));
        }
        __syncthreads();
        if (wid < 4) {
            f32x4v o = {0.f, 0.f, 0.f, 0.f};
#pragma unroll
            for (int ks = 0; ks < 8; ++ks) {
                const bf16x8v a = *(LAS3 const bf16x8v*)(lds + CM_HID + (row * 264 + 32 * ks + 8 * kg) * 2);
                const bf16x8v b = *(const bf16x8v*)(W2T + (size_t)(wid * 16 + row) * 256 + 32 * ks + 8 * kg);
                o = __builtin_amdgcn_mfma_f32_16x16x32_bf16(a, b, o, 0, 0, 0);
            }
            const int d = wid * 16 + row;
#pragma unroll
            for (int i = 0; i < 4; ++i) {
                const int c = c0 + 4 * kg + i; const float v = c < NCMP ? o[i] : 0.f;
                ((float*)(ws + (kv ? WS_VCMP : WS_KCMP)))[((size_t)bh * 256 + c) * 64 + d] = v;
                if (kv) ((bf16_t*)(ws + R_VCT))[((size_t)bh * 64 + d) * 256 + c] = f2bf(v);
                else    ((bf16_t*)(ws + R_KCB))[((size_t)bh * 256 + c) * 64 + d] = f2bf(v);
            }
        }
    }
    __syncthreads();
}
DI void p2_vtranspose(const Params& p, LAS3 unsigned char* lds, int G) {
    unsigned char* ws = p.ws;
    const int tid = threadIdx.x;
    LAS3 bf16_t* tl = (LAS3 bf16_t*)lds;
    for (int u0 = blockIdx.x; u0 < 1024; u0 += 4 * G) {
        u32x4 v[4];
#pragma unroll
        for (int k = 0; k < 4; ++k) { const int u = u0 + k * G; if (u < 1024) {
            const int which = u >> 9, bh = (u >> 6) & 7, tt = u & 63;
            const bf16_t* src = (const bf16_t*)(ws + (which ? R_VW : R_VS)) + ((size_t)bh * T_ + tt * 64) * HD;
            v[k] = *(const u32x4*)(src + (size_t)(tid >> 3) * HD + (tid & 7) * 8); } }
        __syncthreads();
#pragma unroll
        for (int k = 0; k < 4; ++k) if (u0 + k * G < 1024) *(LAS3 u32x4*)(tl + k * 64 * 72 + (tid >> 3) * 72 + (tid & 7) * 8) = v[k];
        __syncthreads();
#pragma unroll
        for (int k = 0; k < 4; ++k) { const int u = u0 + k * G; if (u < 1024) {
            const int which = u >> 9, bh = (u >> 6) & 7, tt = u & 63;
            bf16_t* dst = (bf16_t*)(ws + (which ? R_VWT : R_VST)) + (size_t)bh * HD * T_ + tt * 64;
            LAS3 const bf16_t* t2 = tl + k * 64 * 72;
            const int d = tid >> 3, seg = tid & 7; u32x4 w;
            w.x = (unsigned)t2[(seg * 8 + 0) * 72 + d] | ((unsigned)t2[(seg * 8 + 1) * 72 + d] << 16); w.y = (unsigned)t2[(seg * 8 + 2) * 72 + d] | ((unsigned)t2[(seg * 8 + 3) * 72 + d] << 16);
            w.z = (unsigned)t2[(seg * 8 + 4) * 72 + d] | ((unsigned)t2[(seg * 8 + 5) * 72 + d] << 16); w.w = (unsigned)t2[(seg * 8 + 6) * 72 + d] | ((unsigned)t2[(seg * 8 + 7) * 72 + d] << 16);
            *(u32x4*)(dst + (size_t)d * T_ + seg * 8) = w; } }
    }
    __syncthreads();
}
DI int ord_enc(float f) { const int u = __float_as_int(f); return u ^ ((u >> 31) & 0x7fffffff); }
DI float ord_dec(int o) { return __int_as_float(o ^ ((o >> 31) & 0x7fffffff)); }
#define PEER_CE_DESC(a, b) do { const int _hi = max((a), (b)), _lo = min((a), (b)); (a) = _hi; (b) = _lo; } while (0)
#define PEER_CE_ASC(a, b)  do { const int _hi = max((a), (b)), _lo = min((a), (b)); (a) = _lo; (b) = _hi; } while (0)
DI void sort16_desc(int (&x)[16]) {
#pragma unroll
    for (int k = 2; k <= 16; k <<= 1)
#pragma unroll
        for (int j = k >> 1; j > 0; j >>= 1)
#pragma unroll
            for (int i = 0; i < 16; ++i) { const int l = i ^ j; if (l > i) { if ((i & k) == 0) PEER_CE_DESC(x[i], x[l]); else PEER_CE_ASC(x[i], x[l]); } }
}
DI void merge16_desc(int (&a)[16], const int (&b)[16]) {
#pragma unroll
    for (int i = 0; i < 16; ++i) a[i] = max(a[i], b[15 - i]);
#pragma unroll
    for (int j = 8; j > 0; j >>= 1)
#pragma unroll
        for (int i = 0; i < 16; ++i) { const int l = i ^ j; if (l > i) PEER_CE_DESC(a[i], a[l]); }
}
constexpr int PR_KEYS = 0;
constexpr int PR_IDX = 512 * 68 * 4;
constexpr int PR_RS = PR_IDX + 128 * 32 * 4;
constexpr int PR_END = PR_RS + 1024;
static_assert(PR_END <= 160 * 1024 - 256, "PEER LDS map");

struct EpiPeerRoute {
    static constexpr bool PERM = true, AFTER_DRAIN = true;
    const float* ssq1; int* eout; float* gout; float* rs1out;
    DI void fused(const f32x4 (&acc)[2][2][4][2], const pg8::Unit& u, int wr, int wc, int fr, int fq, PG8_LAS unsigned char* lds, int wid, int lane) const {
        const int tid = wid * 64 + lane, head = u.pn;
        LAS3 int* KEYS = (LAS3 int*)(lds + PR_KEYS); LAS3 int* IDX = (LAS3 int*)(lds + PR_IDX); LAS3 float* RS = (LAS3 float*)(lds + PR_RS);
        if (tid < 256) { float s = 0.f; for (int j = 0; j < 16; ++j) s += ssq1[(size_t)j * NTOK + u.pm * 256 + tid]; RS[tid] = rsqrtf(s * (1.0f / DM) + EPS); if (u.pn == 0) rs1out[u.pm * 256 + tid] = RS[tid]; }
#pragma unroll 1
        for (int ai = 0; ai < 2; ++ai) {
            __syncthreads();
#pragma unroll
            for (int bj = 0; bj < 2; ++bj)
#pragma unroll
                for (int m = 0; m < 4; ++m)
#pragma unroll
                    for (int n = 0; n < 2; ++n) {
                        const int rl = 64 * wr + 16 * m + fr, kk0 = 32 * wc + 8 * fq + 4 * n, hl = ((rl * 2 + bj) * 2 + (kk0 >> 6));
                        const f32x4 v = ai == 0 ? acc[0][bj][m][n] : acc[1][bj][m][n];
                        u32x4 kq;
                        kq.x = (unsigned)((ord_enc(v[0]) & ~0x7f) | (127 - (kk0 + 0))); kq.y = (unsigned)((ord_enc(v[1]) & ~0x7f) | (127 - (kk0 + 1)));
                        kq.z = (unsigned)((ord_enc(v[2]) & ~0x7f) | (127 - (kk0 + 2))); kq.w = (unsigned)((ord_enc(v[3]) & ~0x7f) | (127 - (kk0 + 3)));
                        *(LAS3 u32x4*)(KEYS + hl * 68 + (kk0 & 63)) = kq;
                    }
            __syncthreads();
            int top[16];
            {
                LAS3 const int* src = KEYS + tid * 68;
                int t2[16];
#pragma unroll
                for (int q = 0; q < 4; ++q) { const u32x4 w = *(LAS3 const u32x4*)(src + 4 * q); top[4 * q] = (int)w.x; top[4 * q + 1] = (int)w.y; top[4 * q + 2] = (int)w.z; top[4 * q + 3] = (int)w.w; }
                sort16_desc(top);
#pragma unroll 1
                for (int g = 1; g < 4; ++g) {
#pragma unroll
                    for (int q = 0; q < 4; ++q) { const u32x4 w = *(LAS3 const u32x4*)(src + 16 * g + 4 * q); t2[4 * q] = (int)w.x; t2[4 * q + 1] = (int)w.y; t2[4 * q + 2] = (int)w.z; t2[4 * q + 3] = (int)w.w; }
                    sort16_desc(t2);
                    merge16_desc(top, t2);
                }
#pragma unroll
                for (int i = 0; i < 16; ++i) t2[i] = __shfl_xor(top[i], 1);
                merge16_desc(top, t2);
            }
            int s1[16], s2[16];
            {
                const bool isp1 = (lane & 2) != 0;
#pragma unroll
                for (int i = 0; i < 16; ++i) { const int o = __shfl_xor(top[i], 2); s1[i] = isp1 ? o : top[i]; s2[i] = isp1 ? top[i] : o; }
            }
            const int rl = tid >> 2, q4 = tid & 3;
#pragma unroll
            for (int kq = 0; kq < 4; ++kq) if (q4 == kq) {
#pragma unroll
                for (int j = 0; j < 4; ++j) { IDX[rl * 32 + 4 * kq + j] = 127 - (s1[4 * kq + j] & 0x7f); IDX[rl * 32 + 16 + 4 * kq + j] = 127 - (s2[4 * kq + j] & 0x7f); }
            }
            float v1[16], v2[16];
#pragma unroll
            for (int i = 0; i < 16; ++i) { v1[i] = ord_dec(s1[i] & ~0x7f); v2[i] = ord_dec(s2[i] & ~0x7f); }
            int best[16], grp[16];
            {
                int cnt = 0; bool first = true;
#pragma unroll
                for (int a = 0; a < 16; ++a)
#pragma unroll
                    for (int b = 0; b < 16; ++b) if ((a + 1) * (b + 1) <= 16) {
                        grp[cnt & 15] = (ord_enc(v1[a] + v2[b]) & ~0xff) | (255 - (16 * a + b));
                        ++cnt;
                        if ((cnt & 15) == 0) { sort16_desc(grp); if (first) {
#pragma unroll
                                for (int i = 0; i < 16; ++i) best[i] = grp[i];
                                first = false; } else merge16_desc(best, grp); }
                    }
#pragma unroll
                for (int i = 2; i < 16; ++i) grp[i] = (int)0x80000000;
                sort16_desc(grp); merge16_desc(best, grp);
            }
            __syncthreads();
            const float rs1 = RS[128 * ai + rl];
            float gsum = 0.f, gv[16]; int ev[16];
            const float mtop = ord_dec(best[0] & ~0xff) * rs1;
#pragma unroll
            for (int i = 0; i < 16; ++i) {
                const float sc = ord_dec(best[i] & ~0xff) * rs1; gv[i] = __expf(sc - mtop); gsum += gv[i];
                const int ab = 255 - (best[i] & 0xff);
                ev[i] = IDX[rl * 32 + (ab >> 4)] * 128 + IDX[rl * 32 + 16 + (ab & 15)];
            }
            const float ginv = 1.0f / gsum;
            const size_t tok = (size_t)u.pm * 256 + 128 * ai + rl;
#pragma unroll
            for (int kq = 0; kq < 4; ++kq) if (q4 == kq) {
                *(u32x4*)(eout + tok * 128 + head * 16 + 4 * kq) = (u32x4){(unsigned)ev[4 * kq], (unsigned)ev[4 * kq + 1], (unsigned)ev[4 * kq + 2], (unsigned)ev[4 * kq + 3]};
                *(f32x4*)(gout + tok * 128 + head * 16 + 4 * kq) = (f32x4){gv[4 * kq] * ginv, gv[4 * kq + 1] * ginv, gv[4 * kq + 2] * ginv, gv[4 * kq + 3] * ginv};
            }
        }
        __syncthreads();
    }
    DI void operator()(const f32x4 (&)[2][2][4][2], const pg8::Unit&, int, int, int, int) const {}
};
struct SliceOrder : pg8::StaticOrder {
    int slice;
    __device__ bool next(int i, pg8::Unit& u) const { if (i > 0) return false; return pg8::StaticOrder::next(slice, u); }
};
DI void p5_peer_route(const Params& p, LAS3 unsigned char* lds, int G) {
    unsigned char* ws = p.ws;
    pg8::Gemm g{(const bf16_t*)(ws + R_H1B), (const bf16_t*)(ws + WS_WQS), NTOK, 2048, DM};
    EpiPeerRoute E{(const float*)(ws + WS_SSQ1), (int*)(ws + R_EXP), (float*)(ws + R_GSM), (float*)(ws + WS_RS1)};
    const int nslice = (512 + G - 1) / G;
#pragma unroll 1
    for (int s = 0; s < nslice; ++s) {
        SliceOrder S; S.init(NTOK, 2048, G, (int)blockIdx.x); S.slice = s;
        pg8::gemm_phase<EpiPeerRoute, SliceOrder>(lds, g, S, E, nullptr);
        __syncthreads();
    }
}
constexpr float V8_SCALE = 8.0f;
#define I8_LOADROW(E) (*(const u32x2*)(u8 + ((unsigned)(E) * (unsigned)(DM / 2) + (unsigned)(lane * 8))))
DI int i4_dotrow(const u32x2 w, const unsigned (&xq)[4]) {
    int a = __builtin_amdgcn_sdot4((int)((w.x << 4) & 0xF0F0F0F0u), (int)xq[0], 0, false); a = __builtin_amdgcn_sdot4((int)(w.x & 0xF0F0F0F0u), (int)xq[1], a, false);
    a = __builtin_amdgcn_sdot4((int)((w.y << 4) & 0xF0F0F0F0u), (int)xq[2], a, false); a = __builtin_amdgcn_sdot4((int)(w.y & 0xF0F0F0F0u), (int)xq[3], a, false);
    return a;
}
#define I8_DOTROW(W) i4_dotrow((W), xq)
#define I8_ISSUE(SET, EV, J0) do { int ev_ = (EV); asm volatile("" : "+v"(ev_)); _Pragma("unroll") for (int k = 0; k < 16; ++k) { const int e = __builtin_amdgcn_readlane(ev_, (J0) + k); \
        SET[k] = I8_LOADROW(e); } __builtin_amdgcn_sched_barrier(0); } while (0)
#define I8_CONS(SET, P0) do { _Pragma("unroll") for (int k = 0; k < 16; ++k) { \
        part[(P0) + k] = (float)I8_DOTROW(SET[k]); } __builtin_amdgcn_sched_barrier(0); } while (0)
#define I8_RS(M) do { const bool up = (lane & (M)) != 0; _Pragma("unroll") for (int i = 0; i < (M); ++i) { \
        const float send = up ? part[i] : part[i + (M)], keep = up ? part[i + (M)] : part[i]; part[i] = keep + __shfl_xor(send, (M)); } } while (0)
#define V4_ISSUE(SET, EV, J0) do { int ev_ = (EV); asm volatile("" : "+v"(ev_)); _Pragma("unroll") for (int k = 0; k < 16; ++k) { const int e = __builtin_amdgcn_readlane(ev_, (J0) + k); \
        SET[k] = *(const u32x2*)(v8 + ((unsigned)e * (unsigned)(DM / 2) + (unsigned)(lane * 8))); } __builtin_amdgcn_sched_barrier(0); } while (0)
#define V4_CVT(W, B) __builtin_amdgcn_cvt_scalef32_pk_f32_fp4((W), 1.0f, B)
#define V4_FMA(W, I) do { t_[4 * (I)] = __builtin_elementwise_fma(V4_CVT(W, 0), c2, t_[4 * (I)]); \
        t_[4 * (I) + 1] = __builtin_elementwise_fma(V4_CVT(W, 1), c2, t_[4 * (I) + 1]); \
        t_[4 * (I) + 2] = __builtin_elementwise_fma(V4_CVT(W, 2), c2, t_[4 * (I) + 2]); \
        t_[4 * (I) + 3] = __builtin_elementwise_fma(V4_CVT(W, 3), c2, t_[4 * (I) + 3]); } while (0)
#define V4_ROW(SET, CV, J0, K) do { const float c = (CV)[(J0) + (K)]; const f32x2 c2 = {c, c}; const u32x2 w_ = SET[K]; \
        V4_FMA(w_.x, 0); V4_FMA(w_.y, 1); } while (0)
#define V4_CONS(SET, CV, J0) do { f32x2 t_[8]; _Pragma("unroll") for (int i_ = 0; i_ < 8; ++i_) t_[i_] = (f32x2){0.f, 0.f}; V4_ROW(SET, CV, J0, 0); V4_ROW(SET, CV, J0, 1); V4_ROW(SET, CV, J0, 2); V4_ROW(SET, CV, J0, 3); V4_ROW(SET, CV, J0, 4); V4_ROW(SET, CV, J0, 5); \
        V4_ROW(SET, CV, J0, 6); V4_ROW(SET, CV, J0, 7); V4_ROW(SET, CV, J0, 8); V4_ROW(SET, CV, J0, 9); V4_ROW(SET, CV, J0, 10); V4_ROW(SET, CV, J0, 11); \
        V4_ROW(SET, CV, J0, 12); V4_ROW(SET, CV, J0, 13); V4_ROW(SET, CV, J0, 14); V4_ROW(SET, CV, J0, 15); \
        _Pragma("unroll") for (int i_ = 0; i_ < 8; ++i_) acc[i_] += t_[i_]; __builtin_amdgcn_sched_barrier(0); } while (0)
DI void p6fused(const Params& p, LAS3 unsigned char* lds, int G) {
    unsigned char* ws = p.ws;
    const int tid = threadIdx.x, lane = tid & 63, wid = tid >> 6;
    const int gw = blockIdx.x * 8 + wid, nw = G * 8;
    const unsigned char* u8 = (const unsigned char*)(ws + WS_UB); const unsigned char* v8 = (const unsigned char*)(ws + WS_VB);
    const int* eidx = (const int*)(ws + R_EXP); const float* gsm = (const float*)(ws + R_GSM); const float* rs1v = (const float*)(ws + WS_RS1);
    bf16_t* hb = (bf16_t*)(ws + R_H1B); float* rs2 = (float*)(ws + WS_RS2);
    LAS3 float* cl = (LAS3 float*)(lds + wid * 512);
    int en0 = 0, en1 = 0;
    if (gw < NTOK) { en0 = eidx[(size_t)gw * 128 + lane]; en1 = eidx[(size_t)gw * 128 + 64 + lane]; }
#pragma unroll 1
    for (int tok = gw; tok < NTOK; tok += nw) {
        const int e0 = en0, e1 = en1;
        { const int tn = tok + nw < NTOK ? tok + nw : tok; en0 = eidx[(size_t)tn * 128 + lane]; en1 = eidx[(size_t)tn * 128 + 64 + lane]; }
        {
            u32x2 sa[16], sb[16];
            I8_ISSUE(sa, e0, 0);
            I8_ISSUE(sb, e0, 16);
            const u32x4 xa = *(const u32x4*)(hb + (size_t)tok * DM + lane * 16), xb = *(const u32x4*)(hb + (size_t)tok * DM + lane * 16 + 8);
            const float g0 = gsm[(size_t)tok * 128 + lane], g1 = gsm[(size_t)tok * 128 + 64 + lane];
            const float rs1 = rs1v[tok];
            float xf[16];
#pragma unroll
            for (int q = 0; q < 4; ++q) { xf[2 * q] = bflo(xa[q]); xf[2 * q + 1] = bfhi(xa[q]); xf[8 + 2 * q] = bflo(xb[q]); xf[8 + 2 * q + 1] = bfhi(xb[q]); }
            float amax = 0.f;
#pragma unroll
            for (int i = 0; i < 16; ++i) amax = fmaxf(amax, fabsf(xf[i]));
            amax = wave_max(amax);
            const float sx = fmaxf(amax, 1e-20f) * (1.0f / 127.0f), isx = 1.0f / sx;
            unsigned xq[4];
#pragma unroll
            for (int q = 0; q < 2; ++q) {
                unsigned we = 0u, wo = 0u;
#pragma unroll
                for (int b = 0; b < 4; ++b) { we |= ((unsigned)(int)rintf(xf[8 * q + 2 * b] * isx) & 0xffu) << (8 * b); wo |= ((unsigned)(int)rintf(xf[8 * q + 2 * b + 1] * isx) & 0xffu) << (8 * b); }
                xq[2 * q] = we; xq[2 * q + 1] = wo;
            }
            const float scl = rs1 * sx * (1.0f / (16.0f * U4_ISCALE));
            float part[64];
            I8_CONS(sa, 0);  I8_ISSUE(sa, e0, 32);
            I8_CONS(sb, 16); I8_ISSUE(sb, e0, 48);
            I8_CONS(sa, 32); I8_ISSUE(sa, e1, 0);
            I8_CONS(sb, 48); I8_ISSUE(sb, e1, 16);
            I8_RS(32); I8_RS(16); I8_RS(8); I8_RS(4); I8_RS(2); I8_RS(1);
            cl[lane] = g0 * gelu_tanh(part[0] * scl) * (1.0f / V8_SCALE);
            I8_CONS(sa, 0);  I8_ISSUE(sa, e1, 32);
            I8_CONS(sb, 16); I8_ISSUE(sb, e1, 48);
            I8_CONS(sa, 32);
            I8_CONS(sb, 48);
            I8_RS(32); I8_RS(16); I8_RS(8); I8_RS(4); I8_RS(2); I8_RS(1);
            cl[64 + lane] = g1 * gelu_tanh(part[0] * scl) * (1.0f / V8_SCALE);
        }
        {
            u32x2 sa[16], sb[16];
            V4_ISSUE(sa, e0, 0);
            V4_ISSUE(sb, e0, 16);
            LAS3 const float* c0 = cl; LAS3 const float* c1 = cl + 64;
            const u32x4 ha = *(const u32x4*)(hb + (size_t)tok * DM + lane * 16), hc = *(const u32x4*)(hb + (size_t)tok * DM + lane * 16 + 8);
            const f32x4 hv0 = {bflo(ha.x), bfhi(ha.x), bflo(ha.y), bfhi(ha.y)}, hv1 = {bflo(ha.z), bfhi(ha.z), bflo(ha.w), bfhi(ha.w)};
            const f32x4 hv2 = {bflo(hc.x), bfhi(hc.x), bflo(hc.y), bfhi(hc.y)}, hv3 = {bflo(hc.z), bfhi(hc.z), bflo(hc.w), bfhi(hc.w)};
            f32x2 acc[8];
#pragma unroll
            for (int i = 0; i < 8; ++i) acc[i] = (f32x2){0.f, 0.f};
            V4_CONS(sa, c0, 0);  V4_ISSUE(sa, e0, 32);
            V4_CONS(sb, c0, 16); V4_ISSUE(sb, e0, 48);
            V4_CONS(sa, c0, 32); V4_ISSUE(sa, e1, 0);
            V4_CONS(sb, c0, 48); V4_ISSUE(sb, e1, 16);
            V4_CONS(sa, c1, 0);  V4_ISSUE(sa, e1, 32);
            V4_CONS(sb, c1, 16); V4_ISSUE(sb, e1, 48);
            V4_CONS(sa, c1, 32);
            V4_CONS(sb, c1, 48);
            const f32x4 o0 = hv0 + (f32x4){acc[0].x, acc[0].y, acc[1].x, acc[1].y}, o1 = hv1 + (f32x4){acc[2].x, acc[2].y, acc[3].x, acc[3].y};
            const f32x4 o2 = hv2 + (f32x4){acc[4].x, acc[4].y, acc[5].x, acc[5].y}, o3 = hv3 + (f32x4){acc[6].x, acc[6].y, acc[7].x, acc[7].y};
            u32x4 w0, w1;
            w0.x = pk_bf16(o0[0], o0[1]); w0.y = pk_bf16(o0[2], o0[3]); w0.z = pk_bf16(o1[0], o1[1]); w0.w = pk_bf16(o1[2], o1[3]);
            w1.x = pk_bf16(o2[0], o2[1]); w1.y = pk_bf16(o2[2], o2[3]); w1.z = pk_bf16(o3[0], o3[1]); w1.w = pk_bf16(o3[2], o3[3]);
            *(u32x4*)(hb + (size_t)tok * DM + lane * 16) = w0; *(u32x4*)(hb + (size_t)tok * DM + lane * 16 + 8) = w1;
            float ss = 0.f;
#pragma unroll
            for (int j = 0; j < 4; ++j) ss += o0[j] * o0[j] + o1[j] * o1[j] + o2[j] * o2[j] + o3[j] * o3[j];
            ss = wave_sum(ss);
            if (lane == 0) rs2[tok] = rsqrtf(ss * (1.0f / DM) + EPS);
        }
    }
}
#undef I8_ISSUE
#undef I8_CONS
#undef I8_RS
#undef V4_ISSUE
#undef V4_CONS
#undef V4_FMA
#undef V4_ROW
#undef V4_CVT
#undef I8_LOADROW
#undef I8_DOTROW

constexpr int LDS_MISC = 160 * 1024 - 256;
constexpr int LDS_BYTES = 160 * 1024;
constexpr size_t CTL_BAR = 0;
static_assert(XCD_BAR_WORDS * 4 <= 64 * 1024, "control region");

template <class F> struct EpiAdapt {
    static constexpr bool PERM = true, AFTER_DRAIN = false;
    F f;
    DI void operator()(const f32x4 (&acc)[2][2][4][2], const pg8::Unit& u, int wr, int wc, int fr, int fq) const {
        int fr_ = fr, fq_ = fq; asm volatile("" : "+v"(fr_), "+v"(fq_));
        const int row0 = u.pm * 256 + wr * 64 + fr_, col0 = u.pn * 256 + wc * 32 + 8 * fq_;
#pragma unroll
        for (int ai = 0; ai < 2; ++ai)
#pragma unroll
            for (int m = 0; m < 4; ++m) {
                const int row = row0 + ai * 128 + m * 16;
#pragma unroll
                for (int bj = 0; bj < 2; ++bj)
                    f.store8(row, col0 + bj * 128, acc[ai][bj][m][0], acc[ai][bj][m][1]);
            }
    }
};
template <class F> struct EpiAdaptSsq {
    static constexpr bool PERM = true, AFTER_DRAIN = false;
    F f; float* ssq;
    DI void operator()(const f32x4 (&acc)[2][2][4][2], const pg8::Unit& u, int wr, int wc, int fr, int fq) const {
        int fr_ = fr, fq_ = fq; asm volatile("" : "+v"(fr_), "+v"(fq_));
        const int row0 = u.pm * 256 + wr * 64 + fr_, col0 = u.pn * 256 + wc * 32 + 8 * fq_;
#pragma unroll
        for (int ai = 0; ai < 2; ++ai)
#pragma unroll
            for (int m = 0; m < 4; ++m) {
                const int row = row0 + ai * 128 + m * 16;
                float s = 0.f; const float rsc = f.rowscale(row);
#pragma unroll
                for (int bj = 0; bj < 2; ++bj)
                    s += f.store8r(row, col0 + bj * 128, acc[ai][bj][m][0], acc[ai][bj][m][1], rsc);
                s += __shfl_xor(s, 16); s += __shfl_xor(s, 32);
                if (fq_ == 0) ssq[(size_t)(u.pn * 4 + wc) * NTOK + row] = s;
            }
    }
};
struct EpiOutR {
    const bf16_t* xb; bf16_t* h1b;
    DI float rowscale(int) const { return 0.f; }
    DI float store8r(int row, int col, f32x4 v0, f32x4 v1, float) const {
        const size_t o = (size_t)row * DM + col;
        const u32x4 xw = *(const u32x4*)(xb + o);
        v0 += (f32x4){bflo(xw.x), bfhi(xw.x), bflo(xw.y), bfhi(xw.y)}; v1 += (f32x4){bflo(xw.z), bfhi(xw.z), bflo(xw.w), bfhi(xw.w)};
        u32x4 w; w.x = pack2bf(v0[0], v0[1]); w.y = pack2bf(v0[2], v0[3]); w.z = pack2bf(v1[0], v1[1]); w.w = pack2bf(v1[2], v1[3]); *(u32x4*)(h1b + o) = w;
        return ((v0[0] * v0[0] + v0[1] * v0[1]) + (v0[2] * v0[2] + v0[3] * v0[3])) + ((v1[0] * v1[0] + v1[1] * v1[1]) + (v1[2] * v1[2] + v1[3] * v1[3]));
    }
};
struct EpiBf16Plain { bf16_t* C; int ldc;
    DI void store8(int row, int col, f32x4 v0, f32x4 v1) const { u32x4 w; w.x = pack2bf(v0[0], v0[1]); w.y = pack2bf(v0[2], v0[3]); w.z = pack2bf(v1[0], v1[1]); w.w = pack2bf(v1[2], v1[3]); *(u32x4*)(C + (size_t)row * ldc + col) = w; } };
struct EpiGateR {
    const float* rs2; const float* bias; const bf16_t* pp; const bf16_t* h2; bf16_t* h3;
    DI float rowscale(int row) const { return rs2[row]; }
    DI float store8r(int row, int col, f32x4 v0, f32x4 v1, float s) const {
        const size_t o = (size_t)row * DM + col;
        const f32x4 b0 = *(const f32x4*)(bias + col), b1 = *(const f32x4*)(bias + col + 4); const u32x4 pw = *(const u32x4*)(pp + o), hw = *(const u32x4*)(h2 + o);
        float hv[8] = {bflo(hw.x), bfhi(hw.x), bflo(hw.y), bfhi(hw.y), bflo(hw.z), bfhi(hw.z), bflo(hw.w), bfhi(hw.w)};
        const float pv[8] = {bflo(pw.x), bfhi(pw.x), bflo(pw.y), bfhi(pw.y), bflo(pw.z), bfhi(pw.z), bflo(pw.w), bfhi(pw.w)};
        float ss = 0.f;
#pragma unroll
        for (int j = 0; j < 4; ++j) { hv[j] += sigmoidf_(v0[j] * s + b0[j]) * pv[j]; hv[4 + j] += sigmoidf_(v1[j] * s + b1[j]) * pv[4 + j]; }
#pragma unroll
        for (int j = 0; j < 8; ++j) ss += hv[j] * hv[j];
        u32x4 w; w.x = pack2bf(hv[0], hv[1]); w.y = pack2bf(hv[2], hv[3]); w.z = pack2bf(hv[4], hv[5]); w.w = pack2bf(hv[6], hv[7]); *(u32x4*)(h3 + o) = w;
        return ss;
    }
};

struct MegaArgs { Params p; int ph_lo, ph_hi; };

__global__ void __launch_bounds__(MK_THREADS, 2) mega_fwd(MegaArgs args) {
    extern __shared__ __attribute__((aligned(16))) unsigned char lds_raw[];
    LAS unsigned char* lds = (LAS unsigned char*)lds_raw;
    const Params& p = args.p;
    unsigned char* ws = p.ws;
    const int lo = args.ph_lo, hi = args.ph_hi;
    const int G = gridDim.x;
    volatile LAS unsigned* misc = (volatile LAS unsigned*)(lds + LDS_MISC);
    if (threadIdx.x < 64) misc[threadIdx.x] = 0u;
    __syncthreads();
    const XcdBarrier bar = xcd_barrier_post((unsigned*)(ws + WS_CTL), misc);
#define IN(k) (lo <= (k) && (k) < hi)
#define SEAM(k) do { if (IN(k) && IN((k) + 1)) xcd_barrier(bar); } while (0)

    if (IN(0)) p0_prologue(p, lds, G);
    SEAM(0);
    if (IN(1)) {
        pg8::Gemm g{(const bf16_t*)(ws + WS_XB), (const bf16_t*)(ws + WS_WIN), NTOK, NPROJ, DM};
        pg8::StaticOrder S; S.init(NTOK, NPROJ, G, (int)blockIdx.x);
        EpiAdapt<EpiProj> E{{(const float*)(ws + WS_RS0), (bf16_t*)(ws + R_QB), (bf16_t*)(ws + R_KC), (float*)(ws + R_GATE), (bf16_t*)(ws + R_XR), (bf16_t*)(ws + R_XG)}};
        pg8::gemm_phase<EpiAdapt<EpiProj>, pg8::StaticOrder>(lds, g, S, E, nullptr);
        p1_deferred(p, G);
    }
    SEAM(1);
    if (IN(2)) { p2_compress(p, lds, G); p2_vtranspose(p, lds, G); lru_phase<false>(p, lds, G); }
    SEAM(2);
    if (IN(3)) { p3_attention<0>(p, lds, G); lru_phase<true>(p, lds, G); }
    SEAM(3);
    if (IN(4)) {
        pg8::Gemm g{(const bf16_t*)(ws + WS_MIXED), (const bf16_t*)(ws + WS_WOUT), NTOK, DM, DM};
        pg8::StaticOrder S; S.init(NTOK, DM, G, (int)blockIdx.x);
        EpiAdaptSsq<EpiOutR> E{{(const bf16_t*)(ws + WS_XB), (bf16_t*)(ws + R_H1B)}, (float*)(ws + WS_SSQ1)};
        pg8::gemm_phase<EpiAdaptSsq<EpiOutR>, pg8::StaticOrder>(lds, g, S, E, nullptr);
    }
    SEAM(4);
    if (IN(5)) p5_peer_route(p, lds, G);
    SEAM(5);
    if (IN(6)) p6fused(p, lds, G);
    SEAM(6);
    if (IN(7)) {
        {
            pg8::Gemm g{(const bf16_t*)(ws + WS_PB), (const bf16_t*)(ws + WS_WP), NTOK, DM, PLE};
            pg8::StaticOrder S; S.init(NTOK, DM, G, (int)blockIdx.x);
            EpiAdapt<EpiBf16Plain> E{{(bf16_t*)(ws + R_BIG), DM}};
            pg8::gemm_phase<EpiAdapt<EpiBf16Plain>, pg8::StaticOrder>(lds, g, S, E, nullptr);
        }
        __syncthreads();
        {
            pg8::Gemm g{(const bf16_t*)(ws + R_H1B), (const bf16_t*)(ws + WS_WG), NTOK, DM, DM};
            pg8::StaticOrder S; S.init(NTOK, DM, G, (int)blockIdx.x);
            EpiAdaptSsq<EpiGateR> E{{(const float*)(ws + WS_RS2), p.in[I_PLE_BG], (const bf16_t*)(ws + R_BIG), (const bf16_t*)(ws + R_H1B), (bf16_t*)(ws + WS_XB)}, (float*)(ws + WS_SSQ3)};
            pg8::gemm_phase<EpiAdaptSsq<EpiGateR>, pg8::StaticOrder>(lds, g, S, E, nullptr);
        }
    }
    SEAM(7);
    if (IN(8)) p8_final_norm(p, G);
#undef IN
#undef SEAM
}

static int g_grid = 0;
static void launch_mega(hipStream_t st, const Params& p, int lo, int hi) {
    if (g_grid == 0) {
        int dev = 0, cus = 0, per_cu = 0;
        hipGetDevice(&dev); hipDeviceGetAttribute(&cus, hipDeviceAttributeMultiprocessorCount, dev);
        if (hipFuncSetAttribute((const void*)mega_fwd, hipFuncAttributeMaxDynamicSharedMemorySize, LDS_BYTES) != hipSuccess) { fprintf(stderr, "hipFuncSetAttribute failed\n"); g_grid = -1; return; }
        if (hipOccupancyMaxActiveBlocksPerMultiprocessor(&per_cu, (const void*)mega_fwd, MK_THREADS, LDS_BYTES) != hipSuccess || per_cu < 1) { fprintf(stderr, "occupancy query: %d per CU\n", per_cu); }
        (void)hipGetLastError();
        g_grid = cus;
    }
    if (g_grid < 0) return;
    MegaArgs a{}; a.p = p; a.ph_lo = lo; a.ph_hi = hi;
    hipLaunchKernelGGL(mega_fwd, dim3(g_grid), dim3(MK_THREADS), LDS_BYTES, st, a);
}
extern "C" void kernel_launch(void* const* d_in, const int* in_sizes, int n_in, void* d_out, int out_size, void* d_ws, size_t ws_size, hipStream_t stream) {
    if (n_in != 31 || out_size != NTOK * DM || ws_size < WS_END) { fprintf(stderr, "kernel_launch: unexpected shapes (n_in %d out %d ws %zu)\n", n_in, out_size, ws_size); return; }
    Params p{};
    for (int i = 0; i < 31; ++i) p.in[i] = (const float*)d_in[i];
    p.out = (float*)d_out; p.ws = (unsigned char*)d_ws;
    (void)hipMemsetAsync((char*)d_ws + WS_CTL, 0, 16384 + 1024, stream);
    launch_mega(stream, p, 0, 9);
}
```

```cpp
#include <hip/hip_runtime.h>
#include <stdint.h>
#include <stdio.h>

typedef unsigned short bf16_t;
typedef float f32x4 __attribute__((ext_vector_type(4)));
typedef float f32x2 __attribute__((ext_vector_type(2)));
typedef unsigned u32x4 __attribute__((ext_vector_type(4)));
typedef unsigned u32x2 __attribute__((ext_vector_type(2)));
#define DI __device__ __forceinline__

constexpr int NB = 4, T_ = 4096, DM = 1024, NTOK = NB * T_;
constexpr int NH = 8, HD = 64, NKV = 2, GRP = 4, ATTW = 512, KVW = 128, LRUW = 512;
constexpr int INCOLS = 2328, NPROJ = 2560;
constexpr int NCMP = 255, NSEL = 64;
constexpr int PEER_H = 8, PEER_K = 16, PEER_NK = 128;
constexpr int PLE = 256;
constexpr float EPS = 1e-6f;

constexpr int PC_KV = 512, PC_XR = 1280, PC_XG = 1792, PC_GATE = 2304;

constexpr size_t MB = 1024 * 1024;
constexpr size_t WS_CTL   = 0;
constexpr size_t WS_WIN   = 64 * 1024;
constexpr size_t WS_WOUT  = WS_WIN  + (size_t)NPROJ * DM * 2;
constexpr size_t WS_WQS   = WS_WOUT + (size_t)DM * DM * 2;
constexpr size_t WS_WG    = WS_WQS  + (size_t)2048 * DM * 2;
constexpr size_t WS_WP    = WS_WG   + (size_t)DM * DM * 2;
constexpr size_t WS_CW1K  = WS_WP   + (size_t)DM * PLE * 2;
constexpr size_t WS_CW1V  = WS_CW1K + (size_t)256 * 2048 * 2;
constexpr size_t WS_CBK   = WS_CW1V + (size_t)256 * 2048 * 2;
constexpr size_t WS_CBV   = WS_CBK  + 1024;
constexpr size_t WS_RS0   = WS_CBV  + 1024;
constexpr size_t WS_RS2   = WS_RS0  + (size_t)NTOK * 4;
constexpr size_t WS_RS1   = WS_RS2  + (size_t)NTOK * 4;
constexpr size_t WS_SSQ2  = WS_RS1  + (size_t)NTOK * 4;
constexpr size_t WS_SSQ1  = WS_SSQ2 + (size_t)16 * NTOK * 4;
constexpr size_t WS_SSQ3  = WS_SSQ1 + (size_t)16 * NTOK * 4;
constexpr size_t WS_KCMP  = WS_SSQ3 + (size_t)16 * NTOK * 4;
constexpr size_t WS_VCMP  = WS_KCMP + (size_t)8 * 256 * 64 * 4;
constexpr size_t WS_LRUP  = WS_VCMP + (size_t)8 * 256 * 64 * 4;
constexpr size_t WS_LRUH  = WS_LRUP + (size_t)256 * 512 * 4;
constexpr size_t WS_WAT   = WS_LRUH + (size_t)256 * 512 * 4;
constexpr size_t WS_WXT   = WS_WAT + 8 * 64 * 64 * 2;
constexpr size_t WS_CW2K  = WS_WXT + 8 * 64 * 64 * 2;
constexpr size_t WS_CW2V  = WS_CW2K + 64 * 256 * 2;
constexpr size_t WS_HID   = WS_CW2V + 64 * 256 * 2;
constexpr size_t WS_UB    = (WS_HID + (size_t)2 * 2048 * 256 * 4 + 4095) / 4096 * 4096;
constexpr size_t WS_VB    = WS_UB + (size_t)16384 * DM * 2;
constexpr size_t WS_PB    = WS_VB + (size_t)16384 * DM * 2;
constexpr size_t WS_XB    = WS_PB + (size_t)NTOK * PLE * 2;
constexpr size_t WS_R     = WS_XB + (size_t)NTOK * DM * 2;
constexpr size_t KVT = (size_t)NB * NKV * T_ * HD * 2 + 65536;
constexpr size_t R_QB    = WS_R;
constexpr size_t R_KC    = R_QB + (size_t)NTOK * 512 * 2;
constexpr size_t R_VC    = R_KC + KVT;
constexpr size_t R_KS    = R_VC + KVT;
constexpr size_t R_VS    = R_KS + KVT;
constexpr size_t R_KW    = R_VS + KVT;
constexpr size_t R_VW    = R_KW + KVT;
constexpr size_t R_GATE  = R_VW + KVT;
constexpr size_t R_XR    = R_GATE + (size_t)NTOK * 24 * 4;
constexpr size_t R_XG    = R_XR + (size_t)NTOK * 512 * 2;
constexpr size_t R_VST   = R_XG + (size_t)NTOK * 512 * 2;
constexpr size_t R_VWT   = R_VST + KVT;
constexpr size_t R_KCB   = R_VWT + KVT;
constexpr size_t R_VCT   = R_KCB + (size_t)8 * 256 * 64 * 2;
constexpr size_t R_END13 = R_VCT + (size_t)8 * 256 * 64 * 2;
constexpr size_t R_H1B   = WS_R;
constexpr size_t R_EXP   = R_H1B + (size_t)NTOK * DM * 2;
constexpr size_t R_GSM   = R_EXP + (size_t)NTOK * 128 * 4;
constexpr size_t R_COEF  = R_GSM + (size_t)NTOK * 128 * 4;
constexpr size_t R_BIG   = R_COEF + (size_t)NTOK * 128 * 4;
constexpr size_t WS_MIXED = (R_END13 + 4095) / 4096 * 4096;
static_assert(WS_MIXED + (size_t)NTOK * DM * 2 <= R_BIG + 64 * MB, "mixed must fit below the end of region R");
constexpr size_t WS_END  = (R_END13 > R_BIG + 64 * MB ? R_END13 : R_BIG + 64 * MB);
static_assert(WS_END <= 256 * MB, "workspace map exceeds 256 MiB");

DI float bf2f(bf16_t v) { return __uint_as_float((unsigned)v << 16); }
DI bf16_t f2bf(float x) { unsigned u = __float_as_uint(x); u += 0x7fffu + ((u >> 16) & 1u); return (bf16_t)(u >> 16); }
DI unsigned pack2bf(float lo, float hi) { return (unsigned)f2bf(lo) | ((unsigned)f2bf(hi) << 16); }
DI float gelu_tanh(float x) { const float u = 0.7978845608028654f * (x + 0.044715f * x * x * x); return 0.5f * x * (1.0f + tanhf(u)); }
DI float sigmoidf_(float x) { return 1.0f / (1.0f + __expf(-x)); }

__device__ const unsigned char REL_BUCKET_LUT[128] = {
0,1,2,3,4,5,6,7,8,9,10,11,12,13,14,15,16,16,16,17,17,18,18,18,19,19,19,20,20,20,20,21,21,21,21,22,22,22,22,22,23,23,23,23,23,23,24,24,24,24,24,24,25,25,25,25,25,25,25,26,26,26,26,26,26,26,26,27,27,27,27,27,27,27,27,27,27,28,28,28,28,28,28,28,28,28,28,29,29,29,29,29,29,29,29,29,29,29,29,30,30,30,30,30,30,30,30,30,30,30,30,30,30,31,31,31,31,31,31,31,31,31,31,31,31,31,31,31};
DI int rel_bucket(int dist) { dist = dist < 0 ? 0 : dist; return dist >= 128 ? 31 : (int)REL_BUCKET_LUT[dist]; }

struct Params {
    const float* in[31];
    float* out;
    unsigned char* ws;
};
enum { I_X = 0, I_P, I_ATTN_NORM, I_W_IN, I_CK_PE, I_CK_W1, I_CK_W2, I_CV_PE, I_CV_W1, I_CV_W2, I_REL, I_CONV_W, I_CONV_B, I_LRU_WA, I_LRU_BA, I_LRU_WX, I_LRU_BX,
       I_LRU_LAM, I_GN_ATTN, I_GN_LRU, I_W_OUT, I_FFN_NORM, I_PEER_WQ, I_PEER_SUB, I_PEER_U, I_PEER_V, I_PLE_NORM, I_PLE_WG, I_PLE_BG, I_PLE_PROJ, I_FINAL_NORM };

struct EpiProj {
    static constexpr bool HAS8 = true;
    const float* rs0; bf16_t* qb; bf16_t* kv0; float* gates; bf16_t* xr; bf16_t* xg;
    DI void store8(int row, int col, f32x4 v0, f32x4 v1) const {
        const float s = rs0[row];
        v0 *= s; v1 *= s;
        const int tl = __builtin_amdgcn_readfirstlane(col >> 8);
        if (tl < 2) { const float qs = 0.125f * 1.4426950408889634f;
            v0 *= qs; v1 *= qs;
            u32x4 w; w.x = pack2bf(v0[0], v0[1]); w.y = pack2bf(v0[2], v0[3]); w.z = pack2bf(v1[0], v1[1]); w.w = pack2bf(v1[2], v1[3]); *(u32x4*)(qb + (size_t)row * 512 + col) = w; }
        else if (tl < 5) {
            const int c = col - PC_KV, tensor = c >> 7, within = c & 127, kvh = within >> 6, d = within & 63, b = row >> 12, t = row & 4095;
            bf16_t* dst = (bf16_t*)((unsigned char*)kv0 + (size_t)tensor * KVT) + ((size_t)(b * NKV + kvh) * T_ + t) * HD + d;
            u32x4 w; w.x = pack2bf(v0[0], v0[1]); w.y = pack2bf(v0[2], v0[3]); w.z = pack2bf(v1[0], v1[1]); w.w = pack2bf(v1[2], v1[3]); *(u32x4*)dst = w;
        }
        else if (tl < 7) { u32x4 w; w.x = pack2bf(v0[0], v0[1]); w.y = pack2bf(v0[2], v0[3]); w.z = pack2bf(v1[0], v1[1]); w.w = pack2bf(v1[2], v1[3]); *(u32x4*)(xr + (size_t)row * 512 + (col - PC_XR)) = w; }
        else if (tl < 9) { u32x4 w; w.x = pack2bf(v0[0], v0[1]); w.y = pack2bf(v0[2], v0[3]); w.z = pack2bf(v1[0], v1[1]); w.w = pack2bf(v1[2], v1[3]); *(u32x4*)(xg + (size_t)row * 512 + (col - PC_XG)) = w; }
        else if (col < PC_GATE + 24) { float* g = gates + (size_t)row * 24 + (col - PC_GATE); *(f32x4*)g = v0; *(f32x4*)(g + 4) = v1; }
    }
};
struct EpiOut {
    const float* x; float* h1; bf16_t* h1b;
    DI void store4(int row, int col, f32x4 v) const {
        const size_t o = (size_t)row * DM + col;
        v += *(const f32x4*)(x + o);
        *(f32x4*)(h1 + o) = v;
        u32x2 w; w.x = pack2bf(v[0], v[1]); w.y = pack2bf(v[2], v[3]); *(u32x2*)(h1b + o) = w;
    }
};
struct EpiF32Plain { float* C; int ldc; int coloff;
    DI void store4(int row, int col, f32x4 v) const { *(f32x4*)(C + (size_t)row * ldc + (col - coloff)) = v; } };
struct EpiGate {
    const float* rs2; const float* bias; const float* pp; float* h;
    DI void store4(int row, int col, f32x4 v) const {
        const size_t o = (size_t)row * DM + col;
        const float s = rs2[row];
        const f32x4 bb = *(const f32x4*)(bias + col), p4 = *(const f32x4*)(pp + o);
        f32x4 hv = *(f32x4*)(h + o);
#pragma unroll
        for (int j = 0; j < 4; ++j) hv[j] += sigmoidf_(v[j] * s + bb[j]) * p4[j];
        *(f32x4*)(h + o) = hv;
    }
};
DI float wave_sum(float v) {
#pragma unroll
    for (int o = 32; o > 0; o >>= 1) v += __shfl_xor(v, o);
    return v;
}
DI float wave_max(float v) {
#pragma unroll
    for (int o = 32; o > 0; o >>= 1) v = fmaxf(v, __shfl_xor(v, o));
    return v;
}
DI float block_sum256(float v, float* red) {
    v = wave_sum(v); __syncthreads();
    if ((threadIdx.x & 63) == 0) red[threadIdx.x >> 6] = v; __syncthreads();
    return (red[0] + red[1]) + (red[2] + red[3]);
}
DI float block_max256(float v, float* red) {
    v = wave_max(v); __syncthreads();
    if ((threadIdx.x & 63) == 0) red[threadIdx.x >> 6] = v; __syncthreads();
    return fmaxf(fmaxf(red[0], red[1]), fmaxf(red[2], red[3]));
}

#define XB_TMO      128
#define XB_XCNT(j)  (256  + 64 * (j))
#define XB_XSUB(j)  (1280 + 64 * (j))
#define XB_XGEN(j)  (2304 + 64 * (j))
#define XB_TOP      3328
#define XB_TOPGEN   3392
#define XCD_BAR_WORDS 3456
#define XB_SPIN_CAP (1u << 18)
#define LAS __attribute__((address_space(3)))

__device__ __forceinline__ unsigned xb_ld(unsigned* p)              { return __hip_atomic_load(p, __ATOMIC_RELAXED, __HIP_MEMORY_SCOPE_AGENT); }
__device__ __forceinline__ unsigned xb_add(unsigned* p, unsigned v) { return __hip_atomic_fetch_add(p, v, __ATOMIC_RELAXED, __HIP_MEMORY_SCOPE_AGENT); }
__device__ __forceinline__ unsigned xb_xcc_id() { return (unsigned)__builtin_amdgcn_s_getreg((3 << 11) | 20) & 0xFu; }
#define XB_SPIN(cond, bar) do { unsigned _sp = 0; while (cond) { __builtin_amdgcn_s_sleep(1); \
    if ((++_sp & 255u) == 0u) { if (xb_ld(&(bar)[XB_TMO])) break; if (_sp > XB_SPIN_CAP) { atomicAdd(&(bar)[XB_TMO], 1u); break; } } } } while (0)

struct XcdBarrier {
    unsigned* bar; unsigned x;
    volatile LAS unsigned* st;
};

__device__ __forceinline__ XcdBarrier xcd_barrier_post(unsigned* bar, volatile LAS unsigned* st) {
    XcdBarrier b; b.bar = bar; b.x = xb_xcc_id(); b.st = st;
    if (threadIdx.x == 0) (void)xb_add(&bar[XB_XCNT(b.x)], 1u);
    return b;
}
__device__ __forceinline__ void xcd_barrier_complete(unsigned* bar, unsigned x, unsigned& nloc, unsigned& nx) {
    const unsigned G = gridDim.x * gridDim.y * gridDim.z;
    unsigned sum, cnt, mine, sp = 0u;
    for (;;) {
        sum = 0u; cnt = 0u; mine = 0u;
#pragma unroll
        for (unsigned j = 0; j < 16; ++j) { const unsigned c = xb_ld(&bar[XB_XCNT(j)]); sum += c; cnt += (c > 0u) ? 1u : 0u; mine = (j == x) ? c : mine; }
        if (sum == G) break;
        __builtin_amdgcn_s_sleep(1);
        if ((++sp & 255u) == 0u) { if (xb_ld(&bar[XB_TMO])) break; if (sp > XB_SPIN_CAP) { atomicAdd(&bar[XB_TMO], 1u); break; } }
    }
    nloc = mine > 0u ? mine : 1u; nx = cnt > 0u ? cnt : 1u;
}

__device__ __forceinline__ void xcd_barrier(const XcdBarrier& b) {
    asm volatile("s_waitcnt vmcnt(0)" ::: "memory");
    __syncthreads();
    if (threadIdx.x == 0) {
        unsigned* bar = b.bar;
        __builtin_amdgcn_s_waitcnt(0);
        unsigned nloc = b.st[0], nx = b.st[1];
        if (nloc == 0u) { xcd_barrier_complete(bar, b.x, nloc, nx); b.st[0] = nloc; b.st[1] = nx; }
        const unsigned old = xb_add(&bar[XB_XSUB(b.x)], 1u);
        const unsigned gen = old / nloc;
        if (old + 1u == (gen + 1u) * nloc) {
            __builtin_amdgcn_fence(__ATOMIC_RELEASE, "agent");
            asm volatile("s_waitcnt vmcnt(0)" ::: "memory");
            const unsigned og = xb_add(&bar[XB_TOP], 1u);
            const unsigned tg = og / nx;
            if (og + 1u == (tg + 1u) * nx) xb_add(&bar[XB_TOPGEN], 1u);
            else XB_SPIN(xb_ld(&bar[XB_TOPGEN]) == tg, bar);
            __builtin_amdgcn_fence(__ATOMIC_ACQUIRE, "agent");
            xb_add(&bar[XB_XGEN(b.x)], 1u);
            asm volatile("s_waitcnt vmcnt(0)" ::: "memory");
        } else {
            XB_SPIN(xb_ld(&bar[XB_XGEN(b.x)]) == gen, bar);
            __builtin_amdgcn_fence(__ATOMIC_ACQUIRE, "agent");
            asm volatile("s_waitcnt vmcnt(0)" ::: "memory");
        }
    }
    __syncthreads();
}


namespace pg8 {
#define PG8_LAS __attribute__((address_space(3)))
typedef short bf16x8 __attribute__((ext_vector_type(8)));
constexpr int BM = 256, BK = 64, HALF = 128, HTB = HALF * BK * 2  , STAGE_BYTES = 8 * HTB, NXCD = 8, WGM = 8;

__host__ __device__ __forceinline__ int lds_byte(int r, int c) { const int st = (r >> 4) * 2 + (c >> 5), rr = r & 15, cc = c & 31, ob = rr * 64 + cc * 2; return st * 1024 + (ob ^ (((ob >> 9) & 1) << 5)); }
__host__ __device__ __forceinline__ void stage_rc(int b, int& R, int& C) { const int st = b / 1024, sb = b % 1024, swz = sb ^ (((sb >> 9) & 1) << 5); R = (st >> 1) * 16 + swz / 64; C = (st & 1) * 32 + (swz % 64) / 2; }
__host__ __device__ __forceinline__ int perm32(int rho) { const int n = rho >> 4, i = rho & 15; return 8 * (i >> 2) + 4 * n + (i & 3); }

struct Unit { int pm, pn; };
struct Gemm { const bf16_t* A; const bf16_t* Bt; int M, N, K; };

struct StaticOrder {
    int nM, nN, nwg, G, c;
    __host__ __device__ void init(int M, int N, int G_, int c_) { nM = M / BM; nN = N / BM; nwg = nM * nN; G = G_; c = c_; }
    __host__ __device__ bool next(int i, Unit& u) const {
        const long L = (long)i * G + c; if (L >= nwg) return false;
        int wgid = (int)L; { const int q = nwg / NXCD, r = nwg % NXCD, xcd = wgid % NXCD, off = wgid / NXCD; wgid = (xcd < r ? xcd * (q + 1) : r * (q + 1) + (xcd - r) * q) + off; }
        const int nig = WGM * nN, gid = wgid / nig, fm = gid * WGM, gsz = (nM - fm) < WGM ? (nM - fm) : WGM;
        u.pm = fm + ((wgid % nig) % gsz); u.pn = (wgid % nig) / gsz; return true;
    }
    __device__ __forceinline__ void a_ready(const Unit&) const {}
    __device__ __forceinline__ void done(const Unit&) const {}
};
template <class Epi, class Sched, bool STAMP = false>
__device__ __forceinline__ void gemm_phase(PG8_LAS unsigned char* lds, const Gemm g, const Sched& S, const Epi& E, unsigned long long* stamps) {
    int tid_ = threadIdx.x; asm volatile("" : "+v"(tid_));
    const int tid = tid_, wid = __builtin_amdgcn_readfirstlane(tid >> 6), lane = tid & 63, wr = wid >> 2, wc = wid & 3, fr = lane & 15, fq = lane >> 4;
    const int K = g.K, nt = K / BK;
    int ts_lo = 0, ts_hi = 0, nts = 0; const unsigned long long rt_entry = STAMP ? (unsigned long long)wall_clock64() : 0ull;
#define PG8_STAMP() do { if (STAMP && wid == 0 && nts < 64) { const unsigned long long _c = (unsigned long long)clock64(); \
        ts_lo = (lane == nts) ? (int)(unsigned)_c : ts_lo; ts_hi = (lane == nts) ? (int)(unsigned)(_c >> 32) : ts_hi; ++nts; } } while (0)
    PG8_STAMP();
    unsigned voffA[2], voffB[2];
#pragma unroll
    for (int i = 0; i < 2; ++i) { int R, C; stage_rc(tid * 16 + i * 8192, R, C); const int Rb = Epi::PERM ? ((R & ~31) + perm32(R & 31)) : R;
        voffA[i] = (unsigned)(R * K + C) * 2u; voffB[i] = (unsigned)(Rb * K + C) * 2u; }
    const size_t kstep = (size_t)(BK * 2);
    const size_t hstep = (size_t)HALF * K * 2;
    const size_t tstep = 2 * hstep;
    const unsigned ldsw = (unsigned)wid * 1024u;
    const int aoff = lds_byte(wr * 64 + fr, fq * 8), boff = lds_byte(wc * 32 + fr, fq * 8);
#define PG8_SA(b, h) (((b) * 2 + (h)) * HTB)
#define PG8_SB(b, h) ((4 + (b) * 2 + (h)) * HTB)
#define PG8_STAGE(bufoff, gbase, voff) do { _Pragma("unroll") for (int _i = 0; _i < 2; ++_i) \
        __builtin_amdgcn_global_load_lds((const unsigned*)((const char*)(gbase) + (voff)[_i]), (PG8_LAS unsigned*)(lds + (bufoff) + ldsw + _i * 8192), 16, 0, 0); } while (0)
#define PG8_LDA(dst, b, h) do { _Pragma("unroll") for (int m = 0; m < 4; ++m) _Pragma("unroll") for (int k = 0; k < 2; ++k) dst[m][k] = *(const PG8_LAS bf16x8*)(lds + PG8_SA(b, h) + aoff + m * 2048 + k * 1024); } while (0)
#define PG8_LDB(dst, b, h) do { _Pragma("unroll") for (int n = 0; n < 2; ++n) _Pragma("unroll") for (int k = 0; k < 2; ++k) dst[n][k] = *(const PG8_LAS bf16x8*)(lds + PG8_SB(b, h) + boff + n * 2048 + k * 1024); } while (0)
#define PG8_MMA(ai, bj, At, Bt) do { __builtin_amdgcn_s_setprio(1); _Pragma("unroll") for (int m = 0; m < 4; ++m) _Pragma("unroll") for (int n = 0; n < 2; ++n) _Pragma("unroll") for (int k = 0; k < 2; ++k) \
        acc[ai][bj][m][n] = __builtin_amdgcn_mfma_f32_16x16x32_bf16(Bt[n][k], At[m][k], acc[ai][bj][m][n], 0, 0, 0); __builtin_amdgcn_s_setprio(0); } while (0)
#define PG8_WAIT_V(n) asm volatile("s_waitcnt vmcnt(" #n ")" ::: "memory")
#define PG8_WAIT_L(n) asm volatile("s_waitcnt lgkmcnt(" #n ")" ::: "memory")
#define PG8_BAR __builtin_amdgcn_s_barrier()
#define PG8_SCHED __builtin_amdgcn_sched_barrier(0)
    Unit cur, nxt; int ui = 0;
    if (!S.next(0, cur)) return;
    f32x4 acc[2][2][4][2];
#pragma unroll
    for (int a = 0; a < 2; ++a)
#pragma unroll
        for (int b = 0; b < 2; ++b)
#pragma unroll
            for (int m = 0; m < 4; ++m)
#pragma unroll
                for (int n = 0; n < 2; ++n) acc[a][b][m][n] = (f32x4){0.f, 0.f, 0.f, 0.f};
    bf16x8 At[4][2], B0[2][2], B1[2][2];
    const char* cA = (const char*)g.A + (size_t)cur.pm * tstep; const char* cB = (const char*)g.Bt + (size_t)cur.pn * tstep;
    S.a_ready(cur);
    PG8_STAGE(PG8_SB(0, 0), cB, voffB); PG8_STAGE(PG8_SA(0, 0), cA, voffA); PG8_STAGE(PG8_SB(0, 1), cB + hstep, voffB); PG8_STAGE(PG8_SA(0, 1), cA + hstep, voffA);
    if (wr == 1) PG8_BAR;
    PG8_WAIT_V(4); PG8_BAR;
    PG8_STAGE(PG8_SB(1, 0), cB + kstep, voffB); PG8_STAGE(PG8_SA(1, 0), cA + kstep, voffA); PG8_STAGE(PG8_SB(1, 1), cB + hstep + kstep, voffB);
    PG8_WAIT_V(6); PG8_BAR;
    PG8_STAMP();
    for (;;) {
        const bool has_next = S.next(ui + 1, nxt);
        const char* nA = has_next ? (const char*)g.A + (size_t)nxt.pm * tstep : cA; const char* nB = has_next ? (const char*)g.Bt + (size_t)nxt.pn * tstep : cB;
        for (int t = 0; t < nt; t += 2) {
            const bool last = (t == nt - 2);
            const char* a1 = cA + (size_t)(t + 1) * kstep;
            const char* a2 = last ? nA : cA + (size_t)(t + 2) * kstep; const char* b2 = last ? nB : cB + (size_t)(t + 2) * kstep;
            const char* a3 = a2 + kstep; const char* b3 = b2 + kstep;
            if (last && has_next) S.a_ready(nxt);
            PG8_LDB(B0, 0, 0); PG8_SCHED; PG8_LDA(At, 0, 0); PG8_STAGE(PG8_SA(1, 1), a1 + hstep, voffA);
            PG8_WAIT_L(8); PG8_BAR; PG8_WAIT_L(0); PG8_MMA(0, 0, At, B0); PG8_BAR; PG8_SCHED;
            PG8_LDB(B1, 0, 1); PG8_STAGE(PG8_SB(0, 0), b2, voffB);
            PG8_BAR; PG8_WAIT_L(0); PG8_MMA(0, 1, At, B1); PG8_BAR;
            PG8_LDA(At, 0, 1); PG8_STAGE(PG8_SA(0, 0), a2, voffA);
            PG8_BAR; PG8_WAIT_L(0); PG8_MMA(1, 0, At, B0); PG8_BAR; PG8_SCHED;
            PG8_STAGE(PG8_SB(0, 1), b2 + hstep, voffB);
            PG8_WAIT_V(6); PG8_BAR; PG8_MMA(1, 1, At, B1); PG8_BAR;
            PG8_LDB(B0, 1, 0); PG8_SCHED; PG8_LDA(At, 1, 0); PG8_STAGE(PG8_SA(0, 1), a2 + hstep, voffA);
            PG8_WAIT_L(8); PG8_BAR; PG8_WAIT_L(0); PG8_MMA(0, 0, At, B0); PG8_BAR; PG8_SCHED;
            PG8_LDB(B1, 1, 1); PG8_STAGE(PG8_SB(1, 0), b3, voffB);
            PG8_BAR; PG8_WAIT_L(0); PG8_MMA(0, 1, At, B1); PG8_BAR;
            PG8_LDA(At, 1, 1); PG8_STAGE(PG8_SA(1, 0), a3, voffA);
            PG8_BAR; PG8_WAIT_L(0); PG8_MMA(1, 0, At, B0); PG8_BAR; PG8_SCHED;
            PG8_STAGE(PG8_SB(1, 1), b3 + hstep, voffB);
            PG8_WAIT_V(6); PG8_BAR; PG8_MMA(1, 1, At, B1); PG8_BAR;
        }
        PG8_STAMP();
        if constexpr (!Epi::AFTER_DRAIN) { E(acc, cur, wr, wc, fr, fq); S.done(cur); }
        PG8_STAMP();
        if (!has_next) break;
#pragma unroll
        for (int a = 0; a < 2; ++a)
#pragma unroll
            for (int b = 0; b < 2; ++b)
#pragma unroll
                for (int m = 0; m < 4; ++m)
#pragma unroll
                    for (int n = 0; n < 2; ++n) acc[a][b][m][n] = (f32x4){0.f, 0.f, 0.f, 0.f};
        cur = nxt; cA = nA; cB = nB; ++ui;
    }
    PG8_WAIT_V(0);
    if (wr == 0) PG8_BAR;
    PG8_BAR;
    if constexpr (Epi::AFTER_DRAIN) { E.fused(acc, cur, wr, wc, fr, fq, lds, wid, lane); S.done(cur); }
    PG8_STAMP();
    if (STAMP && wid == 0) { stamps[lane] = lane < nts ? (((unsigned long long)(unsigned)ts_hi << 32) | (unsigned)ts_lo) : 0ull;
        if (lane == 62) stamps[62] = rt_entry; if (lane == 63) stamps[63] = (unsigned long long)wall_clock64(); }
#undef PG8_STAMP
#undef PG8_SA
#undef PG8_SB
#undef PG8_STAGE
#undef PG8_LDA
#undef PG8_LDB
#undef PG8_MMA
#undef PG8_WAIT_V
#undef PG8_WAIT_L
#undef PG8_BAR
#undef PG8_SCHED
}
}
#define LAS3 __attribute__((address_space(3)))
constexpr int MK_THREADS = 512;
constexpr float U4_ISCALE = 83.0f;
typedef __bf16 bf16x2_t __attribute__((ext_vector_type(2)));
DI float dot2bf(unsigned a, unsigned b, float c) { return __builtin_amdgcn_fdot2_f32_bf16(__builtin_bit_cast(bf16x2_t, a), __builtin_bit_cast(bf16x2_t, b), c, false); }
DI float bflo(unsigned v) { return __uint_as_float(v << 16); }
DI float bfhi(unsigned v) { return __uint_as_float(v & 0xffff0000u); }

template <class ColMap>
DI void transpose_tile(const float* __restrict__ src, int ldsrc, const float* __restrict__ gain, bf16_t* __restrict__ dst, int K, int k0, int n0, const ColMap& cm, LAS3 float* tl) {
    const int tid = threadIdx.x;
    __syncthreads();
    {
        const int n = tid & 63, sc = cm(n0 + n);
#pragma unroll
        for (int j = 0; j < 8; ++j) { const int k = (tid >> 6) + 8 * j; tl[k * 65 + n] = sc >= 0 ? src[(size_t)(k0 + k) * ldsrc + sc] * (gain ? gain[k0 + k] : 1.0f) : 0.f; }
    }
    __syncthreads();
    {
        const int n = tid >> 3, k8 = (tid & 7) * 8;
        u32x4 w;
        w.x = pack2bf(tl[(k8 + 0) * 65 + n], tl[(k8 + 1) * 65 + n]); w.y = pack2bf(tl[(k8 + 2) * 65 + n], tl[(k8 + 3) * 65 + n]);
        w.z = pack2bf(tl[(k8 + 4) * 65 + n], tl[(k8 + 5) * 65 + n]); w.w = pack2bf(tl[(k8 + 6) * 65 + n], tl[(k8 + 7) * 65 + n]);
        *(u32x4*)(dst + (size_t)(n0 + n) * K + k0 + k8) = w;
    }
}
struct ColId { DI int operator()(int n) const { return n; } };
struct ColWin { DI int operator()(int n) const { return n < PC_XR ? n : (n < PC_XG ? 1304 + (n - PC_XR) : (n < PC_GATE ? 1816 + (n - PC_XG) : (n < PC_GATE + 24 ? 1280 + (n - PC_GATE) : -1))); } };

DI void cvt_rows_bf16(const float* __restrict__ src, const float* __restrict__ gain, bf16_t* __restrict__ dst, size_t n8, int cols, size_t gtid, size_t nthr) {
    for (size_t i0 = gtid; i0 < n8; i0 += 8 * nthr) {
        f32x4 a[8], b[8];
#pragma unroll
        for (int u = 0; u < 8; ++u) { const size_t i = i0 + u * nthr; if (i < n8) { a[u] = *(const f32x4*)(src + i * 8); b[u] = *(const f32x4*)(src + i * 8 + 4); } }
#pragma unroll
        for (int u = 0; u < 8; ++u) { const size_t i = i0 + u * nthr; if (i < n8) {
            f32x4 x = a[u], y = b[u];
            if (gain) { const int c = (int)((i * 8) % cols); x *= *(const f32x4*)(gain + c); y *= *(const f32x4*)(gain + c + 4); }
            u32x4 w; w.x = pack2bf(x[0], x[1]); w.y = pack2bf(x[2], x[3]); w.z = pack2bf(y[0], y[1]); w.w = pack2bf(y[2], y[3]);
            *(u32x4*)(dst + i * 8) = w; } }
    }
}
DI void cvt_rows_i4(const float* __restrict__ src, const float* __restrict__ gain, float scale, unsigned char* __restrict__ dst, size_t n8, int cols, size_t gtid, size_t nthr) {
    for (size_t i0 = gtid; i0 < n8; i0 += 8 * nthr) {
        f32x4 a[8], b[8];
#pragma unroll
        for (int u = 0; u < 8; ++u) { const size_t i = i0 + u * nthr; if (i < n8) { a[u] = *(const f32x4*)(src + i * 8); b[u] = *(const f32x4*)(src + i * 8 + 4); } }
#pragma unroll
        for (int u = 0; u < 8; ++u) { const size_t i = i0 + u * nthr; if (i < n8) {
            f32x4 x = a[u], y = b[u];
            if (gain) { const int c = (int)((i * 8) % cols); x *= *(const f32x4*)(gain + c); y *= *(const f32x4*)(gain + c + 4); }
            unsigned w = 0u;
#pragma unroll
            for (int j = 0; j < 4; ++j) {
                const int qa = (int)rintf(fminf(fmaxf(x[j] * scale, -7.f), 7.f)), qb = (int)rintf(fminf(fmaxf(y[j] * scale, -7.f), 7.f));
                w |= ((unsigned)qa & 0xfu) << (4 * j); w |= ((unsigned)qb & 0xfu) << (16 + 4 * j);
            }
            { const unsigned n1 = __shfl_down(w, 1), n2 = __shfl_down(w, 2), n3 = __shfl_down(w, 3); if ((threadIdx.x & 3) == 0) *(u32x4*)(dst + i * 4) = (u32x4){w, n1, n2, n3}; } } }
    }
}
DI void cvt_rows_fp4(const float* __restrict__ src, const float* __restrict__ gain, float scale, unsigned char* __restrict__ dst, size_t n8, int cols, size_t gtid, size_t nthr) {
    for (size_t i0 = gtid; i0 < n8; i0 += 8 * nthr) {
        f32x4 a[8], b[8];
#pragma unroll
        for (int u = 0; u < 8; ++u) { const size_t i = i0 + u * nthr; if (i < n8) { a[u] = *(const f32x4*)(src + i * 8); b[u] = *(const f32x4*)(src + i * 8 + 4); } }
#pragma unroll
        for (int u = 0; u < 8; ++u) { const size_t i = i0 + u * nthr; if (i < n8) {
            f32x4 x = a[u], y = b[u];
            if (gain) { const int c = (int)((i * 8) % cols); x *= *(const f32x4*)(gain + c); y *= *(const f32x4*)(gain + c + 4); }
            x *= scale; y *= scale;
            unsigned w = 0u;
            w = __builtin_amdgcn_cvt_scalef32_pk_fp4_f32(w, x[0], x[1], 1.0f, 0); w = __builtin_amdgcn_cvt_scalef32_pk_fp4_f32(w, x[2], x[3], 1.0f, 1);
            w = __builtin_amdgcn_cvt_scalef32_pk_fp4_f32(w, y[0], y[1], 1.0f, 2); w = __builtin_amdgcn_cvt_scalef32_pk_fp4_f32(w, y[2], y[3], 1.0f, 3);
            { const unsigned n1 = __shfl_down(w, 1), n2 = __shfl_down(w, 2), n3 = __shfl_down(w, 3); if ((threadIdx.x & 3) == 0) *(u32x4*)(dst + i * 4) = (u32x4){w, n1, n2, n3}; } } }
    }
}
DI void p1_deferred(const Params& p, int G) {
    const int nunits = (NTOK / 256) * (NPROJ / 256), nfull = nunits % G;
    const int first = nfull == 0 ? 0 : nfull, nwg = G - first;
    if ((int)blockIdx.x < first) return;
    const size_t gtid = (size_t)(blockIdx.x - first) * MK_THREADS + threadIdx.x, nthr = (size_t)nwg * MK_THREADS;
    cvt_rows_i4(p.in[I_PEER_U], p.in[I_FFN_NORM], U4_ISCALE, (unsigned char*)(p.ws + WS_UB), (size_t)16384 * DM / 8, DM, gtid, nthr);
    cvt_rows_bf16(p.in[I_P], nullptr, (bf16_t*)(p.ws + WS_PB), (size_t)NTOK * PLE / 8, PLE, gtid, nthr);
}
DI void p0_prologue(const Params& p, LAS3 unsigned char* lds, int G) {
    unsigned char* ws = p.ws;
    const int tid = threadIdx.x, lane = tid & 63, wid = tid >> 6, bid = blockIdx.x;
    const size_t gtid = (size_t)bid * MK_THREADS + tid, nthr = (size_t)G * MK_THREADS;
    const int gw = bid * 8 + wid, nw = G * 8;
    {
        const float* x = p.in[I_X]; bf16_t* xb = (bf16_t*)(ws + WS_XB); float* rs0 = (float*)(ws + WS_RS0);
        for (int row0 = gw; row0 < NTOK; row0 += 4 * nw) {
            f32x4 v[4][4];
#pragma unroll
            for (int u = 0; u < 4; ++u) { const int row = row0 + u * nw; if (row < NTOK) { const float* xr_ = x + (size_t)row * DM + lane * 8;
                v[u][0] = *(const f32x4*)xr_; v[u][1] = *(const f32x4*)(xr_ + 4); v[u][2] = *(const f32x4*)(xr_ + 512); v[u][3] = *(const f32x4*)(xr_ + 516); } }
#pragma unroll
            for (int u = 0; u < 4; ++u) { const int row = row0 + u * nw; if (row < NTOK) {
                float s = 0.f;
#pragma unroll
                for (int j = 0; j < 4; ++j) s += (v[u][j][0] * v[u][j][0] + v[u][j][1] * v[u][j][1]) + (v[u][j][2] * v[u][j][2] + v[u][j][3] * v[u][j][3]);
                s = wave_sum(s);
                u32x4 w0, w1;
                w0.x = pack2bf(v[u][0][0], v[u][0][1]); w0.y = pack2bf(v[u][0][2], v[u][0][3]); w0.z = pack2bf(v[u][1][0], v[u][1][1]); w0.w = pack2bf(v[u][1][2], v[u][1][3]);
                w1.x = pack2bf(v[u][2][0], v[u][2][1]); w1.y = pack2bf(v[u][2][2], v[u][2][3]); w1.z = pack2bf(v[u][3][0], v[u][3][1]); w1.w = pack2bf(v[u][3][2], v[u][3][3]);
                *(u32x4*)(xb + (size_t)row * DM + lane * 8) = w0; *(u32x4*)(xb + (size_t)row * DM + 512 + lane * 8) = w1;
                if (lane == 0) rs0[row] = rsqrtf(s * (1.0f / DM) + EPS); } }
        }
    }
    cvt_rows_fp4(p.in[I_PEER_V], nullptr, 8.0f, (unsigned char*)(ws + WS_VB), (size_t)16384 * DM / 8, DM, gtid, nthr);
    LAS3 float* tl = (LAS3 float*)lds;
    {
        for (int u = bid; u < 1496; u += G) {
            if (u < 640) transpose_tile(p.in[I_W_IN], INCOLS, p.in[I_ATTN_NORM], (bf16_t*)(ws + WS_WIN), DM, (u % 16) * 64, (u / 16) * 64, ColWin{}, tl);
            else if (u < 896) { const int v = u - 640; transpose_tile(p.in[I_W_OUT], DM, nullptr, (bf16_t*)(ws + WS_WOUT), DM, (v % 16) * 64, (v / 16) * 64, ColId{}, tl); }
            else if (u < 1152) { const int v = u - 896; transpose_tile(p.in[I_PLE_WG], DM, p.in[I_PLE_NORM], (bf16_t*)(ws + WS_WG), DM, (v % 16) * 64, (v / 16) * 64, ColId{}, tl); }
            else if (u < 1216) { const int v = u - 1152; transpose_tile(p.in[I_PLE_PROJ], DM, nullptr, (bf16_t*)(ws + WS_WP), PLE, (v % 4) * 64, (v / 4) * 64, ColId{}, tl); }
            else if (u < 1344) { const int v = u - 1216; transpose_tile(p.in[I_CK_W1], 256, nullptr, (bf16_t*)(ws + WS_CW1K), 2048, (v % 32) * 64, (v / 32) * 64, ColId{}, tl); }
            else if (u < 1472) { const int v = u - 1344; transpose_tile(p.in[I_CV_W1], 256, nullptr, (bf16_t*)(ws + WS_CW1V), 2048, (v % 32) * 64, (v / 32) * 64, ColId{}, tl); }
            else if (u < 1480) { const int v = u - 1472; transpose_tile(p.in[I_LRU_WA] + v * 4096, 64, nullptr, (bf16_t*)(ws + WS_WAT) + v * 4096, 64, 0, 0, ColId{}, tl); }
            else if (u < 1488) { const int v = u - 1480; transpose_tile(p.in[I_LRU_WX] + v * 4096, 64, nullptr, (bf16_t*)(ws + WS_WXT) + v * 4096, 64, 0, 0, ColId{}, tl); }
            else if (u < 1492) { const int v = u - 1488; transpose_tile(p.in[I_CK_W2], 64, nullptr, (bf16_t*)(ws + WS_CW2K), 256, v * 64, 0, ColId{}, tl); }
            else { const int v = u - 1492; transpose_tile(p.in[I_CV_W2], 64, nullptr, (bf16_t*)(ws + WS_CW2V), 256, v * 64, 0, ColId{}, tl); }
        }
        __syncthreads();
    }
    {
        LAS3 float* wt = (LAS3 float*)lds;
        LAS3 float* st = (LAS3 float*)(lds + 32768);
        const float* wq = p.in[I_PEER_WQ]; const float* sub = p.in[I_PEER_SUB]; const float* gain = p.in[I_FFN_NORM]; bf16_t* WqsT = (bf16_t*)(ws + WS_WQS);
        for (int u = bid; u < 256; u += G) {
            const int hp = u >> 4, d0 = (u & 15) * 64, pp = hp & 1;
            __syncthreads();
            {
                f32x4 wv[4], sv[8];
#pragma unroll
                for (int u = 0; u < 4; ++u) { const int i = tid + u * MK_THREADS, d = i >> 5, dk4 = (i & 31) * 4; wv[u] = *(const f32x4*)(wq + (size_t)(d0 + d) * 2048 + hp * 128 + dk4); }
#pragma unroll
                for (int u = 0; u < 8; ++u) { const int i = tid + u * MK_THREADS, kk = i >> 5, dk4 = (i & 31) * 4; sv[u] = *(const f32x4*)(sub + ((size_t)pp * 128 + kk) * 128 + dk4); }
#pragma unroll
                for (int u = 0; u < 4; ++u) { const int i = tid + u * MK_THREADS, d = i >> 5, dk4 = (i & 31) * 4;
#pragma unroll
                    for (int j = 0; j < 4; ++j) wt[(dk4 + j) * 64 + d] = wv[u][j]; }
#pragma unroll
                for (int u = 0; u < 8; ++u) { const int i = tid + u * MK_THREADS, kk = i >> 5, dk4 = (i & 31) * 4;
#pragma unroll
                    for (int j = 0; j < 4; ++j) st[kk * 129 + dk4 + j] = sv[u][j]; }
            }
            __syncthreads();
            const int kk = tid & 127, dg = (tid >> 7) * 16;
            float acc[16];
#pragma unroll
            for (int j = 0; j < 16; ++j) acc[j] = 0.f;
            for (int dk = 0; dk < 128; ++dk) {
                const float sv = st[kk * 129 + dk];
#pragma unroll
                for (int j4 = 0; j4 < 4; ++j4) { const f32x4 w4 = *(LAS3 f32x4*)(wt + dk * 64 + dg + j4 * 4);
#pragma unroll
                    for (int j = 0; j < 4; ++j) acc[j4 * 4 + j] += sv * w4[j]; }
            }
            u32x4 o0, o1;
#define GQ(j) (acc[j] * gain[d0 + dg + (j)])
            o0.x = pack2bf(GQ(0), GQ(1)); o0.y = pack2bf(GQ(2), GQ(3)); o0.z = pack2bf(GQ(4), GQ(5)); o0.w = pack2bf(GQ(6), GQ(7));
            o1.x = pack2bf(GQ(8), GQ(9)); o1.y = pack2bf(GQ(10), GQ(11)); o1.z = pack2bf(GQ(12), GQ(13)); o1.w = pack2bf(GQ(14), GQ(15));
#undef GQ
            bf16_t* dst = WqsT + (size_t)(hp * 128 + kk) * DM + d0 + dg;
            *(u32x4*)dst = o0; *(u32x4*)(dst + 8) = o1;
        }
        __syncthreads();
    }
    for (int o = gw; o < 512; o += nw) {
        const int kv = o >> 8, j = o & 255;
        const float* pe = p.in[kv ? I_CV_PE : I_CK_PE]; const float* w1 = p.in[kv ? I_CV_W1 : I_CK_W1];
        float acc = 0.f;
        for (int k = lane; k < 2048; k += 64) acc += pe[k] * w1[(size_t)k * 256 + j];
        acc = wave_sum(acc);
        if (lane == 0) ((float*)(ws + (kv ? WS_CBV : WS_CBK)))[j] = acc;
    }
}

DI void p6_peer_apply(const Params& p, int G) {
    unsigned char* ws = p.ws;
    const int tid = threadIdx.x, lane = tid & 63, wid = tid >> 6;
    const int gw = blockIdx.x * 8 + wid, nw = G * 8;
    const bf16_t* ub = (const bf16_t*)(ws + WS_UB); const bf16_t* vb = (const bf16_t*)(ws + WS_VB);
    const int* eidx = (const int*)(ws + R_EXP); const float* gsm = (const float*)(ws + R_GSM); const float* ssq1 = (const float*)(ws + WS_SSQ1);
    float* h = p.out; bf16_t* hb = (bf16_t*)(ws + R_H1B); float* rs2 = (float*)(ws + WS_RS2);
    for (int tok = gw; tok < NTOK; tok += nw) {
        float sq = lane < 16 ? ssq1[(size_t)lane * NTOK + tok] : 0.f;
        sq = wave_sum(sq);
        const float rs1 = rsqrtf(sq * (1.0f / DM) + EPS);
        const u32x4 xa = *(const u32x4*)(hb + (size_t)tok * DM + lane * 8), xc = *(const u32x4*)(hb + (size_t)tok * DM + 512 + lane * 8);
        const int e0 = eidx[(size_t)tok * 128 + lane], e1 = eidx[(size_t)tok * 128 + 64 + lane];
        const float g0 = gsm[(size_t)tok * 128 + lane], g1 = gsm[(size_t)tok * 128 + 64 + lane];
        float coef0 = 0.f, coef1 = 0.f;
#pragma unroll
        for (int half = 0; half < 2; ++half) {
            const int ev = half ? e1 : e0;
            float part[64];
#pragma unroll
            for (int j = 0; j < 64; ++j) {
                const int e = __builtin_amdgcn_readlane(ev, j);
                const bf16_t* ur = ub + (size_t)e * DM + lane * 8;
                const u32x4 ua = *(const u32x4*)ur, uc = *(const u32x4*)(ur + 512);
                float a = dot2bf(xa.x, ua.x, 0.f); a = dot2bf(xa.y, ua.y, a); a = dot2bf(xa.z, ua.z, a); a = dot2bf(xa.w, ua.w, a);
                a = dot2bf(xc.x, uc.x, a); a = dot2bf(xc.y, uc.y, a); a = dot2bf(xc.z, uc.z, a); a = dot2bf(xc.w, uc.w, a);
                part[j] = a;
            }
#pragma unroll
            for (int m = 32; m >= 1; m >>= 1) {
                const bool up = (lane & m) != 0;
#pragma unroll
                for (int i = 0; i < m; ++i) {
                    const float send = up ? part[i] : part[i + m];
                    const float keep = up ? part[i + m] : part[i];
                    part[i] = keep + __shfl_xor(send, m);
                }
            }
            const float act = gelu_tanh(part[0] * rs1);
            if (half) coef1 = g1 * act; else coef0 = g0 * act;
        }
        float acc[16];
#pragma unroll
        for (int i = 0; i < 16; ++i) acc[i] = 0.f;
#pragma unroll
        for (int half = 0; half < 2; ++half) {
            const int ev = half ? e1 : e0; const float cv = half ? coef1 : coef0;
#pragma unroll 16
            for (int j = 0; j < 64; ++j) {
                const int e = __builtin_amdgcn_readlane(ev, j);
                const float c = __uint_as_float(__builtin_amdgcn_readlane(__float_as_uint(cv), j));
                const bf16_t* vr = vb + (size_t)e * DM + lane * 8;
                const u32x4 va = *(const u32x4*)vr, vc = *(const u32x4*)(vr + 512);
                acc[0] += c * bflo(va.x); acc[1] += c * bfhi(va.x); acc[2] += c * bflo(va.y); acc[3] += c * bfhi(va.y);
                acc[4] += c * bflo(va.z); acc[5] += c * bfhi(va.z); acc[6] += c * bflo(va.w); acc[7] += c * bfhi(va.w);
                acc[8] += c * bflo(vc.x); acc[9] += c * bfhi(vc.x); acc[10] += c * bflo(vc.y); acc[11] += c * bfhi(vc.y);
                acc[12] += c * bflo(vc.z); acc[13] += c * bfhi(vc.z); acc[14] += c * bflo(vc.w); acc[15] += c * bfhi(vc.w);
            }
        }
        float* hr = h + (size_t)tok * DM + lane * 8;
        f32x4 h0 = *(f32x4*)hr, h1 = *(f32x4*)(hr + 4), h2 = *(f32x4*)(hr + 512), h3 = *(f32x4*)(hr + 516);
        h0 += (f32x4){acc[0], acc[1], acc[2], acc[3]}; h1 += (f32x4){acc[4], acc[5], acc[6], acc[7]};
        h2 += (f32x4){acc[8], acc[9], acc[10], acc[11]}; h3 += (f32x4){acc[12], acc[13], acc[14], acc[15]};
        *(f32x4*)hr = h0; *(f32x4*)(hr + 4) = h1; *(f32x4*)(hr + 512) = h2; *(f32x4*)(hr + 516) = h3;
        u32x4 w0, w1;
        w0.x = pack2bf(h0[0], h0[1]); w0.y = pack2bf(h0[2], h0[3]); w0.z = pack2bf(h1[0], h1[1]); w0.w = pack2bf(h1[2], h1[3]);
        w1.x = pack2bf(h2[0], h2[1]); w1.y = pack2bf(h2[2], h2[3]); w1.z = pack2bf(h3[0], h3[1]); w1.w = pack2bf(h3[2], h3[3]);
        *(u32x4*)(hb + (size_t)tok * DM + lane * 8) = w0; *(u32x4*)(hb + (size_t)tok * DM + 512 + lane * 8) = w1;
        float s = 0.f;
#pragma unroll
        for (int j = 0; j < 4; ++j) s += h0[j] * h0[j] + h1[j] * h1[j] + h2[j] * h2[j] + h3[j] * h3[j];
        s = wave_sum(s);
        if (lane == 0) rs2[tok] = rsqrtf(s * (1.0f / DM) + EPS);
    }
}

DI void p8_final_norm(const Params& p, int G) {
    const int lane = threadIdx.x & 63, gw = blockIdx.x * 8 + (threadIdx.x >> 6), nw = G * 8;
    const float* ssq3 = (const float*)(p.ws + WS_SSQ3); const float* g = p.in[I_FINAL_NORM]; const bf16_t* h3 = (const bf16_t*)(p.ws + WS_XB); float* out = p.out;
    f32x4 gg[4];
    gg[0] = *(const f32x4*)(g + lane * 8); gg[1] = *(const f32x4*)(g + lane * 8 + 4); gg[2] = *(const f32x4*)(g + 512 + lane * 8); gg[3] = *(const f32x4*)(g + 512 + lane * 8 + 4);
    for (int row0 = gw; row0 < NTOK; row0 += 4 * nw) {
        u32x4 va[4], vb[4]; float sq[4];
#pragma unroll
        for (int u = 0; u < 4; ++u) { const int row = row0 + u * nw; if (row < NTOK) { sq[u] = lane < 16 ? ssq3[(size_t)lane * NTOK + row] : 0.f;
            va[u] = *(const u32x4*)(h3 + (size_t)row * DM + lane * 8); vb[u] = *(const u32x4*)(h3 + (size_t)row * DM + 512 + lane * 8); } }
#pragma unroll
        for (int u = 0; u < 4; ++u) { const int row = row0 + u * nw; if (row < NTOK) {
            const float rs = rsqrtf(wave_sum(sq[u]) * (1.0f / DM) + EPS);
            float* o = out + (size_t)row * DM + lane * 8;
            *(f32x4*)o = (f32x4){bflo(va[u].x), bfhi(va[u].x), bflo(va[u].y), bfhi(va[u].y)} * rs * gg[0];
            *(f32x4*)(o + 4) = (f32x4){bflo(va[u].z), bfhi(va[u].z), bflo(va[u].w), bfhi(va[u].w)} * rs * gg[1];
            *(f32x4*)(o + 512) = (f32x4){bflo(vb[u].x), bfhi(vb[u].x), bflo(vb[u].y), bfhi(vb[u].y)} * rs * gg[2];
            *(f32x4*)(o + 516) = (f32x4){bflo(vb[u].z), bfhi(vb[u].z), bflo(vb[u].w), bfhi(vb[u].w)} * rs * gg[3]; } }
    }
}
typedef float f32x16 __attribute__((ext_vector_type(16)));
typedef short bf16x8v __attribute__((ext_vector_type(8)));
typedef __bf16 bf16x2v_ __attribute__((ext_vector_type(2)));
DI unsigned pk_bf16(float lo, float hi) { return __builtin_bit_cast(unsigned, __builtin_convertvector((f32x2){lo, hi}, bf16x2v_)); }
constexpr float LOG2E = 1.4426950408889634f;
constexpr int AT_KROW = 144, AT_VROW = 136;
constexpr int AT_KT = 64 * AT_KROW, AT_VT = 64 * AT_VROW, AT_BUF = 2 * AT_KT + 2 * AT_VT;
constexpr int AT_VAL = 0;
constexpr int AT_LUT = 2 * AT_BUF;
constexpr int AT_IMP = AT_LUT + 8 * 128 * 4;
constexpr int AT_SEL = AT_IMP + 8 * 32 * 65 * 4;
constexpr int AT_SSQ = AT_SEL + 512;
constexpr int AT_END = AT_SSQ + 1024;
static_assert(AT_END <= 160 * 1024 - 256, "attention LDS map");

struct AtSrc { const bf16_t* k0; const bf16_t* k1; const bf16_t* v0; const bf16_t* v1; int vld; };
DI void at_load(const AtSrc& s, int kpos, int tid, u32x4 (&r)[4]) {
    const int row = tid >> 3, seg = tid & 7;
    r[0] = *(const u32x4*)(s.k0 + (size_t)(kpos + row) * HD + seg * 8);
    r[1] = *(const u32x4*)(s.k1 + (size_t)(kpos + row) * HD + seg * 8);
    r[2] = *(const u32x4*)(s.v0 + (size_t)row * s.vld + kpos + seg * 8);
    r[3] = *(const u32x4*)(s.v1 + (size_t)row * s.vld + kpos + seg * 8);
}
DI void at_store(LAS3 unsigned char* buf, int tid, const u32x4 (&r)[4]) {
    const int row = tid >> 3, seg = tid & 7;
    *(LAS3 u32x4*)(buf + row * AT_KROW + seg * 16) = r[0];
    *(LAS3 u32x4*)(buf + AT_KT + row * AT_KROW + seg * 16) = r[1];
    LAS3 unsigned char* v = buf + 2 * AT_KT + row * AT_VROW + seg * 16;
    *(LAS3 u32x2*)(v) = (u32x2){r[2].x, r[2].y}; *(LAS3 u32x2*)(v + 8) = (u32x2){r[2].z, r[2].w};
    *(LAS3 u32x2*)(v + AT_VT) = (u32x2){r[3].x, r[3].y}; *(LAS3 u32x2*)(v + AT_VT + 8) = (u32x2){r[3].z, r[3].w};
}

template <int MODE, int PASS, int APROBE>
DI void at_step(LAS3 const unsigned char* Kb, LAS3 const unsigned char* Vb, const bf16x8v (&Q)[4], int k0, int tq, int lane, LAS3 const float* lut, bool blk_ok, bool farstep,
                float& m_run, float& l_run, f32x16 (&O)[2], float inv_l, LAS3 float* imp_row, float& bcarry) {
    const int r = lane & 31, hf = lane >> 5;
    f32x16 S[2];
#pragma unroll
    for (int sub = 0; sub < 2; ++sub) {
#pragma unroll
        for (int i = 0; i < 16; ++i) S[sub][i] = 0.f;
#pragma unroll
        for (int ks = 0; ks < 4; ++ks) {
            const bf16x8v a = *(LAS3 const bf16x8v*)(Kb + (32 * sub + r) * AT_KROW + 32 * ks + 16 * hf);
            if (APROBE < 3) S[sub] = __builtin_amdgcn_mfma_f32_32x32x16_bf16(a, Q[ks], S[sub], 0, 0, 0);
            else S[sub][ks] += __builtin_bit_cast(float, (int)a[0] | ((int)a[1] << 16));
        }
    }
    __builtin_amdgcn_sched_barrier(0);
    float mx = -INFINITY;
    const float bfar = lut[127];
    if (APROBE >= 2) { mx = S[0][0]; } else
    if (!farstep) {
#pragma unroll
        for (int sub = 0; sub < 2; ++sub)
#pragma unroll
            for (int i = 0; i < 16; ++i) {
                const int kp = k0 + 32 * sub + (i & 3) + 8 * (i >> 2) + 4 * hf;
                const int dist = MODE == 0 ? tq - (16 * kp + 31) : tq - kp;
                bool ok = dist >= 0 && blk_ok;
                if (MODE == 2) ok = ok && dist < 512;
                const int idx = dist < 0 ? 0 : (dist > 127 ? 127 : dist);
                float s = S[sub][i] + lut[idx];
                s = ok ? s : -INFINITY;
                S[sub][i] = s; mx = fmaxf(mx, s);
            }
    } else {
#pragma unroll
        for (int sub = 0; sub < 2; ++sub)
#pragma unroll
            for (int i = 0; i < 16; ++i) mx = fmaxf(mx, S[sub][i]);
        mx += bfar;
        if (MODE == 1) mx = blk_ok ? mx : -INFINITY;
    }
    if (APROBE >= 2) { l_run += mx; } else
    if (PASS != 2) {
        mx = fmaxf(mx, __shfl_xor(mx, 32));
        const float m_new = fmaxf(m_run, mx), m_safe = (m_new == -INFINITY) ? 0.f : m_new;
        const float alpha = __builtin_amdgcn_exp2f(m_run - m_safe);
        float m_use = farstep ? m_safe - bfar : m_safe;
        if (MODE == 1 && farstep) m_use = blk_ok ? m_use : INFINITY;
        float sum = 0.f;
#pragma unroll
        for (int sub = 0; sub < 2; ++sub)
#pragma unroll
            for (int i = 0; i < 16; ++i) { const float pv = __builtin_amdgcn_exp2f(S[sub][i] - m_use); S[sub][i] = pv; sum += pv; }
        l_run = l_run * alpha + sum; m_run = m_new;
        if (PASS == 0) {
            if (__any(alpha != 1.0f)) {
#pragma unroll
                for (int db = 0; db < 2; ++db)
#pragma unroll
                    for (int i = 0; i < 16; ++i) O[db][i] *= alpha;
            }
        }
    } else {
        const float mu = farstep ? m_run - bfar : m_run;
#pragma unroll
        for (int sub = 0; sub < 2; ++sub) {
#pragma unroll
            for (int i = 0; i < 16; ++i) S[sub][i] = __builtin_amdgcn_exp2f(S[sub][i] - mu) * inv_l;
            float bp[4], av[4];
#pragma unroll
            for (int a = 0; a < 4; ++a) {
                av[a] = S[sub][4 * a] + S[sub][4 * a + 1] + S[sub][4 * a + 2] + 0.5f * S[sub][4 * a + 3];
                bp[a] = __shfl_xor(0.5f * S[sub][4 * a + 3], 32);
            }
            const int sbase = (k0 >> 2) + 8 * sub + hf;
#pragma unroll
            for (int a = 0; a < 4; ++a) imp_row[sbase + 2 * a] = av[a] + (hf ? bp[a] : (a > 0 ? bp[a > 0 ? a - 1 : 0] : bcarry));
            bcarry = bp[3];
        }
    }
    __builtin_amdgcn_sched_barrier(0);
    if (PASS != 1) {
#pragma unroll
        for (int sub = 0; sub < 2; ++sub)
#pragma unroll
            for (int s2 = 0; s2 < 2; ++s2) {
                u32x4 pw;
                pw.x = pk_bf16(S[sub][8 * s2 + 0], S[sub][8 * s2 + 1]); pw.y = pk_bf16(S[sub][8 * s2 + 2], S[sub][8 * s2 + 3]);
                pw.z = pk_bf16(S[sub][8 * s2 + 4], S[sub][8 * s2 + 5]); pw.w = pk_bf16(S[sub][8 * s2 + 6], S[sub][8 * s2 + 7]);
                const bf16x8v pf = __builtin_bit_cast(bf16x8v, pw);
#pragma unroll
                for (int db = 0; db < 2; ++db) {
                    LAS3 const unsigned char* va = Vb + (32 * db + r) * AT_VROW + (32 * sub + 16 * s2 + 4 * hf) * 2;
                    const u32x2 v0 = *(LAS3 const u32x2*)va, v1 = *(LAS3 const u32x2*)(va + 16);
                    const bf16x8v vf = __builtin_bit_cast(bf16x8v, (u32x4){v0.x, v0.y, v1.x, v1.y});
                    if (APROBE < 3) O[db] = __builtin_amdgcn_mfma_f32_32x32x16_bf16(vf, pf, O[db], 0, 0, 0); else O[db][s2] += __builtin_bit_cast(float, (int)vf[0] | ((int)pf[1] << 16));
                }
            }
    }
}

template <int MODE, int PASS, int APROBE>
DI void at_branch(LAS3 unsigned char* lds, const AtSrc& src, int blk_lo, int blk_hi, const bf16x8v (&Q)[4], int tq, int tid, int kvh, LAS3 const float* lut,
                  unsigned mlo, unsigned mhi, float& m_run, float& l_run, f32x16 (&O)[2], float inv_l, LAS3 float* imp_row) {
    const int lane = tid & 63;
    u32x4 st[4];
    float bcarry = 0.f;
    at_load(src, blk_lo * 64, tid, st);
    for (int blk = blk_lo; blk <= blk_hi; ++blk) {
        LAS3 unsigned char* buf = lds + ((blk - blk_lo) & 1) * AT_BUF;
        at_store(buf, tid, st);
        __syncthreads();
        if (blk < blk_hi) at_load(src, (blk + 1) * 64, tid, st);
        bool blk_ok = true;
        if (MODE == 1) blk_ok = ((blk < 32 ? (mlo >> blk) : (mhi >> (blk - 32))) & 1u) != 0u;
        const int t0u = tq - (lane & 31);
        const bool farstep = MODE == 0 ? (t0u - 16 * (blk * 64 + 63) - 31 >= 128) : (MODE == 1 ? (t0u - blk * 64 - 63 >= 128) : (t0u - blk * 64 - 63 >= 128 && t0u + 31 - blk * 64 < 512));
        if (MODE != 1 || __any(blk_ok)) {
            at_step<MODE, PASS, APROBE>(buf + kvh * AT_KT, buf + 2 * AT_KT + kvh * AT_VT, Q, blk * 64, tq, lane, lut, blk_ok, farstep, m_run, l_run, O, inv_l, imp_row, bcarry);
        }
    }
    __syncthreads();
}

template <int APROBE> DI void p3_attention(const Params& p, LAS3 unsigned char* lds, int G) {
    unsigned char* ws = p.ws;
    const int tid = threadIdx.x, lane = tid & 63, h = __builtin_amdgcn_readfirstlane(tid >> 6), kvh = h >> 2, r = lane & 31, hf = lane >> 5;
    LAS3 float* lutall = (LAS3 float*)(lds + AT_LUT);
    {
        const float* rel = p.in[I_REL];
        for (int i = tid; i < 1024; i += MK_THREADS) lutall[i] = rel[rel_bucket(i & 127) * NH + (i >> 7)] * LOG2E;
    }
    __syncthreads();
    LAS3 const float* lut = lutall + h * 128;
    LAS3 float* impw = (LAS3 float*)(lds + AT_IMP);
    LAS3 float* vals = (LAS3 float*)(lds + AT_VAL);
    LAS3 unsigned char* selb = lds + AT_SEL;
    LAS3 float* ssq = (LAS3 float*)(lds + AT_SSQ);
    const bf16_t* qb = (const bf16_t*)(ws + R_QB);
    const float* gates = (const float*)(ws + R_GATE);
    const float* gn = p.in[I_GN_ATTN];
    bf16_t* mixed = APROBE ? (bf16_t*)(ws + R_BIG + 32 * MB) : (bf16_t*)(ws + WS_MIXED);
    for (int ui = blockIdx.x; ui < 512; ui += G) {
        const int q8 = ui & 255, rnd = ui >> 8, b = q8 >> 6, j6 = q8 & 63, tb = rnd == 0 ? 127 - j6 : j6;
        const int t0 = 32 * tb, qb64 = tb >> 1, tq = t0 + r;
        const size_t tok = (size_t)b * T_ + tq;
        bf16x8v Q[4];
#pragma unroll
        for (int ks = 0; ks < 4; ++ks) Q[ks] = *(const bf16x8v*)(qb + tok * 512 + h * 64 + 16 * ks + 8 * hf);
        f32x16 O[2];
#pragma unroll
        for (int db = 0; db < 2; ++db)
#pragma unroll
            for (int i = 0; i < 16; ++i) O[db][i] = 0.f;
        LAS3 float* oslot = (LAS3 float*)(lds + AT_IMP) + h * 2048 + lane;
        const size_t bh0 = (size_t)b * 2, bh1 = bh0 + 1;
        {
            const bf16_t* kcb = (const bf16_t*)(ws + R_KCB); const bf16_t* vct = (const bf16_t*)(ws + R_VCT);
            const AtSrc src{kcb + bh0 * 256 * 64, kcb + bh1 * 256 * 64, vct + bh0 * 64 * 256, vct + bh1 * 64 * 256, 256};
            const int nst = tb / 32 + 1;
            float m_run = -INFINITY, l_run = 0.f;
            at_branch<0, 1, APROBE>(lds, src, 0, nst - 1, Q, tq, tid, kvh, lut, 0u, 0u, m_run, l_run, O, 0.f, nullptr);
            const float l_tot = l_run + __shfl_xor(l_run, 32);
            const float inv_l = l_tot > 0.f ? 1.0f / l_tot : 0.f;
            float m_fix = (m_run == -INFINITY) ? 0.f : m_run;
            at_branch<0, 2, APROBE>(lds, src, 0, nst - 1, Q, tq, tid, kvh, lut, 0u, 0u, m_fix, l_run, O, inv_l, impw + (h * 32 + r) * 65);
        }
        {
            const int row = tid >> 3, j8 = tid & 7, kr = row >> 5, tr = row & 31;
#pragma unroll
            for (int jj = 0; jj < 8; ++jj) {
                const int s = j8 * 8 + jj, db = qb64 - s;
                float v = 0.f;
#pragma unroll
                for (int g = 0; g < 4; ++g) v += impw[((kr * 4 + g) * 32 + tr) * 65 + s];
                vals[row * 65 + s] = (db >= 0 && db < 2) ? 2.0e4f : (s == 0 ? 1.0e4f : (db >= 0 ? v : -1.0f));
            }
            __syncthreads();
            unsigned bits = 0u;
            {
                float vv[8]; int rk[8];
#pragma unroll
                for (int jj = 0; jj < 8; ++jj) { vv[jj] = vals[row * 65 + j8 * 8 + jj]; rk[jj] = 0; }
#pragma unroll 2
                for (int s2 = 0; s2 < 64; ++s2) {
                    const float w = vals[row * 65 + s2];
#pragma unroll
                    for (int jj = 0; jj < 8; ++jj) rk[jj] += (w > vv[jj] || (w == vv[jj] && s2 < j8 * 8 + jj)) ? 1 : 0;
                }
#pragma unroll
                for (int jj = 0; jj < 8; ++jj) if (rk[jj] < 16 && qb64 - (j8 * 8 + jj) >= 0) bits |= 1u << jj;
            }
            selb[row * 8 + j8] = (unsigned char)bits;
            __syncthreads();
        }
        const unsigned mlo = *(LAS3 const unsigned*)(selb + (kvh * 32 + r) * 8), mhi = *(LAS3 const unsigned*)(selb + (kvh * 32 + r) * 8 + 4);
        __syncthreads();
        {
            const float g0 = sigmoidf_(gates[tok * 24 + h * 3 + 0]);
#pragma unroll
            for (int db = 0; db < 2; ++db)
#pragma unroll
                for (int i = 0; i < 16; ++i) { oslot[(db * 16 + i) * 64] = g0 * O[db][i]; O[db][i] = 0.f; }
        }
        {
            const bf16_t* ksb = (const bf16_t*)(ws + R_KS); const bf16_t* vst = (const bf16_t*)(ws + R_VST);
            const AtSrc src{ksb + bh0 * T_ * HD, ksb + bh1 * T_ * HD, vst + bh0 * HD * T_, vst + bh1 * HD * T_, T_};
            float m_run = -INFINITY, l_run = 0.f;
            at_branch<1, 0, APROBE>(lds, src, 0, qb64, Q, tq, tid, kvh, lut, mlo, mhi, m_run, l_run, O, 0.f, nullptr);
            const float l_tot = l_run + __shfl_xor(l_run, 32), sc = sigmoidf_(gates[tok * 24 + h * 3 + 1]) / l_tot;
#pragma unroll
            for (int db = 0; db < 2; ++db)
#pragma unroll
                for (int i = 0; i < 16; ++i) { oslot[(db * 16 + i) * 64] += sc * O[db][i]; O[db][i] = 0.f; }
        }
        {
            const bf16_t* kwb = (const bf16_t*)(ws + R_KW); const bf16_t* vwt = (const bf16_t*)(ws + R_VWT);
            const AtSrc src{kwb + bh0 * T_ * HD, kwb + bh1 * T_ * HD, vwt + bh0 * HD * T_, vwt + bh1 * HD * T_, T_};
            int wb0 = (t0 - 511) >> 6; wb0 = wb0 < 0 ? 0 : wb0;
            float m_run = -INFINITY, l_run = 0.f;
            at_branch<2, 0, APROBE>(lds, src, wb0, qb64, Q, tq, tid, kvh, lut, 0u, 0u, m_run, l_run, O, 0.f, nullptr);
            const float l_tot = l_run + __shfl_xor(l_run, 32), sc = sigmoidf_(gates[tok * 24 + h * 3 + 2]) / l_tot;
#pragma unroll
            for (int db = 0; db < 2; ++db)
#pragma unroll
                for (int i = 0; i < 16; ++i) O[db][i] = oslot[(db * 16 + i) * 64] + sc * O[db][i];
        }
        {
            float ss = 0.f;
#pragma unroll
            for (int db = 0; db < 2; ++db)
#pragma unroll
                for (int i = 0; i < 16; ++i) ss += O[db][i] * O[db][i];
            ss += __shfl_xor(ss, 32);
            if (hf == 0) ssq[h * 32 + r] = ss;
            __syncthreads();
            float tot = 0.f;
#pragma unroll
            for (int hh = 0; hh < 8; ++hh) tot += ssq[hh * 32 + r];
            const float rs = rsqrtf(tot * (1.0f / 512) + EPS);
#pragma unroll
            for (int db = 0; db < 2; ++db)
#pragma unroll
                for (int a = 0; a < 4; ++a) {
                    const int d = 32 * db + 8 * a + 4 * hf;
                    const f32x4 g4 = *(const f32x4*)(gn + h * 64 + d);
                    u32x2 w; w.x = pk_bf16(O[db][4 * a] * rs * g4[0], O[db][4 * a + 1] * rs * g4[1]); w.y = pk_bf16(O[db][4 * a + 2] * rs * g4[2], O[db][4 * a + 3] * rs * g4[3]);
                    *(u32x2*)(mixed + tok * DM + h * 64 + d) = w;
                }
            __syncthreads();
        }
    }
}
constexpr int LR_STRIDE = 516;
constexpr int LR_XC = 0, LR_A = 32 * LR_STRIDE * 4, LR_RS = 2 * 32 * LR_STRIDE * 4, LR_END = LR_RS + 256;
static_assert(LR_END <= 160 * 1024 - 256, "LRU LDS map");

template <bool FINAL>
DI void lru_phase(const Params& p, LAS3 unsigned char* lds, int G) {
    unsigned char* ws = p.ws;
    const int tid = threadIdx.x, lane = tid & 63, n = __builtin_amdgcn_readfirstlane(tid >> 6), r = lane & 31, hf = lane >> 5, ch = tid;
    LAS3 float* XC = (LAS3 float*)(lds + LR_XC); LAS3 float* AA = (LAS3 float*)(lds + LR_A); LAS3 float* RS = (LAS3 float*)(lds + LR_RS);
    const bf16_t* xr = (const bf16_t*)(ws + R_XR); const bf16_t* xg = (const bf16_t*)(ws + R_XG);
    float* sumP = (float*)(ws + WS_LRUP); float* sumH = (float*)(ws + WS_LRUH);
    bf16_t* mixed = (bf16_t*)(ws + WS_MIXED);
    const float cw0 = p.in[I_CONV_W][0 * 512 + ch], cw1 = p.in[I_CONV_W][1 * 512 + ch], cw2 = p.in[I_CONV_W][2 * 512 + ch], cw3 = p.in[I_CONV_W][3 * 512 + ch], cb = p.in[I_CONV_B][ch];
    const float gl = FINAL ? p.in[I_GN_LRU][ch] : 0.f;
    float ba[2], bx[2], sp[2];
#pragma unroll
    for (int nb = 0; nb < 2; ++nb) { const int c2 = n * 64 + 32 * nb + r; ba[nb] = p.in[I_LRU_BA][c2]; bx[nb] = p.in[I_LRU_BX][c2]; sp[nb] = log1pf(__expf(-p.in[I_LRU_LAM][c2])); }
    const bf16_t* waT = (const bf16_t*)(ws + WS_WAT); const bf16_t* wxT = (const bf16_t*)(ws + WS_WXT);
    for (int ci = blockIdx.x; ci < 256; ci += G) {
        const int b = ci >> 6, cib = ci & 63, t0 = cib * 64;
        const size_t tok0 = (size_t)b * T_ + t0;
        float x1 = 0.f, x2 = 0.f, x3 = 0.f;
        if (t0 > 0) { x1 = bf2f(xr[(tok0 - 1) * 512 + ch]); x2 = bf2f(xr[(tok0 - 2) * 512 + ch]); x3 = bf2f(xr[(tok0 - 3) * 512 + ch]); }
        float hst = 0.f, pprod = 1.f;
        if (FINAL) {
            const float* Pp = sumP + (size_t)(b * 64) * 512 + ch; const float* Hp = sumH + (size_t)(b * 64) * 512 + ch;
            for (int k0 = 0; k0 < cib; k0 += 16) {
                float pv[16], hv[16];
#pragma unroll
                for (int j = 0; j < 16; ++j) { const int k = k0 + j < cib ? k0 + j : cib - 1; pv[j] = Pp[(size_t)k * 512]; hv[j] = Hp[(size_t)k * 512]; }
#pragma unroll
                for (int j = 0; j < 16; ++j) if (k0 + j < cib) hst = pv[j] * hst + hv[j];
            }
        }
#pragma unroll 1
        for (int half = 0; half < 2; ++half) {
            const size_t tokh = tok0 + half * 32;
            __syncthreads();
            {
                bf16_t xw[32]; float xv[32];
#pragma unroll
                for (int t = 0; t < 32; ++t) xw[t] = xr[(tokh + t) * 512 + ch];
#pragma unroll
                for (int t = 0; t < 32; ++t) xv[t] = bf2f(xw[t]);
#pragma unroll
                for (int t = 0; t < 32; ++t) {
                    const float x0 = xv[t];
                    XC[t * LR_STRIDE + ch] = cw0 * x3 + cw1 * x2 + cw2 * x1 + cw3 * x0 + cb;
                    x3 = x2; x2 = x1; x1 = x0;
                }
            }
            __syncthreads();
            {
                f32x16 ar[2], ai[2];
#pragma unroll
                for (int nb = 0; nb < 2; ++nb)
#pragma unroll
                    for (int i = 0; i < 16; ++i) { ar[nb][i] = 0.f; ai[nb][i] = 0.f; }
                bf16x8v Ba[2][4], Bx[2][4];
#pragma unroll
                for (int nb = 0; nb < 2; ++nb)
#pragma unroll
                    for (int ks = 0; ks < 4; ++ks) {
                        const size_t o = (size_t)(n * 64 + 32 * nb + r) * 64 + 16 * ks + 8 * hf;
                        Ba[nb][ks] = *(const bf16x8v*)(waT + o); Bx[nb][ks] = *(const bf16x8v*)(wxT + o);
                    }
#pragma unroll
                for (int ks = 0; ks < 4; ++ks) {
                    LAS3 const float* src = XC + r * LR_STRIDE + n * 64 + 16 * ks + 8 * hf;
                    const f32x4 f0 = *(LAS3 const f32x4*)src, f1 = *(LAS3 const f32x4*)(src + 4);
                    u32x4 pw; pw.x = pk_bf16(f0[0], f0[1]); pw.y = pk_bf16(f0[2], f0[3]); pw.z = pk_bf16(f1[0], f1[1]); pw.w = pk_bf16(f1[2], f1[3]);
                    const bf16x8v af = __builtin_bit_cast(bf16x8v, pw);
#pragma unroll
                    for (int nb = 0; nb < 2; ++nb) {
                        ar[nb] = __builtin_amdgcn_mfma_f32_32x32x16_bf16(af, Ba[nb][ks], ar[nb], 0, 0, 0);
                        ai[nb] = __builtin_amdgcn_mfma_f32_32x32x16_bf16(af, Bx[nb][ks], ai[nb], 0, 0, 0);
                    }
                }
                __syncthreads();
#pragma unroll
                for (int nb = 0; nb < 2; ++nb)
#pragma unroll
                    for (int i = 0; i < 16; ++i) {
                        const int t = (i & 3) + 8 * (i >> 2) + 4 * hf, o = t * LR_STRIDE + n * 64 + 32 * nb + r;
                        const float xcv = XC[o];
                        const float rg = sigmoidf_(ar[nb][i] + ba[nb]), ig = sigmoidf_(ai[nb][i] + bx[nb]);
                        const float log_a = -8.0f * rg * sp[nb];
                        AA[o] = __expf(log_a);
                        XC[o] = sqrtf(-expm1f(2.0f * log_a)) * (ig * xcv);
                    }
            }
            __syncthreads();
            if (!FINAL) {
#pragma unroll 8
                for (int t = 0; t < 32; ++t) { const float a = AA[t * LR_STRIDE + ch]; hst = a * hst + XC[t * LR_STRIDE + ch]; pprod *= a; }
            } else {
                {
                    bf16_t gv[32];
#pragma unroll
                    for (int t = 0; t < 32; ++t) gv[t] = xg[(tokh + t) * 512 + ch];
#pragma unroll
                    for (int t = 0; t < 32; ++t) {
                        hst = AA[t * LR_STRIDE + ch] * hst + XC[t * LR_STRIDE + ch];
                        XC[t * LR_STRIDE + ch] = hst * gelu_tanh(bf2f(gv[t]));
                    }
                }
                __syncthreads();
                {
                    const int t = tid >> 4, part = tid & 15;
                    float s = 0.f;
#pragma unroll 8
                    for (int j = 0; j < 32; ++j) { const float v = XC[t * LR_STRIDE + part + 16 * j]; s += v * v; }
                    s += __shfl_xor(s, 1); s += __shfl_xor(s, 2); s += __shfl_xor(s, 4); s += __shfl_xor(s, 8);
                    if (part == 0) RS[t] = rsqrtf(s * (1.0f / 512) + EPS);
                }
                __syncthreads();
                {
                    const int t = tid >> 4, part = tid & 15; const float rs = RS[t];
                    const float* gp = p.in[I_GN_LRU] + part * 32; LAS3 const float* xp = XC + t * LR_STRIDE + part * 32;
                    bf16_t* dst = mixed + (tokh + t) * DM + 512 + part * 32;
#pragma unroll
                    for (int q = 0; q < 4; ++q) {
                        const f32x4 a = *(LAS3 const f32x4*)(xp + 8 * q), b = *(LAS3 const f32x4*)(xp + 8 * q + 4), ga = *(const f32x4*)(gp + 8 * q), gb = *(const f32x4*)(gp + 8 * q + 4);
                        u32x4 w; w.x = pack2bf(a[0] * rs * ga[0], a[1] * rs * ga[1]); w.y = pack2bf(a[2] * rs * ga[2], a[3] * rs * ga[3]);
                        w.z = pack2bf(b[0] * rs * gb[0], b[1] * rs * gb[1]); w.w = pack2bf(b[2] * rs * gb[2], b[3] * rs * gb[3]);
                        *(u32x4*)(dst + 8 * q) = w;
                    }
                }
            }
        }
        if (!FINAL) { sumP[(size_t)ci * 512 + ch] = pprod; sumH[(size_t)ci * 512 + ch] = hst; }
    }
    __syncthreads();
}
typedef float f32x4v __attribute__((ext_vector_type(4)));
constexpr int CM_IMG = 0;
constexpr int CM_HID = 36864;
constexpr int CM_END = CM_HID + 16 * 264 * 2;
DI void p2_compress(const Params& p, LAS3 unsigned char* lds, int G) {
    unsigned char* ws = p.ws;
    const int tid = threadIdx.x, lane = tid & 63, wid = __builtin_amdgcn_readfirstlane(tid >> 6), row = lane & 15, kg = lane >> 4;
    for (int u = blockIdx.x; u < 256; u += G) {
        const int kv = u >> 7, bh = (u >> 4) & 7, c0 = (u & 15) * 16;
        const bf16_t* src = (const bf16_t*)(ws + (kv ? R_VC : R_KC)) + ((size_t)bh * T_ + 16 * c0) * HD;
        const bf16_t* W1T = (const bf16_t*)(ws + (kv ? WS_CW1V : WS_CW1K));
        const float* cb = (const float*)(ws + (kv ? WS_CBV : WS_CBK));
        const bf16_t* W2T = (const bf16_t*)(ws + (kv ? WS_CW2V : WS_CW2K));
        __syncthreads();
        {
            u32x4 cv[5];
#pragma unroll
            for (int k = 0; k < 5; ++k) { const int i = tid + k * MK_THREADS; if (i < 272 * 8) cv[k] = *(const u32x4*)(src + (size_t)(i >> 3) * HD + (i & 7) * 8); }
#pragma unroll
            for (int k = 0; k < 5; ++k) { const int i = tid + k * MK_THREADS; if (i < 272 * 8) { const int tau = i >> 3, cch = i & 7; *(LAS3 u32x4*)(lds + CM_IMG + tau * 128 + (tau >> 4) * 16 + cch * 16) = cv[k]; } }
        }
        __syncthreads();
        f32x4v acc[2] = {{0.f, 0.f, 0.f, 0.f}, {0.f, 0.f, 0.f, 0.f}};
        const bf16_t* wb0 = W1T + (size_t)(wid * 32 + row) * 2048 + 8 * kg, * wb1 = wb0 + (size_t)16 * 2048;
#pragma unroll 16
        for (int ks = 0; ks < 64; ++ks) {
            const int tau = 16 * row + (ks >> 1);
            const bf16x8v a = *(LAS3 const bf16x8v*)(lds + CM_IMG + tau * 128 + (tau >> 4) * 16 + (32 * (ks & 1) + 8 * kg) * 2);
            const bf16x8v b0 = *(const bf16x8v*)(wb0 + 32 * ks), b1 = *(const bf16x8v*)(wb1 + 32 * ks);
            acc[0] = __builtin_amdgcn_mfma_f32_16x16x32_bf16(a, b0, acc[0], 0, 0, 0);
            acc[1] = __builtin_amdgcn_mfma_f32_16x16x32_bf16(a, b1, acc[1], 0, 0, 0);
        }
#pragma unroll
        for (int nb = 0; nb < 2; ++nb) {
            const int col = wid * 32 + 16 * nb + row; const float bias = cb[col];
#pragma unroll
            for (int i = 0; i < 4; ++i) *(LAS3 bf16_t*)(lds + CM_HID + ((4 * kg + i) * 264 + col) * 2) = f2bf(gelu_tanh(acc[nb][i] + bias));
        }
        __syncthreads();
        if (wid < 4) {
            f32x4v o = {0.f, 0.f, 0.f, 0.f};
#pragma unroll
            for (int ks = 0; ks < 8; ++ks) {
                const bf16x8v a = *(LAS3 const bf16x8v*)(lds + CM_HID + (row * 264 + 32 * ks + 8 * kg) * 2);
                const bf16x8v b = *(const bf16x8v*)(W2T + (size_t)(wid * 16 + row) * 256 + 32 * ks + 8 * kg);
                o = __builtin_amdgcn_mfma_f32_16x16x32_bf16(a, b, o, 0, 0, 0);
            }
            const int d = wid * 16 + row;
#pragma unroll
            for (int i = 0; i < 4; ++i) {
                const int c = c0 + 4 * kg + i; const float v = c < NCMP ? o[i] : 0.f;
                ((float*)(ws + (kv ? WS_VCMP : WS_KCMP)))[((size_t)bh * 256 + c) * 64 + d] = v;
                if (kv) ((bf16_t*)(ws + R_VCT))[((size_t)bh * 64 + d) * 256 + c] = f2bf(v);
                else    ((bf16_t*)(ws + R_KCB))[((size_t)bh * 256 + c) * 64 + d] = f2bf(v);
            }
        }
    }
    __syncthreads();
}
DI void p2_vtranspose(const Params& p, LAS3 unsigned char* lds, int G) {
    unsigned char* ws = p.ws;
    const int tid = threadIdx.x;
    LAS3 bf16_t* tl = (LAS3 bf16_t*)lds;
    for (int u0 = blockIdx.x; u0 < 1024; u0 += 4 * G) {
        u32x4 v[4];
#pragma unroll
        for (int k = 0; k < 4; ++k) { const int u = u0 + k * G; if (u < 1024) {
            const int which = u >> 9, bh = (u >> 6) & 7, tt = u & 63;
            const bf16_t* src = (const bf16_t*)(ws + (which ? R_VW : R_VS)) + ((size_t)bh * T_ + tt * 64) * HD;
            v[k] = *(const u32x4*)(src + (size_t)(tid >> 3) * HD + (tid & 7) * 8); } }
        __syncthreads();
#pragma unroll
        for (int k = 0; k < 4; ++k) if (u0 + k * G < 1024) *(LAS3 u32x4*)(tl + k * 64 * 72 + (tid >> 3) * 72 + (tid & 7) * 8) = v[k];
        __syncthreads();
#pragma unroll
        for (int k = 0; k < 4; ++k) { const int u = u0 + k * G; if (u < 1024) {
            const int which = u >> 9, bh = (u >> 6) & 7, tt = u & 63;
            bf16_t* dst = (bf16_t*)(ws + (which ? R_VWT : R_VST)) + (size_t)bh * HD * T_ + tt * 64;
            LAS3 const bf16_t* t2 = tl + k * 64 * 72;
            const int d = tid >> 3, seg = tid & 7; u32x4 w;
            w.x = (unsigned)t2[(seg * 8 + 0) * 72 + d] | ((unsigned)t2[(seg * 8 + 1) * 72 + d] << 16); w.y = (unsigned)t2[(seg * 8 + 2) * 72 + d] | ((unsigned)t2[(seg * 8 + 3) * 72 + d] << 16);
            w.z = (unsigned)t2[(seg * 8 + 4) * 72 + d] | ((unsigned)t2[(seg * 8 + 5) * 72 + d] << 16); w.w = (unsigned)t2[(seg * 8 + 6) * 72 + d] | ((unsigned)t2[(seg * 8 + 7) * 72 + d] << 16);
            *(u32x4*)(dst + (size_t)d * T_ + seg * 8) = w; } }
    }
    __syncthreads();
}
DI int ord_enc(float f) { const int u = __float_as_int(f); return u ^ ((u >> 31) & 0x7fffffff); }
DI float ord_dec(int o) { return __int_as_float(o ^ ((o >> 31) & 0x7fffffff)); }
#define PEER_CE_DESC(a, b) do { const int _hi = max((a), (b)), _lo = min((a), (b)); (a) = _hi; (b) = _lo; } while (0)
#define PEER_CE_ASC(a, b)  do { const int _hi = max((a), (b)), _lo = min((a), (b)); (a) = _lo; (b) = _hi; } while (0)
DI void sort16_desc(int (&x)[16]) {
#pragma unroll
    for (int k = 2; k <= 16; k <<= 1)
#pragma unroll
        for (int j = k >> 1; j > 0; j >>= 1)
#pragma unroll
            for (int i = 0; i < 16; ++i) { const int l = i ^ j; if (l > i) { if ((i & k) == 0) PEER_CE_DESC(x[i], x[l]); else PEER_CE_ASC(x[i], x[l]); } }
}
DI void merge16_desc(int (&a)[16], const int (&b)[16]) {
#pragma unroll
    for (int i = 0; i < 16; ++i) a[i] = max(a[i], b[15 - i]);
#pragma unroll
    for (int j = 8; j > 0; j >>= 1)
#pragma unroll
        for (int i = 0; i < 16; ++i) { const int l = i ^ j; if (l > i) PEER_CE_DESC(a[i], a[l]); }
}
constexpr int PR_KEYS = 0;
constexpr int PR_IDX = 512 * 68 * 4;
constexpr int PR_RS = PR_IDX + 128 * 32 * 4;
constexpr int PR_END = PR_RS + 1024;
static_assert(PR_END <= 160 * 1024 - 256, "PEER LDS map");

struct EpiPeerRoute {
    static constexpr bool PERM = true, AFTER_DRAIN = true;
    const float* ssq1; int* eout; float* gout; float* rs1out;
    DI void fused(const f32x4 (&acc)[2][2][4][2], const pg8::Unit& u, int wr, int wc, int fr, int fq, PG8_LAS unsigned char* lds, int wid, int lane) const {
        const int tid = wid * 64 + lane, head = u.pn;
        LAS3 int* KEYS = (LAS3 int*)(lds + PR_KEYS); LAS3 int* IDX = (LAS3 int*)(lds + PR_IDX); LAS3 float* RS = (LAS3 float*)(lds + PR_RS);
        if (tid < 256) { float s = 0.f; for (int j = 0; j < 16; ++j) s += ssq1[(size_t)j * NTOK + u.pm * 256 + tid]; RS[tid] = rsqrtf(s * (1.0f / DM) + EPS); if (u.pn == 0) rs1out[u.pm * 256 + tid] = RS[tid]; }
#pragma unroll 1
        for (int ai = 0; ai < 2; ++ai) {
            __syncthreads();
#pragma unroll
            for (int bj = 0; bj < 2; ++bj)
#pragma unroll
                for (int m = 0; m < 4; ++m)
#pragma unroll
                    for (int n = 0; n < 2; ++n) {
                        const int rl = 64 * wr + 16 * m + fr, kk0 = 32 * wc + 8 * fq + 4 * n, hl = ((rl * 2 + bj) * 2 + (kk0 >> 6));
                        const f32x4 v = ai == 0 ? acc[0][bj][m][n] : acc[1][bj][m][n];
                        u32x4 kq;
                        kq.x = (unsigned)((ord_enc(v[0]) & ~0x7f) | (127 - (kk0 + 0))); kq.y = (unsigned)((ord_enc(v[1]) & ~0x7f) | (127 - (kk0 + 1)));
                        kq.z = (unsigned)((ord_enc(v[2]) & ~0x7f) | (127 - (kk0 + 2))); kq.w = (unsigned)((ord_enc(v[3]) & ~0x7f) | (127 - (kk0 + 3)));
                        *(LAS3 u32x4*)(KEYS + hl * 68 + (kk0 & 63)) = kq;
                    }
            __syncthreads();
            int top[16];
            {
                LAS3 const int* src = KEYS + tid * 68;
                int t2[16];
#pragma unroll
                for (int q = 0; q < 4; ++q) { const u32x4 w = *(LAS3 const u32x4*)(src + 4 * q); top[4 * q] = (int)w.x; top[4 * q + 1] = (int)w.y; top[4 * q + 2] = (int)w.z; top[4 * q + 3] = (int)w.w; }
                sort16_desc(top);
#pragma unroll 1
                for (int g = 1; g < 4; ++g) {
#pragma unroll
                    for (int q = 0; q < 4; ++q) { const u32x4 w = *(LAS3 const u32x4*)(src + 16 * g + 4 * q); t2[4 * q] = (int)w.x; t2[4 * q + 1] = (int)w.y; t2[4 * q + 2] = (int)w.z; t2[4 * q + 3] = (int)w.w; }
                    sort16_desc(t2);
                    merge16_desc(top, t2);
                }
#pragma unroll
                for (int i = 0; i < 16; ++i) t2[i] = __shfl_xor(top[i], 1);
                merge16_desc(top, t2);
            }
            int s1[16], s2[16];
            {
                const bool isp1 = (lane & 2) != 0;
#pragma unroll
                for (int i = 0; i < 16; ++i) { const int o = __shfl_xor(top[i], 2); s1[i] = isp1 ? o : top[i]; s2[i] = isp1 ? top[i] : o; }
            }
            const int rl = tid >> 2, q4 = tid & 3;
#pragma unroll
            for (int kq = 0; kq < 4; ++kq) if (q4 == kq) {
#pragma unroll
                for (int j = 0; j < 4; ++j) { IDX[rl * 32 + 4 * kq + j] = 127 - (s1[4 * kq + j] & 0x7f); IDX[rl * 32 + 16 + 4 * kq + j] = 127 - (s2[4 * kq + j] & 0x7f); }
            }
            float v1[16], v2[16];
#pragma unroll
            for (int i = 0; i < 16; ++i) { v1[i] = ord_dec(s1[i] & ~0x7f); v2[i] = ord_dec(s2[i] & ~0x7f); }
            int best[16], grp[16];
            {
                int cnt = 0; bool first = true;
#pragma unroll
                for (int a = 0; a < 16; ++a)
#pragma unroll
                    for (int b = 0; b < 16; ++b) if ((a + 1) * (b + 1) <= 16) {
                        grp[cnt & 15] = (ord_enc(v1[a] + v2[b]) & ~0xff) | (255 - (16 * a + b));
                        ++cnt;
                        if ((cnt & 15) == 0) { sort16_desc(grp); if (first) {
#pragma unroll
                                for (int i = 0; i < 16; ++i) best[i] = grp[i];
                                first = false; } else merge16_desc(best, grp); }
                    }
#pragma unroll
                for (int i = 2; i < 16; ++i) grp[i] = (int)0x80000000;
                sort16_desc(grp); merge16_desc(best, grp);
            }
            __syncthreads();
            const float rs1 = RS[128 * ai + rl];
            float gsum = 0.f, gv[16]; int ev[16];
            const float mtop = ord_dec(best[0] & ~0xff) * rs1;
#pragma unroll
            for (int i = 0; i < 16; ++i) {
                const float sc = ord_dec(best[i] & ~0xff) * rs1; gv[i] = __expf(sc - mtop); gsum += gv[i];
                const int ab = 255 - (best[i] & 0xff);
                ev[i] = IDX[rl * 32 + (ab >> 4)] * 128 + IDX[rl * 32 + 16 + (ab & 15)];
            }
            const float ginv = 1.0f / gsum;
            const size_t tok = (size_t)u.pm * 256 + 128 * ai + rl;
#pragma unroll
            for (int kq = 0; kq < 4; ++kq) if (q4 == kq) {
                *(u32x4*)(eout + tok * 128 + head * 16 + 4 * kq) = (u32x4){(unsigned)ev[4 * kq], (unsigned)ev[4 * kq + 1], (unsigned)ev[4 * kq + 2], (unsigned)ev[4 * kq + 3]};
                *(f32x4*)(gout + tok * 128 + head * 16 + 4 * kq) = (f32x4){gv[4 * kq] * ginv, gv[4 * kq + 1] * ginv, gv[4 * kq + 2] * ginv, gv[4 * kq + 3] * ginv};
            }
        }
        __syncthreads();
    }
    DI void operator()(const f32x4 (&)[2][2][4][2], const pg8::Unit&, int, int, int, int) const {}
};
struct SliceOrder : pg8::StaticOrder {
    int slice;
    __device__ bool next(int i, pg8::Unit& u) const { if (i > 0) return false; return pg8::StaticOrder::next(slice, u); }
};
DI void p5_peer_route(const Params& p, LAS3 unsigned char* lds, int G) {
    unsigned char* ws = p.ws;
    pg8::Gemm g{(const bf16_t*)(ws + R_H1B), (const bf16_t*)(ws + WS_WQS), NTOK, 2048, DM};
    EpiPeerRoute E{(const float*)(ws + WS_SSQ1), (int*)(ws + R_EXP), (float*)(ws + R_GSM), (float*)(ws + WS_RS1)};
    const int nslice = (512 + G - 1) / G;
#pragma unroll 1
    for (int s = 0; s < nslice; ++s) {
        SliceOrder S; S.init(NTOK, 2048, G, (int)blockIdx.x); S.slice = s;
        pg8::gemm_phase<EpiPeerRoute, SliceOrder>(lds, g, S, E, nullptr);
        __syncthreads();
    }
}
constexpr float V8_SCALE = 8.0f;
#define I8_LOADROW(E) (*(const u32x2*)(u8 + ((unsigned)(E) * (unsigned)(DM / 2) + (unsigned)(lane * 8))))
DI int i4_dotrow(const u32x2 w, const unsigned (&xq)[4]) {
    int a = __builtin_amdgcn_sdot4((int)((w.x << 4) & 0xF0F0F0F0u), (int)xq[0], 0, false); a = __builtin_amdgcn_sdot4((int)(w.x & 0xF0F0F0F0u), (int)xq[1], a, false);
    a = __builtin_amdgcn_sdot4((int)((w.y << 4) & 0xF0F0F0F0u), (int)xq[2], a, false); a = __builtin_amdgcn_sdot4((int)(w.y & 0xF0F0F0F0u), (int)xq[3], a, false);
    return a;
}
#define I8_DOTROW(W) i4_dotrow((W), xq)
#define I8_ISSUE(SET, EV, J0) do { int ev_ = (EV); asm volatile("" : "+v"(ev_)); _Pragma("unroll") for (int k = 0; k < 16; ++k) { const int e = __builtin_amdgcn_readlane(ev_, (J0) + k); \
        SET[k] = I8_LOADROW(e); } __builtin_amdgcn_sched_barrier(0); } while (0)
#define I8_CONS(SET, P0) do { _Pragma("unroll") for (int k = 0; k < 16; ++k) { \
        part[(P0) + k] = (float)I8_DOTROW(SET[k]); } __builtin_amdgcn_sched_barrier(0); } while (0)
#define I8_RS(M) do { const bool up = (lane & (M)) != 0; _Pragma("unroll") for (int i = 0; i < (M); ++i) { \
        const float send = up ? part[i] : part[i + (M)], keep = up ? part[i + (M)] : part[i]; part[i] = keep + __shfl_xor(send, (M)); } } while (0)
#define V4_ISSUE(SET, EV, J0) do { int ev_ = (EV); asm volatile("" : "+v"(ev_)); _Pragma("unroll") for (int k = 0; k < 16; ++k) { const int e = __builtin_amdgcn_readlane(ev_, (J0) + k); \
        SET[k] = *(const u32x2*)(v8 + ((unsigned)e * (unsigned)(DM / 2) + (unsigned)(lane * 8))); } __builtin_amdgcn_sched_barrier(0); } while (0)
#define V4_CVT(W, B) __builtin_amdgcn_cvt_scalef32_pk_f32_fp4((W), 1.0f, B)
#define V4_FMA(W, I) do { t_[4 * (I)] = __builtin_elementwise_fma(V4_CVT(W, 0), c2, t_[4 * (I)]); \
        t_[4 * (I) + 1] = __builtin_elementwise_fma(V4_CVT(W, 1), c2, t_[4 * (I) + 1]); \
        t_[4 * (I) + 2] = __builtin_elementwise_fma(V4_CVT(W, 2), c2, t_[4 * (I) + 2]); \
        t_[4 * (I) + 3] = __builtin_elementwise_fma(V4_CVT(W, 3), c2, t_[4 * (I) + 3]); } while (0)
#define V4_ROW(SET, CV, J0, K) do { const float c = (CV)[(J0) + (K)]; const f32x2 c2 = {c, c}; const u32x2 w_ = SET[K]; \
        V4_FMA(w_.x, 0); V4_FMA(w_.y, 1); } while (0)
#define V4_CONS(SET, CV, J0) do { f32x2 t_[8]; _Pragma("unroll") for (int i_ = 0; i_ < 8; ++i_) t_[i_] = (f32x2){0.f, 0.f}; V4_ROW(SET, CV, J0, 0); V4_ROW(SET, CV, J0, 1); V4_ROW(SET, CV, J0, 2); V4_ROW(SET, CV, J0, 3); V4_ROW(SET, CV, J0, 4); V4_ROW(SET, CV, J0, 5); \
        V4_ROW(SET, CV, J0, 6); V4_ROW(SET, CV, J0, 7); V4_ROW(SET, CV, J0, 8); V4_ROW(SET, CV, J0, 9); V4_ROW(SET, CV, J0, 10); V4_ROW(SET, CV, J0, 11); \
        V4_ROW(SET, CV, J0, 12); V4_ROW(SET, CV, J0, 13); V4_ROW(SET, CV, J0, 14); V4_ROW(SET, CV, J0, 15); \
        _Pragma("unroll") for (int i_ = 0; i_ < 8; ++i_) acc[i_] += t_[i_]; __builtin_amdgcn_sched_barrier(0); } while (0)
DI void p6fused(const Params& p, LAS3 unsigned char* lds, int G) {
    unsigned char* ws = p.ws;
    const int tid = threadIdx.x, lane = tid & 63, wid = tid >> 6;
    const int gw = blockIdx.x * 8 + wid, nw = G * 8;
    const unsigned char* u8 = (const unsigned char*)(ws + WS_UB); const unsigned char* v8 = (const unsigned char*)(ws + WS_VB);
    const int* eidx = (const int*)(ws + R_EXP); const float* gsm = (const float*)(ws + R_GSM); const float* rs1v = (const float*)(ws + WS_RS1);
    bf16_t* hb = (bf16_t*)(ws + R_H1B); float* rs2 = (float*)(ws + WS_RS2);
    LAS3 float* cl = (LAS3 float*)(lds + wid * 512);
    int en0 = 0, en1 = 0; u32x4 xna = {0u, 0u, 0u, 0u}, xnb = xna; float gn0 = 0.f, gn1 = 0.f, rsn = 0.f;
    if (gw < NTOK) { en0 = eidx[(size_t)gw * 128 + lane]; en1 = eidx[(size_t)gw * 128 + 64 + lane];
        xna = *(const u32x4*)(hb + (size_t)gw * DM + lane * 16); xnb = *(const u32x4*)(hb + (size_t)gw * DM + lane * 16 + 8);
        gn0 = gsm[(size_t)gw * 128 + lane]; gn1 = gsm[(size_t)gw * 128 + 64 + lane]; rsn = rs1v[gw]; }
#pragma unroll 1
    for (int tok = gw; tok < NTOK; tok += nw) {
        const int e0 = en0, e1 = en1; const u32x4 xa = xna, xb = xnb; const float g0 = gn0, g1 = gn1, rs1 = rsn;
        const int tn = tok + nw < NTOK ? tok + nw : tok;
        en0 = eidx[(size_t)tn * 128 + lane]; en1 = eidx[(size_t)tn * 128 + 64 + lane];
        {
            u32x2 sa[16], sb[16];
            I8_ISSUE(sa, e0, 0);
            I8_ISSUE(sb, e0, 16);
            xna = *(const u32x4*)(hb + (size_t)tn * DM + lane * 16); xnb = *(const u32x4*)(hb + (size_t)tn * DM + lane * 16 + 8);
            gn0 = gsm[(size_t)tn * 128 + lane]; gn1 = gsm[(size_t)tn * 128 + 64 + lane]; rsn = rs1v[tn];
            float xf[16];
#pragma unroll
            for (int q = 0; q < 4; ++q) { xf[2 * q] = bflo(xa[q]); xf[2 * q + 1] = bfhi(xa[q]); xf[8 + 2 * q] = bflo(xb[q]); xf[8 + 2 * q + 1] = bfhi(xb[q]); }
            float amax = 0.f;
#pragma unroll
            for (int i = 0; i < 16; ++i) amax = fmaxf(amax, fabsf(xf[i]));
            amax = wave_max(amax);
            const float sx = fmaxf(amax, 1e-20f) * (1.0f / 127.0f), isx = 1.0f / sx;
            unsigned xq[4];
#pragma unroll
            for (int q = 0; q < 2; ++q) {
                unsigned we = 0u, wo = 0u;
#pragma unroll
                for (int b = 0; b < 4; ++b) { we |= ((unsigned)(int)rintf(xf[8 * q + 2 * b] * isx) & 0xffu) << (8 * b); wo |= ((unsigned)(int)rintf(xf[8 * q + 2 * b + 1] * isx) & 0xffu) << (8 * b); }
                xq[2 * q] = we; xq[2 * q + 1] = wo;
            }
            const float scl = rs1 * sx * (1.0f / (16.0f * U4_ISCALE));
            float part[64];
            I8_CONS(sa, 0);  I8_ISSUE(sa, e0, 32);
            I8_CONS(sb, 16); I8_ISSUE(sb, e0, 48);
            I8_CONS(sa, 32); I8_ISSUE(sa, e1, 0);
            I8_CONS(sb, 48); I8_ISSUE(sb, e1, 16);
            I8_RS(32); I8_RS(16); I8_RS(8); I8_RS(4); I8_RS(2); I8_RS(1);
            cl[lane] = g0 * gelu_tanh(part[0] * scl) * (1.0f / V8_SCALE);
            I8_CONS(sa, 0);  I8_ISSUE(sa, e1, 32);
            I8_CONS(sb, 16); I8_ISSUE(sb, e1, 48);
            I8_CONS(sa, 32);
            I8_CONS(sb, 48);
            I8_RS(32); I8_RS(16); I8_RS(8); I8_RS(4); I8_RS(2); I8_RS(1);
            cl[64 + lane] = g1 * gelu_tanh(part[0] * scl) * (1.0f / V8_SCALE);
        }
        {
            u32x2 sa[16], sb[16];
            V4_ISSUE(sa, e0, 0);
            V4_ISSUE(sb, e0, 16);
            LAS3 const float* c0 = cl; LAS3 const float* c1 = cl + 64;
            const u32x4 ha = xa, hc = xb;
            const f32x4 hv0 = {bflo(ha.x), bfhi(ha.x), bflo(ha.y), bfhi(ha.y)}, hv1 = {bflo(ha.z), bfhi(ha.z), bflo(ha.w), bfhi(ha.w)};
            const f32x4 hv2 = {bflo(hc.x), bfhi(hc.x), bflo(hc.y), bfhi(hc.y)}, hv3 = {bflo(hc.z), bfhi(hc.z), bflo(hc.w), bfhi(hc.w)};
            f32x2 acc[8];
#pragma unroll
            for (int i = 0; i < 8; ++i) acc[i] = (f32x2){0.f, 0.f};
            V4_CONS(sa, c0, 0);  V4_ISSUE(sa, e0, 32);
            V4_CONS(sb, c0, 16); V4_ISSUE(sb, e0, 48);
            V4_CONS(sa, c0, 32); V4_ISSUE(sa, e1, 0);
            V4_CONS(sb, c0, 48); V4_ISSUE(sb, e1, 16);
            V4_CONS(sa, c1, 0);  V4_ISSUE(sa, e1, 32);
            V4_CONS(sb, c1, 16); V4_ISSUE(sb, e1, 48);
            V4_CONS(sa, c1, 32);
            V4_CONS(sb, c1, 48);
            const f32x4 o0 = hv0 + (f32x4){acc[0].x, acc[0].y, acc[1].x, acc[1].y}, o1 = hv1 + (f32x4){acc[2].x, acc[2].y, acc[3].x, acc[3].y};
            const f32x4 o2 = hv2 + (f32x4){acc[4].x, acc[4].y, acc[5].x, acc[5].y}, o3 = hv3 + (f32x4){acc[6].x, acc[6].y, acc[7].x, acc[7].y};
            u32x4 w0, w1;
            w0.x = pk_bf16(o0[0], o0[1]); w0.y = pk_bf16(o0[2], o0[3]); w0.z = pk_bf16(o1[0], o1[1]); w0.w = pk_bf16(o1[2], o1[3]);
            w1.x = pk_bf16(o2[0], o2[1]); w1.y = pk_bf16(o2[2], o2[3]); w1.z = pk_bf16(o3[0], o3[1]); w1.w = pk_bf16(o3[2], o3[3]);
            *(u32x4*)(hb + (size_t)tok * DM + lane * 16) = w0; *(u32x4*)(hb + (size_t)tok * DM + lane * 16 + 8) = w1;
            float ss = 0.f;
#pragma unroll
            for (int j = 0; j < 4; ++j) ss += o0[j] * o0[j] + o1[j] * o1[j] + o2[j] * o2[j] + o3[j] * o3[j];
            ss = wave_sum(ss);
            if (lane == 0) rs2[tok] = rsqrtf(ss * (1.0f / DM) + EPS);
        }
    }
}
#undef I8_ISSUE
#undef I8_CONS
#undef I8_RS
#undef V4_ISSUE
#undef V4_CONS
#undef V4_FMA
#undef V4_ROW
#undef V4_CVT
#undef I8_LOADROW
#undef I8_DOTROW

constexpr int LDS_MISC = 160 * 1024 - 256;
constexpr int LDS_BYTES = 160 * 1024;
constexpr size_t CTL_BAR = 0;
static_assert(XCD_BAR_WORDS * 4 <= 64 * 1024, "control region");

template <class F> struct EpiAdapt {
    static constexpr bool PERM = true, AFTER_DRAIN = false;
    F f;
    DI void operator()(const f32x4 (&acc)[2][2][4][2], const pg8::Unit& u, int wr, int wc, int fr, int fq) const {
        int fr_ = fr, fq_ = fq; asm volatile("" : "+v"(fr_), "+v"(fq_));
        const int row0 = u.pm * 256 + wr * 64 + fr_, col0 = u.pn * 256 + wc * 32 + 8 * fq_;
#pragma unroll
        for (int ai = 0; ai < 2; ++ai)
#pragma unroll
            for (int m = 0; m < 4; ++m) {
                const int row = row0 + ai * 128 + m * 16;
#pragma unroll
                for (int bj = 0; bj < 2; ++bj)
                    f.store8(row, col0 + bj * 128, acc[ai][bj][m][0], acc[ai][bj][m][1]);
            }
    }
};
template <class F> struct EpiAdaptSsq {
    static constexpr bool PERM = true, AFTER_DRAIN = false;
    F f; float* ssq;
    DI void operator()(const f32x4 (&acc)[2][2][4][2], const pg8::Unit& u, int wr, int wc, int fr, int fq) const {
        int fr_ = fr, fq_ = fq; asm volatile("" : "+v"(fr_), "+v"(fq_));
        const int row0 = u.pm * 256 + wr * 64 + fr_, col0 = u.pn * 256 + wc * 32 + 8 * fq_;
#pragma unroll
        for (int ai = 0; ai < 2; ++ai)
#pragma unroll
            for (int m = 0; m < 4; ++m) {
                const int row = row0 + ai * 128 + m * 16;
                float s = 0.f; const float rsc = f.rowscale(row);
#pragma unroll
                for (int bj = 0; bj < 2; ++bj)
                    s += f.store8r(row, col0 + bj * 128, acc[ai][bj][m][0], acc[ai][bj][m][1], rsc);
                s += __shfl_xor(s, 16); s += __shfl_xor(s, 32);
                if (fq_ == 0) ssq[(size_t)(u.pn * 4 + wc) * NTOK + row] = s;
            }
    }
};
struct EpiOutR {
    const bf16_t* xb; bf16_t* h1b;
    DI float rowscale(int) const { return 0.f; }
    DI float store8r(int row, int col, f32x4 v0, f32x4 v1, float) const {
        const size_t o = (size_t)row * DM + col;
        const u32x4 xw = *(const u32x4*)(xb + o);
        v0 += (f32x4){bflo(xw.x), bfhi(xw.x), bflo(xw.y), bfhi(xw.y)}; v1 += (f32x4){bflo(xw.z), bfhi(xw.z), bflo(xw.w), bfhi(xw.w)};
        u32x4 w; w.x = pack2bf(v0[0], v0[1]); w.y = pack2bf(v0[2], v0[3]); w.z = pack2bf(v1[0], v1[1]); w.w = pack2bf(v1[2], v1[3]); *(u32x4*)(h1b + o) = w;
        return ((v0[0] * v0[0] + v0[1] * v0[1]) + (v0[2] * v0[2] + v0[3] * v0[3])) + ((v1[0] * v1[0] + v1[1] * v1[1]) + (v1[2] * v1[2] + v1[3] * v1[3]));
    }
};
struct EpiBf16Plain { bf16_t* C; int ldc;
    DI void store8(int row, int col, f32x4 v0, f32x4 v1) const { u32x4 w; w.x = pack2bf(v0[0], v0[1]); w.y = pack2bf(v0[2], v0[3]); w.z = pack2bf(v1[0], v1[1]); w.w = pack2bf(v1[2], v1[3]); *(u32x4*)(C + (size_t)row * ldc + col) = w; } };
struct EpiGateR {
    const float* rs2; const float* bias; const bf16_t* pp; const bf16_t* h2; bf16_t* h3;
    DI float rowscale(int row) const { return rs2[row]; }
    DI float store8r(int row, int col, f32x4 v0, f32x4 v1, float s) const {
        const size_t o = (size_t)row * DM + col;
        const f32x4 b0 = *(const f32x4*)(bias + col), b1 = *(const f32x4*)(bias + col + 4); const u32x4 pw = *(const u32x4*)(pp + o), hw = *(const u32x4*)(h2 + o);
        float hv[8] = {bflo(hw.x), bfhi(hw.x), bflo(hw.y), bfhi(hw.y), bflo(hw.z), bfhi(hw.z), bflo(hw.w), bfhi(hw.w)};
        const float pv[8] = {bflo(pw.x), bfhi(pw.x), bflo(pw.y), bfhi(pw.y), bflo(pw.z), bfhi(pw.z), bflo(pw.w), bfhi(pw.w)};
        float ss = 0.f;
#pragma unroll
        for (int j = 0; j < 4; ++j) { hv[j] += sigmoidf_(v0[j] * s + b0[j]) * pv[j]; hv[4 + j] += sigmoidf_(v1[j] * s + b1[j]) * pv[4 + j]; }
#pragma unroll
        for (int j = 0; j < 8; ++j) ss += hv[j] * hv[j];
        u32x4 w; w.x = pack2bf(hv[0], hv[1]); w.y = pack2bf(hv[2], hv[3]); w.z = pack2bf(hv[4], hv[5]); w.w = pack2bf(hv[6], hv[7]); *(u32x4*)(h3 + o) = w;
        return ss;
    }
};

struct MegaArgs { Params p; int ph_lo, ph_hi; };

__global__ void __launch_bounds__(MK_THREADS, 2) mega_fwd(MegaArgs args) {
    extern __shared__ __attribute__((aligned(16))) unsigned char lds_raw[];
    LAS unsigned char* lds = (LAS unsigned char*)lds_raw;
    const Params& p = args.p;
    unsigned char* ws = p.ws;
    const int lo = args.ph_lo, hi = args.ph_hi;
    const int G = gridDim.x;
    volatile LAS unsigned* misc = (volatile LAS unsigned*)(lds + LDS_MISC);
    if (threadIdx.x < 64) misc[threadIdx.x] = 0u;
    __syncthreads();
    const XcdBarrier bar = xcd_barrier_post((unsigned*)(ws + WS_CTL), misc);
#define IN(k) (lo <= (k) && (k) < hi)
#define SEAM(k) do { if (IN(k) && IN((k) + 1)) xcd_barrier(bar); } while (0)

    if (IN(0)) p0_prologue(p, lds, G);
    SEAM(0);
    if (IN(1)) {
        pg8::Gemm g{(const bf16_t*)(ws + WS_XB), (const bf16_t*)(ws + WS_WIN), NTOK, NPROJ, DM};
        pg8::StaticOrder S; S.init(NTOK, NPROJ, G, (int)blockIdx.x);
        EpiAdapt<EpiProj> E{{(const float*)(ws + WS_RS0), (bf16_t*)(ws + R_QB), (bf16_t*)(ws + R_KC), (float*)(ws + R_GATE), (bf16_t*)(ws + R_XR), (bf16_t*)(ws + R_XG)}};
        pg8::gemm_phase<EpiAdapt<EpiProj>, pg8::StaticOrder>(lds, g, S, E, nullptr);
        p1_deferred(p, G);
    }
    SEAM(1);
    if (IN(2)) { p2_compress(p, lds, G); p2_vtranspose(p, lds, G); lru_phase<false>(p, lds, G); }
    SEAM(2);
    if (IN(3)) { p3_attention<0>(p, lds, G); lru_phase<true>(p, lds, G); }
    SEAM(3);
    if (IN(4)) {
        pg8::Gemm g{(const bf16_t*)(ws + WS_MIXED), (const bf16_t*)(ws + WS_WOUT), NTOK, DM, DM};
        pg8::StaticOrder S; S.init(NTOK, DM, G, (int)blockIdx.x);
        EpiAdaptSsq<EpiOutR> E{{(const bf16_t*)(ws + WS_XB), (bf16_t*)(ws + R_H1B)}, (float*)(ws + WS_SSQ1)};
        pg8::gemm_phase<EpiAdaptSsq<EpiOutR>, pg8::StaticOrder>(lds, g, S, E, nullptr);
    }
    SEAM(4);
    if (IN(5)) p5_peer_route(p, lds, G);
    SEAM(5);
    if (IN(6)) p6fused(p, lds, G);
    SEAM(6);
    if (IN(7)) {
        {
            pg8::Gemm g{(const bf16_t*)(ws + WS_PB), (const bf16_t*)(ws + WS_WP), NTOK, DM, PLE};
            pg8::StaticOrder S; S.init(NTOK, DM, G, (int)blockIdx.x);
            EpiAdapt<EpiBf16Plain> E{{(bf16_t*)(ws + R_BIG), DM}};
            pg8::gemm_phase<EpiAdapt<EpiBf16Plain>, pg8::StaticOrder>(lds, g, S, E, nullptr);
        }
        __syncthreads();
        {
            pg8::Gemm g{(const bf16_t*)(ws + R_H1B), (const bf16_t*)(ws + WS_WG), NTOK, DM, DM};
            pg8::StaticOrder S; S.init(NTOK, DM, G, (int)blockIdx.x);
            EpiAdaptSsq<EpiGateR> E{{(const float*)(ws + WS_RS2), p.in[I_PLE_BG], (const bf16_t*)(ws + R_BIG), (const bf16_t*)(ws + R_H1B), (bf16_t*)(ws + WS_XB)}, (float*)(ws + WS_SSQ3)};
            pg8::gemm_phase<EpiAdaptSsq<EpiGateR>, pg8::StaticOrder>(lds, g, S, E, nullptr);
        }
    }
    SEAM(7);
    if (IN(8)) p8_final_norm(p, G);
#undef IN
#undef SEAM
}

static int g_grid = 0;
static void launch_mega(hipStream_t st, const Params& p, int lo, int hi) {
    if (g_grid == 0) {
        int dev = 0, cus = 0, per_cu = 0;
        hipGetDevice(&dev); hipDeviceGetAttribute(&cus, hipDeviceAttributeMultiprocessorCount, dev);
        if (hipFuncSetAttribute((const void*)mega_fwd, hipFuncAttributeMaxDynamicSharedMemorySize, LDS_BYTES) != hipSuccess) { fprintf(stderr, "hipFuncSetAttribute failed\n"); g_grid = -1; return; }
        if (hipOccupancyMaxActiveBlocksPerMultiprocessor(&per_cu, (const void*)mega_fwd, MK_THREADS, LDS_BYTES) != hipSuccess || per_cu < 1) { fprintf(stderr, "occupancy query: %d per CU\n", per_cu); }
        (void)hipGetLastError();
        g_grid = cus;
    }
    if (g_grid < 0) return;
    MegaArgs a{}; a.p = p; a.ph_lo = lo; a.ph_hi = hi;
    hipLaunchKernelGGL(mega_fwd, dim3(g_grid), dim3(MK_THREADS), LDS_BYTES, st, a);
}
extern "C" void kernel_launch(void* const* d_in, const int* in_sizes, int n_in, void* d_out, int out_size, void* d_ws, size_t ws_size, hipStream_t stream) {
    if (n_in != 31 || out_size != NTOK * DM || ws_size < WS_END) { fprintf(stderr, "kernel_launch: unexpected shapes (n_in %d out %d ws %zu)\n", n_in, out_size, ws_size); return; }
    Params p{};
    for (int i = 0; i < 31; ++i) p.in[i] = (const float*)d_in[i];
    p.out = (float*)d_out; p.ws = (unsigned char*)d_ws;
    (void)hipMemsetAsync((char*)d_ws + WS_CTL, 0, 16384 + 1024, stream);
    launch_mega(stream, p, 0, 9);
}
```

```cpp
#include <hip/hip_runtime.h>
#include <stdint.h>
#include <stdio.h>

typedef unsigned short bf16_t;
typedef float f32x4 __attribute__((ext_vector_type(4)));
typedef float f32x2 __attribute__((ext_vector_type(2)));
typedef unsigned u32x4 __attribute__((ext_vector_type(4)));
typedef unsigned u32x2 __attribute__((ext_vector_type(2)));
#define DI __device__ __forceinline__

constexpr int NB = 4, T_ = 4096, DM = 1024, NTOK = NB * T_;
constexpr int NH = 8, HD = 64, NKV = 2, GRP = 4, ATTW = 512, KVW = 128, LRUW = 512;
constexpr int INCOLS = 2328, NPROJ = 2560;
constexpr int NCMP = 255, NSEL = 64;
constexpr int PEER_H = 8, PEER_K = 16, PEER_NK = 128;
constexpr int PLE = 256;
constexpr float EPS = 1e-6f;

constexpr int PC_KV = 512, PC_XR = 1280, PC_XG = 1792, PC_GATE = 2304;

constexpr size_t MB = 1024 * 1024;
constexpr size_t WS_CTL   = 0;
constexpr size_t WS_WIN   = 64 * 1024;
constexpr size_t WS_WOUT  = WS_WIN  + (size_t)NPROJ * DM * 2;
constexpr size_t WS_WQS   = WS_WOUT + (size_t)DM * DM * 2;
constexpr size_t WS_WG    = WS_WQS  + (size_t)2048 * DM * 2;
constexpr size_t WS_WP    = WS_WG   + (size_t)DM * DM * 2;
constexpr size_t WS_CW1K  = WS_WP   + (size_t)DM * PLE * 2;
constexpr size_t WS_CW1V  = WS_CW1K + (size_t)256 * 2048 * 2;
constexpr size_t WS_CBK   = WS_CW1V + (size_t)256 * 2048 * 2;
constexpr size_t WS_CBV   = WS_CBK  + 1024;
constexpr size_t WS_RS0   = WS_CBV  + 1024;
constexpr size_t WS_RS2   = WS_RS0  + (size_t)NTOK * 4;
constexpr size_t WS_RS1   = WS_RS2  + (size_t)NTOK * 4;
constexpr size_t WS_SSQ2  = WS_RS1  + (size_t)NTOK * 4;
constexpr size_t WS_SSQ1  = WS_SSQ2 + (size_t)16 * NTOK * 4;
constexpr size_t WS_SSQ3  = WS_SSQ1 + (size_t)16 * NTOK * 4;
constexpr size_t WS_KCMP  = WS_SSQ3 + (size_t)16 * NTOK * 4;
constexpr size_t WS_VCMP  = WS_KCMP + (size_t)8 * 256 * 64 * 4;
constexpr size_t WS_LRUP  = WS_VCMP + (size_t)8 * 256 * 64 * 4;
constexpr size_t WS_LRUH  = WS_LRUP + (size_t)256 * 512 * 4;
constexpr size_t WS_WAT   = WS_LRUH + (size_t)256 * 512 * 4;
constexpr size_t WS_WXT   = WS_WAT + 8 * 64 * 64 * 2;
constexpr size_t WS_CW2K  = WS_WXT + 8 * 64 * 64 * 2;
constexpr size_t WS_CW2V  = WS_CW2K + 64 * 256 * 2;
constexpr size_t WS_HID   = WS_CW2V + 64 * 256 * 2;
constexpr size_t WS_UB    = (WS_HID + (size_t)2 * 2048 * 256 * 4 + 4095) / 4096 * 4096;
constexpr size_t WS_LGA   = WS_UB + 8 * MB;
constexpr size_t WS_VB    = WS_UB + (size_t)16384 * DM * 2;
constexpr size_t WS_LGB   = WS_VB + 8 * MB;
constexpr size_t WS_PB    = WS_VB + (size_t)16384 * DM * 2;
constexpr size_t WS_XB    = WS_PB + (size_t)NTOK * PLE * 2;
constexpr size_t WS_R     = WS_XB + (size_t)NTOK * DM * 2;
constexpr size_t KVT = (size_t)NB * NKV * T_ * HD * 2 + 65536;
constexpr size_t R_QB    = WS_R;
constexpr size_t R_KC    = R_QB + (size_t)NTOK * 512 * 2;
constexpr size_t R_VC    = R_KC + KVT;
constexpr size_t R_KS    = R_VC + KVT;
constexpr size_t R_VS    = R_KS + KVT;
constexpr size_t R_KW    = R_VS + KVT;
constexpr size_t R_VW    = R_KW + KVT;
constexpr size_t R_GATE  = R_VW + KVT;
constexpr size_t R_XR    = R_GATE + (size_t)NTOK * 24 * 4;
constexpr size_t R_XG    = R_XR + (size_t)NTOK * 512 * 2;
constexpr size_t R_VST   = R_XG + (size_t)NTOK * 512 * 2;
constexpr size_t R_VWT   = R_VST + KVT;
constexpr size_t R_KCB   = R_VWT + KVT;
constexpr size_t R_VCT   = R_KCB + (size_t)8 * 256 * 64 * 2;
constexpr size_t R_END13 = R_VCT + (size_t)8 * 256 * 64 * 2;
constexpr size_t R_H1B   = WS_R;
constexpr size_t R_EXP   = R_H1B + (size_t)NTOK * DM * 2;
constexpr size_t R_GSM   = R_EXP + (size_t)NTOK * 128 * 4;
constexpr size_t R_COEF  = R_GSM + (size_t)NTOK * 128 * 4;
constexpr size_t R_BIG   = R_COEF + (size_t)NTOK * 128 * 4;
constexpr size_t WS_MIXED = (R_END13 + 4095) / 4096 * 4096;
static_assert(WS_MIXED + (size_t)NTOK * DM * 2 <= R_BIG + 64 * MB, "mixed must fit below the end of region R");
constexpr size_t WS_END  = (R_END13 > R_BIG + 64 * MB ? R_END13 : R_BIG + 64 * MB);
static_assert(WS_END <= 256 * MB, "workspace map exceeds 256 MiB");

DI float bf2f(bf16_t v) { return __uint_as_float((unsigned)v << 16); }
typedef __bf16 bf16x2hw_t __attribute__((ext_vector_type(2)));
DI unsigned pack2bf(float lo, float hi) { return __builtin_bit_cast(unsigned, __builtin_convertvector((f32x2){lo, hi}, bf16x2hw_t)); }
DI bf16_t f2bf(float x) { return (bf16_t)(pack2bf(x, x) & 0xffffu); }
DI float sigmoidf_(float x) { return __builtin_amdgcn_rcpf(1.0f + __expf(-x)); }
DI float gelu_tanh(float x) { const float u = 0.7978845608028654f * (x + 0.044715f * x * x * x); return x * sigmoidf_(2.0f * u); }

__device__ const unsigned char REL_BUCKET_LUT[128] = {
0,1,2,3,4,5,6,7,8,9,10,11,12,13,14,15,16,16,16,17,17,18,18,18,19,19,19,20,20,20,20,21,21,21,21,22,22,22,22,22,23,23,23,23,23,23,24,24,24,24,24,24,25,25,25,25,25,25,25,26,26,26,26,26,26,26,26,27,27,27,27,27,27,27,27,27,27,28,28,28,28,28,28,28,28,28,28,29,29,29,29,29,29,29,29,29,29,29,29,30,30,30,30,30,30,30,30,30,30,30,30,30,30,31,31,31,31,31,31,31,31,31,31,31,31,31,31,31};
DI int rel_bucket(int dist) { dist = dist < 0 ? 0 : dist; return dist >= 128 ? 31 : (int)REL_BUCKET_LUT[dist]; }

struct Params {
    const float* in[31];
    float* out;
    unsigned char* ws;
};
enum { I_X = 0, I_P, I_ATTN_NORM, I_W_IN, I_CK_PE, I_CK_W1, I_CK_W2, I_CV_PE, I_CV_W1, I_CV_W2, I_REL, I_CONV_W, I_CONV_B, I_LRU_WA, I_LRU_BA, I_LRU_WX, I_LRU_BX,
       I_LRU_LAM, I_GN_ATTN, I_GN_LRU, I_W_OUT, I_FFN_NORM, I_PEER_WQ, I_PEER_SUB, I_PEER_U, I_PEER_V, I_PLE_NORM, I_PLE_WG, I_PLE_BG, I_PLE_PROJ, I_FINAL_NORM };

struct EpiProj {
    static constexpr bool HAS8 = true;
    const float* rs0; bf16_t* qb; bf16_t* kv0; float* gates; bf16_t* xr; bf16_t* xg;
    DI void store8(int row, int col, f32x4 v0, f32x4 v1) const {
        const float s = rs0[row];
        v0 *= s; v1 *= s;
        const int tl = __builtin_amdgcn_readfirstlane(col >> 8);
        if (tl < 2) { const float qs = 0.125f * 1.4426950408889634f;
            v0 *= qs; v1 *= qs;
            u32x4 w; w.x = pack2bf(v0[0], v0[1]); w.y = pack2bf(v0[2], v0[3]); w.z = pack2bf(v1[0], v1[1]); w.w = pack2bf(v1[2], v1[3]); *(u32x4*)(qb + (size_t)row * 512 + col) = w; }
        else if (tl < 5) {
            const int c = col - PC_KV, tensor = c >> 7, within = c & 127, kvh = within >> 6, d = within & 63, b = row >> 12, t = row & 4095;
            bf16_t* dst = (bf16_t*)((unsigned char*)kv0 + (size_t)tensor * KVT) + ((size_t)(b * NKV + kvh) * T_ + t) * HD + d;
            u32x4 w; w.x = pack2bf(v0[0], v0[1]); w.y = pack2bf(v0[2], v0[3]); w.z = pack2bf(v1[0], v1[1]); w.w = pack2bf(v1[2], v1[3]); *(u32x4*)dst = w;
        }
        else if (tl < 7) { u32x4 w; w.x = pack2bf(v0[0], v0[1]); w.y = pack2bf(v0[2], v0[3]); w.z = pack2bf(v1[0], v1[1]); w.w = pack2bf(v1[2], v1[3]); *(u32x4*)(xr + (size_t)row * 512 + (col - PC_XR)) = w; }
        else if (tl < 9) { u32x4 w; w.x = pack2bf(v0[0], v0[1]); w.y = pack2bf(v0[2], v0[3]); w.z = pack2bf(v1[0], v1[1]); w.w = pack2bf(v1[2], v1[3]); *(u32x4*)(xg + (size_t)row * 512 + (col - PC_XG)) = w; }
        else if (col < PC_GATE + 24) { float* g = gates + (size_t)row * 24 + (col - PC_GATE); *(f32x4*)g = v0; *(f32x4*)(g + 4) = v1; }
    }
};
struct EpiOut {
    const float* x; float* h1; bf16_t* h1b;
    DI void store4(int row, int col, f32x4 v) const {
        const size_t o = (size_t)row * DM + col;
        v += *(const f32x4*)(x + o);
        *(f32x4*)(h1 + o) = v;
        u32x2 w; w.x = pack2bf(v[0], v[1]); w.y = pack2bf(v[2], v[3]); *(u32x2*)(h1b + o) = w;
    }
};
struct EpiF32Plain { float* C; int ldc; int coloff;
    DI void store4(int row, int col, f32x4 v) const { *(f32x4*)(C + (size_t)row * ldc + (col - coloff)) = v; } };
struct EpiGate {
    const float* rs2; const float* bias; const float* pp; float* h;
    DI void store4(int row, int col, f32x4 v) const {
        const size_t o = (size_t)row * DM + col;
        const float s = rs2[row];
        const f32x4 bb = *(const f32x4*)(bias + col), p4 = *(const f32x4*)(pp + o);
        f32x4 hv = *(f32x4*)(h + o);
#pragma unroll
        for (int j = 0; j < 4; ++j) hv[j] += sigmoidf_(v[j] * s + bb[j]) * p4[j];
        *(f32x4*)(h + o) = hv;
    }
};
DI float wave_sum(float v) {
#pragma unroll
    for (int o = 32; o > 0; o >>= 1) v += __shfl_xor(v, o);
    return v;
}
DI float wave_max(float v) {
#pragma unroll
    for (int o = 32; o > 0; o >>= 1) v = fmaxf(v, __shfl_xor(v, o));
    return v;
}
DI float block_sum256(float v, float* red) {
    v = wave_sum(v); __syncthreads();
    if ((threadIdx.x & 63) == 0) red[threadIdx.x >> 6] = v; __syncthreads();
    return (red[0] + red[1]) + (red[2] + red[3]);
}
DI float block_max256(float v, float* red) {
    v = wave_max(v); __syncthreads();
    if ((threadIdx.x & 63) == 0) red[threadIdx.x >> 6] = v; __syncthreads();
    return fmaxf(fmaxf(red[0], red[1]), fmaxf(red[2], red[3]));
}

#define XB_TMO      128
#define XB_XCNT(j)  (256  + 64 * (j))
#define XB_XSUB(j)  (1280 + 64 * (j))
#define XB_XGEN(j)  (2304 + 64 * (j))
#define XB_TOP      3328
#define XB_TOPGEN   3392
#define XCD_BAR_WORDS 3456
#define XB_SPIN_CAP (1u << 18)
#define LAS __attribute__((address_space(3)))

__device__ __forceinline__ unsigned xb_ld(unsigned* p)              { return __hip_atomic_load(p, __ATOMIC_RELAXED, __HIP_MEMORY_SCOPE_AGENT); }
__device__ __forceinline__ float xb_ldf(const float* p)            { return __hip_atomic_load(p, __ATOMIC_RELAXED, __HIP_MEMORY_SCOPE_AGENT); }
__device__ __forceinline__ unsigned xb_add(unsigned* p, unsigned v) { return __hip_atomic_fetch_add(p, v, __ATOMIC_RELAXED, __HIP_MEMORY_SCOPE_AGENT); }
__device__ __forceinline__ unsigned xb_xcc_id() { return (unsigned)__builtin_amdgcn_s_getreg((3 << 11) | 20) & 0xFu; }
#define XB_SPIN(cond, bar) do { unsigned _sp = 0; while (cond) { __builtin_amdgcn_s_sleep(1); \
    if ((++_sp & 255u) == 0u) { if (xb_ld(&(bar)[XB_TMO])) break; if (_sp > XB_SPIN_CAP) { atomicAdd(&(bar)[XB_TMO], 1u); break; } } } } while (0)

struct XcdBarrier {
    unsigned* bar; unsigned x;
    volatile LAS unsigned* st;
};

__device__ __forceinline__ XcdBarrier xcd_barrier_post(unsigned* bar, volatile LAS unsigned* st) {
    XcdBarrier b; b.bar = bar; b.x = xb_xcc_id(); b.st = st;
    if (threadIdx.x == 0) (void)xb_add(&bar[XB_XCNT(b.x)], 1u);
    return b;
}
__device__ __forceinline__ void xcd_barrier_complete(unsigned* bar, unsigned x, unsigned& nloc, unsigned& nx) {
    const unsigned G = gridDim.x * gridDim.y * gridDim.z;
    unsigned sum, cnt, mine, sp = 0u;
    for (;;) {
        sum = 0u; cnt = 0u; mine = 0u;
#pragma unroll
        for (unsigned j = 0; j < 16; ++j) { const unsigned c = xb_ld(&bar[XB_XCNT(j)]); sum += c; cnt += (c > 0u) ? 1u : 0u; mine = (j == x) ? c : mine; }
        if (sum == G) break;
        __builtin_amdgcn_s_sleep(1);
        if ((++sp & 255u) == 0u) { if (xb_ld(&bar[XB_TMO])) break; if (sp > XB_SPIN_CAP) { atomicAdd(&bar[XB_TMO], 1u); break; } }
    }
    nloc = mine > 0u ? mine : 1u; nx = cnt > 0u ? cnt : 1u;
}

__device__ __forceinline__ void xcd_barrier(const XcdBarrier& b) {
    asm volatile("s_waitcnt vmcnt(0)" ::: "memory");
    __syncthreads();
    if (threadIdx.x == 0) {
        unsigned* bar = b.bar;
        __builtin_amdgcn_s_waitcnt(0);
        unsigned nloc = b.st[0], nx = b.st[1];
        if (nloc == 0u) { xcd_barrier_complete(bar, b.x, nloc, nx); b.st[0] = nloc; b.st[1] = nx; }
        const unsigned old = xb_add(&bar[XB_XSUB(b.x)], 1u);
        const unsigned gen = old / nloc;
        if (old + 1u == (gen + 1u) * nloc) {
            __builtin_amdgcn_fence(__ATOMIC_RELEASE, "agent");
            asm volatile("s_waitcnt vmcnt(0)" ::: "memory");
            const unsigned og = xb_add(&bar[XB_TOP], 1u);
            const unsigned tg = og / nx;
            if (og + 1u == (tg + 1u) * nx) xb_add(&bar[XB_TOPGEN], 1u);
            else XB_SPIN(xb_ld(&bar[XB_TOPGEN]) == tg, bar);
            __builtin_amdgcn_fence(__ATOMIC_ACQUIRE, "agent");
            xb_add(&bar[XB_XGEN(b.x)], 1u);
            asm volatile("s_waitcnt vmcnt(0)" ::: "memory");
        } else {
            XB_SPIN(xb_ld(&bar[XB_XGEN(b.x)]) == gen, bar);
            __builtin_amdgcn_fence(__ATOMIC_ACQUIRE, "agent");
            asm volatile("s_waitcnt vmcnt(0)" ::: "memory");
        }
    }
    __syncthreads();
}


namespace pg8 {
#define PG8_LAS __attribute__((address_space(3)))
typedef short bf16x8 __attribute__((ext_vector_type(8)));
constexpr int BM = 256, BK = 64, HALF = 128, HTB = HALF * BK * 2  , STAGE_BYTES = 8 * HTB, NXCD = 8, WGM = 8;

__host__ __device__ __forceinline__ int lds_byte(int r, int c) { const int st = (r >> 4) * 2 + (c >> 5), rr = r & 15, cc = c & 31, ob = rr * 64 + cc * 2; return st * 1024 + (ob ^ (((ob >> 9) & 1) << 5)); }
__host__ __device__ __forceinline__ void stage_rc(int b, int& R, int& C) { const int st = b / 1024, sb = b % 1024, swz = sb ^ (((sb >> 9) & 1) << 5); R = (st >> 1) * 16 + swz / 64; C = (st & 1) * 32 + (swz % 64) / 2; }
__host__ __device__ __forceinline__ int perm32(int rho) { const int n = rho >> 4, i = rho & 15; return 8 * (i >> 2) + 4 * n + (i & 3); }

struct Unit { int pm, pn; };
struct Gemm { const bf16_t* A; const bf16_t* Bt; int M, N, K; };

struct StaticOrder {
    int nM, nN, nwg, G, c;
    __host__ __device__ void init(int M, int N, int G_, int c_) { nM = M / BM; nN = N / BM; nwg = nM * nN; G = G_; c = c_; }
    __host__ __device__ bool next(int i, Unit& u) const {
        const long L = (long)i * G + c; if (L >= nwg) return false;
        int wgid = (int)L; { const int q = nwg / NXCD, r = nwg % NXCD, xcd = wgid % NXCD, off = wgid / NXCD; wgid = (xcd < r ? xcd * (q + 1) : r * (q + 1) + (xcd - r) * q) + off; }
        const int nig = WGM * nN, gid = wgid / nig, fm = gid * WGM, gsz = (nM - fm) < WGM ? (nM - fm) : WGM;
        u.pm = fm + ((wgid % nig) % gsz); u.pn = (wgid % nig) / gsz; return true;
    }
    __device__ __forceinline__ void a_ready(const Unit&) const {}
    __device__ __forceinline__ void done(const Unit&) const {}
};
template <class Epi, class Sched, bool STAMP = false>
__device__ __forceinline__ void gemm_phase(PG8_LAS unsigned char* lds, const Gemm g, const Sched& S, const Epi& E, unsigned long long* stamps) {
    int tid_ = threadIdx.x; asm volatile("" : "+v"(tid_));
    const int tid = tid_, wid = __builtin_amdgcn_readfirstlane(tid >> 6), lane = tid & 63, wr = wid >> 2, wc = wid & 3, fr = lane & 15, fq = lane >> 4;
    const int K = g.K, nt = K / BK;
    int ts_lo = 0, ts_hi = 0, nts = 0; const unsigned long long rt_entry = STAMP ? (unsigned long long)wall_clock64() : 0ull;
#define PG8_STAMP() do { if (STAMP && wid == 0 && nts < 64) { const unsigned long long _c = (unsigned long long)clock64(); \
        ts_lo = (lane == nts) ? (int)(unsigned)_c : ts_lo; ts_hi = (lane == nts) ? (int)(unsigned)(_c >> 32) : ts_hi; ++nts; } } while (0)
    PG8_STAMP();
    unsigned voffA[2], voffB[2];
#pragma unroll
    for (int i = 0; i < 2; ++i) { int R, C; stage_rc(tid * 16 + i * 8192, R, C); const int Rb = Epi::PERM ? ((R & ~31) + perm32(R & 31)) : R;
        voffA[i] = (unsigned)(R * K + C) * 2u; voffB[i] = (unsigned)(Rb * K + C) * 2u; }
    const size_t kstep = (size_t)(BK * 2);
    const size_t hstep = (size_t)HALF * K * 2;
    const size_t tstep = 2 * hstep;
    const unsigned ldsw = (unsigned)wid * 1024u;
    const int aoff = lds_byte(wr * 64 + fr, fq * 8), boff = lds_byte(wc * 32 + fr, fq * 8);
#define PG8_SA(b, h) (((b) * 2 + (h)) * HTB)
#define PG8_SB(b, h) ((4 + (b) * 2 + (h)) * HTB)
#define PG8_STAGE(bufoff, gbase, voff) do { _Pragma("unroll") for (int _i = 0; _i < 2; ++_i) \
        __builtin_amdgcn_global_load_lds((const unsigned*)((const char*)(gbase) + (voff)[_i]), (PG8_LAS unsigned*)(lds + (bufoff) + ldsw + _i * 8192), 16, 0, 0); } while (0)
#define PG8_LDA(dst, b, h) do { _Pragma("unroll") for (int m = 0; m < 4; ++m) _Pragma("unroll") for (int k = 0; k < 2; ++k) dst[m][k] = *(const PG8_LAS bf16x8*)(lds + PG8_SA(b, h) + aoff + m * 2048 + k * 1024); } while (0)
#define PG8_LDB(dst, b, h) do { _Pragma("unroll") for (int n = 0; n < 2; ++n) _Pragma("unroll") for (int k = 0; k < 2; ++k) dst[n][k] = *(const PG8_LAS bf16x8*)(lds + PG8_SB(b, h) + boff + n * 2048 + k * 1024); } while (0)
#define PG8_MMA(ai, bj, At, Bt) do { __builtin_amdgcn_s_setprio(1); _Pragma("unroll") for (int m = 0; m < 4; ++m) _Pragma("unroll") for (int n = 0; n < 2; ++n) _Pragma("unroll") for (int k = 0; k < 2; ++k) \
        acc[ai][bj][m][n] = __builtin_amdgcn_mfma_f32_16x16x32_bf16(Bt[n][k], At[m][k], acc[ai][bj][m][n], 0, 0, 0); __builtin_amdgcn_s_setprio(0); } while (0)
#define PG8_WAIT_V(n) asm volatile("s_waitcnt vmcnt(" #n ")" ::: "memory")
#define PG8_WAIT_L(n) asm volatile("s_waitcnt lgkmcnt(" #n ")" ::: "memory")
#define PG8_BAR __builtin_amdgcn_s_barrier()
#define PG8_SCHED __builtin_amdgcn_sched_barrier(0)
    Unit cur, nxt; int ui = 0;
    if (!S.next(0, cur)) return;
    f32x4 acc[2][2][4][2];
#pragma unroll
    for (int a = 0; a < 2; ++a)
#pragma unroll
        for (int b = 0; b < 2; ++b)
#pragma unroll
            for (int m = 0; m < 4; ++m)
#pragma unroll
                for (int n = 0; n < 2; ++n) acc[a][b][m][n] = (f32x4){0.f, 0.f, 0.f, 0.f};
    bf16x8 At[4][2], B0[2][2], B1[2][2];
    const char* cA = (const char*)g.A + (size_t)cur.pm * tstep; const char* cB = (const char*)g.Bt + (size_t)cur.pn * tstep;
    S.a_ready(cur);
    PG8_STAGE(PG8_SB(0, 0), cB, voffB); PG8_STAGE(PG8_SA(0, 0), cA, voffA); PG8_STAGE(PG8_SB(0, 1), cB + hstep, voffB); PG8_STAGE(PG8_SA(0, 1), cA + hstep, voffA);
    if (wr == 1) PG8_BAR;
    PG8_WAIT_V(4); PG8_BAR;
    PG8_STAGE(PG8_SB(1, 0), cB + kstep, voffB); PG8_STAGE(PG8_SA(1, 0), cA + kstep, voffA); PG8_STAGE(PG8_SB(1, 1), cB + hstep + kstep, voffB);
    PG8_WAIT_V(6); PG8_BAR;
    PG8_STAMP();
    for (;;) {
        const bool has_next = S.next(ui + 1, nxt);
        const char* nA = has_next ? (const char*)g.A + (size_t)nxt.pm * tstep : cA; const char* nB = has_next ? (const char*)g.Bt + (size_t)nxt.pn * tstep : cB;
        for (int t = 0; t < nt; t += 2) {
            const bool last = (t == nt - 2);
            const char* a1 = cA + (size_t)(t + 1) * kstep;
            const char* a2 = last ? nA : cA + (size_t)(t + 2) * kstep; const char* b2 = last ? nB : cB + (size_t)(t + 2) * kstep;
            const char* a3 = a2 + kstep; const char* b3 = b2 + kstep;
            if (last && has_next) S.a_ready(nxt);
            PG8_LDB(B0, 0, 0); PG8_SCHED; PG8_LDA(At, 0, 0); PG8_STAGE(PG8_SA(1, 1), a1 + hstep, voffA);
            PG8_WAIT_L(8); PG8_BAR; PG8_WAIT_L(0); PG8_MMA(0, 0, At, B0); PG8_BAR; PG8_SCHED;
            PG8_LDB(B1, 0, 1); PG8_STAGE(PG8_SB(0, 0), b2, voffB);
            PG8_BAR; PG8_WAIT_L(0); PG8_MMA(0, 1, At, B1); PG8_BAR;
            PG8_LDA(At, 0, 1); PG8_STAGE(PG8_SA(0, 0), a2, voffA);
            PG8_BAR; PG8_WAIT_L(0); PG8_MMA(1, 0, At, B0); PG8_BAR; PG8_SCHED;
            PG8_STAGE(PG8_SB(0, 1), b2 + hstep, voffB);
            PG8_WAIT_V(6); PG8_BAR; PG8_MMA(1, 1, At, B1); PG8_BAR;
            PG8_LDB(B0, 1, 0); PG8_SCHED; PG8_LDA(At, 1, 0); PG8_STAGE(PG8_SA(0, 1), a2 + hstep, voffA);
            PG8_WAIT_L(8); PG8_BAR; PG8_WAIT_L(0); PG8_MMA(0, 0, At, B0); PG8_BAR; PG8_SCHED;
            PG8_LDB(B1, 1, 1); PG8_STAGE(PG8_SB(1, 0), b3, voffB);
            PG8_BAR; PG8_WAIT_L(0); PG8_MMA(0, 1, At, B1); PG8_BAR;
            PG8_LDA(At, 1, 1); PG8_STAGE(PG8_SA(1, 0), a3, voffA);
            PG8_BAR; PG8_WAIT_L(0); PG8_MMA(1, 0, At, B0); PG8_BAR; PG8_SCHED;
            PG8_STAGE(PG8_SB(1, 1), b3 + hstep, voffB);
            PG8_WAIT_V(6); PG8_BAR; PG8_MMA(1, 1, At, B1); PG8_BAR;
        }
        PG8_STAMP();
        if constexpr (!Epi::AFTER_DRAIN) { E(acc, cur, wr, wc, fr, fq); S.done(cur); }
        PG8_STAMP();
        if (!has_next) break;
#pragma unroll
        for (int a = 0; a < 2; ++a)
#pragma unroll
            for (int b = 0; b < 2; ++b)
#pragma unroll
                for (int m = 0; m < 4; ++m)
#pragma unroll
                    for (int n = 0; n < 2; ++n) acc[a][b][m][n] = (f32x4){0.f, 0.f, 0.f, 0.f};
        cur = nxt; cA = nA; cB = nB; ++ui;
    }
    PG8_WAIT_V(0);
    if (wr == 0) PG8_BAR;
    PG8_BAR;
    if constexpr (Epi::AFTER_DRAIN) { E.fused(acc, cur, wr, wc, fr, fq, lds, wid, lane); S.done(cur); }
    PG8_STAMP();
    if (STAMP && wid == 0) { stamps[lane] = lane < nts ? (((unsigned long long)(unsigned)ts_hi << 32) | (unsigned)ts_lo) : 0ull;
        if (lane == 62) stamps[62] = rt_entry; if (lane == 63) stamps[63] = (unsigned long long)wall_clock64(); }
#undef PG8_STAMP
#undef PG8_SA
#undef PG8_SB
#undef PG8_STAGE
#undef PG8_LDA
#undef PG8_LDB
#undef PG8_MMA
#undef PG8_WAIT_V
#undef PG8_WAIT_L
#undef PG8_BAR
#undef PG8_SCHED
}
}
#define LAS3 __attribute__((address_space(3)))
constexpr int MK_THREADS = 512;
constexpr float U4_ISCALE = 83.0f;
typedef __bf16 bf16x2_t __attribute__((ext_vector_type(2)));
DI float dot2bf(unsigned a, unsigned b, float c) { return __builtin_amdgcn_fdot2_f32_bf16(__builtin_bit_cast(bf16x2_t, a), __builtin_bit_cast(bf16x2_t, b), c, false); }
DI float bflo(unsigned v) { return __uint_as_float(v << 16); }
DI float bfhi(unsigned v) { return __uint_as_float(v & 0xffff0000u); }

template <class ColMap>
DI void transpose_tile(const float* __restrict__ src, int ldsrc, const float* __restrict__ gain, bf16_t* __restrict__ dst, int K, int k0, int n0, const ColMap& cm, LAS3 float* tl) {
    const int tid = threadIdx.x;
    __syncthreads();
    {
        const int n = tid & 63, sc = cm(n0 + n);
#pragma unroll
        for (int j = 0; j < 8; ++j) { const int k = (tid >> 6) + 8 * j; tl[k * 65 + n] = sc >= 0 ? src[(size_t)(k0 + k) * ldsrc + sc] * (gain ? gain[k0 + k] : 1.0f) : 0.f; }
    }
    __syncthreads();
    {
        const int n = tid >> 3, k8 = (tid & 7) * 8;
        u32x4 w;
        w.x = pack2bf(tl[(k8 + 0) * 65 + n], tl[(k8 + 1) * 65 + n]); w.y = pack2bf(tl[(k8 + 2) * 65 + n], tl[(k8 + 3) * 65 + n]);
        w.z = pack2bf(tl[(k8 + 4) * 65 + n], tl[(k8 + 5) * 65 + n]); w.w = pack2bf(tl[(k8 + 6) * 65 + n], tl[(k8 + 7) * 65 + n]);
        *(u32x4*)(dst + (size_t)(n0 + n) * K + k0 + k8) = w;
    }
}
template <class ColMap, bool FRAG = false>
DI void transpose_tile_wave(const float* __restrict__ src, int ldsrc, const float* __restrict__ gain, bf16_t* __restrict__ dst, int K, int k0, int n0, const ColMap& cm, LAS3 float* tl, int lane) {
    const int sc = cm(n0 + lane);
    float v[64];
#pragma unroll
    for (int k = 0; k < 64; ++k) v[k] = sc >= 0 ? src[(size_t)(k0 + k) * ldsrc + sc] : 0.f;
    if (gain) {
        const float gl = gain[k0 + lane];
#pragma unroll
        for (int k = 0; k < 64; ++k) v[k] *= __uint_as_float(__builtin_amdgcn_readlane(__float_as_uint(gl), k));
    }
#pragma unroll
    for (int k = 0; k < 64; ++k) tl[k * 65 + lane] = v[k];
    const int nl = lane >> 3, k8 = (lane & 7) * 8;
#pragma unroll
    for (int ps = 0; ps < 8; ++ps) {
        const int n = nl + 8 * ps;
        u32x4 w;
        w.x = pack2bf(tl[(k8 + 0) * 65 + n], tl[(k8 + 1) * 65 + n]); w.y = pack2bf(tl[(k8 + 2) * 65 + n], tl[(k8 + 3) * 65 + n]);
        w.z = pack2bf(tl[(k8 + 4) * 65 + n], tl[(k8 + 5) * 65 + n]); w.w = pack2bf(tl[(k8 + 6) * 65 + n], tl[(k8 + 7) * 65 + n]);
        if (FRAG) { const int nn = n0 + n, kk = k0 + k8; *(u32x4*)(dst + ((((size_t)(nn >> 4) * (K / 32) + (kk >> 5)) * 64) + ((nn & 15) + 16 * ((kk >> 3) & 3))) * 8) = w; }
        else *(u32x4*)(dst + (size_t)(n0 + n) * K + k0 + k8) = w;
    }
}
struct ColId { DI int operator()(int n) const { return n; } };
struct ColWin { DI int operator()(int n) const { return n < PC_XR ? n : (n < PC_XG ? 1304 + (n - PC_XR) : (n < PC_GATE ? 1816 + (n - PC_XG) : (n < PC_GATE + 24 ? 1280 + (n - PC_GATE) : -1))); } };

DI void cvt_rows_bf16(const float* __restrict__ src, const float* __restrict__ gain, bf16_t* __restrict__ dst, size_t n8, int cols, size_t gtid, size_t nthr) {
    for (size_t i0 = gtid; i0 < n8; i0 += 8 * nthr) {
        f32x4 a[8], b[8];
#pragma unroll
        for (int u = 0; u < 8; ++u) { const size_t i = i0 + u * nthr; if (i < n8) { a[u] = *(const f32x4*)(src + i * 8); b[u] = *(const f32x4*)(src + i * 8 + 4); } }
#pragma unroll
        for (int u = 0; u < 8; ++u) { const size_t i = i0 + u * nthr; if (i < n8) {
            f32x4 x = a[u], y = b[u];
            if (gain) { const int c = (int)((i * 8) % cols); x *= *(const f32x4*)(gain + c); y *= *(const f32x4*)(gain + c + 4); }
            u32x4 w; w.x = pack2bf(x[0], x[1]); w.y = pack2bf(x[2], x[3]); w.z = pack2bf(y[0], y[1]); w.w = pack2bf(y[2], y[3]);
            *(u32x4*)(dst + i * 8) = w; } }
    }
}
DI void cvt_rows_i4(const float* __restrict__ src, const float* __restrict__ gain, float scale, unsigned char* __restrict__ dst, size_t n8, int cols, size_t gtid, size_t nthr) {
    for (size_t i0 = gtid; i0 < n8; i0 += 8 * nthr) {
        f32x4 a[8], b[8];
#pragma unroll
        for (int u = 0; u < 8; ++u) { const size_t i = i0 + u * nthr; if (i < n8) { a[u] = *(const f32x4*)(src + i * 8); b[u] = *(const f32x4*)(src + i * 8 + 4); } }
#pragma unroll
        for (int u = 0; u < 8; ++u) { const size_t i = i0 + u * nthr; if (i < n8) {
            f32x4 x = a[u], y = b[u];
            if (gain) { const int c = (int)((i * 8) % cols); x *= *(const f32x4*)(gain + c); y *= *(const f32x4*)(gain + c + 4); }
            unsigned w = 0u;
#pragma unroll
            for (int j = 0; j < 4; ++j) {
                const int qa = (int)rintf(fminf(fmaxf(x[j] * scale, -7.f), 7.f)), qb = (int)rintf(fminf(fmaxf(y[j] * scale, -7.f), 7.f));
                w |= ((unsigned)qa & 0xfu) << (4 * j); w |= ((unsigned)qb & 0xfu) << (16 + 4 * j);
            }
            { const unsigned n1 = __shfl_down(w, 1), n2 = __shfl_down(w, 2), n3 = __shfl_down(w, 3); if ((threadIdx.x & 3) == 0) *(u32x4*)(dst + i * 4) = (u32x4){w, n1, n2, n3}; } } }
    }
}
DI void cvt_rows_fp4(const float* __restrict__ src, const float* __restrict__ gain, float scale, unsigned char* __restrict__ dst, size_t n8, int cols, size_t gtid, size_t nthr) {
    for (size_t i0 = gtid; i0 < n8; i0 += 8 * nthr) {
        f32x4 a[8], b[8];
#pragma unroll
        for (int u = 0; u < 8; ++u) { const size_t i = i0 + u * nthr; if (i < n8) { a[u] = *(const f32x4*)(src + i * 8); b[u] = *(const f32x4*)(src + i * 8 + 4); } }
#pragma unroll
        for (int u = 0; u < 8; ++u) { const size_t i = i0 + u * nthr; if (i < n8) {
            f32x4 x = a[u], y = b[u];
            if (gain) { const int c = (int)((i * 8) % cols); x *= *(const f32x4*)(gain + c); y *= *(const f32x4*)(gain + c + 4); }
            x *= scale; y *= scale;
            unsigned w = 0u;
            w = __builtin_amdgcn_cvt_scalef32_pk_fp4_f32(w, x[0], x[1], 1.0f, 0); w = __builtin_amdgcn_cvt_scalef32_pk_fp4_f32(w, x[2], x[3], 1.0f, 1);
            w = __builtin_amdgcn_cvt_scalef32_pk_fp4_f32(w, y[0], y[1], 1.0f, 2); w = __builtin_amdgcn_cvt_scalef32_pk_fp4_f32(w, y[2], y[3], 1.0f, 3);
            { const unsigned n1 = __shfl_down(w, 1), n2 = __shfl_down(w, 2), n3 = __shfl_down(w, 3); if ((threadIdx.x & 3) == 0) *(u32x4*)(dst + i * 4) = (u32x4){w, n1, n2, n3}; } } }
    }
}
DI void p1_deferred(const Params& p, int G) {
    const int nunits = (NTOK / 256) * (NPROJ / 256), nfull = nunits % G;
    const int first = nfull == 0 ? 0 : nfull, nwg = G - first;
    if ((int)blockIdx.x < first) return;
    const size_t gtid = (size_t)(blockIdx.x - first) * MK_THREADS + threadIdx.x, nthr = (size_t)nwg * MK_THREADS;
    if (gtid < 512) {
        const float* part = (const float*)(p.ws + WS_HID) + (gtid >> 8) * 32 * 256 + (gtid & 255);
        float a = 0.f;
#pragma unroll
        for (int k = 0; k < 32; ++k) a += part[k * 256];
        ((float*)(p.ws + ((gtid >> 8) ? WS_CBV : WS_CBK)))[gtid & 255] = a;
    }
    cvt_rows_i4(p.in[I_PEER_U], p.in[I_FFN_NORM], U4_ISCALE, (unsigned char*)(p.ws + WS_UB), (size_t)16384 * DM / 8, DM, gtid, nthr);
    cvt_rows_bf16(p.in[I_P], nullptr, (bf16_t*)(p.ws + WS_PB), (size_t)NTOK * PLE / 8, PLE, gtid, nthr);
}
DI void p0_prologue(const Params& p, LAS3 unsigned char* lds, int G) {
    unsigned char* ws = p.ws;
    const int tid = threadIdx.x, lane = tid & 63, wid = tid >> 6, bid = blockIdx.x;
    const size_t gtid = (size_t)bid * MK_THREADS + tid, nthr = (size_t)G * MK_THREADS;
    const int gw = bid * 8 + wid, nw = G * 8;
    {
        const float* x = p.in[I_X]; bf16_t* xb = (bf16_t*)(ws + WS_XB); float* rs0 = (float*)(ws + WS_RS0);
        for (int row0 = gw; row0 < NTOK; row0 += 4 * nw) {
            f32x4 v[4][4];
#pragma unroll
            for (int u = 0; u < 4; ++u) { const int row = row0 + u * nw; if (row < NTOK) { const float* xr_ = x + (size_t)row * DM + lane * 8;
                v[u][0] = *(const f32x4*)xr_; v[u][1] = *(const f32x4*)(xr_ + 4); v[u][2] = *(const f32x4*)(xr_ + 512); v[u][3] = *(const f32x4*)(xr_ + 516); } }
#pragma unroll
            for (int u = 0; u < 4; ++u) { const int row = row0 + u * nw; if (row < NTOK) {
                float s = 0.f;
#pragma unroll
                for (int j = 0; j < 4; ++j) s += (v[u][j][0] * v[u][j][0] + v[u][j][1] * v[u][j][1]) + (v[u][j][2] * v[u][j][2] + v[u][j][3] * v[u][j][3]);
                s = wave_sum(s);
                u32x4 w0, w1;
                w0.x = pack2bf(v[u][0][0], v[u][0][1]); w0.y = pack2bf(v[u][0][2], v[u][0][3]); w0.z = pack2bf(v[u][1][0], v[u][1][1]); w0.w = pack2bf(v[u][1][2], v[u][1][3]);
                w1.x = pack2bf(v[u][2][0], v[u][2][1]); w1.y = pack2bf(v[u][2][2], v[u][2][3]); w1.z = pack2bf(v[u][3][0], v[u][3][1]); w1.w = pack2bf(v[u][3][2], v[u][3][3]);
                *(u32x4*)(xb + (size_t)row * DM + lane * 8) = w0; *(u32x4*)(xb + (size_t)row * DM + 512 + lane * 8) = w1;
                if (lane == 0) rs0[row] = rsqrtf(s * (1.0f / DM) + EPS); } }
        }
    }
    cvt_rows_fp4(p.in[I_PEER_V], nullptr, 8.0f, (unsigned char*)(ws + WS_VB), (size_t)16384 * DM / 8, DM, gtid, nthr);
    {
        LAS3 float* tl = (LAS3 float*)lds + wid * (64 * 65);
        for (int u = gw; u < 1496; u += nw) {
            if (u < 640) transpose_tile_wave(p.in[I_W_IN], INCOLS, p.in[I_ATTN_NORM], (bf16_t*)(ws + WS_WIN), DM, (u % 16) * 64, (u / 16) * 64, ColWin{}, tl, lane);
            else if (u < 896) { const int v = u - 640; transpose_tile_wave(p.in[I_W_OUT], DM, nullptr, (bf16_t*)(ws + WS_WOUT), DM, (v % 16) * 64, (v / 16) * 64, ColId{}, tl, lane); }
            else if (u < 1152) { const int v = u - 896; transpose_tile_wave(p.in[I_PLE_WG], DM, p.in[I_PLE_NORM], (bf16_t*)(ws + WS_WG), DM, (v % 16) * 64, (v / 16) * 64, ColId{}, tl, lane); }
            else if (u < 1216) { const int v = u - 1152; transpose_tile_wave(p.in[I_PLE_PROJ], DM, nullptr, (bf16_t*)(ws + WS_WP), PLE, (v % 4) * 64, (v / 4) * 64, ColId{}, tl, lane); }
            else if (u < 1344) { const int v = u - 1216; transpose_tile_wave<ColId, true>(p.in[I_CK_W1], 256, nullptr, (bf16_t*)(ws + WS_CW1K), 2048, (v % 32) * 64, (v / 32) * 64, ColId{}, tl, lane); }
            else if (u < 1472) { const int v = u - 1344; transpose_tile_wave<ColId, true>(p.in[I_CV_W1], 256, nullptr, (bf16_t*)(ws + WS_CW1V), 2048, (v % 32) * 64, (v / 32) * 64, ColId{}, tl, lane); }
            else if (u < 1480) { const int v = u - 1472; transpose_tile_wave(p.in[I_LRU_WA] + v * 4096, 64, nullptr, (bf16_t*)(ws + WS_WAT) + v * 4096, 64, 0, 0, ColId{}, tl, lane); }
            else if (u < 1488) { const int v = u - 1480; transpose_tile_wave(p.in[I_LRU_WX] + v * 4096, 64, nullptr, (bf16_t*)(ws + WS_WXT) + v * 4096, 64, 0, 0, ColId{}, tl, lane); }
            else if (u < 1492) { const int v = u - 1488; transpose_tile_wave(p.in[I_CK_W2], 64, nullptr, (bf16_t*)(ws + WS_CW2K), 256, v * 64, 0, ColId{}, tl, lane); }
            else { const int v = u - 1492; transpose_tile_wave(p.in[I_CV_W2], 64, nullptr, (bf16_t*)(ws + WS_CW2V), 256, v * 64, 0, ColId{}, tl, lane); }
        }
        __syncthreads();
    }
    {
        LAS3 float* wt = (LAS3 float*)lds;
        LAS3 float* st = (LAS3 float*)(lds + 32768);
        const float* wq = p.in[I_PEER_WQ]; const float* sub = p.in[I_PEER_SUB]; const float* gain = p.in[I_FFN_NORM]; bf16_t* WqsT = (bf16_t*)(ws + WS_WQS);
        for (int u = bid; u < 256; u += G) {
            const int hp = u >> 4, d0 = (u & 15) * 64, pp = hp & 1;
            __syncthreads();
            {
                f32x4 wv[4], sv[8];
#pragma unroll
                for (int u = 0; u < 4; ++u) { const int i = tid + u * MK_THREADS, d = i >> 5, dk4 = (i & 31) * 4; wv[u] = *(const f32x4*)(wq + (size_t)(d0 + d) * 2048 + hp * 128 + dk4); }
#pragma unroll
                for (int u = 0; u < 8; ++u) { const int i = tid + u * MK_THREADS, kk = i >> 5, dk4 = (i & 31) * 4; sv[u] = *(const f32x4*)(sub + ((size_t)pp * 128 + kk) * 128 + dk4); }
#pragma unroll
                for (int u = 0; u < 4; ++u) { const int i = tid + u * MK_THREADS, d = i >> 5, dk4 = (i & 31) * 4;
#pragma unroll
                    for (int j = 0; j < 4; ++j) wt[(dk4 + j) * 64 + d] = wv[u][j]; }
#pragma unroll
                for (int u = 0; u < 8; ++u) { const int i = tid + u * MK_THREADS, kk = i >> 5, dk4 = (i & 31) * 4;
#pragma unroll
                    for (int j = 0; j < 4; ++j) st[kk * 129 + dk4 + j] = sv[u][j]; }
            }
            __syncthreads();
            {
                typedef float f32x16_ __attribute__((ext_vector_type(16)));
                const int kk0 = (wid & 3) * 32, dd0 = (wid >> 2) * 32, r = lane & 31, hf = lane >> 5;
                f32x16_ acc;
#pragma unroll
                for (int i = 0; i < 16; ++i) acc[i] = 0.f;
#pragma unroll 8
                for (int i = 0; i < 64; ++i) acc = __builtin_amdgcn_mfma_f32_32x32x2f32(st[(kk0 + r) * 129 + 2 * i + hf], wt[(2 * i + hf) * 64 + dd0 + r], acc, 0, 0, 0);
                const float gd = gain[d0 + dd0 + r];
#pragma unroll
                for (int i = 0; i < 16; ++i) {
                    const int kk = kk0 + (i & 3) + 8 * (i >> 2) + 4 * hf;
                    WqsT[(size_t)(hp * 128 + kk) * DM + d0 + dd0 + r] = f2bf(acc[i] * gd);
                }
            }
        }
        __syncthreads();
    }
    for (int o = gw; o < 256; o += nw) {
        const int kv = o >> 7, jg = (o >> 5) & 3, kp = o & 31;
        const float* pe = p.in[kv ? I_CV_PE : I_CK_PE]; const float* w1 = p.in[kv ? I_CV_W1 : I_CK_W1];
        const float pel = pe[kp * 64 + lane];
        float wv[64];
#pragma unroll
        for (int i = 0; i < 64; ++i) wv[i] = w1[(size_t)(kp * 64 + i) * 256 + jg * 64 + lane];
        float acc = 0.f;
#pragma unroll
        for (int i = 0; i < 64; ++i) acc += __uint_as_float(__builtin_amdgcn_readlane(__float_as_uint(pel), i)) * wv[i];
        ((float*)(ws + WS_HID))[(kv * 32 + kp) * 256 + jg * 64 + lane] = acc;
    }
}

DI void p6_peer_apply(const Params& p, int G) {
    unsigned char* ws = p.ws;
    const int tid = threadIdx.x, lane = tid & 63, wid = tid >> 6;
    const int gw = blockIdx.x * 8 + wid, nw = G * 8;
    const bf16_t* ub = (const bf16_t*)(ws + WS_UB); const bf16_t* vb = (const bf16_t*)(ws + WS_VB);
    const int* eidx = (const int*)(ws + R_EXP); const float* gsm = (const float*)(ws + R_GSM); const float* ssq1 = (const float*)(ws + WS_SSQ1);
    float* h = p.out; bf16_t* hb = (bf16_t*)(ws + R_H1B); float* rs2 = (float*)(ws + WS_RS2);
    for (int tok = gw; tok < NTOK; tok += nw) {
        float sq = lane < 16 ? ssq1[(size_t)lane * NTOK + tok] : 0.f;
        sq = wave_sum(sq);
        const float rs1 = rsqrtf(sq * (1.0f / DM) + EPS);
        const u32x4 xa = *(const u32x4*)(hb + (size_t)tok * DM + lane * 8), xc = *(const u32x4*)(hb + (size_t)tok * DM + 512 + lane * 8);
        const int e0 = eidx[(size_t)tok * 128 + lane], e1 = eidx[(size_t)tok * 128 + 64 + lane];
        const float g0 = gsm[(size_t)tok * 128 + lane], g1 = gsm[(size_t)tok * 128 + 64 + lane];
        float coef0 = 0.f, coef1 = 0.f;
#pragma unroll
        for (int half = 0; half < 2; ++half) {
            const int ev = half ? e1 : e0;
            float part[64];
#pragma unroll
            for (int j = 0; j < 64; ++j) {
                const int e = __builtin_amdgcn_readlane(ev, j);
                const bf16_t* ur = ub + (size_t)e * DM + lane * 8;
                const u32x4 ua = *(const u32x4*)ur, uc = *(const u32x4*)(ur + 512);
                float a = dot2bf(xa.x, ua.x, 0.f); a = dot2bf(xa.y, ua.y, a); a = dot2bf(xa.z, ua.z, a); a = dot2bf(xa.w, ua.w, a);
                a = dot2bf(xc.x, uc.x, a); a = dot2bf(xc.y, uc.y, a); a = dot2bf(xc.z, uc.z, a); a = dot2bf(xc.w, uc.w, a);
                part[j] = a;
            }
#pragma unroll
            for (int m = 32; m >= 1; m >>= 1) {
                const bool up = (lane & m) != 0;
#pragma unroll
                for (int i = 0; i < m; ++i) {
                    const float send = up ? part[i] : part[i + m];
                    const float keep = up ? part[i + m] : part[i];
                    part[i] = keep + __shfl_xor(send, m);
                }
            }
            const float act = gelu_tanh(part[0] * rs1);
            if (half) coef1 = g1 * act; else coef0 = g0 * act;
        }
        float acc[16];
#pragma unroll
        for (int i = 0; i < 16; ++i) acc[i] = 0.f;
#pragma unroll
        for (int half = 0; half < 2; ++half) {
            const int ev = half ? e1 : e0; const float cv = half ? coef1 : coef0;
#pragma unroll 16
            for (int j = 0; j < 64; ++j) {
                const int e = __builtin_amdgcn_readlane(ev, j);
                const float c = __uint_as_float(__builtin_amdgcn_readlane(__float_as_uint(cv), j));
                const bf16_t* vr = vb + (size_t)e * DM + lane * 8;
                const u32x4 va = *(const u32x4*)vr, vc = *(const u32x4*)(vr + 512);
                acc[0] += c * bflo(va.x); acc[1] += c * bfhi(va.x); acc[2] += c * bflo(va.y); acc[3] += c * bfhi(va.y);
                acc[4] += c * bflo(va.z); acc[5] += c * bfhi(va.z); acc[6] += c * bflo(va.w); acc[7] += c * bfhi(va.w);
                acc[8] += c * bflo(vc.x); acc[9] += c * bfhi(vc.x); acc[10] += c * bflo(vc.y); acc[11] += c * bfhi(vc.y);
                acc[12] += c * bflo(vc.z); acc[13] += c * bfhi(vc.z); acc[14] += c * bflo(vc.w); acc[15] += c * bfhi(vc.w);
            }
        }
        float* hr = h + (size_t)tok * DM + lane * 8;
        f32x4 h0 = *(f32x4*)hr, h1 = *(f32x4*)(hr + 4), h2 = *(f32x4*)(hr + 512), h3 = *(f32x4*)(hr + 516);
        h0 += (f32x4){acc[0], acc[1], acc[2], acc[3]}; h1 += (f32x4){acc[4], acc[5], acc[6], acc[7]};
        h2 += (f32x4){acc[8], acc[9], acc[10], acc[11]}; h3 += (f32x4){acc[12], acc[13], acc[14], acc[15]};
        *(f32x4*)hr = h0; *(f32x4*)(hr + 4) = h1; *(f32x4*)(hr + 512) = h2; *(f32x4*)(hr + 516) = h3;
        u32x4 w0, w1;
        w0.x = pack2bf(h0[0], h0[1]); w0.y = pack2bf(h0[2], h0[3]); w0.z = pack2bf(h1[0], h1[1]); w0.w = pack2bf(h1[2], h1[3]);
        w1.x = pack2bf(h2[0], h2[1]); w1.y = pack2bf(h2[2], h2[3]); w1.z = pack2bf(h3[0], h3[1]); w1.w = pack2bf(h3[2], h3[3]);
        *(u32x4*)(hb + (size_t)tok * DM + lane * 8) = w0; *(u32x4*)(hb + (size_t)tok * DM + 512 + lane * 8) = w1;
        float s = 0.f;
#pragma unroll
        for (int j = 0; j < 4; ++j) s += h0[j] * h0[j] + h1[j] * h1[j] + h2[j] * h2[j] + h3[j] * h3[j];
        s = wave_sum(s);
        if (lane == 0) rs2[tok] = rsqrtf(s * (1.0f / DM) + EPS);
    }
}

DI void p8_final_norm(const Params& p, int G) {
    const int lane = threadIdx.x & 63, gw = blockIdx.x * 8 + (threadIdx.x >> 6), nw = G * 8;
    const float* ssq3 = (const float*)(p.ws + WS_SSQ3); const float* g = p.in[I_FINAL_NORM]; const bf16_t* h3 = (const bf16_t*)(p.ws + WS_XB); float* out = p.out;
    f32x4 gg[4];
    gg[0] = *(const f32x4*)(g + lane * 8); gg[1] = *(const f32x4*)(g + lane * 8 + 4); gg[2] = *(const f32x4*)(g + 512 + lane * 8); gg[3] = *(const f32x4*)(g + 512 + lane * 8 + 4);
    for (int row0 = gw; row0 < NTOK; row0 += 4 * nw) {
        u32x4 va[4], vb[4]; float sq[4];
#pragma unroll
        for (int u = 0; u < 4; ++u) { const int row = row0 + u * nw; if (row < NTOK) { sq[u] = lane < 16 ? ssq3[(size_t)lane * NTOK + row] : 0.f;
            va[u] = *(const u32x4*)(h3 + (size_t)row * DM + lane * 8); vb[u] = *(const u32x4*)(h3 + (size_t)row * DM + 512 + lane * 8); } }
#pragma unroll
        for (int u = 0; u < 4; ++u) { const int row = row0 + u * nw; if (row < NTOK) {
            const float rs = rsqrtf(wave_sum(sq[u]) * (1.0f / DM) + EPS);
            float* o = out + (size_t)row * DM + lane * 8;
            *(f32x4*)o = (f32x4){bflo(va[u].x), bfhi(va[u].x), bflo(va[u].y), bfhi(va[u].y)} * rs * gg[0];
            *(f32x4*)(o + 4) = (f32x4){bflo(va[u].z), bfhi(va[u].z), bflo(va[u].w), bfhi(va[u].w)} * rs * gg[1];
            *(f32x4*)(o + 512) = (f32x4){bflo(vb[u].x), bfhi(vb[u].x), bflo(vb[u].y), bfhi(vb[u].y)} * rs * gg[2];
            *(f32x4*)(o + 516) = (f32x4){bflo(vb[u].z), bfhi(vb[u].z), bflo(vb[u].w), bfhi(vb[u].w)} * rs * gg[3]; } }
    }
}
typedef float f32x16 __attribute__((ext_vector_type(16)));
typedef short bf16x8v __attribute__((ext_vector_type(8)));
typedef short s16x4v __attribute__((ext_vector_type(4)));
typedef __bf16 bf16x2v_ __attribute__((ext_vector_type(2)));
DI unsigned pk_bf16(float lo, float hi) { return __builtin_bit_cast(unsigned, __builtin_convertvector((f32x2){lo, hi}, bf16x2v_)); }
constexpr float LOG2E = 1.4426950408889634f;
constexpr int AT_KROW = 128, AT_VROW = 128;
constexpr int AT_KT = 64 * AT_KROW, AT_VT = 64 * AT_VROW, AT_BUF = 2 * AT_KT + 2 * AT_VT;
constexpr int AT_VAL = 0;
constexpr int AT_LUT = 2 * AT_BUF;
constexpr int AT_IMP = AT_LUT + 8 * 128 * 4;
constexpr int AT_SEL = AT_IMP + 8 * 32 * 65 * 4;
constexpr int AT_SSQ = AT_SEL + 512;
constexpr int AT_END = AT_SSQ + 1024;
static_assert(AT_END <= 160 * 1024 - 256, "attention LDS map");

struct AtSrc { const bf16_t* k0; const bf16_t* v0; int kvstride; };
struct AtDma { const unsigned char* base; int voffE, voffO, ldsoff; };
DI AtDma at_dma_setup(const AtSrc& s, int w, int lane) {
    AtDma d;
    const int isv = w >> 2, kvh = (w >> 1) & 1, half = w & 1, row0 = lane >> 3;
    const int chE = isv ? ((lane & 7) ^ (((lane >> 4) & 1) << 2)) : ((lane & 7) ^ (lane >> 4)), chO = isv ? chE : (chE ^ 4);
    const bf16_t* b0 = isv ? s.v0 : s.k0;
    d.base = (const unsigned char*)(b0 + (size_t)kvh * s.kvstride + (size_t)(half * 32) * HD);
    d.voffE = (row0 * HD + chE * 8) * 2; d.voffO = (row0 * HD + chO * 8) * 2;
    d.ldsoff = isv * (2 * AT_KT) + kvh * AT_KT + half * 4096;
    return d;
}
DI void at_dma(const AtDma& d, int blk, LAS3 unsigned char* buf) {
    const unsigned char* p = d.base + (size_t)blk * (64 * HD * 2);
#pragma unroll
    for (int j = 0; j < 4; ++j)
        __builtin_amdgcn_global_load_lds((const unsigned*)(p + j * (8 * HD * 2) + ((j & 1) ? d.voffO : d.voffE)), (LAS3 unsigned*)(buf + d.ldsoff + j * 1024), 16, 0, 0);
}

template <int MODE, int PASS, int APROBE>
DI void at_step(LAS3 const unsigned char* Kb, LAS3 const unsigned char* Vb, const bf16x8v (&Q)[4], int k0, int tq, int lane, LAS3 const float* lut, bool blk_ok, bool farstep,
                float& m_run, float& l_run, f32x16 (&O)[2], f32x16& Lacc, float inv_l, LAS3 float* imp_row, float& bcarry) {
    const int r = lane & 31, hf = lane >> 5;
    f32x16 S[2];
#pragma unroll
    for (int sub = 0; sub < 2; ++sub) {
#pragma unroll
        for (int i = 0; i < 16; ++i) S[sub][i] = 0.f;
#pragma unroll
        for (int ks = 0; ks < 4; ++ks) {
            const bf16x8v a = *(LAS3 const bf16x8v*)(Kb + (32 * sub + r) * AT_KROW + (((2 * ks + hf) ^ ((r >> 1) & 7)) << 4));
            S[sub] = __builtin_amdgcn_mfma_f32_32x32x16_bf16(a, Q[ks], S[sub], 0, 0, 0);
        }
    }
    const int i16 = lane & 15, qq = i16 >> 2, pp = i16 & 3, g1 = (lane >> 4) & 1;
    LAS3 const unsigned char* vb = Vb + (4 * hf + qq) * AT_VROW + 16 * (2 * g1 + (pp >> 1)) + 8 * (pp & 1);
    LAS3 const unsigned char* vbd[2] = {vb + 64 * (qq >> 1), vb + 64 * (1 ^ (qq >> 1))};
    bf16x8v vf[2][2];
#define AT_LOADV(sub)                                                                                                                            \
    _Pragma("unroll") for (int s2 = 0; s2 < 2; ++s2)                                                                                             \
    _Pragma("unroll") for (int db = 0; db < 2; ++db) {                                                                                           \
        const s16x4v v0 = __builtin_amdgcn_ds_read_tr16_b64_v4i16((LAS3 s16x4v*)(vbd[db] + (32 * (sub) + 16 * s2) * AT_VROW));                   \
        const s16x4v v1 = __builtin_amdgcn_ds_read_tr16_b64_v4i16((LAS3 s16x4v*)(vbd[db] + (32 * (sub) + 16 * s2 + 8) * AT_VROW));               \
        vf[s2][db] = (bf16x8v){v0[0], v0[1], v0[2], v0[3], v1[0], v1[1], v1[2], v1[3]};                                                          \
    }
    if (PASS != 1) { AT_LOADV(0) }
    __builtin_amdgcn_sched_barrier(0);
    float mx = -INFINITY;
    const float bfar = lut[127];
    if (!farstep) {
#pragma unroll
        for (int sub = 0; sub < 2; ++sub)
#pragma unroll
            for (int i = 0; i < 16; ++i) {
                const int kp = k0 + 32 * sub + (i & 3) + 8 * (i >> 2) + 4 * hf;
                const int dist = MODE == 0 ? tq - (16 * kp + 31) : tq - kp;
                bool ok = dist >= 0 && blk_ok;
                if (MODE == 2) ok = ok && dist < 512;
                const int idx = dist < 0 ? 0 : (dist > 127 ? 127 : dist);
                float s = S[sub][i] + lut[idx];
                s = ok ? s : -INFINITY;
                S[sub][i] = s; mx = fmaxf(mx, s);
            }
    } else {
#pragma unroll
        for (int sub = 0; sub < 2; ++sub)
#pragma unroll
            for (int i = 0; i < 16; ++i) mx = fmaxf(mx, S[sub][i]);
        mx += bfar;
        if (MODE == 1) mx = blk_ok ? mx : -INFINITY;
    }
    float m_use, alpha = 1.f, m_new = m_run, sum = 0.f;
    const bf16x8v ones = {0x3F80, 0x3F80, 0x3F80, 0x3F80, 0x3F80, 0x3F80, 0x3F80, 0x3F80};
    if (PASS != 2) {
        { const auto rr = __builtin_amdgcn_permlane32_swap(__float_as_uint(mx), __float_as_uint(mx), false, false); mx = fmaxf(__uint_as_float(rr[0]), __uint_as_float(rr[1])); }
        m_new = fmaxf(m_run, mx);
        const float m_safe = (m_new == -INFINITY) ? 0.f : m_new;
        alpha = __builtin_amdgcn_exp2f(m_run - m_safe);
        m_use = farstep ? m_safe - bfar : m_safe;
        if (MODE == 1 && farstep) m_use = blk_ok ? m_use : INFINITY;
        if (PASS == 0) {
            if (__any(alpha != 1.0f)) {
#pragma unroll
                for (int db = 0; db < 2; ++db)
#pragma unroll
                    for (int i = 0; i < 16; ++i) O[db][i] *= alpha;
                Lacc[0] *= alpha;
            }
        }
    } else m_use = farstep ? m_run - bfar : m_run;
    __builtin_amdgcn_sched_barrier(0);
#pragma unroll
    for (int sub = 0; sub < 2; ++sub) {
        if (PASS != 2) {
#pragma unroll
            for (int i = 0; i < 16; ++i) { const float pv = __builtin_amdgcn_exp2f(S[sub][i] - m_use); S[sub][i] = pv; if (PASS != 0) sum += pv; }
        } else {
#pragma unroll
            for (int i = 0; i < 16; ++i) S[sub][i] = __builtin_amdgcn_exp2f(S[sub][i] - m_use) * inv_l;
            float bp[4], av[4];
#pragma unroll
            for (int a = 0; a < 4; ++a) {
                av[a] = S[sub][4 * a] + S[sub][4 * a + 1] + S[sub][4 * a + 2] + 0.5f * S[sub][4 * a + 3];
                bp[a] = __shfl_xor(0.5f * S[sub][4 * a + 3], 32);
            }
            const int sbase = (k0 >> 2) + 8 * sub + hf;
#pragma unroll
            for (int a = 0; a < 4; ++a) imp_row[sbase + 2 * a] = av[a] + (hf ? bp[a] : (a > 0 ? bp[a > 0 ? a - 1 : 0] : bcarry));
            bcarry = bp[3];
        }
        if (PASS != 1) {
#pragma unroll
            for (int s2 = 0; s2 < 2; ++s2) {
                u32x4 pw;
                pw.x = pk_bf16(S[sub][8 * s2 + 0], S[sub][8 * s2 + 1]); pw.y = pk_bf16(S[sub][8 * s2 + 2], S[sub][8 * s2 + 3]);
                pw.z = pk_bf16(S[sub][8 * s2 + 4], S[sub][8 * s2 + 5]); pw.w = pk_bf16(S[sub][8 * s2 + 6], S[sub][8 * s2 + 7]);
                const bf16x8v pf = __builtin_bit_cast(bf16x8v, pw);
#pragma unroll
                for (int db = 0; db < 2; ++db) O[db] = __builtin_amdgcn_mfma_f32_32x32x16_bf16(vf[s2][db], pf, O[db], 0, 0, 0);
                if (PASS == 0) Lacc = __builtin_amdgcn_mfma_f32_32x32x16_bf16(ones, pf, Lacc, 0, 0, 0);
            }
            __builtin_amdgcn_sched_barrier(0);
            if (sub == 0) { AT_LOADV(1) }
        }
    }
#undef AT_LOADV
    if (PASS != 2) { if (PASS != 0) l_run = l_run * alpha + sum; m_run = m_new; }
}

template <int MODE, bool IMP>
DI void at_step0(LAS3 const unsigned char* Kb, LAS3 const unsigned char* Vb, const bf16x8v (&Q)[4], int k0, int tq, int lane, LAS3 const float* lut, bool blk_ok, bool farstep,
                 f32x16& Cm, int& inited, f32x16 (&O)[2], f32x16& Lacc, float& l_run, LAS3 float* imp_row, float& bcarry) {
    const int r = lane & 31, hf = lane >> 5;
    f32x16 S[2];
#pragma unroll
    for (int sub = 0; sub < 2; ++sub) {
#pragma unroll
        for (int ks = 0; ks < 4; ++ks) {
            const bf16x8v a = *(LAS3 const bf16x8v*)(Kb + (32 * sub + r) * AT_KROW + (((2 * ks + hf) ^ ((r >> 1) & 7)) << 4));
            if (IMP && ks == 0) {
                f32x16 z;
#pragma unroll
                for (int i = 0; i < 16; ++i) z[i] = 0.f;
                S[sub] = __builtin_amdgcn_mfma_f32_32x32x16_bf16(a, Q[ks], z, 0, 0, 0);
            } else S[sub] = __builtin_amdgcn_mfma_f32_32x32x16_bf16(a, Q[ks], ks == 0 ? Cm : S[sub], 0, 0, 0);
        }
    }
    if (IMP) {
        const float cmv = Cm[0];
#pragma unroll
        for (int sub = 0; sub < 2; ++sub)
#pragma unroll
            for (int i = 0; i < 16; ++i) S[sub][i] += cmv;
    }
    const int i16 = lane & 15, qq = i16 >> 2, pp = i16 & 3, g1 = (lane >> 4) & 1;
    LAS3 const unsigned char* vb = Vb + (4 * hf + qq) * AT_VROW + 16 * (2 * g1 + (pp >> 1)) + 8 * (pp & 1);
    LAS3 const unsigned char* vbd[2] = {vb + 64 * (qq >> 1), vb + 64 * (1 ^ (qq >> 1))};
    bf16x8v vf[2][2];
#define AT_LOADV(sub)                                                                                                                            \
    _Pragma("unroll") for (int s2 = 0; s2 < 2; ++s2)                                                                                             \
    _Pragma("unroll") for (int db = 0; db < 2; ++db) {                                                                                           \
        const s16x4v v0 = __builtin_amdgcn_ds_read_tr16_b64_v4i16((LAS3 s16x4v*)(vbd[db] + (32 * (sub) + 16 * s2) * AT_VROW));                   \
        const s16x4v v1 = __builtin_amdgcn_ds_read_tr16_b64_v4i16((LAS3 s16x4v*)(vbd[db] + (32 * (sub) + 16 * s2 + 8) * AT_VROW));               \
        vf[s2][db] = (bf16x8v){v0[0], v0[1], v0[2], v0[3], v1[0], v1[1], v1[2], v1[3]};                                                          \
    }
    AT_LOADV(0)
    __builtin_amdgcn_sched_barrier(0);
    float mx = -INFINITY;
    if (!farstep) {
        const float bfar = lut[127];
        const int dbase = MODE == 0 ? tq - 16 * (k0 + 4 * hf) - 31 : tq - (k0 + 4 * hf);
#pragma unroll
        for (int sub = 0; sub < 2; ++sub) {
            float lv[16];
#pragma unroll
            for (int i = 0; i < 16; ++i) {
                const int koff = 32 * sub + (i & 3) + 8 * (i >> 2);
                const int dist = dbase - (MODE == 0 ? 16 * koff : koff);
                lv[i] = lut[dist < 0 ? 0 : (dist > 127 ? 127 : dist)];
            }
            __builtin_amdgcn_sched_barrier(0);
#pragma unroll
            for (int i = 0; i < 16; ++i) {
                const int koff = 32 * sub + (i & 3) + 8 * (i >> 2);
                const int dist = dbase - (MODE == 0 ? 16 * koff : koff);
                bool ok = dist >= 0 && blk_ok;
                if (MODE == 2) ok = ok && dist < 512;
                float sv = S[sub][i] + (lv[i] - bfar);
                sv = ok ? sv : -INFINITY;
                S[sub][i] = sv; mx = fmaxf(mx, sv);
            }
            __builtin_amdgcn_sched_barrier(0);
        }
    } else {
#pragma unroll
        for (int sub = 0; sub < 2; ++sub)
#pragma unroll
            for (int i = 0; i < 16; ++i) mx = fmaxf(mx, S[sub][i]);
        if (MODE == 1) mx = blk_ok ? mx : -INFINITY;
    }
    { const auto rr = __builtin_amdgcn_permlane32_swap(__float_as_uint(mx), __float_as_uint(mx), false, false); mx = fmaxf(__uint_as_float(rr[0]), __uint_as_float(rr[1])); }
    {
        const bool first = (mx > -INFINITY) && (inited == 0);
        const float delta = (first || mx > 8.0f) ? mx : 0.f;
        if (__any(delta != 0.f)) {
            const float alpha = first ? 1.0f : __builtin_amdgcn_exp2f(-delta);
#pragma unroll
            for (int sub = 0; sub < 2; ++sub)
#pragma unroll
                for (int i = 0; i < 16; ++i) S[sub][i] -= delta;
#pragma unroll
            for (int db = 0; db < 2; ++db)
#pragma unroll
                for (int i = 0; i < 16; ++i) O[db][i] *= alpha;
            if (!IMP) Lacc[0] *= alpha;
#pragma unroll
            for (int i = 0; i < 16; ++i) Cm[i] -= delta;
            if (IMP) {
                l_run *= alpha; bcarry *= alpha;
                for (int j = hf; j < (k0 >> 2); j += 2) imp_row[j] *= alpha;
            }
        }
        inited = first ? 1 : inited;
    }
    const unsigned pmask = (MODE == 1 && farstep && !blk_ok) ? 0u : 0xffffffffu;
    const bf16x8v ones = {0x3F80, 0x3F80, 0x3F80, 0x3F80, 0x3F80, 0x3F80, 0x3F80, 0x3F80};
    __builtin_amdgcn_sched_barrier(0);
#pragma unroll
    for (int sub = 0; sub < 2; ++sub) {
#pragma unroll
        for (int i = 0; i < 16; ++i) S[sub][i] = __builtin_amdgcn_exp2f(S[sub][i]);
        if (IMP) {
            float bp[4], av[4];
#pragma unroll
            for (int i = 0; i < 16; ++i) l_run += S[sub][i];
#pragma unroll
            for (int a = 0; a < 4; ++a) {
                av[a] = S[sub][4 * a] + S[sub][4 * a + 1] + S[sub][4 * a + 2] + 0.5f * S[sub][4 * a + 3];
                bp[a] = __shfl_xor(0.5f * S[sub][4 * a + 3], 32);
            }
            const int sbase = (k0 >> 2) + 8 * sub + hf;
#pragma unroll
            for (int a = 0; a < 4; ++a) imp_row[sbase + 2 * a] = av[a] + (hf ? bp[a] : (a > 0 ? bp[a > 0 ? a - 1 : 0] : bcarry));
            bcarry = bp[3];
        }
#pragma unroll
        for (int s2 = 0; s2 < 2; ++s2) {
            u32x4 pw;
            pw.x = pk_bf16(S[sub][8 * s2 + 0], S[sub][8 * s2 + 1]); pw.y = pk_bf16(S[sub][8 * s2 + 2], S[sub][8 * s2 + 3]);
            pw.z = pk_bf16(S[sub][8 * s2 + 4], S[sub][8 * s2 + 5]); pw.w = pk_bf16(S[sub][8 * s2 + 6], S[sub][8 * s2 + 7]);
            if (MODE == 1) { pw.x &= pmask; pw.y &= pmask; pw.z &= pmask; pw.w &= pmask; }
            const bf16x8v pf = __builtin_bit_cast(bf16x8v, pw);
#pragma unroll
            for (int db = 0; db < 2; ++db) O[db] = __builtin_amdgcn_mfma_f32_32x32x16_bf16(vf[s2][db], pf, O[db], 0, 0, 0);
            if (!IMP) Lacc = __builtin_amdgcn_mfma_f32_32x32x16_bf16(ones, pf, Lacc, 0, 0, 0);
        }
        __builtin_amdgcn_sched_barrier(0);
        if (sub == 0) { AT_LOADV(1) }
    }
#undef AT_LOADV
}

template <int MODE, int PASS, int APROBE>
DI void at_branch(LAS3 unsigned char* lds, const AtSrc& src, int blk_lo, int blk_hi, const bf16x8v (&Q)[4], int tq, int tid, int kvh, LAS3 const float* lut,
                  unsigned mlo, unsigned mhi, float& m_run, float& l_run, f32x16 (&O)[2], f32x16& Lacc, float inv_l, LAS3 float* imp_row) {
    const int lane = tid & 63;
    float bcarry = 0.f;
    f32x16 Cm; int inited = 0;
    if (PASS == 0 || PASS == 3) {
        const float bfar = lut[127];
#pragma unroll
        for (int i = 0; i < 16; ++i) Cm[i] = bfar;
    }
    const AtDma dma = at_dma_setup(src, __builtin_amdgcn_readfirstlane(tid >> 6), lane);
    at_dma(dma, blk_lo, lds);
    for (int blk = blk_lo; blk <= blk_hi; ++blk) {
        LAS3 unsigned char* buf = lds + ((blk - blk_lo) & 1) * AT_BUF;
        asm volatile("s_waitcnt vmcnt(0)" ::: "memory");
        __syncthreads();
        if (blk < blk_hi) at_dma(dma, blk + 1, lds + ((blk + 1 - blk_lo) & 1) * AT_BUF);
        bool blk_ok = true;
        if (MODE == 1) blk_ok = ((blk < 32 ? (mlo >> blk) : (mhi >> (blk - 32))) & 1u) != 0u;
        const int t0u = tq - (lane & 31);
        const bool farstep = MODE == 0 ? (t0u - 16 * (blk * 64 + 63) - 31 >= 128) : (MODE == 1 ? (t0u - blk * 64 - 63 >= 128) : (t0u - blk * 64 - 63 >= 128 && t0u + 31 - blk * 64 < 512));
        if (MODE != 1 || __any(blk_ok)) {
            if (PASS == 0 || PASS == 3) at_step0<MODE, PASS == 3>(buf + kvh * AT_KT, buf + 2 * AT_KT + kvh * AT_VT, Q, blk * 64, tq, lane, lut, blk_ok, farstep, Cm, inited, O, Lacc, l_run, imp_row, bcarry);
            else at_step<MODE, PASS, APROBE>(buf + kvh * AT_KT, buf + 2 * AT_KT + kvh * AT_VT, Q, blk * 64, tq, lane, lut, blk_ok, farstep, m_run, l_run, O, Lacc, inv_l, imp_row, bcarry);
        }
    }
    __syncthreads();
}

template <int APROBE> DI void p3_attention(const Params& p, LAS3 unsigned char* lds, int G) {
    unsigned char* ws = p.ws;
    const int tid = threadIdx.x, lane = tid & 63, h = __builtin_amdgcn_readfirstlane(tid >> 6), kvh = h >> 2, r = lane & 31, hf = lane >> 5;
    LAS3 float* lutall = (LAS3 float*)(lds + AT_LUT);
    {
        const float* rel = p.in[I_REL];
        for (int i = tid; i < 1024; i += MK_THREADS) lutall[i] = rel[rel_bucket(i & 127) * NH + (i >> 7)] * LOG2E;
    }
    __syncthreads();
    LAS3 const float* lut = lutall + h * 128;
    LAS3 float* impw = (LAS3 float*)(lds + AT_IMP);
    LAS3 float* vals = (LAS3 float*)(lds + AT_VAL);
    LAS3 unsigned char* selb = lds + AT_SEL;
    LAS3 float* ssq = (LAS3 float*)(lds + AT_SSQ);
    const bf16_t* qb = (const bf16_t*)(ws + R_QB);
    const float* gates = (const float*)(ws + R_GATE);
    const float* gn = p.in[I_GN_ATTN];
    bf16_t* mixed = APROBE ? (bf16_t*)(ws + R_BIG + 32 * MB) : (bf16_t*)(ws + WS_MIXED);
    const int tid_outer = tid;
    for (int ui = blockIdx.x; ui < 512; ui += G) {
        int tidv = tid_outer; asm volatile("" : "+v"(tidv));
        const int tid = tidv, lane = tid & 63, r = lane & 31, hf = lane >> 5;
        const int q8 = ui & 255, rnd = ui >> 8, b = q8 >> 6, j6 = q8 & 63, tb = rnd == 0 ? 127 - j6 : j6;
        const int t0 = 32 * tb, qb64 = tb >> 1, tq = t0 + r;
        const size_t tok = (size_t)b * T_ + tq;
        bf16x8v Q[4];
#pragma unroll
        for (int ks = 0; ks < 4; ++ks) Q[ks] = *(const bf16x8v*)(qb + tok * 512 + h * 64 + 16 * ks + 8 * hf);
        f32x16 O[2], Lacc;
#pragma unroll
        for (int db = 0; db < 2; ++db)
#pragma unroll
            for (int i = 0; i < 16; ++i) O[db][i] = 0.f;
#pragma unroll
        for (int i = 0; i < 16; ++i) Lacc[i] = 0.f;
        LAS3 float* oslot = (LAS3 float*)(lds + AT_IMP) + h * 2048 + lane;
        const size_t bh0 = (size_t)b * 2, bh1 = bh0 + 1;
        float inv_lo;
        {
            const bf16_t* kcb = (const bf16_t*)(ws + R_KCB); const bf16_t* vcb = (const bf16_t*)(ws + R_VCT);
            const AtSrc src{kcb + bh0 * 256 * 64, vcb + bh0 * 256 * 64, 256 * 64};
            const int nst = tb / 32 + 1;
            float m_run = -INFINITY, l_run = 0.f;
            at_branch<0, 3, APROBE>(lds, src, 0, nst - 1, Q, tq, tid, kvh, lut, 0u, 0u, m_run, l_run, O, Lacc, 0.f, impw + (h * 32 + r) * 65);
            const float l_tot = l_run + __shfl_xor(l_run, 32);
            inv_lo = l_tot > 0.f ? __builtin_amdgcn_rcpf(l_tot) : 0.f;
            if (hf == 0) ssq[h * 32 + r] = inv_lo;
            __syncthreads();
        }
        {
            const int row = tid >> 3, j8 = tid & 7, kr = row >> 5, tr = row & 31;
#pragma unroll
            for (int jj = 0; jj < 8; ++jj) {
                const int s = j8 * 8 + jj, db = qb64 - s;
                float v = 0.f;
#pragma unroll
                for (int g = 0; g < 4; ++g) v += impw[((kr * 4 + g) * 32 + tr) * 65 + s] * ssq[(kr * 4 + g) * 32 + tr];
                vals[row * 65 + s] = (db >= 0 && db < 2) ? 2.0e4f : (s == 0 ? 1.0e4f : (db >= 0 ? v : -1.0f));
            }
            __syncthreads();
            unsigned bits = 0u;
            {
                float vv[8]; int rk[8];
#pragma unroll
                for (int jj = 0; jj < 8; ++jj) { vv[jj] = vals[row * 65 + j8 * 8 + jj]; rk[jj] = 0; }
#pragma unroll 2
                for (int s2 = 0; s2 < 64; ++s2) {
                    const float w = vals[row * 65 + s2];
#pragma unroll
                    for (int jj = 0; jj < 8; ++jj) rk[jj] += (w > vv[jj] || (w == vv[jj] && s2 < j8 * 8 + jj)) ? 1 : 0;
                }
#pragma unroll
                for (int jj = 0; jj < 8; ++jj) if (rk[jj] < 16 && qb64 - (j8 * 8 + jj) >= 0) bits |= 1u << jj;
            }
            selb[row * 8 + j8] = (unsigned char)bits;
            __syncthreads();
        }
        const unsigned mlo = *(LAS3 const unsigned*)(selb + (kvh * 32 + r) * 8), mhi = *(LAS3 const unsigned*)(selb + (kvh * 32 + r) * 8 + 4);
        __syncthreads();
        {
            const float g0 = sigmoidf_(gates[tok * 24 + h * 3 + 0]) * inv_lo;
#pragma unroll
            for (int db = 0; db < 2; ++db)
#pragma unroll
                for (int i = 0; i < 16; ++i) { oslot[(db * 16 + i) * 64] = g0 * O[db][i]; O[db][i] = 0.f; }
        }
        {
            const bf16_t* ksb = (const bf16_t*)(ws + R_KS); const bf16_t* vsb = (const bf16_t*)(ws + R_VS);
            const AtSrc src{ksb + bh0 * T_ * HD, vsb + bh0 * T_ * HD, T_ * HD};
            float m_run = -INFINITY, l_run = 0.f;
#pragma unroll
            for (int i = 0; i < 16; ++i) Lacc[i] = 0.f;
            at_branch<1, 0, APROBE>(lds, src, 0, qb64, Q, tq, tid, kvh, lut, mlo, mhi, m_run, l_run, O, Lacc, 0.f, nullptr);
            const float sc = sigmoidf_(gates[tok * 24 + h * 3 + 1]) * __builtin_amdgcn_rcpf(Lacc[0]);
#pragma unroll
            for (int db = 0; db < 2; ++db)
#pragma unroll
                for (int i = 0; i < 16; ++i) { oslot[(db * 16 + i) * 64] += sc * O[db][i]; O[db][i] = 0.f; }
        }
        {
            const bf16_t* kwb = (const bf16_t*)(ws + R_KW); const bf16_t* vwb = (const bf16_t*)(ws + R_VW);
            const AtSrc src{kwb + bh0 * T_ * HD, vwb + bh0 * T_ * HD, T_ * HD};
            int wb0 = (t0 - 511) >> 6; wb0 = wb0 < 0 ? 0 : wb0;
            float m_run = -INFINITY, l_run = 0.f;
#pragma unroll
            for (int i = 0; i < 16; ++i) Lacc[i] = 0.f;
            at_branch<2, 0, APROBE>(lds, src, wb0, qb64, Q, tq, tid, kvh, lut, 0u, 0u, m_run, l_run, O, Lacc, 0.f, nullptr);
            const float sc = sigmoidf_(gates[tok * 24 + h * 3 + 2]) * __builtin_amdgcn_rcpf(Lacc[0]);
#pragma unroll
            for (int db = 0; db < 2; ++db)
#pragma unroll
                for (int i = 0; i < 16; ++i) O[db][i] = oslot[(db * 16 + i) * 64] + sc * O[db][i];
        }
        {
            float ss = 0.f;
#pragma unroll
            for (int db = 0; db < 2; ++db)
#pragma unroll
                for (int i = 0; i < 16; ++i) ss += O[db][i] * O[db][i];
            ss += __shfl_xor(ss, 32);
            if (hf == 0) ssq[h * 32 + r] = ss;
            __syncthreads();
            float tot = 0.f;
#pragma unroll
            for (int hh = 0; hh < 8; ++hh) tot += ssq[hh * 32 + r];
            const float rs = rsqrtf(tot * (1.0f / 512) + EPS);
#pragma unroll
            for (int db = 0; db < 2; ++db)
#pragma unroll
                for (int a = 0; a < 4; ++a) {
                    const int d = 32 * db + 8 * a + 4 * hf;
                    const f32x4 g4 = *(const f32x4*)(gn + h * 64 + d);
                    u32x2 w; w.x = pk_bf16(O[db][4 * a] * rs * g4[0], O[db][4 * a + 1] * rs * g4[1]); w.y = pk_bf16(O[db][4 * a + 2] * rs * g4[2], O[db][4 * a + 3] * rs * g4[3]);
                    *(u32x2*)(mixed + tok * DM + h * 64 + d) = w;
                }
            __syncthreads();
        }
    }
}
constexpr int LR_STRIDE = 516;
constexpr int LR_XC = 0, LR_A = 32 * LR_STRIDE * 4, LR_RS = 2 * 32 * LR_STRIDE * 4, LR_END = LR_RS + 256;
static_assert(LR_END <= 160 * 1024 - 256, "LRU LDS map");

template <bool FINAL>
DI void lru_phase(const Params& p, LAS3 unsigned char* lds, int G) {
    unsigned char* ws = p.ws;
    const int tid = threadIdx.x, lane = tid & 63, n = __builtin_amdgcn_readfirstlane(tid >> 6), r = lane & 31, hf = lane >> 5, ch = tid;
    LAS3 float* XC = (LAS3 float*)(lds + LR_XC); LAS3 float* AA = (LAS3 float*)(lds + LR_A); LAS3 float* RS = (LAS3 float*)(lds + LR_RS);
    const bf16_t* xr = (const bf16_t*)(ws + R_XR); const bf16_t* xg = (const bf16_t*)(ws + R_XG);
    float* sumP = (float*)(ws + WS_LRUP); float* sumH = (float*)(ws + WS_LRUH);
    bf16_t* mixed = (bf16_t*)(ws + WS_MIXED);
    bf16_t* lga = (bf16_t*)(ws + WS_LGA); bf16_t* lgb = (bf16_t*)(ws + WS_LGB);
    const float cw0 = p.in[I_CONV_W][0 * 512 + ch], cw1 = p.in[I_CONV_W][1 * 512 + ch], cw2 = p.in[I_CONV_W][2 * 512 + ch], cw3 = p.in[I_CONV_W][3 * 512 + ch], cb = p.in[I_CONV_B][ch];
    const float gl = FINAL ? p.in[I_GN_LRU][ch] : 0.f;
    float ba[2], bx[2], sp[2];
#pragma unroll
    for (int nb = 0; nb < 2; ++nb) { const int c2 = n * 64 + 32 * nb + r; ba[nb] = p.in[I_LRU_BA][c2]; bx[nb] = p.in[I_LRU_BX][c2]; sp[nb] = log1pf(__expf(-p.in[I_LRU_LAM][c2])); }
    const bf16_t* waT = (const bf16_t*)(ws + WS_WAT); const bf16_t* wxT = (const bf16_t*)(ws + WS_WXT);
    bf16x8v Ba[2][4], Bx[2][4];
#define LR_LOADB                                                                                         \
    _Pragma("unroll") for (int nb = 0; nb < 2; ++nb)                                                     \
    _Pragma("unroll") for (int ks = 0; ks < 4; ++ks) {                                                   \
        const size_t o = (size_t)(n * 64 + 32 * nb + r) * 64 + 16 * ks + 8 * hf;                         \
        Ba[nb][ks] = *(const bf16x8v*)(waT + o); Bx[nb][ks] = *(const bf16x8v*)(wxT + o);                \
    }
    if (!FINAL) { LR_LOADB }
    for (int ci = blockIdx.x; ci < 256; ci += G) {
        const int b = ci >> 6, cib = ci & 63, t0 = cib * 64;
        const size_t tok0 = (size_t)b * T_ + t0;
        float x1 = 0.f, x2 = 0.f, x3 = 0.f;
        if (t0 > 0) { x1 = bf2f(xr[(tok0 - 1) * 512 + ch]); x2 = bf2f(xr[(tok0 - 2) * 512 + ch]); x3 = bf2f(xr[(tok0 - 3) * 512 + ch]); }
        float hst = 0.f, pprod = 1.f;
        if (FINAL) {
            const float* Pp = sumP + (size_t)(b * 64) * 512 + ch; const float* Hp = sumH + (size_t)(b * 64) * 512 + ch;
            for (int k0 = 0; k0 < cib; k0 += 16) {
                float pv[16], hv[16];
#pragma unroll
                for (int j = 0; j < 16; ++j) { const int k = k0 + j < cib ? k0 + j : cib - 1; pv[j] = Pp[(size_t)k * 512]; hv[j] = Hp[(size_t)k * 512]; }
#pragma unroll
                for (int j = 0; j < 16; ++j) if (k0 + j < cib) hst = pv[j] * hst + hv[j];
            }
        }
#pragma unroll 1
        for (int half = 0; half < 2; ++half) {
            const size_t tokh = tok0 + half * 32;
            bf16_t gv[32];
            if (FINAL) {
#pragma unroll
                for (int t = 0; t < 32; ++t) gv[t] = xg[(tokh + t) * 512 + ch];
            }
            __syncthreads();
            {
                bf16_t xw[32]; float xv[32];
#pragma unroll
                for (int t = 0; t < 32; ++t) xw[t] = xr[(tokh + t) * 512 + ch];
#pragma unroll
                for (int t = 0; t < 32; ++t) xv[t] = bf2f(xw[t]);
#pragma unroll
                for (int t = 0; t < 32; ++t) {
                    const float x0 = xv[t];
                    XC[t * LR_STRIDE + ch] = cw0 * x3 + cw1 * x2 + cw2 * x1 + cw3 * x0 + cb;
                    x3 = x2; x2 = x1; x1 = x0;
                }
            }
            __syncthreads();
            {
                f32x16 ar[2], ai[2];
#pragma unroll
                for (int nb = 0; nb < 2; ++nb)
#pragma unroll
                    for (int i = 0; i < 16; ++i) { ar[nb][i] = 0.f; ai[nb][i] = 0.f; }
                if (FINAL) { LR_LOADB }
#pragma unroll
                for (int ks = 0; ks < 4; ++ks) {
                    LAS3 const float* src = XC + r * LR_STRIDE + n * 64 + 16 * ks + 8 * hf;
                    const f32x4 f0 = *(LAS3 const f32x4*)src, f1 = *(LAS3 const f32x4*)(src + 4);
                    u32x4 pw; pw.x = pk_bf16(f0[0], f0[1]); pw.y = pk_bf16(f0[2], f0[3]); pw.z = pk_bf16(f1[0], f1[1]); pw.w = pk_bf16(f1[2], f1[3]);
                    const bf16x8v af = __builtin_bit_cast(bf16x8v, pw);
#pragma unroll
                    for (int nb = 0; nb < 2; ++nb) {
                        ar[nb] = __builtin_amdgcn_mfma_f32_32x32x16_bf16(af, Ba[nb][ks], ar[nb], 0, 0, 0);
                        ai[nb] = __builtin_amdgcn_mfma_f32_32x32x16_bf16(af, Bx[nb][ks], ai[nb], 0, 0, 0);
                    }
                }
                __syncthreads();
#pragma unroll
                for (int nb = 0; nb < 2; ++nb)
#pragma unroll
                    for (int i = 0; i < 16; ++i) {
                        const int t = (i & 3) + 8 * (i >> 2) + 4 * hf, o = t * LR_STRIDE + n * 64 + 32 * nb + r;
                        const float xcv = XC[o];
                        const float rg = sigmoidf_(ar[nb][i] + ba[nb]), ig = sigmoidf_(ai[nb][i] + bx[nb]);
                        float log_a = -8.0f * rg * sp[nb];
                        bf16_t la_b = 0;
                        if (!FINAL) { la_b = f2bf(log_a); log_a = bf2f(la_b); }
                        const float av = __expf(log_a);
                        float omA = -2.0f * log_a * (1.0f + log_a * (1.0f + 0.66666667f * log_a)), omB = 1.0f - av * av;
                        asm volatile("" : "+v"(omA), "+v"(omB));
                        const float om = log_a > -0.0009765625f ? omA : omB;
                        AA[o] = FINAL ? av : log_a;
                        float bval = __builtin_amdgcn_sqrtf(om) * (ig * xcv);
                        if (!FINAL) bval = bf2f(f2bf(bval));
                        XC[o] = bval;
                    }
            }
            __syncthreads();
            if (!FINAL) {
#pragma unroll 8
                for (int t = 0; t < 32; ++t) { const float a = __expf(AA[t * LR_STRIDE + ch]); hst = a * hst + XC[t * LR_STRIDE + ch]; pprod *= a; }
                {
                    const int l8 = (tid & 63) * 8;
#pragma unroll
                    for (int q = 0; q < 4; ++q) {
                        const int t = n + 8 * q;
                        LAS3 const float* ap = AA + t * LR_STRIDE + l8; LAS3 const float* bp = XC + t * LR_STRIDE + l8;
                        const f32x4 a0 = *(LAS3 const f32x4*)ap, a1 = *(LAS3 const f32x4*)(ap + 4), b0 = *(LAS3 const f32x4*)bp, b1 = *(LAS3 const f32x4*)(bp + 4);
                        u32x4 wa, wb;
                        wa.x = pack2bf(a0[0], a0[1]); wa.y = pack2bf(a0[2], a0[3]); wa.z = pack2bf(a1[0], a1[1]); wa.w = pack2bf(a1[2], a1[3]);
                        wb.x = pack2bf(b0[0], b0[1]); wb.y = pack2bf(b0[2], b0[3]); wb.z = pack2bf(b1[0], b1[1]); wb.w = pack2bf(b1[2], b1[3]);
                        *(u32x4*)(lga + (tokh + t) * 512 + l8) = wa; *(u32x4*)(lgb + (tokh + t) * 512 + l8) = wb;
                    }
                }
            } else {
                {
                    float av[32], bv[32];
#pragma unroll
                    for (int t = 0; t < 32; ++t) { av[t] = AA[t * LR_STRIDE + ch]; bv[t] = XC[t * LR_STRIDE + ch]; }
#pragma unroll
                    for (int t = 0; t < 32; ++t) { hst = av[t] * hst + bv[t]; XC[t * LR_STRIDE + ch] = hst * gelu_tanh(bf2f(gv[t])); }
                }
                __syncthreads();
                {
                    const int t = tid >> 4, part = tid & 15;
                    float s = 0.f;
#pragma unroll 8
                    for (int j = 0; j < 32; ++j) { const float v = XC[t * LR_STRIDE + part + 16 * j]; s += v * v; }
                    s += __shfl_xor(s, 1); s += __shfl_xor(s, 2); s += __shfl_xor(s, 4); s += __shfl_xor(s, 8);
                    if (part == 0) RS[t] = rsqrtf(s * (1.0f / 512) + EPS);
                }
                __syncthreads();
                {
                    const int t = tid >> 4, part = tid & 15; const float rs = RS[t];
                    const float* gp = p.in[I_GN_LRU] + part * 32; LAS3 const float* xp = XC + t * LR_STRIDE + part * 32;
                    bf16_t* dst = mixed + (tokh + t) * DM + 512 + part * 32;
#pragma unroll
                    for (int q = 0; q < 4; ++q) {
                        const f32x4 a = *(LAS3 const f32x4*)(xp + 8 * q), b = *(LAS3 const f32x4*)(xp + 8 * q + 4), ga = *(const f32x4*)(gp + 8 * q), gb = *(const f32x4*)(gp + 8 * q + 4);
                        u32x4 w; w.x = pack2bf(a[0] * rs * ga[0], a[1] * rs * ga[1]); w.y = pack2bf(a[2] * rs * ga[2], a[3] * rs * ga[3]);
                        w.z = pack2bf(b[0] * rs * gb[0], b[1] * rs * gb[1]); w.w = pack2bf(b[2] * rs * gb[2], b[3] * rs * gb[3]);
                        *(u32x4*)(dst + 8 * q) = w;
                    }
                }
            }
        }
        if (!FINAL) { sumP[(size_t)ci * 512 + ch] = pprod; sumH[(size_t)ci * 512 + ch] = hst; }
    }
    __syncthreads();
}
#undef LR_LOADB

constexpr int LF_X = 0, LF_RS = 64 * LR_STRIDE * 4, LF_END = LF_RS + 256;
static_assert(LF_END <= 160 * 1024 - 256, "LRU final LDS map");
DI void lru_final(const Params& p, LAS3 unsigned char* lds, int G) {
    unsigned char* ws = p.ws;
    const int tid = threadIdx.x, ch = tid;
    LAS3 float* XC = (LAS3 float*)(lds + LF_X); LAS3 float* RS = (LAS3 float*)(lds + LF_RS);
    const bf16_t* xg = (const bf16_t*)(ws + R_XG); const bf16_t* lga = (const bf16_t*)(ws + WS_LGA); const bf16_t* lgb = (const bf16_t*)(ws + WS_LGB);
    const float* sumP = (const float*)(ws + WS_LRUP); const float* sumH = (const float*)(ws + WS_LRUH);
    bf16_t* mixed = (bf16_t*)(ws + WS_MIXED);
    for (int ci = blockIdx.x; ci < 256; ci += G) {
        const int b = ci >> 6, cib = ci & 63, t0 = cib * 64;
        const size_t tok0 = (size_t)b * T_ + t0;
        bf16_t la[2][16], lb[2][16], gx[2][16];
#define LF_LOAD(SET, GRP) _Pragma("unroll") for (int t = 0; t < 16; ++t) { const size_t o = (tok0 + 16 * (GRP) + t) * 512 + ch; la[SET][t] = lga[o]; lb[SET][t] = lgb[o]; gx[SET][t] = xg[o]; }
#define LF_SCAN(SET, GRP) _Pragma("unroll") for (int t = 0; t < 16; ++t) { hst = __expf(bf2f(la[SET][t])) * hst + bf2f(lb[SET][t]); XC[(16 * (GRP) + t) * LR_STRIDE + ch] = hst * gelu_tanh(bf2f(gx[SET][t])); }
        LF_LOAD(0, 0)
        float hst = 0.f;
        {
            const float* Pp = sumP + (size_t)(b * 64) * 512 + ch; const float* Hp = sumH + (size_t)(b * 64) * 512 + ch;
            for (int k0 = 0; k0 < cib; k0 += 16) {
                float pv[16], hv[16];
#pragma unroll
                for (int j = 0; j < 16; ++j) { const int k = k0 + j < cib ? k0 + j : cib - 1; pv[j] = Pp[(size_t)k * 512]; hv[j] = Hp[(size_t)k * 512]; }
#pragma unroll
                for (int j = 0; j < 16; ++j) if (k0 + j < cib) hst = pv[j] * hst + hv[j];
            }
        }
        __syncthreads();
        LF_LOAD(1, 1) LF_SCAN(0, 0)
        LF_LOAD(0, 2) LF_SCAN(1, 1)
        LF_LOAD(1, 3) LF_SCAN(0, 2)
        LF_SCAN(1, 3)
#undef LF_LOAD
#undef LF_SCAN
        __syncthreads();
        {
            const int wv = tid >> 6, l8 = (tid & 63) * 8;
            const f32x4 ga = *(const f32x4*)(p.in[I_GN_LRU] + l8), gb = *(const f32x4*)(p.in[I_GN_LRU] + l8 + 4);
#pragma unroll
            for (int q = 0; q < 8; ++q) {
                const int t = wv + 8 * q;
                LAS3 const float* xp = XC + t * LR_STRIDE + l8;
                const f32x4 a = *(LAS3 const f32x4*)xp, b4 = *(LAS3 const f32x4*)(xp + 4);
                float sq = (a[0] * a[0] + a[1] * a[1]) + (a[2] * a[2] + a[3] * a[3]) + (b4[0] * b4[0] + b4[1] * b4[1]) + (b4[2] * b4[2] + b4[3] * b4[3]);
                sq = wave_sum(sq);
                const float rs = rsqrtf(sq * (1.0f / 512) + EPS);
                u32x4 w; w.x = pack2bf(a[0] * rs * ga[0], a[1] * rs * ga[1]); w.y = pack2bf(a[2] * rs * ga[2], a[3] * rs * ga[3]);
                w.z = pack2bf(b4[0] * rs * gb[0], b4[1] * rs * gb[1]); w.w = pack2bf(b4[2] * rs * gb[2], b4[3] * rs * gb[3]);
                *(u32x4*)(mixed + (tok0 + t) * DM + 512 + l8) = w;
            }
        }
    }
    __syncthreads();
}
typedef float f32x4v __attribute__((ext_vector_type(4)));
constexpr int CM_IMG = 0;
constexpr int CM_HID = 36864;
constexpr int CM_END = CM_HID + 16 * 264 * 2;
DI void p2_compress(const Params& p, LAS3 unsigned char* lds, int G) {
    unsigned char* ws = p.ws;
    const int tid = threadIdx.x, lane = tid & 63, wid = __builtin_amdgcn_readfirstlane(tid >> 6), row = lane & 15, kg = lane >> 4;
    for (int u = blockIdx.x; u < 256; u += G) {
        const int kv = u >> 7, bh = (u >> 4) & 7, c0 = (u & 15) * 16;
        const bf16_t* src = (const bf16_t*)(ws + (kv ? R_VC : R_KC)) + ((size_t)bh * T_ + 16 * c0) * HD;
        const bf16_t* W1T = (const bf16_t*)(ws + (kv ? WS_CW1V : WS_CW1K));
        const float* cb = (const float*)(ws + (kv ? WS_CBV : WS_CBK));
        const bf16_t* W2T = (const bf16_t*)(ws + (kv ? WS_CW2V : WS_CW2K));
        __syncthreads();
        {
            u32x4 cv[5];
#pragma unroll
            for (int k = 0; k < 5; ++k) { const int i = tid + k * MK_THREADS; if (i < 272 * 8) cv[k] = *(const u32x4*)(src + (size_t)(i >> 3) * HD + (i & 7) * 8); }
#pragma unroll
            for (int k = 0; k < 5; ++k) { const int i = tid + k * MK_THREADS; if (i < 272 * 8) { const int tau = i >> 3, cch = i & 7; *(LAS3 u32x4*)(lds + CM_IMG + tau * 128 + (tau >> 4) * 16 + cch * 16) = cv[k]; } }
        }
        __syncthreads();
        f32x4v acc[2] = {{0.f, 0.f, 0.f, 0.f}, {0.f, 0.f, 0.f, 0.f}};
        const bf16_t* wb0 = W1T + ((size_t)(wid * 2) * 64 * 64 + lane) * 8, * wb1 = wb0 + (size_t)64 * 64 * 8;
#pragma unroll 16
        for (int ks = 0; ks < 64; ++ks) {
            const int tau = 16 * row + (ks >> 1);
            const bf16x8v a = *(LAS3 const bf16x8v*)(lds + CM_IMG + tau * 128 + (tau >> 4) * 16 + (32 * (ks & 1) + 8 * kg) * 2);
            const bf16x8v b0 = *(const bf16x8v*)(wb0 + 512 * ks), b1 = *(const bf16x8v*)(wb1 + 512 * ks);
            acc[0] = __builtin_amdgcn_mfma_f32_16x16x32_bf16(a, b0, acc[0], 0, 0, 0);
            acc[1] = __builtin_amdgcn_mfma_f32_16x16x32_bf16(a, b1, acc[1], 0, 0, 0);
        }
#pragma unroll
        for (int nb = 0; nb < 2; ++nb) {
            const int col = wid * 32 + 16 * nb + row; const float bias = cb[col];
#pragma unroll
            for (int i = 0; i < 4; ++i) *(LAS3 bf16_t*)(lds + CM_HID + ((4 * kg + i) * 264 + col) * 2) = f2bf(gelu_tanh(acc[nb][i] + bias));
        }
        __syncthreads();
        if (wid < 4) {
            f32x4v o = {0.f, 0.f, 0.f, 0.f};
#pragma unroll
            for (int ks = 0; ks < 8; ++ks) {
                const bf16x8v a = *(LAS3 const bf16x8v*)(lds + CM_HID + (row * 264 + 32 * ks + 8 * kg) * 2);
                const bf16x8v b = *(const bf16x8v*)(W2T + (size_t)(wid * 16 + row) * 256 + 32 * ks + 8 * kg);
                o = __builtin_amdgcn_mfma_f32_16x16x32_bf16(a, b, o, 0, 0, 0);
            }
            const int d = wid * 16 + row;
#pragma unroll
            for (int i = 0; i < 4; ++i) {
                const int c = c0 + 4 * kg + i; const float v = c < NCMP ? o[i] : 0.f;
                ((float*)(ws + (kv ? WS_VCMP : WS_KCMP)))[((size_t)bh * 256 + c) * 64 + d] = v;
                if (kv) ((bf16_t*)(ws + R_VCT))[((size_t)bh * 256 + c) * 64 + d] = f2bf(v);
                else    ((bf16_t*)(ws + R_KCB))[((size_t)bh * 256 + c) * 64 + d] = f2bf(v);
            }
        }
    }
    __syncthreads();
}
DI void p2_vtranspose(const Params& p, LAS3 unsigned char* lds, int G) {
    unsigned char* ws = p.ws;
    const int tid = threadIdx.x;
    LAS3 bf16_t* tl = (LAS3 bf16_t*)lds;
    for (int u0 = blockIdx.x; u0 < 1024; u0 += 4 * G) {
        u32x4 v[4];
#pragma unroll
        for (int k = 0; k < 4; ++k) { const int u = u0 + k * G; if (u < 1024) {
            const int which = u >> 9, bh = (u >> 6) & 7, tt = u & 63;
            const bf16_t* src = (const bf16_t*)(ws + (which ? R_VW : R_VS)) + ((size_t)bh * T_ + tt * 64) * HD;
            v[k] = *(const u32x4*)(src + (size_t)(tid >> 3) * HD + (tid & 7) * 8); } }
        __syncthreads();
#pragma unroll
        for (int k = 0; k < 4; ++k) if (u0 + k * G < 1024) *(LAS3 u32x4*)(tl + k * 64 * 72 + (tid >> 3) * 72 + (tid & 7) * 8) = v[k];
        __syncthreads();
#pragma unroll
        for (int k = 0; k < 4; ++k) { const int u = u0 + k * G; if (u < 1024) {
            const int which = u >> 9, bh = (u >> 6) & 7, tt = u & 63;
            bf16_t* dst = (bf16_t*)(ws + (which ? R_VWT : R_VST)) + (size_t)bh * HD * T_ + tt * 64;
            LAS3 const bf16_t* t2 = tl + k * 64 * 72;
            const int d = tid >> 3, seg = tid & 7; u32x4 w;
            w.x = (unsigned)t2[(seg * 8 + 0) * 72 + d] | ((unsigned)t2[(seg * 8 + 1) * 72 + d] << 16); w.y = (unsigned)t2[(seg * 8 + 2) * 72 + d] | ((unsigned)t2[(seg * 8 + 3) * 72 + d] << 16);
            w.z = (unsigned)t2[(seg * 8 + 4) * 72 + d] | ((unsigned)t2[(seg * 8 + 5) * 72 + d] << 16); w.w = (unsigned)t2[(seg * 8 + 6) * 72 + d] | ((unsigned)t2[(seg * 8 + 7) * 72 + d] << 16);
            *(u32x4*)(dst + (size_t)d * T_ + seg * 8) = w; } }
    }
    __syncthreads();
}
DI int ord_enc(float f) { const int u = __float_as_int(f); return u ^ ((u >> 31) & 0x7fffffff); }
DI float ord_dec(int o) { return __int_as_float(o ^ ((o >> 31) & 0x7fffffff)); }
#define PEER_CE_DESC(a, b) do { const int _hi = max((a), (b)), _lo = min((a), (b)); (a) = _hi; (b) = _lo; } while (0)
#define PEER_CE_ASC(a, b)  do { const int _hi = max((a), (b)), _lo = min((a), (b)); (a) = _lo; (b) = _hi; } while (0)
DI void sort16_desc(int (&x)[16]) {
    constexpr int NET[63][2] = {{0, 1}, {2, 3}, {0, 2}, {1, 3}, {1, 2}, {4, 5}, {6, 7}, {4, 6}, {5, 7}, {5, 6}, {0, 4}, {2, 6}, {2, 4}, {1, 5}, {3, 7}, {3, 5}, {1, 2}, {3, 4}, {5, 6}, {8, 9}, {10, 11},
        {8, 10}, {9, 11}, {9, 10}, {12, 13}, {14, 15}, {12, 14}, {13, 15}, {13, 14}, {8, 12}, {10, 14}, {10, 12}, {9, 13}, {11, 15}, {11, 13}, {9, 10}, {11, 12}, {13, 14}, {0, 8}, {4, 12}, {4, 8},
        {2, 10}, {6, 14}, {6, 10}, {2, 4}, {6, 8}, {10, 12}, {1, 9}, {5, 13}, {5, 9}, {3, 11}, {7, 15}, {7, 11}, {3, 5}, {7, 9}, {11, 13}, {1, 2}, {3, 4}, {5, 6}, {7, 8}, {9, 10}, {11, 12}, {13, 14}};
#pragma unroll
    for (int c = 0; c < 63; ++c) PEER_CE_DESC(x[NET[c][0]], x[NET[c][1]]);
}
DI void merge16_desc(int (&a)[16], const int (&b)[16]) {
#pragma unroll
    for (int i = 0; i < 16; ++i) a[i] = max(a[i], b[15 - i]);
#pragma unroll
    for (int j = 8; j > 0; j >>= 1)
#pragma unroll
        for (int i = 0; i < 16; ++i) { const int l = i ^ j; if (l > i) PEER_CE_DESC(a[i], a[l]); }
}
constexpr int PR_KEYS = 0;
constexpr int PR_LST = 512 * 68 * 4;
constexpr int PR_RS = PR_LST + 128 * 36 * 4;
constexpr int PR_END = PR_RS + 1024;
static_assert(PR_END <= 160 * 1024 - 256, "PEER LDS map");

struct EpiPeerRoute {
    static constexpr bool PERM = true, AFTER_DRAIN = true;
    const float* ssq1; int* eout; float* gout; float* rs1out;
    DI void fused(const f32x4 (&acc)[2][2][4][2], const pg8::Unit& u, int wr, int wc, int fr, int fq, PG8_LAS unsigned char* lds, int wid, int lane) const {
        const int tid = wid * 64 + lane, head = u.pn;
        LAS3 int* KEYS = (LAS3 int*)(lds + PR_KEYS); LAS3 int* LST = (LAS3 int*)(lds + PR_LST); LAS3 float* RS = (LAS3 float*)(lds + PR_RS);
        if (tid < 256) { float s = 0.f; for (int j = 0; j < 16; ++j) s += ssq1[(size_t)j * NTOK + u.pm * 256 + tid]; RS[tid] = rsqrtf(s * (1.0f / DM) + EPS); if (u.pn == 0) rs1out[u.pm * 256 + tid] = RS[tid]; }
#pragma unroll 1
        for (int ai = 0; ai < 2; ++ai) {
            __syncthreads();
#pragma unroll
            for (int bj = 0; bj < 2; ++bj)
#pragma unroll
                for (int m = 0; m < 4; ++m)
#pragma unroll
                    for (int n = 0; n < 2; ++n) {
                        const int rl = 64 * wr + 16 * m + fr, kk0 = 32 * wc + 8 * fq + 4 * n, hl = ((rl * 2 + bj) * 2 + (kk0 >> 6));
                        const f32x4 v = ai == 0 ? acc[0][bj][m][n] : acc[1][bj][m][n];
                        u32x4 kq;
                        kq.x = (unsigned)((ord_enc(v[0]) & ~0x7f) | (127 - (kk0 + 0))); kq.y = (unsigned)((ord_enc(v[1]) & ~0x7f) | (127 - (kk0 + 1)));
                        kq.z = (unsigned)((ord_enc(v[2]) & ~0x7f) | (127 - (kk0 + 2))); kq.w = (unsigned)((ord_enc(v[3]) & ~0x7f) | (127 - (kk0 + 3)));
                        *(LAS3 u32x4*)(KEYS + hl * 68 + (kk0 & 63)) = kq;
                    }
            __syncthreads();
            int top[16];
            {
                LAS3 const int* src = KEYS + tid * 68;
                int t2[16];
#pragma unroll
                for (int q = 0; q < 4; ++q) { const u32x4 w = *(LAS3 const u32x4*)(src + 4 * q); top[4 * q] = (int)w.x; top[4 * q + 1] = (int)w.y; top[4 * q + 2] = (int)w.z; top[4 * q + 3] = (int)w.w; }
                sort16_desc(top);
#pragma unroll 1
                for (int g = 1; g < 4; ++g) {
#pragma unroll
                    for (int q = 0; q < 4; ++q) { const u32x4 w = *(LAS3 const u32x4*)(src + 16 * g + 4 * q); t2[4 * q] = (int)w.x; t2[4 * q + 1] = (int)w.y; t2[4 * q + 2] = (int)w.z; t2[4 * q + 3] = (int)w.w; }
                    sort16_desc(t2);
                    merge16_desc(top, t2);
                }
#pragma unroll
                for (int i = 0; i < 16; ++i) t2[i] = __shfl_xor(top[i], 1);
                merge16_desc(top, t2);
            }
            const int rl = tid >> 2;
            if ((lane & 1) == 0) {
                LAS3 int* dst = LST + rl * 36 + 16 * ((lane >> 1) & 1);
#pragma unroll
                for (int q = 0; q < 4; ++q) *(LAS3 u32x4*)(dst + 4 * q) = (u32x4){(unsigned)top[4 * q], (unsigned)top[4 * q + 1], (unsigned)top[4 * q + 2], (unsigned)top[4 * q + 3]};
            }
            __syncthreads();
            if (tid < 128) {
                int s1[16], s2[16];
                {
                    LAS3 const int* src = LST + tid * 36;
#pragma unroll
                    for (int q = 0; q < 4; ++q) {
                        const u32x4 wa = *(LAS3 const u32x4*)(src + 4 * q), wb = *(LAS3 const u32x4*)(src + 16 + 4 * q);
                        s1[4 * q] = (int)wa.x; s1[4 * q + 1] = (int)wa.y; s1[4 * q + 2] = (int)wa.z; s1[4 * q + 3] = (int)wa.w;
                        s2[4 * q] = (int)wb.x; s2[4 * q + 1] = (int)wb.y; s2[4 * q + 2] = (int)wb.z; s2[4 * q + 3] = (int)wb.w;
                    }
                }
                float v1[16], v2[16];
#pragma unroll
                for (int i = 0; i < 16; ++i) { v1[i] = ord_dec(s1[i] & ~0x7f); v2[i] = ord_dec(s2[i] & ~0x7f); }
#define PEER_CAND(a, b) ((ord_enc(v1[a] + v2[b]) & ~0xff) | (255 - (16 * (a) + (b))))
                int best[16], grp[16];
#pragma unroll
                for (int b = 0; b < 16; ++b) best[b] = PEER_CAND(0, b);
#pragma unroll
                for (int b = 0; b < 8; ++b) { grp[b] = PEER_CAND(1, b); grp[8 + b] = PEER_CAND(15 - b, 0); }
#pragma unroll
                for (int j = 8; j > 0; j >>= 1)
#pragma unroll
                    for (int i = 0; i < 16; ++i) { const int l = i ^ j; if (l > i) PEER_CE_DESC(grp[i], grp[l]); }
                merge16_desc(best, grp);
                grp[0] = PEER_CAND(2, 0); grp[1] = PEER_CAND(2, 1); grp[2] = PEER_CAND(2, 2); grp[3] = PEER_CAND(2, 3); grp[4] = PEER_CAND(2, 4);
                grp[5] = PEER_CAND(3, 0); grp[6] = PEER_CAND(3, 1); grp[7] = PEER_CAND(3, 2); grp[8] = PEER_CAND(3, 3);
                grp[9] = PEER_CAND(4, 0); grp[10] = PEER_CAND(4, 1); grp[11] = PEER_CAND(4, 2);
                grp[12] = PEER_CAND(5, 0); grp[13] = PEER_CAND(5, 1); grp[14] = PEER_CAND(6, 0); grp[15] = PEER_CAND(6, 1);
                sort16_desc(grp); merge16_desc(best, grp);
                grp[0] = PEER_CAND(7, 0); grp[1] = PEER_CAND(7, 1);
#pragma unroll
                for (int i = 2; i < 16; ++i) grp[i] = (int)0x80000000;
                PEER_CE_DESC(grp[0], grp[1]);
                merge16_desc(best, grp);
#undef PEER_CAND
                const float rs1 = RS[128 * ai + tid];
                float gsum = 0.f, gv[16]; int ev[16];
                const float mtop = ord_dec(best[0] & ~0xff) * rs1;
                LAS3 const int* lst = LST + tid * 36;
#pragma unroll
                for (int i = 0; i < 16; ++i) {
                    const float sc = ord_dec(best[i] & ~0xff) * rs1; gv[i] = __expf(sc - mtop); gsum += gv[i];
                    const int ab = 255 - (best[i] & 0xff);
                    ev[i] = (127 - (lst[ab >> 4] & 0x7f)) * 128 + (127 - (lst[16 + (ab & 15)] & 0x7f));
                }
                const float ginv = 1.0f / gsum;
                const size_t tok = (size_t)u.pm * 256 + 128 * ai + tid;
#pragma unroll
                for (int kq = 0; kq < 4; ++kq) {
                    *(u32x4*)(eout + tok * 128 + head * 16 + 4 * kq) = (u32x4){(unsigned)ev[4 * kq], (unsigned)ev[4 * kq + 1], (unsigned)ev[4 * kq + 2], (unsigned)ev[4 * kq + 3]};
                    *(f32x4*)(gout + tok * 128 + head * 16 + 4 * kq) = (f32x4){gv[4 * kq] * ginv, gv[4 * kq + 1] * ginv, gv[4 * kq + 2] * ginv, gv[4 * kq + 3] * ginv};
                }
            }
        }
        __syncthreads();
    }
    DI void operator()(const f32x4 (&)[2][2][4][2], const pg8::Unit&, int, int, int, int) const {}
};
struct SliceOrder : pg8::StaticOrder {
    int slice;
    __device__ bool next(int i, pg8::Unit& u) const { if (i > 0) return false; return pg8::StaticOrder::next(slice, u); }
};
DI void p5_peer_route(const Params& p, LAS3 unsigned char* lds, int G) {
    unsigned char* ws = p.ws;
    pg8::Gemm g{(const bf16_t*)(ws + R_H1B), (const bf16_t*)(ws + WS_WQS), NTOK, 2048, DM};
    EpiPeerRoute E{(const float*)(ws + WS_SSQ1), (int*)(ws + R_EXP), (float*)(ws + R_GSM), (float*)(ws + WS_RS1)};
    const int nslice = (512 + G - 1) / G;
#pragma unroll 1
    for (int s = 0; s < nslice; ++s) {
        SliceOrder S; S.init(NTOK, 2048, G, (int)blockIdx.x); S.slice = s;
        pg8::gemm_phase<EpiPeerRoute, SliceOrder>(lds, g, S, E, nullptr);
        __syncthreads();
    }
}
constexpr float V8_SCALE = 8.0f;
#define I8_LOADROW(E) (*(const u32x2*)(u8 + ((unsigned)(E) * (unsigned)(DM / 2) + (unsigned)(lane * 8))))
DI int i4_dotrow(const u32x2 w, const unsigned (&xq)[4]) {
    int a = __builtin_amdgcn_sdot4((int)((w.x << 4) & 0xF0F0F0F0u), (int)xq[0], 0, false); a = __builtin_amdgcn_sdot4((int)(w.x & 0xF0F0F0F0u), (int)xq[1], a, false);
    a = __builtin_amdgcn_sdot4((int)((w.y << 4) & 0xF0F0F0F0u), (int)xq[2], a, false); a = __builtin_amdgcn_sdot4((int)(w.y & 0xF0F0F0F0u), (int)xq[3], a, false);
    return a;
}
#define I8_DOTROW(W) i4_dotrow((W), xq)
#define I8_ISSUE(SET, EV, J0) do { int ev_ = (EV); asm volatile("" : "+v"(ev_)); _Pragma("unroll") for (int k = 0; k < 16; ++k) { const int e = __builtin_amdgcn_readlane(ev_, (J0) + k); \
        SET[k] = I8_LOADROW(e); } __builtin_amdgcn_sched_barrier(0); } while (0)
#define I8_CONS(SET, P0) do { _Pragma("unroll") for (int k = 0; k < 16; ++k) { \
        part[(P0) + k] = (float)I8_DOTROW(SET[k]); } __builtin_amdgcn_sched_barrier(0); } while (0)
#define I8_RS(M) do { const bool up = (lane & (M)) != 0; _Pragma("unroll") for (int i = 0; i < (M); ++i) { \
        const float send = up ? part[i] : part[i + (M)], keep = up ? part[i + (M)] : part[i]; part[i] = keep + __shfl_xor(send, (M)); } } while (0)
#define I8_RS32() do { _Pragma("unroll") for (int i = 0; i < 32; ++i) { const auto rr_ = __builtin_amdgcn_permlane32_swap(__float_as_uint(part[i]), __float_as_uint(part[i + 32]), false, false); \
        part[i] = __uint_as_float(rr_[0]) + __uint_as_float(rr_[1]); } } while (0)
#define I8_RS16() do { _Pragma("unroll") for (int i = 0; i < 16; ++i) { const auto rr_ = __builtin_amdgcn_permlane16_swap(__float_as_uint(part[i]), __float_as_uint(part[i + 16]), false, false); \
        part[i] = __uint_as_float(rr_[0]) + __uint_as_float(rr_[1]); } } while (0)
#define V4_ISSUE(SET, EV, J0) do { int ev_ = (EV); asm volatile("" : "+v"(ev_)); _Pragma("unroll") for (int k = 0; k < 16; ++k) { const int e = __builtin_amdgcn_readlane(ev_, (J0) + k); \
        SET[k] = *(const u32x2*)(v8 + ((unsigned)e * (unsigned)(DM / 2) + (unsigned)(lane * 8))); } __builtin_amdgcn_sched_barrier(0); } while (0)
#define V4_CVT(W, B) __builtin_amdgcn_cvt_scalef32_pk_f32_fp4((W), 1.0f, B)
#define V4_FMA(W, I) do { t_[4 * (I)] = __builtin_elementwise_fma(V4_CVT(W, 0), c2, t_[4 * (I)]); \
        t_[4 * (I) + 1] = __builtin_elementwise_fma(V4_CVT(W, 1), c2, t_[4 * (I) + 1]); \
        t_[4 * (I) + 2] = __builtin_elementwise_fma(V4_CVT(W, 2), c2, t_[4 * (I) + 2]); \
        t_[4 * (I) + 3] = __builtin_elementwise_fma(V4_CVT(W, 3), c2, t_[4 * (I) + 3]); } while (0)
#define V4_ROW(SET, CV, J0, K) do { const float c = (CV)[(J0) + (K)]; const f32x2 c2 = {c, c}; const u32x2 w_ = SET[K]; \
        V4_FMA(w_.x, 0); V4_FMA(w_.y, 1); } while (0)
#define V4_CONS(SET, CV, J0) do { f32x2 t_[8]; _Pragma("unroll") for (int i_ = 0; i_ < 8; ++i_) t_[i_] = (f32x2){0.f, 0.f}; V4_ROW(SET, CV, J0, 0); V4_ROW(SET, CV, J0, 1); V4_ROW(SET, CV, J0, 2); V4_ROW(SET, CV, J0, 3); V4_ROW(SET, CV, J0, 4); V4_ROW(SET, CV, J0, 5); \
        V4_ROW(SET, CV, J0, 6); V4_ROW(SET, CV, J0, 7); V4_ROW(SET, CV, J0, 8); V4_ROW(SET, CV, J0, 9); V4_ROW(SET, CV, J0, 10); V4_ROW(SET, CV, J0, 11); \
        V4_ROW(SET, CV, J0, 12); V4_ROW(SET, CV, J0, 13); V4_ROW(SET, CV, J0, 14); V4_ROW(SET, CV, J0, 15); \
        _Pragma("unroll") for (int i_ = 0; i_ < 8; ++i_) acc[i_] += t_[i_]; __builtin_amdgcn_sched_barrier(0); } while (0)
DI void p6fused(const Params& p, LAS3 unsigned char* lds, int G) {
    unsigned char* ws = p.ws;
    const int tid = threadIdx.x, lane = tid & 63, wid = tid >> 6;
    const int gw = blockIdx.x * 8 + wid, nw = G * 8;
    const unsigned char* u8 = (const unsigned char*)(ws + WS_UB); const unsigned char* v8 = (const unsigned char*)(ws + WS_VB);
    const int* eidx = (const int*)(ws + R_EXP); const float* gsm = (const float*)(ws + R_GSM); const float* rs1v = (const float*)(ws + WS_RS1);
    bf16_t* hb = (bf16_t*)(ws + R_H1B); float* rs2 = (float*)(ws + WS_RS2);
    LAS3 float* cl = (LAS3 float*)(lds + wid * 512);
    int en0 = 0, en1 = 0; u32x4 xna = {0u, 0u, 0u, 0u}, xnb = xna; float gn0 = 0.f, gn1 = 0.f, rsn = 0.f;
    if (gw < NTOK) { en0 = eidx[(size_t)gw * 128 + lane]; en1 = eidx[(size_t)gw * 128 + 64 + lane];
        xna = *(const u32x4*)(hb + (size_t)gw * DM + lane * 16); xnb = *(const u32x4*)(hb + (size_t)gw * DM + lane * 16 + 8);
        gn0 = gsm[(size_t)gw * 128 + lane]; gn1 = gsm[(size_t)gw * 128 + 64 + lane]; rsn = rs1v[gw]; }
#pragma unroll 1
    for (int tok = gw; tok < NTOK; tok += nw) {
        const int e0 = en0, e1 = en1; const u32x4 xa = xna, xb = xnb; const float g0 = gn0, g1 = gn1, rs1 = rsn;
        const int tn = tok + nw < NTOK ? tok + nw : tok;
        en0 = eidx[(size_t)tn * 128 + lane]; en1 = eidx[(size_t)tn * 128 + 64 + lane];
        {
            u32x2 sa[16], sb[16];
            I8_ISSUE(sa, e0, 0);
            I8_ISSUE(sb, e0, 16);
            xna = *(const u32x4*)(hb + (size_t)tn * DM + lane * 16); xnb = *(const u32x4*)(hb + (size_t)tn * DM + lane * 16 + 8);
            gn0 = gsm[(size_t)tn * 128 + lane]; gn1 = gsm[(size_t)tn * 128 + 64 + lane]; rsn = rs1v[tn];
            float xf[16];
#pragma unroll
            for (int q = 0; q < 4; ++q) { xf[2 * q] = bflo(xa[q]); xf[2 * q + 1] = bfhi(xa[q]); xf[8 + 2 * q] = bflo(xb[q]); xf[8 + 2 * q + 1] = bfhi(xb[q]); }
            float amax = 0.f;
#pragma unroll
            for (int i = 0; i < 16; ++i) amax = fmaxf(amax, fabsf(xf[i]));
            amax = wave_max(amax);
            const float sx = fmaxf(amax, 1e-20f) * (1.0f / 127.0f), isx = 1.0f / sx;
            unsigned xq[4];
#pragma unroll
            for (int q = 0; q < 2; ++q) {
                unsigned we = 0u, wo = 0u;
#pragma unroll
                for (int b = 0; b < 4; ++b) { we |= ((unsigned)(int)rintf(xf[8 * q + 2 * b] * isx) & 0xffu) << (8 * b); wo |= ((unsigned)(int)rintf(xf[8 * q + 2 * b + 1] * isx) & 0xffu) << (8 * b); }
                xq[2 * q] = we; xq[2 * q + 1] = wo;
            }
            const float scl = rs1 * sx * (1.0f / (16.0f * U4_ISCALE));
            float part[64];
            I8_CONS(sa, 0);  I8_ISSUE(sa, e0, 32);
            I8_CONS(sb, 16); I8_ISSUE(sb, e0, 48);
            I8_CONS(sa, 32); I8_ISSUE(sa, e1, 0);
            I8_CONS(sb, 48); I8_ISSUE(sb, e1, 16);
            I8_RS32(); I8_RS16(); I8_RS(8); I8_RS(4); I8_RS(2); I8_RS(1);
            cl[lane] = g0 * gelu_tanh(part[0] * scl) * (1.0f / V8_SCALE);
            I8_CONS(sa, 0);  I8_ISSUE(sa, e1, 32);
            I8_CONS(sb, 16); I8_ISSUE(sb, e1, 48);
            I8_CONS(sa, 32);
            I8_CONS(sb, 48);
            I8_RS32(); I8_RS16(); I8_RS(8); I8_RS(4); I8_RS(2); I8_RS(1);
            cl[64 + lane] = g1 * gelu_tanh(part[0] * scl) * (1.0f / V8_SCALE);
        }
        {
            u32x2 sa[16], sb[16];
            V4_ISSUE(sa, e0, 0);
            V4_ISSUE(sb, e0, 16);
            LAS3 const float* c0 = cl; LAS3 const float* c1 = cl + 64;
            const u32x4 ha = xa, hc = xb;
            const f32x4 hv0 = {bflo(ha.x), bfhi(ha.x), bflo(ha.y), bfhi(ha.y)}, hv1 = {bflo(ha.z), bfhi(ha.z), bflo(ha.w), bfhi(ha.w)};
            const f32x4 hv2 = {bflo(hc.x), bfhi(hc.x), bflo(hc.y), bfhi(hc.y)}, hv3 = {bflo(hc.z), bfhi(hc.z), bflo(hc.w), bfhi(hc.w)};
            f32x2 acc[8];
#pragma unroll
            for (int i = 0; i < 8; ++i) acc[i] = (f32x2){0.f, 0.f};
            V4_CONS(sa, c0, 0);  V4_ISSUE(sa, e0, 32);
            V4_CONS(sb, c0, 16); V4_ISSUE(sb, e0, 48);
            V4_CONS(sa, c0, 32); V4_ISSUE(sa, e1, 0);
            V4_CONS(sb, c0, 48); V4_ISSUE(sb, e1, 16);
            V4_CONS(sa, c1, 0);  V4_ISSUE(sa, e1, 32);
            V4_CONS(sb, c1, 16); V4_ISSUE(sb, e1, 48);
            V4_CONS(sa, c1, 32);
            V4_CONS(sb, c1, 48);
            const f32x4 o0 = hv0 + (f32x4){acc[0].x, acc[0].y, acc[1].x, acc[1].y}, o1 = hv1 + (f32x4){acc[2].x, acc[2].y, acc[3].x, acc[3].y};
            const f32x4 o2 = hv2 + (f32x4){acc[4].x, acc[4].y, acc[5].x, acc[5].y}, o3 = hv3 + (f32x4){acc[6].x, acc[6].y, acc[7].x, acc[7].y};
            u32x4 w0, w1;
            w0.x = pk_bf16(o0[0], o0[1]); w0.y = pk_bf16(o0[2], o0[3]); w0.z = pk_bf16(o1[0], o1[1]); w0.w = pk_bf16(o1[2], o1[3]);
            w1.x = pk_bf16(o2[0], o2[1]); w1.y = pk_bf16(o2[2], o2[3]); w1.z = pk_bf16(o3[0], o3[1]); w1.w = pk_bf16(o3[2], o3[3]);
            *(u32x4*)(hb + (size_t)tok * DM + lane * 16) = w0; *(u32x4*)(hb + (size_t)tok * DM + lane * 16 + 8) = w1;
            float ss = 0.f;
#pragma unroll
            for (int j = 0; j < 4; ++j) ss += o0[j] * o0[j] + o1[j] * o1[j] + o2[j] * o2[j] + o3[j] * o3[j];
            ss = wave_sum(ss);
            if (lane == 0) rs2[tok] = rsqrtf(ss * (1.0f / DM) + EPS);
        }
    }
}
#undef I8_ISSUE
#undef I8_CONS
#undef I8_RS
#undef I8_RS32
#undef I8_RS16
#undef V4_ISSUE
#undef V4_CONS
#undef V4_FMA
#undef V4_ROW
#undef V4_CVT
#undef I8_LOADROW
#undef I8_DOTROW

constexpr int LDS_MISC = 160 * 1024 - 256;
constexpr int LDS_BYTES = 160 * 1024;
constexpr size_t CTL_BAR = 0;
static_assert(XCD_BAR_WORDS * 4 <= 64 * 1024, "control region");

template <class F> struct EpiAdapt {
    static constexpr bool PERM = true, AFTER_DRAIN = false;
    F f;
    DI void operator()(const f32x4 (&acc)[2][2][4][2], const pg8::Unit& u, int wr, int wc, int fr, int fq) const {
        int fr_ = fr, fq_ = fq; asm volatile("" : "+v"(fr_), "+v"(fq_));
        const int row0 = u.pm * 256 + wr * 64 + fr_, col0 = u.pn * 256 + wc * 32 + 8 * fq_;
#pragma unroll
        for (int ai = 0; ai < 2; ++ai)
#pragma unroll
            for (int m = 0; m < 4; ++m) {
                const int row = row0 + ai * 128 + m * 16;
#pragma unroll
                for (int bj = 0; bj < 2; ++bj)
                    f.store8(row, col0 + bj * 128, acc[ai][bj][m][0], acc[ai][bj][m][1]);
            }
    }
};
template <class F> struct EpiAdaptSsq {
    static constexpr bool PERM = true, AFTER_DRAIN = false;
    F f; float* ssq;
    DI void operator()(const f32x4 (&acc)[2][2][4][2], const pg8::Unit& u, int wr, int wc, int fr, int fq) const {
        int fr_ = fr, fq_ = fq; asm volatile("" : "+v"(fr_), "+v"(fq_));
        const int row0 = u.pm * 256 + wr * 64 + fr_, col0 = u.pn * 256 + wc * 32 + 8 * fq_;
#pragma unroll
        for (int ai = 0; ai < 2; ++ai)
#pragma unroll
            for (int m = 0; m < 4; ++m) {
                const int row = row0 + ai * 128 + m * 16;
                float s = 0.f; const float rsc = f.rowscale(row);
#pragma unroll
                for (int bj = 0; bj < 2; ++bj)
                    s += f.store8r(row, col0 + bj * 128, acc[ai][bj][m][0], acc[ai][bj][m][1], rsc);
                s += __shfl_xor(s, 16); s += __shfl_xor(s, 32);
                if (fq_ == 0) ssq[(size_t)(u.pn * 4 + wc) * NTOK + row] = s;
            }
    }
};
struct EpiOutR {
    const bf16_t* xb; bf16_t* h1b;
    DI float rowscale(int) const { return 0.f; }
    DI float store8r(int row, int col, f32x4 v0, f32x4 v1, float) const {
        const size_t o = (size_t)row * DM + col;
        const u32x4 xw = *(const u32x4*)(xb + o);
        v0 += (f32x4){bflo(xw.x), bfhi(xw.x), bflo(xw.y), bfhi(xw.y)}; v1 += (f32x4){bflo(xw.z), bfhi(xw.z), bflo(xw.w), bfhi(xw.w)};
        u32x4 w; w.x = pack2bf(v0[0], v0[1]); w.y = pack2bf(v0[2], v0[3]); w.z = pack2bf(v1[0], v1[1]); w.w = pack2bf(v1[2], v1[3]); *(u32x4*)(h1b + o) = w;
        return ((v0[0] * v0[0] + v0[1] * v0[1]) + (v0[2] * v0[2] + v0[3] * v0[3])) + ((v1[0] * v1[0] + v1[1] * v1[1]) + (v1[2] * v1[2] + v1[3] * v1[3]));
    }
};
struct EpiBf16Plain { bf16_t* C; int ldc;
    DI void store8(int row, int col, f32x4 v0, f32x4 v1) const { u32x4 w; w.x = pack2bf(v0[0], v0[1]); w.y = pack2bf(v0[2], v0[3]); w.z = pack2bf(v1[0], v1[1]); w.w = pack2bf(v1[2], v1[3]); *(u32x4*)(C + (size_t)row * ldc + col) = w; } };
struct EpiGateR {
    const float* rs2; const float* bias; const bf16_t* pp; const bf16_t* h2; bf16_t* h3;
    DI float rowscale(int row) const { return rs2[row]; }
    DI float store8r(int row, int col, f32x4 v0, f32x4 v1, float s) const {
        const size_t o = (size_t)row * DM + col;
        const f32x4 b0 = *(const f32x4*)(bias + col), b1 = *(const f32x4*)(bias + col + 4); const u32x4 pw = *(const u32x4*)(pp + o), hw = *(const u32x4*)(h2 + o);
        float hv[8] = {bflo(hw.x), bfhi(hw.x), bflo(hw.y), bfhi(hw.y), bflo(hw.z), bfhi(hw.z), bflo(hw.w), bfhi(hw.w)};
        const float pv[8] = {bflo(pw.x), bfhi(pw.x), bflo(pw.y), bfhi(pw.y), bflo(pw.z), bfhi(pw.z), bflo(pw.w), bfhi(pw.w)};
        float ss = 0.f;
#pragma unroll
        for (int j = 0; j < 4; ++j) { hv[j] += sigmoidf_(v0[j] * s + b0[j]) * pv[j]; hv[4 + j] += sigmoidf_(v1[j] * s + b1[j]) * pv[4 + j]; }
#pragma unroll
        for (int j = 0; j < 8; ++j) ss += hv[j] * hv[j];
        u32x4 w; w.x = pack2bf(hv[0], hv[1]); w.y = pack2bf(hv[2], hv[3]); w.z = pack2bf(hv[4], hv[5]); w.w = pack2bf(hv[6], hv[7]); *(u32x4*)(h3 + o) = w;
        return ss;
    }
};

constexpr size_t CTL_PANEL = 16384;
struct EpiGateFinal {
    static constexpr bool PERM = true, AFTER_DRAIN = true;
    const float* rs2; const float* bias; const bf16_t* pp; const bf16_t* h2; float* ssq; unsigned* ctl; const float* gfin; float* out;
    DI void fused(const f32x4 (&acc_)[2][2][4][2], const pg8::Unit& u, int wr, int wc, int fr, int fq, PG8_LAS unsigned char*, int, int) const {
        f32x4 (&acc)[2][2][4][2] = const_cast<f32x4 (&)[2][2][4][2]>(acc_);
        int fr_ = fr, fq_ = fq; asm volatile("" : "+v"(fr_), "+v"(fq_));
        const int row0 = u.pm * 256 + wr * 64 + fr_, col0 = u.pn * 256 + wc * 32 + 8 * fq_;
#pragma unroll
        for (int ai = 0; ai < 2; ++ai)
#pragma unroll
            for (int m = 0; m < 4; ++m) {
                const int row = row0 + ai * 128 + m * 16;
                const float s = rs2[row];
                float ss = 0.f;
#pragma unroll
                for (int bj = 0; bj < 2; ++bj) {
                    const int col = col0 + bj * 128; const size_t o = (size_t)row * DM + col;
                    const f32x4 b0 = *(const f32x4*)(bias + col), b1 = *(const f32x4*)(bias + col + 4); const u32x4 pw = *(const u32x4*)(pp + o), hw = *(const u32x4*)(h2 + o);
                    const f32x4 v0 = acc[ai][bj][m][0], v1 = acc[ai][bj][m][1];
                    f32x4 h0 = {bflo(hw.x), bfhi(hw.x), bflo(hw.y), bfhi(hw.y)}, h1 = {bflo(hw.z), bfhi(hw.z), bflo(hw.w), bfhi(hw.w)};
                    const f32x4 p0 = {bflo(pw.x), bfhi(pw.x), bflo(pw.y), bfhi(pw.y)}, p1 = {bflo(pw.z), bfhi(pw.z), bflo(pw.w), bfhi(pw.w)};
#pragma unroll
                    for (int j = 0; j < 4; ++j) { h0[j] += sigmoidf_(v0[j] * s + b0[j]) * p0[j]; h1[j] += sigmoidf_(v1[j] * s + b1[j]) * p1[j]; }
#pragma unroll
                    for (int j = 0; j < 4; ++j) ss += h0[j] * h0[j] + h1[j] * h1[j];
                    acc[ai][bj][m][0] = h0; acc[ai][bj][m][1] = h1;
                }
                ss += __shfl_xor(ss, 16); ss += __shfl_xor(ss, 32);
                if (fq_ == 0) ssq[(size_t)(u.pn * 4 + wc) * NTOK + row] = ss;
            }
        asm volatile("s_waitcnt vmcnt(0)" ::: "memory");
        __syncthreads();
        if (threadIdx.x == 0) {
            unsigned* cnt = ctl + (CTL_PANEL / 4) + u.pm * 16;
            __builtin_amdgcn_fence(__ATOMIC_RELEASE, "agent");
            asm volatile("s_waitcnt vmcnt(0)" ::: "memory");
            (void)xb_add(cnt, 1u);
            XB_SPIN(xb_ld(cnt) < 4u, ctl);
            __builtin_amdgcn_fence(__ATOMIC_ACQUIRE, "agent");
            asm volatile("s_waitcnt vmcnt(0)" ::: "memory");
        }
        __syncthreads();
#pragma unroll
        for (int ai = 0; ai < 2; ++ai)
#pragma unroll
            for (int m = 0; m < 4; ++m) {
                const int row = row0 + ai * 128 + m * 16;
                float t = 0.f;
#pragma unroll
                for (int j = 0; j < 4; ++j) t += xb_ldf(ssq + (size_t)(4 * fq_ + j) * NTOK + row);
                t += __shfl_xor(t, 16); t += __shfl_xor(t, 32);
                const float rs = rsqrtf(t * (1.0f / DM) + EPS);
#pragma unroll
                for (int bj = 0; bj < 2; ++bj) {
                    const int col = col0 + bj * 128;
                    const f32x4 g0 = *(const f32x4*)(gfin + col), g1 = *(const f32x4*)(gfin + col + 4);
                    float* o = out + (size_t)row * DM + col;
                    *(f32x4*)o = acc[ai][bj][m][0] * rs * g0; *(f32x4*)(o + 4) = acc[ai][bj][m][1] * rs * g1;
                }
            }
    }
    DI void operator()(const f32x4 (&)[2][2][4][2], const pg8::Unit&, int, int, int, int) const {}
};

struct MegaArgs { Params p; int ph_lo, ph_hi; };

__global__ void __launch_bounds__(MK_THREADS, 2) mega_fwd(MegaArgs args) {
    extern __shared__ __attribute__((aligned(16))) unsigned char lds_raw[];
    LAS unsigned char* lds = (LAS unsigned char*)lds_raw;
    const Params& p = args.p;
    unsigned char* ws = p.ws;
    const int lo = args.ph_lo, hi = args.ph_hi;
    const int G = gridDim.x;
    volatile LAS unsigned* misc = (volatile LAS unsigned*)(lds + LDS_MISC);
    if (threadIdx.x < 64) misc[threadIdx.x] = 0u;
    __syncthreads();
    const XcdBarrier bar = xcd_barrier_post((unsigned*)(ws + WS_CTL), misc);
#define IN(k) (lo <= (k) && (k) < hi)
#define SEAM(k) do { if (IN(k) && IN((k) + 1)) xcd_barrier(bar); } while (0)

    if (IN(0)) p0_prologue(p, lds, G);
    SEAM(0);
    if (IN(1)) {
        pg8::Gemm g{(const bf16_t*)(ws + WS_XB), (const bf16_t*)(ws + WS_WIN), NTOK, NPROJ, DM};
        pg8::StaticOrder S; S.init(NTOK, NPROJ, G, (int)blockIdx.x);
        EpiAdapt<EpiProj> E{{(const float*)(ws + WS_RS0), (bf16_t*)(ws + R_QB), (bf16_t*)(ws + R_KC), (float*)(ws + R_GATE), (bf16_t*)(ws + R_XR), (bf16_t*)(ws + R_XG)}};
        pg8::gemm_phase<EpiAdapt<EpiProj>, pg8::StaticOrder>(lds, g, S, E, nullptr);
        p1_deferred(p, G);
    }
    SEAM(1);
    if (IN(2)) { p2_compress(p, lds, G); lru_phase<false>(p, lds, G); }
    SEAM(2);
    if (IN(3)) { p3_attention<0>(p, lds, G); lru_final(p, lds, G); }
    SEAM(3);
    if (IN(4)) {
        pg8::Gemm g{(const bf16_t*)(ws + WS_MIXED), (const bf16_t*)(ws + WS_WOUT), NTOK, DM, DM};
        pg8::StaticOrder S; S.init(NTOK, DM, G, (int)blockIdx.x);
        EpiAdaptSsq<EpiOutR> E{{(const bf16_t*)(ws + WS_XB), (bf16_t*)(ws + R_H1B)}, (float*)(ws + WS_SSQ1)};
        pg8::gemm_phase<EpiAdaptSsq<EpiOutR>, pg8::StaticOrder>(lds, g, S, E, nullptr);
    }
    SEAM(4);
    if (IN(5)) p5_peer_route(p, lds, G);
    SEAM(5);
    if (IN(6)) p6fused(p, lds, G);
    SEAM(6);
    if (IN(7)) {
        {
            pg8::Gemm g{(const bf16_t*)(ws + WS_PB), (const bf16_t*)(ws + WS_WP), NTOK, DM, PLE};
            pg8::StaticOrder S; S.init(NTOK, DM, G, (int)blockIdx.x);
            EpiAdapt<EpiBf16Plain> E{{(bf16_t*)(ws + R_BIG), DM}};
            pg8::gemm_phase<EpiAdapt<EpiBf16Plain>, pg8::StaticOrder>(lds, g, S, E, nullptr);
        }
        __syncthreads();
        if (G >= 256) {
            pg8::Gemm g{(const bf16_t*)(ws + R_H1B), (const bf16_t*)(ws + WS_WG), NTOK, DM, DM};
            pg8::StaticOrder S; S.init(NTOK, DM, G, (int)blockIdx.x);
            EpiGateFinal E{(const float*)(ws + WS_RS2), p.in[I_PLE_BG], (const bf16_t*)(ws + R_BIG), (const bf16_t*)(ws + R_H1B), (float*)(ws + WS_SSQ3), (unsigned*)(ws + WS_CTL), p.in[I_FINAL_NORM], p.out};
            pg8::gemm_phase<EpiGateFinal, pg8::StaticOrder>(lds, g, S, E, nullptr);
        } else {
            pg8::Gemm g{(const bf16_t*)(ws + R_H1B), (const bf16_t*)(ws + WS_WG), NTOK, DM, DM};
            pg8::StaticOrder S; S.init(NTOK, DM, G, (int)blockIdx.x);
            EpiAdaptSsq<EpiGateR> E{{(const float*)(ws + WS_RS2), p.in[I_PLE_BG], (const bf16_t*)(ws + R_BIG), (const bf16_t*)(ws + R_H1B), (bf16_t*)(ws + WS_XB)}, (float*)(ws + WS_SSQ3)};
            pg8::gemm_phase<EpiAdaptSsq<EpiGateR>, pg8::StaticOrder>(lds, g, S, E, nullptr);
        }
    }
    if (G < 256) {
        SEAM(7);
        if (IN(8)) p8_final_norm(p, G);
    }
#undef IN
#undef SEAM
}

static int g_grid = 0;
static void launch_mega(hipStream_t st, const Params& p, int lo, int hi) {
    if (g_grid == 0) {
        int dev = 0, cus = 0, per_cu = 0;
        hipGetDevice(&dev); hipDeviceGetAttribute(&cus, hipDeviceAttributeMultiprocessorCount, dev);
        if (hipFuncSetAttribute((const void*)mega_fwd, hipFuncAttributeMaxDynamicSharedMemorySize, LDS_BYTES) != hipSuccess) { fprintf(stderr, "hipFuncSetAttribute failed\n"); g_grid = -1; return; }
        if (hipOccupancyMaxActiveBlocksPerMultiprocessor(&per_cu, (const void*)mega_fwd, MK_THREADS, LDS_BYTES) != hipSuccess || per_cu < 1) { fprintf(stderr, "occupancy query: %d per CU\n", per_cu); }
        (void)hipGetLastError();
        g_grid = cus;
    }
    if (g_grid < 0) return;
    MegaArgs a{}; a.p = p; a.ph_lo = lo; a.ph_hi = hi;
    hipLaunchKernelGGL(mega_fwd, dim3(g_grid), dim3(MK_THREADS), LDS_BYTES, st, a);
}
extern "C" void kernel_launch(void* const* d_in, const int* in_sizes, int n_in, void* d_out, int out_size, void* d_ws, size_t ws_size, hipStream_t stream) {
    if (n_in != 31 || out_size != NTOK * DM || ws_size < WS_END) { fprintf(stderr, "kernel_launch: unexpected shapes (n_in %d out %d ws %zu)\n", n_in, out_size, ws_size); return; }
    Params p{};
    for (int i = 0; i < 31; ++i) p.in[i] = (const float*)d_in[i];
    p.out = (float*)d_out; p.ws = (unsigned char*)d_ws;
    (void)hipMemsetAsync((char*)d_ws + WS_CTL, 0, 16384 + 4096, stream);
    launch_mega(stream, p, 0, 9);
}
```

```cpp
#include <hip/hip_runtime.h>
#include <stdint.h>
#include <stdio.h>

typedef unsigned short bf16_t;
typedef float f32x4 __attribute__((ext_vector_type(4)));
typedef float f32x2 __attribute__((ext_vector_type(2)));
typedef unsigned u32x4 __attribute__((ext_vector_type(4)));
typedef unsigned u32x2 __attribute__((ext_vector_type(2)));
#define DI __device__ __forceinline__

constexpr int NB = 4, T_ = 4096, DM = 1024, NTOK = NB * T_;
constexpr int NH = 8, HD = 64, NKV = 2, GRP = 4, ATTW = 512, KVW = 128, LRUW = 512;
constexpr int INCOLS = 2328, NPROJ = 2560;
constexpr int NCMP = 255, NSEL = 64;
constexpr int PEER_H = 8, PEER_K = 16, PEER_NK = 128;
constexpr int PLE = 256;
constexpr float EPS = 1e-6f;

constexpr int PC_KV = 512, PC_XR = 1280, PC_XG = 1792, PC_GATE = 2304;

constexpr size_t MB = 1024 * 1024;
constexpr size_t WS_CTL   = 0;
constexpr size_t WS_WIN   = 64 * 1024;
constexpr size_t WS_WOUT  = WS_WIN  + (size_t)NPROJ * DM * 2;
constexpr size_t WS_WQS   = WS_WOUT + (size_t)DM * DM * 2;
constexpr size_t WS_WG    = WS_WQS  + (size_t)2048 * DM * 2;
constexpr size_t WS_WP    = WS_WG   + (size_t)DM * DM * 2;
constexpr size_t WS_CW1K  = WS_WP   + (size_t)DM * PLE * 2;
constexpr size_t WS_CW1V  = WS_CW1K + (size_t)256 * 2048 * 2;
constexpr size_t WS_CBK   = WS_CW1V + (size_t)256 * 2048 * 2;
constexpr size_t WS_CBV   = WS_CBK  + 1024;
constexpr size_t WS_RS0   = WS_CBV  + 1024;
constexpr size_t WS_RS2   = WS_RS0  + (size_t)NTOK * 4;
constexpr size_t WS_RS1   = WS_RS2  + (size_t)NTOK * 4;
constexpr size_t WS_SSQ2  = WS_RS1  + (size_t)NTOK * 4;
constexpr size_t WS_SSQ1  = WS_SSQ2 + (size_t)16 * NTOK * 4;
constexpr size_t WS_SSQ3  = WS_SSQ1 + (size_t)16 * NTOK * 4;
constexpr size_t WS_KCMP  = WS_SSQ3 + (size_t)16 * NTOK * 4;
constexpr size_t WS_VCMP  = WS_KCMP + (size_t)8 * 256 * 64 * 4;
constexpr size_t WS_LRUP  = WS_VCMP + (size_t)8 * 256 * 64 * 4;
constexpr size_t WS_LRUH  = WS_LRUP + (size_t)256 * 512 * 4;
constexpr size_t WS_WAT   = WS_LRUH + (size_t)256 * 512 * 4;
constexpr size_t WS_WXT   = WS_WAT + 8 * 64 * 64 * 2;
constexpr size_t WS_CW2K  = WS_WXT + 8 * 64 * 64 * 2;
constexpr size_t WS_CW2V  = WS_CW2K + 64 * 256 * 2;
constexpr size_t WS_HID   = WS_CW2V + 64 * 256 * 2;
constexpr size_t WS_UB    = (WS_HID + (size_t)2 * 2048 * 256 * 4 + 4095) / 4096 * 4096;
constexpr size_t WS_LGA   = WS_UB + 8 * MB;
constexpr size_t WS_VB    = WS_UB + (size_t)16384 * DM * 2;
constexpr size_t WS_LGB   = WS_VB + 8 * MB;
constexpr size_t WS_PB    = WS_VB + (size_t)16384 * DM * 2;
constexpr size_t WS_XB    = WS_PB + (size_t)NTOK * PLE * 2;
constexpr size_t WS_R     = WS_XB + (size_t)NTOK * DM * 2;
constexpr size_t KVT = (size_t)NB * NKV * T_ * HD * 2 + 65536;
constexpr size_t R_QB    = WS_R;
constexpr size_t R_KC    = R_QB + (size_t)NTOK * 512 * 2;
constexpr size_t R_VC    = R_KC + KVT;
constexpr size_t R_KS    = R_VC + KVT;
constexpr size_t R_VS    = R_KS + KVT;
constexpr size_t R_KW    = R_VS + KVT;
constexpr size_t R_VW    = R_KW + KVT;
constexpr size_t R_GATE  = R_VW + KVT;
constexpr size_t R_XR    = R_GATE + (size_t)NTOK * 24 * 4;
constexpr size_t R_XG    = R_XR + (size_t)NTOK * 512 * 2;
constexpr size_t R_VST   = R_XG + (size_t)NTOK * 512 * 2;
constexpr size_t R_VWT   = R_VST + KVT;
constexpr size_t R_KCB   = R_VWT + KVT;
constexpr size_t R_VCT   = R_KCB + (size_t)8 * 256 * 64 * 2;
constexpr size_t R_END13 = R_VCT + (size_t)8 * 256 * 64 * 2;
constexpr size_t R_H1B   = WS_R;
constexpr size_t R_EXP   = R_H1B + (size_t)NTOK * DM * 2;
constexpr size_t R_GSM   = R_EXP + (size_t)NTOK * 128 * 4;
constexpr size_t R_COEF  = R_GSM + (size_t)NTOK * 128 * 4;
constexpr size_t R_BIG   = R_COEF + (size_t)NTOK * 128 * 4;
constexpr size_t WS_MIXED = (R_END13 + 4095) / 4096 * 4096;
static_assert(WS_MIXED + (size_t)NTOK * DM * 2 <= R_BIG + 64 * MB, "mixed must fit below the end of region R");
constexpr size_t WS_END  = (R_END13 > R_BIG + 64 * MB ? R_END13 : R_BIG + 64 * MB);
static_assert(WS_END <= 256 * MB, "workspace map exceeds 256 MiB");

DI float bf2f(bf16_t v) { return __uint_as_float((unsigned)v << 16); }
typedef __bf16 bf16x2hw_t __attribute__((ext_vector_type(2)));
DI unsigned pack2bf(float lo, float hi) { return __builtin_bit_cast(unsigned, __builtin_convertvector((f32x2){lo, hi}, bf16x2hw_t)); }
DI bf16_t f2bf(float x) { return (bf16_t)(pack2bf(x, x) & 0xffffu); }
DI float sigmoidf_(float x) { return __builtin_amdgcn_rcpf(1.0f + __expf(-x)); }
DI float gelu_tanh(float x) { const float u = 0.7978845608028654f * (x + 0.044715f * x * x * x); return x * sigmoidf_(2.0f * u); }

__device__ const unsigned char REL_BUCKET_LUT[128] = {
0,1,2,3,4,5,6,7,8,9,10,11,12,13,14,15,16,16,16,17,17,18,18,18,19,19,19,20,20,20,20,21,21,21,21,22,22,22,22,22,23,23,23,23,23,23,24,24,24,24,24,24,25,25,25,25,25,25,25,26,26,26,26,26,26,26,26,27,27,27,27,27,27,27,27,27,27,28,28,28,28,28,28,28,28,28,28,29,29,29,29,29,29,29,29,29,29,29,29,30,30,30,30,30,30,30,30,30,30,30,30,30,30,31,31,31,31,31,31,31,31,31,31,31,31,31,31,31};
DI int rel_bucket(int dist) { dist = dist < 0 ? 0 : dist; return dist >= 128 ? 31 : (int)REL_BUCKET_LUT[dist]; }

struct Params {
    const float* in[31];
    float* out;
    unsigned char* ws;
};
enum { I_X = 0, I_P, I_ATTN_NORM, I_W_IN, I_CK_PE, I_CK_W1, I_CK_W2, I_CV_PE, I_CV_W1, I_CV_W2, I_REL, I_CONV_W, I_CONV_B, I_LRU_WA, I_LRU_BA, I_LRU_WX, I_LRU_BX,
       I_LRU_LAM, I_GN_ATTN, I_GN_LRU, I_W_OUT, I_FFN_NORM, I_PEER_WQ, I_PEER_SUB, I_PEER_U, I_PEER_V, I_PLE_NORM, I_PLE_WG, I_PLE_BG, I_PLE_PROJ, I_FINAL_NORM };

struct EpiProj {
    static constexpr bool HAS8 = true;
    const float* rs0; bf16_t* qb; bf16_t* kv0; float* gates; bf16_t* xr; bf16_t* xg;
    DI void store8(int row, int col, f32x4 v0, f32x4 v1) const {
        const float s = rs0[row];
        v0 *= s; v1 *= s;
        const int tl = __builtin_amdgcn_readfirstlane(col >> 8);
        if (tl < 2) { const float qs = 0.125f * 1.4426950408889634f;
            v0 *= qs; v1 *= qs;
            u32x4 w; w.x = pack2bf(v0[0], v0[1]); w.y = pack2bf(v0[2], v0[3]); w.z = pack2bf(v1[0], v1[1]); w.w = pack2bf(v1[2], v1[3]); *(u32x4*)(qb + (size_t)row * 512 + col) = w; }
        else if (tl < 5) {
            const int c = col - PC_KV, tensor = c >> 7, within = c & 127, kvh = within >> 6, d = within & 63, b = row >> 12, t = row & 4095;
            bf16_t* dst = (bf16_t*)((unsigned char*)kv0 + (size_t)tensor * KVT) + ((size_t)(b * NKV + kvh) * T_ + t) * HD + d;
            u32x4 w; w.x = pack2bf(v0[0], v0[1]); w.y = pack2bf(v0[2], v0[3]); w.z = pack2bf(v1[0], v1[1]); w.w = pack2bf(v1[2], v1[3]); *(u32x4*)dst = w;
        }
        else if (tl < 7) { u32x4 w; w.x = pack2bf(v0[0], v0[1]); w.y = pack2bf(v0[2], v0[3]); w.z = pack2bf(v1[0], v1[1]); w.w = pack2bf(v1[2], v1[3]); *(u32x4*)(xr + (size_t)row * 512 + (col - PC_XR)) = w; }
        else if (tl < 9) { u32x4 w; w.x = pack2bf(v0[0], v0[1]); w.y = pack2bf(v0[2], v0[3]); w.z = pack2bf(v1[0], v1[1]); w.w = pack2bf(v1[2], v1[3]); *(u32x4*)(xg + (size_t)row * 512 + (col - PC_XG)) = w; }
        else if (col < PC_GATE + 24) { float* g = gates + (size_t)row * 24 + (col - PC_GATE); *(f32x4*)g = v0; *(f32x4*)(g + 4) = v1; }
    }
};
struct EpiOut {
    const float* x; float* h1; bf16_t* h1b;
    DI void store4(int row, int col, f32x4 v) const {
        const size_t o = (size_t)row * DM + col;
        v += *(const f32x4*)(x + o);
        *(f32x4*)(h1 + o) = v;
        u32x2 w; w.x = pack2bf(v[0], v[1]); w.y = pack2bf(v[2], v[3]); *(u32x2*)(h1b + o) = w;
    }
};
struct EpiF32Plain { float* C; int ldc; int coloff;
    DI void store4(int row, int col, f32x4 v) const { *(f32x4*)(C + (size_t)row * ldc + (col - coloff)) = v; } };
struct EpiGate {
    const float* rs2; const float* bias; const float* pp; float* h;
    DI void store4(int row, int col, f32x4 v) const {
        const size_t o = (size_t)row * DM + col;
        const float s = rs2[row];
        const f32x4 bb = *(const f32x4*)(bias + col), p4 = *(const f32x4*)(pp + o);
        f32x4 hv = *(f32x4*)(h + o);
#pragma unroll
        for (int j = 0; j < 4; ++j) hv[j] += sigmoidf_(v[j] * s + bb[j]) * p4[j];
        *(f32x4*)(h + o) = hv;
    }
};
DI float wave_sum(float v) {
#pragma unroll
    for (int o = 32; o > 0; o >>= 1) v += __shfl_xor(v, o);
    return v;
}
DI float wave_max(float v) {
#pragma unroll
    for (int o = 32; o > 0; o >>= 1) v = fmaxf(v, __shfl_xor(v, o));
    return v;
}
DI float block_sum256(float v, float* red) {
    v = wave_sum(v); __syncthreads();
    if ((threadIdx.x & 63) == 0) red[threadIdx.x >> 6] = v; __syncthreads();
    return (red[0] + red[1]) + (red[2] + red[3]);
}
DI float block_max256(float v, float* red) {
    v = wave_max(v); __syncthreads();
    if ((threadIdx.x & 63) == 0) red[threadIdx.x >> 6] = v; __syncthreads();
    return fmaxf(fmaxf(red[0], red[1]), fmaxf(red[2], red[3]));
}

#define XB_TMO      128
#define XB_XCNT(j)  (256  + 64 * (j))
#define XB_XSUB(j)  (1280 + 64 * (j))
#define XB_XGEN(j)  (2304 + 64 * (j))
#define XB_TOP      3328
#define XB_TOPGEN   3392
#define XCD_BAR_WORDS 3456
#define XB_SPIN_CAP (1u << 18)
#define LAS __attribute__((address_space(3)))

__device__ __forceinline__ unsigned xb_ld(unsigned* p)              { return __hip_atomic_load(p, __ATOMIC_RELAXED, __HIP_MEMORY_SCOPE_AGENT); }
__device__ __forceinline__ float xb_ldf(const float* p)            { return __hip_atomic_load(p, __ATOMIC_RELAXED, __HIP_MEMORY_SCOPE_AGENT); }
__device__ __forceinline__ unsigned xb_add(unsigned* p, unsigned v) { return __hip_atomic_fetch_add(p, v, __ATOMIC_RELAXED, __HIP_MEMORY_SCOPE_AGENT); }
__device__ __forceinline__ unsigned xb_xcc_id() { return (unsigned)__builtin_amdgcn_s_getreg((3 << 11) | 20) & 0xFu; }
#define XB_SPIN(cond, bar) do { unsigned _sp = 0; while (cond) { __builtin_amdgcn_s_sleep(1); \
    if ((++_sp & 255u) == 0u) { if (xb_ld(&(bar)[XB_TMO])) break; if (_sp > XB_SPIN_CAP) { atomicAdd(&(bar)[XB_TMO], 1u); break; } } } } while (0)

struct XcdBarrier {
    unsigned* bar; unsigned x;
    volatile LAS unsigned* st;
};

__device__ __forceinline__ XcdBarrier xcd_barrier_post(unsigned* bar, volatile LAS unsigned* st) {
    XcdBarrier b; b.bar = bar; b.x = xb_xcc_id(); b.st = st;
    if (threadIdx.x == 0) (void)xb_add(&bar[XB_XCNT(b.x)], 1u);
    return b;
}
__device__ __forceinline__ void xcd_barrier_complete(unsigned* bar, unsigned x, unsigned& nloc, unsigned& nx) {
    const unsigned G = gridDim.x * gridDim.y * gridDim.z;
    unsigned sum, cnt, mine, sp = 0u;
    for (;;) {
        sum = 0u; cnt = 0u; mine = 0u;
#pragma unroll
        for (unsigned j = 0; j < 16; ++j) { const unsigned c = xb_ld(&bar[XB_XCNT(j)]); sum += c; cnt += (c > 0u) ? 1u : 0u; mine = (j == x) ? c : mine; }
        if (sum == G) break;
        __builtin_amdgcn_s_sleep(1);
        if ((++sp & 255u) == 0u) { if (xb_ld(&bar[XB_TMO])) break; if (sp > XB_SPIN_CAP) { atomicAdd(&bar[XB_TMO], 1u); break; } }
    }
    nloc = mine > 0u ? mine : 1u; nx = cnt > 0u ? cnt : 1u;
}

__device__ __forceinline__ void xcd_barrier(const XcdBarrier& b) {
    asm volatile("s_waitcnt vmcnt(0)" ::: "memory");
    __syncthreads();
    if (threadIdx.x == 0) {
        unsigned* bar = b.bar;
        __builtin_amdgcn_s_waitcnt(0);
        unsigned nloc = b.st[0], nx = b.st[1];
        if (nloc == 0u) { xcd_barrier_complete(bar, b.x, nloc, nx); b.st[0] = nloc; b.st[1] = nx; }
        const unsigned old = xb_add(&bar[XB_XSUB(b.x)], 1u);
        const unsigned gen = old / nloc;
        if (old + 1u == (gen + 1u) * nloc) {
            __builtin_amdgcn_fence(__ATOMIC_RELEASE, "agent");
            asm volatile("s_waitcnt vmcnt(0)" ::: "memory");
            const unsigned og = xb_add(&bar[XB_TOP], 1u);
            const unsigned tg = og / nx;
            if (og + 1u == (tg + 1u) * nx) xb_add(&bar[XB_TOPGEN], 1u);
            else XB_SPIN(xb_ld(&bar[XB_TOPGEN]) == tg, bar);
            __builtin_amdgcn_fence(__ATOMIC_ACQUIRE, "agent");
            xb_add(&bar[XB_XGEN(b.x)], 1u);
            asm volatile("s_waitcnt vmcnt(0)" ::: "memory");
        } else {
            XB_SPIN(xb_ld(&bar[XB_XGEN(b.x)]) == gen, bar);
            __builtin_amdgcn_fence(__ATOMIC_ACQUIRE, "agent");
            asm volatile("s_waitcnt vmcnt(0)" ::: "memory");
        }
    }
    __syncthreads();
}


namespace pg8 {
#define PG8_LAS __attribute__((address_space(3)))
typedef short bf16x8 __attribute__((ext_vector_type(8)));
constexpr int BM = 256, BK = 64, HALF = 128, HTB = HALF * BK * 2  , STAGE_BYTES = 8 * HTB, NXCD = 8, WGM = 8;

__host__ __device__ __forceinline__ int lds_byte(int r, int c) { const int st = (r >> 4) * 2 + (c >> 5), rr = r & 15, cc = c & 31, ob = rr * 64 + cc * 2; return st * 1024 + (ob ^ (((ob >> 9) & 1) << 5)); }
__host__ __device__ __forceinline__ void stage_rc(int b, int& R, int& C) { const int st = b / 1024, sb = b % 1024, swz = sb ^ (((sb >> 9) & 1) << 5); R = (st >> 1) * 16 + swz / 64; C = (st & 1) * 32 + (swz % 64) / 2; }
__host__ __device__ __forceinline__ int perm32(int rho) { const int n = rho >> 4, i = rho & 15; return 8 * (i >> 2) + 4 * n + (i & 3); }

struct Unit { int pm, pn; };
struct Gemm { const bf16_t* A; const bf16_t* Bt; int M, N, K; };

struct StaticOrder {
    int nM, nN, nwg, G, c;
    __host__ __device__ void init(int M, int N, int G_, int c_) { nM = M / BM; nN = N / BM; nwg = nM * nN; G = G_; c = c_; }
    __host__ __device__ bool next(int i, Unit& u) const {
        const long L = (long)i * G + c; if (L >= nwg) return false;
        int wgid = (int)L; { const int q = nwg / NXCD, r = nwg % NXCD, xcd = wgid % NXCD, off = wgid / NXCD; wgid = (xcd < r ? xcd * (q + 1) : r * (q + 1) + (xcd - r) * q) + off; }
        const int nig = WGM * nN, gid = wgid / nig, fm = gid * WGM, gsz = (nM - fm) < WGM ? (nM - fm) : WGM;
        u.pm = fm + ((wgid % nig) % gsz); u.pn = (wgid % nig) / gsz; return true;
    }
    __device__ __forceinline__ void a_ready(const Unit&) const {}
    __device__ __forceinline__ void done(const Unit&) const {}
};
template <class Epi, class Sched, bool STAMP = false>
__device__ __forceinline__ void gemm_phase(PG8_LAS unsigned char* lds, const Gemm g, const Sched& S, const Epi& E, unsigned long long* stamps) {
    int tid_ = threadIdx.x; asm volatile("" : "+v"(tid_));
    const int tid = tid_, wid = __builtin_amdgcn_readfirstlane(tid >> 6), lane = tid & 63, wr = wid >> 2, wc = wid & 3, fr = lane & 15, fq = lane >> 4;
    const int K = g.K, nt = K / BK;
    int ts_lo = 0, ts_hi = 0, nts = 0; const unsigned long long rt_entry = STAMP ? (unsigned long long)wall_clock64() : 0ull;
#define PG8_STAMP() do { if (STAMP && wid == 0 && nts < 64) { const unsigned long long _c = (unsigned long long)clock64(); \
        ts_lo = (lane == nts) ? (int)(unsigned)_c : ts_lo; ts_hi = (lane == nts) ? (int)(unsigned)(_c >> 32) : ts_hi; ++nts; } } while (0)
    PG8_STAMP();
    unsigned voffA[2], voffB[2];
#pragma unroll
    for (int i = 0; i < 2; ++i) { int R, C; stage_rc(tid * 16 + i * 8192, R, C); const int Rb = Epi::PERM ? ((R & ~31) + perm32(R & 31)) : R;
        voffA[i] = (unsigned)(R * K + C) * 2u; voffB[i] = (unsigned)(Rb * K + C) * 2u; }
    const size_t kstep = (size_t)(BK * 2);
    const size_t hstep = (size_t)HALF * K * 2;
    const size_t tstep = 2 * hstep;
    const unsigned ldsw = (unsigned)wid * 1024u;
    const int aoff = lds_byte(wr * 64 + fr, fq * 8), boff = lds_byte(wc * 32 + fr, fq * 8);
#define PG8_SA(b, h) (((b) * 2 + (h)) * HTB)
#define PG8_SB(b, h) ((4 + (b) * 2 + (h)) * HTB)
#define PG8_STAGE(bufoff, gbase, voff) do { _Pragma("unroll") for (int _i = 0; _i < 2; ++_i) \
        __builtin_amdgcn_global_load_lds((const unsigned*)((const char*)(gbase) + (voff)[_i]), (PG8_LAS unsigned*)(lds + (bufoff) + ldsw + _i * 8192), 16, 0, 0); } while (0)
#define PG8_LDA(dst, b, h) do { _Pragma("unroll") for (int m = 0; m < 4; ++m) _Pragma("unroll") for (int k = 0; k < 2; ++k) dst[m][k] = *(const PG8_LAS bf16x8*)(lds + PG8_SA(b, h) + aoff + m * 2048 + k * 1024); } while (0)
#define PG8_LDB(dst, b, h) do { _Pragma("unroll") for (int n = 0; n < 2; ++n) _Pragma("unroll") for (int k = 0; k < 2; ++k) dst[n][k] = *(const PG8_LAS bf16x8*)(lds + PG8_SB(b, h) + boff + n * 2048 + k * 1024); } while (0)
#define PG8_MMA(ai, bj, At, Bt) do { __builtin_amdgcn_s_setprio(1); _Pragma("unroll") for (int m = 0; m < 4; ++m) _Pragma("unroll") for (int n = 0; n < 2; ++n) _Pragma("unroll") for (int k = 0; k < 2; ++k) \
        acc[ai][bj][m][n] = __builtin_amdgcn_mfma_f32_16x16x32_bf16(Bt[n][k], At[m][k], acc[ai][bj][m][n], 0, 0, 0); __builtin_amdgcn_s_setprio(0); } while (0)
#define PG8_WAIT_V(n) asm volatile("s_waitcnt vmcnt(" #n ")" ::: "memory")
#define PG8_WAIT_L(n) asm volatile("s_waitcnt lgkmcnt(" #n ")" ::: "memory")
#define PG8_BAR __builtin_amdgcn_s_barrier()
#define PG8_SCHED __builtin_amdgcn_sched_barrier(0)
    Unit cur, nxt; int ui = 0;
    if (!S.next(0, cur)) return;
    f32x4 acc[2][2][4][2];
#pragma unroll
    for (int a = 0; a < 2; ++a)
#pragma unroll
        for (int b = 0; b < 2; ++b)
#pragma unroll
            for (int m = 0; m < 4; ++m)
#pragma unroll
                for (int n = 0; n < 2; ++n) acc[a][b][m][n] = (f32x4){0.f, 0.f, 0.f, 0.f};
    bf16x8 At[4][2], B0[2][2], B1[2][2];
    const char* cA = (const char*)g.A + (size_t)cur.pm * tstep; const char* cB = (const char*)g.Bt + (size_t)cur.pn * tstep;
    S.a_ready(cur);
    PG8_STAGE(PG8_SB(0, 0), cB, voffB); PG8_STAGE(PG8_SA(0, 0), cA, voffA); PG8_STAGE(PG8_SB(0, 1), cB + hstep, voffB); PG8_STAGE(PG8_SA(0, 1), cA + hstep, voffA);
    if (wr == 1) PG8_BAR;
    PG8_WAIT_V(4); PG8_BAR;
    PG8_STAGE(PG8_SB(1, 0), cB + kstep, voffB); PG8_STAGE(PG8_SA(1, 0), cA + kstep, voffA); PG8_STAGE(PG8_SB(1, 1), cB + hstep + kstep, voffB);
    PG8_WAIT_V(6); PG8_BAR;
    PG8_STAMP();
    for (;;) {
        const bool has_next = S.next(ui + 1, nxt);
        const char* nA = has_next ? (const char*)g.A + (size_t)nxt.pm * tstep : cA; const char* nB = has_next ? (const char*)g.Bt + (size_t)nxt.pn * tstep : cB;
        for (int t = 0; t < nt; t += 2) {
            const bool last = (t == nt - 2);
            const char* a1 = cA + (size_t)(t + 1) * kstep;
            const char* a2 = last ? nA : cA + (size_t)(t + 2) * kstep; const char* b2 = last ? nB : cB + (size_t)(t + 2) * kstep;
            const char* a3 = a2 + kstep; const char* b3 = b2 + kstep;
            if (last && has_next) S.a_ready(nxt);
            PG8_LDB(B0, 0, 0); PG8_SCHED; PG8_LDA(At, 0, 0); PG8_STAGE(PG8_SA(1, 1), a1 + hstep, voffA);
            PG8_WAIT_L(8); PG8_BAR; PG8_WAIT_L(0); PG8_MMA(0, 0, At, B0); PG8_BAR; PG8_SCHED;
            PG8_LDB(B1, 0, 1); PG8_STAGE(PG8_SB(0, 0), b2, voffB);
            PG8_BAR; PG8_WAIT_L(0); PG8_MMA(0, 1, At, B1); PG8_BAR;
            PG8_LDA(At, 0, 1); PG8_STAGE(PG8_SA(0, 0), a2, voffA);
            PG8_BAR; PG8_WAIT_L(0); PG8_MMA(1, 0, At, B0); PG8_BAR; PG8_SCHED;
            PG8_STAGE(PG8_SB(0, 1), b2 + hstep, voffB);
            PG8_WAIT_V(6); PG8_BAR; PG8_MMA(1, 1, At, B1); PG8_BAR;
            PG8_LDB(B0, 1, 0); PG8_SCHED; PG8_LDA(At, 1, 0); PG8_STAGE(PG8_SA(0, 1), a2 + hstep, voffA);
            PG8_WAIT_L(8); PG8_BAR; PG8_WAIT_L(0); PG8_MMA(0, 0, At, B0); PG8_BAR; PG8_SCHED;
            PG8_LDB(B1, 1, 1); PG8_STAGE(PG8_SB(1, 0), b3, voffB);
            PG8_BAR; PG8_WAIT_L(0); PG8_MMA(0, 1, At, B1); PG8_BAR;
            PG8_LDA(At, 1, 1); PG8_STAGE(PG8_SA(1, 0), a3, voffA);
            PG8_BAR; PG8_WAIT_L(0); PG8_MMA(1, 0, At, B0); PG8_BAR; PG8_SCHED;
            PG8_STAGE(PG8_SB(1, 1), b3 + hstep, voffB);
            PG8_WAIT_V(6); PG8_BAR; PG8_MMA(1, 1, At, B1); PG8_BAR;
        }
        PG8_STAMP();
        if constexpr (!Epi::AFTER_DRAIN) { E(acc, cur, wr, wc, fr, fq); S.done(cur); }
        PG8_STAMP();
        if (!has_next) break;
#pragma unroll
        for (int a = 0; a < 2; ++a)
#pragma unroll
            for (int b = 0; b < 2; ++b)
#pragma unroll
                for (int m = 0; m < 4; ++m)
#pragma unroll
                    for (int n = 0; n < 2; ++n) acc[a][b][m][n] = (f32x4){0.f, 0.f, 0.f, 0.f};
        cur = nxt; cA = nA; cB = nB; ++ui;
    }
    PG8_WAIT_V(0);
    if (wr == 0) PG8_BAR;
    PG8_BAR;
    if constexpr (Epi::AFTER_DRAIN) { E.fused(acc, cur, wr, wc, fr, fq, lds, wid, lane); S.done(cur); }
    PG8_STAMP();
    if (STAMP && wid == 0) { stamps[lane] = lane < nts ? (((unsigned long long)(unsigned)ts_hi << 32) | (unsigned)ts_lo) : 0ull;
        if (lane == 62) stamps[62] = rt_entry; if (lane == 63) stamps[63] = (unsigned long long)wall_clock64(); }
#undef PG8_STAMP
#undef PG8_SA
#undef PG8_SB
#undef PG8_STAGE
#undef PG8_LDA
#undef PG8_LDB
#undef PG8_MMA
#undef PG8_WAIT_V
#undef PG8_WAIT_L
#undef PG8_BAR
#undef PG8_SCHED
}
}
#define LAS3 __attribute__((address_space(3)))
constexpr int MK_THREADS = 512;
constexpr float U4_ISCALE = 83.0f;
typedef __bf16 bf16x2_t __attribute__((ext_vector_type(2)));
DI float dot2bf(unsigned a, unsigned b, float c) { return __builtin_amdgcn_fdot2_f32_bf16(__builtin_bit_cast(bf16x2_t, a), __builtin_bit_cast(bf16x2_t, b), c, false); }
DI float bflo(unsigned v) { return __uint_as_float(v << 16); }
DI float bfhi(unsigned v) { return __uint_as_float(v & 0xffff0000u); }

template <class ColMap>
DI void transpose_tile(const float* __restrict__ src, int ldsrc, const float* __restrict__ gain, bf16_t* __restrict__ dst, int K, int k0, int n0, const ColMap& cm, LAS3 float* tl) {
    const int tid = threadIdx.x;
    __syncthreads();
    {
        const int n = tid & 63, sc = cm(n0 + n);
#pragma unroll
        for (int j = 0; j < 8; ++j) { const int k = (tid >> 6) + 8 * j; tl[k * 65 + n] = sc >= 0 ? src[(size_t)(k0 + k) * ldsrc + sc] * (gain ? gain[k0 + k] : 1.0f) : 0.f; }
    }
    __syncthreads();
    {
        const int n = tid >> 3, k8 = (tid & 7) * 8;
        u32x4 w;
        w.x = pack2bf(tl[(k8 + 0) * 65 + n], tl[(k8 + 1) * 65 + n]); w.y = pack2bf(tl[(k8 + 2) * 65 + n], tl[(k8 + 3) * 65 + n]);
        w.z = pack2bf(tl[(k8 + 4) * 65 + n], tl[(k8 + 5) * 65 + n]); w.w = pack2bf(tl[(k8 + 6) * 65 + n], tl[(k8 + 7) * 65 + n]);
        *(u32x4*)(dst + (size_t)(n0 + n) * K + k0 + k8) = w;
    }
}
template <class ColMap, bool FRAG = false>
DI void transpose_tile_wave(const float* __restrict__ src, int ldsrc, const float* __restrict__ gain, bf16_t* __restrict__ dst, int K, int k0, int n0, const ColMap& cm, LAS3 float* tl, int lane) {
    const int sc = cm(n0 + lane);
    float v[64];
#pragma unroll
    for (int k = 0; k < 64; ++k) v[k] = sc >= 0 ? src[(size_t)(k0 + k) * ldsrc + sc] : 0.f;
    if (gain) {
        const float gl = gain[k0 + lane];
#pragma unroll
        for (int k = 0; k < 64; ++k) v[k] *= __uint_as_float(__builtin_amdgcn_readlane(__float_as_uint(gl), k));
    }
#pragma unroll
    for (int k = 0; k < 64; ++k) tl[k * 65 + lane] = v[k];
    const int nl = lane >> 3, k8 = (lane & 7) * 8;
#pragma unroll
    for (int ps = 0; ps < 8; ++ps) {
        const int n = nl + 8 * ps;
        u32x4 w;
        w.x = pack2bf(tl[(k8 + 0) * 65 + n], tl[(k8 + 1) * 65 + n]); w.y = pack2bf(tl[(k8 + 2) * 65 + n], tl[(k8 + 3) * 65 + n]);
        w.z = pack2bf(tl[(k8 + 4) * 65 + n], tl[(k8 + 5) * 65 + n]); w.w = pack2bf(tl[(k8 + 6) * 65 + n], tl[(k8 + 7) * 65 + n]);
        if (FRAG) { const int nn = n0 + n, kk = k0 + k8; *(u32x4*)(dst + ((((size_t)(nn >> 4) * (K / 32) + (kk >> 5)) * 64) + ((nn & 15) + 16 * ((kk >> 3) & 3))) * 8) = w; }
        else *(u32x4*)(dst + (size_t)(n0 + n) * K + k0 + k8) = w;
    }
}
struct ColId { DI int operator()(int n) const { return n; } };
struct ColWin { DI int operator()(int n) const { return n < PC_XR ? n : (n < PC_XG ? 1304 + (n - PC_XR) : (n < PC_GATE ? 1816 + (n - PC_XG) : (n < PC_GATE + 24 ? 1280 + (n - PC_GATE) : -1))); } };

DI void cvt_rows_bf16(const float* __restrict__ src, const float* __restrict__ gain, bf16_t* __restrict__ dst, size_t n8, int cols, size_t gtid, size_t nthr) {
    for (size_t i0 = gtid; i0 < n8; i0 += 8 * nthr) {
        f32x4 a[8], b[8];
#pragma unroll
        for (int u = 0; u < 8; ++u) { const size_t i = i0 + u * nthr; if (i < n8) { a[u] = *(const f32x4*)(src + i * 8); b[u] = *(const f32x4*)(src + i * 8 + 4); } }
#pragma unroll
        for (int u = 0; u < 8; ++u) { const size_t i = i0 + u * nthr; if (i < n8) {
            f32x4 x = a[u], y = b[u];
            if (gain) { const int c = (int)((i * 8) % cols); x *= *(const f32x4*)(gain + c); y *= *(const f32x4*)(gain + c + 4); }
            u32x4 w; w.x = pack2bf(x[0], x[1]); w.y = pack2bf(x[2], x[3]); w.z = pack2bf(y[0], y[1]); w.w = pack2bf(y[2], y[3]);
            *(u32x4*)(dst + i * 8) = w; } }
    }
}
DI void cvt_rows_i4(const float* __restrict__ src, const float* __restrict__ gain, float scale, unsigned char* __restrict__ dst, size_t n8, int cols, size_t gtid, size_t nthr) {
    for (size_t i0 = gtid; i0 < n8; i0 += 8 * nthr) {
        f32x4 a[8], b[8];
#pragma unroll
        for (int u = 0; u < 8; ++u) { const size_t i = i0 + u * nthr; if (i < n8) { a[u] = *(const f32x4*)(src + i * 8); b[u] = *(const f32x4*)(src + i * 8 + 4); } }
#pragma unroll
        for (int u = 0; u < 8; ++u) { const size_t i = i0 + u * nthr; if (i < n8) {
            f32x4 x = a[u], y = b[u];
            if (gain) { const int c = (int)((i * 8) % cols); x *= *(const f32x4*)(gain + c); y *= *(const f32x4*)(gain + c + 4); }
            unsigned w = 0u;
#pragma unroll
            for (int j = 0; j < 4; ++j) {
                const int qa = (int)rintf(fminf(fmaxf(x[j] * scale, -7.f), 7.f)), qb = (int)rintf(fminf(fmaxf(y[j] * scale, -7.f), 7.f));
                w |= ((unsigned)qa & 0xfu) << (4 * j); w |= ((unsigned)qb & 0xfu) << (16 + 4 * j);
            }
            { const unsigned n1 = __shfl_down(w, 1), n2 = __shfl_down(w, 2), n3 = __shfl_down(w, 3); if ((threadIdx.x & 3) == 0) *(u32x4*)(dst + i * 4) = (u32x4){w, n1, n2, n3}; } } }
    }
}
DI void cvt_rows_fp4(const float* __restrict__ src, const float* __restrict__ gain, float scale, unsigned char* __restrict__ dst, size_t n8, int cols, size_t gtid, size_t nthr) {
    for (size_t i0 = gtid; i0 < n8; i0 += 8 * nthr) {
        f32x4 a[8], b[8];
#pragma unroll
        for (int u = 0; u < 8; ++u) { const size_t i = i0 + u * nthr; if (i < n8) { a[u] = *(const f32x4*)(src + i * 8); b[u] = *(const f32x4*)(src + i * 8 + 4); } }
#pragma unroll
        for (int u = 0; u < 8; ++u) { const size_t i = i0 + u * nthr; if (i < n8) {
            f32x4 x = a[u], y = b[u];
            if (gain) { const int c = (int)((i * 8) % cols); x *= *(const f32x4*)(gain + c); y *= *(const f32x4*)(gain + c + 4); }
            x *= scale; y *= scale;
            unsigned w = 0u;
            w = __builtin_amdgcn_cvt_scalef32_pk_fp4_f32(w, x[0], x[1], 1.0f, 0); w = __builtin_amdgcn_cvt_scalef32_pk_fp4_f32(w, x[2], x[3], 1.0f, 1);
            w = __builtin_amdgcn_cvt_scalef32_pk_fp4_f32(w, y[0], y[1], 1.0f, 2); w = __builtin_amdgcn_cvt_scalef32_pk_fp4_f32(w, y[2], y[3], 1.0f, 3);
            { const unsigned n1 = __shfl_down(w, 1), n2 = __shfl_down(w, 2), n3 = __shfl_down(w, 3); if ((threadIdx.x & 3) == 0) *(u32x4*)(dst + i * 4) = (u32x4){w, n1, n2, n3}; } } }
    }
}
DI void p1_deferred(const Params& p, int G) {
    const int nunits = (NTOK / 256) * (NPROJ / 256), nfull = nunits % G;
    const int first = nfull == 0 ? 0 : nfull, nwg = G - first;
    if ((int)blockIdx.x < first) return;
    const size_t gtid = (size_t)(blockIdx.x - first) * MK_THREADS + threadIdx.x, nthr = (size_t)nwg * MK_THREADS;
    if (gtid < 512) {
        const float* part = (const float*)(p.ws + WS_HID) + (gtid >> 8) * 32 * 256 + (gtid & 255);
        float a = 0.f;
#pragma unroll
        for (int k = 0; k < 32; ++k) a += part[k * 256];
        ((float*)(p.ws + ((gtid >> 8) ? WS_CBV : WS_CBK)))[gtid & 255] = a;
    }
    cvt_rows_i4(p.in[I_PEER_U], p.in[I_FFN_NORM], U4_ISCALE, (unsigned char*)(p.ws + WS_UB), (size_t)16384 * DM / 8, DM, gtid, nthr);
    cvt_rows_bf16(p.in[I_P], nullptr, (bf16_t*)(p.ws + WS_PB), (size_t)NTOK * PLE / 8, PLE, gtid, nthr);
}
DI void p0_prologue(const Params& p, LAS3 unsigned char* lds, int G) {
    unsigned char* ws = p.ws;
    const int tid = threadIdx.x, lane = tid & 63, wid = tid >> 6, bid = blockIdx.x;
    const size_t gtid = (size_t)bid * MK_THREADS + tid, nthr = (size_t)G * MK_THREADS;
    const int gw = bid * 8 + wid, nw = G * 8;
    {
        const float* x = p.in[I_X]; bf16_t* xb = (bf16_t*)(ws + WS_XB); float* rs0 = (float*)(ws + WS_RS0);
        for (int row0 = gw; row0 < NTOK; row0 += 4 * nw) {
            f32x4 v[4][4];
#pragma unroll
            for (int u = 0; u < 4; ++u) { const int row = row0 + u * nw; if (row < NTOK) { const float* xr_ = x + (size_t)row * DM + lane * 8;
                v[u][0] = *(const f32x4*)xr_; v[u][1] = *(const f32x4*)(xr_ + 4); v[u][2] = *(const f32x4*)(xr_ + 512); v[u][3] = *(const f32x4*)(xr_ + 516); } }
#pragma unroll
            for (int u = 0; u < 4; ++u) { const int row = row0 + u * nw; if (row < NTOK) {
                float s = 0.f;
#pragma unroll
                for (int j = 0; j < 4; ++j) s += (v[u][j][0] * v[u][j][0] + v[u][j][1] * v[u][j][1]) + (v[u][j][2] * v[u][j][2] + v[u][j][3] * v[u][j][3]);
                s = wave_sum(s);
                u32x4 w0, w1;
                w0.x = pack2bf(v[u][0][0], v[u][0][1]); w0.y = pack2bf(v[u][0][2], v[u][0][3]); w0.z = pack2bf(v[u][1][0], v[u][1][1]); w0.w = pack2bf(v[u][1][2], v[u][1][3]);
                w1.x = pack2bf(v[u][2][0], v[u][2][1]); w1.y = pack2bf(v[u][2][2], v[u][2][3]); w1.z = pack2bf(v[u][3][0], v[u][3][1]); w1.w = pack2bf(v[u][3][2], v[u][3][3]);
                *(u32x4*)(xb + (size_t)row * DM + lane * 8) = w0; *(u32x4*)(xb + (size_t)row * DM + 512 + lane * 8) = w1;
                if (lane == 0) rs0[row] = rsqrtf(s * (1.0f / DM) + EPS); } }
        }
    }
    cvt_rows_fp4(p.in[I_PEER_V], nullptr, 8.0f, (unsigned char*)(ws + WS_VB), (size_t)16384 * DM / 8, DM, gtid, nthr);
    {
        LAS3 float* tl = (LAS3 float*)lds + wid * (64 * 65);
        for (int u = gw; u < 1496; u += nw) {
            if (u < 640) transpose_tile_wave(p.in[I_W_IN], INCOLS, p.in[I_ATTN_NORM], (bf16_t*)(ws + WS_WIN), DM, (u % 16) * 64, (u / 16) * 64, ColWin{}, tl, lane);
            else if (u < 896) { const int v = u - 640; transpose_tile_wave(p.in[I_W_OUT], DM, nullptr, (bf16_t*)(ws + WS_WOUT), DM, (v % 16) * 64, (v / 16) * 64, ColId{}, tl, lane); }
            else if (u < 1152) { const int v = u - 896; transpose_tile_wave(p.in[I_PLE_WG], DM, p.in[I_PLE_NORM], (bf16_t*)(ws + WS_WG), DM, (v % 16) * 64, (v / 16) * 64, ColId{}, tl, lane); }
            else if (u < 1216) { const int v = u - 1152; transpose_tile_wave(p.in[I_PLE_PROJ], DM, nullptr, (bf16_t*)(ws + WS_WP), PLE, (v % 4) * 64, (v / 4) * 64, ColId{}, tl, lane); }
            else if (u < 1344) { const int v = u - 1216; transpose_tile_wave<ColId, true>(p.in[I_CK_W1], 256, nullptr, (bf16_t*)(ws + WS_CW1K), 2048, (v % 32) * 64, (v / 32) * 64, ColId{}, tl, lane); }
            else if (u < 1472) { const int v = u - 1344; transpose_tile_wave<ColId, true>(p.in[I_CV_W1], 256, nullptr, (bf16_t*)(ws + WS_CW1V), 2048, (v % 32) * 64, (v / 32) * 64, ColId{}, tl, lane); }
            else if (u < 1480) { const int v = u - 1472; transpose_tile_wave(p.in[I_LRU_WA] + v * 4096, 64, nullptr, (bf16_t*)(ws + WS_WAT) + v * 4096, 64, 0, 0, ColId{}, tl, lane); }
            else if (u < 1488) { const int v = u - 1480; transpose_tile_wave(p.in[I_LRU_WX] + v * 4096, 64, nullptr, (bf16_t*)(ws + WS_WXT) + v * 4096, 64, 0, 0, ColId{}, tl, lane); }
            else if (u < 1492) { const int v = u - 1488; transpose_tile_wave(p.in[I_CK_W2], 64, nullptr, (bf16_t*)(ws + WS_CW2K), 256, v * 64, 0, ColId{}, tl, lane); }
            else { const int v = u - 1492; transpose_tile_wave(p.in[I_CV_W2], 64, nullptr, (bf16_t*)(ws + WS_CW2V), 256, v * 64, 0, ColId{}, tl, lane); }
        }
        __syncthreads();
    }
    {
        LAS3 float* wt = (LAS3 float*)lds;
        LAS3 float* st = (LAS3 float*)(lds + 32768);
        const float* wq = p.in[I_PEER_WQ]; const float* sub = p.in[I_PEER_SUB]; const float* gain = p.in[I_FFN_NORM]; bf16_t* WqsT = (bf16_t*)(ws + WS_WQS);
        for (int u = bid; u < 256; u += G) {
            const int hp = u >> 4, d0 = (u & 15) * 64, pp = hp & 1;
            __syncthreads();
            {
                f32x4 wv[4], sv[8];
#pragma unroll
                for (int u = 0; u < 4; ++u) { const int i = tid + u * MK_THREADS, d = i >> 5, dk4 = (i & 31) * 4; wv[u] = *(const f32x4*)(wq + (size_t)(d0 + d) * 2048 + hp * 128 + dk4); }
#pragma unroll
                for (int u = 0; u < 8; ++u) { const int i = tid + u * MK_THREADS, kk = i >> 5, dk4 = (i & 31) * 4; sv[u] = *(const f32x4*)(sub + ((size_t)pp * 128 + kk) * 128 + dk4); }
#pragma unroll
                for (int u = 0; u < 4; ++u) { const int i = tid + u * MK_THREADS, d = i >> 5, dk4 = (i & 31) * 4;
#pragma unroll
                    for (int j = 0; j < 4; ++j) wt[(dk4 + j) * 64 + d] = wv[u][j]; }
#pragma unroll
                for (int u = 0; u < 8; ++u) { const int i = tid + u * MK_THREADS, kk = i >> 5, dk4 = (i & 31) * 4;
#pragma unroll
                    for (int j = 0; j < 4; ++j) st[kk * 129 + dk4 + j] = sv[u][j]; }
            }
            __syncthreads();
            {
                typedef float f32x16_ __attribute__((ext_vector_type(16)));
                const int kk0 = (wid & 3) * 32, dd0 = (wid >> 2) * 32, r = lane & 31, hf = lane >> 5;
                f32x16_ acc;
#pragma unroll
                for (int i = 0; i < 16; ++i) acc[i] = 0.f;
#pragma unroll 8
                for (int i = 0; i < 64; ++i) acc = __builtin_amdgcn_mfma_f32_32x32x2f32(st[(kk0 + r) * 129 + 2 * i + hf], wt[(2 * i + hf) * 64 + dd0 + r], acc, 0, 0, 0);
                const float gd = gain[d0 + dd0 + r];
#pragma unroll
                for (int i = 0; i < 16; ++i) {
                    const int kk = kk0 + (i & 3) + 8 * (i >> 2) + 4 * hf;
                    WqsT[(size_t)(hp * 128 + kk) * DM + d0 + dd0 + r] = f2bf(acc[i] * gd);
                }
            }
        }
        __syncthreads();
    }
    for (int o = gw; o < 256; o += nw) {
        const int kv = o >> 7, jg = (o >> 5) & 3, kp = o & 31;
        const float* pe = p.in[kv ? I_CV_PE : I_CK_PE]; const float* w1 = p.in[kv ? I_CV_W1 : I_CK_W1];
        const float pel = pe[kp * 64 + lane];
        float wv[64];
#pragma unroll
        for (int i = 0; i < 64; ++i) wv[i] = w1[(size_t)(kp * 64 + i) * 256 + jg * 64 + lane];
        float acc = 0.f;
#pragma unroll
        for (int i = 0; i < 64; ++i) acc += __uint_as_float(__builtin_amdgcn_readlane(__float_as_uint(pel), i)) * wv[i];
        ((float*)(ws + WS_HID))[(kv * 32 + kp) * 256 + jg * 64 + lane] = acc;
    }
}

DI void p6_peer_apply(const Params& p, int G) {
    unsigned char* ws = p.ws;
    const int tid = threadIdx.x, lane = tid & 63, wid = tid >> 6;
    const int gw = blockIdx.x * 8 + wid, nw = G * 8;
    const bf16_t* ub = (const bf16_t*)(ws + WS_UB); const bf16_t* vb = (const bf16_t*)(ws + WS_VB);
    const int* eidx = (const int*)(ws + R_EXP); const float* gsm = (const float*)(ws + R_GSM); const float* ssq1 = (const float*)(ws + WS_SSQ1);
    float* h = p.out; bf16_t* hb = (bf16_t*)(ws + R_H1B); float* rs2 = (float*)(ws + WS_RS2);
    for (int tok = gw; tok < NTOK; tok += nw) {
        float sq = lane < 16 ? ssq1[(size_t)lane * NTOK + tok] : 0.f;
        sq = wave_sum(sq);
        const float rs1 = rsqrtf(sq * (1.0f / DM) + EPS);
        const u32x4 xa = *(const u32x4*)(hb + (size_t)tok * DM + lane * 8), xc = *(const u32x4*)(hb + (size_t)tok * DM + 512 + lane * 8);
        const int e0 = eidx[(size_t)tok * 128 + lane], e1 = eidx[(size_t)tok * 128 + 64 + lane];
        const float g0 = gsm[(size_t)tok * 128 + lane], g1 = gsm[(size_t)tok * 128 + 64 + lane];
        float coef0 = 0.f, coef1 = 0.f;
#pragma unroll
        for (int half = 0; half < 2; ++half) {
            const int ev = half ? e1 : e0;
            float part[64];
#pragma unroll
            for (int j = 0; j < 64; ++j) {
                const int e = __builtin_amdgcn_readlane(ev, j);
                const bf16_t* ur = ub + (size_t)e * DM + lane * 8;
                const u32x4 ua = *(const u32x4*)ur, uc = *(const u32x4*)(ur + 512);
                float a = dot2bf(xa.x, ua.x, 0.f); a = dot2bf(xa.y, ua.y, a); a = dot2bf(xa.z, ua.z, a); a = dot2bf(xa.w, ua.w, a);
                a = dot2bf(xc.x, uc.x, a); a = dot2bf(xc.y, uc.y, a); a = dot2bf(xc.z, uc.z, a); a = dot2bf(xc.w, uc.w, a);
                part[j] = a;
            }
#pragma unroll
            for (int m = 32; m >= 1; m >>= 1) {
                const bool up = (lane & m) != 0;
#pragma unroll
                for (int i = 0; i < m; ++i) {
                    const float send = up ? part[i] : part[i + m];
                    const float keep = up ? part[i + m] : part[i];
                    part[i] = keep + __shfl_xor(send, m);
                }
            }
            const float act = gelu_tanh(part[0] * rs1);
            if (half) coef1 = g1 * act; else coef0 = g0 * act;
        }
        float acc[16];
#pragma unroll
        for (int i = 0; i < 16; ++i) acc[i] = 0.f;
#pragma unroll
        for (int half = 0; half < 2; ++half) {
            const int ev = half ? e1 : e0; const float cv = half ? coef1 : coef0;
#pragma unroll 16
            for (int j = 0; j < 64; ++j) {
                const int e = __builtin_amdgcn_readlane(ev, j);
                const float c = __uint_as_float(__builtin_amdgcn_readlane(__float_as_uint(cv), j));
                const bf16_t* vr = vb + (size_t)e * DM + lane * 8;
                const u32x4 va = *(const u32x4*)vr, vc = *(const u32x4*)(vr + 512);
                acc[0] += c * bflo(va.x); acc[1] += c * bfhi(va.x); acc[2] += c * bflo(va.y); acc[3] += c * bfhi(va.y);
                acc[4] += c * bflo(va.z); acc[5] += c * bfhi(va.z); acc[6] += c * bflo(va.w); acc[7] += c * bfhi(va.w);
                acc[8] += c * bflo(vc.x); acc[9] += c * bfhi(vc.x); acc[10] += c * bflo(vc.y); acc[11] += c * bfhi(vc.y);
                acc[12] += c * bflo(vc.z); acc[13] += c * bfhi(vc.z); acc[14] += c * bflo(vc.w); acc[15] += c * bfhi(vc.w);
            }
        }
        float* hr = h + (size_t)tok * DM + lane * 8;
        f32x4 h0 = *(f32x4*)hr, h1 = *(f32x4*)(hr + 4), h2 = *(f32x4*)(hr + 512), h3 = *(f32x4*)(hr + 516);
        h0 += (f32x4){acc[0], acc[1], acc[2], acc[3]}; h1 += (f32x4){acc[4], acc[5], acc[6], acc[7]};
        h2 += (f32x4){acc[8], acc[9], acc[10], acc[11]}; h3 += (f32x4){acc[12], acc[13], acc[14], acc[15]};
        *(f32x4*)hr = h0; *(f32x4*)(hr + 4) = h1; *(f32x4*)(hr + 512) = h2; *(f32x4*)(hr + 516) = h3;
        u32x4 w0, w1;
        w0.x = pack2bf(h0[0], h0[1]); w0.y = pack2bf(h0[2], h0[3]); w0.z = pack2bf(h1[0], h1[1]); w0.w = pack2bf(h1[2], h1[3]);
        w1.x = pack2bf(h2[0], h2[1]); w1.y = pack2bf(h2[2], h2[3]); w1.z = pack2bf(h3[0], h3[1]); w1.w = pack2bf(h3[2], h3[3]);
        *(u32x4*)(hb + (size_t)tok * DM + lane * 8) = w0; *(u32x4*)(hb + (size_t)tok * DM + 512 + lane * 8) = w1;
        float s = 0.f;
#pragma unroll
        for (int j = 0; j < 4; ++j) s += h0[j] * h0[j] + h1[j] * h1[j] + h2[j] * h2[j] + h3[j] * h3[j];
        s = wave_sum(s);
        if (lane == 0) rs2[tok] = rsqrtf(s * (1.0f / DM) + EPS);
    }
}

DI void p8_final_norm(const Params& p, int G) {
    const int lane = threadIdx.x & 63, gw = blockIdx.x * 8 + (threadIdx.x >> 6), nw = G * 8;
    const float* ssq3 = (const float*)(p.ws + WS_SSQ3); const float* g = p.in[I_FINAL_NORM]; const bf16_t* h3 = (const bf16_t*)(p.ws + WS_XB); float* out = p.out;
    f32x4 gg[4];
    gg[0] = *(const f32x4*)(g + lane * 8); gg[1] = *(const f32x4*)(g + lane * 8 + 4); gg[2] = *(const f32x4*)(g + 512 + lane * 8); gg[3] = *(const f32x4*)(g + 512 + lane * 8 + 4);
    for (int row0 = gw; row0 < NTOK; row0 += 4 * nw) {
        u32x4 va[4], vb[4]; float sq[4];
#pragma unroll
        for (int u = 0; u < 4; ++u) { const int row = row0 + u * nw; if (row < NTOK) { sq[u] = lane < 16 ? ssq3[(size_t)lane * NTOK + row] : 0.f;
            va[u] = *(const u32x4*)(h3 + (size_t)row * DM + lane * 8); vb[u] = *(const u32x4*)(h3 + (size_t)row * DM + 512 + lane * 8); } }
#pragma unroll
        for (int u = 0; u < 4; ++u) { const int row = row0 + u * nw; if (row < NTOK) {
            const float rs = rsqrtf(wave_sum(sq[u]) * (1.0f / DM) + EPS);
            float* o = out + (size_t)row * DM + lane * 8;
            *(f32x4*)o = (f32x4){bflo(va[u].x), bfhi(va[u].x), bflo(va[u].y), bfhi(va[u].y)} * rs * gg[0];
            *(f32x4*)(o + 4) = (f32x4){bflo(va[u].z), bfhi(va[u].z), bflo(va[u].w), bfhi(va[u].w)} * rs * gg[1];
            *(f32x4*)(o + 512) = (f32x4){bflo(vb[u].x), bfhi(vb[u].x), bflo(vb[u].y), bfhi(vb[u].y)} * rs * gg[2];
            *(f32x4*)(o + 516) = (f32x4){bflo(vb[u].z), bfhi(vb[u].z), bflo(vb[u].w), bfhi(vb[u].w)} * rs * gg[3]; } }
    }
}
typedef float f32x16 __attribute__((ext_vector_type(16)));
typedef short bf16x8v __attribute__((ext_vector_type(8)));
typedef short s16x4v __attribute__((ext_vector_type(4)));
typedef __bf16 bf16x2v_ __attribute__((ext_vector_type(2)));
DI unsigned pk_bf16(float lo, float hi) { return __builtin_bit_cast(unsigned, __builtin_convertvector((f32x2){lo, hi}, bf16x2v_)); }
constexpr float LOG2E = 1.4426950408889634f;
constexpr int AT_KROW = 128, AT_VROW = 128;
constexpr int AT_KT = 64 * AT_KROW, AT_VT = 64 * AT_VROW, AT_BUF = 2 * AT_KT + 2 * AT_VT;
constexpr int AT_VAL = 0;
constexpr int AT_LUT = 2 * AT_BUF;
constexpr int AT_IMP = AT_LUT + 8 * 128 * 4;
constexpr int AT_SEL = AT_IMP + 8 * 32 * 65 * 4;
constexpr int AT_SSQ = AT_SEL + 512;
constexpr int AT_END = AT_SSQ + 1024;
static_assert(AT_END <= 160 * 1024 - 256, "attention LDS map");

struct AtSrc { const bf16_t* k0; const bf16_t* v0; int kvstride; };
struct AtDma { const unsigned char* base; int voffE, voffO, ldsoff; };
DI AtDma at_dma_setup(const AtSrc& s, int w, int lane) {
    AtDma d;
    const int isv = w >> 2, kvh = (w >> 1) & 1, half = w & 1, row0 = lane >> 3;
    const int chE = isv ? ((lane & 7) ^ (((lane >> 4) & 1) << 2)) : ((lane & 7) ^ (lane >> 4)), chO = isv ? chE : (chE ^ 4);
    const bf16_t* b0 = isv ? s.v0 : s.k0;
    d.base = (const unsigned char*)(b0 + (size_t)kvh * s.kvstride + (size_t)(half * 32) * HD);
    d.voffE = (row0 * HD + chE * 8) * 2; d.voffO = (row0 * HD + chO * 8) * 2;
    d.ldsoff = isv * (2 * AT_KT) + kvh * AT_KT + half * 4096;
    return d;
}
DI void at_dma(const AtDma& d, int blk, LAS3 unsigned char* buf) {
    const unsigned char* p = d.base + (size_t)blk * (64 * HD * 2);
#pragma unroll
    for (int j = 0; j < 4; ++j)
        __builtin_amdgcn_global_load_lds((const unsigned*)(p + j * (8 * HD * 2) + ((j & 1) ? d.voffO : d.voffE)), (LAS3 unsigned*)(buf + d.ldsoff + j * 1024), 16, 0, 0);
}

template <int MODE, int PASS, int APROBE>
DI void at_step(LAS3 const unsigned char* Kb, LAS3 const unsigned char* Vb, const bf16x8v (&Q)[4], int k0, int tq, int lane, LAS3 const float* lut, bool blk_ok, bool farstep,
                float& m_run, float& l_run, f32x16 (&O)[2], f32x16& Lacc, float inv_l, LAS3 float* imp_row, float& bcarry) {
    const int r = lane & 31, hf = lane >> 5;
    f32x16 S[2];
#pragma unroll
    for (int sub = 0; sub < 2; ++sub) {
#pragma unroll
        for (int i = 0; i < 16; ++i) S[sub][i] = 0.f;
#pragma unroll
        for (int ks = 0; ks < 4; ++ks) {
            const bf16x8v a = *(LAS3 const bf16x8v*)(Kb + (32 * sub + r) * AT_KROW + (((2 * ks + hf) ^ ((r >> 1) & 7)) << 4));
            S[sub] = __builtin_amdgcn_mfma_f32_32x32x16_bf16(a, Q[ks], S[sub], 0, 0, 0);
        }
    }
    const int i16 = lane & 15, qq = i16 >> 2, pp = i16 & 3, g1 = (lane >> 4) & 1;
    LAS3 const unsigned char* vb = Vb + (4 * hf + qq) * AT_VROW + 16 * (2 * g1 + (pp >> 1)) + 8 * (pp & 1);
    LAS3 const unsigned char* vbd[2] = {vb + 64 * (qq >> 1), vb + 64 * (1 ^ (qq >> 1))};
    bf16x8v vf[2][2];
#define AT_LOADV(sub)                                                                                                                            \
    _Pragma("unroll") for (int s2 = 0; s2 < 2; ++s2)                                                                                             \
    _Pragma("unroll") for (int db = 0; db < 2; ++db) {                                                                                           \
        const s16x4v v0 = __builtin_amdgcn_ds_read_tr16_b64_v4i16((LAS3 s16x4v*)(vbd[db] + (32 * (sub) + 16 * s2) * AT_VROW));                   \
        const s16x4v v1 = __builtin_amdgcn_ds_read_tr16_b64_v4i16((LAS3 s16x4v*)(vbd[db] + (32 * (sub) + 16 * s2 + 8) * AT_VROW));               \
        vf[s2][db] = (bf16x8v){v0[0], v0[1], v0[2], v0[3], v1[0], v1[1], v1[2], v1[3]};                                                          \
    }
    if (PASS != 1) { AT_LOADV(0) }
    __builtin_amdgcn_sched_barrier(0);
    float mx = -INFINITY;
    const float bfar = lut[127];
    if (!farstep) {
#pragma unroll
        for (int sub = 0; sub < 2; ++sub)
#pragma unroll
            for (int i = 0; i < 16; ++i) {
                const int kp = k0 + 32 * sub + (i & 3) + 8 * (i >> 2) + 4 * hf;
                const int dist = MODE == 0 ? tq - (16 * kp + 31) : tq - kp;
                bool ok = dist >= 0 && blk_ok;
                if (MODE == 2) ok = ok && dist < 512;
                const int idx = dist < 0 ? 0 : (dist > 127 ? 127 : dist);
                float s = S[sub][i] + lut[idx];
                s = ok ? s : -INFINITY;
                S[sub][i] = s; mx = fmaxf(mx, s);
            }
    } else {
#pragma unroll
        for (int sub = 0; sub < 2; ++sub)
#pragma unroll
            for (int i = 0; i < 16; ++i) mx = fmaxf(mx, S[sub][i]);
        mx += bfar;
        if (MODE == 1) mx = blk_ok ? mx : -INFINITY;
    }
    float m_use, alpha = 1.f, m_new = m_run, sum = 0.f;
    const bf16x8v ones = {0x3F80, 0x3F80, 0x3F80, 0x3F80, 0x3F80, 0x3F80, 0x3F80, 0x3F80};
    if (PASS != 2) {
        { const auto rr = __builtin_amdgcn_permlane32_swap(__float_as_uint(mx), __float_as_uint(mx), false, false); mx = fmaxf(__uint_as_float(rr[0]), __uint_as_float(rr[1])); }
        m_new = fmaxf(m_run, mx);
        const float m_safe = (m_new == -INFINITY) ? 0.f : m_new;
        alpha = __builtin_amdgcn_exp2f(m_run - m_safe);
        m_use = farstep ? m_safe - bfar : m_safe;
        if (MODE == 1 && farstep) m_use = blk_ok ? m_use : INFINITY;
        if (PASS == 0) {
            if (__any(alpha != 1.0f)) {
#pragma unroll
                for (int db = 0; db < 2; ++db)
#pragma unroll
                    for (int i = 0; i < 16; ++i) O[db][i] *= alpha;
                Lacc[0] *= alpha;
            }
        }
    } else m_use = farstep ? m_run - bfar : m_run;
    __builtin_amdgcn_sched_barrier(0);
#pragma unroll
    for (int sub = 0; sub < 2; ++sub) {
        if (PASS != 2) {
#pragma unroll
            for (int i = 0; i < 16; ++i) { const float pv = __builtin_amdgcn_exp2f(S[sub][i] - m_use); S[sub][i] = pv; if (PASS != 0) sum += pv; }
        } else {
#pragma unroll
            for (int i = 0; i < 16; ++i) S[sub][i] = __builtin_amdgcn_exp2f(S[sub][i] - m_use) * inv_l;
            float bp[4], av[4];
#pragma unroll
            for (int a = 0; a < 4; ++a) {
                av[a] = S[sub][4 * a] + S[sub][4 * a + 1] + S[sub][4 * a + 2] + 0.5f * S[sub][4 * a + 3];
                bp[a] = __shfl_xor(0.5f * S[sub][4 * a + 3], 32);
            }
            const int sbase = (k0 >> 2) + 8 * sub + hf;
#pragma unroll
            for (int a = 0; a < 4; ++a) imp_row[sbase + 2 * a] = av[a] + (hf ? bp[a] : (a > 0 ? bp[a > 0 ? a - 1 : 0] : bcarry));
            bcarry = bp[3];
        }
        if (PASS != 1) {
#pragma unroll
            for (int s2 = 0; s2 < 2; ++s2) {
                u32x4 pw;
                pw.x = pk_bf16(S[sub][8 * s2 + 0], S[sub][8 * s2 + 1]); pw.y = pk_bf16(S[sub][8 * s2 + 2], S[sub][8 * s2 + 3]);
                pw.z = pk_bf16(S[sub][8 * s2 + 4], S[sub][8 * s2 + 5]); pw.w = pk_bf16(S[sub][8 * s2 + 6], S[sub][8 * s2 + 7]);
                const bf16x8v pf = __builtin_bit_cast(bf16x8v, pw);
#pragma unroll
                for (int db = 0; db < 2; ++db) O[db] = __builtin_amdgcn_mfma_f32_32x32x16_bf16(vf[s2][db], pf, O[db], 0, 0, 0);
                if (PASS == 0) Lacc = __builtin_amdgcn_mfma_f32_32x32x16_bf16(ones, pf, Lacc, 0, 0, 0);
            }
            __builtin_amdgcn_sched_barrier(0);
            if (sub == 0) { AT_LOADV(1) }
        }
    }
#undef AT_LOADV
    if (PASS != 2) { if (PASS != 0) l_run = l_run * alpha + sum; m_run = m_new; }
}

template <int MODE, bool IMP>
DI void at_step0(LAS3 const unsigned char* Kb, LAS3 const unsigned char* Vb, const bf16x8v (&Q)[4], int k0, int tq, int lane, LAS3 const float* lut, bool blk_ok, bool farstep,
                 f32x16& Cm, int& inited, f32x16 (&O)[2], f32x16& Lacc, float& l_run, LAS3 float* imp_row, float& bcarry) {
    const int r = lane & 31, hf = lane >> 5;
    f32x16 S[2];
#pragma unroll
    for (int sub = 0; sub < 2; ++sub) {
#pragma unroll
        for (int ks = 0; ks < 4; ++ks) {
            const bf16x8v a = *(LAS3 const bf16x8v*)(Kb + (32 * sub + r) * AT_KROW + (((2 * ks + hf) ^ ((r >> 1) & 7)) << 4));
            if (IMP && ks == 0) {
                f32x16 z;
#pragma unroll
                for (int i = 0; i < 16; ++i) z[i] = 0.f;
                S[sub] = __builtin_amdgcn_mfma_f32_32x32x16_bf16(a, Q[ks], z, 0, 0, 0);
            } else S[sub] = __builtin_amdgcn_mfma_f32_32x32x16_bf16(a, Q[ks], ks == 0 ? Cm : S[sub], 0, 0, 0);
        }
    }
    if (IMP) {
        const float cmv = Cm[0];
#pragma unroll
        for (int sub = 0; sub < 2; ++sub)
#pragma unroll
            for (int i = 0; i < 16; ++i) S[sub][i] += cmv;
    }
    const int i16 = lane & 15, qq = i16 >> 2, pp = i16 & 3, g1 = (lane >> 4) & 1;
    LAS3 const unsigned char* vb = Vb + (4 * hf + qq) * AT_VROW + 16 * (2 * g1 + (pp >> 1)) + 8 * (pp & 1);
    LAS3 const unsigned char* vbd[2] = {vb + 64 * (qq >> 1), vb + 64 * (1 ^ (qq >> 1))};
    bf16x8v vf[2][2];
#define AT_LOADV(sub)                                                                                                                            \
    _Pragma("unroll") for (int s2 = 0; s2 < 2; ++s2)                                                                                             \
    _Pragma("unroll") for (int db = 0; db < 2; ++db) {                                                                                           \
        const s16x4v v0 = __builtin_amdgcn_ds_read_tr16_b64_v4i16((LAS3 s16x4v*)(vbd[db] + (32 * (sub) + 16 * s2) * AT_VROW));                   \
        const s16x4v v1 = __builtin_amdgcn_ds_read_tr16_b64_v4i16((LAS3 s16x4v*)(vbd[db] + (32 * (sub) + 16 * s2 + 8) * AT_VROW));               \
        vf[s2][db] = (bf16x8v){v0[0], v0[1], v0[2], v0[3], v1[0], v1[1], v1[2], v1[3]};                                                          \
    }
    AT_LOADV(0)
    __builtin_amdgcn_sched_barrier(0);
    float mx = -INFINITY;
    if (!farstep) {
        const float bfar = lut[127];
        const int dbase = MODE == 0 ? tq - 16 * (k0 + 4 * hf) - 31 : tq - (k0 + 4 * hf);
#pragma unroll
        for (int sub = 0; sub < 2; ++sub) {
            float lv[16];
#pragma unroll
            for (int i = 0; i < 16; ++i) {
                const int koff = 32 * sub + (i & 3) + 8 * (i >> 2);
                const int dist = dbase - (MODE == 0 ? 16 * koff : koff);
                lv[i] = lut[dist < 0 ? 0 : (dist > 127 ? 127 : dist)];
            }
            __builtin_amdgcn_sched_barrier(0);
#pragma unroll
            for (int i = 0; i < 16; ++i) {
                const int koff = 32 * sub + (i & 3) + 8 * (i >> 2);
                const int dist = dbase - (MODE == 0 ? 16 * koff : koff);
                bool ok = dist >= 0 && blk_ok;
                if (MODE == 2) ok = ok && dist < 512;
                float sv = S[sub][i] + (lv[i] - bfar);
                sv = ok ? sv : -INFINITY;
                S[sub][i] = sv; mx = fmaxf(mx, sv);
            }
            __builtin_amdgcn_sched_barrier(0);
        }
    } else {
#pragma unroll
        for (int sub = 0; sub < 2; ++sub)
#pragma unroll
            for (int i = 0; i < 16; ++i) mx = fmaxf(mx, S[sub][i]);
        if (MODE == 1) mx = blk_ok ? mx : -INFINITY;
    }
    { const auto rr = __builtin_amdgcn_permlane32_swap(__float_as_uint(mx), __float_as_uint(mx), false, false); mx = fmaxf(__uint_as_float(rr[0]), __uint_as_float(rr[1])); }
    {
        const bool first = (mx > -INFINITY) && (inited == 0);
        const float delta = (first || mx > 8.0f) ? mx : 0.f;
        if (__any(delta != 0.f)) {
            const float alpha = first ? 1.0f : __builtin_amdgcn_exp2f(-delta);
#pragma unroll
            for (int sub = 0; sub < 2; ++sub)
#pragma unroll
                for (int i = 0; i < 16; ++i) S[sub][i] -= delta;
#pragma unroll
            for (int db = 0; db < 2; ++db)
#pragma unroll
                for (int i = 0; i < 16; ++i) O[db][i] *= alpha;
            if (!IMP) Lacc[0] *= alpha;
#pragma unroll
            for (int i = 0; i < 16; ++i) Cm[i] -= delta;
            if (IMP) {
                l_run *= alpha; bcarry *= alpha;
                for (int j = hf; j < (k0 >> 2); j += 2) imp_row[j] *= alpha;
            }
        }
        inited = first ? 1 : inited;
    }
    const unsigned pmask = (MODE == 1 && farstep && !blk_ok) ? 0u : 0xffffffffu;
    const bf16x8v ones = {0x3F80, 0x3F80, 0x3F80, 0x3F80, 0x3F80, 0x3F80, 0x3F80, 0x3F80};
    __builtin_amdgcn_sched_barrier(0);
#pragma unroll
    for (int sub = 0; sub < 2; ++sub) {
#pragma unroll
        for (int i = 0; i < 16; ++i) S[sub][i] = __builtin_amdgcn_exp2f(S[sub][i]);
        if (IMP) {
            float bp[4], av[4];
#pragma unroll
            for (int i = 0; i < 16; ++i) l_run += S[sub][i];
#pragma unroll
            for (int a = 0; a < 4; ++a) {
                av[a] = S[sub][4 * a] + S[sub][4 * a + 1] + S[sub][4 * a + 2] + 0.5f * S[sub][4 * a + 3];
                bp[a] = __shfl_xor(0.5f * S[sub][4 * a + 3], 32);
            }
            const int sbase = (k0 >> 2) + 8 * sub + hf;
#pragma unroll
            for (int a = 0; a < 4; ++a) imp_row[sbase + 2 * a] = av[a] + (hf ? bp[a] : (a > 0 ? bp[a > 0 ? a - 1 : 0] : bcarry));
            bcarry = bp[3];
        }
#pragma unroll
        for (int s2 = 0; s2 < 2; ++s2) {
            u32x4 pw;
            pw.x = pk_bf16(S[sub][8 * s2 + 0], S[sub][8 * s2 + 1]); pw.y = pk_bf16(S[sub][8 * s2 + 2], S[sub][8 * s2 + 3]);
            pw.z = pk_bf16(S[sub][8 * s2 + 4], S[sub][8 * s2 + 5]); pw.w = pk_bf16(S[sub][8 * s2 + 6], S[sub][8 * s2 + 7]);
            if (MODE == 1) { pw.x &= pmask; pw.y &= pmask; pw.z &= pmask; pw.w &= pmask; }
            const bf16x8v pf = __builtin_bit_cast(bf16x8v, pw);
#pragma unroll
            for (int db = 0; db < 2; ++db) O[db] = __builtin_amdgcn_mfma_f32_32x32x16_bf16(vf[s2][db], pf, O[db], 0, 0, 0);
            if (!IMP) Lacc = __builtin_amdgcn_mfma_f32_32x32x16_bf16(ones, pf, Lacc, 0, 0, 0);
        }
        __builtin_amdgcn_sched_barrier(0);
        if (sub == 0) { AT_LOADV(1) }
    }
#undef AT_LOADV
}

template <int MODE, int PASS, int APROBE>
DI void at_branch(LAS3 unsigned char* lds, const AtSrc& src, int blk_lo, int blk_hi, const bf16x8v (&Q)[4], int tq, int tid, int kvh, LAS3 const float* lut,
                  unsigned mlo, unsigned mhi, float& m_run, float& l_run, f32x16 (&O)[2], f32x16& Lacc, float inv_l, LAS3 float* imp_row) {
    const int lane = tid & 63;
    float bcarry = 0.f;
    f32x16 Cm; int inited = 0;
    if (PASS == 0 || PASS == 3) {
        const float bfar = lut[127];
#pragma unroll
        for (int i = 0; i < 16; ++i) Cm[i] = bfar;
    }
    const AtDma dma = at_dma_setup(src, __builtin_amdgcn_readfirstlane(tid >> 6), lane);
    at_dma(dma, blk_lo, lds);
    for (int blk = blk_lo; blk <= blk_hi; ++blk) {
        LAS3 unsigned char* buf = lds + ((blk - blk_lo) & 1) * AT_BUF;
        asm volatile("s_waitcnt vmcnt(0)" ::: "memory");
        __syncthreads();
        if (blk < blk_hi) at_dma(dma, blk + 1, lds + ((blk + 1 - blk_lo) & 1) * AT_BUF);
        bool blk_ok = true;
        if (MODE == 1) blk_ok = ((blk < 32 ? (mlo >> blk) : (mhi >> (blk - 32))) & 1u) != 0u;
        const int t0u = tq - (lane & 31);
        const bool farstep = MODE == 0 ? (t0u - 16 * (blk * 64 + 63) - 31 >= 128) : (MODE == 1 ? (t0u - blk * 64 - 63 >= 128) : (t0u - blk * 64 - 63 >= 128 && t0u + 31 - blk * 64 < 512));
        if (MODE != 1 || __any(blk_ok)) {
            if (PASS == 0 || PASS == 3) at_step0<MODE, PASS == 3>(buf + kvh * AT_KT, buf + 2 * AT_KT + kvh * AT_VT, Q, blk * 64, tq, lane, lut, blk_ok, farstep, Cm, inited, O, Lacc, l_run, imp_row, bcarry);
            else at_step<MODE, PASS, APROBE>(buf + kvh * AT_KT, buf + 2 * AT_KT + kvh * AT_VT, Q, blk * 64, tq, lane, lut, blk_ok, farstep, m_run, l_run, O, Lacc, inv_l, imp_row, bcarry);
        }
    }
    __syncthreads();
}

template <int APROBE> DI void p3_attention(const Params& p, LAS3 unsigned char* lds, int G) {
    unsigned char* ws = p.ws;
    const int tid = threadIdx.x, lane = tid & 63, h = __builtin_amdgcn_readfirstlane(tid >> 6), kvh = h >> 2, r = lane & 31, hf = lane >> 5;
    LAS3 float* lutall = (LAS3 float*)(lds + AT_LUT);
    {
        const float* rel = p.in[I_REL];
        for (int i = tid; i < 1024; i += MK_THREADS) lutall[i] = rel[rel_bucket(i & 127) * NH + (i >> 7)] * LOG2E;
    }
    __syncthreads();
    LAS3 const float* lut = lutall + h * 128;
    LAS3 float* impw = (LAS3 float*)(lds + AT_IMP);
    LAS3 float* vals = (LAS3 float*)(lds + AT_VAL);
    LAS3 unsigned char* selb = lds + AT_SEL;
    LAS3 float* ssq = (LAS3 float*)(lds + AT_SSQ);
    const bf16_t* qb = (const bf16_t*)(ws + R_QB);
    const float* gates = (const float*)(ws + R_GATE);
    const float* gn = p.in[I_GN_ATTN];
    bf16_t* mixed = APROBE ? (bf16_t*)(ws + R_BIG + 32 * MB) : (bf16_t*)(ws + WS_MIXED);
    const int tid_outer = tid;
    for (int ui = blockIdx.x; ui < 512; ui += G) {
        int tidv = tid_outer; asm volatile("" : "+v"(tidv));
        const int tid = tidv, lane = tid & 63, r = lane & 31, hf = lane >> 5;
        const int q8 = ui & 255, rnd = ui >> 8, b = q8 >> 6, j6 = q8 & 63, tb = rnd == 0 ? 127 - j6 : j6;
        const int t0 = 32 * tb, qb64 = tb >> 1, tq = t0 + r;
        const size_t tok = (size_t)b * T_ + tq;
        bf16x8v Q[4];
#pragma unroll
        for (int ks = 0; ks < 4; ++ks) Q[ks] = *(const bf16x8v*)(qb + tok * 512 + h * 64 + 16 * ks + 8 * hf);
        f32x16 O[2], Lacc;
#pragma unroll
        for (int db = 0; db < 2; ++db)
#pragma unroll
            for (int i = 0; i < 16; ++i) O[db][i] = 0.f;
#pragma unroll
        for (int i = 0; i < 16; ++i) Lacc[i] = 0.f;
        LAS3 float* oslot = (LAS3 float*)(lds + AT_IMP) + h * 2048 + lane;
        const size_t bh0 = (size_t)b * 2, bh1 = bh0 + 1;
        float inv_lo;
        {
            const bf16_t* kcb = (const bf16_t*)(ws + R_KCB); const bf16_t* vcb = (const bf16_t*)(ws + R_VCT);
            const AtSrc src{kcb + bh0 * 256 * 64, vcb + bh0 * 256 * 64, 256 * 64};
            const int nst = tb / 32 + 1;
            float m_run = -INFINITY, l_run = 0.f;
            at_branch<0, 3, APROBE>(lds, src, 0, nst - 1, Q, tq, tid, kvh, lut, 0u, 0u, m_run, l_run, O, Lacc, 0.f, impw + (h * 32 + r) * 65);
            const float l_tot = l_run + __shfl_xor(l_run, 32);
            inv_lo = l_tot > 0.f ? __builtin_amdgcn_rcpf(l_tot) : 0.f;
            if (hf == 0) ssq[h * 32 + r] = inv_lo;
            __syncthreads();
        }
        {
            const int row = tid >> 3, j8 = tid & 7, kr = row >> 5, tr = row & 31;
#pragma unroll
            for (int jj = 0; jj < 8; ++jj) {
                const int s = j8 * 8 + jj, db = qb64 - s;
                float v = 0.f;
#pragma unroll
                for (int g = 0; g < 4; ++g) v += impw[((kr * 4 + g) * 32 + tr) * 65 + s] * ssq[(kr * 4 + g) * 32 + tr];
                vals[row * 65 + s] = (db >= 0 && db < 2) ? 2.0e4f : (s == 0 ? 1.0e4f : (db >= 0 ? v : -1.0f));
            }
            __syncthreads();
            unsigned bits = 0u;
            {
                float vv[8]; int rk[8];
#pragma unroll
                for (int jj = 0; jj < 8; ++jj) { vv[jj] = vals[row * 65 + j8 * 8 + jj]; rk[jj] = 0; }
#pragma unroll 2
                for (int s2 = 0; s2 < 64; ++s2) {
                    const float w = vals[row * 65 + s2];
#pragma unroll
                    for (int jj = 0; jj < 8; ++jj) rk[jj] += (w > vv[jj] || (w == vv[jj] && s2 < j8 * 8 + jj)) ? 1 : 0;
                }
#pragma unroll
                for (int jj = 0; jj < 8; ++jj) if (rk[jj] < 16 && qb64 - (j8 * 8 + jj) >= 0) bits |= 1u << jj;
            }
            selb[row * 8 + j8] = (unsigned char)bits;
            __syncthreads();
        }
        const unsigned mlo = *(LAS3 const unsigned*)(selb + (kvh * 32 + r) * 8), mhi = *(LAS3 const unsigned*)(selb + (kvh * 32 + r) * 8 + 4);
        __syncthreads();
        {
            const float g0 = sigmoidf_(gates[tok * 24 + h * 3 + 0]) * inv_lo;
#pragma unroll
            for (int db = 0; db < 2; ++db)
#pragma unroll
                for (int i = 0; i < 16; ++i) { oslot[(db * 16 + i) * 64] = g0 * O[db][i]; O[db][i] = 0.f; }
        }
        {
            const bf16_t* ksb = (const bf16_t*)(ws + R_KS); const bf16_t* vsb = (const bf16_t*)(ws + R_VS);
            const AtSrc src{ksb + bh0 * T_ * HD, vsb + bh0 * T_ * HD, T_ * HD};
            float m_run = -INFINITY, l_run = 0.f;
#pragma unroll
            for (int i = 0; i < 16; ++i) Lacc[i] = 0.f;
            at_branch<1, 0, APROBE>(lds, src, 0, qb64, Q, tq, tid, kvh, lut, mlo, mhi, m_run, l_run, O, Lacc, 0.f, nullptr);
            const float sc = sigmoidf_(gates[tok * 24 + h * 3 + 1]) * __builtin_amdgcn_rcpf(Lacc[0]);
#pragma unroll
            for (int db = 0; db < 2; ++db)
#pragma unroll
                for (int i = 0; i < 16; ++i) { oslot[(db * 16 + i) * 64] += sc * O[db][i]; O[db][i] = 0.f; }
        }
        {
            const bf16_t* kwb = (const bf16_t*)(ws + R_KW); const bf16_t* vwb = (const bf16_t*)(ws + R_VW);
            const AtSrc src{kwb + bh0 * T_ * HD, vwb + bh0 * T_ * HD, T_ * HD};
            int wb0 = (t0 - 511) >> 6; wb0 = wb0 < 0 ? 0 : wb0;
            float m_run = -INFINITY, l_run = 0.f;
#pragma unroll
            for (int i = 0; i < 16; ++i) Lacc[i] = 0.f;
            at_branch<2, 0, APROBE>(lds, src, wb0, qb64, Q, tq, tid, kvh, lut, 0u, 0u, m_run, l_run, O, Lacc, 0.f, nullptr);
            const float sc = sigmoidf_(gates[tok * 24 + h * 3 + 2]) * __builtin_amdgcn_rcpf(Lacc[0]);
#pragma unroll
            for (int db = 0; db < 2; ++db)
#pragma unroll
                for (int i = 0; i < 16; ++i) O[db][i] = oslot[(db * 16 + i) * 64] + sc * O[db][i];
        }
        {
            float ss = 0.f;
#pragma unroll
            for (int db = 0; db < 2; ++db)
#pragma unroll
                for (int i = 0; i < 16; ++i) ss += O[db][i] * O[db][i];
            ss += __shfl_xor(ss, 32);
            if (hf == 0) ssq[h * 32 + r] = ss;
            __syncthreads();
            float tot = 0.f;
#pragma unroll
            for (int hh = 0; hh < 8; ++hh) tot += ssq[hh * 32 + r];
            const float rs = rsqrtf(tot * (1.0f / 512) + EPS);
#pragma unroll
            for (int db = 0; db < 2; ++db)
#pragma unroll
                for (int a = 0; a < 4; ++a) {
                    const int d = 32 * db + 8 * a + 4 * hf;
                    const f32x4 g4 = *(const f32x4*)(gn + h * 64 + d);
                    u32x2 w; w.x = pk_bf16(O[db][4 * a] * rs * g4[0], O[db][4 * a + 1] * rs * g4[1]); w.y = pk_bf16(O[db][4 * a + 2] * rs * g4[2], O[db][4 * a + 3] * rs * g4[3]);
                    *(u32x2*)(mixed + tok * DM + h * 64 + d) = w;
                }
            __syncthreads();
        }
    }
}
constexpr int LR_STRIDE = 516;
constexpr int LR_XC = 0, LR_A = 32 * LR_STRIDE * 4, LR_RS = 2 * 32 * LR_STRIDE * 4, LR_END = LR_RS + 256;
static_assert(LR_END <= 160 * 1024 - 256, "LRU LDS map");

template <bool FINAL>
DI void lru_phase(const Params& p, LAS3 unsigned char* lds, int G) {
    unsigned char* ws = p.ws;
    const int tid = threadIdx.x, lane = tid & 63, n = __builtin_amdgcn_readfirstlane(tid >> 6), r = lane & 31, hf = lane >> 5, ch = tid;
    LAS3 float* XC = (LAS3 float*)(lds + LR_XC); LAS3 float* AA = (LAS3 float*)(lds + LR_A); LAS3 float* RS = (LAS3 float*)(lds + LR_RS);
    const bf16_t* xr = (const bf16_t*)(ws + R_XR); const bf16_t* xg = (const bf16_t*)(ws + R_XG);
    float* sumP = (float*)(ws + WS_LRUP); float* sumH = (float*)(ws + WS_LRUH);
    bf16_t* mixed = (bf16_t*)(ws + WS_MIXED);
    bf16_t* lga = (bf16_t*)(ws + WS_LGA); bf16_t* lgb = (bf16_t*)(ws + WS_LGB);
    const float cw0 = p.in[I_CONV_W][0 * 512 + ch], cw1 = p.in[I_CONV_W][1 * 512 + ch], cw2 = p.in[I_CONV_W][2 * 512 + ch], cw3 = p.in[I_CONV_W][3 * 512 + ch], cb = p.in[I_CONV_B][ch];
    const float gl = FINAL ? p.in[I_GN_LRU][ch] : 0.f;
    float ba[2], bx[2], sp[2];
#pragma unroll
    for (int nb = 0; nb < 2; ++nb) { const int c2 = n * 64 + 32 * nb + r; ba[nb] = p.in[I_LRU_BA][c2]; bx[nb] = p.in[I_LRU_BX][c2]; sp[nb] = log1pf(__expf(-p.in[I_LRU_LAM][c2])); }
    const bf16_t* waT = (const bf16_t*)(ws + WS_WAT); const bf16_t* wxT = (const bf16_t*)(ws + WS_WXT);
    bf16x8v Ba[2][4], Bx[2][4];
#define LR_LOADB                                                                                         \
    _Pragma("unroll") for (int nb = 0; nb < 2; ++nb)                                                     \
    _Pragma("unroll") for (int ks = 0; ks < 4; ++ks) {                                                   \
        const size_t o = (size_t)(n * 64 + 32 * nb + r) * 64 + 16 * ks + 8 * hf;                         \
        Ba[nb][ks] = *(const bf16x8v*)(waT + o); Bx[nb][ks] = *(const bf16x8v*)(wxT + o);                \
    }
    if (!FINAL) { LR_LOADB }
    for (int ci = blockIdx.x; ci < 256; ci += G) {
        const int b = ci >> 6, cib = ci & 63, t0 = cib * 64;
        const size_t tok0 = (size_t)b * T_ + t0;
        float x1 = 0.f, x2 = 0.f, x3 = 0.f;
        if (t0 > 0) { x1 = bf2f(xr[(tok0 - 1) * 512 + ch]); x2 = bf2f(xr[(tok0 - 2) * 512 + ch]); x3 = bf2f(xr[(tok0 - 3) * 512 + ch]); }
        float hst = 0.f, pprod = 1.f;
        if (FINAL) {
            const float* Pp = sumP + (size_t)(b * 64) * 512 + ch; const float* Hp = sumH + (size_t)(b * 64) * 512 + ch;
            for (int k0 = 0; k0 < cib; k0 += 16) {
                float pv[16], hv[16];
#pragma unroll
                for (int j = 0; j < 16; ++j) { const int k = k0 + j < cib ? k0 + j : cib - 1; pv[j] = Pp[(size_t)k * 512]; hv[j] = Hp[(size_t)k * 512]; }
#pragma unroll
                for (int j = 0; j < 16; ++j) if (k0 + j < cib) hst = pv[j] * hst + hv[j];
            }
        }
#pragma unroll 1
        for (int half = 0; half < 2; ++half) {
            const size_t tokh = tok0 + half * 32;
            bf16_t gv[32];
            if (FINAL) {
#pragma unroll
                for (int t = 0; t < 32; ++t) gv[t] = xg[(tokh + t) * 512 + ch];
            }
            __syncthreads();
            {
                bf16_t xw[32]; float xv[32];
#pragma unroll
                for (int t = 0; t < 32; ++t) xw[t] = xr[(tokh + t) * 512 + ch];
#pragma unroll
                for (int t = 0; t < 32; ++t) xv[t] = bf2f(xw[t]);
#pragma unroll
                for (int t = 0; t < 32; ++t) {
                    const float x0 = xv[t];
                    XC[t * LR_STRIDE + ch] = cw0 * x3 + cw1 * x2 + cw2 * x1 + cw3 * x0 + cb;
                    x3 = x2; x2 = x1; x1 = x0;
                }
            }
            __syncthreads();
            {
                f32x16 ar[2], ai[2];
#pragma unroll
                for (int nb = 0; nb < 2; ++nb)
#pragma unroll
                    for (int i = 0; i < 16; ++i) { ar[nb][i] = 0.f; ai[nb][i] = 0.f; }
                if (FINAL) { LR_LOADB }
#pragma unroll
                for (int ks = 0; ks < 4; ++ks) {
                    LAS3 const float* src = XC + r * LR_STRIDE + n * 64 + 16 * ks + 8 * hf;
                    const f32x4 f0 = *(LAS3 const f32x4*)src, f1 = *(LAS3 const f32x4*)(src + 4);
                    u32x4 pw; pw.x = pk_bf16(f0[0], f0[1]); pw.y = pk_bf16(f0[2], f0[3]); pw.z = pk_bf16(f1[0], f1[1]); pw.w = pk_bf16(f1[2], f1[3]);
                    const bf16x8v af = __builtin_bit_cast(bf16x8v, pw);
#pragma unroll
                    for (int nb = 0; nb < 2; ++nb) {
                        ar[nb] = __builtin_amdgcn_mfma_f32_32x32x16_bf16(af, Ba[nb][ks], ar[nb], 0, 0, 0);
                        ai[nb] = __builtin_amdgcn_mfma_f32_32x32x16_bf16(af, Bx[nb][ks], ai[nb], 0, 0, 0);
                    }
                }
                __syncthreads();
#pragma unroll
                for (int nb = 0; nb < 2; ++nb)
#pragma unroll
                    for (int i = 0; i < 16; ++i) {
                        const int t = (i & 3) + 8 * (i >> 2) + 4 * hf, o = t * LR_STRIDE + n * 64 + 32 * nb + r;
                        const float xcv = XC[o];
                        const float rg = sigmoidf_(ar[nb][i] + ba[nb]), ig = sigmoidf_(ai[nb][i] + bx[nb]);
                        float log_a = -8.0f * rg * sp[nb];
                        bf16_t la_b = 0;
                        if (!FINAL) { la_b = f2bf(log_a); log_a = bf2f(la_b); }
                        const float av = __expf(log_a);
                        float omA = -2.0f * log_a * (1.0f + log_a * (1.0f + 0.66666667f * log_a)), omB = 1.0f - av * av;
                        asm volatile("" : "+v"(omA), "+v"(omB));
                        const float om = log_a > -0.0009765625f ? omA : omB;
                        AA[o] = FINAL ? av : log_a;
                        float bval = __builtin_amdgcn_sqrtf(om) * (ig * xcv);
                        if (!FINAL) bval = bf2f(f2bf(bval));
                        XC[o] = bval;
                    }
            }
            __syncthreads();
            if (!FINAL) {
#pragma unroll 8
                for (int t = 0; t < 32; ++t) { const float a = __expf(AA[t * LR_STRIDE + ch]); hst = a * hst + XC[t * LR_STRIDE + ch]; pprod *= a; }
                {
                    const int l8 = (tid & 63) * 8;
#pragma unroll
                    for (int q = 0; q < 4; ++q) {
                        const int t = n + 8 * q;
                        LAS3 const float* ap = AA + t * LR_STRIDE + l8; LAS3 const float* bp = XC + t * LR_STRIDE + l8;
                        const f32x4 a0 = *(LAS3 const f32x4*)ap, a1 = *(LAS3 const f32x4*)(ap + 4), b0 = *(LAS3 const f32x4*)bp, b1 = *(LAS3 const f32x4*)(bp + 4);
                        u32x4 wa, wb;
                        wa.x = pack2bf(a0[0], a0[1]); wa.y = pack2bf(a0[2], a0[3]); wa.z = pack2bf(a1[0], a1[1]); wa.w = pack2bf(a1[2], a1[3]);
                        wb.x = pack2bf(b0[0], b0[1]); wb.y = pack2bf(b0[2], b0[3]); wb.z = pack2bf(b1[0], b1[1]); wb.w = pack2bf(b1[2], b1[3]);
                        __builtin_nontemporal_store(wa, (u32x4*)(lga + (tokh + t) * 512 + l8)); __builtin_nontemporal_store(wb, (u32x4*)(lgb + (tokh + t) * 512 + l8));
                    }
                }
            } else {
                {
                    float av[32], bv[32];
#pragma unroll
                    for (int t = 0; t < 32; ++t) { av[t] = AA[t * LR_STRIDE + ch]; bv[t] = XC[t * LR_STRIDE + ch]; }
#pragma unroll
                    for (int t = 0; t < 32; ++t) { hst = av[t] * hst + bv[t]; XC[t * LR_STRIDE + ch] = hst * gelu_tanh(bf2f(gv[t])); }
                }
                __syncthreads();
                {
                    const int t = tid >> 4, part = tid & 15;
                    float s = 0.f;
#pragma unroll 8
                    for (int j = 0; j < 32; ++j) { const float v = XC[t * LR_STRIDE + part + 16 * j]; s += v * v; }
                    s += __shfl_xor(s, 1); s += __shfl_xor(s, 2); s += __shfl_xor(s, 4); s += __shfl_xor(s, 8);
                    if (part == 0) RS[t] = rsqrtf(s * (1.0f / 512) + EPS);
                }
                __syncthreads();
                {
                    const int t = tid >> 4, part = tid & 15; const float rs = RS[t];
                    const float* gp = p.in[I_GN_LRU] + part * 32; LAS3 const float* xp = XC + t * LR_STRIDE + part * 32;
                    bf16_t* dst = mixed + (tokh + t) * DM + 512 + part * 32;
#pragma unroll
                    for (int q = 0; q < 4; ++q) {
                        const f32x4 a = *(LAS3 const f32x4*)(xp + 8 * q), b = *(LAS3 const f32x4*)(xp + 8 * q + 4), ga = *(const f32x4*)(gp + 8 * q), gb = *(const f32x4*)(gp + 8 * q + 4);
                        u32x4 w; w.x = pack2bf(a[0] * rs * ga[0], a[1] * rs * ga[1]); w.y = pack2bf(a[2] * rs * ga[2], a[3] * rs * ga[3]);
                        w.z = pack2bf(b[0] * rs * gb[0], b[1] * rs * gb[1]); w.w = pack2bf(b[2] * rs * gb[2], b[3] * rs * gb[3]);
                        *(u32x4*)(dst + 8 * q) = w;
                    }
                }
            }
        }
        if (!FINAL) { sumP[(size_t)ci * 512 + ch] = pprod; sumH[(size_t)ci * 512 + ch] = hst; }
    }
    __syncthreads();
}
#undef LR_LOADB

constexpr int LF_X = 0, LF_RS = 64 * LR_STRIDE * 4, LF_END = LF_RS + 256;
static_assert(LF_END <= 160 * 1024 - 256, "LRU final LDS map");
DI void lru_final(const Params& p, LAS3 unsigned char* lds, int G) {
    unsigned char* ws = p.ws;
    const int tid = threadIdx.x, ch = tid;
    LAS3 float* XC = (LAS3 float*)(lds + LF_X); LAS3 float* RS = (LAS3 float*)(lds + LF_RS);
    const bf16_t* xg = (const bf16_t*)(ws + R_XG); const bf16_t* lga = (const bf16_t*)(ws + WS_LGA); const bf16_t* lgb = (const bf16_t*)(ws + WS_LGB);
    const float* sumP = (const float*)(ws + WS_LRUP); const float* sumH = (const float*)(ws + WS_LRUH);
    bf16_t* mixed = (bf16_t*)(ws + WS_MIXED);
    for (int ci = blockIdx.x; ci < 256; ci += G) {
        const int b = ci >> 6, cib = ci & 63, t0 = cib * 64;
        const size_t tok0 = (size_t)b * T_ + t0;
        bf16_t la[2][16], lb[2][16], gx[2][16];
#define LF_LOAD(SET, GRP) _Pragma("unroll") for (int t = 0; t < 16; ++t) { const size_t o = (tok0 + 16 * (GRP) + t) * 512 + ch; la[SET][t] = lga[o]; lb[SET][t] = lgb[o]; gx[SET][t] = xg[o]; }
#define LF_SCAN(SET, GRP) _Pragma("unroll") for (int t = 0; t < 16; ++t) { hst = __expf(bf2f(la[SET][t])) * hst + bf2f(lb[SET][t]); XC[(16 * (GRP) + t) * LR_STRIDE + ch] = hst * gelu_tanh(bf2f(gx[SET][t])); }
        LF_LOAD(0, 0)
        float hst = 0.f;
        {
            const float* Pp = sumP + (size_t)(b * 64) * 512 + ch; const float* Hp = sumH + (size_t)(b * 64) * 512 + ch;
            for (int k0 = 0; k0 < cib; k0 += 16) {
                float pv[16], hv[16];
#pragma unroll
                for (int j = 0; j < 16; ++j) { const int k = k0 + j < cib ? k0 + j : cib - 1; pv[j] = Pp[(size_t)k * 512]; hv[j] = Hp[(size_t)k * 512]; }
#pragma unroll
                for (int j = 0; j < 16; ++j) if (k0 + j < cib) hst = pv[j] * hst + hv[j];
            }
        }
        __syncthreads();
        LF_LOAD(1, 1) LF_SCAN(0, 0)
        LF_LOAD(0, 2) LF_SCAN(1, 1)
        LF_LOAD(1, 3) LF_SCAN(0, 2)
        LF_SCAN(1, 3)
#undef LF_LOAD
#undef LF_SCAN
        __syncthreads();
        {
            const int wv = tid >> 6, l8 = (tid & 63) * 8;
            const f32x4 ga = *(const f32x4*)(p.in[I_GN_LRU] + l8), gb = *(const f32x4*)(p.in[I_GN_LRU] + l8 + 4);
#pragma unroll
            for (int q = 0; q < 8; ++q) {
                const int t = wv + 8 * q;
                LAS3 const float* xp = XC + t * LR_STRIDE + l8;
                const f32x4 a = *(LAS3 const f32x4*)xp, b4 = *(LAS3 const f32x4*)(xp + 4);
                float sq = (a[0] * a[0] + a[1] * a[1]) + (a[2] * a[2] + a[3] * a[3]) + (b4[0] * b4[0] + b4[1] * b4[1]) + (b4[2] * b4[2] + b4[3] * b4[3]);
                sq = wave_sum(sq);
                const float rs = rsqrtf(sq * (1.0f / 512) + EPS);
                u32x4 w; w.x = pack2bf(a[0] * rs * ga[0], a[1] * rs * ga[1]); w.y = pack2bf(a[2] * rs * ga[2], a[3] * rs * ga[3]);
                w.z = pack2bf(b4[0] * rs * gb[0], b4[1] * rs * gb[1]); w.w = pack2bf(b4[2] * rs * gb[2], b4[3] * rs * gb[3]);
                *(u32x4*)(mixed + (tok0 + t) * DM + 512 + l8) = w;
            }
        }
    }
    __syncthreads();
}
typedef float f32x4v __attribute__((ext_vector_type(4)));
constexpr int CM_IMG = 0;
constexpr int CM_HID = 36864;
constexpr int CM_END = CM_HID + 16 * 264 * 2;
DI void p2_compress(const Params& p, LAS3 unsigned char* lds, int G) {
    unsigned char* ws = p.ws;
    const int tid = threadIdx.x, lane = tid & 63, wid = __builtin_amdgcn_readfirstlane(tid >> 6), row = lane & 15, kg = lane >> 4;
    for (int u = blockIdx.x; u < 256; u += G) {
        const int kv = u >> 7, bh = (u >> 4) & 7, c0 = (u & 15) * 16;
        const bf16_t* src = (const bf16_t*)(ws + (kv ? R_VC : R_KC)) + ((size_t)bh * T_ + 16 * c0) * HD;
        const bf16_t* W1T = (const bf16_t*)(ws + (kv ? WS_CW1V : WS_CW1K));
        const float* cb = (const float*)(ws + (kv ? WS_CBV : WS_CBK));
        const bf16_t* W2T = (const bf16_t*)(ws + (kv ? WS_CW2V : WS_CW2K));
        __syncthreads();
        {
            u32x4 cv[5];
#pragma unroll
            for (int k = 0; k < 5; ++k) { const int i = tid + k * MK_THREADS; if (i < 272 * 8) cv[k] = *(const u32x4*)(src + (size_t)(i >> 3) * HD + (i & 7) * 8); }
#pragma unroll
            for (int k = 0; k < 5; ++k) { const int i = tid + k * MK_THREADS; if (i < 272 * 8) { const int tau = i >> 3, cch = i & 7; *(LAS3 u32x4*)(lds + CM_IMG + tau * 128 + (tau >> 4) * 16 + cch * 16) = cv[k]; } }
        }
        __syncthreads();
        f32x4v acc[2] = {{0.f, 0.f, 0.f, 0.f}, {0.f, 0.f, 0.f, 0.f}};
        const bf16_t* wb0 = W1T + ((size_t)(wid * 2) * 64 * 64 + lane) * 8, * wb1 = wb0 + (size_t)64 * 64 * 8;
#pragma unroll 16
        for (int ks = 0; ks < 64; ++ks) {
            const int tau = 16 * row + (ks >> 1);
            const bf16x8v a = *(LAS3 const bf16x8v*)(lds + CM_IMG + tau * 128 + (tau >> 4) * 16 + (32 * (ks & 1) + 8 * kg) * 2);
            const bf16x8v b0 = *(const bf16x8v*)(wb0 + 512 * ks), b1 = *(const bf16x8v*)(wb1 + 512 * ks);
            acc[0] = __builtin_amdgcn_mfma_f32_16x16x32_bf16(a, b0, acc[0], 0, 0, 0);
            acc[1] = __builtin_amdgcn_mfma_f32_16x16x32_bf16(a, b1, acc[1], 0, 0, 0);
        }
#pragma unroll
        for (int nb = 0; nb < 2; ++nb) {
            const int col = wid * 32 + 16 * nb + row; const float bias = cb[col];
#pragma unroll
            for (int i = 0; i < 4; ++i) *(LAS3 bf16_t*)(lds + CM_HID + ((4 * kg + i) * 264 + col) * 2) = f2bf(gelu_tanh(acc[nb][i] + bias));
        }
        __syncthreads();
        if (wid < 4) {
            f32x4v o = {0.f, 0.f, 0.f, 0.f};
#pragma unroll
            for (int ks = 0; ks < 8; ++ks) {
                const bf16x8v a = *(LAS3 const bf16x8v*)(lds + CM_HID + (row * 264 + 32 * ks + 8 * kg) * 2);
                const bf16x8v b = *(const bf16x8v*)(W2T + (size_t)(wid * 16 + row) * 256 + 32 * ks + 8 * kg);
                o = __builtin_amdgcn_mfma_f32_16x16x32_bf16(a, b, o, 0, 0, 0);
            }
            const int d = wid * 16 + row;
#pragma unroll
            for (int i = 0; i < 4; ++i) {
                const int c = c0 + 4 * kg + i; const float v = c < NCMP ? o[i] : 0.f;
                ((float*)(ws + (kv ? WS_VCMP : WS_KCMP)))[((size_t)bh * 256 + c) * 64 + d] = v;
                if (kv) ((bf16_t*)(ws + R_VCT))[((size_t)bh * 256 + c) * 64 + d] = f2bf(v);
                else    ((bf16_t*)(ws + R_KCB))[((size_t)bh * 256 + c) * 64 + d] = f2bf(v);
            }
        }
    }
    __syncthreads();
}
DI void p2_vtranspose(const Params& p, LAS3 unsigned char* lds, int G) {
    unsigned char* ws = p.ws;
    const int tid = threadIdx.x;
    LAS3 bf16_t* tl = (LAS3 bf16_t*)lds;
    for (int u0 = blockIdx.x; u0 < 1024; u0 += 4 * G) {
        u32x4 v[4];
#pragma unroll
        for (int k = 0; k < 4; ++k) { const int u = u0 + k * G; if (u < 1024) {
            const int which = u >> 9, bh = (u >> 6) & 7, tt = u & 63;
            const bf16_t* src = (const bf16_t*)(ws + (which ? R_VW : R_VS)) + ((size_t)bh * T_ + tt * 64) * HD;
            v[k] = *(const u32x4*)(src + (size_t)(tid >> 3) * HD + (tid & 7) * 8); } }
        __syncthreads();
#pragma unroll
        for (int k = 0; k < 4; ++k) if (u0 + k * G < 1024) *(LAS3 u32x4*)(tl + k * 64 * 72 + (tid >> 3) * 72 + (tid & 7) * 8) = v[k];
        __syncthreads();
#pragma unroll
        for (int k = 0; k < 4; ++k) { const int u = u0 + k * G; if (u < 1024) {
            const int which = u >> 9, bh = (u >> 6) & 7, tt = u & 63;
            bf16_t* dst = (bf16_t*)(ws + (which ? R_VWT : R_VST)) + (size_t)bh * HD * T_ + tt * 64;
            LAS3 const bf16_t* t2 = tl + k * 64 * 72;
            const int d = tid >> 3, seg = tid & 7; u32x4 w;
            w.x = (unsigned)t2[(seg * 8 + 0) * 72 + d] | ((unsigned)t2[(seg * 8 + 1) * 72 + d] << 16); w.y = (unsigned)t2[(seg * 8 + 2) * 72 + d] | ((unsigned)t2[(seg * 8 + 3) * 72 + d] << 16);
            w.z = (unsigned)t2[(seg * 8 + 4) * 72 + d] | ((unsigned)t2[(seg * 8 + 5) * 72 + d] << 16); w.w = (unsigned)t2[(seg * 8 + 6) * 72 + d] | ((unsigned)t2[(seg * 8 + 7) * 72 + d] << 16);
            *(u32x4*)(dst + (size_t)d * T_ + seg * 8) = w; } }
    }
    __syncthreads();
}
DI int ord_enc(float f) { const int u = __float_as_int(f); return u ^ ((u >> 31) & 0x7fffffff); }
DI float ord_dec(int o) { return __int_as_float(o ^ ((o >> 31) & 0x7fffffff)); }
#define PEER_CE_DESC(a, b) do { const int _hi = max((a), (b)), _lo = min((a), (b)); (a) = _hi; (b) = _lo; } while (0)
#define PEER_CE_ASC(a, b)  do { const int _hi = max((a), (b)), _lo = min((a), (b)); (a) = _lo; (b) = _hi; } while (0)
DI void sort16_desc(int (&x)[16]) {
    constexpr int NET[63][2] = {{0, 1}, {2, 3}, {0, 2}, {1, 3}, {1, 2}, {4, 5}, {6, 7}, {4, 6}, {5, 7}, {5, 6}, {0, 4}, {2, 6}, {2, 4}, {1, 5}, {3, 7}, {3, 5}, {1, 2}, {3, 4}, {5, 6}, {8, 9}, {10, 11},
        {8, 10}, {9, 11}, {9, 10}, {12, 13}, {14, 15}, {12, 14}, {13, 15}, {13, 14}, {8, 12}, {10, 14}, {10, 12}, {9, 13}, {11, 15}, {11, 13}, {9, 10}, {11, 12}, {13, 14}, {0, 8}, {4, 12}, {4, 8},
        {2, 10}, {6, 14}, {6, 10}, {2, 4}, {6, 8}, {10, 12}, {1, 9}, {5, 13}, {5, 9}, {3, 11}, {7, 15}, {7, 11}, {3, 5}, {7, 9}, {11, 13}, {1, 2}, {3, 4}, {5, 6}, {7, 8}, {9, 10}, {11, 12}, {13, 14}};
#pragma unroll
    for (int c = 0; c < 63; ++c) PEER_CE_DESC(x[NET[c][0]], x[NET[c][1]]);
}
DI void merge16_desc(int (&a)[16], const int (&b)[16]) {
#pragma unroll
    for (int i = 0; i < 16; ++i) a[i] = max(a[i], b[15 - i]);
#pragma unroll
    for (int j = 8; j > 0; j >>= 1)
#pragma unroll
        for (int i = 0; i < 16; ++i) { const int l = i ^ j; if (l > i) PEER_CE_DESC(a[i], a[l]); }
}
constexpr int PR_KEYS = 0;
constexpr int PR_LST = 512 * 68 * 4;
constexpr int PR_RS = PR_LST + 128 * 36 * 4;
constexpr int PR_END = PR_RS + 1024;
static_assert(PR_END <= 160 * 1024 - 256, "PEER LDS map");

struct EpiPeerRoute {
    static constexpr bool PERM = true, AFTER_DRAIN = true;
    const float* ssq1; int* eout; float* gout; float* rs1out;
    DI void fused(const f32x4 (&acc)[2][2][4][2], const pg8::Unit& u, int wr, int wc, int fr, int fq, PG8_LAS unsigned char* lds, int wid, int lane) const {
        const int tid = wid * 64 + lane, head = u.pn;
        LAS3 int* KEYS = (LAS3 int*)(lds + PR_KEYS); LAS3 int* LST = (LAS3 int*)(lds + PR_LST); LAS3 float* RS = (LAS3 float*)(lds + PR_RS);
        if (tid < 256) { float s = 0.f; for (int j = 0; j < 16; ++j) s += ssq1[(size_t)j * NTOK + u.pm * 256 + tid]; RS[tid] = rsqrtf(s * (1.0f / DM) + EPS); if (u.pn == 0) rs1out[u.pm * 256 + tid] = RS[tid]; }
#pragma unroll 1
        for (int ai = 0; ai < 2; ++ai) {
            __syncthreads();
#pragma unroll
            for (int bj = 0; bj < 2; ++bj)
#pragma unroll
                for (int m = 0; m < 4; ++m)
#pragma unroll
                    for (int n = 0; n < 2; ++n) {
                        const int rl = 64 * wr + 16 * m + fr, kk0 = 32 * wc + 8 * fq + 4 * n, hl = ((rl * 2 + bj) * 2 + (kk0 >> 6));
                        const f32x4 v = ai == 0 ? acc[0][bj][m][n] : acc[1][bj][m][n];
                        u32x4 kq;
                        kq.x = (unsigned)((ord_enc(v[0]) & ~0x7f) | (127 - (kk0 + 0))); kq.y = (unsigned)((ord_enc(v[1]) & ~0x7f) | (127 - (kk0 + 1)));
                        kq.z = (unsigned)((ord_enc(v[2]) & ~0x7f) | (127 - (kk0 + 2))); kq.w = (unsigned)((ord_enc(v[3]) & ~0x7f) | (127 - (kk0 + 3)));
                        *(LAS3 u32x4*)(KEYS + hl * 68 + (kk0 & 63)) = kq;
                    }
            __syncthreads();
            int top[16];
            {
                LAS3 const int* src = KEYS + tid * 68;
                int t2[16];
#pragma unroll
                for (int q = 0; q < 4; ++q) { const u32x4 w = *(LAS3 const u32x4*)(src + 4 * q); top[4 * q] = (int)w.x; top[4 * q + 1] = (int)w.y; top[4 * q + 2] = (int)w.z; top[4 * q + 3] = (int)w.w; }
                sort16_desc(top);
#pragma unroll 1
                for (int g = 1; g < 4; ++g) {
#pragma unroll
                    for (int q = 0; q < 4; ++q) { const u32x4 w = *(LAS3 const u32x4*)(src + 16 * g + 4 * q); t2[4 * q] = (int)w.x; t2[4 * q + 1] = (int)w.y; t2[4 * q + 2] = (int)w.z; t2[4 * q + 3] = (int)w.w; }
                    sort16_desc(t2);
                    merge16_desc(top, t2);
                }
#pragma unroll
                for (int i = 0; i < 16; ++i) t2[i] = __shfl_xor(top[i], 1);
                merge16_desc(top, t2);
            }
            const int rl = tid >> 2;
            if ((lane & 1) == 0) {
                LAS3 int* dst = LST + rl * 36 + 16 * ((lane >> 1) & 1);
#pragma unroll
                for (int q = 0; q < 4; ++q) *(LAS3 u32x4*)(dst + 4 * q) = (u32x4){(unsigned)top[4 * q], (unsigned)top[4 * q + 1], (unsigned)top[4 * q + 2], (unsigned)top[4 * q + 3]};
            }
            __syncthreads();
            if (tid < 128) {
                int s1[16], s2[16];
                {
                    LAS3 const int* src = LST + tid * 36;
#pragma unroll
                    for (int q = 0; q < 4; ++q) {
                        const u32x4 wa = *(LAS3 const u32x4*)(src + 4 * q), wb = *(LAS3 const u32x4*)(src + 16 + 4 * q);
                        s1[4 * q] = (int)wa.x; s1[4 * q + 1] = (int)wa.y; s1[4 * q + 2] = (int)wa.z; s1[4 * q + 3] = (int)wa.w;
                        s2[4 * q] = (int)wb.x; s2[4 * q + 1] = (int)wb.y; s2[4 * q + 2] = (int)wb.z; s2[4 * q + 3] = (int)wb.w;
                    }
                }
                float v1[16], v2[16];
#pragma unroll
                for (int i = 0; i < 16; ++i) { v1[i] = ord_dec(s1[i] & ~0x7f); v2[i] = ord_dec(s2[i] & ~0x7f); }
#define PEER_CAND(a, b) ((ord_enc(v1[a] + v2[b]) & ~0xff) | (255 - (16 * (a) + (b))))
                int best[16], grp[16];
#pragma unroll
                for (int b = 0; b < 16; ++b) best[b] = PEER_CAND(0, b);
#pragma unroll
                for (int b = 0; b < 8; ++b) { grp[b] = PEER_CAND(1, b); grp[8 + b] = PEER_CAND(15 - b, 0); }
#pragma unroll
                for (int j = 8; j > 0; j >>= 1)
#pragma unroll
                    for (int i = 0; i < 16; ++i) { const int l = i ^ j; if (l > i) PEER_CE_DESC(grp[i], grp[l]); }
                merge16_desc(best, grp);
                grp[0] = PEER_CAND(2, 0); grp[1] = PEER_CAND(2, 1); grp[2] = PEER_CAND(2, 2); grp[3] = PEER_CAND(2, 3); grp[4] = PEER_CAND(2, 4);
                grp[5] = PEER_CAND(3, 0); grp[6] = PEER_CAND(3, 1); grp[7] = PEER_CAND(3, 2); grp[8] = PEER_CAND(3, 3);
                grp[9] = PEER_CAND(4, 0); grp[10] = PEER_CAND(4, 1); grp[11] = PEER_CAND(4, 2);
                grp[12] = PEER_CAND(5, 0); grp[13] = PEER_CAND(5, 1); grp[14] = PEER_CAND(6, 0); grp[15] = PEER_CAND(6, 1);
                sort16_desc(grp); merge16_desc(best, grp);
                grp[0] = PEER_CAND(7, 0); grp[1] = PEER_CAND(7, 1);
#pragma unroll
                for (int i = 2; i < 16; ++i) grp[i] = (int)0x80000000;
                PEER_CE_DESC(grp[0], grp[1]);
                merge16_desc(best, grp);
#undef PEER_CAND
                const float rs1 = RS[128 * ai + tid];
                float gsum = 0.f, gv[16]; int ev[16];
                const float mtop = ord_dec(best[0] & ~0xff) * rs1;
                LAS3 const int* lst = LST + tid * 36;
#pragma unroll
                for (int i = 0; i < 16; ++i) {
                    const float sc = ord_dec(best[i] & ~0xff) * rs1; gv[i] = __expf(sc - mtop); gsum += gv[i];
                    const int ab = 255 - (best[i] & 0xff);
                    ev[i] = (127 - (lst[ab >> 4] & 0x7f)) * 128 + (127 - (lst[16 + (ab & 15)] & 0x7f));
                }
                const float ginv = 1.0f / gsum;
                const size_t tok = (size_t)u.pm * 256 + 128 * ai + tid;
#pragma unroll
                for (int kq = 0; kq < 4; ++kq) {
                    *(u32x4*)(eout + tok * 128 + head * 16 + 4 * kq) = (u32x4){(unsigned)ev[4 * kq], (unsigned)ev[4 * kq + 1], (unsigned)ev[4 * kq + 2], (unsigned)ev[4 * kq + 3]};
                    *(f32x4*)(gout + tok * 128 + head * 16 + 4 * kq) = (f32x4){gv[4 * kq] * ginv, gv[4 * kq + 1] * ginv, gv[4 * kq + 2] * ginv, gv[4 * kq + 3] * ginv};
                }
            }
        }
        __syncthreads();
    }
    DI void operator()(const f32x4 (&)[2][2][4][2], const pg8::Unit&, int, int, int, int) const {}
};
struct SliceOrder : pg8::StaticOrder {
    int slice;
    __device__ bool next(int i, pg8::Unit& u) const { if (i > 0) return false; return pg8::StaticOrder::next(slice, u); }
};
DI void p5_peer_route(const Params& p, LAS3 unsigned char* lds, int G) {
    unsigned char* ws = p.ws;
    pg8::Gemm g{(const bf16_t*)(ws + R_H1B), (const bf16_t*)(ws + WS_WQS), NTOK, 2048, DM};
    EpiPeerRoute E{(const float*)(ws + WS_SSQ1), (int*)(ws + R_EXP), (float*)(ws + R_GSM), (float*)(ws + WS_RS1)};
    const int nslice = (512 + G - 1) / G;
#pragma unroll 1
    for (int s = 0; s < nslice; ++s) {
        SliceOrder S; S.init(NTOK, 2048, G, (int)blockIdx.x); S.slice = s;
        pg8::gemm_phase<EpiPeerRoute, SliceOrder>(lds, g, S, E, nullptr);
        __syncthreads();
    }
}
constexpr float V8_SCALE = 8.0f;
#define I8_LOADROW(E) (*(const u32x2*)(u8 + ((unsigned)(E) * (unsigned)(DM / 2) + (unsigned)(lane * 8))))
DI int i4_dotrow(const u32x2 w, const unsigned (&xq)[4]) {
    int a = __builtin_amdgcn_sdot4((int)((w.x << 4) & 0xF0F0F0F0u), (int)xq[0], 0, false); a = __builtin_amdgcn_sdot4((int)(w.x & 0xF0F0F0F0u), (int)xq[1], a, false);
    a = __builtin_amdgcn_sdot4((int)((w.y << 4) & 0xF0F0F0F0u), (int)xq[2], a, false); a = __builtin_amdgcn_sdot4((int)(w.y & 0xF0F0F0F0u), (int)xq[3], a, false);
    return a;
}
#define I8_DOTROW(W) i4_dotrow((W), xq)
#define I8_ISSUE(SET, EV, J0) do { int ev_ = (EV); asm volatile("" : "+v"(ev_)); _Pragma("unroll") for (int k = 0; k < 16; ++k) { const int e = __builtin_amdgcn_readlane(ev_, (J0) + k); \
        SET[k] = I8_LOADROW(e); } __builtin_amdgcn_sched_barrier(0); } while (0)
#define I8_CONS(SET, P0) do { _Pragma("unroll") for (int k = 0; k < 16; ++k) { \
        part[(P0) + k] = (float)I8_DOTROW(SET[k]); } __builtin_amdgcn_sched_barrier(0); } while (0)
#define I8_RS(M) do { const bool up = (lane & (M)) != 0; _Pragma("unroll") for (int i = 0; i < (M); ++i) { \
        const float send = up ? part[i] : part[i + (M)], keep = up ? part[i + (M)] : part[i]; part[i] = keep + __shfl_xor(send, (M)); } } while (0)
#define I8_RS32() do { _Pragma("unroll") for (int i = 0; i < 32; ++i) { const auto rr_ = __builtin_amdgcn_permlane32_swap(__float_as_uint(part[i]), __float_as_uint(part[i + 32]), false, false); \
        part[i] = __uint_as_float(rr_[0]) + __uint_as_float(rr_[1]); } } while (0)
#define I8_RS16() do { _Pragma("unroll") for (int i = 0; i < 16; ++i) { const auto rr_ = __builtin_amdgcn_permlane16_swap(__float_as_uint(part[i]), __float_as_uint(part[i + 16]), false, false); \
        part[i] = __uint_as_float(rr_[0]) + __uint_as_float(rr_[1]); } } while (0)
#define V4_ISSUE(SET, EV, J0) do { int ev_ = (EV); asm volatile("" : "+v"(ev_)); _Pragma("unroll") for (int k = 0; k < 16; ++k) { const int e = __builtin_amdgcn_readlane(ev_, (J0) + k); \
        SET[k] = *(const u32x2*)(v8 + ((unsigned)e * (unsigned)(DM / 2) + (unsigned)(lane * 8))); } __builtin_amdgcn_sched_barrier(0); } while (0)
#define V4_CVT(W, B) __builtin_amdgcn_cvt_scalef32_pk_f32_fp4((W), 1.0f, B)
#define V4_FMA(W, I) do { t_[4 * (I)] = __builtin_elementwise_fma(V4_CVT(W, 0), c2, t_[4 * (I)]); \
        t_[4 * (I) + 1] = __builtin_elementwise_fma(V4_CVT(W, 1), c2, t_[4 * (I) + 1]); \
        t_[4 * (I) + 2] = __builtin_elementwise_fma(V4_CVT(W, 2), c2, t_[4 * (I) + 2]); \
        t_[4 * (I) + 3] = __builtin_elementwise_fma(V4_CVT(W, 3), c2, t_[4 * (I) + 3]); } while (0)
#define V4_ROW(SET, CV, J0, K) do { const float c = (CV)[(J0) + (K)]; const f32x2 c2 = {c, c}; const u32x2 w_ = SET[K]; \
        V4_FMA(w_.x, 0); V4_FMA(w_.y, 1); } while (0)
#define V4_CONS(SET, CV, J0) do { f32x2 t_[8]; _Pragma("unroll") for (int i_ = 0; i_ < 8; ++i_) t_[i_] = (f32x2){0.f, 0.f}; V4_ROW(SET, CV, J0, 0); V4_ROW(SET, CV, J0, 1); V4_ROW(SET, CV, J0, 2); V4_ROW(SET, CV, J0, 3); V4_ROW(SET, CV, J0, 4); V4_ROW(SET, CV, J0, 5); \
        V4_ROW(SET, CV, J0, 6); V4_ROW(SET, CV, J0, 7); V4_ROW(SET, CV, J0, 8); V4_ROW(SET, CV, J0, 9); V4_ROW(SET, CV, J0, 10); V4_ROW(SET, CV, J0, 11); \
        V4_ROW(SET, CV, J0, 12); V4_ROW(SET, CV, J0, 13); V4_ROW(SET, CV, J0, 14); V4_ROW(SET, CV, J0, 15); \
        _Pragma("unroll") for (int i_ = 0; i_ < 8; ++i_) acc[i_] += t_[i_]; __builtin_amdgcn_sched_barrier(0); } while (0)
DI void p6fused(const Params& p, LAS3 unsigned char* lds, int G) {
    unsigned char* ws = p.ws;
    const int tid = threadIdx.x, lane = tid & 63, wid = tid >> 6;
    const int gw = blockIdx.x * 8 + wid, nw = G * 8;
    const unsigned char* u8 = (const unsigned char*)(ws + WS_UB); const unsigned char* v8 = (const unsigned char*)(ws + WS_VB);
    const int* eidx = (const int*)(ws + R_EXP); const float* gsm = (const float*)(ws + R_GSM); const float* rs1v = (const float*)(ws + WS_RS1);
    bf16_t* hb = (bf16_t*)(ws + R_H1B); float* rs2 = (float*)(ws + WS_RS2);
    LAS3 float* cl = (LAS3 float*)(lds + wid * 512);
    int en0 = 0, en1 = 0; u32x4 xna = {0u, 0u, 0u, 0u}, xnb = xna; float gn0 = 0.f, gn1 = 0.f, rsn = 0.f;
    if (gw < NTOK) { en0 = eidx[(size_t)gw * 128 + lane]; en1 = eidx[(size_t)gw * 128 + 64 + lane];
        xna = *(const u32x4*)(hb + (size_t)gw * DM + lane * 16); xnb = *(const u32x4*)(hb + (size_t)gw * DM + lane * 16 + 8);
        gn0 = gsm[(size_t)gw * 128 + lane]; gn1 = gsm[(size_t)gw * 128 + 64 + lane]; rsn = rs1v[gw]; }
#pragma unroll 1
    for (int tok = gw; tok < NTOK; tok += nw) {
        const int e0 = en0, e1 = en1; const u32x4 xa = xna, xb = xnb; const float g0 = gn0, g1 = gn1, rs1 = rsn;
        const int tn = tok + nw < NTOK ? tok + nw : tok;
        en0 = eidx[(size_t)tn * 128 + lane]; en1 = eidx[(size_t)tn * 128 + 64 + lane];
        {
            u32x2 sa[16], sb[16];
            I8_ISSUE(sa, e0, 0);
            I8_ISSUE(sb, e0, 16);
            xna = *(const u32x4*)(hb + (size_t)tn * DM + lane * 16); xnb = *(const u32x4*)(hb + (size_t)tn * DM + lane * 16 + 8);
            gn0 = gsm[(size_t)tn * 128 + lane]; gn1 = gsm[(size_t)tn * 128 + 64 + lane]; rsn = rs1v[tn];
            float xf[16];
#pragma unroll
            for (int q = 0; q < 4; ++q) { xf[2 * q] = bflo(xa[q]); xf[2 * q + 1] = bfhi(xa[q]); xf[8 + 2 * q] = bflo(xb[q]); xf[8 + 2 * q + 1] = bfhi(xb[q]); }
            float amax = 0.f;
#pragma unroll
            for (int i = 0; i < 16; ++i) amax = fmaxf(amax, fabsf(xf[i]));
            amax = wave_max(amax);
            const float sx = fmaxf(amax, 1e-20f) * (1.0f / 127.0f), isx = 1.0f / sx;
            unsigned xq[4];
#pragma unroll
            for (int q = 0; q < 2; ++q) {
                unsigned we = 0u, wo = 0u;
#pragma unroll
                for (int b = 0; b < 4; ++b) { we |= ((unsigned)(int)rintf(xf[8 * q + 2 * b] * isx) & 0xffu) << (8 * b); wo |= ((unsigned)(int)rintf(xf[8 * q + 2 * b + 1] * isx) & 0xffu) << (8 * b); }
                xq[2 * q] = we; xq[2 * q + 1] = wo;
            }
            const float scl = rs1 * sx * (1.0f / (16.0f * U4_ISCALE));
            float part[64];
            I8_CONS(sa, 0);  I8_ISSUE(sa, e0, 32);
            I8_CONS(sb, 16); I8_ISSUE(sb, e0, 48);
            I8_CONS(sa, 32); I8_ISSUE(sa, e1, 0);
            I8_CONS(sb, 48); I8_ISSUE(sb, e1, 16);
            I8_RS32(); I8_RS16(); I8_RS(8); I8_RS(4); I8_RS(2); I8_RS(1);
            cl[lane] = g0 * gelu_tanh(part[0] * scl) * (1.0f / V8_SCALE);
            I8_CONS(sa, 0);  I8_ISSUE(sa, e1, 32);
            I8_CONS(sb, 16); I8_ISSUE(sb, e1, 48);
            I8_CONS(sa, 32);
            I8_CONS(sb, 48);
            I8_RS32(); I8_RS16(); I8_RS(8); I8_RS(4); I8_RS(2); I8_RS(1);
            cl[64 + lane] = g1 * gelu_tanh(part[0] * scl) * (1.0f / V8_SCALE);
        }
        {
            u32x2 sa[16], sb[16];
            V4_ISSUE(sa, e0, 0);
            V4_ISSUE(sb, e0, 16);
            LAS3 const float* c0 = cl; LAS3 const float* c1 = cl + 64;
            const u32x4 ha = xa, hc = xb;
            const f32x4 hv0 = {bflo(ha.x), bfhi(ha.x), bflo(ha.y), bfhi(ha.y)}, hv1 = {bflo(ha.z), bfhi(ha.z), bflo(ha.w), bfhi(ha.w)};
            const f32x4 hv2 = {bflo(hc.x), bfhi(hc.x), bflo(hc.y), bfhi(hc.y)}, hv3 = {bflo(hc.z), bfhi(hc.z), bflo(hc.w), bfhi(hc.w)};
            f32x2 acc[8];
#pragma unroll
            for (int i = 0; i < 8; ++i) acc[i] = (f32x2){0.f, 0.f};
            V4_CONS(sa, c0, 0);  V4_ISSUE(sa, e0, 32);
            V4_CONS(sb, c0, 16); V4_ISSUE(sb, e0, 48);
            V4_CONS(sa, c0, 32); V4_ISSUE(sa, e1, 0);
            V4_CONS(sb, c0, 48); V4_ISSUE(sb, e1, 16);
            V4_CONS(sa, c1, 0);  V4_ISSUE(sa, e1, 32);
            V4_CONS(sb, c1, 16); V4_ISSUE(sb, e1, 48);
            V4_CONS(sa, c1, 32);
            V4_CONS(sb, c1, 48);
            const f32x4 o0 = hv0 + (f32x4){acc[0].x, acc[0].y, acc[1].x, acc[1].y}, o1 = hv1 + (f32x4){acc[2].x, acc[2].y, acc[3].x, acc[3].y};
            const f32x4 o2 = hv2 + (f32x4){acc[4].x, acc[4].y, acc[5].x, acc[5].y}, o3 = hv3 + (f32x4){acc[6].x, acc[6].y, acc[7].x, acc[7].y};
            u32x4 w0, w1;
            w0.x = pk_bf16(o0[0], o0[1]); w0.y = pk_bf16(o0[2], o0[3]); w0.z = pk_bf16(o1[0], o1[1]); w0.w = pk_bf16(o1[2], o1[3]);
            w1.x = pk_bf16(o2[0], o2[1]); w1.y = pk_bf16(o2[2], o2[3]); w1.z = pk_bf16(o3[0], o3[1]); w1.w = pk_bf16(o3[2], o3[3]);
            *(u32x4*)(hb + (size_t)tok * DM + lane * 16) = w0; *(u32x4*)(hb + (size_t)tok * DM + lane * 16 + 8) = w1;
            float ss = 0.f;
#pragma unroll
            for (int j = 0; j < 4; ++j) ss += o0[j] * o0[j] + o1[j] * o1[j] + o2[j] * o2[j] + o3[j] * o3[j];
            ss = wave_sum(ss);
            if (lane == 0) rs2[tok] = rsqrtf(ss * (1.0f / DM) + EPS);
        }
    }
}
#undef I8_ISSUE
#undef I8_CONS
#undef I8_RS
#undef I8_RS32
#undef I8_RS16
#undef V4_ISSUE
#undef V4_CONS
#undef V4_FMA
#undef V4_ROW
#undef V4_CVT
#undef I8_LOADROW
#undef I8_DOTROW

constexpr int LDS_MISC = 160 * 1024 - 256;
constexpr int LDS_BYTES = 160 * 1024;
constexpr size_t CTL_BAR = 0;
static_assert(XCD_BAR_WORDS * 4 <= 64 * 1024, "control region");

template <class F> struct EpiAdapt {
    static constexpr bool PERM = true, AFTER_DRAIN = false;
    F f;
    DI void operator()(const f32x4 (&acc)[2][2][4][2], const pg8::Unit& u, int wr, int wc, int fr, int fq) const {
        int fr_ = fr, fq_ = fq; asm volatile("" : "+v"(fr_), "+v"(fq_));
        const int row0 = u.pm * 256 + wr * 64 + fr_, col0 = u.pn * 256 + wc * 32 + 8 * fq_;
#pragma unroll
        for (int ai = 0; ai < 2; ++ai)
#pragma unroll
            for (int m = 0; m < 4; ++m) {
                const int row = row0 + ai * 128 + m * 16;
#pragma unroll
                for (int bj = 0; bj < 2; ++bj)
                    f.store8(row, col0 + bj * 128, acc[ai][bj][m][0], acc[ai][bj][m][1]);
            }
    }
};
template <class F> struct EpiAdaptSsq {
    static constexpr bool PERM = true, AFTER_DRAIN = false;
    F f; float* ssq;
    DI void operator()(const f32x4 (&acc)[2][2][4][2], const pg8::Unit& u, int wr, int wc, int fr, int fq) const {
        int fr_ = fr, fq_ = fq; asm volatile("" : "+v"(fr_), "+v"(fq_));
        const int row0 = u.pm * 256 + wr * 64 + fr_, col0 = u.pn * 256 + wc * 32 + 8 * fq_;
#pragma unroll
        for (int ai = 0; ai < 2; ++ai)
#pragma unroll
            for (int m = 0; m < 4; ++m) {
                const int row = row0 + ai * 128 + m * 16;
                float s = 0.f; const float rsc = f.rowscale(row);
#pragma unroll
                for (int bj = 0; bj < 2; ++bj)
                    s += f.store8r(row, col0 + bj * 128, acc[ai][bj][m][0], acc[ai][bj][m][1], rsc);
                s += __shfl_xor(s, 16); s += __shfl_xor(s, 32);
                if (fq_ == 0) ssq[(size_t)(u.pn * 4 + wc) * NTOK + row] = s;
            }
    }
};
struct EpiOutR {
    const bf16_t* xb; bf16_t* h1b;
    DI float rowscale(int) const { return 0.f; }
    DI float store8r(int row, int col, f32x4 v0, f32x4 v1, float) const {
        const size_t o = (size_t)row * DM + col;
        const u32x4 xw = *(const u32x4*)(xb + o);
        v0 += (f32x4){bflo(xw.x), bfhi(xw.x), bflo(xw.y), bfhi(xw.y)}; v1 += (f32x4){bflo(xw.z), bfhi(xw.z), bflo(xw.w), bfhi(xw.w)};
        u32x4 w; w.x = pack2bf(v0[0], v0[1]); w.y = pack2bf(v0[2], v0[3]); w.z = pack2bf(v1[0], v1[1]); w.w = pack2bf(v1[2], v1[3]); *(u32x4*)(h1b + o) = w;
        return ((v0[0] * v0[0] + v0[1] * v0[1]) + (v0[2] * v0[2] + v0[3] * v0[3])) + ((v1[0] * v1[0] + v1[1] * v1[1]) + (v1[2] * v1[2] + v1[3] * v1[3]));
    }
};
struct EpiBf16Plain { bf16_t* C; int ldc;
    DI void store8(int row, int col, f32x4 v0, f32x4 v1) const { u32x4 w; w.x = pack2bf(v0[0], v0[1]); w.y = pack2bf(v0[2], v0[3]); w.z = pack2bf(v1[0], v1[1]); w.w = pack2bf(v1[2], v1[3]); *(u32x4*)(C + (size_t)row * ldc + col) = w; } };
struct EpiGateR {
    const float* rs2; const float* bias; const bf16_t* pp; const bf16_t* h2; bf16_t* h3;
    DI float rowscale(int row) const { return rs2[row]; }
    DI float store8r(int row, int col, f32x4 v0, f32x4 v1, float s) const {
        const size_t o = (size_t)row * DM + col;
        const f32x4 b0 = *(const f32x4*)(bias + col), b1 = *(const f32x4*)(bias + col + 4); const u32x4 pw = *(const u32x4*)(pp + o), hw = *(const u32x4*)(h2 + o);
        float hv[8] = {bflo(hw.x), bfhi(hw.x), bflo(hw.y), bfhi(hw.y), bflo(hw.z), bfhi(hw.z), bflo(hw.w), bfhi(hw.w)};
        const float pv[8] = {bflo(pw.x), bfhi(pw.x), bflo(pw.y), bfhi(pw.y), bflo(pw.z), bfhi(pw.z), bflo(pw.w), bfhi(pw.w)};
        float ss = 0.f;
#pragma unroll
        for (int j = 0; j < 4; ++j) { hv[j] += sigmoidf_(v0[j] * s + b0[j]) * pv[j]; hv[4 + j] += sigmoidf_(v1[j] * s + b1[j]) * pv[4 + j]; }
#pragma unroll
        for (int j = 0; j < 8; ++j) ss += hv[j] * hv[j];
        u32x4 w; w.x = pack2bf(hv[0], hv[1]); w.y = pack2bf(hv[2], hv[3]); w.z = pack2bf(hv[4], hv[5]); w.w = pack2bf(hv[6], hv[7]); *(u32x4*)(h3 + o) = w;
        return ss;
    }
};

constexpr size_t CTL_PANEL = 16384;
struct EpiGateFinal {
    static constexpr bool PERM = true, AFTER_DRAIN = true;
    const float* rs2; const float* bias; const bf16_t* pp; const bf16_t* h2; float* ssq; unsigned* ctl; const float* gfin; float* out;
    DI void fused(const f32x4 (&acc_)[2][2][4][2], const pg8::Unit& u, int wr, int wc, int fr, int fq, PG8_LAS unsigned char*, int, int) const {
        f32x4 (&acc)[2][2][4][2] = const_cast<f32x4 (&)[2][2][4][2]>(acc_);
        int fr_ = fr, fq_ = fq; asm volatile("" : "+v"(fr_), "+v"(fq_));
        const int row0 = u.pm * 256 + wr * 64 + fr_, col0 = u.pn * 256 + wc * 32 + 8 * fq_;
#pragma unroll
        for (int ai = 0; ai < 2; ++ai)
#pragma unroll
            for (int m = 0; m < 4; ++m) {
                const int row = row0 + ai * 128 + m * 16;
                const float s = rs2[row];
                float ss = 0.f;
#pragma unroll
                for (int bj = 0; bj < 2; ++bj) {
                    const int col = col0 + bj * 128; const size_t o = (size_t)row * DM + col;
                    const f32x4 b0 = *(const f32x4*)(bias + col), b1 = *(const f32x4*)(bias + col + 4); const u32x4 pw = *(const u32x4*)(pp + o), hw = *(const u32x4*)(h2 + o);
                    const f32x4 v0 = acc[ai][bj][m][0], v1 = acc[ai][bj][m][1];
                    f32x4 h0 = {bflo(hw.x), bfhi(hw.x), bflo(hw.y), bfhi(hw.y)}, h1 = {bflo(hw.z), bfhi(hw.z), bflo(hw.w), bfhi(hw.w)};
                    const f32x4 p0 = {bflo(pw.x), bfhi(pw.x), bflo(pw.y), bfhi(pw.y)}, p1 = {bflo(pw.z), bfhi(pw.z), bflo(pw.w), bfhi(pw.w)};
#pragma unroll
                    for (int j = 0; j < 4; ++j) { h0[j] += sigmoidf_(v0[j] * s + b0[j]) * p0[j]; h1[j] += sigmoidf_(v1[j] * s + b1[j]) * p1[j]; }
#pragma unroll
                    for (int j = 0; j < 4; ++j) ss += h0[j] * h0[j] + h1[j] * h1[j];
                    acc[ai][bj][m][0] = h0; acc[ai][bj][m][1] = h1;
                }
                ss += __shfl_xor(ss, 16); ss += __shfl_xor(ss, 32);
                if (fq_ == 0) ssq[(size_t)(u.pn * 4 + wc) * NTOK + row] = ss;
            }
        asm volatile("s_waitcnt vmcnt(0)" ::: "memory");
        __syncthreads();
        if (threadIdx.x == 0) {
            unsigned* cnt = ctl + (CTL_PANEL / 4) + u.pm * 16;
            __builtin_amdgcn_fence(__ATOMIC_RELEASE, "agent");
            asm volatile("s_waitcnt vmcnt(0)" ::: "memory");
            (void)xb_add(cnt, 1u);
            XB_SPIN(xb_ld(cnt) < 4u, ctl);
            __builtin_amdgcn_fence(__ATOMIC_ACQUIRE, "agent");
            asm volatile("s_waitcnt vmcnt(0)" ::: "memory");
        }
        __syncthreads();
#pragma unroll
        for (int ai = 0; ai < 2; ++ai)
#pragma unroll
            for (int m = 0; m < 4; ++m) {
                const int row = row0 + ai * 128 + m * 16;
                float t = 0.f;
#pragma unroll
                for (int j = 0; j < 4; ++j) t += xb_ldf(ssq + (size_t)(4 * fq_ + j) * NTOK + row);
                t += __shfl_xor(t, 16); t += __shfl_xor(t, 32);
                const float rs = rsqrtf(t * (1.0f / DM) + EPS);
#pragma unroll
                for (int bj = 0; bj < 2; ++bj) {
                    const int col = col0 + bj * 128;
                    const f32x4 g0 = *(const f32x4*)(gfin + col), g1 = *(const f32x4*)(gfin + col + 4);
                    float* o = out + (size_t)row * DM + col;
                    *(f32x4*)o = acc[ai][bj][m][0] * rs * g0; *(f32x4*)(o + 4) = acc[ai][bj][m][1] * rs * g1;
                }
            }
    }
    DI void operator()(const f32x4 (&)[2][2][4][2], const pg8::Unit&, int, int, int, int) const {}
};

struct MegaArgs { Params p; int ph_lo, ph_hi; };

__global__ void __launch_bounds__(MK_THREADS, 2) mega_fwd(MegaArgs args) {
    extern __shared__ __attribute__((aligned(16))) unsigned char lds_raw[];
    LAS unsigned char* lds = (LAS unsigned char*)lds_raw;
    const Params& p = args.p;
    unsigned char* ws = p.ws;
    const int lo = args.ph_lo, hi = args.ph_hi;
    const int G = gridDim.x;
    volatile LAS unsigned* misc = (volatile LAS unsigned*)(lds + LDS_MISC);
    if (threadIdx.x < 64) misc[threadIdx.x] = 0u;
    __syncthreads();
    const XcdBarrier bar = xcd_barrier_post((unsigned*)(ws + WS_CTL), misc);
#define IN(k) (lo <= (k) && (k) < hi)
#define SEAM(k) do { if (IN(k) && IN((k) + 1)) xcd_barrier(bar); } while (0)

    if (IN(0)) p0_prologue(p, lds, G);
    SEAM(0);
    if (IN(1)) {
        pg8::Gemm g{(const bf16_t*)(ws + WS_XB), (const bf16_t*)(ws + WS_WIN), NTOK, NPROJ, DM};
        pg8::StaticOrder S; S.init(NTOK, NPROJ, G, (int)blockIdx.x);
        EpiAdapt<EpiProj> E{{(const float*)(ws + WS_RS0), (bf16_t*)(ws + R_QB), (bf16_t*)(ws + R_KC), (float*)(ws + R_GATE), (bf16_t*)(ws + R_XR), (bf16_t*)(ws + R_XG)}};
        pg8::gemm_phase<EpiAdapt<EpiProj>, pg8::StaticOrder>(lds, g, S, E, nullptr);
        p1_deferred(p, G);
    }
    SEAM(1);
    if (IN(2)) { p2_compress(p, lds, G); lru_phase<false>(p, lds, G); }
    SEAM(2);
    if (IN(3)) { p3_attention<0>(p, lds, G); lru_final(p, lds, G); }
    SEAM(3);
    if (IN(4)) {
        pg8::Gemm g{(const bf16_t*)(ws + WS_MIXED), (const bf16_t*)(ws + WS_WOUT), NTOK, DM, DM};
        pg8::StaticOrder S; S.init(NTOK, DM, G, (int)blockIdx.x);
        EpiAdaptSsq<EpiOutR> E{{(const bf16_t*)(ws + WS_XB), (bf16_t*)(ws + R_H1B)}, (float*)(ws + WS_SSQ1)};
        pg8::gemm_phase<EpiAdaptSsq<EpiOutR>, pg8::StaticOrder>(lds, g, S, E, nullptr);
    }
    SEAM(4);
    if (IN(5)) p5_peer_route(p, lds, G);
    SEAM(5);
    if (IN(6)) p6fused(p, lds, G);
    SEAM(6);
    if (IN(7)) {
        {
            pg8::Gemm g{(const bf16_t*)(ws + WS_PB), (const bf16_t*)(ws + WS_WP), NTOK, DM, PLE};
            pg8::StaticOrder S; S.init(NTOK, DM, G, (int)blockIdx.x);
            EpiAdapt<EpiBf16Plain> E{{(bf16_t*)(ws + R_BIG), DM}};
            pg8::gemm_phase<EpiAdapt<EpiBf16Plain>, pg8::StaticOrder>(lds, g, S, E, nullptr);
        }
        __syncthreads();
        if (G >= 256) {
            pg8::Gemm g{(const bf16_t*)(ws + R_H1B), (const bf16_t*)(ws + WS_WG), NTOK, DM, DM};
            pg8::StaticOrder S; S.init(NTOK, DM, G, (int)blockIdx.x);
            EpiGateFinal E{(const float*)(ws + WS_RS2), p.in[I_PLE_BG], (const bf16_t*)(ws + R_BIG), (const bf16_t*)(ws + R_H1B), (float*)(ws + WS_SSQ3), (unsigned*)(ws + WS_CTL), p.in[I_FINAL_NORM], p.out};
            pg8::gemm_phase<EpiGateFinal, pg8::StaticOrder>(lds, g, S, E, nullptr);
        } else {
            pg8::Gemm g{(const bf16_t*)(ws + R_H1B), (const bf16_t*)(ws + WS_WG), NTOK, DM, DM};
            pg8::StaticOrder S; S.init(NTOK, DM, G, (int)blockIdx.x);
            EpiAdaptSsq<EpiGateR> E{{(const float*)(ws + WS_RS2), p.in[I_PLE_BG], (const bf16_t*)(ws + R_BIG), (const bf16_t*)(ws + R_H1B), (bf16_t*)(ws + WS_XB)}, (float*)(ws + WS_SSQ3)};
            pg8::gemm_phase<EpiAdaptSsq<EpiGateR>, pg8::StaticOrder>(lds, g, S, E, nullptr);
        }
    }
    if (G < 256) {
        SEAM(7);
        if (IN(8)) p8_final_norm(p, G);
    }
#undef IN
#undef SEAM
}

static int g_grid = 0;
static void launch_mega(hipStream_t st, const Params& p, int lo, int hi) {
    if (g_grid == 0) {
        int dev = 0, cus = 0, per_cu = 0;
        hipGetDevice(&dev); hipDeviceGetAttribute(&cus, hipDeviceAttributeMultiprocessorCount, dev);
        if (hipFuncSetAttribute((const void*)mega_fwd, hipFuncAttributeMaxDynamicSharedMemorySize, LDS_BYTES) != hipSuccess) { fprintf(stderr, "hipFuncSetAttribute failed\n"); g_grid = -1; return; }
        if (hipOccupancyMaxActiveBlocksPerMultiprocessor(&per_cu, (const void*)mega_fwd, MK_THREADS, LDS_BYTES) != hipSuccess || per_cu < 1) { fprintf(stderr, "occupancy query: %d per CU\n", per_cu); }
        (void)hipGetLastError();
        g_grid = cus;
    }
    if (g_grid < 0) return;
    MegaArgs a{}; a.p = p; a.ph_lo = lo; a.ph_hi = hi;
    hipLaunchKernelGGL(mega_fwd, dim3(g_grid), dim3(MK_THREADS), LDS_BYTES, st, a);
}
extern "C" void kernel_launch(void* const* d_in, const int* in_sizes, int n_in, void* d_out, int out_size, void* d_ws, size_t ws_size, hipStream_t stream) {
    if (n_in != 31 || out_size != NTOK * DM || ws_size < WS_END) { fprintf(stderr, "kernel_launch: unexpected shapes (n_in %d out %d ws %zu)\n", n_in, out_size, ws_size); return; }
    Params p{};
    for (int i = 0; i < 31; ++i) p.in[i] = (const float*)d_in[i];
    p.out = (float*)d_out; p.ws = (unsigned char*)d_ws;
    (void)hipMemsetAsync((char*)d_ws + WS_CTL, 0, 16384 + 4096, stream);
    launch_mega(stream, p, 0, 9);
}
```
